# Optimizing an MI355X kernel written in HIP

```python
import jax
import jax.numpy as jnp
from jax import lax
import numpy as np

D_MODEL = 1024
BATCH = 8
SEQ = 2048
DEPTH = 4
DEC_BATCH = 128
DEC_SEQ = 1
PAST_LEN = 16384
PAGE_SIZE = 128

N_META = 16
N_MIXERS = 2
N_RET = (DEPTH + 1) // 2
N_RWKV = DEPTH // 2
RET_HEADS = 4
RET_DK = D_MODEL // RET_HEADS
RET_DV = 2 * RET_DK
RET_VDIM = RET_HEADS * RET_DV
RET_CHUNK = 128
RWKV_HEAD = 64
RWKV_HEADS = D_MODEL // RWKV_HEAD
LORA_W = 64
LORA_A = 64
LORA_V = 32
LORA_G = 160
D_FF = 2816
CONV_W = 3
RMS_EPS = 1e-6
RET_GN_EPS = 1e-5
RWKV_GN_EPS = 64e-5

kernel_name = 'hybrid_retention_rwkv7_convffn_step'


def rmsnorm(x, g):
    return x * lax.rsqrt(jnp.mean(jnp.square(x), axis=-1, keepdims=True) + RMS_EPS) * g


def head_norm(y, eps):
    yc = y - jnp.mean(y, axis=-1, keepdims=True)
    return yc * lax.rsqrt(jnp.mean(jnp.square(yc), axis=-1, keepdims=True) + eps)


def rotary(x, pos):
    half = x.shape[-1] // 2
    inv = 1.0 / (10000.0 ** jnp.linspace(0.0, 1.0, half, dtype=jnp.float32))
    ang = pos.astype(jnp.float32)[:, None] * inv[None, :]
    cos = jnp.cos(ang)[None, :, None, :]
    sin = jnp.sin(ang)[None, :, None, :]
    x1, x2 = x[..., :half], x[..., half:]
    return jnp.concatenate([x1 * cos - x2 * sin, x1 * sin + x2 * cos], axis=-1)


def retention_chunk(q, k, v, S, log_g):
    L = q.shape[2]
    idx = jnp.arange(L, dtype=jnp.float32)
    rel = idx[:, None] - idx[None, :]
    dec = jnp.where(rel >= 0, jnp.exp(log_g[:, None, None] * jnp.maximum(rel, 0.0)), 0.0)
    scores = jnp.einsum('bhid,bhjd->bhij', q, k) * dec[None]
    o = (jnp.einsum('bhij,bhje->bhie', scores, v)
         + jnp.exp(log_g[:, None] * (idx + 1.0))[None, :, :, None] * jnp.einsum('bhid,bhde->bhie', q, S))
    kd = k * jnp.exp(log_g[:, None] * (L - 1.0 - idx))[None, :, :, None]
    S_new = jnp.exp(log_g * L)[None, :, None, None] * S + jnp.einsum('bhjd,bhje->bhde', kd, v)
    return o, S_new


def retention_seq(q, k, v, S, log_g, lead):
    B, H, L, _ = q.shape
    S = S.astype(jnp.float32)
    if lead:
        padw = ((0, 0), (0, 0), (lead, 0), (0, 0))
        q, k, v = jnp.pad(q, padw), jnp.pad(k, padw), jnp.pad(v, padw)
    total = lead + L
    n_full = total // RET_CHUNK
    rem = total - n_full * RET_CHUNK
    outs = []
    if n_full:
        def to_chunks(t):
            t = t[:, :, :n_full * RET_CHUNK].reshape(B, H, n_full, RET_CHUNK, t.shape[-1])
            return t.transpose(2, 0, 1, 3, 4)

        def body(S_c, qkv):
            qc, kc, vc = qkv
            o_c, S_c = retention_chunk(qc, kc, vc, S_c, log_g)
            return S_c, o_c

        S, o = lax.scan(body, S, (to_chunks(q), to_chunks(k), to_chunks(v)))
        outs.append(o.transpose(1, 2, 0, 3, 4).reshape(B, H, n_full * RET_CHUNK, RET_DV))
    if rem:
        s0 = n_full * RET_CHUNK
        o, S = retention_chunk(q[:, :, s0:], k[:, :, s0:], v[:, :, s0:], S, log_g)
        outs.append(o)
    o = jnp.concatenate(outs, axis=2)[:, :, lead:]
    return o, S


def retention_mixer(x, S, pos, lead, w_in, gn_w, w_out):
    B, T, _ = x.shape
    proj = x @ w_in
    qk = RET_HEADS * RET_DK
    q = rotary(proj[..., :qk].reshape(B, T, RET_HEADS, RET_DK), pos)
    k = rotary(proj[..., qk:2 * qk].reshape(B, T, RET_HEADS, RET_DK), pos) * (RET_DK ** -0.5)
    v = proj[..., 2 * qk:2 * qk + RET_VDIM].reshape(B, T, RET_HEADS, RET_DV)
    g = proj[..., 2 * qk + RET_VDIM:]
    log_g = jnp.log(1.0 - 2.0 ** (-5.0 - jnp.arange(RET_HEADS, dtype=jnp.float32)))
    o, S = retention_seq(q.transpose(0, 2, 1, 3), k.transpose(0, 2, 1, 3), v.transpose(0, 2, 1, 3), S, log_g, lead)
    o = head_norm(o.transpose(0, 2, 1, 3), RET_GN_EPS) * gn_w.reshape(RET_HEADS, RET_DV)
    o = jax.nn.silu(g) * o.reshape(B, T, RET_VDIM)
    return o @ w_out, S


def rwkv7_mixer(x, prev, S, v_first, vres, p, j):
    B, T, D = x.shape
    H, N = RWKV_HEADS, RWKV_HEAD
    xprev = jnp.concatenate([prev[:, None, :].astype(jnp.float32), x[:, :-1]], axis=1)
    xs = x[None] + (xprev - x)[None] * p['rwkv_mu'][j][:, None, None, :]
    xr, xw, xk, xv, xa, xg = xs[0], xs[1], xs[2], xs[3], xs[4], xs[5]
    rkv = jnp.einsum('nbtd,nde->nbte', jnp.stack([xr, xk, xv]), p['rwkv_w_rkv'][j])
    r, k, v = rkv[0], rkv[1], rkv[2]
    logw = -jax.nn.softplus(-(p['rwkv_w0'][j] + jnp.tanh(xw @ p['rwkv_w1'][j]) @ p['rwkv_w2'][j])) - 0.5
    w = jnp.exp(-jnp.exp(logw))
    a = jax.nn.sigmoid(p['rwkv_a0'][j] + (xa @ p['rwkv_a1'][j]) @ p['rwkv_a2'][j])
    g = jax.nn.sigmoid(xg @ p['rwkv_g1'][j]) @ p['rwkv_g2'][j]
    kk = (k * p['rwkv_k_k'][j]).reshape(B, T, H, N)
    kk = kk * lax.rsqrt(jnp.maximum(jnp.sum(jnp.square(kk), axis=-1, keepdims=True), 1e-12))
    k = k * (1.0 + (a - 1.0) * p['rwkv_k_a'][j])
    if vres is None:
        v_first = v
    else:
        v0, v1, v2 = vres
        v = v + (v_first - v) * jax.nn.sigmoid(v0 + (xv @ v1) @ v2)
    rh, wh, kh, vh, ah = [t.reshape(B, T, H, N) for t in (r, w, k, v, a)]

    def step(S_t, inp):
        r_t, w_t, k_t, v_t, kk_t, a_t = inp
        sa = jnp.einsum('bhij,bhj->bhi', S_t, -kk_t)
        S_t = (S_t * w_t[:, :, None, :] + sa[..., None] * (kk_t * a_t)[:, :, None, :]
               + v_t[..., None] * k_t[:, :, None, :])
        return S_t, jnp.einsum('bhij,bhj->bhi', S_t, r_t)

    seq = tuple(jnp.swapaxes(t, 0, 1) for t in (rh, wh, kh, vh, kk, ah))
    S, y = lax.scan(step, S.astype(jnp.float32), seq)
    y = jnp.swapaxes(y, 0, 1)
    y = head_norm(y, RWKV_GN_EPS).reshape(B, T, D) * p['rwkv_ln_w'][j] + p['rwkv_ln_b'][j]
    bonus = jnp.sum(rh * kh * p['rwkv_r_k'][j], axis=-1, keepdims=True) * vh
    out = ((y + bonus.reshape(B, T, D)) * g) @ p['rwkv_w_o'][j]
    return out, x[:, -1], S, v_first


def conv_ffn(x, buf, w_ug, conv_w, conv_b, w_d):
    T = x.shape[1]
    ug = x @ w_ug
    u, gate = ug[..., :D_FF], ug[..., D_FF:]
    cat = jnp.concatenate([buf.astype(jnp.float32), gate], axis=1)
    conv = conv_b + sum(cat[:, t:t + T] * conv_w[t] for t in range(CONV_W))
    return (jax.nn.silu(conv) * u) @ w_d, cat[:, T:]


def trunk(x, pos, lead, ret_S, wkv_S, shift, conv_buf, p):
    x = x.astype(jnp.float32)
    new_ret, new_wkv, new_shift, new_conv = [], [], [], []
    v_first = None
    for i in range(DEPTH):
        j = i // N_MIXERS
        h = rmsnorm(x, p['norm_mix'][i])
        if i % N_MIXERS == 0:
            o, s = retention_mixer(h, ret_S[j], pos, lead, p['ret_w_in'][j], p['ret_gn_w'][j], p['ret_w_out'][j])
            new_ret.append(s)
        else:
            vres = None if j == 0 else (p['rwkv_v0'][j - 1], p['rwkv_v1'][j - 1], p['rwkv_v2'][j - 1])
            o, sh, s, v_first = rwkv7_mixer(h, shift[j], wkv_S[j], v_first, vres, p, j)
            new_wkv.append(s)
            new_shift.append(sh)
        x = x + o
        f, cb = conv_ffn(rmsnorm(x, p['norm_ffn'][i]), conv_buf[i], p['ffn_w_ug'][i],
                         p['ffn_conv_w'][i], p['ffn_conv_b'][i], p['ffn_w_d'][i])
        new_conv.append(cb)
        x = x + f
    return (rmsnorm(x, p['norm_final']), jnp.stack(new_ret), jnp.stack(new_wkv),
            jnp.stack(new_shift), jnp.stack(new_conv))


def setup_inputs(seed: int = 0) -> dict:
    key = jax.random.key(seed)
    ks = iter(jax.random.split(key, 48))
    f32 = jnp.float32

    def nrm(shape, scale):
        return jax.random.normal(next(ks), shape, f32) * scale

    Dm = D_MODEL
    nv = N_RWKV - 1
    inp = {}
    inp['x_prompt'] = nrm((BATCH, SEQ, Dm), 1.0)
    inp['x_sample'] = nrm((DEC_BATCH, DEC_SEQ, Dm), 1.0)
    inp['state_ret'] = nrm((N_RET, DEC_BATCH, RET_HEADS, RET_DK, RET_DV), 0.5)
    inp['state_wkv'] = nrm((N_RWKV, DEC_BATCH, RWKV_HEADS, RWKV_HEAD, RWKV_HEAD), 0.5)
    inp['state_shift'] = nrm((N_RWKV, DEC_BATCH, Dm), 1.0)
    inp['state_conv'] = nrm((DEPTH, DEC_BATCH, CONV_W - 1, D_FF), 1.0)
    inp['meta_tokens'] = nrm((N_META, Dm), 1.0)
    inp['norm_mix'] = 1.0 + nrm((DEPTH, Dm), 0.01)
    inp['norm_ffn'] = 1.0 + nrm((DEPTH, Dm), 0.01)
    inp['norm_final'] = 1.0 + nrm((Dm,), 0.01)
    inp['ret_w_in'] = nrm((N_RET, Dm, 2 * RET_HEADS * RET_DK + 2 * RET_VDIM), Dm ** -0.5)
    inp['ret_gn_w'] = 1.0 + nrm((N_RET, RET_VDIM), 0.01)
    inp['ret_w_out'] = nrm((N_RET, RET_VDIM, Dm), RET_VDIM ** -0.5)
    inp['rwkv_mu'] = jax.random.uniform(next(ks), (N_RWKV, 6, Dm), f32)
    inp['rwkv_w_rkv'] = nrm((N_RWKV, 3, Dm, Dm), Dm ** -0.5)
    inp['rwkv_w0'] = nrm((N_RWKV, Dm), 0.5)
    inp['rwkv_w1'] = nrm((N_RWKV, Dm, LORA_W), Dm ** -0.5)
    inp['rwkv_w2'] = nrm((N_RWKV, LORA_W, Dm), 0.5 * LORA_W ** -0.5)
    inp['rwkv_a0'] = nrm((N_RWKV, Dm), 0.5)
    inp['rwkv_a1'] = nrm((N_RWKV, Dm, LORA_A), Dm ** -0.5)
    inp['rwkv_a2'] = nrm((N_RWKV, LORA_A, Dm), 0.5 * LORA_A ** -0.5)
    inp['rwkv_v0'] = nrm((nv, Dm), 0.5)
    inp['rwkv_v1'] = nrm((nv, Dm, LORA_V), Dm ** -0.5)
    inp['rwkv_v2'] = nrm((nv, LORA_V, Dm), 0.5 * LORA_V ** -0.5)
    inp['rwkv_g1'] = nrm((N_RWKV, Dm, LORA_G), Dm ** -0.5)
    inp['rwkv_g2'] = nrm((N_RWKV, LORA_G, Dm), LORA_G ** -0.5)
    inp['rwkv_k_k'] = 1.0 + nrm((N_RWKV, Dm), 0.1)
    inp['rwkv_k_a'] = 1.0 + nrm((N_RWKV, Dm), 0.1)
    inp['rwkv_r_k'] = nrm((N_RWKV, RWKV_HEADS, RWKV_HEAD), 0.1)
    inp['rwkv_ln_w'] = 1.0 + nrm((N_RWKV, Dm), 0.01)
    inp['rwkv_ln_b'] = nrm((N_RWKV, Dm), 0.01)
    inp['rwkv_w_o'] = nrm((N_RWKV, Dm, Dm), Dm ** -0.5)
    inp['ffn_w_ug'] = nrm((DEPTH, Dm, 2 * D_FF), Dm ** -0.5)
    inp['ffn_conv_w'] = nrm((DEPTH, CONV_W, D_FF), CONV_W ** -0.5)
    inp['ffn_conv_b'] = nrm((DEPTH, D_FF), 0.01)
    inp['ffn_w_d'] = nrm((DEPTH, D_FF, Dm), D_FF ** -0.5)
    return inp


def reference(x_prompt, x_sample, state_ret, state_wkv, state_shift, state_conv, meta_tokens,
              norm_mix, norm_ffn, norm_final, ret_w_in, ret_gn_w, ret_w_out,
              rwkv_mu, rwkv_w_rkv, rwkv_w0, rwkv_w1, rwkv_w2, rwkv_a0, rwkv_a1, rwkv_a2,
              rwkv_v0, rwkv_v1, rwkv_v2, rwkv_g1, rwkv_g2, rwkv_k_k, rwkv_k_a, rwkv_r_k,
              rwkv_ln_w, rwkv_ln_b, rwkv_w_o, ffn_w_ug, ffn_conv_w, ffn_conv_b, ffn_w_d):
    p = dict(norm_mix=norm_mix, norm_ffn=norm_ffn, norm_final=norm_final,
             ret_w_in=ret_w_in, ret_gn_w=ret_gn_w, ret_w_out=ret_w_out,
             rwkv_mu=rwkv_mu, rwkv_w_rkv=rwkv_w_rkv, rwkv_w0=rwkv_w0, rwkv_w1=rwkv_w1, rwkv_w2=rwkv_w2,
             rwkv_a0=rwkv_a0, rwkv_a1=rwkv_a1, rwkv_a2=rwkv_a2, rwkv_v0=rwkv_v0, rwkv_v1=rwkv_v1,
             rwkv_v2=rwkv_v2, rwkv_g1=rwkv_g1, rwkv_g2=rwkv_g2, rwkv_k_k=rwkv_k_k, rwkv_k_a=rwkv_k_a,
             rwkv_r_k=rwkv_r_k, rwkv_ln_w=rwkv_ln_w, rwkv_ln_b=rwkv_ln_b, rwkv_w_o=rwkv_w_o,
             ffn_w_ug=ffn_w_ug, ffn_conv_w=ffn_conv_w, ffn_conv_b=ffn_conv_b, ffn_w_d=ffn_w_d)
    f32 = jnp.float32
    B = x_prompt.shape[0]
    meta = jnp.broadcast_to(meta_tokens[None].astype(x_prompt.dtype), (B, N_META, D_MODEL))
    xp = jnp.concatenate([meta, x_prompt], axis=1)
    pos_p = jnp.arange(xp.shape[1])
    lead = (-N_META) % RET_CHUNK
    yp, p_ret, p_wkv, p_shift, p_conv = trunk(
        xp, pos_p, lead,
        jnp.zeros((N_RET, B, RET_HEADS, RET_DK, RET_DV), f32),
        jnp.zeros((N_RWKV, B, RWKV_HEADS, RWKV_HEAD, RWKV_HEAD), f32),
        jnp.zeros((N_RWKV, B, D_MODEL), f32),
        jnp.zeros((DEPTH, B, CONV_W - 1, D_FF), f32), p)
    y_prompt = yp[:, N_META:].astype(x_prompt.dtype)
    pos_s = PAST_LEN + jnp.arange(x_sample.shape[1])
    ys, s_ret, s_wkv, s_shift, s_conv = trunk(
        x_sample, pos_s, 0, state_ret, state_wkv, state_shift, state_conv, p)
    y_sample = ys.astype(x_sample.dtype)
    return (y_prompt, y_sample, p_ret, p_wkv, p_shift, p_conv, s_ret, s_wkv, s_shift, s_conv)
```

```cpp
#include <hip/hip_runtime.h>
#include <stdint.h>

namespace {
constexpr int D = 1024, BATCH = 8, SEQ = 2048, NMETA = 16, TP = SEQ + NMETA, MP = BATCH * TP, SB = 128, M = MP + SB;
constexpr int DEPTH = 4, RH = 4, RDK = 256, RDV = 512, RV = 2048, RWIN = 6144;
constexpr int WH = 16, WN = 64, LW = 64, LA = 64, LV = 32, LG = 160, DFF = 2816;
constexpr float PAST_POS = 16384.f;

constexpr size_t O_YP = 0;
constexpr size_t O_YS = O_YP + (size_t)BATCH * SEQ * D;
constexpr size_t O_RETP = O_YS + (size_t)SB * D;
constexpr size_t O_WKVP = O_RETP + (size_t)2 * BATCH * RH * RDK * RDV;
constexpr size_t O_SHP = O_WKVP + (size_t)2 * BATCH * WH * WN * WN;
constexpr size_t O_CVP = O_SHP + (size_t)2 * BATCH * D;
constexpr size_t O_RETS = O_CVP + (size_t)DEPTH * BATCH * 2 * DFF;
constexpr size_t O_WKVS = O_RETS + (size_t)2 * SB * RH * RDK * RDV;
constexpr size_t O_SHS = O_WKVS + (size_t)2 * SB * WH * WN * WN;
constexpr size_t O_CVS = O_SHS + (size_t)2 * SB * D;
constexpr size_t O_END = O_CVS + (size_t)DEPTH * SB * 2 * DFF;

__device__ __forceinline__ float wave_sum(float v) {
#pragma unroll
    for (int o = 1; o < 64; o <<= 1) v += __shfl_xor(v, o);
    return v;
}
__device__ __forceinline__ float sigmoidf_(float x) { return 1.f / (1.f + expf(-x)); }
__device__ __forceinline__ float siluf_(float x) { return x / (1.f + expf(-x)); }

__global__ void k_build_x(const float* __restrict__ xp, const float* __restrict__ xs, const float* __restrict__ meta, float* __restrict__ x) {
    const size_t n4 = (size_t)M * (D / 4);
    for (size_t idx = (size_t)blockIdx.x * blockDim.x + threadIdx.x; idx < n4; idx += (size_t)gridDim.x * blockDim.x) {
        const int r = (int)(idx / (D / 4)), c4 = (int)(idx % (D / 4));
        const float* src;
        if (r < MP) { const int b = r / TP, t = r % TP; src = t < NMETA ? meta + (size_t)t * D : xp + ((size_t)b * SEQ + (t - NMETA)) * D; }
        else src = xs + (size_t)(r - MP) * D;
        ((float4*)x)[idx] = ((const float4*)src)[c4];
    }
}

__global__ void k_rmsnorm(const float* __restrict__ x, const float* __restrict__ g, float* __restrict__ out, int mode, float* __restrict__ shp, float* __restrict__ shs, float* __restrict__ dout) {
    const int row = blockIdx.x * 4 + (threadIdx.x >> 6), lane = threadIdx.x & 63;
    if (row >= M) return;
    const float4* xr = (const float4*)(x + (size_t)row * D);
    float4 v[4]; float ss = 0.f;
#pragma unroll
    for (int j = 0; j < 4; ++j) { v[j] = xr[lane + 64 * j]; ss += v[j].x * v[j].x + v[j].y * v[j].y + v[j].z * v[j].z + v[j].w * v[j].w; }
    ss = wave_sum(ss);
    const float rstd = rsqrtf(ss * (1.f / D) + 1e-6f);
    float* o = nullptr; float* o2 = nullptr;
    if (mode == 0) {
        o = out + (size_t)row * D;
        if (shp) { if (row < MP) { const int b = row / TP, t = row % TP; if (t == TP - 1) o2 = shp + (size_t)b * D; } else o2 = shs + (size_t)(row - MP) * D; }
    } else {
        if (row < MP) { const int b = row / TP, t = row % TP; if (t >= NMETA) o = dout + O_YP + ((size_t)b * SEQ + (t - NMETA)) * D; }
        else o = dout + O_YS + (size_t)(row - MP) * D;
    }
#pragma unroll
    for (int j = 0; j < 4; ++j) {
        const float4 gg = ((const float4*)g)[lane + 64 * j];
        float4 r; r.x = v[j].x * rstd * gg.x; r.y = v[j].y * rstd * gg.y; r.z = v[j].z * rstd * gg.z; r.w = v[j].w * rstd * gg.w;
        if (o) ((float4*)o)[lane + 64 * j] = r;
        if (o2) ((float4*)o2)[lane + 64 * j] = r;
    }
}

template <int ACC>
__global__ void __launch_bounds__(256) k_gemm(const float* __restrict__ A, int lda, const float* __restrict__ B, int ldb, float* __restrict__ C, int ldc, int N, int K) {
    __shared__ float As[16][68];
    __shared__ float Bs[16][68];
    const int bm = blockIdx.y * 64, bn = blockIdx.x * 64;
    const int tx = threadIdx.x & 15, ty = threadIdx.x >> 4;
    float acc[4][4];
#pragma unroll
    for (int i = 0; i < 4; ++i)
#pragma unroll
        for (int j = 0; j < 4; ++j) acc[i][j] = 0.f;
    for (int k0 = 0; k0 < K; k0 += 16) {
#pragma unroll
        for (int i = 0; i < 4; ++i) { const int idx = threadIdx.x + i * 256; const int m = idx >> 4, k = idx & 15; As[k][m] = A[(size_t)(bm + m) * lda + k0 + k]; }
#pragma unroll
        for (int i = 0; i < 4; ++i) { const int idx = threadIdx.x + i * 256; const int k = idx >> 6, n = idx & 63; Bs[k][n] = (bn + n < N) ? B[(size_t)(k0 + k) * ldb + bn + n] : 0.f; }
        __syncthreads();
#pragma unroll
        for (int k = 0; k < 16; ++k) {
            float a[4], b[4];
#pragma unroll
            for (int i = 0; i < 4; ++i) a[i] = As[k][ty * 4 + i];
#pragma unroll
            for (int j = 0; j < 4; ++j) b[j] = Bs[k][tx * 4 + j];
#pragma unroll
            for (int i = 0; i < 4; ++i)
#pragma unroll
                for (int j = 0; j < 4; ++j) acc[i][j] = fmaf(a[i], b[j], acc[i][j]);
        }
        __syncthreads();
    }
#pragma unroll
    for (int i = 0; i < 4; ++i)
#pragma unroll
        for (int j = 0; j < 4; ++j) {
            const int n = bn + tx * 4 + j;
            if (n < N) { float* p = C + (size_t)(bm + ty * 4 + i) * ldc + n; *p = ACC ? (*p + acc[i][j]) : acc[i][j]; }
        }
}

__global__ void k_rotary(const float* __restrict__ proj, float* __restrict__ q, float* __restrict__ k) {
    const size_t n = (size_t)M * RH * 128;
    for (size_t idx = (size_t)blockIdx.x * blockDim.x + threadIdx.x; idx < n; idx += (size_t)gridDim.x * blockDim.x) {
        const int m = (int)(idx & 127), h = (int)((idx >> 7) & 3), row = (int)(idx >> 9);
        const float pos = row < MP ? (float)(row % TP) : PAST_POS;
        const float inv = 1.0f / powf(10000.0f, (float)m / 127.0f);
        const float ang = pos * inv;
        float s, c; sincosf(ang, &s, &c);
        const float* pr = proj + (size_t)row * RWIN + h * RDK + m;
        const float q1 = pr[0], q2 = pr[128], k1 = pr[1024], k2 = pr[1024 + 128];
        float* qo = q + (size_t)row * D + h * RDK + m; float* ko = k + (size_t)row * D + h * RDK + m;
        qo[0] = q1 * c - q2 * s; qo[128] = q1 * s + q2 * c;
        ko[0] = (k1 * c - k2 * s) * 0.0625f; ko[128] = (k1 * s + k2 * c) * 0.0625f;
    }
}

__global__ void __launch_bounds__(256) k_retention(const float* __restrict__ q, const float* __restrict__ k, const float* __restrict__ proj, const float* __restrict__ Sin  ,
                                                  float* __restrict__ o  , float* __restrict__ Sout_p, float* __restrict__ Sout_s, int is_sample) {
    __shared__ float sq[256], sk[256], red[4][64];
    const int es = blockIdx.x & 7, h = (blockIdx.x >> 3) & 3, seq = blockIdx.x >> 5;
    const int e = threadIdx.x & 63, dq = threadIdx.x >> 6;
    const int r0 = is_sample ? MP + seq : seq * TP, T = is_sample ? 1 : TP;
    const float gamma = 1.0f - exp2f(-5.0f - (float)h);
    float S[64];
    if (is_sample) {
        const float* sp = Sin + (((size_t)seq * RH + h) * RDK + dq * 64) * RDV + es * 64 + e;
#pragma unroll
        for (int dd = 0; dd < 64; ++dd) S[dd] = sp[(size_t)dd * RDV];
    } else {
#pragma unroll
        for (int dd = 0; dd < 64; ++dd) S[dd] = 0.f;
    }
    for (int t = 0; t < T; ++t) {
        const int row = r0 + t;
        sq[threadIdx.x] = q[(size_t)row * D + h * RDK + threadIdx.x];
        sk[threadIdx.x] = k[(size_t)row * D + h * RDK + threadIdx.x];
        const float ve = proj[(size_t)row * RWIN + 2048 + h * RDV + es * 64 + e];
        __syncthreads();
        float acc = 0.f;
#pragma unroll
        for (int dd = 0; dd < 64; ++dd) { S[dd] = fmaf(S[dd], gamma, sk[dq * 64 + dd] * ve); acc = fmaf(sq[dq * 64 + dd], S[dd], acc); }
        red[dq][e] = acc;
        __syncthreads();
        if (dq == 0) o[(size_t)row * RV + h * RDV + es * 64 + e] = (red[0][e] + red[1][e]) + (red[2][e] + red[3][e]);
    }
    float* so = (is_sample ? Sout_s : Sout_p) + (((size_t)seq * RH + h) * RDK + dq * 64) * RDV + es * 64 + e;
#pragma unroll
    for (int dd = 0; dd < 64; ++dd) so[(size_t)dd * RDV] = S[dd];
}

__global__ void k_ret_norm(const float* __restrict__ o, const float* __restrict__ proj, const float* __restrict__ gnw, float* __restrict__ y) {
    const int wid = blockIdx.x * 4 + (threadIdx.x >> 6), lane = threadIdx.x & 63;
    if (wid >= M * RH) return;
    const int row = wid >> 2, h = wid & 3;
    const float* op = o + (size_t)row * RV + h * RDV;
    float v[8]; float s = 0.f;
#pragma unroll
    for (int j = 0; j < 8; ++j) { v[j] = op[lane + 64 * j]; s += v[j]; }
    const float mean = wave_sum(s) * (1.f / RDV);
    float s2 = 0.f;
#pragma unroll
    for (int j = 0; j < 8; ++j) { v[j] -= mean; s2 += v[j] * v[j]; }
    const float rstd = rsqrtf(wave_sum(s2) * (1.f / RDV) + 1e-5f);
#pragma unroll
    for (int j = 0; j < 8; ++j) {
        const int e = lane + 64 * j;
        const float g = proj[(size_t)row * RWIN + 4096 + h * RDV + e];
        y[(size_t)row * RV + h * RDV + e] = v[j] * rstd * gnw[h * RDV + e] * siluf_(g);
    }
}

__global__ void k_rwkv_mix(const float* __restrict__ hbuf, const float* __restrict__ shift  , const float* __restrict__ mu  , float* __restrict__ xs) {
    const size_t n = (size_t)M * D;
    for (size_t idx = (size_t)blockIdx.x * blockDim.x + threadIdx.x; idx < n; idx += (size_t)gridDim.x * blockDim.x) {
        const int c = (int)(idx % D), row = (int)(idx / D);
        const float hv = hbuf[idx];
        float pv;
        if (row < MP) pv = (row % TP == 0) ? 0.f : hbuf[idx - D]; else pv = shift[(size_t)(row - MP) * D + c];
        const float d = pv - hv;
#pragma unroll
        for (int j = 0; j < 6; ++j) xs[(size_t)j * n + idx] = hv + d * mu[j * D + c];
    }
}
__global__ void k_act(float* __restrict__ p, size_t n, int kind) {
    for (size_t idx = (size_t)blockIdx.x * blockDim.x + threadIdx.x; idx < n; idx += (size_t)gridDim.x * blockDim.x) p[idx] = kind == 0 ? tanhf(p[idx]) : sigmoidf_(p[idx]);
}

__global__ void k_rwkv_prep(float* __restrict__ kbuf, float* __restrict__ vbuf, const float* __restrict__ lw2, const float* __restrict__ la2, const float* __restrict__ lv2,
                            const float* __restrict__ w0, const float* __restrict__ a0, const float* __restrict__ v0, const float* __restrict__ kkp, const float* __restrict__ kap,
                            const float* __restrict__ vfirst, float* __restrict__ wout, float* __restrict__ nkk, float* __restrict__ kka, int has_vres) {
    const int wid = blockIdx.x * 4 + (threadIdx.x >> 6), lane = threadIdx.x & 63;
    if (wid >= M * WH) return;
    const int row = wid >> 4, h = wid & 15, c = h * WN + lane;
    const size_t idx = (size_t)row * D + c;
    const float xw = -(w0[c] + lw2[idx]);
    const float sp = xw > 20.f ? xw : log1pf(expf(xw));
    const float logw = -sp - 0.5f;
    const float w = expf(-expf(logw));
    const float a = sigmoidf_(a0[c] + la2[idx]);
    const float kv = kbuf[idx];
    float kk = kv * kkp[c];
    const float ss = wave_sum(kk * kk);
    kk = kk * rsqrtf(fmaxf(ss, 1e-12f));
    const float kmod = kv * (1.f + (a - 1.f) * kap[c]);
    if (has_vres) { const float v = vbuf[idx]; vbuf[idx] = v + (vfirst[idx] - v) * sigmoidf_(v0[c] + lv2[idx]); }
    kbuf[idx] = kmod; wout[idx] = w; nkk[idx] = -kk; kka[idx] = kk * a;
}

__global__ void __launch_bounds__(64) k_wkv(const float* __restrict__ r, const float* __restrict__ w, const float* __restrict__ k, const float* __restrict__ v, const float* __restrict__ nkk, const float* __restrict__ kka,
                                           const float* __restrict__ Sin  , float* __restrict__ y, float* __restrict__ Sout_p, float* __restrict__ Sout_s, int is_sample) {
    __shared__ float sv[5][64];
    const int h = blockIdx.x & 15, seq = blockIdx.x >> 4, lane = threadIdx.x;
    const int r0 = is_sample ? MP + seq : seq * TP, T = is_sample ? 1 : TP;
    float S[64];
    if (is_sample) {
        const float* sp = Sin + (((size_t)seq * WH + h) * WN + lane) * WN;
#pragma unroll
        for (int j = 0; j < 64; j += 4) { const float4 t4 = *(const float4*)(sp + j); S[j] = t4.x; S[j + 1] = t4.y; S[j + 2] = t4.z; S[j + 3] = t4.w; }
    } else {
#pragma unroll
        for (int j = 0; j < 64; ++j) S[j] = 0.f;
    }
    for (int t = 0; t < T; ++t) {
        const size_t idx = (size_t)(r0 + t) * D + h * WN + lane;
        sv[0][lane] = nkk[idx]; sv[1][lane] = w[idx]; sv[2][lane] = kka[idx]; sv[3][lane] = k[idx]; sv[4][lane] = r[idx];
        const float vi = v[idx];
        __syncthreads();
        float sa0 = 0.f, sa1 = 0.f, sa2 = 0.f, sa3 = 0.f;
#pragma unroll
        for (int j = 0; j < 64; j += 4) { sa0 = fmaf(S[j], sv[0][j], sa0); sa1 = fmaf(S[j + 1], sv[0][j + 1], sa1); sa2 = fmaf(S[j + 2], sv[0][j + 2], sa2); sa3 = fmaf(S[j + 3], sv[0][j + 3], sa3); }
        const float sa = (sa0 + sa1) + (sa2 + sa3);
        float y0 = 0.f, y1 = 0.f, y2 = 0.f, y3 = 0.f;
#pragma unroll
        for (int j = 0; j < 64; j += 4) {
            S[j] = fmaf(S[j], sv[1][j], fmaf(sa, sv[2][j], vi * sv[3][j])); y0 = fmaf(S[j], sv[4][j], y0);
            S[j + 1] = fmaf(S[j + 1], sv[1][j + 1], fmaf(sa, sv[2][j + 1], vi * sv[3][j + 1])); y1 = fmaf(S[j + 1], sv[4][j + 1], y1);
            S[j + 2] = fmaf(S[j + 2], sv[1][j + 2], fmaf(sa, sv[2][j + 2], vi * sv[3][j + 2])); y2 = fmaf(S[j + 2], sv[4][j + 2], y2);
            S[j + 3] = fmaf(S[j + 3], sv[1][j + 3], fmaf(sa, sv[2][j + 3], vi * sv[3][j + 3])); y3 = fmaf(S[j + 3], sv[4][j + 3], y3);
        }
        y[idx] = (y0 + y1) + (y2 + y3);
        __syncthreads();
    }
    float* so = (is_sample ? Sout_s : Sout_p) + (((size_t)seq * WH + h) * WN + lane) * WN;
#pragma unroll
    for (int j = 0; j < 64; j += 4) { float4 t4; t4.x = S[j]; t4.y = S[j + 1]; t4.z = S[j + 2]; t4.w = S[j + 3]; *(float4*)(so + j) = t4; }
}

__global__ void k_rwkv_post(const float* __restrict__ y, const float* __restrict__ r, const float* __restrict__ k, const float* __restrict__ v, const float* __restrict__ g,
                            const float* __restrict__ rk, const float* __restrict__ lnw, const float* __restrict__ lnb, float* __restrict__ z) {
    const int wid = blockIdx.x * 4 + (threadIdx.x >> 6), lane = threadIdx.x & 63;
    if (wid >= M * WH) return;
    const int row = wid >> 4, h = wid & 15, c = h * WN + lane;
    const size_t idx = (size_t)row * D + c;
    const float yv = y[idx];
    const float mean = wave_sum(yv) * (1.f / WN);
    const float yc = yv - mean;
    const float rstd = rsqrtf(wave_sum(yc * yc) * (1.f / WN) + 64e-5f);
    const float yn = yc * rstd * lnw[c] + lnb[c];
    const float bon = wave_sum(r[idx] * k[idx] * rk[c]) * v[idx];
    z[idx] = (yn + bon) * g[idx];
}

__global__ void k_conv(const float* __restrict__ ug, const float* __restrict__ cst  , const float* __restrict__ cw  , const float* __restrict__ cb,
                       float* __restrict__ act, float* __restrict__ cvp  , float* __restrict__ cvs  ) {
    const size_t n = (size_t)M * DFF;
    for (size_t idx = (size_t)blockIdx.x * blockDim.x + threadIdx.x; idx < n; idx += (size_t)gridDim.x * blockDim.x) {
        const int f = (int)(idx % DFF), row = (int)(idx / DFF);
        const float* up = ug + (size_t)row * (2 * DFF);
        const float u = up[f], g0 = up[DFF + f];
        float g1, g2;
        if (row < MP) {
            const int b = row / TP, t = row % TP;
            g1 = t >= 1 ? up[DFF + f - 2 * DFF] : 0.f;
            g2 = t >= 2 ? up[DFF + f - 4 * DFF] : 0.f;
            if (t >= TP - 2) cvp[((size_t)b * 2 + (t - (TP - 2))) * DFF + f] = g0;
        } else {
            const int s = row - MP;
            g2 = cst[((size_t)s * 2 + 0) * DFF + f]; g1 = cst[((size_t)s * 2 + 1) * DFF + f];
            cvs[((size_t)s * 2 + 0) * DFF + f] = g1; cvs[((size_t)s * 2 + 1) * DFF + f] = g0;
        }
        const float cv = cb[f] + cw[f] * g2 + cw[DFF + f] * g1 + cw[2 * DFF + f] * g0;
        act[idx] = siluf_(cv) * u;
    }
}

inline void gemm(hipStream_t st, const float* A, int lda, const float* B, int ldb, float* C, int ldc, int N, int K, bool acc) {
    dim3 grid((N + 63) / 64, M / 64);
    if (acc) k_gemm<1><<<grid, 256, 0, st>>>(A, lda, B, ldb, C, ldc, N, K);
    else k_gemm<0><<<grid, 256, 0, st>>>(A, lda, B, ldb, C, ldc, N, K);
}
}

extern "C" void kernel_launch(void* const* d_in, const int* in_sizes, int n_in, void* d_out, int out_size, void* d_ws, size_t ws_size, hipStream_t stream) {
    const float* x_prompt = (const float*)d_in[0]; const float* x_sample = (const float*)d_in[1];
    const float* state_ret = (const float*)d_in[2]; const float* state_wkv = (const float*)d_in[3];
    const float* state_shift = (const float*)d_in[4]; const float* state_conv = (const float*)d_in[5];
    const float* meta = (const float*)d_in[6]; const float* norm_mix = (const float*)d_in[7]; const float* norm_ffn = (const float*)d_in[8];
    const float* norm_final = (const float*)d_in[9]; const float* ret_w_in = (const float*)d_in[10]; const float* ret_gn_w = (const float*)d_in[11];
    const float* ret_w_out = (const float*)d_in[12]; const float* rwkv_mu = (const float*)d_in[13]; const float* rwkv_w_rkv = (const float*)d_in[14];
    const float* rwkv_w0 = (const float*)d_in[15]; const float* rwkv_w1 = (const float*)d_in[16]; const float* rwkv_w2 = (const float*)d_in[17];
    const float* rwkv_a0 = (const float*)d_in[18]; const float* rwkv_a1 = (const float*)d_in[19]; const float* rwkv_a2 = (const float*)d_in[20];
    const float* rwkv_v0 = (const float*)d_in[21]; const float* rwkv_v1 = (const float*)d_in[22]; const float* rwkv_v2 = (const float*)d_in[23];
    const float* rwkv_g1 = (const float*)d_in[24]; const float* rwkv_g2 = (const float*)d_in[25]; const float* rwkv_k_k = (const float*)d_in[26];
    const float* rwkv_k_a = (const float*)d_in[27]; const float* rwkv_r_k = (const float*)d_in[28]; const float* rwkv_ln_w = (const float*)d_in[29];
    const float* rwkv_ln_b = (const float*)d_in[30]; const float* rwkv_w_o = (const float*)d_in[31]; const float* ffn_w_ug = (const float*)d_in[32];
    const float* ffn_conv_w = (const float*)d_in[33]; const float* ffn_conv_b = (const float*)d_in[34]; const float* ffn_w_d = (const float*)d_in[35];
    float* out = (float*)d_out;

    float* ws = (float*)d_ws; size_t off = 0;
    auto take = [&](size_t n) { float* p = ws + off; off += (n + 63) & ~(size_t)63; return p; };
    const size_t MD = (size_t)M * D;
    float* x = take(MD); float* h = take(MD);
    float* big = take((size_t)M * RWIN);
    float* qb = take(MD); float* kb = take(MD);
    float* ob = take((size_t)M * RV);
    float* yb = take((size_t)M * RV);
    float* act = take((size_t)M * DFF);
    float* vfirst = take(MD);
    float* gb = take(MD); float* yw = take(MD); float* zb = take(MD); float* lv2 = take(MD);
    float* lw1 = take((size_t)M * LW); float* la1 = take((size_t)M * LA); float* lg1 = take((size_t)M * LG); float* lv1 = take((size_t)M * LV);
    (void)ws_size; (void)in_sizes; (void)n_in; (void)out_size;

    k_build_x<<<2048, 256, 0, stream>>>(x_prompt, x_sample, meta, x);
    for (int i = 0; i < DEPTH; ++i) {
        const int j = i / 2;
        if (i % 2 == 0) {
            k_rmsnorm<<<M / 4, 256, 0, stream>>>(x, norm_mix + (size_t)i * D, h, 0, nullptr, nullptr, out);
            float* proj = big;
            gemm(stream, h, D, ret_w_in + (size_t)j * D * RWIN, RWIN, proj, RWIN, RWIN, D, false);
            k_rotary<<<4096, 256, 0, stream>>>(proj, qb, kb);
            k_retention<<<BATCH * RH * 8, 256, 0, stream>>>(qb, kb, proj, nullptr, ob, out + O_RETP + (size_t)j * BATCH * RH * RDK * RDV, nullptr, 0);
            k_retention<<<SB * RH * 8, 256, 0, stream>>>(qb, kb, proj, state_ret + (size_t)j * SB * RH * RDK * RDV, ob, nullptr, out + O_RETS + (size_t)j * SB * RH * RDK * RDV, 1);
            k_ret_norm<<<M * RH / 4, 256, 0, stream>>>(ob, proj, ret_gn_w + (size_t)j * RV, yb);
            gemm(stream, yb, RV, ret_w_out + (size_t)j * RV * D, D, x, D, D, RV, true);
        } else {
            k_rmsnorm<<<M / 4, 256, 0, stream>>>(x, norm_mix + (size_t)i * D, h, 0, out + O_SHP + (size_t)j * BATCH * D, out + O_SHS + (size_t)j * SB * D, out);
            float* xs = big;
            k_rwkv_mix<<<4096, 256, 0, stream>>>(h, state_shift + (size_t)j * SB * D, rwkv_mu + (size_t)j * 6 * D, xs);
            float* rb = qb; float* kk_ = kb; float* vb = ob; float* wb = ob + MD; float* nkk = yb; float* kka = yb + MD; float* lw2 = act; float* la2 = act + MD;
            const float* wrkv = rwkv_w_rkv + (size_t)j * 3 * D * D;
            gemm(stream, xs + 0 * MD, D, wrkv + 0 * (size_t)D * D, D, rb, D, D, D, false);
            gemm(stream, xs + 2 * MD, D, wrkv + 1 * (size_t)D * D, D, kk_, D, D, D, false);
            gemm(stream, xs + 3 * MD, D, wrkv + 2 * (size_t)D * D, D, (j == 0) ? vfirst : vb, D, D, D, false);
            gemm(stream, xs + 1 * MD, D, rwkv_w1 + (size_t)j * D * LW, LW, lw1, LW, LW, D, false);
            gemm(stream, xs + 4 * MD, D, rwkv_a1 + (size_t)j * D * LA, LA, la1, LA, LA, D, false);
            gemm(stream, xs + 5 * MD, D, rwkv_g1 + (size_t)j * D * LG, LG, lg1, LG, LG, D, false);
            k_act<<<1024, 256, 0, stream>>>(lw1, (size_t)M * LW, 0);
            k_act<<<1024, 256, 0, stream>>>(lg1, (size_t)M * LG, 1);
            gemm(stream, lw1, LW, rwkv_w2 + (size_t)j * LW * D, D, lw2, D, D, LW, false);
            gemm(stream, la1, LA, rwkv_a2 + (size_t)j * LA * D, D, la2, D, D, LA, false);
            gemm(stream, lg1, LG, rwkv_g2 + (size_t)j * LG * D, D, gb, D, D, LG, false);
            if (j > 0) {
                gemm(stream, xs + 3 * MD, D, rwkv_v1 + (size_t)(j - 1) * D * LV, LV, lv1, LV, LV, D, false);
                gemm(stream, lv1, LV, rwkv_v2 + (size_t)(j - 1) * LV * D, D, lv2, D, D, LV, false);
            }
            float* vuse = (j == 0) ? vfirst : vb;
            k_rwkv_prep<<<M * WH / 4, 256, 0, stream>>>(kk_, vuse, lw2, la2, lv2, rwkv_w0 + (size_t)j * D, rwkv_a0 + (size_t)j * D, rwkv_v0 + (size_t)(j > 0 ? j - 1 : 0) * D,
                                                       rwkv_k_k + (size_t)j * D, rwkv_k_a + (size_t)j * D, vfirst, wb, nkk, kka, j > 0 ? 1 : 0);
            k_wkv<<<BATCH * WH, 64, 0, stream>>>(rb, wb, kk_, vuse, nkk, kka, nullptr, yw, out + O_WKVP + (size_t)j * BATCH * WH * WN * WN, nullptr, 0);
            k_wkv<<<SB * WH, 64, 0, stream>>>(rb, wb, kk_, vuse, nkk, kka, state_wkv + (size_t)j * SB * WH * WN * WN, yw, nullptr, out + O_WKVS + (size_t)j * SB * WH * WN * WN, 1);
            k_rwkv_post<<<M * WH / 4, 256, 0, stream>>>(yw, rb, kk_, vuse, gb, rwkv_r_k + (size_t)j * D, rwkv_ln_w + (size_t)j * D, rwkv_ln_b + (size_t)j * D, zb);
            gemm(stream, zb, D, rwkv_w_o + (size_t)j * D * D, D, x, D, D, D, true);
        }
        k_rmsnorm<<<M / 4, 256, 0, stream>>>(x, norm_ffn + (size_t)i * D, h, 0, nullptr, nullptr, out);
        float* ug = big;
        gemm(stream, h, D, ffn_w_ug + (size_t)i * D * 2 * DFF, 2 * DFF, ug, 2 * DFF, 2 * DFF, D, false);
        k_conv<<<4096, 256, 0, stream>>>(ug, state_conv + (size_t)i * SB * 2 * DFF, ffn_conv_w + (size_t)i * 3 * DFF, ffn_conv_b + (size_t)i * DFF, act,
                                        out + O_CVP + (size_t)i * BATCH * 2 * DFF, out + O_CVS + (size_t)i * SB * 2 * DFF);
        gemm(stream, act, DFF, ffn_w_d + (size_t)i * DFF * D, D, x, D, D, DFF, true);
    }
    k_rmsnorm<<<M / 4, 256, 0, stream>>>(x, norm_final, nullptr, 1, nullptr, nullptr, out);
}
```

```cpp
#include <hip/hip_runtime.h>
#include <hip/hip_cooperative_groups.h>
#include <cstdio>
#include <stdint.h>
namespace cg = cooperative_groups;
namespace pg8 {
#define PG8_LAS __attribute__((address_space(3)))
typedef unsigned short bf16_t;
typedef short bf16x8 __attribute__((ext_vector_type(8)));
typedef float f32x4 __attribute__((ext_vector_type(4)));
typedef unsigned u32x4 __attribute__((ext_vector_type(4)));
constexpr int BM = 256, BK = 64, HALF = 128, HTB = HALF * BK * 2  , STAGE_BYTES = 8 * HTB, NXCD = 8, WGM = 8;

__host__ __device__ __forceinline__ int lds_byte(int r, int c) { const int st = (r >> 4) * 2 + (c >> 5), rr = r & 15, cc = c & 31, ob = rr * 64 + cc * 2; return st * 1024 + (ob ^ (((ob >> 9) & 1) << 5)); }
__host__ __device__ __forceinline__ void stage_rc(int b, int& R, int& C) { const int st = b / 1024, sb = b % 1024, swz = sb ^ (((sb >> 9) & 1) << 5); R = (st >> 1) * 16 + swz / 64; C = (st & 1) * 32 + (swz % 64) / 2; }
__host__ __device__ __forceinline__ int perm32(int rho) { const int n = rho >> 4, i = rho & 15; return 8 * (i >> 2) + 4 * n + (i & 3); }

struct Unit { int pm, pn; };
struct Gemm { const bf16_t* A; const bf16_t* Bt; int M, N, K; };

struct StaticOrder {
    int nM, nN, nwg, G, c;
    __host__ __device__ void init(int M, int N, int G_, int c_) { nM = M / BM; nN = N / BM; nwg = nM * nN; G = G_; c = c_; }
    __host__ __device__ bool next(int i, Unit& u) const {
        const long L = (long)i * G + c; if (L >= nwg) return false;
        int wgid = (int)L; { const int q = nwg / NXCD, r = nwg % NXCD, xcd = wgid % NXCD, off = wgid / NXCD; wgid = (xcd < r ? xcd * (q + 1) : r * (q + 1) + (xcd - r) * q) + off; }
        const int nig = WGM * nN, gid = wgid / nig, fm = gid * WGM, gsz = (nM - fm) < WGM ? (nM - fm) : WGM;
        u.pm = fm + ((wgid % nig) % gsz); u.pn = (wgid % nig) / gsz; return true;
    }
    __device__ __forceinline__ void a_ready(const Unit&) const {}
    __device__ __forceinline__ void done(const Unit&) const {}
};
template <class Epi, class Sched, bool ALIGN_EPI = false, bool SP2 = false>
__device__ __forceinline__ void gemm_phase(PG8_LAS unsigned char* lds, const Gemm g, const Sched& S, const Epi& E) {
    int tid = threadIdx.x; asm volatile("" : "+v"(tid));
    const int wid = __builtin_amdgcn_readfirstlane(tid >> 6), lane = tid & 63, wr = wid >> 2, wc = wid & 3, fr = lane & 15, fq = lane >> 4;
    const int K = g.K, nt = K / BK;
    unsigned voffA[2], voffB[2];
#pragma unroll
    for (int i = 0; i < 2; ++i) { int R, C; stage_rc(tid * 16 + i * 8192, R, C); const int Rb = E.perm ? ((R & ~31) + perm32(R & 31)) : R;
        voffA[i] = (unsigned)(R * K + C) * 2u; voffB[i] = (unsigned)(Rb * K + C) * 2u; }
    const size_t kstep = (size_t)(BK * 2);
    const size_t hstep = (size_t)HALF * K * 2;
    const size_t tstep = 2 * hstep;
    const unsigned ldsw = (unsigned)wid * 1024u;
    const int aoff = lds_byte(wr * 64 + fr, fq * 8), boff = lds_byte(wc * 32 + fr, fq * 8);
#define PG8_SA(b, h) (((b) * 2 + (h)) * HTB)
#define PG8_SB(b, h) ((4 + (b) * 2 + (h)) * HTB)
#define PG8_STAGE(bufoff, gbase, voff) do { _Pragma("unroll") for (int _i = 0; _i < 2; ++_i) \
        __builtin_amdgcn_global_load_lds((const unsigned*)((const char*)(gbase) + (voff)[_i]), (PG8_LAS unsigned*)(lds + (bufoff) + ldsw + _i * 8192), 16, 0, 0); } while (0)
#define PG8_LDA(dst, b, h) do { _Pragma("unroll") for (int m = 0; m < 4; ++m) _Pragma("unroll") for (int k = 0; k < 2; ++k) dst[m][k] = *(const PG8_LAS bf16x8*)(lds + PG8_SA(b, h) + aoff + m * 2048 + k * 1024); } while (0)
#define PG8_LDB(dst, b, h) do { _Pragma("unroll") for (int n = 0; n < 2; ++n) _Pragma("unroll") for (int k = 0; k < 2; ++k) dst[n][k] = *(const PG8_LAS bf16x8*)(lds + PG8_SB(b, h) + boff + n * 2048 + k * 1024); } while (0)
#define PG8_MMA(ai, bj, At, Bt) do { __builtin_amdgcn_s_setprio(1); _Pragma("unroll") for (int m = 0; m < 4; ++m) _Pragma("unroll") for (int n = 0; n < 2; ++n) _Pragma("unroll") for (int k = 0; k < 2; ++k) \
        acc[ai][bj][m][n] = __builtin_amdgcn_mfma_f32_16x16x32_bf16(Bt[n][k], At[m][k], acc[ai][bj][m][n], 0, 0, 0); __builtin_amdgcn_s_setprio(0); } while (0)
#define PG8_WAIT_V(n) asm volatile("s_waitcnt vmcnt(" #n ")" ::: "memory")
#define PG8_WAIT_L(n) asm volatile("s_waitcnt lgkmcnt(" #n ")" ::: "memory")
#define PG8_BAR __builtin_amdgcn_s_barrier()
#define PG8_SCHED __builtin_amdgcn_sched_barrier(0)
    Unit cur, nxt; int ui = 0;
    if (!S.next(0, cur)) return;
    f32x4 acc[2][2][4][2];
#pragma unroll
    for (int a = 0; a < 2; ++a)
#pragma unroll
        for (int b = 0; b < 2; ++b)
#pragma unroll
            for (int m = 0; m < 4; ++m)
#pragma unroll
                for (int n = 0; n < 2; ++n) acc[a][b][m][n] = (f32x4){0.f, 0.f, 0.f, 0.f};
    bf16x8 At[4][2], B0[2][2], B1[2][2];
    const char* cA = (const char*)g.A + (size_t)cur.pm * tstep; const char* cB = (const char*)g.Bt + (size_t)cur.pn * tstep;
    S.a_ready(cur);
    if constexpr (SP2) {
        PG8_STAGE(PG8_SB(0, 0), cB, voffB); PG8_STAGE(PG8_SB(0, 1), cB + hstep, voffB); PG8_STAGE(PG8_SA(0, 0), cA, voffA); PG8_STAGE(PG8_SA(0, 1), cA + hstep, voffA);
        if (wr == 1) PG8_BAR;
        PG8_WAIT_V(2); PG8_BAR;
        PG8_STAGE(PG8_SB(1, 0), cB + kstep, voffB); PG8_STAGE(PG8_SA(1, 0), cA + kstep, voffA); PG8_STAGE(PG8_SB(1, 1), cB + hstep + kstep, voffB);
        PG8_WAIT_V(6); PG8_BAR;
    } else {
        PG8_STAGE(PG8_SB(0, 0), cB, voffB); PG8_STAGE(PG8_SA(0, 0), cA, voffA); PG8_STAGE(PG8_SB(0, 1), cB + hstep, voffB); PG8_STAGE(PG8_SA(0, 1), cA + hstep, voffA);
        if (wr == 1) PG8_BAR;
        PG8_WAIT_V(4); PG8_BAR;
        PG8_STAGE(PG8_SB(1, 0), cB + kstep, voffB); PG8_STAGE(PG8_SA(1, 0), cA + kstep, voffA); PG8_STAGE(PG8_SB(1, 1), cB + hstep + kstep, voffB);
        PG8_WAIT_V(6); PG8_BAR;
    }
    for (;;) {
        const bool has_next = S.next(ui + 1, nxt);
        const char* nA = has_next ? (const char*)g.A + (size_t)nxt.pm * tstep : cA; const char* nB = has_next ? (const char*)g.Bt + (size_t)nxt.pn * tstep : cB;
        for (int t = 0; t < nt; t += 2) {
            const bool last = (t == nt - 2);
            const char* a1 = cA + (size_t)(t + 1) * kstep;
            const char* a2 = last ? nA : cA + (size_t)(t + 2) * kstep; const char* b2 = last ? nB : cB + (size_t)(t + 2) * kstep;
            const char* a3 = a2 + kstep; const char* b3 = b2 + kstep;
            if (last && has_next) S.a_ready(nxt);
            if constexpr (SP2) {
            PG8_LDB(B0, 0, 0); PG8_LDB(B1, 0, 1); PG8_SCHED; PG8_LDA(At, 0, 0); PG8_STAGE(PG8_SA(1, 1), a1 + hstep, voffA);
            PG8_WAIT_V(8); PG8_WAIT_L(0); PG8_BAR; PG8_MMA(0, 0, At, B0); PG8_MMA(0, 1, At, B1); PG8_BAR; PG8_SCHED;
            PG8_LDA(At, 0, 1); PG8_STAGE(PG8_SB(0, 0), b2, voffB); PG8_STAGE(PG8_SB(0, 1), b2 + hstep, voffB); PG8_STAGE(PG8_SA(0, 0), a2, voffA);
            PG8_WAIT_V(8); PG8_WAIT_L(0); PG8_BAR; PG8_MMA(1, 0, At, B0); PG8_MMA(1, 1, At, B1); PG8_BAR; PG8_SCHED;
            PG8_LDB(B0, 1, 0); PG8_LDB(B1, 1, 1); PG8_SCHED; PG8_LDA(At, 1, 0); PG8_STAGE(PG8_SA(0, 1), a2 + hstep, voffA);
            PG8_WAIT_V(8); PG8_WAIT_L(0); PG8_BAR; PG8_MMA(0, 0, At, B0); PG8_MMA(0, 1, At, B1); PG8_BAR; PG8_SCHED;
            PG8_LDA(At, 1, 1); PG8_STAGE(PG8_SB(1, 0), b3, voffB); PG8_STAGE(PG8_SB(1, 1), b3 + hstep, voffB); PG8_STAGE(PG8_SA(1, 0), a3, voffA);
            PG8_WAIT_V(8); PG8_WAIT_L(0); PG8_BAR; PG8_MMA(1, 0, At, B0); PG8_MMA(1, 1, At, B1); PG8_BAR; PG8_SCHED;
            } else {
            PG8_LDB(B0, 0, 0); PG8_SCHED; PG8_LDA(At, 0, 0); PG8_STAGE(PG8_SA(1, 1), a1 + hstep, voffA);
            PG8_WAIT_L(8); PG8_BAR; PG8_WAIT_L(0); PG8_MMA(0, 0, At, B0); PG8_BAR; PG8_SCHED;
            PG8_LDB(B1, 0, 1); PG8_STAGE(PG8_SB(0, 0), b2, voffB);
            PG8_BAR; PG8_WAIT_L(0); PG8_MMA(0, 1, At, B1); PG8_BAR;
            PG8_LDA(At, 0, 1); PG8_STAGE(PG8_SA(0, 0), a2, voffA);
            PG8_BAR; PG8_WAIT_L(0); PG8_MMA(1, 0, At, B0); PG8_BAR; PG8_SCHED;
            PG8_STAGE(PG8_SB(0, 1), b2 + hstep, voffB);
            PG8_WAIT_V(6); PG8_BAR; PG8_MMA(1, 1, At, B1); PG8_BAR;
            PG8_LDB(B0, 1, 0); PG8_SCHED; PG8_LDA(At, 1, 0); PG8_STAGE(PG8_SA(0, 1), a2 + hstep, voffA);
            PG8_WAIT_L(8); PG8_BAR; PG8_WAIT_L(0); PG8_MMA(0, 0, At, B0); PG8_BAR; PG8_SCHED;
            PG8_LDB(B1, 1, 1); PG8_STAGE(PG8_SB(1, 0), b3, voffB);
            PG8_BAR; PG8_WAIT_L(0); PG8_MMA(0, 1, At, B1); PG8_BAR;
            PG8_LDA(At, 1, 1); PG8_STAGE(PG8_SA(1, 0), a3, voffA);
            PG8_BAR; PG8_WAIT_L(0); PG8_MMA(1, 0, At, B0); PG8_BAR; PG8_SCHED;
            PG8_STAGE(PG8_SB(1, 1), b3 + hstep, voffB);
            PG8_WAIT_V(6); PG8_BAR; PG8_MMA(1, 1, At, B1); PG8_BAR;
            }
        }
        if constexpr (ALIGN_EPI) { if (wr == 0) PG8_BAR; }
        if constexpr (!Epi::AFTER_DRAIN) { E(acc, cur, wr, wc, fr, fq); S.done(cur); }
        if (!has_next) break;
#pragma unroll
        for (int a = 0; a < 2; ++a)
#pragma unroll
            for (int b = 0; b < 2; ++b)
#pragma unroll
                for (int m = 0; m < 4; ++m)
#pragma unroll
                    for (int n = 0; n < 2; ++n) acc[a][b][m][n] = (f32x4){0.f, 0.f, 0.f, 0.f};
        cur = nxt; cA = nA; cB = nB; ++ui;
        if constexpr (ALIGN_EPI) { if (wr == 1) PG8_BAR; }
    }
    PG8_WAIT_V(0);
    if constexpr (!ALIGN_EPI) { if (wr == 0) PG8_BAR; }
    PG8_BAR;
    if constexpr (Epi::AFTER_DRAIN) { E.fused(acc, cur, wr, wc, fr, fq, lds, wid, lane); S.done(cur); }
#undef PG8_SA
#undef PG8_SB
#undef PG8_STAGE
#undef PG8_LDA
#undef PG8_LDB
#undef PG8_MMA
#undef PG8_WAIT_V
#undef PG8_WAIT_L
#undef PG8_BAR
#undef PG8_SCHED
}
}

namespace {
constexpr int D = 1024, BATCH = 8, SEQ = 2048, NMETA = 16, TP = SEQ + NMETA, MP = BATCH * TP, SB = 128, M = MP + SB;
constexpr int DEPTH = 4, RH = 4, RDK = 256, RDV = 512, RV = 2048, RWIN = 6144;
constexpr int WH = 16, WN = 64, LW = 64, LA = 64, LV = 32, LG = 160, DFF = 2816;
constexpr int NRW = 3584, KRW = 2048, KL2 = 384, NL2 = 4096;
constexpr float PAST_POS = 16384.f;
constexpr int NWAVES = 8, NTHR = 512;
constexpr int LDS_BYTES = 147456;

constexpr size_t O_YP = 0;
constexpr size_t O_YS = O_YP + (size_t)BATCH * SEQ * D;
constexpr size_t O_RETP = O_YS + (size_t)SB * D;
constexpr size_t O_WKVP = O_RETP + (size_t)2 * BATCH * RH * RDK * RDV;
constexpr size_t O_SHP = O_WKVP + (size_t)2 * BATCH * WH * WN * WN;
constexpr size_t O_CVP = O_SHP + (size_t)2 * BATCH * D;
constexpr size_t O_RETS = O_CVP + (size_t)DEPTH * BATCH * 2 * DFF;
constexpr size_t O_WKVS = O_RETS + (size_t)2 * SB * RH * RDK * RDV;
constexpr size_t O_SHS = O_WKVS + (size_t)2 * SB * WH * WN * WN;
constexpr size_t O_CVS = O_SHS + (size_t)2 * SB * D;

enum { I_XP = 0, I_XS, I_SRET, I_SWKV, I_SSHIFT, I_SCONV, I_META, I_NMIX, I_NFFN, I_NFIN, I_RWIN, I_RGN, I_RWOUT, I_MU, I_WRKV, I_W0, I_W1, I_W2,
       I_A0, I_A1, I_A2, I_V0, I_V1, I_V2, I_G1, I_G2, I_KK, I_KA, I_RK, I_LNW, I_LNB, I_WO, I_WUG, I_CW, I_CB, I_WD, N_IN };

constexpr size_t al256(size_t x) { return (x + 255) & ~(size_t)255; }
constexpr size_t WS_CTL = 0;
constexpr size_t WS_CS = 1u << 20;
constexpr size_t WS_WIN = 4u << 20;
constexpr size_t SZ_WIN = (size_t)RWIN * D * 2;
constexpr size_t WS_WOUT = WS_WIN + 2 * SZ_WIN;
constexpr size_t SZ_WOUT = (size_t)D * RV * 2;
constexpr size_t WS_WRW = WS_WOUT + 2 * SZ_WOUT;
constexpr size_t SZ_WRW = (size_t)NRW * KRW * 2;
constexpr size_t WS_WL2 = WS_WRW + 2 * SZ_WRW;
constexpr size_t SZ_WL2 = (size_t)NL2 * KL2 * 2;
constexpr size_t WS_WO = WS_WL2 + 2 * SZ_WL2;
constexpr size_t SZ_WO = (size_t)D * D * 2;
constexpr size_t WS_WUG = WS_WO + 2 * SZ_WO;
constexpr size_t SZ_WUG = (size_t)2 * DFF * D * 2;
constexpr size_t WS_WD = WS_WUG + 4 * SZ_WUG;
constexpr size_t SZ_WD = (size_t)D * DFF * 2;
constexpr size_t WS_X = al256(WS_WD + 4 * SZ_WD);
constexpr size_t SZ_MD4 = (size_t)M * D * 4;
constexpr size_t WS_H = WS_X + SZ_MD4;
constexpr size_t WS_VF = WS_H + SZ_MD4;
constexpr size_t WS_REG = WS_VF + SZ_MD4;
constexpr size_t WS_QK = WS_REG;
constexpr size_t WS_V = WS_QK + SZ_MD4;
constexpr size_t WS_SG = WS_V + SZ_MD4;
constexpr size_t WS_O = WS_SG + SZ_MD4;
constexpr size_t WS_Y = WS_O + 2 * SZ_MD4;
constexpr size_t WS_R = WS_REG;
constexpr size_t WS_K = WS_R + SZ_MD4;
constexpr size_t WS_VB = WS_K + SZ_MD4;
constexpr size_t WS_WDEC = WS_VB + SZ_MD4;
constexpr size_t WS_NKK = WS_WDEC + SZ_MD4;
constexpr size_t WS_KKA = WS_NKK + SZ_MD4;
constexpr size_t WS_YW = WS_KKA + SZ_MD4;
constexpr size_t WS_L2 = WS_YW + SZ_MD4;
constexpr size_t WS_A2 = WS_L2 + 4 * SZ_MD4;
constexpr size_t WS_Z = al256(WS_A2 + (size_t)M * KL2 * 2);
constexpr size_t WS_RW_END = WS_Z + (size_t)M * D * 2;
constexpr size_t SZ_FF2 = (size_t)M * DFF * 2;
constexpr size_t WS_U = WS_REG;
constexpr size_t WS_G = al256(WS_U + SZ_FF2);
constexpr size_t WS_ACT = al256(WS_G + SZ_FF2);
constexpr size_t WS_END = WS_RW_END;

#define LAS __attribute__((address_space(3)))
typedef unsigned short bf16;
typedef unsigned v4u __attribute__((ext_vector_type(4)));
typedef unsigned v2u __attribute__((ext_vector_type(2)));
using pg8::f32x4;
using pg8::Unit;

struct Params { const float* in[N_IN]; float* out; unsigned char* ws; };

__device__ __forceinline__ unsigned cvt_pk_bf16(float lo, float hi) { unsigned r; asm("v_cvt_pk_bf16_f32 %0, %1, %2" : "=v"(r) : "v"(lo), "v"(hi)); return r; }
__device__ __forceinline__ float bf_lo(unsigned w) { return __uint_as_float(w << 16); }
__device__ __forceinline__ float bf_hi(unsigned w) { return __uint_as_float(w & 0xffff0000u); }
__device__ __forceinline__ void unpack8(const v4u w, float (&f)[8]) { f[0] = bf_lo(w.x); f[1] = bf_hi(w.x); f[2] = bf_lo(w.y); f[3] = bf_hi(w.y); f[4] = bf_lo(w.z); f[5] = bf_hi(w.z); f[6] = bf_lo(w.w); f[7] = bf_hi(w.w); }
__device__ __forceinline__ v4u pack8(const float (&f)[8]) { v4u w; w.x = cvt_pk_bf16(f[0], f[1]); w.y = cvt_pk_bf16(f[2], f[3]); w.z = cvt_pk_bf16(f[4], f[5]); w.w = cvt_pk_bf16(f[6], f[7]); return w; }
__device__ __forceinline__ float wave_sum(float v) {
#pragma unroll
    for (int o = 1; o < 64; o <<= 1) v += __shfl_xor(v, o);
    return v;
}
__device__ __forceinline__ float sigmoidf_(float x) { return 1.f / (1.f + __expf(-x)); }
__device__ __forceinline__ float siluf_(float x) { return x / (1.f + __expf(-x)); }
__device__ __forceinline__ float tanhf_(float x) { return 1.f - 2.f / (1.f + __expf(2.f * x)); }

enum { EK_RETIN = 0, EK_RESID, EK_UG, EK_RWPROJ, EK_F32 };
struct EpiAny {
    static constexpr bool AFTER_DRAIN = false;
    int kind; bool perm; int jl; unsigned char* ws;
    __device__ __forceinline__ void operator()(const f32x4 (&acc)[2][2][4][2], const Unit& u, int wr, int wc, int fr, int fq) const {
        const int row0 = u.pm * 256 + wr * 64 + fr;
        if (kind == EK_RETIN) {
            bf16* QK = (bf16*)(ws + WS_QK); bf16* V = (bf16*)(ws + WS_V); bf16* SG = (bf16*)(ws + WS_SG); const float* CS = (const float*)(ws + WS_CS);
            const int cw = wc * 32 + 8 * fq;
            if (u.pn < 8) {
                const bool isk = u.pn >= 4; const int h = u.pn & 3; const float sc = isk ? 0.0625f : 1.f;
                bf16* base = QK + (isk ? 1024 : 0) + h * 256 + cw;
#pragma unroll
                for (int ai = 0; ai < 2; ++ai)
#pragma unroll
                    for (int m = 0; m < 4; ++m) {
                        const int row = row0 + ai * 128 + m * 16;
                        const int pi = row < MP ? row % TP : TP;
                        const f32x4* cs = (const f32x4*)(CS + ((size_t)pi * 128 + cw) * 2);
                        const f32x4 t0 = cs[0], t1 = cs[1], t2 = cs[2], t3 = cs[3];
                        const float c[8] = {t0.x, t0.z, t1.x, t1.z, t2.x, t2.z, t3.x, t3.z}, s[8] = {t0.y, t0.w, t1.y, t1.w, t2.y, t2.w, t3.y, t3.w};
                        float o1[8], o2[8];
#pragma unroll
                        for (int n = 0; n < 2; ++n)
#pragma unroll
                            for (int j = 0; j < 4; ++j) {
                                const float x1 = acc[ai][0][m][n][j], x2 = acc[ai][1][m][n][j];
                                o1[n * 4 + j] = (x1 * c[n * 4 + j] - x2 * s[n * 4 + j]) * sc;
                                o2[n * 4 + j] = (x1 * s[n * 4 + j] + x2 * c[n * 4 + j]) * sc;
                            }
                        bf16* rp = base + (size_t)row * 2048;
                        *(v4u*)rp = pack8(o1); *(v4u*)(rp + 128) = pack8(o2);
                        asm volatile("" ::: "memory");
                    }
            } else {
                const bool isg = u.pn >= 16;
                bf16* base = (isg ? SG : V) + ((u.pn - (isg ? 16 : 8)) * 256) + cw;
#pragma unroll
                for (int ai = 0; ai < 2; ++ai)
#pragma unroll
                    for (int m = 0; m < 4; ++m) {
                        bf16* rp = base + (size_t)(row0 + ai * 128 + m * 16) * 2048;
#pragma unroll
                        for (int bj = 0; bj < 2; ++bj) {
                            float o[8];
#pragma unroll
                            for (int n = 0; n < 2; ++n)
#pragma unroll
                                for (int j = 0; j < 4; ++j) { const float x = acc[ai][bj][m][n][j]; o[n * 4 + j] = isg ? siluf_(x) : x; }
                            *(v4u*)(rp + bj * 128) = pack8(o);
                        }
                    }
            }
        } else if (kind == EK_RESID) {
            float* X = (float*)(ws + WS_X);
            const int col0 = u.pn * 256 + wc * 32 + 4 * fq;
#pragma unroll
            for (int ai = 0; ai < 2; ++ai)
#pragma unroll
                for (int m = 0; m < 4; ++m) {
                    float* rp = X + (size_t)(row0 + ai * 128 + m * 16) * D + col0;
#pragma unroll
                    for (int bj = 0; bj < 2; ++bj)
#pragma unroll
                        for (int n = 0; n < 2; ++n) { f32x4* q = (f32x4*)(rp + bj * 128 + n * 16); *q = *q + acc[ai][bj][m][n]; }
                    asm volatile("" ::: "memory");
                }
        } else if (kind == EK_UG) {
            bf16* U = (bf16*)(ws + WS_U); bf16* G = (bf16*)(ws + WS_G);
            const int f0 = u.pn * 128 + wc * 32 + 8 * fq;
#pragma unroll
            for (int ai = 0; ai < 2; ++ai)
#pragma unroll
                for (int m = 0; m < 4; ++m) {
                    const size_t ro = (size_t)(row0 + ai * 128 + m * 16) * DFF + f0;
#pragma unroll
                    for (int bj = 0; bj < 2; ++bj) {
                        float o[8];
#pragma unroll
                        for (int n = 0; n < 2; ++n)
#pragma unroll
                            for (int j = 0; j < 4; ++j) o[n * 4 + j] = acc[ai][bj][m][n][j];
                        *(v4u*)((bj ? G : U) + ro) = pack8(o);
                    }
                }
        } else if (kind == EK_RWPROJ) {
            const int cl = wc * 32 + 4 * fq;
            if (u.pn < 12) {
                float* dst = (float*)(ws + (u.pn < 4 ? WS_R : (u.pn < 8 ? WS_K : (jl == 0 ? WS_VF : WS_VB)))) + (u.pn & 3) * 256 + cl;
#pragma unroll
                for (int ai = 0; ai < 2; ++ai)
#pragma unroll
                    for (int m = 0; m < 4; ++m) {
                        float* rp = dst + (size_t)(row0 + ai * 128 + m * 16) * D;
#pragma unroll
                        for (int bj = 0; bj < 2; ++bj)
#pragma unroll
                            for (int n = 0; n < 2; ++n) *(f32x4*)(rp + bj * 128 + n * 16) = acc[ai][bj][m][n];
                    }
            } else {
                bf16* A2 = (bf16*)(ws + WS_A2);
#pragma unroll
                for (int bj = 0; bj < 2; ++bj)
#pragma unroll
                    for (int n = 0; n < 2; ++n) {
                        const int c = (u.pn - 12) * 256 + bj * 128 + cl + 16 * n;
                        if (c < KL2) {
                            const int kd = c < 64 ? 1 : ((c >= 128 && c < 288) ? 2 : 0);
#pragma unroll
                            for (int ai = 0; ai < 2; ++ai)
#pragma unroll
                                for (int m = 0; m < 4; ++m) {
                                    f32x4 v = acc[ai][bj][m][n];
                                    if (kd == 1) { v.x = tanhf_(v.x); v.y = tanhf_(v.y); v.z = tanhf_(v.z); v.w = tanhf_(v.w); }
                                    else if (kd == 2) { v.x = sigmoidf_(v.x); v.y = sigmoidf_(v.y); v.z = sigmoidf_(v.z); v.w = sigmoidf_(v.w); }
                                    v2u w; w.x = cvt_pk_bf16(v.x, v.y); w.y = cvt_pk_bf16(v.z, v.w);
                                    *(v2u*)(A2 + (size_t)(row0 + ai * 128 + m * 16) * KL2 + c) = w;
                                }
                        }
                    }
            }
        } else {
            float* C = (float*)(ws + WS_L2); constexpr int ldc = NL2;
            const int col0 = u.pn * 256 + wc * 32 + 4 * fq;
#pragma unroll
            for (int ai = 0; ai < 2; ++ai)
#pragma unroll
                for (int m = 0; m < 4; ++m) {
                    float* rp = C + (size_t)(row0 + ai * 128 + m * 16) * ldc + col0;
#pragma unroll
                    for (int bj = 0; bj < 2; ++bj)
#pragma unroll
                        for (int n = 0; n < 2; ++n) *(f32x4*)(rp + bj * 128 + n * 16) = acc[ai][bj][m][n];
                }
        }
    }
};

__device__ __forceinline__ void tr_item(const float* __restrict__ W, int ldw, int k0, int n0, bf16* __restrict__ WT, int ldt, int drow, const float* __restrict__ mu, LAS float* scr, int lane) {
#pragma unroll 8
    for (int i = 0; i < 32; ++i) { const int kk = 2 * i + (lane >> 5); scr[kk * 33 + (lane & 31)] = W[(size_t)(k0 + kk) * ldw + n0 + (lane & 31)]; }
    asm volatile("s_waitcnt lgkmcnt(0)" ::: "memory");
    const int c = lane & 7;
    float mv[8];
    if (mu) {
#pragma unroll
        for (int e = 0; e < 8; ++e) mv[e] = mu[k0 + 8 * c + e];
    }
#pragma unroll
    for (int j = 0; j < 4; ++j) {
        const int n = (lane >> 3) + 8 * j; const LAS float* s = scr + (8 * c) * 33 + n;
        float f[8];
#pragma unroll
        for (int e = 0; e < 8; ++e) f[e] = s[e * 33];
        bf16* dp = WT + (size_t)(drow + n) * ldt + k0 + 8 * c;
        if (mu) {
            float f1[8], f2[8];
#pragma unroll
            for (int e = 0; e < 8; ++e) { f1[e] = f[e] * (1.f - mv[e]); f2[e] = f[e] * mv[e]; }
            *(v4u*)dp = pack8(f1); *(v4u*)(dp + 1024) = pack8(f2);
        } else *(v4u*)dp = pack8(f);
    }
    asm volatile("s_waitcnt lgkmcnt(0)" ::: "memory");
}

__device__ __forceinline__ void ph_p0(const Params& p, LAS unsigned char* lds, int tid, int lane, int wave) {
    unsigned char* ws = p.ws;
    LAS float* scr = (LAS float*)(lds + wave * 16384);
    const int gw = blockIdx.x * NWAVES + wave, NGW = gridDim.x * NWAVES;
    constexpr int C_WIN = 2 * 16 * 192, C_WOUT = 2 * 32 * 32, C_RKV = 2 * 3 * 512, C_W1 = 2 * 32, C_A1 = 2 * 32, C_G1 = 2 * 80, C_V1 = 16, C_WO = 2 * 512, C_WUG = 4 * 16 * 176, C_WD = 4 * 44 * 32;
    constexpr int NITEMS = C_WIN + C_WOUT + C_RKV + C_W1 + C_A1 + C_G1 + C_V1 + C_WO + C_WUG + C_WD;
    for (int it = gw; it < NITEMS; it += NGW) {
        int r = it;
        if (r < C_WIN) { const int j = r / 3072, q = r % 3072, kb = q / 192, nb = q % 192;
            tr_item(p.in[I_RWIN] + (size_t)j * D * RWIN, RWIN, 64 * kb, 32 * nb, (bf16*)(ws + WS_WIN + j * SZ_WIN), D, 32 * nb, nullptr, scr, lane); continue; }
        r -= C_WIN;
        if (r < C_WOUT) { const int j = r / 1024, q = r % 1024, kb = q / 32, nb = q % 32;
            tr_item(p.in[I_RWOUT] + (size_t)j * RV * D, D, 64 * kb, 32 * nb, (bf16*)(ws + WS_WOUT + j * SZ_WOUT), RV, 32 * nb, nullptr, scr, lane); continue; }
        r -= C_WOUT;
        if (r < C_RKV) { const int j = r / 1536, q = r % 1536, s = q / 512, q2 = q % 512, kb = q2 / 32, nb = q2 % 32, c = (s == 0 ? 0 : (s == 1 ? 2 : 3));
            tr_item(p.in[I_WRKV] + (size_t)(j * 3 + s) * D * D, D, 64 * kb, 32 * nb, (bf16*)(ws + WS_WRW + j * SZ_WRW), KRW, s * 1024 + 32 * nb, p.in[I_MU] + (size_t)(j * 6 + c) * D, scr, lane); continue; }
        r -= C_RKV;
        if (r < C_W1) { const int j = r / 32, q = r % 32, kb = q / 2, nb = q % 2;
            tr_item(p.in[I_W1] + (size_t)j * D * LW, LW, 64 * kb, 32 * nb, (bf16*)(ws + WS_WRW + j * SZ_WRW), KRW, 3072 + 32 * nb, p.in[I_MU] + (size_t)(j * 6 + 1) * D, scr, lane); continue; }
        r -= C_W1;
        if (r < C_A1) { const int j = r / 32, q = r % 32, kb = q / 2, nb = q % 2;
            tr_item(p.in[I_A1] + (size_t)j * D * LA, LA, 64 * kb, 32 * nb, (bf16*)(ws + WS_WRW + j * SZ_WRW), KRW, 3136 + 32 * nb, p.in[I_MU] + (size_t)(j * 6 + 4) * D, scr, lane); continue; }
        r -= C_A1;
        if (r < C_G1) { const int j = r / 80, q = r % 80, kb = q / 5, nb = q % 5;
            tr_item(p.in[I_G1] + (size_t)j * D * LG, LG, 64 * kb, 32 * nb, (bf16*)(ws + WS_WRW + j * SZ_WRW), KRW, 3200 + 32 * nb, p.in[I_MU] + (size_t)(j * 6 + 5) * D, scr, lane); continue; }
        r -= C_G1;
        if (r < C_V1) { const int kb = r;
            tr_item(p.in[I_V1], LV, 64 * kb, 0, (bf16*)(ws + WS_WRW + 1 * SZ_WRW), KRW, 3360, p.in[I_MU] + (size_t)(1 * 6 + 3) * D, scr, lane); continue; }
        r -= C_V1;
        if (r < C_WO) { const int j = r / 512, q = r % 512, kb = q / 32, nb = q % 32;
            tr_item(p.in[I_WO] + (size_t)j * D * D, D, 64 * kb, 32 * nb, (bf16*)(ws + WS_WO + j * SZ_WO), D, 32 * nb, nullptr, scr, lane); continue; }
        r -= C_WO;
        if (r < C_WUG) { const int i = r / 2816, q = r % 2816, kb = q / 176, nb = q % 176, n0 = 32 * nb;
            const int drow = n0 < DFF ? 256 * (n0 / 128) + (n0 % 128) : 256 * ((n0 - DFF) / 128) + 128 + ((n0 - DFF) % 128);
            tr_item(p.in[I_WUG] + (size_t)i * D * 2 * DFF, 2 * DFF, 64 * kb, n0, (bf16*)(ws + WS_WUG + i * SZ_WUG), D, drow, nullptr, scr, lane); continue; }
        r -= C_WUG;
        { const int i = r / 1408, q = r % 1408, kb = q / 32, nb = q % 32;
            tr_item(p.in[I_WD] + (size_t)i * DFF * D, D, 64 * kb, 32 * nb, (bf16*)(ws + WS_WD + i * SZ_WD), DFF, 32 * nb, nullptr, scr, lane); }
    }
    const size_t gt = (size_t)blockIdx.x * NTHR + tid, GT = (size_t)gridDim.x * NTHR;
    for (size_t i = gt; i < (size_t)(224 + 192) * (KRW / 8); i += GT) {
        const int rr = (int)(i / (KRW / 8)), c8 = (int)(i % (KRW / 8));
        const int j = rr < 224 ? 0 : 1, row = rr < 224 ? 3360 + rr : 3392 + (rr - 224);
        *(v4u*)((bf16*)(ws + WS_WRW + j * SZ_WRW) + (size_t)row * KRW + c8 * 8) = (v4u){0u, 0u, 0u, 0u};
    }
    for (size_t i = gt; i < (size_t)2 * NL2 * KL2; i += GT) {
        const int j = (int)(i / ((size_t)NL2 * KL2)); const int rem = (int)(i % ((size_t)NL2 * KL2)); const int n = rem / KL2, k = rem % KL2, grp = n >> 10, nn = n & 1023;
        float v = 0.f;
        if (grp == 0) { if (k < 64) v = p.in[I_W2][((size_t)j * LW + k) * D + nn]; }
        else if (grp == 1) { if (k >= 64 && k < 128) v = p.in[I_A2][((size_t)j * LA + (k - 64)) * D + nn]; }
        else if (grp == 2) { if (k >= 128 && k < 288) v = p.in[I_G2][((size_t)j * LG + (k - 128)) * D + nn]; }
        else { if (j == 1 && k >= 288 && k < 320) v = p.in[I_V2][((size_t)(k - 288)) * D + nn]; }
        ((bf16*)(ws + WS_WL2 + j * SZ_WL2))[(size_t)n * KL2 + k] = (bf16)(cvt_pk_bf16(v, 0.f) & 0xffffu);
    }
    for (size_t i = gt; i < (size_t)(TP + 1) * 128; i += GT) {
        const int pi = (int)(i >> 7), mi = (int)(i & 127);
        const float pos = pi < TP ? (float)pi : PAST_POS;
        const float inv = 1.0f / powf(10000.0f, (float)mi / 127.0f);
        float s, c; sincosf(pos * inv, &s, &c);
        ((float2*)(ws + WS_CS))[i] = make_float2(c, s);
    }
    float* X = (float*)(ws + WS_X);
    for (size_t i = gt; i < (size_t)M * (D / 4); i += GT) {
        const int r = (int)(i / (D / 4)), c4 = (int)(i % (D / 4));
        const float* src;
        if (r < MP) { const int b = r / TP, t = r % TP; src = t < NMETA ? p.in[I_META] + (size_t)t * D : p.in[I_XP] + ((size_t)b * SEQ + (t - NMETA)) * D; }
        else src = p.in[I_XS] + (size_t)(r - MP) * D;
        ((f32x4*)X)[i] = ((const f32x4*)src)[c4];
    }
}

__device__ __forceinline__ void ph_norm(const Params& p, const float* __restrict__ g, int mode, int jl, int lane, int wave) {
    const float* X = (const float*)(p.ws + WS_X); bf16* H = (bf16*)(p.ws + WS_H);
    const int gw = blockIdx.x * NWAVES + wave, NGW = gridDim.x * NWAVES;
    for (int row = gw; row < M; row += NGW) {
        const float* xr = X + (size_t)row * D;
        float v[2][8]; float ss = 0.f;
#pragma unroll
        for (int j = 0; j < 2; ++j) {
            const f32x4 a = *(const f32x4*)(xr + 512 * j + 8 * lane), b = *(const f32x4*)(xr + 512 * j + 8 * lane + 4);
            v[j][0] = a.x; v[j][1] = a.y; v[j][2] = a.z; v[j][3] = a.w; v[j][4] = b.x; v[j][5] = b.y; v[j][6] = b.z; v[j][7] = b.w;
#pragma unroll
            for (int e = 0; e < 8; ++e) ss += v[j][e] * v[j][e];
        }
        ss = wave_sum(ss);
        const float rstd = rsqrtf(ss * (1.f / D) + 1e-6f);
        const bool prompt = row < MP; const int b = prompt ? row / TP : 0, t = prompt ? row % TP : 0;
#pragma unroll
        for (int j = 0; j < 2; ++j) {
            const int c0 = 512 * j + 8 * lane;
            const f32x4 ga = *(const f32x4*)(g + c0), gb = *(const f32x4*)(g + c0 + 4);
            float o[8];
            o[0] = v[j][0] * rstd * ga.x; o[1] = v[j][1] * rstd * ga.y; o[2] = v[j][2] * rstd * ga.z; o[3] = v[j][3] * rstd * ga.w;
            o[4] = v[j][4] * rstd * gb.x; o[5] = v[j][5] * rstd * gb.y; o[6] = v[j][6] * rstd * gb.z; o[7] = v[j][7] * rstd * gb.w;
            if (mode == 0) { *(v4u*)(H + (size_t)row * D + c0) = pack8(o); }
            else if (mode == 1) {
                const v4u w = pack8(o);
                *(v4u*)(H + (size_t)row * 2048 + c0) = w;
                if (prompt) {
                    if (t != TP - 1) *(v4u*)(H + (size_t)(row + 1) * 2048 + 1024 + c0) = w;
                    else { float* so = p.out + O_SHP + ((size_t)jl * BATCH + b) * D + c0; *(f32x4*)so = (f32x4){o[0], o[1], o[2], o[3]}; *(f32x4*)(so + 4) = (f32x4){o[4], o[5], o[6], o[7]}; }
                    if (t == 0) *(v4u*)(H + (size_t)row * 2048 + 1024 + c0) = (v4u){0u, 0u, 0u, 0u};
                } else {
                    const int s = row - MP;
                    const float* sp = p.in[I_SSHIFT] + ((size_t)jl * SB + s) * D + c0;
                    const f32x4 sa = *(const f32x4*)sp, sb2 = *(const f32x4*)(sp + 4);
                    const float pv[8] = {sa.x, sa.y, sa.z, sa.w, sb2.x, sb2.y, sb2.z, sb2.w};
                    *(v4u*)(H + (size_t)row * 2048 + 1024 + c0) = pack8(pv);
                    float* so = p.out + O_SHS + ((size_t)jl * SB + s) * D + c0; *(f32x4*)so = (f32x4){o[0], o[1], o[2], o[3]}; *(f32x4*)(so + 4) = (f32x4){o[4], o[5], o[6], o[7]};
                }
            } else {
                float* dst = nullptr;
                if (prompt) { if (t >= NMETA) dst = p.out + O_YP + ((size_t)b * SEQ + (t - NMETA)) * D + c0; }
                else dst = p.out + O_YS + (size_t)(row - MP) * D + c0;
                if (dst) { *(f32x4*)dst = (f32x4){o[0], o[1], o[2], o[3]}; *(f32x4*)(dst + 4) = (f32x4){o[4], o[5], o[6], o[7]}; }
            }
        }
    }
}

__device__ __forceinline__ void ph_ret_norm(const Params& p, int jl, int lane, int wave) {
    const float* O = (const float*)(p.ws + WS_O); const bf16* SG = (const bf16*)(p.ws + WS_SG); bf16* Y = (bf16*)(p.ws + WS_Y);
    const float* gnw = p.in[I_RGN] + (size_t)jl * RV;
    const int gw = blockIdx.x * NWAVES + wave, NGW = gridDim.x * NWAVES;
    for (int it = gw; it < M * RH; it += NGW) {
        const int row = it >> 2, h = it & 3; const size_t off = (size_t)row * RV + h * RDV + 8 * lane;
        const f32x4 a = *(const f32x4*)(O + off), b = *(const f32x4*)(O + off + 4);
        float v[8] = {a.x, a.y, a.z, a.w, b.x, b.y, b.z, b.w};
        float s = 0.f;
#pragma unroll
        for (int e = 0; e < 8; ++e) s += v[e];
        const float mean = wave_sum(s) * (1.f / RDV);
        float s2 = 0.f;
#pragma unroll
        for (int e = 0; e < 8; ++e) { v[e] -= mean; s2 += v[e] * v[e]; }
        const float rstd = rsqrtf(wave_sum(s2) * (1.f / RDV) + 1e-5f);
        float sg[8]; unpack8(*(const v4u*)(SG + off), sg);
        const f32x4 ga = *(const f32x4*)(gnw + h * RDV + 8 * lane), gb = *(const f32x4*)(gnw + h * RDV + 8 * lane + 4);
        const float gg[8] = {ga.x, ga.y, ga.z, ga.w, gb.x, gb.y, gb.z, gb.w};
        float o[8];
#pragma unroll
        for (int e = 0; e < 8; ++e) o[e] = v[e] * rstd * gg[e] * sg[e];
        *(v4u*)(Y + off) = pack8(o);
    }
}

__device__ __forceinline__ void ph_conv(const Params& p, int li, int tid) {
    const bf16* U = (const bf16*)(p.ws + WS_U); const bf16* G = (const bf16*)(p.ws + WS_G); bf16* ACT = (bf16*)(p.ws + WS_ACT);
    const float* cw = p.in[I_CW] + (size_t)li * 3 * DFF; const float* cb = p.in[I_CB] + (size_t)li * DFF;
    const float* cst = p.in[I_SCONV] + (size_t)li * SB * 2 * DFF;
    float* cvp = p.out + O_CVP + (size_t)li * BATCH * 2 * DFF; float* cvs = p.out + O_CVS + (size_t)li * SB * 2 * DFF;
    const size_t gt = (size_t)blockIdx.x * NTHR + tid, GT = (size_t)gridDim.x * NTHR;
    constexpr int CH = DFF / 8;
    for (size_t i = gt; i < (size_t)M * CH; i += GT) {
        const int row = (int)(i / CH), f0 = (int)(i % CH) * 8;
        const size_t off = (size_t)row * DFF + f0;
        float u[8], g0[8], g1[8], g2[8];
        unpack8(*(const v4u*)(U + off), u); unpack8(*(const v4u*)(G + off), g0);
        if (row < MP) {
            const int b = row / TP, t = row % TP;
            if (t >= 1) unpack8(*(const v4u*)(G + off - DFF), g1); else {
#pragma unroll
                for (int e = 0; e < 8; ++e) g1[e] = 0.f; }
            if (t >= 2) unpack8(*(const v4u*)(G + off - 2 * DFF), g2); else {
#pragma unroll
                for (int e = 0; e < 8; ++e) g2[e] = 0.f; }
            if (t >= TP - 2) { float* o = cvp + ((size_t)b * 2 + (t - (TP - 2))) * DFF + f0; *(f32x4*)o = (f32x4){g0[0], g0[1], g0[2], g0[3]}; *(f32x4*)(o + 4) = (f32x4){g0[4], g0[5], g0[6], g0[7]}; }
        } else {
            const int s = row - MP;
            const float* c0 = cst + ((size_t)s * 2 + 0) * DFF + f0; const float* c1 = c0 + DFF;
            const f32x4 a0 = *(const f32x4*)c0, a1 = *(const f32x4*)(c0 + 4), b0 = *(const f32x4*)c1, b1 = *(const f32x4*)(c1 + 4);
            g2[0] = a0.x; g2[1] = a0.y; g2[2] = a0.z; g2[3] = a0.w; g2[4] = a1.x; g2[5] = a1.y; g2[6] = a1.z; g2[7] = a1.w;
            g1[0] = b0.x; g1[1] = b0.y; g1[2] = b0.z; g1[3] = b0.w; g1[4] = b1.x; g1[5] = b1.y; g1[6] = b1.z; g1[7] = b1.w;
            float* o = cvs + ((size_t)s * 2 + 0) * DFF + f0;
            *(f32x4*)o = b0; *(f32x4*)(o + 4) = b1;
            *(f32x4*)(o + DFF) = (f32x4){g0[0], g0[1], g0[2], g0[3]}; *(f32x4*)(o + DFF + 4) = (f32x4){g0[4], g0[5], g0[6], g0[7]};
        }
        float w0[8], w1[8], w2[8], bb[8];
        { const f32x4 x0 = *(const f32x4*)(cw + f0), x1 = *(const f32x4*)(cw + f0 + 4); w0[0] = x0.x; w0[1] = x0.y; w0[2] = x0.z; w0[3] = x0.w; w0[4] = x1.x; w0[5] = x1.y; w0[6] = x1.z; w0[7] = x1.w; }
        { const f32x4 x0 = *(const f32x4*)(cw + DFF + f0), x1 = *(const f32x4*)(cw + DFF + f0 + 4); w1[0] = x0.x; w1[1] = x0.y; w1[2] = x0.z; w1[3] = x0.w; w1[4] = x1.x; w1[5] = x1.y; w1[6] = x1.z; w1[7] = x1.w; }
        { const f32x4 x0 = *(const f32x4*)(cw + 2 * DFF + f0), x1 = *(const f32x4*)(cw + 2 * DFF + f0 + 4); w2[0] = x0.x; w2[1] = x0.y; w2[2] = x0.z; w2[3] = x0.w; w2[4] = x1.x; w2[5] = x1.y; w2[6] = x1.z; w2[7] = x1.w; }
        { const f32x4 x0 = *(const f32x4*)(cb + f0), x1 = *(const f32x4*)(cb + f0 + 4); bb[0] = x0.x; bb[1] = x0.y; bb[2] = x0.z; bb[3] = x0.w; bb[4] = x1.x; bb[5] = x1.y; bb[6] = x1.z; bb[7] = x1.w; }
        float o[8];
#pragma unroll
        for (int e = 0; e < 8; ++e) { const float cv = bb[e] + w0[e] * g2[e] + w1[e] * g1[e] + w2[e] * g0[e]; o[e] = siluf_(cv) * u[e]; }
        *(v4u*)(ACT + off) = pack8(o);
    }
}

__device__ __forceinline__ void ph_rwkv_prep(const Params& p, int jl, int lane, int wave) {
    float* Kb = (float*)(p.ws + WS_K); float* Vb = (float*)(p.ws + (jl == 0 ? WS_VF : WS_VB)); const float* VF = (const float*)(p.ws + WS_VF);
    const float* L2 = (const float*)(p.ws + WS_L2);
    float* Wd = (float*)(p.ws + WS_WDEC); float* NKK = (float*)(p.ws + WS_NKK); float* KKA = (float*)(p.ws + WS_KKA);
    const float* w0 = p.in[I_W0] + (size_t)jl * D; const float* a0 = p.in[I_A0] + (size_t)jl * D; const float* v0 = p.in[I_V0];
    const float* kkp = p.in[I_KK] + (size_t)jl * D; const float* kap = p.in[I_KA] + (size_t)jl * D;
    const int gw = blockIdx.x * NWAVES + wave, NGW = gridDim.x * NWAVES;
    for (int it = gw; it < M * WH; it += NGW) {
        const int row = it >> 4, h = it & 15, c = h * WN + lane;
        const size_t idx = (size_t)row * D + c, l2 = (size_t)row * NL2 + c;
        const float xw = -(w0[c] + L2[l2]);
        const float sp = xw > 20.f ? xw : log1pf(expf(xw));
        const float w = expf(-expf(-sp - 0.5f));
        const float a = sigmoidf_(a0[c] + L2[l2 + 1024]);
        const float kv = Kb[idx];
        float kk = kv * kkp[c];
        const float ss = wave_sum(kk * kk);
        kk = kk * rsqrtf(fmaxf(ss, 1e-12f));
        if (jl == 1) { const float v = Vb[idx]; Vb[idx] = v + (VF[idx] - v) * sigmoidf_(v0[c] + L2[l2 + 3072]); }
        Kb[idx] = kv * (1.f + (a - 1.f) * kap[c]); Wd[idx] = w; NKK[idx] = -kk; KKA[idx] = kk * a;
    }
}
__device__ __forceinline__ void ph_rwkv_post(const Params& p, int jl, int lane, int wave) {
    const float* YW = (const float*)(p.ws + WS_YW); const float* R = (const float*)(p.ws + WS_R); const float* Kb = (const float*)(p.ws + WS_K);
    const float* Vb = (const float*)(p.ws + (jl == 0 ? WS_VF : WS_VB)); const float* L2 = (const float*)(p.ws + WS_L2); bf16* Z = (bf16*)(p.ws + WS_Z);
    const float* rk = p.in[I_RK] + (size_t)jl * D; const float* lnw = p.in[I_LNW] + (size_t)jl * D; const float* lnb = p.in[I_LNB] + (size_t)jl * D;
    const int gw = blockIdx.x * NWAVES + wave, NGW = gridDim.x * NWAVES;
    for (int it = gw; it < M * WH; it += NGW) {
        const int row = it >> 4, h = it & 15, c = h * WN + lane;
        const size_t idx = (size_t)row * D + c;
        const float yv = YW[idx];
        const float mean = wave_sum(yv) * (1.f / WN);
        const float yc = yv - mean;
        const float rstd = rsqrtf(wave_sum(yc * yc) * (1.f / WN) + 64e-5f);
        const float yn = yc * rstd * lnw[c] + lnb[c];
        const float bon = wave_sum(R[idx] * Kb[idx] * rk[c]) * Vb[idx];
        const float z = (yn + bon) * L2[(size_t)row * NL2 + 2048 + c];
        Z[idx] = (bf16)(cvt_pk_bf16(z, 0.f) & 0xffffu);
    }
}

enum { OP_P0 = 0, OP_NORM_RET, OP_G_RETIN, OP_RET, OP_RETNORM, OP_G_RETOUT, OP_NORM_RW, OP_G_RWPROJ, OP_G_LORA2, OP_PREP, OP_WKV, OP_POST, OP_G_WO,
       OP_NORM_FFN, OP_G_UG, OP_CONV, OP_G_WD, OP_FINAL };
struct Ph { unsigned char op, layer; };
constexpr int NPH = 1 + 2 * (5 + 4) + 2 * (7 + 4) + 1;
__device__ __host__ inline Ph phase_at(int i) {
    if (i == 0) return Ph{OP_P0, 0};
    i -= 1;
    int l;
    if (i < 9) l = 0; else if (i < 20) { l = 1; i -= 9; } else if (i < 29) { l = 2; i -= 20; } else if (i < 40) { l = 3; i -= 29; } else return Ph{OP_FINAL, 0};
    int op = OP_FINAL;
    if ((l & 1) == 0) {
        switch (i) { case 0: op = OP_NORM_RET; break; case 1: op = OP_G_RETIN; break; case 2: op = OP_RET; break; case 3: op = OP_RETNORM; break; case 4: op = OP_G_RETOUT; break;
                     case 5: op = OP_NORM_FFN; break; case 6: op = OP_G_UG; break; case 7: op = OP_CONV; break; default: op = OP_G_WD; break; }
    } else {
        switch (i) { case 0: op = OP_NORM_RW; break; case 1: op = OP_G_RWPROJ; break; case 2: op = OP_G_LORA2; break; case 3: op = OP_PREP; break; case 4: op = OP_WKV; break; case 5: op = OP_POST; break; case 6: op = OP_G_WO; break;
                     case 7: op = OP_NORM_FFN; break; case 8: op = OP_G_UG; break; case 9: op = OP_CONV; break; default: op = OP_G_WD; break; }
    }
    return Ph{(unsigned char)op, (unsigned char)l};
}

__global__ void __launch_bounds__(NTHR, 2) mega(Params p, int lo, int hi) {
    extern __shared__ __attribute__((aligned(16))) unsigned char lds_raw[];
    LAS unsigned char* lds = (LAS unsigned char*)lds_raw;
    for (int ph = lo; ph < hi; ++ph) {
        int tid = threadIdx.x; asm volatile("" : "+v"(tid));
        const int lane = tid & 63, wave = __builtin_amdgcn_readfirstlane(tid >> 6);
        unsigned char* ws = p.ws;
        const Ph P = phase_at(ph);
        const int li = P.layer, jl = li >> 1;
        const bf16* gA = nullptr; const bf16* gB = nullptr; int gN = 0, gK = 0; EpiAny E{}; E.jl = jl; E.ws = ws; bool is_gemm = false;
        switch (P.op) {
        case OP_P0: ph_p0(p, lds, tid, lane, wave); break;
        case OP_NORM_RET: ph_norm(p, p.in[I_NMIX] + (size_t)li * D, 0, jl, lane, wave); break;
        case OP_NORM_FFN: ph_norm(p, p.in[I_NFFN] + (size_t)li * D, 0, jl, lane, wave); break;
        case OP_NORM_RW: ph_norm(p, p.in[I_NMIX] + (size_t)li * D, 1, jl, lane, wave); break;
        case OP_FINAL: ph_norm(p, p.in[I_NFIN], 2, 0, lane, wave); break;
        case OP_RETNORM: ph_ret_norm(p, jl, lane, wave); break;
        case OP_PREP: ph_rwkv_prep(p, jl, lane, wave); break;
        case OP_POST: ph_rwkv_post(p, jl, lane, wave); break;
        case OP_CONV: ph_conv(p, li, tid); break;
        case OP_G_RETIN: is_gemm = true; E.kind = EK_RETIN; E.perm = true;
            gA = (const bf16*)(ws + WS_H); gB = (const bf16*)(ws + WS_WIN + jl * SZ_WIN); gN = RWIN; gK = D; break;
        case OP_G_RETOUT: is_gemm = true; E.kind = EK_RESID; E.perm = false;
            gA = (const bf16*)(ws + WS_Y); gB = (const bf16*)(ws + WS_WOUT + jl * SZ_WOUT); gN = D; gK = RV; break;
        case OP_G_RWPROJ: is_gemm = true; E.kind = EK_RWPROJ; E.perm = false;
            gA = (const bf16*)(ws + WS_H); gB = (const bf16*)(ws + WS_WRW + jl * SZ_WRW); gN = NRW; gK = KRW; break;
        case OP_G_LORA2: is_gemm = true; E.kind = EK_F32; E.perm = false;
            gA = (const bf16*)(ws + WS_A2); gB = (const bf16*)(ws + WS_WL2 + jl * SZ_WL2); gN = (jl == 0 ? 3072 : 4096); gK = KL2; break;
        case OP_G_WO: is_gemm = true; E.kind = EK_RESID; E.perm = false;
            gA = (const bf16*)(ws + WS_Z); gB = (const bf16*)(ws + WS_WO + jl * SZ_WO); gN = D; gK = D; break;
        case OP_G_UG: is_gemm = true; E.kind = EK_UG; E.perm = true;
            gA = (const bf16*)(ws + WS_H); gB = (const bf16*)(ws + WS_WUG + li * SZ_WUG); gN = 2 * DFF; gK = D; break;
        case OP_G_WD: is_gemm = true; E.kind = EK_RESID; E.perm = false;
            gA = (const bf16*)(ws + WS_ACT); gB = (const bf16*)(ws + WS_WD + li * SZ_WD); gN = D; gK = DFF; break;
        default: break;
        }
        if (is_gemm) {
            pg8::Gemm g{gA, gB, M, gN, gK}; pg8::StaticOrder S; S.init(M, gN, (int)gridDim.x, (int)blockIdx.x);
            pg8::gemm_phase<EpiAny, pg8::StaticOrder, true, true>(lds, g, S, E);
        }
        if (ph + 1 < hi) cg::this_grid().sync();
    }
}

__global__ void __launch_bounds__(256) k_retention(const bf16* __restrict__ QK, const bf16* __restrict__ V, const float* __restrict__ Sin, float* __restrict__ o, float* __restrict__ Sout_p, float* __restrict__ Sout_s, int is_sample) {
    __shared__ float sq[256], sk[256], red[4][64];
    const int es = blockIdx.x & 7, h = (blockIdx.x >> 3) & 3, seq = blockIdx.x >> 5;
    const int e = threadIdx.x & 63, dq = threadIdx.x >> 6;
    const int r0 = is_sample ? MP + seq : seq * TP, T = is_sample ? 1 : TP;
    const float gamma = 1.0f - exp2f(-5.0f - (float)h);
    float S[64];
    if (is_sample) {
        const float* sp = Sin + (((size_t)seq * RH + h) * RDK + dq * 64) * RDV + es * 64 + e;
#pragma unroll
        for (int dd = 0; dd < 64; ++dd) S[dd] = sp[(size_t)dd * RDV];
    } else {
#pragma unroll
        for (int dd = 0; dd < 64; ++dd) S[dd] = 0.f;
    }
    for (int t = 0; t < T; ++t) {
        const int row = r0 + t;
        sq[threadIdx.x] = __uint_as_float((unsigned)QK[(size_t)row * 2048 + h * RDK + threadIdx.x] << 16);
        sk[threadIdx.x] = __uint_as_float((unsigned)QK[(size_t)row * 2048 + 1024 + h * RDK + threadIdx.x] << 16);
        const float ve = __uint_as_float((unsigned)V[(size_t)row * 2048 + h * RDV + es * 64 + e] << 16);
        __syncthreads();
        float acc = 0.f;
#pragma unroll
        for (int dd = 0; dd < 64; ++dd) { S[dd] = fmaf(S[dd], gamma, sk[dq * 64 + dd] * ve); acc = fmaf(sq[dq * 64 + dd], S[dd], acc); }
        red[dq][e] = acc;
        __syncthreads();
        if (dq == 0) o[(size_t)row * RV + h * RDV + es * 64 + e] = (red[0][e] + red[1][e]) + (red[2][e] + red[3][e]);
    }
    float* so = (is_sample ? Sout_s : Sout_p) + (((size_t)seq * RH + h) * RDK + dq * 64) * RDV + es * 64 + e;
#pragma unroll
    for (int dd = 0; dd < 64; ++dd) so[(size_t)dd * RDV] = S[dd];
}
__global__ void __launch_bounds__(64) k_wkv(const float* __restrict__ r, const float* __restrict__ w, const float* __restrict__ k, const float* __restrict__ v, const float* __restrict__ nkk, const float* __restrict__ kka,
                                           const float* __restrict__ Sin, float* __restrict__ y, float* __restrict__ Sout_p, float* __restrict__ Sout_s, int is_sample) {
    __shared__ float sv[5][64];
    const int h = blockIdx.x & 15, seq = blockIdx.x >> 4, lane = threadIdx.x;
    const int r0 = is_sample ? MP + seq : seq * TP, T = is_sample ? 1 : TP;
    float S[64];
    if (is_sample) {
        const float* sp = Sin + (((size_t)seq * WH + h) * WN + lane) * WN;
#pragma unroll
        for (int j = 0; j < 64; j += 4) { const float4 t4 = *(const float4*)(sp + j); S[j] = t4.x; S[j + 1] = t4.y; S[j + 2] = t4.z; S[j + 3] = t4.w; }
    } else {
#pragma unroll
        for (int j = 0; j < 64; ++j) S[j] = 0.f;
    }
    for (int t = 0; t < T; ++t) {
        const size_t idx = (size_t)(r0 + t) * D + h * WN + lane;
        sv[0][lane] = nkk[idx]; sv[1][lane] = w[idx]; sv[2][lane] = kka[idx]; sv[3][lane] = k[idx]; sv[4][lane] = r[idx];
        const float vi = v[idx];
        __syncthreads();
        float sa0 = 0.f, sa1 = 0.f, sa2 = 0.f, sa3 = 0.f;
#pragma unroll
        for (int j = 0; j < 64; j += 4) { sa0 = fmaf(S[j], sv[0][j], sa0); sa1 = fmaf(S[j + 1], sv[0][j + 1], sa1); sa2 = fmaf(S[j + 2], sv[0][j + 2], sa2); sa3 = fmaf(S[j + 3], sv[0][j + 3], sa3); }
        const float sa = (sa0 + sa1) + (sa2 + sa3);
        float y0 = 0.f, y1 = 0.f, y2 = 0.f, y3 = 0.f;
#pragma unroll
        for (int j = 0; j < 64; j += 4) {
            S[j] = fmaf(S[j], sv[1][j], fmaf(sa, sv[2][j], vi * sv[3][j])); y0 = fmaf(S[j], sv[4][j], y0);
            S[j + 1] = fmaf(S[j + 1], sv[1][j + 1], fmaf(sa, sv[2][j + 1], vi * sv[3][j + 1])); y1 = fmaf(S[j + 1], sv[4][j + 1], y1);
            S[j + 2] = fmaf(S[j + 2], sv[1][j + 2], fmaf(sa, sv[2][j + 2], vi * sv[3][j + 2])); y2 = fmaf(S[j + 2], sv[4][j + 2], y2);
            S[j + 3] = fmaf(S[j + 3], sv[1][j + 3], fmaf(sa, sv[2][j + 3], vi * sv[3][j + 3])); y3 = fmaf(S[j + 3], sv[4][j + 3], y3);
        }
        y[idx] = (y0 + y1) + (y2 + y3);
        __syncthreads();
    }
    float* so = (is_sample ? Sout_s : Sout_p) + (((size_t)seq * WH + h) * WN + lane) * WN;
#pragma unroll
    for (int j = 0; j < 64; j += 4) { float4 t4; t4.x = S[j]; t4.y = S[j + 1]; t4.z = S[j + 2]; t4.w = S[j + 3]; *(float4*)(so + j) = t4; }
}
}

extern "C" void kernel_launch(void* const* d_in, const int* in_sizes, int n_in, void* d_out, int out_size, void* d_ws, size_t ws_size, hipStream_t stream) {
    static int grid = 0;
    if (grid == 0) {
        int dev = 0, cus = 0;
        if (n_in != N_IN || ws_size < WS_END) { fprintf(stderr, "kernel_launch: unexpected n_in %d / ws_size %zu (need %zu)\n", n_in, ws_size, (size_t)WS_END); grid = -1; return; }
        if (hipGetDevice(&dev) != hipSuccess || hipDeviceGetAttribute(&cus, hipDeviceAttributeMultiprocessorCount, dev) != hipSuccess) { grid = -1; return; }
        if (hipFuncSetAttribute((const void*)mega, hipFuncAttributeMaxDynamicSharedMemorySize, LDS_BYTES) != hipSuccess) { fprintf(stderr, "kernel_launch: hipFuncSetAttribute failed\n"); grid = -1; return; }
        int per_cu = 0;
        if (hipOccupancyMaxActiveBlocksPerMultiprocessor(&per_cu, (const void*)mega, NTHR, LDS_BYTES) != hipSuccess || per_cu < 1) { fprintf(stderr, "kernel_launch: occupancy query says %d\n", per_cu); (void)hipGetLastError(); }
        grid = cus;
    }
    if (grid < 0) return;
    Params p{};
    for (int i = 0; i < N_IN; ++i) p.in[i] = (const float*)d_in[i];
    p.out = (float*)d_out; p.ws = (unsigned char*)d_ws;
    unsigned char* ws = p.ws; float* out = p.out;
    for (int ph = 0; ph < NPH; ++ph) {
        const Ph P = phase_at(ph); const int jl = P.layer >> 1;
        if (P.op == OP_RET) {
            k_retention<<<BATCH * RH * 8, 256, 0, stream>>>((const bf16*)(ws + WS_QK), (const bf16*)(ws + WS_V), nullptr, (float*)(ws + WS_O), out + O_RETP + (size_t)jl * BATCH * RH * RDK * RDV, nullptr, 0);
            k_retention<<<SB * RH * 8, 256, 0, stream>>>((const bf16*)(ws + WS_QK), (const bf16*)(ws + WS_V), p.in[I_SRET] + (size_t)jl * SB * RH * RDK * RDV, (float*)(ws + WS_O), nullptr, out + O_RETS + (size_t)jl * SB * RH * RDK * RDV, 1);
        } else if (P.op == OP_WKV) {
            const float* vuse = (const float*)(ws + (jl == 0 ? WS_VF : WS_VB));
            k_wkv<<<BATCH * WH, 64, 0, stream>>>((const float*)(ws + WS_R), (const float*)(ws + WS_WDEC), (const float*)(ws + WS_K), vuse, (const float*)(ws + WS_NKK), (const float*)(ws + WS_KKA), nullptr,
                                               (float*)(ws + WS_YW), out + O_WKVP + (size_t)jl * BATCH * WH * WN * WN, nullptr, 0);
            k_wkv<<<SB * WH, 64, 0, stream>>>((const float*)(ws + WS_R), (const float*)(ws + WS_WDEC), (const float*)(ws + WS_K), vuse, (const float*)(ws + WS_NKK), (const float*)(ws + WS_KKA), p.in[I_SWKV] + (size_t)jl * SB * WH * WN * WN,
                                            (float*)(ws + WS_YW), nullptr, out + O_WKVS + (size_t)jl * SB * WH * WN * WN, 1);
        } else {
            hipLaunchKernelGGL(mega, dim3(grid), dim3(NTHR), LDS_BYTES, stream, p, ph, ph + 1);
        }
    }
    (void)in_sizes; (void)out_size;
}
```

```cpp
#include <hip/hip_runtime.h>
#include <hip/hip_cooperative_groups.h>
#include <cstdio>
#include <stdint.h>
namespace cg = cooperative_groups;
namespace pg8 {
#define PG8_LAS __attribute__((address_space(3)))
typedef unsigned short bf16_t;
typedef short bf16x8 __attribute__((ext_vector_type(8)));
typedef float f32x4 __attribute__((ext_vector_type(4)));
typedef unsigned u32x4 __attribute__((ext_vector_type(4)));
constexpr int BM = 256, BK = 64, HALF = 128, HTB = HALF * BK * 2  , STAGE_BYTES = 8 * HTB, NXCD = 8, WGM = 8;

__host__ __device__ __forceinline__ int lds_byte(int r, int c) { const int st = (r >> 4) * 2 + (c >> 5), rr = r & 15, cc = c & 31, ob = rr * 64 + cc * 2; return st * 1024 + (ob ^ (((ob >> 9) & 1) << 5)); }
__host__ __device__ __forceinline__ void stage_rc(int b, int& R, int& C) { const int st = b / 1024, sb = b % 1024, swz = sb ^ (((sb >> 9) & 1) << 5); R = (st >> 1) * 16 + swz / 64; C = (st & 1) * 32 + (swz % 64) / 2; }
__host__ __device__ __forceinline__ int perm32(int rho) { const int n = rho >> 4, i = rho & 15; return 8 * (i >> 2) + 4 * n + (i & 3); }

struct Unit { int pm, pn; };
struct Gemm { const bf16_t* A; const bf16_t* Bt; int M, N, K; };

struct StaticOrder {
    int nM, nN, nwg, G, c;
    __host__ __device__ void init(int M, int N, int G_, int c_) { nM = M / BM; nN = N / BM; nwg = nM * nN; G = G_; c = c_; }
    __host__ __device__ bool next(int i, Unit& u) const {
        const long L = (long)i * G + c; if (L >= nwg) return false;
        int wgid = (int)L; { const int q = nwg / NXCD, r = nwg % NXCD, xcd = wgid % NXCD, off = wgid / NXCD; wgid = (xcd < r ? xcd * (q + 1) : r * (q + 1) + (xcd - r) * q) + off; }
        const int nig = WGM * nN, gid = wgid / nig, fm = gid * WGM, gsz = (nM - fm) < WGM ? (nM - fm) : WGM;
        u.pm = fm + ((wgid % nig) % gsz); u.pn = (wgid % nig) / gsz; return true;
    }
    __device__ __forceinline__ void a_ready(const Unit&) const {}
    __device__ __forceinline__ void done(const Unit&) const {}
};
template <class Epi, class Sched, bool ALIGN_EPI = false, bool SP2 = false>
__device__ __forceinline__ void gemm_phase(PG8_LAS unsigned char* lds, const Gemm g, const Sched& S, const Epi& E) {
    int tid = threadIdx.x; asm volatile("" : "+v"(tid));
    const int wid = __builtin_amdgcn_readfirstlane(tid >> 6), lane = tid & 63, wr = wid >> 2, wc = wid & 3, fr = lane & 15, fq = lane >> 4;
    const int K = g.K, nt = K / BK;
    unsigned voffA[2], voffB[2];
#pragma unroll
    for (int i = 0; i < 2; ++i) { int R, C; stage_rc(tid * 16 + i * 8192, R, C); const int Rb = E.perm ? ((R & ~31) + perm32(R & 31)) : R;
        voffA[i] = (unsigned)(R * K + C) * 2u; voffB[i] = (unsigned)(Rb * K + C) * 2u; }
    const size_t kstep = (size_t)(BK * 2);
    const size_t hstep = (size_t)HALF * K * 2;
    const size_t tstep = 2 * hstep;
    const unsigned ldsw = (unsigned)wid * 1024u;
    const int aoff = lds_byte(wr * 64 + fr, fq * 8), boff = lds_byte(wc * 32 + fr, fq * 8);
#define PG8_SA(b, h) (((b) * 2 + (h)) * HTB)
#define PG8_SB(b, h) ((4 + (b) * 2 + (h)) * HTB)
#define PG8_STAGE(bufoff, gbase, voff) do { _Pragma("unroll") for (int _i = 0; _i < 2; ++_i) \
        __builtin_amdgcn_global_load_lds((const unsigned*)((const char*)(gbase) + (voff)[_i]), (PG8_LAS unsigned*)(lds + (bufoff) + ldsw + _i * 8192), 16, 0, 0); } while (0)
#define PG8_LDA(dst, b, h) do { _Pragma("unroll") for (int m = 0; m < 4; ++m) _Pragma("unroll") for (int k = 0; k < 2; ++k) dst[m][k] = *(const PG8_LAS bf16x8*)(lds + PG8_SA(b, h) + aoff + m * 2048 + k * 1024); } while (0)
#define PG8_LDB(dst, b, h) do { _Pragma("unroll") for (int n = 0; n < 2; ++n) _Pragma("unroll") for (int k = 0; k < 2; ++k) dst[n][k] = *(const PG8_LAS bf16x8*)(lds + PG8_SB(b, h) + boff + n * 2048 + k * 1024); } while (0)
#define PG8_MMA(ai, bj, At, Bt) do { __builtin_amdgcn_s_setprio(1); _Pragma("unroll") for (int m = 0; m < 4; ++m) _Pragma("unroll") for (int n = 0; n < 2; ++n) _Pragma("unroll") for (int k = 0; k < 2; ++k) \
        acc[ai][bj][m][n] = __builtin_amdgcn_mfma_f32_16x16x32_bf16(Bt[n][k], At[m][k], acc[ai][bj][m][n], 0, 0, 0); __builtin_amdgcn_s_setprio(0); } while (0)
#define PG8_WAIT_V(n) asm volatile("s_waitcnt vmcnt(" #n ")" ::: "memory")
#define PG8_WAIT_L(n) asm volatile("s_waitcnt lgkmcnt(" #n ")" ::: "memory")
#define PG8_BAR __builtin_amdgcn_s_barrier()
#define PG8_SCHED __builtin_amdgcn_sched_barrier(0)
    Unit cur, nxt; int ui = 0;
    if (!S.next(0, cur)) return;
    f32x4 acc[2][2][4][2];
#pragma unroll
    for (int a = 0; a < 2; ++a)
#pragma unroll
        for (int b = 0; b < 2; ++b)
#pragma unroll
            for (int m = 0; m < 4; ++m)
#pragma unroll
                for (int n = 0; n < 2; ++n) acc[a][b][m][n] = (f32x4){0.f, 0.f, 0.f, 0.f};
    bf16x8 At[4][2], B0[2][2], B1[2][2];
    const char* cA = (const char*)g.A + (size_t)cur.pm * tstep; const char* cB = (const char*)g.Bt + (size_t)cur.pn * tstep;
    S.a_ready(cur);
    if constexpr (SP2) {
        PG8_STAGE(PG8_SB(0, 0), cB, voffB); PG8_STAGE(PG8_SB(0, 1), cB + hstep, voffB); PG8_STAGE(PG8_SA(0, 0), cA, voffA); PG8_STAGE(PG8_SA(0, 1), cA + hstep, voffA);
        if (wr == 1) PG8_BAR;
        PG8_WAIT_V(2); PG8_BAR;
        PG8_STAGE(PG8_SB(1, 0), cB + kstep, voffB); PG8_STAGE(PG8_SA(1, 0), cA + kstep, voffA); PG8_STAGE(PG8_SB(1, 1), cB + hstep + kstep, voffB);
        PG8_WAIT_V(6); PG8_BAR;
    } else {
        PG8_STAGE(PG8_SB(0, 0), cB, voffB); PG8_STAGE(PG8_SA(0, 0), cA, voffA); PG8_STAGE(PG8_SB(0, 1), cB + hstep, voffB); PG8_STAGE(PG8_SA(0, 1), cA + hstep, voffA);
        if (wr == 1) PG8_BAR;
        PG8_WAIT_V(4); PG8_BAR;
        PG8_STAGE(PG8_SB(1, 0), cB + kstep, voffB); PG8_STAGE(PG8_SA(1, 0), cA + kstep, voffA); PG8_STAGE(PG8_SB(1, 1), cB + hstep + kstep, voffB);
        PG8_WAIT_V(6); PG8_BAR;
    }
    for (;;) {
        const bool has_next = S.next(ui + 1, nxt);
        const char* nA = has_next ? (const char*)g.A + (size_t)nxt.pm * tstep : cA; const char* nB = has_next ? (const char*)g.Bt + (size_t)nxt.pn * tstep : cB;
        for (int t = 0; t < nt; t += 2) {
            const bool last = (t == nt - 2);
            const char* a1 = cA + (size_t)(t + 1) * kstep;
            const char* a2 = last ? nA : cA + (size_t)(t + 2) * kstep; const char* b2 = last ? nB : cB + (size_t)(t + 2) * kstep;
            const char* a3 = a2 + kstep; const char* b3 = b2 + kstep;
            if (last && has_next) S.a_ready(nxt);
            if constexpr (SP2) {
            PG8_LDB(B0, 0, 0); PG8_LDB(B1, 0, 1); PG8_SCHED; PG8_LDA(At, 0, 0); PG8_STAGE(PG8_SA(1, 1), a1 + hstep, voffA);
            PG8_WAIT_V(8); PG8_WAIT_L(0); PG8_BAR; PG8_MMA(0, 0, At, B0); PG8_MMA(0, 1, At, B1); PG8_BAR; PG8_SCHED;
            PG8_LDA(At, 0, 1); PG8_STAGE(PG8_SB(0, 0), b2, voffB); PG8_STAGE(PG8_SB(0, 1), b2 + hstep, voffB); PG8_STAGE(PG8_SA(0, 0), a2, voffA);
            PG8_WAIT_V(8); PG8_WAIT_L(0); PG8_BAR; PG8_MMA(1, 0, At, B0); PG8_MMA(1, 1, At, B1); PG8_BAR; PG8_SCHED;
            PG8_LDB(B0, 1, 0); PG8_LDB(B1, 1, 1); PG8_SCHED; PG8_LDA(At, 1, 0); PG8_STAGE(PG8_SA(0, 1), a2 + hstep, voffA);
            PG8_WAIT_V(8); PG8_WAIT_L(0); PG8_BAR; PG8_MMA(0, 0, At, B0); PG8_MMA(0, 1, At, B1); PG8_BAR; PG8_SCHED;
            PG8_LDA(At, 1, 1); PG8_STAGE(PG8_SB(1, 0), b3, voffB); PG8_STAGE(PG8_SB(1, 1), b3 + hstep, voffB); PG8_STAGE(PG8_SA(1, 0), a3, voffA);
            PG8_WAIT_V(8); PG8_WAIT_L(0); PG8_BAR; PG8_MMA(1, 0, At, B0); PG8_MMA(1, 1, At, B1); PG8_BAR; PG8_SCHED;
            } else {
            PG8_LDB(B0, 0, 0); PG8_SCHED; PG8_LDA(At, 0, 0); PG8_STAGE(PG8_SA(1, 1), a1 + hstep, voffA);
            PG8_WAIT_L(8); PG8_BAR; PG8_WAIT_L(0); PG8_MMA(0, 0, At, B0); PG8_BAR; PG8_SCHED;
            PG8_LDB(B1, 0, 1); PG8_STAGE(PG8_SB(0, 0), b2, voffB);
            PG8_BAR; PG8_WAIT_L(0); PG8_MMA(0, 1, At, B1); PG8_BAR;
            PG8_LDA(At, 0, 1); PG8_STAGE(PG8_SA(0, 0), a2, voffA);
            PG8_BAR; PG8_WAIT_L(0); PG8_MMA(1, 0, At, B0); PG8_BAR; PG8_SCHED;
            PG8_STAGE(PG8_SB(0, 1), b2 + hstep, voffB);
            PG8_WAIT_V(6); PG8_BAR; PG8_MMA(1, 1, At, B1); PG8_BAR;
            PG8_LDB(B0, 1, 0); PG8_SCHED; PG8_LDA(At, 1, 0); PG8_STAGE(PG8_SA(0, 1), a2 + hstep, voffA);
            PG8_WAIT_L(8); PG8_BAR; PG8_WAIT_L(0); PG8_MMA(0, 0, At, B0); PG8_BAR; PG8_SCHED;
            PG8_LDB(B1, 1, 1); PG8_STAGE(PG8_SB(1, 0), b3, voffB);
            PG8_BAR; PG8_WAIT_L(0); PG8_MMA(0, 1, At, B1); PG8_BAR;
            PG8_LDA(At, 1, 1); PG8_STAGE(PG8_SA(1, 0), a3, voffA);
            PG8_BAR; PG8_WAIT_L(0); PG8_MMA(1, 0, At, B0); PG8_BAR; PG8_SCHED;
            PG8_STAGE(PG8_SB(1, 1), b3 + hstep, voffB);
            PG8_WAIT_V(6); PG8_BAR; PG8_MMA(1, 1, At, B1); PG8_BAR;
            }
        }
        if constexpr (ALIGN_EPI) { if (wr == 0) PG8_BAR; }
        if constexpr (!Epi::AFTER_DRAIN) { E(acc, cur, wr, wc, fr, fq); S.done(cur); }
        if (!has_next) break;
#pragma unroll
        for (int a = 0; a < 2; ++a)
#pragma unroll
            for (int b = 0; b < 2; ++b)
#pragma unroll
                for (int m = 0; m < 4; ++m)
#pragma unroll
                    for (int n = 0; n < 2; ++n) acc[a][b][m][n] = (f32x4){0.f, 0.f, 0.f, 0.f};
        cur = nxt; cA = nA; cB = nB; ++ui;
        if constexpr (ALIGN_EPI) { if (wr == 1) PG8_BAR; }
    }
    PG8_WAIT_V(0);
    if constexpr (!ALIGN_EPI) { if (wr == 0) PG8_BAR; }
    PG8_BAR;
    if constexpr (Epi::AFTER_DRAIN) { E.fused(acc, cur, wr, wc, fr, fq, lds, wid, lane); S.done(cur); }
#undef PG8_SA
#undef PG8_SB
#undef PG8_STAGE
#undef PG8_LDA
#undef PG8_LDB
#undef PG8_MMA
#undef PG8_WAIT_V
#undef PG8_WAIT_L
#undef PG8_BAR
#undef PG8_SCHED
}
}

namespace {
constexpr int D = 1024, BATCH = 8, SEQ = 2048, NMETA = 16, TP = SEQ + NMETA, MP = BATCH * TP, SB = 128, M = MP + SB;
constexpr int DEPTH = 4, RH = 4, RDK = 256, RDV = 512, RV = 2048, RWIN = 6144;
constexpr int WH = 16, WN = 64, LW = 64, LA = 64, LV = 32, LG = 160, DFF = 2816;
constexpr int NRW = 3584, KRW = 2048, KL2 = 384, NL2 = 4096;
constexpr float PAST_POS = 16384.f;
constexpr int NWAVES = 8, NTHR = 512;
constexpr int LDS_BYTES = 147456;

constexpr size_t O_YP = 0;
constexpr size_t O_YS = O_YP + (size_t)BATCH * SEQ * D;
constexpr size_t O_RETP = O_YS + (size_t)SB * D;
constexpr size_t O_WKVP = O_RETP + (size_t)2 * BATCH * RH * RDK * RDV;
constexpr size_t O_SHP = O_WKVP + (size_t)2 * BATCH * WH * WN * WN;
constexpr size_t O_CVP = O_SHP + (size_t)2 * BATCH * D;
constexpr size_t O_RETS = O_CVP + (size_t)DEPTH * BATCH * 2 * DFF;
constexpr size_t O_WKVS = O_RETS + (size_t)2 * SB * RH * RDK * RDV;
constexpr size_t O_SHS = O_WKVS + (size_t)2 * SB * WH * WN * WN;
constexpr size_t O_CVS = O_SHS + (size_t)2 * SB * D;

enum { I_XP = 0, I_XS, I_SRET, I_SWKV, I_SSHIFT, I_SCONV, I_META, I_NMIX, I_NFFN, I_NFIN, I_RWIN, I_RGN, I_RWOUT, I_MU, I_WRKV, I_W0, I_W1, I_W2,
       I_A0, I_A1, I_A2, I_V0, I_V1, I_V2, I_G1, I_G2, I_KK, I_KA, I_RK, I_LNW, I_LNB, I_WO, I_WUG, I_CW, I_CB, I_WD, N_IN };

constexpr size_t al256(size_t x) { return (x + 255) & ~(size_t)255; }
constexpr size_t WS_CTL = 0;
constexpr size_t WS_CS = 1u << 20;
constexpr size_t WS_WIN = 4u << 20;
constexpr size_t SZ_WIN = (size_t)RWIN * D * 2;
constexpr size_t WS_WOUT = WS_WIN + 2 * SZ_WIN;
constexpr size_t SZ_WOUT = (size_t)D * RV * 2;
constexpr size_t WS_WRW = WS_WOUT + 2 * SZ_WOUT;
constexpr size_t SZ_WRW = (size_t)NRW * KRW * 2;
constexpr size_t WS_WL2 = WS_WRW + 2 * SZ_WRW;
constexpr size_t SZ_WL2 = (size_t)NL2 * KL2 * 2;
constexpr size_t WS_WO = WS_WL2 + 2 * SZ_WL2;
constexpr size_t SZ_WO = (size_t)D * D * 2;
constexpr size_t WS_WUG = WS_WO + 2 * SZ_WO;
constexpr size_t SZ_WUG = (size_t)2 * DFF * D * 2;
constexpr size_t WS_WD = WS_WUG + 4 * SZ_WUG;
constexpr size_t SZ_WD = (size_t)D * DFF * 2;
constexpr size_t WS_X = al256(WS_WD + 4 * SZ_WD);
constexpr size_t SZ_MD4 = (size_t)M * D * 4;
constexpr size_t WS_H = WS_X + SZ_MD4;
constexpr size_t WS_VF = WS_H + SZ_MD4;
constexpr size_t WS_REG = WS_VF + SZ_MD4;
constexpr size_t WS_QK = WS_REG;
constexpr size_t WS_V = WS_QK + SZ_MD4;
constexpr size_t WS_SG = WS_V + SZ_MD4;
constexpr size_t WS_O = WS_SG + SZ_MD4;
constexpr size_t WS_Y = WS_O + 2 * SZ_MD4;
constexpr size_t WS_R = WS_REG;
constexpr size_t WS_K = WS_R + SZ_MD4;
constexpr size_t WS_VB = WS_K + SZ_MD4;
constexpr size_t WS_WDEC = WS_VB + SZ_MD4;
constexpr size_t WS_NKK = WS_WDEC + SZ_MD4;
constexpr size_t WS_KKA = WS_NKK + SZ_MD4;
constexpr size_t WS_YW = WS_KKA + SZ_MD4;
constexpr size_t WS_L2 = WS_YW + SZ_MD4;
constexpr size_t WS_A2 = WS_L2 + 4 * SZ_MD4;
constexpr size_t WS_Z = al256(WS_A2 + (size_t)M * KL2 * 2);
constexpr size_t WS_RW_END = WS_Z + (size_t)M * D * 2;
constexpr size_t SZ_FF2 = (size_t)M * DFF * 2;
constexpr size_t WS_U = WS_REG;
constexpr size_t WS_G = al256(WS_U + SZ_FF2);
constexpr size_t WS_ACT = al256(WS_G + SZ_FF2);
constexpr size_t WS_END = WS_RW_END;

#define LAS __attribute__((address_space(3)))
typedef unsigned short bf16;
typedef unsigned v4u __attribute__((ext_vector_type(4)));
typedef unsigned v2u __attribute__((ext_vector_type(2)));
using pg8::f32x4;
using pg8::Unit;

struct Params { const float* in[N_IN]; float* out; unsigned char* ws; };

__device__ __forceinline__ unsigned cvt_pk_bf16(float lo, float hi) { unsigned r; asm("v_cvt_pk_bf16_f32 %0, %1, %2" : "=v"(r) : "v"(lo), "v"(hi)); return r; }
__device__ __forceinline__ float bf_lo(unsigned w) { return __uint_as_float(w << 16); }
__device__ __forceinline__ float bf_hi(unsigned w) { return __uint_as_float(w & 0xffff0000u); }
__device__ __forceinline__ void unpack8(const v4u w, float (&f)[8]) { f[0] = bf_lo(w.x); f[1] = bf_hi(w.x); f[2] = bf_lo(w.y); f[3] = bf_hi(w.y); f[4] = bf_lo(w.z); f[5] = bf_hi(w.z); f[6] = bf_lo(w.w); f[7] = bf_hi(w.w); }
__device__ __forceinline__ v4u pack8(const float (&f)[8]) { v4u w; w.x = cvt_pk_bf16(f[0], f[1]); w.y = cvt_pk_bf16(f[2], f[3]); w.z = cvt_pk_bf16(f[4], f[5]); w.w = cvt_pk_bf16(f[6], f[7]); return w; }
__device__ __forceinline__ float wave_sum(float v) {
#pragma unroll
    for (int o = 1; o < 64; o <<= 1) v += __shfl_xor(v, o);
    return v;
}
__device__ __forceinline__ float sigmoidf_(float x) { return 1.f / (1.f + __expf(-x)); }
__device__ __forceinline__ float siluf_(float x) { return x / (1.f + __expf(-x)); }
__device__ __forceinline__ float tanhf_(float x) { return 1.f - 2.f / (1.f + __expf(2.f * x)); }

enum { EK_RETIN = 0, EK_RESID, EK_UG, EK_RWPROJ, EK_F32 };
struct EpiAny {
    static constexpr bool AFTER_DRAIN = false;
    int kind; bool perm; int jl; unsigned char* ws;
    __device__ __forceinline__ void operator()(const f32x4 (&acc)[2][2][4][2], const Unit& u, int wr, int wc, int fr, int fq) const {
        const int row0 = u.pm * 256 + wr * 64 + fr;
        if (kind == EK_RETIN) {
            bf16* QK = (bf16*)(ws + WS_QK); bf16* V = (bf16*)(ws + WS_V); bf16* SG = (bf16*)(ws + WS_SG); const float* CS = (const float*)(ws + WS_CS);
            const int cw = wc * 32 + 8 * fq;
            if (u.pn < 8) {
                const bool isk = u.pn >= 4; const int h = u.pn & 3; const float sc = isk ? 0.0625f : 1.f;
                bf16* base = QK + (isk ? 1024 : 0) + h * 256 + cw;
#pragma unroll
                for (int ai = 0; ai < 2; ++ai)
#pragma unroll
                    for (int m = 0; m < 4; ++m) {
                        const int row = row0 + ai * 128 + m * 16;
                        const int pi = row < MP ? row % TP : TP;
                        const f32x4* cs = (const f32x4*)(CS + ((size_t)pi * 128 + cw) * 2);
                        const f32x4 t0 = cs[0], t1 = cs[1], t2 = cs[2], t3 = cs[3];
                        const float c[8] = {t0.x, t0.z, t1.x, t1.z, t2.x, t2.z, t3.x, t3.z}, s[8] = {t0.y, t0.w, t1.y, t1.w, t2.y, t2.w, t3.y, t3.w};
                        float o1[8], o2[8];
#pragma unroll
                        for (int n = 0; n < 2; ++n)
#pragma unroll
                            for (int j = 0; j < 4; ++j) {
                                const float x1 = acc[ai][0][m][n][j], x2 = acc[ai][1][m][n][j];
                                o1[n * 4 + j] = (x1 * c[n * 4 + j] - x2 * s[n * 4 + j]) * sc;
                                o2[n * 4 + j] = (x1 * s[n * 4 + j] + x2 * c[n * 4 + j]) * sc;
                            }
                        bf16* rp = base + (size_t)row * 2048;
                        *(v4u*)rp = pack8(o1); *(v4u*)(rp + 128) = pack8(o2);
                        asm volatile("" ::: "memory");
                    }
            } else {
                const bool isg = u.pn >= 16;
                bf16* base = (isg ? SG : V) + ((u.pn - (isg ? 16 : 8)) * 256) + cw;
#pragma unroll
                for (int ai = 0; ai < 2; ++ai)
#pragma unroll
                    for (int m = 0; m < 4; ++m) {
                        bf16* rp = base + (size_t)(row0 + ai * 128 + m * 16) * 2048;
#pragma unroll
                        for (int bj = 0; bj < 2; ++bj) {
                            float o[8];
#pragma unroll
                            for (int n = 0; n < 2; ++n)
#pragma unroll
                                for (int j = 0; j < 4; ++j) { const float x = acc[ai][bj][m][n][j]; o[n * 4 + j] = isg ? siluf_(x) : x; }
                            *(v4u*)(rp + bj * 128) = pack8(o);
                        }
                    }
            }
        } else if (kind == EK_RESID) {
            float* X = (float*)(ws + WS_X);
            const int col0 = u.pn * 256 + wc * 32 + 4 * fq;
#pragma unroll
            for (int ai = 0; ai < 2; ++ai)
#pragma unroll
                for (int m = 0; m < 4; ++m) {
                    float* rp = X + (size_t)(row0 + ai * 128 + m * 16) * D + col0;
#pragma unroll
                    for (int bj = 0; bj < 2; ++bj)
#pragma unroll
                        for (int n = 0; n < 2; ++n) { f32x4* q = (f32x4*)(rp + bj * 128 + n * 16); *q = *q + acc[ai][bj][m][n]; }
                    asm volatile("" ::: "memory");
                }
        } else if (kind == EK_UG) {
            bf16* U = (bf16*)(ws + WS_U); bf16* G = (bf16*)(ws + WS_G);
            const int f0 = u.pn * 128 + wc * 32 + 8 * fq;
#pragma unroll
            for (int ai = 0; ai < 2; ++ai)
#pragma unroll
                for (int m = 0; m < 4; ++m) {
                    const size_t ro = (size_t)(row0 + ai * 128 + m * 16) * DFF + f0;
#pragma unroll
                    for (int bj = 0; bj < 2; ++bj) {
                        float o[8];
#pragma unroll
                        for (int n = 0; n < 2; ++n)
#pragma unroll
                            for (int j = 0; j < 4; ++j) o[n * 4 + j] = acc[ai][bj][m][n][j];
                        *(v4u*)((bj ? G : U) + ro) = pack8(o);
                    }
                }
        } else if (kind == EK_RWPROJ) {
            const int cl = wc * 32 + 4 * fq;
            if (u.pn < 12) {
                float* dst = (float*)(ws + (u.pn < 4 ? WS_R : (u.pn < 8 ? WS_K : (jl == 0 ? WS_VF : WS_VB)))) + (u.pn & 3) * 256 + cl;
#pragma unroll
                for (int ai = 0; ai < 2; ++ai)
#pragma unroll
                    for (int m = 0; m < 4; ++m) {
                        float* rp = dst + (size_t)(row0 + ai * 128 + m * 16) * D;
#pragma unroll
                        for (int bj = 0; bj < 2; ++bj)
#pragma unroll
                            for (int n = 0; n < 2; ++n) *(f32x4*)(rp + bj * 128 + n * 16) = acc[ai][bj][m][n];
                    }
            } else {
                bf16* A2 = (bf16*)(ws + WS_A2);
#pragma unroll
                for (int bj = 0; bj < 2; ++bj)
#pragma unroll
                    for (int n = 0; n < 2; ++n) {
                        const int c = (u.pn - 12) * 256 + bj * 128 + cl + 16 * n;
                        if (c < KL2) {
                            const int kd = c < 64 ? 1 : ((c >= 128 && c < 288) ? 2 : 0);
#pragma unroll
                            for (int ai = 0; ai < 2; ++ai)
#pragma unroll
                                for (int m = 0; m < 4; ++m) {
                                    f32x4 v = acc[ai][bj][m][n];
                                    if (kd == 1) { v.x = tanhf_(v.x); v.y = tanhf_(v.y); v.z = tanhf_(v.z); v.w = tanhf_(v.w); }
                                    else if (kd == 2) { v.x = sigmoidf_(v.x); v.y = sigmoidf_(v.y); v.z = sigmoidf_(v.z); v.w = sigmoidf_(v.w); }
                                    v2u w; w.x = cvt_pk_bf16(v.x, v.y); w.y = cvt_pk_bf16(v.z, v.w);
                                    *(v2u*)(A2 + (size_t)(row0 + ai * 128 + m * 16) * KL2 + c) = w;
                                }
                        }
                    }
            }
        } else {
            float* C = (float*)(ws + WS_L2); constexpr int ldc = NL2;
            const int col0 = u.pn * 256 + wc * 32 + 4 * fq;
#pragma unroll
            for (int ai = 0; ai < 2; ++ai)
#pragma unroll
                for (int m = 0; m < 4; ++m) {
                    float* rp = C + (size_t)(row0 + ai * 128 + m * 16) * ldc + col0;
#pragma unroll
                    for (int bj = 0; bj < 2; ++bj)
#pragma unroll
                        for (int n = 0; n < 2; ++n) *(f32x4*)(rp + bj * 128 + n * 16) = acc[ai][bj][m][n];
                }
        }
    }
};

__device__ __forceinline__ void tr_item(const float* __restrict__ W, int ldw, int k0, int n0, bf16* __restrict__ WT, int ldt, int drow, const float* __restrict__ mu, LAS float* scr, int lane) {
#pragma unroll 8
    for (int i = 0; i < 32; ++i) { const int kk = 2 * i + (lane >> 5); scr[kk * 33 + (lane & 31)] = W[(size_t)(k0 + kk) * ldw + n0 + (lane & 31)]; }
    asm volatile("s_waitcnt lgkmcnt(0)" ::: "memory");
    const int c = lane & 7;
    float mv[8];
    if (mu) {
#pragma unroll
        for (int e = 0; e < 8; ++e) mv[e] = mu[k0 + 8 * c + e];
    }
#pragma unroll
    for (int j = 0; j < 4; ++j) {
        const int n = (lane >> 3) + 8 * j; const LAS float* s = scr + (8 * c) * 33 + n;
        float f[8];
#pragma unroll
        for (int e = 0; e < 8; ++e) f[e] = s[e * 33];
        bf16* dp = WT + (size_t)(drow + n) * ldt + k0 + 8 * c;
        if (mu) {
            float f1[8], f2[8];
#pragma unroll
            for (int e = 0; e < 8; ++e) { f1[e] = f[e] * (1.f - mv[e]); f2[e] = f[e] * mv[e]; }
            *(v4u*)dp = pack8(f1); *(v4u*)(dp + 1024) = pack8(f2);
        } else *(v4u*)dp = pack8(f);
    }
    asm volatile("s_waitcnt lgkmcnt(0)" ::: "memory");
}

__device__ __forceinline__ void ph_p0(const Params& p, LAS unsigned char* lds, int tid, int lane, int wave) {
    unsigned char* ws = p.ws;
    LAS float* scr = (LAS float*)(lds + wave * 16384);
    const int gw = blockIdx.x * NWAVES + wave, NGW = gridDim.x * NWAVES;
    constexpr int C_WIN = 2 * 16 * 192, C_WOUT = 2 * 32 * 32, C_RKV = 2 * 3 * 512, C_W1 = 2 * 32, C_A1 = 2 * 32, C_G1 = 2 * 80, C_V1 = 16, C_WO = 2 * 512, C_WUG = 4 * 16 * 176, C_WD = 4 * 44 * 32;
    constexpr int NITEMS = C_WIN + C_WOUT + C_RKV + C_W1 + C_A1 + C_G1 + C_V1 + C_WO + C_WUG + C_WD;
    for (int it = gw; it < NITEMS; it += NGW) {
        int r = it;
        if (r < C_WIN) { const int j = r / 3072, q = r % 3072, kb = q / 192, nb = q % 192;
            tr_item(p.in[I_RWIN] + (size_t)j * D * RWIN, RWIN, 64 * kb, 32 * nb, (bf16*)(ws + WS_WIN + j * SZ_WIN), D, 32 * nb, nullptr, scr, lane); continue; }
        r -= C_WIN;
        if (r < C_WOUT) { const int j = r / 1024, q = r % 1024, kb = q / 32, nb = q % 32;
            tr_item(p.in[I_RWOUT] + (size_t)j * RV * D, D, 64 * kb, 32 * nb, (bf16*)(ws + WS_WOUT + j * SZ_WOUT), RV, 32 * nb, nullptr, scr, lane); continue; }
        r -= C_WOUT;
        if (r < C_RKV) { const int j = r / 1536, q = r % 1536, s = q / 512, q2 = q % 512, kb = q2 / 32, nb = q2 % 32, c = (s == 0 ? 0 : (s == 1 ? 2 : 3));
            tr_item(p.in[I_WRKV] + (size_t)(j * 3 + s) * D * D, D, 64 * kb, 32 * nb, (bf16*)(ws + WS_WRW + j * SZ_WRW), KRW, s * 1024 + 32 * nb, p.in[I_MU] + (size_t)(j * 6 + c) * D, scr, lane); continue; }
        r -= C_RKV;
        if (r < C_W1) { const int j = r / 32, q = r % 32, kb = q / 2, nb = q % 2;
            tr_item(p.in[I_W1] + (size_t)j * D * LW, LW, 64 * kb, 32 * nb, (bf16*)(ws + WS_WRW + j * SZ_WRW), KRW, 3072 + 32 * nb, p.in[I_MU] + (size_t)(j * 6 + 1) * D, scr, lane); continue; }
        r -= C_W1;
        if (r < C_A1) { const int j = r / 32, q = r % 32, kb = q / 2, nb = q % 2;
            tr_item(p.in[I_A1] + (size_t)j * D * LA, LA, 64 * kb, 32 * nb, (bf16*)(ws + WS_WRW + j * SZ_WRW), KRW, 3136 + 32 * nb, p.in[I_MU] + (size_t)(j * 6 + 4) * D, scr, lane); continue; }
        r -= C_A1;
        if (r < C_G1) { const int j = r / 80, q = r % 80, kb = q / 5, nb = q % 5;
            tr_item(p.in[I_G1] + (size_t)j * D * LG, LG, 64 * kb, 32 * nb, (bf16*)(ws + WS_WRW + j * SZ_WRW), KRW, 3200 + 32 * nb, p.in[I_MU] + (size_t)(j * 6 + 5) * D, scr, lane); continue; }
        r -= C_G1;
        if (r < C_V1) { const int kb = r;
            tr_item(p.in[I_V1], LV, 64 * kb, 0, (bf16*)(ws + WS_WRW + 1 * SZ_WRW), KRW, 3360, p.in[I_MU] + (size_t)(1 * 6 + 3) * D, scr, lane); continue; }
        r -= C_V1;
        if (r < C_WO) { const int j = r / 512, q = r % 512, kb = q / 32, nb = q % 32;
            tr_item(p.in[I_WO] + (size_t)j * D * D, D, 64 * kb, 32 * nb, (bf16*)(ws + WS_WO + j * SZ_WO), D, 32 * nb, nullptr, scr, lane); continue; }
        r -= C_WO;
        if (r < C_WUG) { const int i = r / 2816, q = r % 2816, kb = q / 176, nb = q % 176, n0 = 32 * nb;
            const int drow = n0 < DFF ? 256 * (n0 / 128) + (n0 % 128) : 256 * ((n0 - DFF) / 128) + 128 + ((n0 - DFF) % 128);
            tr_item(p.in[I_WUG] + (size_t)i * D * 2 * DFF, 2 * DFF, 64 * kb, n0, (bf16*)(ws + WS_WUG + i * SZ_WUG), D, drow, nullptr, scr, lane); continue; }
        r -= C_WUG;
        { const int i = r / 1408, q = r % 1408, kb = q / 32, nb = q % 32;
            tr_item(p.in[I_WD] + (size_t)i * DFF * D, D, 64 * kb, 32 * nb, (bf16*)(ws + WS_WD + i * SZ_WD), DFF, 32 * nb, nullptr, scr, lane); }
    }
    const size_t gt = (size_t)blockIdx.x * NTHR + tid, GT = (size_t)gridDim.x * NTHR;
    for (size_t i = gt; i < (size_t)(224 + 192) * (KRW / 8); i += GT) {
        const int rr = (int)(i / (KRW / 8)), c8 = (int)(i % (KRW / 8));
        const int j = rr < 224 ? 0 : 1, row = rr < 224 ? 3360 + rr : 3392 + (rr - 224);
        *(v4u*)((bf16*)(ws + WS_WRW + j * SZ_WRW) + (size_t)row * KRW + c8 * 8) = (v4u){0u, 0u, 0u, 0u};
    }
    for (size_t i = gt; i < (size_t)2 * NL2 * KL2; i += GT) {
        const int j = (int)(i / ((size_t)NL2 * KL2)); const int rem = (int)(i % ((size_t)NL2 * KL2)); const int n = rem / KL2, k = rem % KL2, grp = n >> 10, nn = n & 1023;
        float v = 0.f;
        if (grp == 0) { if (k < 64) v = p.in[I_W2][((size_t)j * LW + k) * D + nn]; }
        else if (grp == 1) { if (k >= 64 && k < 128) v = p.in[I_A2][((size_t)j * LA + (k - 64)) * D + nn]; }
        else if (grp == 2) { if (k >= 128 && k < 288) v = p.in[I_G2][((size_t)j * LG + (k - 128)) * D + nn]; }
        else { if (j == 1 && k >= 288 && k < 320) v = p.in[I_V2][((size_t)(k - 288)) * D + nn]; }
        ((bf16*)(ws + WS_WL2 + j * SZ_WL2))[(size_t)n * KL2 + k] = (bf16)(cvt_pk_bf16(v, 0.f) & 0xffffu);
    }
    for (size_t i = gt; i < (size_t)(TP + 1) * 128; i += GT) {
        const int pi = (int)(i >> 7), mi = (int)(i & 127);
        const float pos = pi < TP ? (float)pi : PAST_POS;
        const float inv = 1.0f / powf(10000.0f, (float)mi / 127.0f);
        float s, c; sincosf(pos * inv, &s, &c);
        ((float2*)(ws + WS_CS))[i] = make_float2(c, s);
    }
    float* X = (float*)(ws + WS_X);
    for (size_t i = gt; i < (size_t)M * (D / 4); i += GT) {
        const int r = (int)(i / (D / 4)), c4 = (int)(i % (D / 4));
        const float* src;
        if (r < MP) { const int b = r / TP, t = r % TP; src = t < NMETA ? p.in[I_META] + (size_t)t * D : p.in[I_XP] + ((size_t)b * SEQ + (t - NMETA)) * D; }
        else src = p.in[I_XS] + (size_t)(r - MP) * D;
        ((f32x4*)X)[i] = ((const f32x4*)src)[c4];
    }
}

__device__ __forceinline__ void ph_norm(const Params& p, const float* __restrict__ g, int mode, int jl, int lane, int wave) {
    const float* X = (const float*)(p.ws + WS_X); bf16* H = (bf16*)(p.ws + WS_H);
    const int gw = blockIdx.x * NWAVES + wave, NGW = gridDim.x * NWAVES;
    for (int row = gw; row < M; row += NGW) {
        const float* xr = X + (size_t)row * D;
        float v[2][8]; float ss = 0.f;
#pragma unroll
        for (int j = 0; j < 2; ++j) {
            const f32x4 a = *(const f32x4*)(xr + 512 * j + 8 * lane), b = *(const f32x4*)(xr + 512 * j + 8 * lane + 4);
            v[j][0] = a.x; v[j][1] = a.y; v[j][2] = a.z; v[j][3] = a.w; v[j][4] = b.x; v[j][5] = b.y; v[j][6] = b.z; v[j][7] = b.w;
#pragma unroll
            for (int e = 0; e < 8; ++e) ss += v[j][e] * v[j][e];
        }
        ss = wave_sum(ss);
        const float rstd = rsqrtf(ss * (1.f / D) + 1e-6f);
        const bool prompt = row < MP; const int b = prompt ? row / TP : 0, t = prompt ? row % TP : 0;
#pragma unroll
        for (int j = 0; j < 2; ++j) {
            const int c0 = 512 * j + 8 * lane;
            const f32x4 ga = *(const f32x4*)(g + c0), gb = *(const f32x4*)(g + c0 + 4);
            float o[8];
            o[0] = v[j][0] * rstd * ga.x; o[1] = v[j][1] * rstd * ga.y; o[2] = v[j][2] * rstd * ga.z; o[3] = v[j][3] * rstd * ga.w;
            o[4] = v[j][4] * rstd * gb.x; o[5] = v[j][5] * rstd * gb.y; o[6] = v[j][6] * rstd * gb.z; o[7] = v[j][7] * rstd * gb.w;
            if (mode == 0) { *(v4u*)(H + (size_t)row * D + c0) = pack8(o); }
            else if (mode == 1) {
                const v4u w = pack8(o);
                *(v4u*)(H + (size_t)row * 2048 + c0) = w;
                if (prompt) {
                    if (t != TP - 1) *(v4u*)(H + (size_t)(row + 1) * 2048 + 1024 + c0) = w;
                    else { float* so = p.out + O_SHP + ((size_t)jl * BATCH + b) * D + c0; *(f32x4*)so = (f32x4){o[0], o[1], o[2], o[3]}; *(f32x4*)(so + 4) = (f32x4){o[4], o[5], o[6], o[7]}; }
                    if (t == 0) *(v4u*)(H + (size_t)row * 2048 + 1024 + c0) = (v4u){0u, 0u, 0u, 0u};
                } else {
                    const int s = row - MP;
                    const float* sp = p.in[I_SSHIFT] + ((size_t)jl * SB + s) * D + c0;
                    const f32x4 sa = *(const f32x4*)sp, sb2 = *(const f32x4*)(sp + 4);
                    const float pv[8] = {sa.x, sa.y, sa.z, sa.w, sb2.x, sb2.y, sb2.z, sb2.w};
                    *(v4u*)(H + (size_t)row * 2048 + 1024 + c0) = pack8(pv);
                    float* so = p.out + O_SHS + ((size_t)jl * SB + s) * D + c0; *(f32x4*)so = (f32x4){o[0], o[1], o[2], o[3]}; *(f32x4*)(so + 4) = (f32x4){o[4], o[5], o[6], o[7]};
                }
            } else {
                float* dst = nullptr;
                if (prompt) { if (t >= NMETA) dst = p.out + O_YP + ((size_t)b * SEQ + (t - NMETA)) * D + c0; }
                else dst = p.out + O_YS + (size_t)(row - MP) * D + c0;
                if (dst) { *(f32x4*)dst = (f32x4){o[0], o[1], o[2], o[3]}; *(f32x4*)(dst + 4) = (f32x4){o[4], o[5], o[6], o[7]}; }
            }
        }
    }
}

__device__ __forceinline__ void ph_ret_norm(const Params& p, int jl, int lane, int wave) {
    const float* O = (const float*)(p.ws + WS_O); const bf16* SG = (const bf16*)(p.ws + WS_SG); bf16* Y = (bf16*)(p.ws + WS_Y);
    const float* gnw = p.in[I_RGN] + (size_t)jl * RV;
    const int gw = blockIdx.x * NWAVES + wave, NGW = gridDim.x * NWAVES;
    for (int it = gw; it < M * RH; it += NGW) {
        const int row = it >> 2, h = it & 3; const size_t off = (size_t)row * RV + h * RDV + 8 * lane;
        const f32x4 a = *(const f32x4*)(O + off), b = *(const f32x4*)(O + off + 4);
        float v[8] = {a.x, a.y, a.z, a.w, b.x, b.y, b.z, b.w};
        float s = 0.f;
#pragma unroll
        for (int e = 0; e < 8; ++e) s += v[e];
        const float mean = wave_sum(s) * (1.f / RDV);
        float s2 = 0.f;
#pragma unroll
        for (int e = 0; e < 8; ++e) { v[e] -= mean; s2 += v[e] * v[e]; }
        const float rstd = rsqrtf(wave_sum(s2) * (1.f / RDV) + 1e-5f);
        float sg[8]; unpack8(*(const v4u*)(SG + off), sg);
        const f32x4 ga = *(const f32x4*)(gnw + h * RDV + 8 * lane), gb = *(const f32x4*)(gnw + h * RDV + 8 * lane + 4);
        const float gg[8] = {ga.x, ga.y, ga.z, ga.w, gb.x, gb.y, gb.z, gb.w};
        float o[8];
#pragma unroll
        for (int e = 0; e < 8; ++e) o[e] = v[e] * rstd * gg[e] * sg[e];
        *(v4u*)(Y + off) = pack8(o);
    }
}

__device__ __forceinline__ void ph_conv(const Params& p, int li, int tid) {
    const bf16* U = (const bf16*)(p.ws + WS_U); const bf16* G = (const bf16*)(p.ws + WS_G); bf16* ACT = (bf16*)(p.ws + WS_ACT);
    const float* cw = p.in[I_CW] + (size_t)li * 3 * DFF; const float* cb = p.in[I_CB] + (size_t)li * DFF;
    const float* cst = p.in[I_SCONV] + (size_t)li * SB * 2 * DFF;
    float* cvp = p.out + O_CVP + (size_t)li * BATCH * 2 * DFF; float* cvs = p.out + O_CVS + (size_t)li * SB * 2 * DFF;
    const size_t gt = (size_t)blockIdx.x * NTHR + tid, GT = (size_t)gridDim.x * NTHR;
    constexpr int CH = DFF / 8;
    for (size_t i = gt; i < (size_t)M * CH; i += GT) {
        const int row = (int)(i / CH), f0 = (int)(i % CH) * 8;
        const size_t off = (size_t)row * DFF + f0;
        float u[8], g0[8], g1[8], g2[8];
        unpack8(*(const v4u*)(U + off), u); unpack8(*(const v4u*)(G + off), g0);
        if (row < MP) {
            const int b = row / TP, t = row % TP;
            if (t >= 1) unpack8(*(const v4u*)(G + off - DFF), g1); else {
#pragma unroll
                for (int e = 0; e < 8; ++e) g1[e] = 0.f; }
            if (t >= 2) unpack8(*(const v4u*)(G + off - 2 * DFF), g2); else {
#pragma unroll
                for (int e = 0; e < 8; ++e) g2[e] = 0.f; }
            if (t >= TP - 2) { float* o = cvp + ((size_t)b * 2 + (t - (TP - 2))) * DFF + f0; *(f32x4*)o = (f32x4){g0[0], g0[1], g0[2], g0[3]}; *(f32x4*)(o + 4) = (f32x4){g0[4], g0[5], g0[6], g0[7]}; }
        } else {
            const int s = row - MP;
            const float* c0 = cst + ((size_t)s * 2 + 0) * DFF + f0; const float* c1 = c0 + DFF;
            const f32x4 a0 = *(const f32x4*)c0, a1 = *(const f32x4*)(c0 + 4), b0 = *(const f32x4*)c1, b1 = *(const f32x4*)(c1 + 4);
            g2[0] = a0.x; g2[1] = a0.y; g2[2] = a0.z; g2[3] = a0.w; g2[4] = a1.x; g2[5] = a1.y; g2[6] = a1.z; g2[7] = a1.w;
            g1[0] = b0.x; g1[1] = b0.y; g1[2] = b0.z; g1[3] = b0.w; g1[4] = b1.x; g1[5] = b1.y; g1[6] = b1.z; g1[7] = b1.w;
            float* o = cvs + ((size_t)s * 2 + 0) * DFF + f0;
            *(f32x4*)o = b0; *(f32x4*)(o + 4) = b1;
            *(f32x4*)(o + DFF) = (f32x4){g0[0], g0[1], g0[2], g0[3]}; *(f32x4*)(o + DFF + 4) = (f32x4){g0[4], g0[5], g0[6], g0[7]};
        }
        float w0[8], w1[8], w2[8], bb[8];
        { const f32x4 x0 = *(const f32x4*)(cw + f0), x1 = *(const f32x4*)(cw + f0 + 4); w0[0] = x0.x; w0[1] = x0.y; w0[2] = x0.z; w0[3] = x0.w; w0[4] = x1.x; w0[5] = x1.y; w0[6] = x1.z; w0[7] = x1.w; }
        { const f32x4 x0 = *(const f32x4*)(cw + DFF + f0), x1 = *(const f32x4*)(cw + DFF + f0 + 4); w1[0] = x0.x; w1[1] = x0.y; w1[2] = x0.z; w1[3] = x0.w; w1[4] = x1.x; w1[5] = x1.y; w1[6] = x1.z; w1[7] = x1.w; }
        { const f32x4 x0 = *(const f32x4*)(cw + 2 * DFF + f0), x1 = *(const f32x4*)(cw + 2 * DFF + f0 + 4); w2[0] = x0.x; w2[1] = x0.y; w2[2] = x0.z; w2[3] = x0.w; w2[4] = x1.x; w2[5] = x1.y; w2[6] = x1.z; w2[7] = x1.w; }
        { const f32x4 x0 = *(const f32x4*)(cb + f0), x1 = *(const f32x4*)(cb + f0 + 4); bb[0] = x0.x; bb[1] = x0.y; bb[2] = x0.z; bb[3] = x0.w; bb[4] = x1.x; bb[5] = x1.y; bb[6] = x1.z; bb[7] = x1.w; }
        float o[8];
#pragma unroll
        for (int e = 0; e < 8; ++e) { const float cv = bb[e] + w0[e] * g2[e] + w1[e] * g1[e] + w2[e] * g0[e]; o[e] = siluf_(cv) * u[e]; }
        *(v4u*)(ACT + off) = pack8(o);
    }
}

__device__ __forceinline__ void ph_rwkv_prep(const Params& p, int jl, int lane, int wave) {
    float* Kb = (float*)(p.ws + WS_K); float* Vb = (float*)(p.ws + (jl == 0 ? WS_VF : WS_VB)); const float* VF = (const float*)(p.ws + WS_VF);
    const float* L2 = (const float*)(p.ws + WS_L2);
    float* Wd = (float*)(p.ws + WS_WDEC); float* NKK = (float*)(p.ws + WS_NKK); float* KKA = (float*)(p.ws + WS_KKA);
    const float* w0 = p.in[I_W0] + (size_t)jl * D; const float* a0 = p.in[I_A0] + (size_t)jl * D; const float* v0 = p.in[I_V0];
    const float* kkp = p.in[I_KK] + (size_t)jl * D; const float* kap = p.in[I_KA] + (size_t)jl * D;
    const int gw = blockIdx.x * NWAVES + wave, NGW = gridDim.x * NWAVES;
    for (int it = gw; it < M * WH; it += NGW) {
        const int row = it >> 4, h = it & 15, c = h * WN + lane;
        const size_t idx = (size_t)row * D + c, l2 = (size_t)row * NL2 + c;
        const float xw = -(w0[c] + L2[l2]);
        const float sp = xw > 20.f ? xw : log1pf(expf(xw));
        const float w = expf(-expf(-sp - 0.5f));
        const float a = sigmoidf_(a0[c] + L2[l2 + 1024]);
        const float kv = Kb[idx];
        float kk = kv * kkp[c];
        const float ss = wave_sum(kk * kk);
        kk = kk * rsqrtf(fmaxf(ss, 1e-12f));
        if (jl == 1) { const float v = Vb[idx]; Vb[idx] = v + (VF[idx] - v) * sigmoidf_(v0[c] + L2[l2 + 3072]); }
        Kb[idx] = kv * (1.f + (a - 1.f) * kap[c]); Wd[idx] = w; NKK[idx] = -kk; KKA[idx] = kk * a;
    }
}
__device__ __forceinline__ void ph_rwkv_post(const Params& p, int jl, int lane, int wave) {
    const float* YW = (const float*)(p.ws + WS_YW); const float* R = (const float*)(p.ws + WS_R); const float* Kb = (const float*)(p.ws + WS_K);
    const float* Vb = (const float*)(p.ws + (jl == 0 ? WS_VF : WS_VB)); const float* L2 = (const float*)(p.ws + WS_L2); bf16* Z = (bf16*)(p.ws + WS_Z);
    const float* rk = p.in[I_RK] + (size_t)jl * D; const float* lnw = p.in[I_LNW] + (size_t)jl * D; const float* lnb = p.in[I_LNB] + (size_t)jl * D;
    const int gw = blockIdx.x * NWAVES + wave, NGW = gridDim.x * NWAVES;
    for (int it = gw; it < M * WH; it += NGW) {
        const int row = it >> 4, h = it & 15, c = h * WN + lane;
        const size_t idx = (size_t)row * D + c;
        const float yv = YW[idx];
        const float mean = wave_sum(yv) * (1.f / WN);
        const float yc = yv - mean;
        const float rstd = rsqrtf(wave_sum(yc * yc) * (1.f / WN) + 64e-5f);
        const float yn = yc * rstd * lnw[c] + lnb[c];
        const float bon = wave_sum(R[idx] * Kb[idx] * rk[c]) * Vb[idx];
        const float z = (yn + bon) * L2[(size_t)row * NL2 + 2048 + c];
        Z[idx] = (bf16)(cvt_pk_bf16(z, 0.f) & 0xffffu);
    }
}

__device__ __forceinline__ void ph_ret_slow(const Params& p, int jl, LAS unsigned char* lds, int tid) {
    const bf16* QK = (const bf16*)(p.ws + WS_QK); const bf16* V = (const bf16*)(p.ws + WS_V); float* O = (float*)(p.ws + WS_O);
    const int half = tid >> 8, t256 = tid & 255, e = t256 & 63, dq = t256 >> 6;
    LAS float* sq = (LAS float*)lds + half * 256; LAS float* sk = (LAS float*)lds + 512 + half * 256; LAS float* red = (LAS float*)lds + 1024 + half * 256;
    for (int pass = 0; pass < 2; ++pass) {
        const int nitems = pass ? SB * RH * 8 : BATCH * RH * 8;
        for (int it = blockIdx.x * 2 + half; it < nitems; it += gridDim.x * 2) {
            const int es = it & 7, h = (it >> 3) & 3, seq = it >> 5;
            const int r0 = pass ? MP + seq : seq * TP, T = pass ? 1 : TP;
            const float gamma = 1.0f - exp2f(-5.0f - (float)h);
            float S[64];
            if (pass) {
                const float* sp = p.in[I_SRET] + ((((size_t)jl * SB + seq) * RH + h) * RDK + dq * 64) * RDV + es * 64 + e;
#pragma unroll
                for (int dd = 0; dd < 64; ++dd) S[dd] = sp[(size_t)dd * RDV];
            } else {
#pragma unroll
                for (int dd = 0; dd < 64; ++dd) S[dd] = 0.f;
            }
            for (int t = 0; t < T; ++t) {
                const int row = r0 + t;
                sq[t256] = __uint_as_float((unsigned)QK[(size_t)row * 2048 + h * RDK + t256] << 16);
                sk[t256] = __uint_as_float((unsigned)QK[(size_t)row * 2048 + 1024 + h * RDK + t256] << 16);
                const float ve = __uint_as_float((unsigned)V[(size_t)row * 2048 + h * RDV + es * 64 + e] << 16);
                __syncthreads();
                float acc = 0.f;
#pragma unroll
                for (int dd = 0; dd < 64; ++dd) { S[dd] = fmaf(S[dd], gamma, sk[dq * 64 + dd] * ve); acc = fmaf(sq[dq * 64 + dd], S[dd], acc); }
                red[dq * 64 + e] = acc;
                __syncthreads();
                if (dq == 0) O[(size_t)row * RV + h * RDV + es * 64 + e] = (red[e] + red[64 + e]) + (red[128 + e] + red[192 + e]);
            }
            float* so = (pass ? p.out + O_RETS + (size_t)jl * SB * RH * RDK * RDV : p.out + O_RETP + (size_t)jl * BATCH * RH * RDK * RDV) + (((size_t)seq * RH + h) * RDK + dq * 64) * RDV + es * 64 + e;
#pragma unroll
            for (int dd = 0; dd < 64; ++dd) so[(size_t)dd * RDV] = S[dd];
        }
    }
}
__device__ __forceinline__ void ph_wkv_slow(const Params& p, int jl, LAS unsigned char* lds, int lane, int wave) {
    const float* r = (const float*)(p.ws + WS_R); const float* w = (const float*)(p.ws + WS_WDEC); const float* k = (const float*)(p.ws + WS_K);
    const float* v = (const float*)(p.ws + (jl == 0 ? WS_VF : WS_VB)); const float* nkk = (const float*)(p.ws + WS_NKK); const float* kka = (const float*)(p.ws + WS_KKA);
    float* y = (float*)(p.ws + WS_YW);
    LAS float* sv = (LAS float*)lds + wave * 320;
    for (int pass = 0; pass < 2; ++pass) {
        const int nitems = pass ? SB * WH : BATCH * WH;
        for (int it = blockIdx.x * NWAVES + wave; it < nitems; it += gridDim.x * NWAVES) {
            const int h = it & 15, seq = it >> 4;
            const int r0 = pass ? MP + seq : seq * TP, T = pass ? 1 : TP;
            float S[64];
            if (pass) {
                const float* sp = p.in[I_SWKV] + ((((size_t)jl * SB + seq) * WH + h) * WN + lane) * WN;
#pragma unroll
                for (int j = 0; j < 64; j += 4) { const f32x4 t4 = *(const f32x4*)(sp + j); S[j] = t4.x; S[j + 1] = t4.y; S[j + 2] = t4.z; S[j + 3] = t4.w; }
            } else {
#pragma unroll
                for (int j = 0; j < 64; ++j) S[j] = 0.f;
            }
            for (int t = 0; t < T; ++t) {
                const size_t idx = (size_t)(r0 + t) * D + h * WN + lane;
                sv[lane] = nkk[idx]; sv[64 + lane] = w[idx]; sv[128 + lane] = kka[idx]; sv[192 + lane] = k[idx]; sv[256 + lane] = r[idx];
                const float vi = v[idx];
                __syncthreads();
                float sa0 = 0.f, sa1 = 0.f, sa2 = 0.f, sa3 = 0.f;
#pragma unroll
                for (int j = 0; j < 64; j += 4) { sa0 = fmaf(S[j], sv[j], sa0); sa1 = fmaf(S[j + 1], sv[j + 1], sa1); sa2 = fmaf(S[j + 2], sv[j + 2], sa2); sa3 = fmaf(S[j + 3], sv[j + 3], sa3); }
                const float sa = (sa0 + sa1) + (sa2 + sa3);
                float y0 = 0.f, y1 = 0.f, y2 = 0.f, y3 = 0.f;
#pragma unroll
                for (int j = 0; j < 64; j += 4) {
                    S[j] = fmaf(S[j], sv[64 + j], fmaf(sa, sv[128 + j], vi * sv[192 + j])); y0 = fmaf(S[j], sv[256 + j], y0);
                    S[j + 1] = fmaf(S[j + 1], sv[64 + j + 1], fmaf(sa, sv[128 + j + 1], vi * sv[192 + j + 1])); y1 = fmaf(S[j + 1], sv[256 + j + 1], y1);
                    S[j + 2] = fmaf(S[j + 2], sv[64 + j + 2], fmaf(sa, sv[128 + j + 2], vi * sv[192 + j + 2])); y2 = fmaf(S[j + 2], sv[256 + j + 2], y2);
                    S[j + 3] = fmaf(S[j + 3], sv[64 + j + 3], fmaf(sa, sv[128 + j + 3], vi * sv[192 + j + 3])); y3 = fmaf(S[j + 3], sv[256 + j + 3], y3);
                }
                y[idx] = (y0 + y1) + (y2 + y3);
                __syncthreads();
            }
            float* so = (pass ? p.out + O_WKVS + (size_t)jl * SB * WH * WN * WN : p.out + O_WKVP + (size_t)jl * BATCH * WH * WN * WN) + (((size_t)seq * WH + h) * WN + lane) * WN;
#pragma unroll
            for (int j = 0; j < 64; j += 4) { f32x4 t4; t4.x = S[j]; t4.y = S[j + 1]; t4.z = S[j + 2]; t4.w = S[j + 3]; *(f32x4*)(so + j) = t4; }
        }
    }
}

enum { OP_P0 = 0, OP_NORM_RET, OP_G_RETIN, OP_RET, OP_RETNORM, OP_G_RETOUT, OP_NORM_RW, OP_G_RWPROJ, OP_G_LORA2, OP_PREP, OP_WKV, OP_POST, OP_G_WO,
       OP_NORM_FFN, OP_G_UG, OP_CONV, OP_G_WD, OP_FINAL };
struct Ph { unsigned char op, layer; };
constexpr int NPH = 1 + 2 * (5 + 4) + 2 * (7 + 4) + 1;
__device__ __host__ inline Ph phase_at(int i) {
    if (i == 0) return Ph{OP_P0, 0};
    i -= 1;
    int l;
    if (i < 9) l = 0; else if (i < 20) { l = 1; i -= 9; } else if (i < 29) { l = 2; i -= 20; } else if (i < 40) { l = 3; i -= 29; } else return Ph{OP_FINAL, 0};
    int op = OP_FINAL;
    if ((l & 1) == 0) {
        switch (i) { case 0: op = OP_NORM_RET; break; case 1: op = OP_G_RETIN; break; case 2: op = OP_RET; break; case 3: op = OP_RETNORM; break; case 4: op = OP_G_RETOUT; break;
                     case 5: op = OP_NORM_FFN; break; case 6: op = OP_G_UG; break; case 7: op = OP_CONV; break; default: op = OP_G_WD; break; }
    } else {
        switch (i) { case 0: op = OP_NORM_RW; break; case 1: op = OP_G_RWPROJ; break; case 2: op = OP_G_LORA2; break; case 3: op = OP_PREP; break; case 4: op = OP_WKV; break; case 5: op = OP_POST; break; case 6: op = OP_G_WO; break;
                     case 7: op = OP_NORM_FFN; break; case 8: op = OP_G_UG; break; case 9: op = OP_CONV; break; default: op = OP_G_WD; break; }
    }
    return Ph{(unsigned char)op, (unsigned char)l};
}

__global__ void __launch_bounds__(NTHR, 2) mega(Params p, int lo, int hi) {
    extern __shared__ __attribute__((aligned(16))) unsigned char lds_raw[];
    LAS unsigned char* lds = (LAS unsigned char*)lds_raw;
    for (int ph = lo; ph < hi; ++ph) {
        int tid = threadIdx.x; asm volatile("" : "+v"(tid));
        const int lane = tid & 63, wave = __builtin_amdgcn_readfirstlane(tid >> 6);
        unsigned char* ws = p.ws;
        const Ph P = phase_at(ph);
        const int li = P.layer, jl = li >> 1;
        const bf16* gA = nullptr; const bf16* gB = nullptr; int gN = 0, gK = 0; EpiAny E{}; E.jl = jl; E.ws = ws; bool is_gemm = false;
        switch (P.op) {
        case OP_P0: ph_p0(p, lds, tid, lane, wave); break;
        case OP_NORM_RET: ph_norm(p, p.in[I_NMIX] + (size_t)li * D, 0, jl, lane, wave); break;
        case OP_NORM_FFN: ph_norm(p, p.in[I_NFFN] + (size_t)li * D, 0, jl, lane, wave); break;
        case OP_NORM_RW: ph_norm(p, p.in[I_NMIX] + (size_t)li * D, 1, jl, lane, wave); break;
        case OP_FINAL: ph_norm(p, p.in[I_NFIN], 2, 0, lane, wave); break;
        case OP_RETNORM: ph_ret_norm(p, jl, lane, wave); break;
        case OP_PREP: ph_rwkv_prep(p, jl, lane, wave); break;
        case OP_POST: ph_rwkv_post(p, jl, lane, wave); break;
        case OP_CONV: ph_conv(p, li, tid); break;
        case OP_RET: ph_ret_slow(p, jl, lds, tid); break;
        case OP_WKV: ph_wkv_slow(p, jl, lds, lane, wave); break;
        case OP_G_RETIN: is_gemm = true; E.kind = EK_RETIN; E.perm = true;
            gA = (const bf16*)(ws + WS_H); gB = (const bf16*)(ws + WS_WIN + jl * SZ_WIN); gN = RWIN; gK = D; break;
        case OP_G_RETOUT: is_gemm = true; E.kind = EK_RESID; E.perm = false;
            gA = (const bf16*)(ws + WS_Y); gB = (const bf16*)(ws + WS_WOUT + jl * SZ_WOUT); gN = D; gK = RV; break;
        case OP_G_RWPROJ: is_gemm = true; E.kind = EK_RWPROJ; E.perm = false;
            gA = (const bf16*)(ws + WS_H); gB = (const bf16*)(ws + WS_WRW + jl * SZ_WRW); gN = NRW; gK = KRW; break;
        case OP_G_LORA2: is_gemm = true; E.kind = EK_F32; E.perm = false;
            gA = (const bf16*)(ws + WS_A2); gB = (const bf16*)(ws + WS_WL2 + jl * SZ_WL2); gN = (jl == 0 ? 3072 : 4096); gK = KL2; break;
        case OP_G_WO: is_gemm = true; E.kind = EK_RESID; E.perm = false;
            gA = (const bf16*)(ws + WS_Z); gB = (const bf16*)(ws + WS_WO + jl * SZ_WO); gN = D; gK = D; break;
        case OP_G_UG: is_gemm = true; E.kind = EK_UG; E.perm = true;
            gA = (const bf16*)(ws + WS_H); gB = (const bf16*)(ws + WS_WUG + li * SZ_WUG); gN = 2 * DFF; gK = D; break;
        case OP_G_WD: is_gemm = true; E.kind = EK_RESID; E.perm = false;
            gA = (const bf16*)(ws + WS_ACT); gB = (const bf16*)(ws + WS_WD + li * SZ_WD); gN = D; gK = DFF; break;
        default: break;
        }
        if (is_gemm) {
            pg8::Gemm g{gA, gB, M, gN, gK}; pg8::StaticOrder S; S.init(M, gN, (int)gridDim.x, (int)blockIdx.x);
            pg8::gemm_phase<EpiAny, pg8::StaticOrder, true, true>(lds, g, S, E);
        }
        if (ph + 1 < hi) cg::this_grid().sync();
    }
}

}

extern "C" void kernel_launch(void* const* d_in, const int* in_sizes, int n_in, void* d_out, int out_size, void* d_ws, size_t ws_size, hipStream_t stream) {
    static int grid = 0;
    if (grid == 0) {
        int dev = 0, cus = 0;
        if (n_in != N_IN || ws_size < WS_END) { fprintf(stderr, "kernel_launch: unexpected n_in %d / ws_size %zu (need %zu)\n", n_in, ws_size, (size_t)WS_END); grid = -1; return; }
        if (hipGetDevice(&dev) != hipSuccess || hipDeviceGetAttribute(&cus, hipDeviceAttributeMultiprocessorCount, dev) != hipSuccess) { grid = -1; return; }
        if (hipFuncSetAttribute((const void*)mega, hipFuncAttributeMaxDynamicSharedMemorySize, LDS_BYTES) != hipSuccess) { fprintf(stderr, "kernel_launch: hipFuncSetAttribute failed\n"); grid = -1; return; }
        int per_cu = 0;
        if (hipOccupancyMaxActiveBlocksPerMultiprocessor(&per_cu, (const void*)mega, NTHR, LDS_BYTES) != hipSuccess || per_cu < 1) { fprintf(stderr, "kernel_launch: occupancy query says %d\n", per_cu); (void)hipGetLastError(); }
        grid = cus * (per_cu >= 1 ? 1 : 1);
    }
    if (grid < 0) return;
    Params p{};
    for (int i = 0; i < N_IN; ++i) p.in[i] = (const float*)d_in[i];
    p.out = (float*)d_out; p.ws = (unsigned char*)d_ws;
    int lo = 0, hi = NPH;
    void* args[] = {(void*)&p, (void*)&lo, (void*)&hi};
    const hipError_t e = hipLaunchCooperativeKernel((const void*)mega, dim3(grid), dim3(NTHR), args, LDS_BYTES, stream);
    if (e != hipSuccess) fprintf(stderr, "kernel_launch: cooperative launch failed: %s (grid %d)\n", hipGetErrorString(e), grid);
    (void)in_sizes; (void)out_size;
}
```

```cpp
#include <hip/hip_runtime.h>
#include <hip/hip_cooperative_groups.h>
#include <cstdio>
#include <stdint.h>
namespace cg = cooperative_groups;
namespace pg8 {
#define PG8_LAS __attribute__((address_space(3)))
typedef unsigned short bf16_t;
typedef short bf16x8 __attribute__((ext_vector_type(8)));
typedef float f32x4 __attribute__((ext_vector_type(4)));
typedef unsigned u32x4 __attribute__((ext_vector_type(4)));
constexpr int BM = 256, BK = 64, HALF = 128, HTB = HALF * BK * 2  , STAGE_BYTES = 8 * HTB, NXCD = 8, WGM = 8;

__host__ __device__ __forceinline__ int lds_byte(int r, int c) { const int st = (r >> 4) * 2 + (c >> 5), rr = r & 15, cc = c & 31, ob = rr * 64 + cc * 2; return st * 1024 + (ob ^ (((ob >> 9) & 1) << 5)); }
__host__ __device__ __forceinline__ void stage_rc(int b, int& R, int& C) { const int st = b / 1024, sb = b % 1024, swz = sb ^ (((sb >> 9) & 1) << 5); R = (st >> 1) * 16 + swz / 64; C = (st & 1) * 32 + (swz % 64) / 2; }
__host__ __device__ __forceinline__ int perm32(int rho) { const int n = rho >> 4, i = rho & 15; return 8 * (i >> 2) + 4 * n + (i & 3); }

struct Unit { int pm, pn; };
struct Gemm { const bf16_t* A; const bf16_t* Bt; int M, N, K; };

struct StaticOrder {
    int nM, nN, nwg, G, c;
    __host__ __device__ void init(int M, int N, int G_, int c_) { nM = M / BM; nN = N / BM; nwg = nM * nN; G = G_; c = c_; }
    __host__ __device__ bool next(int i, Unit& u) const {
        const long L = (long)i * G + c; if (L >= nwg) return false;
        int wgid = (int)L; { const int q = nwg / NXCD, r = nwg % NXCD, xcd = wgid % NXCD, off = wgid / NXCD; wgid = (xcd < r ? xcd * (q + 1) : r * (q + 1) + (xcd - r) * q) + off; }
        const int nig = WGM * nN, gid = wgid / nig, fm = gid * WGM, gsz = (nM - fm) < WGM ? (nM - fm) : WGM;
        u.pm = fm + ((wgid % nig) % gsz); u.pn = (wgid % nig) / gsz; return true;
    }
    __device__ __forceinline__ void a_ready(const Unit&) const {}
    __device__ __forceinline__ void done(const Unit&) const {}
};
template <class Epi, class Sched, bool ALIGN_EPI = false, bool SP2 = false>
__device__ __forceinline__ void gemm_phase(PG8_LAS unsigned char* lds, const Gemm g, const Sched& S, const Epi& E) {
    int tid = threadIdx.x; asm volatile("" : "+v"(tid));
    const int wid = __builtin_amdgcn_readfirstlane(tid >> 6), lane = tid & 63, wr = wid >> 2, wc = wid & 3, fr = lane & 15, fq = lane >> 4;
    const int K = g.K, nt = K / BK;
    unsigned voffA[2], voffB[2];
#pragma unroll
    for (int i = 0; i < 2; ++i) { int R, C; stage_rc(tid * 16 + i * 8192, R, C); const int Rb = E.perm ? ((R & ~31) + perm32(R & 31)) : R;
        voffA[i] = (unsigned)(R * K + C) * 2u; voffB[i] = (unsigned)(Rb * K + C) * 2u; }
    const size_t kstep = (size_t)(BK * 2);
    const size_t hstep = (size_t)HALF * K * 2;
    const size_t tstep = 2 * hstep;
    const unsigned ldsw = (unsigned)wid * 1024u;
    const int aoff = lds_byte(wr * 64 + fr, fq * 8), boff = lds_byte(wc * 32 + fr, fq * 8);
#define PG8_SA(b, h) (((b) * 2 + (h)) * HTB)
#define PG8_SB(b, h) ((4 + (b) * 2 + (h)) * HTB)
#define PG8_STAGE(bufoff, gbase, voff) do { _Pragma("unroll") for (int _i = 0; _i < 2; ++_i) \
        __builtin_amdgcn_global_load_lds((const unsigned*)((const char*)(gbase) + (voff)[_i]), (PG8_LAS unsigned*)(lds + (bufoff) + ldsw + _i * 8192), 16, 0, 0); } while (0)
#define PG8_LDA(dst, b, h) do { _Pragma("unroll") for (int m = 0; m < 4; ++m) _Pragma("unroll") for (int k = 0; k < 2; ++k) dst[m][k] = *(const PG8_LAS bf16x8*)(lds + PG8_SA(b, h) + aoff + m * 2048 + k * 1024); } while (0)
#define PG8_LDB(dst, b, h) do { _Pragma("unroll") for (int n = 0; n < 2; ++n) _Pragma("unroll") for (int k = 0; k < 2; ++k) dst[n][k] = *(const PG8_LAS bf16x8*)(lds + PG8_SB(b, h) + boff + n * 2048 + k * 1024); } while (0)
#define PG8_MMA(ai, bj, At, Bt) do { __builtin_amdgcn_s_setprio(1); _Pragma("unroll") for (int m = 0; m < 4; ++m) _Pragma("unroll") for (int n = 0; n < 2; ++n) _Pragma("unroll") for (int k = 0; k < 2; ++k) \
        acc[ai][bj][m][n] = __builtin_amdgcn_mfma_f32_16x16x32_bf16(Bt[n][k], At[m][k], acc[ai][bj][m][n], 0, 0, 0); __builtin_amdgcn_s_setprio(0); } while (0)
#define PG8_WAIT_V(n) asm volatile("s_waitcnt vmcnt(" #n ")" ::: "memory")
#define PG8_WAIT_L(n) asm volatile("s_waitcnt lgkmcnt(" #n ")" ::: "memory")
#define PG8_BAR __builtin_amdgcn_s_barrier()
#define PG8_SCHED __builtin_amdgcn_sched_barrier(0)
    Unit cur, nxt; int ui = 0;
    if (!S.next(0, cur)) return;
    f32x4 acc[2][2][4][2];
#pragma unroll
    for (int a = 0; a < 2; ++a)
#pragma unroll
        for (int b = 0; b < 2; ++b)
#pragma unroll
            for (int m = 0; m < 4; ++m)
#pragma unroll
                for (int n = 0; n < 2; ++n) acc[a][b][m][n] = (f32x4){0.f, 0.f, 0.f, 0.f};
    bf16x8 At[4][2], B0[2][2], B1[2][2];
    const char* cA = (const char*)g.A + (size_t)cur.pm * tstep; const char* cB = (const char*)g.Bt + (size_t)cur.pn * tstep;
    S.a_ready(cur);
    if constexpr (SP2) {
        PG8_STAGE(PG8_SB(0, 0), cB, voffB); PG8_STAGE(PG8_SB(0, 1), cB + hstep, voffB); PG8_STAGE(PG8_SA(0, 0), cA, voffA); PG8_STAGE(PG8_SA(0, 1), cA + hstep, voffA);
        if (wr == 1) PG8_BAR;
        PG8_WAIT_V(2); PG8_BAR;
        PG8_STAGE(PG8_SB(1, 0), cB + kstep, voffB); PG8_STAGE(PG8_SA(1, 0), cA + kstep, voffA); PG8_STAGE(PG8_SB(1, 1), cB + hstep + kstep, voffB);
        PG8_WAIT_V(6); PG8_BAR;
    } else {
        PG8_STAGE(PG8_SB(0, 0), cB, voffB); PG8_STAGE(PG8_SA(0, 0), cA, voffA); PG8_STAGE(PG8_SB(0, 1), cB + hstep, voffB); PG8_STAGE(PG8_SA(0, 1), cA + hstep, voffA);
        if (wr == 1) PG8_BAR;
        PG8_WAIT_V(4); PG8_BAR;
        PG8_STAGE(PG8_SB(1, 0), cB + kstep, voffB); PG8_STAGE(PG8_SA(1, 0), cA + kstep, voffA); PG8_STAGE(PG8_SB(1, 1), cB + hstep + kstep, voffB);
        PG8_WAIT_V(6); PG8_BAR;
    }
    for (;;) {
        const bool has_next = S.next(ui + 1, nxt);
        const char* nA = has_next ? (const char*)g.A + (size_t)nxt.pm * tstep : cA; const char* nB = has_next ? (const char*)g.Bt + (size_t)nxt.pn * tstep : cB;
        for (int t = 0; t < nt; t += 2) {
            const bool last = (t == nt - 2);
            const char* a1 = cA + (size_t)(t + 1) * kstep;
            const char* a2 = last ? nA : cA + (size_t)(t + 2) * kstep; const char* b2 = last ? nB : cB + (size_t)(t + 2) * kstep;
            const char* a3 = a2 + kstep; const char* b3 = b2 + kstep;
            if (last && has_next) S.a_ready(nxt);
            if constexpr (SP2) {
            PG8_LDB(B0, 0, 0); PG8_LDB(B1, 0, 1); PG8_SCHED; PG8_LDA(At, 0, 0); PG8_STAGE(PG8_SA(1, 1), a1 + hstep, voffA);
            PG8_WAIT_V(8); PG8_WAIT_L(0); PG8_BAR; PG8_MMA(0, 0, At, B0); PG8_MMA(0, 1, At, B1); PG8_BAR; PG8_SCHED;
            PG8_LDA(At, 0, 1); PG8_STAGE(PG8_SB(0, 0), b2, voffB); PG8_STAGE(PG8_SB(0, 1), b2 + hstep, voffB); PG8_STAGE(PG8_SA(0, 0), a2, voffA);
            PG8_WAIT_V(8); PG8_WAIT_L(0); PG8_BAR; PG8_MMA(1, 0, At, B0); PG8_MMA(1, 1, At, B1); PG8_BAR; PG8_SCHED;
            PG8_LDB(B0, 1, 0); PG8_LDB(B1, 1, 1); PG8_SCHED; PG8_LDA(At, 1, 0); PG8_STAGE(PG8_SA(0, 1), a2 + hstep, voffA);
            PG8_WAIT_V(8); PG8_WAIT_L(0); PG8_BAR; PG8_MMA(0, 0, At, B0); PG8_MMA(0, 1, At, B1); PG8_BAR; PG8_SCHED;
            PG8_LDA(At, 1, 1); PG8_STAGE(PG8_SB(1, 0), b3, voffB); PG8_STAGE(PG8_SB(1, 1), b3 + hstep, voffB); PG8_STAGE(PG8_SA(1, 0), a3, voffA);
            PG8_WAIT_V(8); PG8_WAIT_L(0); PG8_BAR; PG8_MMA(1, 0, At, B0); PG8_MMA(1, 1, At, B1); PG8_BAR; PG8_SCHED;
            } else {
            PG8_LDB(B0, 0, 0); PG8_SCHED; PG8_LDA(At, 0, 0); PG8_STAGE(PG8_SA(1, 1), a1 + hstep, voffA);
            PG8_WAIT_L(8); PG8_BAR; PG8_WAIT_L(0); PG8_MMA(0, 0, At, B0); PG8_BAR; PG8_SCHED;
            PG8_LDB(B1, 0, 1); PG8_STAGE(PG8_SB(0, 0), b2, voffB);
            PG8_BAR; PG8_WAIT_L(0); PG8_MMA(0, 1, At, B1); PG8_BAR;
            PG8_LDA(At, 0, 1); PG8_STAGE(PG8_SA(0, 0), a2, voffA);
            PG8_BAR; PG8_WAIT_L(0); PG8_MMA(1, 0, At, B0); PG8_BAR; PG8_SCHED;
            PG8_STAGE(PG8_SB(0, 1), b2 + hstep, voffB);
            PG8_WAIT_V(6); PG8_BAR; PG8_MMA(1, 1, At, B1); PG8_BAR;
            PG8_LDB(B0, 1, 0); PG8_SCHED; PG8_LDA(At, 1, 0); PG8_STAGE(PG8_SA(0, 1), a2 + hstep, voffA);
            PG8_WAIT_L(8); PG8_BAR; PG8_WAIT_L(0); PG8_MMA(0, 0, At, B0); PG8_BAR; PG8_SCHED;
            PG8_LDB(B1, 1, 1); PG8_STAGE(PG8_SB(1, 0), b3, voffB);
            PG8_BAR; PG8_WAIT_L(0); PG8_MMA(0, 1, At, B1); PG8_BAR;
            PG8_LDA(At, 1, 1); PG8_STAGE(PG8_SA(1, 0), a3, voffA);
            PG8_BAR; PG8_WAIT_L(0); PG8_MMA(1, 0, At, B0); PG8_BAR; PG8_SCHED;
            PG8_STAGE(PG8_SB(1, 1), b3 + hstep, voffB);
            PG8_WAIT_V(6); PG8_BAR; PG8_MMA(1, 1, At, B1); PG8_BAR;
            }
        }
        if constexpr (ALIGN_EPI) { if (wr == 0) PG8_BAR; }
        if constexpr (!Epi::AFTER_DRAIN) { E(acc, cur, wr, wc, fr, fq); S.done(cur); }
        if (!has_next) break;
#pragma unroll
        for (int a = 0; a < 2; ++a)
#pragma unroll
            for (int b = 0; b < 2; ++b)
#pragma unroll
                for (int m = 0; m < 4; ++m)
#pragma unroll
                    for (int n = 0; n < 2; ++n) acc[a][b][m][n] = (f32x4){0.f, 0.f, 0.f, 0.f};
        cur = nxt; cA = nA; cB = nB; ++ui;
        if constexpr (ALIGN_EPI) { if (wr == 1) PG8_BAR; }
    }
    PG8_WAIT_V(0);
    if constexpr (!ALIGN_EPI) { if (wr == 0) PG8_BAR; }
    PG8_BAR;
    if constexpr (Epi::AFTER_DRAIN) { E.fused(acc, cur, wr, wc, fr, fq, lds, wid, lane); S.done(cur); }
#undef PG8_SA
#undef PG8_SB
#undef PG8_STAGE
#undef PG8_LDA
#undef PG8_LDB
#undef PG8_MMA
#undef PG8_WAIT_V
#undef PG8_WAIT_L
#undef PG8_BAR
#undef PG8_SCHED
}
}

namespace {
constexpr int D = 1024, BATCH = 8, SEQ = 2048, NMETA = 16, TP = SEQ + NMETA, MP = BATCH * TP, SB = 128, M = MP + SB;
constexpr int DEPTH = 4, RH = 4, RDK = 256, RDV = 512, RV = 2048, RWIN = 6144;
constexpr int WH = 16, WN = 64, LW = 64, LA = 64, LV = 32, LG = 160, DFF = 2816;
constexpr int NRW = 3584, KRW = 2048, KL2 = 384, NL2 = 4096;
constexpr float PAST_POS = 16384.f;
constexpr int NWAVES = 8, NTHR = 512;
constexpr int LDS_BYTES = 147456;

constexpr size_t O_YP = 0;
constexpr size_t O_YS = O_YP + (size_t)BATCH * SEQ * D;
constexpr size_t O_RETP = O_YS + (size_t)SB * D;
constexpr size_t O_WKVP = O_RETP + (size_t)2 * BATCH * RH * RDK * RDV;
constexpr size_t O_SHP = O_WKVP + (size_t)2 * BATCH * WH * WN * WN;
constexpr size_t O_CVP = O_SHP + (size_t)2 * BATCH * D;
constexpr size_t O_RETS = O_CVP + (size_t)DEPTH * BATCH * 2 * DFF;
constexpr size_t O_WKVS = O_RETS + (size_t)2 * SB * RH * RDK * RDV;
constexpr size_t O_SHS = O_WKVS + (size_t)2 * SB * WH * WN * WN;
constexpr size_t O_CVS = O_SHS + (size_t)2 * SB * D;

enum { I_XP = 0, I_XS, I_SRET, I_SWKV, I_SSHIFT, I_SCONV, I_META, I_NMIX, I_NFFN, I_NFIN, I_RWIN, I_RGN, I_RWOUT, I_MU, I_WRKV, I_W0, I_W1, I_W2,
       I_A0, I_A1, I_A2, I_V0, I_V1, I_V2, I_G1, I_G2, I_KK, I_KA, I_RK, I_LNW, I_LNB, I_WO, I_WUG, I_CW, I_CB, I_WD, N_IN };

constexpr size_t al256(size_t x) { return (x + 255) & ~(size_t)255; }
constexpr size_t WS_CTL = 0;
constexpr size_t WS_CS = 1u << 20;
constexpr size_t WS_WIN = 4u << 20;
constexpr size_t SZ_WIN = (size_t)RWIN * D * 2;
constexpr size_t WS_WOUT = WS_WIN + 2 * SZ_WIN;
constexpr size_t SZ_WOUT = (size_t)D * RV * 2;
constexpr size_t WS_WRW = WS_WOUT + 2 * SZ_WOUT;
constexpr size_t SZ_WRW = (size_t)NRW * KRW * 2;
constexpr size_t WS_WL2 = WS_WRW + 2 * SZ_WRW;
constexpr size_t SZ_WL2 = (size_t)NL2 * KL2 * 2;
constexpr size_t WS_WO = WS_WL2 + 2 * SZ_WL2;
constexpr size_t SZ_WO = (size_t)D * D * 2;
constexpr size_t WS_WUG = WS_WO + 2 * SZ_WO;
constexpr size_t SZ_WUG = (size_t)2 * DFF * D * 2;
constexpr size_t WS_WD = WS_WUG + 4 * SZ_WUG;
constexpr size_t SZ_WD = (size_t)D * DFF * 2;
constexpr size_t WS_X = al256(WS_WD + 4 * SZ_WD);
constexpr size_t SZ_MD4 = (size_t)M * D * 4;
constexpr size_t WS_H = WS_X + SZ_MD4;
constexpr size_t WS_VF = WS_H + SZ_MD4;
constexpr size_t WS_REG = WS_VF + SZ_MD4;
constexpr size_t WS_QK = WS_REG;
constexpr size_t WS_V = WS_QK + SZ_MD4;
constexpr size_t WS_SG = WS_V + SZ_MD4;
constexpr size_t WS_O = WS_SG + SZ_MD4;
constexpr size_t WS_Y = WS_O + 2 * SZ_MD4;
constexpr size_t WS_R = WS_REG;
constexpr size_t WS_K = WS_R + SZ_MD4;
constexpr size_t WS_VB = WS_K + SZ_MD4;
constexpr size_t WS_WDEC = WS_VB + SZ_MD4;
constexpr size_t WS_NKK = WS_WDEC + SZ_MD4;
constexpr size_t WS_KKA = WS_NKK + SZ_MD4;
constexpr size_t WS_YW = WS_KKA + SZ_MD4;
constexpr size_t WS_L2 = WS_YW + SZ_MD4;
constexpr size_t WS_A2 = WS_L2 + 4 * SZ_MD4;
constexpr size_t WS_Z = al256(WS_A2 + (size_t)M * KL2 * 2);
constexpr size_t WS_RW_END = WS_Z + (size_t)M * D * 2;
constexpr size_t SZ_FF2 = (size_t)M * DFF * 2;
constexpr size_t WS_U = WS_REG;
constexpr size_t WS_G = al256(WS_U + SZ_FF2);
constexpr size_t WS_ACT = al256(WS_G + SZ_FF2);
constexpr size_t WS_END = WS_RW_END;

#define LAS __attribute__((address_space(3)))
typedef unsigned short bf16;
typedef unsigned v4u __attribute__((ext_vector_type(4)));
typedef unsigned v2u __attribute__((ext_vector_type(2)));
using pg8::f32x4;
using pg8::Unit;

struct Params { const float* in[N_IN]; float* out; unsigned char* ws; };

__device__ __forceinline__ unsigned cvt_pk_bf16(float lo, float hi) { unsigned r; asm("v_cvt_pk_bf16_f32 %0, %1, %2" : "=v"(r) : "v"(lo), "v"(hi)); return r; }
__device__ __forceinline__ float bf_lo(unsigned w) { return __uint_as_float(w << 16); }
__device__ __forceinline__ float bf_hi(unsigned w) { return __uint_as_float(w & 0xffff0000u); }
__device__ __forceinline__ void unpack8(const v4u w, float (&f)[8]) { f[0] = bf_lo(w.x); f[1] = bf_hi(w.x); f[2] = bf_lo(w.y); f[3] = bf_hi(w.y); f[4] = bf_lo(w.z); f[5] = bf_hi(w.z); f[6] = bf_lo(w.w); f[7] = bf_hi(w.w); }
__device__ __forceinline__ v4u pack8(const float (&f)[8]) { v4u w; w.x = cvt_pk_bf16(f[0], f[1]); w.y = cvt_pk_bf16(f[2], f[3]); w.z = cvt_pk_bf16(f[4], f[5]); w.w = cvt_pk_bf16(f[6], f[7]); return w; }
__device__ __forceinline__ float wave_sum(float v) {
#pragma unroll
    for (int o = 1; o < 64; o <<= 1) v += __shfl_xor(v, o);
    return v;
}
__device__ __forceinline__ float sigmoidf_(float x) { return 1.f / (1.f + __expf(-x)); }
__device__ __forceinline__ float siluf_(float x) { return x / (1.f + __expf(-x)); }
__device__ __forceinline__ float tanhf_(float x) { return 1.f - 2.f / (1.f + __expf(2.f * x)); }

enum { EK_RETIN = 0, EK_RESID, EK_UG, EK_RWPROJ, EK_F32 };
struct EpiAny {
    static constexpr bool AFTER_DRAIN = false;
    int kind; bool perm; int jl; unsigned char* ws;
    __device__ __forceinline__ void operator()(const f32x4 (&acc)[2][2][4][2], const Unit& u, int wr, int wc, int fr, int fq) const {
        const int row0 = u.pm * 256 + wr * 64 + fr;
        if (kind == EK_RETIN) {
            bf16* QK = (bf16*)(ws + WS_QK); bf16* V = (bf16*)(ws + WS_V); bf16* SG = (bf16*)(ws + WS_SG); const float* CS = (const float*)(ws + WS_CS);
            const int cw = wc * 32 + 8 * fq;
            if (u.pn < 8) {
                const bool isk = u.pn >= 4; const int h = u.pn & 3; const float sc = isk ? 0.0625f : 1.f;
                bf16* base = QK + (isk ? 1024 : 0) + h * 256 + cw;
#pragma unroll
                for (int ai = 0; ai < 2; ++ai)
#pragma unroll
                    for (int m = 0; m < 4; ++m) {
                        const int row = row0 + ai * 128 + m * 16;
                        const int pi = row < MP ? row % TP : TP;
                        const f32x4* cs = (const f32x4*)(CS + ((size_t)pi * 128 + cw) * 2);
                        const f32x4 t0 = cs[0], t1 = cs[1], t2 = cs[2], t3 = cs[3];
                        const float c[8] = {t0.x, t0.z, t1.x, t1.z, t2.x, t2.z, t3.x, t3.z}, s[8] = {t0.y, t0.w, t1.y, t1.w, t2.y, t2.w, t3.y, t3.w};
                        float o1[8], o2[8];
#pragma unroll
                        for (int n = 0; n < 2; ++n)
#pragma unroll
                            for (int j = 0; j < 4; ++j) {
                                const float x1 = acc[ai][0][m][n][j], x2 = acc[ai][1][m][n][j];
                                o1[n * 4 + j] = (x1 * c[n * 4 + j] - x2 * s[n * 4 + j]) * sc;
                                o2[n * 4 + j] = (x1 * s[n * 4 + j] + x2 * c[n * 4 + j]) * sc;
                            }
                        bf16* rp = base + (size_t)row * 2048;
                        *(v4u*)rp = pack8(o1); *(v4u*)(rp + 128) = pack8(o2);
                        asm volatile("" ::: "memory");
                    }
            } else {
                const bool isg = u.pn >= 16;
                bf16* base = (isg ? SG : V) + ((u.pn - (isg ? 16 : 8)) * 256) + cw;
#pragma unroll
                for (int ai = 0; ai < 2; ++ai)
#pragma unroll
                    for (int m = 0; m < 4; ++m) {
                        bf16* rp = base + (size_t)(row0 + ai * 128 + m * 16) * 2048;
#pragma unroll
                        for (int bj = 0; bj < 2; ++bj) {
                            float o[8];
#pragma unroll
                            for (int n = 0; n < 2; ++n)
#pragma unroll
                                for (int j = 0; j < 4; ++j) { const float x = acc[ai][bj][m][n][j]; o[n * 4 + j] = isg ? siluf_(x) : x; }
                            *(v4u*)(rp + bj * 128) = pack8(o);
                        }
                    }
            }
        } else if (kind == EK_RESID) {
            float* X = (float*)(ws + WS_X);
            const int col0 = u.pn * 256 + wc * 32 + 4 * fq;
#pragma unroll
            for (int ai = 0; ai < 2; ++ai)
#pragma unroll
                for (int m = 0; m < 4; ++m) {
                    float* rp = X + (size_t)(row0 + ai * 128 + m * 16) * D + col0;
#pragma unroll
                    for (int bj = 0; bj < 2; ++bj)
#pragma unroll
                        for (int n = 0; n < 2; ++n) { f32x4* q = (f32x4*)(rp + bj * 128 + n * 16); *q = *q + acc[ai][bj][m][n]; }
                    asm volatile("" ::: "memory");
                }
        } else if (kind == EK_UG) {
            bf16* U = (bf16*)(ws + WS_U); bf16* G = (bf16*)(ws + WS_G);
            const int f0 = u.pn * 128 + wc * 32 + 8 * fq;
#pragma unroll
            for (int ai = 0; ai < 2; ++ai)
#pragma unroll
                for (int m = 0; m < 4; ++m) {
                    const size_t ro = (size_t)(row0 + ai * 128 + m * 16) * DFF + f0;
#pragma unroll
                    for (int bj = 0; bj < 2; ++bj) {
                        float o[8];
#pragma unroll
                        for (int n = 0; n < 2; ++n)
#pragma unroll
                            for (int j = 0; j < 4; ++j) o[n * 4 + j] = acc[ai][bj][m][n][j];
                        *(v4u*)((bj ? G : U) + ro) = pack8(o);
                    }
                }
        } else if (kind == EK_RWPROJ) {
            const int cl = wc * 32 + 4 * fq;
            if (u.pn < 12) {
                float* dst = (float*)(ws + (u.pn < 4 ? WS_R : (u.pn < 8 ? WS_K : (jl == 0 ? WS_VF : WS_VB)))) + (u.pn & 3) * 256 + cl;
#pragma unroll
                for (int ai = 0; ai < 2; ++ai)
#pragma unroll
                    for (int m = 0; m < 4; ++m) {
                        float* rp = dst + (size_t)(row0 + ai * 128 + m * 16) * D;
#pragma unroll
                        for (int bj = 0; bj < 2; ++bj)
#pragma unroll
                            for (int n = 0; n < 2; ++n) *(f32x4*)(rp + bj * 128 + n * 16) = acc[ai][bj][m][n];
                    }
            } else {
                bf16* A2 = (bf16*)(ws + WS_A2);
#pragma unroll
                for (int bj = 0; bj < 2; ++bj)
#pragma unroll
                    for (int n = 0; n < 2; ++n) {
                        const int c = (u.pn - 12) * 256 + bj * 128 + cl + 16 * n;
                        if (c < KL2) {
                            const int kd = c < 64 ? 1 : ((c >= 128 && c < 288) ? 2 : 0);
#pragma unroll
                            for (int ai = 0; ai < 2; ++ai)
#pragma unroll
                                for (int m = 0; m < 4; ++m) {
                                    f32x4 v = acc[ai][bj][m][n];
                                    if (kd == 1) { v.x = tanhf_(v.x); v.y = tanhf_(v.y); v.z = tanhf_(v.z); v.w = tanhf_(v.w); }
                                    else if (kd == 2) { v.x = sigmoidf_(v.x); v.y = sigmoidf_(v.y); v.z = sigmoidf_(v.z); v.w = sigmoidf_(v.w); }
                                    v2u w; w.x = cvt_pk_bf16(v.x, v.y); w.y = cvt_pk_bf16(v.z, v.w);
                                    *(v2u*)(A2 + (size_t)(row0 + ai * 128 + m * 16) * KL2 + c) = w;
                                }
                        }
                    }
            }
        } else {
            float* C = (float*)(ws + WS_L2); constexpr int ldc = NL2;
            const int col0 = u.pn * 256 + wc * 32 + 4 * fq;
#pragma unroll
            for (int ai = 0; ai < 2; ++ai)
#pragma unroll
                for (int m = 0; m < 4; ++m) {
                    float* rp = C + (size_t)(row0 + ai * 128 + m * 16) * ldc + col0;
#pragma unroll
                    for (int bj = 0; bj < 2; ++bj)
#pragma unroll
                        for (int n = 0; n < 2; ++n) *(f32x4*)(rp + bj * 128 + n * 16) = acc[ai][bj][m][n];
                }
        }
    }
};

__device__ __forceinline__ void tr_item(const float* __restrict__ W, int ldw, int k0, int n0, bf16* __restrict__ WT, int ldt, int drow, const float* __restrict__ mu, LAS float* scr, int lane) {
#pragma unroll 8
    for (int i = 0; i < 32; ++i) { const int kk = 2 * i + (lane >> 5); scr[kk * 33 + (lane & 31)] = W[(size_t)(k0 + kk) * ldw + n0 + (lane & 31)]; }
    asm volatile("s_waitcnt lgkmcnt(0)" ::: "memory");
    const int c = lane & 7;
    float mv[8];
    if (mu) {
#pragma unroll
        for (int e = 0; e < 8; ++e) mv[e] = mu[k0 + 8 * c + e];
    }
#pragma unroll
    for (int j = 0; j < 4; ++j) {
        const int n = (lane >> 3) + 8 * j; const LAS float* s = scr + (8 * c) * 33 + n;
        float f[8];
#pragma unroll
        for (int e = 0; e < 8; ++e) f[e] = s[e * 33];
        bf16* dp = WT + (size_t)(drow + n) * ldt + k0 + 8 * c;
        if (mu) {
            float f1[8], f2[8];
#pragma unroll
            for (int e = 0; e < 8; ++e) { f1[e] = f[e] * (1.f - mv[e]); f2[e] = f[e] * mv[e]; }
            *(v4u*)dp = pack8(f1); *(v4u*)(dp + 1024) = pack8(f2);
        } else *(v4u*)dp = pack8(f);
    }
    asm volatile("s_waitcnt lgkmcnt(0)" ::: "memory");
}

__device__ __forceinline__ void ph_p0(const Params& p, LAS unsigned char* lds, int tid, int lane, int wave) {
    unsigned char* ws = p.ws;
    LAS float* scr = (LAS float*)(lds + wave * 16384);
    const int gw = blockIdx.x * NWAVES + wave, NGW = gridDim.x * NWAVES;
    constexpr int C_WIN = 2 * 16 * 192, C_WOUT = 2 * 32 * 32, C_RKV = 2 * 3 * 512, C_W1 = 2 * 32, C_A1 = 2 * 32, C_G1 = 2 * 80, C_V1 = 16, C_WO = 2 * 512, C_WUG = 4 * 16 * 176, C_WD = 4 * 44 * 32;
    constexpr int NITEMS = C_WIN + C_WOUT + C_RKV + C_W1 + C_A1 + C_G1 + C_V1 + C_WO + C_WUG + C_WD;
    for (int it = gw; it < NITEMS; it += NGW) {
        int r = it;
        if (r < C_WIN) { const int j = r / 3072, q = r % 3072, kb = q / 192, nb = q % 192;
            tr_item(p.in[I_RWIN] + (size_t)j * D * RWIN, RWIN, 64 * kb, 32 * nb, (bf16*)(ws + WS_WIN + j * SZ_WIN), D, 32 * nb, nullptr, scr, lane); continue; }
        r -= C_WIN;
        if (r < C_WOUT) { const int j = r / 1024, q = r % 1024, kb = q / 32, nb = q % 32;
            tr_item(p.in[I_RWOUT] + (size_t)j * RV * D, D, 64 * kb, 32 * nb, (bf16*)(ws + WS_WOUT + j * SZ_WOUT), RV, 32 * nb, nullptr, scr, lane); continue; }
        r -= C_WOUT;
        if (r < C_RKV) { const int j = r / 1536, q = r % 1536, s = q / 512, q2 = q % 512, kb = q2 / 32, nb = q2 % 32, c = (s == 0 ? 0 : (s == 1 ? 2 : 3));
            tr_item(p.in[I_WRKV] + (size_t)(j * 3 + s) * D * D, D, 64 * kb, 32 * nb, (bf16*)(ws + WS_WRW + j * SZ_WRW), KRW, s * 1024 + 32 * nb, p.in[I_MU] + (size_t)(j * 6 + c) * D, scr, lane); continue; }
        r -= C_RKV;
        if (r < C_W1) { const int j = r / 32, q = r % 32, kb = q / 2, nb = q % 2;
            tr_item(p.in[I_W1] + (size_t)j * D * LW, LW, 64 * kb, 32 * nb, (bf16*)(ws + WS_WRW + j * SZ_WRW), KRW, 3072 + 32 * nb, p.in[I_MU] + (size_t)(j * 6 + 1) * D, scr, lane); continue; }
        r -= C_W1;
        if (r < C_A1) { const int j = r / 32, q = r % 32, kb = q / 2, nb = q % 2;
            tr_item(p.in[I_A1] + (size_t)j * D * LA, LA, 64 * kb, 32 * nb, (bf16*)(ws + WS_WRW + j * SZ_WRW), KRW, 3136 + 32 * nb, p.in[I_MU] + (size_t)(j * 6 + 4) * D, scr, lane); continue; }
        r -= C_A1;
        if (r < C_G1) { const int j = r / 80, q = r % 80, kb = q / 5, nb = q % 5;
            tr_item(p.in[I_G1] + (size_t)j * D * LG, LG, 64 * kb, 32 * nb, (bf16*)(ws + WS_WRW + j * SZ_WRW), KRW, 3200 + 32 * nb, p.in[I_MU] + (size_t)(j * 6 + 5) * D, scr, lane); continue; }
        r -= C_G1;
        if (r < C_V1) { const int kb = r;
            tr_item(p.in[I_V1], LV, 64 * kb, 0, (bf16*)(ws + WS_WRW + 1 * SZ_WRW), KRW, 3360, p.in[I_MU] + (size_t)(1 * 6 + 3) * D, scr, lane); continue; }
        r -= C_V1;
        if (r < C_WO) { const int j = r / 512, q = r % 512, kb = q / 32, nb = q % 32;
            tr_item(p.in[I_WO] + (size_t)j * D * D, D, 64 * kb, 32 * nb, (bf16*)(ws + WS_WO + j * SZ_WO), D, 32 * nb, nullptr, scr, lane); continue; }
        r -= C_WO;
        if (r < C_WUG) { const int i = r / 2816, q = r % 2816, kb = q / 176, nb = q % 176, n0 = 32 * nb;
            const int drow = n0 < DFF ? 256 * (n0 / 128) + (n0 % 128) : 256 * ((n0 - DFF) / 128) + 128 + ((n0 - DFF) % 128);
            tr_item(p.in[I_WUG] + (size_t)i * D * 2 * DFF, 2 * DFF, 64 * kb, n0, (bf16*)(ws + WS_WUG + i * SZ_WUG), D, drow, nullptr, scr, lane); continue; }
        r -= C_WUG;
        { const int i = r / 1408, q = r % 1408, kb = q / 32, nb = q % 32;
            tr_item(p.in[I_WD] + (size_t)i * DFF * D, D, 64 * kb, 32 * nb, (bf16*)(ws + WS_WD + i * SZ_WD), DFF, 32 * nb, nullptr, scr, lane); }
    }
    const size_t gt = (size_t)blockIdx.x * NTHR + tid, GT = (size_t)gridDim.x * NTHR;
    for (size_t i = gt; i < (size_t)(224 + 192) * (KRW / 8); i += GT) {
        const int rr = (int)(i / (KRW / 8)), c8 = (int)(i % (KRW / 8));
        const int j = rr < 224 ? 0 : 1, row = rr < 224 ? 3360 + rr : 3392 + (rr - 224);
        *(v4u*)((bf16*)(ws + WS_WRW + j * SZ_WRW) + (size_t)row * KRW + c8 * 8) = (v4u){0u, 0u, 0u, 0u};
    }
    for (size_t i = gt; i < (size_t)2 * NL2 * KL2; i += GT) {
        const int j = (int)(i / ((size_t)NL2 * KL2)); const int rem = (int)(i % ((size_t)NL2 * KL2)); const int n = rem / KL2, k = rem % KL2, grp = n >> 10, nn = n & 1023;
        float v = 0.f;
        if (grp == 0) { if (k < 64) v = p.in[I_W2][((size_t)j * LW + k) * D + nn]; }
        else if (grp == 1) { if (k >= 64 && k < 128) v = p.in[I_A2][((size_t)j * LA + (k - 64)) * D + nn]; }
        else if (grp == 2) { if (k >= 128 && k < 288) v = p.in[I_G2][((size_t)j * LG + (k - 128)) * D + nn]; }
        else { if (j == 1 && k >= 288 && k < 320) v = p.in[I_V2][((size_t)(k - 288)) * D + nn]; }
        ((bf16*)(ws + WS_WL2 + j * SZ_WL2))[(size_t)n * KL2 + k] = (bf16)(cvt_pk_bf16(v, 0.f) & 0xffffu);
    }
    for (size_t i = gt; i < (size_t)(TP + 1) * 128; i += GT) {
        const int pi = (int)(i >> 7), mi = (int)(i & 127);
        const float pos = pi < TP ? (float)pi : PAST_POS;
        const float inv = 1.0f / powf(10000.0f, (float)mi / 127.0f);
        float s, c; sincosf(pos * inv, &s, &c);
        ((float2*)(ws + WS_CS))[i] = make_float2(c, s);
    }
    float* X = (float*)(ws + WS_X);
    for (size_t i = gt; i < (size_t)M * (D / 4); i += GT) {
        const int r = (int)(i / (D / 4)), c4 = (int)(i % (D / 4));
        const float* src;
        if (r < MP) { const int b = r / TP, t = r % TP; src = t < NMETA ? p.in[I_META] + (size_t)t * D : p.in[I_XP] + ((size_t)b * SEQ + (t - NMETA)) * D; }
        else src = p.in[I_XS] + (size_t)(r - MP) * D;
        ((f32x4*)X)[i] = ((const f32x4*)src)[c4];
    }
}

__device__ __forceinline__ void ph_norm(const Params& p, const float* __restrict__ g, int mode, int jl, int lane, int wave) {
    const float* X = (const float*)(p.ws + WS_X); bf16* H = (bf16*)(p.ws + WS_H);
    const int gw = blockIdx.x * NWAVES + wave, NGW = gridDim.x * NWAVES;
    for (int row = gw; row < M; row += NGW) {
        const float* xr = X + (size_t)row * D;
        float v[2][8]; float ss = 0.f;
#pragma unroll
        for (int j = 0; j < 2; ++j) {
            const f32x4 a = *(const f32x4*)(xr + 512 * j + 8 * lane), b = *(const f32x4*)(xr + 512 * j + 8 * lane + 4);
            v[j][0] = a.x; v[j][1] = a.y; v[j][2] = a.z; v[j][3] = a.w; v[j][4] = b.x; v[j][5] = b.y; v[j][6] = b.z; v[j][7] = b.w;
#pragma unroll
            for (int e = 0; e < 8; ++e) ss += v[j][e] * v[j][e];
        }
        ss = wave_sum(ss);
        const float rstd = rsqrtf(ss * (1.f / D) + 1e-6f);
        const bool prompt = row < MP; const int b = prompt ? row / TP : 0, t = prompt ? row % TP : 0;
#pragma unroll
        for (int j = 0; j < 2; ++j) {
            const int c0 = 512 * j + 8 * lane;
            const f32x4 ga = *(const f32x4*)(g + c0), gb = *(const f32x4*)(g + c0 + 4);
            float o[8];
            o[0] = v[j][0] * rstd * ga.x; o[1] = v[j][1] * rstd * ga.y; o[2] = v[j][2] * rstd * ga.z; o[3] = v[j][3] * rstd * ga.w;
            o[4] = v[j][4] * rstd * gb.x; o[5] = v[j][5] * rstd * gb.y; o[6] = v[j][6] * rstd * gb.z; o[7] = v[j][7] * rstd * gb.w;
            if (mode == 0) { *(v4u*)(H + (size_t)row * D + c0) = pack8(o); }
            else if (mode == 1) {
                const v4u w = pack8(o);
                *(v4u*)(H + (size_t)row * 2048 + c0) = w;
                if (prompt) {
                    if (t != TP - 1) *(v4u*)(H + (size_t)(row + 1) * 2048 + 1024 + c0) = w;
                    else { float* so = p.out + O_SHP + ((size_t)jl * BATCH + b) * D + c0; *(f32x4*)so = (f32x4){o[0], o[1], o[2], o[3]}; *(f32x4*)(so + 4) = (f32x4){o[4], o[5], o[6], o[7]}; }
                    if (t == 0) *(v4u*)(H + (size_t)row * 2048 + 1024 + c0) = (v4u){0u, 0u, 0u, 0u};
                } else {
                    const int s = row - MP;
                    const float* sp = p.in[I_SSHIFT] + ((size_t)jl * SB + s) * D + c0;
                    const f32x4 sa = *(const f32x4*)sp, sb2 = *(const f32x4*)(sp + 4);
                    const float pv[8] = {sa.x, sa.y, sa.z, sa.w, sb2.x, sb2.y, sb2.z, sb2.w};
                    *(v4u*)(H + (size_t)row * 2048 + 1024 + c0) = pack8(pv);
                    float* so = p.out + O_SHS + ((size_t)jl * SB + s) * D + c0; *(f32x4*)so = (f32x4){o[0], o[1], o[2], o[3]}; *(f32x4*)(so + 4) = (f32x4){o[4], o[5], o[6], o[7]};
                }
            } else {
                float* dst = nullptr;
                if (prompt) { if (t >= NMETA) dst = p.out + O_YP + ((size_t)b * SEQ + (t - NMETA)) * D + c0; }
                else dst = p.out + O_YS + (size_t)(row - MP) * D + c0;
                if (dst) { *(f32x4*)dst = (f32x4){o[0], o[1], o[2], o[3]}; *(f32x4*)(dst + 4) = (f32x4){o[4], o[5], o[6], o[7]}; }
            }
        }
    }
}

__device__ __forceinline__ void ph_ret_norm(const Params& p, int jl, int lane, int wave) {
    const float* O = (const float*)(p.ws + WS_O); const bf16* SG = (const bf16*)(p.ws + WS_SG); bf16* Y = (bf16*)(p.ws + WS_Y);
    const float* gnw = p.in[I_RGN] + (size_t)jl * RV;
    const int gw = blockIdx.x * NWAVES + wave, NGW = gridDim.x * NWAVES;
    for (int it = gw; it < M * RH; it += NGW) {
        const int row = it >> 2, h = it & 3; const size_t off = (size_t)row * RV + h * RDV + 8 * lane;
        const f32x4 a = *(const f32x4*)(O + off), b = *(const f32x4*)(O + off + 4);
        float v[8] = {a.x, a.y, a.z, a.w, b.x, b.y, b.z, b.w};
        float s = 0.f;
#pragma unroll
        for (int e = 0; e < 8; ++e) s += v[e];
        const float mean = wave_sum(s) * (1.f / RDV);
        float s2 = 0.f;
#pragma unroll
        for (int e = 0; e < 8; ++e) { v[e] -= mean; s2 += v[e] * v[e]; }
        const float rstd = rsqrtf(wave_sum(s2) * (1.f / RDV) + 1e-5f);
        float sg[8]; unpack8(*(const v4u*)(SG + off), sg);
        const f32x4 ga = *(const f32x4*)(gnw + h * RDV + 8 * lane), gb = *(const f32x4*)(gnw + h * RDV + 8 * lane + 4);
        const float gg[8] = {ga.x, ga.y, ga.z, ga.w, gb.x, gb.y, gb.z, gb.w};
        float o[8];
#pragma unroll
        for (int e = 0; e < 8; ++e) o[e] = v[e] * rstd * gg[e] * sg[e];
        *(v4u*)(Y + off) = pack8(o);
    }
}

__device__ __forceinline__ void ph_conv(const Params& p, int li, int tid) {
    const bf16* U = (const bf16*)(p.ws + WS_U); const bf16* G = (const bf16*)(p.ws + WS_G); bf16* ACT = (bf16*)(p.ws + WS_ACT);
    const float* cw = p.in[I_CW] + (size_t)li * 3 * DFF; const float* cb = p.in[I_CB] + (size_t)li * DFF;
    const float* cst = p.in[I_SCONV] + (size_t)li * SB * 2 * DFF;
    float* cvp = p.out + O_CVP + (size_t)li * BATCH * 2 * DFF; float* cvs = p.out + O_CVS + (size_t)li * SB * 2 * DFF;
    const size_t gt = (size_t)blockIdx.x * NTHR + tid, GT = (size_t)gridDim.x * NTHR;
    constexpr int CH = DFF / 8;
    for (size_t i = gt; i < (size_t)M * CH; i += GT) {
        const int row = (int)(i / CH), f0 = (int)(i % CH) * 8;
        const size_t off = (size_t)row * DFF + f0;
        float u[8], g0[8], g1[8], g2[8];
        unpack8(*(const v4u*)(U + off), u); unpack8(*(const v4u*)(G + off), g0);
        if (row < MP) {
            const int b = row / TP, t = row % TP;
            if (t >= 1) unpack8(*(const v4u*)(G + off - DFF), g1); else {
#pragma unroll
                for (int e = 0; e < 8; ++e) g1[e] = 0.f; }
            if (t >= 2) unpack8(*(const v4u*)(G + off - 2 * DFF), g2); else {
#pragma unroll
                for (int e = 0; e < 8; ++e) g2[e] = 0.f; }
            if (t >= TP - 2) { float* o = cvp + ((size_t)b * 2 + (t - (TP - 2))) * DFF + f0; *(f32x4*)o = (f32x4){g0[0], g0[1], g0[2], g0[3]}; *(f32x4*)(o + 4) = (f32x4){g0[4], g0[5], g0[6], g0[7]}; }
        } else {
            const int s = row - MP;
            const float* c0 = cst + ((size_t)s * 2 + 0) * DFF + f0; const float* c1 = c0 + DFF;
            const f32x4 a0 = *(const f32x4*)c0, a1 = *(const f32x4*)(c0 + 4), b0 = *(const f32x4*)c1, b1 = *(const f32x4*)(c1 + 4);
            g2[0] = a0.x; g2[1] = a0.y; g2[2] = a0.z; g2[3] = a0.w; g2[4] = a1.x; g2[5] = a1.y; g2[6] = a1.z; g2[7] = a1.w;
            g1[0] = b0.x; g1[1] = b0.y; g1[2] = b0.z; g1[3] = b0.w; g1[4] = b1.x; g1[5] = b1.y; g1[6] = b1.z; g1[7] = b1.w;
            float* o = cvs + ((size_t)s * 2 + 0) * DFF + f0;
            *(f32x4*)o = b0; *(f32x4*)(o + 4) = b1;
            *(f32x4*)(o + DFF) = (f32x4){g0[0], g0[1], g0[2], g0[3]}; *(f32x4*)(o + DFF + 4) = (f32x4){g0[4], g0[5], g0[6], g0[7]};
        }
        float w0[8], w1[8], w2[8], bb[8];
        { const f32x4 x0 = *(const f32x4*)(cw + f0), x1 = *(const f32x4*)(cw + f0 + 4); w0[0] = x0.x; w0[1] = x0.y; w0[2] = x0.z; w0[3] = x0.w; w0[4] = x1.x; w0[5] = x1.y; w0[6] = x1.z; w0[7] = x1.w; }
        { const f32x4 x0 = *(const f32x4*)(cw + DFF + f0), x1 = *(const f32x4*)(cw + DFF + f0 + 4); w1[0] = x0.x; w1[1] = x0.y; w1[2] = x0.z; w1[3] = x0.w; w1[4] = x1.x; w1[5] = x1.y; w1[6] = x1.z; w1[7] = x1.w; }
        { const f32x4 x0 = *(const f32x4*)(cw + 2 * DFF + f0), x1 = *(const f32x4*)(cw + 2 * DFF + f0 + 4); w2[0] = x0.x; w2[1] = x0.y; w2[2] = x0.z; w2[3] = x0.w; w2[4] = x1.x; w2[5] = x1.y; w2[6] = x1.z; w2[7] = x1.w; }
        { const f32x4 x0 = *(const f32x4*)(cb + f0), x1 = *(const f32x4*)(cb + f0 + 4); bb[0] = x0.x; bb[1] = x0.y; bb[2] = x0.z; bb[3] = x0.w; bb[4] = x1.x; bb[5] = x1.y; bb[6] = x1.z; bb[7] = x1.w; }
        float o[8];
#pragma unroll
        for (int e = 0; e < 8; ++e) { const float cv = bb[e] + w0[e] * g2[e] + w1[e] * g1[e] + w2[e] * g0[e]; o[e] = siluf_(cv) * u[e]; }
        *(v4u*)(ACT + off) = pack8(o);
    }
}

__device__ __forceinline__ void ph_rwkv_prep(const Params& p, int jl, int lane, int wave) {
    float* Kb = (float*)(p.ws + WS_K); float* Vb = (float*)(p.ws + (jl == 0 ? WS_VF : WS_VB)); const float* VF = (const float*)(p.ws + WS_VF);
    const float* L2 = (const float*)(p.ws + WS_L2);
    float* Wd = (float*)(p.ws + WS_WDEC); float* NKK = (float*)(p.ws + WS_NKK); float* KKA = (float*)(p.ws + WS_KKA);
    const float* w0 = p.in[I_W0] + (size_t)jl * D; const float* a0 = p.in[I_A0] + (size_t)jl * D; const float* v0 = p.in[I_V0];
    const float* kkp = p.in[I_KK] + (size_t)jl * D; const float* kap = p.in[I_KA] + (size_t)jl * D;
    const int gw = blockIdx.x * NWAVES + wave, NGW = gridDim.x * NWAVES;
    for (int it = gw; it < M * WH; it += NGW) {
        const int row = it >> 4, h = it & 15, c = h * WN + lane;
        const size_t idx = (size_t)row * D + c, l2 = (size_t)row * NL2 + c;
        const float xw = -(w0[c] + L2[l2]);
        const float sp = xw > 20.f ? xw : log1pf(expf(xw));
        const float w = expf(-expf(-sp - 0.5f));
        const float a = sigmoidf_(a0[c] + L2[l2 + 1024]);
        const float kv = Kb[idx];
        float kk = kv * kkp[c];
        const float ss = wave_sum(kk * kk);
        kk = kk * rsqrtf(fmaxf(ss, 1e-12f));
        if (jl == 1) { const float v = Vb[idx]; Vb[idx] = v + (VF[idx] - v) * sigmoidf_(v0[c] + L2[l2 + 3072]); }
        Kb[idx] = kv * (1.f + (a - 1.f) * kap[c]); Wd[idx] = w; NKK[idx] = -kk; KKA[idx] = kk * a;
    }
}
__device__ __forceinline__ void ph_rwkv_post(const Params& p, int jl, int lane, int wave) {
    const float* YW = (const float*)(p.ws + WS_YW); const float* R = (const float*)(p.ws + WS_R); const float* Kb = (const float*)(p.ws + WS_K);
    const float* Vb = (const float*)(p.ws + (jl == 0 ? WS_VF : WS_VB)); const float* L2 = (const float*)(p.ws + WS_L2); bf16* Z = (bf16*)(p.ws + WS_Z);
    const float* rk = p.in[I_RK] + (size_t)jl * D; const float* lnw = p.in[I_LNW] + (size_t)jl * D; const float* lnb = p.in[I_LNB] + (size_t)jl * D;
    const int gw = blockIdx.x * NWAVES + wave, NGW = gridDim.x * NWAVES;
    for (int it = gw; it < M * WH; it += NGW) {
        const int row = it >> 4, h = it & 15, c = h * WN + lane;
        const size_t idx = (size_t)row * D + c;
        const float yv = YW[idx];
        const float mean = wave_sum(yv) * (1.f / WN);
        const float yc = yv - mean;
        const float rstd = rsqrtf(wave_sum(yc * yc) * (1.f / WN) + 64e-5f);
        const float yn = yc * rstd * lnw[c] + lnb[c];
        const float bon = wave_sum(R[idx] * Kb[idx] * rk[c]) * Vb[idx];
        const float z = (yn + bon) * L2[(size_t)row * NL2 + 2048 + c];
        Z[idx] = (bf16)(cvt_pk_bf16(z, 0.f) & 0xffffu);
    }
}

__device__ __forceinline__ void ph_ret_slow(const Params& p, int jl, LAS unsigned char* lds, int tid) {
    const bf16* QK = (const bf16*)(p.ws + WS_QK); const bf16* V = (const bf16*)(p.ws + WS_V); float* O = (float*)(p.ws + WS_O);
    const int half = tid >> 8, t256 = tid & 255, e = t256 & 63, dq = t256 >> 6;
    LAS float* sq = (LAS float*)lds + half * 256; LAS float* sk = (LAS float*)lds + 512 + half * 256; LAS float* red = (LAS float*)lds + 1024 + half * 256;
    for (int pass = 0; pass < 2; ++pass) {
        const int nitems = pass ? SB * RH * 8 : BATCH * RH * 8;
        for (int it = blockIdx.x * 2 + half; it < nitems; it += gridDim.x * 2) {
            const int es = it & 7, h = (it >> 3) & 3, seq = it >> 5;
            const int r0 = pass ? MP + seq : seq * TP, T = pass ? 1 : TP;
            const float gamma = 1.0f - exp2f(-5.0f - (float)h);
            float S[64];
            if (pass) {
                const float* sp = p.in[I_SRET] + ((((size_t)jl * SB + seq) * RH + h) * RDK + dq * 64) * RDV + es * 64 + e;
#pragma unroll
                for (int dd = 0; dd < 64; ++dd) S[dd] = sp[(size_t)dd * RDV];
            } else {
#pragma unroll
                for (int dd = 0; dd < 64; ++dd) S[dd] = 0.f;
            }
            for (int t = 0; t < T; ++t) {
                const int row = r0 + t;
                sq[t256] = __uint_as_float((unsigned)QK[(size_t)row * 2048 + h * RDK + t256] << 16);
                sk[t256] = __uint_as_float((unsigned)QK[(size_t)row * 2048 + 1024 + h * RDK + t256] << 16);
                const float ve = __uint_as_float((unsigned)V[(size_t)row * 2048 + h * RDV + es * 64 + e] << 16);
                __syncthreads();
                float acc = 0.f;
#pragma unroll
                for (int dd = 0; dd < 64; ++dd) { S[dd] = fmaf(S[dd], gamma, sk[dq * 64 + dd] * ve); acc = fmaf(sq[dq * 64 + dd], S[dd], acc); }
                red[dq * 64 + e] = acc;
                __syncthreads();
                if (dq == 0) O[(size_t)row * RV + h * RDV + es * 64 + e] = (red[e] + red[64 + e]) + (red[128 + e] + red[192 + e]);
            }
            float* so = (pass ? p.out + O_RETS + (size_t)jl * SB * RH * RDK * RDV : p.out + O_RETP + (size_t)jl * BATCH * RH * RDK * RDV) + (((size_t)seq * RH + h) * RDK + dq * 64) * RDV + es * 64 + e;
#pragma unroll
            for (int dd = 0; dd < 64; ++dd) so[(size_t)dd * RDV] = S[dd];
        }
    }
}
__device__ __forceinline__ void ph_wkv_slow(const Params& p, int jl, LAS unsigned char* lds, int lane, int wave) {
    const float* r = (const float*)(p.ws + WS_R); const float* w = (const float*)(p.ws + WS_WDEC); const float* k = (const float*)(p.ws + WS_K);
    const float* v = (const float*)(p.ws + (jl == 0 ? WS_VF : WS_VB)); const float* nkk = (const float*)(p.ws + WS_NKK); const float* kka = (const float*)(p.ws + WS_KKA);
    float* y = (float*)(p.ws + WS_YW);
    LAS float* sv = (LAS float*)lds + wave * 320;
    for (int pass = 0; pass < 2; ++pass) {
        const int nitems = pass ? SB * WH : BATCH * WH;
        for (int it = blockIdx.x * NWAVES + wave; it < nitems; it += gridDim.x * NWAVES) {
            const int h = it & 15, seq = it >> 4;
            const int r0 = pass ? MP + seq : seq * TP, T = pass ? 1 : TP;
            float S[64];
            if (pass) {
                const float* sp = p.in[I_SWKV] + ((((size_t)jl * SB + seq) * WH + h) * WN + lane) * WN;
#pragma unroll
                for (int j = 0; j < 64; j += 4) { const f32x4 t4 = *(const f32x4*)(sp + j); S[j] = t4.x; S[j + 1] = t4.y; S[j + 2] = t4.z; S[j + 3] = t4.w; }
            } else {
#pragma unroll
                for (int j = 0; j < 64; ++j) S[j] = 0.f;
            }
            for (int t = 0; t < T; ++t) {
                const size_t idx = (size_t)(r0 + t) * D + h * WN + lane;
                sv[lane] = nkk[idx]; sv[64 + lane] = w[idx]; sv[128 + lane] = kka[idx]; sv[192 + lane] = k[idx]; sv[256 + lane] = r[idx];
                const float vi = v[idx];
                __syncthreads();
                float sa0 = 0.f, sa1 = 0.f, sa2 = 0.f, sa3 = 0.f;
#pragma unroll
                for (int j = 0; j < 64; j += 4) { sa0 = fmaf(S[j], sv[j], sa0); sa1 = fmaf(S[j + 1], sv[j + 1], sa1); sa2 = fmaf(S[j + 2], sv[j + 2], sa2); sa3 = fmaf(S[j + 3], sv[j + 3], sa3); }
                const float sa = (sa0 + sa1) + (sa2 + sa3);
                float y0 = 0.f, y1 = 0.f, y2 = 0.f, y3 = 0.f;
#pragma unroll
                for (int j = 0; j < 64; j += 4) {
                    S[j] = fmaf(S[j], sv[64 + j], fmaf(sa, sv[128 + j], vi * sv[192 + j])); y0 = fmaf(S[j], sv[256 + j], y0);
                    S[j + 1] = fmaf(S[j + 1], sv[64 + j + 1], fmaf(sa, sv[128 + j + 1], vi * sv[192 + j + 1])); y1 = fmaf(S[j + 1], sv[256 + j + 1], y1);
                    S[j + 2] = fmaf(S[j + 2], sv[64 + j + 2], fmaf(sa, sv[128 + j + 2], vi * sv[192 + j + 2])); y2 = fmaf(S[j + 2], sv[256 + j + 2], y2);
                    S[j + 3] = fmaf(S[j + 3], sv[64 + j + 3], fmaf(sa, sv[128 + j + 3], vi * sv[192 + j + 3])); y3 = fmaf(S[j + 3], sv[256 + j + 3], y3);
                }
                y[idx] = (y0 + y1) + (y2 + y3);
                __syncthreads();
            }
            float* so = (pass ? p.out + O_WKVS + (size_t)jl * SB * WH * WN * WN : p.out + O_WKVP + (size_t)jl * BATCH * WH * WN * WN) + (((size_t)seq * WH + h) * WN + lane) * WN;
#pragma unroll
            for (int j = 0; j < 64; j += 4) { f32x4 t4; t4.x = S[j]; t4.y = S[j + 1]; t4.z = S[j + 2]; t4.w = S[j + 3]; *(f32x4*)(so + j) = t4; }
        }
    }
}

constexpr int RT_KP = 528, RT_VP = 144, RT_SP = 528;
constexpr int RT_K_OFF = 0, RT_V_OFF = 128 * RT_KP, RT_ST_OFF = RT_V_OFF + 128 * RT_VP, RT_END = RT_ST_OFF + 64 * RT_SP;
static_assert(RT_END <= LDS_BYTES, "retention LDS map");
typedef short v4s __attribute__((ext_vector_type(4)));
using pg8::bf16x8;
__device__ __forceinline__ bf16x8 tr_pair(LAS unsigned char* a0, LAS unsigned char* a1) {
    const v4s lo = __builtin_amdgcn_ds_read_tr16_b64_v4i16((LAS v4s*)a0), hi = __builtin_amdgcn_ds_read_tr16_b64_v4i16((LAS v4s*)a1);
    return __builtin_shufflevector(lo, hi, 0, 1, 2, 3, 4, 5, 6, 7);
}
__device__ __forceinline__ void ph_ret_fast(const Params& p, int jl, LAS unsigned char* lds, int tid, int lane, int wave) {
    const bf16* QK = (const bf16*)(p.ws + WS_QK); const bf16* V = (const bf16*)(p.ws + WS_V); float* O = (float*)(p.ws + WS_O);
    const int fr = lane & 15, fq = lane >> 4, li_q = (lane & 15) >> 2, li_p = lane & 3;
    for (int u = blockIdx.x; u < BATCH * RH * 8; u += gridDim.x) {
        const int es = u & 7, h = (u >> 3) & 3, b = u >> 5;
        const float gamma = 1.0f - exp2f(-5.0f - (float)h), lg = log2f(gamma), g128 = exp2f(128.f * lg), g127 = exp2f(127.f * lg);
        const int i0 = 16 * wave, d0 = 32 * wave;
        f32x4 Sacc[2][4];
#pragma unroll
        for (int a = 0; a < 2; ++a)
#pragma unroll
            for (int c = 0; c < 4; ++c) Sacc[a][c] = (f32x4){0.f, 0.f, 0.f, 0.f};
        __syncthreads();
        for (int i = tid; i < 64 * RT_SP / 16; i += NTHR) *(LAS v4u*)(lds + RT_ST_OFF + i * 16) = (v4u){0u, 0u, 0u, 0u};
        v4u kst[8], vst[2];
        const bf16* Kg = QK + 1024 + 256 * h; const bf16* Vg = V + 512 * h + 64 * es; const bf16* Qg = QK + 256 * h;
#define RT_LOAD_STAGE(cc) do { \
            _Pragma("unroll") for (int k_ = 0; k_ < 8; ++k_) { const int id_ = tid + 512 * k_, row_ = id_ >> 5, ch_ = id_ & 31, t_ = 128 * (cc) - 112 + row_; \
                kst[k_] = t_ >= 0 ? *(const v4u*)(Kg + (size_t)(b * TP + t_) * 2048 + 8 * ch_) : (v4u){0u, 0u, 0u, 0u}; } \
            _Pragma("unroll") for (int k_ = 0; k_ < 2; ++k_) { const int id_ = tid + 512 * k_, row_ = id_ >> 3, ch_ = id_ & 7, t_ = 128 * (cc) - 112 + row_; \
                vst[k_] = t_ >= 0 ? *(const v4u*)(Vg + (size_t)(b * TP + t_) * 2048 + 8 * ch_) : (v4u){0u, 0u, 0u, 0u}; } } while (0)
        RT_LOAD_STAGE(0);
        for (int c = 0; c < 17; ++c) {
            __syncthreads();
#pragma unroll
            for (int k_ = 0; k_ < 8; ++k_) { const int id_ = tid + 512 * k_, row_ = id_ >> 5, ch_ = id_ & 31; *(LAS v4u*)(lds + RT_K_OFF + row_ * RT_KP + ch_ * 16) = kst[k_]; }
#pragma unroll
            for (int k_ = 0; k_ < 2; ++k_) { const int id_ = tid + 512 * k_, row_ = id_ >> 3, ch_ = id_ & 7;
                float f[8]; unpack8(vst[k_], f); const float sc = exp2f(-(float)row_ * lg);
#pragma unroll
                for (int e = 0; e < 8; ++e) f[e] *= sc;
                *(LAS v4u*)(lds + RT_V_OFF + row_ * RT_VP + ch_ * 16) = pack8(f); }
            bf16x8 Qf[8];
            { const int t_ = 128 * c - 112 + i0 + fr;
#pragma unroll
              for (int s = 0; s < 8; ++s) Qf[s] = t_ >= 0 ? *(const bf16x8*)(Qg + (size_t)(b * TP + t_) * 2048 + 32 * s + 8 * fq) : (bf16x8){0, 0, 0, 0, 0, 0, 0, 0}; }
            __syncthreads();
            bf16x8 Pf[4];
            { const int ii = i0 + fr; const float gi = exp2f((float)ii * lg);
#pragma unroll
              for (int s2 = 0; s2 < 4; ++s2) { f32x4 Dp[2];
#pragma unroll
                  for (int hh = 0; hh < 2; ++hh) { Dp[hh] = (f32x4){0.f, 0.f, 0.f, 0.f};
#pragma unroll
                      for (int s = 0; s < 8; ++s) { const bf16x8 Kf = *(const LAS bf16x8*)(lds + RT_K_OFF + (16 * (2 * s2 + hh) + fr) * RT_KP + (32 * s + 8 * fq) * 2);
                          Dp[hh] = __builtin_amdgcn_mfma_f32_16x16x32_bf16(Kf, Qf[s], Dp[hh], 0, 0, 0); } }
                  float f[8];
#pragma unroll
                  for (int hh = 0; hh < 2; ++hh)
#pragma unroll
                      for (int r = 0; r < 4; ++r) { const int jj = 16 * (2 * s2 + hh) + 4 * fq + r; f[hh * 4 + r] = ii >= jj ? Dp[hh][r] * gi : 0.f; }
                  const v4u w = pack8(f); Pf[s2] = __builtin_bit_cast(bf16x8, w); } }
            f32x4 Oacc[4];
#pragma unroll
            for (int et = 0; et < 4; ++et) { Oacc[et] = (f32x4){0.f, 0.f, 0.f, 0.f};
#pragma unroll
                for (int s = 0; s < 8; ++s) { const bf16x8 Sf = *(const LAS bf16x8*)(lds + RT_ST_OFF + (16 * et + fr) * RT_SP + (32 * s + 8 * fq) * 2);
                    Oacc[et] = __builtin_amdgcn_mfma_f32_16x16x32_bf16(Qf[s], Sf, Oacc[et], 0, 0, 0); } }
            __syncthreads();
            if (c + 1 < 17) RT_LOAD_STAGE(c + 1);
#pragma unroll
            for (int r = 0; r < 4; ++r) { const float lam = exp2f((float)(i0 + 4 * fq + r + 1) * lg);
#pragma unroll
                for (int et = 0; et < 4; ++et) Oacc[et][r] *= lam; }
#pragma unroll
            for (int et = 0; et < 4; ++et)
#pragma unroll
                for (int s = 0; s < 4; ++s) {
                    LAS unsigned char* a0 = lds + RT_V_OFF + (32 * s + 4 * fq + li_q) * RT_VP + (16 * et + 4 * li_p) * 2;
                    const bf16x8 Vf = tr_pair(a0, a0 + 16 * RT_VP);
                    Oacc[et] = __builtin_amdgcn_mfma_f32_16x16x32_bf16(Pf[s], Vf, Oacc[et], 0, 0, 0); }
#pragma unroll
            for (int r = 0; r < 4; ++r) { const int t_ = 128 * c - 112 + i0 + 4 * fq + r;
                if (t_ >= 0) { float* op = O + (size_t)(b * TP + t_) * RV + 512 * h + 64 * es + fr;
#pragma unroll
                    for (int et = 0; et < 4; ++et) op[16 * et] = Oacc[et][r]; } }
#pragma unroll
            for (int dt = 0; dt < 2; ++dt)
#pragma unroll
                for (int et = 0; et < 4; ++et) Sacc[dt][et] = Sacc[dt][et] * (g128 / g127);
#pragma unroll
            for (int s = 0; s < 4; ++s) {
                bf16x8 Kt[2], Vt[4];
#pragma unroll
                for (int dt = 0; dt < 2; ++dt) { LAS unsigned char* a0 = lds + RT_K_OFF + (32 * s + 8 * fq + li_q) * RT_KP + (d0 + 16 * dt + 4 * li_p) * 2; Kt[dt] = tr_pair(a0, a0 + 4 * RT_KP); }
#pragma unroll
                for (int et = 0; et < 4; ++et) { LAS unsigned char* a0 = lds + RT_V_OFF + (32 * s + 8 * fq + li_q) * RT_VP + (16 * et + 4 * li_p) * 2; Vt[et] = tr_pair(a0, a0 + 4 * RT_VP); }
#pragma unroll
                for (int dt = 0; dt < 2; ++dt)
#pragma unroll
                    for (int et = 0; et < 4; ++et) Sacc[dt][et] = __builtin_amdgcn_mfma_f32_16x16x32_bf16(Kt[dt], Vt[et], Sacc[dt][et], 0, 0, 0);
            }
#pragma unroll
            for (int dt = 0; dt < 2; ++dt)
#pragma unroll
                for (int et = 0; et < 4; ++et) Sacc[dt][et] = Sacc[dt][et] * g127;
#pragma unroll
            for (int dt = 0; dt < 2; ++dt)
#pragma unroll
                for (int et = 0; et < 4; ++et) { v2u w; w.x = cvt_pk_bf16(Sacc[dt][et][0], Sacc[dt][et][1]); w.y = cvt_pk_bf16(Sacc[dt][et][2], Sacc[dt][et][3]);
                    *(LAS v2u*)(lds + RT_ST_OFF + (16 * et + fr) * RT_SP + (d0 + 16 * dt + 4 * fq) * 2) = w; }
        }
#undef RT_LOAD_STAGE
        float* so = p.out + O_RETP + ((((size_t)jl * BATCH + b) * RH + h) * RDK) * RDV + 64 * es;
#pragma unroll
        for (int dt = 0; dt < 2; ++dt)
#pragma unroll
            for (int et = 0; et < 4; ++et)
#pragma unroll
                for (int r = 0; r < 4; ++r) so[(size_t)(d0 + 16 * dt + 4 * fq + r) * RDV + 16 * et + fr] = Sacc[dt][et][r];
    }
    {
        LAS float* sq = (LAS float*)lds; LAS float* sk = sq + 256; LAS float* red = sk + 256;
        const int e4 = tid & 127, dq = tid >> 7;
        for (int it = blockIdx.x; it < SB * RH; it += gridDim.x) {
            const int h = it & 3, s = it >> 2, row = MP + s;
            const float gamma = 1.0f - exp2f(-5.0f - (float)h);
            __syncthreads();
            if (tid < 256) sq[tid] = bf_lo((unsigned)QK[(size_t)row * 2048 + 256 * h + tid]);
            else sk[tid - 256] = bf_lo((unsigned)QK[(size_t)row * 2048 + 1024 + 256 * h + (tid - 256)]);
            const v2u vv = *(const v2u*)(V + (size_t)row * 2048 + 512 * h + 4 * e4);
            const f32x4 v4 = (f32x4){bf_lo(vv.x), bf_hi(vv.x), bf_lo(vv.y), bf_hi(vv.y)};
            __syncthreads();
            const float* sin_ = p.in[I_SRET] + ((((size_t)jl * SB + s) * RH + h) * RDK) * RDV + 4 * e4;
            float* sout = p.out + O_RETS + ((((size_t)jl * SB + s) * RH + h) * RDK) * RDV + 4 * e4;
            f32x4 oacc = (f32x4){0.f, 0.f, 0.f, 0.f};
#pragma unroll 8
            for (int k = 0; k < 64; ++k) { const int d = dq + 4 * k;
                const f32x4 sv = __builtin_nontemporal_load((const f32x4*)(sin_ + (size_t)d * RDV));
                const f32x4 sn = sv * gamma + v4 * sk[d];
                oacc += sn * sq[d];
                __builtin_nontemporal_store(sn, (f32x4*)(sout + (size_t)d * RDV)); }
            *(LAS f32x4*)(red + dq * 512 + 4 * e4) = oacc;
            __syncthreads();
            if (dq == 0) { const f32x4 r = (*(LAS f32x4*)(red + 4 * e4) + *(LAS f32x4*)(red + 512 + 4 * e4)) + (*(LAS f32x4*)(red + 1024 + 4 * e4) + *(LAS f32x4*)(red + 1536 + 4 * e4));
                *(f32x4*)(O + (size_t)row * RV + 512 * h + 4 * e4) = r; }
        }
    }
}

constexpr int WK_TB = 32, WK_STEP_B = 6 * 256, WK_BUF_B = WK_TB * WK_STEP_B, WK_Y_OFF = 2 * WK_BUF_B, WK_YB_B = WK_TB * 32 * 4;
static_assert(WK_Y_OFF + 2 * WK_YB_B <= LDS_BYTES, "wkv LDS map");
__device__ __forceinline__ float row16_sum(float x) {
    x += __builtin_bit_cast(float, __builtin_amdgcn_update_dpp(0, __builtin_bit_cast(int, x), 0x128, 0xf, 0xf, false));
    x += __builtin_bit_cast(float, __builtin_amdgcn_update_dpp(0, __builtin_bit_cast(int, x), 0x124, 0xf, 0xf, false));
    x += __builtin_bit_cast(float, __builtin_amdgcn_update_dpp(0, __builtin_bit_cast(int, x), 0x122, 0xf, 0xf, false));
    x += __builtin_bit_cast(float, __builtin_amdgcn_update_dpp(0, __builtin_bit_cast(int, x), 0x121, 0xf, 0xf, false));
    return x;
}
__device__ __forceinline__ void ph_wkv_fast(const Params& p, int jl, LAS unsigned char* lds, int tid, int lane, int wave) {
    const float* arr[6] = {(const float*)(p.ws + WS_NKK), (const float*)(p.ws + WS_WDEC), (const float*)(p.ws + WS_KKA), (const float*)(p.ws + WS_K), (const float*)(p.ws + WS_R),
                           (const float*)(p.ws + (jl == 0 ? WS_VF : WS_VB))};
    float* YW = (float*)(p.ws + WS_YW);
    const int ri = lane >> 4, cg = lane & 15;
    for (int it = blockIdx.x; it < BATCH * WH * 2; it += gridDim.x) {
        const int half = it & 1, h = (it >> 1) & 15, seq = it >> 5, r0 = seq * TP;
        const int sts = tid >> 4, sc4 = tid & 15;
        f32x4 S = (f32x4){0.f, 0.f, 0.f, 0.f};
        f32x4 st[6];
        __syncthreads();
#pragma unroll
        for (int k = 0; k < 6; ++k) st[k] = *(const f32x4*)(arr[k] + (size_t)(r0 + sts) * D + h * WN + 4 * sc4);
#pragma unroll
        for (int k = 0; k < 6; ++k) *(LAS f32x4*)(lds + sts * WK_STEP_B + k * 256 + sc4 * 16) = st[k];
        __syncthreads();
        constexpr int NB = (TP + WK_TB - 1) / WK_TB;
        for (int bt = 0; bt < NB; ++bt) {
            const int t0 = bt * WK_TB, tn = t0 + WK_TB;
            const bool has_next = tn < TP;
            if (has_next) {
                const int tt = tn + sts;
#pragma unroll
                for (int k = 0; k < 6; ++k) st[k] = tt < TP ? *(const f32x4*)(arr[k] + (size_t)(r0 + tt) * D + h * WN + 4 * sc4) : (f32x4){0.f, 0.f, 0.f, 0.f};
            }
            LAS unsigned char* B = lds + (bt & 1) * WK_BUF_B;
            LAS float* yb = (LAS float*)(lds + WK_Y_OFF + (bt & 1) * WK_YB_B);
            const int nst = (TP - t0) < WK_TB ? (TP - t0) : WK_TB;
#pragma unroll 4
            for (int ts = 0; ts < nst; ++ts) {
                LAS unsigned char* sp = B + ts * WK_STEP_B + cg * 16;
                const f32x4 nk = *(LAS f32x4*)(sp), w4 = *(LAS f32x4*)(sp + 256), ka = *(LAS f32x4*)(sp + 512), k4 = *(LAS f32x4*)(sp + 768), r4 = *(LAS f32x4*)(sp + 1024);
                const float vi = *(LAS float*)(B + ts * WK_STEP_B + 1280 + (32 * half + 4 * wave + ri) * 4);
                const float sa = row16_sum((S.x * nk.x + S.y * nk.y) + (S.z * nk.z + S.w * nk.w));
                S.x = fmaf(S.x, w4.x, fmaf(sa, ka.x, vi * k4.x)); S.y = fmaf(S.y, w4.y, fmaf(sa, ka.y, vi * k4.y));
                S.z = fmaf(S.z, w4.z, fmaf(sa, ka.z, vi * k4.z)); S.w = fmaf(S.w, w4.w, fmaf(sa, ka.w, vi * k4.w));
                const float y = row16_sum((S.x * r4.x + S.y * r4.y) + (S.z * r4.z + S.w * r4.w));
                if (cg == 0) yb[ts * 32 + 4 * wave + ri] = y;
            }
            if (has_next) {
                LAS unsigned char* Bn = lds + ((bt + 1) & 1) * WK_BUF_B;
#pragma unroll
                for (int k = 0; k < 6; ++k) *(LAS f32x4*)(Bn + sts * WK_STEP_B + k * 256 + sc4 * 16) = st[k];
            }
            __syncthreads();
#pragma unroll
            for (int k = 0; k < 2; ++k) { const int idx = tid + 512 * k, ts = idx >> 5, rr = idx & 31;
                if (t0 + ts < TP) YW[(size_t)(r0 + t0 + ts) * D + h * WN + 32 * half + rr] = yb[idx]; }
        }
        *(f32x4*)(p.out + O_WKVP + ((((size_t)jl * BATCH + seq) * WH + h) * WN + 32 * half + 4 * wave + ri) * WN + 4 * cg) = S;
    }
    {
        const int gw = blockIdx.x * NWAVES + wave, NGW = gridDim.x * NWAVES;
        for (int it = gw; it < SB * WH * 16; it += NGW) {
            const int rg = it & 15, h = (it >> 4) & 15, s = it >> 8, row = MP + s, i = 4 * rg + ri;
            const size_t vo = (size_t)row * D + h * WN + 4 * cg;
            const f32x4 nk = *(const f32x4*)(arr[0] + vo), w4 = *(const f32x4*)(arr[1] + vo), ka = *(const f32x4*)(arr[2] + vo), k4 = *(const f32x4*)(arr[3] + vo), r4 = *(const f32x4*)(arr[4] + vo);
            const float vi = arr[5][(size_t)row * D + h * WN + i];
            const size_t so = ((((size_t)jl * SB + s) * WH + h) * WN + i) * WN + 4 * cg;
            f32x4 S = *(const f32x4*)(p.in[I_SWKV] + so);
            const float sa = row16_sum((S.x * nk.x + S.y * nk.y) + (S.z * nk.z + S.w * nk.w));
            S.x = fmaf(S.x, w4.x, fmaf(sa, ka.x, vi * k4.x)); S.y = fmaf(S.y, w4.y, fmaf(sa, ka.y, vi * k4.y));
            S.z = fmaf(S.z, w4.z, fmaf(sa, ka.z, vi * k4.z)); S.w = fmaf(S.w, w4.w, fmaf(sa, ka.w, vi * k4.w));
            const float y = row16_sum((S.x * r4.x + S.y * r4.y) + (S.z * r4.z + S.w * r4.w));
            *(f32x4*)(p.out + O_WKVS + so) = S;
            if (cg == 0) YW[(size_t)row * D + h * WN + i] = y;
        }
    }
}

enum { OP_P0 = 0, OP_NORM_RET, OP_G_RETIN, OP_RET, OP_RETNORM, OP_G_RETOUT, OP_NORM_RW, OP_G_RWPROJ, OP_G_LORA2, OP_PREP, OP_WKV, OP_POST, OP_G_WO,
       OP_NORM_FFN, OP_G_UG, OP_CONV, OP_G_WD, OP_FINAL };
struct Ph { unsigned char op, layer; };
constexpr int NPH = 1 + 2 * (5 + 4) + 2 * (7 + 4) + 1;
__device__ __host__ inline Ph phase_at(int i) {
    if (i == 0) return Ph{OP_P0, 0};
    i -= 1;
    int l;
    if (i < 9) l = 0; else if (i < 20) { l = 1; i -= 9; } else if (i < 29) { l = 2; i -= 20; } else if (i < 40) { l = 3; i -= 29; } else return Ph{OP_FINAL, 0};
    int op = OP_FINAL;
    if ((l & 1) == 0) {
        switch (i) { case 0: op = OP_NORM_RET; break; case 1: op = OP_G_RETIN; break; case 2: op = OP_RET; break; case 3: op = OP_RETNORM; break; case 4: op = OP_G_RETOUT; break;
                     case 5: op = OP_NORM_FFN; break; case 6: op = OP_G_UG; break; case 7: op = OP_CONV; break; default: op = OP_G_WD; break; }
    } else {
        switch (i) { case 0: op = OP_NORM_RW; break; case 1: op = OP_G_RWPROJ; break; case 2: op = OP_G_LORA2; break; case 3: op = OP_PREP; break; case 4: op = OP_WKV; break; case 5: op = OP_POST; break; case 6: op = OP_G_WO; break;
                     case 7: op = OP_NORM_FFN; break; case 8: op = OP_G_UG; break; case 9: op = OP_CONV; break; default: op = OP_G_WD; break; }
    }
    return Ph{(unsigned char)op, (unsigned char)l};
}

__global__ void __launch_bounds__(NTHR, 2) mega(Params p, int lo, int hi) {
    extern __shared__ __attribute__((aligned(16))) unsigned char lds_raw[];
    LAS unsigned char* lds = (LAS unsigned char*)lds_raw;
    for (int ph = lo; ph < hi; ++ph) {
        int tid = threadIdx.x; asm volatile("" : "+v"(tid));
        const int lane = tid & 63, wave = __builtin_amdgcn_readfirstlane(tid >> 6);
        unsigned char* ws = p.ws;
        const Ph P = phase_at(ph);
        const int li = P.layer, jl = li >> 1;
        const bf16* gA = nullptr; const bf16* gB = nullptr; int gN = 0, gK = 0; EpiAny E{}; E.jl = jl; E.ws = ws; bool is_gemm = false;
        switch (P.op) {
        case OP_P0: ph_p0(p, lds, tid, lane, wave); break;
        case OP_NORM_RET: ph_norm(p, p.in[I_NMIX] + (size_t)li * D, 0, jl, lane, wave); break;
        case OP_NORM_FFN: ph_norm(p, p.in[I_NFFN] + (size_t)li * D, 0, jl, lane, wave); break;
        case OP_NORM_RW: ph_norm(p, p.in[I_NMIX] + (size_t)li * D, 1, jl, lane, wave); break;
        case OP_FINAL: ph_norm(p, p.in[I_NFIN], 2, 0, lane, wave); break;
        case OP_RETNORM: ph_ret_norm(p, jl, lane, wave); break;
        case OP_PREP: ph_rwkv_prep(p, jl, lane, wave); break;
        case OP_POST: ph_rwkv_post(p, jl, lane, wave); break;
        case OP_CONV: ph_conv(p, li, tid); break;
        case OP_RET: ph_ret_fast(p, jl, lds, tid, lane, wave); break;
        case OP_WKV: ph_wkv_fast(p, jl, lds, tid, lane, wave); break;
        case OP_G_RETIN: is_gemm = true; E.kind = EK_RETIN; E.perm = true;
            gA = (const bf16*)(ws + WS_H); gB = (const bf16*)(ws + WS_WIN + jl * SZ_WIN); gN = RWIN; gK = D; break;
        case OP_G_RETOUT: is_gemm = true; E.kind = EK_RESID; E.perm = false;
            gA = (const bf16*)(ws + WS_Y); gB = (const bf16*)(ws + WS_WOUT + jl * SZ_WOUT); gN = D; gK = RV; break;
        case OP_G_RWPROJ: is_gemm = true; E.kind = EK_RWPROJ; E.perm = false;
            gA = (const bf16*)(ws + WS_H); gB = (const bf16*)(ws + WS_WRW + jl * SZ_WRW); gN = NRW; gK = KRW; break;
        case OP_G_LORA2: is_gemm = true; E.kind = EK_F32; E.perm = false;
            gA = (const bf16*)(ws + WS_A2); gB = (const bf16*)(ws + WS_WL2 + jl * SZ_WL2); gN = (jl == 0 ? 3072 : 4096); gK = KL2; break;
        case OP_G_WO: is_gemm = true; E.kind = EK_RESID; E.perm = false;
            gA = (const bf16*)(ws + WS_Z); gB = (const bf16*)(ws + WS_WO + jl * SZ_WO); gN = D; gK = D; break;
        case OP_G_UG: is_gemm = true; E.kind = EK_UG; E.perm = true;
            gA = (const bf16*)(ws + WS_H); gB = (const bf16*)(ws + WS_WUG + li * SZ_WUG); gN = 2 * DFF; gK = D; break;
        case OP_G_WD: is_gemm = true; E.kind = EK_RESID; E.perm = false;
            gA = (const bf16*)(ws + WS_ACT); gB = (const bf16*)(ws + WS_WD + li * SZ_WD); gN = D; gK = DFF; break;
        default: break;
        }
        if (is_gemm) {
            pg8::Gemm g{gA, gB, M, gN, gK}; pg8::StaticOrder S; S.init(M, gN, (int)gridDim.x, (int)blockIdx.x);
            pg8::gemm_phase<EpiAny, pg8::StaticOrder, true, true>(lds, g, S, E);
        }
        if (ph + 1 < hi) cg::this_grid().sync();
    }
}

}

extern "C" void kernel_launch(void* const* d_in, const int* in_sizes, int n_in, void* d_out, int out_size, void* d_ws, size_t ws_size, hipStream_t stream) {
    static int grid = 0;
    if (grid == 0) {
        int dev = 0, cus = 0;
        if (n_in != N_IN || ws_size < WS_END) { fprintf(stderr, "kernel_launch: unexpected n_in %d / ws_size %zu (need %zu)\n", n_in, ws_size, (size_t)WS_END); grid = -1; return; }
        if (hipGetDevice(&dev) != hipSuccess || hipDeviceGetAttribute(&cus, hipDeviceAttributeMultiprocessorCount, dev) != hipSuccess) { grid = -1; return; }
        if (hipFuncSetAttribute((const void*)mega, hipFuncAttributeMaxDynamicSharedMemorySize, LDS_BYTES) != hipSuccess) { fprintf(stderr, "kernel_launch: hipFuncSetAttribute failed\n"); grid = -1; return; }
        int per_cu = 0;
        if (hipOccupancyMaxActiveBlocksPerMultiprocessor(&per_cu, (const void*)mega, NTHR, LDS_BYTES) != hipSuccess || per_cu < 1) { fprintf(stderr, "kernel_launch: occupancy query says %d\n", per_cu); (void)hipGetLastError(); }
        grid = cus * (per_cu >= 1 ? 1 : 1);
    }
    if (grid < 0) return;
    Params p{};
    for (int i = 0; i < N_IN; ++i) p.in[i] = (const float*)d_in[i];
    p.out = (float*)d_out; p.ws = (unsigned char*)d_ws;
    int lo = 0, hi = NPH;
    void* args[] = {(void*)&p, (void*)&lo, (void*)&hi};
    const hipError_t e = hipLaunchCooperativeKernel((const void*)mega, dim3(grid), dim3(NTHR), args, LDS_BYTES, stream);
    if (e != hipSuccess) fprintf(stderr, "kernel_launch: cooperative launch failed: %s (grid %d)\n", hipGetErrorString(e), grid);
    (void)in_sizes; (void)out_size;
}
```

```cpp
#include <hip/hip_runtime.h>
#include <hip/hip_cooperative_groups.h>
#include <cstdio>
#include <stdint.h>
namespace cg = cooperative_groups;
namespace pg8 {
#define PG8_LAS __attribute__((address_space(3)))
typedef unsigned short bf16_t;
typedef short bf16x8 __attribute__((ext_vector_type(8)));
typedef float f32x4 __attribute__((ext_vector_type(4)));
typedef unsigned u32x4 __attribute__((ext_vector_type(4)));
constexpr int BM = 256, BK = 64, HALF = 128, HTB = HALF * BK * 2  , STAGE_BYTES = 8 * HTB, NXCD = 8, WGM = 8;

__host__ __device__ __forceinline__ int lds_byte(int r, int c) { const int st = (r >> 4) * 2 + (c >> 5), rr = r & 15, cc = c & 31, ob = rr * 64 + cc * 2; return st * 1024 + (ob ^ (((ob >> 9) & 1) << 5)); }
__host__ __device__ __forceinline__ void stage_rc(int b, int& R, int& C) { const int st = b / 1024, sb = b % 1024, swz = sb ^ (((sb >> 9) & 1) << 5); R = (st >> 1) * 16 + swz / 64; C = (st & 1) * 32 + (swz % 64) / 2; }
__host__ __device__ __forceinline__ int perm32(int rho) { const int n = rho >> 4, i = rho & 15; return 8 * (i >> 2) + 4 * n + (i & 3); }

struct Unit { int pm, pn, ord; };
struct Gemm { const bf16_t* A; const bf16_t* Bt; int M, N, K; };

struct StaticOrder {
    int nM, nN, nwg, G, c;
    __host__ __device__ void init(int M, int N, int G_, int c_) { nM = M / BM; nN = N / BM; nwg = nM * nN; G = G_; c = c_; }
    __host__ __device__ bool next(int i, Unit& u) const {
        const long L = (long)i * G + c; if (L >= nwg) return false;
        int wgid = (int)L; { const int q = nwg / NXCD, r = nwg % NXCD, xcd = wgid % NXCD, off = wgid / NXCD; wgid = (xcd < r ? xcd * (q + 1) : r * (q + 1) + (xcd - r) * q) + off; }
        const int nig = WGM * nN, gid = wgid / nig, fm = gid * WGM, gsz = (nM - fm) < WGM ? (nM - fm) : WGM;
        u.pm = fm + ((wgid % nig) % gsz); u.pn = (wgid % nig) / gsz; u.ord = i; return true;
    }
    __device__ __forceinline__ void a_ready(const Unit&) const {}
    __device__ __forceinline__ void done(const Unit&) const {}
};
template <class Epi, class Sched, bool ALIGN_EPI = false, bool SP2 = false>
__device__ __forceinline__ void gemm_phase(PG8_LAS unsigned char* lds, const Gemm g, const Sched& S, const Epi& E) {
    int tid = threadIdx.x; asm volatile("" : "+v"(tid));
    const int wid = __builtin_amdgcn_readfirstlane(tid >> 6), lane = tid & 63, wr = wid >> 2, wc = wid & 3, fr = lane & 15, fq = lane >> 4;
    const int K = g.K, nt = K / BK;
    unsigned voffA[2], voffB[2];
#pragma unroll
    for (int i = 0; i < 2; ++i) { int R, C; stage_rc(tid * 16 + i * 8192, R, C); const int Rb = E.perm ? ((R & ~31) + perm32(R & 31)) : R;
        voffA[i] = (unsigned)(R * K + C) * 2u; voffB[i] = (unsigned)(Rb * K + C) * 2u; }
    const size_t kstep = (size_t)(BK * 2);
    const size_t hstep = (size_t)HALF * K * 2;
    const size_t tstep = 2 * hstep;
    const unsigned ldsw = (unsigned)wid * 1024u;
    const int aoff = lds_byte(wr * 64 + fr, fq * 8), boff = lds_byte(wc * 32 + fr, fq * 8);
#define PG8_SA(b, h) (((b) * 2 + (h)) * HTB)
#define PG8_SB(b, h) ((4 + (b) * 2 + (h)) * HTB)
#define PG8_STAGE(bufoff, gbase, voff) do { _Pragma("unroll") for (int _i = 0; _i < 2; ++_i) \
        __builtin_amdgcn_global_load_lds((const unsigned*)((const char*)(gbase) + (voff)[_i]), (PG8_LAS unsigned*)(lds + (bufoff) + ldsw + _i * 8192), 16, 0, 0); } while (0)
#define PG8_LDA(dst, b, h) do { _Pragma("unroll") for (int m = 0; m < 4; ++m) _Pragma("unroll") for (int k = 0; k < 2; ++k) dst[m][k] = *(const PG8_LAS bf16x8*)(lds + PG8_SA(b, h) + aoff + m * 2048 + k * 1024); } while (0)
#define PG8_LDB(dst, b, h) do { _Pragma("unroll") for (int n = 0; n < 2; ++n) _Pragma("unroll") for (int k = 0; k < 2; ++k) dst[n][k] = *(const PG8_LAS bf16x8*)(lds + PG8_SB(b, h) + boff + n * 2048 + k * 1024); } while (0)
#define PG8_MMA(ai, bj, At, Bt) do { __builtin_amdgcn_s_setprio(1); _Pragma("unroll") for (int m = 0; m < 4; ++m) _Pragma("unroll") for (int n = 0; n < 2; ++n) _Pragma("unroll") for (int k = 0; k < 2; ++k) \
        acc[ai][bj][m][n] = __builtin_amdgcn_mfma_f32_16x16x32_bf16(Bt[n][k], At[m][k], acc[ai][bj][m][n], 0, 0, 0); __builtin_amdgcn_s_setprio(0); } while (0)
#define PG8_WAIT_V(n) asm volatile("s_waitcnt vmcnt(" #n ")" ::: "memory")
#define PG8_WAIT_L(n) asm volatile("s_waitcnt lgkmcnt(" #n ")" ::: "memory")
#define PG8_BAR __builtin_amdgcn_s_barrier()
#define PG8_SCHED __builtin_amdgcn_sched_barrier(0)
    Unit cur, nxt; int ui = 0;
    if (!S.next(0, cur)) return;
    f32x4 acc[2][2][4][2];
#pragma unroll
    for (int a = 0; a < 2; ++a)
#pragma unroll
        for (int b = 0; b < 2; ++b)
#pragma unroll
            for (int m = 0; m < 4; ++m)
#pragma unroll
                for (int n = 0; n < 2; ++n) acc[a][b][m][n] = (f32x4){0.f, 0.f, 0.f, 0.f};
    bf16x8 At[4][2], B0[2][2], B1[2][2];
    const char* cA = (const char*)g.A + (size_t)cur.pm * tstep; const char* cB = (const char*)g.Bt + (size_t)cur.pn * tstep;
    S.a_ready(cur);
    if constexpr (SP2) {
        PG8_STAGE(PG8_SB(0, 0), cB, voffB); PG8_STAGE(PG8_SB(0, 1), cB + hstep, voffB); PG8_STAGE(PG8_SA(0, 0), cA, voffA); PG8_STAGE(PG8_SA(0, 1), cA + hstep, voffA);
        if (wr == 1) PG8_BAR;
        PG8_WAIT_V(2); PG8_BAR;
        PG8_STAGE(PG8_SB(1, 0), cB + kstep, voffB); PG8_STAGE(PG8_SA(1, 0), cA + kstep, voffA); PG8_STAGE(PG8_SB(1, 1), cB + hstep + kstep, voffB);
        PG8_WAIT_V(6); PG8_BAR;
    } else {
        PG8_STAGE(PG8_SB(0, 0), cB, voffB); PG8_STAGE(PG8_SA(0, 0), cA, voffA); PG8_STAGE(PG8_SB(0, 1), cB + hstep, voffB); PG8_STAGE(PG8_SA(0, 1), cA + hstep, voffA);
        if (wr == 1) PG8_BAR;
        PG8_WAIT_V(4); PG8_BAR;
        PG8_STAGE(PG8_SB(1, 0), cB + kstep, voffB); PG8_STAGE(PG8_SA(1, 0), cA + kstep, voffA); PG8_STAGE(PG8_SB(1, 1), cB + hstep + kstep, voffB);
        PG8_WAIT_V(6); PG8_BAR;
    }
    for (;;) {
        const bool has_next = S.next(ui + 1, nxt);
        const char* nA = has_next ? (const char*)g.A + (size_t)nxt.pm * tstep : cA; const char* nB = has_next ? (const char*)g.Bt + (size_t)nxt.pn * tstep : cB;
        for (int t = 0; t < nt; t += 2) {
            const bool last = (t == nt - 2);
            const char* a1 = cA + (size_t)(t + 1) * kstep;
            const char* a2 = last ? nA : cA + (size_t)(t + 2) * kstep; const char* b2 = last ? nB : cB + (size_t)(t + 2) * kstep;
            const char* a3 = a2 + kstep; const char* b3 = b2 + kstep;
            if (last && has_next) S.a_ready(nxt);
            if constexpr (SP2) {
            PG8_LDB(B0, 0, 0); PG8_LDB(B1, 0, 1); PG8_SCHED; PG8_LDA(At, 0, 0); PG8_STAGE(PG8_SA(1, 1), a1 + hstep, voffA);
            PG8_WAIT_V(8); PG8_WAIT_L(0); PG8_BAR; PG8_MMA(0, 0, At, B0); PG8_MMA(0, 1, At, B1); PG8_BAR; PG8_SCHED;
            PG8_LDA(At, 0, 1); PG8_STAGE(PG8_SB(0, 0), b2, voffB); PG8_STAGE(PG8_SB(0, 1), b2 + hstep, voffB); PG8_STAGE(PG8_SA(0, 0), a2, voffA);
            PG8_WAIT_V(8); PG8_WAIT_L(0); PG8_BAR; PG8_MMA(1, 0, At, B0); PG8_MMA(1, 1, At, B1); PG8_BAR; PG8_SCHED;
            PG8_LDB(B0, 1, 0); PG8_LDB(B1, 1, 1); PG8_SCHED; PG8_LDA(At, 1, 0); PG8_STAGE(PG8_SA(0, 1), a2 + hstep, voffA);
            PG8_WAIT_V(8); PG8_WAIT_L(0); PG8_BAR; PG8_MMA(0, 0, At, B0); PG8_MMA(0, 1, At, B1); PG8_BAR; PG8_SCHED;
            PG8_LDA(At, 1, 1); PG8_STAGE(PG8_SB(1, 0), b3, voffB); PG8_STAGE(PG8_SB(1, 1), b3 + hstep, voffB); PG8_STAGE(PG8_SA(1, 0), a3, voffA);
            PG8_WAIT_V(8); PG8_WAIT_L(0); PG8_BAR; PG8_MMA(1, 0, At, B0); PG8_MMA(1, 1, At, B1); PG8_BAR; PG8_SCHED;
            } else {
            PG8_LDB(B0, 0, 0); PG8_SCHED; PG8_LDA(At, 0, 0); PG8_STAGE(PG8_SA(1, 1), a1 + hstep, voffA);
            PG8_WAIT_L(8); PG8_BAR; PG8_WAIT_L(0); PG8_MMA(0, 0, At, B0); PG8_BAR; PG8_SCHED;
            PG8_LDB(B1, 0, 1); PG8_STAGE(PG8_SB(0, 0), b2, voffB);
            PG8_BAR; PG8_WAIT_L(0); PG8_MMA(0, 1, At, B1); PG8_BAR;
            PG8_LDA(At, 0, 1); PG8_STAGE(PG8_SA(0, 0), a2, voffA);
            PG8_BAR; PG8_WAIT_L(0); PG8_MMA(1, 0, At, B0); PG8_BAR; PG8_SCHED;
            PG8_STAGE(PG8_SB(0, 1), b2 + hstep, voffB);
            PG8_WAIT_V(6); PG8_BAR; PG8_MMA(1, 1, At, B1); PG8_BAR;
            PG8_LDB(B0, 1, 0); PG8_SCHED; PG8_LDA(At, 1, 0); PG8_STAGE(PG8_SA(0, 1), a2 + hstep, voffA);
            PG8_WAIT_L(8); PG8_BAR; PG8_WAIT_L(0); PG8_MMA(0, 0, At, B0); PG8_BAR; PG8_SCHED;
            PG8_LDB(B1, 1, 1); PG8_STAGE(PG8_SB(1, 0), b3, voffB);
            PG8_BAR; PG8_WAIT_L(0); PG8_MMA(0, 1, At, B1); PG8_BAR;
            PG8_LDA(At, 1, 1); PG8_STAGE(PG8_SA(1, 0), a3, voffA);
            PG8_BAR; PG8_WAIT_L(0); PG8_MMA(1, 0, At, B0); PG8_BAR; PG8_SCHED;
            PG8_STAGE(PG8_SB(1, 1), b3 + hstep, voffB);
            PG8_WAIT_V(6); PG8_BAR; PG8_MMA(1, 1, At, B1); PG8_BAR;
            }
        }
        if constexpr (ALIGN_EPI) { if (wr == 0) PG8_BAR; }
        if constexpr (!Epi::AFTER_DRAIN) { E(acc, cur, wr, wc, fr, fq); S.done(cur); }
        if (!has_next) break;
#pragma unroll
        for (int a = 0; a < 2; ++a)
#pragma unroll
            for (int b = 0; b < 2; ++b)
#pragma unroll
                for (int m = 0; m < 4; ++m)
#pragma unroll
                    for (int n = 0; n < 2; ++n) acc[a][b][m][n] = (f32x4){0.f, 0.f, 0.f, 0.f};
        cur = nxt; cA = nA; cB = nB; ++ui;
        if constexpr (ALIGN_EPI) { if (wr == 1) PG8_BAR; }
    }
    PG8_WAIT_V(0);
    if constexpr (!ALIGN_EPI) { if (wr == 0) PG8_BAR; }
    PG8_BAR;
    if constexpr (Epi::AFTER_DRAIN) { E.fused(acc, cur, wr, wc, fr, fq, lds, wid, lane); S.done(cur); }
#undef PG8_SA
#undef PG8_SB
#undef PG8_STAGE
#undef PG8_LDA
#undef PG8_LDB
#undef PG8_MMA
#undef PG8_WAIT_V
#undef PG8_WAIT_L
#undef PG8_BAR
#undef PG8_SCHED
}
}

namespace {
constexpr int D = 1024, BATCH = 8, SEQ = 2048, NMETA = 16, TP = SEQ + NMETA, MP = BATCH * TP, SB = 128, M = MP + SB;
constexpr int DEPTH = 4, RH = 4, RDK = 256, RDV = 512, RV = 2048, RWIN = 6144;
constexpr int WH = 16, WN = 64, LW = 64, LA = 64, LV = 32, LG = 160, DFF = 2816;
constexpr int NRW = 3584, KRW = 2048, KL2 = 384, NL2 = 4096;
constexpr float PAST_POS = 16384.f;
constexpr int NWAVES = 8, NTHR = 512;
constexpr int LDS_BYTES = 147456;

constexpr size_t O_YP = 0;
constexpr size_t O_YS = O_YP + (size_t)BATCH * SEQ * D;
constexpr size_t O_RETP = O_YS + (size_t)SB * D;
constexpr size_t O_WKVP = O_RETP + (size_t)2 * BATCH * RH * RDK * RDV;
constexpr size_t O_SHP = O_WKVP + (size_t)2 * BATCH * WH * WN * WN;
constexpr size_t O_CVP = O_SHP + (size_t)2 * BATCH * D;
constexpr size_t O_RETS = O_CVP + (size_t)DEPTH * BATCH * 2 * DFF;
constexpr size_t O_WKVS = O_RETS + (size_t)2 * SB * RH * RDK * RDV;
constexpr size_t O_SHS = O_WKVS + (size_t)2 * SB * WH * WN * WN;
constexpr size_t O_CVS = O_SHS + (size_t)2 * SB * D;

enum { I_XP = 0, I_XS, I_SRET, I_SWKV, I_SSHIFT, I_SCONV, I_META, I_NMIX, I_NFFN, I_NFIN, I_RWIN, I_RGN, I_RWOUT, I_MU, I_WRKV, I_W0, I_W1, I_W2,
       I_A0, I_A1, I_A2, I_V0, I_V1, I_V2, I_G1, I_G2, I_KK, I_KA, I_RK, I_LNW, I_LNB, I_WO, I_WUG, I_CW, I_CB, I_WD, N_IN };

constexpr size_t al256(size_t x) { return (x + 255) & ~(size_t)255; }
constexpr size_t WS_CTL = 0;
constexpr size_t WS_CS = 1u << 20;
constexpr size_t WS_WIN = 4u << 20;
constexpr size_t SZ_WIN = (size_t)RWIN * D * 2;
constexpr size_t WS_WOUT = WS_WIN + 2 * SZ_WIN;
constexpr size_t SZ_WOUT = (size_t)D * RV * 2;
constexpr size_t WS_WRW = WS_WOUT + 2 * SZ_WOUT;
constexpr size_t SZ_WRW = (size_t)NRW * KRW * 2;
constexpr size_t WS_WL2 = WS_WRW + 2 * SZ_WRW;
constexpr size_t SZ_WL2 = (size_t)NL2 * KL2 * 2;
constexpr size_t WS_WO = WS_WL2 + 2 * SZ_WL2;
constexpr size_t SZ_WO = (size_t)D * D * 2;
constexpr size_t WS_WUG = WS_WO + 2 * SZ_WO;
constexpr size_t SZ_WUG = (size_t)2 * DFF * D * 2;
constexpr size_t WS_WD = WS_WUG + 4 * SZ_WUG;
constexpr size_t SZ_WD = (size_t)D * DFF * 2;
constexpr size_t WS_X = al256(WS_WD + 4 * SZ_WD);
constexpr size_t SZ_MD4 = (size_t)M * D * 4;
constexpr size_t WS_H = WS_X + SZ_MD4;
constexpr size_t WS_VF = WS_H + SZ_MD4;
constexpr size_t WS_REG = WS_VF + SZ_MD4;
constexpr size_t WS_QK = WS_REG;
constexpr size_t WS_V = WS_QK + SZ_MD4;
constexpr size_t WS_SG = WS_V + SZ_MD4;
constexpr size_t WS_O = WS_SG + SZ_MD4;
constexpr size_t WS_Y = WS_O + 2 * SZ_MD4;
constexpr size_t WS_R = WS_REG;
constexpr size_t WS_K = WS_R + SZ_MD4;
constexpr size_t WS_VB = WS_K + SZ_MD4;
constexpr size_t WS_WDEC = WS_VB + SZ_MD4;
constexpr size_t WS_NKK = WS_WDEC + SZ_MD4;
constexpr size_t WS_KKA = WS_NKK + SZ_MD4;
constexpr size_t WS_YW = WS_KKA + SZ_MD4;
constexpr size_t WS_L2 = WS_YW + SZ_MD4;
constexpr size_t WS_A2 = WS_L2 + 4 * SZ_MD4;
constexpr size_t WS_Z = al256(WS_A2 + (size_t)M * KL2 * 2);
constexpr size_t WS_RW_END = WS_Z + (size_t)M * D * 2;
constexpr size_t SZ_FF2 = (size_t)M * DFF * 2;
constexpr size_t WS_U = WS_REG;
constexpr size_t WS_G = al256(WS_U + SZ_FF2);
constexpr size_t WS_ACT = al256(WS_G + SZ_FF2);
constexpr size_t WS_XB = al256(WS_RW_END);
constexpr size_t WS_SS = al256(WS_XB + (size_t)M * D * 2);
constexpr size_t WS_END = al256(WS_SS + (size_t)8 * M * 16 * 4);

#define LAS __attribute__((address_space(3)))
typedef unsigned short bf16;
typedef unsigned v4u __attribute__((ext_vector_type(4)));
typedef unsigned v2u __attribute__((ext_vector_type(2)));
using pg8::f32x4;
using pg8::Unit;
using pg8::bf16x8;

struct Params { const float* in[N_IN]; float* out; unsigned char* ws; };

__device__ __forceinline__ unsigned cvt_pk_bf16(float lo, float hi) { unsigned r; asm("v_cvt_pk_bf16_f32 %0, %1, %2" : "=v"(r) : "v"(lo), "v"(hi)); return r; }
__device__ __forceinline__ float bf_lo(unsigned w) { return __uint_as_float(w << 16); }
__device__ __forceinline__ float bf_hi(unsigned w) { return __uint_as_float(w & 0xffff0000u); }
__device__ __forceinline__ void unpack8(const v4u w, float (&f)[8]) { f[0] = bf_lo(w.x); f[1] = bf_hi(w.x); f[2] = bf_lo(w.y); f[3] = bf_hi(w.y); f[4] = bf_lo(w.z); f[5] = bf_hi(w.z); f[6] = bf_lo(w.w); f[7] = bf_hi(w.w); }
__device__ __forceinline__ v4u pack8(const float (&f)[8]) { v4u w; w.x = cvt_pk_bf16(f[0], f[1]); w.y = cvt_pk_bf16(f[2], f[3]); w.z = cvt_pk_bf16(f[4], f[5]); w.w = cvt_pk_bf16(f[6], f[7]); return w; }
__device__ __forceinline__ float wave_sum(float v) {
#pragma unroll
    for (int o = 1; o < 64; o <<= 1) v += __shfl_xor(v, o);
    return v;
}
__device__ __forceinline__ float sigmoidf_(float x) { return 1.f / (1.f + __expf(-x)); }
__device__ __forceinline__ float siluf_(float x) { return x / (1.f + __expf(-x)); }
__device__ __forceinline__ float tanhf_(float x) { return 1.f - 2.f / (1.f + __expf(2.f * x)); }

__device__ __forceinline__ float row_rstd(const unsigned char* ws, int slot, int row) {
    const f32x4* q = (const f32x4*)((const float*)(ws + WS_SS) + ((size_t)slot * M + row) * 16);
    const f32x4 a = q[0], b = q[1], c = q[2], d = q[3];
    const float ss = (((a.x + a.y) + (a.z + a.w)) + ((b.x + b.y) + (b.z + b.w))) + (((c.x + c.y) + (c.z + c.w)) + ((d.x + d.y) + (d.z + d.w)));
    return rsqrtf(ss * (1.f / D) + 1e-6f);
}
enum { EK_RETIN = 0, EK_RESID, EK_UG, EK_RWPROJ, EK_F32 };
struct EpiAny {
    static constexpr bool AFTER_DRAIN = false;
    int kind; bool perm; int jl; unsigned char* ws; int slot; const LAS float* rtab; float amul;
    __device__ __forceinline__ void operator()(const f32x4 (&acc)[2][2][4][2], const Unit& u, int wr, int wc, int fr, int fq) const {
        const int row0 = u.pm * 256 + wr * 64 + fr;
        if (kind == EK_RETIN) {
            bf16* QK = (bf16*)(ws + WS_QK); bf16* V = (bf16*)(ws + WS_V); bf16* SG = (bf16*)(ws + WS_SG); const float* CS = (const float*)(ws + WS_CS);
            const int cw = wc * 32 + 8 * fq;
            if (u.pn < 8) {
                const bool isk = u.pn >= 4; const int h = u.pn & 3; const float sc = isk ? 0.0625f : 1.f;
                bf16* base = QK + (isk ? 1024 : 0) + h * 256 + cw;
#pragma unroll
                for (int ai = 0; ai < 2; ++ai) {
                    f32x4 tt[4][4];
#pragma unroll
                    for (int m = 0; m < 4; ++m) { const int row = row0 + ai * 128 + m * 16; const int pi = row < MP ? row % TP : TP;
                        const f32x4* cs = (const f32x4*)(CS + ((size_t)pi * 128 + cw) * 2);
#pragma unroll
                        for (int q4 = 0; q4 < 4; ++q4) tt[m][q4] = cs[q4]; }
#pragma unroll
                    for (int m = 0; m < 4; ++m) {
                        const int row = row0 + ai * 128 + m * 16;
                        const float rs = rtab[u.ord * 256 + (row - u.pm * 256)] * sc;
                        const f32x4 t0 = tt[m][0], t1 = tt[m][1], t2 = tt[m][2], t3 = tt[m][3];
                        const float c[8] = {t0.x, t0.z, t1.x, t1.z, t2.x, t2.z, t3.x, t3.z}, s[8] = {t0.y, t0.w, t1.y, t1.w, t2.y, t2.w, t3.y, t3.w};
                        float o1[8], o2[8];
#pragma unroll
                        for (int n = 0; n < 2; ++n)
#pragma unroll
                            for (int j = 0; j < 4; ++j) {
                                const float x1 = acc[ai][0][m][n][j], x2 = acc[ai][1][m][n][j];
                                o1[n * 4 + j] = (x1 * c[n * 4 + j] - x2 * s[n * 4 + j]) * rs;
                                o2[n * 4 + j] = (x1 * s[n * 4 + j] + x2 * c[n * 4 + j]) * rs;
                            }
                        bf16* rp = base + (size_t)row * 2048;
                        *(v4u*)rp = pack8(o1); *(v4u*)(rp + 128) = pack8(o2);
                    }
                    asm volatile("" ::: "memory");
                }
            } else {
                const bool isg = u.pn >= 16;
                bf16* base = (isg ? SG : V) + ((u.pn - (isg ? 16 : 8)) * 256) + cw;
#pragma unroll
                for (int ai = 0; ai < 2; ++ai)
#pragma unroll
                    for (int m = 0; m < 4; ++m) {
                        bf16* rp = base + (size_t)(row0 + ai * 128 + m * 16) * 2048;
                        const float rs = rtab[u.ord * 256 + (wr * 64 + fr + ai * 128 + m * 16)];
#pragma unroll
                        for (int bj = 0; bj < 2; ++bj) {
                            float o[8];
#pragma unroll
                            for (int n = 0; n < 2; ++n)
#pragma unroll
                                for (int j = 0; j < 4; ++j) { const float x = acc[ai][bj][m][n][j] * rs; o[n * 4 + j] = isg ? siluf_(x) : x; }
                            *(v4u*)(rp + bj * 128) = pack8(o);
                        }
                    }
            }
        } else if (kind == EK_RESID) {
            float* X = (float*)(ws + WS_X);
            const int col0 = u.pn * 256 + wc * 32 + 4 * fq;
#pragma unroll
            for (int am = 0; am < 4; ++am) { const int ai = am >> 1, mb = (am & 1) * 2;
                f32x4 xv[2][2][2];
#pragma unroll
                for (int mm = 0; mm < 2; ++mm) { const int m = mb + mm; const float* rp = X + (size_t)(row0 + ai * 128 + m * 16) * D + col0;
#pragma unroll
                    for (int bj = 0; bj < 2; ++bj)
#pragma unroll
                        for (int n = 0; n < 2; ++n) xv[mm][bj][n] = *(const f32x4*)(rp + bj * 128 + n * 16); }
#pragma unroll
                for (int mm = 0; mm < 2; ++mm) { const int m = mb + mm;
                    const int row = row0 + ai * 128 + m * 16;
                    float* rp = X + (size_t)row * D + col0; bf16* xb = (bf16*)(ws + WS_XB) + (size_t)row * D + col0;
                    float ssq = 0.f;
#pragma unroll
                    for (int bj = 0; bj < 2; ++bj)
#pragma unroll
                        for (int n = 0; n < 2; ++n) { const f32x4 v = xv[mm][bj][n] + acc[ai][bj][m][n] * amul; *(f32x4*)(rp + bj * 128 + n * 16) = v;
                            if (slot >= 0) { ssq += (v.x * v.x + v.y * v.y) + (v.z * v.z + v.w * v.w); v2u w; w.x = cvt_pk_bf16(v.x, v.y); w.y = cvt_pk_bf16(v.z, v.w); *(v2u*)(xb + bj * 128 + n * 16) = w; } }
                    if (slot >= 0) { ssq += __shfl_xor(ssq, 16); ssq += __shfl_xor(ssq, 32); if (fq == 0) ((float*)(ws + WS_SS))[((size_t)slot * M + row) * 16 + u.pn * 4 + wc] = ssq; }
                }
                asm volatile("" ::: "memory");
            }
        } else if (kind == EK_UG) {
            bf16* U = (bf16*)(ws + WS_U); bf16* G = (bf16*)(ws + WS_G);
            const int f0 = u.pn * 128 + wc * 32 + 8 * fq;
#pragma unroll
            for (int ai = 0; ai < 2; ++ai)
#pragma unroll
                for (int m = 0; m < 4; ++m) {
                    const size_t ro = (size_t)(row0 + ai * 128 + m * 16) * DFF + f0;
                    const float rs = rtab[u.ord * 256 + (wr * 64 + fr + ai * 128 + m * 16)];
#pragma unroll
                    for (int bj = 0; bj < 2; ++bj) {
                        float o[8];
#pragma unroll
                        for (int n = 0; n < 2; ++n)
#pragma unroll
                            for (int j = 0; j < 4; ++j) o[n * 4 + j] = acc[ai][bj][m][n][j] * rs;
                        *(v4u*)((bj ? G : U) + ro) = pack8(o);
                    }
                }
        } else if (kind == EK_RWPROJ) {
            const int cl = wc * 32 + 4 * fq;
            if (u.pn < 12) {
                float* dst = (float*)(ws + (u.pn < 4 ? WS_R : (u.pn < 8 ? WS_K : (jl == 0 ? WS_VF : WS_VB)))) + (u.pn & 3) * 256 + cl;
#pragma unroll
                for (int ai = 0; ai < 2; ++ai)
#pragma unroll
                    for (int m = 0; m < 4; ++m) {
                        float* rp = dst + (size_t)(row0 + ai * 128 + m * 16) * D;
#pragma unroll
                        for (int bj = 0; bj < 2; ++bj)
#pragma unroll
                            for (int n = 0; n < 2; ++n) *(f32x4*)(rp + bj * 128 + n * 16) = acc[ai][bj][m][n];
                    }
            } else {
                bf16* A2 = (bf16*)(ws + WS_A2);
#pragma unroll
                for (int bj = 0; bj < 2; ++bj)
#pragma unroll
                    for (int n = 0; n < 2; ++n) {
                        const int c = (u.pn - 12) * 256 + bj * 128 + cl + 16 * n;
                        if (c < KL2) {
                            const int kd = c < 64 ? 1 : ((c >= 128 && c < 288) ? 2 : 0);
#pragma unroll
                            for (int ai = 0; ai < 2; ++ai)
#pragma unroll
                                for (int m = 0; m < 4; ++m) {
                                    f32x4 v = acc[ai][bj][m][n];
                                    if (kd == 1) { v.x = tanhf_(v.x); v.y = tanhf_(v.y); v.z = tanhf_(v.z); v.w = tanhf_(v.w); }
                                    else if (kd == 2) { v.x = sigmoidf_(v.x); v.y = sigmoidf_(v.y); v.z = sigmoidf_(v.z); v.w = sigmoidf_(v.w); }
                                    v2u w; w.x = cvt_pk_bf16(v.x, v.y); w.y = cvt_pk_bf16(v.z, v.w);
                                    *(v2u*)(A2 + (size_t)(row0 + ai * 128 + m * 16) * KL2 + c) = w;
                                }
                        }
                    }
            }
        } else {
            float* C = (float*)(ws + WS_L2); constexpr int ldc = NL2;
            const int col0 = u.pn * 256 + wc * 32 + 4 * fq;
#pragma unroll
            for (int ai = 0; ai < 2; ++ai)
#pragma unroll
                for (int m = 0; m < 4; ++m) {
                    float* rp = C + (size_t)(row0 + ai * 128 + m * 16) * ldc + col0;
#pragma unroll
                    for (int bj = 0; bj < 2; ++bj)
#pragma unroll
                        for (int n = 0; n < 2; ++n) *(f32x4*)(rp + bj * 128 + n * 16) = acc[ai][bj][m][n];
                }
        }
    }
};

constexpr int MT0 = 16384;
__device__ __forceinline__ void tail_resid(const bf16* __restrict__ A, const bf16* __restrict__ Bt, int K, unsigned char* ws, int slot, float amul, LAS unsigned char* lds, int lane, int wave) {
    const int fr = lane & 15, fq = lane >> 4;
    float* X = (float*)(ws + WS_X);
    const int kw = K >> 3;
    for (int job = blockIdx.x; job < 16 * 16; job += gridDim.x) {
        const int rs = job >> 4, cs = job & 15;
        const bf16* ap = A + (size_t)(MT0 + 16 * rs + fr) * K + wave * kw + 8 * fq;
        const bf16* bp = Bt + (size_t)(64 * cs + fr) * K + wave * kw + 8 * fq;
        f32x4 acc[4];
#pragma unroll
        for (int t = 0; t < 4; ++t) acc[t] = (f32x4){0.f, 0.f, 0.f, 0.f};
#pragma unroll 4
        for (int k0 = 0; k0 < kw; k0 += 32) {
            const bf16x8 af = *(const bf16x8*)(ap + k0);
#pragma unroll
            for (int t = 0; t < 4; ++t) { const bf16x8 bf = *(const bf16x8*)(bp + (size_t)(16 * t) * K + k0); acc[t] = __builtin_amdgcn_mfma_f32_16x16x32_bf16(bf, af, acc[t], 0, 0, 0); }
        }
        __syncthreads();
#pragma unroll
        for (int t = 0; t < 4; ++t) *(LAS f32x4*)(lds + ((wave * 4 + t) * 64 + lane) * 16) = acc[t];
        __syncthreads();
        if (wave == 0) {
#pragma unroll
            for (int t = 0; t < 4; ++t) { f32x4 s = acc[t];
#pragma unroll
                for (int w = 1; w < 8; ++w) s += *(LAS f32x4*)(lds + ((w * 4 + t) * 64 + lane) * 16);
                acc[t] = s; }
            const int row = MT0 + 16 * rs + fr;
            float* rp = X + (size_t)row * D + 64 * cs + 4 * fq; bf16* xb = (bf16*)(ws + WS_XB) + (size_t)row * D + 64 * cs + 4 * fq;
            float ssq = 0.f;
#pragma unroll
            for (int t = 0; t < 4; ++t) { const f32x4 v = *(const f32x4*)(rp + 16 * t) + acc[t] * amul; *(f32x4*)(rp + 16 * t) = v;
                if (slot >= 0) { ssq += (v.x * v.x + v.y * v.y) + (v.z * v.z + v.w * v.w); v2u w; w.x = cvt_pk_bf16(v.x, v.y); w.y = cvt_pk_bf16(v.z, v.w); *(v2u*)(xb + 16 * t) = w; } }
            if (slot >= 0) { ssq += __shfl_xor(ssq, 16); ssq += __shfl_xor(ssq, 32); if (fq == 0) ((float*)(ws + WS_SS))[((size_t)slot * M + row) * 16 + cs] = ssq; }
        }
    }
}

__device__ __forceinline__ void tr_item(const float* __restrict__ W, int ldw, int k0, int n0, bf16* __restrict__ WT, int ldt, int drow, const float* __restrict__ mu, LAS float* scr, int lane, const float* __restrict__ gs = nullptr) {
#pragma unroll 8
    for (int i = 0; i < 32; ++i) { const int kk = 2 * i + (lane >> 5); scr[kk * 33 + (lane & 31)] = W[(size_t)(k0 + kk) * ldw + n0 + (lane & 31)]; }
    asm volatile("s_waitcnt lgkmcnt(0)" ::: "memory");
    const int c = lane & 7;
    float mv[8];
    if (mu) {
#pragma unroll
        for (int e = 0; e < 8; ++e) mv[e] = mu[k0 + 8 * c + e];
    } else if (gs) {
#pragma unroll
        for (int e = 0; e < 8; ++e) mv[e] = gs[k0 + 8 * c + e];
    }
#pragma unroll
    for (int j = 0; j < 4; ++j) {
        const int n = (lane >> 3) + 8 * j; const LAS float* s = scr + (8 * c) * 33 + n;
        float f[8];
#pragma unroll
        for (int e = 0; e < 8; ++e) f[e] = s[e * 33];
        bf16* dp = WT + (size_t)(drow + n) * ldt + k0 + 8 * c;
        if (mu) {
            float f1[8], f2[8];
#pragma unroll
            for (int e = 0; e < 8; ++e) { f1[e] = f[e] * (1.f - mv[e]); f2[e] = f[e] * mv[e]; }
            *(v4u*)dp = pack8(f1); *(v4u*)(dp + 1024) = pack8(f2);
        } else { if (gs) {
#pragma unroll
            for (int e = 0; e < 8; ++e) f[e] *= mv[e]; }
            *(v4u*)dp = pack8(f); }
    }
    asm volatile("s_waitcnt lgkmcnt(0)" ::: "memory");
}

__device__ __forceinline__ void ph_p0(const Params& p, LAS unsigned char* lds, int tid, int lane, int wave) {
    unsigned char* ws = p.ws;
    LAS float* scr = (LAS float*)(lds + wave * 16384);
    const int gw = blockIdx.x * NWAVES + wave, NGW = gridDim.x * NWAVES;
    constexpr int C_WIN = 2 * 16 * 192, C_WOUT = 2 * 32 * 32, C_RKV = 2 * 3 * 512, C_W1 = 2 * 32, C_A1 = 2 * 32, C_G1 = 2 * 80, C_V1 = 16, C_WO = 2 * 512, C_WUG = 4 * 16 * 176, C_WD = 4 * 44 * 32;
    constexpr int NITEMS = C_WIN + C_WOUT + C_RKV + C_W1 + C_A1 + C_G1 + C_V1 + C_WO + C_WUG + C_WD;
    for (int it = gw; it < NITEMS; it += NGW) {
        int r = it;
        if (r < C_WIN) { const int j = r / 3072, q = r % 3072, kb = q / 192, nb = q % 192;
            tr_item(p.in[I_RWIN] + (size_t)j * D * RWIN, RWIN, 64 * kb, 32 * nb, (bf16*)(ws + WS_WIN + j * SZ_WIN), D, 32 * nb, nullptr, scr, lane, p.in[I_NMIX] + (size_t)(2 * j) * D); continue; }
        r -= C_WIN;
        if (r < C_WOUT) { const int j = r / 1024, q = r % 1024, kb = q / 32, nb = q % 32;
            tr_item(p.in[I_RWOUT] + (size_t)j * RV * D, D, 64 * kb, 32 * nb, (bf16*)(ws + WS_WOUT + j * SZ_WOUT), RV, 32 * nb, nullptr, scr, lane); continue; }
        r -= C_WOUT;
        if (r < C_RKV) { const int j = r / 1536, q = r % 1536, s = q / 512, q2 = q % 512, kb = q2 / 32, nb = q2 % 32, c = (s == 0 ? 0 : (s == 1 ? 2 : 3));
            tr_item(p.in[I_WRKV] + (size_t)(j * 3 + s) * D * D, D, 64 * kb, 32 * nb, (bf16*)(ws + WS_WRW + j * SZ_WRW), KRW, s * 1024 + 32 * nb, p.in[I_MU] + (size_t)(j * 6 + c) * D, scr, lane); continue; }
        r -= C_RKV;
        if (r < C_W1) { const int j = r / 32, q = r % 32, kb = q / 2, nb = q % 2;
            tr_item(p.in[I_W1] + (size_t)j * D * LW, LW, 64 * kb, 32 * nb, (bf16*)(ws + WS_WRW + j * SZ_WRW), KRW, 3072 + 32 * nb, p.in[I_MU] + (size_t)(j * 6 + 1) * D, scr, lane); continue; }
        r -= C_W1;
        if (r < C_A1) { const int j = r / 32, q = r % 32, kb = q / 2, nb = q % 2;
            tr_item(p.in[I_A1] + (size_t)j * D * LA, LA, 64 * kb, 32 * nb, (bf16*)(ws + WS_WRW + j * SZ_WRW), KRW, 3136 + 32 * nb, p.in[I_MU] + (size_t)(j * 6 + 4) * D, scr, lane); continue; }
        r -= C_A1;
        if (r < C_G1) { const int j = r / 80, q = r % 80, kb = q / 5, nb = q % 5;
            tr_item(p.in[I_G1] + (size_t)j * D * LG, LG, 64 * kb, 32 * nb, (bf16*)(ws + WS_WRW + j * SZ_WRW), KRW, 3200 + 32 * nb, p.in[I_MU] + (size_t)(j * 6 + 5) * D, scr, lane); continue; }
        r -= C_G1;
        if (r < C_V1) { const int kb = r;
            tr_item(p.in[I_V1], LV, 64 * kb, 0, (bf16*)(ws + WS_WRW + 1 * SZ_WRW), KRW, 3360, p.in[I_MU] + (size_t)(1 * 6 + 3) * D, scr, lane); continue; }
        r -= C_V1;
        if (r < C_WO) { const int j = r / 512, q = r % 512, kb = q / 32, nb = q % 32;
            tr_item(p.in[I_WO] + (size_t)j * D * D, D, 64 * kb, 32 * nb, (bf16*)(ws + WS_WO + j * SZ_WO), D, 32 * nb, nullptr, scr, lane); continue; }
        r -= C_WO;
        if (r < C_WUG) { const int i = r / 2816, q = r % 2816, kb = q / 176, nb = q % 176, n0 = 32 * nb;
            const int drow = n0 < DFF ? 256 * (n0 / 128) + (n0 % 128) : 256 * ((n0 - DFF) / 128) + 128 + ((n0 - DFF) % 128);
            tr_item(p.in[I_WUG] + (size_t)i * D * 2 * DFF, 2 * DFF, 64 * kb, n0, (bf16*)(ws + WS_WUG + i * SZ_WUG), D, drow, nullptr, scr, lane, p.in[I_NFFN] + (size_t)i * D); continue; }
        r -= C_WUG;
        { const int i = r / 1408, q = r % 1408, kb = q / 32, nb = q % 32;
            tr_item(p.in[I_WD] + (size_t)i * DFF * D, D, 64 * kb, 32 * nb, (bf16*)(ws + WS_WD + i * SZ_WD), DFF, 32 * nb, nullptr, scr, lane); }
    }
    const size_t gt = (size_t)blockIdx.x * NTHR + tid, GT = (size_t)gridDim.x * NTHR;
    for (size_t i = gt; i < (size_t)(224 + 192) * (KRW / 8); i += GT) {
        const int rr = (int)(i / (KRW / 8)), c8 = (int)(i % (KRW / 8));
        const int j = rr < 224 ? 0 : 1, row = rr < 224 ? 3360 + rr : 3392 + (rr - 224);
        *(v4u*)((bf16*)(ws + WS_WRW + j * SZ_WRW) + (size_t)row * KRW + c8 * 8) = (v4u){0u, 0u, 0u, 0u};
    }
    for (size_t i = gt; i < (size_t)2 * NL2 * KL2; i += GT) {
        const int j = (int)(i / ((size_t)NL2 * KL2)); const int rem = (int)(i % ((size_t)NL2 * KL2)); const int n = rem / KL2, k = rem % KL2, grp = n >> 10, nn = n & 1023;
        float v = 0.f;
        if (grp == 0) { if (k < 64) v = p.in[I_W2][((size_t)j * LW + k) * D + nn]; }
        else if (grp == 1) { if (k >= 64 && k < 128) v = p.in[I_A2][((size_t)j * LA + (k - 64)) * D + nn]; }
        else if (grp == 2) { if (k >= 128 && k < 288) v = p.in[I_G2][((size_t)j * LG + (k - 128)) * D + nn]; }
        else { if (j == 1 && k >= 288 && k < 320) v = p.in[I_V2][((size_t)(k - 288)) * D + nn]; }
        ((bf16*)(ws + WS_WL2 + j * SZ_WL2))[(size_t)n * KL2 + k] = (bf16)(cvt_pk_bf16(v, 0.f) & 0xffffu);
    }
    for (size_t i = gt; i < (size_t)(TP + 1) * 128; i += GT) {
        const int pi = (int)(i >> 7), mi = (int)(i & 127);
        const float pos = pi < TP ? (float)pi : PAST_POS;
        const float inv = 1.0f / powf(10000.0f, (float)mi / 127.0f);
        float s, c; sincosf(pos * inv, &s, &c);
        ((float2*)(ws + WS_CS))[i] = make_float2(c, s);
    }
    float* X = (float*)(ws + WS_X); bf16* XB = (bf16*)(ws + WS_XB);
    for (int r = gw; r < M; r += NGW) {
        const float* src;
        if (r < MP) { const int b = r / TP, t = r % TP; src = t < NMETA ? p.in[I_META] + (size_t)t * D : p.in[I_XP] + ((size_t)b * SEQ + (t - NMETA)) * D; }
        else src = p.in[I_XS] + (size_t)(r - MP) * D;
        float ss = 0.f;
#pragma unroll
        for (int j = 0; j < 2; ++j) { const int c0 = 512 * j + 8 * lane;
            const f32x4 a4 = *(const f32x4*)(src + c0), b4 = *(const f32x4*)(src + c0 + 4);
            *(f32x4*)(X + (size_t)r * D + c0) = a4; *(f32x4*)(X + (size_t)r * D + c0 + 4) = b4;
            const float f[8] = {a4.x, a4.y, a4.z, a4.w, b4.x, b4.y, b4.z, b4.w};
#pragma unroll
            for (int e = 0; e < 8; ++e) ss += f[e] * f[e];
            *(v4u*)(XB + (size_t)r * D + c0) = pack8(f); }
        ss = wave_sum(ss);
        if (lane < 16) ((float*)(ws + WS_SS))[(size_t)r * 16 + lane] = lane == 0 ? ss : 0.f;
    }
}

__device__ __forceinline__ void ph_norm(const Params& p, const float* __restrict__ g, int mode, int jl, int lane, int wave) {
    const float* X = (const float*)(p.ws + WS_X); bf16* H = (bf16*)(p.ws + WS_H);
    const int gw = blockIdx.x * NWAVES + wave, NGW = gridDim.x * NWAVES;
    for (int row = gw; row < M; row += NGW) {
        const float* xr = X + (size_t)row * D;
        float v[2][8]; float ss = 0.f;
#pragma unroll
        for (int j = 0; j < 2; ++j) {
            const f32x4 a = *(const f32x4*)(xr + 512 * j + 8 * lane), b = *(const f32x4*)(xr + 512 * j + 8 * lane + 4);
            v[j][0] = a.x; v[j][1] = a.y; v[j][2] = a.z; v[j][3] = a.w; v[j][4] = b.x; v[j][5] = b.y; v[j][6] = b.z; v[j][7] = b.w;
#pragma unroll
            for (int e = 0; e < 8; ++e) ss += v[j][e] * v[j][e];
        }
        ss = wave_sum(ss);
        const float rstd = rsqrtf(ss * (1.f / D) + 1e-6f);
        const bool prompt = row < MP; const int b = prompt ? row / TP : 0, t = prompt ? row % TP : 0;
#pragma unroll
        for (int j = 0; j < 2; ++j) {
            const int c0 = 512 * j + 8 * lane;
            const f32x4 ga = *(const f32x4*)(g + c0), gb = *(const f32x4*)(g + c0 + 4);
            float o[8];
            o[0] = v[j][0] * rstd * ga.x; o[1] = v[j][1] * rstd * ga.y; o[2] = v[j][2] * rstd * ga.z; o[3] = v[j][3] * rstd * ga.w;
            o[4] = v[j][4] * rstd * gb.x; o[5] = v[j][5] * rstd * gb.y; o[6] = v[j][6] * rstd * gb.z; o[7] = v[j][7] * rstd * gb.w;
            if (mode == 0) { *(v4u*)(H + (size_t)row * D + c0) = pack8(o); }
            else if (mode == 1) {
                const v4u w = pack8(o);
                *(v4u*)(H + (size_t)row * 2048 + c0) = w;
                if (prompt) {
                    if (t != TP - 1) *(v4u*)(H + (size_t)(row + 1) * 2048 + 1024 + c0) = w;
                    else { float* so = p.out + O_SHP + ((size_t)jl * BATCH + b) * D + c0; *(f32x4*)so = (f32x4){o[0], o[1], o[2], o[3]}; *(f32x4*)(so + 4) = (f32x4){o[4], o[5], o[6], o[7]}; }
                    if (t == 0) *(v4u*)(H + (size_t)row * 2048 + 1024 + c0) = (v4u){0u, 0u, 0u, 0u};
                } else {
                    const int s = row - MP;
                    const float* sp = p.in[I_SSHIFT] + ((size_t)jl * SB + s) * D + c0;
                    const f32x4 sa = *(const f32x4*)sp, sb2 = *(const f32x4*)(sp + 4);
                    const float pv[8] = {sa.x, sa.y, sa.z, sa.w, sb2.x, sb2.y, sb2.z, sb2.w};
                    *(v4u*)(H + (size_t)row * 2048 + 1024 + c0) = pack8(pv);
                    float* so = p.out + O_SHS + ((size_t)jl * SB + s) * D + c0; *(f32x4*)so = (f32x4){o[0], o[1], o[2], o[3]}; *(f32x4*)(so + 4) = (f32x4){o[4], o[5], o[6], o[7]};
                }
            } else {
                float* dst = nullptr;
                if (prompt) { if (t >= NMETA) dst = p.out + O_YP + ((size_t)b * SEQ + (t - NMETA)) * D + c0; }
                else dst = p.out + O_YS + (size_t)(row - MP) * D + c0;
                if (dst) { *(f32x4*)dst = (f32x4){o[0], o[1], o[2], o[3]}; *(f32x4*)(dst + 4) = (f32x4){o[4], o[5], o[6], o[7]}; }
            }
        }
    }
}

__device__ __forceinline__ void ph_ret_norm(const Params& p, int jl, int lane, int wave) {
    const float* O = (const float*)(p.ws + WS_O); const bf16* SG = (const bf16*)(p.ws + WS_SG); bf16* Y = (bf16*)(p.ws + WS_Y);
    const float* gnw = p.in[I_RGN] + (size_t)jl * RV;
    const int gw = blockIdx.x * NWAVES + wave, NGW = gridDim.x * NWAVES;
    for (int it = gw; it < M * RH; it += NGW) {
        const int row = it >> 2, h = it & 3; const size_t off = (size_t)row * RV + h * RDV + 8 * lane;
        const f32x4 a = *(const f32x4*)(O + off), b = *(const f32x4*)(O + off + 4);
        float v[8] = {a.x, a.y, a.z, a.w, b.x, b.y, b.z, b.w};
        float s = 0.f;
#pragma unroll
        for (int e = 0; e < 8; ++e) s += v[e];
        const float mean = wave_sum(s) * (1.f / RDV);
        float s2 = 0.f;
#pragma unroll
        for (int e = 0; e < 8; ++e) { v[e] -= mean; s2 += v[e] * v[e]; }
        const float rstd = rsqrtf(wave_sum(s2) * (1.f / RDV) + 1e-5f);
        float sg[8]; unpack8(*(const v4u*)(SG + off), sg);
        const f32x4 ga = *(const f32x4*)(gnw + h * RDV + 8 * lane), gb = *(const f32x4*)(gnw + h * RDV + 8 * lane + 4);
        const float gg[8] = {ga.x, ga.y, ga.z, ga.w, gb.x, gb.y, gb.z, gb.w};
        float o[8];
#pragma unroll
        for (int e = 0; e < 8; ++e) o[e] = v[e] * rstd * gg[e] * sg[e];
        *(v4u*)(Y + off) = pack8(o);
    }
}

__device__ __forceinline__ void ph_conv(const Params& p, int li, int tid) {
    const bf16* U = (const bf16*)(p.ws + WS_U); const bf16* G = (const bf16*)(p.ws + WS_G); bf16* ACT = (bf16*)(p.ws + WS_ACT);
    const float* cw = p.in[I_CW] + (size_t)li * 3 * DFF; const float* cb = p.in[I_CB] + (size_t)li * DFF;
    const float* cst = p.in[I_SCONV] + (size_t)li * SB * 2 * DFF;
    float* cvp = p.out + O_CVP + (size_t)li * BATCH * 2 * DFF; float* cvs = p.out + O_CVS + (size_t)li * SB * 2 * DFF;
    const size_t gt = (size_t)blockIdx.x * NTHR + tid, GT = (size_t)gridDim.x * NTHR;
    constexpr int CH = DFF / 8;
    for (size_t i = gt; i < (size_t)M * CH; i += GT) {
        const int row = (int)(i / CH), f0 = (int)(i % CH) * 8;
        const size_t off = (size_t)row * DFF + f0;
        float u[8], g0[8], g1[8], g2[8];
        unpack8(*(const v4u*)(U + off), u); unpack8(*(const v4u*)(G + off), g0);
        if (row < MP) {
            const int b = row / TP, t = row % TP;
            if (t >= 1) unpack8(*(const v4u*)(G + off - DFF), g1); else {
#pragma unroll
                for (int e = 0; e < 8; ++e) g1[e] = 0.f; }
            if (t >= 2) unpack8(*(const v4u*)(G + off - 2 * DFF), g2); else {
#pragma unroll
                for (int e = 0; e < 8; ++e) g2[e] = 0.f; }
            if (t >= TP - 2) { float* o = cvp + ((size_t)b * 2 + (t - (TP - 2))) * DFF + f0; *(f32x4*)o = (f32x4){g0[0], g0[1], g0[2], g0[3]}; *(f32x4*)(o + 4) = (f32x4){g0[4], g0[5], g0[6], g0[7]}; }
        } else {
            const int s = row - MP;
            const float* c0 = cst + ((size_t)s * 2 + 0) * DFF + f0; const float* c1 = c0 + DFF;
            const f32x4 a0 = *(const f32x4*)c0, a1 = *(const f32x4*)(c0 + 4), b0 = *(const f32x4*)c1, b1 = *(const f32x4*)(c1 + 4);
            g2[0] = a0.x; g2[1] = a0.y; g2[2] = a0.z; g2[3] = a0.w; g2[4] = a1.x; g2[5] = a1.y; g2[6] = a1.z; g2[7] = a1.w;
            g1[0] = b0.x; g1[1] = b0.y; g1[2] = b0.z; g1[3] = b0.w; g1[4] = b1.x; g1[5] = b1.y; g1[6] = b1.z; g1[7] = b1.w;
            float* o = cvs + ((size_t)s * 2 + 0) * DFF + f0;
            *(f32x4*)o = b0; *(f32x4*)(o + 4) = b1;
            *(f32x4*)(o + DFF) = (f32x4){g0[0], g0[1], g0[2], g0[3]}; *(f32x4*)(o + DFF + 4) = (f32x4){g0[4], g0[5], g0[6], g0[7]};
        }
        float w0[8], w1[8], w2[8], bb[8];
        { const f32x4 x0 = *(const f32x4*)(cw + f0), x1 = *(const f32x4*)(cw + f0 + 4); w0[0] = x0.x; w0[1] = x0.y; w0[2] = x0.z; w0[3] = x0.w; w0[4] = x1.x; w0[5] = x1.y; w0[6] = x1.z; w0[7] = x1.w; }
        { const f32x4 x0 = *(const f32x4*)(cw + DFF + f0), x1 = *(const f32x4*)(cw + DFF + f0 + 4); w1[0] = x0.x; w1[1] = x0.y; w1[2] = x0.z; w1[3] = x0.w; w1[4] = x1.x; w1[5] = x1.y; w1[6] = x1.z; w1[7] = x1.w; }
        { const f32x4 x0 = *(const f32x4*)(cw + 2 * DFF + f0), x1 = *(const f32x4*)(cw + 2 * DFF + f0 + 4); w2[0] = x0.x; w2[1] = x0.y; w2[2] = x0.z; w2[3] = x0.w; w2[4] = x1.x; w2[5] = x1.y; w2[6] = x1.z; w2[7] = x1.w; }
        { const f32x4 x0 = *(const f32x4*)(cb + f0), x1 = *(const f32x4*)(cb + f0 + 4); bb[0] = x0.x; bb[1] = x0.y; bb[2] = x0.z; bb[3] = x0.w; bb[4] = x1.x; bb[5] = x1.y; bb[6] = x1.z; bb[7] = x1.w; }
        float o[8];
#pragma unroll
        for (int e = 0; e < 8; ++e) { const float cv = bb[e] + w0[e] * g2[e] + w1[e] * g1[e] + w2[e] * g0[e]; o[e] = siluf_(cv) * u[e]; }
        *(v4u*)(ACT + off) = pack8(o);
    }
}

__device__ __forceinline__ void ph_rwkv_prep(const Params& p, int jl, int lane, int wave) {
    float* Kb = (float*)(p.ws + WS_K); float* Vb = (float*)(p.ws + (jl == 0 ? WS_VF : WS_VB)); const float* VF = (const float*)(p.ws + WS_VF);
    const float* L2 = (const float*)(p.ws + WS_L2);
    float* Wd = (float*)(p.ws + WS_WDEC); float* NKK = (float*)(p.ws + WS_NKK); float* KKA = (float*)(p.ws + WS_KKA);
    const float* w0 = p.in[I_W0] + (size_t)jl * D; const float* a0 = p.in[I_A0] + (size_t)jl * D; const float* v0 = p.in[I_V0];
    const float* kkp = p.in[I_KK] + (size_t)jl * D; const float* kap = p.in[I_KA] + (size_t)jl * D;
    const int gw = blockIdx.x * NWAVES + wave, NGW = gridDim.x * NWAVES;
    for (int it = gw; it < M * WH; it += NGW) {
        const int row = it >> 4, h = it & 15, c = h * WN + lane;
        const size_t idx = (size_t)row * D + c, l2 = (size_t)row * NL2 + c;
        const float xw = -(w0[c] + L2[l2]);
        const float sp = xw > 20.f ? xw : log1pf(expf(xw));
        const float w = expf(-expf(-sp - 0.5f));
        const float a = sigmoidf_(a0[c] + L2[l2 + 1024]);
        const float kv = Kb[idx];
        float kk = kv * kkp[c];
        const float ss = wave_sum(kk * kk);
        kk = kk * rsqrtf(fmaxf(ss, 1e-12f));
        if (jl == 1) { const float v = Vb[idx]; Vb[idx] = v + (VF[idx] - v) * sigmoidf_(v0[c] + L2[l2 + 3072]); }
        Kb[idx] = kv * (1.f + (a - 1.f) * kap[c]); Wd[idx] = w; NKK[idx] = -kk; KKA[idx] = kk * a;
    }
}
__device__ __forceinline__ void ph_rwkv_post(const Params& p, int jl, int lane, int wave) {
    const float* YW = (const float*)(p.ws + WS_YW); const float* R = (const float*)(p.ws + WS_R); const float* Kb = (const float*)(p.ws + WS_K);
    const float* Vb = (const float*)(p.ws + (jl == 0 ? WS_VF : WS_VB)); const float* L2 = (const float*)(p.ws + WS_L2); bf16* Z = (bf16*)(p.ws + WS_Z);
    const float* rk = p.in[I_RK] + (size_t)jl * D; const float* lnw = p.in[I_LNW] + (size_t)jl * D; const float* lnb = p.in[I_LNB] + (size_t)jl * D;
    const int gw = blockIdx.x * NWAVES + wave, NGW = gridDim.x * NWAVES;
    for (int it = gw; it < M * WH; it += NGW) {
        const int row = it >> 4, h = it & 15, c = h * WN + lane;
        const size_t idx = (size_t)row * D + c;
        const float yv = YW[idx];
        const float mean = wave_sum(yv) * (1.f / WN);
        const float yc = yv - mean;
        const float rstd = rsqrtf(wave_sum(yc * yc) * (1.f / WN) + 64e-5f);
        const float yn = yc * rstd * lnw[c] + lnb[c];
        const float bon = wave_sum(R[idx] * Kb[idx] * rk[c]) * Vb[idx];
        const float z = (yn + bon) * L2[(size_t)row * NL2 + 2048 + c];
        Z[idx] = (bf16)(cvt_pk_bf16(z, 0.f) & 0xffffu);
    }
}

__device__ __forceinline__ void ph_ret_slow(const Params& p, int jl, LAS unsigned char* lds, int tid) {
    const bf16* QK = (const bf16*)(p.ws + WS_QK); const bf16* V = (const bf16*)(p.ws + WS_V); float* O = (float*)(p.ws + WS_O);
    const int half = tid >> 8, t256 = tid & 255, e = t256 & 63, dq = t256 >> 6;
    LAS float* sq = (LAS float*)lds + half * 256; LAS float* sk = (LAS float*)lds + 512 + half * 256; LAS float* red = (LAS float*)lds + 1024 + half * 256;
    for (int pass = 0; pass < 2; ++pass) {
        const int nitems = pass ? SB * RH * 8 : BATCH * RH * 8;
        for (int it = blockIdx.x * 2 + half; it < nitems; it += gridDim.x * 2) {
            const int es = it & 7, h = (it >> 3) & 3, seq = it >> 5;
            const int r0 = pass ? MP + seq : seq * TP, T = pass ? 1 : TP;
            const float gamma = 1.0f - exp2f(-5.0f - (float)h);
            float S[64];
            if (pass) {
                const float* sp = p.in[I_SRET] + ((((size_t)jl * SB + seq) * RH + h) * RDK + dq * 64) * RDV + es * 64 + e;
#pragma unroll
                for (int dd = 0; dd < 64; ++dd) S[dd] = sp[(size_t)dd * RDV];
            } else {
#pragma unroll
                for (int dd = 0; dd < 64; ++dd) S[dd] = 0.f;
            }
            for (int t = 0; t < T; ++t) {
                const int row = r0 + t;
                sq[t256] = __uint_as_float((unsigned)QK[(size_t)row * 2048 + h * RDK + t256] << 16);
                sk[t256] = __uint_as_float((unsigned)QK[(size_t)row * 2048 + 1024 + h * RDK + t256] << 16);
                const float ve = __uint_as_float((unsigned)V[(size_t)row * 2048 + h * RDV + es * 64 + e] << 16);
                __syncthreads();
                float acc = 0.f;
#pragma unroll
                for (int dd = 0; dd < 64; ++dd) { S[dd] = fmaf(S[dd], gamma, sk[dq * 64 + dd] * ve); acc = fmaf(sq[dq * 64 + dd], S[dd], acc); }
                red[dq * 64 + e] = acc;
                __syncthreads();
                if (dq == 0) O[(size_t)row * RV + h * RDV + es * 64 + e] = (red[e] + red[64 + e]) + (red[128 + e] + red[192 + e]);
            }
            float* so = (pass ? p.out + O_RETS + (size_t)jl * SB * RH * RDK * RDV : p.out + O_RETP + (size_t)jl * BATCH * RH * RDK * RDV) + (((size_t)seq * RH + h) * RDK + dq * 64) * RDV + es * 64 + e;
#pragma unroll
            for (int dd = 0; dd < 64; ++dd) so[(size_t)dd * RDV] = S[dd];
        }
    }
}
__device__ __forceinline__ void ph_wkv_slow(const Params& p, int jl, LAS unsigned char* lds, int lane, int wave) {
    const float* r = (const float*)(p.ws + WS_R); const float* w = (const float*)(p.ws + WS_WDEC); const float* k = (const float*)(p.ws + WS_K);
    const float* v = (const float*)(p.ws + (jl == 0 ? WS_VF : WS_VB)); const float* nkk = (const float*)(p.ws + WS_NKK); const float* kka = (const float*)(p.ws + WS_KKA);
    float* y = (float*)(p.ws + WS_YW);
    LAS float* sv = (LAS float*)lds + wave * 320;
    for (int pass = 0; pass < 2; ++pass) {
        const int nitems = pass ? SB * WH : BATCH * WH;
        for (int it = blockIdx.x * NWAVES + wave; it < nitems; it += gridDim.x * NWAVES) {
            const int h = it & 15, seq = it >> 4;
            const int r0 = pass ? MP + seq : seq * TP, T = pass ? 1 : TP;
            float S[64];
            if (pass) {
                const float* sp = p.in[I_SWKV] + ((((size_t)jl * SB + seq) * WH + h) * WN + lane) * WN;
#pragma unroll
                for (int j = 0; j < 64; j += 4) { const f32x4 t4 = *(const f32x4*)(sp + j); S[j] = t4.x; S[j + 1] = t4.y; S[j + 2] = t4.z; S[j + 3] = t4.w; }
            } else {
#pragma unroll
                for (int j = 0; j < 64; ++j) S[j] = 0.f;
            }
            for (int t = 0; t < T; ++t) {
                const size_t idx = (size_t)(r0 + t) * D + h * WN + lane;
                sv[lane] = nkk[idx]; sv[64 + lane] = w[idx]; sv[128 + lane] = kka[idx]; sv[192 + lane] = k[idx]; sv[256 + lane] = r[idx];
                const float vi = v[idx];
                __syncthreads();
                float sa0 = 0.f, sa1 = 0.f, sa2 = 0.f, sa3 = 0.f;
#pragma unroll
                for (int j = 0; j < 64; j += 4) { sa0 = fmaf(S[j], sv[j], sa0); sa1 = fmaf(S[j + 1], sv[j + 1], sa1); sa2 = fmaf(S[j + 2], sv[j + 2], sa2); sa3 = fmaf(S[j + 3], sv[j + 3], sa3); }
                const float sa = (sa0 + sa1) + (sa2 + sa3);
                float y0 = 0.f, y1 = 0.f, y2 = 0.f, y3 = 0.f;
#pragma unroll
                for (int j = 0; j < 64; j += 4) {
                    S[j] = fmaf(S[j], sv[64 + j], fmaf(sa, sv[128 + j], vi * sv[192 + j])); y0 = fmaf(S[j], sv[256 + j], y0);
                    S[j + 1] = fmaf(S[j + 1], sv[64 + j + 1], fmaf(sa, sv[128 + j + 1], vi * sv[192 + j + 1])); y1 = fmaf(S[j + 1], sv[256 + j + 1], y1);
                    S[j + 2] = fmaf(S[j + 2], sv[64 + j + 2], fmaf(sa, sv[128 + j + 2], vi * sv[192 + j + 2])); y2 = fmaf(S[j + 2], sv[256 + j + 2], y2);
                    S[j + 3] = fmaf(S[j + 3], sv[64 + j + 3], fmaf(sa, sv[128 + j + 3], vi * sv[192 + j + 3])); y3 = fmaf(S[j + 3], sv[256 + j + 3], y3);
                }
                y[idx] = (y0 + y1) + (y2 + y3);
                __syncthreads();
            }
            float* so = (pass ? p.out + O_WKVS + (size_t)jl * SB * WH * WN * WN : p.out + O_WKVP + (size_t)jl * BATCH * WH * WN * WN) + (((size_t)seq * WH + h) * WN + lane) * WN;
#pragma unroll
            for (int j = 0; j < 64; j += 4) { f32x4 t4; t4.x = S[j]; t4.y = S[j + 1]; t4.z = S[j + 2]; t4.w = S[j + 3]; *(f32x4*)(so + j) = t4; }
        }
    }
}

constexpr int RT_KP = 528, RT_VP = 144, RT_SP = 528;
constexpr int RT_K_OFF = 0, RT_V_OFF = 128 * RT_KP, RT_ST_OFF = RT_V_OFF + 128 * RT_VP, RT_END = RT_ST_OFF + 64 * RT_SP;
static_assert(RT_END <= LDS_BYTES, "retention LDS map");
typedef short v4s __attribute__((ext_vector_type(4)));
__device__ __forceinline__ bf16x8 tr_pair(LAS unsigned char* a0, LAS unsigned char* a1) {
    const v4s lo = __builtin_amdgcn_ds_read_tr16_b64_v4i16((LAS v4s*)a0), hi = __builtin_amdgcn_ds_read_tr16_b64_v4i16((LAS v4s*)a1);
    return __builtin_shufflevector(lo, hi, 0, 1, 2, 3, 4, 5, 6, 7);
}
__device__ __forceinline__ void ph_ret_fast(const Params& p, int jl, LAS unsigned char* lds, int tid, int lane, int wave) {
    const bf16* QK = (const bf16*)(p.ws + WS_QK); const bf16* V = (const bf16*)(p.ws + WS_V); float* O = (float*)(p.ws + WS_O);
    const int fr = lane & 15, fq = lane >> 4, li_q = (lane & 15) >> 2, li_p = lane & 3;
    for (int u = blockIdx.x; u < BATCH * RH * 8; u += gridDim.x) {
        const int es = u & 7, h = (u >> 3) & 3, b = u >> 5;
        const float gamma = 1.0f - exp2f(-5.0f - (float)h), lg = log2f(gamma), g128 = exp2f(128.f * lg), g127 = exp2f(127.f * lg);
        const int i0 = 16 * wave, d0 = 32 * wave;
        f32x4 Sacc[2][4];
#pragma unroll
        for (int a = 0; a < 2; ++a)
#pragma unroll
            for (int c = 0; c < 4; ++c) Sacc[a][c] = (f32x4){0.f, 0.f, 0.f, 0.f};
        __syncthreads();
        for (int i = tid; i < 64 * RT_SP / 16; i += NTHR) *(LAS v4u*)(lds + RT_ST_OFF + i * 16) = (v4u){0u, 0u, 0u, 0u};
        v4u kst[8], vst[2];
        const bf16* Kg = QK + 1024 + 256 * h; const bf16* Vg = V + 512 * h + 64 * es; const bf16* Qg = QK + 256 * h;
#define RT_LOAD_STAGE(cc) do { \
            _Pragma("unroll") for (int k_ = 0; k_ < 8; ++k_) { const int id_ = tid + 512 * k_, row_ = id_ >> 5, ch_ = id_ & 31, t_ = 128 * (cc) - 112 + row_; \
                kst[k_] = t_ >= 0 ? *(const v4u*)(Kg + (size_t)(b * TP + t_) * 2048 + 8 * ch_) : (v4u){0u, 0u, 0u, 0u}; } \
            _Pragma("unroll") for (int k_ = 0; k_ < 2; ++k_) { const int id_ = tid + 512 * k_, row_ = id_ >> 3, ch_ = id_ & 7, t_ = 128 * (cc) - 112 + row_; \
                vst[k_] = t_ >= 0 ? *(const v4u*)(Vg + (size_t)(b * TP + t_) * 2048 + 8 * ch_) : (v4u){0u, 0u, 0u, 0u}; } } while (0)
        RT_LOAD_STAGE(0);
        for (int c = 0; c < 17; ++c) {
            __syncthreads();
#pragma unroll
            for (int k_ = 0; k_ < 8; ++k_) { const int id_ = tid + 512 * k_, row_ = id_ >> 5, ch_ = id_ & 31; *(LAS v4u*)(lds + RT_K_OFF + row_ * RT_KP + ch_ * 16) = kst[k_]; }
#pragma unroll
            for (int k_ = 0; k_ < 2; ++k_) { const int id_ = tid + 512 * k_, row_ = id_ >> 3, ch_ = id_ & 7;
                float f[8]; unpack8(vst[k_], f); const float sc = exp2f(-(float)row_ * lg);
#pragma unroll
                for (int e = 0; e < 8; ++e) f[e] *= sc;
                *(LAS v4u*)(lds + RT_V_OFF + row_ * RT_VP + ch_ * 16) = pack8(f); }
            bf16x8 Qf[8];
            { const int t_ = 128 * c - 112 + i0 + fr;
#pragma unroll
              for (int s = 0; s < 8; ++s) Qf[s] = t_ >= 0 ? *(const bf16x8*)(Qg + (size_t)(b * TP + t_) * 2048 + 32 * s + 8 * fq) : (bf16x8){0, 0, 0, 0, 0, 0, 0, 0}; }
            __syncthreads();
            bf16x8 Pf[4];
            { const int ii = i0 + fr; const float gi = exp2f((float)ii * lg);
#pragma unroll
              for (int s2 = 0; s2 < 4; ++s2) { f32x4 Dp[2];
#pragma unroll
                  for (int hh = 0; hh < 2; ++hh) { Dp[hh] = (f32x4){0.f, 0.f, 0.f, 0.f};
#pragma unroll
                      for (int s = 0; s < 8; ++s) { const bf16x8 Kf = *(const LAS bf16x8*)(lds + RT_K_OFF + (16 * (2 * s2 + hh) + fr) * RT_KP + (32 * s + 8 * fq) * 2);
                          Dp[hh] = __builtin_amdgcn_mfma_f32_16x16x32_bf16(Kf, Qf[s], Dp[hh], 0, 0, 0); } }
                  float f[8];
#pragma unroll
                  for (int hh = 0; hh < 2; ++hh)
#pragma unroll
                      for (int r = 0; r < 4; ++r) { const int jj = 16 * (2 * s2 + hh) + 4 * fq + r; f[hh * 4 + r] = ii >= jj ? Dp[hh][r] * gi : 0.f; }
                  const v4u w = pack8(f); Pf[s2] = __builtin_bit_cast(bf16x8, w); } }
            f32x4 Oacc[4];
#pragma unroll
            for (int et = 0; et < 4; ++et) { Oacc[et] = (f32x4){0.f, 0.f, 0.f, 0.f};
#pragma unroll
                for (int s = 0; s < 8; ++s) { const bf16x8 Sf = *(const LAS bf16x8*)(lds + RT_ST_OFF + (16 * et + fr) * RT_SP + (32 * s + 8 * fq) * 2);
                    Oacc[et] = __builtin_amdgcn_mfma_f32_16x16x32_bf16(Qf[s], Sf, Oacc[et], 0, 0, 0); } }
            __syncthreads();
            if (c + 1 < 17) RT_LOAD_STAGE(c + 1);
#pragma unroll
            for (int r = 0; r < 4; ++r) { const float lam = exp2f((float)(i0 + 4 * fq + r + 1) * lg);
#pragma unroll
                for (int et = 0; et < 4; ++et) Oacc[et][r] *= lam; }
#pragma unroll
            for (int et = 0; et < 4; ++et)
#pragma unroll
                for (int s = 0; s < 4; ++s) {
                    LAS unsigned char* a0 = lds + RT_V_OFF + (32 * s + 4 * fq + li_q) * RT_VP + (16 * et + 4 * li_p) * 2;
                    const bf16x8 Vf = tr_pair(a0, a0 + 16 * RT_VP);
                    Oacc[et] = __builtin_amdgcn_mfma_f32_16x16x32_bf16(Pf[s], Vf, Oacc[et], 0, 0, 0); }
#pragma unroll
            for (int r = 0; r < 4; ++r) { const int t_ = 128 * c - 112 + i0 + 4 * fq + r;
                if (t_ >= 0) { float* op = O + (size_t)(b * TP + t_) * RV + 512 * h + 64 * es + fr;
#pragma unroll
                    for (int et = 0; et < 4; ++et) op[16 * et] = Oacc[et][r]; } }
#pragma unroll
            for (int dt = 0; dt < 2; ++dt)
#pragma unroll
                for (int et = 0; et < 4; ++et) Sacc[dt][et] = Sacc[dt][et] * (g128 / g127);
#pragma unroll
            for (int s = 0; s < 4; ++s) {
                bf16x8 Kt[2], Vt[4];
#pragma unroll
                for (int dt = 0; dt < 2; ++dt) { LAS unsigned char* a0 = lds + RT_K_OFF + (32 * s + 8 * fq + li_q) * RT_KP + (d0 + 16 * dt + 4 * li_p) * 2; Kt[dt] = tr_pair(a0, a0 + 4 * RT_KP); }
#pragma unroll
                for (int et = 0; et < 4; ++et) { LAS unsigned char* a0 = lds + RT_V_OFF + (32 * s + 8 * fq + li_q) * RT_VP + (16 * et + 4 * li_p) * 2; Vt[et] = tr_pair(a0, a0 + 4 * RT_VP); }
#pragma unroll
                for (int dt = 0; dt < 2; ++dt)
#pragma unroll
                    for (int et = 0; et < 4; ++et) Sacc[dt][et] = __builtin_amdgcn_mfma_f32_16x16x32_bf16(Kt[dt], Vt[et], Sacc[dt][et], 0, 0, 0);
            }
#pragma unroll
            for (int dt = 0; dt < 2; ++dt)
#pragma unroll
                for (int et = 0; et < 4; ++et) Sacc[dt][et] = Sacc[dt][et] * g127;
#pragma unroll
            for (int dt = 0; dt < 2; ++dt)
#pragma unroll
                for (int et = 0; et < 4; ++et) { v2u w; w.x = cvt_pk_bf16(Sacc[dt][et][0], Sacc[dt][et][1]); w.y = cvt_pk_bf16(Sacc[dt][et][2], Sacc[dt][et][3]);
                    *(LAS v2u*)(lds + RT_ST_OFF + (16 * et + fr) * RT_SP + (d0 + 16 * dt + 4 * fq) * 2) = w; }
        }
#undef RT_LOAD_STAGE
        float* so = p.out + O_RETP + ((((size_t)jl * BATCH + b) * RH + h) * RDK) * RDV + 64 * es;
#pragma unroll
        for (int dt = 0; dt < 2; ++dt)
#pragma unroll
            for (int et = 0; et < 4; ++et)
#pragma unroll
                for (int r = 0; r < 4; ++r) so[(size_t)(d0 + 16 * dt + 4 * fq + r) * RDV + 16 * et + fr] = Sacc[dt][et][r];
    }
    {
        LAS float* sq = (LAS float*)lds; LAS float* sk = sq + 256; LAS float* red = sk + 256;
        const int e4 = tid & 127, dq = tid >> 7;
        for (int it = blockIdx.x; it < SB * RH; it += gridDim.x) {
            const int h = it & 3, s = it >> 2, row = MP + s;
            const float gamma = 1.0f - exp2f(-5.0f - (float)h);
            __syncthreads();
            if (tid < 256) sq[tid] = bf_lo((unsigned)QK[(size_t)row * 2048 + 256 * h + tid]);
            else sk[tid - 256] = bf_lo((unsigned)QK[(size_t)row * 2048 + 1024 + 256 * h + (tid - 256)]);
            const v2u vv = *(const v2u*)(V + (size_t)row * 2048 + 512 * h + 4 * e4);
            const f32x4 v4 = (f32x4){bf_lo(vv.x), bf_hi(vv.x), bf_lo(vv.y), bf_hi(vv.y)};
            __syncthreads();
            const float* sin_ = p.in[I_SRET] + ((((size_t)jl * SB + s) * RH + h) * RDK) * RDV + 4 * e4;
            float* sout = p.out + O_RETS + ((((size_t)jl * SB + s) * RH + h) * RDK) * RDV + 4 * e4;
            f32x4 oacc = (f32x4){0.f, 0.f, 0.f, 0.f};
#pragma unroll 8
            for (int k = 0; k < 64; ++k) { const int d = dq + 4 * k;
                const f32x4 sv = __builtin_nontemporal_load((const f32x4*)(sin_ + (size_t)d * RDV));
                const f32x4 sn = sv * gamma + v4 * sk[d];
                oacc += sn * sq[d];
                __builtin_nontemporal_store(sn, (f32x4*)(sout + (size_t)d * RDV)); }
            *(LAS f32x4*)(red + dq * 512 + 4 * e4) = oacc;
            __syncthreads();
            if (dq == 0) { const f32x4 r = (*(LAS f32x4*)(red + 4 * e4) + *(LAS f32x4*)(red + 512 + 4 * e4)) + (*(LAS f32x4*)(red + 1024 + 4 * e4) + *(LAS f32x4*)(red + 1536 + 4 * e4));
                *(f32x4*)(O + (size_t)row * RV + 512 * h + 4 * e4) = r; }
        }
    }
}

typedef float f32x2w __attribute__((ext_vector_type(2)));
constexpr int WK_TB = 32, WK_STEP_B = 6 * 256 + 16, WK_BUF_B = WK_TB * WK_STEP_B, WK_Y_OFF = 2 * WK_BUF_B, WK_YB_B = WK_TB * 32 * 4;
static_assert(WK_Y_OFF + 2 * WK_YB_B <= LDS_BYTES - 16, "wkv LDS map");
__device__ __forceinline__ float row16_sum(float x) {
    x += __builtin_bit_cast(float, __builtin_amdgcn_update_dpp(0, __builtin_bit_cast(int, x), 0x128, 0xf, 0xf, false));
    x += __builtin_bit_cast(float, __builtin_amdgcn_update_dpp(0, __builtin_bit_cast(int, x), 0x124, 0xf, 0xf, false));
    x += __builtin_bit_cast(float, __builtin_amdgcn_update_dpp(0, __builtin_bit_cast(int, x), 0x122, 0xf, 0xf, false));
    x += __builtin_bit_cast(float, __builtin_amdgcn_update_dpp(0, __builtin_bit_cast(int, x), 0x121, 0xf, 0xf, false));
    return x;
}
__device__ __forceinline__ float half8_sum(float x) {
    x += __builtin_bit_cast(float, __builtin_amdgcn_update_dpp(0, __builtin_bit_cast(int, x), 0x141, 0xf, 0xf, false));
    x += __builtin_bit_cast(float, __builtin_amdgcn_update_dpp(0, __builtin_bit_cast(int, x), 0xB1, 0xf, 0xf, false));
    x += __builtin_bit_cast(float, __builtin_amdgcn_update_dpp(0, __builtin_bit_cast(int, x), 0x4E, 0xf, 0xf, false));
    return x;
}
__device__ __forceinline__ void ph_wkv_fast(const Params& p, int jl, LAS unsigned char* lds, int tid, int lane, int wave) {
    const float* arr[6] = {(const float*)(p.ws + WS_NKK), (const float*)(p.ws + WS_WDEC), (const float*)(p.ws + WS_KKA), (const float*)(p.ws + WS_K), (const float*)(p.ws + WS_R),
                           (const float*)(p.ws + (jl == 0 ? WS_VF : WS_VB))};
    float* YW = (float*)(p.ws + WS_YW);
    const int ri = lane >> 4, cg = lane & 15;
    for (int it = blockIdx.x; it < BATCH * WH * 2; it += gridDim.x) {
        const int half = it & 1, h = (it >> 1) & 15, seq = it >> 5, r0 = seq * TP;
        const int sts = tid >> 4, sc4 = tid & 15;
        f32x4 SA = (f32x4){0.f, 0.f, 0.f, 0.f}, SB = (f32x4){0.f, 0.f, 0.f, 0.f}; float sa = 0.f;
        f32x4 st[6];
#define WK_STAGE_LOAD(tbase) do { const int tt_ = (tbase) + sts; \
            st[0] = (tt_ + 1 < TP) ? *(const f32x4*)(arr[0] + (size_t)(r0 + tt_ + 1) * D + h * WN + 4 * sc4) : (f32x4){0.f, 0.f, 0.f, 0.f}; \
            _Pragma("unroll") for (int k_ = 1; k_ < 6; ++k_) st[k_] = (tt_ < TP) ? *(const f32x4*)(arr[k_] + (size_t)(r0 + tt_) * D + h * WN + 4 * sc4) : (f32x4){0.f, 0.f, 0.f, 0.f}; } while (0)
#define WK_STAGE_WRITE(Bp) do { LAS unsigned char* sl_ = (Bp) + sts * WK_STEP_B; \
            const f32x4 wn_ = st[1] * st[0]; \
            const float c1_ = row16_sum((st[2].x * st[0].x + st[2].y * st[0].y) + (st[2].z * st[0].z + st[2].w * st[0].w)); \
            const float c2_ = row16_sum((st[3].x * st[0].x + st[3].y * st[0].y) + (st[3].z * st[0].z + st[3].w * st[0].w)); \
            *(LAS f32x4*)(sl_ + sc4 * 16) = wn_; \
            _Pragma("unroll") for (int k_ = 1; k_ < 6; ++k_) *(LAS f32x4*)(sl_ + k_ * 256 + sc4 * 16) = st[k_]; \
            if (sc4 == 0) *(LAS f32x2w*)(sl_ + 1536) = (f32x2w){c1_, c2_}; } while (0)
        __syncthreads();
        WK_STAGE_LOAD(0);
        WK_STAGE_WRITE(lds);
        __syncthreads();
        constexpr int NB = (TP + WK_TB - 1) / WK_TB;
        for (int bt = 0; bt < NB; ++bt) {
            const int t0 = bt * WK_TB, tn = t0 + WK_TB;
            const bool has_next = tn < TP;
            if (has_next) WK_STAGE_LOAD(tn);
            LAS unsigned char* B = lds + (bt & 1) * WK_BUF_B;
            LAS float* yb = (LAS float*)(lds + WK_Y_OFF + (bt & 1) * WK_YB_B);
            const int nst = (TP - t0) < WK_TB ? (TP - t0) : WK_TB;
            if (wave < 4) {
                const int ri8 = lane >> 3, cg8 = lane & 7;
                const int voff = 1280 + (32 * half + 8 * wave + ri8) * 4;
                LAS unsigned char* sp = B + cg8 * 32;
                f32x4 wnA = *(LAS f32x4*)(sp), wnB = *(LAS f32x4*)(sp + 16), wA = *(LAS f32x4*)(sp + 256), wB = *(LAS f32x4*)(sp + 272), kaA = *(LAS f32x4*)(sp + 512), kaB = *(LAS f32x4*)(sp + 528),
                      kA = *(LAS f32x4*)(sp + 768), kB = *(LAS f32x4*)(sp + 784), rA = *(LAS f32x4*)(sp + 1024), rB = *(LAS f32x4*)(sp + 1040);
                float vi = *(LAS float*)(B + voff); f32x2w cc = *(LAS f32x2w*)(B + 1536);
#pragma unroll 2
                for (int ts = 0; ts < nst; ++ts) {
                    const int tsn = (ts + 1 < WK_TB) ? ts + 1 : ts;
                    LAS unsigned char* spn = B + tsn * WK_STEP_B + cg8 * 32;
                    const f32x4 wnA_n = *(LAS f32x4*)(spn), wnB_n = *(LAS f32x4*)(spn + 16), wA_n = *(LAS f32x4*)(spn + 256), wB_n = *(LAS f32x4*)(spn + 272), kaA_n = *(LAS f32x4*)(spn + 512), kaB_n = *(LAS f32x4*)(spn + 528),
                                kA_n = *(LAS f32x4*)(spn + 768), kB_n = *(LAS f32x4*)(spn + 784), rA_n = *(LAS f32x4*)(spn + 1024), rB_n = *(LAS f32x4*)(spn + 1040);
                    const float vi_n = *(LAS float*)(B + tsn * WK_STEP_B + voff); const f32x2w cc_n = *(LAS f32x2w*)(B + tsn * WK_STEP_B + 1536);
                    const f32x4 pa = SA * wnA + SB * wnB;
                    const f32x4 vk_a = kA * vi, vk_b = kB * vi;
                    SA = SA * wA + (kaA * sa + vk_a); SB = SB * wB + (kaB * sa + vk_b);
                    sa = fmaf(sa, cc.x, fmaf(vi, cc.y, half8_sum((pa.x + pa.y) + (pa.z + pa.w))));
                    const f32x4 py = SA * rA + SB * rB;
                    const float y = half8_sum((py.x + py.y) + (py.z + py.w));
                    if (cg8 == 0) yb[ts * 32 + 8 * wave + ri8] = y;
                    wnA = wnA_n; wnB = wnB_n; wA = wA_n; wB = wB_n; kaA = kaA_n; kaB = kaB_n; kA = kA_n; kB = kB_n; rA = rA_n; rB = rB_n; vi = vi_n; cc = cc_n;
                }
            }
            if (has_next) WK_STAGE_WRITE(lds + ((bt + 1) & 1) * WK_BUF_B);
            __syncthreads();
#pragma unroll
            for (int k = 0; k < 2; ++k) { const int idx = tid + 512 * k, ts = idx >> 5, rr = idx & 31;
                if (t0 + ts < TP) YW[(size_t)(r0 + t0 + ts) * D + h * WN + 32 * half + rr] = yb[idx]; }
        }
#undef WK_STAGE_LOAD
#undef WK_STAGE_WRITE
        if (wave < 4) { float* so = p.out + O_WKVP + ((((size_t)jl * BATCH + seq) * WH + h) * WN + 32 * half + 8 * wave + (lane >> 3)) * WN + 8 * (lane & 7);
            *(f32x4*)so = SA; *(f32x4*)(so + 4) = SB; }
    }
    {
        const int gw = blockIdx.x * NWAVES + wave, NGW = gridDim.x * NWAVES;
        for (int it = gw; it < SB * WH * 16; it += NGW) {
            const int rg = it & 15, h = (it >> 4) & 15, s = it >> 8, row = MP + s, i = 4 * rg + ri;
            const size_t vo = (size_t)row * D + h * WN + 4 * cg;
            const f32x4 nk = *(const f32x4*)(arr[0] + vo), w4 = *(const f32x4*)(arr[1] + vo), ka = *(const f32x4*)(arr[2] + vo), k4 = *(const f32x4*)(arr[3] + vo), r4 = *(const f32x4*)(arr[4] + vo);
            const float vi = arr[5][(size_t)row * D + h * WN + i];
            const size_t so = ((((size_t)jl * SB + s) * WH + h) * WN + i) * WN + 4 * cg;
            f32x4 S = *(const f32x4*)(p.in[I_SWKV] + so);
            const float sa = row16_sum((S.x * nk.x + S.y * nk.y) + (S.z * nk.z + S.w * nk.w));
            S.x = fmaf(S.x, w4.x, fmaf(sa, ka.x, vi * k4.x)); S.y = fmaf(S.y, w4.y, fmaf(sa, ka.y, vi * k4.y));
            S.z = fmaf(S.z, w4.z, fmaf(sa, ka.z, vi * k4.z)); S.w = fmaf(S.w, w4.w, fmaf(sa, ka.w, vi * k4.w));
            const float y = row16_sum((S.x * r4.x + S.y * r4.y) + (S.z * r4.z + S.w * r4.w));
            *(f32x4*)(p.out + O_WKVS + so) = S;
            if (cg == 0) YW[(size_t)row * D + h * WN + i] = y;
        }
    }
}

typedef __attribute__((address_space(1))) unsigned gu32;
#define XB_TMO      128
#define XB_XCNT(j)  (256  + 64 * (j))
#define XB_XSUB(j)  (1280 + 64 * (j))
#define XB_XGEN(j)  (2304 + 64 * (j))
#define XB_TOP      3328
#define XB_TOPGEN   3392
#define XCD_BAR_WORDS 3456
#define XB_SPIN_CAP (1u << 18)

__device__ __forceinline__ unsigned xb_ld(unsigned* p)              { return __hip_atomic_load(p, __ATOMIC_RELAXED, __HIP_MEMORY_SCOPE_AGENT); }
__device__ __forceinline__ unsigned xb_add(unsigned* p, unsigned v) { return __hip_atomic_fetch_add(p, v, __ATOMIC_RELAXED, __HIP_MEMORY_SCOPE_AGENT); }
__device__ __forceinline__ unsigned xb_xcc_id() { return (unsigned)__builtin_amdgcn_s_getreg((3 << 11) | 20) & 0xFu; }
#define XB_SPIN(cond, bar) do { unsigned _sp = 0; while (cond) { __builtin_amdgcn_s_sleep(1); \
    if ((++_sp & 255u) == 0u) { if (xb_ld(&(bar)[XB_TMO])) break; if (_sp > XB_SPIN_CAP) { atomicAdd(&(bar)[XB_TMO], 1u); break; } } } } while (0)

struct XcdBarrier {
    unsigned* bar; unsigned x;
    volatile LAS unsigned* st;
};

__device__ __forceinline__ XcdBarrier xcd_barrier_post(unsigned* bar, volatile LAS unsigned* st) {
    XcdBarrier b; b.bar = bar; b.x = xb_xcc_id(); b.st = st;
    if (threadIdx.x == 0) (void)xb_add(&bar[XB_XCNT(b.x)], 1u);
    return b;
}
__device__ __forceinline__ void xcd_barrier_complete(unsigned* bar, unsigned x, unsigned& nloc, unsigned& nx) {
    const unsigned G = gridDim.x * gridDim.y * gridDim.z;
    unsigned sum, cnt, mine, sp = 0u;
    for (;;) {
        sum = 0u; cnt = 0u; mine = 0u;
#pragma unroll
        for (unsigned j = 0; j < 16; ++j) { const unsigned c = xb_ld(&bar[XB_XCNT(j)]); sum += c; cnt += (c > 0u) ? 1u : 0u; mine = (j == x) ? c : mine; }
        if (sum == G) break;
        __builtin_amdgcn_s_sleep(1);
        if ((++sp & 255u) == 0u) { if (xb_ld(&bar[XB_TMO])) break; if (sp > XB_SPIN_CAP) { atomicAdd(&bar[XB_TMO], 1u); break; } }
    }
    nloc = mine > 0u ? mine : 1u; nx = cnt > 0u ? cnt : 1u;
}

__device__ __forceinline__ void xcd_barrier(const XcdBarrier& b) {
    asm volatile("s_waitcnt vmcnt(0)" ::: "memory");
    __syncthreads();
    if (threadIdx.x == 0) {
        unsigned* bar = b.bar;
        __builtin_amdgcn_s_waitcnt(0);
        unsigned nloc = b.st[0], nx = b.st[1];
        if (nloc == 0u) { xcd_barrier_complete(bar, b.x, nloc, nx); b.st[0] = nloc; b.st[1] = nx; }
        const unsigned old = xb_add(&bar[XB_XSUB(b.x)], 1u);
        const unsigned gen = old / nloc;
        if (old + 1u == (gen + 1u) * nloc) {
            __builtin_amdgcn_fence(__ATOMIC_RELEASE, "agent");
            asm volatile("s_waitcnt vmcnt(0)" ::: "memory");
            const unsigned og = xb_add(&bar[XB_TOP], 1u);
            const unsigned tg = og / nx;
            if (og + 1u == (tg + 1u) * nx) xb_add(&bar[XB_TOPGEN], 1u);
            else XB_SPIN(xb_ld(&bar[XB_TOPGEN]) == tg, bar);
            __builtin_amdgcn_fence(__ATOMIC_ACQUIRE, "agent");
            xb_add(&bar[XB_XGEN(b.x)], 1u);
            asm volatile("s_waitcnt vmcnt(0)" ::: "memory");
        } else {
            XB_SPIN(xb_ld(&bar[XB_XGEN(b.x)]) == gen, bar);
            __builtin_amdgcn_fence(__ATOMIC_ACQUIRE, "agent");
            asm volatile("s_waitcnt vmcnt(0)" ::: "memory");
        }
    }
    __syncthreads();
}

enum { OP_P0 = 0, OP_NORM_RET, OP_G_RETIN, OP_RET, OP_RETNORM, OP_G_RETOUT, OP_NORM_RW, OP_G_RWPROJ, OP_G_LORA2, OP_PREP, OP_WKV, OP_POST, OP_G_WO,
       OP_NORM_FFN, OP_G_UG, OP_CONV, OP_G_WD, OP_FINAL };
struct Ph { unsigned char op, layer; };
constexpr int NPH = 1 + 2 * 7 + 2 * 10 + 1;
__device__ __host__ inline Ph phase_at(int i) {
    if (i == 0) return Ph{OP_P0, 0};
    i -= 1;
    int l;
    if (i < 7) l = 0; else if (i < 17) { l = 1; i -= 7; } else if (i < 24) { l = 2; i -= 17; } else if (i < 34) { l = 3; i -= 24; } else return Ph{OP_FINAL, 0};
    int op = OP_FINAL;
    if ((l & 1) == 0) {
        switch (i) { case 0: op = OP_G_RETIN; break; case 1: op = OP_RET; break; case 2: op = OP_RETNORM; break; case 3: op = OP_G_RETOUT; break;
                     case 4: op = OP_G_UG; break; case 5: op = OP_CONV; break; default: op = OP_G_WD; break; }
    } else {
        switch (i) { case 0: op = OP_NORM_RW; break; case 1: op = OP_G_RWPROJ; break; case 2: op = OP_G_LORA2; break; case 3: op = OP_PREP; break; case 4: op = OP_WKV; break; case 5: op = OP_POST; break; case 6: op = OP_G_WO; break;
                     case 7: op = OP_G_UG; break; case 8: op = OP_CONV; break; default: op = OP_G_WD; break; }
    }
    return Ph{(unsigned char)op, (unsigned char)l};
}

__global__ void __launch_bounds__(NTHR, 2) mega(Params p, int lo, int hi) {
    extern __shared__ __attribute__((aligned(16))) unsigned char lds_raw[];
    LAS unsigned char* lds = (LAS unsigned char*)lds_raw;
    volatile LAS unsigned* bst = (volatile LAS unsigned*)(lds + LDS_BYTES - 16);
    if (threadIdx.x < 4) bst[threadIdx.x] = 0u;
    __syncthreads();
    const XcdBarrier bar = xcd_barrier_post((unsigned*)(p.ws + WS_CTL), bst);
    for (int ph = lo; ph < hi; ++ph) {
        int tid = threadIdx.x; asm volatile("" : "+v"(tid));
        const int lane = tid & 63, wave = __builtin_amdgcn_readfirstlane(tid >> 6);
        unsigned char* ws = p.ws;
        const Ph P = phase_at(ph);
        const int li = P.layer, jl = li >> 1;
        const bf16* gA = nullptr; const bf16* gB = nullptr; int gN = 0, gK = 0; EpiAny E{}; E.jl = jl; E.ws = ws; E.slot = -1; E.amul = 1.f; bool is_gemm = false;
        switch (P.op) {
        case OP_P0: ph_p0(p, lds, tid, lane, wave); break;
        case OP_NORM_RET: ph_norm(p, p.in[I_NMIX] + (size_t)li * D, 0, jl, lane, wave); break;
        case OP_NORM_FFN: ph_norm(p, p.in[I_NFFN] + (size_t)li * D, 0, jl, lane, wave); break;
        case OP_NORM_RW: ph_norm(p, p.in[I_NMIX] + (size_t)li * D, 1, jl, lane, wave); break;
        case OP_FINAL: ph_norm(p, p.in[I_NFIN], 2, 0, lane, wave); break;
        case OP_RETNORM: ph_ret_norm(p, jl, lane, wave); break;
        case OP_PREP: ph_rwkv_prep(p, jl, lane, wave); break;
        case OP_POST: ph_rwkv_post(p, jl, lane, wave); break;
        case OP_CONV: ph_conv(p, li, tid); break;
        case OP_RET: ph_ret_fast(p, jl, lds, tid, lane, wave); break;
        case OP_WKV: ph_wkv_fast(p, jl, lds, tid, lane, wave); break;
        case OP_G_RETIN: is_gemm = true; E.kind = EK_RETIN; E.perm = true; E.slot = 2 * li;
            gA = (const bf16*)(ws + WS_XB); gB = (const bf16*)(ws + WS_WIN + jl * SZ_WIN); gN = RWIN; gK = D; break;
        case OP_G_RETOUT: is_gemm = true; E.kind = EK_RESID; E.perm = false; E.slot = 2 * li + 1;
            gA = (const bf16*)(ws + WS_Y); gB = (const bf16*)(ws + WS_WOUT + jl * SZ_WOUT); gN = D; gK = RV; break;
        case OP_G_RWPROJ: is_gemm = true; E.kind = EK_RWPROJ; E.perm = false;
            gA = (const bf16*)(ws + WS_H); gB = (const bf16*)(ws + WS_WRW + jl * SZ_WRW); gN = NRW; gK = KRW; break;
        case OP_G_LORA2: is_gemm = true; E.kind = EK_F32; E.perm = false;
            gA = (const bf16*)(ws + WS_A2); gB = (const bf16*)(ws + WS_WL2 + jl * SZ_WL2); gN = (jl == 0 ? 3072 : 4096); gK = KL2; break;
        case OP_G_WO: is_gemm = true; E.kind = EK_RESID; E.perm = false; E.slot = 2 * li + 1;
            gA = (const bf16*)(ws + WS_Z); gB = (const bf16*)(ws + WS_WO + jl * SZ_WO); gN = D; gK = D; break;
        case OP_G_UG: is_gemm = true; E.kind = EK_UG; E.perm = true; E.slot = 2 * li + 1;
            gA = (const bf16*)(ws + WS_XB); gB = (const bf16*)(ws + WS_WUG + li * SZ_WUG); gN = 2 * DFF; gK = D; break;
        case OP_G_WD: is_gemm = true; E.kind = EK_RESID; E.perm = false; E.slot = (li == 1) ? 2 * (li + 1) : -1;
            gA = (const bf16*)(ws + WS_ACT); gB = (const bf16*)(ws + WS_WD + li * SZ_WD); gN = D; gK = DFF; break;
        default: break;
        }
        if (is_gemm) {
            const int gM = (E.kind == EK_RESID) ? MT0 : M;
            pg8::Gemm g{gA, gB, gM, gN, gK}; pg8::StaticOrder S; S.init(gM, gN, (int)gridDim.x, (int)blockIdx.x);
            if (E.kind == EK_RETIN || E.kind == EK_UG) {
                LAS float* rt = (LAS float*)(lds + 131072);
                Unit uu;
                for (int ui = 0; ui < 8 && S.next(ui, uu); ++ui) if (tid < 256) rt[ui * 256 + tid] = row_rstd(ws, E.slot, uu.pm * 256 + tid);
                E.rtab = rt;
                __syncthreads();
            }
            pg8::gemm_phase<EpiAny, pg8::StaticOrder, true, true>(lds, g, S, E);
            if (E.kind == EK_RESID) tail_resid(gA, gB, gK, ws, E.slot, E.amul, lds, lane, wave);
        }
        if (ph + 1 < hi) { if (ph == 0) cg::this_grid().sync(); else xcd_barrier(bar); }
    }
}

}

extern "C" void kernel_launch(void* const* d_in, const int* in_sizes, int n_in, void* d_out, int out_size, void* d_ws, size_t ws_size, hipStream_t stream) {
    static int grid = 0;
    if (grid == 0) {
        int dev = 0, cus = 0;
        if (n_in != N_IN || ws_size < WS_END) { fprintf(stderr, "kernel_launch: unexpected n_in %d / ws_size %zu (need %zu)\n", n_in, ws_size, (size_t)WS_END); grid = -1; return; }
        if (hipGetDevice(&dev) != hipSuccess || hipDeviceGetAttribute(&cus, hipDeviceAttributeMultiprocessorCount, dev) != hipSuccess) { grid = -1; return; }
        if (hipFuncSetAttribute((const void*)mega, hipFuncAttributeMaxDynamicSharedMemorySize, LDS_BYTES) != hipSuccess) { fprintf(stderr, "kernel_launch: hipFuncSetAttribute failed\n"); grid = -1; return; }
        int per_cu = 0;
        if (hipOccupancyMaxActiveBlocksPerMultiprocessor(&per_cu, (const void*)mega, NTHR, LDS_BYTES) != hipSuccess || per_cu < 1) { fprintf(stderr, "kernel_launch: occupancy query says %d\n", per_cu); (void)hipGetLastError(); }
        grid = cus * (per_cu >= 1 ? 1 : 1);
    }
    if (grid < 0) return;
    Params p{};
    for (int i = 0; i < N_IN; ++i) p.in[i] = (const float*)d_in[i];
    p.out = (float*)d_out; p.ws = (unsigned char*)d_ws;
    if (hipMemsetAsync(d_ws, 0, 65536, stream) != hipSuccess) { fprintf(stderr, "kernel_launch: memset failed\n"); return; }
    int lo = 0, hi = NPH;
    void* args[] = {(void*)&p, (void*)&lo, (void*)&hi};
    const hipError_t e = hipLaunchCooperativeKernel((const void*)mega, dim3(grid), dim3(NTHR), args, LDS_BYTES, stream);
    if (e != hipSuccess) fprintf(stderr, "kernel_launch: cooperative launch failed: %s (grid %d)\n", hipGetErrorString(e), grid);
    (void)in_sizes; (void)out_size;
}
```

```cpp
#include <hip/hip_runtime.h>
#include <hip/hip_cooperative_groups.h>
#include <cstdio>
#include <stdint.h>
namespace cg = cooperative_groups;
namespace pg8 {
#define PG8_LAS __attribute__((address_space(3)))
typedef unsigned short bf16_t;
typedef short bf16x8 __attribute__((ext_vector_type(8)));
typedef float f32x4 __attribute__((ext_vector_type(4)));
typedef unsigned u32x4 __attribute__((ext_vector_type(4)));
constexpr int BM = 256, BK = 64, HALF = 128, HTB = HALF * BK * 2  , STAGE_BYTES = 8 * HTB, NXCD = 8, WGM = 8;

__host__ __device__ __forceinline__ int lds_byte(int r, int c) { const int st = (r >> 4) * 2 + (c >> 5), rr = r & 15, cc = c & 31, ob = rr * 64 + cc * 2; return st * 1024 + (ob ^ (((ob >> 9) & 1) << 5)); }
__host__ __device__ __forceinline__ void stage_rc(int b, int& R, int& C) { const int st = b / 1024, sb = b % 1024, swz = sb ^ (((sb >> 9) & 1) << 5); R = (st >> 1) * 16 + swz / 64; C = (st & 1) * 32 + (swz % 64) / 2; }
__host__ __device__ __forceinline__ int perm32(int rho) { const int n = rho >> 4, i = rho & 15; return 8 * (i >> 2) + 4 * n + (i & 3); }

struct Unit { int pm, pn, ord; };
struct Gemm { const bf16_t* A; const bf16_t* Bt; int M, N, K, trows; };

struct StaticOrder {
    int nM, nN, nwg, G, c;
    __host__ __device__ void init(int M, int N, int G_, int c_) { nM = M / BM; nN = N / BM; nwg = nM * nN; G = G_; c = c_; }
    __host__ __device__ __forceinline__ bool next(int i, Unit& u) const {
        const long L = (long)i * G + c; if (L >= nwg) return false;
        int wgid = (int)L; { const int q = nwg / NXCD, r = nwg % NXCD, xcd = wgid % NXCD, off = wgid / NXCD; wgid = (xcd < r ? xcd * (q + 1) : r * (q + 1) + (xcd - r) * q) + off; }
        const int nig = WGM * nN, gid = wgid / nig, fm = gid * WGM, gsz = (nM - fm) < WGM ? (nM - fm) : WGM;
        u.pm = fm + ((wgid % nig) % gsz); u.pn = (wgid % nig) / gsz; u.ord = i; return true;
    }
    __device__ __forceinline__ void a_ready(const Unit&) const {}
    __device__ __forceinline__ void done(const Unit&) const {}
};
template <class Epi, class Sched, bool ALIGN_EPI = false, bool SP2 = false>
__device__ __forceinline__ void gemm_phase(PG8_LAS unsigned char* lds, const Gemm g, const Sched& S, const Epi& E) {
    int tid = threadIdx.x; asm volatile("" : "+v"(tid));
    const int wid = __builtin_amdgcn_readfirstlane(tid >> 6), lane = tid & 63, wr = wid >> 2, wc = wid & 3, fr = lane & 15, fq = lane >> 4;
    const int K = g.K, nt = K / BK;
    unsigned voffA[2], voffB[2];
#pragma unroll
    for (int i = 0; i < 2; ++i) { int R, C; stage_rc(tid * 16 + i * 8192, R, C); const int Rb = E.perm ? ((R & ~31) + perm32(R & 31)) : R;
        voffA[i] = (unsigned)(R * K + C) * 2u; voffB[i] = (unsigned)(Rb * K + C) * 2u; }
    const size_t kstep = (size_t)(BK * 2);
    const size_t hstep = (size_t)HALF * K * 2;
    const size_t tstep = 2 * hstep; const size_t tstepA = (size_t)g.trows * K * 2;
    const unsigned ldsw = (unsigned)wid * 1024u;
    const int aoff = lds_byte(wr * 64 + fr, fq * 8), boff = lds_byte(wc * 32 + fr, fq * 8);
#define PG8_SA(b, h) (((b) * 2 + (h)) * HTB)
#define PG8_SB(b, h) ((4 + (b) * 2 + (h)) * HTB)
#define PG8_STAGE(bufoff, gbase, voff) do { _Pragma("unroll") for (int _i = 0; _i < 2; ++_i) \
        __builtin_amdgcn_global_load_lds((const unsigned*)((const char*)(gbase) + (voff)[_i]), (PG8_LAS unsigned*)(lds + (bufoff) + ldsw + _i * 8192), 16, 0, 0); } while (0)
#define PG8_LDA(dst, b, h) do { _Pragma("unroll") for (int m = 0; m < 4; ++m) _Pragma("unroll") for (int k = 0; k < 2; ++k) dst[m][k] = *(const PG8_LAS bf16x8*)(lds + PG8_SA(b, h) + aoff + m * 2048 + k * 1024); } while (0)
#define PG8_LDB(dst, b, h) do { _Pragma("unroll") for (int n = 0; n < 2; ++n) _Pragma("unroll") for (int k = 0; k < 2; ++k) dst[n][k] = *(const PG8_LAS bf16x8*)(lds + PG8_SB(b, h) + boff + n * 2048 + k * 1024); } while (0)
#define PG8_MMA(ai, bj, At, Bt) do { __builtin_amdgcn_s_setprio(1); _Pragma("unroll") for (int m = 0; m < 4; ++m) _Pragma("unroll") for (int n = 0; n < 2; ++n) _Pragma("unroll") for (int k = 0; k < 2; ++k) \
        acc[ai][bj][m][n] = __builtin_amdgcn_mfma_f32_16x16x32_bf16(Bt[n][k], At[m][k], acc[ai][bj][m][n], 0, 0, 0); __builtin_amdgcn_s_setprio(0); } while (0)
#define PG8_WAIT_V(n) asm volatile("s_waitcnt vmcnt(" #n ")" ::: "memory")
#define PG8_WAIT_L(n) asm volatile("s_waitcnt lgkmcnt(" #n ")" ::: "memory")
#define PG8_BAR __builtin_amdgcn_s_barrier()
#define PG8_SCHED __builtin_amdgcn_sched_barrier(0)
    Unit cur, nxt; int ui = 0;
    if (!S.next(0, cur)) return;
    f32x4 acc[2][2][4][2];
#pragma unroll
    for (int a = 0; a < 2; ++a)
#pragma unroll
        for (int b = 0; b < 2; ++b)
#pragma unroll
            for (int m = 0; m < 4; ++m)
#pragma unroll
                for (int n = 0; n < 2; ++n) acc[a][b][m][n] = (f32x4){0.f, 0.f, 0.f, 0.f};
    bf16x8 At[4][2], B0[2][2], B1[2][2];
    const char* cA = (const char*)g.A + (size_t)cur.pm * tstepA; const char* cB = (const char*)g.Bt + (size_t)cur.pn * tstep;
    S.a_ready(cur);
    if constexpr (SP2) {
        PG8_STAGE(PG8_SB(0, 0), cB, voffB); PG8_STAGE(PG8_SB(0, 1), cB + hstep, voffB); PG8_STAGE(PG8_SA(0, 0), cA, voffA); PG8_STAGE(PG8_SA(0, 1), cA + hstep, voffA);
        if (wr == 1) PG8_BAR;
        PG8_WAIT_V(2); PG8_BAR;
        PG8_STAGE(PG8_SB(1, 0), cB + kstep, voffB); PG8_STAGE(PG8_SA(1, 0), cA + kstep, voffA); PG8_STAGE(PG8_SB(1, 1), cB + hstep + kstep, voffB);
        PG8_WAIT_V(6); PG8_BAR;
    } else {
        PG8_STAGE(PG8_SB(0, 0), cB, voffB); PG8_STAGE(PG8_SA(0, 0), cA, voffA); PG8_STAGE(PG8_SB(0, 1), cB + hstep, voffB); PG8_STAGE(PG8_SA(0, 1), cA + hstep, voffA);
        if (wr == 1) PG8_BAR;
        PG8_WAIT_V(4); PG8_BAR;
        PG8_STAGE(PG8_SB(1, 0), cB + kstep, voffB); PG8_STAGE(PG8_SA(1, 0), cA + kstep, voffA); PG8_STAGE(PG8_SB(1, 1), cB + hstep + kstep, voffB);
        PG8_WAIT_V(6); PG8_BAR;
    }
    for (;;) {
        const bool has_next = S.next(ui + 1, nxt);
        const char* nA = has_next ? (const char*)g.A + (size_t)nxt.pm * tstepA : cA; const char* nB = has_next ? (const char*)g.Bt + (size_t)nxt.pn * tstep : cB;
        for (int t = 0; t < nt; t += 2) {
            const bool last = (t == nt - 2);
            const char* a1 = cA + (size_t)(t + 1) * kstep;
            const char* a2 = last ? nA : cA + (size_t)(t + 2) * kstep; const char* b2 = last ? nB : cB + (size_t)(t + 2) * kstep;
            const char* a3 = a2 + kstep; const char* b3 = b2 + kstep;
            if (last && has_next) S.a_ready(nxt);
            if constexpr (SP2) {
            PG8_LDB(B0, 0, 0); PG8_LDB(B1, 0, 1); PG8_SCHED; PG8_LDA(At, 0, 0); PG8_STAGE(PG8_SA(1, 1), a1 + hstep, voffA);
            PG8_WAIT_V(8); PG8_WAIT_L(0); PG8_BAR; PG8_MMA(0, 0, At, B0); PG8_MMA(0, 1, At, B1); PG8_BAR; PG8_SCHED;
            PG8_LDA(At, 0, 1); PG8_STAGE(PG8_SB(0, 0), b2, voffB); PG8_STAGE(PG8_SB(0, 1), b2 + hstep, voffB); PG8_STAGE(PG8_SA(0, 0), a2, voffA);
            PG8_WAIT_V(8); PG8_WAIT_L(0); PG8_BAR; PG8_MMA(1, 0, At, B0); PG8_MMA(1, 1, At, B1); PG8_BAR; PG8_SCHED;
            PG8_LDB(B0, 1, 0); PG8_LDB(B1, 1, 1); PG8_SCHED; PG8_LDA(At, 1, 0); PG8_STAGE(PG8_SA(0, 1), a2 + hstep, voffA);
            PG8_WAIT_V(8); PG8_WAIT_L(0); PG8_BAR; PG8_MMA(0, 0, At, B0); PG8_MMA(0, 1, At, B1); PG8_BAR; PG8_SCHED;
            PG8_LDA(At, 1, 1); PG8_STAGE(PG8_SB(1, 0), b3, voffB); PG8_STAGE(PG8_SB(1, 1), b3 + hstep, voffB); PG8_STAGE(PG8_SA(1, 0), a3, voffA);
            PG8_WAIT_V(8); PG8_WAIT_L(0); PG8_BAR; PG8_MMA(1, 0, At, B0); PG8_MMA(1, 1, At, B1); PG8_BAR; PG8_SCHED;
            } else {
            PG8_LDB(B0, 0, 0); PG8_SCHED; PG8_LDA(At, 0, 0); PG8_STAGE(PG8_SA(1, 1), a1 + hstep, voffA);
            PG8_WAIT_L(8); PG8_BAR; PG8_WAIT_L(0); PG8_MMA(0, 0, At, B0); PG8_BAR; PG8_SCHED;
            PG8_LDB(B1, 0, 1); PG8_STAGE(PG8_SB(0, 0), b2, voffB);
            PG8_BAR; PG8_WAIT_L(0); PG8_MMA(0, 1, At, B1); PG8_BAR;
            PG8_LDA(At, 0, 1); PG8_STAGE(PG8_SA(0, 0), a2, voffA);
            PG8_BAR; PG8_WAIT_L(0); PG8_MMA(1, 0, At, B0); PG8_BAR; PG8_SCHED;
            PG8_STAGE(PG8_SB(0, 1), b2 + hstep, voffB);
            PG8_WAIT_V(6); PG8_BAR; PG8_MMA(1, 1, At, B1); PG8_BAR;
            PG8_LDB(B0, 1, 0); PG8_SCHED; PG8_LDA(At, 1, 0); PG8_STAGE(PG8_SA(0, 1), a2 + hstep, voffA);
            PG8_WAIT_L(8); PG8_BAR; PG8_WAIT_L(0); PG8_MMA(0, 0, At, B0); PG8_BAR; PG8_SCHED;
            PG8_LDB(B1, 1, 1); PG8_STAGE(PG8_SB(1, 0), b3, voffB);
            PG8_BAR; PG8_WAIT_L(0); PG8_MMA(0, 1, At, B1); PG8_BAR;
            PG8_LDA(At, 1, 1); PG8_STAGE(PG8_SA(1, 0), a3, voffA);
            PG8_BAR; PG8_WAIT_L(0); PG8_MMA(1, 0, At, B0); PG8_BAR; PG8_SCHED;
            PG8_STAGE(PG8_SB(1, 1), b3 + hstep, voffB);
            PG8_WAIT_V(6); PG8_BAR; PG8_MMA(1, 1, At, B1); PG8_BAR;
            }
        }
        if constexpr (ALIGN_EPI) { if (wr == 0) PG8_BAR; }
        if constexpr (!Epi::AFTER_DRAIN) { E(acc, cur, wr, wc, fr, fq); S.done(cur); }
        if (!has_next) break;
#pragma unroll
        for (int a = 0; a < 2; ++a)
#pragma unroll
            for (int b = 0; b < 2; ++b)
#pragma unroll
                for (int m = 0; m < 4; ++m)
#pragma unroll
                    for (int n = 0; n < 2; ++n) acc[a][b][m][n] = (f32x4){0.f, 0.f, 0.f, 0.f};
        cur = nxt; cA = nA; cB = nB; ++ui;
        if constexpr (ALIGN_EPI) { if (wr == 1) PG8_BAR; }
    }
    PG8_WAIT_V(0);
    if constexpr (!ALIGN_EPI) { if (wr == 0) PG8_BAR; }
    PG8_BAR;
    if constexpr (Epi::AFTER_DRAIN) { E.fused(acc, cur, wr, wc, fr, fq, lds, wid, lane); S.done(cur); }
#undef PG8_SA
#undef PG8_SB
#undef PG8_STAGE
#undef PG8_LDA
#undef PG8_LDB
#undef PG8_MMA
#undef PG8_WAIT_V
#undef PG8_WAIT_L
#undef PG8_BAR
#undef PG8_SCHED
}
}

namespace {
constexpr int D = 1024, BATCH = 8, SEQ = 2048, NMETA = 16, TP = SEQ + NMETA, MP = BATCH * TP, SB = 128, M = MP + SB;
constexpr int DEPTH = 4, RH = 4, RDK = 256, RDV = 512, RV = 2048, RWIN = 6144;
constexpr int WH = 16, WN = 64, LW = 64, LA = 64, LV = 32, LG = 160, DFF = 2816;
constexpr int NRW = 3584, KRW = 2048, KL2 = 384, NL2 = 4096;
constexpr float PAST_POS = 16384.f;
constexpr int NWAVES = 8, NTHR = 512;
constexpr int LDS_BYTES = 147456;

constexpr size_t O_YP = 0;
constexpr size_t O_YS = O_YP + (size_t)BATCH * SEQ * D;
constexpr size_t O_RETP = O_YS + (size_t)SB * D;
constexpr size_t O_WKVP = O_RETP + (size_t)2 * BATCH * RH * RDK * RDV;
constexpr size_t O_SHP = O_WKVP + (size_t)2 * BATCH * WH * WN * WN;
constexpr size_t O_CVP = O_SHP + (size_t)2 * BATCH * D;
constexpr size_t O_RETS = O_CVP + (size_t)DEPTH * BATCH * 2 * DFF;
constexpr size_t O_WKVS = O_RETS + (size_t)2 * SB * RH * RDK * RDV;
constexpr size_t O_SHS = O_WKVS + (size_t)2 * SB * WH * WN * WN;
constexpr size_t O_CVS = O_SHS + (size_t)2 * SB * D;

enum { I_XP = 0, I_XS, I_SRET, I_SWKV, I_SSHIFT, I_SCONV, I_META, I_NMIX, I_NFFN, I_NFIN, I_RWIN, I_RGN, I_RWOUT, I_MU, I_WRKV, I_W0, I_W1, I_W2,
       I_A0, I_A1, I_A2, I_V0, I_V1, I_V2, I_G1, I_G2, I_KK, I_KA, I_RK, I_LNW, I_LNB, I_WO, I_WUG, I_CW, I_CB, I_WD, N_IN };

constexpr size_t al256(size_t x) { return (x + 255) & ~(size_t)255; }
constexpr size_t WS_CTL = 0;
constexpr size_t WS_CS = 1u << 20;
constexpr size_t WS_WIN = 4u << 20;
constexpr size_t SZ_WIN = (size_t)RWIN * D * 2;
constexpr size_t WS_WOUT = WS_WIN + 2 * SZ_WIN;
constexpr size_t SZ_WOUT = (size_t)D * RV * 2;
constexpr size_t WS_WRW = WS_WOUT + 2 * SZ_WOUT;
constexpr size_t SZ_WRW = (size_t)NRW * KRW * 2;
constexpr size_t WS_WL2 = WS_WRW + 2 * SZ_WRW;
constexpr size_t SZ_WL2 = (size_t)NL2 * KL2 * 2;
constexpr size_t WS_WO = WS_WL2 + 2 * SZ_WL2;
constexpr size_t SZ_WO = (size_t)D * D * 2;
constexpr size_t WS_WUG = WS_WO + 2 * SZ_WO;
constexpr size_t SZ_WUG = (size_t)2 * DFF * D * 2;
constexpr size_t WS_WD = WS_WUG + 4 * SZ_WUG;
constexpr size_t SZ_WD = (size_t)D * DFF * 2;
constexpr size_t WS_X = al256(WS_WD + 4 * SZ_WD);
constexpr size_t SZ_MD4 = (size_t)M * D * 4;
constexpr size_t WS_H = WS_X + SZ_MD4;
constexpr size_t WS_VF = WS_H + SZ_MD4;
constexpr size_t WS_REG = WS_VF + SZ_MD4;
constexpr size_t WS_QK = WS_REG;
constexpr size_t WS_V = WS_QK + SZ_MD4;
constexpr size_t WS_SG = WS_V + SZ_MD4;
constexpr size_t WS_O = WS_SG + SZ_MD4;
constexpr size_t WS_Y = WS_O + 2 * SZ_MD4;
constexpr size_t WS_R = WS_REG;
constexpr size_t WS_K = WS_R + SZ_MD4;
constexpr size_t WS_VB = WS_K + SZ_MD4;
constexpr size_t WS_WDEC = WS_VB + SZ_MD4;
constexpr size_t WS_NKK = WS_WDEC + SZ_MD4;
constexpr size_t WS_KKA = WS_NKK + SZ_MD4;
constexpr size_t WS_YW = WS_KKA + SZ_MD4;
constexpr size_t WS_L2 = WS_YW + SZ_MD4;
constexpr size_t WS_A2 = WS_L2 + 4 * SZ_MD4;
constexpr size_t WS_Z = al256(WS_A2 + (size_t)M * KL2 * 2);
constexpr size_t WS_RW_END = WS_Z + (size_t)M * D * 2;
constexpr size_t SZ_FF2 = (size_t)M * DFF * 2;
constexpr size_t WS_U = WS_REG;
constexpr size_t WS_G = al256(WS_U + SZ_FF2);
constexpr size_t WS_ACT = al256(WS_G + SZ_FF2);
constexpr size_t WS_XB = al256(WS_RW_END) + 2 * (size_t)D * 2;
constexpr size_t WS_SS = al256(WS_XB + (size_t)(M + 126) * D * 2);
constexpr size_t WS_PTRS = al256(WS_SS + (size_t)8 * M * 16 * 4);
constexpr size_t WS_END = WS_PTRS + 256;

#define LAS __attribute__((address_space(3)))
typedef unsigned short bf16;
typedef unsigned v4u __attribute__((ext_vector_type(4)));
typedef unsigned v2u __attribute__((ext_vector_type(2)));
using pg8::f32x4;
using pg8::Unit;
using pg8::bf16x8;

struct Params { const float* in[N_IN]; float* out; unsigned char* ws; };

__device__ __forceinline__ unsigned cvt_pk_bf16(float lo, float hi) { unsigned r; asm("v_cvt_pk_bf16_f32 %0, %1, %2" : "=v"(r) : "v"(lo), "v"(hi)); return r; }
__device__ __forceinline__ float bf_lo(unsigned w) { return __uint_as_float(w << 16); }
__device__ __forceinline__ float bf_hi(unsigned w) { return __uint_as_float(w & 0xffff0000u); }
__device__ __forceinline__ void unpack8(const v4u w, float (&f)[8]) { f[0] = bf_lo(w.x); f[1] = bf_hi(w.x); f[2] = bf_lo(w.y); f[3] = bf_hi(w.y); f[4] = bf_lo(w.z); f[5] = bf_hi(w.z); f[6] = bf_lo(w.w); f[7] = bf_hi(w.w); }
__device__ __forceinline__ v4u pack8(const float (&f)[8]) { v4u w; w.x = cvt_pk_bf16(f[0], f[1]); w.y = cvt_pk_bf16(f[2], f[3]); w.z = cvt_pk_bf16(f[4], f[5]); w.w = cvt_pk_bf16(f[6], f[7]); return w; }
__device__ __forceinline__ float wave_sum(float v) {
#pragma unroll
    for (int o = 1; o < 64; o <<= 1) v += __shfl_xor(v, o);
    return v;
}
__device__ __forceinline__ float sigmoidf_(float x) { return 1.f / (1.f + __expf(-x)); }
__device__ __forceinline__ float siluf_(float x) { return x / (1.f + __expf(-x)); }
__device__ __forceinline__ float tanhf_(float x) { return 1.f - 2.f / (1.f + __expf(2.f * x)); }

__device__ __forceinline__ float row_rstd(const unsigned char* ws, int slot, int row) {
    const f32x4* q = (const f32x4*)((const float*)(ws + WS_SS) + ((size_t)slot * M + row) * 16);
    const f32x4 a = q[0], b = q[1], c = q[2], d = q[3];
    const float ss = (((a.x + a.y) + (a.z + a.w)) + ((b.x + b.y) + (b.z + b.w))) + (((c.x + c.y) + (c.z + c.w)) + ((d.x + d.y) + (d.z + d.w)));
    return rsqrtf(ss * (1.f / D) + 1e-6f);
}
__device__ __forceinline__ float dpp_ror1(float v) { return __int_as_float(__builtin_amdgcn_update_dpp(0, __float_as_int(v), 0x121, 0xf, 0xf, false)); }
__device__ __forceinline__ float dpp_ror2(float v) { return __int_as_float(__builtin_amdgcn_update_dpp(0, __float_as_int(v), 0x122, 0xf, 0xf, false)); }
enum { EK_RETIN = 0, EK_RESID, EK_UG, EK_RWPROJ, EK_F32 };
template <int GRP> struct EpiAnyT {
    static constexpr bool AFTER_DRAIN = false;
    int kind; bool perm; int jl; unsigned char* ws; int slot; const LAS float* rtab; float amul; int li; LAS unsigned char* ldsb; const float* pcw; const float* pcb; const float* pcst; float* pout;
    __device__ __forceinline__ void operator()(const f32x4 (&acc)[2][2][4][2], const Unit& u, int wr, int wc, int fr, int fq) const {
        const int row0 = u.pm * 256 + wr * 64 + fr;
        if (GRP == 0 && kind == EK_RETIN) {
            bf16* QK = (bf16*)(ws + WS_QK); bf16* V = (bf16*)(ws + WS_V); bf16* SG = (bf16*)(ws + WS_SG); const float* CS = (const float*)(ws + WS_CS);
            const int cw = wc * 32 + 8 * fq;
            if (u.pn < 8) {
                const bool isk = u.pn >= 4; const int h = u.pn & 3; const float sc = isk ? 0.0625f : 1.f;
                bf16* base = QK + (isk ? 1024 : 0) + h * 256 + cw;
#pragma unroll
                for (int ai = 0; ai < 2; ++ai) {
                    f32x4 tt[4][4];
#pragma unroll
                    for (int m = 0; m < 4; ++m) { const int row = row0 + ai * 128 + m * 16; const int pi = row < MP ? row % TP : TP;
                        const f32x4* cs = (const f32x4*)(CS + ((size_t)pi * 128 + cw) * 2);
#pragma unroll
                        for (int q4 = 0; q4 < 4; ++q4) tt[m][q4] = cs[q4]; }
#pragma unroll
                    for (int m = 0; m < 4; ++m) {
                        const int row = row0 + ai * 128 + m * 16;
                        const float rs = rtab[u.ord * 256 + (row - u.pm * 256)] * sc;
                        const f32x4 t0 = tt[m][0], t1 = tt[m][1], t2 = tt[m][2], t3 = tt[m][3];
                        const float c[8] = {t0.x, t0.z, t1.x, t1.z, t2.x, t2.z, t3.x, t3.z}, s[8] = {t0.y, t0.w, t1.y, t1.w, t2.y, t2.w, t3.y, t3.w};
                        float o1[8], o2[8];
#pragma unroll
                        for (int n = 0; n < 2; ++n)
#pragma unroll
                            for (int j = 0; j < 4; ++j) {
                                const float x1 = acc[ai][0][m][n][j], x2 = acc[ai][1][m][n][j];
                                o1[n * 4 + j] = (x1 * c[n * 4 + j] - x2 * s[n * 4 + j]) * rs;
                                o2[n * 4 + j] = (x1 * s[n * 4 + j] + x2 * c[n * 4 + j]) * rs;
                            }
                        bf16* rp = base + (size_t)row * 2048;
                        *(v4u*)rp = pack8(o1); *(v4u*)(rp + 128) = pack8(o2);
                    }
                    asm volatile("" ::: "memory");
                }
            } else {
                const bool isg = u.pn >= 16;
                bf16* base = (isg ? SG : V) + ((u.pn - (isg ? 16 : 8)) * 256) + cw;
#pragma unroll
                for (int ai = 0; ai < 2; ++ai)
#pragma unroll
                    for (int m = 0; m < 4; ++m) {
                        bf16* rp = base + (size_t)(row0 + ai * 128 + m * 16) * 2048;
                        const float rs = rtab[u.ord * 256 + (wr * 64 + fr + ai * 128 + m * 16)];
#pragma unroll
                        for (int bj = 0; bj < 2; ++bj) {
                            float o[8];
#pragma unroll
                            for (int n = 0; n < 2; ++n)
#pragma unroll
                                for (int j = 0; j < 4; ++j) { const float x = acc[ai][bj][m][n][j] * rs; o[n * 4 + j] = isg ? siluf_(x) : x; }
                            *(v4u*)(rp + bj * 128) = pack8(o);
                        }
                    }
            }
        } else if (GRP == 0 && kind == EK_RESID) {
            float* X = (float*)(ws + WS_X);
            const int col0 = u.pn * 256 + wc * 32 + 4 * fq;
#pragma unroll
            for (int am = 0; am < 4; ++am) { const int ai = am >> 1, mb = (am & 1) * 2;
                f32x4 xv[2][2][2];
#pragma unroll
                for (int mm = 0; mm < 2; ++mm) { const int m = mb + mm; const float* rp = X + (size_t)(row0 + ai * 128 + m * 16) * D + col0;
#pragma unroll
                    for (int bj = 0; bj < 2; ++bj)
#pragma unroll
                        for (int n = 0; n < 2; ++n) xv[mm][bj][n] = *(const f32x4*)(rp + bj * 128 + n * 16); }
#pragma unroll
                for (int mm = 0; mm < 2; ++mm) { const int m = mb + mm;
                    const int row = row0 + ai * 128 + m * 16;
                    float* rp = X + (size_t)row * D + col0; bf16* xb = (bf16*)(ws + WS_XB) + (size_t)row * D + col0;
                    float ssq = 0.f;
#pragma unroll
                    for (int bj = 0; bj < 2; ++bj)
#pragma unroll
                        for (int n = 0; n < 2; ++n) { const f32x4 v = xv[mm][bj][n] + acc[ai][bj][m][n] * amul; *(f32x4*)(rp + bj * 128 + n * 16) = v;
                            if (slot >= 0) { ssq += (v.x * v.x + v.y * v.y) + (v.z * v.z + v.w * v.w); v2u w; w.x = cvt_pk_bf16(v.x, v.y); w.y = cvt_pk_bf16(v.z, v.w); *(v2u*)(xb + bj * 128 + n * 16) = w; } }
                    if (slot >= 0) { ssq += __shfl_xor(ssq, 16); ssq += __shfl_xor(ssq, 32); if (fq == 0) ((float*)(ws + WS_SS))[((size_t)slot * M + row) * 16 + u.pn * 4 + wc] = ssq; }
                }
                asm volatile("" ::: "memory");
            }
        } else if (GRP == 1 && kind == EK_UG) {
            const float* cw = pcw + (size_t)li * 3 * DFF; const float* cb = pcb + (size_t)li * DFF; const float* cst = pcst + (size_t)li * SB * 2 * DFF;
            float* cvp = pout + O_CVP + (size_t)li * BATCH * 2 * DFF; float* cvs = pout + O_CVS + (size_t)li * SB * 2 * DFF;
            bf16* ACT = (bf16*)(ws + WS_ACT);
            const int fl = wc * 32 + 8 * fq;
            LAS float* halo = (LAS float*)(ldsb + 131072 + 8192);
            const LAS float* rt = rtab + u.ord * 256;
#pragma unroll
            for (int ai = 0; ai < 2; ++ai) if (fr >= 14) {
                const float rs = rt[128 * ai + 64 * wr + 48 + fr];
                LAS float* hp = halo + ((2 * ai + wr) * 2 + (fr - 14)) * 128 + fl;
                *(LAS f32x4*)hp = acc[ai][1][3][0] * rs; *(LAS f32x4*)(hp + 4) = acc[ai][1][3][1] * rs;
            }
            asm volatile("s_waitcnt lgkmcnt(0)" ::: "memory"); __builtin_amdgcn_s_barrier(); asm volatile("" ::: "memory");
#pragma unroll
            for (int n = 0; n < 2; ++n) {
                const int f0 = u.pn * 128 + fl + 4 * n;
                const f32x4 w0 = *(const f32x4*)(cw + f0), w1 = *(const f32x4*)(cw + DFF + f0), w2 = *(const f32x4*)(cw + 2 * DFF + f0), bb = *(const f32x4*)(cb + f0);
                f32x4 prev = (f32x4){0.f, 0.f, 0.f, 0.f};
#pragma unroll
                for (int ai = 0; ai < 2; ++ai)
#pragma unroll
                    for (int m = 0; m < 4; ++m) {
                        const int l = 128 * ai + 64 * wr + 16 * m + fr, row = 254 * u.pm - 2 + l;
                        const float rs = rt[l];
                        const f32x4 cur = acc[ai][1][m][n] * rs, uu = acc[ai][0][m][n] * rs;
                        if (m == 0) {
                            const int B = 2 * ai + wr;
                            prev = (f32x4){0.f, 0.f, 0.f, 0.f};
                            if (B > 0 && fr >= 14) prev = *(const LAS f32x4*)(halo + ((B - 1) * 2 + (fr - 14)) * 128 + fl + 4 * n);
                        }
                        f32x4 g1, g2;
                        {
                            const float c1x = dpp_ror1(cur.x), c1y = dpp_ror1(cur.y), c1z = dpp_ror1(cur.z), c1w = dpp_ror1(cur.w);
                            const float p1x = dpp_ror1(prev.x), p1y = dpp_ror1(prev.y), p1z = dpp_ror1(prev.z), p1w = dpp_ror1(prev.w);
                            const float c2x = dpp_ror2(cur.x), c2y = dpp_ror2(cur.y), c2z = dpp_ror2(cur.z), c2w = dpp_ror2(cur.w);
                            const float p2x = dpp_ror2(prev.x), p2y = dpp_ror2(prev.y), p2z = dpp_ror2(prev.z), p2w = dpp_ror2(prev.w);
                            const bool s1 = fr >= 1, s2 = fr >= 2;
                            g1.x = s1 ? c1x : p1x; g1.y = s1 ? c1y : p1y; g1.z = s1 ? c1z : p1z; g1.w = s1 ? c1w : p1w;
                            g2.x = s2 ? c2x : p2x; g2.y = s2 ? c2y : p2y; g2.z = s2 ? c2z : p2z; g2.w = s2 ? c2w : p2w;
                        }
                        if (l >= 2 && row < M) {
                            if (row < MP) {
                                const int b = row / TP, t = row - b * TP;
                                if (t < 2) { g2 = (f32x4){0.f, 0.f, 0.f, 0.f}; if (t == 0) g1 = g2; }
                                if (t >= TP - 2) *(f32x4*)(cvp + ((size_t)b * 2 + (t - (TP - 2))) * DFF + f0) = cur;
                            } else {
                                const int s = row - MP;
                                const float* c0 = cst + ((size_t)s * 2 + 0) * DFF + f0;
                                g2 = *(const f32x4*)c0; g1 = *(const f32x4*)(c0 + DFF);
                                float* o = cvs + ((size_t)s * 2 + 0) * DFF + f0;
                                *(f32x4*)o = g1; *(f32x4*)(o + DFF) = cur;
                            }
                            const f32x4 cv = bb + w0 * g2 + w1 * g1 + w2 * cur;
                            v2u w; w.x = cvt_pk_bf16(siluf_(cv.x) * uu.x, siluf_(cv.y) * uu.y); w.y = cvt_pk_bf16(siluf_(cv.z) * uu.z, siluf_(cv.w) * uu.w);
                            *(v2u*)(ACT + (size_t)row * DFF + f0) = w;
#ifdef CONV_CHECK
                            { v2u wu; wu.x = cvt_pk_bf16(uu.x, uu.y); wu.y = cvt_pk_bf16(uu.z, uu.w); *(v2u*)((bf16*)(ws + WS_U) + (size_t)row * DFF + f0) = wu;
                              v2u wg; wg.x = cvt_pk_bf16(cur.x, cur.y); wg.y = cvt_pk_bf16(cur.z, cur.w); *(v2u*)((bf16*)(ws + WS_G) + (size_t)row * DFF + f0) = wg; }
#endif
                        }
                        prev = cur;
                    }
            }
        } else if (GRP == 0 && kind == EK_RWPROJ) {
            const int cl = wc * 32 + 4 * fq;
            if (u.pn < 12) {
                float* dst = (float*)(ws + (u.pn < 4 ? WS_R : (u.pn < 8 ? WS_K : (jl == 0 ? WS_VF : WS_VB)))) + (u.pn & 3) * 256 + cl;
#pragma unroll
                for (int ai = 0; ai < 2; ++ai)
#pragma unroll
                    for (int m = 0; m < 4; ++m) {
                        float* rp = dst + (size_t)(row0 + ai * 128 + m * 16) * D;
#pragma unroll
                        for (int bj = 0; bj < 2; ++bj)
#pragma unroll
                            for (int n = 0; n < 2; ++n) *(f32x4*)(rp + bj * 128 + n * 16) = acc[ai][bj][m][n];
                    }
            } else {
                bf16* A2 = (bf16*)(ws + WS_A2);
#pragma unroll
                for (int bj = 0; bj < 2; ++bj)
#pragma unroll
                    for (int n = 0; n < 2; ++n) {
                        const int c = (u.pn - 12) * 256 + bj * 128 + cl + 16 * n;
                        if (c < KL2) {
                            const int kd = c < 64 ? 1 : ((c >= 128 && c < 288) ? 2 : 0);
#pragma unroll
                            for (int ai = 0; ai < 2; ++ai)
#pragma unroll
                                for (int m = 0; m < 4; ++m) {
                                    f32x4 v = acc[ai][bj][m][n];
                                    if (kd == 1) { v.x = tanhf_(v.x); v.y = tanhf_(v.y); v.z = tanhf_(v.z); v.w = tanhf_(v.w); }
                                    else if (kd == 2) { v.x = sigmoidf_(v.x); v.y = sigmoidf_(v.y); v.z = sigmoidf_(v.z); v.w = sigmoidf_(v.w); }
                                    v2u w; w.x = cvt_pk_bf16(v.x, v.y); w.y = cvt_pk_bf16(v.z, v.w);
                                    *(v2u*)(A2 + (size_t)(row0 + ai * 128 + m * 16) * KL2 + c) = w;
                                }
                        }
                    }
            }
        } else if (GRP == 0) {
            float* C = (float*)(ws + WS_L2); constexpr int ldc = NL2;
            const int col0 = u.pn * 256 + wc * 32 + 4 * fq;
#pragma unroll
            for (int ai = 0; ai < 2; ++ai)
#pragma unroll
                for (int m = 0; m < 4; ++m) {
                    float* rp = C + (size_t)(row0 + ai * 128 + m * 16) * ldc + col0;
#pragma unroll
                    for (int bj = 0; bj < 2; ++bj)
#pragma unroll
                        for (int n = 0; n < 2; ++n) *(f32x4*)(rp + bj * 128 + n * 16) = acc[ai][bj][m][n];
                }
        }
    }
};

constexpr int MT0 = 16384;
__device__ __forceinline__ void tail_resid(const bf16* __restrict__ A, const bf16* __restrict__ Bt, int K, unsigned char* ws, int slot, float amul, LAS unsigned char* lds, int lane, int wave) {
    const int fr = lane & 15, fq = lane >> 4;
    float* X = (float*)(ws + WS_X);
    const int kw = K >> 3;
    for (int job = blockIdx.x; job < 16 * 16; job += gridDim.x) {
        const int rs = job >> 4, cs = job & 15;
        const bf16* ap = A + (size_t)(MT0 + 16 * rs + fr) * K + wave * kw + 8 * fq;
        const bf16* bp = Bt + (size_t)(64 * cs + fr) * K + wave * kw + 8 * fq;
        f32x4 acc[4];
#pragma unroll
        for (int t = 0; t < 4; ++t) acc[t] = (f32x4){0.f, 0.f, 0.f, 0.f};
#pragma unroll 4
        for (int k0 = 0; k0 < kw; k0 += 32) {
            const bf16x8 af = *(const bf16x8*)(ap + k0);
#pragma unroll
            for (int t = 0; t < 4; ++t) { const bf16x8 bf = *(const bf16x8*)(bp + (size_t)(16 * t) * K + k0); acc[t] = __builtin_amdgcn_mfma_f32_16x16x32_bf16(bf, af, acc[t], 0, 0, 0); }
        }
        __syncthreads();
#pragma unroll
        for (int t = 0; t < 4; ++t) *(LAS f32x4*)(lds + ((wave * 4 + t) * 64 + lane) * 16) = acc[t];
        __syncthreads();
        if (wave == 0) {
#pragma unroll
            for (int t = 0; t < 4; ++t) { f32x4 s = acc[t];
#pragma unroll
                for (int w = 1; w < 8; ++w) s += *(LAS f32x4*)(lds + ((w * 4 + t) * 64 + lane) * 16);
                acc[t] = s; }
            const int row = MT0 + 16 * rs + fr;
            float* rp = X + (size_t)row * D + 64 * cs + 4 * fq; bf16* xb = (bf16*)(ws + WS_XB) + (size_t)row * D + 64 * cs + 4 * fq;
            float ssq = 0.f;
#pragma unroll
            for (int t = 0; t < 4; ++t) { const f32x4 v = *(const f32x4*)(rp + 16 * t) + acc[t] * amul; *(f32x4*)(rp + 16 * t) = v;
                if (slot >= 0) { ssq += (v.x * v.x + v.y * v.y) + (v.z * v.z + v.w * v.w); v2u w; w.x = cvt_pk_bf16(v.x, v.y); w.y = cvt_pk_bf16(v.z, v.w); *(v2u*)(xb + 16 * t) = w; } }
            if (slot >= 0) { ssq += __shfl_xor(ssq, 16); ssq += __shfl_xor(ssq, 32); if (fq == 0) ((float*)(ws + WS_SS))[((size_t)slot * M + row) * 16 + cs] = ssq; }
        }
    }
}

__device__ __forceinline__ void tr_item(const float* __restrict__ W, int ldw, int k0, int n0, bf16* __restrict__ WT, int ldt, int drow, const float* __restrict__ mu, LAS float* scr, int lane, const float* __restrict__ gs = nullptr) {
#pragma unroll 8
    for (int i = 0; i < 32; ++i) { const int kk = 2 * i + (lane >> 5); scr[kk * 33 + (lane & 31)] = W[(size_t)(k0 + kk) * ldw + n0 + (lane & 31)]; }
    asm volatile("s_waitcnt lgkmcnt(0)" ::: "memory");
    const int c = lane & 7;
    float mv[8];
    if (mu) {
#pragma unroll
        for (int e = 0; e < 8; ++e) mv[e] = mu[k0 + 8 * c + e];
    } else if (gs) {
#pragma unroll
        for (int e = 0; e < 8; ++e) mv[e] = gs[k0 + 8 * c + e];
    }
#pragma unroll
    for (int j = 0; j < 4; ++j) {
        const int n = (lane >> 3) + 8 * j; const LAS float* s = scr + (8 * c) * 33 + n;
        float f[8];
#pragma unroll
        for (int e = 0; e < 8; ++e) f[e] = s[e * 33];
        bf16* dp = WT + (size_t)(drow + n) * ldt + k0 + 8 * c;
        if (mu) {
            float f1[8], f2[8];
#pragma unroll
            for (int e = 0; e < 8; ++e) { f1[e] = f[e] * (1.f - mv[e]); f2[e] = f[e] * mv[e]; }
            *(v4u*)dp = pack8(f1); *(v4u*)(dp + 1024) = pack8(f2);
        } else { if (gs) {
#pragma unroll
            for (int e = 0; e < 8; ++e) f[e] *= mv[e]; }
            *(v4u*)dp = pack8(f); }
    }
    asm volatile("s_waitcnt lgkmcnt(0)" ::: "memory");
}

__device__ __forceinline__ void ph_p0(const Params& p, LAS unsigned char* lds, int tid, int lane, int wave) {
    unsigned char* ws = p.ws;
    LAS float* scr = (LAS float*)(lds + wave * 16384);
    const int gw = blockIdx.x * NWAVES + wave, NGW = gridDim.x * NWAVES;
    constexpr int C_WIN = 2 * 16 * 192, C_WOUT = 2 * 32 * 32, C_RKV = 2 * 3 * 512, C_W1 = 2 * 32, C_A1 = 2 * 32, C_G1 = 2 * 80, C_V1 = 16, C_WO = 2 * 512, C_WUG = 4 * 16 * 176, C_WD = 4 * 44 * 32;
    constexpr int NITEMS = C_WIN + C_WOUT + C_RKV + C_W1 + C_A1 + C_G1 + C_V1 + C_WO + C_WUG + C_WD;
    for (int it = gw; it < NITEMS; it += NGW) {
        int r = it;
        if (r < C_WIN) { const int j = r / 3072, q = r % 3072, kb = q / 192, nb = q % 192;
            tr_item(p.in[I_RWIN] + (size_t)j * D * RWIN, RWIN, 64 * kb, 32 * nb, (bf16*)(ws + WS_WIN + j * SZ_WIN), D, 32 * nb, nullptr, scr, lane, p.in[I_NMIX] + (size_t)(2 * j) * D); continue; }
        r -= C_WIN;
        if (r < C_WOUT) { const int j = r / 1024, q = r % 1024, kb = q / 32, nb = q % 32;
            tr_item(p.in[I_RWOUT] + (size_t)j * RV * D, D, 64 * kb, 32 * nb, (bf16*)(ws + WS_WOUT + j * SZ_WOUT), RV, 32 * nb, nullptr, scr, lane); continue; }
        r -= C_WOUT;
        if (r < C_RKV) { const int j = r / 1536, q = r % 1536, s = q / 512, q2 = q % 512, kb = q2 / 32, nb = q2 % 32, c = (s == 0 ? 0 : (s == 1 ? 2 : 3));
            tr_item(p.in[I_WRKV] + (size_t)(j * 3 + s) * D * D, D, 64 * kb, 32 * nb, (bf16*)(ws + WS_WRW + j * SZ_WRW), KRW, s * 1024 + 32 * nb, p.in[I_MU] + (size_t)(j * 6 + c) * D, scr, lane); continue; }
        r -= C_RKV;
        if (r < C_W1) { const int j = r / 32, q = r % 32, kb = q / 2, nb = q % 2;
            tr_item(p.in[I_W1] + (size_t)j * D * LW, LW, 64 * kb, 32 * nb, (bf16*)(ws + WS_WRW + j * SZ_WRW), KRW, 3072 + 32 * nb, p.in[I_MU] + (size_t)(j * 6 + 1) * D, scr, lane); continue; }
        r -= C_W1;
        if (r < C_A1) { const int j = r / 32, q = r % 32, kb = q / 2, nb = q % 2;
            tr_item(p.in[I_A1] + (size_t)j * D * LA, LA, 64 * kb, 32 * nb, (bf16*)(ws + WS_WRW + j * SZ_WRW), KRW, 3136 + 32 * nb, p.in[I_MU] + (size_t)(j * 6 + 4) * D, scr, lane); continue; }
        r -= C_A1;
        if (r < C_G1) { const int j = r / 80, q = r % 80, kb = q / 5, nb = q % 5;
            tr_item(p.in[I_G1] + (size_t)j * D * LG, LG, 64 * kb, 32 * nb, (bf16*)(ws + WS_WRW + j * SZ_WRW), KRW, 3200 + 32 * nb, p.in[I_MU] + (size_t)(j * 6 + 5) * D, scr, lane); continue; }
        r -= C_G1;
        if (r < C_V1) { const int kb = r;
            tr_item(p.in[I_V1], LV, 64 * kb, 0, (bf16*)(ws + WS_WRW + 1 * SZ_WRW), KRW, 3360, p.in[I_MU] + (size_t)(1 * 6 + 3) * D, scr, lane); continue; }
        r -= C_V1;
        if (r < C_WO) { const int j = r / 512, q = r % 512, kb = q / 32, nb = q % 32;
            tr_item(p.in[I_WO] + (size_t)j * D * D, D, 64 * kb, 32 * nb, (bf16*)(ws + WS_WO + j * SZ_WO), D, 32 * nb, nullptr, scr, lane); continue; }
        r -= C_WO;
        if (r < C_WUG) { const int i = r / 2816, q = r % 2816, kb = q / 176, nb = q % 176, n0 = 32 * nb;
            const int drow = n0 < DFF ? 256 * (n0 / 128) + (n0 % 128) : 256 * ((n0 - DFF) / 128) + 128 + ((n0 - DFF) % 128);
            tr_item(p.in[I_WUG] + (size_t)i * D * 2 * DFF, 2 * DFF, 64 * kb, n0, (bf16*)(ws + WS_WUG + i * SZ_WUG), D, drow, nullptr, scr, lane, p.in[I_NFFN] + (size_t)i * D); continue; }
        r -= C_WUG;
        { const int i = r / 1408, q = r % 1408, kb = q / 32, nb = q % 32;
            tr_item(p.in[I_WD] + (size_t)i * DFF * D, D, 64 * kb, 32 * nb, (bf16*)(ws + WS_WD + i * SZ_WD), DFF, 32 * nb, nullptr, scr, lane); }
    }
    const size_t gt = (size_t)blockIdx.x * NTHR + tid, GT = (size_t)gridDim.x * NTHR;
    for (size_t i = gt; i < (size_t)(224 + 192) * (KRW / 8); i += GT) {
        const int rr = (int)(i / (KRW / 8)), c8 = (int)(i % (KRW / 8));
        const int j = rr < 224 ? 0 : 1, row = rr < 224 ? 3360 + rr : 3392 + (rr - 224);
        *(v4u*)((bf16*)(ws + WS_WRW + j * SZ_WRW) + (size_t)row * KRW + c8 * 8) = (v4u){0u, 0u, 0u, 0u};
    }
    for (size_t i = gt; i < (size_t)2 * NL2 * KL2; i += GT) {
        const int j = (int)(i / ((size_t)NL2 * KL2)); const int rem = (int)(i % ((size_t)NL2 * KL2)); const int n = rem / KL2, k = rem % KL2, grp = n >> 10, nn = n & 1023;
        float v = 0.f;
        if (grp == 0) { if (k < 64) v = p.in[I_W2][((size_t)j * LW + k) * D + nn]; }
        else if (grp == 1) { if (k >= 64 && k < 128) v = p.in[I_A2][((size_t)j * LA + (k - 64)) * D + nn]; }
        else if (grp == 2) { if (k >= 128 && k < 288) v = p.in[I_G2][((size_t)j * LG + (k - 128)) * D + nn]; }
        else { if (j == 1 && k >= 288 && k < 320) v = p.in[I_V2][((size_t)(k - 288)) * D + nn]; }
        ((bf16*)(ws + WS_WL2 + j * SZ_WL2))[(size_t)n * KL2 + k] = (bf16)(cvt_pk_bf16(v, 0.f) & 0xffffu);
    }
    for (size_t i = gt; i < (size_t)(TP + 1) * 128; i += GT) {
        const int pi = (int)(i >> 7), mi = (int)(i & 127);
        const float pos = pi < TP ? (float)pi : PAST_POS;
        const float inv = 1.0f / powf(10000.0f, (float)mi / 127.0f);
        float s, c; sincosf(pos * inv, &s, &c);
        ((float2*)(ws + WS_CS))[i] = make_float2(c, s);
    }
    float* X = (float*)(ws + WS_X); bf16* XB = (bf16*)(ws + WS_XB);
    for (int r = gw; r < M; r += NGW) {
        const float* src;
        if (r < MP) { const int b = r / TP, t = r % TP; src = t < NMETA ? p.in[I_META] + (size_t)t * D : p.in[I_XP] + ((size_t)b * SEQ + (t - NMETA)) * D; }
        else src = p.in[I_XS] + (size_t)(r - MP) * D;
        float ss = 0.f;
#pragma unroll
        for (int j = 0; j < 2; ++j) { const int c0 = 512 * j + 8 * lane;
            const f32x4 a4 = *(const f32x4*)(src + c0), b4 = *(const f32x4*)(src + c0 + 4);
            *(f32x4*)(X + (size_t)r * D + c0) = a4; *(f32x4*)(X + (size_t)r * D + c0 + 4) = b4;
            const float f[8] = {a4.x, a4.y, a4.z, a4.w, b4.x, b4.y, b4.z, b4.w};
#pragma unroll
            for (int e = 0; e < 8; ++e) ss += f[e] * f[e];
            *(v4u*)(XB + (size_t)r * D + c0) = pack8(f); }
        ss = wave_sum(ss);
        if (lane < 16) ((float*)(ws + WS_SS))[(size_t)r * 16 + lane] = lane == 0 ? ss : 0.f;
    }
}

__device__ __forceinline__ void ph_norm(const Params& p, const float* __restrict__ g, int mode, int jl, int lane, int wave) {
    const float* X = (const float*)(p.ws + WS_X); bf16* H = (bf16*)(p.ws + WS_H);
    const int gw = blockIdx.x * NWAVES + wave, NGW = gridDim.x * NWAVES;
    for (int row = gw; row < M; row += NGW) {
        const float* xr = X + (size_t)row * D;
        float v[2][8]; float ss = 0.f;
#pragma unroll
        for (int j = 0; j < 2; ++j) {
            const f32x4 a = *(const f32x4*)(xr + 512 * j + 8 * lane), b = *(const f32x4*)(xr + 512 * j + 8 * lane + 4);
            v[j][0] = a.x; v[j][1] = a.y; v[j][2] = a.z; v[j][3] = a.w; v[j][4] = b.x; v[j][5] = b.y; v[j][6] = b.z; v[j][7] = b.w;
#pragma unroll
            for (int e = 0; e < 8; ++e) ss += v[j][e] * v[j][e];
        }
        ss = wave_sum(ss);
        const float rstd = rsqrtf(ss * (1.f / D) + 1e-6f);
        const bool prompt = row < MP; const int b = prompt ? row / TP : 0, t = prompt ? row % TP : 0;
#pragma unroll
        for (int j = 0; j < 2; ++j) {
            const int c0 = 512 * j + 8 * lane;
            const f32x4 ga = *(const f32x4*)(g + c0), gb = *(const f32x4*)(g + c0 + 4);
            float o[8];
            o[0] = v[j][0] * rstd * ga.x; o[1] = v[j][1] * rstd * ga.y; o[2] = v[j][2] * rstd * ga.z; o[3] = v[j][3] * rstd * ga.w;
            o[4] = v[j][4] * rstd * gb.x; o[5] = v[j][5] * rstd * gb.y; o[6] = v[j][6] * rstd * gb.z; o[7] = v[j][7] * rstd * gb.w;
            if (mode == 0) { *(v4u*)(H + (size_t)row * D + c0) = pack8(o); }
            else if (mode == 1) {
                const v4u w = pack8(o);
                *(v4u*)(H + (size_t)row * 2048 + c0) = w;
                if (prompt) {
                    if (t != TP - 1) *(v4u*)(H + (size_t)(row + 1) * 2048 + 1024 + c0) = w;
                    else { float* so = p.out + O_SHP + ((size_t)jl * BATCH + b) * D + c0; *(f32x4*)so = (f32x4){o[0], o[1], o[2], o[3]}; *(f32x4*)(so + 4) = (f32x4){o[4], o[5], o[6], o[7]}; }
                    if (t == 0) *(v4u*)(H + (size_t)row * 2048 + 1024 + c0) = (v4u){0u, 0u, 0u, 0u};
                } else {
                    const int s = row - MP;
                    const float* sp = p.in[I_SSHIFT] + ((size_t)jl * SB + s) * D + c0;
                    const f32x4 sa = *(const f32x4*)sp, sb2 = *(const f32x4*)(sp + 4);
                    const float pv[8] = {sa.x, sa.y, sa.z, sa.w, sb2.x, sb2.y, sb2.z, sb2.w};
                    *(v4u*)(H + (size_t)row * 2048 + 1024 + c0) = pack8(pv);
                    float* so = p.out + O_SHS + ((size_t)jl * SB + s) * D + c0; *(f32x4*)so = (f32x4){o[0], o[1], o[2], o[3]}; *(f32x4*)(so + 4) = (f32x4){o[4], o[5], o[6], o[7]};
                }
            } else {
                float* dst = nullptr;
                if (prompt) { if (t >= NMETA) dst = p.out + O_YP + ((size_t)b * SEQ + (t - NMETA)) * D + c0; }
                else dst = p.out + O_YS + (size_t)(row - MP) * D + c0;
                if (dst) { *(f32x4*)dst = (f32x4){o[0], o[1], o[2], o[3]}; *(f32x4*)(dst + 4) = (f32x4){o[4], o[5], o[6], o[7]}; }
            }
        }
    }
}

__device__ __forceinline__ void ph_ret_norm(const Params& p, int jl, int lane, int wave) {
    const float* O = (const float*)(p.ws + WS_O); const bf16* SG = (const bf16*)(p.ws + WS_SG); bf16* Y = (bf16*)(p.ws + WS_Y);
    const float* gnw = p.in[I_RGN] + (size_t)jl * RV;
    const int gw = blockIdx.x * NWAVES + wave, NGW = gridDim.x * NWAVES;
    for (int it = gw; it < M * RH; it += NGW) {
        const int row = it >> 2, h = it & 3; const size_t off = (size_t)row * RV + h * RDV + 8 * lane;
        const f32x4 a = *(const f32x4*)(O + off), b = *(const f32x4*)(O + off + 4);
        float v[8] = {a.x, a.y, a.z, a.w, b.x, b.y, b.z, b.w};
        float s = 0.f;
#pragma unroll
        for (int e = 0; e < 8; ++e) s += v[e];
        const float mean = wave_sum(s) * (1.f / RDV);
        float s2 = 0.f;
#pragma unroll
        for (int e = 0; e < 8; ++e) { v[e] -= mean; s2 += v[e] * v[e]; }
        const float rstd = rsqrtf(wave_sum(s2) * (1.f / RDV) + 1e-5f);
        float sg[8]; unpack8(*(const v4u*)(SG + off), sg);
        const f32x4 ga = *(const f32x4*)(gnw + h * RDV + 8 * lane), gb = *(const f32x4*)(gnw + h * RDV + 8 * lane + 4);
        const float gg[8] = {ga.x, ga.y, ga.z, ga.w, gb.x, gb.y, gb.z, gb.w};
        float o[8];
#pragma unroll
        for (int e = 0; e < 8; ++e) o[e] = v[e] * rstd * gg[e] * sg[e];
        *(v4u*)(Y + off) = pack8(o);
    }
}

__device__ __forceinline__ void conv_act8(const float (&u)[8], const float (&g0)[8], const float (&g1)[8], const float (&g2)[8], const float (&w0)[8], const float (&w1)[8], const float (&w2)[8], const float (&bb)[8], bf16* dst) {
    float o[8];
#pragma unroll
    for (int e = 0; e < 8; ++e) { const float cv = bb[e] + w0[e] * g2[e] + w1[e] * g1[e] + w2[e] * g0[e]; o[e] = siluf_(cv) * u[e]; }
    *(v4u*)dst = pack8(o);
}
__device__ __forceinline__ void ph_conv(const Params& p, int li, int tid) {
    const bf16* U = (const bf16*)(p.ws + WS_U); const bf16* G = (const bf16*)(p.ws + WS_G); bf16* ACT = (bf16*)(p.ws + WS_ACT);
    const float* cw = p.in[I_CW] + (size_t)li * 3 * DFF; const float* cb = p.in[I_CB] + (size_t)li * DFF;
    const float* cst = p.in[I_SCONV] + (size_t)li * SB * 2 * DFF;
    float* cvp = p.out + O_CVP + (size_t)li * BATCH * 2 * DFF; float* cvs = p.out + O_CVS + (size_t)li * SB * 2 * DFF;
    const int gt = blockIdx.x * NTHR + tid, GT = gridDim.x * NTHR;
    constexpr int CH = DFF / 8;
    const int nruns = GT / CH, RL = (MP + nruns - 1) / nruns;
    const int c = gt % CH, r = gt / CH, f0 = 8 * c;
    float w0[8], w1[8], w2[8], bb[8];
    { const f32x4 x0 = *(const f32x4*)(cw + f0), x1 = *(const f32x4*)(cw + f0 + 4); w0[0] = x0.x; w0[1] = x0.y; w0[2] = x0.z; w0[3] = x0.w; w0[4] = x1.x; w0[5] = x1.y; w0[6] = x1.z; w0[7] = x1.w; }
    { const f32x4 x0 = *(const f32x4*)(cw + DFF + f0), x1 = *(const f32x4*)(cw + DFF + f0 + 4); w1[0] = x0.x; w1[1] = x0.y; w1[2] = x0.z; w1[3] = x0.w; w1[4] = x1.x; w1[5] = x1.y; w1[6] = x1.z; w1[7] = x1.w; }
    { const f32x4 x0 = *(const f32x4*)(cw + 2 * DFF + f0), x1 = *(const f32x4*)(cw + 2 * DFF + f0 + 4); w2[0] = x0.x; w2[1] = x0.y; w2[2] = x0.z; w2[3] = x0.w; w2[4] = x1.x; w2[5] = x1.y; w2[6] = x1.z; w2[7] = x1.w; }
    { const f32x4 x0 = *(const f32x4*)(cb + f0), x1 = *(const f32x4*)(cb + f0 + 4); bb[0] = x0.x; bb[1] = x0.y; bb[2] = x0.z; bb[3] = x0.w; bb[4] = x1.x; bb[5] = x1.y; bb[6] = x1.z; bb[7] = x1.w; }
    if (r < nruns) {
        const int row0 = r * RL, row1 = (row0 + RL < MP) ? row0 + RL : MP;
        if (row0 < row1) {
            int t = row0 % TP, b = row0 / TP;
            float g1[8], g2[8];
            const size_t off0 = (size_t)row0 * DFF + f0;
            if (t >= 1) unpack8(*(const v4u*)(G + off0 - DFF), g1); else {
#pragma unroll
                for (int e = 0; e < 8; ++e) g1[e] = 0.f; }
            if (t >= 2) unpack8(*(const v4u*)(G + off0 - 2 * DFF), g2); else {
#pragma unroll
                for (int e = 0; e < 8; ++e) g2[e] = 0.f; }
            for (int rowb = row0; rowb < row1; rowb += 4) {
                v4u uc[4], gc[4];
#pragma unroll
                for (int q = 0; q < 4; ++q) { const int rr = (rowb + q < row1) ? rowb + q : row1 - 1; const size_t offq = (size_t)rr * DFF + f0; uc[q] = *(const v4u*)(U + offq); gc[q] = *(const v4u*)(G + offq); }
#pragma unroll
                for (int q = 0; q < 4; ++q) if (rowb + q < row1) {
                    const size_t off = (size_t)(rowb + q) * DFF + f0;
                    float u[8], g0[8];
                    unpack8(uc[q], u); unpack8(gc[q], g0);
                    if (t >= TP - 2) { float* o = cvp + ((size_t)b * 2 + (t - (TP - 2))) * DFF + f0; *(f32x4*)o = (f32x4){g0[0], g0[1], g0[2], g0[3]}; *(f32x4*)(o + 4) = (f32x4){g0[4], g0[5], g0[6], g0[7]}; }
                    conv_act8(u, g0, g1, g2, w0, w1, w2, bb, ACT + off);
                    if (++t == TP) { t = 0; ++b;
#pragma unroll
                        for (int e = 0; e < 8; ++e) { g1[e] = 0.f; g2[e] = 0.f; } }
                    else {
#pragma unroll
                        for (int e = 0; e < 8; ++e) { g2[e] = g1[e]; g1[e] = g0[e]; } }
                }
            }
        }
    }
    for (int i = gt; i < SB * CH; i += GT) {
        const int s = i / CH, fs = (i % CH) * 8, row = MP + s;
        const size_t off = (size_t)row * DFF + fs;
        float u[8], g0[8], g1[8], g2[8], v0[8], v1[8], v2[8], vb[8];
        unpack8(*(const v4u*)(U + off), u); unpack8(*(const v4u*)(G + off), g0);
        const float* c0 = cst + ((size_t)s * 2 + 0) * DFF + fs; const float* c1 = c0 + DFF;
        const f32x4 a0 = *(const f32x4*)c0, a1 = *(const f32x4*)(c0 + 4), b0 = *(const f32x4*)c1, b1 = *(const f32x4*)(c1 + 4);
        g2[0] = a0.x; g2[1] = a0.y; g2[2] = a0.z; g2[3] = a0.w; g2[4] = a1.x; g2[5] = a1.y; g2[6] = a1.z; g2[7] = a1.w;
        g1[0] = b0.x; g1[1] = b0.y; g1[2] = b0.z; g1[3] = b0.w; g1[4] = b1.x; g1[5] = b1.y; g1[6] = b1.z; g1[7] = b1.w;
        float* o = cvs + ((size_t)s * 2 + 0) * DFF + fs;
        *(f32x4*)o = b0; *(f32x4*)(o + 4) = b1;
        *(f32x4*)(o + DFF) = (f32x4){g0[0], g0[1], g0[2], g0[3]}; *(f32x4*)(o + DFF + 4) = (f32x4){g0[4], g0[5], g0[6], g0[7]};
        { const f32x4 x0 = *(const f32x4*)(cw + fs), x1 = *(const f32x4*)(cw + fs + 4); v0[0] = x0.x; v0[1] = x0.y; v0[2] = x0.z; v0[3] = x0.w; v0[4] = x1.x; v0[5] = x1.y; v0[6] = x1.z; v0[7] = x1.w; }
        { const f32x4 x0 = *(const f32x4*)(cw + DFF + fs), x1 = *(const f32x4*)(cw + DFF + fs + 4); v1[0] = x0.x; v1[1] = x0.y; v1[2] = x0.z; v1[3] = x0.w; v1[4] = x1.x; v1[5] = x1.y; v1[6] = x1.z; v1[7] = x1.w; }
        { const f32x4 x0 = *(const f32x4*)(cw + 2 * DFF + fs), x1 = *(const f32x4*)(cw + 2 * DFF + fs + 4); v2[0] = x0.x; v2[1] = x0.y; v2[2] = x0.z; v2[3] = x0.w; v2[4] = x1.x; v2[5] = x1.y; v2[6] = x1.z; v2[7] = x1.w; }
        { const f32x4 x0 = *(const f32x4*)(cb + fs), x1 = *(const f32x4*)(cb + fs + 4); vb[0] = x0.x; vb[1] = x0.y; vb[2] = x0.z; vb[3] = x0.w; vb[4] = x1.x; vb[5] = x1.y; vb[6] = x1.z; vb[7] = x1.w; }
        conv_act8(u, g0, g1, g2, v0, v1, v2, vb, ACT + off);
    }
}

__device__ __forceinline__ void ph_rwkv_prep(const Params& p, int jl, int lane, int wave) {
    float* Kb = (float*)(p.ws + WS_K); float* Vb = (float*)(p.ws + (jl == 0 ? WS_VF : WS_VB)); const float* VF = (const float*)(p.ws + WS_VF);
    const float* L2 = (const float*)(p.ws + WS_L2);
    float* Wd = (float*)(p.ws + WS_WDEC); float* NKK = (float*)(p.ws + WS_NKK); float* KKA = (float*)(p.ws + WS_KKA);
    const float* w0 = p.in[I_W0] + (size_t)jl * D; const float* a0 = p.in[I_A0] + (size_t)jl * D; const float* v0 = p.in[I_V0];
    const float* kkp = p.in[I_KK] + (size_t)jl * D; const float* kap = p.in[I_KA] + (size_t)jl * D;
    const int gw = blockIdx.x * NWAVES + wave, NGW = gridDim.x * NWAVES;
    for (int it = gw; it < M * WH; it += NGW) {
        const int row = it >> 4, h = it & 15, c = h * WN + lane;
        const size_t idx = (size_t)row * D + c, l2 = (size_t)row * NL2 + c;
        const float xw = -(w0[c] + L2[l2]);
        const float sp = xw > 20.f ? xw : log1pf(expf(xw));
        const float w = expf(-expf(-sp - 0.5f));
        const float a = sigmoidf_(a0[c] + L2[l2 + 1024]);
        const float kv = Kb[idx];
        float kk = kv * kkp[c];
        const float ss = wave_sum(kk * kk);
        kk = kk * rsqrtf(fmaxf(ss, 1e-12f));
        if (jl == 1) { const float v = Vb[idx]; Vb[idx] = v + (VF[idx] - v) * sigmoidf_(v0[c] + L2[l2 + 3072]); }
        Kb[idx] = kv * (1.f + (a - 1.f) * kap[c]); Wd[idx] = w; NKK[idx] = -kk; KKA[idx] = kk * a;
    }
}
__device__ __forceinline__ void ph_rwkv_post(const Params& p, int jl, int lane, int wave) {
    const float* YW = (const float*)(p.ws + WS_YW); const float* R = (const float*)(p.ws + WS_R); const float* Kb = (const float*)(p.ws + WS_NKK);
    const float* Vb = (const float*)(p.ws + WS_KKA); const float* L2 = (const float*)(p.ws + WS_L2); bf16* Z = (bf16*)(p.ws + WS_Z);
    const float* rk = p.in[I_RK] + (size_t)jl * D; const float* lnw = p.in[I_LNW] + (size_t)jl * D; const float* lnb = p.in[I_LNB] + (size_t)jl * D;
    const int gw = blockIdx.x * NWAVES + wave, NGW = gridDim.x * NWAVES;
    for (int it = gw; it < M * WH; it += NGW) {
        const int row = it >> 4, h = it & 15, c = h * WN + lane;
        const size_t idx = (size_t)row * D + c;
        const float yv = YW[idx];
        const float mean = wave_sum(yv) * (1.f / WN);
        const float yc = yv - mean;
        const float rstd = rsqrtf(wave_sum(yc * yc) * (1.f / WN) + 64e-5f);
        const float yn = yc * rstd * lnw[c] + lnb[c];
        const float bon = wave_sum(R[idx] * Kb[idx] * rk[c]) * Vb[idx];
        const float z = (yn + bon) * L2[(size_t)row * NL2 + 2048 + c];
        Z[idx] = (bf16)(cvt_pk_bf16(z, 0.f) & 0xffffu);
    }
}

__device__ __forceinline__ void ph_ret_slow(const Params& p, int jl, LAS unsigned char* lds, int tid) {
    const bf16* QK = (const bf16*)(p.ws + WS_QK); const bf16* V = (const bf16*)(p.ws + WS_V); float* O = (float*)(p.ws + WS_O);
    const int half = tid >> 8, t256 = tid & 255, e = t256 & 63, dq = t256 >> 6;
    LAS float* sq = (LAS float*)lds + half * 256; LAS float* sk = (LAS float*)lds + 512 + half * 256; LAS float* red = (LAS float*)lds + 1024 + half * 256;
    for (int pass = 0; pass < 2; ++pass) {
        const int nitems = pass ? SB * RH * 8 : BATCH * RH * 8;
        for (int it = blockIdx.x * 2 + half; it < nitems; it += gridDim.x * 2) {
            const int es = it & 7, h = (it >> 3) & 3, seq = it >> 5;
            const int r0 = pass ? MP + seq : seq * TP, T = pass ? 1 : TP;
            const float gamma = 1.0f - exp2f(-5.0f - (float)h);
            float S[64];
            if (pass) {
                const float* sp = p.in[I_SRET] + ((((size_t)jl * SB + seq) * RH + h) * RDK + dq * 64) * RDV + es * 64 + e;
#pragma unroll
                for (int dd = 0; dd < 64; ++dd) S[dd] = sp[(size_t)dd * RDV];
            } else {
#pragma unroll
                for (int dd = 0; dd < 64; ++dd) S[dd] = 0.f;
            }
            for (int t = 0; t < T; ++t) {
                const int row = r0 + t;
                sq[t256] = __uint_as_float((unsigned)QK[(size_t)row * 2048 + h * RDK + t256] << 16);
                sk[t256] = __uint_as_float((unsigned)QK[(size_t)row * 2048 + 1024 + h * RDK + t256] << 16);
                const float ve = __uint_as_float((unsigned)V[(size_t)row * 2048 + h * RDV + es * 64 + e] << 16);
                __syncthreads();
                float acc = 0.f;
#pragma unroll
                for (int dd = 0; dd < 64; ++dd) { S[dd] = fmaf(S[dd], gamma, sk[dq * 64 + dd] * ve); acc = fmaf(sq[dq * 64 + dd], S[dd], acc); }
                red[dq * 64 + e] = acc;
                __syncthreads();
                if (dq == 0) O[(size_t)row * RV + h * RDV + es * 64 + e] = (red[e] + red[64 + e]) + (red[128 + e] + red[192 + e]);
            }
            float* so = (pass ? p.out + O_RETS + (size_t)jl * SB * RH * RDK * RDV : p.out + O_RETP + (size_t)jl * BATCH * RH * RDK * RDV) + (((size_t)seq * RH + h) * RDK + dq * 64) * RDV + es * 64 + e;
#pragma unroll
            for (int dd = 0; dd < 64; ++dd) so[(size_t)dd * RDV] = S[dd];
        }
    }
}
__device__ __forceinline__ void ph_wkv_slow(const Params& p, int jl, LAS unsigned char* lds, int lane, int wave) {
    const float* r = (const float*)(p.ws + WS_R); const float* w = (const float*)(p.ws + WS_WDEC); const float* k = (const float*)(p.ws + WS_K);
    const float* v = (const float*)(p.ws + (jl == 0 ? WS_VF : WS_VB)); const float* nkk = (const float*)(p.ws + WS_NKK); const float* kka = (const float*)(p.ws + WS_KKA);
    float* y = (float*)(p.ws + WS_YW);
    LAS float* sv = (LAS float*)lds + wave * 320;
    for (int pass = 0; pass < 2; ++pass) {
        const int nitems = pass ? SB * WH : BATCH * WH;
        for (int it = blockIdx.x * NWAVES + wave; it < nitems; it += gridDim.x * NWAVES) {
            const int h = it & 15, seq = it >> 4;
            const int r0 = pass ? MP + seq : seq * TP, T = pass ? 1 : TP;
            float S[64];
            if (pass) {
                const float* sp = p.in[I_SWKV] + ((((size_t)jl * SB + seq) * WH + h) * WN + lane) * WN;
#pragma unroll
                for (int j = 0; j < 64; j += 4) { const f32x4 t4 = *(const f32x4*)(sp + j); S[j] = t4.x; S[j + 1] = t4.y; S[j + 2] = t4.z; S[j + 3] = t4.w; }
            } else {
#pragma unroll
                for (int j = 0; j < 64; ++j) S[j] = 0.f;
            }
            for (int t = 0; t < T; ++t) {
                const size_t idx = (size_t)(r0 + t) * D + h * WN + lane;
                sv[lane] = nkk[idx]; sv[64 + lane] = w[idx]; sv[128 + lane] = kka[idx]; sv[192 + lane] = k[idx]; sv[256 + lane] = r[idx];
                const float vi = v[idx];
                __syncthreads();
                float sa0 = 0.f, sa1 = 0.f, sa2 = 0.f, sa3 = 0.f;
#pragma unroll
                for (int j = 0; j < 64; j += 4) { sa0 = fmaf(S[j], sv[j], sa0); sa1 = fmaf(S[j + 1], sv[j + 1], sa1); sa2 = fmaf(S[j + 2], sv[j + 2], sa2); sa3 = fmaf(S[j + 3], sv[j + 3], sa3); }
                const float sa = (sa0 + sa1) + (sa2 + sa3);
                float y0 = 0.f, y1 = 0.f, y2 = 0.f, y3 = 0.f;
#pragma unroll
                for (int j = 0; j < 64; j += 4) {
                    S[j] = fmaf(S[j], sv[64 + j], fmaf(sa, sv[128 + j], vi * sv[192 + j])); y0 = fmaf(S[j], sv[256 + j], y0);
                    S[j + 1] = fmaf(S[j + 1], sv[64 + j + 1], fmaf(sa, sv[128 + j + 1], vi * sv[192 + j + 1])); y1 = fmaf(S[j + 1], sv[256 + j + 1], y1);
                    S[j + 2] = fmaf(S[j + 2], sv[64 + j + 2], fmaf(sa, sv[128 + j + 2], vi * sv[192 + j + 2])); y2 = fmaf(S[j + 2], sv[256 + j + 2], y2);
                    S[j + 3] = fmaf(S[j + 3], sv[64 + j + 3], fmaf(sa, sv[128 + j + 3], vi * sv[192 + j + 3])); y3 = fmaf(S[j + 3], sv[256 + j + 3], y3);
                }
                y[idx] = (y0 + y1) + (y2 + y3);
                __syncthreads();
            }
            float* so = (pass ? p.out + O_WKVS + (size_t)jl * SB * WH * WN * WN : p.out + O_WKVP + (size_t)jl * BATCH * WH * WN * WN) + (((size_t)seq * WH + h) * WN + lane) * WN;
#pragma unroll
            for (int j = 0; j < 64; j += 4) { f32x4 t4; t4.x = S[j]; t4.y = S[j + 1]; t4.z = S[j + 2]; t4.w = S[j + 3]; *(f32x4*)(so + j) = t4; }
        }
    }
}

constexpr int RT_KP = 528, RT_VP = 144, RT_SP = 528;
constexpr int RT_K_OFF = 0, RT_V_OFF = 128 * RT_KP, RT_ST_OFF = RT_V_OFF + 128 * RT_VP, RT_END = RT_ST_OFF + 64 * RT_SP;
static_assert(RT_END <= LDS_BYTES, "retention LDS map");
typedef short v4s __attribute__((ext_vector_type(4)));
__device__ __forceinline__ bf16x8 tr_pair(LAS unsigned char* a0, LAS unsigned char* a1) {
    const v4s lo = __builtin_amdgcn_ds_read_tr16_b64_v4i16((LAS v4s*)a0), hi = __builtin_amdgcn_ds_read_tr16_b64_v4i16((LAS v4s*)a1);
    return __builtin_shufflevector(lo, hi, 0, 1, 2, 3, 4, 5, 6, 7);
}
__device__ __forceinline__ void ph_ret_fast(const Params& p, int jl, LAS unsigned char* lds, int tid, int lane, int wave) {
    const bf16* QK = (const bf16*)(p.ws + WS_QK); const bf16* V = (const bf16*)(p.ws + WS_V); float* O = (float*)(p.ws + WS_O);
    const int fr = lane & 15, fq = lane >> 4, li_q = (lane & 15) >> 2, li_p = lane & 3;
    for (int u = blockIdx.x; u < BATCH * RH * 8; u += gridDim.x) {
        const int es = u & 7, h = (u >> 3) & 3, b = u >> 5;
        const float gamma = 1.0f - exp2f(-5.0f - (float)h), lg = log2f(gamma), g128 = exp2f(128.f * lg), g127 = exp2f(127.f * lg);
        const int i0 = 16 * wave, d0 = 32 * wave;
        f32x4 Sacc[2][4];
#pragma unroll
        for (int a = 0; a < 2; ++a)
#pragma unroll
            for (int c = 0; c < 4; ++c) Sacc[a][c] = (f32x4){0.f, 0.f, 0.f, 0.f};
        __syncthreads();
        for (int i = tid; i < 64 * RT_SP / 16; i += NTHR) *(LAS v4u*)(lds + RT_ST_OFF + i * 16) = (v4u){0u, 0u, 0u, 0u};
        v4u kst[8], vst[2];
        const bf16* Kg = QK + 1024 + 256 * h; const bf16* Vg = V + 512 * h + 64 * es; const bf16* Qg = QK + 256 * h;
#define RT_LOAD_STAGE(cc) do { \
            _Pragma("unroll") for (int k_ = 0; k_ < 8; ++k_) { const int id_ = tid + 512 * k_, row_ = id_ >> 5, ch_ = id_ & 31, t_ = 128 * (cc) - 112 + row_; \
                kst[k_] = t_ >= 0 ? *(const v4u*)(Kg + (size_t)(b * TP + t_) * 2048 + 8 * ch_) : (v4u){0u, 0u, 0u, 0u}; } \
            _Pragma("unroll") for (int k_ = 0; k_ < 2; ++k_) { const int id_ = tid + 512 * k_, row_ = id_ >> 3, ch_ = id_ & 7, t_ = 128 * (cc) - 112 + row_; \
                vst[k_] = t_ >= 0 ? *(const v4u*)(Vg + (size_t)(b * TP + t_) * 2048 + 8 * ch_) : (v4u){0u, 0u, 0u, 0u}; } } while (0)
        RT_LOAD_STAGE(0);
        for (int c = 0; c < 17; ++c) {
            __syncthreads();
#pragma unroll
            for (int k_ = 0; k_ < 8; ++k_) { const int id_ = tid + 512 * k_, row_ = id_ >> 5, ch_ = id_ & 31; *(LAS v4u*)(lds + RT_K_OFF + row_ * RT_KP + ch_ * 16) = kst[k_]; }
#pragma unroll
            for (int k_ = 0; k_ < 2; ++k_) { const int id_ = tid + 512 * k_, row_ = id_ >> 3, ch_ = id_ & 7;
                float f[8]; unpack8(vst[k_], f); const float sc = exp2f(-(float)row_ * lg);
#pragma unroll
                for (int e = 0; e < 8; ++e) f[e] *= sc;
                *(LAS v4u*)(lds + RT_V_OFF + row_ * RT_VP + ch_ * 16) = pack8(f); }
            bf16x8 Qf[8];
            { const int t_ = 128 * c - 112 + i0 + fr;
#pragma unroll
              for (int s = 0; s < 8; ++s) Qf[s] = t_ >= 0 ? *(const bf16x8*)(Qg + (size_t)(b * TP + t_) * 2048 + 32 * s + 8 * fq) : (bf16x8){0, 0, 0, 0, 0, 0, 0, 0}; }
            __syncthreads();
            bf16x8 Pf[4];
            { const int ii = i0 + fr; const float gi = exp2f((float)ii * lg);
#pragma unroll
              for (int s2 = 0; s2 < 4; ++s2) { f32x4 Dp[2];
#pragma unroll
                  for (int hh = 0; hh < 2; ++hh) { Dp[hh] = (f32x4){0.f, 0.f, 0.f, 0.f};
#pragma unroll
                      for (int s = 0; s < 8; ++s) { const bf16x8 Kf = *(const LAS bf16x8*)(lds + RT_K_OFF + (16 * (2 * s2 + hh) + fr) * RT_KP + (32 * s + 8 * fq) * 2);
                          Dp[hh] = __builtin_amdgcn_mfma_f32_16x16x32_bf16(Kf, Qf[s], Dp[hh], 0, 0, 0); } }
                  float f[8];
#pragma unroll
                  for (int hh = 0; hh < 2; ++hh)
#pragma unroll
                      for (int r = 0; r < 4; ++r) { const int jj = 16 * (2 * s2 + hh) + 4 * fq + r; f[hh * 4 + r] = ii >= jj ? Dp[hh][r] * gi : 0.f; }
                  const v4u w = pack8(f); Pf[s2] = __builtin_bit_cast(bf16x8, w); } }
            f32x4 Oacc[4];
#pragma unroll
            for (int et = 0; et < 4; ++et) { Oacc[et] = (f32x4){0.f, 0.f, 0.f, 0.f};
#pragma unroll
                for (int s = 0; s < 8; ++s) { const bf16x8 Sf = *(const LAS bf16x8*)(lds + RT_ST_OFF + (16 * et + fr) * RT_SP + (32 * s + 8 * fq) * 2);
                    Oacc[et] = __builtin_amdgcn_mfma_f32_16x16x32_bf16(Qf[s], Sf, Oacc[et], 0, 0, 0); } }
            __syncthreads();
            if (c + 1 < 17) RT_LOAD_STAGE(c + 1);
#pragma unroll
            for (int r = 0; r < 4; ++r) { const float lam = exp2f((float)(i0 + 4 * fq + r + 1) * lg);
#pragma unroll
                for (int et = 0; et < 4; ++et) Oacc[et][r] *= lam; }
#pragma unroll
            for (int et = 0; et < 4; ++et)
#pragma unroll
                for (int s = 0; s < 4; ++s) {
                    LAS unsigned char* a0 = lds + RT_V_OFF + (32 * s + 4 * fq + li_q) * RT_VP + (16 * et + 4 * li_p) * 2;
                    const bf16x8 Vf = tr_pair(a0, a0 + 16 * RT_VP);
                    Oacc[et] = __builtin_amdgcn_mfma_f32_16x16x32_bf16(Pf[s], Vf, Oacc[et], 0, 0, 0); }
#pragma unroll
            for (int r = 0; r < 4; ++r) { const int t_ = 128 * c - 112 + i0 + 4 * fq + r;
                if (t_ >= 0) { float* op = O + (size_t)(b * TP + t_) * RV + 512 * h + 64 * es + fr;
#pragma unroll
                    for (int et = 0; et < 4; ++et) op[16 * et] = Oacc[et][r]; } }
#pragma unroll
            for (int dt = 0; dt < 2; ++dt)
#pragma unroll
                for (int et = 0; et < 4; ++et) Sacc[dt][et] = Sacc[dt][et] * (g128 / g127);
#pragma unroll
            for (int s = 0; s < 4; ++s) {
                bf16x8 Kt[2], Vt[4];
#pragma unroll
                for (int dt = 0; dt < 2; ++dt) { LAS unsigned char* a0 = lds + RT_K_OFF + (32 * s + 8 * fq + li_q) * RT_KP + (d0 + 16 * dt + 4 * li_p) * 2; Kt[dt] = tr_pair(a0, a0 + 4 * RT_KP); }
#pragma unroll
                for (int et = 0; et < 4; ++et) { LAS unsigned char* a0 = lds + RT_V_OFF + (32 * s + 8 * fq + li_q) * RT_VP + (16 * et + 4 * li_p) * 2; Vt[et] = tr_pair(a0, a0 + 4 * RT_VP); }
#pragma unroll
                for (int dt = 0; dt < 2; ++dt)
#pragma unroll
                    for (int et = 0; et < 4; ++et) Sacc[dt][et] = __builtin_amdgcn_mfma_f32_16x16x32_bf16(Kt[dt], Vt[et], Sacc[dt][et], 0, 0, 0);
            }
#pragma unroll
            for (int dt = 0; dt < 2; ++dt)
#pragma unroll
                for (int et = 0; et < 4; ++et) Sacc[dt][et] = Sacc[dt][et] * g127;
#pragma unroll
            for (int dt = 0; dt < 2; ++dt)
#pragma unroll
                for (int et = 0; et < 4; ++et) { v2u w; w.x = cvt_pk_bf16(Sacc[dt][et][0], Sacc[dt][et][1]); w.y = cvt_pk_bf16(Sacc[dt][et][2], Sacc[dt][et][3]);
                    *(LAS v2u*)(lds + RT_ST_OFF + (16 * et + fr) * RT_SP + (d0 + 16 * dt + 4 * fq) * 2) = w; }
        }
#undef RT_LOAD_STAGE
        float* so = p.out + O_RETP + ((((size_t)jl * BATCH + b) * RH + h) * RDK) * RDV + 64 * es;
#pragma unroll
        for (int dt = 0; dt < 2; ++dt)
#pragma unroll
            for (int et = 0; et < 4; ++et)
#pragma unroll
                for (int r = 0; r < 4; ++r) so[(size_t)(d0 + 16 * dt + 4 * fq + r) * RDV + 16 * et + fr] = Sacc[dt][et][r];
    }
    {
        LAS float* sq = (LAS float*)lds; LAS float* sk = sq + 256; LAS float* red = sk + 256;
        const int e4 = tid & 127, dq = tid >> 7;
        for (int it = blockIdx.x; it < SB * RH; it += gridDim.x) {
            const int h = it & 3, s = it >> 2, row = MP + s;
            const float gamma = 1.0f - exp2f(-5.0f - (float)h);
            __syncthreads();
            if (tid < 256) sq[tid] = bf_lo((unsigned)QK[(size_t)row * 2048 + 256 * h + tid]);
            else sk[tid - 256] = bf_lo((unsigned)QK[(size_t)row * 2048 + 1024 + 256 * h + (tid - 256)]);
            const v2u vv = *(const v2u*)(V + (size_t)row * 2048 + 512 * h + 4 * e4);
            const f32x4 v4 = (f32x4){bf_lo(vv.x), bf_hi(vv.x), bf_lo(vv.y), bf_hi(vv.y)};
            __syncthreads();
            const float* sin_ = p.in[I_SRET] + ((((size_t)jl * SB + s) * RH + h) * RDK) * RDV + 4 * e4;
            float* sout = p.out + O_RETS + ((((size_t)jl * SB + s) * RH + h) * RDK) * RDV + 4 * e4;
            f32x4 oacc = (f32x4){0.f, 0.f, 0.f, 0.f};
#pragma unroll 8
            for (int k = 0; k < 64; ++k) { const int d = dq + 4 * k;
                const f32x4 sv = __builtin_nontemporal_load((const f32x4*)(sin_ + (size_t)d * RDV));
                const f32x4 sn = sv * gamma + v4 * sk[d];
                oacc += sn * sq[d];
                __builtin_nontemporal_store(sn, (f32x4*)(sout + (size_t)d * RDV)); }
            *(LAS f32x4*)(red + dq * 512 + 4 * e4) = oacc;
            __syncthreads();
            if (dq == 0) { const f32x4 r = (*(LAS f32x4*)(red + 4 * e4) + *(LAS f32x4*)(red + 512 + 4 * e4)) + (*(LAS f32x4*)(red + 1024 + 4 * e4) + *(LAS f32x4*)(red + 1536 + 4 * e4));
                *(f32x4*)(O + (size_t)row * RV + 512 * h + 4 * e4) = r; }
        }
    }
}

typedef float f32x2w __attribute__((ext_vector_type(2)));
constexpr int WK_TB = 32, WK_STEP_B = 6 * 256 + 16, WK_BUF_B = WK_TB * WK_STEP_B, WK_Y_OFF = 2 * WK_BUF_B, WK_YB_B = WK_TB * 32 * 4;
static_assert(WK_Y_OFF + 2 * WK_YB_B <= LDS_BYTES - 16, "wkv LDS map");
__device__ __forceinline__ float row16_sum(float x) {
    x += __builtin_bit_cast(float, __builtin_amdgcn_update_dpp(0, __builtin_bit_cast(int, x), 0x128, 0xf, 0xf, false));
    x += __builtin_bit_cast(float, __builtin_amdgcn_update_dpp(0, __builtin_bit_cast(int, x), 0x124, 0xf, 0xf, false));
    x += __builtin_bit_cast(float, __builtin_amdgcn_update_dpp(0, __builtin_bit_cast(int, x), 0x122, 0xf, 0xf, false));
    x += __builtin_bit_cast(float, __builtin_amdgcn_update_dpp(0, __builtin_bit_cast(int, x), 0x121, 0xf, 0xf, false));
    return x;
}
__device__ __forceinline__ float half8_sum(float x) {
    x += __builtin_bit_cast(float, __builtin_amdgcn_update_dpp(0, __builtin_bit_cast(int, x), 0x141, 0xf, 0xf, false));
    x += __builtin_bit_cast(float, __builtin_amdgcn_update_dpp(0, __builtin_bit_cast(int, x), 0xB1, 0xf, 0xf, false));
    x += __builtin_bit_cast(float, __builtin_amdgcn_update_dpp(0, __builtin_bit_cast(int, x), 0x4E, 0xf, 0xf, false));
    return x;
}
struct WkPar { f32x4 w0, a0, kkp, kap, v0; };
__device__ __forceinline__ f32x4 wk_unit_neg(const f32x4 kraw, const f32x4 kkp) {
    const f32x4 kk = kraw * kkp;
    const float ss = row16_sum((kk.x * kk.x + kk.y * kk.y) + (kk.z * kk.z + kk.w * kk.w));
    return kk * (-rsqrtf(fmaxf(ss, 1e-12f)));
}
__device__ __forceinline__ float wk_decay(float x) { const float xw = -x; const float sp = xw > 20.f ? xw : log1pf(expf(xw)); return expf(-expf(-sp - 0.5f)); }
__device__ __forceinline__ void wk_prep(const WkPar& P, const f32x4 kraw, const f32x4 vraw, const f32x4 lw2, const f32x4 la2, const f32x4 vf, const f32x4 lv2, bool vres,
                                        f32x4& w, f32x4& ka, f32x4& km, f32x4& vp, f32x4& nk) {
    nk = wk_unit_neg(kraw, P.kkp);
    w = (f32x4){wk_decay(P.w0.x + lw2.x), wk_decay(P.w0.y + lw2.y), wk_decay(P.w0.z + lw2.z), wk_decay(P.w0.w + lw2.w)};
    const f32x4 a = (f32x4){sigmoidf_(P.a0.x + la2.x), sigmoidf_(P.a0.y + la2.y), sigmoidf_(P.a0.z + la2.z), sigmoidf_(P.a0.w + la2.w)};
    ka = nk * (-a);
    km = kraw * ((a - 1.f) * P.kap + 1.f);
    vp = vraw;
    if (vres) { const f32x4 sg = (f32x4){sigmoidf_(P.v0.x + lv2.x), sigmoidf_(P.v0.y + lv2.y), sigmoidf_(P.v0.z + lv2.z), sigmoidf_(P.v0.w + lv2.w)}; vp = vraw + (vf - vraw) * sg; }
}
__device__ __forceinline__ void ph_wkv_fast(const Params& p, int jl, LAS unsigned char* lds, int tid, int lane, int wave) {
    const float* Kr = (const float*)(p.ws + WS_K); const float* Vr = (const float*)(p.ws + (jl == 0 ? WS_VF : WS_VB)); const float* VFp = (const float*)(p.ws + WS_VF);
    const float* Rr = (const float*)(p.ws + WS_R); const float* L2 = (const float*)(p.ws + WS_L2);
    float* KM = (float*)(p.ws + WS_NKK); float* VP = (float*)(p.ws + WS_KKA);
    float* YW = (float*)(p.ws + WS_YW);
    const bool vres = jl == 1;
    const int ri = lane >> 4, cg = lane & 15;
    for (int it = blockIdx.x; it < BATCH * WH * 2; it += gridDim.x) {
        const int half = it & 1, h = (it >> 1) & 15, seq = it >> 5, r0 = seq * TP;
        const int sts = tid >> 4, sc4 = tid & 15;
        const int ch = h * WN + 4 * sc4;
        WkPar P; P.w0 = *(const f32x4*)(p.in[I_W0] + (size_t)jl * D + ch); P.a0 = *(const f32x4*)(p.in[I_A0] + (size_t)jl * D + ch); P.kkp = *(const f32x4*)(p.in[I_KK] + (size_t)jl * D + ch);
        P.kap = *(const f32x4*)(p.in[I_KA] + (size_t)jl * D + ch); P.v0 = *(const f32x4*)(p.in[I_V0] + ch);
        f32x4 SA = (f32x4){0.f, 0.f, 0.f, 0.f}, SB = (f32x4){0.f, 0.f, 0.f, 0.f}; float sa = 0.f;
        f32x4 st[8];
        const f32x4 z4 = (f32x4){0.f, 0.f, 0.f, 0.f};
#define WK_STAGE_LOAD(tbase) do { const int tt_ = (tbase) + sts; const size_t ro_ = (size_t)(r0 + tt_) * D + ch, lo_ = (size_t)(r0 + tt_) * NL2 + ch; \
            st[0] = (tt_ + 1 < TP) ? *(const f32x4*)(Kr + ro_ + D) : z4; \
            if (tt_ < TP) { st[1] = *(const f32x4*)(Kr + ro_); st[2] = *(const f32x4*)(Vr + ro_); st[3] = *(const f32x4*)(Rr + ro_); st[4] = *(const f32x4*)(L2 + lo_); st[5] = *(const f32x4*)(L2 + lo_ + 1024); \
                if (vres) { st[6] = *(const f32x4*)(VFp + ro_); st[7] = *(const f32x4*)(L2 + lo_ + 3072); } else { st[6] = z4; st[7] = z4; } } \
            else { st[1] = z4; st[2] = z4; st[3] = z4; st[4] = z4; st[5] = z4; st[6] = z4; st[7] = z4; } } while (0)
#define WK_STAGE_WRITE(Bp, tbase) do { LAS unsigned char* sl_ = (Bp) + sts * WK_STEP_B; const int tt_ = (tbase) + sts; \
            f32x4 w_, ka_, km_, vp_, nk_; wk_prep(P, st[1], st[2], st[4], st[5], st[6], st[7], vres, w_, ka_, km_, vp_, nk_); \
            const f32x4 nk1_ = wk_unit_neg(st[0], P.kkp); \
            const float c1_ = row16_sum((ka_.x * nk1_.x + ka_.y * nk1_.y) + (ka_.z * nk1_.z + ka_.w * nk1_.w)); \
            const float c2_ = row16_sum((km_.x * nk1_.x + km_.y * nk1_.y) + (km_.z * nk1_.z + km_.w * nk1_.w)); \
            *(LAS f32x4*)(sl_ + sc4 * 16) = w_ * nk1_; *(LAS f32x4*)(sl_ + 256 + sc4 * 16) = w_; *(LAS f32x4*)(sl_ + 512 + sc4 * 16) = ka_; \
            *(LAS f32x4*)(sl_ + 768 + sc4 * 16) = km_; *(LAS f32x4*)(sl_ + 1024 + sc4 * 16) = st[3]; *(LAS f32x4*)(sl_ + 1280 + sc4 * 16) = vp_; \
            if (sc4 == 0) *(LAS f32x2w*)(sl_ + 1536) = (f32x2w){c1_, c2_}; \
            if (half == 0 && tt_ < TP) { const size_t ro_ = (size_t)(r0 + tt_) * D + ch; *(f32x4*)(KM + ro_) = km_; *(f32x4*)(VP + ro_) = vp_; } } while (0)
        __syncthreads();
        WK_STAGE_LOAD(0);
        WK_STAGE_WRITE(lds, 0);
        __syncthreads();
        constexpr int NB = (TP + WK_TB - 1) / WK_TB;
        for (int bt = 0; bt < NB; ++bt) {
            const int t0 = bt * WK_TB, tn = t0 + WK_TB;
            const bool has_next = tn < TP;
            if (has_next) WK_STAGE_LOAD(tn);
            LAS unsigned char* B = lds + (bt & 1) * WK_BUF_B;
            LAS float* yb = (LAS float*)(lds + WK_Y_OFF + (bt & 1) * WK_YB_B);
            const int nst = (TP - t0) < WK_TB ? (TP - t0) : WK_TB;
            if (wave < 4) {
                const int ri8 = lane >> 3, cg8 = lane & 7;
                const int voff = 1280 + (32 * half + 8 * wave + ri8) * 4;
                LAS unsigned char* sp = B + cg8 * 32;
                f32x4 wnA = *(LAS f32x4*)(sp), wnB = *(LAS f32x4*)(sp + 16), wA = *(LAS f32x4*)(sp + 256), wB = *(LAS f32x4*)(sp + 272), kaA = *(LAS f32x4*)(sp + 512), kaB = *(LAS f32x4*)(sp + 528),
                      kA = *(LAS f32x4*)(sp + 768), kB = *(LAS f32x4*)(sp + 784), rA = *(LAS f32x4*)(sp + 1024), rB = *(LAS f32x4*)(sp + 1040);
                float vi = *(LAS float*)(B + voff); f32x2w cc = *(LAS f32x2w*)(B + 1536);
#pragma unroll 2
                for (int ts = 0; ts < nst; ++ts) {
                    const int tsn = (ts + 1 < WK_TB) ? ts + 1 : ts;
                    LAS unsigned char* spn = B + tsn * WK_STEP_B + cg8 * 32;
                    const f32x4 wnA_n = *(LAS f32x4*)(spn), wnB_n = *(LAS f32x4*)(spn + 16), wA_n = *(LAS f32x4*)(spn + 256), wB_n = *(LAS f32x4*)(spn + 272), kaA_n = *(LAS f32x4*)(spn + 512), kaB_n = *(LAS f32x4*)(spn + 528),
                                kA_n = *(LAS f32x4*)(spn + 768), kB_n = *(LAS f32x4*)(spn + 784), rA_n = *(LAS f32x4*)(spn + 1024), rB_n = *(LAS f32x4*)(spn + 1040);
                    const float vi_n = *(LAS float*)(B + tsn * WK_STEP_B + voff); const f32x2w cc_n = *(LAS f32x2w*)(B + tsn * WK_STEP_B + 1536);
                    const f32x4 pa = SA * wnA + SB * wnB;
                    const f32x4 vk_a = kA * vi, vk_b = kB * vi;
                    SA = SA * wA + (kaA * sa + vk_a); SB = SB * wB + (kaB * sa + vk_b);
                    sa = fmaf(sa, cc.x, fmaf(vi, cc.y, half8_sum((pa.x + pa.y) + (pa.z + pa.w))));
                    const f32x4 py = SA * rA + SB * rB;
                    const float y = half8_sum((py.x + py.y) + (py.z + py.w));
                    if (cg8 == 0) yb[ts * 32 + 8 * wave + ri8] = y;
                    wnA = wnA_n; wnB = wnB_n; wA = wA_n; wB = wB_n; kaA = kaA_n; kaB = kaB_n; kA = kA_n; kB = kB_n; rA = rA_n; rB = rB_n; vi = vi_n; cc = cc_n;
                }
            }
            if (has_next) WK_STAGE_WRITE(lds + ((bt + 1) & 1) * WK_BUF_B, tn);
            __syncthreads();
#pragma unroll
            for (int k = 0; k < 2; ++k) { const int idx = tid + 512 * k, ts = idx >> 5, rr = idx & 31;
                if (t0 + ts < TP) YW[(size_t)(r0 + t0 + ts) * D + h * WN + 32 * half + rr] = yb[idx]; }
        }
#undef WK_STAGE_LOAD
#undef WK_STAGE_WRITE
        if (wave < 4) { float* so = p.out + O_WKVP + ((((size_t)jl * BATCH + seq) * WH + h) * WN + 32 * half + 8 * wave + (lane >> 3)) * WN + 8 * (lane & 7);
            *(f32x4*)so = SA; *(f32x4*)(so + 4) = SB; }
    }
    {
        const int gw = blockIdx.x * NWAVES + wave, NGW = gridDim.x * NWAVES;
        for (int it = gw; it < SB * WH * 16; it += NGW) {
            const int rg = it & 15, h = (it >> 4) & 15, s = it >> 8, row = MP + s, i = 4 * rg + ri;
            const int ch = h * WN + 4 * cg;
            WkPar P; P.w0 = *(const f32x4*)(p.in[I_W0] + (size_t)jl * D + ch); P.a0 = *(const f32x4*)(p.in[I_A0] + (size_t)jl * D + ch); P.kkp = *(const f32x4*)(p.in[I_KK] + (size_t)jl * D + ch);
            P.kap = *(const f32x4*)(p.in[I_KA] + (size_t)jl * D + ch); P.v0 = *(const f32x4*)(p.in[I_V0] + ch);
            const size_t vo = (size_t)row * D + ch, lo = (size_t)row * NL2 + ch;
            const f32x4 kraw = *(const f32x4*)(Kr + vo), vraw = *(const f32x4*)(Vr + vo), r4 = *(const f32x4*)(Rr + vo), lw2 = *(const f32x4*)(L2 + lo), la2 = *(const f32x4*)(L2 + lo + 1024);
            f32x4 vf = (f32x4){0.f, 0.f, 0.f, 0.f}, lv2 = vf;
            if (vres) { vf = *(const f32x4*)(VFp + vo); lv2 = *(const f32x4*)(L2 + lo + 3072); }
            f32x4 w4, ka, k4, vp, nk; wk_prep(P, kraw, vraw, lw2, la2, vf, lv2, vres, w4, ka, k4, vp, nk);
            const int srcl = (lane & 48) | rg;
            const float v0_ = __shfl(vp.x, srcl), v1_ = __shfl(vp.y, srcl), v2_ = __shfl(vp.z, srcl), v3_ = __shfl(vp.w, srcl);
            const float vi = ri == 0 ? v0_ : (ri == 1 ? v1_ : (ri == 2 ? v2_ : v3_));
            const size_t so = ((((size_t)jl * SB + s) * WH + h) * WN + i) * WN + 4 * cg;
            f32x4 S = *(const f32x4*)(p.in[I_SWKV] + so);
            const float sa = row16_sum((S.x * nk.x + S.y * nk.y) + (S.z * nk.z + S.w * nk.w));
            S.x = fmaf(S.x, w4.x, fmaf(sa, ka.x, vi * k4.x)); S.y = fmaf(S.y, w4.y, fmaf(sa, ka.y, vi * k4.y));
            S.z = fmaf(S.z, w4.z, fmaf(sa, ka.z, vi * k4.z)); S.w = fmaf(S.w, w4.w, fmaf(sa, ka.w, vi * k4.w));
            const float y = row16_sum((S.x * r4.x + S.y * r4.y) + (S.z * r4.z + S.w * r4.w));
            *(f32x4*)(p.out + O_WKVS + so) = S;
            if (cg == 0) YW[(size_t)row * D + h * WN + i] = y;
            if (rg == 0 && ri == 0) { *(f32x4*)(KM + vo) = k4; *(f32x4*)(VP + vo) = vp; }
        }
    }
}

typedef __attribute__((address_space(1))) unsigned gu32;
#define XB_TMO      128
#define XB_XCNT(j)  (256  + 64 * (j))
#define XB_XSUB(j)  (1280 + 64 * (j))
#define XB_XGEN(j)  (2304 + 64 * (j))
#define XB_TOP      3328
#define XB_TOPGEN   3392
#define XCD_BAR_WORDS 3456
#define XB_SPIN_CAP (1u << 18)

__device__ __forceinline__ unsigned xb_ld(unsigned* p)              { return __hip_atomic_load(p, __ATOMIC_RELAXED, __HIP_MEMORY_SCOPE_AGENT); }
__device__ __forceinline__ unsigned xb_add(unsigned* p, unsigned v) { return __hip_atomic_fetch_add(p, v, __ATOMIC_RELAXED, __HIP_MEMORY_SCOPE_AGENT); }
__device__ __forceinline__ unsigned xb_xcc_id() { return (unsigned)__builtin_amdgcn_s_getreg((3 << 11) | 20) & 0xFu; }
#define XB_SPIN(cond, bar) do { unsigned _sp = 0; while (cond) { __builtin_amdgcn_s_sleep(1); \
    if ((++_sp & 255u) == 0u) { if (xb_ld(&(bar)[XB_TMO])) break; if (_sp > XB_SPIN_CAP) { atomicAdd(&(bar)[XB_TMO], 1u); break; } } } } while (0)

struct XcdBarrier {
    unsigned* bar; unsigned x;
    volatile LAS unsigned* st;
};

__device__ __forceinline__ XcdBarrier xcd_barrier_post(unsigned* bar, volatile LAS unsigned* st) {
    XcdBarrier b; b.bar = bar; b.x = xb_xcc_id(); b.st = st;
    if (threadIdx.x == 0) (void)xb_add(&bar[XB_XCNT(b.x)], 1u);
    return b;
}
__device__ __forceinline__ void xcd_barrier_complete(unsigned* bar, unsigned x, unsigned& nloc, unsigned& nx) {
    const unsigned G = gridDim.x * gridDim.y * gridDim.z;
    unsigned sum, cnt, mine, sp = 0u;
    for (;;) {
        sum = 0u; cnt = 0u; mine = 0u;
#pragma unroll
        for (unsigned j = 0; j < 16; ++j) { const unsigned c = xb_ld(&bar[XB_XCNT(j)]); sum += c; cnt += (c > 0u) ? 1u : 0u; mine = (j == x) ? c : mine; }
        if (sum == G) break;
        __builtin_amdgcn_s_sleep(1);
        if ((++sp & 255u) == 0u) { if (xb_ld(&bar[XB_TMO])) break; if (sp > XB_SPIN_CAP) { atomicAdd(&bar[XB_TMO], 1u); break; } }
    }
    nloc = mine > 0u ? mine : 1u; nx = cnt > 0u ? cnt : 1u;
}

__device__ __forceinline__ void xcd_barrier(const XcdBarrier& b) {
    asm volatile("s_waitcnt vmcnt(0)" ::: "memory");
    __syncthreads();
    if (threadIdx.x == 0) {
        unsigned* bar = b.bar;
        __builtin_amdgcn_s_waitcnt(0);
        unsigned nloc = b.st[0], nx = b.st[1];
        if (nloc == 0u) { xcd_barrier_complete(bar, b.x, nloc, nx); b.st[0] = nloc; b.st[1] = nx; }
        const unsigned old = xb_add(&bar[XB_XSUB(b.x)], 1u);
        const unsigned gen = old / nloc;
        if (old + 1u == (gen + 1u) * nloc) {
            __builtin_amdgcn_fence(__ATOMIC_RELEASE, "agent");
            asm volatile("s_waitcnt vmcnt(0)" ::: "memory");
            const unsigned og = xb_add(&bar[XB_TOP], 1u);
            const unsigned tg = og / nx;
            if (og + 1u == (tg + 1u) * nx) xb_add(&bar[XB_TOPGEN], 1u);
            else XB_SPIN(xb_ld(&bar[XB_TOPGEN]) == tg, bar);
            __builtin_amdgcn_fence(__ATOMIC_ACQUIRE, "agent");
            xb_add(&bar[XB_XGEN(b.x)], 1u);
            asm volatile("s_waitcnt vmcnt(0)" ::: "memory");
        } else {
            XB_SPIN(xb_ld(&bar[XB_XGEN(b.x)]) == gen, bar);
            __builtin_amdgcn_fence(__ATOMIC_ACQUIRE, "agent");
            asm volatile("s_waitcnt vmcnt(0)" ::: "memory");
        }
    }
    __syncthreads();
}

enum { OP_P0 = 0, OP_NORM_RET, OP_G_RETIN, OP_RET, OP_RETNORM, OP_G_RETOUT, OP_NORM_RW, OP_G_RWPROJ, OP_G_LORA2, OP_PREP, OP_WKV, OP_POST, OP_G_WO,
       OP_NORM_FFN, OP_G_UG, OP_CONV, OP_G_WD, OP_FINAL };
struct Ph { unsigned char op, layer; };
#ifdef CONV_CHECK
constexpr int NPH = 1 + 2 * 7 + 2 * 9 + 1;
#else
constexpr int NPH = 1 + 2 * 6 + 2 * 8 + 1;
#endif
__device__ __host__ inline Ph phase_at(int i) {
    if (i == 0) return Ph{OP_P0, 0};
    i -= 1;
    int l;
#ifdef CONV_CHECK
    if (i < 7) l = 0; else if (i < 16) { l = 1; i -= 7; } else if (i < 23) { l = 2; i -= 16; } else if (i < 32) { l = 3; i -= 23; } else return Ph{OP_FINAL, 0};
#else
    if (i < 6) l = 0; else if (i < 14) { l = 1; i -= 6; } else if (i < 20) { l = 2; i -= 14; } else if (i < 28) { l = 3; i -= 20; } else return Ph{OP_FINAL, 0};
#endif
    int op = OP_FINAL;
    if ((l & 1) == 0) {
        switch (i) { case 0: op = OP_G_RETIN; break; case 1: op = OP_RET; break; case 2: op = OP_RETNORM; break; case 3: op = OP_G_RETOUT; break;
#ifdef CONV_CHECK
                     case 4: op = OP_G_UG; break; case 5: op = OP_CONV; break; default: op = OP_G_WD; break; }
#else
                     case 4: op = OP_G_UG; break; default: op = OP_G_WD; break; }
#endif
    } else {
        switch (i) { case 0: op = OP_NORM_RW; break; case 1: op = OP_G_RWPROJ; break; case 2: op = OP_G_LORA2; break; case 3: op = OP_WKV; break; case 4: op = OP_POST; break; case 5: op = OP_G_WO; break;
#ifdef CONV_CHECK
                     case 6: op = OP_G_UG; break; case 7: op = OP_CONV; break; default: op = OP_G_WD; break; }
#else
                     case 6: op = OP_G_UG; break; default: op = OP_G_WD; break; }
#endif
    }
    return Ph{(unsigned char)op, (unsigned char)l};
}

__global__ void __launch_bounds__(NTHR, 2) mega(Params p, int lo, int hi) {
    extern __shared__ __attribute__((aligned(16))) unsigned char lds_raw[];
    LAS unsigned char* lds = (LAS unsigned char*)lds_raw;
    volatile LAS unsigned* bst = (volatile LAS unsigned*)(lds + LDS_BYTES - 16);
    if (threadIdx.x < 4) bst[threadIdx.x] = 0u;
    __syncthreads();
    (void)xcd_barrier_post((unsigned*)(p.ws + WS_CTL), bst);
    for (int ph = lo; ph < hi; ++ph) {
        int tid = threadIdx.x; asm volatile("" : "+v"(tid));
        const int lane = tid & 63, wave = __builtin_amdgcn_readfirstlane(tid >> 6);
        unsigned char* ws = p.ws;
        const Ph P = phase_at(ph);
        const int li = P.layer, jl = li >> 1;
        const bf16* gA = nullptr; const bf16* gB = nullptr; int gN = 0, gK = 0; EpiAnyT<0> E{}; E.jl = jl; E.ws = ws; E.slot = -1; E.amul = 1.f; E.li = li; E.ldsb = lds; bool is_gemm = false;
        switch (P.op) {
        case OP_P0: ph_p0(p, lds, tid, lane, wave); break;
        case OP_NORM_RET: ph_norm(p, p.in[I_NMIX] + (size_t)li * D, 0, jl, lane, wave); break;
        case OP_NORM_FFN: ph_norm(p, p.in[I_NFFN] + (size_t)li * D, 0, jl, lane, wave); break;
        case OP_NORM_RW: ph_norm(p, p.in[I_NMIX] + (size_t)li * D, 1, jl, lane, wave); break;
        case OP_FINAL: ph_norm(p, p.in[I_NFIN], 2, 0, lane, wave); break;
        case OP_RETNORM: ph_ret_norm(p, jl, lane, wave); break;
        case OP_PREP: ph_rwkv_prep(p, jl, lane, wave); break;
        case OP_POST: ph_rwkv_post(p, jl, lane, wave); break;
        case OP_CONV: ph_conv(p, li, tid); break;
        case OP_RET: ph_ret_fast(p, jl, lds, tid, lane, wave); break;
        case OP_WKV: ph_wkv_fast(p, jl, lds, tid, lane, wave); break;
        case OP_G_RETIN: is_gemm = true; E.kind = EK_RETIN; E.perm = true; E.slot = 2 * li;
            gA = (const bf16*)(ws + WS_XB); gB = (const bf16*)(ws + WS_WIN + jl * SZ_WIN); gN = RWIN; gK = D; break;
        case OP_G_RETOUT: is_gemm = true; E.kind = EK_RESID; E.perm = false; E.slot = 2 * li + 1;
            gA = (const bf16*)(ws + WS_Y); gB = (const bf16*)(ws + WS_WOUT + jl * SZ_WOUT); gN = D; gK = RV; break;
        case OP_G_RWPROJ: is_gemm = true; E.kind = EK_RWPROJ; E.perm = false;
            gA = (const bf16*)(ws + WS_H); gB = (const bf16*)(ws + WS_WRW + jl * SZ_WRW); gN = NRW; gK = KRW; break;
        case OP_G_LORA2: is_gemm = true; E.kind = EK_F32; E.perm = false;
            gA = (const bf16*)(ws + WS_A2); gB = (const bf16*)(ws + WS_WL2 + jl * SZ_WL2); gN = (jl == 0 ? 3072 : 4096); gK = KL2; break;
        case OP_G_WO: is_gemm = true; E.kind = EK_RESID; E.perm = false; E.slot = 2 * li + 1;
            gA = (const bf16*)(ws + WS_Z); gB = (const bf16*)(ws + WS_WO + jl * SZ_WO); gN = D; gK = D; break;
        case OP_G_UG: is_gemm = true; E.kind = EK_UG; E.perm = true; E.slot = 2 * li + 1;
            gA = (const bf16*)(ws + WS_XB); gB = (const bf16*)(ws + WS_WUG + li * SZ_WUG); gN = 2 * DFF; gK = D; break;
        case OP_G_WD: is_gemm = true; E.kind = EK_RESID; E.perm = false; E.slot = (li == 1) ? 2 * (li + 1) : -1;
            gA = (const bf16*)(ws + WS_ACT); gB = (const bf16*)(ws + WS_WD + li * SZ_WD); gN = D; gK = DFF; break;
        default: break;
        }
        if (is_gemm) {
            const bool ug = E.kind == EK_UG;
            const int gM = (E.kind == EK_RESID) ? MT0 : (ug ? 66 * 256 : M);
            pg8::Gemm g{ug ? gA - 2 * D : gA, gB, gM, gN, gK, ug ? 254 : 256}; pg8::StaticOrder S; S.init(gM, gN, (int)gridDim.x, (int)blockIdx.x);
            if (E.kind == EK_RETIN || E.kind == EK_UG) {
                LAS float* rt = (LAS float*)(lds + 131072);
                Unit uu;
                for (int ui = 0; ui < 8 && S.next(ui, uu); ++ui) if (tid < 256) { int rr = ug ? 254 * uu.pm - 2 + tid : uu.pm * 256 + tid; rr = rr < 0 ? 0 : (rr > M - 1 ? M - 1 : rr); rt[ui * 256 + tid] = row_rstd(ws, E.slot, rr); }
                E.rtab = rt; E.ldsb = lds;
                __syncthreads();
            }
            if (ug) { EpiAnyT<1> E1{}; E1.kind = E.kind; E1.perm = E.perm; E1.jl = E.jl; E1.ws = E.ws; E1.slot = E.slot; E1.rtab = E.rtab; E1.amul = E.amul; E1.li = E.li; E1.ldsb = E.ldsb; E1.pcw = p.in[I_CW]; E1.pcb = p.in[I_CB]; E1.pcst = p.in[I_SCONV]; E1.pout = p.out;
                pg8::gemm_phase<EpiAnyT<1>, pg8::StaticOrder, true, true>(lds, g, S, E1); }
            else pg8::gemm_phase<EpiAnyT<0>, pg8::StaticOrder, true, true>(lds, g, S, E);
            if (E.kind == EK_RESID) tail_resid(gA, gB, gK, ws, E.slot, E.amul, lds, lane, wave);
        }
        if (ph + 1 < hi) { if (ph == 0) cg::this_grid().sync(); else { XcdBarrier bar; bar.bar = (unsigned*)(p.ws + WS_CTL); bar.x = xb_xcc_id(); bar.st = (volatile LAS unsigned*)(lds + LDS_BYTES - 16); xcd_barrier(bar); } }
    }
}

}

extern "C" void kernel_launch(void* const* d_in, const int* in_sizes, int n_in, void* d_out, int out_size, void* d_ws, size_t ws_size, hipStream_t stream) {
    static int grid = 0;
    if (grid == 0) {
        int dev = 0, cus = 0;
        if (n_in != N_IN || ws_size < WS_END) { fprintf(stderr, "kernel_launch: unexpected n_in %d / ws_size %zu (need %zu)\n", n_in, ws_size, (size_t)WS_END); grid = -1; return; }
        if (hipGetDevice(&dev) != hipSuccess || hipDeviceGetAttribute(&cus, hipDeviceAttributeMultiprocessorCount, dev) != hipSuccess) { grid = -1; return; }
        if (hipFuncSetAttribute((const void*)mega, hipFuncAttributeMaxDynamicSharedMemorySize, LDS_BYTES) != hipSuccess) { fprintf(stderr, "kernel_launch: hipFuncSetAttribute failed\n"); grid = -1; return; }
        int per_cu = 0;
        if (hipOccupancyMaxActiveBlocksPerMultiprocessor(&per_cu, (const void*)mega, NTHR, LDS_BYTES) != hipSuccess || per_cu < 1) { fprintf(stderr, "kernel_launch: occupancy query says %d\n", per_cu); (void)hipGetLastError(); }
        grid = cus * (per_cu >= 1 ? 1 : 1);
    }
    if (grid < 0) return;
    Params p{};
    for (int i = 0; i < N_IN; ++i) p.in[i] = (const float*)d_in[i];
    p.out = (float*)d_out; p.ws = (unsigned char*)d_ws;
    if (hipMemsetAsync(d_ws, 0, 65536, stream) != hipSuccess) { fprintf(stderr, "kernel_launch: memset failed\n"); return; }
    int lo = 0, hi = NPH;
    void* args[] = {(void*)&p, (void*)&lo, (void*)&hi};
    const hipError_t e = hipLaunchCooperativeKernel((const void*)mega, dim3(grid), dim3(NTHR), args, LDS_BYTES, stream);
    if (e != hipSuccess) fprintf(stderr, "kernel_launch: cooperative launch failed: %s (grid %d)\n", hipGetErrorString(e), grid);
    (void)in_sizes; (void)out_size;
}
```

```cpp
#include <hip/hip_runtime.h>
#include <hip/hip_cooperative_groups.h>
#include <cstdio>
#include <stdint.h>
namespace cg = cooperative_groups;
namespace pg8 {
#define PG8_LAS __attribute__((address_space(3)))
typedef unsigned short bf16_t;
typedef short bf16x8 __attribute__((ext_vector_type(8)));
typedef float f32x4 __attribute__((ext_vector_type(4)));
typedef unsigned u32x4 __attribute__((ext_vector_type(4)));
constexpr int BM = 256, BK = 64, HALF = 128, HTB = HALF * BK * 2  , STAGE_BYTES = 8 * HTB, NXCD = 8, WGM = 8;

__host__ __device__ __forceinline__ int lds_byte(int r, int c) { const int st = (r >> 4) * 2 + (c >> 5), rr = r & 15, cc = c & 31, ob = rr * 64 + cc * 2; return st * 1024 + (ob ^ (((ob >> 9) & 1) << 5)); }
__host__ __device__ __forceinline__ void stage_rc(int b, int& R, int& C) { const int st = b / 1024, sb = b % 1024, swz = sb ^ (((sb >> 9) & 1) << 5); R = (st >> 1) * 16 + swz / 64; C = (st & 1) * 32 + (swz % 64) / 2; }
__host__ __device__ __forceinline__ int perm32(int rho) { const int n = rho >> 4, i = rho & 15; return 8 * (i >> 2) + 4 * n + (i & 3); }

struct Unit { int pm, pn, ord; };
struct Gemm { const bf16_t* A; const bf16_t* Bt; int M, N, K, trows; };

struct StaticOrder {
    int nM, nN, nwg, G, c;
    __host__ __device__ void init(int M, int N, int G_, int c_) { nM = M / BM; nN = N / BM; nwg = nM * nN; G = G_; c = c_; }
    __host__ __device__ __forceinline__ bool next(int i, Unit& u) const {
        const long L = (long)i * G + c; if (L >= nwg) return false;
        int wgid = (int)L; { const int q = nwg / NXCD, r = nwg % NXCD, xcd = wgid % NXCD, off = wgid / NXCD; wgid = (xcd < r ? xcd * (q + 1) : r * (q + 1) + (xcd - r) * q) + off; }
        const int nig = WGM * nN, gid = wgid / nig, fm = gid * WGM, gsz = (nM - fm) < WGM ? (nM - fm) : WGM;
        u.pm = fm + ((wgid % nig) % gsz); u.pn = (wgid % nig) / gsz; u.ord = i; return true;
    }
    __device__ __forceinline__ void a_ready(const Unit&) const {}
    __device__ __forceinline__ void done(const Unit&) const {}
};
template <class Epi, class Sched, bool ALIGN_EPI = false, bool SP2 = false>
__device__ __forceinline__ void gemm_phase(PG8_LAS unsigned char* lds, const Gemm g, const Sched& S, const Epi& E, int tid_in) {
    int tid = tid_in; asm volatile("" : "+v"(tid));
    const int wid = __builtin_amdgcn_readfirstlane(tid >> 6), lane = tid & 63, wr = wid >> 2, wc = wid & 3, fr = lane & 15, fq = lane >> 4;
    const int K = g.K, nt = K / BK;
    unsigned voffA[2], voffB[2];
#pragma unroll
    for (int i = 0; i < 2; ++i) { int R, C; stage_rc(tid * 16 + i * 8192, R, C); const int Rb = E.perm ? ((R & ~31) + perm32(R & 31)) : R;
        voffA[i] = (unsigned)(R * K + C) * 2u; voffB[i] = (unsigned)(Rb * K + C) * 2u; }
    const size_t kstep = (size_t)(BK * 2);
    const size_t hstep = (size_t)HALF * K * 2;
    const size_t tstep = 2 * hstep; const size_t tstepA = (size_t)g.trows * K * 2;
    const unsigned ldsw = (unsigned)wid * 1024u;
    const int aoff = lds_byte(wr * 64 + fr, fq * 8), boff = lds_byte(wc * 32 + fr, fq * 8);
#define PG8_SA(b, h) (((b) * 2 + (h)) * HTB)
#define PG8_SB(b, h) ((4 + (b) * 2 + (h)) * HTB)
#define PG8_STAGE(bufoff, gbase, voff) do { _Pragma("unroll") for (int _i = 0; _i < 2; ++_i) \
        __builtin_amdgcn_global_load_lds((const unsigned*)((const char*)(gbase) + (voff)[_i]), (PG8_LAS unsigned*)(lds + (bufoff) + ldsw + _i * 8192), 16, 0, 0); } while (0)
#define PG8_LDA(dst, b, h) do { _Pragma("unroll") for (int m = 0; m < 4; ++m) _Pragma("unroll") for (int k = 0; k < 2; ++k) dst[m][k] = *(const PG8_LAS bf16x8*)(lds + PG8_SA(b, h) + aoff + m * 2048 + k * 1024); } while (0)
#define PG8_LDB(dst, b, h) do { _Pragma("unroll") for (int n = 0; n < 2; ++n) _Pragma("unroll") for (int k = 0; k < 2; ++k) dst[n][k] = *(const PG8_LAS bf16x8*)(lds + PG8_SB(b, h) + boff + n * 2048 + k * 1024); } while (0)
#define PG8_MMA(ai, bj, At, Bt) do { __builtin_amdgcn_s_setprio(1); _Pragma("unroll") for (int m = 0; m < 4; ++m) _Pragma("unroll") for (int n = 0; n < 2; ++n) _Pragma("unroll") for (int k = 0; k < 2; ++k) \
        acc[ai][bj][m][n] = __builtin_amdgcn_mfma_f32_16x16x32_bf16(Bt[n][k], At[m][k], acc[ai][bj][m][n], 0, 0, 0); __builtin_amdgcn_s_setprio(0); } while (0)
#define PG8_WAIT_V(n) asm volatile("s_waitcnt vmcnt(" #n ")" ::: "memory")
#define PG8_WAIT_L(n) asm volatile("s_waitcnt lgkmcnt(" #n ")" ::: "memory")
#define PG8_BAR __builtin_amdgcn_s_barrier()
#define PG8_SCHED __builtin_amdgcn_sched_barrier(0)
    Unit cur, nxt; int ui = 0;
    if (!S.next(0, cur)) return;
    f32x4 acc[2][2][4][2];
#pragma unroll
    for (int a = 0; a < 2; ++a)
#pragma unroll
        for (int b = 0; b < 2; ++b)
#pragma unroll
            for (int m = 0; m < 4; ++m)
#pragma unroll
                for (int n = 0; n < 2; ++n) acc[a][b][m][n] = (f32x4){0.f, 0.f, 0.f, 0.f};
    bf16x8 At[4][2], B0[2][2], B1[2][2];
    const char* cA = (const char*)g.A + (size_t)cur.pm * tstepA; const char* cB = (const char*)g.Bt + (size_t)cur.pn * tstep;
    S.a_ready(cur);
    if constexpr (SP2) {
        PG8_STAGE(PG8_SB(0, 0), cB, voffB); PG8_STAGE(PG8_SB(0, 1), cB + hstep, voffB); PG8_STAGE(PG8_SA(0, 0), cA, voffA); PG8_STAGE(PG8_SA(0, 1), cA + hstep, voffA);
        if (wr == 1) PG8_BAR;
        PG8_WAIT_V(2); PG8_BAR;
        PG8_STAGE(PG8_SB(1, 0), cB + kstep, voffB); PG8_STAGE(PG8_SA(1, 0), cA + kstep, voffA); PG8_STAGE(PG8_SB(1, 1), cB + hstep + kstep, voffB);
        PG8_WAIT_V(6); PG8_BAR;
    } else {
        PG8_STAGE(PG8_SB(0, 0), cB, voffB); PG8_STAGE(PG8_SA(0, 0), cA, voffA); PG8_STAGE(PG8_SB(0, 1), cB + hstep, voffB); PG8_STAGE(PG8_SA(0, 1), cA + hstep, voffA);
        if (wr == 1) PG8_BAR;
        PG8_WAIT_V(4); PG8_BAR;
        PG8_STAGE(PG8_SB(1, 0), cB + kstep, voffB); PG8_STAGE(PG8_SA(1, 0), cA + kstep, voffA); PG8_STAGE(PG8_SB(1, 1), cB + hstep + kstep, voffB);
        PG8_WAIT_V(6); PG8_BAR;
    }
    for (;;) {
        const bool has_next = S.next(ui + 1, nxt);
        const char* nA = has_next ? (const char*)g.A + (size_t)nxt.pm * tstepA : cA; const char* nB = has_next ? (const char*)g.Bt + (size_t)nxt.pn * tstep : cB;
        for (int t = 0; t < nt; t += 2) {
            const bool last = (t == nt - 2);
            const char* a1 = cA + (size_t)(t + 1) * kstep;
            const char* a2 = last ? nA : cA + (size_t)(t + 2) * kstep; const char* b2 = last ? nB : cB + (size_t)(t + 2) * kstep;
            const char* a3 = a2 + kstep; const char* b3 = b2 + kstep;
            if (last && has_next) S.a_ready(nxt);
            if constexpr (SP2) {
            PG8_LDB(B0, 0, 0); PG8_LDB(B1, 0, 1); PG8_SCHED; PG8_LDA(At, 0, 0); PG8_STAGE(PG8_SA(1, 1), a1 + hstep, voffA);
            PG8_WAIT_V(8); PG8_WAIT_L(0); PG8_BAR; PG8_MMA(0, 0, At, B0); PG8_MMA(0, 1, At, B1); PG8_BAR; PG8_SCHED;
            PG8_LDA(At, 0, 1); PG8_STAGE(PG8_SB(0, 0), b2, voffB); PG8_STAGE(PG8_SB(0, 1), b2 + hstep, voffB); PG8_STAGE(PG8_SA(0, 0), a2, voffA);
            PG8_WAIT_V(8); PG8_WAIT_L(0); PG8_BAR; PG8_MMA(1, 0, At, B0); PG8_MMA(1, 1, At, B1); PG8_BAR; PG8_SCHED;
            PG8_LDB(B0, 1, 0); PG8_LDB(B1, 1, 1); PG8_SCHED; PG8_LDA(At, 1, 0); PG8_STAGE(PG8_SA(0, 1), a2 + hstep, voffA);
            PG8_WAIT_V(8); PG8_WAIT_L(0); PG8_BAR; PG8_MMA(0, 0, At, B0); PG8_MMA(0, 1, At, B1); PG8_BAR; PG8_SCHED;
            PG8_LDA(At, 1, 1); PG8_STAGE(PG8_SB(1, 0), b3, voffB); PG8_STAGE(PG8_SB(1, 1), b3 + hstep, voffB); PG8_STAGE(PG8_SA(1, 0), a3, voffA);
            PG8_WAIT_V(8); PG8_WAIT_L(0); PG8_BAR; PG8_MMA(1, 0, At, B0); PG8_MMA(1, 1, At, B1); PG8_BAR; PG8_SCHED;
            } else {
            PG8_LDB(B0, 0, 0); PG8_SCHED; PG8_LDA(At, 0, 0); PG8_STAGE(PG8_SA(1, 1), a1 + hstep, voffA);
            PG8_WAIT_L(8); PG8_BAR; PG8_WAIT_L(0); PG8_MMA(0, 0, At, B0); PG8_BAR; PG8_SCHED;
            PG8_LDB(B1, 0, 1); PG8_STAGE(PG8_SB(0, 0), b2, voffB);
            PG8_BAR; PG8_WAIT_L(0); PG8_MMA(0, 1, At, B1); PG8_BAR;
            PG8_LDA(At, 0, 1); PG8_STAGE(PG8_SA(0, 0), a2, voffA);
            PG8_BAR; PG8_WAIT_L(0); PG8_MMA(1, 0, At, B0); PG8_BAR; PG8_SCHED;
            PG8_STAGE(PG8_SB(0, 1), b2 + hstep, voffB);
            PG8_WAIT_V(6); PG8_BAR; PG8_MMA(1, 1, At, B1); PG8_BAR;
            PG8_LDB(B0, 1, 0); PG8_SCHED; PG8_LDA(At, 1, 0); PG8_STAGE(PG8_SA(0, 1), a2 + hstep, voffA);
            PG8_WAIT_L(8); PG8_BAR; PG8_WAIT_L(0); PG8_MMA(0, 0, At, B0); PG8_BAR; PG8_SCHED;
            PG8_LDB(B1, 1, 1); PG8_STAGE(PG8_SB(1, 0), b3, voffB);
            PG8_BAR; PG8_WAIT_L(0); PG8_MMA(0, 1, At, B1); PG8_BAR;
            PG8_LDA(At, 1, 1); PG8_STAGE(PG8_SA(1, 0), a3, voffA);
            PG8_BAR; PG8_WAIT_L(0); PG8_MMA(1, 0, At, B0); PG8_BAR; PG8_SCHED;
            PG8_STAGE(PG8_SB(1, 1), b3 + hstep, voffB);
            PG8_WAIT_V(6); PG8_BAR; PG8_MMA(1, 1, At, B1); PG8_BAR;
            }
        }
        if constexpr (ALIGN_EPI) { if (wr == 0) PG8_BAR; }
        if constexpr (!Epi::AFTER_DRAIN) { E(acc, cur, wr, wc, fr, fq); S.done(cur); }
        if (!has_next) break;
#pragma unroll
        for (int a = 0; a < 2; ++a)
#pragma unroll
            for (int b = 0; b < 2; ++b)
#pragma unroll
                for (int m = 0; m < 4; ++m)
#pragma unroll
                    for (int n = 0; n < 2; ++n) acc[a][b][m][n] = (f32x4){0.f, 0.f, 0.f, 0.f};
        cur = nxt; cA = nA; cB = nB; ++ui;
        if constexpr (ALIGN_EPI) { if (wr == 1) PG8_BAR; }
    }
    PG8_WAIT_V(0);
    if constexpr (!ALIGN_EPI) { if (wr == 0) PG8_BAR; }
    PG8_BAR;
    if constexpr (Epi::AFTER_DRAIN) { E.fused(acc, cur, wr, wc, fr, fq, lds, wid, lane); S.done(cur); }
#undef PG8_SA
#undef PG8_SB
#undef PG8_STAGE
#undef PG8_LDA
#undef PG8_LDB
#undef PG8_MMA
#undef PG8_WAIT_V
#undef PG8_WAIT_L
#undef PG8_BAR
#undef PG8_SCHED
}
}

namespace {
constexpr int D = 1024, BATCH = 8, SEQ = 2048, NMETA = 16, TP = SEQ + NMETA, MP = BATCH * TP, SB = 128, M = MP + SB;
constexpr int DEPTH = 4, RH = 4, RDK = 256, RDV = 512, RV = 2048, RWIN = 6144;
constexpr int WH = 16, WN = 64, LW = 64, LA = 64, LV = 32, LG = 160, DFF = 2816;
constexpr int NRW = 3584, KRW = 2048, KL2 = 384, NL2 = 4096;
constexpr float PAST_POS = 16384.f;
constexpr int NWAVES = 8, NTHR = 512;
constexpr int LDS_BYTES = 147456;

constexpr size_t O_YP = 0;
constexpr size_t O_YS = O_YP + (size_t)BATCH * SEQ * D;
constexpr size_t O_RETP = O_YS + (size_t)SB * D;
constexpr size_t O_WKVP = O_RETP + (size_t)2 * BATCH * RH * RDK * RDV;
constexpr size_t O_SHP = O_WKVP + (size_t)2 * BATCH * WH * WN * WN;
constexpr size_t O_CVP = O_SHP + (size_t)2 * BATCH * D;
constexpr size_t O_RETS = O_CVP + (size_t)DEPTH * BATCH * 2 * DFF;
constexpr size_t O_WKVS = O_RETS + (size_t)2 * SB * RH * RDK * RDV;
constexpr size_t O_SHS = O_WKVS + (size_t)2 * SB * WH * WN * WN;
constexpr size_t O_CVS = O_SHS + (size_t)2 * SB * D;

enum { I_XP = 0, I_XS, I_SRET, I_SWKV, I_SSHIFT, I_SCONV, I_META, I_NMIX, I_NFFN, I_NFIN, I_RWIN, I_RGN, I_RWOUT, I_MU, I_WRKV, I_W0, I_W1, I_W2,
       I_A0, I_A1, I_A2, I_V0, I_V1, I_V2, I_G1, I_G2, I_KK, I_KA, I_RK, I_LNW, I_LNB, I_WO, I_WUG, I_CW, I_CB, I_WD, N_IN };

constexpr size_t al256(size_t x) { return (x + 255) & ~(size_t)255; }
constexpr size_t WS_CTL = 0;
constexpr size_t WS_CS = 1u << 20;
constexpr size_t WS_WIN = 4u << 20;
constexpr size_t SZ_WIN = (size_t)RWIN * D * 2;
constexpr size_t WS_WOUT = WS_WIN + 2 * SZ_WIN;
constexpr size_t SZ_WOUT = (size_t)D * RV * 2;
constexpr size_t WS_WRW = WS_WOUT + 2 * SZ_WOUT;
constexpr size_t SZ_WRW = (size_t)NRW * KRW * 2;
constexpr size_t WS_WL2 = WS_WRW + 2 * SZ_WRW;
constexpr size_t SZ_WL2 = (size_t)NL2 * KL2 * 2;
constexpr size_t WS_WO = WS_WL2 + 2 * SZ_WL2;
constexpr size_t SZ_WO = (size_t)D * D * 2;
constexpr size_t WS_WUG = WS_WO + 2 * SZ_WO;
constexpr size_t SZ_WUG = (size_t)2 * DFF * D * 2;
constexpr size_t WS_WD = WS_WUG + 4 * SZ_WUG;
constexpr size_t SZ_WD = (size_t)D * DFF * 2;
constexpr size_t WS_X = al256(WS_WD + 4 * SZ_WD);
constexpr size_t SZ_MD4 = (size_t)M * D * 4;
constexpr size_t WS_H = WS_X + SZ_MD4;
constexpr size_t WS_VF = WS_H + SZ_MD4;
constexpr size_t WS_REG = WS_VF + SZ_MD4;
constexpr size_t WS_QK = WS_REG;
constexpr size_t WS_V = WS_QK + SZ_MD4;
constexpr size_t WS_SG = WS_V + SZ_MD4;
constexpr size_t WS_O = WS_SG + SZ_MD4;
constexpr size_t WS_Y = WS_O + 2 * SZ_MD4;
constexpr size_t WS_R = WS_REG;
constexpr size_t WS_K = WS_R + SZ_MD4;
constexpr size_t WS_VB = WS_K + SZ_MD4;
constexpr size_t WS_WDEC = WS_VB + SZ_MD4;
constexpr size_t WS_NKK = WS_WDEC + SZ_MD4;
constexpr size_t WS_KKA = WS_NKK + SZ_MD4;
constexpr size_t WS_YW = WS_KKA + SZ_MD4;
constexpr size_t WS_L2 = WS_YW + SZ_MD4;
constexpr size_t WS_A2 = WS_L2 + 4 * SZ_MD4;
constexpr size_t WS_Z = al256(WS_A2 + (size_t)M * KL2 * 2);
constexpr size_t WS_RW_END = WS_Z + (size_t)M * D * 2;
constexpr size_t SZ_FF2 = (size_t)M * DFF * 2;
constexpr size_t WS_U = WS_REG;
constexpr size_t WS_G = al256(WS_U + SZ_FF2);
constexpr size_t WS_ACT = al256(WS_G + SZ_FF2);
constexpr size_t WS_XB = al256(WS_RW_END) + 2 * (size_t)D * 2;
constexpr size_t WS_SS = al256(WS_XB + (size_t)(M + 126) * D * 2);
constexpr size_t WS_PTRS = al256(WS_SS + (size_t)8 * M * 16 * 4);
constexpr size_t WS_END = WS_PTRS + 256;

#define LAS __attribute__((address_space(3)))
typedef unsigned short bf16;
typedef unsigned v4u __attribute__((ext_vector_type(4)));
typedef unsigned v2u __attribute__((ext_vector_type(2)));
using pg8::f32x4;
using pg8::Unit;
using pg8::bf16x8;

struct Params { const float* in[N_IN]; float* out; unsigned char* ws; };

__device__ __forceinline__ unsigned cvt_pk_bf16(float lo, float hi) { unsigned r; asm("v_cvt_pk_bf16_f32 %0, %1, %2" : "=v"(r) : "v"(lo), "v"(hi)); return r; }
__device__ __forceinline__ float bf_lo(unsigned w) { return __uint_as_float(w << 16); }
__device__ __forceinline__ float bf_hi(unsigned w) { return __uint_as_float(w & 0xffff0000u); }
__device__ __forceinline__ void unpack8(const v4u w, float (&f)[8]) { f[0] = bf_lo(w.x); f[1] = bf_hi(w.x); f[2] = bf_lo(w.y); f[3] = bf_hi(w.y); f[4] = bf_lo(w.z); f[5] = bf_hi(w.z); f[6] = bf_lo(w.w); f[7] = bf_hi(w.w); }
__device__ __forceinline__ v4u pack8(const float (&f)[8]) { v4u w; w.x = cvt_pk_bf16(f[0], f[1]); w.y = cvt_pk_bf16(f[2], f[3]); w.z = cvt_pk_bf16(f[4], f[5]); w.w = cvt_pk_bf16(f[6], f[7]); return w; }
__device__ __forceinline__ f32x4 ld_bf4(const bf16* q) { const v2u w = *(const v2u*)q; return (f32x4){bf_lo(w.x), bf_hi(w.x), bf_lo(w.y), bf_hi(w.y)}; }
__device__ __forceinline__ void st_bf4(bf16* q, const f32x4 v) { v2u w; w.x = cvt_pk_bf16(v.x, v.y); w.y = cvt_pk_bf16(v.z, v.w); *(v2u*)q = w; }
__device__ __forceinline__ float shfl_xor_l(float v, int m, int lane) { return __int_as_float(__builtin_amdgcn_ds_bpermute((lane ^ m) << 2, __float_as_int(v))); }
__device__ __forceinline__ float shfl_l(float v, int src) { return __int_as_float(__builtin_amdgcn_ds_bpermute(src << 2, __float_as_int(v))); }
__device__ __forceinline__ float wave_sum(float v, int lane) {
#pragma unroll
    for (int o = 1; o < 64; o <<= 1) v += shfl_xor_l(v, o, lane);
    return v;
}
__device__ __forceinline__ float sigmoidf_(float x) { return 1.f / (1.f + __expf(-x)); }
__device__ __forceinline__ float siluf_(float x) { return x / (1.f + __expf(-x)); }
__device__ __forceinline__ float tanhf_(float x) { return 1.f - 2.f / (1.f + __expf(2.f * x)); }

__device__ __forceinline__ float row_rstd(const unsigned char* ws, int slot, int row) {
    const f32x4* q = (const f32x4*)((const float*)(ws + WS_SS) + ((size_t)slot * M + row) * 16);
    const f32x4 a = q[0], b = q[1], c = q[2], d = q[3];
    const float ss = (((a.x + a.y) + (a.z + a.w)) + ((b.x + b.y) + (b.z + b.w))) + (((c.x + c.y) + (c.z + c.w)) + ((d.x + d.y) + (d.z + d.w)));
    return rsqrtf(ss * (1.f / D) + 1e-6f);
}
__device__ __forceinline__ float dpp_ror1(float v) { return __int_as_float(__builtin_amdgcn_update_dpp(0, __float_as_int(v), 0x121, 0xf, 0xf, false)); }
__device__ __forceinline__ float dpp_ror2(float v) { return __int_as_float(__builtin_amdgcn_update_dpp(0, __float_as_int(v), 0x122, 0xf, 0xf, false)); }
enum { EK_RETIN = 0, EK_RESID, EK_UG, EK_RWPROJ, EK_F32 };
template <int GRP> struct EpiExtra {};
template <> struct EpiExtra<1> { const float* pcw; const float* pcb; const float* pcst; float* pout; };
template <int GRP> struct EpiAnyT : EpiExtra<GRP> {
    static constexpr bool AFTER_DRAIN = false;
    int kind; bool perm; int jl; unsigned char* ws; int slot; const LAS float* rtab; float amul; int li; LAS unsigned char* ldsb;
    __device__ __forceinline__ void operator()(const f32x4 (&acc)[2][2][4][2], const Unit& u, int wr, int wc, int fr, int fq) const {
        const int row0 = u.pm * 256 + wr * 64 + fr;
        if (GRP == 0 && kind == EK_RETIN) {
            bf16* QK = (bf16*)(ws + WS_QK); bf16* V = (bf16*)(ws + WS_V); bf16* SG = (bf16*)(ws + WS_SG); const float* CS = (const float*)(ws + WS_CS);
            const int cw = wc * 32 + 8 * fq;
            if (u.pn < 8) {
                const bool isk = u.pn >= 4; const int h = u.pn & 3; const float sc = isk ? 0.0625f : 1.f;
                bf16* base = QK + (isk ? 1024 : 0) + h * 256 + cw;
#pragma unroll
                for (int ai = 0; ai < 2; ++ai) {
                    f32x4 tt[4][4];
#pragma unroll
                    for (int m = 0; m < 4; ++m) { const int row = row0 + ai * 128 + m * 16; const int pi = row < MP ? row % TP : TP;
                        const f32x4* cs = (const f32x4*)(CS + ((size_t)pi * 128 + cw) * 2);
#pragma unroll
                        for (int q4 = 0; q4 < 4; ++q4) tt[m][q4] = cs[q4]; }
#pragma unroll
                    for (int m = 0; m < 4; ++m) {
                        const int row = row0 + ai * 128 + m * 16;
                        const float rs = rtab[u.ord * 256 + (row - u.pm * 256)] * sc;
                        const f32x4 t0 = tt[m][0], t1 = tt[m][1], t2 = tt[m][2], t3 = tt[m][3];
                        const float c[8] = {t0.x, t0.z, t1.x, t1.z, t2.x, t2.z, t3.x, t3.z}, s[8] = {t0.y, t0.w, t1.y, t1.w, t2.y, t2.w, t3.y, t3.w};
                        float o1[8], o2[8];
#pragma unroll
                        for (int n = 0; n < 2; ++n)
#pragma unroll
                            for (int j = 0; j < 4; ++j) {
                                const float x1 = acc[ai][0][m][n][j], x2 = acc[ai][1][m][n][j];
                                o1[n * 4 + j] = (x1 * c[n * 4 + j] - x2 * s[n * 4 + j]) * rs;
                                o2[n * 4 + j] = (x1 * s[n * 4 + j] + x2 * c[n * 4 + j]) * rs;
                            }
                        bf16* rp = base + (size_t)row * 2048;
                        *(v4u*)rp = pack8(o1); *(v4u*)(rp + 128) = pack8(o2);
                    }
                    asm volatile("" ::: "memory");
                }
            } else {
                const bool isg = u.pn >= 16;
                bf16* base = (isg ? SG : V) + ((u.pn - (isg ? 16 : 8)) * 256) + cw;
#pragma unroll
                for (int ai = 0; ai < 2; ++ai)
#pragma unroll
                    for (int m = 0; m < 4; ++m) {
                        bf16* rp = base + (size_t)(row0 + ai * 128 + m * 16) * 2048;
                        const float rs = rtab[u.ord * 256 + (wr * 64 + fr + ai * 128 + m * 16)];
#pragma unroll
                        for (int bj = 0; bj < 2; ++bj) {
                            float o[8];
#pragma unroll
                            for (int n = 0; n < 2; ++n)
#pragma unroll
                                for (int j = 0; j < 4; ++j) { const float x = acc[ai][bj][m][n][j] * rs; o[n * 4 + j] = isg ? siluf_(x) : x; }
                            *(v4u*)(rp + bj * 128) = pack8(o);
                        }
                    }
            }
        } else if (GRP == 0 && kind == EK_RESID) {
            float* X = (float*)(ws + WS_X);
            const int col0 = u.pn * 256 + wc * 32 + 4 * fq;
#pragma unroll
            for (int am = 0; am < 4; ++am) { const int ai = am >> 1, mb = (am & 1) * 2;
                f32x4 xv[2][2][2];
#pragma unroll
                for (int mm = 0; mm < 2; ++mm) { const int m = mb + mm; const float* rp = X + (size_t)(row0 + ai * 128 + m * 16) * D + col0;
#pragma unroll
                    for (int bj = 0; bj < 2; ++bj)
#pragma unroll
                        for (int n = 0; n < 2; ++n) xv[mm][bj][n] = *(const f32x4*)(rp + bj * 128 + n * 16); }
#pragma unroll
                for (int mm = 0; mm < 2; ++mm) { const int m = mb + mm;
                    const int row = row0 + ai * 128 + m * 16;
                    float* rp = X + (size_t)row * D + col0; bf16* xb = (bf16*)(ws + WS_XB) + (size_t)row * D + col0;
                    float ssq = 0.f;
#pragma unroll
                    for (int bj = 0; bj < 2; ++bj)
#pragma unroll
                        for (int n = 0; n < 2; ++n) { const f32x4 v = xv[mm][bj][n] + acc[ai][bj][m][n] * amul; *(f32x4*)(rp + bj * 128 + n * 16) = v;
                            if (slot >= 0) { ssq += (v.x * v.x + v.y * v.y) + (v.z * v.z + v.w * v.w); v2u w; w.x = cvt_pk_bf16(v.x, v.y); w.y = cvt_pk_bf16(v.z, v.w); *(v2u*)(xb + bj * 128 + n * 16) = w; } }
                    if (slot >= 0) { ssq += shfl_xor_l(ssq, 16, fq * 16 + fr); ssq += shfl_xor_l(ssq, 32, fq * 16 + fr); if (fq == 0) ((float*)(ws + WS_SS))[((size_t)slot * M + row) * 16 + u.pn * 4 + wc] = ssq; }
                }
                asm volatile("" ::: "memory");
            }
        } else if (GRP == 1 && kind == EK_UG) {
            const EpiExtra<1>& X1 = *(const EpiExtra<1>*)(const void*)this;
            const float* cw = X1.pcw + (size_t)li * 3 * DFF; const float* cb = X1.pcb + (size_t)li * DFF; const float* cst = X1.pcst + (size_t)li * SB * 2 * DFF;
            float* cvp = X1.pout + O_CVP + (size_t)li * BATCH * 2 * DFF; float* cvs = X1.pout + O_CVS + (size_t)li * SB * 2 * DFF;
            bf16* ACT = (bf16*)(ws + WS_ACT);
            const int fl = wc * 32 + 8 * fq;
            LAS float* halo = (LAS float*)(ldsb + 131072 + 8192);
            const LAS float* rt = rtab + u.ord * 256;
#pragma unroll
            for (int ai = 0; ai < 2; ++ai) if (fr >= 14) {
                const float rs = rt[128 * ai + 64 * wr + 48 + fr];
                LAS float* hp = halo + ((2 * ai + wr) * 2 + (fr - 14)) * 128 + fl;
                *(LAS f32x4*)hp = acc[ai][1][3][0] * rs; *(LAS f32x4*)(hp + 4) = acc[ai][1][3][1] * rs;
            }
            asm volatile("s_waitcnt lgkmcnt(0)" ::: "memory"); __builtin_amdgcn_s_barrier(); asm volatile("" ::: "memory");
#pragma unroll
            for (int n = 0; n < 2; ++n) {
                const int f0 = u.pn * 128 + fl + 4 * n;
                const f32x4 w0 = *(const f32x4*)(cw + f0), w1 = *(const f32x4*)(cw + DFF + f0), w2 = *(const f32x4*)(cw + 2 * DFF + f0), bb = *(const f32x4*)(cb + f0);
                f32x4 prev = (f32x4){0.f, 0.f, 0.f, 0.f};
#pragma unroll
                for (int ai = 0; ai < 2; ++ai)
#pragma unroll
                    for (int m = 0; m < 4; ++m) {
                        const int l = 128 * ai + 64 * wr + 16 * m + fr, row = 254 * u.pm - 2 + l;
                        const float rs = rt[l];
                        const f32x4 cur = acc[ai][1][m][n] * rs, uu = acc[ai][0][m][n] * rs;
                        if (m == 0) {
                            const int B = 2 * ai + wr;
                            prev = (f32x4){0.f, 0.f, 0.f, 0.f};
                            if (B > 0 && fr >= 14) prev = *(const LAS f32x4*)(halo + ((B - 1) * 2 + (fr - 14)) * 128 + fl + 4 * n);
                        }
                        f32x4 g1, g2;
                        {
                            const float c1x = dpp_ror1(cur.x), c1y = dpp_ror1(cur.y), c1z = dpp_ror1(cur.z), c1w = dpp_ror1(cur.w);
                            const float p1x = dpp_ror1(prev.x), p1y = dpp_ror1(prev.y), p1z = dpp_ror1(prev.z), p1w = dpp_ror1(prev.w);
                            const float c2x = dpp_ror2(cur.x), c2y = dpp_ror2(cur.y), c2z = dpp_ror2(cur.z), c2w = dpp_ror2(cur.w);
                            const float p2x = dpp_ror2(prev.x), p2y = dpp_ror2(prev.y), p2z = dpp_ror2(prev.z), p2w = dpp_ror2(prev.w);
                            const bool s1 = fr >= 1, s2 = fr >= 2;
                            g1.x = s1 ? c1x : p1x; g1.y = s1 ? c1y : p1y; g1.z = s1 ? c1z : p1z; g1.w = s1 ? c1w : p1w;
                            g2.x = s2 ? c2x : p2x; g2.y = s2 ? c2y : p2y; g2.z = s2 ? c2z : p2z; g2.w = s2 ? c2w : p2w;
                        }
                        if (l >= 2 && row < M) {
                            if (row < MP) {
                                const int b = row / TP, t = row - b * TP;
                                if (t < 2) { g2 = (f32x4){0.f, 0.f, 0.f, 0.f}; if (t == 0) g1 = g2; }
                                if (t >= TP - 2) *(f32x4*)(cvp + ((size_t)b * 2 + (t - (TP - 2))) * DFF + f0) = cur;
                            } else {
                                const int s = row - MP;
                                const float* c0 = cst + ((size_t)s * 2 + 0) * DFF + f0;
                                g2 = *(const f32x4*)c0; g1 = *(const f32x4*)(c0 + DFF);
                                float* o = cvs + ((size_t)s * 2 + 0) * DFF + f0;
                                *(f32x4*)o = g1; *(f32x4*)(o + DFF) = cur;
                            }
                            const f32x4 cv = bb + w0 * g2 + w1 * g1 + w2 * cur;
                            v2u w; w.x = cvt_pk_bf16(siluf_(cv.x) * uu.x, siluf_(cv.y) * uu.y); w.y = cvt_pk_bf16(siluf_(cv.z) * uu.z, siluf_(cv.w) * uu.w);
                            *(v2u*)(ACT + (size_t)row * DFF + f0) = w;
                        }
                        prev = cur;
                    }
            }
        } else if (GRP == 0 && kind == EK_RWPROJ) {
            const int cw = wc * 32 + 8 * fq;
            if (u.pn < 12) {
                bf16* dst = (bf16*)(ws + (u.pn < 4 ? WS_R : (u.pn < 8 ? WS_K : (jl == 0 ? WS_VF : WS_VB)))) + (u.pn & 3) * 256 + cw;
#pragma unroll
                for (int ai = 0; ai < 2; ++ai)
#pragma unroll
                    for (int m = 0; m < 4; ++m) {
                        bf16* rp = dst + (size_t)(row0 + ai * 128 + m * 16) * D;
#pragma unroll
                        for (int bj = 0; bj < 2; ++bj) { float o[8];
#pragma unroll
                            for (int n = 0; n < 2; ++n)
#pragma unroll
                                for (int j = 0; j < 4; ++j) o[n * 4 + j] = acc[ai][bj][m][n][j];
                            *(v4u*)(rp + bj * 128) = pack8(o); }
                    }
            } else {
                bf16* A2 = (bf16*)(ws + WS_A2);
#pragma unroll
                for (int bj = 0; bj < 2; ++bj) {
                    const int c = (u.pn - 12) * 256 + bj * 128 + cw;
                    if (c < KL2) {
                        const int kd = c < 64 ? 1 : ((c >= 128 && c < 288) ? 2 : 0);
#pragma unroll
                        for (int ai = 0; ai < 2; ++ai)
#pragma unroll
                            for (int m = 0; m < 4; ++m) { float o[8];
#pragma unroll
                                for (int n = 0; n < 2; ++n)
#pragma unroll
                                    for (int j = 0; j < 4; ++j) { const float x = acc[ai][bj][m][n][j]; o[n * 4 + j] = kd == 1 ? tanhf_(x) : (kd == 2 ? sigmoidf_(x) : x); }
                                *(v4u*)(A2 + (size_t)(row0 + ai * 128 + m * 16) * KL2 + c) = pack8(o); }
                    }
                }
            }
        } else if (GRP == 0) {
            bf16* C = (bf16*)(ws + WS_L2);
            const int col0 = u.pn * 256 + wc * 32 + 8 * fq;
#pragma unroll
            for (int ai = 0; ai < 2; ++ai)
#pragma unroll
                for (int m = 0; m < 4; ++m) {
                    bf16* rp = C + (size_t)(row0 + ai * 128 + m * 16) * NL2 + col0;
#pragma unroll
                    for (int bj = 0; bj < 2; ++bj) { float o[8];
#pragma unroll
                        for (int n = 0; n < 2; ++n)
#pragma unroll
                            for (int j = 0; j < 4; ++j) o[n * 4 + j] = acc[ai][bj][m][n][j];
                        *(v4u*)(rp + bj * 128) = pack8(o); }
                }
        }
    }
};

constexpr int MT0 = 16384;
__device__ __forceinline__ void tail_resid(const bf16* __restrict__ A, const bf16* __restrict__ Bt, int K, unsigned char* ws, int slot, float amul, LAS unsigned char* lds, int lane, int wave) {
    const int fr = lane & 15, fq = lane >> 4;
    float* X = (float*)(ws + WS_X);
    const int kw = K >> 3;
    for (int job = blockIdx.x; job < 16 * 16; job += gridDim.x) {
        const int rs = job >> 4, cs = job & 15;
        const bf16* ap = A + (size_t)(MT0 + 16 * rs + fr) * K + wave * kw + 8 * fq;
        const bf16* bp = Bt + (size_t)(64 * cs + fr) * K + wave * kw + 8 * fq;
        f32x4 acc[4];
#pragma unroll
        for (int t = 0; t < 4; ++t) acc[t] = (f32x4){0.f, 0.f, 0.f, 0.f};
#pragma unroll 4
        for (int k0 = 0; k0 < kw; k0 += 32) {
            const bf16x8 af = *(const bf16x8*)(ap + k0);
#pragma unroll
            for (int t = 0; t < 4; ++t) { const bf16x8 bf = *(const bf16x8*)(bp + (size_t)(16 * t) * K + k0); acc[t] = __builtin_amdgcn_mfma_f32_16x16x32_bf16(bf, af, acc[t], 0, 0, 0); }
        }
        __syncthreads();
#pragma unroll
        for (int t = 0; t < 4; ++t) *(LAS f32x4*)(lds + ((wave * 4 + t) * 64 + lane) * 16) = acc[t];
        __syncthreads();
        if (wave == 0) {
#pragma unroll
            for (int t = 0; t < 4; ++t) { f32x4 s = acc[t];
#pragma unroll
                for (int w = 1; w < 8; ++w) s += *(LAS f32x4*)(lds + ((w * 4 + t) * 64 + lane) * 16);
                acc[t] = s; }
            const int row = MT0 + 16 * rs + fr;
            float* rp = X + (size_t)row * D + 64 * cs + 4 * fq; bf16* xb = (bf16*)(ws + WS_XB) + (size_t)row * D + 64 * cs + 4 * fq;
            float ssq = 0.f;
#pragma unroll
            for (int t = 0; t < 4; ++t) { const f32x4 v = *(const f32x4*)(rp + 16 * t) + acc[t] * amul; *(f32x4*)(rp + 16 * t) = v;
                if (slot >= 0) { ssq += (v.x * v.x + v.y * v.y) + (v.z * v.z + v.w * v.w); v2u w; w.x = cvt_pk_bf16(v.x, v.y); w.y = cvt_pk_bf16(v.z, v.w); *(v2u*)(xb + 16 * t) = w; } }
            if (slot >= 0) { ssq += shfl_xor_l(ssq, 16, lane); ssq += shfl_xor_l(ssq, 32, lane); if (fq == 0) ((float*)(ws + WS_SS))[((size_t)slot * M + row) * 16 + cs] = ssq; }
        }
    }
}

__device__ __forceinline__ void tr_item(const float* __restrict__ W, int ldw, int k0, int n0, bf16* __restrict__ WT, int ldt, int drow, const float* __restrict__ mu, LAS float* scr, int lane, const float* __restrict__ gs = nullptr) {
#pragma unroll 8
    for (int i = 0; i < 32; ++i) { const int kk = 2 * i + (lane >> 5); scr[kk * 33 + (lane & 31)] = W[(size_t)(k0 + kk) * ldw + n0 + (lane & 31)]; }
    asm volatile("s_waitcnt lgkmcnt(0)" ::: "memory");
    const int c = lane & 7;
    float mv[8];
    if (mu) {
#pragma unroll
        for (int e = 0; e < 8; ++e) mv[e] = mu[k0 + 8 * c + e];
    } else if (gs) {
#pragma unroll
        for (int e = 0; e < 8; ++e) mv[e] = gs[k0 + 8 * c + e];
    }
#pragma unroll
    for (int j = 0; j < 4; ++j) {
        const int n = (lane >> 3) + 8 * j; const LAS float* s = scr + (8 * c) * 33 + n;
        float f[8];
#pragma unroll
        for (int e = 0; e < 8; ++e) f[e] = s[e * 33];
        bf16* dp = WT + (size_t)(drow + n) * ldt + k0 + 8 * c;
        if (mu) {
            float f1[8], f2[8];
#pragma unroll
            for (int e = 0; e < 8; ++e) { f1[e] = f[e] * (1.f - mv[e]); f2[e] = f[e] * mv[e]; }
            *(v4u*)dp = pack8(f1); *(v4u*)(dp + 1024) = pack8(f2);
        } else { if (gs) {
#pragma unroll
            for (int e = 0; e < 8; ++e) f[e] *= mv[e]; }
            *(v4u*)dp = pack8(f); }
    }
    asm volatile("s_waitcnt lgkmcnt(0)" ::: "memory");
}

__device__ __forceinline__ void ph_p0(const Params& p, LAS unsigned char* lds, int tid, int lane, int wave) {
    unsigned char* ws = p.ws;
    LAS float* scr = (LAS float*)(lds + wave * 16384);
    const int gw = blockIdx.x * NWAVES + wave, NGW = gridDim.x * NWAVES;
    constexpr int C_WIN = 2 * 16 * 192, C_WOUT = 2 * 32 * 32, C_RKV = 2 * 3 * 512, C_W1 = 2 * 32, C_A1 = 2 * 32, C_G1 = 2 * 80, C_V1 = 16, C_WO = 2 * 512, C_WUG = 4 * 16 * 176, C_WD = 4 * 44 * 32;
    constexpr int NITEMS = C_WIN + C_WOUT + C_RKV + C_W1 + C_A1 + C_G1 + C_V1 + C_WO + C_WUG + C_WD;
    for (int it = gw; it < NITEMS; it += NGW) {
        int r = it;
        if (r < C_WIN) { const int j = r / 3072, q = r % 3072, kb = q / 192, nb = q % 192;
            tr_item(p.in[I_RWIN] + (size_t)j * D * RWIN, RWIN, 64 * kb, 32 * nb, (bf16*)(ws + WS_WIN + j * SZ_WIN), D, 32 * nb, nullptr, scr, lane, p.in[I_NMIX] + (size_t)(2 * j) * D); continue; }
        r -= C_WIN;
        if (r < C_WOUT) { const int j = r / 1024, q = r % 1024, kb = q / 32, nb = q % 32;
            tr_item(p.in[I_RWOUT] + (size_t)j * RV * D, D, 64 * kb, 32 * nb, (bf16*)(ws + WS_WOUT + j * SZ_WOUT), RV, 32 * nb, nullptr, scr, lane); continue; }
        r -= C_WOUT;
        if (r < C_RKV) { const int j = r / 1536, q = r % 1536, s = q / 512, q2 = q % 512, kb = q2 / 32, nb = q2 % 32, c = (s == 0 ? 0 : (s == 1 ? 2 : 3));
            tr_item(p.in[I_WRKV] + (size_t)(j * 3 + s) * D * D, D, 64 * kb, 32 * nb, (bf16*)(ws + WS_WRW + j * SZ_WRW), KRW, s * 1024 + 32 * nb, p.in[I_MU] + (size_t)(j * 6 + c) * D, scr, lane); continue; }
        r -= C_RKV;
        if (r < C_W1) { const int j = r / 32, q = r % 32, kb = q / 2, nb = q % 2;
            tr_item(p.in[I_W1] + (size_t)j * D * LW, LW, 64 * kb, 32 * nb, (bf16*)(ws + WS_WRW + j * SZ_WRW), KRW, 3072 + 32 * nb, p.in[I_MU] + (size_t)(j * 6 + 1) * D, scr, lane); continue; }
        r -= C_W1;
        if (r < C_A1) { const int j = r / 32, q = r % 32, kb = q / 2, nb = q % 2;
            tr_item(p.in[I_A1] + (size_t)j * D * LA, LA, 64 * kb, 32 * nb, (bf16*)(ws + WS_WRW + j * SZ_WRW), KRW, 3136 + 32 * nb, p.in[I_MU] + (size_t)(j * 6 + 4) * D, scr, lane); continue; }
        r -= C_A1;
        if (r < C_G1) { const int j = r / 80, q = r % 80, kb = q / 5, nb = q % 5;
            tr_item(p.in[I_G1] + (size_t)j * D * LG, LG, 64 * kb, 32 * nb, (bf16*)(ws + WS_WRW + j * SZ_WRW), KRW, 3200 + 32 * nb, p.in[I_MU] + (size_t)(j * 6 + 5) * D, scr, lane); continue; }
        r -= C_G1;
        if (r < C_V1) { const int kb = r;
            tr_item(p.in[I_V1], LV, 64 * kb, 0, (bf16*)(ws + WS_WRW + 1 * SZ_WRW), KRW, 3360, p.in[I_MU] + (size_t)(1 * 6 + 3) * D, scr, lane); continue; }
        r -= C_V1;
        if (r < C_WO) { const int j = r / 512, q = r % 512, kb = q / 32, nb = q % 32;
            tr_item(p.in[I_WO] + (size_t)j * D * D, D, 64 * kb, 32 * nb, (bf16*)(ws + WS_WO + j * SZ_WO), D, 32 * nb, nullptr, scr, lane); continue; }
        r -= C_WO;
        if (r < C_WUG) { const int i = r / 2816, q = r % 2816, kb = q / 176, nb = q % 176, n0 = 32 * nb;
            const int drow = n0 < DFF ? 256 * (n0 / 128) + (n0 % 128) : 256 * ((n0 - DFF) / 128) + 128 + ((n0 - DFF) % 128);
            tr_item(p.in[I_WUG] + (size_t)i * D * 2 * DFF, 2 * DFF, 64 * kb, n0, (bf16*)(ws + WS_WUG + i * SZ_WUG), D, drow, nullptr, scr, lane, p.in[I_NFFN] + (size_t)i * D); continue; }
        r -= C_WUG;
        { const int i = r / 1408, q = r % 1408, kb = q / 32, nb = q % 32;
            tr_item(p.in[I_WD] + (size_t)i * DFF * D, D, 64 * kb, 32 * nb, (bf16*)(ws + WS_WD + i * SZ_WD), DFF, 32 * nb, nullptr, scr, lane); }
    }
    const size_t gt = (size_t)blockIdx.x * NTHR + tid, GT = (size_t)gridDim.x * NTHR;
    for (size_t i = gt; i < (size_t)(224 + 192) * (KRW / 8); i += GT) {
        const int rr = (int)(i / (KRW / 8)), c8 = (int)(i % (KRW / 8));
        const int j = rr < 224 ? 0 : 1, row = rr < 224 ? 3360 + rr : 3392 + (rr - 224);
        *(v4u*)((bf16*)(ws + WS_WRW + j * SZ_WRW) + (size_t)row * KRW + c8 * 8) = (v4u){0u, 0u, 0u, 0u};
    }
    for (size_t i = gt; i < (size_t)2 * NL2 * KL2; i += GT) {
        const int j = (int)(i / ((size_t)NL2 * KL2)); const int rem = (int)(i % ((size_t)NL2 * KL2)); const int n = rem / KL2, k = rem % KL2, grp = n >> 10, nn = n & 1023;
        float v = 0.f;
        if (grp == 0) { if (k < 64) v = p.in[I_W2][((size_t)j * LW + k) * D + nn]; }
        else if (grp == 1) { if (k >= 64 && k < 128) v = p.in[I_A2][((size_t)j * LA + (k - 64)) * D + nn]; }
        else if (grp == 2) { if (k >= 128 && k < 288) v = p.in[I_G2][((size_t)j * LG + (k - 128)) * D + nn]; }
        else { if (j == 1 && k >= 288 && k < 320) v = p.in[I_V2][((size_t)(k - 288)) * D + nn]; }
        ((bf16*)(ws + WS_WL2 + j * SZ_WL2))[(size_t)n * KL2 + k] = (bf16)(cvt_pk_bf16(v, 0.f) & 0xffffu);
    }
    for (size_t i = gt; i < (size_t)(TP + 1) * 128; i += GT) {
        const int pi = (int)(i >> 7), mi = (int)(i & 127);
        const float pos = pi < TP ? (float)pi : PAST_POS;
        const float inv = 1.0f / powf(10000.0f, (float)mi / 127.0f);
        float s, c; sincosf(pos * inv, &s, &c);
        ((float2*)(ws + WS_CS))[i] = make_float2(c, s);
    }
    float* X = (float*)(ws + WS_X); bf16* XB = (bf16*)(ws + WS_XB);
    for (int r = gw; r < M; r += NGW) {
        const float* src;
        if (r < MP) { const int b = r / TP, t = r % TP; src = t < NMETA ? p.in[I_META] + (size_t)t * D : p.in[I_XP] + ((size_t)b * SEQ + (t - NMETA)) * D; }
        else src = p.in[I_XS] + (size_t)(r - MP) * D;
        float ss = 0.f;
#pragma unroll
        for (int j = 0; j < 2; ++j) { const int c0 = 512 * j + 8 * lane;
            const f32x4 a4 = *(const f32x4*)(src + c0), b4 = *(const f32x4*)(src + c0 + 4);
            *(f32x4*)(X + (size_t)r * D + c0) = a4; *(f32x4*)(X + (size_t)r * D + c0 + 4) = b4;
            const float f[8] = {a4.x, a4.y, a4.z, a4.w, b4.x, b4.y, b4.z, b4.w};
#pragma unroll
            for (int e = 0; e < 8; ++e) ss += f[e] * f[e];
            *(v4u*)(XB + (size_t)r * D + c0) = pack8(f); }
        ss = wave_sum(ss, lane);
        if (lane < 16) ((float*)(ws + WS_SS))[(size_t)r * 16 + lane] = lane == 0 ? ss : 0.f;
    }
}

__device__ __forceinline__ void ph_norm(const Params& p, const float* __restrict__ g, int mode, int jl, int lane, int wave) {
    const float* X = (const float*)(p.ws + WS_X); bf16* H = (bf16*)(p.ws + WS_H);
    const int gw = blockIdx.x * NWAVES + wave, NGW = gridDim.x * NWAVES;
    for (int row = gw; row < M; row += NGW) {
        const float* xr = X + (size_t)row * D;
        float v[2][8]; float ss = 0.f;
#pragma unroll
        for (int j = 0; j < 2; ++j) {
            const f32x4 a = *(const f32x4*)(xr + 512 * j + 8 * lane), b = *(const f32x4*)(xr + 512 * j + 8 * lane + 4);
            v[j][0] = a.x; v[j][1] = a.y; v[j][2] = a.z; v[j][3] = a.w; v[j][4] = b.x; v[j][5] = b.y; v[j][6] = b.z; v[j][7] = b.w;
#pragma unroll
            for (int e = 0; e < 8; ++e) ss += v[j][e] * v[j][e];
        }
        ss = wave_sum(ss, lane);
        const float rstd = rsqrtf(ss * (1.f / D) + 1e-6f);
        const bool prompt = row < MP; const int b = prompt ? row / TP : 0, t = prompt ? row % TP : 0;
#pragma unroll
        for (int j = 0; j < 2; ++j) {
            const int c0 = 512 * j + 8 * lane;
            const f32x4 ga = *(const f32x4*)(g + c0), gb = *(const f32x4*)(g + c0 + 4);
            float o[8];
            o[0] = v[j][0] * rstd * ga.x; o[1] = v[j][1] * rstd * ga.y; o[2] = v[j][2] * rstd * ga.z; o[3] = v[j][3] * rstd * ga.w;
            o[4] = v[j][4] * rstd * gb.x; o[5] = v[j][5] * rstd * gb.y; o[6] = v[j][6] * rstd * gb.z; o[7] = v[j][7] * rstd * gb.w;
            if (mode == 0) { *(v4u*)(H + (size_t)row * D + c0) = pack8(o); }
            else if (mode == 1) {
                const v4u w = pack8(o);
                *(v4u*)(H + (size_t)row * 2048 + c0) = w;
                if (prompt) {
                    if (t != TP - 1) *(v4u*)(H + (size_t)(row + 1) * 2048 + 1024 + c0) = w;
                    else { float* so = p.out + O_SHP + ((size_t)jl * BATCH + b) * D + c0; *(f32x4*)so = (f32x4){o[0], o[1], o[2], o[3]}; *(f32x4*)(so + 4) = (f32x4){o[4], o[5], o[6], o[7]}; }
                    if (t == 0) *(v4u*)(H + (size_t)row * 2048 + 1024 + c0) = (v4u){0u, 0u, 0u, 0u};
                } else {
                    const int s = row - MP;
                    const float* sp = p.in[I_SSHIFT] + ((size_t)jl * SB + s) * D + c0;
                    const f32x4 sa = *(const f32x4*)sp, sb2 = *(const f32x4*)(sp + 4);
                    const float pv[8] = {sa.x, sa.y, sa.z, sa.w, sb2.x, sb2.y, sb2.z, sb2.w};
                    *(v4u*)(H + (size_t)row * 2048 + 1024 + c0) = pack8(pv);
                    float* so = p.out + O_SHS + ((size_t)jl * SB + s) * D + c0; *(f32x4*)so = (f32x4){o[0], o[1], o[2], o[3]}; *(f32x4*)(so + 4) = (f32x4){o[4], o[5], o[6], o[7]};
                }
            } else {
                float* dst = nullptr;
                if (prompt) { if (t >= NMETA) dst = p.out + O_YP + ((size_t)b * SEQ + (t - NMETA)) * D + c0; }
                else dst = p.out + O_YS + (size_t)(row - MP) * D + c0;
                if (dst) { *(f32x4*)dst = (f32x4){o[0], o[1], o[2], o[3]}; *(f32x4*)(dst + 4) = (f32x4){o[4], o[5], o[6], o[7]}; }
            }
        }
    }
}

__device__ __forceinline__ void ph_ret_norm(const Params& p, int jl, int lane, int wave) {
    const float* O = (const float*)(p.ws + WS_O); const bf16* SG = (const bf16*)(p.ws + WS_SG); bf16* Y = (bf16*)(p.ws + WS_Y);
    const float* gnw = p.in[I_RGN] + (size_t)jl * RV;
    const int gw = blockIdx.x * NWAVES + wave, NGW = gridDim.x * NWAVES;
    for (int it = gw; it < M * RH; it += NGW) {
        const int row = it >> 2, h = it & 3; const size_t off = (size_t)row * RV + h * RDV + 8 * lane;
        const f32x4 a = *(const f32x4*)(O + off), b = *(const f32x4*)(O + off + 4);
        float v[8] = {a.x, a.y, a.z, a.w, b.x, b.y, b.z, b.w};
        float s = 0.f;
#pragma unroll
        for (int e = 0; e < 8; ++e) s += v[e];
        const float mean = wave_sum(s, lane) * (1.f / RDV);
        float s2 = 0.f;
#pragma unroll
        for (int e = 0; e < 8; ++e) { v[e] -= mean; s2 += v[e] * v[e]; }
        const float rstd = rsqrtf(wave_sum(s2, lane) * (1.f / RDV) + 1e-5f);
        float sg[8]; unpack8(*(const v4u*)(SG + off), sg);
        const f32x4 ga = *(const f32x4*)(gnw + h * RDV + 8 * lane), gb = *(const f32x4*)(gnw + h * RDV + 8 * lane + 4);
        const float gg[8] = {ga.x, ga.y, ga.z, ga.w, gb.x, gb.y, gb.z, gb.w};
        float o[8];
#pragma unroll
        for (int e = 0; e < 8; ++e) o[e] = v[e] * rstd * gg[e] * sg[e];
        *(v4u*)(Y + off) = pack8(o);
    }
}

__device__ __forceinline__ float row16_sum(float x);
__device__ __forceinline__ void ph_rwkv_post(const Params& p, int jl, int lane, int wave) {
    const float* YW = (const float*)(p.ws + WS_YW); const bf16* R = (const bf16*)(p.ws + WS_R); const bf16* KM = (const bf16*)(p.ws + WS_NKK);
    const bf16* VP = (const bf16*)(p.ws + WS_KKA); const bf16* L2 = (const bf16*)(p.ws + WS_L2); bf16* Z = (bf16*)(p.ws + WS_Z);
    const float* rk = p.in[I_RK] + (size_t)jl * D; const float* lnw = p.in[I_LNW] + (size_t)jl * D; const float* lnb = p.in[I_LNB] + (size_t)jl * D;
    const int gw = blockIdx.x * NWAVES + wave, NGW = gridDim.x * NWAVES;
    const int sub = lane >> 4, c4 = lane & 15;
    for (int it0 = gw * 4; it0 < M * WH; it0 += NGW * 4) {
        const int it = it0 + sub, row = it >> 4, h = it & 15, c = h * WN + 4 * c4;
        const size_t idx = (size_t)row * D + c;
        const f32x4 yv = *(const f32x4*)(YW + idx), r4 = ld_bf4(R + idx), k4 = ld_bf4(KM + idx), v4 = ld_bf4(VP + idx), g4 = ld_bf4(L2 + (size_t)row * NL2 + 2048 + c);
        const f32x4 rk4 = *(const f32x4*)(rk + c), lw4 = *(const f32x4*)(lnw + c), lb4 = *(const f32x4*)(lnb + c);
        const float mean = row16_sum((yv.x + yv.y) + (yv.z + yv.w)) * (1.f / WN);
        const f32x4 yc = yv - mean;
        const float rstd = rsqrtf(row16_sum((yc.x * yc.x + yc.y * yc.y) + (yc.z * yc.z + yc.w * yc.w)) * (1.f / WN) + 64e-5f);
        const f32x4 rkk = r4 * k4 * rk4;
        const float bon = row16_sum((rkk.x + rkk.y) + (rkk.z + rkk.w));
        const f32x4 z = (yc * rstd * lw4 + lb4 + v4 * bon) * g4;
        st_bf4(Z + idx, z);
    }
}

constexpr int RT_KP = 528, RT_VP = 144, RT_SP = 528;
constexpr int RT_K_OFF = 0, RT_V_OFF = 128 * RT_KP, RT_ST_OFF = RT_V_OFF + 128 * RT_VP, RT_END = RT_ST_OFF + 64 * RT_SP;
static_assert(RT_END <= LDS_BYTES, "retention LDS map");
typedef short v4s __attribute__((ext_vector_type(4)));
__device__ __forceinline__ bf16x8 tr_pair(LAS unsigned char* a0, LAS unsigned char* a1) {
    const v4s lo = __builtin_amdgcn_ds_read_tr16_b64_v4i16((LAS v4s*)a0), hi = __builtin_amdgcn_ds_read_tr16_b64_v4i16((LAS v4s*)a1);
    return __builtin_shufflevector(lo, hi, 0, 1, 2, 3, 4, 5, 6, 7);
}
__device__ __forceinline__ void ph_ret_fast(const Params& p, int jl, LAS unsigned char* lds, int tid, int lane, int wave) {
    const bf16* QK = (const bf16*)(p.ws + WS_QK); const bf16* V = (const bf16*)(p.ws + WS_V); float* O = (float*)(p.ws + WS_O);
    const int fr = lane & 15, fq = lane >> 4, li_q = (lane & 15) >> 2, li_p = lane & 3;
    for (int u = blockIdx.x; u < BATCH * RH * 8; u += gridDim.x) {
        const int es = u & 7, h = (u >> 3) & 3, b = u >> 5;
        const float gamma = 1.0f - exp2f(-5.0f - (float)h), lg = log2f(gamma), g128 = exp2f(128.f * lg), g127 = exp2f(127.f * lg);
        const int i0 = 16 * wave, d0 = 32 * wave;
        f32x4 Sacc[2][4];
#pragma unroll
        for (int a = 0; a < 2; ++a)
#pragma unroll
            for (int c = 0; c < 4; ++c) Sacc[a][c] = (f32x4){0.f, 0.f, 0.f, 0.f};
        __syncthreads();
        for (int i = tid; i < 64 * RT_SP / 16; i += NTHR) *(LAS v4u*)(lds + RT_ST_OFF + i * 16) = (v4u){0u, 0u, 0u, 0u};
        v4u kst[8], vst[2];
        const bf16* Kg = QK + 1024 + 256 * h; const bf16* Vg = V + 512 * h + 64 * es; const bf16* Qg = QK + 256 * h;
#define RT_LOAD_STAGE(cc) do { \
            _Pragma("unroll") for (int k_ = 0; k_ < 8; ++k_) { const int id_ = tid + 512 * k_, row_ = id_ >> 5, ch_ = id_ & 31, t_ = 128 * (cc) - 112 + row_; \
                kst[k_] = t_ >= 0 ? *(const v4u*)(Kg + (size_t)(b * TP + t_) * 2048 + 8 * ch_) : (v4u){0u, 0u, 0u, 0u}; } \
            _Pragma("unroll") for (int k_ = 0; k_ < 2; ++k_) { const int id_ = tid + 512 * k_, row_ = id_ >> 3, ch_ = id_ & 7, t_ = 128 * (cc) - 112 + row_; \
                vst[k_] = t_ >= 0 ? *(const v4u*)(Vg + (size_t)(b * TP + t_) * 2048 + 8 * ch_) : (v4u){0u, 0u, 0u, 0u}; } } while (0)
        RT_LOAD_STAGE(0);
        for (int c = 0; c < 17; ++c) {
            __syncthreads();
#pragma unroll
            for (int k_ = 0; k_ < 8; ++k_) { const int id_ = tid + 512 * k_, row_ = id_ >> 5, ch_ = id_ & 31; *(LAS v4u*)(lds + RT_K_OFF + row_ * RT_KP + ch_ * 16) = kst[k_]; }
#pragma unroll
            for (int k_ = 0; k_ < 2; ++k_) { const int id_ = tid + 512 * k_, row_ = id_ >> 3, ch_ = id_ & 7;
                float f[8]; unpack8(vst[k_], f); const float sc = exp2f(-(float)row_ * lg);
#pragma unroll
                for (int e = 0; e < 8; ++e) f[e] *= sc;
                *(LAS v4u*)(lds + RT_V_OFF + row_ * RT_VP + ch_ * 16) = pack8(f); }
            bf16x8 Qf[8];
            { const int t_ = 128 * c - 112 + i0 + fr;
#pragma unroll
              for (int s = 0; s < 8; ++s) Qf[s] = t_ >= 0 ? *(const bf16x8*)(Qg + (size_t)(b * TP + t_) * 2048 + 32 * s + 8 * fq) : (bf16x8){0, 0, 0, 0, 0, 0, 0, 0}; }
            __syncthreads();
            bf16x8 Pf[4];
            { const int ii = i0 + fr; const float gi = exp2f((float)ii * lg);
#pragma unroll
              for (int s2 = 0; s2 < 4; ++s2) { f32x4 Dp[2];
#pragma unroll
                  for (int hh = 0; hh < 2; ++hh) { Dp[hh] = (f32x4){0.f, 0.f, 0.f, 0.f};
#pragma unroll
                      for (int s = 0; s < 8; ++s) { const bf16x8 Kf = *(const LAS bf16x8*)(lds + RT_K_OFF + (16 * (2 * s2 + hh) + fr) * RT_KP + (32 * s + 8 * fq) * 2);
                          Dp[hh] = __builtin_amdgcn_mfma_f32_16x16x32_bf16(Kf, Qf[s], Dp[hh], 0, 0, 0); } }
                  float f[8];
#pragma unroll
                  for (int hh = 0; hh < 2; ++hh)
#pragma unroll
                      for (int r = 0; r < 4; ++r) { const int jj = 16 * (2 * s2 + hh) + 4 * fq + r; f[hh * 4 + r] = ii >= jj ? Dp[hh][r] * gi : 0.f; }
                  const v4u w = pack8(f); Pf[s2] = __builtin_bit_cast(bf16x8, w); } }
            f32x4 Oacc[4];
#pragma unroll
            for (int et = 0; et < 4; ++et) { Oacc[et] = (f32x4){0.f, 0.f, 0.f, 0.f};
#pragma unroll
                for (int s = 0; s < 8; ++s) { const bf16x8 Sf = *(const LAS bf16x8*)(lds + RT_ST_OFF + (16 * et + fr) * RT_SP + (32 * s + 8 * fq) * 2);
                    Oacc[et] = __builtin_amdgcn_mfma_f32_16x16x32_bf16(Qf[s], Sf, Oacc[et], 0, 0, 0); } }
            __syncthreads();
            if (c + 1 < 17) RT_LOAD_STAGE(c + 1);
#pragma unroll
            for (int r = 0; r < 4; ++r) { const float lam = exp2f((float)(i0 + 4 * fq + r + 1) * lg);
#pragma unroll
                for (int et = 0; et < 4; ++et) Oacc[et][r] *= lam; }
#pragma unroll
            for (int et = 0; et < 4; ++et)
#pragma unroll
                for (int s = 0; s < 4; ++s) {
                    LAS unsigned char* a0 = lds + RT_V_OFF + (32 * s + 4 * fq + li_q) * RT_VP + (16 * et + 4 * li_p) * 2;
                    const bf16x8 Vf = tr_pair(a0, a0 + 16 * RT_VP);
                    Oacc[et] = __builtin_amdgcn_mfma_f32_16x16x32_bf16(Pf[s], Vf, Oacc[et], 0, 0, 0); }
#pragma unroll
            for (int r = 0; r < 4; ++r) { const int t_ = 128 * c - 112 + i0 + 4 * fq + r;
                if (t_ >= 0) { float* op = O + (size_t)(b * TP + t_) * RV + 512 * h + 64 * es + fr;
#pragma unroll
                    for (int et = 0; et < 4; ++et) op[16 * et] = Oacc[et][r]; } }
#pragma unroll
            for (int dt = 0; dt < 2; ++dt)
#pragma unroll
                for (int et = 0; et < 4; ++et) Sacc[dt][et] = Sacc[dt][et] * (g128 / g127);
#pragma unroll
            for (int s = 0; s < 4; ++s) {
                bf16x8 Kt[2], Vt[4];
#pragma unroll
                for (int dt = 0; dt < 2; ++dt) { LAS unsigned char* a0 = lds + RT_K_OFF + (32 * s + 8 * fq + li_q) * RT_KP + (d0 + 16 * dt + 4 * li_p) * 2; Kt[dt] = tr_pair(a0, a0 + 4 * RT_KP); }
#pragma unroll
                for (int et = 0; et < 4; ++et) { LAS unsigned char* a0 = lds + RT_V_OFF + (32 * s + 8 * fq + li_q) * RT_VP + (16 * et + 4 * li_p) * 2; Vt[et] = tr_pair(a0, a0 + 4 * RT_VP); }
#pragma unroll
                for (int dt = 0; dt < 2; ++dt)
#pragma unroll
                    for (int et = 0; et < 4; ++et) Sacc[dt][et] = __builtin_amdgcn_mfma_f32_16x16x32_bf16(Kt[dt], Vt[et], Sacc[dt][et], 0, 0, 0);
            }
#pragma unroll
            for (int dt = 0; dt < 2; ++dt)
#pragma unroll
                for (int et = 0; et < 4; ++et) Sacc[dt][et] = Sacc[dt][et] * g127;
#pragma unroll
            for (int dt = 0; dt < 2; ++dt)
#pragma unroll
                for (int et = 0; et < 4; ++et) { v2u w; w.x = cvt_pk_bf16(Sacc[dt][et][0], Sacc[dt][et][1]); w.y = cvt_pk_bf16(Sacc[dt][et][2], Sacc[dt][et][3]);
                    *(LAS v2u*)(lds + RT_ST_OFF + (16 * et + fr) * RT_SP + (d0 + 16 * dt + 4 * fq) * 2) = w; }
        }
#undef RT_LOAD_STAGE
        float* so = p.out + O_RETP + ((((size_t)jl * BATCH + b) * RH + h) * RDK) * RDV + 64 * es;
#pragma unroll
        for (int dt = 0; dt < 2; ++dt)
#pragma unroll
            for (int et = 0; et < 4; ++et)
#pragma unroll
                for (int r = 0; r < 4; ++r) so[(size_t)(d0 + 16 * dt + 4 * fq + r) * RDV + 16 * et + fr] = Sacc[dt][et][r];
    }
    {
        LAS float* sq = (LAS float*)lds; LAS float* sk = sq + 256; LAS float* red = sk + 256;
        const int e4 = tid & 127, dq = tid >> 7;
        for (int it = blockIdx.x; it < SB * RH; it += gridDim.x) {
            const int h = it & 3, s = it >> 2, row = MP + s;
            const float gamma = 1.0f - exp2f(-5.0f - (float)h);
            __syncthreads();
            if (tid < 256) sq[tid] = bf_lo((unsigned)QK[(size_t)row * 2048 + 256 * h + tid]);
            else sk[tid - 256] = bf_lo((unsigned)QK[(size_t)row * 2048 + 1024 + 256 * h + (tid - 256)]);
            const v2u vv = *(const v2u*)(V + (size_t)row * 2048 + 512 * h + 4 * e4);
            const f32x4 v4 = (f32x4){bf_lo(vv.x), bf_hi(vv.x), bf_lo(vv.y), bf_hi(vv.y)};
            __syncthreads();
            const float* sin_ = p.in[I_SRET] + ((((size_t)jl * SB + s) * RH + h) * RDK) * RDV + 4 * e4;
            float* sout = p.out + O_RETS + ((((size_t)jl * SB + s) * RH + h) * RDK) * RDV + 4 * e4;
            f32x4 oacc = (f32x4){0.f, 0.f, 0.f, 0.f};
#pragma unroll 8
            for (int k = 0; k < 64; ++k) { const int d = dq + 4 * k;
                const f32x4 sv = __builtin_nontemporal_load((const f32x4*)(sin_ + (size_t)d * RDV));
                const f32x4 sn = sv * gamma + v4 * sk[d];
                oacc += sn * sq[d];
                __builtin_nontemporal_store(sn, (f32x4*)(sout + (size_t)d * RDV)); }
            *(LAS f32x4*)(red + dq * 512 + 4 * e4) = oacc;
            __syncthreads();
            if (dq == 0) { const f32x4 r = (*(LAS f32x4*)(red + 4 * e4) + *(LAS f32x4*)(red + 512 + 4 * e4)) + (*(LAS f32x4*)(red + 1024 + 4 * e4) + *(LAS f32x4*)(red + 1536 + 4 * e4));
                *(f32x4*)(O + (size_t)row * RV + 512 * h + 4 * e4) = r; }
        }
    }
}

typedef float f32x2w __attribute__((ext_vector_type(2)));
constexpr int WK_TB = 32, WK_STEP_B = 6 * 256 + 16, WK_BUF_B = WK_TB * WK_STEP_B, WK_Y_OFF = 2 * WK_BUF_B, WK_YB_B = WK_TB * 32 * 4;
static_assert(WK_Y_OFF + 2 * WK_YB_B <= LDS_BYTES - 16, "wkv LDS map");
__device__ __forceinline__ float row16_sum(float x) {
    x += __builtin_bit_cast(float, __builtin_amdgcn_update_dpp(0, __builtin_bit_cast(int, x), 0x128, 0xf, 0xf, false));
    x += __builtin_bit_cast(float, __builtin_amdgcn_update_dpp(0, __builtin_bit_cast(int, x), 0x124, 0xf, 0xf, false));
    x += __builtin_bit_cast(float, __builtin_amdgcn_update_dpp(0, __builtin_bit_cast(int, x), 0x122, 0xf, 0xf, false));
    x += __builtin_bit_cast(float, __builtin_amdgcn_update_dpp(0, __builtin_bit_cast(int, x), 0x121, 0xf, 0xf, false));
    return x;
}
__device__ __forceinline__ float half8_sum(float x) {
    x += __builtin_bit_cast(float, __builtin_amdgcn_update_dpp(0, __builtin_bit_cast(int, x), 0x141, 0xf, 0xf, false));
    x += __builtin_bit_cast(float, __builtin_amdgcn_update_dpp(0, __builtin_bit_cast(int, x), 0xB1, 0xf, 0xf, false));
    x += __builtin_bit_cast(float, __builtin_amdgcn_update_dpp(0, __builtin_bit_cast(int, x), 0x4E, 0xf, 0xf, false));
    return x;
}
struct WkPar { f32x4 w0, a0, kkp, kap, v0; };
__device__ __forceinline__ f32x4 wk_unit_neg(const f32x4 kraw, const f32x4 kkp) {
    const f32x4 kk = kraw * kkp;
    const float ss = row16_sum((kk.x * kk.x + kk.y * kk.y) + (kk.z * kk.z + kk.w * kk.w));
    return kk * (-rsqrtf(fmaxf(ss, 1e-12f)));
}
__device__ __forceinline__ float wk_decay(float x) { const float xw = -x; const float sp = xw > 20.f ? xw : log1pf(expf(xw)); return expf(-expf(-sp - 0.5f)); }
__device__ __forceinline__ void wk_prep(const WkPar& P, const f32x4 kraw, const f32x4 vraw, const f32x4 lw2, const f32x4 la2, const f32x4 vf, const f32x4 lv2, bool vres,
                                        f32x4& w, f32x4& ka, f32x4& km, f32x4& vp, f32x4& nk) {
    nk = wk_unit_neg(kraw, P.kkp);
    w = (f32x4){wk_decay(P.w0.x + lw2.x), wk_decay(P.w0.y + lw2.y), wk_decay(P.w0.z + lw2.z), wk_decay(P.w0.w + lw2.w)};
    const f32x4 a = (f32x4){sigmoidf_(P.a0.x + la2.x), sigmoidf_(P.a0.y + la2.y), sigmoidf_(P.a0.z + la2.z), sigmoidf_(P.a0.w + la2.w)};
    ka = nk * (-a);
    km = kraw * ((a - 1.f) * P.kap + 1.f);
    vp = vraw;
    if (vres) { const f32x4 sg = (f32x4){sigmoidf_(P.v0.x + lv2.x), sigmoidf_(P.v0.y + lv2.y), sigmoidf_(P.v0.z + lv2.z), sigmoidf_(P.v0.w + lv2.w)}; vp = vraw + (vf - vraw) * sg; }
}
__device__ __forceinline__ void ph_wkv_fast(const Params& p, int jl, LAS unsigned char* lds, int tid, int lane, int wave) {
    const bf16* Kr = (const bf16*)(p.ws + WS_K); const bf16* Vr = (const bf16*)(p.ws + (jl == 0 ? WS_VF : WS_VB)); const bf16* VFp = (const bf16*)(p.ws + WS_VF);
    const bf16* Rr = (const bf16*)(p.ws + WS_R); const bf16* L2 = (const bf16*)(p.ws + WS_L2);
    bf16* KM = (bf16*)(p.ws + WS_NKK); bf16* VP = (bf16*)(p.ws + WS_KKA);
    float* YW = (float*)(p.ws + WS_YW);
    const bool vres = jl == 1;
    const int ri = lane >> 4, cg = lane & 15;
    for (int it = blockIdx.x; it < BATCH * WH * 2; it += gridDim.x) {
        const int half = it & 1, h = (it >> 1) & 15, seq = it >> 5, r0 = seq * TP;
        const int sts = tid >> 4, sc4 = tid & 15;
        const int ch = h * WN + 4 * sc4;
        WkPar P; P.w0 = *(const f32x4*)(p.in[I_W0] + (size_t)jl * D + ch); P.a0 = *(const f32x4*)(p.in[I_A0] + (size_t)jl * D + ch); P.kkp = *(const f32x4*)(p.in[I_KK] + (size_t)jl * D + ch);
        P.kap = *(const f32x4*)(p.in[I_KA] + (size_t)jl * D + ch); P.v0 = *(const f32x4*)(p.in[I_V0] + ch);
        f32x4 SA = (f32x4){0.f, 0.f, 0.f, 0.f}, SB = (f32x4){0.f, 0.f, 0.f, 0.f}; float sa = 0.f;
        f32x4 st[8];
        const f32x4 z4 = (f32x4){0.f, 0.f, 0.f, 0.f};
#define WK_STAGE_LOAD(tbase) do { const int tt_ = (tbase) + sts; const size_t ro_ = (size_t)(r0 + tt_) * D + ch, lo_ = (size_t)(r0 + tt_) * NL2 + ch; \
            st[0] = (tt_ + 1 < TP) ? ld_bf4(Kr + ro_ + D) : z4; \
            if (tt_ < TP) { st[1] = ld_bf4(Kr + ro_); st[2] = ld_bf4(Vr + ro_); st[3] = ld_bf4(Rr + ro_); st[4] = ld_bf4(L2 + lo_); st[5] = ld_bf4(L2 + lo_ + 1024); \
                if (vres) { st[6] = ld_bf4(VFp + ro_); st[7] = ld_bf4(L2 + lo_ + 3072); } else { st[6] = z4; st[7] = z4; } } \
            else { st[1] = z4; st[2] = z4; st[3] = z4; st[4] = z4; st[5] = z4; st[6] = z4; st[7] = z4; } } while (0)
#define WK_STAGE_WRITE(Bp, tbase) do { LAS unsigned char* sl_ = (Bp) + sts * WK_STEP_B; const int tt_ = (tbase) + sts; \
            f32x4 w_, ka_, km_, vp_, nk_; wk_prep(P, st[1], st[2], st[4], st[5], st[6], st[7], vres, w_, ka_, km_, vp_, nk_); \
            const f32x4 nk1_ = wk_unit_neg(st[0], P.kkp); \
            const float c1_ = row16_sum((ka_.x * nk1_.x + ka_.y * nk1_.y) + (ka_.z * nk1_.z + ka_.w * nk1_.w)); \
            const float c2_ = row16_sum((km_.x * nk1_.x + km_.y * nk1_.y) + (km_.z * nk1_.z + km_.w * nk1_.w)); \
            *(LAS f32x4*)(sl_ + sc4 * 16) = w_ * nk1_; *(LAS f32x4*)(sl_ + 256 + sc4 * 16) = w_; *(LAS f32x4*)(sl_ + 512 + sc4 * 16) = ka_; \
            *(LAS f32x4*)(sl_ + 768 + sc4 * 16) = km_; *(LAS f32x4*)(sl_ + 1024 + sc4 * 16) = st[3]; *(LAS f32x4*)(sl_ + 1280 + sc4 * 16) = vp_; \
            if (sc4 == 0) *(LAS f32x2w*)(sl_ + 1536) = (f32x2w){c1_, c2_}; \
            if (half == 0 && tt_ < TP) { const size_t ro_ = (size_t)(r0 + tt_) * D + ch; st_bf4(KM + ro_, km_); st_bf4(VP + ro_, vp_); } } while (0)
        __syncthreads();
        WK_STAGE_LOAD(0);
        WK_STAGE_WRITE(lds, 0);
        __syncthreads();
        constexpr int NB = (TP + WK_TB - 1) / WK_TB;
        for (int bt = 0; bt < NB; ++bt) {
            const int t0 = bt * WK_TB, tn = t0 + WK_TB;
            const bool has_next = tn < TP;
            if (has_next) WK_STAGE_LOAD(tn);
            LAS unsigned char* B = lds + (bt & 1) * WK_BUF_B;
            LAS float* yb = (LAS float*)(lds + WK_Y_OFF + (bt & 1) * WK_YB_B);
            const int nst = (TP - t0) < WK_TB ? (TP - t0) : WK_TB;
            if (wave < 4) {
                const int ri8 = lane >> 3, cg8 = lane & 7;
                const int voff = 1280 + (32 * half + 8 * wave + ri8) * 4;
                LAS unsigned char* sp = B + cg8 * 32;
                f32x4 wnA = *(LAS f32x4*)(sp), wnB = *(LAS f32x4*)(sp + 16), wA = *(LAS f32x4*)(sp + 256), wB = *(LAS f32x4*)(sp + 272), kaA = *(LAS f32x4*)(sp + 512), kaB = *(LAS f32x4*)(sp + 528),
                      kA = *(LAS f32x4*)(sp + 768), kB = *(LAS f32x4*)(sp + 784), rA = *(LAS f32x4*)(sp + 1024), rB = *(LAS f32x4*)(sp + 1040);
                float vi = *(LAS float*)(B + voff); f32x2w cc = *(LAS f32x2w*)(B + 1536);
#pragma unroll 2
                for (int ts = 0; ts < nst; ++ts) {
                    const int tsn = (ts + 1 < WK_TB) ? ts + 1 : ts;
                    LAS unsigned char* spn = B + tsn * WK_STEP_B + cg8 * 32;
                    const f32x4 wnA_n = *(LAS f32x4*)(spn), wnB_n = *(LAS f32x4*)(spn + 16), wA_n = *(LAS f32x4*)(spn + 256), wB_n = *(LAS f32x4*)(spn + 272), kaA_n = *(LAS f32x4*)(spn + 512), kaB_n = *(LAS f32x4*)(spn + 528),
                                kA_n = *(LAS f32x4*)(spn + 768), kB_n = *(LAS f32x4*)(spn + 784), rA_n = *(LAS f32x4*)(spn + 1024), rB_n = *(LAS f32x4*)(spn + 1040);
                    const float vi_n = *(LAS float*)(B + tsn * WK_STEP_B + voff); const f32x2w cc_n = *(LAS f32x2w*)(B + tsn * WK_STEP_B + 1536);
                    const f32x4 pa = SA * wnA + SB * wnB;
                    const f32x4 vk_a = kA * vi, vk_b = kB * vi;
                    SA = SA * wA + (kaA * sa + vk_a); SB = SB * wB + (kaB * sa + vk_b);
                    sa = fmaf(sa, cc.x, fmaf(vi, cc.y, half8_sum((pa.x + pa.y) + (pa.z + pa.w))));
                    const f32x4 py = SA * rA + SB * rB;
                    const float y = half8_sum((py.x + py.y) + (py.z + py.w));
                    if (cg8 == 0) yb[ts * 32 + 8 * wave + ri8] = y;
                    wnA = wnA_n; wnB = wnB_n; wA = wA_n; wB = wB_n; kaA = kaA_n; kaB = kaB_n; kA = kA_n; kB = kB_n; rA = rA_n; rB = rB_n; vi = vi_n; cc = cc_n;
                }
            }
            if (has_next) WK_STAGE_WRITE(lds + ((bt + 1) & 1) * WK_BUF_B, tn);
            __syncthreads();
#pragma unroll
            for (int k = 0; k < 2; ++k) { const int idx = tid + 512 * k, ts = idx >> 5, rr = idx & 31;
                if (t0 + ts < TP) YW[(size_t)(r0 + t0 + ts) * D + h * WN + 32 * half + rr] = yb[idx]; }
        }
#undef WK_STAGE_LOAD
#undef WK_STAGE_WRITE
        if (wave < 4) { float* so = p.out + O_WKVP + ((((size_t)jl * BATCH + seq) * WH + h) * WN + 32 * half + 8 * wave + (lane >> 3)) * WN + 8 * (lane & 7);
            *(f32x4*)so = SA; *(f32x4*)(so + 4) = SB; }
    }
    {
        const int gw = blockIdx.x * NWAVES + wave, NGW = gridDim.x * NWAVES;
        for (int it = gw; it < SB * WH * 16; it += NGW) {
            const int rg = it & 15, h = (it >> 4) & 15, s = it >> 8, row = MP + s, i = 4 * rg + ri;
            const int ch = h * WN + 4 * cg;
            WkPar P; P.w0 = *(const f32x4*)(p.in[I_W0] + (size_t)jl * D + ch); P.a0 = *(const f32x4*)(p.in[I_A0] + (size_t)jl * D + ch); P.kkp = *(const f32x4*)(p.in[I_KK] + (size_t)jl * D + ch);
            P.kap = *(const f32x4*)(p.in[I_KA] + (size_t)jl * D + ch); P.v0 = *(const f32x4*)(p.in[I_V0] + ch);
            const size_t vo = (size_t)row * D + ch, lo = (size_t)row * NL2 + ch;
            const f32x4 kraw = ld_bf4(Kr + vo), vraw = ld_bf4(Vr + vo), r4 = ld_bf4(Rr + vo), lw2 = ld_bf4(L2 + lo), la2 = ld_bf4(L2 + lo + 1024);
            f32x4 vf = (f32x4){0.f, 0.f, 0.f, 0.f}, lv2 = vf;
            if (vres) { vf = ld_bf4(VFp + vo); lv2 = ld_bf4(L2 + lo + 3072); }
            f32x4 w4, ka, k4, vp, nk; wk_prep(P, kraw, vraw, lw2, la2, vf, lv2, vres, w4, ka, k4, vp, nk);
            const int srcl = (lane & 48) | rg;
            const float v0_ = shfl_l(vp.x, srcl), v1_ = shfl_l(vp.y, srcl), v2_ = shfl_l(vp.z, srcl), v3_ = shfl_l(vp.w, srcl);
            const float vi = ri == 0 ? v0_ : (ri == 1 ? v1_ : (ri == 2 ? v2_ : v3_));
            const size_t so = ((((size_t)jl * SB + s) * WH + h) * WN + i) * WN + 4 * cg;
            f32x4 S = *(const f32x4*)(p.in[I_SWKV] + so);
            const float sa = row16_sum((S.x * nk.x + S.y * nk.y) + (S.z * nk.z + S.w * nk.w));
            S.x = fmaf(S.x, w4.x, fmaf(sa, ka.x, vi * k4.x)); S.y = fmaf(S.y, w4.y, fmaf(sa, ka.y, vi * k4.y));
            S.z = fmaf(S.z, w4.z, fmaf(sa, ka.z, vi * k4.z)); S.w = fmaf(S.w, w4.w, fmaf(sa, ka.w, vi * k4.w));
            const float y = row16_sum((S.x * r4.x + S.y * r4.y) + (S.z * r4.z + S.w * r4.w));
            *(f32x4*)(p.out + O_WKVS + so) = S;
            if (cg == 0) YW[(size_t)row * D + h * WN + i] = y;
            if (rg == 0 && ri == 0) { st_bf4(KM + vo, k4); st_bf4(VP + vo, vp); }
        }
    }
}

typedef __attribute__((address_space(1))) unsigned gu32;
#define XB_TMO      128
#define XB_XCNT(j)  (256  + 64 * (j))
#define XB_XSUB(j)  (1280 + 64 * (j))
#define XB_XGEN(j)  (2304 + 64 * (j))
#define XB_TOP      3328
#define XB_TOPGEN   3392
#define XCD_BAR_WORDS 3456
#define XB_SPIN_CAP (1u << 18)

__device__ __forceinline__ unsigned xb_ld(unsigned* p)              { return __hip_atomic_load(p, __ATOMIC_RELAXED, __HIP_MEMORY_SCOPE_AGENT); }
__device__ __forceinline__ unsigned xb_add(unsigned* p, unsigned v) { return __hip_atomic_fetch_add(p, v, __ATOMIC_RELAXED, __HIP_MEMORY_SCOPE_AGENT); }
__device__ __forceinline__ unsigned xb_xcc_id() { return (unsigned)__builtin_amdgcn_s_getreg((3 << 11) | 20) & 0xFu; }
#define XB_SPIN(cond, bar) do { unsigned _sp = 0; while (cond) { __builtin_amdgcn_s_sleep(1); \
    if ((++_sp & 255u) == 0u) { if (xb_ld(&(bar)[XB_TMO])) break; if (_sp > XB_SPIN_CAP) { atomicAdd(&(bar)[XB_TMO], 1u); break; } } } } while (0)

struct XcdBarrier {
    bool tid0; unsigned* bar; unsigned x;
    volatile LAS unsigned* st;
};

__device__ __forceinline__ XcdBarrier xcd_barrier_post(unsigned* bar, volatile LAS unsigned* st, bool tid0) {
    XcdBarrier b; b.tid0 = tid0; b.bar = bar; b.x = xb_xcc_id(); b.st = st;
    if (b.tid0) (void)xb_add(&bar[XB_XCNT(b.x)], 1u);
    return b;
}
__device__ __forceinline__ void xcd_barrier_complete(unsigned* bar, unsigned x, unsigned& nloc, unsigned& nx) {
    const unsigned G = gridDim.x * gridDim.y * gridDim.z;
    unsigned sum, cnt, mine, sp = 0u;
    for (;;) {
        sum = 0u; cnt = 0u; mine = 0u;
#pragma unroll
        for (unsigned j = 0; j < 16; ++j) { const unsigned c = xb_ld(&bar[XB_XCNT(j)]); sum += c; cnt += (c > 0u) ? 1u : 0u; mine = (j == x) ? c : mine; }
        if (sum == G) break;
        __builtin_amdgcn_s_sleep(1);
        if ((++sp & 255u) == 0u) { if (xb_ld(&bar[XB_TMO])) break; if (sp > XB_SPIN_CAP) { atomicAdd(&bar[XB_TMO], 1u); break; } }
    }
    nloc = mine > 0u ? mine : 1u; nx = cnt > 0u ? cnt : 1u;
}

__device__ __forceinline__ void xcd_barrier(const XcdBarrier& b) {
    asm volatile("s_waitcnt vmcnt(0)" ::: "memory");
    __syncthreads();
    if (b.tid0) {
        unsigned* bar = b.bar;
        __builtin_amdgcn_s_waitcnt(0);
        unsigned nloc = b.st[0], nx = b.st[1];
        if (nloc == 0u) { xcd_barrier_complete(bar, b.x, nloc, nx); b.st[0] = nloc; b.st[1] = nx; }
        const unsigned old = xb_add(&bar[XB_XSUB(b.x)], 1u);
        const unsigned gen = old / nloc;
        if (old + 1u == (gen + 1u) * nloc) {
            __builtin_amdgcn_fence(__ATOMIC_RELEASE, "agent");
            asm volatile("s_waitcnt vmcnt(0)" ::: "memory");
            const unsigned og = xb_add(&bar[XB_TOP], 1u);
            const unsigned tg = og / nx;
            if (og + 1u == (tg + 1u) * nx) xb_add(&bar[XB_TOPGEN], 1u);
            else XB_SPIN(xb_ld(&bar[XB_TOPGEN]) == tg, bar);
            __builtin_amdgcn_fence(__ATOMIC_ACQUIRE, "agent");
            xb_add(&bar[XB_XGEN(b.x)], 1u);
            asm volatile("s_waitcnt vmcnt(0)" ::: "memory");
        } else {
            XB_SPIN(xb_ld(&bar[XB_XGEN(b.x)]) == gen, bar);
            __builtin_amdgcn_fence(__ATOMIC_ACQUIRE, "agent");
            asm volatile("s_waitcnt vmcnt(0)" ::: "memory");
        }
    }
    __syncthreads();
}

enum { OP_P0 = 0, OP_NORM_RET, OP_G_RETIN, OP_RET, OP_RETNORM, OP_G_RETOUT, OP_NORM_RW, OP_G_RWPROJ, OP_G_LORA2, OP_PREP, OP_WKV, OP_POST, OP_G_WO,
       OP_NORM_FFN, OP_G_UG, OP_CONV, OP_G_WD, OP_FINAL };
struct Ph { unsigned char op, layer; };
constexpr int NPH = 1 + 2 * 6 + 2 * 8 + 1;
__device__ __host__ inline Ph phase_at(int i) {
    if (i == 0) return Ph{OP_P0, 0};
    i -= 1;
    int l;
    if (i < 6) l = 0; else if (i < 14) { l = 1; i -= 6; } else if (i < 20) { l = 2; i -= 14; } else if (i < 28) { l = 3; i -= 20; } else return Ph{OP_FINAL, 0};
    int op = OP_FINAL;
    if ((l & 1) == 0) {
        switch (i) { case 0: op = OP_G_RETIN; break; case 1: op = OP_RET; break; case 2: op = OP_RETNORM; break; case 3: op = OP_G_RETOUT; break;
                     case 4: op = OP_G_UG; break; default: op = OP_G_WD; break; }
    } else {
        switch (i) { case 0: op = OP_NORM_RW; break; case 1: op = OP_G_RWPROJ; break; case 2: op = OP_G_LORA2; break; case 3: op = OP_WKV; break; case 4: op = OP_POST; break; case 5: op = OP_G_WO; break;
                     case 6: op = OP_G_UG; break; default: op = OP_G_WD; break; }
    }
    return Ph{(unsigned char)op, (unsigned char)l};
}

__global__ void __launch_bounds__(NTHR, 2) mega(Params p, int lo, int hi) {
    extern __shared__ __attribute__((aligned(16))) unsigned char lds_raw[];
    LAS unsigned char* lds = (LAS unsigned char*)lds_raw;
    volatile LAS unsigned* bst = (volatile LAS unsigned*)(lds + LDS_BYTES - 16);
    const int wave0 = __builtin_amdgcn_readfirstlane((int)threadIdx.x >> 6);
    if (threadIdx.x < 4) bst[threadIdx.x] = 0u;
    __syncthreads();
    (void)xcd_barrier_post((unsigned*)(p.ws + WS_CTL), bst, threadIdx.x == 0);
    for (int ph = lo; ph < hi; ++ph) {
        int tid = wave0 * 64 + (int)__builtin_amdgcn_mbcnt_hi(~0u, __builtin_amdgcn_mbcnt_lo(~0u, 0u)); asm volatile("" : "+v"(tid));
        const int lane = tid & 63, wave = __builtin_amdgcn_readfirstlane(tid >> 6);
        unsigned char* ws = p.ws;
        const Ph P = phase_at(ph);
        const int li = P.layer, jl = li >> 1;
        const bf16* gA = nullptr; const bf16* gB = nullptr; int gN = 0, gK = 0; EpiAnyT<0> E{}; E.jl = jl; E.ws = ws; E.slot = -1; E.amul = 1.f; E.li = li; E.ldsb = lds; bool is_gemm = false;
        switch (P.op) {
        case OP_P0: ph_p0(p, lds, tid, lane, wave); break;
        case OP_NORM_RET: ph_norm(p, p.in[I_NMIX] + (size_t)li * D, 0, jl, lane, wave); break;
        case OP_NORM_FFN: ph_norm(p, p.in[I_NFFN] + (size_t)li * D, 0, jl, lane, wave); break;
        case OP_NORM_RW: ph_norm(p, p.in[I_NMIX] + (size_t)li * D, 1, jl, lane, wave); break;
        case OP_FINAL: ph_norm(p, p.in[I_NFIN], 2, 0, lane, wave); break;
        case OP_RETNORM: ph_ret_norm(p, jl, lane, wave); break;
        case OP_POST: ph_rwkv_post(p, jl, lane, wave); break;
        case OP_RET: ph_ret_fast(p, jl, lds, tid, lane, wave); break;
        case OP_WKV: ph_wkv_fast(p, jl, lds, tid, lane, wave); break;
        case OP_G_RETIN: is_gemm = true; E.kind = EK_RETIN; E.perm = true; E.slot = 2 * li;
            gA = (const bf16*)(ws + WS_XB); gB = (const bf16*)(ws + WS_WIN + jl * SZ_WIN); gN = RWIN; gK = D; break;
        case OP_G_RETOUT: is_gemm = true; E.kind = EK_RESID; E.perm = false; E.slot = 2 * li + 1;
            gA = (const bf16*)(ws + WS_Y); gB = (const bf16*)(ws + WS_WOUT + jl * SZ_WOUT); gN = D; gK = RV; break;
        case OP_G_RWPROJ: is_gemm = true; E.kind = EK_RWPROJ; E.perm = true;
            gA = (const bf16*)(ws + WS_H); gB = (const bf16*)(ws + WS_WRW + jl * SZ_WRW); gN = NRW; gK = KRW; break;
        case OP_G_LORA2: is_gemm = true; E.kind = EK_F32; E.perm = true;
            gA = (const bf16*)(ws + WS_A2); gB = (const bf16*)(ws + WS_WL2 + jl * SZ_WL2); gN = (jl == 0 ? 3072 : 4096); gK = KL2; break;
        case OP_G_WO: is_gemm = true; E.kind = EK_RESID; E.perm = false; E.slot = 2 * li + 1;
            gA = (const bf16*)(ws + WS_Z); gB = (const bf16*)(ws + WS_WO + jl * SZ_WO); gN = D; gK = D; break;
        case OP_G_UG: is_gemm = true; E.kind = EK_UG; E.perm = true; E.slot = 2 * li + 1;
            gA = (const bf16*)(ws + WS_XB); gB = (const bf16*)(ws + WS_WUG + li * SZ_WUG); gN = 2 * DFF; gK = D; break;
        case OP_G_WD: is_gemm = true; E.kind = EK_RESID; E.perm = false; E.slot = (li == 1) ? 2 * (li + 1) : -1;
            gA = (const bf16*)(ws + WS_ACT); gB = (const bf16*)(ws + WS_WD + li * SZ_WD); gN = D; gK = DFF; break;
        default: break;
        }
        if (is_gemm) {
            const bool ug = E.kind == EK_UG;
            const int gM = (E.kind == EK_RESID) ? MT0 : (ug ? 66 * 256 : M);
            pg8::Gemm g{ug ? gA - 2 * D : gA, gB, gM, gN, gK, ug ? 254 : 256}; pg8::StaticOrder S; S.init(gM, gN, (int)gridDim.x, (int)blockIdx.x);
            if (E.kind == EK_RETIN || E.kind == EK_UG) {
                LAS float* rt = (LAS float*)(lds + 131072);
                Unit uu;
                for (int ui = 0; ui < 8 && S.next(ui, uu); ++ui) if (tid < 256) { int rr = ug ? 254 * uu.pm - 2 + tid : uu.pm * 256 + tid; rr = rr < 0 ? 0 : (rr > M - 1 ? M - 1 : rr); rt[ui * 256 + tid] = row_rstd(ws, E.slot, rr); }
                E.rtab = rt; E.ldsb = lds;
                __syncthreads();
            }
            if (ug) { EpiAnyT<1> E1{}; E1.kind = E.kind; E1.perm = E.perm; E1.jl = E.jl; E1.ws = E.ws; E1.slot = E.slot; E1.rtab = E.rtab; E1.amul = E.amul; E1.li = E.li; E1.ldsb = E.ldsb; E1.pcw = p.in[I_CW]; E1.pcb = p.in[I_CB]; E1.pcst = p.in[I_SCONV]; E1.pout = p.out;
                pg8::gemm_phase<EpiAnyT<1>, pg8::StaticOrder, true, true>(lds, g, S, E1, tid); }
            else pg8::gemm_phase<EpiAnyT<0>, pg8::StaticOrder, true, true>(lds, g, S, E, tid);
            if (E.kind == EK_RESID) tail_resid(gA, gB, gK, ws, E.slot, E.amul, lds, lane, wave);
        }
        if (ph + 1 < hi) { if (ph == 0) cg::this_grid().sync(); else { XcdBarrier bar; bar.tid0 = tid == 0; bar.bar = (unsigned*)(p.ws + WS_CTL); bar.x = xb_xcc_id(); bar.st = (volatile LAS unsigned*)(lds + LDS_BYTES - 16); xcd_barrier(bar); } }
    }
}

}

extern "C" void kernel_launch(void* const* d_in, const int* in_sizes, int n_in, void* d_out, int out_size, void* d_ws, size_t ws_size, hipStream_t stream) {
    static int grid = 0;
    if (grid == 0) {
        int dev = 0, cus = 0;
        if (n_in != N_IN || ws_size < WS_END) { fprintf(stderr, "kernel_launch: unexpected n_in %d / ws_size %zu (need %zu)\n", n_in, ws_size, (size_t)WS_END); grid = -1; return; }
        if (hipGetDevice(&dev) != hipSuccess || hipDeviceGetAttribute(&cus, hipDeviceAttributeMultiprocessorCount, dev) != hipSuccess) { grid = -1; return; }
        if (hipFuncSetAttribute((const void*)mega, hipFuncAttributeMaxDynamicSharedMemorySize, LDS_BYTES) != hipSuccess) { fprintf(stderr, "kernel_launch: hipFuncSetAttribute failed\n"); grid = -1; return; }
        int per_cu = 0;
        if (hipOccupancyMaxActiveBlocksPerMultiprocessor(&per_cu, (const void*)mega, NTHR, LDS_BYTES) != hipSuccess || per_cu < 1) { fprintf(stderr, "kernel_launch: occupancy query says %d\n", per_cu); (void)hipGetLastError(); }
        grid = cus * (per_cu >= 1 ? 1 : 1);
    }
    if (grid < 0) return;
    Params p{};
    for (int i = 0; i < N_IN; ++i) p.in[i] = (const float*)d_in[i];
    p.out = (float*)d_out; p.ws = (unsigned char*)d_ws;
    if (hipMemsetAsync(d_ws, 0, 65536, stream) != hipSuccess) { fprintf(stderr, "kernel_launch: memset failed\n"); return; }
    int lo = 0, hi = NPH;
    void* args[] = {(void*)&p, (void*)&lo, (void*)&hi};
    const hipError_t e = hipLaunchCooperativeKernel((const void*)mega, dim3(grid), dim3(NTHR), args, LDS_BYTES, stream);
    if (e != hipSuccess) fprintf(stderr, "kernel_launch: cooperative launch failed: %s (grid %d)\n", hipGetErrorString(e), grid);
    (void)in_sizes; (void)out_size;
}
```

```cpp
#include <hip/hip_runtime.h>
#include <hip/hip_cooperative_groups.h>
#include <cstdio>
#include <stdint.h>
namespace cg = cooperative_groups;
namespace pg8 {
#define PG8_LAS __attribute__((address_space(3)))
typedef unsigned short bf16_t;
typedef short bf16x8 __attribute__((ext_vector_type(8)));
typedef float f32x4 __attribute__((ext_vector_type(4)));
typedef unsigned u32x4 __attribute__((ext_vector_type(4)));
constexpr int BM = 256, BK = 64, HALF = 128, HTB = HALF * BK * 2  , STAGE_BYTES = 8 * HTB, NXCD = 8, WGM = 8;

__host__ __device__ __forceinline__ int lds_byte(int r, int c) { const int st = (r >> 4) * 2 + (c >> 5), rr = r & 15, cc = c & 31, ob = rr * 64 + cc * 2; return st * 1024 + (ob ^ (((ob >> 9) & 1) << 5)); }
__host__ __device__ __forceinline__ void stage_rc(int b, int& R, int& C) { const int st = b / 1024, sb = b % 1024, swz = sb ^ (((sb >> 9) & 1) << 5); R = (st >> 1) * 16 + swz / 64; C = (st & 1) * 32 + (swz % 64) / 2; }
__host__ __device__ __forceinline__ int perm32(int rho) { const int n = rho >> 4, i = rho & 15; return 8 * (i >> 2) + 4 * n + (i & 3); }

struct Unit { int pm, pn, ord; };
struct Gemm { const bf16_t* A; const bf16_t* Bt; int M, N, K, trows; };

struct StaticOrder {
    int nM, nN, nwg, G, c;
    __host__ __device__ void init(int M, int N, int G_, int c_) { nM = M / BM; nN = N / BM; nwg = nM * nN; G = G_; c = c_; }
    __host__ __device__ __forceinline__ bool next(int i, Unit& u) const {
        const long L = (long)i * G + c; if (L >= nwg) return false;
        int wgid = (int)L; { const int q = nwg / NXCD, r = nwg % NXCD, xcd = wgid % NXCD, off = wgid / NXCD; wgid = (xcd < r ? xcd * (q + 1) : r * (q + 1) + (xcd - r) * q) + off; }
        const int nig = WGM * nN, gid = wgid / nig, fm = gid * WGM, gsz = (nM - fm) < WGM ? (nM - fm) : WGM;
        u.pm = fm + ((wgid % nig) % gsz); u.pn = (wgid % nig) / gsz; u.ord = i; return true;
    }
    __device__ __forceinline__ void a_ready(const Unit&) const {}
    __device__ __forceinline__ void done(const Unit&) const {}
};
template <class Epi, class Sched, bool ALIGN_EPI = false, bool SP2 = false>
__device__ __forceinline__ void gemm_phase(PG8_LAS unsigned char* lds, const Gemm g, const Sched& S, const Epi& E, int tid_in) {
    int tid = tid_in; asm volatile("" : "+v"(tid));
    const int wid = __builtin_amdgcn_readfirstlane(tid >> 6), lane = tid & 63, wr = wid >> 2, wc = wid & 3, fr = lane & 15, fq = lane >> 4;
    const int K = g.K, nt = K / BK;
    unsigned voffA[2], voffB[2];
#pragma unroll
    for (int i = 0; i < 2; ++i) { int R, C; stage_rc(tid * 16 + i * 8192, R, C); const int Rb = E.perm ? ((R & ~31) + perm32(R & 31)) : R;
        voffA[i] = (unsigned)(R * K + C) * 2u; voffB[i] = (unsigned)(Rb * K + C) * 2u; }
    const size_t kstep = (size_t)(BK * 2);
    const size_t hstep = (size_t)HALF * K * 2;
    const size_t tstep = 2 * hstep; const size_t tstepA = (size_t)g.trows * K * 2;
    const unsigned ldsw = (unsigned)wid * 1024u;
    const int aoff = lds_byte(wr * 64 + fr, fq * 8), boff = lds_byte(wc * 32 + fr, fq * 8);
#define PG8_SA(b, h) (((b) * 2 + (h)) * HTB)
#define PG8_SB(b, h) ((4 + (b) * 2 + (h)) * HTB)
#define PG8_STAGE(bufoff, gbase, voff) do { _Pragma("unroll") for (int _i = 0; _i < 2; ++_i) \
        __builtin_amdgcn_global_load_lds((const unsigned*)((const char*)(gbase) + (voff)[_i]), (PG8_LAS unsigned*)(lds + (bufoff) + ldsw + _i * 8192), 16, 0, 0); } while (0)
#define PG8_LDA(dst, b, h) do { _Pragma("unroll") for (int m = 0; m < 4; ++m) _Pragma("unroll") for (int k = 0; k < 2; ++k) dst[m][k] = *(const PG8_LAS bf16x8*)(lds + PG8_SA(b, h) + aoff + m * 2048 + k * 1024); } while (0)
#define PG8_LDB(dst, b, h) do { _Pragma("unroll") for (int n = 0; n < 2; ++n) _Pragma("unroll") for (int k = 0; k < 2; ++k) dst[n][k] = *(const PG8_LAS bf16x8*)(lds + PG8_SB(b, h) + boff + n * 2048 + k * 1024); } while (0)
#define PG8_MMA(ai, bj, At, Bt) do { __builtin_amdgcn_s_setprio(1); _Pragma("unroll") for (int m = 0; m < 4; ++m) _Pragma("unroll") for (int n = 0; n < 2; ++n) _Pragma("unroll") for (int k = 0; k < 2; ++k) \
        acc[ai][bj][m][n] = __builtin_amdgcn_mfma_f32_16x16x32_bf16(Bt[n][k], At[m][k], acc[ai][bj][m][n], 0, 0, 0); __builtin_amdgcn_s_setprio(0); } while (0)
#define PG8_WAIT_V(n) asm volatile("s_waitcnt vmcnt(" #n ")" ::: "memory")
#define PG8_WAIT_L(n) asm volatile("s_waitcnt lgkmcnt(" #n ")" ::: "memory")
#define PG8_BAR __builtin_amdgcn_s_barrier()
#define PG8_SCHED __builtin_amdgcn_sched_barrier(0)
    Unit cur, nxt; int ui = 0;
    if (!S.next(0, cur)) return;
    f32x4 acc[2][2][4][2];
#pragma unroll
    for (int a = 0; a < 2; ++a)
#pragma unroll
        for (int b = 0; b < 2; ++b)
#pragma unroll
            for (int m = 0; m < 4; ++m)
#pragma unroll
                for (int n = 0; n < 2; ++n) acc[a][b][m][n] = (f32x4){0.f, 0.f, 0.f, 0.f};
    bf16x8 At[4][2], B0[2][2], B1[2][2];
    const char* cA = (const char*)g.A + (size_t)cur.pm * tstepA; const char* cB = (const char*)g.Bt + (size_t)cur.pn * tstep;
    S.a_ready(cur);
    if constexpr (SP2) {
        PG8_STAGE(PG8_SB(0, 0), cB, voffB); PG8_STAGE(PG8_SB(0, 1), cB + hstep, voffB); PG8_STAGE(PG8_SA(0, 0), cA, voffA); PG8_STAGE(PG8_SA(0, 1), cA + hstep, voffA);
        if (wr == 1) PG8_BAR;
        PG8_WAIT_V(2); PG8_BAR;
        PG8_STAGE(PG8_SB(1, 0), cB + kstep, voffB); PG8_STAGE(PG8_SA(1, 0), cA + kstep, voffA); PG8_STAGE(PG8_SB(1, 1), cB + hstep + kstep, voffB);
        PG8_WAIT_V(6); PG8_BAR;
    } else {
        PG8_STAGE(PG8_SB(0, 0), cB, voffB); PG8_STAGE(PG8_SA(0, 0), cA, voffA); PG8_STAGE(PG8_SB(0, 1), cB + hstep, voffB); PG8_STAGE(PG8_SA(0, 1), cA + hstep, voffA);
        if (wr == 1) PG8_BAR;
        PG8_WAIT_V(4); PG8_BAR;
        PG8_STAGE(PG8_SB(1, 0), cB + kstep, voffB); PG8_STAGE(PG8_SA(1, 0), cA + kstep, voffA); PG8_STAGE(PG8_SB(1, 1), cB + hstep + kstep, voffB);
        PG8_WAIT_V(6); PG8_BAR;
    }
    for (;;) {
        const bool has_next = S.next(ui + 1, nxt);
        const char* nA = has_next ? (const char*)g.A + (size_t)nxt.pm * tstepA : cA; const char* nB = has_next ? (const char*)g.Bt + (size_t)nxt.pn * tstep : cB;
        for (int t = 0; t < nt; t += 2) {
            const bool last = (t == nt - 2);
            const char* a1 = cA + (size_t)(t + 1) * kstep;
            const char* a2 = last ? nA : cA + (size_t)(t + 2) * kstep; const char* b2 = last ? nB : cB + (size_t)(t + 2) * kstep;
            const char* a3 = a2 + kstep; const char* b3 = b2 + kstep;
            if (last && has_next) S.a_ready(nxt);
            if constexpr (SP2) {
            PG8_LDB(B0, 0, 0); PG8_LDB(B1, 0, 1); PG8_SCHED; PG8_LDA(At, 0, 0); PG8_STAGE(PG8_SA(1, 1), a1 + hstep, voffA);
            PG8_WAIT_V(8); PG8_WAIT_L(0); PG8_BAR; PG8_MMA(0, 0, At, B0); PG8_MMA(0, 1, At, B1); PG8_BAR; PG8_SCHED;
            PG8_LDA(At, 0, 1); PG8_STAGE(PG8_SB(0, 0), b2, voffB); PG8_STAGE(PG8_SB(0, 1), b2 + hstep, voffB); PG8_STAGE(PG8_SA(0, 0), a2, voffA);
            PG8_WAIT_V(8); PG8_WAIT_L(0); PG8_BAR; PG8_MMA(1, 0, At, B0); PG8_MMA(1, 1, At, B1); PG8_BAR; PG8_SCHED;
            PG8_LDB(B0, 1, 0); PG8_LDB(B1, 1, 1); PG8_SCHED; PG8_LDA(At, 1, 0); PG8_STAGE(PG8_SA(0, 1), a2 + hstep, voffA);
            PG8_WAIT_V(8); PG8_WAIT_L(0); PG8_BAR; PG8_MMA(0, 0, At, B0); PG8_MMA(0, 1, At, B1); PG8_BAR; PG8_SCHED;
            PG8_LDA(At, 1, 1); PG8_STAGE(PG8_SB(1, 0), b3, voffB); PG8_STAGE(PG8_SB(1, 1), b3 + hstep, voffB); PG8_STAGE(PG8_SA(1, 0), a3, voffA);
            PG8_WAIT_V(8); PG8_WAIT_L(0); PG8_BAR; PG8_MMA(1, 0, At, B0); PG8_MMA(1, 1, At, B1); PG8_BAR; PG8_SCHED;
            } else {
            PG8_LDB(B0, 0, 0); PG8_SCHED; PG8_LDA(At, 0, 0); PG8_STAGE(PG8_SA(1, 1), a1 + hstep, voffA);
            PG8_WAIT_L(8); PG8_BAR; PG8_WAIT_L(0); PG8_MMA(0, 0, At, B0); PG8_BAR; PG8_SCHED;
            PG8_LDB(B1, 0, 1); PG8_STAGE(PG8_SB(0, 0), b2, voffB);
            PG8_BAR; PG8_WAIT_L(0); PG8_MMA(0, 1, At, B1); PG8_BAR;
            PG8_LDA(At, 0, 1); PG8_STAGE(PG8_SA(0, 0), a2, voffA);
            PG8_BAR; PG8_WAIT_L(0); PG8_MMA(1, 0, At, B0); PG8_BAR; PG8_SCHED;
            PG8_STAGE(PG8_SB(0, 1), b2 + hstep, voffB);
            PG8_WAIT_V(6); PG8_BAR; PG8_MMA(1, 1, At, B1); PG8_BAR;
            PG8_LDB(B0, 1, 0); PG8_SCHED; PG8_LDA(At, 1, 0); PG8_STAGE(PG8_SA(0, 1), a2 + hstep, voffA);
            PG8_WAIT_L(8); PG8_BAR; PG8_WAIT_L(0); PG8_MMA(0, 0, At, B0); PG8_BAR; PG8_SCHED;
            PG8_LDB(B1, 1, 1); PG8_STAGE(PG8_SB(1, 0), b3, voffB);
            PG8_BAR; PG8_WAIT_L(0); PG8_MMA(0, 1, At, B1); PG8_BAR;
            PG8_LDA(At, 1, 1); PG8_STAGE(PG8_SA(1, 0), a3, voffA);
            PG8_BAR; PG8_WAIT_L(0); PG8_MMA(1, 0, At, B0); PG8_BAR; PG8_SCHED;
            PG8_STAGE(PG8_SB(1, 1), b3 + hstep, voffB);
            PG8_WAIT_V(6); PG8_BAR; PG8_MMA(1, 1, At, B1); PG8_BAR;
            }
        }
        if constexpr (ALIGN_EPI) { if (wr == 0) PG8_BAR; }
        if constexpr (!Epi::AFTER_DRAIN) { E(acc, cur, wr, wc, fr, fq); S.done(cur); }
        if (!has_next) break;
#pragma unroll
        for (int a = 0; a < 2; ++a)
#pragma unroll
            for (int b = 0; b < 2; ++b)
#pragma unroll
                for (int m = 0; m < 4; ++m)
#pragma unroll
                    for (int n = 0; n < 2; ++n) acc[a][b][m][n] = (f32x4){0.f, 0.f, 0.f, 0.f};
        cur = nxt; cA = nA; cB = nB; ++ui;
        if constexpr (ALIGN_EPI) { if (wr == 1) PG8_BAR; }
    }
    PG8_WAIT_V(0);
    if constexpr (!ALIGN_EPI) { if (wr == 0) PG8_BAR; }
    PG8_BAR;
    if constexpr (Epi::AFTER_DRAIN) { E.fused(acc, cur, wr, wc, fr, fq, lds, wid, lane); S.done(cur); }
#undef PG8_SA
#undef PG8_SB
#undef PG8_STAGE
#undef PG8_LDA
#undef PG8_LDB
#undef PG8_MMA
#undef PG8_WAIT_V
#undef PG8_WAIT_L
#undef PG8_BAR
#undef PG8_SCHED
}
}

namespace {
constexpr int D = 1024, BATCH = 8, SEQ = 2048, NMETA = 16, TP = SEQ + NMETA, MP = BATCH * TP, SB = 128, M = MP + SB;
constexpr int DEPTH = 4, RH = 4, RDK = 256, RDV = 512, RV = 2048, RWIN = 6144;
constexpr int WH = 16, WN = 64, LW = 64, LA = 64, LV = 32, LG = 160, DFF = 2816;
constexpr int NRW = 3584, KRW = 2048, KL2 = 384, NL2 = 4096;
constexpr float PAST_POS = 16384.f;
constexpr int NWAVES = 8, NTHR = 512;
constexpr int LDS_BYTES = 147456;

constexpr size_t O_YP = 0;
constexpr size_t O_YS = O_YP + (size_t)BATCH * SEQ * D;
constexpr size_t O_RETP = O_YS + (size_t)SB * D;
constexpr size_t O_WKVP = O_RETP + (size_t)2 * BATCH * RH * RDK * RDV;
constexpr size_t O_SHP = O_WKVP + (size_t)2 * BATCH * WH * WN * WN;
constexpr size_t O_CVP = O_SHP + (size_t)2 * BATCH * D;
constexpr size_t O_RETS = O_CVP + (size_t)DEPTH * BATCH * 2 * DFF;
constexpr size_t O_WKVS = O_RETS + (size_t)2 * SB * RH * RDK * RDV;
constexpr size_t O_SHS = O_WKVS + (size_t)2 * SB * WH * WN * WN;
constexpr size_t O_CVS = O_SHS + (size_t)2 * SB * D;

enum { I_XP = 0, I_XS, I_SRET, I_SWKV, I_SSHIFT, I_SCONV, I_META, I_NMIX, I_NFFN, I_NFIN, I_RWIN, I_RGN, I_RWOUT, I_MU, I_WRKV, I_W0, I_W1, I_W2,
       I_A0, I_A1, I_A2, I_V0, I_V1, I_V2, I_G1, I_G2, I_KK, I_KA, I_RK, I_LNW, I_LNB, I_WO, I_WUG, I_CW, I_CB, I_WD, N_IN };

constexpr size_t al256(size_t x) { return (x + 255) & ~(size_t)255; }
constexpr size_t WS_CTL = 0;
constexpr size_t WS_CS = 1u << 20;
constexpr size_t WS_WIN = 4u << 20;
constexpr size_t SZ_WIN = (size_t)RWIN * D * 2;
constexpr size_t WS_WOUT = WS_WIN + 2 * SZ_WIN;
constexpr size_t SZ_WOUT = (size_t)D * RV * 2;
constexpr size_t WS_WRW = WS_WOUT + 2 * SZ_WOUT;
constexpr size_t SZ_WRW = (size_t)NRW * KRW * 2;
constexpr size_t WS_WL2 = WS_WRW + 2 * SZ_WRW;
constexpr size_t SZ_WL2 = (size_t)NL2 * KL2 * 2;
constexpr size_t WS_WO = WS_WL2 + 2 * SZ_WL2;
constexpr size_t SZ_WO = (size_t)D * D * 2;
constexpr size_t WS_WUG = WS_WO + 2 * SZ_WO;
constexpr size_t SZ_WUG = (size_t)2 * DFF * D * 2;
constexpr size_t WS_WD = WS_WUG + 4 * SZ_WUG;
constexpr size_t SZ_WD = (size_t)D * DFF * 2;
constexpr size_t WS_X = al256(WS_WD + 4 * SZ_WD);
constexpr size_t SZ_MD4 = (size_t)M * D * 4;
constexpr size_t WS_H = WS_X + SZ_MD4;
constexpr size_t WS_VF = WS_H + SZ_MD4;
constexpr size_t WS_REG = WS_VF + SZ_MD4;
constexpr size_t WS_QK = WS_REG;
constexpr size_t WS_V = WS_QK + SZ_MD4;
constexpr size_t WS_SG = WS_V + SZ_MD4;
constexpr size_t WS_O = WS_SG + SZ_MD4;
constexpr size_t WS_Y = WS_O + 2 * SZ_MD4;
constexpr size_t WS_R = WS_REG;
constexpr size_t WS_K = WS_R + SZ_MD4;
constexpr size_t WS_VB = WS_K + SZ_MD4;
constexpr size_t WS_WDEC = WS_VB + SZ_MD4;
constexpr size_t WS_NKK = WS_WDEC + SZ_MD4;
constexpr size_t WS_KKA = WS_NKK + SZ_MD4;
constexpr size_t WS_YW = WS_KKA + SZ_MD4;
constexpr size_t WS_L2 = WS_YW + SZ_MD4;
constexpr size_t WS_A2 = WS_L2 + 4 * SZ_MD4;
constexpr size_t WS_Z = al256(WS_A2 + (size_t)M * KL2 * 2);
constexpr size_t WS_RW_END = WS_Z + (size_t)M * D * 2;
constexpr size_t SZ_FF2 = (size_t)M * DFF * 2;
constexpr size_t WS_U = WS_REG;
constexpr size_t WS_G = al256(WS_U + SZ_FF2);
constexpr size_t WS_ACT = al256(WS_G + SZ_FF2);
constexpr size_t WS_XB = al256(WS_RW_END) + 2 * (size_t)D * 2;
constexpr size_t WS_SS = al256(WS_XB + (size_t)(M + 126) * D * 2);
constexpr size_t WS_PTRS = al256(WS_SS + (size_t)8 * M * 16 * 4);
constexpr size_t WS_END = WS_PTRS + 256;

#define LAS __attribute__((address_space(3)))
typedef unsigned short bf16;
typedef unsigned v4u __attribute__((ext_vector_type(4)));
typedef unsigned v2u __attribute__((ext_vector_type(2)));
using pg8::f32x4;
using pg8::Unit;
using pg8::bf16x8;

struct Params { const float* in[N_IN]; float* out; unsigned char* ws; };

__device__ __forceinline__ unsigned cvt_pk_bf16(float lo, float hi) { unsigned r; asm("v_cvt_pk_bf16_f32 %0, %1, %2" : "=v"(r) : "v"(lo), "v"(hi)); return r; }
__device__ __forceinline__ float bf_lo(unsigned w) { return __uint_as_float(w << 16); }
__device__ __forceinline__ float bf_hi(unsigned w) { return __uint_as_float(w & 0xffff0000u); }
__device__ __forceinline__ void unpack8(const v4u w, float (&f)[8]) { f[0] = bf_lo(w.x); f[1] = bf_hi(w.x); f[2] = bf_lo(w.y); f[3] = bf_hi(w.y); f[4] = bf_lo(w.z); f[5] = bf_hi(w.z); f[6] = bf_lo(w.w); f[7] = bf_hi(w.w); }
__device__ __forceinline__ v4u pack8(const float (&f)[8]) { v4u w; w.x = cvt_pk_bf16(f[0], f[1]); w.y = cvt_pk_bf16(f[2], f[3]); w.z = cvt_pk_bf16(f[4], f[5]); w.w = cvt_pk_bf16(f[6], f[7]); return w; }
__device__ __forceinline__ f32x4 ld_bf4(const bf16* q) { const v2u w = *(const v2u*)q; return (f32x4){bf_lo(w.x), bf_hi(w.x), bf_lo(w.y), bf_hi(w.y)}; }
__device__ __forceinline__ void st_bf4(bf16* q, const f32x4 v) { v2u w; w.x = cvt_pk_bf16(v.x, v.y); w.y = cvt_pk_bf16(v.z, v.w); *(v2u*)q = w; }
__device__ __forceinline__ float shfl_xor_l(float v, int m, int lane) { return __int_as_float(__builtin_amdgcn_ds_bpermute((lane ^ m) << 2, __float_as_int(v))); }
__device__ __forceinline__ float shfl_l(float v, int src) { return __int_as_float(__builtin_amdgcn_ds_bpermute(src << 2, __float_as_int(v))); }
__device__ __forceinline__ float wave_sum(float v, int lane) {
#pragma unroll
    for (int o = 1; o < 64; o <<= 1) v += shfl_xor_l(v, o, lane);
    return v;
}
__device__ __forceinline__ float sigmoidf_(float x) { return 1.f / (1.f + __expf(-x)); }
__device__ __forceinline__ float siluf_(float x) { return x / (1.f + __expf(-x)); }
__device__ __forceinline__ float tanhf_(float x) { return 1.f - 2.f / (1.f + __expf(2.f * x)); }

__device__ __forceinline__ float row_rstd(const unsigned char* ws, int slot, int row) {
    const f32x4* q = (const f32x4*)((const float*)(ws + WS_SS) + ((size_t)slot * M + row) * 16);
    const f32x4 a = q[0], b = q[1], c = q[2], d = q[3];
    const float ss = (((a.x + a.y) + (a.z + a.w)) + ((b.x + b.y) + (b.z + b.w))) + (((c.x + c.y) + (c.z + c.w)) + ((d.x + d.y) + (d.z + d.w)));
    return rsqrtf(ss * (1.f / D) + 1e-6f);
}
__device__ __forceinline__ float dpp_ror1(float v) { return __int_as_float(__builtin_amdgcn_update_dpp(0, __float_as_int(v), 0x121, 0xf, 0xf, false)); }
__device__ __forceinline__ float dpp_ror2(float v) { return __int_as_float(__builtin_amdgcn_update_dpp(0, __float_as_int(v), 0x122, 0xf, 0xf, false)); }
enum { EK_RETIN = 0, EK_RESID, EK_UG, EK_RWPROJ, EK_F32 };
template <int GRP> struct EpiExtra {};
template <> struct EpiExtra<1> { const float* pcw; const float* pcb; const float* pcst; float* pout; };
template <int GRP> struct EpiAnyT : EpiExtra<GRP> {
    static constexpr bool AFTER_DRAIN = false;
    int kind; bool perm; int jl; unsigned char* ws; int slot; const LAS float* rtab; float amul; int li; LAS unsigned char* ldsb;
    __device__ __forceinline__ void operator()(const f32x4 (&acc)[2][2][4][2], const Unit& u, int wr, int wc, int fr, int fq) const {
        const int row0 = u.pm * 256 + wr * 64 + fr;
        if (GRP == 0 && kind == EK_RETIN) {
            bf16* QK = (bf16*)(ws + WS_QK); bf16* V = (bf16*)(ws + WS_V); bf16* SG = (bf16*)(ws + WS_SG); const float* CS = (const float*)(ws + WS_CS);
            const int cw = wc * 32 + 8 * fq;
            if (u.pn < 8) {
                const bool isk = u.pn >= 4; const int h = u.pn & 3; const float sc = isk ? 0.0625f : 1.f;
                bf16* base = QK + (isk ? 1024 : 0) + h * 256 + cw;
#pragma unroll
                for (int ai = 0; ai < 2; ++ai) {
                    f32x4 tt[4][4];
#pragma unroll
                    for (int m = 0; m < 4; ++m) { const int row = row0 + ai * 128 + m * 16; const int pi = row < MP ? row % TP : TP;
                        const f32x4* cs = (const f32x4*)(CS + ((size_t)pi * 128 + cw) * 2);
#pragma unroll
                        for (int q4 = 0; q4 < 4; ++q4) tt[m][q4] = cs[q4]; }
#pragma unroll
                    for (int m = 0; m < 4; ++m) {
                        const int row = row0 + ai * 128 + m * 16;
                        const float rs = rtab[u.ord * 256 + (row - u.pm * 256)] * sc;
                        const f32x4 t0 = tt[m][0], t1 = tt[m][1], t2 = tt[m][2], t3 = tt[m][3];
                        const float c[8] = {t0.x, t0.z, t1.x, t1.z, t2.x, t2.z, t3.x, t3.z}, s[8] = {t0.y, t0.w, t1.y, t1.w, t2.y, t2.w, t3.y, t3.w};
                        float o1[8], o2[8];
#pragma unroll
                        for (int n = 0; n < 2; ++n)
#pragma unroll
                            for (int j = 0; j < 4; ++j) {
                                const float x1 = acc[ai][0][m][n][j], x2 = acc[ai][1][m][n][j];
                                o1[n * 4 + j] = (x1 * c[n * 4 + j] - x2 * s[n * 4 + j]) * rs;
                                o2[n * 4 + j] = (x1 * s[n * 4 + j] + x2 * c[n * 4 + j]) * rs;
                            }
                        bf16* rp = base + (size_t)row * 2048;
                        *(v4u*)rp = pack8(o1); *(v4u*)(rp + 128) = pack8(o2);
                    }
                    asm volatile("" ::: "memory");
                }
            } else {
                const bool isg = u.pn >= 16;
                bf16* base = (isg ? SG : V) + ((u.pn - (isg ? 16 : 8)) * 256) + cw;
#pragma unroll
                for (int ai = 0; ai < 2; ++ai)
#pragma unroll
                    for (int m = 0; m < 4; ++m) {
                        bf16* rp = base + (size_t)(row0 + ai * 128 + m * 16) * 2048;
                        const float rs = rtab[u.ord * 256 + (wr * 64 + fr + ai * 128 + m * 16)];
#pragma unroll
                        for (int bj = 0; bj < 2; ++bj) {
                            float o[8];
#pragma unroll
                            for (int n = 0; n < 2; ++n)
#pragma unroll
                                for (int j = 0; j < 4; ++j) { const float x = acc[ai][bj][m][n][j] * rs; o[n * 4 + j] = isg ? siluf_(x) : x; }
                            *(v4u*)(rp + bj * 128) = pack8(o);
                        }
                    }
            }
        } else if (GRP == 0 && kind == EK_RESID) {
            float* X = (float*)(ws + WS_X);
            const int col0 = u.pn * 256 + wc * 32 + 4 * fq;
#pragma unroll
            for (int am = 0; am < 4; ++am) { const int ai = am >> 1, mb = (am & 1) * 2;
                f32x4 xv[2][2][2];
#pragma unroll
                for (int mm = 0; mm < 2; ++mm) { const int m = mb + mm; const float* rp = X + (size_t)(row0 + ai * 128 + m * 16) * D + col0;
#pragma unroll
                    for (int bj = 0; bj < 2; ++bj)
#pragma unroll
                        for (int n = 0; n < 2; ++n) xv[mm][bj][n] = *(const f32x4*)(rp + bj * 128 + n * 16); }
#pragma unroll
                for (int mm = 0; mm < 2; ++mm) { const int m = mb + mm;
                    const int row = row0 + ai * 128 + m * 16;
                    float* rp = X + (size_t)row * D + col0; bf16* xb = (bf16*)(ws + WS_XB) + (size_t)row * D + col0;
                    float ssq = 0.f;
#pragma unroll
                    for (int bj = 0; bj < 2; ++bj)
#pragma unroll
                        for (int n = 0; n < 2; ++n) { const f32x4 v = xv[mm][bj][n] + acc[ai][bj][m][n] * amul; *(f32x4*)(rp + bj * 128 + n * 16) = v;
                            if (slot >= 0) { ssq += (v.x * v.x + v.y * v.y) + (v.z * v.z + v.w * v.w); v2u w; w.x = cvt_pk_bf16(v.x, v.y); w.y = cvt_pk_bf16(v.z, v.w); *(v2u*)(xb + bj * 128 + n * 16) = w; } }
                    if (slot >= 0) { ssq += shfl_xor_l(ssq, 16, fq * 16 + fr); ssq += shfl_xor_l(ssq, 32, fq * 16 + fr); if (fq == 0) ((float*)(ws + WS_SS))[((size_t)slot * M + row) * 16 + u.pn * 4 + wc] = ssq; }
                }
                asm volatile("" ::: "memory");
            }
        } else if (GRP == 1 && kind == EK_UG) {
            const EpiExtra<1>& X1 = *(const EpiExtra<1>*)(const void*)this;
            const float* cw = X1.pcw + (size_t)li * 3 * DFF; const float* cb = X1.pcb + (size_t)li * DFF; const float* cst = X1.pcst + (size_t)li * SB * 2 * DFF;
            float* cvp = X1.pout + O_CVP + (size_t)li * BATCH * 2 * DFF; float* cvs = X1.pout + O_CVS + (size_t)li * SB * 2 * DFF;
            bf16* ACT = (bf16*)(ws + WS_ACT);
            const int fl = wc * 32 + 8 * fq;
            LAS float* halo = (LAS float*)(ldsb + 131072 + 8192);
            const LAS float* rt = rtab + u.ord * 256;
#pragma unroll
            for (int ai = 0; ai < 2; ++ai) if (fr >= 14) {
                const float rs = rt[128 * ai + 64 * wr + 48 + fr];
                LAS float* hp = halo + ((2 * ai + wr) * 2 + (fr - 14)) * 128 + fl;
                *(LAS f32x4*)hp = acc[ai][1][3][0] * rs; *(LAS f32x4*)(hp + 4) = acc[ai][1][3][1] * rs;
            }
            asm volatile("s_waitcnt lgkmcnt(0)" ::: "memory"); __builtin_amdgcn_s_barrier(); asm volatile("" ::: "memory");
#pragma unroll
            for (int n = 0; n < 2; ++n) {
                const int f0 = u.pn * 128 + fl + 4 * n;
                const f32x4 w0 = *(const f32x4*)(cw + f0), w1 = *(const f32x4*)(cw + DFF + f0), w2 = *(const f32x4*)(cw + 2 * DFF + f0), bb = *(const f32x4*)(cb + f0);
                f32x4 prev = (f32x4){0.f, 0.f, 0.f, 0.f};
#pragma unroll
                for (int ai = 0; ai < 2; ++ai)
#pragma unroll
                    for (int m = 0; m < 4; ++m) {
                        const int l = 128 * ai + 64 * wr + 16 * m + fr, row = 254 * u.pm - 2 + l;
                        const float rs = rt[l];
                        const f32x4 cur = acc[ai][1][m][n] * rs, uu = acc[ai][0][m][n] * rs;
                        if (m == 0) {
                            const int B = 2 * ai + wr;
                            prev = (f32x4){0.f, 0.f, 0.f, 0.f};
                            if (B > 0 && fr >= 14) prev = *(const LAS f32x4*)(halo + ((B - 1) * 2 + (fr - 14)) * 128 + fl + 4 * n);
                        }
                        f32x4 g1, g2;
                        {
                            const float c1x = dpp_ror1(cur.x), c1y = dpp_ror1(cur.y), c1z = dpp_ror1(cur.z), c1w = dpp_ror1(cur.w);
                            const float p1x = dpp_ror1(prev.x), p1y = dpp_ror1(prev.y), p1z = dpp_ror1(prev.z), p1w = dpp_ror1(prev.w);
                            const float c2x = dpp_ror2(cur.x), c2y = dpp_ror2(cur.y), c2z = dpp_ror2(cur.z), c2w = dpp_ror2(cur.w);
                            const float p2x = dpp_ror2(prev.x), p2y = dpp_ror2(prev.y), p2z = dpp_ror2(prev.z), p2w = dpp_ror2(prev.w);
                            const bool s1 = fr >= 1, s2 = fr >= 2;
                            g1.x = s1 ? c1x : p1x; g1.y = s1 ? c1y : p1y; g1.z = s1 ? c1z : p1z; g1.w = s1 ? c1w : p1w;
                            g2.x = s2 ? c2x : p2x; g2.y = s2 ? c2y : p2y; g2.z = s2 ? c2z : p2z; g2.w = s2 ? c2w : p2w;
                        }
                        if (l >= 2 && row < M) {
                            if (row < MP) {
                                const int b = row / TP, t = row - b * TP;
                                if (t < 2) { g2 = (f32x4){0.f, 0.f, 0.f, 0.f}; if (t == 0) g1 = g2; }
                                if (t >= TP - 2) *(f32x4*)(cvp + ((size_t)b * 2 + (t - (TP - 2))) * DFF + f0) = cur;
                            } else {
                                const int s = row - MP;
                                const float* c0 = cst + ((size_t)s * 2 + 0) * DFF + f0;
                                g2 = *(const f32x4*)c0; g1 = *(const f32x4*)(c0 + DFF);
                                float* o = cvs + ((size_t)s * 2 + 0) * DFF + f0;
                                *(f32x4*)o = g1; *(f32x4*)(o + DFF) = cur;
                            }
                            const f32x4 cv = bb + w0 * g2 + w1 * g1 + w2 * cur;
                            v2u w; w.x = cvt_pk_bf16(siluf_(cv.x) * uu.x, siluf_(cv.y) * uu.y); w.y = cvt_pk_bf16(siluf_(cv.z) * uu.z, siluf_(cv.w) * uu.w);
                            *(v2u*)(ACT + (size_t)row * DFF + f0) = w;
                        }
                        prev = cur;
                    }
            }
        } else if (GRP == 0 && kind == EK_RWPROJ) {
            const int cw = wc * 32 + 8 * fq;
            if (u.pn < 12) {
                bf16* dst = (bf16*)(ws + (u.pn < 4 ? WS_R : (u.pn < 8 ? WS_K : (jl == 0 ? WS_VF : WS_VB)))) + (u.pn & 3) * 256 + cw;
#pragma unroll
                for (int ai = 0; ai < 2; ++ai)
#pragma unroll
                    for (int m = 0; m < 4; ++m) {
                        bf16* rp = dst + (size_t)(row0 + ai * 128 + m * 16) * D;
#pragma unroll
                        for (int bj = 0; bj < 2; ++bj) { float o[8];
#pragma unroll
                            for (int n = 0; n < 2; ++n)
#pragma unroll
                                for (int j = 0; j < 4; ++j) o[n * 4 + j] = acc[ai][bj][m][n][j];
                            *(v4u*)(rp + bj * 128) = pack8(o); }
                    }
            } else {
                bf16* A2 = (bf16*)(ws + WS_A2);
#pragma unroll
                for (int bj = 0; bj < 2; ++bj) {
                    const int c = (u.pn - 12) * 256 + bj * 128 + cw;
                    if (c < KL2) {
                        const int kd = c < 64 ? 1 : ((c >= 128 && c < 288) ? 2 : 0);
#pragma unroll
                        for (int ai = 0; ai < 2; ++ai)
#pragma unroll
                            for (int m = 0; m < 4; ++m) { float o[8];
#pragma unroll
                                for (int n = 0; n < 2; ++n)
#pragma unroll
                                    for (int j = 0; j < 4; ++j) { const float x = acc[ai][bj][m][n][j]; o[n * 4 + j] = kd == 1 ? tanhf_(x) : (kd == 2 ? sigmoidf_(x) : x); }
                                *(v4u*)(A2 + (size_t)(row0 + ai * 128 + m * 16) * KL2 + c) = pack8(o); }
                    }
                }
            }
        } else if (GRP == 0) {
            bf16* C = (bf16*)(ws + WS_L2);
            const int col0 = u.pn * 256 + wc * 32 + 8 * fq;
#pragma unroll
            for (int ai = 0; ai < 2; ++ai)
#pragma unroll
                for (int m = 0; m < 4; ++m) {
                    bf16* rp = C + (size_t)(row0 + ai * 128 + m * 16) * NL2 + col0;
#pragma unroll
                    for (int bj = 0; bj < 2; ++bj) { float o[8];
#pragma unroll
                        for (int n = 0; n < 2; ++n)
#pragma unroll
                            for (int j = 0; j < 4; ++j) o[n * 4 + j] = acc[ai][bj][m][n][j];
                        *(v4u*)(rp + bj * 128) = pack8(o); }
                }
        }
    }
};

constexpr int MT0 = 16384;
__device__ __forceinline__ void tail_resid(const bf16* __restrict__ A, const bf16* __restrict__ Bt, int K, unsigned char* ws, int slot, float amul, LAS unsigned char* lds, int lane, int wave) {
    const int fr = lane & 15, fq = lane >> 4;
    float* X = (float*)(ws + WS_X);
    const int kw = K >> 3;
    for (int job = blockIdx.x; job < 16 * 16; job += gridDim.x) {
        const int rs = job >> 4, cs = job & 15;
        const bf16* ap = A + (size_t)(MT0 + 16 * rs + fr) * K + wave * kw + 8 * fq;
        const bf16* bp = Bt + (size_t)(64 * cs + fr) * K + wave * kw + 8 * fq;
        f32x4 acc[4];
#pragma unroll
        for (int t = 0; t < 4; ++t) acc[t] = (f32x4){0.f, 0.f, 0.f, 0.f};
#pragma unroll 4
        for (int k0 = 0; k0 < kw; k0 += 32) {
            const bf16x8 af = *(const bf16x8*)(ap + k0);
#pragma unroll
            for (int t = 0; t < 4; ++t) { const bf16x8 bf = *(const bf16x8*)(bp + (size_t)(16 * t) * K + k0); acc[t] = __builtin_amdgcn_mfma_f32_16x16x32_bf16(bf, af, acc[t], 0, 0, 0); }
        }
        __syncthreads();
#pragma unroll
        for (int t = 0; t < 4; ++t) *(LAS f32x4*)(lds + ((wave * 4 + t) * 64 + lane) * 16) = acc[t];
        __syncthreads();
        if (wave == 0) {
#pragma unroll
            for (int t = 0; t < 4; ++t) { f32x4 s = acc[t];
#pragma unroll
                for (int w = 1; w < 8; ++w) s += *(LAS f32x4*)(lds + ((w * 4 + t) * 64 + lane) * 16);
                acc[t] = s; }
            const int row = MT0 + 16 * rs + fr;
            float* rp = X + (size_t)row * D + 64 * cs + 4 * fq; bf16* xb = (bf16*)(ws + WS_XB) + (size_t)row * D + 64 * cs + 4 * fq;
            float ssq = 0.f;
#pragma unroll
            for (int t = 0; t < 4; ++t) { const f32x4 v = *(const f32x4*)(rp + 16 * t) + acc[t] * amul; *(f32x4*)(rp + 16 * t) = v;
                if (slot >= 0) { ssq += (v.x * v.x + v.y * v.y) + (v.z * v.z + v.w * v.w); v2u w; w.x = cvt_pk_bf16(v.x, v.y); w.y = cvt_pk_bf16(v.z, v.w); *(v2u*)(xb + 16 * t) = w; } }
            if (slot >= 0) { ssq += shfl_xor_l(ssq, 16, lane); ssq += shfl_xor_l(ssq, 32, lane); if (fq == 0) ((float*)(ws + WS_SS))[((size_t)slot * M + row) * 16 + cs] = ssq; }
        }
    }
}

__device__ __forceinline__ void tr_item(const float* __restrict__ W, int ldw, int k0, int n0, bf16* __restrict__ WT, int ldt, int drow, const float* __restrict__ mu, LAS float* scr, int lane, const float* __restrict__ gs = nullptr) {
#pragma unroll 8
    for (int i = 0; i < 32; ++i) { const int kk = 2 * i + (lane >> 5); scr[kk * 33 + (lane & 31)] = W[(size_t)(k0 + kk) * ldw + n0 + (lane & 31)]; }
    asm volatile("s_waitcnt lgkmcnt(0)" ::: "memory");
    const int c = lane & 7;
    float mv[8];
    if (mu) {
#pragma unroll
        for (int e = 0; e < 8; ++e) mv[e] = mu[k0 + 8 * c + e];
    } else if (gs) {
#pragma unroll
        for (int e = 0; e < 8; ++e) mv[e] = gs[k0 + 8 * c + e];
    }
#pragma unroll
    for (int j = 0; j < 4; ++j) {
        const int n = (lane >> 3) + 8 * j; const LAS float* s = scr + (8 * c) * 33 + n;
        float f[8];
#pragma unroll
        for (int e = 0; e < 8; ++e) f[e] = s[e * 33];
        bf16* dp = WT + (size_t)(drow + n) * ldt + k0 + 8 * c;
        if (mu) {
            float f1[8], f2[8];
#pragma unroll
            for (int e = 0; e < 8; ++e) { f1[e] = f[e] * (1.f - mv[e]); f2[e] = f[e] * mv[e]; }
            *(v4u*)dp = pack8(f1); *(v4u*)(dp + 1024) = pack8(f2);
        } else { if (gs) {
#pragma unroll
            for (int e = 0; e < 8; ++e) f[e] *= mv[e]; }
            *(v4u*)dp = pack8(f); }
    }
    asm volatile("s_waitcnt lgkmcnt(0)" ::: "memory");
}

__device__ __forceinline__ void ph_p0(const Params& p, LAS unsigned char* lds, int tid, int lane, int wave) {
    unsigned char* ws = p.ws;
    LAS float* scr = (LAS float*)(lds + wave * 16384);
    const int gw = blockIdx.x * NWAVES + wave, NGW = gridDim.x * NWAVES;
    constexpr int C_WIN = 2 * 16 * 192, C_WOUT = 2 * 32 * 32, C_RKV = 2 * 3 * 512, C_W1 = 2 * 32, C_A1 = 2 * 32, C_G1 = 2 * 80, C_V1 = 16, C_WO = 2 * 512, C_WUG = 4 * 16 * 176, C_WD = 4 * 44 * 32;
    constexpr int NITEMS = C_WIN + C_WOUT + C_RKV + C_W1 + C_A1 + C_G1 + C_V1 + C_WO + C_WUG + C_WD;
    for (int it = gw; it < NITEMS; it += NGW) {
        int r = it;
        if (r < C_WIN) { const int j = r / 3072, q = r % 3072, kb = q / 192, nb = q % 192;
            tr_item(p.in[I_RWIN] + (size_t)j * D * RWIN, RWIN, 64 * kb, 32 * nb, (bf16*)(ws + WS_WIN + j * SZ_WIN), D, 32 * nb, nullptr, scr, lane, p.in[I_NMIX] + (size_t)(2 * j) * D); continue; }
        r -= C_WIN;
        if (r < C_WOUT) { const int j = r / 1024, q = r % 1024, kb = q / 32, nb = q % 32;
            tr_item(p.in[I_RWOUT] + (size_t)j * RV * D, D, 64 * kb, 32 * nb, (bf16*)(ws + WS_WOUT + j * SZ_WOUT), RV, 32 * nb, nullptr, scr, lane); continue; }
        r -= C_WOUT;
        if (r < C_RKV) { const int j = r / 1536, q = r % 1536, s = q / 512, q2 = q % 512, kb = q2 / 32, nb = q2 % 32, c = (s == 0 ? 0 : (s == 1 ? 2 : 3));
            tr_item(p.in[I_WRKV] + (size_t)(j * 3 + s) * D * D, D, 64 * kb, 32 * nb, (bf16*)(ws + WS_WRW + j * SZ_WRW), KRW, s * 1024 + 32 * nb, p.in[I_MU] + (size_t)(j * 6 + c) * D, scr, lane); continue; }
        r -= C_RKV;
        if (r < C_W1) { const int j = r / 32, q = r % 32, kb = q / 2, nb = q % 2;
            tr_item(p.in[I_W1] + (size_t)j * D * LW, LW, 64 * kb, 32 * nb, (bf16*)(ws + WS_WRW + j * SZ_WRW), KRW, 3072 + 32 * nb, p.in[I_MU] + (size_t)(j * 6 + 1) * D, scr, lane); continue; }
        r -= C_W1;
        if (r < C_A1) { const int j = r / 32, q = r % 32, kb = q / 2, nb = q % 2;
            tr_item(p.in[I_A1] + (size_t)j * D * LA, LA, 64 * kb, 32 * nb, (bf16*)(ws + WS_WRW + j * SZ_WRW), KRW, 3136 + 32 * nb, p.in[I_MU] + (size_t)(j * 6 + 4) * D, scr, lane); continue; }
        r -= C_A1;
        if (r < C_G1) { const int j = r / 80, q = r % 80, kb = q / 5, nb = q % 5;
            tr_item(p.in[I_G1] + (size_t)j * D * LG, LG, 64 * kb, 32 * nb, (bf16*)(ws + WS_WRW + j * SZ_WRW), KRW, 3200 + 32 * nb, p.in[I_MU] + (size_t)(j * 6 + 5) * D, scr, lane); continue; }
        r -= C_G1;
        if (r < C_V1) { const int kb = r;
            tr_item(p.in[I_V1], LV, 64 * kb, 0, (bf16*)(ws + WS_WRW + 1 * SZ_WRW), KRW, 3360, p.in[I_MU] + (size_t)(1 * 6 + 3) * D, scr, lane); continue; }
        r -= C_V1;
        if (r < C_WO) { const int j = r / 512, q = r % 512, kb = q / 32, nb = q % 32;
            tr_item(p.in[I_WO] + (size_t)j * D * D, D, 64 * kb, 32 * nb, (bf16*)(ws + WS_WO + j * SZ_WO), D, 32 * nb, nullptr, scr, lane); continue; }
        r -= C_WO;
        if (r < C_WUG) { const int i = r / 2816, q = r % 2816, kb = q / 176, nb = q % 176, n0 = 32 * nb;
            const int drow = n0 < DFF ? 256 * (n0 / 128) + (n0 % 128) : 256 * ((n0 - DFF) / 128) + 128 + ((n0 - DFF) % 128);
            tr_item(p.in[I_WUG] + (size_t)i * D * 2 * DFF, 2 * DFF, 64 * kb, n0, (bf16*)(ws + WS_WUG + i * SZ_WUG), D, drow, nullptr, scr, lane, p.in[I_NFFN] + (size_t)i * D); continue; }
        r -= C_WUG;
        { const int i = r / 1408, q = r % 1408, kb = q / 32, nb = q % 32;
            tr_item(p.in[I_WD] + (size_t)i * DFF * D, D, 64 * kb, 32 * nb, (bf16*)(ws + WS_WD + i * SZ_WD), DFF, 32 * nb, nullptr, scr, lane); }
    }
    const size_t gt = (size_t)blockIdx.x * NTHR + tid, GT = (size_t)gridDim.x * NTHR;
    for (size_t i = gt; i < (size_t)(224 + 192) * (KRW / 8); i += GT) {
        const int rr = (int)(i / (KRW / 8)), c8 = (int)(i % (KRW / 8));
        const int j = rr < 224 ? 0 : 1, row = rr < 224 ? 3360 + rr : 3392 + (rr - 224);
        *(v4u*)((bf16*)(ws + WS_WRW + j * SZ_WRW) + (size_t)row * KRW + c8 * 8) = (v4u){0u, 0u, 0u, 0u};
    }
    for (size_t i = gt; i < (size_t)2 * NL2 * KL2; i += GT) {
        const int j = (int)(i / ((size_t)NL2 * KL2)); const int rem = (int)(i % ((size_t)NL2 * KL2)); const int n = rem / KL2, k = rem % KL2, grp = n >> 10, nn = n & 1023;
        float v = 0.f;
        if (grp == 0) { if (k < 64) v = p.in[I_W2][((size_t)j * LW + k) * D + nn]; }
        else if (grp == 1) { if (k >= 64 && k < 128) v = p.in[I_A2][((size_t)j * LA + (k - 64)) * D + nn]; }
        else if (grp == 2) { if (k >= 128 && k < 288) v = p.in[I_G2][((size_t)j * LG + (k - 128)) * D + nn]; }
        else { if (j == 1 && k >= 288 && k < 320) v = p.in[I_V2][((size_t)(k - 288)) * D + nn]; }
        ((bf16*)(ws + WS_WL2 + j * SZ_WL2))[(size_t)n * KL2 + k] = (bf16)(cvt_pk_bf16(v, 0.f) & 0xffffu);
    }
    for (size_t i = gt; i < (size_t)(TP + 1) * 128; i += GT) {
        const int pi = (int)(i >> 7), mi = (int)(i & 127);
        const float pos = pi < TP ? (float)pi : PAST_POS;
        const float inv = 1.0f / powf(10000.0f, (float)mi / 127.0f);
        float s, c; sincosf(pos * inv, &s, &c);
        ((float2*)(ws + WS_CS))[i] = make_float2(c, s);
    }
    float* X = (float*)(ws + WS_X); bf16* XB = (bf16*)(ws + WS_XB);
    for (int r = gw; r < M; r += NGW) {
        const float* src;
        if (r < MP) { const int b = r / TP, t = r % TP; src = t < NMETA ? p.in[I_META] + (size_t)t * D : p.in[I_XP] + ((size_t)b * SEQ + (t - NMETA)) * D; }
        else src = p.in[I_XS] + (size_t)(r - MP) * D;
        float ss = 0.f;
#pragma unroll
        for (int j = 0; j < 2; ++j) { const int c0 = 512 * j + 8 * lane;
            const f32x4 a4 = *(const f32x4*)(src + c0), b4 = *(const f32x4*)(src + c0 + 4);
            *(f32x4*)(X + (size_t)r * D + c0) = a4; *(f32x4*)(X + (size_t)r * D + c0 + 4) = b4;
            const float f[8] = {a4.x, a4.y, a4.z, a4.w, b4.x, b4.y, b4.z, b4.w};
#pragma unroll
            for (int e = 0; e < 8; ++e) ss += f[e] * f[e];
            *(v4u*)(XB + (size_t)r * D + c0) = pack8(f); }
        ss = wave_sum(ss, lane);
        if (lane < 16) ((float*)(ws + WS_SS))[(size_t)r * 16 + lane] = lane == 0 ? ss : 0.f;
    }
}

__device__ __forceinline__ void ph_norm(const Params& p, const float* __restrict__ g, int mode, int jl, int lane, int wave) {
    const float* X = (const float*)(p.ws + WS_X); bf16* H = (bf16*)(p.ws + WS_H);
    const int gw = blockIdx.x * NWAVES + wave, NGW = gridDim.x * NWAVES;
    for (int row = gw; row < M; row += NGW) {
        const float* xr = X + (size_t)row * D;
        float v[2][8]; float ss = 0.f;
#pragma unroll
        for (int j = 0; j < 2; ++j) {
            const f32x4 a = *(const f32x4*)(xr + 512 * j + 8 * lane), b = *(const f32x4*)(xr + 512 * j + 8 * lane + 4);
            v[j][0] = a.x; v[j][1] = a.y; v[j][2] = a.z; v[j][3] = a.w; v[j][4] = b.x; v[j][5] = b.y; v[j][6] = b.z; v[j][7] = b.w;
#pragma unroll
            for (int e = 0; e < 8; ++e) ss += v[j][e] * v[j][e];
        }
        ss = wave_sum(ss, lane);
        const float rstd = rsqrtf(ss * (1.f / D) + 1e-6f);
        const bool prompt = row < MP; const int b = prompt ? row / TP : 0, t = prompt ? row % TP : 0;
#pragma unroll
        for (int j = 0; j < 2; ++j) {
            const int c0 = 512 * j + 8 * lane;
            const f32x4 ga = *(const f32x4*)(g + c0), gb = *(const f32x4*)(g + c0 + 4);
            float o[8];
            o[0] = v[j][0] * rstd * ga.x; o[1] = v[j][1] * rstd * ga.y; o[2] = v[j][2] * rstd * ga.z; o[3] = v[j][3] * rstd * ga.w;
            o[4] = v[j][4] * rstd * gb.x; o[5] = v[j][5] * rstd * gb.y; o[6] = v[j][6] * rstd * gb.z; o[7] = v[j][7] * rstd * gb.w;
            if (mode == 0) { *(v4u*)(H + (size_t)row * D + c0) = pack8(o); }
            else if (mode == 1) {
                const v4u w = pack8(o);
                *(v4u*)(H + (size_t)row * 2048 + c0) = w;
                if (prompt) {
                    if (t != TP - 1) *(v4u*)(H + (size_t)(row + 1) * 2048 + 1024 + c0) = w;
                    else { float* so = p.out + O_SHP + ((size_t)jl * BATCH + b) * D + c0; *(f32x4*)so = (f32x4){o[0], o[1], o[2], o[3]}; *(f32x4*)(so + 4) = (f32x4){o[4], o[5], o[6], o[7]}; }
                    if (t == 0) *(v4u*)(H + (size_t)row * 2048 + 1024 + c0) = (v4u){0u, 0u, 0u, 0u};
                } else {
                    const int s = row - MP;
                    const float* sp = p.in[I_SSHIFT] + ((size_t)jl * SB + s) * D + c0;
                    const f32x4 sa = *(const f32x4*)sp, sb2 = *(const f32x4*)(sp + 4);
                    const float pv[8] = {sa.x, sa.y, sa.z, sa.w, sb2.x, sb2.y, sb2.z, sb2.w};
                    *(v4u*)(H + (size_t)row * 2048 + 1024 + c0) = pack8(pv);
                    float* so = p.out + O_SHS + ((size_t)jl * SB + s) * D + c0; *(f32x4*)so = (f32x4){o[0], o[1], o[2], o[3]}; *(f32x4*)(so + 4) = (f32x4){o[4], o[5], o[6], o[7]};
                }
            } else {
                float* dst = nullptr;
                if (prompt) { if (t >= NMETA) dst = p.out + O_YP + ((size_t)b * SEQ + (t - NMETA)) * D + c0; }
                else dst = p.out + O_YS + (size_t)(row - MP) * D + c0;
                if (dst) { *(f32x4*)dst = (f32x4){o[0], o[1], o[2], o[3]}; *(f32x4*)(dst + 4) = (f32x4){o[4], o[5], o[6], o[7]}; }
            }
        }
    }
}

__device__ __forceinline__ void ph_ret_norm(const Params& p, int jl, int lane, int wave) {
    const float* O = (const float*)(p.ws + WS_O); const bf16* SG = (const bf16*)(p.ws + WS_SG); bf16* Y = (bf16*)(p.ws + WS_Y);
    const float* gnw = p.in[I_RGN] + (size_t)jl * RV;
    const int gw = blockIdx.x * NWAVES + wave, NGW = gridDim.x * NWAVES;
    for (int it = gw; it < M * RH; it += NGW) {
        const int row = it >> 2, h = it & 3; const size_t off = (size_t)row * RV + h * RDV + 8 * lane;
        const f32x4 a = *(const f32x4*)(O + off), b = *(const f32x4*)(O + off + 4);
        float v[8] = {a.x, a.y, a.z, a.w, b.x, b.y, b.z, b.w};
        float s = 0.f;
#pragma unroll
        for (int e = 0; e < 8; ++e) s += v[e];
        const float mean = wave_sum(s, lane) * (1.f / RDV);
        float s2 = 0.f;
#pragma unroll
        for (int e = 0; e < 8; ++e) { v[e] -= mean; s2 += v[e] * v[e]; }
        const float rstd = rsqrtf(wave_sum(s2, lane) * (1.f / RDV) + 1e-5f);
        float sg[8]; unpack8(*(const v4u*)(SG + off), sg);
        const f32x4 ga = *(const f32x4*)(gnw + h * RDV + 8 * lane), gb = *(const f32x4*)(gnw + h * RDV + 8 * lane + 4);
        const float gg[8] = {ga.x, ga.y, ga.z, ga.w, gb.x, gb.y, gb.z, gb.w};
        float o[8];
#pragma unroll
        for (int e = 0; e < 8; ++e) o[e] = v[e] * rstd * gg[e] * sg[e];
        *(v4u*)(Y + off) = pack8(o);
    }
}

__device__ __forceinline__ float row16_sum(float x);
__device__ __forceinline__ void ph_rwkv_post(const Params& p, int jl, int lane, int wave) {
    const float* YW = (const float*)(p.ws + WS_YW); const bf16* R = (const bf16*)(p.ws + WS_R); const bf16* KM = (const bf16*)(p.ws + WS_NKK);
    const bf16* VP = (const bf16*)(p.ws + WS_KKA); const bf16* L2 = (const bf16*)(p.ws + WS_L2); bf16* Z = (bf16*)(p.ws + WS_Z);
    const float* rk = p.in[I_RK] + (size_t)jl * D; const float* lnw = p.in[I_LNW] + (size_t)jl * D; const float* lnb = p.in[I_LNB] + (size_t)jl * D;
    const int gw = blockIdx.x * NWAVES + wave, NGW = gridDim.x * NWAVES;
    const int sub = lane >> 4, c4 = lane & 15;
    for (int it0 = gw * 4; it0 < M * WH; it0 += NGW * 4) {
        const int it = it0 + sub, row = it >> 4, h = it & 15, c = h * WN + 4 * c4;
        const size_t idx = (size_t)row * D + c;
        const f32x4 yv = *(const f32x4*)(YW + idx), r4 = ld_bf4(R + idx), k4 = ld_bf4(KM + idx), v4 = ld_bf4(VP + idx), g4 = ld_bf4(L2 + (size_t)row * NL2 + 2048 + c);
        const f32x4 rk4 = *(const f32x4*)(rk + c), lw4 = *(const f32x4*)(lnw + c), lb4 = *(const f32x4*)(lnb + c);
        const float mean = row16_sum((yv.x + yv.y) + (yv.z + yv.w)) * (1.f / WN);
        const f32x4 yc = yv - mean;
        const float rstd = rsqrtf(row16_sum((yc.x * yc.x + yc.y * yc.y) + (yc.z * yc.z + yc.w * yc.w)) * (1.f / WN) + 64e-5f);
        const f32x4 rkk = r4 * k4 * rk4;
        const float bon = row16_sum((rkk.x + rkk.y) + (rkk.z + rkk.w));
        const f32x4 z = (yc * rstd * lw4 + lb4 + v4 * bon) * g4;
        st_bf4(Z + idx, z);
    }
}

constexpr int RT_KP = 528, RT_VP = 144, RT_SP = 528;
constexpr int RT_K_OFF = 0, RT_V_OFF = 128 * RT_KP, RT_ST_OFF = RT_V_OFF + 128 * RT_VP, RT_END = RT_ST_OFF + 64 * RT_SP;
static_assert(RT_END <= LDS_BYTES, "retention LDS map");
typedef short v4s __attribute__((ext_vector_type(4)));
__device__ __forceinline__ bf16x8 tr_pair(LAS unsigned char* a0, LAS unsigned char* a1) {
    const v4s lo = __builtin_amdgcn_ds_read_tr16_b64_v4i16((LAS v4s*)a0), hi = __builtin_amdgcn_ds_read_tr16_b64_v4i16((LAS v4s*)a1);
    return __builtin_shufflevector(lo, hi, 0, 1, 2, 3, 4, 5, 6, 7);
}
__device__ __forceinline__ void ph_ret_fast(const Params& p, int jl, LAS unsigned char* lds, int tid, int lane, int wave) {
    const bf16* QK = (const bf16*)(p.ws + WS_QK); const bf16* V = (const bf16*)(p.ws + WS_V); float* O = (float*)(p.ws + WS_O);
    const int fr = lane & 15, fq = lane >> 4, li_q = (lane & 15) >> 2, li_p = lane & 3;
    for (int u = blockIdx.x; u < BATCH * RH * 8; u += gridDim.x) {
        const int es = u & 7, h = (u >> 3) & 3, b = u >> 5;
        const float gamma = 1.0f - exp2f(-5.0f - (float)h), lg = log2f(gamma), g128 = exp2f(128.f * lg), g127 = exp2f(127.f * lg);
        const int i0 = 16 * wave, d0 = 32 * wave;
        f32x4 Sacc[2][4];
#pragma unroll
        for (int a = 0; a < 2; ++a)
#pragma unroll
            for (int c = 0; c < 4; ++c) Sacc[a][c] = (f32x4){0.f, 0.f, 0.f, 0.f};
        __syncthreads();
        for (int i = tid; i < 64 * RT_SP / 16; i += NTHR) *(LAS v4u*)(lds + RT_ST_OFF + i * 16) = (v4u){0u, 0u, 0u, 0u};
        v4u kst[8], vst[2];
        const bf16* Kg = QK + 1024 + 256 * h; const bf16* Vg = V + 512 * h + 64 * es; const bf16* Qg = QK + 256 * h;
#define RT_LOAD_STAGE(cc) do { \
            _Pragma("unroll") for (int k_ = 0; k_ < 8; ++k_) { const int id_ = tid + 512 * k_, row_ = id_ >> 5, ch_ = id_ & 31, t_ = 128 * (cc) - 112 + row_; \
                kst[k_] = t_ >= 0 ? *(const v4u*)(Kg + (size_t)(b * TP + t_) * 2048 + 8 * ch_) : (v4u){0u, 0u, 0u, 0u}; } \
            _Pragma("unroll") for (int k_ = 0; k_ < 2; ++k_) { const int id_ = tid + 512 * k_, row_ = id_ >> 3, ch_ = id_ & 7, t_ = 128 * (cc) - 112 + row_; \
                vst[k_] = t_ >= 0 ? *(const v4u*)(Vg + (size_t)(b * TP + t_) * 2048 + 8 * ch_) : (v4u){0u, 0u, 0u, 0u}; } } while (0)
        RT_LOAD_STAGE(0);
        for (int c = 0; c < 17; ++c) {
            __syncthreads();
#pragma unroll
            for (int k_ = 0; k_ < 8; ++k_) { const int id_ = tid + 512 * k_, row_ = id_ >> 5, ch_ = id_ & 31; *(LAS v4u*)(lds + RT_K_OFF + row_ * RT_KP + ch_ * 16) = kst[k_]; }
#pragma unroll
            for (int k_ = 0; k_ < 2; ++k_) { const int id_ = tid + 512 * k_, row_ = id_ >> 3, ch_ = id_ & 7;
                float f[8]; unpack8(vst[k_], f); const float sc = exp2f(-(float)row_ * lg);
#pragma unroll
                for (int e = 0; e < 8; ++e) f[e] *= sc;
                *(LAS v4u*)(lds + RT_V_OFF + row_ * RT_VP + ch_ * 16) = pack8(f); }
            bf16x8 Qf[8];
            { const int t_ = 128 * c - 112 + i0 + fr;
#pragma unroll
              for (int s = 0; s < 8; ++s) Qf[s] = t_ >= 0 ? *(const bf16x8*)(Qg + (size_t)(b * TP + t_) * 2048 + 32 * s + 8 * fq) : (bf16x8){0, 0, 0, 0, 0, 0, 0, 0}; }
            __syncthreads();
            bf16x8 Pf[4];
            { const int ii = i0 + fr; const float gi = exp2f((float)ii * lg);
#pragma unroll
              for (int s2 = 0; s2 < 4; ++s2) { f32x4 Dp[2];
#pragma unroll
                  for (int hh = 0; hh < 2; ++hh) { Dp[hh] = (f32x4){0.f, 0.f, 0.f, 0.f};
#pragma unroll
                      for (int s = 0; s < 8; ++s) { const bf16x8 Kf = *(const LAS bf16x8*)(lds + RT_K_OFF + (16 * (2 * s2 + hh) + fr) * RT_KP + (32 * s + 8 * fq) * 2);
                          Dp[hh] = __builtin_amdgcn_mfma_f32_16x16x32_bf16(Kf, Qf[s], Dp[hh], 0, 0, 0); } }
                  float f[8];
#pragma unroll
                  for (int hh = 0; hh < 2; ++hh)
#pragma unroll
                      for (int r = 0; r < 4; ++r) { const int jj = 16 * (2 * s2 + hh) + 4 * fq + r; f[hh * 4 + r] = ii >= jj ? Dp[hh][r] * gi : 0.f; }
                  const v4u w = pack8(f); Pf[s2] = __builtin_bit_cast(bf16x8, w); } }
            f32x4 Oacc[4];
#pragma unroll
            for (int et = 0; et < 4; ++et) { Oacc[et] = (f32x4){0.f, 0.f, 0.f, 0.f};
#pragma unroll
                for (int s = 0; s < 8; ++s) { const bf16x8 Sf = *(const LAS bf16x8*)(lds + RT_ST_OFF + (16 * et + fr) * RT_SP + (32 * s + 8 * fq) * 2);
                    Oacc[et] = __builtin_amdgcn_mfma_f32_16x16x32_bf16(Qf[s], Sf, Oacc[et], 0, 0, 0); } }
            __syncthreads();
            if (c + 1 < 17) RT_LOAD_STAGE(c + 1);
#pragma unroll
            for (int r = 0; r < 4; ++r) { const float lam = exp2f((float)(i0 + 4 * fq + r + 1) * lg);
#pragma unroll
                for (int et = 0; et < 4; ++et) Oacc[et][r] *= lam; }
#pragma unroll
            for (int et = 0; et < 4; ++et)
#pragma unroll
                for (int s = 0; s < 4; ++s) {
                    LAS unsigned char* a0 = lds + RT_V_OFF + (32 * s + 4 * fq + li_q) * RT_VP + (16 * et + 4 * li_p) * 2;
                    const bf16x8 Vf = tr_pair(a0, a0 + 16 * RT_VP);
                    Oacc[et] = __builtin_amdgcn_mfma_f32_16x16x32_bf16(Pf[s], Vf, Oacc[et], 0, 0, 0); }
#pragma unroll
            for (int r = 0; r < 4; ++r) { const int t_ = 128 * c - 112 + i0 + 4 * fq + r;
                if (t_ >= 0) { float* op = O + (size_t)(b * TP + t_) * RV + 512 * h + 64 * es + fr;
#pragma unroll
                    for (int et = 0; et < 4; ++et) op[16 * et] = Oacc[et][r]; } }
#pragma unroll
            for (int dt = 0; dt < 2; ++dt)
#pragma unroll
                for (int et = 0; et < 4; ++et) Sacc[dt][et] = Sacc[dt][et] * (g128 / g127);
#pragma unroll
            for (int s = 0; s < 4; ++s) {
                bf16x8 Kt[2], Vt[4];
#pragma unroll
                for (int dt = 0; dt < 2; ++dt) { LAS unsigned char* a0 = lds + RT_K_OFF + (32 * s + 8 * fq + li_q) * RT_KP + (d0 + 16 * dt + 4 * li_p) * 2; Kt[dt] = tr_pair(a0, a0 + 4 * RT_KP); }
#pragma unroll
                for (int et = 0; et < 4; ++et) { LAS unsigned char* a0 = lds + RT_V_OFF + (32 * s + 8 * fq + li_q) * RT_VP + (16 * et + 4 * li_p) * 2; Vt[et] = tr_pair(a0, a0 + 4 * RT_VP); }
#pragma unroll
                for (int dt = 0; dt < 2; ++dt)
#pragma unroll
                    for (int et = 0; et < 4; ++et) Sacc[dt][et] = __builtin_amdgcn_mfma_f32_16x16x32_bf16(Kt[dt], Vt[et], Sacc[dt][et], 0, 0, 0);
            }
#pragma unroll
            for (int dt = 0; dt < 2; ++dt)
#pragma unroll
                for (int et = 0; et < 4; ++et) Sacc[dt][et] = Sacc[dt][et] * g127;
#pragma unroll
            for (int dt = 0; dt < 2; ++dt)
#pragma unroll
                for (int et = 0; et < 4; ++et) { v2u w; w.x = cvt_pk_bf16(Sacc[dt][et][0], Sacc[dt][et][1]); w.y = cvt_pk_bf16(Sacc[dt][et][2], Sacc[dt][et][3]);
                    *(LAS v2u*)(lds + RT_ST_OFF + (16 * et + fr) * RT_SP + (d0 + 16 * dt + 4 * fq) * 2) = w; }
        }
#undef RT_LOAD_STAGE
        float* so = p.out + O_RETP + ((((size_t)jl * BATCH + b) * RH + h) * RDK) * RDV + 64 * es;
#pragma unroll
        for (int dt = 0; dt < 2; ++dt)
#pragma unroll
            for (int et = 0; et < 4; ++et)
#pragma unroll
                for (int r = 0; r < 4; ++r) so[(size_t)(d0 + 16 * dt + 4 * fq + r) * RDV + 16 * et + fr] = Sacc[dt][et][r];
    }
    {
        LAS float* sq = (LAS float*)lds; LAS float* sk = sq + 256; LAS float* red = sk + 256;
        const int e4 = tid & 127, dq = tid >> 7;
        for (int it = blockIdx.x; it < SB * RH; it += gridDim.x) {
            const int h = it & 3, s = it >> 2, row = MP + s;
            const float gamma = 1.0f - exp2f(-5.0f - (float)h);
            __syncthreads();
            if (tid < 256) sq[tid] = bf_lo((unsigned)QK[(size_t)row * 2048 + 256 * h + tid]);
            else sk[tid - 256] = bf_lo((unsigned)QK[(size_t)row * 2048 + 1024 + 256 * h + (tid - 256)]);
            const v2u vv = *(const v2u*)(V + (size_t)row * 2048 + 512 * h + 4 * e4);
            const f32x4 v4 = (f32x4){bf_lo(vv.x), bf_hi(vv.x), bf_lo(vv.y), bf_hi(vv.y)};
            __syncthreads();
            const float* sin_ = p.in[I_SRET] + ((((size_t)jl * SB + s) * RH + h) * RDK) * RDV + 4 * e4;
            float* sout = p.out + O_RETS + ((((size_t)jl * SB + s) * RH + h) * RDK) * RDV + 4 * e4;
            f32x4 oacc = (f32x4){0.f, 0.f, 0.f, 0.f};
#pragma unroll 8
            for (int k = 0; k < 64; ++k) { const int d = dq + 4 * k;
                const f32x4 sv = __builtin_nontemporal_load((const f32x4*)(sin_ + (size_t)d * RDV));
                const f32x4 sn = sv * gamma + v4 * sk[d];
                oacc += sn * sq[d];
                __builtin_nontemporal_store(sn, (f32x4*)(sout + (size_t)d * RDV)); }
            *(LAS f32x4*)(red + dq * 512 + 4 * e4) = oacc;
            __syncthreads();
            if (dq == 0) { const f32x4 r = (*(LAS f32x4*)(red + 4 * e4) + *(LAS f32x4*)(red + 512 + 4 * e4)) + (*(LAS f32x4*)(red + 1024 + 4 * e4) + *(LAS f32x4*)(red + 1536 + 4 * e4));
                *(f32x4*)(O + (size_t)row * RV + 512 * h + 4 * e4) = r; }
        }
    }
}

typedef float f32x2w __attribute__((ext_vector_type(2)));
constexpr int WK_TB = 32, WK_STEP_B = 6 * 256 + 16, WK_BUF_B = WK_TB * WK_STEP_B, WK_Y_OFF = 2 * WK_BUF_B, WK_YB_B = WK_TB * 32 * 4;
static_assert(WK_Y_OFF + 2 * WK_YB_B <= LDS_BYTES - 16, "wkv LDS map");
__device__ __forceinline__ float row16_sum(float x) {
    x += __builtin_bit_cast(float, __builtin_amdgcn_update_dpp(0, __builtin_bit_cast(int, x), 0x128, 0xf, 0xf, false));
    x += __builtin_bit_cast(float, __builtin_amdgcn_update_dpp(0, __builtin_bit_cast(int, x), 0x124, 0xf, 0xf, false));
    x += __builtin_bit_cast(float, __builtin_amdgcn_update_dpp(0, __builtin_bit_cast(int, x), 0x122, 0xf, 0xf, false));
    x += __builtin_bit_cast(float, __builtin_amdgcn_update_dpp(0, __builtin_bit_cast(int, x), 0x121, 0xf, 0xf, false));
    return x;
}
__device__ __forceinline__ float half8_sum(float x) {
    x += __builtin_bit_cast(float, __builtin_amdgcn_update_dpp(0, __builtin_bit_cast(int, x), 0x141, 0xf, 0xf, false));
    x += __builtin_bit_cast(float, __builtin_amdgcn_update_dpp(0, __builtin_bit_cast(int, x), 0xB1, 0xf, 0xf, false));
    x += __builtin_bit_cast(float, __builtin_amdgcn_update_dpp(0, __builtin_bit_cast(int, x), 0x4E, 0xf, 0xf, false));
    return x;
}
struct WkPar { f32x4 w0, a0, kkp, kap, v0; };
__device__ __forceinline__ f32x4 wk_unit_neg(const f32x4 kraw, const f32x4 kkp) {
    const f32x4 kk = kraw * kkp;
    const float ss = row16_sum((kk.x * kk.x + kk.y * kk.y) + (kk.z * kk.z + kk.w * kk.w));
    return kk * (-rsqrtf(fmaxf(ss, 1e-12f)));
}
__device__ __forceinline__ float wk_decay(float x) { const float xw = -x; const float sp = xw > 20.f ? xw : log1pf(expf(xw)); return expf(-expf(-sp - 0.5f)); }
__device__ __forceinline__ void wk_prep(const WkPar& P, const f32x4 kraw, const f32x4 vraw, const f32x4 lw2, const f32x4 la2, const f32x4 vf, const f32x4 lv2, bool vres,
                                        f32x4& w, f32x4& ka, f32x4& km, f32x4& vp, f32x4& nk) {
    nk = wk_unit_neg(kraw, P.kkp);
    w = (f32x4){wk_decay(P.w0.x + lw2.x), wk_decay(P.w0.y + lw2.y), wk_decay(P.w0.z + lw2.z), wk_decay(P.w0.w + lw2.w)};
    const f32x4 a = (f32x4){sigmoidf_(P.a0.x + la2.x), sigmoidf_(P.a0.y + la2.y), sigmoidf_(P.a0.z + la2.z), sigmoidf_(P.a0.w + la2.w)};
    ka = nk * (-a);
    km = kraw * ((a - 1.f) * P.kap + 1.f);
    vp = vraw;
    if (vres) { const f32x4 sg = (f32x4){sigmoidf_(P.v0.x + lv2.x), sigmoidf_(P.v0.y + lv2.y), sigmoidf_(P.v0.z + lv2.z), sigmoidf_(P.v0.w + lv2.w)}; vp = vraw + (vf - vraw) * sg; }
}
constexpr int WC_C = 16, WC_NCH = TP / WC_C;
static_assert(WC_NCH * WC_C == TP, "chunking");
constexpr int REC_WA = 0, REC_RP = 2048, REC_BK = 4096, REC_VV = 8192, REC_U0 = 10240, REC_Y0 = 14336, REC_GC = 18432, REC_BYTES = 18688;
constexpr size_t WS_REC = WS_END;
constexpr size_t WS_END2 = WS_REC + (size_t)BATCH * WH * WC_NCH * REC_BYTES;
__device__ __forceinline__ unsigned bf_rne_c(float f) { unsigned u = __float_as_uint(f); return (u + 0x7fffu + ((u >> 16) & 1u)) >> 16; }
__device__ __forceinline__ unsigned pk2_c(float lo, float hi) { return bf_rne_c(lo) | (bf_rne_c(hi) << 16); }
__device__ __forceinline__ float bf_rd(const bf16* q) { return __uint_as_float((unsigned)(*q) << 16); }
__device__ __forceinline__ bf16 bf_of(float x) { return (bf16)(cvt_pk_bf16(x, 0.f) & 0xffffu); }

__device__ __forceinline__ void ph_wkv1(const Params& p, int jl, LAS unsigned char* lds, int lane_in, int wave) {
    const bf16* Kr = (const bf16*)(p.ws + WS_K); const bf16* Vr = (const bf16*)(p.ws + (jl == 0 ? WS_VF : WS_VB)); const bf16* VFp = (const bf16*)(p.ws + WS_VF);
    const bf16* Rr = (const bf16*)(p.ws + WS_R); const bf16* L2 = (const bf16*)(p.ws + WS_L2);
    bf16* KM = (bf16*)(p.ws + WS_NKK); bf16* VP = (bf16*)(p.ws + WS_KKA);
    const bool vres = jl == 1;
    const int gw = blockIdx.x * NWAVES + wave, NGW = gridDim.x * NWAVES;
    for (int job = gw; job < BATCH * WH * WC_NCH; job += NGW) {
        int ln = lane_in; asm volatile("" : "+v"(ln));
        const int lane = ln, fr = lane & 15, fq = lane >> 4;
        const int c = job % WC_NCH, sh = job / WC_NCH, h = sh & 15, seq = sh >> 4, r0 = seq * TP + WC_C * c, ch = h * WN + lane;
        LAS unsigned char* sc = lds + wave * 16384;
        const float pw0 = p.in[I_W0][(size_t)jl * D + ch], pa0 = p.in[I_A0][(size_t)jl * D + ch], pkk = p.in[I_KK][(size_t)jl * D + ch], pka = p.in[I_KA][(size_t)jl * D + ch], pv0 = p.in[I_V0][ch];
        float at[16], bt[16], kt[16], rt[16], vv[16], wv[16];
#pragma unroll
        for (int tb = 0; tb < 16; tb += 4) {
            float kraw[4], vraw[4], lw2[4], la2[4], vf[4], lv2[4];
#pragma unroll
            for (int q = 0; q < 4; ++q) { const int t = tb + q; const size_t ro = (size_t)(r0 + t) * D + ch, lo = (size_t)(r0 + t) * NL2 + ch;
                kraw[q] = bf_rd(Kr + ro); vraw[q] = bf_rd(Vr + ro); rt[t] = bf_rd(Rr + ro); lw2[q] = bf_rd(L2 + lo); la2[q] = bf_rd(L2 + lo + 1024);
                vf[q] = 0.f; lv2[q] = 0.f; if (vres) { vf[q] = bf_rd(VFp + ro); lv2[q] = bf_rd(L2 + lo + 3072); } }
            __builtin_amdgcn_sched_barrier(0);
#pragma unroll
            for (int q = 0; q < 4; ++q) { const int t = tb + q; const size_t ro = (size_t)(r0 + t) * D + ch;
                const float kk = kraw[q] * pkk;
                const float nk = -kk * rsqrtf(fmaxf(wave_sum(kk * kk, lane), 1e-12f));
                const float a = sigmoidf_(pa0 + la2[q]);
                wv[t] = wk_decay(pw0 + lw2[q]);
                at[t] = nk; bt[t] = -nk * a; kt[t] = kraw[q] * (1.f + (a - 1.f) * pka);
                float vp = vraw[q];
                if (vres) vp = vraw[q] + (vf[q] - vraw[q]) * sigmoidf_(pv0 + lv2[q]);
                vv[t] = vp;
                KM[ro] = bf_of(kt[t]); VP[ro] = bf_of(vp);
                __builtin_amdgcn_sched_barrier(0);
            }
        }
        float g = 1.f;
#pragma unroll
        for (int t = 0; t < 16; ++t) { const float gp = g; g *= wv[t]; const float ig = 1.f / g; at[t] *= gp; bt[t] *= ig; kt[t] *= ig; rt[t] *= g; }
        unsigned char* rec = p.ws + WS_REC + (size_t)job * REC_BYTES;
        *(float*)(rec + REC_GC + lane * 4) = g;
#pragma unroll
        for (int t = 0; t < 16; ++t) {
            *(LAS bf16*)(sc + (0 * 16 + t) * 144 + 2 * lane) = bf_of(at[t]); *(LAS bf16*)(sc + (1 * 16 + t) * 144 + 2 * lane) = bf_of(bt[t]);
            *(LAS bf16*)(sc + (2 * 16 + t) * 144 + 2 * lane) = bf_of(kt[t]); *(LAS bf16*)(sc + (3 * 16 + t) * 144 + 2 * lane) = bf_of(rt[t]);
        }
        asm volatile("s_waitcnt lgkmcnt(0)" ::: "memory");
        {
            bf16x8 fa[2], fb[2], fk[2], fr_[2];
#pragma unroll
            for (int s = 0; s < 2; ++s) { const int off = fr * 144 + (32 * s + 8 * fq) * 2;
                fa[s] = *(const LAS bf16x8*)(sc + 0 * 2304 + off); fb[s] = *(const LAS bf16x8*)(sc + 1 * 2304 + off); fk[s] = *(const LAS bf16x8*)(sc + 2 * 2304 + off); fr_[s] = *(const LAS bf16x8*)(sc + 3 * 2304 + off); }
            f32x4 gab = (f32x4){0.f, 0.f, 0.f, 0.f}, gak = gab, grb = gab, grk = gab;
#pragma unroll
            for (int s = 0; s < 2; ++s) {
                gab = __builtin_amdgcn_mfma_f32_16x16x32_bf16(fa[s], fb[s], gab, 0, 0, 0); gak = __builtin_amdgcn_mfma_f32_16x16x32_bf16(fa[s], fk[s], gak, 0, 0, 0);
                grb = __builtin_amdgcn_mfma_f32_16x16x32_bf16(fr_[s], fb[s], grb, 0, 0, 0); grk = __builtin_amdgcn_mfma_f32_16x16x32_bf16(fr_[s], fk[s], grk, 0, 0, 0); }
#pragma unroll
            for (int r = 0; r < 4; ++r) { LAS float* gp = (LAS float*)(sc + 9216) + (4 * fq + r) * 16 + fr;
                gp[0] = gab[r]; gp[256] = gak[r]; gp[512] = grb[r]; gp[768] = grk[r]; }
        }
        asm volatile("s_waitcnt lgkmcnt(0)" ::: "memory");
        const LAS float* G = (const LAS float*)(sc + 9216);
        const volatile LAS f32x4* Gq = (const volatile LAS f32x4*)(sc + 9216);
#pragma unroll
        for (int t = 0; t < 16; ++t) {
            float wa = at[t];
#pragma unroll
            for (int q = 0; q * 4 < t; ++q) { const f32x4 lab = Gq[(0 * 256 + t * 16 + 4 * q) >> 2];
#pragma unroll
                for (int e = 0; e < 4; ++e) { const int s = 4 * q + e; if (s < t) wa = fmaf(lab[e], at[s], wa); } }
            at[t] = wa;
            __builtin_amdgcn_sched_barrier(0);
        }
#pragma unroll
        for (int t = 0; t < 16; ++t) {
            float rp = rt[t];
#pragma unroll
            for (int q = 0; q * 4 <= t; ++q) { const f32x4 mrb = Gq[(2 * 256 + t * 16 + 4 * q) >> 2];
#pragma unroll
                for (int e = 0; e < 4; ++e) { const int s = 4 * q + e; if (s <= t) rp = fmaf(mrb[e], at[s], rp); } }
            rt[t] = rp;
            __builtin_amdgcn_sched_barrier(0);
        }
        {
            const int j = lane;
            const int wbase = (((j >> 5) * 64 + ((j >> 2) & 3) * 16) * 8 + ((j >> 4) & 1) * 4 + (j & 3)) * 2;
            const int bbase = (((j >> 4) * 64 + (j & 15)) * 8) * 2;
#pragma unroll
            for (int t = 0; t < 16; ++t) {
                *(LAS bf16*)(sc + REC_WA + wbase + t * 16) = bf_of(at[t]); *(LAS bf16*)(sc + REC_RP + wbase + t * 16) = bf_of(rt[t]);
                *(LAS bf16*)(sc + REC_BK + bbase + (t >> 2) * 256 + (t & 3) * 2) = bf_of(bt[t]); *(LAS bf16*)(sc + REC_BK + bbase + (t >> 2) * 256 + (4 + (t & 3)) * 2) = bf_of(kt[t]);
            }
            asm volatile("s_waitcnt lgkmcnt(0)" ::: "memory");
#pragma unroll
            for (int k = 0; k < 8; ++k) *(v4u*)(rec + (k * 64 + lane) * 16) = *(const LAS v4u*)(sc + (k * 64 + lane) * 16);
            asm volatile("s_waitcnt lgkmcnt(0)" ::: "memory");
        }
        __builtin_amdgcn_sched_barrier(0);
        float u0[16];
#pragma unroll
        for (int t = 0; t < 16; ++t) {
            float uu = 0.f;
#pragma unroll
            for (int q = 0; q * 4 < t; ++q) { const f32x4 lab = Gq[(0 * 256 + t * 16 + 4 * q) >> 2], lak = Gq[(1 * 256 + t * 16 + 4 * q) >> 2];
#pragma unroll
                for (int e = 0; e < 4; ++e) { const int s = 4 * q + e; if (s < t) uu = fmaf(lak[e], vv[s], fmaf(lab[e], u0[s], uu)); } }
            u0[t] = uu;
            __builtin_amdgcn_sched_barrier(0);
        }
        {
            const int i = lane;
            const int vbase = ((i >> 4) * 64 + (i & 15)) * 4;
#pragma unroll
            for (int t = 0; t < 16; ++t) {
                float yy = 0.f;
#pragma unroll
                for (int q = 0; q * 4 <= t; ++q) { const f32x4 mrb = Gq[(2 * 256 + t * 16 + 4 * q) >> 2], mrk = Gq[(3 * 256 + t * 16 + 4 * q) >> 2];
#pragma unroll
                    for (int e = 0; e < 4; ++e) { const int s = 4 * q + e; if (s <= t) yy = fmaf(mrb[e], u0[s], fmaf(mrk[e], vv[s], yy)); } }
                *(LAS float*)(sc + 4096 + (vbase + (t >> 2) * 64 + (t & 3)) * 4) = yy;
                *(LAS float*)(sc + 0 + (vbase + (t >> 2) * 64 + (t & 3)) * 4) = u0[t];
                *(LAS bf16*)(sc + 13312 + (vbase + (t >> 2) * 64 + (t & 3)) * 2) = bf_of(vv[t]);
                __builtin_amdgcn_sched_barrier(0);
            }
            asm volatile("s_waitcnt lgkmcnt(0)" ::: "memory");
#pragma unroll
            for (int k = 0; k < 2; ++k) *(v4u*)(rec + REC_VV + (k * 64 + lane) * 16) = *(const LAS v4u*)(sc + 13312 + (k * 64 + lane) * 16);
#pragma unroll
            for (int k = 0; k < 8; ++k) *(v4u*)(rec + REC_U0 + (k * 64 + lane) * 16) = *(const LAS v4u*)(sc + (k * 64 + lane) * 16);
            asm volatile("s_waitcnt lgkmcnt(0)" ::: "memory");
        }
    }
}

__device__ __forceinline__ void ph_wkv2(const Params& p, int jl, int lane, int wave) {
    const bf16* Kr = (const bf16*)(p.ws + WS_K); const bf16* Vr = (const bf16*)(p.ws + (jl == 0 ? WS_VF : WS_VB)); const bf16* VFp = (const bf16*)(p.ws + WS_VF);
    const bf16* Rr = (const bf16*)(p.ws + WS_R); const bf16* L2 = (const bf16*)(p.ws + WS_L2);
    bf16* KM = (bf16*)(p.ws + WS_NKK); bf16* VP = (bf16*)(p.ws + WS_KKA);
    const bool vres = jl == 1; const int ri = lane >> 4, cg = lane & 15;
    float* YW = (float*)(p.ws + WS_YW);
    const int fr = lane & 15, fq = lane >> 4;
    const int gw = blockIdx.x * NWAVES + wave, NGW = gridDim.x * NWAVES;
    for (int job = gw; job < BATCH * WH * 4; job += NGW) {
        const int it = job & 3, h = (job >> 2) & 15, seq = job >> 6, r0 = seq * TP;
        const unsigned char* rec = p.ws + WS_REC + (size_t)((seq * WH + h) * WC_NCH) * REC_BYTES;
        f32x4 Sacc[4];
#pragma unroll
        for (int jt = 0; jt < 4; ++jt) Sacc[jt] = (f32x4){0.f, 0.f, 0.f, 0.f};
        v4u wa[2], rp[2], bk[4]; v2u vvf; f32x4 u0, y0, gc[4];
#define WC_LOAD(rc) do { const unsigned char* r_ = (rc); \
            wa[0] = *(const v4u*)(r_ + REC_WA + lane * 16); wa[1] = *(const v4u*)(r_ + REC_WA + 1024 + lane * 16); rp[0] = *(const v4u*)(r_ + REC_RP + lane * 16); rp[1] = *(const v4u*)(r_ + REC_RP + 1024 + lane * 16); \
            _Pragma("unroll") for (int jt_ = 0; jt_ < 4; ++jt_) { bk[jt_] = *(const v4u*)(r_ + REC_BK + (jt_ * 64 + lane) * 16); gc[jt_] = *(const f32x4*)(r_ + REC_GC + (16 * jt_ + 4 * fq) * 4); } \
            vvf = *(const v2u*)(r_ + REC_VV + (it * 64 + lane) * 8); u0 = *(const f32x4*)(r_ + REC_U0 + (it * 64 + lane) * 16); y0 = *(const f32x4*)(r_ + REC_Y0 + (it * 64 + lane) * 16); } while (0)
        WC_LOAD(rec);
        for (int c = 0; c < WC_NCH; ++c) {
            const v4u cwa0 = wa[0], cwa1 = wa[1], crp0 = rp[0], crp1 = rp[1], cbk0 = bk[0], cbk1 = bk[1], cbk2 = bk[2], cbk3 = bk[3]; const v2u cvv = vvf; const f32x4 cu0 = u0, cy0 = y0, cg0 = gc[0], cg1 = gc[1], cg2 = gc[2], cg3 = gc[3];
            if (c + 1 < WC_NCH) WC_LOAD(rec + (size_t)(c + 1) * REC_BYTES);
            v4u sb0, sb1;
            sb0.x = cvt_pk_bf16(Sacc[0][0], Sacc[0][1]); sb0.y = cvt_pk_bf16(Sacc[0][2], Sacc[0][3]); sb0.z = cvt_pk_bf16(Sacc[1][0], Sacc[1][1]); sb0.w = cvt_pk_bf16(Sacc[1][2], Sacc[1][3]);
            sb1.x = cvt_pk_bf16(Sacc[2][0], Sacc[2][1]); sb1.y = cvt_pk_bf16(Sacc[2][2], Sacc[2][3]); sb1.z = cvt_pk_bf16(Sacc[3][0], Sacc[3][1]); sb1.w = cvt_pk_bf16(Sacc[3][2], Sacc[3][3]);
            const bf16x8 B0 = __builtin_bit_cast(bf16x8, sb0), B1 = __builtin_bit_cast(bf16x8, sb1);
            f32x4 U = __builtin_amdgcn_mfma_f32_16x16x32_bf16(__builtin_bit_cast(bf16x8, cwa0), B0, cu0, 0, 0, 0);
            U = __builtin_amdgcn_mfma_f32_16x16x32_bf16(__builtin_bit_cast(bf16x8, cwa1), B1, U, 0, 0, 0);
            f32x4 Y = __builtin_amdgcn_mfma_f32_16x16x32_bf16(__builtin_bit_cast(bf16x8, crp0), B0, cy0, 0, 0, 0);
            Y = __builtin_amdgcn_mfma_f32_16x16x32_bf16(__builtin_bit_cast(bf16x8, crp1), B1, Y, 0, 0, 0);
            v4u ub; ub.x = pk2_c(U[0], U[1]); ub.y = pk2_c(U[2], U[3]); ub.z = cvv.x; ub.w = cvv.y;
            const bf16x8 UB = __builtin_bit_cast(bf16x8, ub);
            Sacc[0] = __builtin_amdgcn_mfma_f32_16x16x32_bf16(__builtin_bit_cast(bf16x8, cbk0), UB, Sacc[0], 0, 0, 0) * cg0;
            Sacc[1] = __builtin_amdgcn_mfma_f32_16x16x32_bf16(__builtin_bit_cast(bf16x8, cbk1), UB, Sacc[1], 0, 0, 0) * cg1;
            Sacc[2] = __builtin_amdgcn_mfma_f32_16x16x32_bf16(__builtin_bit_cast(bf16x8, cbk2), UB, Sacc[2], 0, 0, 0) * cg2;
            Sacc[3] = __builtin_amdgcn_mfma_f32_16x16x32_bf16(__builtin_bit_cast(bf16x8, cbk3), UB, Sacc[3], 0, 0, 0) * cg3;
            float* yp = YW + (size_t)(r0 + WC_C * c + 4 * fq) * D + h * WN + 16 * it + fr;
            yp[0] = Y[0]; yp[D] = Y[1]; yp[2 * D] = Y[2]; yp[3 * D] = Y[3];
        }
#undef WC_LOAD
        float* so = p.out + O_WKVP + ((((size_t)jl * BATCH + seq) * WH + h) * WN + 16 * it + fr) * WN + 4 * fq;
#pragma unroll
        for (int jt = 0; jt < 4; ++jt) *(f32x4*)(so + 16 * jt) = Sacc[jt];
    }
    {
        const int gw = blockIdx.x * NWAVES + wave, NGW = gridDim.x * NWAVES;
        for (int it = gw; it < SB * WH * 16; it += NGW) {
            const int rg = it & 15, h = (it >> 4) & 15, s = it >> 8, row = MP + s, i = 4 * rg + ri;
            const int ch = h * WN + 4 * cg;
            WkPar P; P.w0 = *(const f32x4*)(p.in[I_W0] + (size_t)jl * D + ch); P.a0 = *(const f32x4*)(p.in[I_A0] + (size_t)jl * D + ch); P.kkp = *(const f32x4*)(p.in[I_KK] + (size_t)jl * D + ch);
            P.kap = *(const f32x4*)(p.in[I_KA] + (size_t)jl * D + ch); P.v0 = *(const f32x4*)(p.in[I_V0] + ch);
            const size_t vo = (size_t)row * D + ch, lo = (size_t)row * NL2 + ch;
            const f32x4 kraw = ld_bf4(Kr + vo), vraw = ld_bf4(Vr + vo), r4 = ld_bf4(Rr + vo), lw2 = ld_bf4(L2 + lo), la2 = ld_bf4(L2 + lo + 1024);
            f32x4 vf = (f32x4){0.f, 0.f, 0.f, 0.f}, lv2 = vf;
            if (vres) { vf = ld_bf4(VFp + vo); lv2 = ld_bf4(L2 + lo + 3072); }
            f32x4 w4, ka, k4, vp, nk; wk_prep(P, kraw, vraw, lw2, la2, vf, lv2, vres, w4, ka, k4, vp, nk);
            const int srcl = (lane & 48) | rg;
            const float v0_ = shfl_l(vp.x, srcl), v1_ = shfl_l(vp.y, srcl), v2_ = shfl_l(vp.z, srcl), v3_ = shfl_l(vp.w, srcl);
            const float vi = ri == 0 ? v0_ : (ri == 1 ? v1_ : (ri == 2 ? v2_ : v3_));
            const size_t so = ((((size_t)jl * SB + s) * WH + h) * WN + i) * WN + 4 * cg;
            f32x4 S = *(const f32x4*)(p.in[I_SWKV] + so);
            const float sa = row16_sum((S.x * nk.x + S.y * nk.y) + (S.z * nk.z + S.w * nk.w));
            S.x = fmaf(S.x, w4.x, fmaf(sa, ka.x, vi * k4.x)); S.y = fmaf(S.y, w4.y, fmaf(sa, ka.y, vi * k4.y));
            S.z = fmaf(S.z, w4.z, fmaf(sa, ka.z, vi * k4.z)); S.w = fmaf(S.w, w4.w, fmaf(sa, ka.w, vi * k4.w));
            const float y = row16_sum((S.x * r4.x + S.y * r4.y) + (S.z * r4.z + S.w * r4.w));
            *(f32x4*)(p.out + O_WKVS + so) = S;
            if (cg == 0) YW[(size_t)row * D + h * WN + i] = y;
            if (rg == 0 && ri == 0) { st_bf4(KM + vo, k4); st_bf4(VP + vo, vp); }
        }
    }
}

typedef __attribute__((address_space(1))) unsigned gu32;
#define XB_TMO      128
#define XB_XCNT(j)  (256  + 64 * (j))
#define XB_XSUB(j)  (1280 + 64 * (j))
#define XB_XGEN(j)  (2304 + 64 * (j))
#define XB_TOP      3328
#define XB_TOPGEN   3392
#define XCD_BAR_WORDS 3456
#define XB_SPIN_CAP (1u << 18)

__device__ __forceinline__ unsigned xb_ld(unsigned* p)              { return __hip_atomic_load(p, __ATOMIC_RELAXED, __HIP_MEMORY_SCOPE_AGENT); }
__device__ __forceinline__ unsigned xb_add(unsigned* p, unsigned v) { return __hip_atomic_fetch_add(p, v, __ATOMIC_RELAXED, __HIP_MEMORY_SCOPE_AGENT); }
__device__ __forceinline__ unsigned xb_xcc_id() { return (unsigned)__builtin_amdgcn_s_getreg((3 << 11) | 20) & 0xFu; }
#define XB_SPIN(cond, bar) do { unsigned _sp = 0; while (cond) { __builtin_amdgcn_s_sleep(1); \
    if ((++_sp & 255u) == 0u) { if (xb_ld(&(bar)[XB_TMO])) break; if (_sp > XB_SPIN_CAP) { atomicAdd(&(bar)[XB_TMO], 1u); break; } } } } while (0)

struct XcdBarrier {
    bool tid0; unsigned* bar; unsigned x;
    volatile LAS unsigned* st;
};

__device__ __forceinline__ XcdBarrier xcd_barrier_post(unsigned* bar, volatile LAS unsigned* st, bool tid0) {
    XcdBarrier b; b.tid0 = tid0; b.bar = bar; b.x = xb_xcc_id(); b.st = st;
    if (b.tid0) (void)xb_add(&bar[XB_XCNT(b.x)], 1u);
    return b;
}
__device__ __forceinline__ void xcd_barrier_complete(unsigned* bar, unsigned x, unsigned& nloc, unsigned& nx) {
    const unsigned G = gridDim.x * gridDim.y * gridDim.z;
    unsigned sum, cnt, mine, sp = 0u;
    for (;;) {
        sum = 0u; cnt = 0u; mine = 0u;
#pragma unroll
        for (unsigned j = 0; j < 16; ++j) { const unsigned c = xb_ld(&bar[XB_XCNT(j)]); sum += c; cnt += (c > 0u) ? 1u : 0u; mine = (j == x) ? c : mine; }
        if (sum == G) break;
        __builtin_amdgcn_s_sleep(1);
        if ((++sp & 255u) == 0u) { if (xb_ld(&bar[XB_TMO])) break; if (sp > XB_SPIN_CAP) { atomicAdd(&bar[XB_TMO], 1u); break; } }
    }
    nloc = mine > 0u ? mine : 1u; nx = cnt > 0u ? cnt : 1u;
}

__device__ __forceinline__ void xcd_barrier(const XcdBarrier& b) {
    asm volatile("s_waitcnt vmcnt(0)" ::: "memory");
    __syncthreads();
    if (b.tid0) {
        unsigned* bar = b.bar;
        __builtin_amdgcn_s_waitcnt(0);
        unsigned nloc = b.st[0], nx = b.st[1];
        if (nloc == 0u) { xcd_barrier_complete(bar, b.x, nloc, nx); b.st[0] = nloc; b.st[1] = nx; }
        const unsigned old = xb_add(&bar[XB_XSUB(b.x)], 1u);
        const unsigned gen = old / nloc;
        if (old + 1u == (gen + 1u) * nloc) {
            __builtin_amdgcn_fence(__ATOMIC_RELEASE, "agent");
            asm volatile("s_waitcnt vmcnt(0)" ::: "memory");
            const unsigned og = xb_add(&bar[XB_TOP], 1u);
            const unsigned tg = og / nx;
            if (og + 1u == (tg + 1u) * nx) xb_add(&bar[XB_TOPGEN], 1u);
            else XB_SPIN(xb_ld(&bar[XB_TOPGEN]) == tg, bar);
            __builtin_amdgcn_fence(__ATOMIC_ACQUIRE, "agent");
            xb_add(&bar[XB_XGEN(b.x)], 1u);
            asm volatile("s_waitcnt vmcnt(0)" ::: "memory");
        } else {
            XB_SPIN(xb_ld(&bar[XB_XGEN(b.x)]) == gen, bar);
            __builtin_amdgcn_fence(__ATOMIC_ACQUIRE, "agent");
            asm volatile("s_waitcnt vmcnt(0)" ::: "memory");
        }
    }
    __syncthreads();
}

enum { OP_P0 = 0, OP_NORM_RET, OP_G_RETIN, OP_RET, OP_RETNORM, OP_G_RETOUT, OP_NORM_RW, OP_G_RWPROJ, OP_G_LORA2, OP_PREP, OP_WKV, OP_WKV2, OP_POST, OP_G_WO,
       OP_NORM_FFN, OP_G_UG, OP_CONV, OP_G_WD, OP_FINAL };
struct Ph { unsigned char op, layer; };
constexpr int NPH = 1 + 2 * 6 + 2 * 9 + 1;
__device__ __host__ inline Ph phase_at(int i) {
    if (i == 0) return Ph{OP_P0, 0};
    i -= 1;
    int l;
    if (i < 6) l = 0; else if (i < 15) { l = 1; i -= 6; } else if (i < 21) { l = 2; i -= 15; } else if (i < 30) { l = 3; i -= 21; } else return Ph{OP_FINAL, 0};
    int op = OP_FINAL;
    if ((l & 1) == 0) {
        switch (i) { case 0: op = OP_G_RETIN; break; case 1: op = OP_RET; break; case 2: op = OP_RETNORM; break; case 3: op = OP_G_RETOUT; break;
                     case 4: op = OP_G_UG; break; default: op = OP_G_WD; break; }
    } else {
        switch (i) { case 0: op = OP_NORM_RW; break; case 1: op = OP_G_RWPROJ; break; case 2: op = OP_G_LORA2; break; case 3: op = OP_WKV; break; case 4: op = OP_WKV2; break; case 5: op = OP_POST; break; case 6: op = OP_G_WO; break;
                     case 7: op = OP_G_UG; break; default: op = OP_G_WD; break; }
    }
    return Ph{(unsigned char)op, (unsigned char)l};
}

__global__ void __launch_bounds__(NTHR, 2) mega(Params p, int lo, int hi) {
    extern __shared__ __attribute__((aligned(16))) unsigned char lds_raw[];
    LAS unsigned char* lds = (LAS unsigned char*)lds_raw;
    volatile LAS unsigned* bst = (volatile LAS unsigned*)(lds + LDS_BYTES - 16);
    const int wave0 = __builtin_amdgcn_readfirstlane((int)threadIdx.x >> 6);
    if (threadIdx.x < 4) bst[threadIdx.x] = 0u;
    __syncthreads();
    (void)xcd_barrier_post((unsigned*)(p.ws + WS_CTL), bst, threadIdx.x == 0);
    for (int ph = lo; ph < hi; ++ph) {
        int lid_; asm volatile("v_mbcnt_lo_u32_b32 %0, -1, 0\n\tv_mbcnt_hi_u32_b32 %0, -1, %0" : "=v"(lid_));
        int tid = wave0 * 64 + lid_; asm volatile("" : "+v"(tid));
        const int lane = tid & 63, wave = __builtin_amdgcn_readfirstlane(tid >> 6);
        unsigned char* ws = p.ws;
        const Ph P = phase_at(ph);
        const int li = P.layer, jl = li >> 1;
        const bf16* gA = nullptr; const bf16* gB = nullptr; int gN = 0, gK = 0; EpiAnyT<0> E{}; E.jl = jl; E.ws = ws; E.slot = -1; E.amul = 1.f; E.li = li; E.ldsb = lds; bool is_gemm = false;
        switch (P.op) {
        case OP_P0: ph_p0(p, lds, tid, lane, wave); break;
        case OP_NORM_RET: ph_norm(p, p.in[I_NMIX] + (size_t)li * D, 0, jl, lane, wave); break;
        case OP_NORM_FFN: ph_norm(p, p.in[I_NFFN] + (size_t)li * D, 0, jl, lane, wave); break;
        case OP_NORM_RW: ph_norm(p, p.in[I_NMIX] + (size_t)li * D, 1, jl, lane, wave); break;
        case OP_FINAL: ph_norm(p, p.in[I_NFIN], 2, 0, lane, wave); break;
        case OP_RETNORM: ph_ret_norm(p, jl, lane, wave); break;
        case OP_POST: ph_rwkv_post(p, jl, lane, wave); break;
        case OP_RET: ph_ret_fast(p, jl, lds, tid, lane, wave); break;
        case OP_WKV: ph_wkv1(p, jl, lds, lane, wave); break;
        case OP_WKV2: ph_wkv2(p, jl, lane, wave); break;
        case OP_G_RETIN: is_gemm = true; E.kind = EK_RETIN; E.perm = true; E.slot = 2 * li;
            gA = (const bf16*)(ws + WS_XB); gB = (const bf16*)(ws + WS_WIN + jl * SZ_WIN); gN = RWIN; gK = D; break;
        case OP_G_RETOUT: is_gemm = true; E.kind = EK_RESID; E.perm = false; E.slot = 2 * li + 1;
            gA = (const bf16*)(ws + WS_Y); gB = (const bf16*)(ws + WS_WOUT + jl * SZ_WOUT); gN = D; gK = RV; break;
        case OP_G_RWPROJ: is_gemm = true; E.kind = EK_RWPROJ; E.perm = true;
            gA = (const bf16*)(ws + WS_H); gB = (const bf16*)(ws + WS_WRW + jl * SZ_WRW); gN = NRW; gK = KRW; break;
        case OP_G_LORA2: is_gemm = true; E.kind = EK_F32; E.perm = true;
            gA = (const bf16*)(ws + WS_A2); gB = (const bf16*)(ws + WS_WL2 + jl * SZ_WL2); gN = (jl == 0 ? 3072 : 4096); gK = KL2; break;
        case OP_G_WO: is_gemm = true; E.kind = EK_RESID; E.perm = false; E.slot = 2 * li + 1;
            gA = (const bf16*)(ws + WS_Z); gB = (const bf16*)(ws + WS_WO + jl * SZ_WO); gN = D; gK = D; break;
        case OP_G_UG: is_gemm = true; E.kind = EK_UG; E.perm = true; E.slot = 2 * li + 1;
            gA = (const bf16*)(ws + WS_XB); gB = (const bf16*)(ws + WS_WUG + li * SZ_WUG); gN = 2 * DFF; gK = D; break;
        case OP_G_WD: is_gemm = true; E.kind = EK_RESID; E.perm = false; E.slot = (li == 1) ? 2 * (li + 1) : -1;
            gA = (const bf16*)(ws + WS_ACT); gB = (const bf16*)(ws + WS_WD + li * SZ_WD); gN = D; gK = DFF; break;
        default: break;
        }
        if (is_gemm) {
            const bool ug = E.kind == EK_UG;
            const int gM = (E.kind == EK_RESID) ? MT0 : (ug ? 66 * 256 : M);
            pg8::Gemm g{ug ? gA - 2 * D : gA, gB, gM, gN, gK, ug ? 254 : 256}; pg8::StaticOrder S; S.init(gM, gN, (int)gridDim.x, (int)blockIdx.x);
            if (E.kind == EK_RETIN || E.kind == EK_UG) {
                LAS float* rt = (LAS float*)(lds + 131072);
                Unit uu;
                for (int ui = 0; ui < 8 && S.next(ui, uu); ++ui) if (tid < 256) { int rr = ug ? 254 * uu.pm - 2 + tid : uu.pm * 256 + tid; rr = rr < 0 ? 0 : (rr > M - 1 ? M - 1 : rr); rt[ui * 256 + tid] = row_rstd(ws, E.slot, rr); }
                E.rtab = rt; E.ldsb = lds;
                __syncthreads();
            }
            if (ug) { EpiAnyT<1> E1{}; E1.kind = E.kind; E1.perm = E.perm; E1.jl = E.jl; E1.ws = E.ws; E1.slot = E.slot; E1.rtab = E.rtab; E1.amul = E.amul; E1.li = E.li; E1.ldsb = E.ldsb; E1.pcw = p.in[I_CW]; E1.pcb = p.in[I_CB]; E1.pcst = p.in[I_SCONV]; E1.pout = p.out;
                pg8::gemm_phase<EpiAnyT<1>, pg8::StaticOrder, true, true>(lds, g, S, E1, tid); }
            else pg8::gemm_phase<EpiAnyT<0>, pg8::StaticOrder, true, true>(lds, g, S, E, tid);
            if (E.kind == EK_RESID) tail_resid(gA, gB, gK, ws, E.slot, E.amul, lds, lane, wave);
        }
        if (ph + 1 < hi) { if (ph == 0) cg::this_grid().sync(); else { XcdBarrier bar; bar.tid0 = tid == 0; bar.bar = (unsigned*)(p.ws + WS_CTL); bar.x = xb_xcc_id(); bar.st = (volatile LAS unsigned*)(lds + LDS_BYTES - 16); xcd_barrier(bar); } }
    }
}

}

extern "C" void kernel_launch(void* const* d_in, const int* in_sizes, int n_in, void* d_out, int out_size, void* d_ws, size_t ws_size, hipStream_t stream) {
    static int grid = 0;
    if (grid == 0) {
        int dev = 0, cus = 0;
        if (n_in != N_IN || ws_size < WS_END2) { fprintf(stderr, "kernel_launch: unexpected n_in %d / ws_size %zu (need %zu)\n", n_in, ws_size, (size_t)WS_END2); grid = -1; return; }
        if (hipGetDevice(&dev) != hipSuccess || hipDeviceGetAttribute(&cus, hipDeviceAttributeMultiprocessorCount, dev) != hipSuccess) { grid = -1; return; }
        if (hipFuncSetAttribute((const void*)mega, hipFuncAttributeMaxDynamicSharedMemorySize, LDS_BYTES) != hipSuccess) { fprintf(stderr, "kernel_launch: hipFuncSetAttribute failed\n"); grid = -1; return; }
        int per_cu = 0;
        if (hipOccupancyMaxActiveBlocksPerMultiprocessor(&per_cu, (const void*)mega, NTHR, LDS_BYTES) != hipSuccess || per_cu < 1) { fprintf(stderr, "kernel_launch: occupancy query says %d\n", per_cu); (void)hipGetLastError(); }
        grid = cus * (per_cu >= 1 ? 1 : 1);
    }
    if (grid < 0) return;
    Params p{};
    for (int i = 0; i < N_IN; ++i) p.in[i] = (const float*)d_in[i];
    p.out = (float*)d_out; p.ws = (unsigned char*)d_ws;
    if (hipMemsetAsync(d_ws, 0, 65536, stream) != hipSuccess) { fprintf(stderr, "kernel_launch: memset failed\n"); return; }
    int lo = 0, hi = NPH;
    void* args[] = {(void*)&p, (void*)&lo, (void*)&hi};
    const hipError_t e = hipLaunchCooperativeKernel((const void*)mega, dim3(grid), dim3(NTHR), args, LDS_BYTES, stream);
    if (e != hipSuccess) fprintf(stderr, "kernel_launch: cooperative launch failed: %s (grid %d)\n", hipGetErrorString(e), grid);
    (void)in_sizes; (void)out_size;
}
```

```cpp
#include <hip/hip_runtime.h>
#include <hip/hip_cooperative_groups.h>
#include <cstdio>
#include <stdint.h>
namespace cg = cooperative_groups;
namespace pg8 {
#define PG8_LAS __attribute__((address_space(3)))
typedef unsigned short bf16_t;
typedef short bf16x8 __attribute__((ext_vector_type(8)));
typedef float f32x4 __attribute__((ext_vector_type(4)));
typedef unsigned u32x4 __attribute__((ext_vector_type(4)));
constexpr int BM = 256, BK = 64, HALF = 128, HTB = HALF * BK * 2  , STAGE_BYTES = 8 * HTB, NXCD = 8, WGM = 8;

__host__ __device__ __forceinline__ int lds_byte(int r, int c) { const int st = (r >> 4) * 2 + (c >> 5), rr = r & 15, cc = c & 31, ob = rr * 64 + cc * 2; return st * 1024 + (ob ^ (((ob >> 9) & 1) << 5)); }
__host__ __device__ __forceinline__ void stage_rc(int b, int& R, int& C) { const int st = b / 1024, sb = b % 1024, swz = sb ^ (((sb >> 9) & 1) << 5); R = (st >> 1) * 16 + swz / 64; C = (st & 1) * 32 + (swz % 64) / 2; }
__host__ __device__ __forceinline__ int perm32(int rho) { const int n = rho >> 4, i = rho & 15; return 8 * (i >> 2) + 4 * n + (i & 3); }

struct Unit { int pm, pn, ord; };
struct Gemm { const bf16_t* A; const bf16_t* Bt; int M, N, K, trows; };

struct StaticOrder {
    int nM, nN, nwg, G, c;
    __host__ __device__ void init(int M, int N, int G_, int c_) { nM = M / BM; nN = N / BM; nwg = nM * nN; G = G_; c = c_; }
    __host__ __device__ __forceinline__ bool next(int i, Unit& u) const {
        const long L = (long)i * G + c; if (L >= nwg) return false;
        int wgid = (int)L; { const int q = nwg / NXCD, r = nwg % NXCD, xcd = wgid % NXCD, off = wgid / NXCD; wgid = (xcd < r ? xcd * (q + 1) : r * (q + 1) + (xcd - r) * q) + off; }
        const int nig = WGM * nN, gid = wgid / nig, fm = gid * WGM, gsz = (nM - fm) < WGM ? (nM - fm) : WGM;
        u.pm = fm + ((wgid % nig) % gsz); u.pn = (wgid % nig) / gsz; u.ord = i; return true;
    }
    __device__ __forceinline__ void a_ready(const Unit&) const {}
    __device__ __forceinline__ void done(const Unit&) const {}
};
template <class Epi, class Sched, bool ALIGN_EPI = false, bool SP2 = false>
__device__ __forceinline__ void gemm_phase(PG8_LAS unsigned char* lds, const Gemm g, const Sched& S, const Epi& E, int tid_in) {
    int tid = tid_in; asm volatile("" : "+v"(tid));
    const int wid = __builtin_amdgcn_readfirstlane(tid >> 6), lane = tid & 63, wr = wid >> 2, wc = wid & 3, fr = lane & 15, fq = lane >> 4;
    const int K = g.K, nt = K / BK;
    unsigned voffA[2], voffB[2];
#pragma unroll
    for (int i = 0; i < 2; ++i) { int R, C; stage_rc(tid * 16 + i * 8192, R, C); const int Rb = E.perm ? ((R & ~31) + perm32(R & 31)) : R;
        voffA[i] = (unsigned)(R * K + C) * 2u; voffB[i] = (unsigned)(Rb * K + C) * 2u; }
    const size_t kstep = (size_t)(BK * 2);
    const size_t hstep = (size_t)HALF * K * 2;
    const size_t tstep = 2 * hstep; const size_t tstepA = (size_t)g.trows * K * 2;
    const unsigned ldsw = (unsigned)wid * 1024u;
    const int aoff = lds_byte(wr * 64 + fr, fq * 8), boff = lds_byte(wc * 32 + fr, fq * 8);
#define PG8_SA(b, h) (((b) * 2 + (h)) * HTB)
#define PG8_SB(b, h) ((4 + (b) * 2 + (h)) * HTB)
#define PG8_STAGE(bufoff, gbase, voff) do { _Pragma("unroll") for (int _i = 0; _i < 2; ++_i) \
        __builtin_amdgcn_global_load_lds((const unsigned*)((const char*)(gbase) + (voff)[_i]), (PG8_LAS unsigned*)(lds + (bufoff) + ldsw + _i * 8192), 16, 0, 0); } while (0)
#define PG8_LDA(dst, b, h) do { _Pragma("unroll") for (int m = 0; m < 4; ++m) _Pragma("unroll") for (int k = 0; k < 2; ++k) dst[m][k] = *(const PG8_LAS bf16x8*)(lds + PG8_SA(b, h) + aoff + m * 2048 + k * 1024); } while (0)
#define PG8_LDB(dst, b, h) do { _Pragma("unroll") for (int n = 0; n < 2; ++n) _Pragma("unroll") for (int k = 0; k < 2; ++k) dst[n][k] = *(const PG8_LAS bf16x8*)(lds + PG8_SB(b, h) + boff + n * 2048 + k * 1024); } while (0)
#define PG8_MMA(ai, bj, At, Bt) do { __builtin_amdgcn_s_setprio(1); _Pragma("unroll") for (int m = 0; m < 4; ++m) _Pragma("unroll") for (int n = 0; n < 2; ++n) _Pragma("unroll") for (int k = 0; k < 2; ++k) \
        acc[ai][bj][m][n] = __builtin_amdgcn_mfma_f32_16x16x32_bf16(Bt[n][k], At[m][k], acc[ai][bj][m][n], 0, 0, 0); __builtin_amdgcn_s_setprio(0); } while (0)
#define PG8_WAIT_V(n) asm volatile("s_waitcnt vmcnt(" #n ")" ::: "memory")
#define PG8_WAIT_L(n) asm volatile("s_waitcnt lgkmcnt(" #n ")" ::: "memory")
#define PG8_BAR __builtin_amdgcn_s_barrier()
#define PG8_SCHED __builtin_amdgcn_sched_barrier(0)
    Unit cur, nxt; int ui = 0;
    if (!S.next(0, cur)) return;
    f32x4 acc[2][2][4][2];
#pragma unroll
    for (int a = 0; a < 2; ++a)
#pragma unroll
        for (int b = 0; b < 2; ++b)
#pragma unroll
            for (int m = 0; m < 4; ++m)
#pragma unroll
                for (int n = 0; n < 2; ++n) acc[a][b][m][n] = (f32x4){0.f, 0.f, 0.f, 0.f};
    bf16x8 At[4][2], B0[2][2], B1[2][2];
    const char* cA = (const char*)g.A + (size_t)cur.pm * tstepA; const char* cB = (const char*)g.Bt + (size_t)cur.pn * tstep;
    S.a_ready(cur);
    if constexpr (SP2) {
        PG8_STAGE(PG8_SB(0, 0), cB, voffB); PG8_STAGE(PG8_SB(0, 1), cB + hstep, voffB); PG8_STAGE(PG8_SA(0, 0), cA, voffA); PG8_STAGE(PG8_SA(0, 1), cA + hstep, voffA);
        if (wr == 1) PG8_BAR;
        PG8_WAIT_V(2); PG8_BAR;
        PG8_STAGE(PG8_SB(1, 0), cB + kstep, voffB); PG8_STAGE(PG8_SA(1, 0), cA + kstep, voffA); PG8_STAGE(PG8_SB(1, 1), cB + hstep + kstep, voffB);
        PG8_WAIT_V(6); PG8_BAR;
    } else {
        PG8_STAGE(PG8_SB(0, 0), cB, voffB); PG8_STAGE(PG8_SA(0, 0), cA, voffA); PG8_STAGE(PG8_SB(0, 1), cB + hstep, voffB); PG8_STAGE(PG8_SA(0, 1), cA + hstep, voffA);
        if (wr == 1) PG8_BAR;
        PG8_WAIT_V(4); PG8_BAR;
        PG8_STAGE(PG8_SB(1, 0), cB + kstep, voffB); PG8_STAGE(PG8_SA(1, 0), cA + kstep, voffA); PG8_STAGE(PG8_SB(1, 1), cB + hstep + kstep, voffB);
        PG8_WAIT_V(6); PG8_BAR;
    }
    for (;;) {
        const bool has_next = S.next(ui + 1, nxt);
        const char* nA = has_next ? (const char*)g.A + (size_t)nxt.pm * tstepA : cA; const char* nB = has_next ? (const char*)g.Bt + (size_t)nxt.pn * tstep : cB;
        for (int t = 0; t < nt; t += 2) {
            const bool last = (t == nt - 2);
            const char* a1 = cA + (size_t)(t + 1) * kstep;
            const char* a2 = last ? nA : cA + (size_t)(t + 2) * kstep; const char* b2 = last ? nB : cB + (size_t)(t + 2) * kstep;
            const char* a3 = a2 + kstep; const char* b3 = b2 + kstep;
            if (last && has_next) S.a_ready(nxt);
            if constexpr (SP2) {
            PG8_LDB(B0, 0, 0); PG8_LDB(B1, 0, 1); PG8_SCHED; PG8_LDA(At, 0, 0); PG8_STAGE(PG8_SA(1, 1), a1 + hstep, voffA);
            PG8_WAIT_V(8); PG8_WAIT_L(0); PG8_BAR; PG8_MMA(0, 0, At, B0); PG8_MMA(0, 1, At, B1); PG8_BAR; PG8_SCHED;
            PG8_LDA(At, 0, 1); PG8_STAGE(PG8_SB(0, 0), b2, voffB); PG8_STAGE(PG8_SB(0, 1), b2 + hstep, voffB); PG8_STAGE(PG8_SA(0, 0), a2, voffA);
            PG8_WAIT_V(8); PG8_WAIT_L(0); PG8_BAR; PG8_MMA(1, 0, At, B0); PG8_MMA(1, 1, At, B1); PG8_BAR; PG8_SCHED;
            PG8_LDB(B0, 1, 0); PG8_LDB(B1, 1, 1); PG8_SCHED; PG8_LDA(At, 1, 0); PG8_STAGE(PG8_SA(0, 1), a2 + hstep, voffA);
            PG8_WAIT_V(8); PG8_WAIT_L(0); PG8_BAR; PG8_MMA(0, 0, At, B0); PG8_MMA(0, 1, At, B1); PG8_BAR; PG8_SCHED;
            PG8_LDA(At, 1, 1); PG8_STAGE(PG8_SB(1, 0), b3, voffB); PG8_STAGE(PG8_SB(1, 1), b3 + hstep, voffB); PG8_STAGE(PG8_SA(1, 0), a3, voffA);
            PG8_WAIT_V(8); PG8_WAIT_L(0); PG8_BAR; PG8_MMA(1, 0, At, B0); PG8_MMA(1, 1, At, B1); PG8_BAR; PG8_SCHED;
            } else {
            PG8_LDB(B0, 0, 0); PG8_SCHED; PG8_LDA(At, 0, 0); PG8_STAGE(PG8_SA(1, 1), a1 + hstep, voffA);
            PG8_WAIT_L(8); PG8_BAR; PG8_WAIT_L(0); PG8_MMA(0, 0, At, B0); PG8_BAR; PG8_SCHED;
            PG8_LDB(B1, 0, 1); PG8_STAGE(PG8_SB(0, 0), b2, voffB);
            PG8_BAR; PG8_WAIT_L(0); PG8_MMA(0, 1, At, B1); PG8_BAR;
            PG8_LDA(At, 0, 1); PG8_STAGE(PG8_SA(0, 0), a2, voffA);
            PG8_BAR; PG8_WAIT_L(0); PG8_MMA(1, 0, At, B0); PG8_BAR; PG8_SCHED;
            PG8_STAGE(PG8_SB(0, 1), b2 + hstep, voffB);
            PG8_WAIT_V(6); PG8_BAR; PG8_MMA(1, 1, At, B1); PG8_BAR;
            PG8_LDB(B0, 1, 0); PG8_SCHED; PG8_LDA(At, 1, 0); PG8_STAGE(PG8_SA(0, 1), a2 + hstep, voffA);
            PG8_WAIT_L(8); PG8_BAR; PG8_WAIT_L(0); PG8_MMA(0, 0, At, B0); PG8_BAR; PG8_SCHED;
            PG8_LDB(B1, 1, 1); PG8_STAGE(PG8_SB(1, 0), b3, voffB);
            PG8_BAR; PG8_WAIT_L(0); PG8_MMA(0, 1, At, B1); PG8_BAR;
            PG8_LDA(At, 1, 1); PG8_STAGE(PG8_SA(1, 0), a3, voffA);
            PG8_BAR; PG8_WAIT_L(0); PG8_MMA(1, 0, At, B0); PG8_BAR; PG8_SCHED;
            PG8_STAGE(PG8_SB(1, 1), b3 + hstep, voffB);
            PG8_WAIT_V(6); PG8_BAR; PG8_MMA(1, 1, At, B1); PG8_BAR;
            }
        }
        if constexpr (ALIGN_EPI) { if (wr == 0) PG8_BAR; }
        if constexpr (!Epi::AFTER_DRAIN) { E(acc, cur, wr, wc, fr, fq); S.done(cur); }
        if (!has_next) break;
#pragma unroll
        for (int a = 0; a < 2; ++a)
#pragma unroll
            for (int b = 0; b < 2; ++b)
#pragma unroll
                for (int m = 0; m < 4; ++m)
#pragma unroll
                    for (int n = 0; n < 2; ++n) acc[a][b][m][n] = (f32x4){0.f, 0.f, 0.f, 0.f};
        cur = nxt; cA = nA; cB = nB; ++ui;
        if constexpr (ALIGN_EPI) { if (wr == 1) PG8_BAR; }
    }
    PG8_WAIT_V(0);
    if constexpr (!ALIGN_EPI) { if (wr == 0) PG8_BAR; }
    PG8_BAR;
    if constexpr (Epi::AFTER_DRAIN) { E.fused(acc, cur, wr, wc, fr, fq, lds, wid, lane); S.done(cur); }
#undef PG8_SA
#undef PG8_SB
#undef PG8_STAGE
#undef PG8_LDA
#undef PG8_LDB
#undef PG8_MMA
#undef PG8_WAIT_V
#undef PG8_WAIT_L
#undef PG8_BAR
#undef PG8_SCHED
}
}

namespace {
constexpr int D = 1024, BATCH = 8, SEQ = 2048, NMETA = 16, TP = SEQ + NMETA, MP = BATCH * TP, SB = 128, M = MP + SB;
constexpr int DEPTH = 4, RH = 4, RDK = 256, RDV = 512, RV = 2048, RWIN = 6144;
constexpr int WH = 16, WN = 64, LW = 64, LA = 64, LV = 32, LG = 160, DFF = 2816;
constexpr int NRW = 3584, KRW = 2048, KL2 = 384, NL2 = 4096;
constexpr float PAST_POS = 16384.f;
constexpr int NWAVES = 8, NTHR = 512;
constexpr int LDS_BYTES = 147456;

constexpr size_t O_YP = 0;
constexpr size_t O_YS = O_YP + (size_t)BATCH * SEQ * D;
constexpr size_t O_RETP = O_YS + (size_t)SB * D;
constexpr size_t O_WKVP = O_RETP + (size_t)2 * BATCH * RH * RDK * RDV;
constexpr size_t O_SHP = O_WKVP + (size_t)2 * BATCH * WH * WN * WN;
constexpr size_t O_CVP = O_SHP + (size_t)2 * BATCH * D;
constexpr size_t O_RETS = O_CVP + (size_t)DEPTH * BATCH * 2 * DFF;
constexpr size_t O_WKVS = O_RETS + (size_t)2 * SB * RH * RDK * RDV;
constexpr size_t O_SHS = O_WKVS + (size_t)2 * SB * WH * WN * WN;
constexpr size_t O_CVS = O_SHS + (size_t)2 * SB * D;

enum { I_XP = 0, I_XS, I_SRET, I_SWKV, I_SSHIFT, I_SCONV, I_META, I_NMIX, I_NFFN, I_NFIN, I_RWIN, I_RGN, I_RWOUT, I_MU, I_WRKV, I_W0, I_W1, I_W2,
       I_A0, I_A1, I_A2, I_V0, I_V1, I_V2, I_G1, I_G2, I_KK, I_KA, I_RK, I_LNW, I_LNB, I_WO, I_WUG, I_CW, I_CB, I_WD, N_IN };

constexpr size_t al256(size_t x) { return (x + 255) & ~(size_t)255; }
constexpr size_t WS_CTL = 0;
constexpr size_t WS_CS = 1u << 20;
constexpr size_t WS_WIN = 4u << 20;
constexpr size_t SZ_WIN = (size_t)RWIN * D * 2;
constexpr size_t WS_WOUT = WS_WIN + 2 * SZ_WIN;
constexpr size_t SZ_WOUT = (size_t)D * RV * 2;
constexpr size_t WS_WRW = WS_WOUT + 2 * SZ_WOUT;
constexpr size_t SZ_WRW = (size_t)NRW * KRW * 2;
constexpr size_t WS_WL2 = WS_WRW + 2 * SZ_WRW;
constexpr size_t SZ_WL2 = (size_t)NL2 * KL2 * 2;
constexpr size_t WS_WO = WS_WL2 + 2 * SZ_WL2;
constexpr size_t SZ_WO = (size_t)D * D * 2;
constexpr size_t WS_WUG = WS_WO + 2 * SZ_WO;
constexpr size_t SZ_WUG = (size_t)2 * DFF * D * 2;
constexpr size_t WS_WD = WS_WUG + 4 * SZ_WUG;
constexpr size_t SZ_WD = (size_t)D * DFF * 2;
constexpr size_t WS_X = al256(WS_WD + 4 * SZ_WD);
constexpr size_t SZ_MD4 = (size_t)M * D * 4;
constexpr size_t WS_H = WS_X + SZ_MD4;
constexpr size_t WS_VF = WS_H + SZ_MD4;
constexpr size_t WS_REG = WS_VF + SZ_MD4;
constexpr size_t WS_QK = WS_REG;
constexpr size_t WS_V = WS_QK + SZ_MD4;
constexpr size_t WS_SG = WS_V + SZ_MD4;
constexpr size_t WS_O = WS_SG + SZ_MD4;
constexpr size_t WS_Y = WS_O + 2 * SZ_MD4;
constexpr size_t WS_R = WS_REG;
constexpr size_t WS_K = WS_R + SZ_MD4;
constexpr size_t WS_VB = WS_K + SZ_MD4;
constexpr size_t WS_WDEC = WS_VB + SZ_MD4;
constexpr size_t WS_NKK = WS_WDEC + SZ_MD4;
constexpr size_t WS_KKA = WS_NKK + SZ_MD4;
constexpr size_t WS_YW = WS_KKA + SZ_MD4;
constexpr size_t WS_L2 = WS_YW + SZ_MD4;
constexpr size_t WS_A2 = WS_L2 + 4 * SZ_MD4;
constexpr size_t WS_Z = al256(WS_A2 + (size_t)M * KL2 * 2);
constexpr size_t WS_RW_END = WS_Z + (size_t)M * D * 2;
constexpr size_t SZ_FF2 = (size_t)M * DFF * 2;
constexpr size_t WS_U = WS_REG;
constexpr size_t WS_G = al256(WS_U + SZ_FF2);
constexpr size_t WS_ACT = al256(WS_G + SZ_FF2);
constexpr size_t WS_XB = al256(WS_RW_END) + 2 * (size_t)D * 2;
constexpr size_t WS_SS = al256(WS_XB + (size_t)(M + 126) * D * 2);
constexpr size_t WS_PTRS = al256(WS_SS + (size_t)8 * M * 16 * 4);
constexpr size_t WS_END = WS_PTRS + 256;

#define LAS __attribute__((address_space(3)))
typedef unsigned short bf16;
typedef unsigned v4u __attribute__((ext_vector_type(4)));
typedef unsigned v2u __attribute__((ext_vector_type(2)));
using pg8::f32x4;
using pg8::Unit;
using pg8::bf16x8;

struct Params { const float* in[N_IN]; float* out; unsigned char* ws; };

__device__ __forceinline__ unsigned cvt_pk_bf16(float lo, float hi) { unsigned r; asm("v_cvt_pk_bf16_f32 %0, %1, %2" : "=v"(r) : "v"(lo), "v"(hi)); return r; }
__device__ __forceinline__ float bf_lo(unsigned w) { return __uint_as_float(w << 16); }
__device__ __forceinline__ float bf_hi(unsigned w) { return __uint_as_float(w & 0xffff0000u); }
__device__ __forceinline__ void unpack8(const v4u w, float (&f)[8]) { f[0] = bf_lo(w.x); f[1] = bf_hi(w.x); f[2] = bf_lo(w.y); f[3] = bf_hi(w.y); f[4] = bf_lo(w.z); f[5] = bf_hi(w.z); f[6] = bf_lo(w.w); f[7] = bf_hi(w.w); }
__device__ __forceinline__ v4u pack8(const float (&f)[8]) { v4u w; w.x = cvt_pk_bf16(f[0], f[1]); w.y = cvt_pk_bf16(f[2], f[3]); w.z = cvt_pk_bf16(f[4], f[5]); w.w = cvt_pk_bf16(f[6], f[7]); return w; }
__device__ __forceinline__ f32x4 ld_bf4(const bf16* q) { const v2u w = *(const v2u*)q; return (f32x4){bf_lo(w.x), bf_hi(w.x), bf_lo(w.y), bf_hi(w.y)}; }
__device__ __forceinline__ void st_bf4(bf16* q, const f32x4 v) { v2u w; w.x = cvt_pk_bf16(v.x, v.y); w.y = cvt_pk_bf16(v.z, v.w); *(v2u*)q = w; }
__device__ __forceinline__ float shfl_xor_l(float v, int m, int lane) { return __int_as_float(__builtin_amdgcn_ds_bpermute((lane ^ m) << 2, __float_as_int(v))); }
__device__ __forceinline__ float shfl_l(float v, int src) { return __int_as_float(__builtin_amdgcn_ds_bpermute(src << 2, __float_as_int(v))); }
__device__ __forceinline__ float wave_sum(float v, int) {
    v += __builtin_bit_cast(float, __builtin_amdgcn_update_dpp(0, __float_as_int(v), 0x128, 0xf, 0xf, false));
    v += __builtin_bit_cast(float, __builtin_amdgcn_update_dpp(0, __float_as_int(v), 0x124, 0xf, 0xf, false));
    v += __builtin_bit_cast(float, __builtin_amdgcn_update_dpp(0, __float_as_int(v), 0x122, 0xf, 0xf, false));
    v += __builtin_bit_cast(float, __builtin_amdgcn_update_dpp(0, __float_as_int(v), 0x121, 0xf, 0xf, false));
    const int vi = __float_as_int(v);
    return (__int_as_float(__builtin_amdgcn_readlane(vi, 0)) + __int_as_float(__builtin_amdgcn_readlane(vi, 16))) + (__int_as_float(__builtin_amdgcn_readlane(vi, 32)) + __int_as_float(__builtin_amdgcn_readlane(vi, 48)));
}
__device__ __forceinline__ float rcpf_(float x) { return __builtin_amdgcn_rcpf(x); }
__device__ __forceinline__ float sigmoidf_(float x) { return rcpf_(1.f + __expf(-x)); }
__device__ __forceinline__ float siluf_(float x) { return x * rcpf_(1.f + __expf(-x)); }
__device__ __forceinline__ float tanhf_(float x) { return 1.f - 2.f * rcpf_(1.f + __expf(2.f * x)); }

__device__ __forceinline__ float row_rstd(const unsigned char* ws, int slot, int row) {
    const f32x4* q = (const f32x4*)((const float*)(ws + WS_SS) + ((size_t)slot * M + row) * 16);
    const f32x4 a = q[0], b = q[1], c = q[2], d = q[3];
    const float ss = (((a.x + a.y) + (a.z + a.w)) + ((b.x + b.y) + (b.z + b.w))) + (((c.x + c.y) + (c.z + c.w)) + ((d.x + d.y) + (d.z + d.w)));
    return rsqrtf(ss * (1.f / D) + 1e-6f);
}
__device__ __forceinline__ float dpp_ror1(float v) { return __int_as_float(__builtin_amdgcn_update_dpp(0, __float_as_int(v), 0x121, 0xf, 0xf, false)); }
__device__ __forceinline__ float dpp_ror2(float v) { return __int_as_float(__builtin_amdgcn_update_dpp(0, __float_as_int(v), 0x122, 0xf, 0xf, false)); }
enum { EK_RETIN = 0, EK_RESID, EK_UG, EK_RWPROJ, EK_F32 };
template <int GRP> struct EpiExtra {};
template <> struct EpiExtra<1> { const float* pcw; const float* pcb; const float* pcst; float* pout; };
template <int GRP> struct EpiAnyT : EpiExtra<GRP> {
    static constexpr bool AFTER_DRAIN = false;
    int kind; bool perm; int jl; unsigned char* ws; int slot; const LAS float* rtab; float amul; int li; LAS unsigned char* ldsb;
    __device__ __forceinline__ void operator()(const f32x4 (&acc)[2][2][4][2], const Unit& u, int wr, int wc, int fr, int fq) const {
        const int row0 = u.pm * 256 + wr * 64 + fr;
        if (GRP == 0 && kind == EK_RETIN) {
            bf16* QK = (bf16*)(ws + WS_QK); bf16* V = (bf16*)(ws + WS_V); bf16* SG = (bf16*)(ws + WS_SG); const float* CS = (const float*)(ws + WS_CS);
            const int cw = wc * 32 + 8 * fq;
            if (u.pn < 8) {
                const bool isk = u.pn >= 4; const int h = u.pn & 3; const float sc = isk ? 0.0625f : 1.f;
                bf16* base = QK + (isk ? 1024 : 0) + h * 256 + cw;
#pragma unroll
                for (int ai = 0; ai < 2; ++ai) {
                    f32x4 tt[4][4];
#pragma unroll
                    for (int m = 0; m < 4; ++m) { const int row = row0 + ai * 128 + m * 16; const int pi = row < MP ? row % TP : TP;
                        const f32x4* cs = (const f32x4*)(CS + ((size_t)pi * 128 + cw) * 2);
#pragma unroll
                        for (int q4 = 0; q4 < 4; ++q4) tt[m][q4] = cs[q4]; }
#pragma unroll
                    for (int m = 0; m < 4; ++m) {
                        const int row = row0 + ai * 128 + m * 16;
                        const float rs = rtab[u.ord * 256 + (row - u.pm * 256)] * sc;
                        const f32x4 t0 = tt[m][0], t1 = tt[m][1], t2 = tt[m][2], t3 = tt[m][3];
                        const float c[8] = {t0.x, t0.z, t1.x, t1.z, t2.x, t2.z, t3.x, t3.z}, s[8] = {t0.y, t0.w, t1.y, t1.w, t2.y, t2.w, t3.y, t3.w};
                        float o1[8], o2[8];
#pragma unroll
                        for (int n = 0; n < 2; ++n)
#pragma unroll
                            for (int j = 0; j < 4; ++j) {
                                const float x1 = acc[ai][0][m][n][j], x2 = acc[ai][1][m][n][j];
                                o1[n * 4 + j] = (x1 * c[n * 4 + j] - x2 * s[n * 4 + j]) * rs;
                                o2[n * 4 + j] = (x1 * s[n * 4 + j] + x2 * c[n * 4 + j]) * rs;
                            }
                        bf16* rp = base + (size_t)row * 2048;
                        *(v4u*)rp = pack8(o1); *(v4u*)(rp + 128) = pack8(o2);
                    }
                    asm volatile("" ::: "memory");
                }
            } else {
                const bool isg = u.pn >= 16;
                bf16* base = (isg ? SG : V) + ((u.pn - (isg ? 16 : 8)) * 256) + cw;
#pragma unroll
                for (int ai = 0; ai < 2; ++ai)
#pragma unroll
                    for (int m = 0; m < 4; ++m) {
                        bf16* rp = base + (size_t)(row0 + ai * 128 + m * 16) * 2048;
                        const float rs = rtab[u.ord * 256 + (wr * 64 + fr + ai * 128 + m * 16)];
#pragma unroll
                        for (int bj = 0; bj < 2; ++bj) {
                            float o[8];
#pragma unroll
                            for (int n = 0; n < 2; ++n)
#pragma unroll
                                for (int j = 0; j < 4; ++j) { const float x = acc[ai][bj][m][n][j] * rs; o[n * 4 + j] = isg ? siluf_(x) : x; }
                            *(v4u*)(rp + bj * 128) = pack8(o);
                        }
                    }
            }
        } else if (GRP == 0 && kind == EK_RESID) {
            float* X = (float*)(ws + WS_X);
            const int col0 = u.pn * 256 + wc * 32 + 4 * fq;
#pragma unroll
            for (int am = 0; am < 4; ++am) { const int ai = am >> 1, mb = (am & 1) * 2;
                f32x4 xv[2][2][2];
#pragma unroll
                for (int mm = 0; mm < 2; ++mm) { const int m = mb + mm; const float* rp = X + (size_t)(row0 + ai * 128 + m * 16) * D + col0;
#pragma unroll
                    for (int bj = 0; bj < 2; ++bj)
#pragma unroll
                        for (int n = 0; n < 2; ++n) xv[mm][bj][n] = *(const f32x4*)(rp + bj * 128 + n * 16); }
#pragma unroll
                for (int mm = 0; mm < 2; ++mm) { const int m = mb + mm;
                    const int row = row0 + ai * 128 + m * 16;
                    float* rp = X + (size_t)row * D + col0; bf16* xb = (bf16*)(ws + WS_XB) + (size_t)row * D + col0;
                    float ssq = 0.f;
#pragma unroll
                    for (int bj = 0; bj < 2; ++bj)
#pragma unroll
                        for (int n = 0; n < 2; ++n) { const f32x4 v = xv[mm][bj][n] + acc[ai][bj][m][n] * amul; *(f32x4*)(rp + bj * 128 + n * 16) = v;
                            if (slot >= 0) { ssq += (v.x * v.x + v.y * v.y) + (v.z * v.z + v.w * v.w); v2u w; w.x = cvt_pk_bf16(v.x, v.y); w.y = cvt_pk_bf16(v.z, v.w); *(v2u*)(xb + bj * 128 + n * 16) = w; } }
                    if (slot >= 0) { ssq += shfl_xor_l(ssq, 16, fq * 16 + fr); ssq += shfl_xor_l(ssq, 32, fq * 16 + fr); if (fq == 0) ((float*)(ws + WS_SS))[((size_t)slot * M + row) * 16 + u.pn * 4 + wc] = ssq; }
                }
                asm volatile("" ::: "memory");
            }
        } else if (GRP == 1 && kind == EK_UG) {
            const EpiExtra<1>& X1 = *(const EpiExtra<1>*)(const void*)this;
            const float* cw = X1.pcw + (size_t)li * 3 * DFF; const float* cb = X1.pcb + (size_t)li * DFF; const float* cst = X1.pcst + (size_t)li * SB * 2 * DFF;
            float* cvp = X1.pout + O_CVP + (size_t)li * BATCH * 2 * DFF; float* cvs = X1.pout + O_CVS + (size_t)li * SB * 2 * DFF;
            bf16* ACT = (bf16*)(ws + WS_ACT);
            const int fl = wc * 32 + 8 * fq;
            LAS float* halo = (LAS float*)(ldsb + 131072 + 8192);
            const LAS float* rt = rtab + u.ord * 256;
#pragma unroll
            for (int ai = 0; ai < 2; ++ai) if (fr >= 14) {
                const float rs = rt[128 * ai + 64 * wr + 48 + fr];
                LAS float* hp = halo + ((2 * ai + wr) * 2 + (fr - 14)) * 128 + fl;
                *(LAS f32x4*)hp = acc[ai][1][3][0] * rs; *(LAS f32x4*)(hp + 4) = acc[ai][1][3][1] * rs;
            }
            asm volatile("s_waitcnt lgkmcnt(0)" ::: "memory"); __builtin_amdgcn_s_barrier(); asm volatile("" ::: "memory");
#pragma unroll
            for (int n = 0; n < 2; ++n) {
                const int f0 = u.pn * 128 + fl + 4 * n;
                const f32x4 w0 = *(const f32x4*)(cw + f0), w1 = *(const f32x4*)(cw + DFF + f0), w2 = *(const f32x4*)(cw + 2 * DFF + f0), bb = *(const f32x4*)(cb + f0);
                f32x4 prev = (f32x4){0.f, 0.f, 0.f, 0.f};
#pragma unroll
                for (int ai = 0; ai < 2; ++ai)
#pragma unroll
                    for (int m = 0; m < 4; ++m) {
                        const int l = 128 * ai + 64 * wr + 16 * m + fr, row = 254 * u.pm - 2 + l;
                        const float rs = rt[l];
                        const f32x4 cur = acc[ai][1][m][n] * rs, uu = acc[ai][0][m][n] * rs;
                        if (m == 0) {
                            const int B = 2 * ai + wr;
                            prev = (f32x4){0.f, 0.f, 0.f, 0.f};
                            if (B > 0 && fr >= 14) prev = *(const LAS f32x4*)(halo + ((B - 1) * 2 + (fr - 14)) * 128 + fl + 4 * n);
                        }
                        f32x4 g1, g2;
                        {
                            const float c1x = dpp_ror1(cur.x), c1y = dpp_ror1(cur.y), c1z = dpp_ror1(cur.z), c1w = dpp_ror1(cur.w);
                            const float p1x = dpp_ror1(prev.x), p1y = dpp_ror1(prev.y), p1z = dpp_ror1(prev.z), p1w = dpp_ror1(prev.w);
                            const float c2x = dpp_ror2(cur.x), c2y = dpp_ror2(cur.y), c2z = dpp_ror2(cur.z), c2w = dpp_ror2(cur.w);
                            const float p2x = dpp_ror2(prev.x), p2y = dpp_ror2(prev.y), p2z = dpp_ror2(prev.z), p2w = dpp_ror2(prev.w);
                            const bool s1 = fr >= 1, s2 = fr >= 2;
                            g1.x = s1 ? c1x : p1x; g1.y = s1 ? c1y : p1y; g1.z = s1 ? c1z : p1z; g1.w = s1 ? c1w : p1w;
                            g2.x = s2 ? c2x : p2x; g2.y = s2 ? c2y : p2y; g2.z = s2 ? c2z : p2z; g2.w = s2 ? c2w : p2w;
                        }
                        if (l >= 2 && row < M) {
                            if (row < MP) {
                                const int b = row / TP, t = row - b * TP;
                                if (t < 2) { g2 = (f32x4){0.f, 0.f, 0.f, 0.f}; if (t == 0) g1 = g2; }
                                if (t >= TP - 2) *(f32x4*)(cvp + ((size_t)b * 2 + (t - (TP - 2))) * DFF + f0) = cur;
                            } else {
                                const int s = row - MP;
                                const float* c0 = cst + ((size_t)s * 2 + 0) * DFF + f0;
                                g2 = *(const f32x4*)c0; g1 = *(const f32x4*)(c0 + DFF);
                                float* o = cvs + ((size_t)s * 2 + 0) * DFF + f0;
                                *(f32x4*)o = g1; *(f32x4*)(o + DFF) = cur;
                            }
                            const f32x4 cv = bb + w0 * g2 + w1 * g1 + w2 * cur;
                            v2u w; w.x = cvt_pk_bf16(siluf_(cv.x) * uu.x, siluf_(cv.y) * uu.y); w.y = cvt_pk_bf16(siluf_(cv.z) * uu.z, siluf_(cv.w) * uu.w);
                            *(v2u*)(ACT + (size_t)row * DFF + f0) = w;
                        }
                        prev = cur;
                    }
            }
        } else if (GRP == 0 && kind == EK_RWPROJ) {
            const int cw = wc * 32 + 8 * fq;
            if (u.pn < 12) {
                bf16* dst = (bf16*)(ws + (u.pn < 4 ? WS_R : (u.pn < 8 ? WS_K : (jl == 0 ? WS_VF : WS_VB)))) + (u.pn & 3) * 256 + cw;
#pragma unroll
                for (int ai = 0; ai < 2; ++ai)
#pragma unroll
                    for (int m = 0; m < 4; ++m) {
                        bf16* rp = dst + (size_t)(row0 + ai * 128 + m * 16) * D;
#pragma unroll
                        for (int bj = 0; bj < 2; ++bj) { float o[8];
#pragma unroll
                            for (int n = 0; n < 2; ++n)
#pragma unroll
                                for (int j = 0; j < 4; ++j) o[n * 4 + j] = acc[ai][bj][m][n][j];
                            *(v4u*)(rp + bj * 128) = pack8(o); }
                    }
            } else {
                bf16* A2 = (bf16*)(ws + WS_A2);
#pragma unroll
                for (int bj = 0; bj < 2; ++bj) {
                    const int c = (u.pn - 12) * 256 + bj * 128 + cw;
                    if (c < KL2) {
                        const int kd = c < 64 ? 1 : ((c >= 128 && c < 288) ? 2 : 0);
#pragma unroll
                        for (int ai = 0; ai < 2; ++ai)
#pragma unroll
                            for (int m = 0; m < 4; ++m) { float o[8];
#pragma unroll
                                for (int n = 0; n < 2; ++n)
#pragma unroll
                                    for (int j = 0; j < 4; ++j) { const float x = acc[ai][bj][m][n][j]; o[n * 4 + j] = kd == 1 ? tanhf_(x) : (kd == 2 ? sigmoidf_(x) : x); }
                                *(v4u*)(A2 + (size_t)(row0 + ai * 128 + m * 16) * KL2 + c) = pack8(o); }
                    }
                }
            }
        } else if (GRP == 0) {
            bf16* C = (bf16*)(ws + WS_L2);
            const int col0 = u.pn * 256 + wc * 32 + 8 * fq;
#pragma unroll
            for (int ai = 0; ai < 2; ++ai)
#pragma unroll
                for (int m = 0; m < 4; ++m) {
                    bf16* rp = C + (size_t)(row0 + ai * 128 + m * 16) * NL2 + col0;
#pragma unroll
                    for (int bj = 0; bj < 2; ++bj) { float o[8];
#pragma unroll
                        for (int n = 0; n < 2; ++n)
#pragma unroll
                            for (int j = 0; j < 4; ++j) o[n * 4 + j] = acc[ai][bj][m][n][j];
                        *(v4u*)(rp + bj * 128) = pack8(o); }
                }
        }
    }
};

constexpr int MT0 = 16384;
__device__ __forceinline__ void tail_resid(const bf16* __restrict__ A, const bf16* __restrict__ Bt, int K, unsigned char* ws, int slot, float amul, LAS unsigned char* lds, int lane, int wave) {
    const int fr = lane & 15, fq = lane >> 4;
    float* X = (float*)(ws + WS_X);
    const int kw = K >> 3;
    for (int job = blockIdx.x; job < 16 * 16; job += gridDim.x) {
        const int rs = job >> 4, cs = job & 15;
        const bf16* ap = A + (size_t)(MT0 + 16 * rs + fr) * K + wave * kw + 8 * fq;
        const bf16* bp = Bt + (size_t)(64 * cs + fr) * K + wave * kw + 8 * fq;
        f32x4 acc[4];
#pragma unroll
        for (int t = 0; t < 4; ++t) acc[t] = (f32x4){0.f, 0.f, 0.f, 0.f};
#pragma unroll 4
        for (int k0 = 0; k0 < kw; k0 += 32) {
            const bf16x8 af = *(const bf16x8*)(ap + k0);
#pragma unroll
            for (int t = 0; t < 4; ++t) { const bf16x8 bf = *(const bf16x8*)(bp + (size_t)(16 * t) * K + k0); acc[t] = __builtin_amdgcn_mfma_f32_16x16x32_bf16(bf, af, acc[t], 0, 0, 0); }
        }
        __syncthreads();
#pragma unroll
        for (int t = 0; t < 4; ++t) *(LAS f32x4*)(lds + ((wave * 4 + t) * 64 + lane) * 16) = acc[t];
        __syncthreads();
        if (wave == 0) {
#pragma unroll
            for (int t = 0; t < 4; ++t) { f32x4 s = acc[t];
#pragma unroll
                for (int w = 1; w < 8; ++w) s += *(LAS f32x4*)(lds + ((w * 4 + t) * 64 + lane) * 16);
                acc[t] = s; }
            const int row = MT0 + 16 * rs + fr;
            float* rp = X + (size_t)row * D + 64 * cs + 4 * fq; bf16* xb = (bf16*)(ws + WS_XB) + (size_t)row * D + 64 * cs + 4 * fq;
            float ssq = 0.f;
#pragma unroll
            for (int t = 0; t < 4; ++t) { const f32x4 v = *(const f32x4*)(rp + 16 * t) + acc[t] * amul; *(f32x4*)(rp + 16 * t) = v;
                if (slot >= 0) { ssq += (v.x * v.x + v.y * v.y) + (v.z * v.z + v.w * v.w); v2u w; w.x = cvt_pk_bf16(v.x, v.y); w.y = cvt_pk_bf16(v.z, v.w); *(v2u*)(xb + 16 * t) = w; } }
            if (slot >= 0) { ssq += shfl_xor_l(ssq, 16, lane); ssq += shfl_xor_l(ssq, 32, lane); if (fq == 0) ((float*)(ws + WS_SS))[((size_t)slot * M + row) * 16 + cs] = ssq; }
        }
    }
}

__device__ __forceinline__ void tr_item(const float* __restrict__ W, int ldw, int k0, int n0, bf16* __restrict__ WT, int ldt, int drow, const float* __restrict__ mu, LAS float* scr, int lane, const float* __restrict__ gs = nullptr) {
#pragma unroll 8
    for (int i = 0; i < 32; ++i) { const int kk = 2 * i + (lane >> 5); scr[kk * 33 + (lane & 31)] = W[(size_t)(k0 + kk) * ldw + n0 + (lane & 31)]; }
    asm volatile("s_waitcnt lgkmcnt(0)" ::: "memory");
    const int c = lane & 7;
    float mv[8];
    if (mu) {
#pragma unroll
        for (int e = 0; e < 8; ++e) mv[e] = mu[k0 + 8 * c + e];
    } else if (gs) {
#pragma unroll
        for (int e = 0; e < 8; ++e) mv[e] = gs[k0 + 8 * c + e];
    }
#pragma unroll
    for (int j = 0; j < 4; ++j) {
        const int n = (lane >> 3) + 8 * j; const LAS float* s = scr + (8 * c) * 33 + n;
        float f[8];
#pragma unroll
        for (int e = 0; e < 8; ++e) f[e] = s[e * 33];
        bf16* dp = WT + (size_t)(drow + n) * ldt + k0 + 8 * c;
        if (mu) {
            float f1[8], f2[8];
#pragma unroll
            for (int e = 0; e < 8; ++e) { f1[e] = f[e] * (1.f - mv[e]); f2[e] = f[e] * mv[e]; }
            *(v4u*)dp = pack8(f1); *(v4u*)(dp + 1024) = pack8(f2);
        } else { if (gs) {
#pragma unroll
            for (int e = 0; e < 8; ++e) f[e] *= mv[e]; }
            *(v4u*)dp = pack8(f); }
    }
    asm volatile("s_waitcnt lgkmcnt(0)" ::: "memory");
}

__device__ __forceinline__ void ph_p0(const Params& p, LAS unsigned char* lds, int tid, int lane, int wave) {
    unsigned char* ws = p.ws;
    LAS float* scr = (LAS float*)(lds + wave * 16384);
    const int gw = blockIdx.x * NWAVES + wave, NGW = gridDim.x * NWAVES;
    constexpr int C_WIN = 2 * 16 * 192, C_WOUT = 2 * 32 * 32, C_RKV = 2 * 3 * 512, C_W1 = 2 * 32, C_A1 = 2 * 32, C_G1 = 2 * 80, C_V1 = 16, C_WO = 2 * 512, C_WUG = 4 * 16 * 176, C_WD = 4 * 44 * 32;
    constexpr int NITEMS = C_WIN + C_WOUT + C_RKV + C_W1 + C_A1 + C_G1 + C_V1 + C_WO + C_WUG + C_WD;
    for (int it = gw; it < NITEMS; it += NGW) {
        int r = it;
        if (r < C_WIN) { const int j = r / 3072, q = r % 3072, kb = q / 192, nb = q % 192;
            tr_item(p.in[I_RWIN] + (size_t)j * D * RWIN, RWIN, 64 * kb, 32 * nb, (bf16*)(ws + WS_WIN + j * SZ_WIN), D, 32 * nb, nullptr, scr, lane, p.in[I_NMIX] + (size_t)(2 * j) * D); continue; }
        r -= C_WIN;
        if (r < C_WOUT) { const int j = r / 1024, q = r % 1024, kb = q / 32, nb = q % 32;
            tr_item(p.in[I_RWOUT] + (size_t)j * RV * D, D, 64 * kb, 32 * nb, (bf16*)(ws + WS_WOUT + j * SZ_WOUT), RV, 32 * nb, nullptr, scr, lane); continue; }
        r -= C_WOUT;
        if (r < C_RKV) { const int j = r / 1536, q = r % 1536, s = q / 512, q2 = q % 512, kb = q2 / 32, nb = q2 % 32, c = (s == 0 ? 0 : (s == 1 ? 2 : 3));
            tr_item(p.in[I_WRKV] + (size_t)(j * 3 + s) * D * D, D, 64 * kb, 32 * nb, (bf16*)(ws + WS_WRW + j * SZ_WRW), KRW, s * 1024 + 32 * nb, p.in[I_MU] + (size_t)(j * 6 + c) * D, scr, lane); continue; }
        r -= C_RKV;
        if (r < C_W1) { const int j = r / 32, q = r % 32, kb = q / 2, nb = q % 2;
            tr_item(p.in[I_W1] + (size_t)j * D * LW, LW, 64 * kb, 32 * nb, (bf16*)(ws + WS_WRW + j * SZ_WRW), KRW, 3072 + 32 * nb, p.in[I_MU] + (size_t)(j * 6 + 1) * D, scr, lane); continue; }
        r -= C_W1;
        if (r < C_A1) { const int j = r / 32, q = r % 32, kb = q / 2, nb = q % 2;
            tr_item(p.in[I_A1] + (size_t)j * D * LA, LA, 64 * kb, 32 * nb, (bf16*)(ws + WS_WRW + j * SZ_WRW), KRW, 3136 + 32 * nb, p.in[I_MU] + (size_t)(j * 6 + 4) * D, scr, lane); continue; }
        r -= C_A1;
        if (r < C_G1) { const int j = r / 80, q = r % 80, kb = q / 5, nb = q % 5;
            tr_item(p.in[I_G1] + (size_t)j * D * LG, LG, 64 * kb, 32 * nb, (bf16*)(ws + WS_WRW + j * SZ_WRW), KRW, 3200 + 32 * nb, p.in[I_MU] + (size_t)(j * 6 + 5) * D, scr, lane); continue; }
        r -= C_G1;
        if (r < C_V1) { const int kb = r;
            tr_item(p.in[I_V1], LV, 64 * kb, 0, (bf16*)(ws + WS_WRW + 1 * SZ_WRW), KRW, 3360, p.in[I_MU] + (size_t)(1 * 6 + 3) * D, scr, lane); continue; }
        r -= C_V1;
        if (r < C_WO) { const int j = r / 512, q = r % 512, kb = q / 32, nb = q % 32;
            tr_item(p.in[I_WO] + (size_t)j * D * D, D, 64 * kb, 32 * nb, (bf16*)(ws + WS_WO + j * SZ_WO), D, 32 * nb, nullptr, scr, lane); continue; }
        r -= C_WO;
        if (r < C_WUG) { const int i = r / 2816, q = r % 2816, kb = q / 176, nb = q % 176, n0 = 32 * nb;
            const int drow = n0 < DFF ? 256 * (n0 / 128) + (n0 % 128) : 256 * ((n0 - DFF) / 128) + 128 + ((n0 - DFF) % 128);
            tr_item(p.in[I_WUG] + (size_t)i * D * 2 * DFF, 2 * DFF, 64 * kb, n0, (bf16*)(ws + WS_WUG + i * SZ_WUG), D, drow, nullptr, scr, lane, p.in[I_NFFN] + (size_t)i * D); continue; }
        r -= C_WUG;
        { const int i = r / 1408, q = r % 1408, kb = q / 32, nb = q % 32;
            tr_item(p.in[I_WD] + (size_t)i * DFF * D, D, 64 * kb, 32 * nb, (bf16*)(ws + WS_WD + i * SZ_WD), DFF, 32 * nb, nullptr, scr, lane); }
    }
    const size_t gt = (size_t)blockIdx.x * NTHR + tid, GT = (size_t)gridDim.x * NTHR;
    for (size_t i = gt; i < (size_t)(224 + 192) * (KRW / 8); i += GT) {
        const int rr = (int)(i / (KRW / 8)), c8 = (int)(i % (KRW / 8));
        const int j = rr < 224 ? 0 : 1, row = rr < 224 ? 3360 + rr : 3392 + (rr - 224);
        *(v4u*)((bf16*)(ws + WS_WRW + j * SZ_WRW) + (size_t)row * KRW + c8 * 8) = (v4u){0u, 0u, 0u, 0u};
    }
    for (size_t i = gt; i < (size_t)2 * NL2 * KL2; i += GT) {
        const int j = (int)(i / ((size_t)NL2 * KL2)); const int rem = (int)(i % ((size_t)NL2 * KL2)); const int n = rem / KL2, k = rem % KL2, grp = n >> 10, nn = n & 1023;
        float v = 0.f;
        if (grp == 0) { if (k < 64) v = p.in[I_W2][((size_t)j * LW + k) * D + nn]; }
        else if (grp == 1) { if (k >= 64 && k < 128) v = p.in[I_A2][((size_t)j * LA + (k - 64)) * D + nn]; }
        else if (grp == 2) { if (k >= 128 && k < 288) v = p.in[I_G2][((size_t)j * LG + (k - 128)) * D + nn]; }
        else { if (j == 1 && k >= 288 && k < 320) v = p.in[I_V2][((size_t)(k - 288)) * D + nn]; }
        ((bf16*)(ws + WS_WL2 + j * SZ_WL2))[(size_t)n * KL2 + k] = (bf16)(cvt_pk_bf16(v, 0.f) & 0xffffu);
    }
    for (size_t i = gt; i < (size_t)(TP + 1) * 128; i += GT) {
        const int pi = (int)(i >> 7), mi = (int)(i & 127);
        const float pos = pi < TP ? (float)pi : PAST_POS;
        const float inv = 1.0f / powf(10000.0f, (float)mi / 127.0f);
        float s, c; sincosf(pos * inv, &s, &c);
        ((float2*)(ws + WS_CS))[i] = make_float2(c, s);
    }
    float* X = (float*)(ws + WS_X); bf16* XB = (bf16*)(ws + WS_XB);
    for (int r = gw; r < M; r += NGW) {
        const float* src;
        if (r < MP) { const int b = r / TP, t = r % TP; src = t < NMETA ? p.in[I_META] + (size_t)t * D : p.in[I_XP] + ((size_t)b * SEQ + (t - NMETA)) * D; }
        else src = p.in[I_XS] + (size_t)(r - MP) * D;
        float ss = 0.f;
#pragma unroll
        for (int j = 0; j < 2; ++j) { const int c0 = 512 * j + 8 * lane;
            const f32x4 a4 = *(const f32x4*)(src + c0), b4 = *(const f32x4*)(src + c0 + 4);
            *(f32x4*)(X + (size_t)r * D + c0) = a4; *(f32x4*)(X + (size_t)r * D + c0 + 4) = b4;
            const float f[8] = {a4.x, a4.y, a4.z, a4.w, b4.x, b4.y, b4.z, b4.w};
#pragma unroll
            for (int e = 0; e < 8; ++e) ss += f[e] * f[e];
            *(v4u*)(XB + (size_t)r * D + c0) = pack8(f); }
        ss = wave_sum(ss, lane);
        if (lane < 16) ((float*)(ws + WS_SS))[(size_t)r * 16 + lane] = lane == 0 ? ss : 0.f;
    }
}

__device__ __forceinline__ void ph_norm(const Params& p, const float* __restrict__ g, int mode, int jl, int lane, int wave) {
    const float* X = (const float*)(p.ws + WS_X); bf16* H = (bf16*)(p.ws + WS_H);
    const int gw = blockIdx.x * NWAVES + wave, NGW = gridDim.x * NWAVES;
    for (int row = gw; row < M; row += NGW) {
        const float* xr = X + (size_t)row * D;
        float v[2][8]; float ss = 0.f;
#pragma unroll
        for (int j = 0; j < 2; ++j) {
            const f32x4 a = *(const f32x4*)(xr + 512 * j + 8 * lane), b = *(const f32x4*)(xr + 512 * j + 8 * lane + 4);
            v[j][0] = a.x; v[j][1] = a.y; v[j][2] = a.z; v[j][3] = a.w; v[j][4] = b.x; v[j][5] = b.y; v[j][6] = b.z; v[j][7] = b.w;
#pragma unroll
            for (int e = 0; e < 8; ++e) ss += v[j][e] * v[j][e];
        }
        ss = wave_sum(ss, lane);
        const float rstd = rsqrtf(ss * (1.f / D) + 1e-6f);
        const bool prompt = row < MP; const int b = prompt ? row / TP : 0, t = prompt ? row % TP : 0;
#pragma unroll
        for (int j = 0; j < 2; ++j) {
            const int c0 = 512 * j + 8 * lane;
            const f32x4 ga = *(const f32x4*)(g + c0), gb = *(const f32x4*)(g + c0 + 4);
            float o[8];
            o[0] = v[j][0] * rstd * ga.x; o[1] = v[j][1] * rstd * ga.y; o[2] = v[j][2] * rstd * ga.z; o[3] = v[j][3] * rstd * ga.w;
            o[4] = v[j][4] * rstd * gb.x; o[5] = v[j][5] * rstd * gb.y; o[6] = v[j][6] * rstd * gb.z; o[7] = v[j][7] * rstd * gb.w;
            if (mode == 0) { *(v4u*)(H + (size_t)row * D + c0) = pack8(o); }
            else if (mode == 1) {
                const v4u w = pack8(o);
                *(v4u*)(H + (size_t)row * 2048 + c0) = w;
                if (prompt) {
                    if (t != TP - 1) *(v4u*)(H + (size_t)(row + 1) * 2048 + 1024 + c0) = w;
                    else { float* so = p.out + O_SHP + ((size_t)jl * BATCH + b) * D + c0; *(f32x4*)so = (f32x4){o[0], o[1], o[2], o[3]}; *(f32x4*)(so + 4) = (f32x4){o[4], o[5], o[6], o[7]}; }
                    if (t == 0) *(v4u*)(H + (size_t)row * 2048 + 1024 + c0) = (v4u){0u, 0u, 0u, 0u};
                } else {
                    const int s = row - MP;
                    const float* sp = p.in[I_SSHIFT] + ((size_t)jl * SB + s) * D + c0;
                    const f32x4 sa = *(const f32x4*)sp, sb2 = *(const f32x4*)(sp + 4);
                    const float pv[8] = {sa.x, sa.y, sa.z, sa.w, sb2.x, sb2.y, sb2.z, sb2.w};
                    *(v4u*)(H + (size_t)row * 2048 + 1024 + c0) = pack8(pv);
                    float* so = p.out + O_SHS + ((size_t)jl * SB + s) * D + c0; *(f32x4*)so = (f32x4){o[0], o[1], o[2], o[3]}; *(f32x4*)(so + 4) = (f32x4){o[4], o[5], o[6], o[7]};
                }
            } else {
                float* dst = nullptr;
                if (prompt) { if (t >= NMETA) dst = p.out + O_YP + ((size_t)b * SEQ + (t - NMETA)) * D + c0; }
                else dst = p.out + O_YS + (size_t)(row - MP) * D + c0;
                if (dst) { *(f32x4*)dst = (f32x4){o[0], o[1], o[2], o[3]}; *(f32x4*)(dst + 4) = (f32x4){o[4], o[5], o[6], o[7]}; }
            }
        }
    }
}

__device__ __forceinline__ void ph_ret_norm(const Params& p, int jl, int lane, int wave) {
    const float* O = (const float*)(p.ws + WS_O); const bf16* SG = (const bf16*)(p.ws + WS_SG); bf16* Y = (bf16*)(p.ws + WS_Y);
    const float* gnw = p.in[I_RGN] + (size_t)jl * RV;
    const int gw = blockIdx.x * NWAVES + wave, NGW = gridDim.x * NWAVES;
    for (int it = gw; it < M * RH; it += NGW) {
        const int row = it >> 2, h = it & 3; const size_t off = (size_t)row * RV + h * RDV + 8 * lane;
        const f32x4 a = *(const f32x4*)(O + off), b = *(const f32x4*)(O + off + 4);
        float v[8] = {a.x, a.y, a.z, a.w, b.x, b.y, b.z, b.w};
        float s = 0.f;
#pragma unroll
        for (int e = 0; e < 8; ++e) s += v[e];
        const float mean = wave_sum(s, lane) * (1.f / RDV);
        float s2 = 0.f;
#pragma unroll
        for (int e = 0; e < 8; ++e) { v[e] -= mean; s2 += v[e] * v[e]; }
        const float rstd = rsqrtf(wave_sum(s2, lane) * (1.f / RDV) + 1e-5f);
        float sg[8]; unpack8(*(const v4u*)(SG + off), sg);
        const f32x4 ga = *(const f32x4*)(gnw + h * RDV + 8 * lane), gb = *(const f32x4*)(gnw + h * RDV + 8 * lane + 4);
        const float gg[8] = {ga.x, ga.y, ga.z, ga.w, gb.x, gb.y, gb.z, gb.w};
        float o[8];
#pragma unroll
        for (int e = 0; e < 8; ++e) o[e] = v[e] * rstd * gg[e] * sg[e];
        *(v4u*)(Y + off) = pack8(o);
    }
}

__device__ __forceinline__ float row16_sum(float x);
__device__ __forceinline__ void ph_rwkv_post(const Params& p, int jl, int lane, int wave) {
    const float* YW = (const float*)(p.ws + WS_YW); const bf16* R = (const bf16*)(p.ws + WS_R); const bf16* KM = (const bf16*)(p.ws + WS_NKK);
    const bf16* VP = (const bf16*)(p.ws + WS_KKA); const bf16* L2 = (const bf16*)(p.ws + WS_L2); bf16* Z = (bf16*)(p.ws + WS_Z);
    const float* rk = p.in[I_RK] + (size_t)jl * D; const float* lnw = p.in[I_LNW] + (size_t)jl * D; const float* lnb = p.in[I_LNB] + (size_t)jl * D;
    const int gw = blockIdx.x * NWAVES + wave, NGW = gridDim.x * NWAVES;
    const int sub = lane >> 4, c4 = lane & 15;
    for (int it0 = gw * 4; it0 < M * WH; it0 += NGW * 4) {
        const int it = it0 + sub, row = it >> 4, h = it & 15, c = h * WN + 4 * c4;
        const size_t idx = (size_t)row * D + c;
        const f32x4 yv = *(const f32x4*)(YW + idx), r4 = ld_bf4(R + idx), k4 = ld_bf4(KM + idx), v4 = ld_bf4(VP + idx), g4 = ld_bf4(L2 + (size_t)row * NL2 + 2048 + c);
        const f32x4 rk4 = *(const f32x4*)(rk + c), lw4 = *(const f32x4*)(lnw + c), lb4 = *(const f32x4*)(lnb + c);
        const float mean = row16_sum((yv.x + yv.y) + (yv.z + yv.w)) * (1.f / WN);
        const f32x4 yc = yv - mean;
        const float rstd = rsqrtf(row16_sum((yc.x * yc.x + yc.y * yc.y) + (yc.z * yc.z + yc.w * yc.w)) * (1.f / WN) + 64e-5f);
        const f32x4 rkk = r4 * k4 * rk4;
        const float bon = row16_sum((rkk.x + rkk.y) + (rkk.z + rkk.w));
        const f32x4 z = (yc * rstd * lw4 + lb4 + v4 * bon) * g4;
        st_bf4(Z + idx, z);
    }
}

constexpr int RT_KP = 528, RT_VP = 144, RT_SP = 528;
constexpr int RT_K_OFF = 0, RT_V_OFF = 128 * RT_KP, RT_ST_OFF = RT_V_OFF + 128 * RT_VP, RT_END = RT_ST_OFF + 64 * RT_SP;
static_assert(RT_END <= LDS_BYTES, "retention LDS map");
typedef short v4s __attribute__((ext_vector_type(4)));
__device__ __forceinline__ bf16x8 tr_pair(LAS unsigned char* a0, LAS unsigned char* a1) {
    const v4s lo = __builtin_amdgcn_ds_read_tr16_b64_v4i16((LAS v4s*)a0), hi = __builtin_amdgcn_ds_read_tr16_b64_v4i16((LAS v4s*)a1);
    return __builtin_shufflevector(lo, hi, 0, 1, 2, 3, 4, 5, 6, 7);
}
__device__ __forceinline__ void ph_ret_fast(const Params& p, int jl, LAS unsigned char* lds, int tid, int lane, int wave) {
    const bf16* QK = (const bf16*)(p.ws + WS_QK); const bf16* V = (const bf16*)(p.ws + WS_V); float* O = (float*)(p.ws + WS_O);
    const int fr = lane & 15, fq = lane >> 4, li_q = (lane & 15) >> 2, li_p = lane & 3;
    for (int u = blockIdx.x; u < BATCH * RH * 8; u += gridDim.x) {
        const int es = u & 7, h = (u >> 3) & 3, b = u >> 5;
        const float gamma = 1.0f - exp2f(-5.0f - (float)h), lg = log2f(gamma), g128 = exp2f(128.f * lg), g127 = exp2f(127.f * lg);
        const int i0 = 16 * wave, d0 = 32 * wave;
        f32x4 Sacc[2][4];
#pragma unroll
        for (int a = 0; a < 2; ++a)
#pragma unroll
            for (int c = 0; c < 4; ++c) Sacc[a][c] = (f32x4){0.f, 0.f, 0.f, 0.f};
        __syncthreads();
        for (int i = tid; i < 64 * RT_SP / 16; i += NTHR) *(LAS v4u*)(lds + RT_ST_OFF + i * 16) = (v4u){0u, 0u, 0u, 0u};
        v4u kst[8], vst[2];
        const bf16* Kg = QK + 1024 + 256 * h; const bf16* Vg = V + 512 * h + 64 * es; const bf16* Qg = QK + 256 * h;
#define RT_LOAD_STAGE(cc) do { \
            _Pragma("unroll") for (int k_ = 0; k_ < 8; ++k_) { const int id_ = tid + 512 * k_, row_ = id_ >> 5, ch_ = id_ & 31, t_ = 128 * (cc) - 112 + row_; \
                kst[k_] = t_ >= 0 ? *(const v4u*)(Kg + (size_t)(b * TP + t_) * 2048 + 8 * ch_) : (v4u){0u, 0u, 0u, 0u}; } \
            _Pragma("unroll") for (int k_ = 0; k_ < 2; ++k_) { const int id_ = tid + 512 * k_, row_ = id_ >> 3, ch_ = id_ & 7, t_ = 128 * (cc) - 112 + row_; \
                vst[k_] = t_ >= 0 ? *(const v4u*)(Vg + (size_t)(b * TP + t_) * 2048 + 8 * ch_) : (v4u){0u, 0u, 0u, 0u}; } } while (0)
        RT_LOAD_STAGE(0);
        for (int c = 0; c < 17; ++c) {
            __syncthreads();
#pragma unroll
            for (int k_ = 0; k_ < 8; ++k_) { const int id_ = tid + 512 * k_, row_ = id_ >> 5, ch_ = id_ & 31; *(LAS v4u*)(lds + RT_K_OFF + row_ * RT_KP + ch_ * 16) = kst[k_]; }
#pragma unroll
            for (int k_ = 0; k_ < 2; ++k_) { const int id_ = tid + 512 * k_, row_ = id_ >> 3, ch_ = id_ & 7;
                float f[8]; unpack8(vst[k_], f); const float sc = exp2f(-(float)row_ * lg);
#pragma unroll
                for (int e = 0; e < 8; ++e) f[e] *= sc;
                *(LAS v4u*)(lds + RT_V_OFF + row_ * RT_VP + ch_ * 16) = pack8(f); }
            bf16x8 Qf[8];
            { const int t_ = 128 * c - 112 + i0 + fr;
#pragma unroll
              for (int s = 0; s < 8; ++s) Qf[s] = t_ >= 0 ? *(const bf16x8*)(Qg + (size_t)(b * TP + t_) * 2048 + 32 * s + 8 * fq) : (bf16x8){0, 0, 0, 0, 0, 0, 0, 0}; }
            __syncthreads();
            bf16x8 Pf[4];
            { const int ii = i0 + fr; const float gi = exp2f((float)ii * lg);
#pragma unroll
              for (int s2 = 0; s2 < 4; ++s2) { f32x4 Dp[2];
#pragma unroll
                  for (int hh = 0; hh < 2; ++hh) { Dp[hh] = (f32x4){0.f, 0.f, 0.f, 0.f};
#pragma unroll
                      for (int s = 0; s < 8; ++s) { const bf16x8 Kf = *(const LAS bf16x8*)(lds + RT_K_OFF + (16 * (2 * s2 + hh) + fr) * RT_KP + (32 * s + 8 * fq) * 2);
                          Dp[hh] = __builtin_amdgcn_mfma_f32_16x16x32_bf16(Kf, Qf[s], Dp[hh], 0, 0, 0); } }
                  float f[8];
#pragma unroll
                  for (int hh = 0; hh < 2; ++hh)
#pragma unroll
                      for (int r = 0; r < 4; ++r) { const int jj = 16 * (2 * s2 + hh) + 4 * fq + r; f[hh * 4 + r] = ii >= jj ? Dp[hh][r] * gi : 0.f; }
                  const v4u w = pack8(f); Pf[s2] = __builtin_bit_cast(bf16x8, w); } }
            f32x4 Oacc[4];
#pragma unroll
            for (int et = 0; et < 4; ++et) { Oacc[et] = (f32x4){0.f, 0.f, 0.f, 0.f};
#pragma unroll
                for (int s = 0; s < 8; ++s) { const bf16x8 Sf = *(const LAS bf16x8*)(lds + RT_ST_OFF + (16 * et + fr) * RT_SP + (32 * s + 8 * fq) * 2);
                    Oacc[et] = __builtin_amdgcn_mfma_f32_16x16x32_bf16(Qf[s], Sf, Oacc[et], 0, 0, 0); } }
            __syncthreads();
            if (c + 1 < 17) RT_LOAD_STAGE(c + 1);
#pragma unroll
            for (int r = 0; r < 4; ++r) { const float lam = exp2f((float)(i0 + 4 * fq + r + 1) * lg);
#pragma unroll
                for (int et = 0; et < 4; ++et) Oacc[et][r] *= lam; }
#pragma unroll
            for (int et = 0; et < 4; ++et)
#pragma unroll
                for (int s = 0; s < 4; ++s) {
                    LAS unsigned char* a0 = lds + RT_V_OFF + (32 * s + 4 * fq + li_q) * RT_VP + (16 * et + 4 * li_p) * 2;
                    const bf16x8 Vf = tr_pair(a0, a0 + 16 * RT_VP);
                    Oacc[et] = __builtin_amdgcn_mfma_f32_16x16x32_bf16(Pf[s], Vf, Oacc[et], 0, 0, 0); }
#pragma unroll
            for (int r = 0; r < 4; ++r) { const int t_ = 128 * c - 112 + i0 + 4 * fq + r;
                if (t_ >= 0) { float* op = O + (size_t)(b * TP + t_) * RV + 512 * h + 64 * es + fr;
#pragma unroll
                    for (int et = 0; et < 4; ++et) op[16 * et] = Oacc[et][r]; } }
#pragma unroll
            for (int dt = 0; dt < 2; ++dt)
#pragma unroll
                for (int et = 0; et < 4; ++et) Sacc[dt][et] = Sacc[dt][et] * (g128 / g127);
#pragma unroll
            for (int s = 0; s < 4; ++s) {
                bf16x8 Kt[2], Vt[4];
#pragma unroll
                for (int dt = 0; dt < 2; ++dt) { LAS unsigned char* a0 = lds + RT_K_OFF + (32 * s + 8 * fq + li_q) * RT_KP + (d0 + 16 * dt + 4 * li_p) * 2; Kt[dt] = tr_pair(a0, a0 + 4 * RT_KP); }
#pragma unroll
                for (int et = 0; et < 4; ++et) { LAS unsigned char* a0 = lds + RT_V_OFF + (32 * s + 8 * fq + li_q) * RT_VP + (16 * et + 4 * li_p) * 2; Vt[et] = tr_pair(a0, a0 + 4 * RT_VP); }
#pragma unroll
                for (int dt = 0; dt < 2; ++dt)
#pragma unroll
                    for (int et = 0; et < 4; ++et) Sacc[dt][et] = __builtin_amdgcn_mfma_f32_16x16x32_bf16(Kt[dt], Vt[et], Sacc[dt][et], 0, 0, 0);
            }
#pragma unroll
            for (int dt = 0; dt < 2; ++dt)
#pragma unroll
                for (int et = 0; et < 4; ++et) Sacc[dt][et] = Sacc[dt][et] * g127;
#pragma unroll
            for (int dt = 0; dt < 2; ++dt)
#pragma unroll
                for (int et = 0; et < 4; ++et) { v2u w; w.x = cvt_pk_bf16(Sacc[dt][et][0], Sacc[dt][et][1]); w.y = cvt_pk_bf16(Sacc[dt][et][2], Sacc[dt][et][3]);
                    *(LAS v2u*)(lds + RT_ST_OFF + (16 * et + fr) * RT_SP + (d0 + 16 * dt + 4 * fq) * 2) = w; }
        }
#undef RT_LOAD_STAGE
        float* so = p.out + O_RETP + ((((size_t)jl * BATCH + b) * RH + h) * RDK) * RDV + 64 * es;
#pragma unroll
        for (int dt = 0; dt < 2; ++dt)
#pragma unroll
            for (int et = 0; et < 4; ++et)
#pragma unroll
                for (int r = 0; r < 4; ++r) so[(size_t)(d0 + 16 * dt + 4 * fq + r) * RDV + 16 * et + fr] = Sacc[dt][et][r];
    }
    {
        LAS float* sq = (LAS float*)lds; LAS float* sk = sq + 256; LAS float* red = sk + 256;
        const int e4 = tid & 127, dq = tid >> 7;
        for (int it = blockIdx.x; it < SB * RH; it += gridDim.x) {
            const int h = it & 3, s = it >> 2, row = MP + s;
            const float gamma = 1.0f - exp2f(-5.0f - (float)h);
            __syncthreads();
            if (tid < 256) sq[tid] = bf_lo((unsigned)QK[(size_t)row * 2048 + 256 * h + tid]);
            else sk[tid - 256] = bf_lo((unsigned)QK[(size_t)row * 2048 + 1024 + 256 * h + (tid - 256)]);
            const v2u vv = *(const v2u*)(V + (size_t)row * 2048 + 512 * h + 4 * e4);
            const f32x4 v4 = (f32x4){bf_lo(vv.x), bf_hi(vv.x), bf_lo(vv.y), bf_hi(vv.y)};
            __syncthreads();
            const float* sin_ = p.in[I_SRET] + ((((size_t)jl * SB + s) * RH + h) * RDK) * RDV + 4 * e4;
            float* sout = p.out + O_RETS + ((((size_t)jl * SB + s) * RH + h) * RDK) * RDV + 4 * e4;
            f32x4 oacc = (f32x4){0.f, 0.f, 0.f, 0.f};
#pragma unroll 8
            for (int k = 0; k < 64; ++k) { const int d = dq + 4 * k;
                const f32x4 sv = __builtin_nontemporal_load((const f32x4*)(sin_ + (size_t)d * RDV));
                const f32x4 sn = sv * gamma + v4 * sk[d];
                oacc += sn * sq[d];
                __builtin_nontemporal_store(sn, (f32x4*)(sout + (size_t)d * RDV)); }
            *(LAS f32x4*)(red + dq * 512 + 4 * e4) = oacc;
            __syncthreads();
            if (dq == 0) { const f32x4 r = (*(LAS f32x4*)(red + 4 * e4) + *(LAS f32x4*)(red + 512 + 4 * e4)) + (*(LAS f32x4*)(red + 1024 + 4 * e4) + *(LAS f32x4*)(red + 1536 + 4 * e4));
                *(f32x4*)(O + (size_t)row * RV + 512 * h + 4 * e4) = r; }
        }
    }
}

typedef float f32x2w __attribute__((ext_vector_type(2)));
constexpr int WK_TB = 32, WK_STEP_B = 6 * 256 + 16, WK_BUF_B = WK_TB * WK_STEP_B, WK_Y_OFF = 2 * WK_BUF_B, WK_YB_B = WK_TB * 32 * 4;
static_assert(WK_Y_OFF + 2 * WK_YB_B <= LDS_BYTES - 16, "wkv LDS map");
__device__ __forceinline__ float row16_sum(float x) {
    x += __builtin_bit_cast(float, __builtin_amdgcn_update_dpp(0, __builtin_bit_cast(int, x), 0x128, 0xf, 0xf, false));
    x += __builtin_bit_cast(float, __builtin_amdgcn_update_dpp(0, __builtin_bit_cast(int, x), 0x124, 0xf, 0xf, false));
    x += __builtin_bit_cast(float, __builtin_amdgcn_update_dpp(0, __builtin_bit_cast(int, x), 0x122, 0xf, 0xf, false));
    x += __builtin_bit_cast(float, __builtin_amdgcn_update_dpp(0, __builtin_bit_cast(int, x), 0x121, 0xf, 0xf, false));
    return x;
}
__device__ __forceinline__ float half8_sum(float x) {
    x += __builtin_bit_cast(float, __builtin_amdgcn_update_dpp(0, __builtin_bit_cast(int, x), 0x141, 0xf, 0xf, false));
    x += __builtin_bit_cast(float, __builtin_amdgcn_update_dpp(0, __builtin_bit_cast(int, x), 0xB1, 0xf, 0xf, false));
    x += __builtin_bit_cast(float, __builtin_amdgcn_update_dpp(0, __builtin_bit_cast(int, x), 0x4E, 0xf, 0xf, false));
    return x;
}
struct WkPar { f32x4 w0, a0, kkp, kap, v0; };
__device__ __forceinline__ f32x4 wk_unit_neg(const f32x4 kraw, const f32x4 kkp) {
    const f32x4 kk = kraw * kkp;
    const float ss = row16_sum((kk.x * kk.x + kk.y * kk.y) + (kk.z * kk.z + kk.w * kk.w));
    return kk * (-rsqrtf(fmaxf(ss, 1e-12f)));
}
__device__ __forceinline__ float wk_decay(float x) { return __expf(-0.60653065971263342f * sigmoidf_(x)); }
__device__ __forceinline__ void wk_prep(const WkPar& P, const f32x4 kraw, const f32x4 vraw, const f32x4 lw2, const f32x4 la2, const f32x4 vf, const f32x4 lv2, bool vres,
                                        f32x4& w, f32x4& ka, f32x4& km, f32x4& vp, f32x4& nk) {
    nk = wk_unit_neg(kraw, P.kkp);
    w = (f32x4){wk_decay(P.w0.x + lw2.x), wk_decay(P.w0.y + lw2.y), wk_decay(P.w0.z + lw2.z), wk_decay(P.w0.w + lw2.w)};
    const f32x4 a = (f32x4){sigmoidf_(P.a0.x + la2.x), sigmoidf_(P.a0.y + la2.y), sigmoidf_(P.a0.z + la2.z), sigmoidf_(P.a0.w + la2.w)};
    ka = nk * (-a);
    km = kraw * ((a - 1.f) * P.kap + 1.f);
    vp = vraw;
    if (vres) { const f32x4 sg = (f32x4){sigmoidf_(P.v0.x + lv2.x), sigmoidf_(P.v0.y + lv2.y), sigmoidf_(P.v0.z + lv2.z), sigmoidf_(P.v0.w + lv2.w)}; vp = vraw + (vf - vraw) * sg; }
}
constexpr int WC_C = 16, WC_NCH = TP / WC_C;
static_assert(WC_NCH * WC_C == TP, "chunking");
constexpr int REC_WA = 0, REC_RP = 2048, REC_BK = 4096, REC_VV = 8192, REC_U0 = 10240, REC_Y0 = 14336, REC_GC = 18432, REC_BYTES = 18688;
constexpr size_t WS_REC = WS_END;
constexpr size_t WS_END2 = WS_REC + (size_t)BATCH * WH * WC_NCH * REC_BYTES;
__device__ __forceinline__ unsigned bf_rne_c(float f) { unsigned u = __float_as_uint(f); return (u + 0x7fffu + ((u >> 16) & 1u)) >> 16; }
__device__ __forceinline__ unsigned pk2_c(float lo, float hi) { return bf_rne_c(lo) | (bf_rne_c(hi) << 16); }
__device__ __forceinline__ float bf_rd(const bf16* q) { return __uint_as_float((unsigned)(*q) << 16); }
__device__ __forceinline__ bf16 bf_of(float x) { return (bf16)(cvt_pk_bf16(x, 0.f) & 0xffffu); }

__device__ __forceinline__ void ph_wkv1(const Params& p, int jl, LAS unsigned char* lds, int lane_in, int wave) {
    const bf16* Kr = (const bf16*)(p.ws + WS_K); const bf16* Vr = (const bf16*)(p.ws + (jl == 0 ? WS_VF : WS_VB)); const bf16* VFp = (const bf16*)(p.ws + WS_VF);
    const bf16* Rr = (const bf16*)(p.ws + WS_R); const bf16* L2 = (const bf16*)(p.ws + WS_L2);
    bf16* KM = (bf16*)(p.ws + WS_NKK); bf16* VP = (bf16*)(p.ws + WS_KKA);
    const bool vres = jl == 1;
    const int gw = wave * gridDim.x + blockIdx.x, NGW = gridDim.x * NWAVES;
    for (int job = gw; job < BATCH * WH * WC_NCH; job += NGW) {
        int ln = lane_in; asm volatile("" : "+v"(ln));
        const int lane = ln, fr = lane & 15, fq = lane >> 4;
        const int c = job % WC_NCH, sh = job / WC_NCH, h = sh & 15, seq = sh >> 4, r0 = seq * TP + WC_C * c, ch = h * WN + lane;
        LAS unsigned char* sc = lds + wave * 16384;
        const float pw0 = p.in[I_W0][(size_t)jl * D + ch], pa0 = p.in[I_A0][(size_t)jl * D + ch], pkk = p.in[I_KK][(size_t)jl * D + ch], pka = p.in[I_KA][(size_t)jl * D + ch], pv0 = p.in[I_V0][ch];
        float at[16], bt[16], kt[16], rt[16], vv[16], wv[16];
#pragma unroll
        for (int tb = 0; tb < 16; tb += 4) {
            float kraw[4], vraw[4], lw2[4], la2[4], vf[4], lv2[4];
#pragma unroll
            for (int q = 0; q < 4; ++q) { const int t = tb + q; const size_t ro = (size_t)(r0 + t) * D + ch, lo = (size_t)(r0 + t) * NL2 + ch;
                kraw[q] = bf_rd(Kr + ro); vraw[q] = bf_rd(Vr + ro); rt[t] = bf_rd(Rr + ro); lw2[q] = bf_rd(L2 + lo); la2[q] = bf_rd(L2 + lo + 1024);
                vf[q] = 0.f; lv2[q] = 0.f; if (vres) { vf[q] = bf_rd(VFp + ro); lv2[q] = bf_rd(L2 + lo + 3072); } }
            __builtin_amdgcn_sched_barrier(0);
#pragma unroll
            for (int q = 0; q < 4; ++q) { const int t = tb + q; const size_t ro = (size_t)(r0 + t) * D + ch;
                const float kk = kraw[q] * pkk;
                const float nk = -kk * rsqrtf(fmaxf(wave_sum(kk * kk, lane), 1e-12f));
                const float a = sigmoidf_(pa0 + la2[q]);
                wv[t] = wk_decay(pw0 + lw2[q]);
                at[t] = nk; bt[t] = -nk * a; kt[t] = kraw[q] * (1.f + (a - 1.f) * pka);
                float vp = vraw[q];
                if (vres) vp = vraw[q] + (vf[q] - vraw[q]) * sigmoidf_(pv0 + lv2[q]);
                vv[t] = vp;
                KM[ro] = bf_of(kt[t]); VP[ro] = bf_of(vp);
                __builtin_amdgcn_sched_barrier(0);
            }
        }
        float g = 1.f;
#pragma unroll
        for (int t = 0; t < 16; ++t) { const float gp = g; g *= wv[t]; const float ig = rcpf_(g); at[t] *= gp; bt[t] *= ig; kt[t] *= ig; rt[t] *= g; }
        unsigned char* rec = p.ws + WS_REC + (size_t)job * REC_BYTES;
        *(float*)(rec + REC_GC + lane * 4) = g;
#pragma unroll
        for (int t = 0; t < 16; ++t) {
            *(LAS bf16*)(sc + (0 * 16 + t) * 144 + 2 * lane) = bf_of(at[t]); *(LAS bf16*)(sc + (1 * 16 + t) * 144 + 2 * lane) = bf_of(bt[t]);
            *(LAS bf16*)(sc + (2 * 16 + t) * 144 + 2 * lane) = bf_of(kt[t]); *(LAS bf16*)(sc + (3 * 16 + t) * 144 + 2 * lane) = bf_of(rt[t]);
        }
        asm volatile("s_waitcnt lgkmcnt(0)" ::: "memory");
        {
            bf16x8 fa[2], fb[2], fk[2], fr_[2];
#pragma unroll
            for (int s = 0; s < 2; ++s) { const int off = fr * 144 + (32 * s + 8 * fq) * 2;
                fa[s] = *(const LAS bf16x8*)(sc + 0 * 2304 + off); fb[s] = *(const LAS bf16x8*)(sc + 1 * 2304 + off); fk[s] = *(const LAS bf16x8*)(sc + 2 * 2304 + off); fr_[s] = *(const LAS bf16x8*)(sc + 3 * 2304 + off); }
            f32x4 gab = (f32x4){0.f, 0.f, 0.f, 0.f}, gak = gab, grb = gab, grk = gab;
#pragma unroll
            for (int s = 0; s < 2; ++s) {
                gab = __builtin_amdgcn_mfma_f32_16x16x32_bf16(fa[s], fb[s], gab, 0, 0, 0); gak = __builtin_amdgcn_mfma_f32_16x16x32_bf16(fa[s], fk[s], gak, 0, 0, 0);
                grb = __builtin_amdgcn_mfma_f32_16x16x32_bf16(fr_[s], fb[s], grb, 0, 0, 0); grk = __builtin_amdgcn_mfma_f32_16x16x32_bf16(fr_[s], fk[s], grk, 0, 0, 0); }
#pragma unroll
            for (int r = 0; r < 4; ++r) { LAS float* gp = (LAS float*)(sc + 9216) + (4 * fq + r) * 16 + fr;
                gp[0] = gab[r]; gp[256] = gak[r]; gp[512] = grb[r]; gp[768] = grk[r]; }
        }
        asm volatile("s_waitcnt lgkmcnt(0)" ::: "memory");
        const LAS float* G = (const LAS float*)(sc + 9216);
        const volatile LAS f32x4* Gq = (const volatile LAS f32x4*)(sc + 9216);
#pragma unroll
        for (int t = 0; t < 16; ++t) {
            float wa = at[t];
#pragma unroll
            for (int q = 0; q * 4 < t; ++q) { const f32x4 lab = Gq[(0 * 256 + t * 16 + 4 * q) >> 2];
#pragma unroll
                for (int e = 0; e < 4; ++e) { const int s = 4 * q + e; if (s < t) wa = fmaf(lab[e], at[s], wa); } }
            at[t] = wa;
            __builtin_amdgcn_sched_barrier(0);
        }
#pragma unroll
        for (int t = 0; t < 16; ++t) {
            float rp = rt[t];
#pragma unroll
            for (int q = 0; q * 4 <= t; ++q) { const f32x4 mrb = Gq[(2 * 256 + t * 16 + 4 * q) >> 2];
#pragma unroll
                for (int e = 0; e < 4; ++e) { const int s = 4 * q + e; if (s <= t) rp = fmaf(mrb[e], at[s], rp); } }
            rt[t] = rp;
            __builtin_amdgcn_sched_barrier(0);
        }
        {
            const int j = lane;
            const int wbase = (((j >> 5) * 64 + ((j >> 2) & 3) * 16) * 8 + ((j >> 4) & 1) * 4 + (j & 3)) * 2;
            const int bbase = (((j >> 4) * 64 + (j & 15)) * 8) * 2;
#pragma unroll
            for (int t = 0; t < 16; ++t) {
                *(LAS bf16*)(sc + REC_WA + wbase + t * 16) = bf_of(at[t]); *(LAS bf16*)(sc + REC_RP + wbase + t * 16) = bf_of(rt[t]);
                *(LAS bf16*)(sc + REC_BK + bbase + (t >> 2) * 256 + (t & 3) * 2) = bf_of(bt[t]); *(LAS bf16*)(sc + REC_BK + bbase + (t >> 2) * 256 + (4 + (t & 3)) * 2) = bf_of(kt[t]);
            }
            asm volatile("s_waitcnt lgkmcnt(0)" ::: "memory");
#pragma unroll
            for (int k = 0; k < 8; ++k) *(v4u*)(rec + (k * 64 + lane) * 16) = *(const LAS v4u*)(sc + (k * 64 + lane) * 16);
            asm volatile("s_waitcnt lgkmcnt(0)" ::: "memory");
        }
        __builtin_amdgcn_sched_barrier(0);
        float u0[16];
#pragma unroll
        for (int t = 0; t < 16; ++t) {
            float uu = 0.f;
#pragma unroll
            for (int q = 0; q * 4 < t; ++q) { const f32x4 lab = Gq[(0 * 256 + t * 16 + 4 * q) >> 2], lak = Gq[(1 * 256 + t * 16 + 4 * q) >> 2];
#pragma unroll
                for (int e = 0; e < 4; ++e) { const int s = 4 * q + e; if (s < t) uu = fmaf(lak[e], vv[s], fmaf(lab[e], u0[s], uu)); } }
            u0[t] = uu;
            __builtin_amdgcn_sched_barrier(0);
        }
        {
            const int i = lane;
            const int vbase = ((i >> 4) * 64 + (i & 15)) * 4;
#pragma unroll
            for (int t = 0; t < 16; ++t) {
                float yy = 0.f;
#pragma unroll
                for (int q = 0; q * 4 <= t; ++q) { const f32x4 mrb = Gq[(2 * 256 + t * 16 + 4 * q) >> 2], mrk = Gq[(3 * 256 + t * 16 + 4 * q) >> 2];
#pragma unroll
                    for (int e = 0; e < 4; ++e) { const int s = 4 * q + e; if (s <= t) yy = fmaf(mrb[e], u0[s], fmaf(mrk[e], vv[s], yy)); } }
                *(LAS float*)(sc + 4096 + (vbase + (t >> 2) * 64 + (t & 3)) * 4) = yy;
                *(LAS float*)(sc + 0 + (vbase + (t >> 2) * 64 + (t & 3)) * 4) = u0[t];
                *(LAS bf16*)(sc + 13312 + (vbase + (t >> 2) * 64 + (t & 3)) * 2) = bf_of(vv[t]);
                __builtin_amdgcn_sched_barrier(0);
            }
            asm volatile("s_waitcnt lgkmcnt(0)" ::: "memory");
#pragma unroll
            for (int k = 0; k < 2; ++k) *(v4u*)(rec + REC_VV + (k * 64 + lane) * 16) = *(const LAS v4u*)(sc + 13312 + (k * 64 + lane) * 16);
#pragma unroll
            for (int k = 0; k < 8; ++k) *(v4u*)(rec + REC_U0 + (k * 64 + lane) * 16) = *(const LAS v4u*)(sc + (k * 64 + lane) * 16);
            asm volatile("s_waitcnt lgkmcnt(0)" ::: "memory");
        }
    }
}

__device__ __forceinline__ void ph_wkv2(const Params& p, int jl, int lane, int wave) {
    const bf16* Kr = (const bf16*)(p.ws + WS_K); const bf16* Vr = (const bf16*)(p.ws + (jl == 0 ? WS_VF : WS_VB)); const bf16* VFp = (const bf16*)(p.ws + WS_VF);
    const bf16* Rr = (const bf16*)(p.ws + WS_R); const bf16* L2 = (const bf16*)(p.ws + WS_L2);
    bf16* KM = (bf16*)(p.ws + WS_NKK); bf16* VP = (bf16*)(p.ws + WS_KKA);
    const bool vres = jl == 1; const int ri = lane >> 4, cg = lane & 15;
    float* YW = (float*)(p.ws + WS_YW);
    const int fr = lane & 15, fq = lane >> 4;
    const int gw = blockIdx.x * NWAVES + wave, NGW = gridDim.x * NWAVES;
    for (int job = gw; job < BATCH * WH * 4; job += NGW) {
        const int it = job & 3, h = (job >> 2) & 15, seq = job >> 6, r0 = seq * TP;
        const unsigned char* rec = p.ws + WS_REC + (size_t)((seq * WH + h) * WC_NCH) * REC_BYTES;
        f32x4 Sacc[4];
#pragma unroll
        for (int jt = 0; jt < 4; ++jt) Sacc[jt] = (f32x4){0.f, 0.f, 0.f, 0.f};
        v4u wa[2], rp[2], bk[4]; v2u vvf; f32x4 u0, y0, gc[4];
#define WC_LOAD(rc) do { const unsigned char* r_ = (rc); \
            wa[0] = *(const v4u*)(r_ + REC_WA + lane * 16); wa[1] = *(const v4u*)(r_ + REC_WA + 1024 + lane * 16); rp[0] = *(const v4u*)(r_ + REC_RP + lane * 16); rp[1] = *(const v4u*)(r_ + REC_RP + 1024 + lane * 16); \
            _Pragma("unroll") for (int jt_ = 0; jt_ < 4; ++jt_) { bk[jt_] = *(const v4u*)(r_ + REC_BK + (jt_ * 64 + lane) * 16); gc[jt_] = *(const f32x4*)(r_ + REC_GC + (16 * jt_ + 4 * fq) * 4); } \
            vvf = *(const v2u*)(r_ + REC_VV + (it * 64 + lane) * 8); u0 = *(const f32x4*)(r_ + REC_U0 + (it * 64 + lane) * 16); y0 = *(const f32x4*)(r_ + REC_Y0 + (it * 64 + lane) * 16); } while (0)
        WC_LOAD(rec);
        for (int c = 0; c < WC_NCH; ++c) {
            const v4u cwa0 = wa[0], cwa1 = wa[1], crp0 = rp[0], crp1 = rp[1], cbk0 = bk[0], cbk1 = bk[1], cbk2 = bk[2], cbk3 = bk[3]; const v2u cvv = vvf; const f32x4 cu0 = u0, cy0 = y0, cg0 = gc[0], cg1 = gc[1], cg2 = gc[2], cg3 = gc[3];
            if (c + 1 < WC_NCH) WC_LOAD(rec + (size_t)(c + 1) * REC_BYTES);
            v4u sb0, sb1;
            sb0.x = cvt_pk_bf16(Sacc[0][0], Sacc[0][1]); sb0.y = cvt_pk_bf16(Sacc[0][2], Sacc[0][3]); sb0.z = cvt_pk_bf16(Sacc[1][0], Sacc[1][1]); sb0.w = cvt_pk_bf16(Sacc[1][2], Sacc[1][3]);
            sb1.x = cvt_pk_bf16(Sacc[2][0], Sacc[2][1]); sb1.y = cvt_pk_bf16(Sacc[2][2], Sacc[2][3]); sb1.z = cvt_pk_bf16(Sacc[3][0], Sacc[3][1]); sb1.w = cvt_pk_bf16(Sacc[3][2], Sacc[3][3]);
            const bf16x8 B0 = __builtin_bit_cast(bf16x8, sb0), B1 = __builtin_bit_cast(bf16x8, sb1);
            f32x4 U = __builtin_amdgcn_mfma_f32_16x16x32_bf16(__builtin_bit_cast(bf16x8, cwa0), B0, cu0, 0, 0, 0);
            U = __builtin_amdgcn_mfma_f32_16x16x32_bf16(__builtin_bit_cast(bf16x8, cwa1), B1, U, 0, 0, 0);
            f32x4 Y = __builtin_amdgcn_mfma_f32_16x16x32_bf16(__builtin_bit_cast(bf16x8, crp0), B0, cy0, 0, 0, 0);
            Y = __builtin_amdgcn_mfma_f32_16x16x32_bf16(__builtin_bit_cast(bf16x8, crp1), B1, Y, 0, 0, 0);
            v4u ub; ub.x = pk2_c(U[0], U[1]); ub.y = pk2_c(U[2], U[3]); ub.z = cvv.x; ub.w = cvv.y;
            const bf16x8 UB = __builtin_bit_cast(bf16x8, ub);
            Sacc[0] = __builtin_amdgcn_mfma_f32_16x16x32_bf16(__builtin_bit_cast(bf16x8, cbk0), UB, Sacc[0], 0, 0, 0) * cg0;
            Sacc[1] = __builtin_amdgcn_mfma_f32_16x16x32_bf16(__builtin_bit_cast(bf16x8, cbk1), UB, Sacc[1], 0, 0, 0) * cg1;
            Sacc[2] = __builtin_amdgcn_mfma_f32_16x16x32_bf16(__builtin_bit_cast(bf16x8, cbk2), UB, Sacc[2], 0, 0, 0) * cg2;
            Sacc[3] = __builtin_amdgcn_mfma_f32_16x16x32_bf16(__builtin_bit_cast(bf16x8, cbk3), UB, Sacc[3], 0, 0, 0) * cg3;
            float* yp = YW + (size_t)(r0 + WC_C * c + 4 * fq) * D + h * WN + 16 * it + fr;
            yp[0] = Y[0]; yp[D] = Y[1]; yp[2 * D] = Y[2]; yp[3 * D] = Y[3];
        }
#undef WC_LOAD
        float* so = p.out + O_WKVP + ((((size_t)jl * BATCH + seq) * WH + h) * WN + 16 * it + fr) * WN + 4 * fq;
#pragma unroll
        for (int jt = 0; jt < 4; ++jt) *(f32x4*)(so + 16 * jt) = Sacc[jt];
    }
    {
        const int gw = blockIdx.x * NWAVES + wave, NGW = gridDim.x * NWAVES;
        for (int it = gw; it < SB * WH * 16; it += NGW) {
            const int rg = it & 15, h = (it >> 4) & 15, s = it >> 8, row = MP + s, i = 4 * rg + ri;
            const int ch = h * WN + 4 * cg;
            WkPar P; P.w0 = *(const f32x4*)(p.in[I_W0] + (size_t)jl * D + ch); P.a0 = *(const f32x4*)(p.in[I_A0] + (size_t)jl * D + ch); P.kkp = *(const f32x4*)(p.in[I_KK] + (size_t)jl * D + ch);
            P.kap = *(const f32x4*)(p.in[I_KA] + (size_t)jl * D + ch); P.v0 = *(const f32x4*)(p.in[I_V0] + ch);
            const size_t vo = (size_t)row * D + ch, lo = (size_t)row * NL2 + ch;
            const f32x4 kraw = ld_bf4(Kr + vo), vraw = ld_bf4(Vr + vo), r4 = ld_bf4(Rr + vo), lw2 = ld_bf4(L2 + lo), la2 = ld_bf4(L2 + lo + 1024);
            f32x4 vf = (f32x4){0.f, 0.f, 0.f, 0.f}, lv2 = vf;
            if (vres) { vf = ld_bf4(VFp + vo); lv2 = ld_bf4(L2 + lo + 3072); }
            f32x4 w4, ka, k4, vp, nk; wk_prep(P, kraw, vraw, lw2, la2, vf, lv2, vres, w4, ka, k4, vp, nk);
            const int srcl = (lane & 48) | rg;
            const float v0_ = shfl_l(vp.x, srcl), v1_ = shfl_l(vp.y, srcl), v2_ = shfl_l(vp.z, srcl), v3_ = shfl_l(vp.w, srcl);
            const float vi = ri == 0 ? v0_ : (ri == 1 ? v1_ : (ri == 2 ? v2_ : v3_));
            const size_t so = ((((size_t)jl * SB + s) * WH + h) * WN + i) * WN + 4 * cg;
            f32x4 S = *(const f32x4*)(p.in[I_SWKV] + so);
            const float sa = row16_sum((S.x * nk.x + S.y * nk.y) + (S.z * nk.z + S.w * nk.w));
            S.x = fmaf(S.x, w4.x, fmaf(sa, ka.x, vi * k4.x)); S.y = fmaf(S.y, w4.y, fmaf(sa, ka.y, vi * k4.y));
            S.z = fmaf(S.z, w4.z, fmaf(sa, ka.z, vi * k4.z)); S.w = fmaf(S.w, w4.w, fmaf(sa, ka.w, vi * k4.w));
            const float y = row16_sum((S.x * r4.x + S.y * r4.y) + (S.z * r4.z + S.w * r4.w));
            *(f32x4*)(p.out + O_WKVS + so) = S;
            if (cg == 0) YW[(size_t)row * D + h * WN + i] = y;
            if (rg == 0 && ri == 0) { st_bf4(KM + vo, k4); st_bf4(VP + vo, vp); }
        }
    }
}

typedef __attribute__((address_space(1))) unsigned gu32;
#define XB_TMO      128
#define XB_XCNT(j)  (256  + 64 * (j))
#define XB_XSUB(j)  (1280 + 64 * (j))
#define XB_XGEN(j)  (2304 + 64 * (j))
#define XB_TOP      3328
#define XB_TOPGEN   3392
#define XCD_BAR_WORDS 3456
#define XB_SPIN_CAP (1u << 18)

__device__ __forceinline__ unsigned xb_ld(unsigned* p)              { return __hip_atomic_load(p, __ATOMIC_RELAXED, __HIP_MEMORY_SCOPE_AGENT); }
__device__ __forceinline__ unsigned xb_add(unsigned* p, unsigned v) { return __hip_atomic_fetch_add(p, v, __ATOMIC_RELAXED, __HIP_MEMORY_SCOPE_AGENT); }
__device__ __forceinline__ unsigned xb_xcc_id() { return (unsigned)__builtin_amdgcn_s_getreg((3 << 11) | 20) & 0xFu; }
#define XB_SPIN(cond, bar) do { unsigned _sp = 0; while (cond) { __builtin_amdgcn_s_sleep(1); \
    if ((++_sp & 255u) == 0u) { if (xb_ld(&(bar)[XB_TMO])) break; if (_sp > XB_SPIN_CAP) { atomicAdd(&(bar)[XB_TMO], 1u); break; } } } } while (0)

struct XcdBarrier {
    bool tid0; unsigned* bar; unsigned x;
    volatile LAS unsigned* st;
};

__device__ __forceinline__ XcdBarrier xcd_barrier_post(unsigned* bar, volatile LAS unsigned* st, bool tid0) {
    XcdBarrier b; b.tid0 = tid0; b.bar = bar; b.x = xb_xcc_id(); b.st = st;
    if (b.tid0) (void)xb_add(&bar[XB_XCNT(b.x)], 1u);
    return b;
}
__device__ __forceinline__ void xcd_barrier_complete(unsigned* bar, unsigned x, unsigned& nloc, unsigned& nx) {
    const unsigned G = gridDim.x * gridDim.y * gridDim.z;
    unsigned sum, cnt, mine, sp = 0u;
    for (;;) {
        sum = 0u; cnt = 0u; mine = 0u;
#pragma unroll
        for (unsigned j = 0; j < 16; ++j) { const unsigned c = xb_ld(&bar[XB_XCNT(j)]); sum += c; cnt += (c > 0u) ? 1u : 0u; mine = (j == x) ? c : mine; }
        if (sum == G) break;
        __builtin_amdgcn_s_sleep(1);
        if ((++sp & 255u) == 0u) { if (xb_ld(&bar[XB_TMO])) break; if (sp > XB_SPIN_CAP) { atomicAdd(&bar[XB_TMO], 1u); break; } }
    }
    nloc = mine > 0u ? mine : 1u; nx = cnt > 0u ? cnt : 1u;
}

__device__ __forceinline__ void xcd_barrier(const XcdBarrier& b) {
    asm volatile("s_waitcnt vmcnt(0)" ::: "memory");
    __syncthreads();
    if (b.tid0) {
        unsigned* bar = b.bar;
        __builtin_amdgcn_s_waitcnt(0);
        unsigned nloc = b.st[0], nx = b.st[1];
        if (nloc == 0u) { xcd_barrier_complete(bar, b.x, nloc, nx); b.st[0] = nloc; b.st[1] = nx; }
        const unsigned old = xb_add(&bar[XB_XSUB(b.x)], 1u);
        const unsigned gen = old / nloc;
        if (old + 1u == (gen + 1u) * nloc) {
            __builtin_amdgcn_fence(__ATOMIC_RELEASE, "agent");
            asm volatile("s_waitcnt vmcnt(0)" ::: "memory");
            const unsigned og = xb_add(&bar[XB_TOP], 1u);
            const unsigned tg = og / nx;
            if (og + 1u == (tg + 1u) * nx) xb_add(&bar[XB_TOPGEN], 1u);
            else XB_SPIN(xb_ld(&bar[XB_TOPGEN]) == tg, bar);
            __builtin_amdgcn_fence(__ATOMIC_ACQUIRE, "agent");
            xb_add(&bar[XB_XGEN(b.x)], 1u);
            asm volatile("s_waitcnt vmcnt(0)" ::: "memory");
        } else {
            XB_SPIN(xb_ld(&bar[XB_XGEN(b.x)]) == gen, bar);
            __builtin_amdgcn_fence(__ATOMIC_ACQUIRE, "agent");
            asm volatile("s_waitcnt vmcnt(0)" ::: "memory");
        }
    }
    __syncthreads();
}

enum { OP_P0 = 0, OP_NORM_RET, OP_G_RETIN, OP_RET, OP_RETNORM, OP_G_RETOUT, OP_NORM_RW, OP_G_RWPROJ, OP_G_LORA2, OP_PREP, OP_WKV, OP_WKV2, OP_POST, OP_G_WO,
       OP_NORM_FFN, OP_G_UG, OP_CONV, OP_G_WD, OP_FINAL };
struct Ph { unsigned char op, layer; };
constexpr int NPH = 1 + 2 * 6 + 2 * 9 + 1;
__device__ __host__ inline Ph phase_at(int i) {
    if (i == 0) return Ph{OP_P0, 0};
    i -= 1;
    int l;
    if (i < 6) l = 0; else if (i < 15) { l = 1; i -= 6; } else if (i < 21) { l = 2; i -= 15; } else if (i < 30) { l = 3; i -= 21; } else return Ph{OP_FINAL, 0};
    int op = OP_FINAL;
    if ((l & 1) == 0) {
        switch (i) { case 0: op = OP_G_RETIN; break; case 1: op = OP_RET; break; case 2: op = OP_RETNORM; break; case 3: op = OP_G_RETOUT; break;
                     case 4: op = OP_G_UG; break; default: op = OP_G_WD; break; }
    } else {
        switch (i) { case 0: op = OP_NORM_RW; break; case 1: op = OP_G_RWPROJ; break; case 2: op = OP_G_LORA2; break; case 3: op = OP_WKV; break; case 4: op = OP_WKV2; break; case 5: op = OP_POST; break; case 6: op = OP_G_WO; break;
                     case 7: op = OP_G_UG; break; default: op = OP_G_WD; break; }
    }
    return Ph{(unsigned char)op, (unsigned char)l};
}

__global__ void __launch_bounds__(NTHR, 2) mega(Params p, int lo, int hi) {
    extern __shared__ __attribute__((aligned(16))) unsigned char lds_raw[];
    LAS unsigned char* lds = (LAS unsigned char*)lds_raw;
    volatile LAS unsigned* bst = (volatile LAS unsigned*)(lds + LDS_BYTES - 16);
    const int wave0 = __builtin_amdgcn_readfirstlane((int)threadIdx.x >> 6);
    if (threadIdx.x < 4) bst[threadIdx.x] = 0u;
    __syncthreads();
    (void)xcd_barrier_post((unsigned*)(p.ws + WS_CTL), bst, threadIdx.x == 0);
    for (int ph = lo; ph < hi; ++ph) {
        int lid_; asm volatile("v_mbcnt_lo_u32_b32 %0, -1, 0\n\tv_mbcnt_hi_u32_b32 %0, -1, %0" : "=v"(lid_));
        int tid = wave0 * 64 + lid_; asm volatile("" : "+v"(tid));
        const int lane = tid & 63, wave = __builtin_amdgcn_readfirstlane(tid >> 6);
        unsigned char* ws = p.ws;
        const Ph P = phase_at(ph);
        const int li = P.layer, jl = li >> 1;
        const bf16* gA = nullptr; const bf16* gB = nullptr; int gN = 0, gK = 0; EpiAnyT<0> E{}; E.jl = jl; E.ws = ws; E.slot = -1; E.amul = 1.f; E.li = li; E.ldsb = lds; bool is_gemm = false;
        switch (P.op) {
        case OP_P0: ph_p0(p, lds, tid, lane, wave); break;
        case OP_NORM_RET: ph_norm(p, p.in[I_NMIX] + (size_t)li * D, 0, jl, lane, wave); break;
        case OP_NORM_FFN: ph_norm(p, p.in[I_NFFN] + (size_t)li * D, 0, jl, lane, wave); break;
        case OP_NORM_RW: ph_norm(p, p.in[I_NMIX] + (size_t)li * D, 1, jl, lane, wave); break;
        case OP_FINAL: ph_norm(p, p.in[I_NFIN], 2, 0, lane, wave); break;
        case OP_RETNORM: ph_ret_norm(p, jl, lane, wave); break;
        case OP_POST: ph_rwkv_post(p, jl, lane, wave); break;
        case OP_RET: ph_ret_fast(p, jl, lds, tid, lane, wave); break;
        case OP_WKV: ph_wkv1(p, jl, lds, lane, wave); break;
        case OP_WKV2: ph_wkv2(p, jl, lane, wave); break;
        case OP_G_RETIN: is_gemm = true; E.kind = EK_RETIN; E.perm = true; E.slot = 2 * li;
            gA = (const bf16*)(ws + WS_XB); gB = (const bf16*)(ws + WS_WIN + jl * SZ_WIN); gN = RWIN; gK = D; break;
        case OP_G_RETOUT: is_gemm = true; E.kind = EK_RESID; E.perm = false; E.slot = 2 * li + 1;
            gA = (const bf16*)(ws + WS_Y); gB = (const bf16*)(ws + WS_WOUT + jl * SZ_WOUT); gN = D; gK = RV; break;
        case OP_G_RWPROJ: is_gemm = true; E.kind = EK_RWPROJ; E.perm = true;
            gA = (const bf16*)(ws + WS_H); gB = (const bf16*)(ws + WS_WRW + jl * SZ_WRW); gN = NRW; gK = KRW; break;
        case OP_G_LORA2: is_gemm = true; E.kind = EK_F32; E.perm = true;
            gA = (const bf16*)(ws + WS_A2); gB = (const bf16*)(ws + WS_WL2 + jl * SZ_WL2); gN = (jl == 0 ? 3072 : 4096); gK = KL2; break;
        case OP_G_WO: is_gemm = true; E.kind = EK_RESID; E.perm = false; E.slot = 2 * li + 1;
            gA = (const bf16*)(ws + WS_Z); gB = (const bf16*)(ws + WS_WO + jl * SZ_WO); gN = D; gK = D; break;
        case OP_G_UG: is_gemm = true; E.kind = EK_UG; E.perm = true; E.slot = 2 * li + 1;
            gA = (const bf16*)(ws + WS_XB); gB = (const bf16*)(ws + WS_WUG + li * SZ_WUG); gN = 2 * DFF; gK = D; break;
        case OP_G_WD: is_gemm = true; E.kind = EK_RESID; E.perm = false; E.slot = (li == 1) ? 2 * (li + 1) : -1;
            gA = (const bf16*)(ws + WS_ACT); gB = (const bf16*)(ws + WS_WD + li * SZ_WD); gN = D; gK = DFF; break;
        default: break;
        }
        if (is_gemm) {
            const bool ug = E.kind == EK_UG;
            const int gM = (E.kind == EK_RESID) ? MT0 : (ug ? 66 * 256 : M);
            pg8::Gemm g{ug ? gA - 2 * D : gA, gB, gM, gN, gK, ug ? 254 : 256}; pg8::StaticOrder S; S.init(gM, gN, (int)gridDim.x, (int)blockIdx.x);
            if (E.kind == EK_RETIN || E.kind == EK_UG) {
                LAS float* rt = (LAS float*)(lds + 131072);
                Unit uu;
                for (int ui = 0; ui < 8 && S.next(ui, uu); ++ui) if (tid < 256) { int rr = ug ? 254 * uu.pm - 2 + tid : uu.pm * 256 + tid; rr = rr < 0 ? 0 : (rr > M - 1 ? M - 1 : rr); rt[ui * 256 + tid] = row_rstd(ws, E.slot, rr); }
                E.rtab = rt; E.ldsb = lds;
                __syncthreads();
            }
            if (ug) { EpiAnyT<1> E1{}; E1.kind = E.kind; E1.perm = E.perm; E1.jl = E.jl; E1.ws = E.ws; E1.slot = E.slot; E1.rtab = E.rtab; E1.amul = E.amul; E1.li = E.li; E1.ldsb = E.ldsb; E1.pcw = p.in[I_CW]; E1.pcb = p.in[I_CB]; E1.pcst = p.in[I_SCONV]; E1.pout = p.out;
                pg8::gemm_phase<EpiAnyT<1>, pg8::StaticOrder, true, true>(lds, g, S, E1, tid); }
            else pg8::gemm_phase<EpiAnyT<0>, pg8::StaticOrder, true, true>(lds, g, S, E, tid);
            if (E.kind == EK_RESID) tail_resid(gA, gB, gK, ws, E.slot, E.amul, lds, lane, wave);
        }
        if (ph + 1 < hi) { if (ph == 0) cg::this_grid().sync(); else { XcdBarrier bar; bar.tid0 = tid == 0; bar.bar = (unsigned*)(p.ws + WS_CTL); bar.x = xb_xcc_id(); bar.st = (volatile LAS unsigned*)(lds + LDS_BYTES - 16); xcd_barrier(bar); } }
    }
}

}

extern "C" void kernel_launch(void* const* d_in, const int* in_sizes, int n_in, void* d_out, int out_size, void* d_ws, size_t ws_size, hipStream_t stream) {
    static int grid = 0;
    if (grid == 0) {
        int dev = 0, cus = 0;
        if (n_in != N_IN || ws_size < WS_END2) { fprintf(stderr, "kernel_launch: unexpected n_in %d / ws_size %zu (need %zu)\n", n_in, ws_size, (size_t)WS_END2); grid = -1; return; }
        if (hipGetDevice(&dev) != hipSuccess || hipDeviceGetAttribute(&cus, hipDeviceAttributeMultiprocessorCount, dev) != hipSuccess) { grid = -1; return; }
        if (hipFuncSetAttribute((const void*)mega, hipFuncAttributeMaxDynamicSharedMemorySize, LDS_BYTES) != hipSuccess) { fprintf(stderr, "kernel_launch: hipFuncSetAttribute failed\n"); grid = -1; return; }
        int per_cu = 0;
        if (hipOccupancyMaxActiveBlocksPerMultiprocessor(&per_cu, (const void*)mega, NTHR, LDS_BYTES) != hipSuccess || per_cu < 1) { fprintf(stderr, "kernel_launch: occupancy query says %d\n", per_cu); (void)hipGetLastError(); }
        grid = cus * (per_cu >= 1 ? 1 : 1);
    }
    if (grid < 0) return;
    Params p{};
    for (int i = 0; i < N_IN; ++i) p.in[i] = (const float*)d_in[i];
    p.out = (float*)d_out; p.ws = (unsigned char*)d_ws;
    if (hipMemsetAsync(d_ws, 0, 65536, stream) != hipSuccess) { fprintf(stderr, "kernel_launch: memset failed\n"); return; }
    int lo = 0, hi = NPH;
    void* args[] = {(void*)&p, (void*)&lo, (void*)&hi};
    const hipError_t e = hipLaunchCooperativeKernel((const void*)mega, dim3(grid), dim3(NTHR), args, LDS_BYTES, stream);
    if (e != hipSuccess) fprintf(stderr, "kernel_launch: cooperative launch failed: %s (grid %d)\n", hipGetErrorString(e), grid);
    (void)in_sizes; (void)out_size;
}
```

```cpp
#include <hip/hip_runtime.h>
#include <hip/hip_cooperative_groups.h>
#include <cstdio>
#include <stdint.h>
namespace cg = cooperative_groups;
namespace pg8 {
#define PG8_LAS __attribute__((address_space(3)))
typedef unsigned short bf16_t;
typedef short bf16x8 __attribute__((ext_vector_type(8)));
typedef float f32x4 __attribute__((ext_vector_type(4)));
typedef unsigned u32x4 __attribute__((ext_vector_type(4)));
constexpr int BM = 256, BK = 64, HALF = 128, HTB = HALF * BK * 2  , STAGE_BYTES = 8 * HTB, NXCD = 8, WGM = 8;

__host__ __device__ __forceinline__ int lds_byte(int r, int c) { const int st = (r >> 4) * 2 + (c >> 5), rr = r & 15, cc = c & 31, ob = rr * 64 + cc * 2; return st * 1024 + (ob ^ (((ob >> 9) & 1) << 5)); }
__host__ __device__ __forceinline__ void stage_rc(int b, int& R, int& C) { const int st = b / 1024, sb = b % 1024, swz = sb ^ (((sb >> 9) & 1) << 5); R = (st >> 1) * 16 + swz / 64; C = (st & 1) * 32 + (swz % 64) / 2; }
__host__ __device__ __forceinline__ int perm32(int rho) { const int n = rho >> 4, i = rho & 15; return 8 * (i >> 2) + 4 * n + (i & 3); }

struct Unit { int pm, pn, ord; };
struct Gemm { const bf16_t* A; const bf16_t* Bt; int M, N, K, trows; };

struct StaticOrder {
    int nM, nN, nwg, G, c;
    __host__ __device__ void init(int M, int N, int G_, int c_) { nM = M / BM; nN = N / BM; nwg = nM * nN; G = G_; c = c_; }
    __host__ __device__ __forceinline__ bool next(int i, Unit& u) const {
        const long L = (long)i * G + c; if (L >= nwg) return false;
        int wgid = (int)L; { const int q = nwg / NXCD, r = nwg % NXCD, xcd = wgid % NXCD, off = wgid / NXCD; wgid = (xcd < r ? xcd * (q + 1) : r * (q + 1) + (xcd - r) * q) + off; }
        const int nig = WGM * nN, gid = wgid / nig, fm = gid * WGM, gsz = (nM - fm) < WGM ? (nM - fm) : WGM;
        u.pm = fm + ((wgid % nig) % gsz); u.pn = (wgid % nig) / gsz; u.ord = i; return true;
    }
    __device__ __forceinline__ void a_ready(const Unit&) const {}
    __device__ __forceinline__ void done(const Unit&) const {}
};
template <class Epi, class Sched, bool ALIGN_EPI = false, bool SP2 = false>
__device__ __forceinline__ void gemm_phase(PG8_LAS unsigned char* lds, const Gemm g, const Sched& S, const Epi& E, int tid_in) {
    int tid = tid_in; asm volatile("" : "+v"(tid));
    const int wid = __builtin_amdgcn_readfirstlane(tid >> 6), lane = tid & 63, wr = wid >> 2, wc = wid & 3, fr = lane & 15, fq = lane >> 4;
    const int K = g.K, nt = K / BK;
    unsigned voffA[2], voffB[2];
#pragma unroll
    for (int i = 0; i < 2; ++i) { int R, C; stage_rc(tid * 16 + i * 8192, R, C); const int Rb = E.perm ? ((R & ~31) + perm32(R & 31)) : R;
        voffA[i] = (unsigned)(R * K + C) * 2u; voffB[i] = (unsigned)(Rb * K + C) * 2u; }
    const size_t kstep = (size_t)(BK * 2);
    const size_t hstep = (size_t)HALF * K * 2;
    const size_t tstep = 2 * hstep; const size_t tstepA = (size_t)g.trows * K * 2;
    const unsigned ldsw = (unsigned)wid * 1024u;
    const int aoff = lds_byte(wr * 64 + fr, fq * 8), boff = lds_byte(wc * 32 + fr, fq * 8);
#define PG8_SA(b, h) (((b) * 2 + (h)) * HTB)
#define PG8_SB(b, h) ((4 + (b) * 2 + (h)) * HTB)
#define PG8_STAGE(bufoff, gbase, voff) do { _Pragma("unroll") for (int _i = 0; _i < 2; ++_i) \
        __builtin_amdgcn_global_load_lds((const unsigned*)((const char*)(gbase) + (voff)[_i]), (PG8_LAS unsigned*)(lds + (bufoff) + ldsw + _i * 8192), 16, 0, 0); } while (0)
#define PG8_LDA(dst, b, h) do { _Pragma("unroll") for (int m = 0; m < 4; ++m) _Pragma("unroll") for (int k = 0; k < 2; ++k) dst[m][k] = *(const PG8_LAS bf16x8*)(lds + PG8_SA(b, h) + aoff + m * 2048 + k * 1024); } while (0)
#define PG8_LDB(dst, b, h) do { _Pragma("unroll") for (int n = 0; n < 2; ++n) _Pragma("unroll") for (int k = 0; k < 2; ++k) dst[n][k] = *(const PG8_LAS bf16x8*)(lds + PG8_SB(b, h) + boff + n * 2048 + k * 1024); } while (0)
#define PG8_MMA(ai, bj, At, Bt) do { __builtin_amdgcn_s_setprio(1); _Pragma("unroll") for (int m = 0; m < 4; ++m) _Pragma("unroll") for (int n = 0; n < 2; ++n) _Pragma("unroll") for (int k = 0; k < 2; ++k) \
        acc[ai][bj][m][n] = __builtin_amdgcn_mfma_f32_16x16x32_bf16(Bt[n][k], At[m][k], acc[ai][bj][m][n], 0, 0, 0); __builtin_amdgcn_s_setprio(0); } while (0)
#define PG8_WAIT_V(n) asm volatile("s_waitcnt vmcnt(" #n ")" ::: "memory")
#define PG8_WAIT_L(n) asm volatile("s_waitcnt lgkmcnt(" #n ")" ::: "memory")
#define PG8_BAR __builtin_amdgcn_s_barrier()
#define PG8_SCHED __builtin_amdgcn_sched_barrier(0)
    Unit cur, nxt; int ui = 0;
    if (!S.next(0, cur)) return;
    f32x4 acc[2][2][4][2];
#pragma unroll
    for (int a = 0; a < 2; ++a)
#pragma unroll
        for (int b = 0; b < 2; ++b)
#pragma unroll
            for (int m = 0; m < 4; ++m)
#pragma unroll
                for (int n = 0; n < 2; ++n) acc[a][b][m][n] = (f32x4){0.f, 0.f, 0.f, 0.f};
    bf16x8 At[4][2], B0[2][2], B1[2][2];
    const char* cA = (const char*)g.A + (size_t)cur.pm * tstepA; const char* cB = (const char*)g.Bt + (size_t)cur.pn * tstep;
    S.a_ready(cur);
    if constexpr (SP2) {
        PG8_STAGE(PG8_SB(0, 0), cB, voffB); PG8_STAGE(PG8_SB(0, 1), cB + hstep, voffB); PG8_STAGE(PG8_SA(0, 0), cA, voffA); PG8_STAGE(PG8_SA(0, 1), cA + hstep, voffA);
        if (wr == 1) PG8_BAR;
        PG8_WAIT_V(2); PG8_BAR;
        PG8_STAGE(PG8_SB(1, 0), cB + kstep, voffB); PG8_STAGE(PG8_SA(1, 0), cA + kstep, voffA); PG8_STAGE(PG8_SB(1, 1), cB + hstep + kstep, voffB);
        PG8_WAIT_V(6); PG8_BAR;
    } else {
        PG8_STAGE(PG8_SB(0, 0), cB, voffB); PG8_STAGE(PG8_SA(0, 0), cA, voffA); PG8_STAGE(PG8_SB(0, 1), cB + hstep, voffB); PG8_STAGE(PG8_SA(0, 1), cA + hstep, voffA);
        if (wr == 1) PG8_BAR;
        PG8_WAIT_V(4); PG8_BAR;
        PG8_STAGE(PG8_SB(1, 0), cB + kstep, voffB); PG8_STAGE(PG8_SA(1, 0), cA + kstep, voffA); PG8_STAGE(PG8_SB(1, 1), cB + hstep + kstep, voffB);
        PG8_WAIT_V(6); PG8_BAR;
    }
    for (;;) {
        const bool has_next = S.next(ui + 1, nxt);
        const char* nA = has_next ? (const char*)g.A + (size_t)nxt.pm * tstepA : cA; const char* nB = has_next ? (const char*)g.Bt + (size_t)nxt.pn * tstep : cB;
        for (int t = 0; t < nt; t += 2) {
            const bool last = (t == nt - 2);
            const char* a1 = cA + (size_t)(t + 1) * kstep;
            const char* a2 = last ? nA : cA + (size_t)(t + 2) * kstep; const char* b2 = last ? nB : cB + (size_t)(t + 2) * kstep;
            const char* a3 = a2 + kstep; const char* b3 = b2 + kstep;
            if (last && has_next) S.a_ready(nxt);
            if constexpr (SP2) {
            PG8_LDB(B0, 0, 0); PG8_LDB(B1, 0, 1); PG8_SCHED; PG8_LDA(At, 0, 0); PG8_STAGE(PG8_SA(1, 1), a1 + hstep, voffA);
            PG8_WAIT_V(8); PG8_WAIT_L(0); PG8_BAR; PG8_MMA(0, 0, At, B0); PG8_MMA(0, 1, At, B1); PG8_BAR; PG8_SCHED;
            PG8_LDA(At, 0, 1); PG8_STAGE(PG8_SB(0, 0), b2, voffB); PG8_STAGE(PG8_SB(0, 1), b2 + hstep, voffB); PG8_STAGE(PG8_SA(0, 0), a2, voffA);
            PG8_WAIT_V(8); PG8_WAIT_L(0); PG8_BAR; PG8_MMA(1, 0, At, B0); PG8_MMA(1, 1, At, B1); PG8_BAR; PG8_SCHED;
            PG8_LDB(B0, 1, 0); PG8_LDB(B1, 1, 1); PG8_SCHED; PG8_LDA(At, 1, 0); PG8_STAGE(PG8_SA(0, 1), a2 + hstep, voffA);
            PG8_WAIT_V(8); PG8_WAIT_L(0); PG8_BAR; PG8_MMA(0, 0, At, B0); PG8_MMA(0, 1, At, B1); PG8_BAR; PG8_SCHED;
            PG8_LDA(At, 1, 1); PG8_STAGE(PG8_SB(1, 0), b3, voffB); PG8_STAGE(PG8_SB(1, 1), b3 + hstep, voffB); PG8_STAGE(PG8_SA(1, 0), a3, voffA);
            PG8_WAIT_V(8); PG8_WAIT_L(0); PG8_BAR; PG8_MMA(1, 0, At, B0); PG8_MMA(1, 1, At, B1); PG8_BAR; PG8_SCHED;
            } else {
            PG8_LDB(B0, 0, 0); PG8_SCHED; PG8_LDA(At, 0, 0); PG8_STAGE(PG8_SA(1, 1), a1 + hstep, voffA);
            PG8_WAIT_L(8); PG8_BAR; PG8_WAIT_L(0); PG8_MMA(0, 0, At, B0); PG8_BAR; PG8_SCHED;
            PG8_LDB(B1, 0, 1); PG8_STAGE(PG8_SB(0, 0), b2, voffB);
            PG8_BAR; PG8_WAIT_L(0); PG8_MMA(0, 1, At, B1); PG8_BAR;
            PG8_LDA(At, 0, 1); PG8_STAGE(PG8_SA(0, 0), a2, voffA);
            PG8_BAR; PG8_WAIT_L(0); PG8_MMA(1, 0, At, B0); PG8_BAR; PG8_SCHED;
            PG8_STAGE(PG8_SB(0, 1), b2 + hstep, voffB);
            PG8_WAIT_V(6); PG8_BAR; PG8_MMA(1, 1, At, B1); PG8_BAR;
            PG8_LDB(B0, 1, 0); PG8_SCHED; PG8_LDA(At, 1, 0); PG8_STAGE(PG8_SA(0, 1), a2 + hstep, voffA);
            PG8_WAIT_L(8); PG8_BAR; PG8_WAIT_L(0); PG8_MMA(0, 0, At, B0); PG8_BAR; PG8_SCHED;
            PG8_LDB(B1, 1, 1); PG8_STAGE(PG8_SB(1, 0), b3, voffB);
            PG8_BAR; PG8_WAIT_L(0); PG8_MMA(0, 1, At, B1); PG8_BAR;
            PG8_LDA(At, 1, 1); PG8_STAGE(PG8_SA(1, 0), a3, voffA);
            PG8_BAR; PG8_WAIT_L(0); PG8_MMA(1, 0, At, B0); PG8_BAR; PG8_SCHED;
            PG8_STAGE(PG8_SB(1, 1), b3 + hstep, voffB);
            PG8_WAIT_V(6); PG8_BAR; PG8_MMA(1, 1, At, B1); PG8_BAR;
            }
        }
        if constexpr (ALIGN_EPI) { if (wr == 0) PG8_BAR; }
        if constexpr (!Epi::AFTER_DRAIN) { E(acc, cur, wr, wc, fr, fq); S.done(cur); }
        if (!has_next) break;
#pragma unroll
        for (int a = 0; a < 2; ++a)
#pragma unroll
            for (int b = 0; b < 2; ++b)
#pragma unroll
                for (int m = 0; m < 4; ++m)
#pragma unroll
                    for (int n = 0; n < 2; ++n) acc[a][b][m][n] = (f32x4){0.f, 0.f, 0.f, 0.f};
        cur = nxt; cA = nA; cB = nB; ++ui;
        if constexpr (ALIGN_EPI) { if (wr == 1) PG8_BAR; }
    }
    PG8_WAIT_V(0);
    if constexpr (!ALIGN_EPI) { if (wr == 0) PG8_BAR; }
    PG8_BAR;
    if constexpr (Epi::AFTER_DRAIN) { E.fused(acc, cur, wr, wc, fr, fq, lds, wid, lane); S.done(cur); }
#undef PG8_SA
#undef PG8_SB
#undef PG8_STAGE
#undef PG8_LDA
#undef PG8_LDB
#undef PG8_MMA
#undef PG8_WAIT_V
#undef PG8_WAIT_L
#undef PG8_BAR
#undef PG8_SCHED
}
}

namespace {
constexpr int D = 1024, BATCH = 8, SEQ = 2048, NMETA = 16, TP = SEQ + NMETA, MP = BATCH * TP, SB = 128, M = MP + SB;
constexpr int DEPTH = 4, RH = 4, RDK = 256, RDV = 512, RV = 2048, RWIN = 6144;
constexpr int WH = 16, WN = 64, LW = 64, LA = 64, LV = 32, LG = 160, DFF = 2816;
constexpr int NRW = 3584, KRW = 2048, KL2 = 384, NL2 = 4096;
constexpr float PAST_POS = 16384.f;
constexpr int NWAVES = 8, NTHR = 512;
constexpr int LDS_BYTES = 147456;

constexpr size_t O_YP = 0;
constexpr size_t O_YS = O_YP + (size_t)BATCH * SEQ * D;
constexpr size_t O_RETP = O_YS + (size_t)SB * D;
constexpr size_t O_WKVP = O_RETP + (size_t)2 * BATCH * RH * RDK * RDV;
constexpr size_t O_SHP = O_WKVP + (size_t)2 * BATCH * WH * WN * WN;
constexpr size_t O_CVP = O_SHP + (size_t)2 * BATCH * D;
constexpr size_t O_RETS = O_CVP + (size_t)DEPTH * BATCH * 2 * DFF;
constexpr size_t O_WKVS = O_RETS + (size_t)2 * SB * RH * RDK * RDV;
constexpr size_t O_SHS = O_WKVS + (size_t)2 * SB * WH * WN * WN;
constexpr size_t O_CVS = O_SHS + (size_t)2 * SB * D;

enum { I_XP = 0, I_XS, I_SRET, I_SWKV, I_SSHIFT, I_SCONV, I_META, I_NMIX, I_NFFN, I_NFIN, I_RWIN, I_RGN, I_RWOUT, I_MU, I_WRKV, I_W0, I_W1, I_W2,
       I_A0, I_A1, I_A2, I_V0, I_V1, I_V2, I_G1, I_G2, I_KK, I_KA, I_RK, I_LNW, I_LNB, I_WO, I_WUG, I_CW, I_CB, I_WD, N_IN };

constexpr size_t al256(size_t x) { return (x + 255) & ~(size_t)255; }
constexpr size_t WS_CTL = 0;
constexpr size_t WS_CS = 1u << 20;
constexpr size_t WS_WIN = 4u << 20;
constexpr size_t SZ_WIN = (size_t)RWIN * D * 2;
constexpr size_t WS_WOUT = WS_WIN + 2 * SZ_WIN;
constexpr size_t SZ_WOUT = (size_t)D * RV * 2;
constexpr size_t WS_WRW = WS_WOUT + 2 * SZ_WOUT;
constexpr size_t SZ_WRW = (size_t)NRW * KRW * 2;
constexpr size_t WS_WL2 = WS_WRW + 2 * SZ_WRW;
constexpr size_t SZ_WL2 = (size_t)NL2 * KL2 * 2;
constexpr size_t WS_WO = WS_WL2 + 2 * SZ_WL2;
constexpr size_t SZ_WO = (size_t)D * D * 2;
constexpr size_t WS_WUG = WS_WO + 2 * SZ_WO;
constexpr size_t SZ_WUG = (size_t)2 * DFF * D * 2;
constexpr size_t WS_WD = WS_WUG + 4 * SZ_WUG;
constexpr size_t SZ_WD = (size_t)D * DFF * 2;
constexpr size_t WS_X = al256(WS_WD + 4 * SZ_WD);
constexpr size_t SZ_MD4 = (size_t)M * D * 4;
constexpr size_t WS_H = WS_X + SZ_MD4;
constexpr size_t WS_VF = WS_H + SZ_MD4;
constexpr size_t WS_REG = WS_VF + SZ_MD4;
constexpr size_t WS_QK = WS_REG;
constexpr size_t WS_V = WS_QK + SZ_MD4;
constexpr size_t WS_SG = WS_V + SZ_MD4;
constexpr size_t WS_O = WS_SG + SZ_MD4;
constexpr size_t WS_Y = WS_O + 2 * SZ_MD4;
constexpr size_t WS_R = WS_REG;
constexpr size_t WS_K = WS_R + SZ_MD4;
constexpr size_t WS_VB = WS_K + SZ_MD4;
constexpr size_t WS_WDEC = WS_VB + SZ_MD4;
constexpr size_t WS_NKK = WS_WDEC + SZ_MD4;
constexpr size_t WS_KKA = WS_NKK + SZ_MD4;
constexpr size_t WS_YW = WS_KKA + SZ_MD4;
constexpr size_t WS_L2 = WS_YW + SZ_MD4;
constexpr size_t WS_A2 = WS_L2 + 4 * SZ_MD4;
constexpr size_t WS_Z = al256(WS_A2 + (size_t)M * KL2 * 2);
constexpr size_t WS_RW_END = WS_Z + (size_t)M * D * 2;
constexpr size_t SZ_FF2 = (size_t)M * DFF * 2;
constexpr size_t WS_U = WS_REG;
constexpr size_t WS_G = al256(WS_U + SZ_FF2);
constexpr size_t WS_ACT = al256(WS_G + SZ_FF2);
constexpr size_t WS_XB = al256(WS_RW_END) + 2 * (size_t)D * 2;
constexpr size_t WS_SS = al256(WS_XB + (size_t)(M + 126) * D * 2);
constexpr size_t WS_PTRS = al256(WS_SS + (size_t)8 * M * 16 * 4);
constexpr size_t WS_END = WS_PTRS + 256;

#define LAS __attribute__((address_space(3)))
typedef unsigned short bf16;
typedef unsigned v4u __attribute__((ext_vector_type(4)));
typedef unsigned v2u __attribute__((ext_vector_type(2)));
using pg8::f32x4;
using pg8::Unit;
using pg8::bf16x8;

struct Params { const float* in[N_IN]; float* out; unsigned char* ws; };

__device__ __forceinline__ unsigned cvt_pk_bf16(float lo, float hi) { unsigned r; asm("v_cvt_pk_bf16_f32 %0, %1, %2" : "=v"(r) : "v"(lo), "v"(hi)); return r; }
__device__ __forceinline__ float bf_lo(unsigned w) { return __uint_as_float(w << 16); }
__device__ __forceinline__ float bf_hi(unsigned w) { return __uint_as_float(w & 0xffff0000u); }
__device__ __forceinline__ void unpack8(const v4u w, float (&f)[8]) { f[0] = bf_lo(w.x); f[1] = bf_hi(w.x); f[2] = bf_lo(w.y); f[3] = bf_hi(w.y); f[4] = bf_lo(w.z); f[5] = bf_hi(w.z); f[6] = bf_lo(w.w); f[7] = bf_hi(w.w); }
__device__ __forceinline__ v4u pack8(const float (&f)[8]) { v4u w; w.x = cvt_pk_bf16(f[0], f[1]); w.y = cvt_pk_bf16(f[2], f[3]); w.z = cvt_pk_bf16(f[4], f[5]); w.w = cvt_pk_bf16(f[6], f[7]); return w; }
__device__ __forceinline__ f32x4 ld_bf4(const bf16* q) { const v2u w = *(const v2u*)q; return (f32x4){bf_lo(w.x), bf_hi(w.x), bf_lo(w.y), bf_hi(w.y)}; }
__device__ __forceinline__ void st_bf4(bf16* q, const f32x4 v) { v2u w; w.x = cvt_pk_bf16(v.x, v.y); w.y = cvt_pk_bf16(v.z, v.w); *(v2u*)q = w; }
__device__ __forceinline__ float shfl_xor_l(float v, int m, int lane) { return __int_as_float(__builtin_amdgcn_ds_bpermute((lane ^ m) << 2, __float_as_int(v))); }
__device__ __forceinline__ float shfl_l(float v, int src) { return __int_as_float(__builtin_amdgcn_ds_bpermute(src << 2, __float_as_int(v))); }
__device__ __forceinline__ float wave_sum(float v, int) {
    v += __builtin_bit_cast(float, __builtin_amdgcn_update_dpp(0, __float_as_int(v), 0x128, 0xf, 0xf, false));
    v += __builtin_bit_cast(float, __builtin_amdgcn_update_dpp(0, __float_as_int(v), 0x124, 0xf, 0xf, false));
    v += __builtin_bit_cast(float, __builtin_amdgcn_update_dpp(0, __float_as_int(v), 0x122, 0xf, 0xf, false));
    v += __builtin_bit_cast(float, __builtin_amdgcn_update_dpp(0, __float_as_int(v), 0x121, 0xf, 0xf, false));
    const int vi = __float_as_int(v);
    return (__int_as_float(__builtin_amdgcn_readlane(vi, 0)) + __int_as_float(__builtin_amdgcn_readlane(vi, 16))) + (__int_as_float(__builtin_amdgcn_readlane(vi, 32)) + __int_as_float(__builtin_amdgcn_readlane(vi, 48)));
}
__device__ __forceinline__ float rcpf_(float x) { return __builtin_amdgcn_rcpf(x); }
__device__ __forceinline__ float sigmoidf_(float x) { return rcpf_(1.f + __expf(-x)); }
__device__ __forceinline__ float siluf_(float x) { return x * rcpf_(1.f + __expf(-x)); }
__device__ __forceinline__ float tanhf_(float x) { return 1.f - 2.f * rcpf_(1.f + __expf(2.f * x)); }

__device__ __forceinline__ float row_rstd(const unsigned char* ws, int slot, int row) {
    const f32x4* q = (const f32x4*)((const float*)(ws + WS_SS) + ((size_t)slot * M + row) * 16);
    const f32x4 a = q[0], b = q[1], c = q[2], d = q[3];
    const float ss = (((a.x + a.y) + (a.z + a.w)) + ((b.x + b.y) + (b.z + b.w))) + (((c.x + c.y) + (c.z + c.w)) + ((d.x + d.y) + (d.z + d.w)));
    return rsqrtf(ss * (1.f / D) + 1e-6f);
}
__device__ __forceinline__ float dpp_ror1(float v) { return __int_as_float(__builtin_amdgcn_update_dpp(0, __float_as_int(v), 0x121, 0xf, 0xf, false)); }
__device__ __forceinline__ float dpp_ror2(float v) { return __int_as_float(__builtin_amdgcn_update_dpp(0, __float_as_int(v), 0x122, 0xf, 0xf, false)); }
enum { EK_RETIN = 0, EK_RESID, EK_UG, EK_RWPROJ, EK_F32 };
template <int GRP> struct EpiExtra {};
template <> struct EpiExtra<1> { const float* pcw; const float* pcb; const float* pcst; float* pout; };
template <int GRP> struct EpiAnyT : EpiExtra<GRP> {
    static constexpr bool AFTER_DRAIN = false;
    int kind; bool perm; int jl; unsigned char* ws; int slot; const LAS float* rtab; float amul; int li; LAS unsigned char* ldsb;
    __device__ __forceinline__ void operator()(const f32x4 (&acc)[2][2][4][2], const Unit& u, int wr, int wc, int fr, int fq) const {
        const int row0 = u.pm * 256 + wr * 64 + fr;
        if (GRP == 0 && kind == EK_RETIN) {
            bf16* QK = (bf16*)(ws + WS_QK); bf16* V = (bf16*)(ws + WS_V); bf16* SG = (bf16*)(ws + WS_SG); const float* CS = (const float*)(ws + WS_CS);
            const int cw = wc * 32 + 8 * fq;
            if (u.pn < 8) {
                const bool isk = u.pn >= 4; const int h = u.pn & 3; const float sc = isk ? 0.0625f : 1.f;
                bf16* base = QK + (isk ? 1024 : 0) + h * 256 + cw;
#pragma unroll
                for (int ai = 0; ai < 2; ++ai) {
                    f32x4 tt[4][4];
#pragma unroll
                    for (int m = 0; m < 4; ++m) { const int row = row0 + ai * 128 + m * 16; const int pi = row < MP ? row % TP : TP;
                        const f32x4* cs = (const f32x4*)(CS + ((size_t)pi * 128 + cw) * 2);
#pragma unroll
                        for (int q4 = 0; q4 < 4; ++q4) tt[m][q4] = cs[q4]; }
#pragma unroll
                    for (int m = 0; m < 4; ++m) {
                        const int row = row0 + ai * 128 + m * 16;
                        const float rs = rtab[u.ord * 256 + (row - u.pm * 256)] * sc;
                        const f32x4 t0 = tt[m][0], t1 = tt[m][1], t2 = tt[m][2], t3 = tt[m][3];
                        const float c[8] = {t0.x, t0.z, t1.x, t1.z, t2.x, t2.z, t3.x, t3.z}, s[8] = {t0.y, t0.w, t1.y, t1.w, t2.y, t2.w, t3.y, t3.w};
                        float o1[8], o2[8];
#pragma unroll
                        for (int n = 0; n < 2; ++n)
#pragma unroll
                            for (int j = 0; j < 4; ++j) {
                                const float x1 = acc[ai][0][m][n][j], x2 = acc[ai][1][m][n][j];
                                o1[n * 4 + j] = (x1 * c[n * 4 + j] - x2 * s[n * 4 + j]) * rs;
                                o2[n * 4 + j] = (x1 * s[n * 4 + j] + x2 * c[n * 4 + j]) * rs;
                            }
                        bf16* rp = base + (size_t)row * 2048;
                        *(v4u*)rp = pack8(o1); *(v4u*)(rp + 128) = pack8(o2);
                    }
                    asm volatile("" ::: "memory");
                }
            } else {
                const bool isg = u.pn >= 16;
                bf16* base = (isg ? SG : V) + ((u.pn - (isg ? 16 : 8)) * 256) + cw;
#pragma unroll
                for (int ai = 0; ai < 2; ++ai)
#pragma unroll
                    for (int m = 0; m < 4; ++m) {
                        bf16* rp = base + (size_t)(row0 + ai * 128 + m * 16) * 2048;
                        const float rs = rtab[u.ord * 256 + (wr * 64 + fr + ai * 128 + m * 16)];
#pragma unroll
                        for (int bj = 0; bj < 2; ++bj) {
                            float o[8];
#pragma unroll
                            for (int n = 0; n < 2; ++n)
#pragma unroll
                                for (int j = 0; j < 4; ++j) { const float x = acc[ai][bj][m][n][j] * rs; o[n * 4 + j] = isg ? siluf_(x) : x; }
                            *(v4u*)(rp + bj * 128) = pack8(o);
                        }
                    }
            }
        } else if (GRP == 0 && kind == EK_RESID) {
            float* X = (float*)(ws + WS_X);
            const int col0 = u.pn * 256 + wc * 32 + 4 * fq;
#pragma unroll
            for (int am = 0; am < 4; ++am) { const int ai = am >> 1, mb = (am & 1) * 2;
                f32x4 xv[2][2][2];
#pragma unroll
                for (int mm = 0; mm < 2; ++mm) { const int m = mb + mm; const float* rp = X + (size_t)(row0 + ai * 128 + m * 16) * D + col0;
#pragma unroll
                    for (int bj = 0; bj < 2; ++bj)
#pragma unroll
                        for (int n = 0; n < 2; ++n) xv[mm][bj][n] = *(const f32x4*)(rp + bj * 128 + n * 16); }
#pragma unroll
                for (int mm = 0; mm < 2; ++mm) { const int m = mb + mm;
                    const int row = row0 + ai * 128 + m * 16;
                    float* rp = X + (size_t)row * D + col0; bf16* xb = (bf16*)(ws + WS_XB) + (size_t)row * D + col0;
                    float ssq = 0.f;
#pragma unroll
                    for (int bj = 0; bj < 2; ++bj)
#pragma unroll
                        for (int n = 0; n < 2; ++n) { const f32x4 v = xv[mm][bj][n] + acc[ai][bj][m][n] * amul; *(f32x4*)(rp + bj * 128 + n * 16) = v;
                            if (slot >= 0) { ssq += (v.x * v.x + v.y * v.y) + (v.z * v.z + v.w * v.w); v2u w; w.x = cvt_pk_bf16(v.x, v.y); w.y = cvt_pk_bf16(v.z, v.w); *(v2u*)(xb + bj * 128 + n * 16) = w; } }
                    if (slot >= 0) { ssq += shfl_xor_l(ssq, 16, fq * 16 + fr); ssq += shfl_xor_l(ssq, 32, fq * 16 + fr); if (fq == 0) ((float*)(ws + WS_SS))[((size_t)slot * M + row) * 16 + u.pn * 4 + wc] = ssq; }
                }
                asm volatile("" ::: "memory");
            }
        } else if (GRP == 1 && kind == EK_UG) {
            const EpiExtra<1>& X1 = *(const EpiExtra<1>*)(const void*)this;
            const float* cw = X1.pcw + (size_t)li * 3 * DFF; const float* cb = X1.pcb + (size_t)li * DFF; const float* cst = X1.pcst + (size_t)li * SB * 2 * DFF;
            float* cvp = X1.pout + O_CVP + (size_t)li * BATCH * 2 * DFF; float* cvs = X1.pout + O_CVS + (size_t)li * SB * 2 * DFF;
            bf16* ACT = (bf16*)(ws + WS_ACT);
            const int fl = wc * 32 + 8 * fq;
            LAS float* halo = (LAS float*)(ldsb + 131072 + 8192);
            const LAS float* rt = rtab + u.ord * 256;
#pragma unroll
            for (int ai = 0; ai < 2; ++ai) if (fr >= 14) {
                const float rs = rt[128 * ai + 64 * wr + 48 + fr];
                LAS float* hp = halo + ((2 * ai + wr) * 2 + (fr - 14)) * 128 + fl;
                *(LAS f32x4*)hp = acc[ai][1][3][0] * rs; *(LAS f32x4*)(hp + 4) = acc[ai][1][3][1] * rs;
            }
            asm volatile("s_waitcnt lgkmcnt(0)" ::: "memory"); __builtin_amdgcn_s_barrier(); asm volatile("" ::: "memory");
#pragma unroll
            for (int n = 0; n < 2; ++n) {
                const int f0 = u.pn * 128 + fl + 4 * n;
                const f32x4 w0 = *(const f32x4*)(cw + f0), w1 = *(const f32x4*)(cw + DFF + f0), w2 = *(const f32x4*)(cw + 2 * DFF + f0), bb = *(const f32x4*)(cb + f0);
                f32x4 prev = (f32x4){0.f, 0.f, 0.f, 0.f};
#pragma unroll
                for (int ai = 0; ai < 2; ++ai)
#pragma unroll
                    for (int m = 0; m < 4; ++m) {
                        const int l = 128 * ai + 64 * wr + 16 * m + fr, row = 254 * u.pm - 2 + l;
                        const float rs = rt[l];
                        const f32x4 cur = acc[ai][1][m][n] * rs, uu = acc[ai][0][m][n] * rs;
                        if (m == 0) {
                            const int B = 2 * ai + wr;
                            prev = (f32x4){0.f, 0.f, 0.f, 0.f};
                            if (B > 0 && fr >= 14) prev = *(const LAS f32x4*)(halo + ((B - 1) * 2 + (fr - 14)) * 128 + fl + 4 * n);
                        }
                        f32x4 g1, g2;
                        {
                            const float c1x = dpp_ror1(cur.x), c1y = dpp_ror1(cur.y), c1z = dpp_ror1(cur.z), c1w = dpp_ror1(cur.w);
                            const float p1x = dpp_ror1(prev.x), p1y = dpp_ror1(prev.y), p1z = dpp_ror1(prev.z), p1w = dpp_ror1(prev.w);
                            const float c2x = dpp_ror2(cur.x), c2y = dpp_ror2(cur.y), c2z = dpp_ror2(cur.z), c2w = dpp_ror2(cur.w);
                            const float p2x = dpp_ror2(prev.x), p2y = dpp_ror2(prev.y), p2z = dpp_ror2(prev.z), p2w = dpp_ror2(prev.w);
                            const bool s1 = fr >= 1, s2 = fr >= 2;
                            g1.x = s1 ? c1x : p1x; g1.y = s1 ? c1y : p1y; g1.z = s1 ? c1z : p1z; g1.w = s1 ? c1w : p1w;
                            g2.x = s2 ? c2x : p2x; g2.y = s2 ? c2y : p2y; g2.z = s2 ? c2z : p2z; g2.w = s2 ? c2w : p2w;
                        }
                        if (l >= 2 && row < M) {
                            if (row < MP) {
                                const int b = row / TP, t = row - b * TP;
                                if (t < 2) { g2 = (f32x4){0.f, 0.f, 0.f, 0.f}; if (t == 0) g1 = g2; }
                                if (t >= TP - 2) *(f32x4*)(cvp + ((size_t)b * 2 + (t - (TP - 2))) * DFF + f0) = cur;
                            } else {
                                const int s = row - MP;
                                const float* c0 = cst + ((size_t)s * 2 + 0) * DFF + f0;
                                g2 = *(const f32x4*)c0; g1 = *(const f32x4*)(c0 + DFF);
                                float* o = cvs + ((size_t)s * 2 + 0) * DFF + f0;
                                *(f32x4*)o = g1; *(f32x4*)(o + DFF) = cur;
                            }
                            const f32x4 cv = bb + w0 * g2 + w1 * g1 + w2 * cur;
                            v2u w; w.x = cvt_pk_bf16(siluf_(cv.x) * uu.x, siluf_(cv.y) * uu.y); w.y = cvt_pk_bf16(siluf_(cv.z) * uu.z, siluf_(cv.w) * uu.w);
                            *(v2u*)(ACT + (size_t)row * DFF + f0) = w;
                        }
                        prev = cur;
                    }
            }
        } else if (GRP == 0 && kind == EK_RWPROJ) {
            const int cw = wc * 32 + 8 * fq;
            if (u.pn < 12) {
                bf16* dst = (bf16*)(ws + (u.pn < 4 ? WS_R : (u.pn < 8 ? WS_K : (jl == 0 ? WS_VF : WS_VB)))) + (u.pn & 3) * 256 + cw;
#pragma unroll
                for (int ai = 0; ai < 2; ++ai)
#pragma unroll
                    for (int m = 0; m < 4; ++m) {
                        bf16* rp = dst + (size_t)(row0 + ai * 128 + m * 16) * D;
#pragma unroll
                        for (int bj = 0; bj < 2; ++bj) { float o[8];
#pragma unroll
                            for (int n = 0; n < 2; ++n)
#pragma unroll
                                for (int j = 0; j < 4; ++j) o[n * 4 + j] = acc[ai][bj][m][n][j];
                            *(v4u*)(rp + bj * 128) = pack8(o); }
                    }
            } else {
                bf16* A2 = (bf16*)(ws + WS_A2);
#pragma unroll
                for (int bj = 0; bj < 2; ++bj) {
                    const int c = (u.pn - 12) * 256 + bj * 128 + cw;
                    if (c < KL2) {
                        const int kd = c < 64 ? 1 : ((c >= 128 && c < 288) ? 2 : 0);
#pragma unroll
                        for (int ai = 0; ai < 2; ++ai)
#pragma unroll
                            for (int m = 0; m < 4; ++m) { float o[8];
#pragma unroll
                                for (int n = 0; n < 2; ++n)
#pragma unroll
                                    for (int j = 0; j < 4; ++j) { const float x = acc[ai][bj][m][n][j]; o[n * 4 + j] = kd == 1 ? tanhf_(x) : (kd == 2 ? sigmoidf_(x) : x); }
                                *(v4u*)(A2 + (size_t)(row0 + ai * 128 + m * 16) * KL2 + c) = pack8(o); }
                    }
                }
            }
        } else if (GRP == 0) {
            bf16* C = (bf16*)(ws + WS_L2);
            const int col0 = u.pn * 256 + wc * 32 + 8 * fq;
#pragma unroll
            for (int ai = 0; ai < 2; ++ai)
#pragma unroll
                for (int m = 0; m < 4; ++m) {
                    bf16* rp = C + (size_t)(row0 + ai * 128 + m * 16) * NL2 + col0;
#pragma unroll
                    for (int bj = 0; bj < 2; ++bj) { float o[8];
#pragma unroll
                        for (int n = 0; n < 2; ++n)
#pragma unroll
                            for (int j = 0; j < 4; ++j) o[n * 4 + j] = acc[ai][bj][m][n][j];
                        *(v4u*)(rp + bj * 128) = pack8(o); }
                }
        }
    }
};

constexpr int MT0 = 16384;
__device__ __forceinline__ void tail_resid(const bf16* __restrict__ A, const bf16* __restrict__ Bt, int K, unsigned char* ws, int slot, float amul, LAS unsigned char* lds, int lane, int wave) {
    const int fr = lane & 15, fq = lane >> 4;
    float* X = (float*)(ws + WS_X);
    const int kw = K >> 3;
    for (int job = blockIdx.x; job < 16 * 16; job += gridDim.x) {
        const int rs = job >> 4, cs = job & 15;
        const bf16* ap = A + (size_t)(MT0 + 16 * rs + fr) * K + wave * kw + 8 * fq;
        const bf16* bp = Bt + (size_t)(64 * cs + fr) * K + wave * kw + 8 * fq;
        f32x4 acc[4];
#pragma unroll
        for (int t = 0; t < 4; ++t) acc[t] = (f32x4){0.f, 0.f, 0.f, 0.f};
#pragma unroll 4
        for (int k0 = 0; k0 < kw; k0 += 32) {
            const bf16x8 af = *(const bf16x8*)(ap + k0);
#pragma unroll
            for (int t = 0; t < 4; ++t) { const bf16x8 bf = *(const bf16x8*)(bp + (size_t)(16 * t) * K + k0); acc[t] = __builtin_amdgcn_mfma_f32_16x16x32_bf16(bf, af, acc[t], 0, 0, 0); }
        }
        __syncthreads();
#pragma unroll
        for (int t = 0; t < 4; ++t) *(LAS f32x4*)(lds + ((wave * 4 + t) * 64 + lane) * 16) = acc[t];
        __syncthreads();
        if (wave == 0) {
#pragma unroll
            for (int t = 0; t < 4; ++t) { f32x4 s = acc[t];
#pragma unroll
                for (int w = 1; w < 8; ++w) s += *(LAS f32x4*)(lds + ((w * 4 + t) * 64 + lane) * 16);
                acc[t] = s; }
            const int row = MT0 + 16 * rs + fr;
            float* rp = X + (size_t)row * D + 64 * cs + 4 * fq; bf16* xb = (bf16*)(ws + WS_XB) + (size_t)row * D + 64 * cs + 4 * fq;
            float ssq = 0.f;
#pragma unroll
            for (int t = 0; t < 4; ++t) { const f32x4 v = *(const f32x4*)(rp + 16 * t) + acc[t] * amul; *(f32x4*)(rp + 16 * t) = v;
                if (slot >= 0) { ssq += (v.x * v.x + v.y * v.y) + (v.z * v.z + v.w * v.w); v2u w; w.x = cvt_pk_bf16(v.x, v.y); w.y = cvt_pk_bf16(v.z, v.w); *(v2u*)(xb + 16 * t) = w; } }
            if (slot >= 0) { ssq += shfl_xor_l(ssq, 16, lane); ssq += shfl_xor_l(ssq, 32, lane); if (fq == 0) ((float*)(ws + WS_SS))[((size_t)slot * M + row) * 16 + cs] = ssq; }
        }
    }
}

__device__ __forceinline__ void tr_item(const float* __restrict__ W, int ldw, int k0, int n0, bf16* __restrict__ WT, int ldt, int drow, const float* __restrict__ mu, LAS float* scr, int lane, const float* __restrict__ gs = nullptr) {
#pragma unroll 8
    for (int i = 0; i < 32; ++i) { const int kk = 2 * i + (lane >> 5); scr[kk * 33 + (lane & 31)] = W[(size_t)(k0 + kk) * ldw + n0 + (lane & 31)]; }
    asm volatile("s_waitcnt lgkmcnt(0)" ::: "memory");
    const int c = lane & 7;
    float mv[8];
    if (mu) {
#pragma unroll
        for (int e = 0; e < 8; ++e) mv[e] = mu[k0 + 8 * c + e];
    } else if (gs) {
#pragma unroll
        for (int e = 0; e < 8; ++e) mv[e] = gs[k0 + 8 * c + e];
    }
#pragma unroll
    for (int j = 0; j < 4; ++j) {
        const int n = (lane >> 3) + 8 * j; const LAS float* s = scr + (8 * c) * 33 + n;
        float f[8];
#pragma unroll
        for (int e = 0; e < 8; ++e) f[e] = s[e * 33];
        bf16* dp = WT + (size_t)(drow + n) * ldt + k0 + 8 * c;
        if (mu) {
            float f1[8], f2[8];
#pragma unroll
            for (int e = 0; e < 8; ++e) { f1[e] = f[e] * (1.f - mv[e]); f2[e] = f[e] * mv[e]; }
            *(v4u*)dp = pack8(f1); *(v4u*)(dp + 1024) = pack8(f2);
        } else { if (gs) {
#pragma unroll
            for (int e = 0; e < 8; ++e) f[e] *= mv[e]; }
            *(v4u*)dp = pack8(f); }
    }
    asm volatile("s_waitcnt lgkmcnt(0)" ::: "memory");
}

__device__ __forceinline__ void ph_p0(const Params& p, LAS unsigned char* lds, int tid, int lane, int wave) {
    unsigned char* ws = p.ws;
    LAS float* scr = (LAS float*)(lds + wave * 16384);
    const int gw = blockIdx.x * NWAVES + wave, NGW = gridDim.x * NWAVES;
    constexpr int C_WIN = 2 * 16 * 192, C_WOUT = 2 * 32 * 32, C_RKV = 2 * 3 * 512, C_W1 = 2 * 32, C_A1 = 2 * 32, C_G1 = 2 * 80, C_V1 = 16, C_WO = 2 * 512, C_WUG = 4 * 16 * 176, C_WD = 4 * 44 * 32;
    constexpr int NITEMS = C_WIN + C_WOUT + C_RKV + C_W1 + C_A1 + C_G1 + C_V1 + C_WO + C_WUG + C_WD;
    for (int it = gw; it < NITEMS; it += NGW) {
        int r = it;
        if (r < C_WIN) { const int j = r / 3072, q = r % 3072, kb = q / 192, nb = q % 192;
            tr_item(p.in[I_RWIN] + (size_t)j * D * RWIN, RWIN, 64 * kb, 32 * nb, (bf16*)(ws + WS_WIN + j * SZ_WIN), D, 32 * nb, nullptr, scr, lane, p.in[I_NMIX] + (size_t)(2 * j) * D); continue; }
        r -= C_WIN;
        if (r < C_WOUT) { const int j = r / 1024, q = r % 1024, kb = q / 32, nb = q % 32;
            tr_item(p.in[I_RWOUT] + (size_t)j * RV * D, D, 64 * kb, 32 * nb, (bf16*)(ws + WS_WOUT + j * SZ_WOUT), RV, 32 * nb, nullptr, scr, lane); continue; }
        r -= C_WOUT;
        if (r < C_RKV) { const int j = r / 1536, q = r % 1536, s = q / 512, q2 = q % 512, kb = q2 / 32, nb = q2 % 32, c = (s == 0 ? 0 : (s == 1 ? 2 : 3));
            tr_item(p.in[I_WRKV] + (size_t)(j * 3 + s) * D * D, D, 64 * kb, 32 * nb, (bf16*)(ws + WS_WRW + j * SZ_WRW), KRW, s * 1024 + 32 * nb, p.in[I_MU] + (size_t)(j * 6 + c) * D, scr, lane); continue; }
        r -= C_RKV;
        if (r < C_W1) { const int j = r / 32, q = r % 32, kb = q / 2, nb = q % 2;
            tr_item(p.in[I_W1] + (size_t)j * D * LW, LW, 64 * kb, 32 * nb, (bf16*)(ws + WS_WRW + j * SZ_WRW), KRW, 3072 + 32 * nb, p.in[I_MU] + (size_t)(j * 6 + 1) * D, scr, lane); continue; }
        r -= C_W1;
        if (r < C_A1) { const int j = r / 32, q = r % 32, kb = q / 2, nb = q % 2;
            tr_item(p.in[I_A1] + (size_t)j * D * LA, LA, 64 * kb, 32 * nb, (bf16*)(ws + WS_WRW + j * SZ_WRW), KRW, 3136 + 32 * nb, p.in[I_MU] + (size_t)(j * 6 + 4) * D, scr, lane); continue; }
        r -= C_A1;
        if (r < C_G1) { const int j = r / 80, q = r % 80, kb = q / 5, nb = q % 5;
            tr_item(p.in[I_G1] + (size_t)j * D * LG, LG, 64 * kb, 32 * nb, (bf16*)(ws + WS_WRW + j * SZ_WRW), KRW, 3200 + 32 * nb, p.in[I_MU] + (size_t)(j * 6 + 5) * D, scr, lane); continue; }
        r -= C_G1;
        if (r < C_V1) { const int kb = r;
            tr_item(p.in[I_V1], LV, 64 * kb, 0, (bf16*)(ws + WS_WRW + 1 * SZ_WRW), KRW, 3360, p.in[I_MU] + (size_t)(1 * 6 + 3) * D, scr, lane); continue; }
        r -= C_V1;
        if (r < C_WO) { const int j = r / 512, q = r % 512, kb = q / 32, nb = q % 32;
            tr_item(p.in[I_WO] + (size_t)j * D * D, D, 64 * kb, 32 * nb, (bf16*)(ws + WS_WO + j * SZ_WO), D, 32 * nb, nullptr, scr, lane); continue; }
        r -= C_WO;
        if (r < C_WUG) { const int i = r / 2816, q = r % 2816, kb = q / 176, nb = q % 176, n0 = 32 * nb;
            const int drow = n0 < DFF ? 256 * (n0 / 128) + (n0 % 128) : 256 * ((n0 - DFF) / 128) + 128 + ((n0 - DFF) % 128);
            tr_item(p.in[I_WUG] + (size_t)i * D * 2 * DFF, 2 * DFF, 64 * kb, n0, (bf16*)(ws + WS_WUG + i * SZ_WUG), D, drow, nullptr, scr, lane, p.in[I_NFFN] + (size_t)i * D); continue; }
        r -= C_WUG;
        { const int i = r / 1408, q = r % 1408, kb = q / 32, nb = q % 32;
            tr_item(p.in[I_WD] + (size_t)i * DFF * D, D, 64 * kb, 32 * nb, (bf16*)(ws + WS_WD + i * SZ_WD), DFF, 32 * nb, nullptr, scr, lane); }
    }
    const size_t gt = (size_t)blockIdx.x * NTHR + tid, GT = (size_t)gridDim.x * NTHR;
    for (size_t i = gt; i < (size_t)(224 + 192) * (KRW / 8); i += GT) {
        const int rr = (int)(i / (KRW / 8)), c8 = (int)(i % (KRW / 8));
        const int j = rr < 224 ? 0 : 1, row = rr < 224 ? 3360 + rr : 3392 + (rr - 224);
        *(v4u*)((bf16*)(ws + WS_WRW + j * SZ_WRW) + (size_t)row * KRW + c8 * 8) = (v4u){0u, 0u, 0u, 0u};
    }
    for (size_t i = gt; i < (size_t)2 * NL2 * KL2; i += GT) {
        const int j = (int)(i / ((size_t)NL2 * KL2)); const int rem = (int)(i % ((size_t)NL2 * KL2)); const int n = rem / KL2, k = rem % KL2, grp = n >> 10, nn = n & 1023;
        float v = 0.f;
        if (grp == 0) { if (k < 64) v = p.in[I_W2][((size_t)j * LW + k) * D + nn]; }
        else if (grp == 1) { if (k >= 64 && k < 128) v = p.in[I_A2][((size_t)j * LA + (k - 64)) * D + nn]; }
        else if (grp == 2) { if (k >= 128 && k < 288) v = p.in[I_G2][((size_t)j * LG + (k - 128)) * D + nn]; }
        else { if (j == 1 && k >= 288 && k < 320) v = p.in[I_V2][((size_t)(k - 288)) * D + nn]; }
        ((bf16*)(ws + WS_WL2 + j * SZ_WL2))[(size_t)n * KL2 + k] = (bf16)(cvt_pk_bf16(v, 0.f) & 0xffffu);
    }
    for (size_t i = gt; i < (size_t)(TP + 1) * 128; i += GT) {
        const int pi = (int)(i >> 7), mi = (int)(i & 127);
        const float pos = pi < TP ? (float)pi : PAST_POS;
        const float inv = 1.0f / powf(10000.0f, (float)mi / 127.0f);
        float s, c; sincosf(pos * inv, &s, &c);
        ((float2*)(ws + WS_CS))[i] = make_float2(c, s);
    }
    float* X = (float*)(ws + WS_X); bf16* XB = (bf16*)(ws + WS_XB);
    for (int r = gw; r < M; r += NGW) {
        const float* src;
        if (r < MP) { const int b = r / TP, t = r % TP; src = t < NMETA ? p.in[I_META] + (size_t)t * D : p.in[I_XP] + ((size_t)b * SEQ + (t - NMETA)) * D; }
        else src = p.in[I_XS] + (size_t)(r - MP) * D;
        float ss = 0.f;
#pragma unroll
        for (int j = 0; j < 2; ++j) { const int c0 = 512 * j + 8 * lane;
            const f32x4 a4 = *(const f32x4*)(src + c0), b4 = *(const f32x4*)(src + c0 + 4);
            *(f32x4*)(X + (size_t)r * D + c0) = a4; *(f32x4*)(X + (size_t)r * D + c0 + 4) = b4;
            const float f[8] = {a4.x, a4.y, a4.z, a4.w, b4.x, b4.y, b4.z, b4.w};
#pragma unroll
            for (int e = 0; e < 8; ++e) ss += f[e] * f[e];
            *(v4u*)(XB + (size_t)r * D + c0) = pack8(f); }
        ss = wave_sum(ss, lane);
        if (lane < 16) ((float*)(ws + WS_SS))[(size_t)r * 16 + lane] = lane == 0 ? ss : 0.f;
    }
}

__device__ __forceinline__ void ph_norm(const Params& p, const float* __restrict__ g, int mode, int jl, int lane, int wave) {
    const float* X = (const float*)(p.ws + WS_X); bf16* H = (bf16*)(p.ws + WS_H);
    const int gw = blockIdx.x * NWAVES + wave, NGW = gridDim.x * NWAVES;
    for (int row = gw; row < M; row += NGW) {
        const float* xr = X + (size_t)row * D;
        float v[2][8]; float ss = 0.f;
#pragma unroll
        for (int j = 0; j < 2; ++j) {
            const f32x4 a = *(const f32x4*)(xr + 512 * j + 8 * lane), b = *(const f32x4*)(xr + 512 * j + 8 * lane + 4);
            v[j][0] = a.x; v[j][1] = a.y; v[j][2] = a.z; v[j][3] = a.w; v[j][4] = b.x; v[j][5] = b.y; v[j][6] = b.z; v[j][7] = b.w;
#pragma unroll
            for (int e = 0; e < 8; ++e) ss += v[j][e] * v[j][e];
        }
        ss = wave_sum(ss, lane);
        const float rstd = rsqrtf(ss * (1.f / D) + 1e-6f);
        const bool prompt = row < MP; const int b = prompt ? row / TP : 0, t = prompt ? row % TP : 0;
#pragma unroll
        for (int j = 0; j < 2; ++j) {
            const int c0 = 512 * j + 8 * lane;
            const f32x4 ga = *(const f32x4*)(g + c0), gb = *(const f32x4*)(g + c0 + 4);
            float o[8];
            o[0] = v[j][0] * rstd * ga.x; o[1] = v[j][1] * rstd * ga.y; o[2] = v[j][2] * rstd * ga.z; o[3] = v[j][3] * rstd * ga.w;
            o[4] = v[j][4] * rstd * gb.x; o[5] = v[j][5] * rstd * gb.y; o[6] = v[j][6] * rstd * gb.z; o[7] = v[j][7] * rstd * gb.w;
            if (mode == 0) { *(v4u*)(H + (size_t)row * D + c0) = pack8(o); }
            else if (mode == 1) {
                const v4u w = pack8(o);
                *(v4u*)(H + (size_t)row * 2048 + c0) = w;
                if (prompt) {
                    if (t != TP - 1) *(v4u*)(H + (size_t)(row + 1) * 2048 + 1024 + c0) = w;
                    else { float* so = p.out + O_SHP + ((size_t)jl * BATCH + b) * D + c0; *(f32x4*)so = (f32x4){o[0], o[1], o[2], o[3]}; *(f32x4*)(so + 4) = (f32x4){o[4], o[5], o[6], o[7]}; }
                    if (t == 0) *(v4u*)(H + (size_t)row * 2048 + 1024 + c0) = (v4u){0u, 0u, 0u, 0u};
                } else {
                    const int s = row - MP;
                    const float* sp = p.in[I_SSHIFT] + ((size_t)jl * SB + s) * D + c0;
                    const f32x4 sa = *(const f32x4*)sp, sb2 = *(const f32x4*)(sp + 4);
                    const float pv[8] = {sa.x, sa.y, sa.z, sa.w, sb2.x, sb2.y, sb2.z, sb2.w};
                    *(v4u*)(H + (size_t)row * 2048 + 1024 + c0) = pack8(pv);
                    float* so = p.out + O_SHS + ((size_t)jl * SB + s) * D + c0; *(f32x4*)so = (f32x4){o[0], o[1], o[2], o[3]}; *(f32x4*)(so + 4) = (f32x4){o[4], o[5], o[6], o[7]};
                }
            } else {
                float* dst = nullptr;
                if (prompt) { if (t >= NMETA) dst = p.out + O_YP + ((size_t)b * SEQ + (t - NMETA)) * D + c0; }
                else dst = p.out + O_YS + (size_t)(row - MP) * D + c0;
                if (dst) { *(f32x4*)dst = (f32x4){o[0], o[1], o[2], o[3]}; *(f32x4*)(dst + 4) = (f32x4){o[4], o[5], o[6], o[7]}; }
            }
        }
    }
}

__device__ __forceinline__ void ph_ret_norm(const Params& p, int jl, int lane, int wave) {
    const float* O = (const float*)(p.ws + WS_O); const bf16* SG = (const bf16*)(p.ws + WS_SG); bf16* Y = (bf16*)(p.ws + WS_Y);
    const float* gnw = p.in[I_RGN] + (size_t)jl * RV;
    const int gw = blockIdx.x * NWAVES + wave, NGW = gridDim.x * NWAVES;
    for (int it = gw; it < M * RH; it += NGW) {
        const int row = it >> 2, h = it & 3; const size_t off = (size_t)row * RV + h * RDV + 8 * lane;
        const f32x4 a = *(const f32x4*)(O + off), b = *(const f32x4*)(O + off + 4);
        float v[8] = {a.x, a.y, a.z, a.w, b.x, b.y, b.z, b.w};
        float s = 0.f;
#pragma unroll
        for (int e = 0; e < 8; ++e) s += v[e];
        const float mean = wave_sum(s, lane) * (1.f / RDV);
        float s2 = 0.f;
#pragma unroll
        for (int e = 0; e < 8; ++e) { v[e] -= mean; s2 += v[e] * v[e]; }
        const float rstd = rsqrtf(wave_sum(s2, lane) * (1.f / RDV) + 1e-5f);
        float sg[8]; unpack8(*(const v4u*)(SG + off), sg);
        const f32x4 ga = *(const f32x4*)(gnw + h * RDV + 8 * lane), gb = *(const f32x4*)(gnw + h * RDV + 8 * lane + 4);
        const float gg[8] = {ga.x, ga.y, ga.z, ga.w, gb.x, gb.y, gb.z, gb.w};
        float o[8];
#pragma unroll
        for (int e = 0; e < 8; ++e) o[e] = v[e] * rstd * gg[e] * sg[e];
        *(v4u*)(Y + off) = pack8(o);
    }
}

__device__ __forceinline__ float row16_sum(float x);
__device__ __forceinline__ void ph_rwkv_post(const Params& p, int jl, int lane, int wave) {
    const float* YW = (const float*)(p.ws + WS_YW); const bf16* R = (const bf16*)(p.ws + WS_R); const bf16* KM = (const bf16*)(p.ws + WS_NKK);
    const bf16* VP = (const bf16*)(p.ws + WS_KKA); const bf16* L2 = (const bf16*)(p.ws + WS_L2); bf16* Z = (bf16*)(p.ws + WS_Z);
    const float* rk = p.in[I_RK] + (size_t)jl * D; const float* lnw = p.in[I_LNW] + (size_t)jl * D; const float* lnb = p.in[I_LNB] + (size_t)jl * D;
    const int gw = blockIdx.x * NWAVES + wave, NGW = gridDim.x * NWAVES;
    const int sub = lane >> 4, c4 = lane & 15;
    for (int it0 = gw * 4; it0 < M * WH; it0 += NGW * 4) {
        const int it = it0 + sub, row = it >> 4, h = it & 15, c = h * WN + 4 * c4;
        const size_t idx = (size_t)row * D + c;
        const f32x4 yv = *(const f32x4*)(YW + idx), r4 = ld_bf4(R + idx), k4 = ld_bf4(KM + idx), v4 = ld_bf4(VP + idx), g4 = ld_bf4(L2 + (size_t)row * NL2 + 2048 + c);
        const f32x4 rk4 = *(const f32x4*)(rk + c), lw4 = *(const f32x4*)(lnw + c), lb4 = *(const f32x4*)(lnb + c);
        const float mean = row16_sum((yv.x + yv.y) + (yv.z + yv.w)) * (1.f / WN);
        const f32x4 yc = yv - mean;
        const float rstd = rsqrtf(row16_sum((yc.x * yc.x + yc.y * yc.y) + (yc.z * yc.z + yc.w * yc.w)) * (1.f / WN) + 64e-5f);
        const f32x4 rkk = r4 * k4 * rk4;
        const float bon = row16_sum((rkk.x + rkk.y) + (rkk.z + rkk.w));
        const f32x4 z = (yc * rstd * lw4 + lb4 + v4 * bon) * g4;
        st_bf4(Z + idx, z);
    }
}

constexpr int RT_KP = 528, RT_VP = 144, RT_SP = 528;
constexpr int RT_K_OFF = 0, RT_V_OFF = 128 * RT_KP, RT_ST_OFF = RT_V_OFF + 128 * RT_VP, RT_END = RT_ST_OFF + 64 * RT_SP;
static_assert(RT_END <= LDS_BYTES, "retention LDS map");
typedef short v4s __attribute__((ext_vector_type(4)));
__device__ __forceinline__ bf16x8 tr_pair(LAS unsigned char* a0, LAS unsigned char* a1) {
    const v4s lo = __builtin_amdgcn_ds_read_tr16_b64_v4i16((LAS v4s*)a0), hi = __builtin_amdgcn_ds_read_tr16_b64_v4i16((LAS v4s*)a1);
    return __builtin_shufflevector(lo, hi, 0, 1, 2, 3, 4, 5, 6, 7);
}
__device__ __forceinline__ void ph_ret_fast(const Params& p, int jl, LAS unsigned char* lds, int tid, int lane, int wave) {
    const bf16* QK = (const bf16*)(p.ws + WS_QK); const bf16* V = (const bf16*)(p.ws + WS_V); float* O = (float*)(p.ws + WS_O);
    const int fr = lane & 15, fq = lane >> 4, li_q = (lane & 15) >> 2, li_p = lane & 3;
    for (int u = blockIdx.x; u < BATCH * RH * 8; u += gridDim.x) {
        const int es = u & 7, h = (u >> 3) & 3, b = u >> 5;
        const float gamma = 1.0f - exp2f(-5.0f - (float)h), lg = log2f(gamma), g128 = exp2f(128.f * lg), g127 = exp2f(127.f * lg);
        const int i0 = 16 * wave, d0 = 32 * wave;
        f32x4 Sacc[2][4];
#pragma unroll
        for (int a = 0; a < 2; ++a)
#pragma unroll
            for (int c = 0; c < 4; ++c) Sacc[a][c] = (f32x4){0.f, 0.f, 0.f, 0.f};
        __syncthreads();
        for (int i = tid; i < 64 * RT_SP / 16; i += NTHR) *(LAS v4u*)(lds + RT_ST_OFF + i * 16) = (v4u){0u, 0u, 0u, 0u};
        v4u kst[8], vst[2];
        const bf16* Kg = QK + 1024 + 256 * h; const bf16* Vg = V + 512 * h + 64 * es; const bf16* Qg = QK + 256 * h;
#define RT_LOAD_STAGE(cc) do { \
            _Pragma("unroll") for (int k_ = 0; k_ < 8; ++k_) { const int id_ = tid + 512 * k_, row_ = id_ >> 5, ch_ = id_ & 31, t_ = 128 * (cc) - 112 + row_; \
                kst[k_] = t_ >= 0 ? *(const v4u*)(Kg + (size_t)(b * TP + t_) * 2048 + 8 * ch_) : (v4u){0u, 0u, 0u, 0u}; } \
            _Pragma("unroll") for (int k_ = 0; k_ < 2; ++k_) { const int id_ = tid + 512 * k_, row_ = id_ >> 3, ch_ = id_ & 7, t_ = 128 * (cc) - 112 + row_; \
                vst[k_] = t_ >= 0 ? *(const v4u*)(Vg + (size_t)(b * TP + t_) * 2048 + 8 * ch_) : (v4u){0u, 0u, 0u, 0u}; } } while (0)
        RT_LOAD_STAGE(0);
        for (int c = 0; c < 17; ++c) {
            __syncthreads();
#pragma unroll
            for (int k_ = 0; k_ < 8; ++k_) { const int id_ = tid + 512 * k_, row_ = id_ >> 5, ch_ = id_ & 31; *(LAS v4u*)(lds + RT_K_OFF + row_ * RT_KP + ch_ * 16) = kst[k_]; }
#pragma unroll
            for (int k_ = 0; k_ < 2; ++k_) { const int id_ = tid + 512 * k_, row_ = id_ >> 3, ch_ = id_ & 7;
                float f[8]; unpack8(vst[k_], f); const float sc = exp2f(-(float)row_ * lg);
#pragma unroll
                for (int e = 0; e < 8; ++e) f[e] *= sc;
                *(LAS v4u*)(lds + RT_V_OFF + row_ * RT_VP + ch_ * 16) = pack8(f); }
            bf16x8 Qf[8];
            { const int t_ = 128 * c - 112 + i0 + fr;
#pragma unroll
              for (int s = 0; s < 8; ++s) Qf[s] = t_ >= 0 ? *(const bf16x8*)(Qg + (size_t)(b * TP + t_) * 2048 + 32 * s + 8 * fq) : (bf16x8){0, 0, 0, 0, 0, 0, 0, 0}; }
            __syncthreads();
            bf16x8 Pf[4];
            { const int ii = i0 + fr; const float gi = exp2f((float)ii * lg);
#pragma unroll
              for (int s2 = 0; s2 < 4; ++s2) { f32x4 Dp[2];
#pragma unroll
                  for (int hh = 0; hh < 2; ++hh) { Dp[hh] = (f32x4){0.f, 0.f, 0.f, 0.f};
#pragma unroll
                      for (int s = 0; s < 8; ++s) { const bf16x8 Kf = *(const LAS bf16x8*)(lds + RT_K_OFF + (16 * (2 * s2 + hh) + fr) * RT_KP + (32 * s + 8 * fq) * 2);
                          Dp[hh] = __builtin_amdgcn_mfma_f32_16x16x32_bf16(Kf, Qf[s], Dp[hh], 0, 0, 0); } }
                  float f[8];
#pragma unroll
                  for (int hh = 0; hh < 2; ++hh)
#pragma unroll
                      for (int r = 0; r < 4; ++r) { const int jj = 16 * (2 * s2 + hh) + 4 * fq + r; f[hh * 4 + r] = ii >= jj ? Dp[hh][r] * gi : 0.f; }
                  const v4u w = pack8(f); Pf[s2] = __builtin_bit_cast(bf16x8, w); } }
            f32x4 Oacc[4];
#pragma unroll
            for (int et = 0; et < 4; ++et) { Oacc[et] = (f32x4){0.f, 0.f, 0.f, 0.f};
#pragma unroll
                for (int s = 0; s < 8; ++s) { const bf16x8 Sf = *(const LAS bf16x8*)(lds + RT_ST_OFF + (16 * et + fr) * RT_SP + (32 * s + 8 * fq) * 2);
                    Oacc[et] = __builtin_amdgcn_mfma_f32_16x16x32_bf16(Qf[s], Sf, Oacc[et], 0, 0, 0); } }
            __syncthreads();
            if (c + 1 < 17) RT_LOAD_STAGE(c + 1);
#pragma unroll
            for (int r = 0; r < 4; ++r) { const float lam = exp2f((float)(i0 + 4 * fq + r + 1) * lg);
#pragma unroll
                for (int et = 0; et < 4; ++et) Oacc[et][r] *= lam; }
#pragma unroll
            for (int et = 0; et < 4; ++et)
#pragma unroll
                for (int s = 0; s < 4; ++s) {
                    LAS unsigned char* a0 = lds + RT_V_OFF + (32 * s + 4 * fq + li_q) * RT_VP + (16 * et + 4 * li_p) * 2;
                    const bf16x8 Vf = tr_pair(a0, a0 + 16 * RT_VP);
                    Oacc[et] = __builtin_amdgcn_mfma_f32_16x16x32_bf16(Pf[s], Vf, Oacc[et], 0, 0, 0); }
#pragma unroll
            for (int r = 0; r < 4; ++r) { const int t_ = 128 * c - 112 + i0 + 4 * fq + r;
                if (t_ >= 0) { float* op = O + (size_t)(b * TP + t_) * RV + 512 * h + 64 * es + fr;
#pragma unroll
                    for (int et = 0; et < 4; ++et) op[16 * et] = Oacc[et][r]; } }
#pragma unroll
            for (int dt = 0; dt < 2; ++dt)
#pragma unroll
                for (int et = 0; et < 4; ++et) Sacc[dt][et] = Sacc[dt][et] * (g128 / g127);
#pragma unroll
            for (int s = 0; s < 4; ++s) {
                bf16x8 Kt[2], Vt[4];
#pragma unroll
                for (int dt = 0; dt < 2; ++dt) { LAS unsigned char* a0 = lds + RT_K_OFF + (32 * s + 8 * fq + li_q) * RT_KP + (d0 + 16 * dt + 4 * li_p) * 2; Kt[dt] = tr_pair(a0, a0 + 4 * RT_KP); }
#pragma unroll
                for (int et = 0; et < 4; ++et) { LAS unsigned char* a0 = lds + RT_V_OFF + (32 * s + 8 * fq + li_q) * RT_VP + (16 * et + 4 * li_p) * 2; Vt[et] = tr_pair(a0, a0 + 4 * RT_VP); }
#pragma unroll
                for (int dt = 0; dt < 2; ++dt)
#pragma unroll
                    for (int et = 0; et < 4; ++et) Sacc[dt][et] = __builtin_amdgcn_mfma_f32_16x16x32_bf16(Kt[dt], Vt[et], Sacc[dt][et], 0, 0, 0);
            }
#pragma unroll
            for (int dt = 0; dt < 2; ++dt)
#pragma unroll
                for (int et = 0; et < 4; ++et) Sacc[dt][et] = Sacc[dt][et] * g127;
#pragma unroll
            for (int dt = 0; dt < 2; ++dt)
#pragma unroll
                for (int et = 0; et < 4; ++et) { v2u w; w.x = cvt_pk_bf16(Sacc[dt][et][0], Sacc[dt][et][1]); w.y = cvt_pk_bf16(Sacc[dt][et][2], Sacc[dt][et][3]);
                    *(LAS v2u*)(lds + RT_ST_OFF + (16 * et + fr) * RT_SP + (d0 + 16 * dt + 4 * fq) * 2) = w; }
        }
#undef RT_LOAD_STAGE
        float* so = p.out + O_RETP + ((((size_t)jl * BATCH + b) * RH + h) * RDK) * RDV + 64 * es;
#pragma unroll
        for (int dt = 0; dt < 2; ++dt)
#pragma unroll
            for (int et = 0; et < 4; ++et)
#pragma unroll
                for (int r = 0; r < 4; ++r) so[(size_t)(d0 + 16 * dt + 4 * fq + r) * RDV + 16 * et + fr] = Sacc[dt][et][r];
    }
    {
        LAS float* sq = (LAS float*)lds; LAS float* sk = sq + 256; LAS float* red = sk + 256;
        const int e4 = tid & 127, dq = tid >> 7;
        for (int it = blockIdx.x; it < SB * RH; it += gridDim.x) {
            const int h = it & 3, s = it >> 2, row = MP + s;
            const float gamma = 1.0f - exp2f(-5.0f - (float)h);
            __syncthreads();
            if (tid < 256) sq[tid] = bf_lo((unsigned)QK[(size_t)row * 2048 + 256 * h + tid]);
            else sk[tid - 256] = bf_lo((unsigned)QK[(size_t)row * 2048 + 1024 + 256 * h + (tid - 256)]);
            const v2u vv = *(const v2u*)(V + (size_t)row * 2048 + 512 * h + 4 * e4);
            const f32x4 v4 = (f32x4){bf_lo(vv.x), bf_hi(vv.x), bf_lo(vv.y), bf_hi(vv.y)};
            __syncthreads();
            const float* sin_ = p.in[I_SRET] + ((((size_t)jl * SB + s) * RH + h) * RDK) * RDV + 4 * e4;
            float* sout = p.out + O_RETS + ((((size_t)jl * SB + s) * RH + h) * RDK) * RDV + 4 * e4;
            f32x4 oacc = (f32x4){0.f, 0.f, 0.f, 0.f};
#pragma unroll 8
            for (int k = 0; k < 64; ++k) { const int d = dq + 4 * k;
                const f32x4 sv = __builtin_nontemporal_load((const f32x4*)(sin_ + (size_t)d * RDV));
                const f32x4 sn = sv * gamma + v4 * sk[d];
                oacc += sn * sq[d];
                __builtin_nontemporal_store(sn, (f32x4*)(sout + (size_t)d * RDV)); }
            *(LAS f32x4*)(red + dq * 512 + 4 * e4) = oacc;
            __syncthreads();
            if (dq == 0) { const f32x4 r = (*(LAS f32x4*)(red + 4 * e4) + *(LAS f32x4*)(red + 512 + 4 * e4)) + (*(LAS f32x4*)(red + 1024 + 4 * e4) + *(LAS f32x4*)(red + 1536 + 4 * e4));
                *(f32x4*)(O + (size_t)row * RV + 512 * h + 4 * e4) = r; }
        }
    }
}

typedef float f32x2w __attribute__((ext_vector_type(2)));
constexpr int WK_TB = 32, WK_STEP_B = 6 * 256 + 16, WK_BUF_B = WK_TB * WK_STEP_B, WK_Y_OFF = 2 * WK_BUF_B, WK_YB_B = WK_TB * 32 * 4;
static_assert(WK_Y_OFF + 2 * WK_YB_B <= LDS_BYTES - 16, "wkv LDS map");
__device__ __forceinline__ float row16_sum(float x) {
    x += __builtin_bit_cast(float, __builtin_amdgcn_update_dpp(0, __builtin_bit_cast(int, x), 0x128, 0xf, 0xf, false));
    x += __builtin_bit_cast(float, __builtin_amdgcn_update_dpp(0, __builtin_bit_cast(int, x), 0x124, 0xf, 0xf, false));
    x += __builtin_bit_cast(float, __builtin_amdgcn_update_dpp(0, __builtin_bit_cast(int, x), 0x122, 0xf, 0xf, false));
    x += __builtin_bit_cast(float, __builtin_amdgcn_update_dpp(0, __builtin_bit_cast(int, x), 0x121, 0xf, 0xf, false));
    return x;
}
__device__ __forceinline__ float half8_sum(float x) {
    x += __builtin_bit_cast(float, __builtin_amdgcn_update_dpp(0, __builtin_bit_cast(int, x), 0x141, 0xf, 0xf, false));
    x += __builtin_bit_cast(float, __builtin_amdgcn_update_dpp(0, __builtin_bit_cast(int, x), 0xB1, 0xf, 0xf, false));
    x += __builtin_bit_cast(float, __builtin_amdgcn_update_dpp(0, __builtin_bit_cast(int, x), 0x4E, 0xf, 0xf, false));
    return x;
}
struct WkPar { f32x4 w0, a0, kkp, kap, v0; };
__device__ __forceinline__ f32x4 wk_unit_neg(const f32x4 kraw, const f32x4 kkp) {
    const f32x4 kk = kraw * kkp;
    const float ss = row16_sum((kk.x * kk.x + kk.y * kk.y) + (kk.z * kk.z + kk.w * kk.w));
    return kk * (-rsqrtf(fmaxf(ss, 1e-12f)));
}
__device__ __forceinline__ float wk_decay(float x) { return __expf(-0.60653065971263342f * sigmoidf_(x)); }
__device__ __forceinline__ void wk_prep(const WkPar& P, const f32x4 kraw, const f32x4 vraw, const f32x4 lw2, const f32x4 la2, const f32x4 vf, const f32x4 lv2, bool vres,
                                        f32x4& w, f32x4& ka, f32x4& km, f32x4& vp, f32x4& nk) {
    nk = wk_unit_neg(kraw, P.kkp);
    w = (f32x4){wk_decay(P.w0.x + lw2.x), wk_decay(P.w0.y + lw2.y), wk_decay(P.w0.z + lw2.z), wk_decay(P.w0.w + lw2.w)};
    const f32x4 a = (f32x4){sigmoidf_(P.a0.x + la2.x), sigmoidf_(P.a0.y + la2.y), sigmoidf_(P.a0.z + la2.z), sigmoidf_(P.a0.w + la2.w)};
    ka = nk * (-a);
    km = kraw * ((a - 1.f) * P.kap + 1.f);
    vp = vraw;
    if (vres) { const f32x4 sg = (f32x4){sigmoidf_(P.v0.x + lv2.x), sigmoidf_(P.v0.y + lv2.y), sigmoidf_(P.v0.z + lv2.z), sigmoidf_(P.v0.w + lv2.w)}; vp = vraw + (vf - vraw) * sg; }
}
constexpr int WC_C = 16, WC_NCH = TP / WC_C;
static_assert(WC_NCH * WC_C == TP, "chunking");
constexpr int REC_WA = 0, REC_RP = 2048, REC_BK = 4096, REC_VV = 8192, REC_U0 = 10240, REC_Y0 = 14336, REC_GC = 18432, REC_BYTES = 18688;
constexpr size_t WS_REC = WS_END;
constexpr size_t WS_END2 = WS_REC + (size_t)BATCH * WH * WC_NCH * REC_BYTES;
__device__ __forceinline__ unsigned bf_rne_c(float f) { unsigned u = __float_as_uint(f); return (u + 0x7fffu + ((u >> 16) & 1u)) >> 16; }
__device__ __forceinline__ unsigned pk2_c(float lo, float hi) { return bf_rne_c(lo) | (bf_rne_c(hi) << 16); }
__device__ __forceinline__ float bf_rd(const bf16* q) { return __uint_as_float((unsigned)(*q) << 16); }
__device__ __forceinline__ bf16 bf_of(float x) { return (bf16)(cvt_pk_bf16(x, 0.f) & 0xffffu); }

typedef __bf16 bf4v __attribute__((ext_vector_type(4)));
__device__ __forceinline__ v2u pk4(const f32x4 v) { return __builtin_bit_cast(v2u, __builtin_convertvector(v, bf4v)); }
__device__ __forceinline__ f32x4 mm16(const v2u a, const v2u b, const f32x4 c) { return __builtin_amdgcn_mfma_f32_16x16x16bf16_1k(__builtin_bit_cast(v4s, a), __builtin_bit_cast(v4s, b), c, 0, 0, 0); }
__device__ __forceinline__ f32x4 mm32(const v2u a0, const v2u a1, const v2u b0, const v2u b1, const f32x4 c) {
    const v4u a = (v4u){a0.x, a0.y, a1.x, a1.y}, b = (v4u){b0.x, b0.y, b1.x, b1.y};
    return __builtin_amdgcn_mfma_f32_16x16x32_bf16(__builtin_bit_cast(bf16x8, a), __builtin_bit_cast(bf16x8, b), c, 0, 0, 0);
}
template <int CTRL> __device__ __forceinline__ float dppz(float x) { return __int_as_float(__builtin_amdgcn_update_dpp(0, __float_as_int(x), CTRL, 0xf, 0xf, true)); }
__device__ __forceinline__ float psum16(float x) { x += dppz<0x111>(x); x += dppz<0x112>(x); x += dppz<0x114>(x); x += dppz<0x118>(x); return x; }
__device__ __forceinline__ v2u tr16(LAS unsigned char* a) { return __builtin_bit_cast(v2u, __builtin_amdgcn_ds_read_tr16_b64_v4i16((LAS v4s*)a)); }
__device__ __forceinline__ void ph_wkv1(const Params& p, int jl, LAS unsigned char* lds, int lane_in, int wave) {
    const bf16* Kr = (const bf16*)(p.ws + WS_K); const bf16* Vr = (const bf16*)(p.ws + (jl == 0 ? WS_VF : WS_VB)); const bf16* VFp = (const bf16*)(p.ws + WS_VF);
    const bf16* Rr = (const bf16*)(p.ws + WS_R); const bf16* L2 = (const bf16*)(p.ws + WS_L2);
    bf16* KM = (bf16*)(p.ws + WS_NKK); bf16* VP = (bf16*)(p.ws + WS_KKA);
    const bool vres = jl == 1;
    constexpr int IMG = 16 * 144;
    constexpr float CL2 = 0.60653065971263342f * 1.4426950408889634f;
    const int gw = wave * gridDim.x + blockIdx.x, NGW = gridDim.x * NWAVES;
    for (int job = gw; job < BATCH * WH * WC_NCH; job += NGW) {
        int ln = lane_in; asm volatile("" : "+v"(ln));
        const int lane = ln, fr = lane & 15, fq = lane >> 4;
        const int c = job % WC_NCH, sh = job / WC_NCH, h = sh & 15, seq = sh >> 4, r0 = seq * TP + WC_C * c, chb = h * WN + 4 * fq;
        LAS unsigned char* sc = lds + wave * 16384;
        unsigned char* rec = p.ws + WS_REC + (size_t)job * REC_BYTES;
        const size_t ro = (size_t)(r0 + fr) * D + chb, lo = (size_t)(r0 + fr) * NL2 + chb, po = (size_t)jl * D + chb;
        f32x4 kraw[4], kk[4];
        float ss = 0.f;
#pragma unroll
        for (int jt = 0; jt < 4; ++jt) { kraw[jt] = ld_bf4(Kr + ro + 16 * jt); kk[jt] = kraw[jt] * *(const f32x4*)(p.in[I_KK] + po + 16 * jt);
            ss += (kk[jt].x * kk[jt].x + kk[jt].y * kk[jt].y) + (kk[jt].z * kk[jt].z + kk[jt].w * kk[jt].w); }
        ss += shfl_xor_l(ss, 16, lane); ss += shfl_xor_l(ss, 32, lane);
        const float inv = rsqrtf(fmaxf(ss, 1e-12f));
        v2u pa[4], pb[4], pk[4], pr[4]; f32x4 rt[4];
        LAS unsigned char* iw = sc + fr * 144 + 8 * fq;
#pragma unroll
        for (int jt = 0; jt < 4; ++jt) {
            const f32x4 lw2 = ld_bf4(L2 + lo + 16 * jt), la2 = ld_bf4(L2 + lo + 1024 + 16 * jt), rr = ld_bf4(Rr + ro + 16 * jt), vraw = ld_bf4(Vr + ro + 16 * jt);
            const f32x4 pw0 = *(const f32x4*)(p.in[I_W0] + po + 16 * jt), pa0 = *(const f32x4*)(p.in[I_A0] + po + 16 * jt), pka = *(const f32x4*)(p.in[I_KA] + po + 16 * jt);
            f32x4 vp = vraw;
            if (vres) { const f32x4 vf = ld_bf4(VFp + ro + 16 * jt), lv2 = ld_bf4(L2 + lo + 3072 + 16 * jt), pv0 = *(const f32x4*)(p.in[I_V0] + chb + 16 * jt);
#pragma unroll
                for (int e = 0; e < 4; ++e) vp[e] = vraw[e] + (vf[e] - vraw[e]) * sigmoidf_(pv0[e] + lv2[e]); }
            f32x4 at, bt, kt, kq, rq, gg;
#pragma unroll
            for (int e = 0; e < 4; ++e) {
                const float a = sigmoidf_(pa0[e] + la2[e]), d = CL2 * sigmoidf_(pw0[e] + lw2[e]), cum = psum16(d);
                const float g = __builtin_amdgcn_exp2f(-cum), ig = __builtin_amdgcn_exp2f(cum), gp = __builtin_amdgcn_exp2f(d - cum), nk = -kk[jt][e] * inv;
                kt[e] = kraw[jt][e] * (1.f + (a - 1.f) * pka[e]);
                at[e] = nk * gp; bt[e] = -nk * a * ig; kq[e] = kt[e] * ig; rq[e] = rr[e] * g; gg[e] = g;
            }
            st_bf4(KM + ro + 16 * jt, kt); st_bf4(VP + ro + 16 * jt, vp);
            if (fr == 15) *(f32x4*)(rec + REC_GC + (16 * jt + 4 * fq) * 4) = gg;
            pa[jt] = pk4(at); pb[jt] = pk4(bt); pk[jt] = pk4(kq); pr[jt] = pk4(rq); rt[jt] = rq;
            *(LAS v2u*)(iw + 0 * IMG + 32 * jt) = pa[jt]; *(LAS v2u*)(iw + 1 * IMG + 32 * jt) = pb[jt]; *(LAS v2u*)(iw + 2 * IMG + 32 * jt) = pk[jt]; *(LAS v2u*)(iw + 3 * IMG + 32 * jt) = pk4(vp);
        }
        const f32x4 z4 = (f32x4){0.f, 0.f, 0.f, 0.f};
        const int dd = fr - 4 * fq;
        f32x4 L = mm32(pa[2], pa[3], pb[2], pb[3], mm32(pa[0], pa[1], pb[0], pb[1], z4));
        f32x4 LT = mm32(pb[2], pb[3], pa[2], pa[3], mm32(pb[0], pb[1], pa[0], pa[1], z4));
        f32x4 Lak = mm32(pa[2], pa[3], pk[2], pk[3], mm32(pa[0], pa[1], pk[0], pk[1], z4));
        f32x4 MrbT = mm32(pb[2], pb[3], pr[2], pr[3], mm32(pb[0], pb[1], pr[0], pr[1], z4));
        f32x4 MrkT = mm32(pk[2], pk[3], pr[2], pr[3], mm32(pk[0], pk[1], pr[0], pr[1], z4));
        f32x4 TT;
#pragma unroll
        for (int r = 0; r < 4; ++r) {
            L[r] = dd < r ? L[r] : 0.f; Lak[r] = dd < r ? Lak[r] : 0.f;
            LT[r] = r < dd ? LT[r] : 0.f; MrbT[r] = r <= dd ? MrbT[r] : 0.f; MrkT[r] = r <= dd ? MrkT[r] : 0.f;
            TT[r] = LT[r] + (r == dd ? 1.f : 0.f);
        }
        const v2u bL = pk4(L), bLT = pk4(LT), bLak = pk4(Lak);
        const f32x4 L2m = mm16(bLT, bL, z4), L2T = mm16(bL, bLT, z4);
        const v2u bL2 = pk4(L2m), bL2T = pk4(L2T);
        const f32x4 L4m = mm16(bL2T, bL2, z4), L4T = mm16(bL2, bL2T, z4);
        const v2u bL4 = pk4(L4m), bL4T = pk4(L4T);
        const v2u bL8 = pk4(mm16(bL4T, bL4, z4));
        TT = mm16(bL2, pk4(TT), TT); TT = mm16(bL4, pk4(TT), TT); TT = mm16(bL8, pk4(TT), TT);
        f32x4 Zm = mm16(bL, pk4(MrbT), MrbT); Zm = mm16(bL2, pk4(Zm), Zm); Zm = mm16(bL4, pk4(Zm), Zm); Zm = mm16(bL8, pk4(Zm), Zm);
        const v2u bTT = pk4(TT), bMtT = pk4(Zm);
        const v2u bTkT = pk4(mm16(bLak, bTT, z4)), bMyT = pk4(mm16(bLak, bMtT, MrkT));
        LAS unsigned char* ir = sc + (4 * fq + ((lane & 15) >> 2)) * 144 + 8 * (lane & 3);
        v2u wat[4], rpt[4];
#pragma unroll
        for (int jt = 0; jt < 4; ++jt) {
            const v2u Qa = tr16(ir + 0 * IMG + 32 * jt), Qb = tr16(ir + 1 * IMG + 32 * jt), Qk = tr16(ir + 2 * IMG + 32 * jt);
            wat[jt] = pk4(mm16(Qa, bTT, z4)); rpt[jt] = pk4(mm16(Qa, bMtT, rt[jt]));
            *(v4u*)(rec + REC_BK + (jt * 64 + lane) * 16) = (v4u){Qb.x, Qb.y, Qk.x, Qk.y};
        }
#pragma unroll
        for (int s = 0; s < 2; ++s) {
            *(v4u*)(rec + REC_WA + (s * 64 + lane) * 16) = (v4u){wat[2 * s].x, wat[2 * s].y, wat[2 * s + 1].x, wat[2 * s + 1].y};
            *(v4u*)(rec + REC_RP + (s * 64 + lane) * 16) = (v4u){rpt[2 * s].x, rpt[2 * s].y, rpt[2 * s + 1].x, rpt[2 * s + 1].y};
        }
#pragma unroll
        for (int it = 0; it < 4; ++it) {
            const v2u Qv = tr16(ir + 3 * IMG + 32 * it);
            *(v2u*)(rec + REC_VV + (it * 64 + lane) * 8) = Qv;
            *(f32x4*)(rec + REC_U0 + (it * 64 + lane) * 16) = mm16(bTkT, Qv, z4);
            *(f32x4*)(rec + REC_Y0 + (it * 64 + lane) * 16) = mm16(bMyT, Qv, z4);
        }
    }
}

__device__ __forceinline__ void ph_wkv2(const Params& p, int jl, int lane, int wave) {
    const bf16* Kr = (const bf16*)(p.ws + WS_K); const bf16* Vr = (const bf16*)(p.ws + (jl == 0 ? WS_VF : WS_VB)); const bf16* VFp = (const bf16*)(p.ws + WS_VF);
    const bf16* Rr = (const bf16*)(p.ws + WS_R); const bf16* L2 = (const bf16*)(p.ws + WS_L2);
    bf16* KM = (bf16*)(p.ws + WS_NKK); bf16* VP = (bf16*)(p.ws + WS_KKA);
    const bool vres = jl == 1; const int ri = lane >> 4, cg = lane & 15;
    float* YW = (float*)(p.ws + WS_YW);
    const int fr = lane & 15, fq = lane >> 4;
    const int gw = blockIdx.x * NWAVES + wave, NGW = gridDim.x * NWAVES;
    for (int job = gw; job < BATCH * WH * 4; job += NGW) {
        const int it = job & 3, h = (job >> 2) & 15, seq = job >> 6, r0 = seq * TP;
        const unsigned char* rec = p.ws + WS_REC + (size_t)((seq * WH + h) * WC_NCH) * REC_BYTES;
        f32x4 Sacc[4];
#pragma unroll
        for (int jt = 0; jt < 4; ++jt) Sacc[jt] = (f32x4){0.f, 0.f, 0.f, 0.f};
        v4u wa[2], rp[2], bk[4]; v2u vvf; f32x4 u0, y0, gc[4];
#define WC_LOAD(rc) do { const unsigned char* r_ = (rc); \
            wa[0] = *(const v4u*)(r_ + REC_WA + lane * 16); wa[1] = *(const v4u*)(r_ + REC_WA + 1024 + lane * 16); rp[0] = *(const v4u*)(r_ + REC_RP + lane * 16); rp[1] = *(const v4u*)(r_ + REC_RP + 1024 + lane * 16); \
            _Pragma("unroll") for (int jt_ = 0; jt_ < 4; ++jt_) { bk[jt_] = *(const v4u*)(r_ + REC_BK + (jt_ * 64 + lane) * 16); gc[jt_] = *(const f32x4*)(r_ + REC_GC + (16 * jt_ + 4 * fq) * 4); } \
            vvf = *(const v2u*)(r_ + REC_VV + (it * 64 + lane) * 8); u0 = *(const f32x4*)(r_ + REC_U0 + (it * 64 + lane) * 16); y0 = *(const f32x4*)(r_ + REC_Y0 + (it * 64 + lane) * 16); } while (0)
        WC_LOAD(rec);
        for (int c = 0; c < WC_NCH; ++c) {
            const v4u cwa0 = wa[0], cwa1 = wa[1], crp0 = rp[0], crp1 = rp[1], cbk0 = bk[0], cbk1 = bk[1], cbk2 = bk[2], cbk3 = bk[3]; const v2u cvv = vvf; const f32x4 cu0 = u0, cy0 = y0, cg0 = gc[0], cg1 = gc[1], cg2 = gc[2], cg3 = gc[3];
            if (c + 1 < WC_NCH) WC_LOAD(rec + (size_t)(c + 1) * REC_BYTES);
            v4u sb0, sb1;
            sb0.x = cvt_pk_bf16(Sacc[0][0], Sacc[0][1]); sb0.y = cvt_pk_bf16(Sacc[0][2], Sacc[0][3]); sb0.z = cvt_pk_bf16(Sacc[1][0], Sacc[1][1]); sb0.w = cvt_pk_bf16(Sacc[1][2], Sacc[1][3]);
            sb1.x = cvt_pk_bf16(Sacc[2][0], Sacc[2][1]); sb1.y = cvt_pk_bf16(Sacc[2][2], Sacc[2][3]); sb1.z = cvt_pk_bf16(Sacc[3][0], Sacc[3][1]); sb1.w = cvt_pk_bf16(Sacc[3][2], Sacc[3][3]);
            const bf16x8 B0 = __builtin_bit_cast(bf16x8, sb0), B1 = __builtin_bit_cast(bf16x8, sb1);
            f32x4 U = __builtin_amdgcn_mfma_f32_16x16x32_bf16(__builtin_bit_cast(bf16x8, cwa0), B0, cu0, 0, 0, 0);
            U = __builtin_amdgcn_mfma_f32_16x16x32_bf16(__builtin_bit_cast(bf16x8, cwa1), B1, U, 0, 0, 0);
            f32x4 Y = __builtin_amdgcn_mfma_f32_16x16x32_bf16(__builtin_bit_cast(bf16x8, crp0), B0, cy0, 0, 0, 0);
            Y = __builtin_amdgcn_mfma_f32_16x16x32_bf16(__builtin_bit_cast(bf16x8, crp1), B1, Y, 0, 0, 0);
            v4u ub; ub.x = pk2_c(U[0], U[1]); ub.y = pk2_c(U[2], U[3]); ub.z = cvv.x; ub.w = cvv.y;
            const bf16x8 UB = __builtin_bit_cast(bf16x8, ub);
            Sacc[0] = __builtin_amdgcn_mfma_f32_16x16x32_bf16(__builtin_bit_cast(bf16x8, cbk0), UB, Sacc[0], 0, 0, 0) * cg0;
            Sacc[1] = __builtin_amdgcn_mfma_f32_16x16x32_bf16(__builtin_bit_cast(bf16x8, cbk1), UB, Sacc[1], 0, 0, 0) * cg1;
            Sacc[2] = __builtin_amdgcn_mfma_f32_16x16x32_bf16(__builtin_bit_cast(bf16x8, cbk2), UB, Sacc[2], 0, 0, 0) * cg2;
            Sacc[3] = __builtin_amdgcn_mfma_f32_16x16x32_bf16(__builtin_bit_cast(bf16x8, cbk3), UB, Sacc[3], 0, 0, 0) * cg3;
            float* yp = YW + (size_t)(r0 + WC_C * c + 4 * fq) * D + h * WN + 16 * it + fr;
            yp[0] = Y[0]; yp[D] = Y[1]; yp[2 * D] = Y[2]; yp[3 * D] = Y[3];
        }
#undef WC_LOAD
        float* so = p.out + O_WKVP + ((((size_t)jl * BATCH + seq) * WH + h) * WN + 16 * it + fr) * WN + 4 * fq;
#pragma unroll
        for (int jt = 0; jt < 4; ++jt) *(f32x4*)(so + 16 * jt) = Sacc[jt];
    }
    {
        const int gw = blockIdx.x * NWAVES + wave, NGW = gridDim.x * NWAVES;
        for (int it = gw; it < SB * WH * 16; it += NGW) {
            const int rg = it & 15, h = (it >> 4) & 15, s = it >> 8, row = MP + s, i = 4 * rg + ri;
            const int ch = h * WN + 4 * cg;
            WkPar P; P.w0 = *(const f32x4*)(p.in[I_W0] + (size_t)jl * D + ch); P.a0 = *(const f32x4*)(p.in[I_A0] + (size_t)jl * D + ch); P.kkp = *(const f32x4*)(p.in[I_KK] + (size_t)jl * D + ch);
            P.kap = *(const f32x4*)(p.in[I_KA] + (size_t)jl * D + ch); P.v0 = *(const f32x4*)(p.in[I_V0] + ch);
            const size_t vo = (size_t)row * D + ch, lo = (size_t)row * NL2 + ch;
            const f32x4 kraw = ld_bf4(Kr + vo), vraw = ld_bf4(Vr + vo), r4 = ld_bf4(Rr + vo), lw2 = ld_bf4(L2 + lo), la2 = ld_bf4(L2 + lo + 1024);
            f32x4 vf = (f32x4){0.f, 0.f, 0.f, 0.f}, lv2 = vf;
            if (vres) { vf = ld_bf4(VFp + vo); lv2 = ld_bf4(L2 + lo + 3072); }
            f32x4 w4, ka, k4, vp, nk; wk_prep(P, kraw, vraw, lw2, la2, vf, lv2, vres, w4, ka, k4, vp, nk);
            const int srcl = (lane & 48) | rg;
            const float v0_ = shfl_l(vp.x, srcl), v1_ = shfl_l(vp.y, srcl), v2_ = shfl_l(vp.z, srcl), v3_ = shfl_l(vp.w, srcl);
            const float vi = ri == 0 ? v0_ : (ri == 1 ? v1_ : (ri == 2 ? v2_ : v3_));
            const size_t so = ((((size_t)jl * SB + s) * WH + h) * WN + i) * WN + 4 * cg;
            f32x4 S = *(const f32x4*)(p.in[I_SWKV] + so);
            const float sa = row16_sum((S.x * nk.x + S.y * nk.y) + (S.z * nk.z + S.w * nk.w));
            S.x = fmaf(S.x, w4.x, fmaf(sa, ka.x, vi * k4.x)); S.y = fmaf(S.y, w4.y, fmaf(sa, ka.y, vi * k4.y));
            S.z = fmaf(S.z, w4.z, fmaf(sa, ka.z, vi * k4.z)); S.w = fmaf(S.w, w4.w, fmaf(sa, ka.w, vi * k4.w));
            const float y = row16_sum((S.x * r4.x + S.y * r4.y) + (S.z * r4.z + S.w * r4.w));
            *(f32x4*)(p.out + O_WKVS + so) = S;
            if (cg == 0) YW[(size_t)row * D + h * WN + i] = y;
            if (rg == 0 && ri == 0) { st_bf4(KM + vo, k4); st_bf4(VP + vo, vp); }
        }
    }
}

typedef __attribute__((address_space(1))) unsigned gu32;
#define XB_TMO      128
#define XB_XCNT(j)  (256  + 64 * (j))
#define XB_XSUB(j)  (1280 + 64 * (j))
#define XB_XGEN(j)  (2304 + 64 * (j))
#define XB_TOP      3328
#define XB_TOPGEN   3392
#define XCD_BAR_WORDS 3456
#define XB_SPIN_CAP (1u << 18)

__device__ __forceinline__ unsigned xb_ld(unsigned* p)              { return __hip_atomic_load(p, __ATOMIC_RELAXED, __HIP_MEMORY_SCOPE_AGENT); }
__device__ __forceinline__ unsigned xb_add(unsigned* p, unsigned v) { return __hip_atomic_fetch_add(p, v, __ATOMIC_RELAXED, __HIP_MEMORY_SCOPE_AGENT); }
__device__ __forceinline__ unsigned xb_xcc_id() { return (unsigned)__builtin_amdgcn_s_getreg((3 << 11) | 20) & 0xFu; }
#define XB_SPIN(cond, bar) do { unsigned _sp = 0; while (cond) { __builtin_amdgcn_s_sleep(1); \
    if ((++_sp & 255u) == 0u) { if (xb_ld(&(bar)[XB_TMO])) break; if (_sp > XB_SPIN_CAP) { atomicAdd(&(bar)[XB_TMO], 1u); break; } } } } while (0)

struct XcdBarrier {
    bool tid0; unsigned* bar; unsigned x;
    volatile LAS unsigned* st;
};

__device__ __forceinline__ XcdBarrier xcd_barrier_post(unsigned* bar, volatile LAS unsigned* st, bool tid0) {
    XcdBarrier b; b.tid0 = tid0; b.bar = bar; b.x = xb_xcc_id(); b.st = st;
    if (b.tid0) (void)xb_add(&bar[XB_XCNT(b.x)], 1u);
    return b;
}
__device__ __forceinline__ void xcd_barrier_complete(unsigned* bar, unsigned x, unsigned& nloc, unsigned& nx) {
    const unsigned G = gridDim.x * gridDim.y * gridDim.z;
    unsigned sum, cnt, mine, sp = 0u;
    for (;;) {
        sum = 0u; cnt = 0u; mine = 0u;
#pragma unroll
        for (unsigned j = 0; j < 16; ++j) { const unsigned c = xb_ld(&bar[XB_XCNT(j)]); sum += c; cnt += (c > 0u) ? 1u : 0u; mine = (j == x) ? c : mine; }
        if (sum == G) break;
        __builtin_amdgcn_s_sleep(1);
        if ((++sp & 255u) == 0u) { if (xb_ld(&bar[XB_TMO])) break; if (sp > XB_SPIN_CAP) { atomicAdd(&bar[XB_TMO], 1u); break; } }
    }
    nloc = mine > 0u ? mine : 1u; nx = cnt > 0u ? cnt : 1u;
}

__device__ __forceinline__ void xcd_barrier(const XcdBarrier& b) {
    asm volatile("s_waitcnt vmcnt(0)" ::: "memory");
    __syncthreads();
    if (b.tid0) {
        unsigned* bar = b.bar;
        __builtin_amdgcn_s_waitcnt(0);
        unsigned nloc = b.st[0], nx = b.st[1];
        if (nloc == 0u) { xcd_barrier_complete(bar, b.x, nloc, nx); b.st[0] = nloc; b.st[1] = nx; }
        const unsigned old = xb_add(&bar[XB_XSUB(b.x)], 1u);
        const unsigned gen = old / nloc;
        if (old + 1u == (gen + 1u) * nloc) {
            __builtin_amdgcn_fence(__ATOMIC_RELEASE, "agent");
            asm volatile("s_waitcnt vmcnt(0)" ::: "memory");
            const unsigned og = xb_add(&bar[XB_TOP], 1u);
            const unsigned tg = og / nx;
            if (og + 1u == (tg + 1u) * nx) xb_add(&bar[XB_TOPGEN], 1u);
            else XB_SPIN(xb_ld(&bar[XB_TOPGEN]) == tg, bar);
            __builtin_amdgcn_fence(__ATOMIC_ACQUIRE, "agent");
            xb_add(&bar[XB_XGEN(b.x)], 1u);
            asm volatile("s_waitcnt vmcnt(0)" ::: "memory");
        } else {
            XB_SPIN(xb_ld(&bar[XB_XGEN(b.x)]) == gen, bar);
            __builtin_amdgcn_fence(__ATOMIC_ACQUIRE, "agent");
            asm volatile("s_waitcnt vmcnt(0)" ::: "memory");
        }
    }
    __syncthreads();
}

enum { OP_P0 = 0, OP_NORM_RET, OP_G_RETIN, OP_RET, OP_RETNORM, OP_G_RETOUT, OP_NORM_RW, OP_G_RWPROJ, OP_G_LORA2, OP_PREP, OP_WKV, OP_WKV2, OP_POST, OP_G_WO,
       OP_NORM_FFN, OP_G_UG, OP_CONV, OP_G_WD, OP_FINAL };
struct Ph { unsigned char op, layer; };
constexpr int NPH = 1 + 2 * 6 + 2 * 9 + 1;
__device__ __host__ inline Ph phase_at(int i) {
    if (i == 0) return Ph{OP_P0, 0};
    i -= 1;
    int l;
    if (i < 6) l = 0; else if (i < 15) { l = 1; i -= 6; } else if (i < 21) { l = 2; i -= 15; } else if (i < 30) { l = 3; i -= 21; } else return Ph{OP_FINAL, 0};
    int op = OP_FINAL;
    if ((l & 1) == 0) {
        switch (i) { case 0: op = OP_G_RETIN; break; case 1: op = OP_RET; break; case 2: op = OP_RETNORM; break; case 3: op = OP_G_RETOUT; break;
                     case 4: op = OP_G_UG; break; default: op = OP_G_WD; break; }
    } else {
        switch (i) { case 0: op = OP_NORM_RW; break; case 1: op = OP_G_RWPROJ; break; case 2: op = OP_G_LORA2; break; case 3: op = OP_WKV; break; case 4: op = OP_WKV2; break; case 5: op = OP_POST; break; case 6: op = OP_G_WO; break;
                     case 7: op = OP_G_UG; break; default: op = OP_G_WD; break; }
    }
    return Ph{(unsigned char)op, (unsigned char)l};
}

__global__ void __launch_bounds__(NTHR, 2) mega(Params p, int lo, int hi) {
    extern __shared__ __attribute__((aligned(16))) unsigned char lds_raw[];
    LAS unsigned char* lds = (LAS unsigned char*)lds_raw;
    volatile LAS unsigned* bst = (volatile LAS unsigned*)(lds + LDS_BYTES - 16);
    const int wave0 = __builtin_amdgcn_readfirstlane((int)threadIdx.x >> 6);
    if (threadIdx.x < 4) bst[threadIdx.x] = 0u;
    __syncthreads();
    (void)xcd_barrier_post((unsigned*)(p.ws + WS_CTL), bst, threadIdx.x == 0);
    for (int ph = lo; ph < hi; ++ph) {
        int lid_; asm volatile("v_mbcnt_lo_u32_b32 %0, -1, 0\n\tv_mbcnt_hi_u32_b32 %0, -1, %0" : "=v"(lid_));
        int tid = wave0 * 64 + lid_; asm volatile("" : "+v"(tid));
        const int lane = tid & 63, wave = __builtin_amdgcn_readfirstlane(tid >> 6);
        unsigned char* ws = p.ws;
        const Ph P = phase_at(ph);
        const int li = P.layer, jl = li >> 1;
        const bf16* gA = nullptr; const bf16* gB = nullptr; int gN = 0, gK = 0; EpiAnyT<0> E{}; E.jl = jl; E.ws = ws; E.slot = -1; E.amul = 1.f; E.li = li; E.ldsb = lds; bool is_gemm = false;
        switch (P.op) {
        case OP_P0: ph_p0(p, lds, tid, lane, wave); break;
        case OP_NORM_RET: ph_norm(p, p.in[I_NMIX] + (size_t)li * D, 0, jl, lane, wave); break;
        case OP_NORM_FFN: ph_norm(p, p.in[I_NFFN] + (size_t)li * D, 0, jl, lane, wave); break;
        case OP_NORM_RW: ph_norm(p, p.in[I_NMIX] + (size_t)li * D, 1, jl, lane, wave); break;
        case OP_FINAL: ph_norm(p, p.in[I_NFIN], 2, 0, lane, wave); break;
        case OP_RETNORM: ph_ret_norm(p, jl, lane, wave); break;
        case OP_POST: ph_rwkv_post(p, jl, lane, wave); break;
        case OP_RET: ph_ret_fast(p, jl, lds, tid, lane, wave); break;
        case OP_WKV: ph_wkv1(p, jl, lds, lane, wave); break;
        case OP_WKV2: ph_wkv2(p, jl, lane, wave); break;
        case OP_G_RETIN: is_gemm = true; E.kind = EK_RETIN; E.perm = true; E.slot = 2 * li;
            gA = (const bf16*)(ws + WS_XB); gB = (const bf16*)(ws + WS_WIN + jl * SZ_WIN); gN = RWIN; gK = D; break;
        case OP_G_RETOUT: is_gemm = true; E.kind = EK_RESID; E.perm = false; E.slot = 2 * li + 1;
            gA = (const bf16*)(ws + WS_Y); gB = (const bf16*)(ws + WS_WOUT + jl * SZ_WOUT); gN = D; gK = RV; break;
        case OP_G_RWPROJ: is_gemm = true; E.kind = EK_RWPROJ; E.perm = true;
            gA = (const bf16*)(ws + WS_H); gB = (const bf16*)(ws + WS_WRW + jl * SZ_WRW); gN = NRW; gK = KRW; break;
        case OP_G_LORA2: is_gemm = true; E.kind = EK_F32; E.perm = true;
            gA = (const bf16*)(ws + WS_A2); gB = (const bf16*)(ws + WS_WL2 + jl * SZ_WL2); gN = (jl == 0 ? 3072 : 4096); gK = KL2; break;
        case OP_G_WO: is_gemm = true; E.kind = EK_RESID; E.perm = false; E.slot = 2 * li + 1;
            gA = (const bf16*)(ws + WS_Z); gB = (const bf16*)(ws + WS_WO + jl * SZ_WO); gN = D; gK = D; break;
        case OP_G_UG: is_gemm = true; E.kind = EK_UG; E.perm = true; E.slot = 2 * li + 1;
            gA = (const bf16*)(ws + WS_XB); gB = (const bf16*)(ws + WS_WUG + li * SZ_WUG); gN = 2 * DFF; gK = D; break;
        case OP_G_WD: is_gemm = true; E.kind = EK_RESID; E.perm = false; E.slot = (li == 1) ? 2 * (li + 1) : -1;
            gA = (const bf16*)(ws + WS_ACT); gB = (const bf16*)(ws + WS_WD + li * SZ_WD); gN = D; gK = DFF; break;
        default: break;
        }
        if (is_gemm) {
            const bool ug = E.kind == EK_UG;
            const int gM = (E.kind == EK_RESID) ? MT0 : (ug ? 66 * 256 : M);
            pg8::Gemm g{ug ? gA - 2 * D : gA, gB, gM, gN, gK, ug ? 254 : 256}; pg8::StaticOrder S; S.init(gM, gN, (int)gridDim.x, (int)blockIdx.x);
            if (E.kind == EK_RETIN || E.kind == EK_UG) {
                LAS float* rt = (LAS float*)(lds + 131072);
                Unit uu;
                for (int ui = 0; ui < 8 && S.next(ui, uu); ++ui) if (tid < 256) { int rr = ug ? 254 * uu.pm - 2 + tid : uu.pm * 256 + tid; rr = rr < 0 ? 0 : (rr > M - 1 ? M - 1 : rr); rt[ui * 256 + tid] = row_rstd(ws, E.slot, rr); }
                E.rtab = rt; E.ldsb = lds;
                __syncthreads();
            }
            if (ug) { EpiAnyT<1> E1{}; E1.kind = E.kind; E1.perm = E.perm; E1.jl = E.jl; E1.ws = E.ws; E1.slot = E.slot; E1.rtab = E.rtab; E1.amul = E.amul; E1.li = E.li; E1.ldsb = E.ldsb; E1.pcw = p.in[I_CW]; E1.pcb = p.in[I_CB]; E1.pcst = p.in[I_SCONV]; E1.pout = p.out;
                pg8::gemm_phase<EpiAnyT<1>, pg8::StaticOrder, true, true>(lds, g, S, E1, tid); }
            else pg8::gemm_phase<EpiAnyT<0>, pg8::StaticOrder, true, true>(lds, g, S, E, tid);
            if (E.kind == EK_RESID) tail_resid(gA, gB, gK, ws, E.slot, E.amul, lds, lane, wave);
        }
        if (ph + 1 < hi) { if (ph == 0) cg::this_grid().sync(); else { XcdBarrier bar; bar.tid0 = tid == 0; bar.bar = (unsigned*)(p.ws + WS_CTL); bar.x = xb_xcc_id(); bar.st = (volatile LAS unsigned*)(lds + LDS_BYTES - 16); xcd_barrier(bar); } }
    }
}

}

extern "C" void kernel_launch(void* const* d_in, const int* in_sizes, int n_in, void* d_out, int out_size, void* d_ws, size_t ws_size, hipStream_t stream) {
    static int grid = 0;
    if (grid == 0) {
        int dev = 0, cus = 0;
        if (n_in != N_IN || ws_size < WS_END2) { fprintf(stderr, "kernel_launch: unexpected n_in %d / ws_size %zu (need %zu)\n", n_in, ws_size, (size_t)WS_END2); grid = -1; return; }
        if (hipGetDevice(&dev) != hipSuccess || hipDeviceGetAttribute(&cus, hipDeviceAttributeMultiprocessorCount, dev) != hipSuccess) { grid = -1; return; }
        if (hipFuncSetAttribute((const void*)mega, hipFuncAttributeMaxDynamicSharedMemorySize, LDS_BYTES) != hipSuccess) { fprintf(stderr, "kernel_launch: hipFuncSetAttribute failed\n"); grid = -1; return; }
        int per_cu = 0;
        if (hipOccupancyMaxActiveBlocksPerMultiprocessor(&per_cu, (const void*)mega, NTHR, LDS_BYTES) != hipSuccess || per_cu < 1) { fprintf(stderr, "kernel_launch: occupancy query says %d\n", per_cu); (void)hipGetLastError(); }
        grid = cus * (per_cu >= 1 ? 1 : 1);
    }
    if (grid < 0) return;
    Params p{};
    for (int i = 0; i < N_IN; ++i) p.in[i] = (const float*)d_in[i];
    p.out = (float*)d_out; p.ws = (unsigned char*)d_ws;
    if (hipMemsetAsync(d_ws, 0, 65536, stream) != hipSuccess) { fprintf(stderr, "kernel_launch: memset failed\n"); return; }
    int lo = 0, hi = NPH;
    void* args[] = {(void*)&p, (void*)&lo, (void*)&hi};
    const hipError_t e = hipLaunchCooperativeKernel((const void*)mega, dim3(grid), dim3(NTHR), args, LDS_BYTES, stream);
    if (e != hipSuccess) fprintf(stderr, "kernel_launch: cooperative launch failed: %s (grid %d)\n", hipGetErrorString(e), grid);
    (void)in_sizes; (void)out_size;
}
```

```cpp
#include <hip/hip_runtime.h>
#include <hip/hip_cooperative_groups.h>
#include <cstdio>
#include <stdint.h>
namespace cg = cooperative_groups;
namespace pg8 {
#define PG8_LAS __attribute__((address_space(3)))
typedef unsigned short bf16_t;
typedef short bf16x8 __attribute__((ext_vector_type(8)));
typedef float f32x4 __attribute__((ext_vector_type(4)));
typedef unsigned u32x4 __attribute__((ext_vector_type(4)));
constexpr int BM = 256, BK = 64, HALF = 128, HTB = HALF * BK * 2  , STAGE_BYTES = 8 * HTB, NXCD = 8, WGM = 8;

__host__ __device__ __forceinline__ int lds_byte(int r, int c) { const int st = (r >> 4) * 2 + (c >> 5), rr = r & 15, cc = c & 31, ob = rr * 64 + cc * 2; return st * 1024 + (ob ^ (((ob >> 9) & 1) << 5)); }
__host__ __device__ __forceinline__ void stage_rc(int b, int& R, int& C) { const int st = b / 1024, sb = b % 1024, swz = sb ^ (((sb >> 9) & 1) << 5); R = (st >> 1) * 16 + swz / 64; C = (st & 1) * 32 + (swz % 64) / 2; }
__host__ __device__ __forceinline__ int perm32(int rho) { const int n = rho >> 4, i = rho & 15; return 8 * (i >> 2) + 4 * n + (i & 3); }

struct Unit { int pm, pn, ord; };
struct Gemm { const bf16_t* A; const bf16_t* Bt; int M, N, K, trows; };

struct StaticOrder {
    int nM, nN, nwg, G, c;
    __host__ __device__ void init(int M, int N, int G_, int c_) { nM = M / BM; nN = N / BM; nwg = nM * nN; G = G_; c = c_; }
    __host__ __device__ __forceinline__ bool next(int i, Unit& u) const {
        const long L = (long)i * G + c; if (L >= nwg) return false;
        int wgid = (int)L; { const int q = nwg / NXCD, r = nwg % NXCD, xcd = wgid % NXCD, off = wgid / NXCD; wgid = (xcd < r ? xcd * (q + 1) : r * (q + 1) + (xcd - r) * q) + off; }
        const int nig = WGM * nN, gid = wgid / nig, fm = gid * WGM, gsz = (nM - fm) < WGM ? (nM - fm) : WGM;
        u.pm = fm + ((wgid % nig) % gsz); u.pn = (wgid % nig) / gsz; u.ord = i; return true;
    }
    __device__ __forceinline__ void a_ready(const Unit&) const {}
    __device__ __forceinline__ void done(const Unit&) const {}
};
template <class Epi, class Sched, bool ALIGN_EPI = false, bool SP2 = false>
__device__ __forceinline__ void gemm_phase(PG8_LAS unsigned char* lds, const Gemm g, const Sched& S, const Epi& E, int tid_in) {
    int tid = tid_in; asm volatile("" : "+v"(tid));
    const int wid = __builtin_amdgcn_readfirstlane(tid >> 6), lane = tid & 63, wr = wid >> 2, wc = wid & 3, fr = lane & 15, fq = lane >> 4;
    const int K = g.K, nt = K / BK;
    unsigned voffA[2], voffB[2];
#pragma unroll
    for (int i = 0; i < 2; ++i) { int R, C; stage_rc(tid * 16 + i * 8192, R, C); const int Rb = E.perm ? ((R & ~31) + perm32(R & 31)) : R;
        voffA[i] = (unsigned)(R * K + C) * 2u; voffB[i] = (unsigned)(Rb * K + C) * 2u; }
    const size_t kstep = (size_t)(BK * 2);
    const size_t hstep = (size_t)HALF * K * 2;
    const size_t tstep = 2 * hstep; const size_t tstepA = (size_t)g.trows * K * 2;
    const unsigned ldsw = (unsigned)wid * 1024u;
    const int aoff = lds_byte(wr * 64 + fr, fq * 8), boff = lds_byte(wc * 32 + fr, fq * 8);
#define PG8_SA(b, h) (((b) * 2 + (h)) * HTB)
#define PG8_SB(b, h) ((4 + (b) * 2 + (h)) * HTB)
#define PG8_STAGE(bufoff, gbase, voff) do { _Pragma("unroll") for (int _i = 0; _i < 2; ++_i) \
        __builtin_amdgcn_global_load_lds((const unsigned*)((const char*)(gbase) + (voff)[_i]), (PG8_LAS unsigned*)(lds + (bufoff) + ldsw + _i * 8192), 16, 0, 0); } while (0)
#define PG8_LDA(dst, b, h) do { _Pragma("unroll") for (int m = 0; m < 4; ++m) _Pragma("unroll") for (int k = 0; k < 2; ++k) dst[m][k] = *(const PG8_LAS bf16x8*)(lds + PG8_SA(b, h) + aoff + m * 2048 + k * 1024); } while (0)
#define PG8_LDB(dst, b, h) do { _Pragma("unroll") for (int n = 0; n < 2; ++n) _Pragma("unroll") for (int k = 0; k < 2; ++k) dst[n][k] = *(const PG8_LAS bf16x8*)(lds + PG8_SB(b, h) + boff + n * 2048 + k * 1024); } while (0)
#define PG8_MMA(ai, bj, At, Bt) do { __builtin_amdgcn_s_setprio(1); _Pragma("unroll") for (int m = 0; m < 4; ++m) _Pragma("unroll") for (int n = 0; n < 2; ++n) _Pragma("unroll") for (int k = 0; k < 2; ++k) \
        acc[ai][bj][m][n] = __builtin_amdgcn_mfma_f32_16x16x32_bf16(Bt[n][k], At[m][k], acc[ai][bj][m][n], 0, 0, 0); __builtin_amdgcn_s_setprio(0); } while (0)
#define PG8_WAIT_V(n) asm volatile("s_waitcnt vmcnt(" #n ")" ::: "memory")
#define PG8_WAIT_L(n) asm volatile("s_waitcnt lgkmcnt(" #n ")" ::: "memory")
#define PG8_BAR __builtin_amdgcn_s_barrier()
#define PG8_SCHED __builtin_amdgcn_sched_barrier(0)
    Unit cur, nxt; int ui = 0;
    if (!S.next(0, cur)) return;
    f32x4 acc[2][2][4][2];
#pragma unroll
    for (int a = 0; a < 2; ++a)
#pragma unroll
        for (int b = 0; b < 2; ++b)
#pragma unroll
            for (int m = 0; m < 4; ++m)
#pragma unroll
                for (int n = 0; n < 2; ++n) acc[a][b][m][n] = (f32x4){0.f, 0.f, 0.f, 0.f};
    bf16x8 At[4][2], B0[2][2], B1[2][2];
    const char* cA = (const char*)g.A + (size_t)cur.pm * tstepA; const char* cB = (const char*)g.Bt + (size_t)cur.pn * tstep;
    S.a_ready(cur);
    if constexpr (SP2) {
        PG8_STAGE(PG8_SB(0, 0), cB, voffB); PG8_STAGE(PG8_SB(0, 1), cB + hstep, voffB); PG8_STAGE(PG8_SA(0, 0), cA, voffA); PG8_STAGE(PG8_SA(0, 1), cA + hstep, voffA);
        if (wr == 1) PG8_BAR;
        PG8_WAIT_V(2); PG8_BAR;
        PG8_STAGE(PG8_SB(1, 0), cB + kstep, voffB); PG8_STAGE(PG8_SA(1, 0), cA + kstep, voffA); PG8_STAGE(PG8_SB(1, 1), cB + hstep + kstep, voffB);
        PG8_WAIT_V(6); PG8_BAR;
    } else {
        PG8_STAGE(PG8_SB(0, 0), cB, voffB); PG8_STAGE(PG8_SA(0, 0), cA, voffA); PG8_STAGE(PG8_SB(0, 1), cB + hstep, voffB); PG8_STAGE(PG8_SA(0, 1), cA + hstep, voffA);
        if (wr == 1) PG8_BAR;
        PG8_WAIT_V(4); PG8_BAR;
        PG8_STAGE(PG8_SB(1, 0), cB + kstep, voffB); PG8_STAGE(PG8_SA(1, 0), cA + kstep, voffA); PG8_STAGE(PG8_SB(1, 1), cB + hstep + kstep, voffB);
        PG8_WAIT_V(6); PG8_BAR;
    }
    for (;;) {
        const bool has_next = S.next(ui + 1, nxt);
        const char* nA = has_next ? (const char*)g.A + (size_t)nxt.pm * tstepA : cA; const char* nB = has_next ? (const char*)g.Bt + (size_t)nxt.pn * tstep : cB;
        for (int t = 0; t < nt; t += 2) {
            const bool last = (t == nt - 2);
            const char* a1 = cA + (size_t)(t + 1) * kstep;
            const char* a2 = last ? nA : cA + (size_t)(t + 2) * kstep; const char* b2 = last ? nB : cB + (size_t)(t + 2) * kstep;
            const char* a3 = a2 + kstep; const char* b3 = b2 + kstep;
            if (last && has_next) S.a_ready(nxt);
            if constexpr (SP2) {
            PG8_LDB(B0, 0, 0); PG8_LDB(B1, 0, 1); PG8_SCHED; PG8_LDA(At, 0, 0); PG8_STAGE(PG8_SA(1, 1), a1 + hstep, voffA);
            PG8_WAIT_V(8); PG8_WAIT_L(0); PG8_BAR; PG8_MMA(0, 0, At, B0); PG8_MMA(0, 1, At, B1); PG8_BAR; PG8_SCHED;
            PG8_LDA(At, 0, 1); PG8_STAGE(PG8_SB(0, 0), b2, voffB); PG8_STAGE(PG8_SB(0, 1), b2 + hstep, voffB); PG8_STAGE(PG8_SA(0, 0), a2, voffA);
            PG8_WAIT_V(8); PG8_WAIT_L(0); PG8_BAR; PG8_MMA(1, 0, At, B0); PG8_MMA(1, 1, At, B1); PG8_BAR; PG8_SCHED;
            PG8_LDB(B0, 1, 0); PG8_LDB(B1, 1, 1); PG8_SCHED; PG8_LDA(At, 1, 0); PG8_STAGE(PG8_SA(0, 1), a2 + hstep, voffA);
            PG8_WAIT_V(8); PG8_WAIT_L(0); PG8_BAR; PG8_MMA(0, 0, At, B0); PG8_MMA(0, 1, At, B1); PG8_BAR; PG8_SCHED;
            PG8_LDA(At, 1, 1); PG8_STAGE(PG8_SB(1, 0), b3, voffB); PG8_STAGE(PG8_SB(1, 1), b3 + hstep, voffB); PG8_STAGE(PG8_SA(1, 0), a3, voffA);
            PG8_WAIT_V(8); PG8_WAIT_L(0); PG8_BAR; PG8_MMA(1, 0, At, B0); PG8_MMA(1, 1, At, B1); PG8_BAR; PG8_SCHED;
            } else {
            PG8_LDB(B0, 0, 0); PG8_SCHED; PG8_LDA(At, 0, 0); PG8_STAGE(PG8_SA(1, 1), a1 + hstep, voffA);
            PG8_WAIT_L(8); PG8_BAR; PG8_WAIT_L(0); PG8_MMA(0, 0, At, B0); PG8_BAR; PG8_SCHED;
            PG8_LDB(B1, 0, 1); PG8_STAGE(PG8_SB(0, 0), b2, voffB);
            PG8_BAR; PG8_WAIT_L(0); PG8_MMA(0, 1, At, B1); PG8_BAR;
            PG8_LDA(At, 0, 1); PG8_STAGE(PG8_SA(0, 0), a2, voffA);
            PG8_BAR; PG8_WAIT_L(0); PG8_MMA(1, 0, At, B0); PG8_BAR; PG8_SCHED;
            PG8_STAGE(PG8_SB(0, 1), b2 + hstep, voffB);
            PG8_WAIT_V(6); PG8_BAR; PG8_MMA(1, 1, At, B1); PG8_BAR;
            PG8_LDB(B0, 1, 0); PG8_SCHED; PG8_LDA(At, 1, 0); PG8_STAGE(PG8_SA(0, 1), a2 + hstep, voffA);
            PG8_WAIT_L(8); PG8_BAR; PG8_WAIT_L(0); PG8_MMA(0, 0, At, B0); PG8_BAR; PG8_SCHED;
            PG8_LDB(B1, 1, 1); PG8_STAGE(PG8_SB(1, 0), b3, voffB);
            PG8_BAR; PG8_WAIT_L(0); PG8_MMA(0, 1, At, B1); PG8_BAR;
            PG8_LDA(At, 1, 1); PG8_STAGE(PG8_SA(1, 0), a3, voffA);
            PG8_BAR; PG8_WAIT_L(0); PG8_MMA(1, 0, At, B0); PG8_BAR; PG8_SCHED;
            PG8_STAGE(PG8_SB(1, 1), b3 + hstep, voffB);
            PG8_WAIT_V(6); PG8_BAR; PG8_MMA(1, 1, At, B1); PG8_BAR;
            }
        }
        if constexpr (ALIGN_EPI) { if (wr == 0) PG8_BAR; }
        if constexpr (!Epi::AFTER_DRAIN) { E(acc, cur, wr, wc, fr, fq); S.done(cur); }
        if (!has_next) break;
#pragma unroll
        for (int a = 0; a < 2; ++a)
#pragma unroll
            for (int b = 0; b < 2; ++b)
#pragma unroll
                for (int m = 0; m < 4; ++m)
#pragma unroll
                    for (int n = 0; n < 2; ++n) acc[a][b][m][n] = (f32x4){0.f, 0.f, 0.f, 0.f};
        cur = nxt; cA = nA; cB = nB; ++ui;
        if constexpr (ALIGN_EPI) { if (wr == 1) PG8_BAR; }
    }
    PG8_WAIT_V(0);
    if constexpr (!ALIGN_EPI) { if (wr == 0) PG8_BAR; }
    PG8_BAR;
    if constexpr (Epi::AFTER_DRAIN) { E.fused(acc, cur, wr, wc, fr, fq, lds, wid, lane); S.done(cur); }
#undef PG8_SA
#undef PG8_SB
#undef PG8_STAGE
#undef PG8_LDA
#undef PG8_LDB
#undef PG8_MMA
#undef PG8_WAIT_V
#undef PG8_WAIT_L
#undef PG8_BAR
#undef PG8_SCHED
}
}

namespace {
constexpr int D = 1024, BATCH = 8, SEQ = 2048, NMETA = 16, TP = SEQ + NMETA, MP = BATCH * TP, SB = 128, M = MP + SB;
constexpr int DEPTH = 4, RH = 4, RDK = 256, RDV = 512, RV = 2048, RWIN = 6144;
constexpr int WH = 16, WN = 64, LW = 64, LA = 64, LV = 32, LG = 160, DFF = 2816;
constexpr int NRW = 3584, KRW = 2048, KL2 = 384, NL2 = 4096;
constexpr float PAST_POS = 16384.f;
constexpr int NWAVES = 8, NTHR = 512;
constexpr int LDS_BYTES = 147456;

constexpr size_t O_YP = 0;
constexpr size_t O_YS = O_YP + (size_t)BATCH * SEQ * D;
constexpr size_t O_RETP = O_YS + (size_t)SB * D;
constexpr size_t O_WKVP = O_RETP + (size_t)2 * BATCH * RH * RDK * RDV;
constexpr size_t O_SHP = O_WKVP + (size_t)2 * BATCH * WH * WN * WN;
constexpr size_t O_CVP = O_SHP + (size_t)2 * BATCH * D;
constexpr size_t O_RETS = O_CVP + (size_t)DEPTH * BATCH * 2 * DFF;
constexpr size_t O_WKVS = O_RETS + (size_t)2 * SB * RH * RDK * RDV;
constexpr size_t O_SHS = O_WKVS + (size_t)2 * SB * WH * WN * WN;
constexpr size_t O_CVS = O_SHS + (size_t)2 * SB * D;

enum { I_XP = 0, I_XS, I_SRET, I_SWKV, I_SSHIFT, I_SCONV, I_META, I_NMIX, I_NFFN, I_NFIN, I_RWIN, I_RGN, I_RWOUT, I_MU, I_WRKV, I_W0, I_W1, I_W2,
       I_A0, I_A1, I_A2, I_V0, I_V1, I_V2, I_G1, I_G2, I_KK, I_KA, I_RK, I_LNW, I_LNB, I_WO, I_WUG, I_CW, I_CB, I_WD, N_IN };

constexpr size_t al256(size_t x) { return (x + 255) & ~(size_t)255; }
constexpr size_t WS_CTL = 0;
constexpr size_t WS_CS = 1u << 20;
constexpr size_t WS_WIN = 4u << 20;
constexpr size_t SZ_WIN = (size_t)RWIN * D * 2;
constexpr size_t WS_WOUT = WS_WIN + 2 * SZ_WIN;
constexpr size_t SZ_WOUT = (size_t)D * RV * 2;
constexpr size_t WS_WRW = WS_WOUT + 2 * SZ_WOUT;
constexpr size_t SZ_WRW = (size_t)NRW * KRW * 2;
constexpr size_t WS_WL2 = WS_WRW + 2 * SZ_WRW;
constexpr size_t SZ_WL2 = (size_t)NL2 * KL2 * 2;
constexpr size_t WS_WO = WS_WL2 + 2 * SZ_WL2;
constexpr size_t SZ_WO = (size_t)D * D * 2;
constexpr size_t WS_WUG = WS_WO + 2 * SZ_WO;
constexpr size_t SZ_WUG = (size_t)2 * DFF * D * 2;
constexpr size_t WS_WD = WS_WUG + 4 * SZ_WUG;
constexpr size_t SZ_WD = (size_t)D * DFF * 2;
constexpr size_t WS_X = al256(WS_WD + 4 * SZ_WD);
constexpr size_t SZ_MD4 = (size_t)M * D * 4;
constexpr size_t WS_H = WS_X + SZ_MD4;
constexpr size_t WS_VF = WS_H + SZ_MD4;
constexpr size_t WS_REG = WS_VF + SZ_MD4;
constexpr size_t WS_QK = WS_REG;
constexpr size_t WS_V = WS_QK + SZ_MD4;
constexpr size_t WS_SG = WS_V + SZ_MD4;
constexpr size_t WS_O = WS_SG + SZ_MD4;
constexpr size_t WS_Y = WS_O + 2 * SZ_MD4;
constexpr size_t WS_R = WS_REG;
constexpr size_t WS_K = WS_R + SZ_MD4;
constexpr size_t WS_VB = WS_K + SZ_MD4;
constexpr size_t WS_WDEC = WS_VB + SZ_MD4;
constexpr size_t WS_NKK = WS_WDEC + SZ_MD4;
constexpr size_t WS_KKA = WS_NKK + SZ_MD4;
constexpr size_t WS_YW = WS_KKA + SZ_MD4;
constexpr size_t WS_L2 = WS_YW + SZ_MD4;
constexpr size_t WS_A2 = WS_L2 + 4 * SZ_MD4;
constexpr size_t WS_Z = al256(WS_A2 + (size_t)M * KL2 * 2);
constexpr size_t WS_RW_END = WS_Z + (size_t)M * D * 2;
constexpr size_t SZ_FF2 = (size_t)M * DFF * 2;
constexpr size_t WS_U = WS_REG;
constexpr size_t WS_G = al256(WS_U + SZ_FF2);
constexpr size_t WS_ACT = al256(WS_G + SZ_FF2);
constexpr size_t WS_XB = al256(WS_RW_END) + 2 * (size_t)D * 2;
constexpr size_t WS_SS = al256(WS_XB + (size_t)(M + 126) * D * 2);
constexpr size_t WS_PTRS = al256(WS_SS + (size_t)8 * M * 16 * 4);
constexpr size_t WS_END = WS_PTRS + 256;

#define LAS __attribute__((address_space(3)))
typedef unsigned short bf16;
typedef unsigned v4u __attribute__((ext_vector_type(4)));
typedef unsigned v2u __attribute__((ext_vector_type(2)));
using pg8::f32x4;
using pg8::Unit;
using pg8::bf16x8;

struct Params { const float* in[N_IN]; float* out; unsigned char* ws; };

__device__ __forceinline__ unsigned cvt_pk_bf16(float lo, float hi) { unsigned r; asm("v_cvt_pk_bf16_f32 %0, %1, %2" : "=v"(r) : "v"(lo), "v"(hi)); return r; }
__device__ __forceinline__ float bf_lo(unsigned w) { return __uint_as_float(w << 16); }
__device__ __forceinline__ float bf_hi(unsigned w) { return __uint_as_float(w & 0xffff0000u); }
__device__ __forceinline__ void unpack8(const v4u w, float (&f)[8]) { f[0] = bf_lo(w.x); f[1] = bf_hi(w.x); f[2] = bf_lo(w.y); f[3] = bf_hi(w.y); f[4] = bf_lo(w.z); f[5] = bf_hi(w.z); f[6] = bf_lo(w.w); f[7] = bf_hi(w.w); }
__device__ __forceinline__ v4u pack8(const float (&f)[8]) { v4u w; w.x = cvt_pk_bf16(f[0], f[1]); w.y = cvt_pk_bf16(f[2], f[3]); w.z = cvt_pk_bf16(f[4], f[5]); w.w = cvt_pk_bf16(f[6], f[7]); return w; }
__device__ __forceinline__ f32x4 ld_bf4(const bf16* q) { const v2u w = *(const v2u*)q; return (f32x4){bf_lo(w.x), bf_hi(w.x), bf_lo(w.y), bf_hi(w.y)}; }
__device__ __forceinline__ void st_bf4(bf16* q, const f32x4 v) { v2u w; w.x = cvt_pk_bf16(v.x, v.y); w.y = cvt_pk_bf16(v.z, v.w); *(v2u*)q = w; }
__device__ __forceinline__ float shfl_xor_l(float v, int m, int lane) { return __int_as_float(__builtin_amdgcn_ds_bpermute((lane ^ m) << 2, __float_as_int(v))); }
__device__ __forceinline__ float shfl_l(float v, int src) { return __int_as_float(__builtin_amdgcn_ds_bpermute(src << 2, __float_as_int(v))); }
__device__ __forceinline__ float wave_sum(float v, int) {
    v += __builtin_bit_cast(float, __builtin_amdgcn_update_dpp(0, __float_as_int(v), 0x128, 0xf, 0xf, false));
    v += __builtin_bit_cast(float, __builtin_amdgcn_update_dpp(0, __float_as_int(v), 0x124, 0xf, 0xf, false));
    v += __builtin_bit_cast(float, __builtin_amdgcn_update_dpp(0, __float_as_int(v), 0x122, 0xf, 0xf, false));
    v += __builtin_bit_cast(float, __builtin_amdgcn_update_dpp(0, __float_as_int(v), 0x121, 0xf, 0xf, false));
    const int vi = __float_as_int(v);
    return (__int_as_float(__builtin_amdgcn_readlane(vi, 0)) + __int_as_float(__builtin_amdgcn_readlane(vi, 16))) + (__int_as_float(__builtin_amdgcn_readlane(vi, 32)) + __int_as_float(__builtin_amdgcn_readlane(vi, 48)));
}
__device__ __forceinline__ float rcpf_(float x) { return __builtin_amdgcn_rcpf(x); }
__device__ __forceinline__ float sigmoidf_(float x) { return rcpf_(1.f + __expf(-x)); }
__device__ __forceinline__ float siluf_(float x) { return x * rcpf_(1.f + __expf(-x)); }
__device__ __forceinline__ float tanhf_(float x) { return 1.f - 2.f * rcpf_(1.f + __expf(2.f * x)); }

__device__ __forceinline__ float row_rstd(const unsigned char* ws, int slot, int row) {
    const f32x4* q = (const f32x4*)((const float*)(ws + WS_SS) + ((size_t)slot * M + row) * 16);
    const f32x4 a = q[0], b = q[1], c = q[2], d = q[3];
    const float ss = (((a.x + a.y) + (a.z + a.w)) + ((b.x + b.y) + (b.z + b.w))) + (((c.x + c.y) + (c.z + c.w)) + ((d.x + d.y) + (d.z + d.w)));
    return rsqrtf(ss * (1.f / D) + 1e-6f);
}
__device__ __forceinline__ float dpp_ror1(float v) { return __int_as_float(__builtin_amdgcn_update_dpp(0, __float_as_int(v), 0x121, 0xf, 0xf, false)); }
template <int CTRL> __device__ __forceinline__ float dpp_mv(float v) { return __int_as_float(__builtin_amdgcn_mov_dpp(__float_as_int(v), CTRL, 0xf, 0xf, true)); }
__device__ __forceinline__ float dpp_ror2(float v) { return __int_as_float(__builtin_amdgcn_update_dpp(0, __float_as_int(v), 0x122, 0xf, 0xf, false)); }
enum { EK_RETIN = 0, EK_RESID, EK_UG, EK_RWPROJ, EK_F32 };
template <int GRP> struct EpiExtra {};
template <> struct EpiExtra<1> { const float* pcw; const float* pcb; const float* pcst; float* pout; };
template <int GRP> struct EpiAnyT : EpiExtra<GRP> {
    static constexpr bool AFTER_DRAIN = false;
    int kind; bool perm; int jl; unsigned char* ws; int slot; const LAS float* rtab; float amul; int li; LAS unsigned char* ldsb;
    __device__ __forceinline__ void operator()(const f32x4 (&acc)[2][2][4][2], const Unit& u, int wr, int wc, int fr, int fq) const {
        const int row0 = u.pm * 256 + wr * 64 + fr;
        if (GRP == 0 && kind == EK_RETIN) {
            bf16* QK = (bf16*)(ws + WS_QK); bf16* V = (bf16*)(ws + WS_V); bf16* SG = (bf16*)(ws + WS_SG); const float* CS = (const float*)(ws + WS_CS);
            const int cw = wc * 32 + 8 * fq;
            if (u.pn < 8) {
                const bool isk = u.pn >= 4; const int h = u.pn & 3; const float sc = isk ? 0.0625f : 1.f;
                bf16* base = QK + (isk ? 1024 : 0) + h * 256 + cw;
#pragma unroll
                for (int ai = 0; ai < 2; ++ai) {
                    f32x4 tt[4][4];
#pragma unroll
                    for (int m = 0; m < 4; ++m) { const int row = row0 + ai * 128 + m * 16; const int pi = row < MP ? row % TP : TP;
                        const f32x4* cs = (const f32x4*)(CS + ((size_t)pi * 128 + cw) * 2);
#pragma unroll
                        for (int q4 = 0; q4 < 4; ++q4) tt[m][q4] = cs[q4]; }
#pragma unroll
                    for (int m = 0; m < 4; ++m) {
                        const int row = row0 + ai * 128 + m * 16;
                        const float rs = rtab[u.ord * 256 + (row - u.pm * 256)] * sc;
                        const f32x4 t0 = tt[m][0], t1 = tt[m][1], t2 = tt[m][2], t3 = tt[m][3];
                        const float c[8] = {t0.x, t0.z, t1.x, t1.z, t2.x, t2.z, t3.x, t3.z}, s[8] = {t0.y, t0.w, t1.y, t1.w, t2.y, t2.w, t3.y, t3.w};
                        float o1[8], o2[8];
#pragma unroll
                        for (int n = 0; n < 2; ++n)
#pragma unroll
                            for (int j = 0; j < 4; ++j) {
                                const float x1 = acc[ai][0][m][n][j], x2 = acc[ai][1][m][n][j];
                                o1[n * 4 + j] = (x1 * c[n * 4 + j] - x2 * s[n * 4 + j]) * rs;
                                o2[n * 4 + j] = (x1 * s[n * 4 + j] + x2 * c[n * 4 + j]) * rs;
                            }
                        bf16* rp = base + (size_t)row * 2048;
                        *(v4u*)rp = pack8(o1); *(v4u*)(rp + 128) = pack8(o2);
                    }
                    asm volatile("" ::: "memory");
                }
            } else {
                const bool isg = u.pn >= 16;
                bf16* base = (isg ? SG : V) + ((u.pn - (isg ? 16 : 8)) * 256) + cw;
#pragma unroll
                for (int ai = 0; ai < 2; ++ai)
#pragma unroll
                    for (int m = 0; m < 4; ++m) {
                        bf16* rp = base + (size_t)(row0 + ai * 128 + m * 16) * 2048;
                        const float rs = rtab[u.ord * 256 + (wr * 64 + fr + ai * 128 + m * 16)];
#pragma unroll
                        for (int bj = 0; bj < 2; ++bj) {
                            float o[8];
#pragma unroll
                            for (int n = 0; n < 2; ++n)
#pragma unroll
                                for (int j = 0; j < 4; ++j) { const float x = acc[ai][bj][m][n][j] * rs; o[n * 4 + j] = isg ? siluf_(x) : x; }
                            *(v4u*)(rp + bj * 128) = pack8(o);
                        }
                    }
            }
        } else if (GRP == 0 && kind == EK_RESID) {
            float* X = (float*)(ws + WS_X);
            const int col0 = u.pn * 256 + wc * 32 + 4 * fq;
#pragma unroll
            for (int am = 0; am < 4; ++am) { const int ai = am >> 1, mb = (am & 1) * 2;
                f32x4 xv[2][2][2];
#pragma unroll
                for (int mm = 0; mm < 2; ++mm) { const int m = mb + mm; const float* rp = X + (size_t)(row0 + ai * 128 + m * 16) * D + col0;
#pragma unroll
                    for (int bj = 0; bj < 2; ++bj)
#pragma unroll
                        for (int n = 0; n < 2; ++n) xv[mm][bj][n] = *(const f32x4*)(rp + bj * 128 + n * 16); }
#pragma unroll
                for (int mm = 0; mm < 2; ++mm) { const int m = mb + mm;
                    const int row = row0 + ai * 128 + m * 16;
                    float* rp = X + (size_t)row * D + col0; bf16* xb = (bf16*)(ws + WS_XB) + (size_t)row * D + col0;
                    float ssq = 0.f;
#pragma unroll
                    for (int bj = 0; bj < 2; ++bj)
#pragma unroll
                        for (int n = 0; n < 2; ++n) { const f32x4 v = xv[mm][bj][n] + acc[ai][bj][m][n] * amul; *(f32x4*)(rp + bj * 128 + n * 16) = v;
                            if (slot >= 0) { ssq += (v.x * v.x + v.y * v.y) + (v.z * v.z + v.w * v.w); v2u w; w.x = cvt_pk_bf16(v.x, v.y); w.y = cvt_pk_bf16(v.z, v.w); *(v2u*)(xb + bj * 128 + n * 16) = w; } }
                    if (slot >= 0) { ssq += shfl_xor_l(ssq, 16, fq * 16 + fr); ssq += shfl_xor_l(ssq, 32, fq * 16 + fr); if (fq == 0) ((float*)(ws + WS_SS))[((size_t)slot * M + row) * 16 + u.pn * 4 + wc] = ssq; }
                }
                asm volatile("" ::: "memory");
            }
        } else if (GRP == 1 && kind == EK_UG) {
            const EpiExtra<1>& X1 = *(const EpiExtra<1>*)(const void*)this;
            const float* cw = X1.pcw + (size_t)li * 3 * DFF; const float* cb = X1.pcb + (size_t)li * DFF; const float* cst = X1.pcst + (size_t)li * SB * 2 * DFF;
            float* cvp = X1.pout + O_CVP + (size_t)li * BATCH * 2 * DFF; float* cvs = X1.pout + O_CVS + (size_t)li * SB * 2 * DFF;
            bf16* ACT = (bf16*)(ws + WS_ACT);
            const int fl = wc * 32 + 8 * fq;
            LAS float* halo = (LAS float*)(ldsb + 131072 + 8192);
            const LAS float* rt = rtab + u.ord * 256;
#pragma unroll
            for (int ai = 0; ai < 2; ++ai) if (fr >= 14) {
                const float rs = rt[128 * ai + 64 * wr + 48 + fr];
                LAS float* hp = halo + ((2 * ai + wr) * 2 + (fr - 14)) * 128 + fl;
                *(LAS f32x4*)hp = acc[ai][1][3][0] * rs; *(LAS f32x4*)(hp + 4) = acc[ai][1][3][1] * rs;
            }
            asm volatile("s_waitcnt lgkmcnt(0)" ::: "memory"); __builtin_amdgcn_s_barrier(); asm volatile("" ::: "memory");
            const int R0 = 254 * u.pm - 2, bq = (R0 + 2) / TP, tq = (R0 + 2) - bq * TP;
            const bool plain = (R0 + 255 < MP) && tq >= 2 && tq + 253 < TP - 2;
            if (plain) {
                const bool k15 = fr == 15, k14 = fr >= 14;
#pragma unroll
                for (int n = 0; n < 2; ++n) {
                    const int f0 = u.pn * 128 + fl + 4 * n;
                    const f32x4 w0 = *(const f32x4*)(cw + f0), w1 = *(const f32x4*)(cw + DFF + f0), w2 = *(const f32x4*)(cw + 2 * DFF + f0), bb = *(const f32x4*)(cb + f0);
                    const unsigned ob = (unsigned)((R0 + 64 * wr + fr) * DFF + f0) * 2u;
                    f32x4 prev = (f32x4){0.f, 0.f, 0.f, 0.f};
#pragma unroll
                    for (int ai = 0; ai < 2; ++ai)
#pragma unroll
                        for (int m = 0; m < 4; ++m) {
                            const int l = 128 * ai + 64 * wr + 16 * m + fr;
                            const float rs = rt[l];
                            const f32x4 cur = acc[ai][1][m][n] * rs, uu = acc[ai][0][m][n] * rs;
                            if (m == 0) {
                                const int B = 2 * ai + wr;
                                prev = (f32x4){0.f, 0.f, 0.f, 0.f};
                                if (B > 0 && fr >= 14) prev = *(const LAS f32x4*)(halo + ((B - 1) * 2 + (fr - 14)) * 128 + fl + 4 * n);
                            }
                            float ov[4];
#pragma unroll
                            for (int e = 0; e < 4; ++e) {
                                const float ce = cur[e], pe = prev[e];
                                const float g1 = dpp_mv<0x121>(k15 ? pe : ce), g2 = dpp_mv<0x122>(k14 ? pe : ce);
                                const float cv = fmaf(w0[e], g2, fmaf(w1[e], g1, fmaf(w2[e], ce, bb[e])));
                                ov[e] = siluf_(cv) * uu[e];
                            }
                            v2u w; w.x = cvt_pk_bf16(ov[0], ov[1]); w.y = cvt_pk_bf16(ov[2], ov[3]);
                            if (ai > 0 || m > 0 || l >= 2) *(v2u*)((unsigned char*)ACT + (ob + (unsigned)((128 * ai + 16 * m) * DFF * 2))) = w;
                            prev = cur;
                        }
                }
            } else
#pragma unroll
            for (int n = 0; n < 2; ++n) {
                const int f0 = u.pn * 128 + fl + 4 * n;
                const f32x4 w0 = *(const f32x4*)(cw + f0), w1 = *(const f32x4*)(cw + DFF + f0), w2 = *(const f32x4*)(cw + 2 * DFF + f0), bb = *(const f32x4*)(cb + f0);
                f32x4 prev = (f32x4){0.f, 0.f, 0.f, 0.f};
#pragma unroll
                for (int ai = 0; ai < 2; ++ai)
#pragma unroll
                    for (int m = 0; m < 4; ++m) {
                        const int l = 128 * ai + 64 * wr + 16 * m + fr, row = 254 * u.pm - 2 + l;
                        const float rs = rt[l];
                        const f32x4 cur = acc[ai][1][m][n] * rs, uu = acc[ai][0][m][n] * rs;
                        if (m == 0) {
                            const int B = 2 * ai + wr;
                            prev = (f32x4){0.f, 0.f, 0.f, 0.f};
                            if (B > 0 && fr >= 14) prev = *(const LAS f32x4*)(halo + ((B - 1) * 2 + (fr - 14)) * 128 + fl + 4 * n);
                        }
                        f32x4 g1, g2;
                        {
                            const float c1x = dpp_ror1(cur.x), c1y = dpp_ror1(cur.y), c1z = dpp_ror1(cur.z), c1w = dpp_ror1(cur.w);
                            const float p1x = dpp_ror1(prev.x), p1y = dpp_ror1(prev.y), p1z = dpp_ror1(prev.z), p1w = dpp_ror1(prev.w);
                            const float c2x = dpp_ror2(cur.x), c2y = dpp_ror2(cur.y), c2z = dpp_ror2(cur.z), c2w = dpp_ror2(cur.w);
                            const float p2x = dpp_ror2(prev.x), p2y = dpp_ror2(prev.y), p2z = dpp_ror2(prev.z), p2w = dpp_ror2(prev.w);
                            const bool s1 = fr >= 1, s2 = fr >= 2;
                            g1.x = s1 ? c1x : p1x; g1.y = s1 ? c1y : p1y; g1.z = s1 ? c1z : p1z; g1.w = s1 ? c1w : p1w;
                            g2.x = s2 ? c2x : p2x; g2.y = s2 ? c2y : p2y; g2.z = s2 ? c2z : p2z; g2.w = s2 ? c2w : p2w;
                        }
                        if (l >= 2 && row < M) {
                            if (row < MP) {
                                const int b = row / TP, t = row - b * TP;
                                if (t < 2) { g2 = (f32x4){0.f, 0.f, 0.f, 0.f}; if (t == 0) g1 = g2; }
                                if (t >= TP - 2) *(f32x4*)(cvp + ((size_t)b * 2 + (t - (TP - 2))) * DFF + f0) = cur;
                            } else {
                                const int s = row - MP;
                                const float* c0 = cst + ((size_t)s * 2 + 0) * DFF + f0;
                                g2 = *(const f32x4*)c0; g1 = *(const f32x4*)(c0 + DFF);
                                float* o = cvs + ((size_t)s * 2 + 0) * DFF + f0;
                                *(f32x4*)o = g1; *(f32x4*)(o + DFF) = cur;
                            }
                            const f32x4 cv = bb + w0 * g2 + w1 * g1 + w2 * cur;
                            v2u w; w.x = cvt_pk_bf16(siluf_(cv.x) * uu.x, siluf_(cv.y) * uu.y); w.y = cvt_pk_bf16(siluf_(cv.z) * uu.z, siluf_(cv.w) * uu.w);
                            *(v2u*)(ACT + (size_t)row * DFF + f0) = w;
                        }
                        prev = cur;
                    }
            }
        } else if (GRP == 0 && kind == EK_RWPROJ) {
            const int cw = wc * 32 + 8 * fq;
            if (u.pn < 12) {
                bf16* dst = (bf16*)(ws + (u.pn < 4 ? WS_R : (u.pn < 8 ? WS_K : (jl == 0 ? WS_VF : WS_VB)))) + (u.pn & 3) * 256 + cw;
#pragma unroll
                for (int ai = 0; ai < 2; ++ai)
#pragma unroll
                    for (int m = 0; m < 4; ++m) {
                        bf16* rp = dst + (size_t)(row0 + ai * 128 + m * 16) * D;
#pragma unroll
                        for (int bj = 0; bj < 2; ++bj) { float o[8];
#pragma unroll
                            for (int n = 0; n < 2; ++n)
#pragma unroll
                                for (int j = 0; j < 4; ++j) o[n * 4 + j] = acc[ai][bj][m][n][j];
                            *(v4u*)(rp + bj * 128) = pack8(o); }
                    }
            } else {
                bf16* A2 = (bf16*)(ws + WS_A2);
#pragma unroll
                for (int bj = 0; bj < 2; ++bj) {
                    const int c = (u.pn - 12) * 256 + bj * 128 + cw;
                    if (c < KL2) {
                        const int kd = c < 64 ? 1 : ((c >= 128 && c < 288) ? 2 : 0);
#pragma unroll
                        for (int ai = 0; ai < 2; ++ai)
#pragma unroll
                            for (int m = 0; m < 4; ++m) { float o[8];
#pragma unroll
                                for (int n = 0; n < 2; ++n)
#pragma unroll
                                    for (int j = 0; j < 4; ++j) { const float x = acc[ai][bj][m][n][j]; o[n * 4 + j] = kd == 1 ? tanhf_(x) : (kd == 2 ? sigmoidf_(x) : x); }
                                *(v4u*)(A2 + (size_t)(row0 + ai * 128 + m * 16) * KL2 + c) = pack8(o); }
                    }
                }
            }
        } else if (GRP == 0) {
            bf16* C = (bf16*)(ws + WS_L2);
            const int col0 = u.pn * 256 + wc * 32 + 8 * fq;
#pragma unroll
            for (int ai = 0; ai < 2; ++ai)
#pragma unroll
                for (int m = 0; m < 4; ++m) {
                    bf16* rp = C + (size_t)(row0 + ai * 128 + m * 16) * NL2 + col0;
#pragma unroll
                    for (int bj = 0; bj < 2; ++bj) { float o[8];
#pragma unroll
                        for (int n = 0; n < 2; ++n)
#pragma unroll
                            for (int j = 0; j < 4; ++j) o[n * 4 + j] = acc[ai][bj][m][n][j];
                        *(v4u*)(rp + bj * 128) = pack8(o); }
                }
        }
    }
};

constexpr int MT0 = 16384;
__device__ __forceinline__ void tail_resid(const bf16* __restrict__ A, const bf16* __restrict__ Bt, int K, unsigned char* ws, int slot, float amul, LAS unsigned char* lds, int lane, int wave) {
    const int fr = lane & 15, fq = lane >> 4;
    float* X = (float*)(ws + WS_X);
    const int kw = K >> 3;
    for (int job = blockIdx.x; job < 16 * 16; job += gridDim.x) {
        const int rs = job >> 4, cs = job & 15;
        const bf16* ap = A + (size_t)(MT0 + 16 * rs + fr) * K + wave * kw + 8 * fq;
        const bf16* bp = Bt + (size_t)(64 * cs + fr) * K + wave * kw + 8 * fq;
        f32x4 acc[4];
#pragma unroll
        for (int t = 0; t < 4; ++t) acc[t] = (f32x4){0.f, 0.f, 0.f, 0.f};
#pragma unroll 4
        for (int k0 = 0; k0 < kw; k0 += 32) {
            const bf16x8 af = *(const bf16x8*)(ap + k0);
#pragma unroll
            for (int t = 0; t < 4; ++t) { const bf16x8 bf = *(const bf16x8*)(bp + (size_t)(16 * t) * K + k0); acc[t] = __builtin_amdgcn_mfma_f32_16x16x32_bf16(bf, af, acc[t], 0, 0, 0); }
        }
        __syncthreads();
#pragma unroll
        for (int t = 0; t < 4; ++t) *(LAS f32x4*)(lds + ((wave * 4 + t) * 64 + lane) * 16) = acc[t];
        __syncthreads();
        if (wave == 0) {
#pragma unroll
            for (int t = 0; t < 4; ++t) { f32x4 s = acc[t];
#pragma unroll
                for (int w = 1; w < 8; ++w) s += *(LAS f32x4*)(lds + ((w * 4 + t) * 64 + lane) * 16);
                acc[t] = s; }
            const int row = MT0 + 16 * rs + fr;
            float* rp = X + (size_t)row * D + 64 * cs + 4 * fq; bf16* xb = (bf16*)(ws + WS_XB) + (size_t)row * D + 64 * cs + 4 * fq;
            float ssq = 0.f;
#pragma unroll
            for (int t = 0; t < 4; ++t) { const f32x4 v = *(const f32x4*)(rp + 16 * t) + acc[t] * amul; *(f32x4*)(rp + 16 * t) = v;
                if (slot >= 0) { ssq += (v.x * v.x + v.y * v.y) + (v.z * v.z + v.w * v.w); v2u w; w.x = cvt_pk_bf16(v.x, v.y); w.y = cvt_pk_bf16(v.z, v.w); *(v2u*)(xb + 16 * t) = w; } }
            if (slot >= 0) { ssq += shfl_xor_l(ssq, 16, lane); ssq += shfl_xor_l(ssq, 32, lane); if (fq == 0) ((float*)(ws + WS_SS))[((size_t)slot * M + row) * 16 + cs] = ssq; }
        }
    }
}

__device__ __forceinline__ void tr_item(const float* __restrict__ W, int ldw, int k0, int n0, bf16* __restrict__ WT, int ldt, int drow, const float* __restrict__ mu, LAS float* scr, int lane, const float* __restrict__ gs = nullptr) {
#pragma unroll 8
    for (int i = 0; i < 32; ++i) { const int kk = 2 * i + (lane >> 5); scr[kk * 33 + (lane & 31)] = W[(size_t)(k0 + kk) * ldw + n0 + (lane & 31)]; }
    asm volatile("s_waitcnt lgkmcnt(0)" ::: "memory");
    const int c = lane & 7;
    float mv[8];
    if (mu) {
#pragma unroll
        for (int e = 0; e < 8; ++e) mv[e] = mu[k0 + 8 * c + e];
    } else if (gs) {
#pragma unroll
        for (int e = 0; e < 8; ++e) mv[e] = gs[k0 + 8 * c + e];
    }
#pragma unroll
    for (int j = 0; j < 4; ++j) {
        const int n = (lane >> 3) + 8 * j; const LAS float* s = scr + (8 * c) * 33 + n;
        float f[8];
#pragma unroll
        for (int e = 0; e < 8; ++e) f[e] = s[e * 33];
        bf16* dp = WT + (size_t)(drow + n) * ldt + k0 + 8 * c;
        if (mu) {
            float f1[8], f2[8];
#pragma unroll
            for (int e = 0; e < 8; ++e) { f1[e] = f[e] * (1.f - mv[e]); f2[e] = f[e] * mv[e]; }
            *(v4u*)dp = pack8(f1); *(v4u*)(dp + 1024) = pack8(f2);
        } else { if (gs) {
#pragma unroll
            for (int e = 0; e < 8; ++e) f[e] *= mv[e]; }
            *(v4u*)dp = pack8(f); }
    }
    asm volatile("s_waitcnt lgkmcnt(0)" ::: "memory");
}

__device__ __forceinline__ void ph_p0(const Params& p, LAS unsigned char* lds, int tid, int lane, int wave) {
    unsigned char* ws = p.ws;
    LAS float* scr = (LAS float*)(lds + wave * 16384);
    const int gw = blockIdx.x * NWAVES + wave, NGW = gridDim.x * NWAVES;
    constexpr int C_WIN = 2 * 16 * 192, C_WOUT = 2 * 32 * 32, C_RKV = 2 * 3 * 512, C_W1 = 2 * 32, C_A1 = 2 * 32, C_G1 = 2 * 80, C_V1 = 16, C_WO = 2 * 512, C_WUG = 4 * 16 * 176, C_WD = 4 * 44 * 32;
    constexpr int NITEMS = C_WIN + C_WOUT + C_RKV + C_W1 + C_A1 + C_G1 + C_V1 + C_WO + C_WUG + C_WD;
    for (int it = gw; it < NITEMS; it += NGW) {
        int r = it;
        if (r < C_WIN) { const int j = r / 3072, q = r % 3072, kb = q / 192, nb = q % 192;
            tr_item(p.in[I_RWIN] + (size_t)j * D * RWIN, RWIN, 64 * kb, 32 * nb, (bf16*)(ws + WS_WIN + j * SZ_WIN), D, 32 * nb, nullptr, scr, lane, p.in[I_NMIX] + (size_t)(2 * j) * D); continue; }
        r -= C_WIN;
        if (r < C_WOUT) { const int j = r / 1024, q = r % 1024, kb = q / 32, nb = q % 32;
            tr_item(p.in[I_RWOUT] + (size_t)j * RV * D, D, 64 * kb, 32 * nb, (bf16*)(ws + WS_WOUT + j * SZ_WOUT), RV, 32 * nb, nullptr, scr, lane); continue; }
        r -= C_WOUT;
        if (r < C_RKV) { const int j = r / 1536, q = r % 1536, s = q / 512, q2 = q % 512, kb = q2 / 32, nb = q2 % 32, c = (s == 0 ? 0 : (s == 1 ? 2 : 3));
            tr_item(p.in[I_WRKV] + (size_t)(j * 3 + s) * D * D, D, 64 * kb, 32 * nb, (bf16*)(ws + WS_WRW + j * SZ_WRW), KRW, s * 1024 + 32 * nb, p.in[I_MU] + (size_t)(j * 6 + c) * D, scr, lane); continue; }
        r -= C_RKV;
        if (r < C_W1) { const int j = r / 32, q = r % 32, kb = q / 2, nb = q % 2;
            tr_item(p.in[I_W1] + (size_t)j * D * LW, LW, 64 * kb, 32 * nb, (bf16*)(ws + WS_WRW + j * SZ_WRW), KRW, 3072 + 32 * nb, p.in[I_MU] + (size_t)(j * 6 + 1) * D, scr, lane); continue; }
        r -= C_W1;
        if (r < C_A1) { const int j = r / 32, q = r % 32, kb = q / 2, nb = q % 2;
            tr_item(p.in[I_A1] + (size_t)j * D * LA, LA, 64 * kb, 32 * nb, (bf16*)(ws + WS_WRW + j * SZ_WRW), KRW, 3136 + 32 * nb, p.in[I_MU] + (size_t)(j * 6 + 4) * D, scr, lane); continue; }
        r -= C_A1;
        if (r < C_G1) { const int j = r / 80, q = r % 80, kb = q / 5, nb = q % 5;
            tr_item(p.in[I_G1] + (size_t)j * D * LG, LG, 64 * kb, 32 * nb, (bf16*)(ws + WS_WRW + j * SZ_WRW), KRW, 3200 + 32 * nb, p.in[I_MU] + (size_t)(j * 6 + 5) * D, scr, lane); continue; }
        r -= C_G1;
        if (r < C_V1) { const int kb = r;
            tr_item(p.in[I_V1], LV, 64 * kb, 0, (bf16*)(ws + WS_WRW + 1 * SZ_WRW), KRW, 3360, p.in[I_MU] + (size_t)(1 * 6 + 3) * D, scr, lane); continue; }
        r -= C_V1;
        if (r < C_WO) { const int j = r / 512, q = r % 512, kb = q / 32, nb = q % 32;
            tr_item(p.in[I_WO] + (size_t)j * D * D, D, 64 * kb, 32 * nb, (bf16*)(ws + WS_WO + j * SZ_WO), D, 32 * nb, nullptr, scr, lane); continue; }
        r -= C_WO;
        if (r < C_WUG) { const int i = r / 2816, q = r % 2816, kb = q / 176, nb = q % 176, n0 = 32 * nb;
            const int drow = n0 < DFF ? 256 * (n0 / 128) + (n0 % 128) : 256 * ((n0 - DFF) / 128) + 128 + ((n0 - DFF) % 128);
            tr_item(p.in[I_WUG] + (size_t)i * D * 2 * DFF, 2 * DFF, 64 * kb, n0, (bf16*)(ws + WS_WUG + i * SZ_WUG), D, drow, nullptr, scr, lane, p.in[I_NFFN] + (size_t)i * D); continue; }
        r -= C_WUG;
        { const int i = r / 1408, q = r % 1408, kb = q / 32, nb = q % 32;
            tr_item(p.in[I_WD] + (size_t)i * DFF * D, D, 64 * kb, 32 * nb, (bf16*)(ws + WS_WD + i * SZ_WD), DFF, 32 * nb, nullptr, scr, lane); }
    }
    const size_t gt = (size_t)blockIdx.x * NTHR + tid, GT = (size_t)gridDim.x * NTHR;
    for (size_t i = gt; i < (size_t)(224 + 192) * (KRW / 8); i += GT) {
        const int rr = (int)(i / (KRW / 8)), c8 = (int)(i % (KRW / 8));
        const int j = rr < 224 ? 0 : 1, row = rr < 224 ? 3360 + rr : 3392 + (rr - 224);
        *(v4u*)((bf16*)(ws + WS_WRW + j * SZ_WRW) + (size_t)row * KRW + c8 * 8) = (v4u){0u, 0u, 0u, 0u};
    }
    for (size_t i = gt; i < (size_t)2 * NL2 * KL2; i += GT) {
        const int j = (int)(i / ((size_t)NL2 * KL2)); const int rem = (int)(i % ((size_t)NL2 * KL2)); const int n = rem / KL2, k = rem % KL2, grp = n >> 10, nn = n & 1023;
        float v = 0.f;
        if (grp == 0) { if (k < 64) v = p.in[I_W2][((size_t)j * LW + k) * D + nn]; }
        else if (grp == 1) { if (k >= 64 && k < 128) v = p.in[I_A2][((size_t)j * LA + (k - 64)) * D + nn]; }
        else if (grp == 2) { if (k >= 128 && k < 288) v = p.in[I_G2][((size_t)j * LG + (k - 128)) * D + nn]; }
        else { if (j == 1 && k >= 288 && k < 320) v = p.in[I_V2][((size_t)(k - 288)) * D + nn]; }
        ((bf16*)(ws + WS_WL2 + j * SZ_WL2))[(size_t)n * KL2 + k] = (bf16)(cvt_pk_bf16(v, 0.f) & 0xffffu);
    }
    for (size_t i = gt; i < (size_t)(TP + 1) * 128; i += GT) {
        const int pi = (int)(i >> 7), mi = (int)(i & 127);
        const float pos = pi < TP ? (float)pi : PAST_POS;
        const float inv = 1.0f / powf(10000.0f, (float)mi / 127.0f);
        float s, c; sincosf(pos * inv, &s, &c);
        ((float2*)(ws + WS_CS))[i] = make_float2(c, s);
    }
    float* X = (float*)(ws + WS_X); bf16* XB = (bf16*)(ws + WS_XB);
    for (int r = gw; r < M; r += NGW) {
        const float* src;
        if (r < MP) { const int b = r / TP, t = r % TP; src = t < NMETA ? p.in[I_META] + (size_t)t * D : p.in[I_XP] + ((size_t)b * SEQ + (t - NMETA)) * D; }
        else src = p.in[I_XS] + (size_t)(r - MP) * D;
        float ss = 0.f;
#pragma unroll
        for (int j = 0; j < 2; ++j) { const int c0 = 512 * j + 8 * lane;
            const f32x4 a4 = *(const f32x4*)(src + c0), b4 = *(const f32x4*)(src + c0 + 4);
            *(f32x4*)(X + (size_t)r * D + c0) = a4; *(f32x4*)(X + (size_t)r * D + c0 + 4) = b4;
            const float f[8] = {a4.x, a4.y, a4.z, a4.w, b4.x, b4.y, b4.z, b4.w};
#pragma unroll
            for (int e = 0; e < 8; ++e) ss += f[e] * f[e];
            *(v4u*)(XB + (size_t)r * D + c0) = pack8(f); }
        ss = wave_sum(ss, lane);
        if (lane < 16) ((float*)(ws + WS_SS))[(size_t)r * 16 + lane] = lane == 0 ? ss : 0.f;
    }
}

__device__ __forceinline__ void ph_norm(const Params& p, const float* __restrict__ g, int mode, int jl, int lane, int wave) {
    const float* X = (const float*)(p.ws + WS_X); bf16* H = (bf16*)(p.ws + WS_H);
    const int gw = blockIdx.x * NWAVES + wave, NGW = gridDim.x * NWAVES;
    for (int row = gw; row < M; row += NGW) {
        const float* xr = X + (size_t)row * D;
        float v[2][8]; float ss = 0.f;
#pragma unroll
        for (int j = 0; j < 2; ++j) {
            const f32x4 a = *(const f32x4*)(xr + 512 * j + 8 * lane), b = *(const f32x4*)(xr + 512 * j + 8 * lane + 4);
            v[j][0] = a.x; v[j][1] = a.y; v[j][2] = a.z; v[j][3] = a.w; v[j][4] = b.x; v[j][5] = b.y; v[j][6] = b.z; v[j][7] = b.w;
#pragma unroll
            for (int e = 0; e < 8; ++e) ss += v[j][e] * v[j][e];
        }
        ss = wave_sum(ss, lane);
        const float rstd = rsqrtf(ss * (1.f / D) + 1e-6f);
        const bool prompt = row < MP; const int b = prompt ? row / TP : 0, t = prompt ? row % TP : 0;
#pragma unroll
        for (int j = 0; j < 2; ++j) {
            const int c0 = 512 * j + 8 * lane;
            const f32x4 ga = *(const f32x4*)(g + c0), gb = *(const f32x4*)(g + c0 + 4);
            float o[8];
            o[0] = v[j][0] * rstd * ga.x; o[1] = v[j][1] * rstd * ga.y; o[2] = v[j][2] * rstd * ga.z; o[3] = v[j][3] * rstd * ga.w;
            o[4] = v[j][4] * rstd * gb.x; o[5] = v[j][5] * rstd * gb.y; o[6] = v[j][6] * rstd * gb.z; o[7] = v[j][7] * rstd * gb.w;
            if (mode == 0) { *(v4u*)(H + (size_t)row * D + c0) = pack8(o); }
            else if (mode == 1) {
                const v4u w = pack8(o);
                *(v4u*)(H + (size_t)row * 2048 + c0) = w;
                if (prompt) {
                    if (t != TP - 1) *(v4u*)(H + (size_t)(row + 1) * 2048 + 1024 + c0) = w;
                    else { float* so = p.out + O_SHP + ((size_t)jl * BATCH + b) * D + c0; *(f32x4*)so = (f32x4){o[0], o[1], o[2], o[3]}; *(f32x4*)(so + 4) = (f32x4){o[4], o[5], o[6], o[7]}; }
                    if (t == 0) *(v4u*)(H + (size_t)row * 2048 + 1024 + c0) = (v4u){0u, 0u, 0u, 0u};
                } else {
                    const int s = row - MP;
                    const float* sp = p.in[I_SSHIFT] + ((size_t)jl * SB + s) * D + c0;
                    const f32x4 sa = *(const f32x4*)sp, sb2 = *(const f32x4*)(sp + 4);
                    const float pv[8] = {sa.x, sa.y, sa.z, sa.w, sb2.x, sb2.y, sb2.z, sb2.w};
                    *(v4u*)(H + (size_t)row * 2048 + 1024 + c0) = pack8(pv);
                    float* so = p.out + O_SHS + ((size_t)jl * SB + s) * D + c0; *(f32x4*)so = (f32x4){o[0], o[1], o[2], o[3]}; *(f32x4*)(so + 4) = (f32x4){o[4], o[5], o[6], o[7]};
                }
            } else {
                float* dst = nullptr;
                if (prompt) { if (t >= NMETA) dst = p.out + O_YP + ((size_t)b * SEQ + (t - NMETA)) * D + c0; }
                else dst = p.out + O_YS + (size_t)(row - MP) * D + c0;
                if (dst) { *(f32x4*)dst = (f32x4){o[0], o[1], o[2], o[3]}; *(f32x4*)(dst + 4) = (f32x4){o[4], o[5], o[6], o[7]}; }
            }
        }
    }
}

__device__ __forceinline__ void ph_ret_norm(const Params& p, int jl, int lane, int wave) {
    const float* O = (const float*)(p.ws + WS_O); const bf16* SG = (const bf16*)(p.ws + WS_SG); bf16* Y = (bf16*)(p.ws + WS_Y);
    const float* gnw = p.in[I_RGN] + (size_t)jl * RV;
    const int gw = blockIdx.x * NWAVES + wave, NGW = gridDim.x * NWAVES;
    for (int it = gw; it < M * RH; it += NGW) {
        const int row = it >> 2, h = it & 3; const size_t off = (size_t)row * RV + h * RDV + 8 * lane;
        const f32x4 a = *(const f32x4*)(O + off), b = *(const f32x4*)(O + off + 4);
        float v[8] = {a.x, a.y, a.z, a.w, b.x, b.y, b.z, b.w};
        float s = 0.f;
#pragma unroll
        for (int e = 0; e < 8; ++e) s += v[e];
        const float mean = wave_sum(s, lane) * (1.f / RDV);
        float s2 = 0.f;
#pragma unroll
        for (int e = 0; e < 8; ++e) { v[e] -= mean; s2 += v[e] * v[e]; }
        const float rstd = rsqrtf(wave_sum(s2, lane) * (1.f / RDV) + 1e-5f);
        float sg[8]; unpack8(*(const v4u*)(SG + off), sg);
        const f32x4 ga = *(const f32x4*)(gnw + h * RDV + 8 * lane), gb = *(const f32x4*)(gnw + h * RDV + 8 * lane + 4);
        const float gg[8] = {ga.x, ga.y, ga.z, ga.w, gb.x, gb.y, gb.z, gb.w};
        float o[8];
#pragma unroll
        for (int e = 0; e < 8; ++e) o[e] = v[e] * rstd * gg[e] * sg[e];
        *(v4u*)(Y + off) = pack8(o);
    }
}

__device__ __forceinline__ float row16_sum(float x);
__device__ __forceinline__ void ph_rwkv_post(const Params& p, int jl, int lane, int wave) {
    const float* YW = (const float*)(p.ws + WS_YW); const bf16* R = (const bf16*)(p.ws + WS_R); const bf16* KM = (const bf16*)(p.ws + WS_NKK);
    const bf16* VP = (const bf16*)(p.ws + WS_KKA); const bf16* L2 = (const bf16*)(p.ws + WS_L2); bf16* Z = (bf16*)(p.ws + WS_Z);
    const float* rk = p.in[I_RK] + (size_t)jl * D; const float* lnw = p.in[I_LNW] + (size_t)jl * D; const float* lnb = p.in[I_LNB] + (size_t)jl * D;
    const int gw = blockIdx.x * NWAVES + wave, NGW = gridDim.x * NWAVES;
    const int sub = lane >> 4, c4 = lane & 15;
    for (int it0 = gw * 4; it0 < M * WH; it0 += NGW * 4) {
        const int it = it0 + sub, row = it >> 4, h = it & 15, c = h * WN + 4 * c4;
        const size_t idx = (size_t)row * D + c;
        const f32x4 yv = *(const f32x4*)(YW + idx), r4 = ld_bf4(R + idx), k4 = ld_bf4(KM + idx), v4 = ld_bf4(VP + idx), g4 = ld_bf4(L2 + (size_t)row * NL2 + 2048 + c);
        const f32x4 rk4 = *(const f32x4*)(rk + c), lw4 = *(const f32x4*)(lnw + c), lb4 = *(const f32x4*)(lnb + c);
        const float mean = row16_sum((yv.x + yv.y) + (yv.z + yv.w)) * (1.f / WN);
        const f32x4 yc = yv - mean;
        const float rstd = rsqrtf(row16_sum((yc.x * yc.x + yc.y * yc.y) + (yc.z * yc.z + yc.w * yc.w)) * (1.f / WN) + 64e-5f);
        const f32x4 rkk = r4 * k4 * rk4;
        const float bon = row16_sum((rkk.x + rkk.y) + (rkk.z + rkk.w));
        const f32x4 z = (yc * rstd * lw4 + lb4 + v4 * bon) * g4;
        st_bf4(Z + idx, z);
    }
}

constexpr int RT_KP = 528, RT_VP = 144, RT_SP = 528;
constexpr int RT_K_OFF = 0, RT_V_OFF = 128 * RT_KP, RT_ST_OFF = RT_V_OFF + 128 * RT_VP, RT_END = RT_ST_OFF + 64 * RT_SP;
static_assert(RT_END <= LDS_BYTES, "retention LDS map");
typedef short v4s __attribute__((ext_vector_type(4)));
__device__ __forceinline__ bf16x8 tr_pair(LAS unsigned char* a0, LAS unsigned char* a1) {
    const v4s lo = __builtin_amdgcn_ds_read_tr16_b64_v4i16((LAS v4s*)a0), hi = __builtin_amdgcn_ds_read_tr16_b64_v4i16((LAS v4s*)a1);
    return __builtin_shufflevector(lo, hi, 0, 1, 2, 3, 4, 5, 6, 7);
}
__device__ __forceinline__ void ph_ret_fast(const Params& p, int jl, LAS unsigned char* lds, int tid, int lane, int wave) {
    const bf16* QK = (const bf16*)(p.ws + WS_QK); const bf16* V = (const bf16*)(p.ws + WS_V); float* O = (float*)(p.ws + WS_O);
    const int fr = lane & 15, fq = lane >> 4, li_q = (lane & 15) >> 2, li_p = lane & 3;
    for (int u = blockIdx.x; u < BATCH * RH * 8; u += gridDim.x) {
        const int es = u & 7, h = (u >> 3) & 3, b = u >> 5;
        const float gamma = 1.0f - exp2f(-5.0f - (float)h), lg = log2f(gamma), g128 = exp2f(128.f * lg), g127 = exp2f(127.f * lg);
        const int i0 = 16 * wave, d0 = 32 * wave;
        f32x4 Sacc[2][4];
#pragma unroll
        for (int a = 0; a < 2; ++a)
#pragma unroll
            for (int c = 0; c < 4; ++c) Sacc[a][c] = (f32x4){0.f, 0.f, 0.f, 0.f};
        __syncthreads();
        for (int i = tid; i < 64 * RT_SP / 16; i += NTHR) *(LAS v4u*)(lds + RT_ST_OFF + i * 16) = (v4u){0u, 0u, 0u, 0u};
        v4u kst[8], vst[2];
        const bf16* Kg = QK + 1024 + 256 * h; const bf16* Vg = V + 512 * h + 64 * es; const bf16* Qg = QK + 256 * h;
#define RT_LOAD_STAGE(cc) do { \
            _Pragma("unroll") for (int k_ = 0; k_ < 8; ++k_) { const int id_ = tid + 512 * k_, row_ = id_ >> 5, ch_ = id_ & 31, t_ = 128 * (cc) - 112 + row_; \
                kst[k_] = t_ >= 0 ? *(const v4u*)(Kg + (size_t)(b * TP + t_) * 2048 + 8 * ch_) : (v4u){0u, 0u, 0u, 0u}; } \
            _Pragma("unroll") for (int k_ = 0; k_ < 2; ++k_) { const int id_ = tid + 512 * k_, row_ = id_ >> 3, ch_ = id_ & 7, t_ = 128 * (cc) - 112 + row_; \
                vst[k_] = t_ >= 0 ? *(const v4u*)(Vg + (size_t)(b * TP + t_) * 2048 + 8 * ch_) : (v4u){0u, 0u, 0u, 0u}; } } while (0)
        RT_LOAD_STAGE(0);
        for (int c = 0; c < 17; ++c) {
            __syncthreads();
#pragma unroll
            for (int k_ = 0; k_ < 8; ++k_) { const int id_ = tid + 512 * k_, row_ = id_ >> 5, ch_ = id_ & 31; *(LAS v4u*)(lds + RT_K_OFF + row_ * RT_KP + ch_ * 16) = kst[k_]; }
#pragma unroll
            for (int k_ = 0; k_ < 2; ++k_) { const int id_ = tid + 512 * k_, row_ = id_ >> 3, ch_ = id_ & 7;
                float f[8]; unpack8(vst[k_], f); const float sc = exp2f(-(float)row_ * lg);
#pragma unroll
                for (int e = 0; e < 8; ++e) f[e] *= sc;
                *(LAS v4u*)(lds + RT_V_OFF + row_ * RT_VP + ch_ * 16) = pack8(f); }
            bf16x8 Qf[8];
            { const int t_ = 128 * c - 112 + i0 + fr;
#pragma unroll
              for (int s = 0; s < 8; ++s) Qf[s] = t_ >= 0 ? *(const bf16x8*)(Qg + (size_t)(b * TP + t_) * 2048 + 32 * s + 8 * fq) : (bf16x8){0, 0, 0, 0, 0, 0, 0, 0}; }
            __syncthreads();
            bf16x8 Pf[4];
            { const int ii = i0 + fr; const float gi = exp2f((float)ii * lg);
#pragma unroll
              for (int s2 = 0; s2 < 4; ++s2) { f32x4 Dp[2];
#pragma unroll
                  for (int hh = 0; hh < 2; ++hh) { Dp[hh] = (f32x4){0.f, 0.f, 0.f, 0.f};
#pragma unroll
                      for (int s = 0; s < 8; ++s) { const bf16x8 Kf = *(const LAS bf16x8*)(lds + RT_K_OFF + (16 * (2 * s2 + hh) + fr) * RT_KP + (32 * s + 8 * fq) * 2);
                          Dp[hh] = __builtin_amdgcn_mfma_f32_16x16x32_bf16(Kf, Qf[s], Dp[hh], 0, 0, 0); } }
                  float f[8];
#pragma unroll
                  for (int hh = 0; hh < 2; ++hh)
#pragma unroll
                      for (int r = 0; r < 4; ++r) { const int jj = 16 * (2 * s2 + hh) + 4 * fq + r; f[hh * 4 + r] = ii >= jj ? Dp[hh][r] * gi : 0.f; }
                  const v4u w = pack8(f); Pf[s2] = __builtin_bit_cast(bf16x8, w); } }
            f32x4 Oacc[4];
#pragma unroll
            for (int et = 0; et < 4; ++et) { Oacc[et] = (f32x4){0.f, 0.f, 0.f, 0.f};
#pragma unroll
                for (int s = 0; s < 8; ++s) { const bf16x8 Sf = *(const LAS bf16x8*)(lds + RT_ST_OFF + (16 * et + fr) * RT_SP + (32 * s + 8 * fq) * 2);
                    Oacc[et] = __builtin_amdgcn_mfma_f32_16x16x32_bf16(Qf[s], Sf, Oacc[et], 0, 0, 0); } }
            __syncthreads();
            if (c + 1 < 17) RT_LOAD_STAGE(c + 1);
#pragma unroll
            for (int r = 0; r < 4; ++r) { const float lam = exp2f((float)(i0 + 4 * fq + r + 1) * lg);
#pragma unroll
                for (int et = 0; et < 4; ++et) Oacc[et][r] *= lam; }
#pragma unroll
            for (int et = 0; et < 4; ++et)
#pragma unroll
                for (int s = 0; s < 4; ++s) {
                    LAS unsigned char* a0 = lds + RT_V_OFF + (32 * s + 4 * fq + li_q) * RT_VP + (16 * et + 4 * li_p) * 2;
                    const bf16x8 Vf = tr_pair(a0, a0 + 16 * RT_VP);
                    Oacc[et] = __builtin_amdgcn_mfma_f32_16x16x32_bf16(Pf[s], Vf, Oacc[et], 0, 0, 0); }
#pragma unroll
            for (int r = 0; r < 4; ++r) { const int t_ = 128 * c - 112 + i0 + 4 * fq + r;
                if (t_ >= 0) { float* op = O + (size_t)(b * TP + t_) * RV + 512 * h + 64 * es + fr;
#pragma unroll
                    for (int et = 0; et < 4; ++et) op[16 * et] = Oacc[et][r]; } }
#pragma unroll
            for (int dt = 0; dt < 2; ++dt)
#pragma unroll
                for (int et = 0; et < 4; ++et) Sacc[dt][et] = Sacc[dt][et] * (g128 / g127);
#pragma unroll
            for (int s = 0; s < 4; ++s) {
                bf16x8 Kt[2], Vt[4];
#pragma unroll
                for (int dt = 0; dt < 2; ++dt) { LAS unsigned char* a0 = lds + RT_K_OFF + (32 * s + 8 * fq + li_q) * RT_KP + (d0 + 16 * dt + 4 * li_p) * 2; Kt[dt] = tr_pair(a0, a0 + 4 * RT_KP); }
#pragma unroll
                for (int et = 0; et < 4; ++et) { LAS unsigned char* a0 = lds + RT_V_OFF + (32 * s + 8 * fq + li_q) * RT_VP + (16 * et + 4 * li_p) * 2; Vt[et] = tr_pair(a0, a0 + 4 * RT_VP); }
#pragma unroll
                for (int dt = 0; dt < 2; ++dt)
#pragma unroll
                    for (int et = 0; et < 4; ++et) Sacc[dt][et] = __builtin_amdgcn_mfma_f32_16x16x32_bf16(Kt[dt], Vt[et], Sacc[dt][et], 0, 0, 0);
            }
#pragma unroll
            for (int dt = 0; dt < 2; ++dt)
#pragma unroll
                for (int et = 0; et < 4; ++et) Sacc[dt][et] = Sacc[dt][et] * g127;
#pragma unroll
            for (int dt = 0; dt < 2; ++dt)
#pragma unroll
                for (int et = 0; et < 4; ++et) { v2u w; w.x = cvt_pk_bf16(Sacc[dt][et][0], Sacc[dt][et][1]); w.y = cvt_pk_bf16(Sacc[dt][et][2], Sacc[dt][et][3]);
                    *(LAS v2u*)(lds + RT_ST_OFF + (16 * et + fr) * RT_SP + (d0 + 16 * dt + 4 * fq) * 2) = w; }
        }
#undef RT_LOAD_STAGE
        float* so = p.out + O_RETP + ((((size_t)jl * BATCH + b) * RH + h) * RDK) * RDV + 64 * es;
#pragma unroll
        for (int dt = 0; dt < 2; ++dt)
#pragma unroll
            for (int et = 0; et < 4; ++et)
#pragma unroll
                for (int r = 0; r < 4; ++r) so[(size_t)(d0 + 16 * dt + 4 * fq + r) * RDV + 16 * et + fr] = Sacc[dt][et][r];
    }
    {
        LAS float* sq = (LAS float*)lds; LAS float* sk = sq + 256; LAS float* red = sk + 256;
        const int e4 = tid & 127, dq = tid >> 7;
        for (int it = blockIdx.x; it < SB * RH; it += gridDim.x) {
            const int h = it & 3, s = it >> 2, row = MP + s;
            const float gamma = 1.0f - exp2f(-5.0f - (float)h);
            __syncthreads();
            if (tid < 256) sq[tid] = bf_lo((unsigned)QK[(size_t)row * 2048 + 256 * h + tid]);
            else sk[tid - 256] = bf_lo((unsigned)QK[(size_t)row * 2048 + 1024 + 256 * h + (tid - 256)]);
            const v2u vv = *(const v2u*)(V + (size_t)row * 2048 + 512 * h + 4 * e4);
            const f32x4 v4 = (f32x4){bf_lo(vv.x), bf_hi(vv.x), bf_lo(vv.y), bf_hi(vv.y)};
            __syncthreads();
            const float* sin_ = p.in[I_SRET] + ((((size_t)jl * SB + s) * RH + h) * RDK) * RDV + 4 * e4;
            float* sout = p.out + O_RETS + ((((size_t)jl * SB + s) * RH + h) * RDK) * RDV + 4 * e4;
            f32x4 oacc = (f32x4){0.f, 0.f, 0.f, 0.f};
#pragma unroll 8
            for (int k = 0; k < 64; ++k) { const int d = dq + 4 * k;
                const f32x4 sv = __builtin_nontemporal_load((const f32x4*)(sin_ + (size_t)d * RDV));
                const f32x4 sn = sv * gamma + v4 * sk[d];
                oacc += sn * sq[d];
                __builtin_nontemporal_store(sn, (f32x4*)(sout + (size_t)d * RDV)); }
            *(LAS f32x4*)(red + dq * 512 + 4 * e4) = oacc;
            __syncthreads();
            if (dq == 0) { const f32x4 r = (*(LAS f32x4*)(red + 4 * e4) + *(LAS f32x4*)(red + 512 + 4 * e4)) + (*(LAS f32x4*)(red + 1024 + 4 * e4) + *(LAS f32x4*)(red + 1536 + 4 * e4));
                *(f32x4*)(O + (size_t)row * RV + 512 * h + 4 * e4) = r; }
        }
    }
}

typedef float f32x2w __attribute__((ext_vector_type(2)));
constexpr int WK_TB = 32, WK_STEP_B = 6 * 256 + 16, WK_BUF_B = WK_TB * WK_STEP_B, WK_Y_OFF = 2 * WK_BUF_B, WK_YB_B = WK_TB * 32 * 4;
static_assert(WK_Y_OFF + 2 * WK_YB_B <= LDS_BYTES - 16, "wkv LDS map");
__device__ __forceinline__ float row16_sum(float x) {
    x += __builtin_bit_cast(float, __builtin_amdgcn_update_dpp(0, __builtin_bit_cast(int, x), 0x128, 0xf, 0xf, false));
    x += __builtin_bit_cast(float, __builtin_amdgcn_update_dpp(0, __builtin_bit_cast(int, x), 0x124, 0xf, 0xf, false));
    x += __builtin_bit_cast(float, __builtin_amdgcn_update_dpp(0, __builtin_bit_cast(int, x), 0x122, 0xf, 0xf, false));
    x += __builtin_bit_cast(float, __builtin_amdgcn_update_dpp(0, __builtin_bit_cast(int, x), 0x121, 0xf, 0xf, false));
    return x;
}
__device__ __forceinline__ float half8_sum(float x) {
    x += __builtin_bit_cast(float, __builtin_amdgcn_update_dpp(0, __builtin_bit_cast(int, x), 0x141, 0xf, 0xf, false));
    x += __builtin_bit_cast(float, __builtin_amdgcn_update_dpp(0, __builtin_bit_cast(int, x), 0xB1, 0xf, 0xf, false));
    x += __builtin_bit_cast(float, __builtin_amdgcn_update_dpp(0, __builtin_bit_cast(int, x), 0x4E, 0xf, 0xf, false));
    return x;
}
struct WkPar { f32x4 w0, a0, kkp, kap, v0; };
__device__ __forceinline__ f32x4 wk_unit_neg(const f32x4 kraw, const f32x4 kkp) {
    const f32x4 kk = kraw * kkp;
    const float ss = row16_sum((kk.x * kk.x + kk.y * kk.y) + (kk.z * kk.z + kk.w * kk.w));
    return kk * (-rsqrtf(fmaxf(ss, 1e-12f)));
}
__device__ __forceinline__ float wk_decay(float x) { return __expf(-0.60653065971263342f * sigmoidf_(x)); }
__device__ __forceinline__ void wk_prep(const WkPar& P, const f32x4 kraw, const f32x4 vraw, const f32x4 lw2, const f32x4 la2, const f32x4 vf, const f32x4 lv2, bool vres,
                                        f32x4& w, f32x4& ka, f32x4& km, f32x4& vp, f32x4& nk) {
    nk = wk_unit_neg(kraw, P.kkp);
    w = (f32x4){wk_decay(P.w0.x + lw2.x), wk_decay(P.w0.y + lw2.y), wk_decay(P.w0.z + lw2.z), wk_decay(P.w0.w + lw2.w)};
    const f32x4 a = (f32x4){sigmoidf_(P.a0.x + la2.x), sigmoidf_(P.a0.y + la2.y), sigmoidf_(P.a0.z + la2.z), sigmoidf_(P.a0.w + la2.w)};
    ka = nk * (-a);
    km = kraw * ((a - 1.f) * P.kap + 1.f);
    vp = vraw;
    if (vres) { const f32x4 sg = (f32x4){sigmoidf_(P.v0.x + lv2.x), sigmoidf_(P.v0.y + lv2.y), sigmoidf_(P.v0.z + lv2.z), sigmoidf_(P.v0.w + lv2.w)}; vp = vraw + (vf - vraw) * sg; }
}
constexpr int WC_C = 16, WC_NCH = TP / WC_C;
static_assert(WC_NCH * WC_C == TP, "chunking");
constexpr int REC_WA = 0, REC_RP = 2048, REC_BK = 4096, REC_VV = 8192, REC_TK = 10240, REC_MY = 10752, REC_GC = 11264, REC_BYTES = 11520;
constexpr size_t WS_REC = WS_END;
constexpr size_t WS_END2 = WS_REC + (size_t)BATCH * WH * WC_NCH * REC_BYTES;
__device__ __forceinline__ unsigned bf_rne_c(float f) { unsigned u = __float_as_uint(f); return (u + 0x7fffu + ((u >> 16) & 1u)) >> 16; }
__device__ __forceinline__ unsigned pk2_c(float lo, float hi) { return bf_rne_c(lo) | (bf_rne_c(hi) << 16); }
__device__ __forceinline__ float bf_rd(const bf16* q) { return __uint_as_float((unsigned)(*q) << 16); }
__device__ __forceinline__ bf16 bf_of(float x) { return (bf16)(cvt_pk_bf16(x, 0.f) & 0xffffu); }

typedef __bf16 bf4v __attribute__((ext_vector_type(4)));
__device__ __forceinline__ v2u pk4(const f32x4 v) { return __builtin_bit_cast(v2u, __builtin_convertvector(v, bf4v)); }
__device__ __forceinline__ f32x4 mm16(const v2u a, const v2u b, const f32x4 c) { return __builtin_amdgcn_mfma_f32_16x16x16bf16_1k(__builtin_bit_cast(v4s, a), __builtin_bit_cast(v4s, b), c, 0, 0, 0); }
__device__ __forceinline__ f32x4 mm32(const v2u a0, const v2u a1, const v2u b0, const v2u b1, const f32x4 c) {
    const v4u a = (v4u){a0.x, a0.y, a1.x, a1.y}, b = (v4u){b0.x, b0.y, b1.x, b1.y};
    return __builtin_amdgcn_mfma_f32_16x16x32_bf16(__builtin_bit_cast(bf16x8, a), __builtin_bit_cast(bf16x8, b), c, 0, 0, 0);
}
template <int CTRL> __device__ __forceinline__ float dppz(float x) { return __int_as_float(__builtin_amdgcn_update_dpp(0, __float_as_int(x), CTRL, 0xf, 0xf, true)); }
__device__ __forceinline__ float psum16(float x) { x += dppz<0x111>(x); x += dppz<0x112>(x); x += dppz<0x114>(x); x += dppz<0x118>(x); return x; }
__device__ __forceinline__ v2u tr16(LAS unsigned char* a) { return __builtin_bit_cast(v2u, __builtin_amdgcn_ds_read_tr16_b64_v4i16((LAS v4s*)a)); }
__device__ __forceinline__ void ph_wkv1(const Params& p, int jl, LAS unsigned char* lds, int lane_in, int wave) {
    const bf16* Kr = (const bf16*)(p.ws + WS_K); const bf16* Vr = (const bf16*)(p.ws + (jl == 0 ? WS_VF : WS_VB)); const bf16* VFp = (const bf16*)(p.ws + WS_VF);
    const bf16* Rr = (const bf16*)(p.ws + WS_R); const bf16* L2 = (const bf16*)(p.ws + WS_L2);
    bf16* KM = (bf16*)(p.ws + WS_NKK); bf16* VP = (bf16*)(p.ws + WS_KKA);
    const bool vres = jl == 1;
    constexpr int IMG = 16 * 144;
    constexpr float CL2 = 0.60653065971263342f * 1.4426950408889634f;
    const int gw = wave * gridDim.x + blockIdx.x, NGW = gridDim.x * NWAVES;
    for (int job = gw; job < BATCH * WH * WC_NCH; job += NGW) {
        int ln = lane_in; asm volatile("" : "+v"(ln));
        const int lane = ln, fr = lane & 15, fq = lane >> 4;
        const int c = job % WC_NCH, sh = job / WC_NCH, h = sh & 15, seq = sh >> 4, r0 = seq * TP + WC_C * c, chb = h * WN + 4 * fq;
        LAS unsigned char* sc = lds + wave * 16384;
        unsigned char* rec = p.ws + WS_REC + (size_t)job * REC_BYTES;
        const size_t ro = (size_t)(r0 + fr) * D + chb, lo = (size_t)(r0 + fr) * NL2 + chb, po = (size_t)jl * D + chb;
        f32x4 kraw[4], kk[4];
        float ss = 0.f;
#pragma unroll
        for (int jt = 0; jt < 4; ++jt) { kraw[jt] = ld_bf4(Kr + ro + 16 * jt); kk[jt] = kraw[jt] * *(const f32x4*)(p.in[I_KK] + po + 16 * jt);
            ss += (kk[jt].x * kk[jt].x + kk[jt].y * kk[jt].y) + (kk[jt].z * kk[jt].z + kk[jt].w * kk[jt].w); }
        ss += shfl_xor_l(ss, 16, lane); ss += shfl_xor_l(ss, 32, lane);
        const float inv = rsqrtf(fmaxf(ss, 1e-12f));
        v2u pa[4], pb[4], pk[4], pr[4]; f32x4 rt[4];
        LAS unsigned char* iw = sc + fr * 144 + 8 * fq;
#pragma unroll
        for (int jt = 0; jt < 4; ++jt) {
            const f32x4 lw2 = ld_bf4(L2 + lo + 16 * jt), la2 = ld_bf4(L2 + lo + 1024 + 16 * jt), rr = ld_bf4(Rr + ro + 16 * jt), vraw = ld_bf4(Vr + ro + 16 * jt);
            const f32x4 pw0 = *(const f32x4*)(p.in[I_W0] + po + 16 * jt), pa0 = *(const f32x4*)(p.in[I_A0] + po + 16 * jt), pka = *(const f32x4*)(p.in[I_KA] + po + 16 * jt);
            f32x4 vp = vraw;
            if (vres) { const f32x4 vf = ld_bf4(VFp + ro + 16 * jt), lv2 = ld_bf4(L2 + lo + 3072 + 16 * jt), pv0 = *(const f32x4*)(p.in[I_V0] + chb + 16 * jt);
#pragma unroll
                for (int e = 0; e < 4; ++e) vp[e] = vraw[e] + (vf[e] - vraw[e]) * sigmoidf_(pv0[e] + lv2[e]); }
            f32x4 at, bt, kt, kq, rq, gg;
#pragma unroll
            for (int e = 0; e < 4; ++e) {
                const float a = sigmoidf_(pa0[e] + la2[e]), d = CL2 * sigmoidf_(pw0[e] + lw2[e]), cum = psum16(d);
                const float g = __builtin_amdgcn_exp2f(-cum), ig = __builtin_amdgcn_exp2f(cum), gp = __builtin_amdgcn_exp2f(d - cum), nk = -kk[jt][e] * inv;
                kt[e] = kraw[jt][e] * (1.f + (a - 1.f) * pka[e]);
                at[e] = nk * gp; bt[e] = -nk * a * ig; kq[e] = kt[e] * ig; rq[e] = rr[e] * g; gg[e] = g;
            }
            st_bf4(KM + ro + 16 * jt, kt); st_bf4(VP + ro + 16 * jt, vp);
            if (fr == 15) *(f32x4*)(rec + REC_GC + (16 * jt + 4 * fq) * 4) = gg;
            pa[jt] = pk4(at); pb[jt] = pk4(bt); pk[jt] = pk4(kq); pr[jt] = pk4(rq); rt[jt] = rq;
            *(LAS v2u*)(iw + 0 * IMG + 32 * jt) = pa[jt]; *(LAS v2u*)(iw + 1 * IMG + 32 * jt) = pb[jt]; *(LAS v2u*)(iw + 2 * IMG + 32 * jt) = pk[jt]; *(LAS v2u*)(iw + 3 * IMG + 32 * jt) = pk4(vp);
        }
        const f32x4 z4 = (f32x4){0.f, 0.f, 0.f, 0.f};
        const int dd = fr - 4 * fq;
        f32x4 L = mm32(pa[2], pa[3], pb[2], pb[3], mm32(pa[0], pa[1], pb[0], pb[1], z4));
        f32x4 LT = mm32(pb[2], pb[3], pa[2], pa[3], mm32(pb[0], pb[1], pa[0], pa[1], z4));
        f32x4 Lak = mm32(pa[2], pa[3], pk[2], pk[3], mm32(pa[0], pa[1], pk[0], pk[1], z4));
        f32x4 MrbT = mm32(pb[2], pb[3], pr[2], pr[3], mm32(pb[0], pb[1], pr[0], pr[1], z4));
        f32x4 MrkT = mm32(pk[2], pk[3], pr[2], pr[3], mm32(pk[0], pk[1], pr[0], pr[1], z4));
        f32x4 TT;
#pragma unroll
        for (int r = 0; r < 4; ++r) {
            L[r] = dd < r ? L[r] : 0.f; Lak[r] = dd < r ? Lak[r] : 0.f;
            LT[r] = r < dd ? LT[r] : 0.f; MrbT[r] = r <= dd ? MrbT[r] : 0.f; MrkT[r] = r <= dd ? MrkT[r] : 0.f;
            TT[r] = LT[r] + (r == dd ? 1.f : 0.f);
        }
        const v2u bL = pk4(L), bLT = pk4(LT), bLak = pk4(Lak);
        const f32x4 L2m = mm16(bLT, bL, z4), L2T = mm16(bL, bLT, z4);
        const v2u bL2 = pk4(L2m), bL2T = pk4(L2T);
        const f32x4 L4m = mm16(bL2T, bL2, z4), L4T = mm16(bL2, bL2T, z4);
        const v2u bL4 = pk4(L4m), bL4T = pk4(L4T);
        const v2u bL8 = pk4(mm16(bL4T, bL4, z4));
        TT = mm16(bL2, pk4(TT), TT); TT = mm16(bL4, pk4(TT), TT); TT = mm16(bL8, pk4(TT), TT);
        f32x4 Zm = mm16(bL, pk4(MrbT), MrbT); Zm = mm16(bL2, pk4(Zm), Zm); Zm = mm16(bL4, pk4(Zm), Zm); Zm = mm16(bL8, pk4(Zm), Zm);
        const v2u bTT = pk4(TT), bMtT = pk4(Zm);
        *(v2u*)(rec + REC_TK + lane * 8) = pk4(mm16(bLak, bTT, z4)); *(v2u*)(rec + REC_MY + lane * 8) = pk4(mm16(bLak, bMtT, MrkT));
        LAS unsigned char* ir = sc + (4 * fq + ((lane & 15) >> 2)) * 144 + 8 * (lane & 3);
        v2u wat[4], rpt[4];
#pragma unroll
        for (int jt = 0; jt < 4; ++jt) {
            const v2u Qa = tr16(ir + 0 * IMG + 32 * jt), Qb = tr16(ir + 1 * IMG + 32 * jt), Qk = tr16(ir + 2 * IMG + 32 * jt);
            wat[jt] = pk4(mm16(Qa, bTT, z4)); rpt[jt] = pk4(mm16(Qa, bMtT, rt[jt]));
            *(v4u*)(rec + REC_BK + (jt * 64 + lane) * 16) = (v4u){Qb.x, Qb.y, Qk.x, Qk.y};
        }
#pragma unroll
        for (int s = 0; s < 2; ++s) {
            *(v4u*)(rec + REC_WA + (s * 64 + lane) * 16) = (v4u){wat[2 * s].x, wat[2 * s].y, wat[2 * s + 1].x, wat[2 * s + 1].y};
            *(v4u*)(rec + REC_RP + (s * 64 + lane) * 16) = (v4u){rpt[2 * s].x, rpt[2 * s].y, rpt[2 * s + 1].x, rpt[2 * s + 1].y};
        }
#pragma unroll
        for (int it = 0; it < 4; ++it) {
            const v2u Qv = tr16(ir + 3 * IMG + 32 * it);
            *(v2u*)(rec + REC_VV + (it * 64 + lane) * 8) = Qv;

        }
    }
}

__device__ __forceinline__ void ph_wkv2(const Params& p, int jl, int lane, int wave) {
    const bf16* Kr = (const bf16*)(p.ws + WS_K); const bf16* Vr = (const bf16*)(p.ws + (jl == 0 ? WS_VF : WS_VB)); const bf16* VFp = (const bf16*)(p.ws + WS_VF);
    const bf16* Rr = (const bf16*)(p.ws + WS_R); const bf16* L2 = (const bf16*)(p.ws + WS_L2);
    bf16* KM = (bf16*)(p.ws + WS_NKK); bf16* VP = (bf16*)(p.ws + WS_KKA);
    const bool vres = jl == 1; const int ri = lane >> 4, cg = lane & 15;
    float* YW = (float*)(p.ws + WS_YW);
    const int fr = lane & 15, fq = lane >> 4;
    const int gw = blockIdx.x * NWAVES + wave, NGW = gridDim.x * NWAVES;
    for (int job = gw; job < BATCH * WH * 4; job += NGW) {
        const int it = job & 3, h = (job >> 2) & 15, seq = job >> 6, r0 = seq * TP;
        const unsigned char* rec = p.ws + WS_REC + (size_t)((seq * WH + h) * WC_NCH) * REC_BYTES;
        f32x4 Sacc[4];
#pragma unroll
        for (int jt = 0; jt < 4; ++jt) Sacc[jt] = (f32x4){0.f, 0.f, 0.f, 0.f};
        v4u wa[2], rp[2], bk[4]; v2u vvf, tk, my; f32x4 gc[4];
#define WC_LOAD(rc) do { const unsigned char* r_ = (rc); \
            wa[0] = *(const v4u*)(r_ + REC_WA + lane * 16); wa[1] = *(const v4u*)(r_ + REC_WA + 1024 + lane * 16); rp[0] = *(const v4u*)(r_ + REC_RP + lane * 16); rp[1] = *(const v4u*)(r_ + REC_RP + 1024 + lane * 16); \
            _Pragma("unroll") for (int jt_ = 0; jt_ < 4; ++jt_) { bk[jt_] = *(const v4u*)(r_ + REC_BK + (jt_ * 64 + lane) * 16); gc[jt_] = *(const f32x4*)(r_ + REC_GC + (16 * jt_ + 4 * fq) * 4); } \
            vvf = *(const v2u*)(r_ + REC_VV + (it * 64 + lane) * 8); tk = *(const v2u*)(r_ + REC_TK + lane * 8); my = *(const v2u*)(r_ + REC_MY + lane * 8); } while (0)
        WC_LOAD(rec);
        for (int c = 0; c < WC_NCH; ++c) {
            const v4u cwa0 = wa[0], cwa1 = wa[1], crp0 = rp[0], crp1 = rp[1], cbk0 = bk[0], cbk1 = bk[1], cbk2 = bk[2], cbk3 = bk[3]; const v2u cvv = vvf; const f32x4 zz4 = (f32x4){0.f, 0.f, 0.f, 0.f}, cu0 = mm16(tk, vvf, zz4), cy0 = mm16(my, vvf, zz4), cg0 = gc[0], cg1 = gc[1], cg2 = gc[2], cg3 = gc[3];
            if (c + 1 < WC_NCH) WC_LOAD(rec + (size_t)(c + 1) * REC_BYTES);
            v4u sb0, sb1;
            sb0.x = cvt_pk_bf16(Sacc[0][0], Sacc[0][1]); sb0.y = cvt_pk_bf16(Sacc[0][2], Sacc[0][3]); sb0.z = cvt_pk_bf16(Sacc[1][0], Sacc[1][1]); sb0.w = cvt_pk_bf16(Sacc[1][2], Sacc[1][3]);
            sb1.x = cvt_pk_bf16(Sacc[2][0], Sacc[2][1]); sb1.y = cvt_pk_bf16(Sacc[2][2], Sacc[2][3]); sb1.z = cvt_pk_bf16(Sacc[3][0], Sacc[3][1]); sb1.w = cvt_pk_bf16(Sacc[3][2], Sacc[3][3]);
            const bf16x8 B0 = __builtin_bit_cast(bf16x8, sb0), B1 = __builtin_bit_cast(bf16x8, sb1);
            f32x4 U = __builtin_amdgcn_mfma_f32_16x16x32_bf16(__builtin_bit_cast(bf16x8, cwa0), B0, cu0, 0, 0, 0);
            U = __builtin_amdgcn_mfma_f32_16x16x32_bf16(__builtin_bit_cast(bf16x8, cwa1), B1, U, 0, 0, 0);
            f32x4 Y = __builtin_amdgcn_mfma_f32_16x16x32_bf16(__builtin_bit_cast(bf16x8, crp0), B0, cy0, 0, 0, 0);
            Y = __builtin_amdgcn_mfma_f32_16x16x32_bf16(__builtin_bit_cast(bf16x8, crp1), B1, Y, 0, 0, 0);
            v4u ub; ub.x = pk2_c(U[0], U[1]); ub.y = pk2_c(U[2], U[3]); ub.z = cvv.x; ub.w = cvv.y;
            const bf16x8 UB = __builtin_bit_cast(bf16x8, ub);
            Sacc[0] = __builtin_amdgcn_mfma_f32_16x16x32_bf16(__builtin_bit_cast(bf16x8, cbk0), UB, Sacc[0], 0, 0, 0) * cg0;
            Sacc[1] = __builtin_amdgcn_mfma_f32_16x16x32_bf16(__builtin_bit_cast(bf16x8, cbk1), UB, Sacc[1], 0, 0, 0) * cg1;
            Sacc[2] = __builtin_amdgcn_mfma_f32_16x16x32_bf16(__builtin_bit_cast(bf16x8, cbk2), UB, Sacc[2], 0, 0, 0) * cg2;
            Sacc[3] = __builtin_amdgcn_mfma_f32_16x16x32_bf16(__builtin_bit_cast(bf16x8, cbk3), UB, Sacc[3], 0, 0, 0) * cg3;
            float* yp = YW + (size_t)(r0 + WC_C * c + 4 * fq) * D + h * WN + 16 * it + fr;
            yp[0] = Y[0]; yp[D] = Y[1]; yp[2 * D] = Y[2]; yp[3 * D] = Y[3];
        }
#undef WC_LOAD
        float* so = p.out + O_WKVP + ((((size_t)jl * BATCH + seq) * WH + h) * WN + 16 * it + fr) * WN + 4 * fq;
#pragma unroll
        for (int jt = 0; jt < 4; ++jt) *(f32x4*)(so + 16 * jt) = Sacc[jt];
    }
    {
        const int gw = blockIdx.x * NWAVES + wave, NGW = gridDim.x * NWAVES;
        for (int it = gw; it < SB * WH * 16; it += NGW) {
            const int rg = it & 15, h = (it >> 4) & 15, s = it >> 8, row = MP + s, i = 4 * rg + ri;
            const int ch = h * WN + 4 * cg;
            WkPar P; P.w0 = *(const f32x4*)(p.in[I_W0] + (size_t)jl * D + ch); P.a0 = *(const f32x4*)(p.in[I_A0] + (size_t)jl * D + ch); P.kkp = *(const f32x4*)(p.in[I_KK] + (size_t)jl * D + ch);
            P.kap = *(const f32x4*)(p.in[I_KA] + (size_t)jl * D + ch); P.v0 = *(const f32x4*)(p.in[I_V0] + ch);
            const size_t vo = (size_t)row * D + ch, lo = (size_t)row * NL2 + ch;
            const f32x4 kraw = ld_bf4(Kr + vo), vraw = ld_bf4(Vr + vo), r4 = ld_bf4(Rr + vo), lw2 = ld_bf4(L2 + lo), la2 = ld_bf4(L2 + lo + 1024);
            f32x4 vf = (f32x4){0.f, 0.f, 0.f, 0.f}, lv2 = vf;
            if (vres) { vf = ld_bf4(VFp + vo); lv2 = ld_bf4(L2 + lo + 3072); }
            f32x4 w4, ka, k4, vp, nk; wk_prep(P, kraw, vraw, lw2, la2, vf, lv2, vres, w4, ka, k4, vp, nk);
            const int srcl = (lane & 48) | rg;
            const float v0_ = shfl_l(vp.x, srcl), v1_ = shfl_l(vp.y, srcl), v2_ = shfl_l(vp.z, srcl), v3_ = shfl_l(vp.w, srcl);
            const float vi = ri == 0 ? v0_ : (ri == 1 ? v1_ : (ri == 2 ? v2_ : v3_));
            const size_t so = ((((size_t)jl * SB + s) * WH + h) * WN + i) * WN + 4 * cg;
            f32x4 S = *(const f32x4*)(p.in[I_SWKV] + so);
            const float sa = row16_sum((S.x * nk.x + S.y * nk.y) + (S.z * nk.z + S.w * nk.w));
            S.x = fmaf(S.x, w4.x, fmaf(sa, ka.x, vi * k4.x)); S.y = fmaf(S.y, w4.y, fmaf(sa, ka.y, vi * k4.y));
            S.z = fmaf(S.z, w4.z, fmaf(sa, ka.z, vi * k4.z)); S.w = fmaf(S.w, w4.w, fmaf(sa, ka.w, vi * k4.w));
            const float y = row16_sum((S.x * r4.x + S.y * r4.y) + (S.z * r4.z + S.w * r4.w));
            *(f32x4*)(p.out + O_WKVS + so) = S;
            if (cg == 0) YW[(size_t)row * D + h * WN + i] = y;
            if (rg == 0 && ri == 0) { st_bf4(KM + vo, k4); st_bf4(VP + vo, vp); }
        }
    }
}

typedef __attribute__((address_space(1))) unsigned gu32;
#define XB_TMO      128
#define XB_XCNT(j)  (256  + 64 * (j))
#define XB_XSUB(j)  (1280 + 64 * (j))
#define XB_XGEN(j)  (2304 + 64 * (j))
#define XB_TOP      3328
#define XB_TOPGEN   3392
#define XCD_BAR_WORDS 3456
#define XB_SPIN_CAP (1u << 18)

__device__ __forceinline__ unsigned xb_ld(unsigned* p)              { return __hip_atomic_load(p, __ATOMIC_RELAXED, __HIP_MEMORY_SCOPE_AGENT); }
__device__ __forceinline__ unsigned xb_add(unsigned* p, unsigned v) { return __hip_atomic_fetch_add(p, v, __ATOMIC_RELAXED, __HIP_MEMORY_SCOPE_AGENT); }
__device__ __forceinline__ unsigned xb_xcc_id() { return (unsigned)__builtin_amdgcn_s_getreg((3 << 11) | 20) & 0xFu; }
#define XB_SPIN(cond, bar) do { unsigned _sp = 0; while (cond) { __builtin_amdgcn_s_sleep(1); \
    if ((++_sp & 255u) == 0u) { if (xb_ld(&(bar)[XB_TMO])) break; if (_sp > XB_SPIN_CAP) { atomicAdd(&(bar)[XB_TMO], 1u); break; } } } } while (0)

struct XcdBarrier {
    bool tid0; unsigned* bar; unsigned x;
    volatile LAS unsigned* st;
};

__device__ __forceinline__ XcdBarrier xcd_barrier_post(unsigned* bar, volatile LAS unsigned* st, bool tid0) {
    XcdBarrier b; b.tid0 = tid0; b.bar = bar; b.x = xb_xcc_id(); b.st = st;
    if (b.tid0) (void)xb_add(&bar[XB_XCNT(b.x)], 1u);
    return b;
}
__device__ __forceinline__ void xcd_barrier_complete(unsigned* bar, unsigned x, unsigned& nloc, unsigned& nx) {
    const unsigned G = gridDim.x * gridDim.y * gridDim.z;
    unsigned sum, cnt, mine, sp = 0u;
    for (;;) {
        sum = 0u; cnt = 0u; mine = 0u;
#pragma unroll
        for (unsigned j = 0; j < 16; ++j) { const unsigned c = xb_ld(&bar[XB_XCNT(j)]); sum += c; cnt += (c > 0u) ? 1u : 0u; mine = (j == x) ? c : mine; }
        if (sum == G) break;
        __builtin_amdgcn_s_sleep(1);
        if ((++sp & 255u) == 0u) { if (xb_ld(&bar[XB_TMO])) break; if (sp > XB_SPIN_CAP) { atomicAdd(&bar[XB_TMO], 1u); break; } }
    }
    nloc = mine > 0u ? mine : 1u; nx = cnt > 0u ? cnt : 1u;
}

__device__ __forceinline__ void xcd_barrier(const XcdBarrier& b) {
    asm volatile("s_waitcnt vmcnt(0)" ::: "memory");
    __syncthreads();
    if (b.tid0) {
        unsigned* bar = b.bar;
        __builtin_amdgcn_s_waitcnt(0);
        unsigned nloc = b.st[0], nx = b.st[1];
        if (nloc == 0u) { xcd_barrier_complete(bar, b.x, nloc, nx); b.st[0] = nloc; b.st[1] = nx; }
        const unsigned old = xb_add(&bar[XB_XSUB(b.x)], 1u);
        const unsigned gen = old / nloc;
        if (old + 1u == (gen + 1u) * nloc) {
            __builtin_amdgcn_fence(__ATOMIC_RELEASE, "agent");
            asm volatile("s_waitcnt vmcnt(0)" ::: "memory");
            const unsigned og = xb_add(&bar[XB_TOP], 1u);
            const unsigned tg = og / nx;
            if (og + 1u == (tg + 1u) * nx) xb_add(&bar[XB_TOPGEN], 1u);
            else XB_SPIN(xb_ld(&bar[XB_TOPGEN]) == tg, bar);
            __builtin_amdgcn_fence(__ATOMIC_ACQUIRE, "agent");
            xb_add(&bar[XB_XGEN(b.x)], 1u);
            asm volatile("s_waitcnt vmcnt(0)" ::: "memory");
        } else {
            XB_SPIN(xb_ld(&bar[XB_XGEN(b.x)]) == gen, bar);
            __builtin_amdgcn_fence(__ATOMIC_ACQUIRE, "agent");
            asm volatile("s_waitcnt vmcnt(0)" ::: "memory");
        }
    }
    __syncthreads();
}

enum { OP_P0 = 0, OP_NORM_RET, OP_G_RETIN, OP_RET, OP_RETNORM, OP_G_RETOUT, OP_NORM_RW, OP_G_RWPROJ, OP_G_LORA2, OP_PREP, OP_WKV, OP_WKV2, OP_POST, OP_G_WO,
       OP_NORM_FFN, OP_G_UG, OP_CONV, OP_G_WD, OP_FINAL };
struct Ph { unsigned char op, layer; };
constexpr int NPH = 1 + 2 * 6 + 2 * 9 + 1;
__device__ __host__ inline Ph phase_at(int i) {
    if (i == 0) return Ph{OP_P0, 0};
    i -= 1;
    int l;
    if (i < 6) l = 0; else if (i < 15) { l = 1; i -= 6; } else if (i < 21) { l = 2; i -= 15; } else if (i < 30) { l = 3; i -= 21; } else return Ph{OP_FINAL, 0};
    int op = OP_FINAL;
    if ((l & 1) == 0) {
        switch (i) { case 0: op = OP_G_RETIN; break; case 1: op = OP_RET; break; case 2: op = OP_RETNORM; break; case 3: op = OP_G_RETOUT; break;
                     case 4: op = OP_G_UG; break; default: op = OP_G_WD; break; }
    } else {
        switch (i) { case 0: op = OP_NORM_RW; break; case 1: op = OP_G_RWPROJ; break; case 2: op = OP_G_LORA2; break; case 3: op = OP_WKV; break; case 4: op = OP_WKV2; break; case 5: op = OP_POST; break; case 6: op = OP_G_WO; break;
                     case 7: op = OP_G_UG; break; default: op = OP_G_WD; break; }
    }
    return Ph{(unsigned char)op, (unsigned char)l};
}

__global__ void __launch_bounds__(NTHR, 2) mega(Params p, int lo, int hi) {
    extern __shared__ __attribute__((aligned(16))) unsigned char lds_raw[];
    LAS unsigned char* lds = (LAS unsigned char*)lds_raw;
    volatile LAS unsigned* bst = (volatile LAS unsigned*)(lds + LDS_BYTES - 16);
    const int wave0 = __builtin_amdgcn_readfirstlane((int)threadIdx.x >> 6);
    if (threadIdx.x < 4) bst[threadIdx.x] = 0u;
    __syncthreads();
    (void)xcd_barrier_post((unsigned*)(p.ws + WS_CTL), bst, threadIdx.x == 0);
    for (int ph = lo; ph < hi; ++ph) {
        int lid_; asm volatile("v_mbcnt_lo_u32_b32 %0, -1, 0\n\tv_mbcnt_hi_u32_b32 %0, -1, %0" : "=v"(lid_));
        int tid = wave0 * 64 + lid_; asm volatile("" : "+v"(tid));
        const int lane = tid & 63, wave = __builtin_amdgcn_readfirstlane(tid >> 6);
        unsigned char* ws = p.ws;
        const Ph P = phase_at(ph);
        const int li = P.layer, jl = li >> 1;
        const bf16* gA = nullptr; const bf16* gB = nullptr; int gN = 0, gK = 0; EpiAnyT<0> E{}; E.jl = jl; E.ws = ws; E.slot = -1; E.amul = 1.f; E.li = li; E.ldsb = lds; bool is_gemm = false;
        switch (P.op) {
        case OP_P0: ph_p0(p, lds, tid, lane, wave); break;
        case OP_NORM_RET: ph_norm(p, p.in[I_NMIX] + (size_t)li * D, 0, jl, lane, wave); break;
        case OP_NORM_FFN: ph_norm(p, p.in[I_NFFN] + (size_t)li * D, 0, jl, lane, wave); break;
        case OP_NORM_RW: ph_norm(p, p.in[I_NMIX] + (size_t)li * D, 1, jl, lane, wave); break;
        case OP_FINAL: ph_norm(p, p.in[I_NFIN], 2, 0, lane, wave); break;
        case OP_RETNORM: ph_ret_norm(p, jl, lane, wave); break;
        case OP_POST: ph_rwkv_post(p, jl, lane, wave); break;
        case OP_RET: ph_ret_fast(p, jl, lds, tid, lane, wave); break;
        case OP_WKV: ph_wkv1(p, jl, lds, lane, wave); break;
        case OP_WKV2: ph_wkv2(p, jl, lane, wave); break;
        case OP_G_RETIN: is_gemm = true; E.kind = EK_RETIN; E.perm = true; E.slot = 2 * li;
            gA = (const bf16*)(ws + WS_XB); gB = (const bf16*)(ws + WS_WIN + jl * SZ_WIN); gN = RWIN; gK = D; break;
        case OP_G_RETOUT: is_gemm = true; E.kind = EK_RESID; E.perm = false; E.slot = 2 * li + 1;
            gA = (const bf16*)(ws + WS_Y); gB = (const bf16*)(ws + WS_WOUT + jl * SZ_WOUT); gN = D; gK = RV; break;
        case OP_G_RWPROJ: is_gemm = true; E.kind = EK_RWPROJ; E.perm = true;
            gA = (const bf16*)(ws + WS_H); gB = (const bf16*)(ws + WS_WRW + jl * SZ_WRW); gN = NRW; gK = KRW; break;
        case OP_G_LORA2: is_gemm = true; E.kind = EK_F32; E.perm = true;
            gA = (const bf16*)(ws + WS_A2); gB = (const bf16*)(ws + WS_WL2 + jl * SZ_WL2); gN = (jl == 0 ? 3072 : 4096); gK = KL2; break;
        case OP_G_WO: is_gemm = true; E.kind = EK_RESID; E.perm = false; E.slot = 2 * li + 1;
            gA = (const bf16*)(ws + WS_Z); gB = (const bf16*)(ws + WS_WO + jl * SZ_WO); gN = D; gK = D; break;
        case OP_G_UG: is_gemm = true; E.kind = EK_UG; E.perm = true; E.slot = 2 * li + 1;
            gA = (const bf16*)(ws + WS_XB); gB = (const bf16*)(ws + WS_WUG + li * SZ_WUG); gN = 2 * DFF; gK = D; break;
        case OP_G_WD: is_gemm = true; E.kind = EK_RESID; E.perm = false; E.slot = (li == 1) ? 2 * (li + 1) : -1;
            gA = (const bf16*)(ws + WS_ACT); gB = (const bf16*)(ws + WS_WD + li * SZ_WD); gN = D; gK = DFF; break;
        default: break;
        }
        if (is_gemm) {
            const bool ug = E.kind == EK_UG;
            const int gM = (E.kind == EK_RESID) ? MT0 : (ug ? 66 * 256 : M);
            pg8::Gemm g{ug ? gA - 2 * D : gA, gB, gM, gN, gK, ug ? 254 : 256}; pg8::StaticOrder S; S.init(gM, gN, (int)gridDim.x, (int)blockIdx.x);
            if (E.kind == EK_RETIN || E.kind == EK_UG) {
                LAS float* rt = (LAS float*)(lds + 131072);
                Unit uu;
                for (int ui = 0; ui < 8 && S.next(ui, uu); ++ui) if (tid < 256) { int rr = ug ? 254 * uu.pm - 2 + tid : uu.pm * 256 + tid; rr = rr < 0 ? 0 : (rr > M - 1 ? M - 1 : rr); rt[ui * 256 + tid] = row_rstd(ws, E.slot, rr); }
                E.rtab = rt; E.ldsb = lds;
                __syncthreads();
            }
            if (ug) { EpiAnyT<1> E1{}; E1.kind = E.kind; E1.perm = E.perm; E1.jl = E.jl; E1.ws = E.ws; E1.slot = E.slot; E1.rtab = E.rtab; E1.amul = E.amul; E1.li = E.li; E1.ldsb = E.ldsb; E1.pcw = p.in[I_CW]; E1.pcb = p.in[I_CB]; E1.pcst = p.in[I_SCONV]; E1.pout = p.out;
                pg8::gemm_phase<EpiAnyT<1>, pg8::StaticOrder, true, true>(lds, g, S, E1, tid); }
            else pg8::gemm_phase<EpiAnyT<0>, pg8::StaticOrder, true, true>(lds, g, S, E, tid);
            if (E.kind == EK_RESID) tail_resid(gA, gB, gK, ws, E.slot, E.amul, lds, lane, wave);
        }
        if (ph + 1 < hi) { if (ph == 0) cg::this_grid().sync(); else { XcdBarrier bar; bar.tid0 = tid == 0; bar.bar = (unsigned*)(p.ws + WS_CTL); bar.x = xb_xcc_id(); bar.st = (volatile LAS unsigned*)(lds + LDS_BYTES - 16); xcd_barrier(bar); } }
    }
}

}

extern "C" void kernel_launch(void* const* d_in, const int* in_sizes, int n_in, void* d_out, int out_size, void* d_ws, size_t ws_size, hipStream_t stream) {
    static int grid = 0;
    if (grid == 0) {
        int dev = 0, cus = 0;
        if (n_in != N_IN || ws_size < WS_END2) { fprintf(stderr, "kernel_launch: unexpected n_in %d / ws_size %zu (need %zu)\n", n_in, ws_size, (size_t)WS_END2); grid = -1; return; }
        if (hipGetDevice(&dev) != hipSuccess || hipDeviceGetAttribute(&cus, hipDeviceAttributeMultiprocessorCount, dev) != hipSuccess) { grid = -1; return; }
        if (hipFuncSetAttribute((const void*)mega, hipFuncAttributeMaxDynamicSharedMemorySize, LDS_BYTES) != hipSuccess) { fprintf(stderr, "kernel_launch: hipFuncSetAttribute failed\n"); grid = -1; return; }
        int per_cu = 0;
        if (hipOccupancyMaxActiveBlocksPerMultiprocessor(&per_cu, (const void*)mega, NTHR, LDS_BYTES) != hipSuccess || per_cu < 1) { fprintf(stderr, "kernel_launch: occupancy query says %d\n", per_cu); (void)hipGetLastError(); }
        grid = cus * (per_cu >= 1 ? 1 : 1);
    }
    if (grid < 0) return;
    Params p{};
    for (int i = 0; i < N_IN; ++i) p.in[i] = (const float*)d_in[i];
    p.out = (float*)d_out; p.ws = (unsigned char*)d_ws;
    if (hipMemsetAsync(d_ws, 0, 65536, stream) != hipSuccess) { fprintf(stderr, "kernel_launch: memset failed\n"); return; }
    int lo = 0, hi = NPH;
    void* args[] = {(void*)&p, (void*)&lo, (void*)&hi};
    const hipError_t e = hipLaunchCooperativeKernel((const void*)mega, dim3(grid), dim3(NTHR), args, LDS_BYTES, stream);
    if (e != hipSuccess) fprintf(stderr, "kernel_launch: cooperative launch failed: %s (grid %d)\n", hipGetErrorString(e), grid);
    (void)in_sizes; (void)out_size;
}
```

```cpp
#include <hip/hip_runtime.h>
#include <hip/hip_cooperative_groups.h>
#include <cstdio>
#include <stdint.h>
namespace cg = cooperative_groups;
namespace pg8 {
#define PG8_LAS __attribute__((address_space(3)))
typedef unsigned short bf16_t;
typedef short bf16x8 __attribute__((ext_vector_type(8)));
typedef float f32x4 __attribute__((ext_vector_type(4)));
typedef unsigned u32x4 __attribute__((ext_vector_type(4)));
constexpr int BM = 256, BK = 64, HALF = 128, HTB = HALF * BK * 2  , STAGE_BYTES = 8 * HTB, NXCD = 8, WGM = 8;

__host__ __device__ __forceinline__ int lds_byte(int r, int c) { const int st = (r >> 4) * 2 + (c >> 5), rr = r & 15, cc = c & 31, ob = rr * 64 + cc * 2; return st * 1024 + (ob ^ (((ob >> 9) & 1) << 5)); }
__host__ __device__ __forceinline__ void stage_rc(int b, int& R, int& C) { const int st = b / 1024, sb = b % 1024, swz = sb ^ (((sb >> 9) & 1) << 5); R = (st >> 1) * 16 + swz / 64; C = (st & 1) * 32 + (swz % 64) / 2; }
__host__ __device__ __forceinline__ int perm32(int rho) { const int n = rho >> 4, i = rho & 15; return 8 * (i >> 2) + 4 * n + (i & 3); }

struct Unit { int pm, pn, ord; };
struct Gemm { const bf16_t* A; const bf16_t* Bt; int M, N, K, trows; };

struct StaticOrder {
    int nM, nN, nwg, G, c;
    __host__ __device__ void init(int M, int N, int G_, int c_) { nM = M / BM; nN = N / BM; nwg = nM * nN; G = G_; c = c_; }
    __host__ __device__ __forceinline__ bool next(int i, Unit& u) const {
        const long L = (long)i * G + c; if (L >= nwg) return false;
        int wgid = (int)L; { const int q = nwg / NXCD, r = nwg % NXCD, xcd = wgid % NXCD, off = wgid / NXCD; wgid = (xcd < r ? xcd * (q + 1) : r * (q + 1) + (xcd - r) * q) + off; }
        const int nig = WGM * nN, gid = wgid / nig, fm = gid * WGM, gsz = (nM - fm) < WGM ? (nM - fm) : WGM;
        u.pm = fm + ((wgid % nig) % gsz); u.pn = (wgid % nig) / gsz; u.ord = i; return true;
    }
    __device__ __forceinline__ void a_ready(const Unit&) const {}
    __device__ __forceinline__ void done(const Unit&) const {}
};
template <class Epi, class Sched, bool ALIGN_EPI = false, bool SP2 = false>
__device__ __forceinline__ void gemm_phase(PG8_LAS unsigned char* lds, const Gemm g, const Sched& S, const Epi& E, int tid_in) {
    int tid = tid_in; asm volatile("" : "+v"(tid));
    const int wid = __builtin_amdgcn_readfirstlane(tid >> 6), lane = tid & 63, wr = wid >> 2, wc = wid & 3, fr = lane & 15, fq = lane >> 4;
    const int K = g.K, nt = K / BK;
    unsigned voffA[2], voffB[2];
#pragma unroll
    for (int i = 0; i < 2; ++i) { int R, C; stage_rc(tid * 16 + i * 8192, R, C); const int Rb = E.perm ? ((R & ~31) + perm32(R & 31)) : R;
        voffA[i] = (unsigned)(R * K + C) * 2u; voffB[i] = (unsigned)(Rb * K + C) * 2u; }
    const size_t kstep = (size_t)(BK * 2);
    const size_t hstep = (size_t)HALF * K * 2;
    const size_t tstep = 2 * hstep; const size_t tstepA = (size_t)g.trows * K * 2;
    const unsigned ldsw = (unsigned)wid * 1024u;
    const int aoff = lds_byte(wr * 64 + fr, fq * 8), boff = lds_byte(wc * 32 + fr, fq * 8);
#define PG8_SA(b, h) (((b) * 2 + (h)) * HTB)
#define PG8_SB(b, h) ((4 + (b) * 2 + (h)) * HTB)
#define PG8_STAGE(bufoff, gbase, voff) do { _Pragma("unroll") for (int _i = 0; _i < 2; ++_i) \
        __builtin_amdgcn_global_load_lds((const unsigned*)((const char*)(gbase) + (voff)[_i]), (PG8_LAS unsigned*)(lds + (bufoff) + ldsw + _i * 8192), 16, 0, 0); } while (0)
#define PG8_LDA(dst, b, h) do { _Pragma("unroll") for (int m = 0; m < 4; ++m) _Pragma("unroll") for (int k = 0; k < 2; ++k) dst[m][k] = *(const PG8_LAS bf16x8*)(lds + PG8_SA(b, h) + aoff + m * 2048 + k * 1024); } while (0)
#define PG8_LDB(dst, b, h) do { _Pragma("unroll") for (int n = 0; n < 2; ++n) _Pragma("unroll") for (int k = 0; k < 2; ++k) dst[n][k] = *(const PG8_LAS bf16x8*)(lds + PG8_SB(b, h) + boff + n * 2048 + k * 1024); } while (0)
#define PG8_MMA(ai, bj, At, Bt) do { __builtin_amdgcn_s_setprio(1); _Pragma("unroll") for (int m = 0; m < 4; ++m) _Pragma("unroll") for (int n = 0; n < 2; ++n) _Pragma("unroll") for (int k = 0; k < 2; ++k) \
        acc[ai][bj][m][n] = __builtin_amdgcn_mfma_f32_16x16x32_bf16(Bt[n][k], At[m][k], acc[ai][bj][m][n], 0, 0, 0); __builtin_amdgcn_s_setprio(0); } while (0)
#define PG8_WAIT_V(n) asm volatile("s_waitcnt vmcnt(" #n ")" ::: "memory")
#define PG8_WAIT_L(n) asm volatile("s_waitcnt lgkmcnt(" #n ")" ::: "memory")
#define PG8_BAR __builtin_amdgcn_s_barrier()
#define PG8_SCHED __builtin_amdgcn_sched_barrier(0)
    Unit cur, nxt; int ui = 0;
    if (!S.next(0, cur)) return;
    f32x4 acc[2][2][4][2];
#pragma unroll
    for (int a = 0; a < 2; ++a)
#pragma unroll
        for (int b = 0; b < 2; ++b)
#pragma unroll
            for (int m = 0; m < 4; ++m)
#pragma unroll
                for (int n = 0; n < 2; ++n) acc[a][b][m][n] = (f32x4){0.f, 0.f, 0.f, 0.f};
    bf16x8 At[4][2], B0[2][2], B1[2][2];
    const char* cA = (const char*)g.A + (size_t)cur.pm * tstepA; const char* cB = (const char*)g.Bt + (size_t)cur.pn * tstep;
    S.a_ready(cur);
    if constexpr (SP2) {
        PG8_STAGE(PG8_SB(0, 0), cB, voffB); PG8_STAGE(PG8_SB(0, 1), cB + hstep, voffB); PG8_STAGE(PG8_SA(0, 0), cA, voffA); PG8_STAGE(PG8_SA(0, 1), cA + hstep, voffA);
        if (wr == 1) PG8_BAR;
        PG8_WAIT_V(2); PG8_BAR;
        PG8_STAGE(PG8_SB(1, 0), cB + kstep, voffB); PG8_STAGE(PG8_SA(1, 0), cA + kstep, voffA); PG8_STAGE(PG8_SB(1, 1), cB + hstep + kstep, voffB);
        PG8_WAIT_V(6); PG8_BAR;
    } else {
        PG8_STAGE(PG8_SB(0, 0), cB, voffB); PG8_STAGE(PG8_SA(0, 0), cA, voffA); PG8_STAGE(PG8_SB(0, 1), cB + hstep, voffB); PG8_STAGE(PG8_SA(0, 1), cA + hstep, voffA);
        if (wr == 1) PG8_BAR;
        PG8_WAIT_V(4); PG8_BAR;
        PG8_STAGE(PG8_SB(1, 0), cB + kstep, voffB); PG8_STAGE(PG8_SA(1, 0), cA + kstep, voffA); PG8_STAGE(PG8_SB(1, 1), cB + hstep + kstep, voffB);
        PG8_WAIT_V(6); PG8_BAR;
    }
    for (;;) {
        const bool has_next = S.next(ui + 1, nxt);
        const char* nA = has_next ? (const char*)g.A + (size_t)nxt.pm * tstepA : cA; const char* nB = has_next ? (const char*)g.Bt + (size_t)nxt.pn * tstep : cB;
        for (int t = 0; t < nt; t += 2) {
            const bool last = (t == nt - 2);
            const char* a1 = cA + (size_t)(t + 1) * kstep;
            const char* a2 = last ? nA : cA + (size_t)(t + 2) * kstep; const char* b2 = last ? nB : cB + (size_t)(t + 2) * kstep;
            const char* a3 = a2 + kstep; const char* b3 = b2 + kstep;
            if (last && has_next) S.a_ready(nxt);
            if constexpr (SP2) {
            PG8_LDB(B0, 0, 0); PG8_LDB(B1, 0, 1); PG8_SCHED; PG8_LDA(At, 0, 0); PG8_STAGE(PG8_SA(1, 1), a1 + hstep, voffA);
            PG8_WAIT_V(8); PG8_WAIT_L(0); PG8_BAR; PG8_MMA(0, 0, At, B0); PG8_MMA(0, 1, At, B1); PG8_BAR; PG8_SCHED;
            PG8_LDA(At, 0, 1); PG8_STAGE(PG8_SB(0, 0), b2, voffB); PG8_STAGE(PG8_SB(0, 1), b2 + hstep, voffB); PG8_STAGE(PG8_SA(0, 0), a2, voffA);
            PG8_WAIT_V(8); PG8_WAIT_L(0); PG8_BAR; PG8_MMA(1, 0, At, B0); PG8_MMA(1, 1, At, B1); PG8_BAR; PG8_SCHED;
            PG8_LDB(B0, 1, 0); PG8_LDB(B1, 1, 1); PG8_SCHED; PG8_LDA(At, 1, 0); PG8_STAGE(PG8_SA(0, 1), a2 + hstep, voffA);
            PG8_WAIT_V(8); PG8_WAIT_L(0); PG8_BAR; PG8_MMA(0, 0, At, B0); PG8_MMA(0, 1, At, B1); PG8_BAR; PG8_SCHED;
            PG8_LDA(At, 1, 1); PG8_STAGE(PG8_SB(1, 0), b3, voffB); PG8_STAGE(PG8_SB(1, 1), b3 + hstep, voffB); PG8_STAGE(PG8_SA(1, 0), a3, voffA);
            PG8_WAIT_V(8); PG8_WAIT_L(0); PG8_BAR; PG8_MMA(1, 0, At, B0); PG8_MMA(1, 1, At, B1); PG8_BAR; PG8_SCHED;
            } else {
            PG8_LDB(B0, 0, 0); PG8_SCHED; PG8_LDA(At, 0, 0); PG8_STAGE(PG8_SA(1, 1), a1 + hstep, voffA);
            PG8_WAIT_L(8); PG8_BAR; PG8_WAIT_L(0); PG8_MMA(0, 0, At, B0); PG8_BAR; PG8_SCHED;
            PG8_LDB(B1, 0, 1); PG8_STAGE(PG8_SB(0, 0), b2, voffB);
            PG8_BAR; PG8_WAIT_L(0); PG8_MMA(0, 1, At, B1); PG8_BAR;
            PG8_LDA(At, 0, 1); PG8_STAGE(PG8_SA(0, 0), a2, voffA);
            PG8_BAR; PG8_WAIT_L(0); PG8_MMA(1, 0, At, B0); PG8_BAR; PG8_SCHED;
            PG8_STAGE(PG8_SB(0, 1), b2 + hstep, voffB);
            PG8_WAIT_V(6); PG8_BAR; PG8_MMA(1, 1, At, B1); PG8_BAR;
            PG8_LDB(B0, 1, 0); PG8_SCHED; PG8_LDA(At, 1, 0); PG8_STAGE(PG8_SA(0, 1), a2 + hstep, voffA);
            PG8_WAIT_L(8); PG8_BAR; PG8_WAIT_L(0); PG8_MMA(0, 0, At, B0); PG8_BAR; PG8_SCHED;
            PG8_LDB(B1, 1, 1); PG8_STAGE(PG8_SB(1, 0), b3, voffB);
            PG8_BAR; PG8_WAIT_L(0); PG8_MMA(0, 1, At, B1); PG8_BAR;
            PG8_LDA(At, 1, 1); PG8_STAGE(PG8_SA(1, 0), a3, voffA);
            PG8_BAR; PG8_WAIT_L(0); PG8_MMA(1, 0, At, B0); PG8_BAR; PG8_SCHED;
            PG8_STAGE(PG8_SB(1, 1), b3 + hstep, voffB);
            PG8_WAIT_V(6); PG8_BAR; PG8_MMA(1, 1, At, B1); PG8_BAR;
            }
        }
        if constexpr (ALIGN_EPI) { if (wr == 0) PG8_BAR; }
        if constexpr (!Epi::AFTER_DRAIN) { E(acc, cur, wr, wc, fr, fq); S.done(cur); }
        if (!has_next) break;
#pragma unroll
        for (int a = 0; a < 2; ++a)
#pragma unroll
            for (int b = 0; b < 2; ++b)
#pragma unroll
                for (int m = 0; m < 4; ++m)
#pragma unroll
                    for (int n = 0; n < 2; ++n) acc[a][b][m][n] = (f32x4){0.f, 0.f, 0.f, 0.f};
        cur = nxt; cA = nA; cB = nB; ++ui;
        if constexpr (ALIGN_EPI) { if (wr == 1) PG8_BAR; }
    }
    PG8_WAIT_V(0);
    if constexpr (!ALIGN_EPI) { if (wr == 0) PG8_BAR; }
    PG8_BAR;
    if constexpr (Epi::AFTER_DRAIN) { E.fused(acc, cur, wr, wc, fr, fq, lds, wid, lane); S.done(cur); }
#undef PG8_SA
#undef PG8_SB
#undef PG8_STAGE
#undef PG8_LDA
#undef PG8_LDB
#undef PG8_MMA
#undef PG8_WAIT_V
#undef PG8_WAIT_L
#undef PG8_BAR
#undef PG8_SCHED
}
}

namespace {
constexpr int D = 1024, BATCH = 8, SEQ = 2048, NMETA = 16, TP = SEQ + NMETA, MP = BATCH * TP, SB = 128, M = MP + SB;
constexpr int DEPTH = 4, RH = 4, RDK = 256, RDV = 512, RV = 2048, RWIN = 6144;
constexpr int WH = 16, WN = 64, LW = 64, LA = 64, LV = 32, LG = 160, DFF = 2816;
constexpr int NRW = 3584, KRW = 2048, KL2 = 384, NL2 = 4096;
constexpr float PAST_POS = 16384.f;
constexpr int NWAVES = 8, NTHR = 512;
constexpr int LDS_BYTES = 147456;

constexpr size_t O_YP = 0;
constexpr size_t O_YS = O_YP + (size_t)BATCH * SEQ * D;
constexpr size_t O_RETP = O_YS + (size_t)SB * D;
constexpr size_t O_WKVP = O_RETP + (size_t)2 * BATCH * RH * RDK * RDV;
constexpr size_t O_SHP = O_WKVP + (size_t)2 * BATCH * WH * WN * WN;
constexpr size_t O_CVP = O_SHP + (size_t)2 * BATCH * D;
constexpr size_t O_RETS = O_CVP + (size_t)DEPTH * BATCH * 2 * DFF;
constexpr size_t O_WKVS = O_RETS + (size_t)2 * SB * RH * RDK * RDV;
constexpr size_t O_SHS = O_WKVS + (size_t)2 * SB * WH * WN * WN;
constexpr size_t O_CVS = O_SHS + (size_t)2 * SB * D;

enum { I_XP = 0, I_XS, I_SRET, I_SWKV, I_SSHIFT, I_SCONV, I_META, I_NMIX, I_NFFN, I_NFIN, I_RWIN, I_RGN, I_RWOUT, I_MU, I_WRKV, I_W0, I_W1, I_W2,
       I_A0, I_A1, I_A2, I_V0, I_V1, I_V2, I_G1, I_G2, I_KK, I_KA, I_RK, I_LNW, I_LNB, I_WO, I_WUG, I_CW, I_CB, I_WD, N_IN };

constexpr size_t al256(size_t x) { return (x + 255) & ~(size_t)255; }
constexpr size_t WS_CTL = 0;
constexpr size_t WS_CS = 1u << 20;
constexpr size_t WS_WIN = 4u << 20;
constexpr size_t SZ_WIN = (size_t)RWIN * D * 2;
constexpr size_t WS_WOUT = WS_WIN + 2 * SZ_WIN;
constexpr size_t SZ_WOUT = (size_t)D * RV * 2;
constexpr size_t WS_WRW = WS_WOUT + 2 * SZ_WOUT;
constexpr size_t SZ_WRW = (size_t)NRW * KRW * 2;
constexpr size_t WS_WL2 = WS_WRW + 2 * SZ_WRW;
constexpr size_t SZ_WL2 = (size_t)NL2 * KL2 * 2;
constexpr size_t WS_WO = WS_WL2 + 2 * SZ_WL2;
constexpr size_t SZ_WO = (size_t)D * D * 2;
constexpr size_t WS_WUG = WS_WO + 2 * SZ_WO;
constexpr size_t SZ_WUG = (size_t)2 * DFF * D * 2;
constexpr size_t WS_WD = WS_WUG + 4 * SZ_WUG;
constexpr size_t SZ_WD = (size_t)D * DFF * 2;
constexpr size_t WS_X = al256(WS_WD + 4 * SZ_WD);
constexpr size_t SZ_MD4 = (size_t)M * D * 4;
constexpr size_t WS_H = WS_X + SZ_MD4;
constexpr size_t WS_VF = WS_H + SZ_MD4;
constexpr size_t WS_REG = WS_VF + SZ_MD4;
constexpr size_t WS_QK = WS_REG;
constexpr size_t WS_V = WS_QK + SZ_MD4;
constexpr size_t WS_SG = WS_V + SZ_MD4;
constexpr size_t WS_O = WS_SG + SZ_MD4;
constexpr size_t WS_Y = WS_O + 2 * SZ_MD4;
constexpr size_t WS_R = WS_REG;
constexpr size_t WS_K = WS_R + SZ_MD4;
constexpr size_t WS_VB = WS_K + SZ_MD4;
constexpr size_t WS_WDEC = WS_VB + SZ_MD4;
constexpr size_t WS_NKK = WS_WDEC + SZ_MD4;
constexpr size_t WS_KKA = WS_NKK + SZ_MD4;
constexpr size_t WS_YW = WS_KKA + SZ_MD4;
constexpr size_t WS_L2 = WS_YW + SZ_MD4;
constexpr size_t WS_A2 = WS_L2 + 4 * SZ_MD4;
constexpr size_t WS_Z = al256(WS_A2 + (size_t)M * KL2 * 2);
constexpr size_t WS_RW_END = WS_Z + (size_t)M * D * 2;
constexpr size_t SZ_FF2 = (size_t)M * DFF * 2;
constexpr size_t WS_U = WS_REG;
constexpr size_t WS_G = al256(WS_U + SZ_FF2);
constexpr size_t WS_ACT = al256(WS_G + SZ_FF2);
constexpr size_t WS_XB = al256(WS_RW_END) + 2 * (size_t)D * 2;
constexpr size_t WS_SS = al256(WS_XB + (size_t)(M + 126) * D * 2);
constexpr size_t WS_PTRS = al256(WS_SS + (size_t)8 * M * 16 * 4);
constexpr size_t WS_END = WS_PTRS + 256;

#define LAS __attribute__((address_space(3)))
typedef unsigned short bf16;
typedef unsigned v4u __attribute__((ext_vector_type(4)));
typedef unsigned v2u __attribute__((ext_vector_type(2)));
using pg8::f32x4;
using pg8::Unit;
using pg8::bf16x8;

struct Params { const float* in[N_IN]; float* out; unsigned char* ws; };

__device__ __forceinline__ unsigned cvt_pk_bf16(float lo, float hi) { unsigned r; asm("v_cvt_pk_bf16_f32 %0, %1, %2" : "=v"(r) : "v"(lo), "v"(hi)); return r; }
__device__ __forceinline__ float bf_lo(unsigned w) { return __uint_as_float(w << 16); }
__device__ __forceinline__ float bf_hi(unsigned w) { return __uint_as_float(w & 0xffff0000u); }
__device__ __forceinline__ void unpack8(const v4u w, float (&f)[8]) { f[0] = bf_lo(w.x); f[1] = bf_hi(w.x); f[2] = bf_lo(w.y); f[3] = bf_hi(w.y); f[4] = bf_lo(w.z); f[5] = bf_hi(w.z); f[6] = bf_lo(w.w); f[7] = bf_hi(w.w); }
__device__ __forceinline__ v4u pack8(const float (&f)[8]) { v4u w; w.x = cvt_pk_bf16(f[0], f[1]); w.y = cvt_pk_bf16(f[2], f[3]); w.z = cvt_pk_bf16(f[4], f[5]); w.w = cvt_pk_bf16(f[6], f[7]); return w; }
__device__ __forceinline__ f32x4 ld_bf4(const bf16* q) { const v2u w = *(const v2u*)q; return (f32x4){bf_lo(w.x), bf_hi(w.x), bf_lo(w.y), bf_hi(w.y)}; }
__device__ __forceinline__ void st_bf4(bf16* q, const f32x4 v) { v2u w; w.x = cvt_pk_bf16(v.x, v.y); w.y = cvt_pk_bf16(v.z, v.w); *(v2u*)q = w; }
__device__ __forceinline__ float shfl_xor_l(float v, int m, int lane) { return __int_as_float(__builtin_amdgcn_ds_bpermute((lane ^ m) << 2, __float_as_int(v))); }
__device__ __forceinline__ float shfl_l(float v, int src) { return __int_as_float(__builtin_amdgcn_ds_bpermute(src << 2, __float_as_int(v))); }
__device__ __forceinline__ float wave_sum(float v, int) {
    v += __builtin_bit_cast(float, __builtin_amdgcn_update_dpp(0, __float_as_int(v), 0x128, 0xf, 0xf, false));
    v += __builtin_bit_cast(float, __builtin_amdgcn_update_dpp(0, __float_as_int(v), 0x124, 0xf, 0xf, false));
    v += __builtin_bit_cast(float, __builtin_amdgcn_update_dpp(0, __float_as_int(v), 0x122, 0xf, 0xf, false));
    v += __builtin_bit_cast(float, __builtin_amdgcn_update_dpp(0, __float_as_int(v), 0x121, 0xf, 0xf, false));
    const int vi = __float_as_int(v);
    return (__int_as_float(__builtin_amdgcn_readlane(vi, 0)) + __int_as_float(__builtin_amdgcn_readlane(vi, 16))) + (__int_as_float(__builtin_amdgcn_readlane(vi, 32)) + __int_as_float(__builtin_amdgcn_readlane(vi, 48)));
}
__device__ __forceinline__ float rcpf_(float x) { return __builtin_amdgcn_rcpf(x); }
__device__ __forceinline__ float sigmoidf_(float x) { return rcpf_(1.f + __expf(-x)); }
__device__ __forceinline__ float siluf_(float x) { return x * rcpf_(1.f + __expf(-x)); }
__device__ __forceinline__ float tanhf_(float x) { return 1.f - 2.f * rcpf_(1.f + __expf(2.f * x)); }

__device__ __forceinline__ float row_rstd(const unsigned char* ws, int slot, int row) {
    const f32x4* q = (const f32x4*)((const float*)(ws + WS_SS) + ((size_t)slot * M + row) * 16);
    const f32x4 a = q[0], b = q[1], c = q[2], d = q[3];
    const float ss = (((a.x + a.y) + (a.z + a.w)) + ((b.x + b.y) + (b.z + b.w))) + (((c.x + c.y) + (c.z + c.w)) + ((d.x + d.y) + (d.z + d.w)));
    return rsqrtf(ss * (1.f / D) + 1e-6f);
}
__device__ __forceinline__ float dpp_ror1(float v) { return __int_as_float(__builtin_amdgcn_update_dpp(0, __float_as_int(v), 0x121, 0xf, 0xf, false)); }
template <int CTRL> __device__ __forceinline__ float dpp_mv(float v) { return __int_as_float(__builtin_amdgcn_mov_dpp(__float_as_int(v), CTRL, 0xf, 0xf, true)); }
__device__ __forceinline__ float dpp_ror2(float v) { return __int_as_float(__builtin_amdgcn_update_dpp(0, __float_as_int(v), 0x122, 0xf, 0xf, false)); }
enum { EK_RETIN = 0, EK_RESID, EK_UG, EK_RWPROJ, EK_F32 };
template <int GRP> struct EpiExtra {};
template <> struct EpiExtra<1> { const float* pcw; const float* pcb; const float* pcst; float* pout; };
template <int GRP> struct EpiAnyT : EpiExtra<GRP> {
    static constexpr bool AFTER_DRAIN = false;
    int kind; bool perm; int jl; unsigned char* ws; int slot; const LAS float* rtab; float amul; int li; LAS unsigned char* ldsb;
    __device__ __forceinline__ void operator()(const f32x4 (&acc)[2][2][4][2], const Unit& u, int wr, int wc, int fr, int fq) const {
        const int row0 = u.pm * 256 + wr * 64 + fr;
        if (GRP == 0 && kind == EK_RETIN) {
            bf16* QK = (bf16*)(ws + WS_QK); bf16* V = (bf16*)(ws + WS_V); bf16* SG = (bf16*)(ws + WS_SG); const float* CS = (const float*)(ws + WS_CS);
            const int cw = wc * 32 + 8 * fq;
            if (u.pn < 8) {
                const bool isk = u.pn >= 4; const int h = u.pn & 3; const float sc = isk ? 0.0625f : 1.f;
                bf16* base = QK + (isk ? 1024 : 0) + h * 256 + cw;
#pragma unroll
                for (int ai = 0; ai < 2; ++ai) {
                    f32x4 tt[4][4];
#pragma unroll
                    for (int m = 0; m < 4; ++m) { const int row = row0 + ai * 128 + m * 16; const int pi = row < MP ? row % TP : TP;
                        const f32x4* cs = (const f32x4*)(CS + ((size_t)pi * 128 + cw) * 2);
#pragma unroll
                        for (int q4 = 0; q4 < 4; ++q4) tt[m][q4] = cs[q4]; }
#pragma unroll
                    for (int m = 0; m < 4; ++m) {
                        const int row = row0 + ai * 128 + m * 16;
                        const float rs = rtab[u.ord * 256 + (row - u.pm * 256)] * sc;
                        const f32x4 t0 = tt[m][0], t1 = tt[m][1], t2 = tt[m][2], t3 = tt[m][3];
                        const float c[8] = {t0.x, t0.z, t1.x, t1.z, t2.x, t2.z, t3.x, t3.z}, s[8] = {t0.y, t0.w, t1.y, t1.w, t2.y, t2.w, t3.y, t3.w};
                        float o1[8], o2[8];
#pragma unroll
                        for (int n = 0; n < 2; ++n)
#pragma unroll
                            for (int j = 0; j < 4; ++j) {
                                const float x1 = acc[ai][0][m][n][j], x2 = acc[ai][1][m][n][j];
                                o1[n * 4 + j] = (x1 * c[n * 4 + j] - x2 * s[n * 4 + j]) * rs;
                                o2[n * 4 + j] = (x1 * s[n * 4 + j] + x2 * c[n * 4 + j]) * rs;
                            }
                        bf16* rp = base + (size_t)row * 2048;
                        *(v4u*)rp = pack8(o1); *(v4u*)(rp + 128) = pack8(o2);
                    }
                    asm volatile("" ::: "memory");
                }
            } else {
                const bool isg = u.pn >= 16;
                bf16* base = (isg ? SG : V) + ((u.pn - (isg ? 16 : 8)) * 256) + cw;
#pragma unroll
                for (int ai = 0; ai < 2; ++ai)
#pragma unroll
                    for (int m = 0; m < 4; ++m) {
                        bf16* rp = base + (size_t)(row0 + ai * 128 + m * 16) * 2048;
                        const float rs = rtab[u.ord * 256 + (wr * 64 + fr + ai * 128 + m * 16)];
#pragma unroll
                        for (int bj = 0; bj < 2; ++bj) {
                            float o[8];
#pragma unroll
                            for (int n = 0; n < 2; ++n)
#pragma unroll
                                for (int j = 0; j < 4; ++j) { const float x = acc[ai][bj][m][n][j] * rs; o[n * 4 + j] = isg ? siluf_(x) : x; }
                            *(v4u*)(rp + bj * 128) = pack8(o);
                        }
                    }
            }
        } else if (GRP == 0 && kind == EK_RESID) {
            float* X = (float*)(ws + WS_X);
            const int col0 = u.pn * 256 + wc * 32 + 4 * fq;
#pragma unroll
            for (int am = 0; am < 4; ++am) { const int ai = am >> 1, mb = (am & 1) * 2;
                f32x4 xv[2][2][2];
#pragma unroll
                for (int mm = 0; mm < 2; ++mm) { const int m = mb + mm; const float* rp = X + (size_t)(row0 + ai * 128 + m * 16) * D + col0;
#pragma unroll
                    for (int bj = 0; bj < 2; ++bj)
#pragma unroll
                        for (int n = 0; n < 2; ++n) xv[mm][bj][n] = *(const f32x4*)(rp + bj * 128 + n * 16); }
#pragma unroll
                for (int mm = 0; mm < 2; ++mm) { const int m = mb + mm;
                    const int row = row0 + ai * 128 + m * 16;
                    float* rp = X + (size_t)row * D + col0; bf16* xb = (bf16*)(ws + WS_XB) + (size_t)row * D + col0;
                    float ssq = 0.f;
#pragma unroll
                    for (int bj = 0; bj < 2; ++bj)
#pragma unroll
                        for (int n = 0; n < 2; ++n) { const f32x4 v = xv[mm][bj][n] + acc[ai][bj][m][n] * amul; *(f32x4*)(rp + bj * 128 + n * 16) = v;
                            if (slot >= 0) { ssq += (v.x * v.x + v.y * v.y) + (v.z * v.z + v.w * v.w); v2u w; w.x = cvt_pk_bf16(v.x, v.y); w.y = cvt_pk_bf16(v.z, v.w); *(v2u*)(xb + bj * 128 + n * 16) = w; } }
                    if (slot >= 0) { ssq += shfl_xor_l(ssq, 16, fq * 16 + fr); ssq += shfl_xor_l(ssq, 32, fq * 16 + fr); if (fq == 0) ((float*)(ws + WS_SS))[((size_t)slot * M + row) * 16 + u.pn * 4 + wc] = ssq; }
                }
                asm volatile("" ::: "memory");
            }
        } else if (GRP == 1 && kind == EK_UG) {
            const EpiExtra<1>& X1 = *(const EpiExtra<1>*)(const void*)this;
            const float* cw = X1.pcw + (size_t)li * 3 * DFF; const float* cb = X1.pcb + (size_t)li * DFF; const float* cst = X1.pcst + (size_t)li * SB * 2 * DFF;
            float* cvp = X1.pout + O_CVP + (size_t)li * BATCH * 2 * DFF; float* cvs = X1.pout + O_CVS + (size_t)li * SB * 2 * DFF;
            bf16* ACT = (bf16*)(ws + WS_ACT);
            const int fl = wc * 32 + 8 * fq;
            LAS float* halo = (LAS float*)(ldsb + 131072 + 8192);
            const LAS float* rt = rtab + u.ord * 256;
#pragma unroll
            for (int ai = 0; ai < 2; ++ai) if (fr >= 14) {
                const float rs = rt[128 * ai + 64 * wr + 48 + fr];
                LAS float* hp = halo + ((2 * ai + wr) * 2 + (fr - 14)) * 128 + fl;
                *(LAS f32x4*)hp = acc[ai][1][3][0] * rs; *(LAS f32x4*)(hp + 4) = acc[ai][1][3][1] * rs;
            }
            asm volatile("s_waitcnt lgkmcnt(0)" ::: "memory"); __builtin_amdgcn_s_barrier(); asm volatile("" ::: "memory");
            const int R0 = 254 * u.pm - 2, bq = (R0 + 2) / TP, tq = (R0 + 2) - bq * TP;
            const bool plain = (R0 + 255 < MP) && tq >= 2 && tq + 253 < TP - 2;
            if (plain) {
                const bool k15 = fr == 15, k14 = fr >= 14;
#pragma unroll
                for (int n = 0; n < 2; ++n) {
                    const int f0 = u.pn * 128 + fl + 4 * n;
                    const f32x4 w0 = *(const f32x4*)(cw + f0), w1 = *(const f32x4*)(cw + DFF + f0), w2 = *(const f32x4*)(cw + 2 * DFF + f0), bb = *(const f32x4*)(cb + f0);
                    const unsigned ob = (unsigned)((R0 + 64 * wr + fr) * DFF + f0) * 2u;
                    f32x4 prev = (f32x4){0.f, 0.f, 0.f, 0.f};
#pragma unroll
                    for (int ai = 0; ai < 2; ++ai)
#pragma unroll
                        for (int m = 0; m < 4; ++m) {
                            const int l = 128 * ai + 64 * wr + 16 * m + fr;
                            const float rs = rt[l];
                            const f32x4 cur = acc[ai][1][m][n] * rs, uu = acc[ai][0][m][n] * rs;
                            if (m == 0) {
                                const int B = 2 * ai + wr;
                                prev = (f32x4){0.f, 0.f, 0.f, 0.f};
                                if (B > 0 && fr >= 14) prev = *(const LAS f32x4*)(halo + ((B - 1) * 2 + (fr - 14)) * 128 + fl + 4 * n);
                            }
                            float ov[4];
#pragma unroll
                            for (int e = 0; e < 4; ++e) {
                                const float ce = cur[e], pe = prev[e];
                                const float g1 = dpp_mv<0x121>(k15 ? pe : ce), g2 = dpp_mv<0x122>(k14 ? pe : ce);
                                const float cv = fmaf(w0[e], g2, fmaf(w1[e], g1, fmaf(w2[e], ce, bb[e])));
                                ov[e] = siluf_(cv) * uu[e];
                            }
                            v2u w; w.x = cvt_pk_bf16(ov[0], ov[1]); w.y = cvt_pk_bf16(ov[2], ov[3]);
                            if (ai > 0 || m > 0 || l >= 2) *(v2u*)((unsigned char*)ACT + (ob + (unsigned)((128 * ai + 16 * m) * DFF * 2))) = w;
                            prev = cur;
                        }
                }
            } else
#pragma unroll
            for (int n = 0; n < 2; ++n) {
                const int f0 = u.pn * 128 + fl + 4 * n;
                const f32x4 w0 = *(const f32x4*)(cw + f0), w1 = *(const f32x4*)(cw + DFF + f0), w2 = *(const f32x4*)(cw + 2 * DFF + f0), bb = *(const f32x4*)(cb + f0);
                f32x4 prev = (f32x4){0.f, 0.f, 0.f, 0.f};
#pragma unroll
                for (int ai = 0; ai < 2; ++ai)
#pragma unroll
                    for (int m = 0; m < 4; ++m) {
                        const int l = 128 * ai + 64 * wr + 16 * m + fr, row = 254 * u.pm - 2 + l;
                        const float rs = rt[l];
                        const f32x4 cur = acc[ai][1][m][n] * rs, uu = acc[ai][0][m][n] * rs;
                        if (m == 0) {
                            const int B = 2 * ai + wr;
                            prev = (f32x4){0.f, 0.f, 0.f, 0.f};
                            if (B > 0 && fr >= 14) prev = *(const LAS f32x4*)(halo + ((B - 1) * 2 + (fr - 14)) * 128 + fl + 4 * n);
                        }
                        f32x4 g1, g2;
                        {
                            const float c1x = dpp_ror1(cur.x), c1y = dpp_ror1(cur.y), c1z = dpp_ror1(cur.z), c1w = dpp_ror1(cur.w);
                            const float p1x = dpp_ror1(prev.x), p1y = dpp_ror1(prev.y), p1z = dpp_ror1(prev.z), p1w = dpp_ror1(prev.w);
                            const float c2x = dpp_ror2(cur.x), c2y = dpp_ror2(cur.y), c2z = dpp_ror2(cur.z), c2w = dpp_ror2(cur.w);
                            const float p2x = dpp_ror2(prev.x), p2y = dpp_ror2(prev.y), p2z = dpp_ror2(prev.z), p2w = dpp_ror2(prev.w);
                            const bool s1 = fr >= 1, s2 = fr >= 2;
                            g1.x = s1 ? c1x : p1x; g1.y = s1 ? c1y : p1y; g1.z = s1 ? c1z : p1z; g1.w = s1 ? c1w : p1w;
                            g2.x = s2 ? c2x : p2x; g2.y = s2 ? c2y : p2y; g2.z = s2 ? c2z : p2z; g2.w = s2 ? c2w : p2w;
                        }
                        if (l >= 2 && row < M) {
                            if (row < MP) {
                                const int b = row / TP, t = row - b * TP;
                                if (t < 2) { g2 = (f32x4){0.f, 0.f, 0.f, 0.f}; if (t == 0) g1 = g2; }
                                if (t >= TP - 2) *(f32x4*)(cvp + ((size_t)b * 2 + (t - (TP - 2))) * DFF + f0) = cur;
                            } else {
                                const int s = row - MP;
                                const float* c0 = cst + ((size_t)s * 2 + 0) * DFF + f0;
                                g2 = *(const f32x4*)c0; g1 = *(const f32x4*)(c0 + DFF);
                                float* o = cvs + ((size_t)s * 2 + 0) * DFF + f0;
                                *(f32x4*)o = g1; *(f32x4*)(o + DFF) = cur;
                            }
                            const f32x4 cv = bb + w0 * g2 + w1 * g1 + w2 * cur;
                            v2u w; w.x = cvt_pk_bf16(siluf_(cv.x) * uu.x, siluf_(cv.y) * uu.y); w.y = cvt_pk_bf16(siluf_(cv.z) * uu.z, siluf_(cv.w) * uu.w);
                            *(v2u*)(ACT + (size_t)row * DFF + f0) = w;
                        }
                        prev = cur;
                    }
            }
        } else if (GRP == 0 && kind == EK_RWPROJ) {
            const int cw = wc * 32 + 8 * fq;
            if (u.pn < 12) {
                bf16* dst = (bf16*)(ws + (u.pn < 4 ? WS_R : (u.pn < 8 ? WS_K : (jl == 0 ? WS_VF : WS_VB)))) + (u.pn & 3) * 256 + cw;
#pragma unroll
                for (int ai = 0; ai < 2; ++ai)
#pragma unroll
                    for (int m = 0; m < 4; ++m) {
                        bf16* rp = dst + (size_t)(row0 + ai * 128 + m * 16) * D;
#pragma unroll
                        for (int bj = 0; bj < 2; ++bj) { float o[8];
#pragma unroll
                            for (int n = 0; n < 2; ++n)
#pragma unroll
                                for (int j = 0; j < 4; ++j) o[n * 4 + j] = acc[ai][bj][m][n][j];
                            *(v4u*)(rp + bj * 128) = pack8(o); }
                    }
            } else {
                bf16* A2 = (bf16*)(ws + WS_A2);
#pragma unroll
                for (int bj = 0; bj < 2; ++bj) {
                    const int c = (u.pn - 12) * 256 + bj * 128 + cw;
                    if (c < KL2) {
                        const int kd = c < 64 ? 1 : ((c >= 128 && c < 288) ? 2 : 0);
#pragma unroll
                        for (int ai = 0; ai < 2; ++ai)
#pragma unroll
                            for (int m = 0; m < 4; ++m) { float o[8];
#pragma unroll
                                for (int n = 0; n < 2; ++n)
#pragma unroll
                                    for (int j = 0; j < 4; ++j) { const float x = acc[ai][bj][m][n][j]; o[n * 4 + j] = kd == 1 ? tanhf_(x) : (kd == 2 ? sigmoidf_(x) : x); }
                                *(v4u*)(A2 + (size_t)(row0 + ai * 128 + m * 16) * KL2 + c) = pack8(o); }
                    }
                }
            }
        } else if (GRP == 0) {
            bf16* C = (bf16*)(ws + WS_L2);
            const int col0 = u.pn * 256 + wc * 32 + 8 * fq;
#pragma unroll
            for (int ai = 0; ai < 2; ++ai)
#pragma unroll
                for (int m = 0; m < 4; ++m) {
                    bf16* rp = C + (size_t)(row0 + ai * 128 + m * 16) * NL2 + col0;
#pragma unroll
                    for (int bj = 0; bj < 2; ++bj) { float o[8];
#pragma unroll
                        for (int n = 0; n < 2; ++n)
#pragma unroll
                            for (int j = 0; j < 4; ++j) o[n * 4 + j] = acc[ai][bj][m][n][j];
                        *(v4u*)(rp + bj * 128) = pack8(o); }
                }
        }
    }
};

constexpr int MT0 = 16384;
__device__ __forceinline__ void tail_resid(const bf16* __restrict__ A, const bf16* __restrict__ Bt, int K, unsigned char* ws, int slot, float amul, LAS unsigned char* lds, int lane, int wave) {
    const int fr = lane & 15, fq = lane >> 4;
    float* X = (float*)(ws + WS_X);
    const int kw = K >> 3;
    for (int job = blockIdx.x; job < 16 * 16; job += gridDim.x) {
        const int rs = job >> 4, cs = job & 15;
        const bf16* ap = A + (size_t)(MT0 + 16 * rs + fr) * K + wave * kw + 8 * fq;
        const bf16* bp = Bt + (size_t)(64 * cs + fr) * K + wave * kw + 8 * fq;
        f32x4 acc[4];
#pragma unroll
        for (int t = 0; t < 4; ++t) acc[t] = (f32x4){0.f, 0.f, 0.f, 0.f};
#pragma unroll 4
        for (int k0 = 0; k0 < kw; k0 += 32) {
            const bf16x8 af = *(const bf16x8*)(ap + k0);
#pragma unroll
            for (int t = 0; t < 4; ++t) { const bf16x8 bf = *(const bf16x8*)(bp + (size_t)(16 * t) * K + k0); acc[t] = __builtin_amdgcn_mfma_f32_16x16x32_bf16(bf, af, acc[t], 0, 0, 0); }
        }
        __syncthreads();
#pragma unroll
        for (int t = 0; t < 4; ++t) *(LAS f32x4*)(lds + ((wave * 4 + t) * 64 + lane) * 16) = acc[t];
        __syncthreads();
        if (wave == 0) {
#pragma unroll
            for (int t = 0; t < 4; ++t) { f32x4 s = acc[t];
#pragma unroll
                for (int w = 1; w < 8; ++w) s += *(LAS f32x4*)(lds + ((w * 4 + t) * 64 + lane) * 16);
                acc[t] = s; }
            const int row = MT0 + 16 * rs + fr;
            float* rp = X + (size_t)row * D + 64 * cs + 4 * fq; bf16* xb = (bf16*)(ws + WS_XB) + (size_t)row * D + 64 * cs + 4 * fq;
            float ssq = 0.f;
#pragma unroll
            for (int t = 0; t < 4; ++t) { const f32x4 v = *(const f32x4*)(rp + 16 * t) + acc[t] * amul; *(f32x4*)(rp + 16 * t) = v;
                if (slot >= 0) { ssq += (v.x * v.x + v.y * v.y) + (v.z * v.z + v.w * v.w); v2u w; w.x = cvt_pk_bf16(v.x, v.y); w.y = cvt_pk_bf16(v.z, v.w); *(v2u*)(xb + 16 * t) = w; } }
            if (slot >= 0) { ssq += shfl_xor_l(ssq, 16, lane); ssq += shfl_xor_l(ssq, 32, lane); if (fq == 0) ((float*)(ws + WS_SS))[((size_t)slot * M + row) * 16 + cs] = ssq; }
        }
    }
}

__device__ __forceinline__ void tr_item(const float* __restrict__ W, int ldw, int k0, int n0, bf16* __restrict__ WT, int ldt, int drow, const float* __restrict__ mu, LAS float* scr, int lane, const float* __restrict__ gs = nullptr) {
#pragma unroll 8
    for (int i = 0; i < 32; ++i) { const int kk = 2 * i + (lane >> 5); scr[kk * 33 + (lane & 31)] = W[(size_t)(k0 + kk) * ldw + n0 + (lane & 31)]; }
    asm volatile("s_waitcnt lgkmcnt(0)" ::: "memory");
    const int c = lane & 7;
    float mv[8];
    if (mu) {
#pragma unroll
        for (int e = 0; e < 8; ++e) mv[e] = mu[k0 + 8 * c + e];
    } else if (gs) {
#pragma unroll
        for (int e = 0; e < 8; ++e) mv[e] = gs[k0 + 8 * c + e];
    }
#pragma unroll
    for (int j = 0; j < 4; ++j) {
        const int n = (lane >> 3) + 8 * j; const LAS float* s = scr + (8 * c) * 33 + n;
        float f[8];
#pragma unroll
        for (int e = 0; e < 8; ++e) f[e] = s[e * 33];
        bf16* dp = WT + (size_t)(drow + n) * ldt + k0 + 8 * c;
        if (mu) {
            float f1[8], f2[8];
#pragma unroll
            for (int e = 0; e < 8; ++e) { f1[e] = f[e] * (1.f - mv[e]); f2[e] = f[e] * mv[e]; }
            *(v4u*)dp = pack8(f1); *(v4u*)(dp + 1024) = pack8(f2);
        } else { if (gs) {
#pragma unroll
            for (int e = 0; e < 8; ++e) f[e] *= mv[e]; }
            *(v4u*)dp = pack8(f); }
    }
    asm volatile("s_waitcnt lgkmcnt(0)" ::: "memory");
}

__device__ __forceinline__ void ph_p0(const Params& p, LAS unsigned char* lds, int tid, int lane, int wave) {
    unsigned char* ws = p.ws;
    LAS float* scr = (LAS float*)(lds + wave * 16384);
    const int gw = blockIdx.x * NWAVES + wave, NGW = gridDim.x * NWAVES;
    constexpr int C_WIN = 2 * 16 * 192, C_WOUT = 2 * 32 * 32, C_RKV = 2 * 3 * 512, C_W1 = 2 * 32, C_A1 = 2 * 32, C_G1 = 2 * 80, C_V1 = 16, C_WO = 2 * 512, C_WUG = 4 * 16 * 176, C_WD = 4 * 44 * 32;
    constexpr int NITEMS = C_WIN + C_WOUT + C_RKV + C_W1 + C_A1 + C_G1 + C_V1 + C_WO + C_WUG + C_WD;
    for (int it = gw; it < NITEMS; it += NGW) {
        int r = it;
        if (r < C_WIN) { const int j = r / 3072, q = r % 3072, kb = q / 192, nb = q % 192;
            tr_item(p.in[I_RWIN] + (size_t)j * D * RWIN, RWIN, 64 * kb, 32 * nb, (bf16*)(ws + WS_WIN + j * SZ_WIN), D, 32 * nb, nullptr, scr, lane, p.in[I_NMIX] + (size_t)(2 * j) * D); continue; }
        r -= C_WIN;
        if (r < C_WOUT) { const int j = r / 1024, q = r % 1024, kb = q / 32, nb = q % 32;
            tr_item(p.in[I_RWOUT] + (size_t)j * RV * D, D, 64 * kb, 32 * nb, (bf16*)(ws + WS_WOUT + j * SZ_WOUT), RV, 32 * nb, nullptr, scr, lane); continue; }
        r -= C_WOUT;
        if (r < C_RKV) { const int j = r / 1536, q = r % 1536, s = q / 512, q2 = q % 512, kb = q2 / 32, nb = q2 % 32, c = (s == 0 ? 0 : (s == 1 ? 2 : 3));
            tr_item(p.in[I_WRKV] + (size_t)(j * 3 + s) * D * D, D, 64 * kb, 32 * nb, (bf16*)(ws + WS_WRW + j * SZ_WRW), KRW, s * 1024 + 32 * nb, p.in[I_MU] + (size_t)(j * 6 + c) * D, scr, lane); continue; }
        r -= C_RKV;
        if (r < C_W1) { const int j = r / 32, q = r % 32, kb = q / 2, nb = q % 2;
            tr_item(p.in[I_W1] + (size_t)j * D * LW, LW, 64 * kb, 32 * nb, (bf16*)(ws + WS_WRW + j * SZ_WRW), KRW, 3072 + 32 * nb, p.in[I_MU] + (size_t)(j * 6 + 1) * D, scr, lane); continue; }
        r -= C_W1;
        if (r < C_A1) { const int j = r / 32, q = r % 32, kb = q / 2, nb = q % 2;
            tr_item(p.in[I_A1] + (size_t)j * D * LA, LA, 64 * kb, 32 * nb, (bf16*)(ws + WS_WRW + j * SZ_WRW), KRW, 3136 + 32 * nb, p.in[I_MU] + (size_t)(j * 6 + 4) * D, scr, lane); continue; }
        r -= C_A1;
        if (r < C_G1) { const int j = r / 80, q = r % 80, kb = q / 5, nb = q % 5;
            tr_item(p.in[I_G1] + (size_t)j * D * LG, LG, 64 * kb, 32 * nb, (bf16*)(ws + WS_WRW + j * SZ_WRW), KRW, 3200 + 32 * nb, p.in[I_MU] + (size_t)(j * 6 + 5) * D, scr, lane); continue; }
        r -= C_G1;
        if (r < C_V1) { const int kb = r;
            tr_item(p.in[I_V1], LV, 64 * kb, 0, (bf16*)(ws + WS_WRW + 1 * SZ_WRW), KRW, 3360, p.in[I_MU] + (size_t)(1 * 6 + 3) * D, scr, lane); continue; }
        r -= C_V1;
        if (r < C_WO) { const int j = r / 512, q = r % 512, kb = q / 32, nb = q % 32;
            tr_item(p.in[I_WO] + (size_t)j * D * D, D, 64 * kb, 32 * nb, (bf16*)(ws + WS_WO + j * SZ_WO), D, 32 * nb, nullptr, scr, lane); continue; }
        r -= C_WO;
        if (r < C_WUG) { const int i = r / 2816, q = r % 2816, kb = q / 176, nb = q % 176, n0 = 32 * nb;
            const int drow = n0 < DFF ? 256 * (n0 / 128) + (n0 % 128) : 256 * ((n0 - DFF) / 128) + 128 + ((n0 - DFF) % 128);
            tr_item(p.in[I_WUG] + (size_t)i * D * 2 * DFF, 2 * DFF, 64 * kb, n0, (bf16*)(ws + WS_WUG + i * SZ_WUG), D, drow, nullptr, scr, lane, p.in[I_NFFN] + (size_t)i * D); continue; }
        r -= C_WUG;
        { const int i = r / 1408, q = r % 1408, kb = q / 32, nb = q % 32;
            tr_item(p.in[I_WD] + (size_t)i * DFF * D, D, 64 * kb, 32 * nb, (bf16*)(ws + WS_WD + i * SZ_WD), DFF, 32 * nb, nullptr, scr, lane); }
    }
    const size_t gt = (size_t)blockIdx.x * NTHR + tid, GT = (size_t)gridDim.x * NTHR;
    for (size_t i = gt; i < (size_t)(224 + 192) * (KRW / 8); i += GT) {
        const int rr = (int)(i / (KRW / 8)), c8 = (int)(i % (KRW / 8));
        const int j = rr < 224 ? 0 : 1, row = rr < 224 ? 3360 + rr : 3392 + (rr - 224);
        *(v4u*)((bf16*)(ws + WS_WRW + j * SZ_WRW) + (size_t)row * KRW + c8 * 8) = (v4u){0u, 0u, 0u, 0u};
    }
    for (size_t i = gt; i < (size_t)2 * NL2 * KL2; i += GT) {
        const int j = (int)(i / ((size_t)NL2 * KL2)); const int rem = (int)(i % ((size_t)NL2 * KL2)); const int n = rem / KL2, k = rem % KL2, grp = n >> 10, nn = n & 1023;
        float v = 0.f;
        if (grp == 0) { if (k < 64) v = p.in[I_W2][((size_t)j * LW + k) * D + nn]; }
        else if (grp == 1) { if (k >= 64 && k < 128) v = p.in[I_A2][((size_t)j * LA + (k - 64)) * D + nn]; }
        else if (grp == 2) { if (k >= 128 && k < 288) v = p.in[I_G2][((size_t)j * LG + (k - 128)) * D + nn]; }
        else { if (j == 1 && k >= 288 && k < 320) v = p.in[I_V2][((size_t)(k - 288)) * D + nn]; }
        ((bf16*)(ws + WS_WL2 + j * SZ_WL2))[(size_t)n * KL2 + k] = (bf16)(cvt_pk_bf16(v, 0.f) & 0xffffu);
    }
    for (size_t i = gt; i < (size_t)(TP + 1) * 128; i += GT) {
        const int pi = (int)(i >> 7), mi = (int)(i & 127);
        const float pos = pi < TP ? (float)pi : PAST_POS;
        const float inv = 1.0f / powf(10000.0f, (float)mi / 127.0f);
        float s, c; sincosf(pos * inv, &s, &c);
        ((float2*)(ws + WS_CS))[i] = make_float2(c, s);
    }
    float* X = (float*)(ws + WS_X); bf16* XB = (bf16*)(ws + WS_XB);
    for (int r = gw; r < M; r += NGW) {
        const float* src;
        if (r < MP) { const int b = r / TP, t = r % TP; src = t < NMETA ? p.in[I_META] + (size_t)t * D : p.in[I_XP] + ((size_t)b * SEQ + (t - NMETA)) * D; }
        else src = p.in[I_XS] + (size_t)(r - MP) * D;
        float ss = 0.f;
#pragma unroll
        for (int j = 0; j < 2; ++j) { const int c0 = 512 * j + 8 * lane;
            const f32x4 a4 = *(const f32x4*)(src + c0), b4 = *(const f32x4*)(src + c0 + 4);
            *(f32x4*)(X + (size_t)r * D + c0) = a4; *(f32x4*)(X + (size_t)r * D + c0 + 4) = b4;
            const float f[8] = {a4.x, a4.y, a4.z, a4.w, b4.x, b4.y, b4.z, b4.w};
#pragma unroll
            for (int e = 0; e < 8; ++e) ss += f[e] * f[e];
            *(v4u*)(XB + (size_t)r * D + c0) = pack8(f); }
        ss = wave_sum(ss, lane);
        if (lane < 16) ((float*)(ws + WS_SS))[(size_t)r * 16 + lane] = lane == 0 ? ss : 0.f;
    }
}

__device__ __forceinline__ void ph_norm(const Params& p, const float* __restrict__ g, int mode, int jl, int lane, int wave) {
    const float* X = (const float*)(p.ws + WS_X); bf16* H = (bf16*)(p.ws + WS_H);
    const int gw = blockIdx.x * NWAVES + wave, NGW = gridDim.x * NWAVES;
    for (int row = gw; row < M; row += NGW) {
        const float* xr = X + (size_t)row * D;
        float v[2][8]; float ss = 0.f;
#pragma unroll
        for (int j = 0; j < 2; ++j) {
            const f32x4 a = *(const f32x4*)(xr + 512 * j + 8 * lane), b = *(const f32x4*)(xr + 512 * j + 8 * lane + 4);
            v[j][0] = a.x; v[j][1] = a.y; v[j][2] = a.z; v[j][3] = a.w; v[j][4] = b.x; v[j][5] = b.y; v[j][6] = b.z; v[j][7] = b.w;
#pragma unroll
            for (int e = 0; e < 8; ++e) ss += v[j][e] * v[j][e];
        }
        ss = wave_sum(ss, lane);
        const float rstd = rsqrtf(ss * (1.f / D) + 1e-6f);
        const bool prompt = row < MP; const int b = prompt ? row / TP : 0, t = prompt ? row % TP : 0;
#pragma unroll
        for (int j = 0; j < 2; ++j) {
            const int c0 = 512 * j + 8 * lane;
            const f32x4 ga = *(const f32x4*)(g + c0), gb = *(const f32x4*)(g + c0 + 4);
            float o[8];
            o[0] = v[j][0] * rstd * ga.x; o[1] = v[j][1] * rstd * ga.y; o[2] = v[j][2] * rstd * ga.z; o[3] = v[j][3] * rstd * ga.w;
            o[4] = v[j][4] * rstd * gb.x; o[5] = v[j][5] * rstd * gb.y; o[6] = v[j][6] * rstd * gb.z; o[7] = v[j][7] * rstd * gb.w;
            if (mode == 0) { *(v4u*)(H + (size_t)row * D + c0) = pack8(o); }
            else if (mode == 1) {
                const v4u w = pack8(o);
                *(v4u*)(H + (size_t)row * 2048 + c0) = w;
                if (prompt) {
                    if (t != TP - 1) *(v4u*)(H + (size_t)(row + 1) * 2048 + 1024 + c0) = w;
                    else { float* so = p.out + O_SHP + ((size_t)jl * BATCH + b) * D + c0; *(f32x4*)so = (f32x4){o[0], o[1], o[2], o[3]}; *(f32x4*)(so + 4) = (f32x4){o[4], o[5], o[6], o[7]}; }
                    if (t == 0) *(v4u*)(H + (size_t)row * 2048 + 1024 + c0) = (v4u){0u, 0u, 0u, 0u};
                } else {
                    const int s = row - MP;
                    const float* sp = p.in[I_SSHIFT] + ((size_t)jl * SB + s) * D + c0;
                    const f32x4 sa = *(const f32x4*)sp, sb2 = *(const f32x4*)(sp + 4);
                    const float pv[8] = {sa.x, sa.y, sa.z, sa.w, sb2.x, sb2.y, sb2.z, sb2.w};
                    *(v4u*)(H + (size_t)row * 2048 + 1024 + c0) = pack8(pv);
                    float* so = p.out + O_SHS + ((size_t)jl * SB + s) * D + c0; *(f32x4*)so = (f32x4){o[0], o[1], o[2], o[3]}; *(f32x4*)(so + 4) = (f32x4){o[4], o[5], o[6], o[7]};
                }
            } else {
                float* dst = nullptr;
                if (prompt) { if (t >= NMETA) dst = p.out + O_YP + ((size_t)b * SEQ + (t - NMETA)) * D + c0; }
                else dst = p.out + O_YS + (size_t)(row - MP) * D + c0;
                if (dst) { *(f32x4*)dst = (f32x4){o[0], o[1], o[2], o[3]}; *(f32x4*)(dst + 4) = (f32x4){o[4], o[5], o[6], o[7]}; }
            }
        }
    }
}

__device__ __forceinline__ void ph_ret_norm(const Params& p, int jl, int lane, int wave) {
    const float* O = (const float*)(p.ws + WS_O); const bf16* SG = (const bf16*)(p.ws + WS_SG); bf16* Y = (bf16*)(p.ws + WS_Y);
    const float* gnw = p.in[I_RGN] + (size_t)jl * RV;
    const int gw = blockIdx.x * NWAVES + wave, NGW = gridDim.x * NWAVES;
    constexpr int UB = 4;
    for (int it0 = gw; it0 < M * RH; it0 += NGW * UB) {
        const int h = it0 & 3;
        const f32x4 ga = *(const f32x4*)(gnw + h * RDV + 8 * lane), gb = *(const f32x4*)(gnw + h * RDV + 8 * lane + 4);
        const float gg[8] = {ga.x, ga.y, ga.z, ga.w, gb.x, gb.y, gb.z, gb.w};
        f32x4 a[UB], b[UB]; v4u sgv[UB];
#pragma unroll
        for (int q = 0; q < UB; ++q) { const int it = it0 + q * NGW, itc = it < M * RH ? it : it0; const size_t off = (size_t)(itc >> 2) * RV + h * RDV + 8 * lane;
            a[q] = *(const f32x4*)(O + off); b[q] = *(const f32x4*)(O + off + 4); sgv[q] = *(const v4u*)(SG + off); }
#pragma unroll
        for (int q = 0; q < UB; ++q) { const int it = it0 + q * NGW; const size_t off = (size_t)(it >> 2) * RV + h * RDV + 8 * lane;
            float v[8] = {a[q].x, a[q].y, a[q].z, a[q].w, b[q].x, b[q].y, b[q].z, b[q].w};
            float s = 0.f;
#pragma unroll
            for (int e = 0; e < 8; ++e) s += v[e];
            const float mean = wave_sum(s, lane) * (1.f / RDV);
            float s2 = 0.f;
#pragma unroll
            for (int e = 0; e < 8; ++e) { v[e] -= mean; s2 += v[e] * v[e]; }
            const float rstd = rsqrtf(wave_sum(s2, lane) * (1.f / RDV) + 1e-5f);
            float sg[8]; unpack8(sgv[q], sg);
            float o[8];
#pragma unroll
            for (int e = 0; e < 8; ++e) o[e] = v[e] * rstd * gg[e] * sg[e];
            if (it < M * RH) *(v4u*)(Y + off) = pack8(o);
        }
    }
}

__device__ __forceinline__ float row16_sum(float x);
__device__ __forceinline__ void ph_rwkv_post(const Params& p, int jl, int lane, int wave) {
    const float* YW = (const float*)(p.ws + WS_YW); const bf16* R = (const bf16*)(p.ws + WS_R); const bf16* KM = (const bf16*)(p.ws + WS_NKK);
    const bf16* VP = (const bf16*)(p.ws + WS_KKA); const bf16* L2 = (const bf16*)(p.ws + WS_L2); bf16* Z = (bf16*)(p.ws + WS_Z);
    const float* rk = p.in[I_RK] + (size_t)jl * D; const float* lnw = p.in[I_LNW] + (size_t)jl * D; const float* lnb = p.in[I_LNB] + (size_t)jl * D;
    const int gw = blockIdx.x * NWAVES + wave, NGW = gridDim.x * NWAVES;
    const int sub = lane >> 4, c4 = lane & 15;
    constexpr int UB = 4;
    for (int it0 = gw * 4; it0 < M * WH; it0 += NGW * 4 * UB) {
        const int h = (it0 + sub) & 15, c = h * WN + 4 * c4;
        const f32x4 rk4 = *(const f32x4*)(rk + c), lw4 = *(const f32x4*)(lnw + c), lb4 = *(const f32x4*)(lnb + c);
        f32x4 yv[UB]; v2u r2[UB], k2[UB], v2[UB], g2[UB];
#pragma unroll
        for (int q = 0; q < UB; ++q) { const int it = it0 + q * NGW * 4 + sub, itc = it < M * WH ? it : it0 + sub, row = itc >> 4; const size_t idx = (size_t)row * D + c;
            yv[q] = *(const f32x4*)(YW + idx); r2[q] = *(const v2u*)(R + idx); k2[q] = *(const v2u*)(KM + idx); v2[q] = *(const v2u*)(VP + idx); g2[q] = *(const v2u*)(L2 + (size_t)row * NL2 + 2048 + c); }
#pragma unroll
        for (int q = 0; q < UB; ++q) { const int it = it0 + q * NGW * 4 + sub, row = it >> 4; const size_t idx = (size_t)row * D + c;
            const f32x4 r4 = (f32x4){bf_lo(r2[q].x), bf_hi(r2[q].x), bf_lo(r2[q].y), bf_hi(r2[q].y)}, k4 = (f32x4){bf_lo(k2[q].x), bf_hi(k2[q].x), bf_lo(k2[q].y), bf_hi(k2[q].y)};
            const f32x4 v4 = (f32x4){bf_lo(v2[q].x), bf_hi(v2[q].x), bf_lo(v2[q].y), bf_hi(v2[q].y)}, g4 = (f32x4){bf_lo(g2[q].x), bf_hi(g2[q].x), bf_lo(g2[q].y), bf_hi(g2[q].y)};
            const float mean = row16_sum((yv[q].x + yv[q].y) + (yv[q].z + yv[q].w)) * (1.f / WN);
            const f32x4 yc = yv[q] - mean;
            const float rstd = rsqrtf(row16_sum((yc.x * yc.x + yc.y * yc.y) + (yc.z * yc.z + yc.w * yc.w)) * (1.f / WN) + 64e-5f);
            const f32x4 rkk = r4 * k4 * rk4;
            const float bon = row16_sum((rkk.x + rkk.y) + (rkk.z + rkk.w));
            const f32x4 z = (yc * rstd * lw4 + lb4 + v4 * bon) * g4;
            if (it < M * WH) st_bf4(Z + idx, z);
        }
    }
}

constexpr int RT_KP = 528, RT_VP = 144, RT_SP = 528;
constexpr int RT_K_OFF = 0, RT_V_OFF = 128 * RT_KP, RT_ST_OFF = RT_V_OFF + 128 * RT_VP, RT_END = RT_ST_OFF + 64 * RT_SP;
static_assert(RT_END <= LDS_BYTES, "retention LDS map");
typedef short v4s __attribute__((ext_vector_type(4)));
__device__ __forceinline__ bf16x8 tr_pair(LAS unsigned char* a0, LAS unsigned char* a1) {
    const v4s lo = __builtin_amdgcn_ds_read_tr16_b64_v4i16((LAS v4s*)a0), hi = __builtin_amdgcn_ds_read_tr16_b64_v4i16((LAS v4s*)a1);
    return __builtin_shufflevector(lo, hi, 0, 1, 2, 3, 4, 5, 6, 7);
}
__device__ __forceinline__ void ph_ret_fast(const Params& p, int jl, LAS unsigned char* lds, int tid, int lane, int wave) {
    const bf16* QK = (const bf16*)(p.ws + WS_QK); const bf16* V = (const bf16*)(p.ws + WS_V); float* O = (float*)(p.ws + WS_O);
    const int fr = lane & 15, fq = lane >> 4, li_q = (lane & 15) >> 2, li_p = lane & 3;
    for (int u = blockIdx.x; u < BATCH * RH * 8; u += gridDim.x) {
        const int es = u & 7, h = (u >> 3) & 3, b = u >> 5;
        const float gamma = 1.0f - exp2f(-5.0f - (float)h), lg = log2f(gamma), g128 = exp2f(128.f * lg), g127 = exp2f(127.f * lg);
        const int i0 = 16 * wave, d0 = 32 * wave;
        f32x4 Sacc[2][4];
#pragma unroll
        for (int a = 0; a < 2; ++a)
#pragma unroll
            for (int c = 0; c < 4; ++c) Sacc[a][c] = (f32x4){0.f, 0.f, 0.f, 0.f};
        __syncthreads();
        for (int i = tid; i < 64 * RT_SP / 16; i += NTHR) *(LAS v4u*)(lds + RT_ST_OFF + i * 16) = (v4u){0u, 0u, 0u, 0u};
        v4u kst[8], vst[2];
        const bf16* Kg = QK + 1024 + 256 * h; const bf16* Vg = V + 512 * h + 64 * es; const bf16* Qg = QK + 256 * h;
#define RT_LOAD_STAGE(cc) do { \
            _Pragma("unroll") for (int k_ = 0; k_ < 8; ++k_) { const int id_ = tid + 512 * k_, row_ = id_ >> 5, ch_ = id_ & 31, t_ = 128 * (cc) - 112 + row_; \
                kst[k_] = t_ >= 0 ? *(const v4u*)(Kg + (size_t)(b * TP + t_) * 2048 + 8 * ch_) : (v4u){0u, 0u, 0u, 0u}; } \
            _Pragma("unroll") for (int k_ = 0; k_ < 2; ++k_) { const int id_ = tid + 512 * k_, row_ = id_ >> 3, ch_ = id_ & 7, t_ = 128 * (cc) - 112 + row_; \
                vst[k_] = t_ >= 0 ? *(const v4u*)(Vg + (size_t)(b * TP + t_) * 2048 + 8 * ch_) : (v4u){0u, 0u, 0u, 0u}; } } while (0)
        RT_LOAD_STAGE(0);
        for (int c = 0; c < 17; ++c) {
            __syncthreads();
#pragma unroll
            for (int k_ = 0; k_ < 8; ++k_) { const int id_ = tid + 512 * k_, row_ = id_ >> 5, ch_ = id_ & 31; *(LAS v4u*)(lds + RT_K_OFF + row_ * RT_KP + ch_ * 16) = kst[k_]; }
#pragma unroll
            for (int k_ = 0; k_ < 2; ++k_) { const int id_ = tid + 512 * k_, row_ = id_ >> 3, ch_ = id_ & 7;
                float f[8]; unpack8(vst[k_], f); const float sc = exp2f(-(float)row_ * lg);
#pragma unroll
                for (int e = 0; e < 8; ++e) f[e] *= sc;
                *(LAS v4u*)(lds + RT_V_OFF + row_ * RT_VP + ch_ * 16) = pack8(f); }
            bf16x8 Qf[8];
            { const int t_ = 128 * c - 112 + i0 + fr;
#pragma unroll
              for (int s = 0; s < 8; ++s) Qf[s] = t_ >= 0 ? *(const bf16x8*)(Qg + (size_t)(b * TP + t_) * 2048 + 32 * s + 8 * fq) : (bf16x8){0, 0, 0, 0, 0, 0, 0, 0}; }
            __syncthreads();
            bf16x8 Pf[4];
            { const int ii = i0 + fr; const float gi = exp2f((float)ii * lg);
#pragma unroll
              for (int s2 = 0; s2 < 4; ++s2) { f32x4 Dp[2];
#pragma unroll
                  for (int hh = 0; hh < 2; ++hh) { Dp[hh] = (f32x4){0.f, 0.f, 0.f, 0.f};
#pragma unroll
                      for (int s = 0; s < 8; ++s) { const bf16x8 Kf = *(const LAS bf16x8*)(lds + RT_K_OFF + (16 * (2 * s2 + hh) + fr) * RT_KP + (32 * s + 8 * fq) * 2);
                          Dp[hh] = __builtin_amdgcn_mfma_f32_16x16x32_bf16(Kf, Qf[s], Dp[hh], 0, 0, 0); } }
                  float f[8];
#pragma unroll
                  for (int hh = 0; hh < 2; ++hh)
#pragma unroll
                      for (int r = 0; r < 4; ++r) { const int jj = 16 * (2 * s2 + hh) + 4 * fq + r; f[hh * 4 + r] = ii >= jj ? Dp[hh][r] * gi : 0.f; }
                  const v4u w = pack8(f); Pf[s2] = __builtin_bit_cast(bf16x8, w); } }
            f32x4 Oacc[4];
#pragma unroll
            for (int et = 0; et < 4; ++et) { Oacc[et] = (f32x4){0.f, 0.f, 0.f, 0.f};
#pragma unroll
                for (int s = 0; s < 8; ++s) { const bf16x8 Sf = *(const LAS bf16x8*)(lds + RT_ST_OFF + (16 * et + fr) * RT_SP + (32 * s + 8 * fq) * 2);
                    Oacc[et] = __builtin_amdgcn_mfma_f32_16x16x32_bf16(Qf[s], Sf, Oacc[et], 0, 0, 0); } }
            __syncthreads();
            if (c + 1 < 17) RT_LOAD_STAGE(c + 1);
#pragma unroll
            for (int r = 0; r < 4; ++r) { const float lam = exp2f((float)(i0 + 4 * fq + r + 1) * lg);
#pragma unroll
                for (int et = 0; et < 4; ++et) Oacc[et][r] *= lam; }
#pragma unroll
            for (int et = 0; et < 4; ++et)
#pragma unroll
                for (int s = 0; s < 4; ++s) {
                    LAS unsigned char* a0 = lds + RT_V_OFF + (32 * s + 4 * fq + li_q) * RT_VP + (16 * et + 4 * li_p) * 2;
                    const bf16x8 Vf = tr_pair(a0, a0 + 16 * RT_VP);
                    Oacc[et] = __builtin_amdgcn_mfma_f32_16x16x32_bf16(Pf[s], Vf, Oacc[et], 0, 0, 0); }
#pragma unroll
            for (int r = 0; r < 4; ++r) { const int t_ = 128 * c - 112 + i0 + 4 * fq + r;
                if (t_ >= 0) { float* op = O + (size_t)(b * TP + t_) * RV + 512 * h + 64 * es + fr;
#pragma unroll
                    for (int et = 0; et < 4; ++et) op[16 * et] = Oacc[et][r]; } }
#pragma unroll
            for (int dt = 0; dt < 2; ++dt)
#pragma unroll
                for (int et = 0; et < 4; ++et) Sacc[dt][et] = Sacc[dt][et] * (g128 / g127);
#pragma unroll
            for (int s = 0; s < 4; ++s) {
                bf16x8 Kt[2], Vt[4];
#pragma unroll
                for (int dt = 0; dt < 2; ++dt) { LAS unsigned char* a0 = lds + RT_K_OFF + (32 * s + 8 * fq + li_q) * RT_KP + (d0 + 16 * dt + 4 * li_p) * 2; Kt[dt] = tr_pair(a0, a0 + 4 * RT_KP); }
#pragma unroll
                for (int et = 0; et < 4; ++et) { LAS unsigned char* a0 = lds + RT_V_OFF + (32 * s + 8 * fq + li_q) * RT_VP + (16 * et + 4 * li_p) * 2; Vt[et] = tr_pair(a0, a0 + 4 * RT_VP); }
#pragma unroll
                for (int dt = 0; dt < 2; ++dt)
#pragma unroll
                    for (int et = 0; et < 4; ++et) Sacc[dt][et] = __builtin_amdgcn_mfma_f32_16x16x32_bf16(Kt[dt], Vt[et], Sacc[dt][et], 0, 0, 0);
            }
#pragma unroll
            for (int dt = 0; dt < 2; ++dt)
#pragma unroll
                for (int et = 0; et < 4; ++et) Sacc[dt][et] = Sacc[dt][et] * g127;
#pragma unroll
            for (int dt = 0; dt < 2; ++dt)
#pragma unroll
                for (int et = 0; et < 4; ++et) { v2u w; w.x = cvt_pk_bf16(Sacc[dt][et][0], Sacc[dt][et][1]); w.y = cvt_pk_bf16(Sacc[dt][et][2], Sacc[dt][et][3]);
                    *(LAS v2u*)(lds + RT_ST_OFF + (16 * et + fr) * RT_SP + (d0 + 16 * dt + 4 * fq) * 2) = w; }
        }
#undef RT_LOAD_STAGE
        float* so = p.out + O_RETP + ((((size_t)jl * BATCH + b) * RH + h) * RDK) * RDV + 64 * es;
#pragma unroll
        for (int dt = 0; dt < 2; ++dt)
#pragma unroll
            for (int et = 0; et < 4; ++et)
#pragma unroll
                for (int r = 0; r < 4; ++r) so[(size_t)(d0 + 16 * dt + 4 * fq + r) * RDV + 16 * et + fr] = Sacc[dt][et][r];
    }
    {
        LAS float* sq = (LAS float*)lds; LAS float* sk = sq + 256; LAS float* red = sk + 256;
        const int e4 = tid & 127, dq = tid >> 7;
        for (int it = blockIdx.x; it < SB * RH; it += gridDim.x) {
            const int h = it & 3, s = it >> 2, row = MP + s;
            const float gamma = 1.0f - exp2f(-5.0f - (float)h);
            __syncthreads();
            if (tid < 256) sq[tid] = bf_lo((unsigned)QK[(size_t)row * 2048 + 256 * h + tid]);
            else sk[tid - 256] = bf_lo((unsigned)QK[(size_t)row * 2048 + 1024 + 256 * h + (tid - 256)]);
            const v2u vv = *(const v2u*)(V + (size_t)row * 2048 + 512 * h + 4 * e4);
            const f32x4 v4 = (f32x4){bf_lo(vv.x), bf_hi(vv.x), bf_lo(vv.y), bf_hi(vv.y)};
            __syncthreads();
            const float* sin_ = p.in[I_SRET] + ((((size_t)jl * SB + s) * RH + h) * RDK) * RDV + 4 * e4;
            float* sout = p.out + O_RETS + ((((size_t)jl * SB + s) * RH + h) * RDK) * RDV + 4 * e4;
            f32x4 oacc = (f32x4){0.f, 0.f, 0.f, 0.f};
#pragma unroll 8
            for (int k = 0; k < 64; ++k) { const int d = dq + 4 * k;
                const f32x4 sv = __builtin_nontemporal_load((const f32x4*)(sin_ + (size_t)d * RDV));
                const f32x4 sn = sv * gamma + v4 * sk[d];
                oacc += sn * sq[d];
                __builtin_nontemporal_store(sn, (f32x4*)(sout + (size_t)d * RDV)); }
            *(LAS f32x4*)(red + dq * 512 + 4 * e4) = oacc;
            __syncthreads();
            if (dq == 0) { const f32x4 r = (*(LAS f32x4*)(red + 4 * e4) + *(LAS f32x4*)(red + 512 + 4 * e4)) + (*(LAS f32x4*)(red + 1024 + 4 * e4) + *(LAS f32x4*)(red + 1536 + 4 * e4));
                *(f32x4*)(O + (size_t)row * RV + 512 * h + 4 * e4) = r; }
        }
    }
}

typedef float f32x2w __attribute__((ext_vector_type(2)));
constexpr int WK_TB = 32, WK_STEP_B = 6 * 256 + 16, WK_BUF_B = WK_TB * WK_STEP_B, WK_Y_OFF = 2 * WK_BUF_B, WK_YB_B = WK_TB * 32 * 4;
static_assert(WK_Y_OFF + 2 * WK_YB_B <= LDS_BYTES - 16, "wkv LDS map");
__device__ __forceinline__ float row16_sum(float x) {
    x += __builtin_bit_cast(float, __builtin_amdgcn_update_dpp(0, __builtin_bit_cast(int, x), 0x128, 0xf, 0xf, false));
    x += __builtin_bit_cast(float, __builtin_amdgcn_update_dpp(0, __builtin_bit_cast(int, x), 0x124, 0xf, 0xf, false));
    x += __builtin_bit_cast(float, __builtin_amdgcn_update_dpp(0, __builtin_bit_cast(int, x), 0x122, 0xf, 0xf, false));
    x += __builtin_bit_cast(float, __builtin_amdgcn_update_dpp(0, __builtin_bit_cast(int, x), 0x121, 0xf, 0xf, false));
    return x;
}
__device__ __forceinline__ float half8_sum(float x) {
    x += __builtin_bit_cast(float, __builtin_amdgcn_update_dpp(0, __builtin_bit_cast(int, x), 0x141, 0xf, 0xf, false));
    x += __builtin_bit_cast(float, __builtin_amdgcn_update_dpp(0, __builtin_bit_cast(int, x), 0xB1, 0xf, 0xf, false));
    x += __builtin_bit_cast(float, __builtin_amdgcn_update_dpp(0, __builtin_bit_cast(int, x), 0x4E, 0xf, 0xf, false));
    return x;
}
struct WkPar { f32x4 w0, a0, kkp, kap, v0; };
__device__ __forceinline__ f32x4 wk_unit_neg(const f32x4 kraw, const f32x4 kkp) {
    const f32x4 kk = kraw * kkp;
    const float ss = row16_sum((kk.x * kk.x + kk.y * kk.y) + (kk.z * kk.z + kk.w * kk.w));
    return kk * (-rsqrtf(fmaxf(ss, 1e-12f)));
}
__device__ __forceinline__ float wk_decay(float x) { return __expf(-0.60653065971263342f * sigmoidf_(x)); }
__device__ __forceinline__ void wk_prep(const WkPar& P, const f32x4 kraw, const f32x4 vraw, const f32x4 lw2, const f32x4 la2, const f32x4 vf, const f32x4 lv2, bool vres,
                                        f32x4& w, f32x4& ka, f32x4& km, f32x4& vp, f32x4& nk) {
    nk = wk_unit_neg(kraw, P.kkp);
    w = (f32x4){wk_decay(P.w0.x + lw2.x), wk_decay(P.w0.y + lw2.y), wk_decay(P.w0.z + lw2.z), wk_decay(P.w0.w + lw2.w)};
    const f32x4 a = (f32x4){sigmoidf_(P.a0.x + la2.x), sigmoidf_(P.a0.y + la2.y), sigmoidf_(P.a0.z + la2.z), sigmoidf_(P.a0.w + la2.w)};
    ka = nk * (-a);
    km = kraw * ((a - 1.f) * P.kap + 1.f);
    vp = vraw;
    if (vres) { const f32x4 sg = (f32x4){sigmoidf_(P.v0.x + lv2.x), sigmoidf_(P.v0.y + lv2.y), sigmoidf_(P.v0.z + lv2.z), sigmoidf_(P.v0.w + lv2.w)}; vp = vraw + (vf - vraw) * sg; }
}
constexpr int WC_C = 16, WC_NCH = TP / WC_C;
static_assert(WC_NCH * WC_C == TP, "chunking");
constexpr int REC_WA = 0, REC_RP = 2048, REC_BK = 4096, REC_VV = 8192, REC_TK = 10240, REC_MY = 10752, REC_GC = 11264, REC_BYTES = 11520;
constexpr size_t WS_REC = WS_END;
constexpr size_t WS_END2 = WS_REC + (size_t)BATCH * WH * WC_NCH * REC_BYTES;
__device__ __forceinline__ unsigned bf_rne_c(float f) { unsigned u = __float_as_uint(f); return (u + 0x7fffu + ((u >> 16) & 1u)) >> 16; }
__device__ __forceinline__ unsigned pk2_c(float lo, float hi) { return bf_rne_c(lo) | (bf_rne_c(hi) << 16); }
__device__ __forceinline__ float bf_rd(const bf16* q) { return __uint_as_float((unsigned)(*q) << 16); }
__device__ __forceinline__ bf16 bf_of(float x) { return (bf16)(cvt_pk_bf16(x, 0.f) & 0xffffu); }

typedef __bf16 bf4v __attribute__((ext_vector_type(4)));
__device__ __forceinline__ v2u pk4(const f32x4 v) { return __builtin_bit_cast(v2u, __builtin_convertvector(v, bf4v)); }
__device__ __forceinline__ f32x4 mm16(const v2u a, const v2u b, const f32x4 c) { return __builtin_amdgcn_mfma_f32_16x16x16bf16_1k(__builtin_bit_cast(v4s, a), __builtin_bit_cast(v4s, b), c, 0, 0, 0); }
__device__ __forceinline__ f32x4 mm32(const v2u a0, const v2u a1, const v2u b0, const v2u b1, const f32x4 c) {
    const v4u a = (v4u){a0.x, a0.y, a1.x, a1.y}, b = (v4u){b0.x, b0.y, b1.x, b1.y};
    return __builtin_amdgcn_mfma_f32_16x16x32_bf16(__builtin_bit_cast(bf16x8, a), __builtin_bit_cast(bf16x8, b), c, 0, 0, 0);
}
template <int CTRL> __device__ __forceinline__ float dppz(float x) { return __int_as_float(__builtin_amdgcn_update_dpp(0, __float_as_int(x), CTRL, 0xf, 0xf, true)); }
__device__ __forceinline__ float psum16(float x) { x += dppz<0x111>(x); x += dppz<0x112>(x); x += dppz<0x114>(x); x += dppz<0x118>(x); return x; }
__device__ __forceinline__ v2u tr16(LAS unsigned char* a) { return __builtin_bit_cast(v2u, __builtin_amdgcn_ds_read_tr16_b64_v4i16((LAS v4s*)a)); }
__device__ __forceinline__ void ph_wkv1(const Params& p, int jl, LAS unsigned char* lds, int lane_in, int wave) {
    const bf16* Kr = (const bf16*)(p.ws + WS_K); const bf16* Vr = (const bf16*)(p.ws + (jl == 0 ? WS_VF : WS_VB)); const bf16* VFp = (const bf16*)(p.ws + WS_VF);
    const bf16* Rr = (const bf16*)(p.ws + WS_R); const bf16* L2 = (const bf16*)(p.ws + WS_L2);
    bf16* KM = (bf16*)(p.ws + WS_NKK); bf16* VP = (bf16*)(p.ws + WS_KKA);
    const bool vres = jl == 1;
    constexpr int IMG = 16 * 144;
    constexpr float CL2 = 0.60653065971263342f * 1.4426950408889634f;
    const int gw = wave * gridDim.x + blockIdx.x, NGW = gridDim.x * NWAVES;
    for (int job = gw; job < BATCH * WH * WC_NCH; job += NGW) {
        int ln = lane_in; asm volatile("" : "+v"(ln));
        const int lane = ln, fr = lane & 15, fq = lane >> 4;
        const int c = job % WC_NCH, sh = job / WC_NCH, h = sh & 15, seq = sh >> 4, r0 = seq * TP + WC_C * c, chb = h * WN + 4 * fq;
        LAS unsigned char* sc = lds + wave * 16384;
        unsigned char* rec = p.ws + WS_REC + (size_t)job * REC_BYTES;
        const size_t ro = (size_t)(r0 + fr) * D + chb, lo = (size_t)(r0 + fr) * NL2 + chb, po = (size_t)jl * D + chb;
        f32x4 kraw[4], kk[4];
        float ss = 0.f;
#pragma unroll
        for (int jt = 0; jt < 4; ++jt) { kraw[jt] = ld_bf4(Kr + ro + 16 * jt); kk[jt] = kraw[jt] * *(const f32x4*)(p.in[I_KK] + po + 16 * jt);
            ss += (kk[jt].x * kk[jt].x + kk[jt].y * kk[jt].y) + (kk[jt].z * kk[jt].z + kk[jt].w * kk[jt].w); }
        ss += shfl_xor_l(ss, 16, lane); ss += shfl_xor_l(ss, 32, lane);
        const float inv = rsqrtf(fmaxf(ss, 1e-12f));
        v2u pa[4], pb[4], pk[4], pr[4]; f32x4 rt[4];
        LAS unsigned char* iw = sc + fr * 144 + 8 * fq;
#pragma unroll
        for (int jt = 0; jt < 4; ++jt) {
            const f32x4 lw2 = ld_bf4(L2 + lo + 16 * jt), la2 = ld_bf4(L2 + lo + 1024 + 16 * jt), rr = ld_bf4(Rr + ro + 16 * jt), vraw = ld_bf4(Vr + ro + 16 * jt);
            const f32x4 pw0 = *(const f32x4*)(p.in[I_W0] + po + 16 * jt), pa0 = *(const f32x4*)(p.in[I_A0] + po + 16 * jt), pka = *(const f32x4*)(p.in[I_KA] + po + 16 * jt);
            f32x4 vp = vraw;
            if (vres) { const f32x4 vf = ld_bf4(VFp + ro + 16 * jt), lv2 = ld_bf4(L2 + lo + 3072 + 16 * jt), pv0 = *(const f32x4*)(p.in[I_V0] + chb + 16 * jt);
#pragma unroll
                for (int e = 0; e < 4; ++e) vp[e] = vraw[e] + (vf[e] - vraw[e]) * sigmoidf_(pv0[e] + lv2[e]); }
            f32x4 at, bt, kt, kq, rq, gg;
#pragma unroll
            for (int e = 0; e < 4; ++e) {
                const float a = sigmoidf_(pa0[e] + la2[e]), d = CL2 * sigmoidf_(pw0[e] + lw2[e]), cum = psum16(d);
                const float g = __builtin_amdgcn_exp2f(-cum), ig = __builtin_amdgcn_exp2f(cum), gp = __builtin_amdgcn_exp2f(d - cum), nk = -kk[jt][e] * inv;
                kt[e] = kraw[jt][e] * (1.f + (a - 1.f) * pka[e]);
                at[e] = nk * gp; bt[e] = -nk * a * ig; kq[e] = kt[e] * ig; rq[e] = rr[e] * g; gg[e] = g;
            }
            st_bf4(KM + ro + 16 * jt, kt); st_bf4(VP + ro + 16 * jt, vp);
            if (fr == 15) *(f32x4*)(rec + REC_GC + (16 * jt + 4 * fq) * 4) = gg;
            pa[jt] = pk4(at); pb[jt] = pk4(bt); pk[jt] = pk4(kq); pr[jt] = pk4(rq); rt[jt] = rq;
            *(LAS v2u*)(iw + 0 * IMG + 32 * jt) = pa[jt]; *(LAS v2u*)(iw + 1 * IMG + 32 * jt) = pb[jt]; *(LAS v2u*)(iw + 2 * IMG + 32 * jt) = pk[jt]; *(LAS v2u*)(iw + 3 * IMG + 32 * jt) = pk4(vp);
        }
        const f32x4 z4 = (f32x4){0.f, 0.f, 0.f, 0.f};
        const int dd = fr - 4 * fq;
        f32x4 L = mm32(pa[2], pa[3], pb[2], pb[3], mm32(pa[0], pa[1], pb[0], pb[1], z4));
        f32x4 LT = mm32(pb[2], pb[3], pa[2], pa[3], mm32(pb[0], pb[1], pa[0], pa[1], z4));
        f32x4 Lak = mm32(pa[2], pa[3], pk[2], pk[3], mm32(pa[0], pa[1], pk[0], pk[1], z4));
        f32x4 MrbT = mm32(pb[2], pb[3], pr[2], pr[3], mm32(pb[0], pb[1], pr[0], pr[1], z4));
        f32x4 MrkT = mm32(pk[2], pk[3], pr[2], pr[3], mm32(pk[0], pk[1], pr[0], pr[1], z4));
        f32x4 TT;
#pragma unroll
        for (int r = 0; r < 4; ++r) {
            L[r] = dd < r ? L[r] : 0.f; Lak[r] = dd < r ? Lak[r] : 0.f;
            LT[r] = r < dd ? LT[r] : 0.f; MrbT[r] = r <= dd ? MrbT[r] : 0.f; MrkT[r] = r <= dd ? MrkT[r] : 0.f;
            TT[r] = LT[r] + (r == dd ? 1.f : 0.f);
        }
        const v2u bL = pk4(L), bLT = pk4(LT), bLak = pk4(Lak);
        const f32x4 L2m = mm16(bLT, bL, z4), L2T = mm16(bL, bLT, z4);
        const v2u bL2 = pk4(L2m), bL2T = pk4(L2T);
        const f32x4 L4m = mm16(bL2T, bL2, z4), L4T = mm16(bL2, bL2T, z4);
        const v2u bL4 = pk4(L4m), bL4T = pk4(L4T);
        const v2u bL8 = pk4(mm16(bL4T, bL4, z4));
        TT = mm16(bL2, pk4(TT), TT); TT = mm16(bL4, pk4(TT), TT); TT = mm16(bL8, pk4(TT), TT);
        f32x4 Zm = mm16(bL, pk4(MrbT), MrbT); Zm = mm16(bL2, pk4(Zm), Zm); Zm = mm16(bL4, pk4(Zm), Zm); Zm = mm16(bL8, pk4(Zm), Zm);
        const v2u bTT = pk4(TT), bMtT = pk4(Zm);
        *(v2u*)(rec + REC_TK + lane * 8) = pk4(mm16(bLak, bTT, z4)); *(v2u*)(rec + REC_MY + lane * 8) = pk4(mm16(bLak, bMtT, MrkT));
        LAS unsigned char* ir = sc + (4 * fq + ((lane & 15) >> 2)) * 144 + 8 * (lane & 3);
        v2u wat[4], rpt[4];
#pragma unroll
        for (int jt = 0; jt < 4; ++jt) {
            const v2u Qa = tr16(ir + 0 * IMG + 32 * jt), Qb = tr16(ir + 1 * IMG + 32 * jt), Qk = tr16(ir + 2 * IMG + 32 * jt);
            wat[jt] = pk4(mm16(Qa, bTT, z4)); rpt[jt] = pk4(mm16(Qa, bMtT, rt[jt]));
            *(v4u*)(rec + REC_BK + (jt * 64 + lane) * 16) = (v4u){Qb.x, Qb.y, Qk.x, Qk.y};
        }
#pragma unroll
        for (int s = 0; s < 2; ++s) {
            *(v4u*)(rec + REC_WA + (s * 64 + lane) * 16) = (v4u){wat[2 * s].x, wat[2 * s].y, wat[2 * s + 1].x, wat[2 * s + 1].y};
            *(v4u*)(rec + REC_RP + (s * 64 + lane) * 16) = (v4u){rpt[2 * s].x, rpt[2 * s].y, rpt[2 * s + 1].x, rpt[2 * s + 1].y};
        }
#pragma unroll
        for (int it = 0; it < 4; ++it) {
            const v2u Qv = tr16(ir + 3 * IMG + 32 * it);
            *(v2u*)(rec + REC_VV + (it * 64 + lane) * 8) = Qv;

        }
    }
}

__device__ __forceinline__ void ph_wkv2(const Params& p, int jl, int lane, int wave) {
    const bf16* Kr = (const bf16*)(p.ws + WS_K); const bf16* Vr = (const bf16*)(p.ws + (jl == 0 ? WS_VF : WS_VB)); const bf16* VFp = (const bf16*)(p.ws + WS_VF);
    const bf16* Rr = (const bf16*)(p.ws + WS_R); const bf16* L2 = (const bf16*)(p.ws + WS_L2);
    bf16* KM = (bf16*)(p.ws + WS_NKK); bf16* VP = (bf16*)(p.ws + WS_KKA);
    const bool vres = jl == 1; const int ri = lane >> 4, cg = lane & 15;
    float* YW = (float*)(p.ws + WS_YW);
    const int fr = lane & 15, fq = lane >> 4;
    const int gw = blockIdx.x * NWAVES + wave, NGW = gridDim.x * NWAVES;
    for (int job = gw; job < BATCH * WH * 4; job += NGW) {
        const int it = job & 3, h = (job >> 2) & 15, seq = job >> 6, r0 = seq * TP;
        const unsigned char* rec = p.ws + WS_REC + (size_t)((seq * WH + h) * WC_NCH) * REC_BYTES;
        f32x4 Sacc[4];
#pragma unroll
        for (int jt = 0; jt < 4; ++jt) Sacc[jt] = (f32x4){0.f, 0.f, 0.f, 0.f};
        v4u wa[2], rp[2], bk[4]; v2u vvf, tk, my; f32x4 gc[4];
#define WC_LOAD(rc) do { const unsigned char* r_ = (rc); \
            wa[0] = *(const v4u*)(r_ + REC_WA + lane * 16); wa[1] = *(const v4u*)(r_ + REC_WA + 1024 + lane * 16); rp[0] = *(const v4u*)(r_ + REC_RP + lane * 16); rp[1] = *(const v4u*)(r_ + REC_RP + 1024 + lane * 16); \
            _Pragma("unroll") for (int jt_ = 0; jt_ < 4; ++jt_) { bk[jt_] = *(const v4u*)(r_ + REC_BK + (jt_ * 64 + lane) * 16); gc[jt_] = *(const f32x4*)(r_ + REC_GC + (16 * jt_ + 4 * fq) * 4); } \
            vvf = *(const v2u*)(r_ + REC_VV + (it * 64 + lane) * 8); tk = *(const v2u*)(r_ + REC_TK + lane * 8); my = *(const v2u*)(r_ + REC_MY + lane * 8); } while (0)
        WC_LOAD(rec);
        for (int c = 0; c < WC_NCH; ++c) {
            const v4u cwa0 = wa[0], cwa1 = wa[1], crp0 = rp[0], crp1 = rp[1], cbk0 = bk[0], cbk1 = bk[1], cbk2 = bk[2], cbk3 = bk[3]; const v2u cvv = vvf; const f32x4 zz4 = (f32x4){0.f, 0.f, 0.f, 0.f}, cu0 = mm16(tk, vvf, zz4), cy0 = mm16(my, vvf, zz4), cg0 = gc[0], cg1 = gc[1], cg2 = gc[2], cg3 = gc[3];
            if (c + 1 < WC_NCH) WC_LOAD(rec + (size_t)(c + 1) * REC_BYTES);
            v4u sb0, sb1;
            sb0.x = cvt_pk_bf16(Sacc[0][0], Sacc[0][1]); sb0.y = cvt_pk_bf16(Sacc[0][2], Sacc[0][3]); sb0.z = cvt_pk_bf16(Sacc[1][0], Sacc[1][1]); sb0.w = cvt_pk_bf16(Sacc[1][2], Sacc[1][3]);
            sb1.x = cvt_pk_bf16(Sacc[2][0], Sacc[2][1]); sb1.y = cvt_pk_bf16(Sacc[2][2], Sacc[2][3]); sb1.z = cvt_pk_bf16(Sacc[3][0], Sacc[3][1]); sb1.w = cvt_pk_bf16(Sacc[3][2], Sacc[3][3]);
            const bf16x8 B0 = __builtin_bit_cast(bf16x8, sb0), B1 = __builtin_bit_cast(bf16x8, sb1);
            f32x4 U = __builtin_amdgcn_mfma_f32_16x16x32_bf16(__builtin_bit_cast(bf16x8, cwa0), B0, cu0, 0, 0, 0);
            U = __builtin_amdgcn_mfma_f32_16x16x32_bf16(__builtin_bit_cast(bf16x8, cwa1), B1, U, 0, 0, 0);
            f32x4 Y = __builtin_amdgcn_mfma_f32_16x16x32_bf16(__builtin_bit_cast(bf16x8, crp0), B0, cy0, 0, 0, 0);
            Y = __builtin_amdgcn_mfma_f32_16x16x32_bf16(__builtin_bit_cast(bf16x8, crp1), B1, Y, 0, 0, 0);
            v4u ub; ub.x = pk2_c(U[0], U[1]); ub.y = pk2_c(U[2], U[3]); ub.z = cvv.x; ub.w = cvv.y;
            const bf16x8 UB = __builtin_bit_cast(bf16x8, ub);
            Sacc[0] = __builtin_amdgcn_mfma_f32_16x16x32_bf16(__builtin_bit_cast(bf16x8, cbk0), UB, Sacc[0], 0, 0, 0) * cg0;
            Sacc[1] = __builtin_amdgcn_mfma_f32_16x16x32_bf16(__builtin_bit_cast(bf16x8, cbk1), UB, Sacc[1], 0, 0, 0) * cg1;
            Sacc[2] = __builtin_amdgcn_mfma_f32_16x16x32_bf16(__builtin_bit_cast(bf16x8, cbk2), UB, Sacc[2], 0, 0, 0) * cg2;
            Sacc[3] = __builtin_amdgcn_mfma_f32_16x16x32_bf16(__builtin_bit_cast(bf16x8, cbk3), UB, Sacc[3], 0, 0, 0) * cg3;
            float* yp = YW + (size_t)(r0 + WC_C * c + 4 * fq) * D + h * WN + 16 * it + fr;
            yp[0] = Y[0]; yp[D] = Y[1]; yp[2 * D] = Y[2]; yp[3 * D] = Y[3];
        }
#undef WC_LOAD
        float* so = p.out + O_WKVP + ((((size_t)jl * BATCH + seq) * WH + h) * WN + 16 * it + fr) * WN + 4 * fq;
#pragma unroll
        for (int jt = 0; jt < 4; ++jt) *(f32x4*)(so + 16 * jt) = Sacc[jt];
    }
    {
        const int gw = blockIdx.x * NWAVES + wave, NGW = gridDim.x * NWAVES;
        for (int it = gw; it < SB * WH * 16; it += NGW) {
            const int rg = it & 15, h = (it >> 4) & 15, s = it >> 8, row = MP + s, i = 4 * rg + ri;
            const int ch = h * WN + 4 * cg;
            WkPar P; P.w0 = *(const f32x4*)(p.in[I_W0] + (size_t)jl * D + ch); P.a0 = *(const f32x4*)(p.in[I_A0] + (size_t)jl * D + ch); P.kkp = *(const f32x4*)(p.in[I_KK] + (size_t)jl * D + ch);
            P.kap = *(const f32x4*)(p.in[I_KA] + (size_t)jl * D + ch); P.v0 = *(const f32x4*)(p.in[I_V0] + ch);
            const size_t vo = (size_t)row * D + ch, lo = (size_t)row * NL2 + ch;
            const f32x4 kraw = ld_bf4(Kr + vo), vraw = ld_bf4(Vr + vo), r4 = ld_bf4(Rr + vo), lw2 = ld_bf4(L2 + lo), la2 = ld_bf4(L2 + lo + 1024);
            f32x4 vf = (f32x4){0.f, 0.f, 0.f, 0.f}, lv2 = vf;
            if (vres) { vf = ld_bf4(VFp + vo); lv2 = ld_bf4(L2 + lo + 3072); }
            f32x4 w4, ka, k4, vp, nk; wk_prep(P, kraw, vraw, lw2, la2, vf, lv2, vres, w4, ka, k4, vp, nk);
            const int srcl = (lane & 48) | rg;
            const float v0_ = shfl_l(vp.x, srcl), v1_ = shfl_l(vp.y, srcl), v2_ = shfl_l(vp.z, srcl), v3_ = shfl_l(vp.w, srcl);
            const float vi = ri == 0 ? v0_ : (ri == 1 ? v1_ : (ri == 2 ? v2_ : v3_));
            const size_t so = ((((size_t)jl * SB + s) * WH + h) * WN + i) * WN + 4 * cg;
            f32x4 S = *(const f32x4*)(p.in[I_SWKV] + so);
            const float sa = row16_sum((S.x * nk.x + S.y * nk.y) + (S.z * nk.z + S.w * nk.w));
            S.x = fmaf(S.x, w4.x, fmaf(sa, ka.x, vi * k4.x)); S.y = fmaf(S.y, w4.y, fmaf(sa, ka.y, vi * k4.y));
            S.z = fmaf(S.z, w4.z, fmaf(sa, ka.z, vi * k4.z)); S.w = fmaf(S.w, w4.w, fmaf(sa, ka.w, vi * k4.w));
            const float y = row16_sum((S.x * r4.x + S.y * r4.y) + (S.z * r4.z + S.w * r4.w));
            *(f32x4*)(p.out + O_WKVS + so) = S;
            if (cg == 0) YW[(size_t)row * D + h * WN + i] = y;
            if (rg == 0 && ri == 0) { st_bf4(KM + vo, k4); st_bf4(VP + vo, vp); }
        }
    }
}

typedef __attribute__((address_space(1))) unsigned gu32;
#define XB_TMO      128
#define XB_XCNT(j)  (256  + 64 * (j))
#define XB_XSUB(j)  (1280 + 64 * (j))
#define XB_XGEN(j)  (2304 + 64 * (j))
#define XB_TOP      3328
#define XB_TOPGEN   3392
#define XCD_BAR_WORDS 3456
#define XB_SPIN_CAP (1u << 18)

__device__ __forceinline__ unsigned xb_ld(unsigned* p)              { return __hip_atomic_load(p, __ATOMIC_RELAXED, __HIP_MEMORY_SCOPE_AGENT); }
__device__ __forceinline__ unsigned xb_add(unsigned* p, unsigned v) { return __hip_atomic_fetch_add(p, v, __ATOMIC_RELAXED, __HIP_MEMORY_SCOPE_AGENT); }
__device__ __forceinline__ unsigned xb_xcc_id() { return (unsigned)__builtin_amdgcn_s_getreg((3 << 11) | 20) & 0xFu; }
#define XB_SPIN(cond, bar) do { unsigned _sp = 0; while (cond) { __builtin_amdgcn_s_sleep(1); \
    if ((++_sp & 255u) == 0u) { if (xb_ld(&(bar)[XB_TMO])) break; if (_sp > XB_SPIN_CAP) { atomicAdd(&(bar)[XB_TMO], 1u); break; } } } } while (0)

struct XcdBarrier {
    bool tid0; unsigned* bar; unsigned x;
    volatile LAS unsigned* st;
};

__device__ __forceinline__ XcdBarrier xcd_barrier_post(unsigned* bar, volatile LAS unsigned* st, bool tid0) {
    XcdBarrier b; b.tid0 = tid0; b.bar = bar; b.x = xb_xcc_id(); b.st = st;
    if (b.tid0) (void)xb_add(&bar[XB_XCNT(b.x)], 1u);
    return b;
}
__device__ __forceinline__ void xcd_barrier_complete(unsigned* bar, unsigned x, unsigned& nloc, unsigned& nx) {
    const unsigned G = gridDim.x * gridDim.y * gridDim.z;
    unsigned sum, cnt, mine, sp = 0u;
    for (;;) {
        sum = 0u; cnt = 0u; mine = 0u;
#pragma unroll
        for (unsigned j = 0; j < 16; ++j) { const unsigned c = xb_ld(&bar[XB_XCNT(j)]); sum += c; cnt += (c > 0u) ? 1u : 0u; mine = (j == x) ? c : mine; }
        if (sum == G) break;
        __builtin_amdgcn_s_sleep(1);
        if ((++sp & 255u) == 0u) { if (xb_ld(&bar[XB_TMO])) break; if (sp > XB_SPIN_CAP) { atomicAdd(&bar[XB_TMO], 1u); break; } }
    }
    nloc = mine > 0u ? mine : 1u; nx = cnt > 0u ? cnt : 1u;
}

__device__ __forceinline__ void xcd_barrier(const XcdBarrier& b) {
    asm volatile("s_waitcnt vmcnt(0)" ::: "memory");
    __syncthreads();
    if (b.tid0) {
        unsigned* bar = b.bar;
        __builtin_amdgcn_s_waitcnt(0);
        unsigned nloc = b.st[0], nx = b.st[1];
        if (nloc == 0u) { xcd_barrier_complete(bar, b.x, nloc, nx); b.st[0] = nloc; b.st[1] = nx; }
        const unsigned old = xb_add(&bar[XB_XSUB(b.x)], 1u);
        const unsigned gen = old / nloc;
        if (old + 1u == (gen + 1u) * nloc) {
            __builtin_amdgcn_fence(__ATOMIC_RELEASE, "agent");
            asm volatile("s_waitcnt vmcnt(0)" ::: "memory");
            const unsigned og = xb_add(&bar[XB_TOP], 1u);
            const unsigned tg = og / nx;
            if (og + 1u == (tg + 1u) * nx) xb_add(&bar[XB_TOPGEN], 1u);
            else XB_SPIN(xb_ld(&bar[XB_TOPGEN]) == tg, bar);
            __builtin_amdgcn_fence(__ATOMIC_ACQUIRE, "agent");
            xb_add(&bar[XB_XGEN(b.x)], 1u);
            asm volatile("s_waitcnt vmcnt(0)" ::: "memory");
        } else {
            XB_SPIN(xb_ld(&bar[XB_XGEN(b.x)]) == gen, bar);
            __builtin_amdgcn_fence(__ATOMIC_ACQUIRE, "agent");
            asm volatile("s_waitcnt vmcnt(0)" ::: "memory");
        }
    }
    __syncthreads();
}

enum { OP_P0 = 0, OP_NORM_RET, OP_G_RETIN, OP_RET, OP_RETNORM, OP_G_RETOUT, OP_NORM_RW, OP_G_RWPROJ, OP_G_LORA2, OP_PREP, OP_WKV, OP_WKV2, OP_POST, OP_G_WO,
       OP_NORM_FFN, OP_G_UG, OP_CONV, OP_G_WD, OP_FINAL };
struct Ph { unsigned char op, layer; };
constexpr int NPH = 1 + 2 * 6 + 2 * 9 + 1;
__device__ __host__ inline Ph phase_at(int i) {
    if (i == 0) return Ph{OP_P0, 0};
    i -= 1;
    int l;
    if (i < 6) l = 0; else if (i < 15) { l = 1; i -= 6; } else if (i < 21) { l = 2; i -= 15; } else if (i < 30) { l = 3; i -= 21; } else return Ph{OP_FINAL, 0};
    int op = OP_FINAL;
    if ((l & 1) == 0) {
        switch (i) { case 0: op = OP_G_RETIN; break; case 1: op = OP_RET; break; case 2: op = OP_RETNORM; break; case 3: op = OP_G_RETOUT; break;
                     case 4: op = OP_G_UG; break; default: op = OP_G_WD; break; }
    } else {
        switch (i) { case 0: op = OP_NORM_RW; break; case 1: op = OP_G_RWPROJ; break; case 2: op = OP_G_LORA2; break; case 3: op = OP_WKV; break; case 4: op = OP_WKV2; break; case 5: op = OP_POST; break; case 6: op = OP_G_WO; break;
                     case 7: op = OP_G_UG; break; default: op = OP_G_WD; break; }
    }
    return Ph{(unsigned char)op, (unsigned char)l};
}

__global__ void __launch_bounds__(NTHR, 2) mega(Params p, int lo, int hi) {
    extern __shared__ __attribute__((aligned(16))) unsigned char lds_raw[];
    LAS unsigned char* lds = (LAS unsigned char*)lds_raw;
    volatile LAS unsigned* bst = (volatile LAS unsigned*)(lds + LDS_BYTES - 16);
    const int wave0 = __builtin_amdgcn_readfirstlane((int)threadIdx.x >> 6);
    if (threadIdx.x < 4) bst[threadIdx.x] = 0u;
    __syncthreads();
    (void)xcd_barrier_post((unsigned*)(p.ws + WS_CTL), bst, threadIdx.x == 0);
    for (int ph = lo; ph < hi; ++ph) {
        int lid_; asm volatile("v_mbcnt_lo_u32_b32 %0, -1, 0\n\tv_mbcnt_hi_u32_b32 %0, -1, %0" : "=v"(lid_));
        int tid = wave0 * 64 + lid_; asm volatile("" : "+v"(tid));
        const int lane = tid & 63, wave = __builtin_amdgcn_readfirstlane(tid >> 6);
        unsigned char* ws = p.ws;
        const Ph P = phase_at(ph);
        const int li = P.layer, jl = li >> 1;
        const bf16* gA = nullptr; const bf16* gB = nullptr; int gN = 0, gK = 0; EpiAnyT<0> E{}; E.jl = jl; E.ws = ws; E.slot = -1; E.amul = 1.f; E.li = li; E.ldsb = lds; bool is_gemm = false;
        switch (P.op) {
        case OP_P0: ph_p0(p, lds, tid, lane, wave); break;
        case OP_NORM_RET: ph_norm(p, p.in[I_NMIX] + (size_t)li * D, 0, jl, lane, wave); break;
        case OP_NORM_FFN: ph_norm(p, p.in[I_NFFN] + (size_t)li * D, 0, jl, lane, wave); break;
        case OP_NORM_RW: ph_norm(p, p.in[I_NMIX] + (size_t)li * D, 1, jl, lane, wave); break;
        case OP_FINAL: ph_norm(p, p.in[I_NFIN], 2, 0, lane, wave); break;
        case OP_RETNORM: ph_ret_norm(p, jl, lane, wave); break;
        case OP_POST: ph_rwkv_post(p, jl, lane, wave); break;
        case OP_RET: ph_ret_fast(p, jl, lds, tid, lane, wave); break;
        case OP_WKV: ph_wkv1(p, jl, lds, lane, wave); break;
        case OP_WKV2: ph_wkv2(p, jl, lane, wave); break;
        case OP_G_RETIN: is_gemm = true; E.kind = EK_RETIN; E.perm = true; E.slot = 2 * li;
            gA = (const bf16*)(ws + WS_XB); gB = (const bf16*)(ws + WS_WIN + jl * SZ_WIN); gN = RWIN; gK = D; break;
        case OP_G_RETOUT: is_gemm = true; E.kind = EK_RESID; E.perm = false; E.slot = 2 * li + 1;
            gA = (const bf16*)(ws + WS_Y); gB = (const bf16*)(ws + WS_WOUT + jl * SZ_WOUT); gN = D; gK = RV; break;
        case OP_G_RWPROJ: is_gemm = true; E.kind = EK_RWPROJ; E.perm = true;
            gA = (const bf16*)(ws + WS_H); gB = (const bf16*)(ws + WS_WRW + jl * SZ_WRW); gN = NRW; gK = KRW; break;
        case OP_G_LORA2: is_gemm = true; E.kind = EK_F32; E.perm = true;
            gA = (const bf16*)(ws + WS_A2); gB = (const bf16*)(ws + WS_WL2 + jl * SZ_WL2); gN = (jl == 0 ? 3072 : 4096); gK = KL2; break;
        case OP_G_WO: is_gemm = true; E.kind = EK_RESID; E.perm = false; E.slot = 2 * li + 1;
            gA = (const bf16*)(ws + WS_Z); gB = (const bf16*)(ws + WS_WO + jl * SZ_WO); gN = D; gK = D; break;
        case OP_G_UG: is_gemm = true; E.kind = EK_UG; E.perm = true; E.slot = 2 * li + 1;
            gA = (const bf16*)(ws + WS_XB); gB = (const bf16*)(ws + WS_WUG + li * SZ_WUG); gN = 2 * DFF; gK = D; break;
        case OP_G_WD: is_gemm = true; E.kind = EK_RESID; E.perm = false; E.slot = (li == 1) ? 2 * (li + 1) : -1;
            gA = (const bf16*)(ws + WS_ACT); gB = (const bf16*)(ws + WS_WD + li * SZ_WD); gN = D; gK = DFF; break;
        default: break;
        }
        if (is_gemm) {
            const bool ug = E.kind == EK_UG;
            const int gM = (E.kind == EK_RESID) ? MT0 : (ug ? 66 * 256 : M);
            pg8::Gemm g{ug ? gA - 2 * D : gA, gB, gM, gN, gK, ug ? 254 : 256}; pg8::StaticOrder S; S.init(gM, gN, (int)gridDim.x, (int)blockIdx.x);
            if (E.kind == EK_RETIN || E.kind == EK_UG) {
                LAS float* rt = (LAS float*)(lds + 131072);
                Unit uu;
                for (int ui = 0; ui < 8 && S.next(ui, uu); ++ui) if (tid < 256) { int rr = ug ? 254 * uu.pm - 2 + tid : uu.pm * 256 + tid; rr = rr < 0 ? 0 : (rr > M - 1 ? M - 1 : rr); rt[ui * 256 + tid] = row_rstd(ws, E.slot, rr); }
                E.rtab = rt; E.ldsb = lds;
                __syncthreads();
            }
            if (ug) { EpiAnyT<1> E1{}; E1.kind = E.kind; E1.perm = E.perm; E1.jl = E.jl; E1.ws = E.ws; E1.slot = E.slot; E1.rtab = E.rtab; E1.amul = E.amul; E1.li = E.li; E1.ldsb = E.ldsb; E1.pcw = p.in[I_CW]; E1.pcb = p.in[I_CB]; E1.pcst = p.in[I_SCONV]; E1.pout = p.out;
                pg8::gemm_phase<EpiAnyT<1>, pg8::StaticOrder, true, true>(lds, g, S, E1, tid); }
            else pg8::gemm_phase<EpiAnyT<0>, pg8::StaticOrder, true, true>(lds, g, S, E, tid);
            if (E.kind == EK_RESID) tail_resid(gA, gB, gK, ws, E.slot, E.amul, lds, lane, wave);
        }
        if (ph + 1 < hi) { if (ph == 0) cg::this_grid().sync(); else { XcdBarrier bar; bar.tid0 = tid == 0; bar.bar = (unsigned*)(p.ws + WS_CTL); bar.x = xb_xcc_id(); bar.st = (volatile LAS unsigned*)(lds + LDS_BYTES - 16); xcd_barrier(bar); } }
    }
}

}

extern "C" void kernel_launch(void* const* d_in, const int* in_sizes, int n_in, void* d_out, int out_size, void* d_ws, size_t ws_size, hipStream_t stream) {
    static int grid = 0;
    if (grid == 0) {
        int dev = 0, cus = 0;
        if (n_in != N_IN || ws_size < WS_END2) { fprintf(stderr, "kernel_launch: unexpected n_in %d / ws_size %zu (need %zu)\n", n_in, ws_size, (size_t)WS_END2); grid = -1; return; }
        if (hipGetDevice(&dev) != hipSuccess || hipDeviceGetAttribute(&cus, hipDeviceAttributeMultiprocessorCount, dev) != hipSuccess) { grid = -1; return; }
        if (hipFuncSetAttribute((const void*)mega, hipFuncAttributeMaxDynamicSharedMemorySize, LDS_BYTES) != hipSuccess) { fprintf(stderr, "kernel_launch: hipFuncSetAttribute failed\n"); grid = -1; return; }
        int per_cu = 0;
        if (hipOccupancyMaxActiveBlocksPerMultiprocessor(&per_cu, (const void*)mega, NTHR, LDS_BYTES) != hipSuccess || per_cu < 1) { fprintf(stderr, "kernel_launch: occupancy query says %d\n", per_cu); (void)hipGetLastError(); }
        grid = cus * (per_cu >= 1 ? 1 : 1);
    }
    if (grid < 0) return;
    Params p{};
    for (int i = 0; i < N_IN; ++i) p.in[i] = (const float*)d_in[i];
    p.out = (float*)d_out; p.ws = (unsigned char*)d_ws;
    if (hipMemsetAsync(d_ws, 0, 65536, stream) != hipSuccess) { fprintf(stderr, "kernel_launch: memset failed\n"); return; }
    int lo = 0, hi = NPH;
    void* args[] = {(void*)&p, (void*)&lo, (void*)&hi};
    const hipError_t e = hipLaunchCooperativeKernel((const void*)mega, dim3(grid), dim3(NTHR), args, LDS_BYTES, stream);
    if (e != hipSuccess) fprintf(stderr, "kernel_launch: cooperative launch failed: %s (grid %d)\n", hipGetErrorString(e), grid);
    (void)in_sizes; (void)out_size;
}
```

```cpp
#include <hip/hip_runtime.h>
#include <hip/hip_cooperative_groups.h>
#include <cstdio>
#include <stdint.h>
namespace cg = cooperative_groups;
namespace pg8 {
#define PG8_LAS __attribute__((address_space(3)))
typedef unsigned short bf16_t;
typedef short bf16x8 __attribute__((ext_vector_type(8)));
typedef float f32x4 __attribute__((ext_vector_type(4)));
typedef unsigned u32x4 __attribute__((ext_vector_type(4)));
constexpr int BM = 256, BK = 64, HALF = 128, HTB = HALF * BK * 2  , STAGE_BYTES = 8 * HTB, NXCD = 8, WGM = 8;

__host__ __device__ __forceinline__ int lds_byte(int r, int c) { const int st = (r >> 4) * 2 + (c >> 5), rr = r & 15, cc = c & 31, ob = rr * 64 + cc * 2; return st * 1024 + (ob ^ (((ob >> 9) & 1) << 5)); }
__host__ __device__ __forceinline__ void stage_rc(int b, int& R, int& C) { const int st = b / 1024, sb = b % 1024, swz = sb ^ (((sb >> 9) & 1) << 5); R = (st >> 1) * 16 + swz / 64; C = (st & 1) * 32 + (swz % 64) / 2; }
__host__ __device__ __forceinline__ int perm32(int rho) { const int n = rho >> 4, i = rho & 15; return 8 * (i >> 2) + 4 * n + (i & 3); }

struct Unit { int pm, pn, ord; };
struct Gemm { const bf16_t* A; const bf16_t* Bt; int M, N, K, trows; };

struct StaticOrder {
    int nM, nN, nwg, G, c;
    __host__ __device__ void init(int M, int N, int G_, int c_) { nM = M / BM; nN = N / BM; nwg = nM * nN; G = G_; c = c_; }
    __host__ __device__ __forceinline__ bool next(int i, Unit& u) const {
        const long L = (long)i * G + c; if (L >= nwg) return false;
        int wgid = (int)L; { const int q = nwg / NXCD, r = nwg % NXCD, xcd = wgid % NXCD, off = wgid / NXCD; wgid = (xcd < r ? xcd * (q + 1) : r * (q + 1) + (xcd - r) * q) + off; }
        const int nig = WGM * nN, gid = wgid / nig, fm = gid * WGM, gsz = (nM - fm) < WGM ? (nM - fm) : WGM;
        u.pm = fm + ((wgid % nig) % gsz); u.pn = (wgid % nig) / gsz; u.ord = i; return true;
    }
    __device__ __forceinline__ void a_ready(const Unit&) const {}
    __device__ __forceinline__ void done(const Unit&) const {}
};
template <class Epi, class Sched, bool ALIGN_EPI = false, bool SP2 = false>
__device__ __forceinline__ void gemm_phase(PG8_LAS unsigned char* lds, const Gemm g, const Sched& S, const Epi& E, int tid_in) {
    int tid = tid_in; asm volatile("" : "+v"(tid));
    const int wid = __builtin_amdgcn_readfirstlane(tid >> 6), lane = tid & 63, wr = wid >> 2, wc = wid & 3, fr = lane & 15, fq = lane >> 4;
    const int K = g.K, nt = K / BK;
    unsigned voffA[2], voffB[2];
#pragma unroll
    for (int i = 0; i < 2; ++i) { int R, C; stage_rc(tid * 16 + i * 8192, R, C); const int Rb = E.perm ? ((R & ~31) + perm32(R & 31)) : R;
        voffA[i] = (unsigned)(R * K + C) * 2u; voffB[i] = (unsigned)(Rb * K + C) * 2u; }
    const size_t kstep = (size_t)(BK * 2);
    const size_t hstep = (size_t)HALF * K * 2;
    const size_t tstep = 2 * hstep; const size_t tstepA = (size_t)g.trows * K * 2;
    const unsigned ldsw = (unsigned)wid * 1024u;
    const int aoff = lds_byte(wr * 64 + fr, fq * 8), boff = lds_byte(wc * 32 + fr, fq * 8);
#define PG8_SA(b, h) (((b) * 2 + (h)) * HTB)
#define PG8_SB(b, h) ((4 + (b) * 2 + (h)) * HTB)
#define PG8_STAGE(bufoff, gbase, voff) do { _Pragma("unroll") for (int _i = 0; _i < 2; ++_i) \
        __builtin_amdgcn_global_load_lds((const unsigned*)((const char*)(gbase) + (voff)[_i]), (PG8_LAS unsigned*)(lds + (bufoff) + ldsw + _i * 8192), 16, 0, 0); } while (0)
#define PG8_LDA(dst, b, h) do { _Pragma("unroll") for (int m = 0; m < 4; ++m) _Pragma("unroll") for (int k = 0; k < 2; ++k) dst[m][k] = *(const PG8_LAS bf16x8*)(lds + PG8_SA(b, h) + aoff + m * 2048 + k * 1024); } while (0)
#define PG8_LDB(dst, b, h) do { _Pragma("unroll") for (int n = 0; n < 2; ++n) _Pragma("unroll") for (int k = 0; k < 2; ++k) dst[n][k] = *(const PG8_LAS bf16x8*)(lds + PG8_SB(b, h) + boff + n * 2048 + k * 1024); } while (0)
#define PG8_MMA(ai, bj, At, Bt) do { __builtin_amdgcn_s_setprio(1); _Pragma("unroll") for (int m = 0; m < 4; ++m) _Pragma("unroll") for (int n = 0; n < 2; ++n) _Pragma("unroll") for (int k = 0; k < 2; ++k) \
        acc[ai][bj][m][n] = __builtin_amdgcn_mfma_f32_16x16x32_bf16(Bt[n][k], At[m][k], acc[ai][bj][m][n], 0, 0, 0); __builtin_amdgcn_s_setprio(0); } while (0)
#define PG8_WAIT_V(n) asm volatile("s_waitcnt vmcnt(" #n ")" ::: "memory")
#define PG8_WAIT_L(n) asm volatile("s_waitcnt lgkmcnt(" #n ")" ::: "memory")
#define PG8_BAR __builtin_amdgcn_s_barrier()
#define PG8_SCHED __builtin_amdgcn_sched_barrier(0)
    Unit cur, nxt; int ui = 0;
    if (!S.next(0, cur)) return;
    f32x4 acc[2][2][4][2];
#pragma unroll
    for (int a = 0; a < 2; ++a)
#pragma unroll
        for (int b = 0; b < 2; ++b)
#pragma unroll
            for (int m = 0; m < 4; ++m)
#pragma unroll
                for (int n = 0; n < 2; ++n) acc[a][b][m][n] = (f32x4){0.f, 0.f, 0.f, 0.f};
    bf16x8 At[4][2], B0[2][2], B1[2][2];
    const char* cA = (const char*)g.A + (size_t)cur.pm * tstepA; const char* cB = (const char*)g.Bt + (size_t)cur.pn * tstep;
    S.a_ready(cur);
    if constexpr (SP2) {
        PG8_STAGE(PG8_SB(0, 0), cB, voffB); PG8_STAGE(PG8_SB(0, 1), cB + hstep, voffB); PG8_STAGE(PG8_SA(0, 0), cA, voffA); PG8_STAGE(PG8_SA(0, 1), cA + hstep, voffA);
        if (wr == 1) PG8_BAR;
        PG8_WAIT_V(2); PG8_BAR;
        PG8_STAGE(PG8_SB(1, 0), cB + kstep, voffB); PG8_STAGE(PG8_SA(1, 0), cA + kstep, voffA); PG8_STAGE(PG8_SB(1, 1), cB + hstep + kstep, voffB);
        PG8_WAIT_V(6); PG8_BAR;
    } else {
        PG8_STAGE(PG8_SB(0, 0), cB, voffB); PG8_STAGE(PG8_SA(0, 0), cA, voffA); PG8_STAGE(PG8_SB(0, 1), cB + hstep, voffB); PG8_STAGE(PG8_SA(0, 1), cA + hstep, voffA);
        if (wr == 1) PG8_BAR;
        PG8_WAIT_V(4); PG8_BAR;
        PG8_STAGE(PG8_SB(1, 0), cB + kstep, voffB); PG8_STAGE(PG8_SA(1, 0), cA + kstep, voffA); PG8_STAGE(PG8_SB(1, 1), cB + hstep + kstep, voffB);
        PG8_WAIT_V(6); PG8_BAR;
    }
    for (;;) {
        const bool has_next = S.next(ui + 1, nxt);
        const char* nA = has_next ? (const char*)g.A + (size_t)nxt.pm * tstepA : cA; const char* nB = has_next ? (const char*)g.Bt + (size_t)nxt.pn * tstep : cB;
        for (int t = 0; t < nt; t += 2) {
            const bool last = (t == nt - 2);
            const char* a1 = cA + (size_t)(t + 1) * kstep;
            const char* a2 = last ? nA : cA + (size_t)(t + 2) * kstep; const char* b2 = last ? nB : cB + (size_t)(t + 2) * kstep;
            const char* a3 = a2 + kstep; const char* b3 = b2 + kstep;
            if (last && has_next) S.a_ready(nxt);
            if constexpr (SP2) {
            PG8_LDB(B0, 0, 0); PG8_LDB(B1, 0, 1); PG8_SCHED; PG8_LDA(At, 0, 0); PG8_STAGE(PG8_SA(1, 1), a1 + hstep, voffA);
            PG8_WAIT_V(8); PG8_WAIT_L(0); PG8_BAR; PG8_MMA(0, 0, At, B0); PG8_MMA(0, 1, At, B1); PG8_BAR; PG8_SCHED;
            PG8_LDA(At, 0, 1); PG8_STAGE(PG8_SB(0, 0), b2, voffB); PG8_STAGE(PG8_SB(0, 1), b2 + hstep, voffB); PG8_STAGE(PG8_SA(0, 0), a2, voffA);
            PG8_WAIT_V(8); PG8_WAIT_L(0); PG8_BAR; PG8_MMA(1, 0, At, B0); PG8_MMA(1, 1, At, B1); PG8_BAR; PG8_SCHED;
            PG8_LDB(B0, 1, 0); PG8_LDB(B1, 1, 1); PG8_SCHED; PG8_LDA(At, 1, 0); PG8_STAGE(PG8_SA(0, 1), a2 + hstep, voffA);
            PG8_WAIT_V(8); PG8_WAIT_L(0); PG8_BAR; PG8_MMA(0, 0, At, B0); PG8_MMA(0, 1, At, B1); PG8_BAR; PG8_SCHED;
            PG8_LDA(At, 1, 1); PG8_STAGE(PG8_SB(1, 0), b3, voffB); PG8_STAGE(PG8_SB(1, 1), b3 + hstep, voffB); PG8_STAGE(PG8_SA(1, 0), a3, voffA);
            PG8_WAIT_V(8); PG8_WAIT_L(0); PG8_BAR; PG8_MMA(1, 0, At, B0); PG8_MMA(1, 1, At, B1); PG8_BAR; PG8_SCHED;
            } else {
            PG8_LDB(B0, 0, 0); PG8_SCHED; PG8_LDA(At, 0, 0); PG8_STAGE(PG8_SA(1, 1), a1 + hstep, voffA);
            PG8_WAIT_L(8); PG8_BAR; PG8_WAIT_L(0); PG8_MMA(0, 0, At, B0); PG8_BAR; PG8_SCHED;
            PG8_LDB(B1, 0, 1); PG8_STAGE(PG8_SB(0, 0), b2, voffB);
            PG8_BAR; PG8_WAIT_L(0); PG8_MMA(0, 1, At, B1); PG8_BAR;
            PG8_LDA(At, 0, 1); PG8_STAGE(PG8_SA(0, 0), a2, voffA);
            PG8_BAR; PG8_WAIT_L(0); PG8_MMA(1, 0, At, B0); PG8_BAR; PG8_SCHED;
            PG8_STAGE(PG8_SB(0, 1), b2 + hstep, voffB);
            PG8_WAIT_V(6); PG8_BAR; PG8_MMA(1, 1, At, B1); PG8_BAR;
            PG8_LDB(B0, 1, 0); PG8_SCHED; PG8_LDA(At, 1, 0); PG8_STAGE(PG8_SA(0, 1), a2 + hstep, voffA);
            PG8_WAIT_L(8); PG8_BAR; PG8_WAIT_L(0); PG8_MMA(0, 0, At, B0); PG8_BAR; PG8_SCHED;
            PG8_LDB(B1, 1, 1); PG8_STAGE(PG8_SB(1, 0), b3, voffB);
            PG8_BAR; PG8_WAIT_L(0); PG8_MMA(0, 1, At, B1); PG8_BAR;
            PG8_LDA(At, 1, 1); PG8_STAGE(PG8_SA(1, 0), a3, voffA);
            PG8_BAR; PG8_WAIT_L(0); PG8_MMA(1, 0, At, B0); PG8_BAR; PG8_SCHED;
            PG8_STAGE(PG8_SB(1, 1), b3 + hstep, voffB);
            PG8_WAIT_V(6); PG8_BAR; PG8_MMA(1, 1, At, B1); PG8_BAR;
            }
        }
        if constexpr (ALIGN_EPI) { if (wr == 0) PG8_BAR; }
        if constexpr (!Epi::AFTER_DRAIN) { E(acc, cur, wr, wc, fr, fq); S.done(cur); }
        if (!has_next) break;
#pragma unroll
        for (int a = 0; a < 2; ++a)
#pragma unroll
            for (int b = 0; b < 2; ++b)
#pragma unroll
                for (int m = 0; m < 4; ++m)
#pragma unroll
                    for (int n = 0; n < 2; ++n) acc[a][b][m][n] = (f32x4){0.f, 0.f, 0.f, 0.f};
        cur = nxt; cA = nA; cB = nB; ++ui;
        if constexpr (ALIGN_EPI) { if (wr == 1) PG8_BAR; }
    }
    PG8_WAIT_V(0);
    if constexpr (!ALIGN_EPI) { if (wr == 0) PG8_BAR; }
    PG8_BAR;
    if constexpr (Epi::AFTER_DRAIN) { E.fused(acc, cur, wr, wc, fr, fq, lds, wid, lane); S.done(cur); }
#undef PG8_SA
#undef PG8_SB
#undef PG8_STAGE
#undef PG8_LDA
#undef PG8_LDB
#undef PG8_MMA
#undef PG8_WAIT_V
#undef PG8_WAIT_L
#undef PG8_BAR
#undef PG8_SCHED
}
}

namespace {
constexpr int D = 1024, BATCH = 8, SEQ = 2048, NMETA = 16, TP = SEQ + NMETA, MP = BATCH * TP, SB = 128, M = MP + SB;
constexpr int DEPTH = 4, RH = 4, RDK = 256, RDV = 512, RV = 2048, RWIN = 6144;
constexpr int WH = 16, WN = 64, LW = 64, LA = 64, LV = 32, LG = 160, DFF = 2816;
constexpr int NRW = 3584, KRW = 2048, KL2 = 384, NL2 = 4096;
constexpr float PAST_POS = 16384.f;
constexpr int NWAVES = 8, NTHR = 512;
constexpr int LDS_BYTES = 147456;

constexpr size_t O_YP = 0;
constexpr size_t O_YS = O_YP + (size_t)BATCH * SEQ * D;
constexpr size_t O_RETP = O_YS + (size_t)SB * D;
constexpr size_t O_WKVP = O_RETP + (size_t)2 * BATCH * RH * RDK * RDV;
constexpr size_t O_SHP = O_WKVP + (size_t)2 * BATCH * WH * WN * WN;
constexpr size_t O_CVP = O_SHP + (size_t)2 * BATCH * D;
constexpr size_t O_RETS = O_CVP + (size_t)DEPTH * BATCH * 2 * DFF;
constexpr size_t O_WKVS = O_RETS + (size_t)2 * SB * RH * RDK * RDV;
constexpr size_t O_SHS = O_WKVS + (size_t)2 * SB * WH * WN * WN;
constexpr size_t O_CVS = O_SHS + (size_t)2 * SB * D;

enum { I_XP = 0, I_XS, I_SRET, I_SWKV, I_SSHIFT, I_SCONV, I_META, I_NMIX, I_NFFN, I_NFIN, I_RWIN, I_RGN, I_RWOUT, I_MU, I_WRKV, I_W0, I_W1, I_W2,
       I_A0, I_A1, I_A2, I_V0, I_V1, I_V2, I_G1, I_G2, I_KK, I_KA, I_RK, I_LNW, I_LNB, I_WO, I_WUG, I_CW, I_CB, I_WD, N_IN };

constexpr size_t al256(size_t x) { return (x + 255) & ~(size_t)255; }
constexpr size_t WS_CTL = 0;
constexpr size_t WS_CS = 1u << 20;
constexpr size_t WS_WIN = 4u << 20;
constexpr size_t SZ_WIN = (size_t)RWIN * D * 2;
constexpr size_t WS_WOUT = WS_WIN + 2 * SZ_WIN;
constexpr size_t SZ_WOUT = (size_t)D * RV * 2;
constexpr size_t WS_WRW = WS_WOUT + 2 * SZ_WOUT;
constexpr size_t SZ_WRW = (size_t)NRW * KRW * 2;
constexpr size_t WS_WL2 = WS_WRW + 2 * SZ_WRW;
constexpr size_t SZ_WL2 = (size_t)NL2 * KL2 * 2;
constexpr size_t WS_WO = WS_WL2 + 2 * SZ_WL2;
constexpr size_t SZ_WO = (size_t)D * D * 2;
constexpr size_t WS_WUG = WS_WO + 2 * SZ_WO;
constexpr size_t SZ_WUG = (size_t)2 * DFF * D * 2;
constexpr size_t WS_WD = WS_WUG + 4 * SZ_WUG;
constexpr size_t SZ_WD = (size_t)D * DFF * 2;
constexpr size_t WS_X = al256(WS_WD + 4 * SZ_WD);
constexpr size_t SZ_MD4 = (size_t)M * D * 4;
constexpr size_t WS_H = WS_X + SZ_MD4;
constexpr size_t WS_VF = WS_H + SZ_MD4;
constexpr size_t WS_REG = WS_VF + SZ_MD4;
constexpr size_t WS_QK = WS_REG;
constexpr size_t WS_V = WS_QK + SZ_MD4;
constexpr size_t WS_SG = WS_V + SZ_MD4;
constexpr size_t WS_O = WS_SG + SZ_MD4;
constexpr size_t WS_Y = WS_O + 2 * SZ_MD4;
constexpr size_t WS_R = WS_REG;
constexpr size_t WS_K = WS_R + SZ_MD4;
constexpr size_t WS_VB = WS_K + SZ_MD4;
constexpr size_t WS_WDEC = WS_VB + SZ_MD4;
constexpr size_t WS_NKK = WS_WDEC + SZ_MD4;
constexpr size_t WS_KKA = WS_NKK + SZ_MD4;
constexpr size_t WS_YW = WS_KKA + SZ_MD4;
constexpr size_t WS_L2 = WS_YW + SZ_MD4;
constexpr size_t WS_A2 = WS_L2 + 4 * SZ_MD4;
constexpr size_t WS_Z = al256(WS_A2 + (size_t)M * KL2 * 2);
constexpr size_t WS_RW_END = WS_Z + (size_t)M * D * 2;
constexpr size_t SZ_FF2 = (size_t)M * DFF * 2;
constexpr size_t WS_U = WS_REG;
constexpr size_t WS_G = al256(WS_U + SZ_FF2);
constexpr size_t WS_ACT = al256(WS_G + SZ_FF2);
constexpr size_t WS_XB = al256(WS_RW_END) + 2 * (size_t)D * 2;
constexpr size_t WS_SS = al256(WS_XB + (size_t)(M + 126) * D * 2);
constexpr size_t WS_PTRS = al256(WS_SS + (size_t)8 * M * 16 * 4);
constexpr size_t WS_END = WS_PTRS + 256;

#define LAS __attribute__((address_space(3)))
typedef unsigned short bf16;
typedef unsigned v4u __attribute__((ext_vector_type(4)));
typedef unsigned v2u __attribute__((ext_vector_type(2)));
using pg8::f32x4;
using pg8::Unit;
using pg8::bf16x8;

struct Params { const float* in[N_IN]; float* out; unsigned char* ws; };

__device__ __forceinline__ unsigned cvt_pk_bf16(float lo, float hi) { unsigned r; asm("v_cvt_pk_bf16_f32 %0, %1, %2" : "=v"(r) : "v"(lo), "v"(hi)); return r; }
__device__ __forceinline__ bf16 bf_cv(float x) { return __builtin_bit_cast(unsigned short, (__bf16)x); }
__device__ __forceinline__ float bf_lo(unsigned w) { return __uint_as_float(w << 16); }
__device__ __forceinline__ float bf_hi(unsigned w) { return __uint_as_float(w & 0xffff0000u); }
__device__ __forceinline__ void unpack8(const v4u w, float (&f)[8]) { f[0] = bf_lo(w.x); f[1] = bf_hi(w.x); f[2] = bf_lo(w.y); f[3] = bf_hi(w.y); f[4] = bf_lo(w.z); f[5] = bf_hi(w.z); f[6] = bf_lo(w.w); f[7] = bf_hi(w.w); }
__device__ __forceinline__ v4u pack8(const float (&f)[8]) { v4u w; w.x = cvt_pk_bf16(f[0], f[1]); w.y = cvt_pk_bf16(f[2], f[3]); w.z = cvt_pk_bf16(f[4], f[5]); w.w = cvt_pk_bf16(f[6], f[7]); return w; }
__device__ __forceinline__ f32x4 ld_bf4(const bf16* q) { const v2u w = *(const v2u*)q; return (f32x4){bf_lo(w.x), bf_hi(w.x), bf_lo(w.y), bf_hi(w.y)}; }
__device__ __forceinline__ void st_bf4(bf16* q, const f32x4 v) { v2u w; w.x = cvt_pk_bf16(v.x, v.y); w.y = cvt_pk_bf16(v.z, v.w); *(v2u*)q = w; }
__device__ __forceinline__ float shfl_xor_l(float v, int m, int lane) { return __int_as_float(__builtin_amdgcn_ds_bpermute((lane ^ m) << 2, __float_as_int(v))); }
__device__ __forceinline__ float shfl_l(float v, int src) { return __int_as_float(__builtin_amdgcn_ds_bpermute(src << 2, __float_as_int(v))); }
__device__ __forceinline__ float wave_sum(float v, int) {
    v += __builtin_bit_cast(float, __builtin_amdgcn_update_dpp(0, __float_as_int(v), 0x128, 0xf, 0xf, false));
    v += __builtin_bit_cast(float, __builtin_amdgcn_update_dpp(0, __float_as_int(v), 0x124, 0xf, 0xf, false));
    v += __builtin_bit_cast(float, __builtin_amdgcn_update_dpp(0, __float_as_int(v), 0x122, 0xf, 0xf, false));
    v += __builtin_bit_cast(float, __builtin_amdgcn_update_dpp(0, __float_as_int(v), 0x121, 0xf, 0xf, false));
    const int vi = __float_as_int(v);
    return (__int_as_float(__builtin_amdgcn_readlane(vi, 0)) + __int_as_float(__builtin_amdgcn_readlane(vi, 16))) + (__int_as_float(__builtin_amdgcn_readlane(vi, 32)) + __int_as_float(__builtin_amdgcn_readlane(vi, 48)));
}
__device__ __forceinline__ float rcpf_(float x) { return __builtin_amdgcn_rcpf(x); }
__device__ __forceinline__ float sigmoidf_(float x) { return rcpf_(1.f + __expf(-x)); }
__device__ __forceinline__ float siluf_(float x) { return x * rcpf_(1.f + __expf(-x)); }
__device__ __forceinline__ float tanhf_(float x) { return 1.f - 2.f * rcpf_(1.f + __expf(2.f * x)); }

__device__ __forceinline__ float row_rstd(const unsigned char* ws, int slot, int row) {
    const f32x4* q = (const f32x4*)((const float*)(ws + WS_SS) + ((size_t)slot * M + row) * 16);
    const f32x4 a = q[0], b = q[1], c = q[2], d = q[3];
    const float ss = (((a.x + a.y) + (a.z + a.w)) + ((b.x + b.y) + (b.z + b.w))) + (((c.x + c.y) + (c.z + c.w)) + ((d.x + d.y) + (d.z + d.w)));
    return rsqrtf(ss * (1.f / D) + 1e-6f);
}
__device__ __forceinline__ float dpp_ror1(float v) { return __int_as_float(__builtin_amdgcn_update_dpp(0, __float_as_int(v), 0x121, 0xf, 0xf, false)); }
template <int CTRL> __device__ __forceinline__ float dpp_mv(float v) { return __int_as_float(__builtin_amdgcn_mov_dpp(__float_as_int(v), CTRL, 0xf, 0xf, true)); }
__device__ __forceinline__ float dpp_ror2(float v) { return __int_as_float(__builtin_amdgcn_update_dpp(0, __float_as_int(v), 0x122, 0xf, 0xf, false)); }
enum { EK_RETIN = 0, EK_RESID, EK_UG, EK_RWPROJ, EK_F32 };
template <int GRP> struct EpiExtra {};
template <> struct EpiExtra<1> { const float* pcw; const float* pcb; const float* pcst; float* pout; };
template <int GRP> struct EpiAnyT : EpiExtra<GRP> {
    static constexpr bool AFTER_DRAIN = false;
    int kind; bool perm; int jl; unsigned char* ws; int slot; const LAS float* rtab; float amul; int li; LAS unsigned char* ldsb;
    __device__ __forceinline__ void operator()(const f32x4 (&acc)[2][2][4][2], const Unit& u, int wr, int wc, int fr, int fq) const {
        const int row0 = u.pm * 256 + wr * 64 + fr;
        if (GRP == 0 && kind == EK_RETIN) {
            bf16* QK = (bf16*)(ws + WS_QK); bf16* V = (bf16*)(ws + WS_V); bf16* SG = (bf16*)(ws + WS_SG); const float* CS = (const float*)(ws + WS_CS);
            const int cw = wc * 32 + 8 * fq;
            if (u.pn < 8) {
                const bool isk = u.pn >= 4; const int h = u.pn & 3; const float sc = isk ? 0.0625f : 1.f;
                bf16* base = QK + (isk ? 1024 : 0) + h * 256 + cw;
#pragma unroll
                for (int ai = 0; ai < 2; ++ai) {
                    f32x4 tt[4][4];
#pragma unroll
                    for (int m = 0; m < 4; ++m) { const int row = row0 + ai * 128 + m * 16; const int pi = row < MP ? row % TP : TP;
                        const f32x4* cs = (const f32x4*)(CS + ((size_t)pi * 128 + cw) * 2);
#pragma unroll
                        for (int q4 = 0; q4 < 4; ++q4) tt[m][q4] = cs[q4]; }
#pragma unroll
                    for (int m = 0; m < 4; ++m) {
                        const int row = row0 + ai * 128 + m * 16;
                        const float rs = rtab[u.ord * 256 + (row - u.pm * 256)] * sc;
                        const f32x4 t0 = tt[m][0], t1 = tt[m][1], t2 = tt[m][2], t3 = tt[m][3];
                        const float c[8] = {t0.x, t0.z, t1.x, t1.z, t2.x, t2.z, t3.x, t3.z}, s[8] = {t0.y, t0.w, t1.y, t1.w, t2.y, t2.w, t3.y, t3.w};
                        float o1[8], o2[8];
#pragma unroll
                        for (int n = 0; n < 2; ++n)
#pragma unroll
                            for (int j = 0; j < 4; ++j) {
                                const float x1 = acc[ai][0][m][n][j], x2 = acc[ai][1][m][n][j];
                                o1[n * 4 + j] = (x1 * c[n * 4 + j] - x2 * s[n * 4 + j]) * rs;
                                o2[n * 4 + j] = (x1 * s[n * 4 + j] + x2 * c[n * 4 + j]) * rs;
                            }
                        bf16* rp = base + (size_t)row * 2048;
                        *(v4u*)rp = pack8(o1); *(v4u*)(rp + 128) = pack8(o2);
                    }
                    asm volatile("" ::: "memory");
                }
            } else {
                const bool isg = u.pn >= 16;
                bf16* base = (isg ? SG : V) + ((u.pn - (isg ? 16 : 8)) * 256) + cw;
#pragma unroll
                for (int ai = 0; ai < 2; ++ai)
#pragma unroll
                    for (int m = 0; m < 4; ++m) {
                        bf16* rp = base + (size_t)(row0 + ai * 128 + m * 16) * 2048;
                        const float rs = rtab[u.ord * 256 + (wr * 64 + fr + ai * 128 + m * 16)];
#pragma unroll
                        for (int bj = 0; bj < 2; ++bj) {
                            float o[8];
#pragma unroll
                            for (int n = 0; n < 2; ++n)
#pragma unroll
                                for (int j = 0; j < 4; ++j) { const float x = acc[ai][bj][m][n][j] * rs; o[n * 4 + j] = isg ? siluf_(x) : x; }
                            *(v4u*)(rp + bj * 128) = pack8(o);
                        }
                    }
            }
        } else if (GRP == 0 && kind == EK_RESID) {
            float* X = (float*)(ws + WS_X);
            const int col0 = u.pn * 256 + wc * 32 + 4 * fq;
#pragma unroll
            for (int am = 0; am < 4; ++am) { const int ai = am >> 1, mb = (am & 1) * 2;
                f32x4 xv[2][2][2];
#pragma unroll
                for (int mm = 0; mm < 2; ++mm) { const int m = mb + mm; const float* rp = X + (size_t)(row0 + ai * 128 + m * 16) * D + col0;
#pragma unroll
                    for (int bj = 0; bj < 2; ++bj)
#pragma unroll
                        for (int n = 0; n < 2; ++n) xv[mm][bj][n] = *(const f32x4*)(rp + bj * 128 + n * 16); }
#pragma unroll
                for (int mm = 0; mm < 2; ++mm) { const int m = mb + mm;
                    const int row = row0 + ai * 128 + m * 16;
                    float* rp = X + (size_t)row * D + col0; bf16* xb = (bf16*)(ws + WS_XB) + (size_t)row * D + col0;
                    float ssq = 0.f;
#pragma unroll
                    for (int bj = 0; bj < 2; ++bj)
#pragma unroll
                        for (int n = 0; n < 2; ++n) { const f32x4 v = xv[mm][bj][n] + acc[ai][bj][m][n] * amul; *(f32x4*)(rp + bj * 128 + n * 16) = v;
                            if (slot >= 0) { ssq += (v.x * v.x + v.y * v.y) + (v.z * v.z + v.w * v.w); v2u w; w.x = cvt_pk_bf16(v.x, v.y); w.y = cvt_pk_bf16(v.z, v.w); *(v2u*)(xb + bj * 128 + n * 16) = w; } }
                    if (slot >= 0) { ssq += shfl_xor_l(ssq, 16, fq * 16 + fr); ssq += shfl_xor_l(ssq, 32, fq * 16 + fr); if (fq == 0) ((float*)(ws + WS_SS))[((size_t)slot * M + row) * 16 + u.pn * 4 + wc] = ssq; }
                }
                asm volatile("" ::: "memory");
            }
        } else if (GRP == 1 && kind == EK_UG) {
            const EpiExtra<1>& X1 = *(const EpiExtra<1>*)(const void*)this;
            const float* cw = X1.pcw + (size_t)li * 3 * DFF; const float* cb = X1.pcb + (size_t)li * DFF; const float* cst = X1.pcst + (size_t)li * SB * 2 * DFF;
            float* cvp = X1.pout + O_CVP + (size_t)li * BATCH * 2 * DFF; float* cvs = X1.pout + O_CVS + (size_t)li * SB * 2 * DFF;
            bf16* ACT = (bf16*)(ws + WS_ACT);
            const int fl = wc * 32 + 8 * fq;
            LAS float* halo = (LAS float*)(ldsb + 131072 + 8192);
            const LAS float* rt = rtab + u.ord * 256;
#pragma unroll
            for (int ai = 0; ai < 2; ++ai) if (fr >= 14) {
                const float rs = rt[128 * ai + 64 * wr + 48 + fr];
                LAS float* hp = halo + ((2 * ai + wr) * 2 + (fr - 14)) * 128 + fl;
                *(LAS f32x4*)hp = acc[ai][1][3][0] * rs; *(LAS f32x4*)(hp + 4) = acc[ai][1][3][1] * rs;
            }
            asm volatile("s_waitcnt lgkmcnt(0)" ::: "memory"); __builtin_amdgcn_s_barrier(); asm volatile("" ::: "memory");
            const int R0 = 254 * u.pm - 2, bq = (R0 + 2) / TP, tq = (R0 + 2) - bq * TP;
            const bool plain = (R0 + 255 < MP) && tq >= 2 && tq + 253 < TP - 2;
            if (plain) {
                const bool k15 = fr == 15, k14 = fr >= 14;
#pragma unroll
                for (int n = 0; n < 2; ++n) {
                    const int f0 = u.pn * 128 + fl + 4 * n;
                    const f32x4 w0 = *(const f32x4*)(cw + f0), w1 = *(const f32x4*)(cw + DFF + f0), w2 = *(const f32x4*)(cw + 2 * DFF + f0), bb = *(const f32x4*)(cb + f0);
                    const unsigned ob = (unsigned)((R0 + 64 * wr + fr) * DFF + f0) * 2u;
                    f32x4 prev = (f32x4){0.f, 0.f, 0.f, 0.f};
#pragma unroll
                    for (int ai = 0; ai < 2; ++ai)
#pragma unroll
                        for (int m = 0; m < 4; ++m) {
                            const int l = 128 * ai + 64 * wr + 16 * m + fr;
                            const float rs = rt[l];
                            const f32x4 cur = acc[ai][1][m][n] * rs, uu = acc[ai][0][m][n] * rs;
                            if (m == 0) {
                                const int B = 2 * ai + wr;
                                prev = (f32x4){0.f, 0.f, 0.f, 0.f};
                                if (B > 0 && fr >= 14) prev = *(const LAS f32x4*)(halo + ((B - 1) * 2 + (fr - 14)) * 128 + fl + 4 * n);
                            }
                            float ov[4];
#pragma unroll
                            for (int e = 0; e < 4; ++e) {
                                const float ce = cur[e], pe = prev[e];
                                const float g1 = dpp_mv<0x121>(k15 ? pe : ce), g2 = dpp_mv<0x122>(k14 ? pe : ce);
                                const float cv = fmaf(w0[e], g2, fmaf(w1[e], g1, fmaf(w2[e], ce, bb[e])));
                                ov[e] = siluf_(cv) * uu[e];
                            }
                            v2u w; w.x = cvt_pk_bf16(ov[0], ov[1]); w.y = cvt_pk_bf16(ov[2], ov[3]);
                            if (ai > 0 || m > 0 || l >= 2) *(v2u*)((unsigned char*)ACT + (ob + (unsigned)((128 * ai + 16 * m) * DFF * 2))) = w;
                            prev = cur;
                        }
                }
            } else
#pragma unroll
            for (int n = 0; n < 2; ++n) {
                const int f0 = u.pn * 128 + fl + 4 * n;
                const f32x4 w0 = *(const f32x4*)(cw + f0), w1 = *(const f32x4*)(cw + DFF + f0), w2 = *(const f32x4*)(cw + 2 * DFF + f0), bb = *(const f32x4*)(cb + f0);
                f32x4 prev = (f32x4){0.f, 0.f, 0.f, 0.f};
#pragma unroll
                for (int ai = 0; ai < 2; ++ai)
#pragma unroll
                    for (int m = 0; m < 4; ++m) {
                        const int l = 128 * ai + 64 * wr + 16 * m + fr, row = 254 * u.pm - 2 + l;
                        const float rs = rt[l];
                        const f32x4 cur = acc[ai][1][m][n] * rs, uu = acc[ai][0][m][n] * rs;
                        if (m == 0) {
                            const int B = 2 * ai + wr;
                            prev = (f32x4){0.f, 0.f, 0.f, 0.f};
                            if (B > 0 && fr >= 14) prev = *(const LAS f32x4*)(halo + ((B - 1) * 2 + (fr - 14)) * 128 + fl + 4 * n);
                        }
                        f32x4 g1, g2;
                        {
                            const float c1x = dpp_ror1(cur.x), c1y = dpp_ror1(cur.y), c1z = dpp_ror1(cur.z), c1w = dpp_ror1(cur.w);
                            const float p1x = dpp_ror1(prev.x), p1y = dpp_ror1(prev.y), p1z = dpp_ror1(prev.z), p1w = dpp_ror1(prev.w);
                            const float c2x = dpp_ror2(cur.x), c2y = dpp_ror2(cur.y), c2z = dpp_ror2(cur.z), c2w = dpp_ror2(cur.w);
                            const float p2x = dpp_ror2(prev.x), p2y = dpp_ror2(prev.y), p2z = dpp_ror2(prev.z), p2w = dpp_ror2(prev.w);
                            const bool s1 = fr >= 1, s2 = fr >= 2;
                            g1.x = s1 ? c1x : p1x; g1.y = s1 ? c1y : p1y; g1.z = s1 ? c1z : p1z; g1.w = s1 ? c1w : p1w;
                            g2.x = s2 ? c2x : p2x; g2.y = s2 ? c2y : p2y; g2.z = s2 ? c2z : p2z; g2.w = s2 ? c2w : p2w;
                        }
                        if (l >= 2 && row < M) {
                            if (row < MP) {
                                const int b = row / TP, t = row - b * TP;
                                if (t < 2) { g2 = (f32x4){0.f, 0.f, 0.f, 0.f}; if (t == 0) g1 = g2; }
                                if (t >= TP - 2) *(f32x4*)(cvp + ((size_t)b * 2 + (t - (TP - 2))) * DFF + f0) = cur;
                            } else {
                                const int s = row - MP;
                                const float* c0 = cst + ((size_t)s * 2 + 0) * DFF + f0;
                                g2 = *(const f32x4*)c0; g1 = *(const f32x4*)(c0 + DFF);
                                float* o = cvs + ((size_t)s * 2 + 0) * DFF + f0;
                                *(f32x4*)o = g1; *(f32x4*)(o + DFF) = cur;
                            }
                            const f32x4 cv = bb + w0 * g2 + w1 * g1 + w2 * cur;
                            v2u w; w.x = cvt_pk_bf16(siluf_(cv.x) * uu.x, siluf_(cv.y) * uu.y); w.y = cvt_pk_bf16(siluf_(cv.z) * uu.z, siluf_(cv.w) * uu.w);
                            *(v2u*)(ACT + (size_t)row * DFF + f0) = w;
                        }
                        prev = cur;
                    }
            }
        } else if (GRP == 0 && kind == EK_RWPROJ) {
            const int cw = wc * 32 + 8 * fq;
            if (u.pn < 12) {
                bf16* dst = (bf16*)(ws + (u.pn < 4 ? WS_R : (u.pn < 8 ? WS_K : (jl == 0 ? WS_VF : WS_VB)))) + (u.pn & 3) * 256 + cw;
#pragma unroll
                for (int ai = 0; ai < 2; ++ai)
#pragma unroll
                    for (int m = 0; m < 4; ++m) {
                        bf16* rp = dst + (size_t)(row0 + ai * 128 + m * 16) * D;
#pragma unroll
                        for (int bj = 0; bj < 2; ++bj) { float o[8];
#pragma unroll
                            for (int n = 0; n < 2; ++n)
#pragma unroll
                                for (int j = 0; j < 4; ++j) o[n * 4 + j] = acc[ai][bj][m][n][j];
                            *(v4u*)(rp + bj * 128) = pack8(o); }
                    }
            } else {
                bf16* A2 = (bf16*)(ws + WS_A2);
#pragma unroll
                for (int bj = 0; bj < 2; ++bj) {
                    const int c = (u.pn - 12) * 256 + bj * 128 + cw;
                    if (c < KL2) {
                        const int kd = c < 64 ? 1 : ((c >= 128 && c < 288) ? 2 : 0);
#pragma unroll
                        for (int ai = 0; ai < 2; ++ai)
#pragma unroll
                            for (int m = 0; m < 4; ++m) { float o[8];
#pragma unroll
                                for (int n = 0; n < 2; ++n)
#pragma unroll
                                    for (int j = 0; j < 4; ++j) { const float x = acc[ai][bj][m][n][j]; o[n * 4 + j] = kd == 1 ? tanhf_(x) : (kd == 2 ? sigmoidf_(x) : x); }
                                *(v4u*)(A2 + (size_t)(row0 + ai * 128 + m * 16) * KL2 + c) = pack8(o); }
                    }
                }
            }
        } else if (GRP == 0) {
            bf16* C = (bf16*)(ws + WS_L2);
            const int col0 = u.pn * 256 + wc * 32 + 8 * fq;
#pragma unroll
            for (int ai = 0; ai < 2; ++ai)
#pragma unroll
                for (int m = 0; m < 4; ++m) {
                    bf16* rp = C + (size_t)(row0 + ai * 128 + m * 16) * NL2 + col0;
#pragma unroll
                    for (int bj = 0; bj < 2; ++bj) { float o[8];
#pragma unroll
                        for (int n = 0; n < 2; ++n)
#pragma unroll
                            for (int j = 0; j < 4; ++j) o[n * 4 + j] = acc[ai][bj][m][n][j];
                        *(v4u*)(rp + bj * 128) = pack8(o); }
                }
        }
    }
};

constexpr int MT0 = 16384;
__device__ __forceinline__ void tail_resid(const bf16* __restrict__ A, const bf16* __restrict__ Bt, int K, unsigned char* ws, int slot, float amul, LAS unsigned char* lds, int lane, int wave) {
    const int fr = lane & 15, fq = lane >> 4;
    float* X = (float*)(ws + WS_X);
    const int kw = K >> 3;
    for (int job = blockIdx.x; job < 16 * 16; job += gridDim.x) {
        const int rs = job >> 4, cs = job & 15;
        const bf16* ap = A + (size_t)(MT0 + 16 * rs + fr) * K + wave * kw + 8 * fq;
        const bf16* bp = Bt + (size_t)(64 * cs + fr) * K + wave * kw + 8 * fq;
        f32x4 acc[4];
#pragma unroll
        for (int t = 0; t < 4; ++t) acc[t] = (f32x4){0.f, 0.f, 0.f, 0.f};
#pragma unroll 4
        for (int k0 = 0; k0 < kw; k0 += 32) {
            const bf16x8 af = *(const bf16x8*)(ap + k0);
#pragma unroll
            for (int t = 0; t < 4; ++t) { const bf16x8 bf = *(const bf16x8*)(bp + (size_t)(16 * t) * K + k0); acc[t] = __builtin_amdgcn_mfma_f32_16x16x32_bf16(bf, af, acc[t], 0, 0, 0); }
        }
        __syncthreads();
#pragma unroll
        for (int t = 0; t < 4; ++t) *(LAS f32x4*)(lds + ((wave * 4 + t) * 64 + lane) * 16) = acc[t];
        __syncthreads();
        if (wave == 0) {
#pragma unroll
            for (int t = 0; t < 4; ++t) { f32x4 s = acc[t];
#pragma unroll
                for (int w = 1; w < 8; ++w) s += *(LAS f32x4*)(lds + ((w * 4 + t) * 64 + lane) * 16);
                acc[t] = s; }
            const int row = MT0 + 16 * rs + fr;
            float* rp = X + (size_t)row * D + 64 * cs + 4 * fq; bf16* xb = (bf16*)(ws + WS_XB) + (size_t)row * D + 64 * cs + 4 * fq;
            float ssq = 0.f;
#pragma unroll
            for (int t = 0; t < 4; ++t) { const f32x4 v = *(const f32x4*)(rp + 16 * t) + acc[t] * amul; *(f32x4*)(rp + 16 * t) = v;
                if (slot >= 0) { ssq += (v.x * v.x + v.y * v.y) + (v.z * v.z + v.w * v.w); v2u w; w.x = cvt_pk_bf16(v.x, v.y); w.y = cvt_pk_bf16(v.z, v.w); *(v2u*)(xb + 16 * t) = w; } }
            if (slot >= 0) { ssq += shfl_xor_l(ssq, 16, lane); ssq += shfl_xor_l(ssq, 32, lane); if (fq == 0) ((float*)(ws + WS_SS))[((size_t)slot * M + row) * 16 + cs] = ssq; }
        }
    }
}

__device__ __forceinline__ void tr_item(const float* __restrict__ W, int ldw, int k0, int n0, bf16* __restrict__ WT, int ldt, int drow, const float* __restrict__ mu, LAS float* scr, int lane, const float* __restrict__ gs = nullptr) {
#pragma unroll 8
    for (int i = 0; i < 32; ++i) { const int kk = 2 * i + (lane >> 5); scr[kk * 33 + (lane & 31)] = W[(size_t)(k0 + kk) * ldw + n0 + (lane & 31)]; }
    asm volatile("s_waitcnt lgkmcnt(0)" ::: "memory");
    const int c = lane & 7;
    float mv[8];
    if (mu) {
#pragma unroll
        for (int e = 0; e < 8; ++e) mv[e] = mu[k0 + 8 * c + e];
    } else if (gs) {
#pragma unroll
        for (int e = 0; e < 8; ++e) mv[e] = gs[k0 + 8 * c + e];
    }
#pragma unroll
    for (int j = 0; j < 4; ++j) {
        const int n = (lane >> 3) + 8 * j; const LAS float* s = scr + (8 * c) * 33 + n;
        float f[8];
#pragma unroll
        for (int e = 0; e < 8; ++e) f[e] = s[e * 33];
        bf16* dp = WT + (size_t)(drow + n) * ldt + k0 + 8 * c;
        if (mu) {
            float f1[8], f2[8];
#pragma unroll
            for (int e = 0; e < 8; ++e) { f1[e] = f[e] * (1.f - mv[e]); f2[e] = f[e] * mv[e]; }
            *(v4u*)dp = pack8(f1); *(v4u*)(dp + 1024) = pack8(f2);
        } else { if (gs) {
#pragma unroll
            for (int e = 0; e < 8; ++e) f[e] *= mv[e]; }
            *(v4u*)dp = pack8(f); }
    }
    asm volatile("s_waitcnt lgkmcnt(0)" ::: "memory");
}

__device__ __forceinline__ void ph_p0(const Params& p, LAS unsigned char* lds, int tid, int lane, int wave) {
    unsigned char* ws = p.ws;
    LAS float* scr = (LAS float*)(lds + wave * 16384);
    const int gw = blockIdx.x * NWAVES + wave, NGW = gridDim.x * NWAVES;
    constexpr int C_WIN = 2 * 16 * 192, C_WOUT = 2 * 32 * 32, C_RKV = 2 * 3 * 512, C_W1 = 2 * 32, C_A1 = 2 * 32, C_G1 = 2 * 80, C_V1 = 16, C_WO = 2 * 512, C_WUG = 4 * 16 * 176, C_WD = 4 * 44 * 32;
    constexpr int NITEMS = C_WIN + C_WOUT + C_RKV + C_W1 + C_A1 + C_G1 + C_V1 + C_WO + C_WUG + C_WD;
    for (int it = gw; it < NITEMS; it += NGW) {
        int r = it;
        if (r < C_WIN) { const int j = r / 3072, q = r % 3072, kb = q / 192, nb = q % 192;
            tr_item(p.in[I_RWIN] + (size_t)j * D * RWIN, RWIN, 64 * kb, 32 * nb, (bf16*)(ws + WS_WIN + j * SZ_WIN), D, 32 * nb, nullptr, scr, lane, p.in[I_NMIX] + (size_t)(2 * j) * D); continue; }
        r -= C_WIN;
        if (r < C_WOUT) { const int j = r / 1024, q = r % 1024, kb = q / 32, nb = q % 32;
            tr_item(p.in[I_RWOUT] + (size_t)j * RV * D, D, 64 * kb, 32 * nb, (bf16*)(ws + WS_WOUT + j * SZ_WOUT), RV, 32 * nb, nullptr, scr, lane); continue; }
        r -= C_WOUT;
        if (r < C_RKV) { const int j = r / 1536, q = r % 1536, s = q / 512, q2 = q % 512, kb = q2 / 32, nb = q2 % 32, c = (s == 0 ? 0 : (s == 1 ? 2 : 3));
            tr_item(p.in[I_WRKV] + (size_t)(j * 3 + s) * D * D, D, 64 * kb, 32 * nb, (bf16*)(ws + WS_WRW + j * SZ_WRW), KRW, s * 1024 + 32 * nb, p.in[I_MU] + (size_t)(j * 6 + c) * D, scr, lane); continue; }
        r -= C_RKV;
        if (r < C_W1) { const int j = r / 32, q = r % 32, kb = q / 2, nb = q % 2;
            tr_item(p.in[I_W1] + (size_t)j * D * LW, LW, 64 * kb, 32 * nb, (bf16*)(ws + WS_WRW + j * SZ_WRW), KRW, 3072 + 32 * nb, p.in[I_MU] + (size_t)(j * 6 + 1) * D, scr, lane); continue; }
        r -= C_W1;
        if (r < C_A1) { const int j = r / 32, q = r % 32, kb = q / 2, nb = q % 2;
            tr_item(p.in[I_A1] + (size_t)j * D * LA, LA, 64 * kb, 32 * nb, (bf16*)(ws + WS_WRW + j * SZ_WRW), KRW, 3136 + 32 * nb, p.in[I_MU] + (size_t)(j * 6 + 4) * D, scr, lane); continue; }
        r -= C_A1;
        if (r < C_G1) { const int j = r / 80, q = r % 80, kb = q / 5, nb = q % 5;
            tr_item(p.in[I_G1] + (size_t)j * D * LG, LG, 64 * kb, 32 * nb, (bf16*)(ws + WS_WRW + j * SZ_WRW), KRW, 3200 + 32 * nb, p.in[I_MU] + (size_t)(j * 6 + 5) * D, scr, lane); continue; }
        r -= C_G1;
        if (r < C_V1) { const int kb = r;
            tr_item(p.in[I_V1], LV, 64 * kb, 0, (bf16*)(ws + WS_WRW + 1 * SZ_WRW), KRW, 3360, p.in[I_MU] + (size_t)(1 * 6 + 3) * D, scr, lane); continue; }
        r -= C_V1;
        if (r < C_WO) { const int j = r / 512, q = r % 512, kb = q / 32, nb = q % 32;
            tr_item(p.in[I_WO] + (size_t)j * D * D, D, 64 * kb, 32 * nb, (bf16*)(ws + WS_WO + j * SZ_WO), D, 32 * nb, nullptr, scr, lane); continue; }
        r -= C_WO;
        if (r < C_WUG) { const int i = r / 2816, q = r % 2816, kb = q / 176, nb = q % 176, n0 = 32 * nb;
            const int drow = n0 < DFF ? 256 * (n0 / 128) + (n0 % 128) : 256 * ((n0 - DFF) / 128) + 128 + ((n0 - DFF) % 128);
            tr_item(p.in[I_WUG] + (size_t)i * D * 2 * DFF, 2 * DFF, 64 * kb, n0, (bf16*)(ws + WS_WUG + i * SZ_WUG), D, drow, nullptr, scr, lane, p.in[I_NFFN] + (size_t)i * D); continue; }
        r -= C_WUG;
        { const int i = r / 1408, q = r % 1408, kb = q / 32, nb = q % 32;
            tr_item(p.in[I_WD] + (size_t)i * DFF * D, D, 64 * kb, 32 * nb, (bf16*)(ws + WS_WD + i * SZ_WD), DFF, 32 * nb, nullptr, scr, lane); }
    }
    const size_t gt = (size_t)blockIdx.x * NTHR + tid, GT = (size_t)gridDim.x * NTHR;
    for (size_t i = gt; i < (size_t)(224 + 192) * (KRW / 8); i += GT) {
        const int rr = (int)(i / (KRW / 8)), c8 = (int)(i % (KRW / 8));
        const int j = rr < 224 ? 0 : 1, row = rr < 224 ? 3360 + rr : 3392 + (rr - 224);
        *(v4u*)((bf16*)(ws + WS_WRW + j * SZ_WRW) + (size_t)row * KRW + c8 * 8) = (v4u){0u, 0u, 0u, 0u};
    }
    for (size_t i = gt; i < (size_t)2 * NL2 * KL2; i += GT) {
        const int j = (int)(i / ((size_t)NL2 * KL2)); const int rem = (int)(i % ((size_t)NL2 * KL2)); const int n = rem / KL2, k = rem % KL2, grp = n >> 10, nn = n & 1023;
        float v = 0.f;
        if (grp == 0) { if (k < 64) v = p.in[I_W2][((size_t)j * LW + k) * D + nn]; }
        else if (grp == 1) { if (k >= 64 && k < 128) v = p.in[I_A2][((size_t)j * LA + (k - 64)) * D + nn]; }
        else if (grp == 2) { if (k >= 128 && k < 288) v = p.in[I_G2][((size_t)j * LG + (k - 128)) * D + nn]; }
        else { if (j == 1 && k >= 288 && k < 320) v = p.in[I_V2][((size_t)(k - 288)) * D + nn]; }
        ((bf16*)(ws + WS_WL2 + j * SZ_WL2))[(size_t)n * KL2 + k] = (bf16)(cvt_pk_bf16(v, 0.f) & 0xffffu);
    }
    for (size_t i = gt; i < (size_t)(TP + 1) * 128; i += GT) {
        const int pi = (int)(i >> 7), mi = (int)(i & 127);
        const float pos = pi < TP ? (float)pi : PAST_POS;
        const float inv = 1.0f / powf(10000.0f, (float)mi / 127.0f);
        float s, c; sincosf(pos * inv, &s, &c);
        ((float2*)(ws + WS_CS))[i] = make_float2(c, s);
    }
    float* X = (float*)(ws + WS_X); bf16* XB = (bf16*)(ws + WS_XB);
    for (int r = gw; r < M; r += NGW) {
        const float* src;
        if (r < MP) { const int b = r / TP, t = r % TP; src = t < NMETA ? p.in[I_META] + (size_t)t * D : p.in[I_XP] + ((size_t)b * SEQ + (t - NMETA)) * D; }
        else src = p.in[I_XS] + (size_t)(r - MP) * D;
        float ss = 0.f;
#pragma unroll
        for (int j = 0; j < 2; ++j) { const int c0 = 512 * j + 8 * lane;
            const f32x4 a4 = *(const f32x4*)(src + c0), b4 = *(const f32x4*)(src + c0 + 4);
            *(f32x4*)(X + (size_t)r * D + c0) = a4; *(f32x4*)(X + (size_t)r * D + c0 + 4) = b4;
            const float f[8] = {a4.x, a4.y, a4.z, a4.w, b4.x, b4.y, b4.z, b4.w};
#pragma unroll
            for (int e = 0; e < 8; ++e) ss += f[e] * f[e];
            *(v4u*)(XB + (size_t)r * D + c0) = pack8(f); }
        ss = wave_sum(ss, lane);
        if (lane < 16) ((float*)(ws + WS_SS))[(size_t)r * 16 + lane] = lane == 0 ? ss : 0.f;
    }
}

__device__ __forceinline__ void ph_norm(const Params& p, const float* __restrict__ g, int mode, int jl, int lane, int wave) {
    const float* X = (const float*)(p.ws + WS_X); bf16* H = (bf16*)(p.ws + WS_H);
    const int gw = blockIdx.x * NWAVES + wave, NGW = gridDim.x * NWAVES;
    for (int row = gw; row < M; row += NGW) {
        const float* xr = X + (size_t)row * D;
        float v[2][8]; float ss = 0.f;
#pragma unroll
        for (int j = 0; j < 2; ++j) {
            const f32x4 a = *(const f32x4*)(xr + 512 * j + 8 * lane), b = *(const f32x4*)(xr + 512 * j + 8 * lane + 4);
            v[j][0] = a.x; v[j][1] = a.y; v[j][2] = a.z; v[j][3] = a.w; v[j][4] = b.x; v[j][5] = b.y; v[j][6] = b.z; v[j][7] = b.w;
#pragma unroll
            for (int e = 0; e < 8; ++e) ss += v[j][e] * v[j][e];
        }
        ss = wave_sum(ss, lane);
        const float rstd = rsqrtf(ss * (1.f / D) + 1e-6f);
        const bool prompt = row < MP; const int b = prompt ? row / TP : 0, t = prompt ? row % TP : 0;
#pragma unroll
        for (int j = 0; j < 2; ++j) {
            const int c0 = 512 * j + 8 * lane;
            const f32x4 ga = *(const f32x4*)(g + c0), gb = *(const f32x4*)(g + c0 + 4);
            float o[8];
            o[0] = v[j][0] * rstd * ga.x; o[1] = v[j][1] * rstd * ga.y; o[2] = v[j][2] * rstd * ga.z; o[3] = v[j][3] * rstd * ga.w;
            o[4] = v[j][4] * rstd * gb.x; o[5] = v[j][5] * rstd * gb.y; o[6] = v[j][6] * rstd * gb.z; o[7] = v[j][7] * rstd * gb.w;
            if (mode == 0) { *(v4u*)(H + (size_t)row * D + c0) = pack8(o); }
            else if (mode == 1) {
                const v4u w = pack8(o);
                *(v4u*)(H + (size_t)row * 2048 + c0) = w;
                if (prompt) {
                    if (t != TP - 1) *(v4u*)(H + (size_t)(row + 1) * 2048 + 1024 + c0) = w;
                    else { float* so = p.out + O_SHP + ((size_t)jl * BATCH + b) * D + c0; *(f32x4*)so = (f32x4){o[0], o[1], o[2], o[3]}; *(f32x4*)(so + 4) = (f32x4){o[4], o[5], o[6], o[7]}; }
                    if (t == 0) *(v4u*)(H + (size_t)row * 2048 + 1024 + c0) = (v4u){0u, 0u, 0u, 0u};
                } else {
                    const int s = row - MP;
                    const float* sp = p.in[I_SSHIFT] + ((size_t)jl * SB + s) * D + c0;
                    const f32x4 sa = *(const f32x4*)sp, sb2 = *(const f32x4*)(sp + 4);
                    const float pv[8] = {sa.x, sa.y, sa.z, sa.w, sb2.x, sb2.y, sb2.z, sb2.w};
                    *(v4u*)(H + (size_t)row * 2048 + 1024 + c0) = pack8(pv);
                    float* so = p.out + O_SHS + ((size_t)jl * SB + s) * D + c0; *(f32x4*)so = (f32x4){o[0], o[1], o[2], o[3]}; *(f32x4*)(so + 4) = (f32x4){o[4], o[5], o[6], o[7]};
                }
            } else {
                float* dst = nullptr;
                if (prompt) { if (t >= NMETA) dst = p.out + O_YP + ((size_t)b * SEQ + (t - NMETA)) * D + c0; }
                else dst = p.out + O_YS + (size_t)(row - MP) * D + c0;
                if (dst) { *(f32x4*)dst = (f32x4){o[0], o[1], o[2], o[3]}; *(f32x4*)(dst + 4) = (f32x4){o[4], o[5], o[6], o[7]}; }
            }
        }
    }
}

__device__ __forceinline__ void ph_ret_norm(const Params& p, int jl, int lane, int wave) {
    const bf16* O = (const bf16*)(p.ws + WS_O); const bf16* SG = (const bf16*)(p.ws + WS_SG); bf16* Y = (bf16*)(p.ws + WS_Y);
    const float* gnw = p.in[I_RGN] + (size_t)jl * RV;
    const int gw = blockIdx.x * NWAVES + wave, NGW = gridDim.x * NWAVES;
    constexpr int UB = 4;
    for (int it0 = gw; it0 < M * RH; it0 += NGW * UB) {
        const int h = it0 & 3;
        const f32x4 ga = *(const f32x4*)(gnw + h * RDV + 8 * lane), gb = *(const f32x4*)(gnw + h * RDV + 8 * lane + 4);
        const float gg[8] = {ga.x, ga.y, ga.z, ga.w, gb.x, gb.y, gb.z, gb.w};
        v4u ov[UB], sgv[UB];
#pragma unroll
        for (int q = 0; q < UB; ++q) { const int it = it0 + q * NGW, itc = it < M * RH ? it : it0; const size_t off = (size_t)(itc >> 2) * RV + h * RDV + 8 * lane;
            ov[q] = *(const v4u*)(O + off); sgv[q] = *(const v4u*)(SG + off); }
#pragma unroll
        for (int q = 0; q < UB; ++q) { const int it = it0 + q * NGW; const size_t off = (size_t)(it >> 2) * RV + h * RDV + 8 * lane;
            float v[8]; unpack8(ov[q], v);
            float s = 0.f;
#pragma unroll
            for (int e = 0; e < 8; ++e) s += v[e];
            const float mean = wave_sum(s, lane) * (1.f / RDV);
            float s2 = 0.f;
#pragma unroll
            for (int e = 0; e < 8; ++e) { v[e] -= mean; s2 += v[e] * v[e]; }
            const float rstd = rsqrtf(wave_sum(s2, lane) * (1.f / RDV) + 1e-5f);
            float sg[8]; unpack8(sgv[q], sg);
            float o[8];
#pragma unroll
            for (int e = 0; e < 8; ++e) o[e] = v[e] * rstd * gg[e] * sg[e];
            if (it < M * RH) *(v4u*)(Y + off) = pack8(o);
        }
    }
}

__device__ __forceinline__ float row16_sum(float x);
__device__ __forceinline__ void ph_rwkv_post(const Params& p, int jl, int lane, int wave) {
    const bf16* YW = (const bf16*)(p.ws + WS_YW); const bf16* R = (const bf16*)(p.ws + WS_R); const bf16* KM = (const bf16*)(p.ws + WS_NKK);
    const bf16* VP = (const bf16*)(p.ws + WS_KKA); const bf16* L2 = (const bf16*)(p.ws + WS_L2); bf16* Z = (bf16*)(p.ws + WS_Z);
    const float* rk = p.in[I_RK] + (size_t)jl * D; const float* lnw = p.in[I_LNW] + (size_t)jl * D; const float* lnb = p.in[I_LNB] + (size_t)jl * D;
    const int gw = blockIdx.x * NWAVES + wave, NGW = gridDim.x * NWAVES;
    const int sub = lane >> 4, c4 = lane & 15;
    constexpr int UB = 4;
    for (int it0 = gw * 4; it0 < M * WH; it0 += NGW * 4 * UB) {
        const int h = (it0 + sub) & 15, c = h * WN + 4 * c4;
        const f32x4 rk4 = *(const f32x4*)(rk + c), lw4 = *(const f32x4*)(lnw + c), lb4 = *(const f32x4*)(lnb + c);
        v2u y2[UB], r2[UB], k2[UB], v2[UB], g2[UB];
#pragma unroll
        for (int q = 0; q < UB; ++q) { const int it = it0 + q * NGW * 4 + sub, itc = it < M * WH ? it : it0 + sub, row = itc >> 4; const size_t idx = (size_t)row * D + c;
            y2[q] = *(const v2u*)(YW + idx); r2[q] = *(const v2u*)(R + idx); k2[q] = *(const v2u*)(KM + idx); v2[q] = *(const v2u*)(VP + idx); g2[q] = *(const v2u*)(L2 + (size_t)row * NL2 + 2048 + c); }
#pragma unroll
        for (int q = 0; q < UB; ++q) { const int it = it0 + q * NGW * 4 + sub, row = it >> 4; const size_t idx = (size_t)row * D + c;
            const f32x4 r4 = (f32x4){bf_lo(r2[q].x), bf_hi(r2[q].x), bf_lo(r2[q].y), bf_hi(r2[q].y)}, k4 = (f32x4){bf_lo(k2[q].x), bf_hi(k2[q].x), bf_lo(k2[q].y), bf_hi(k2[q].y)};
            const f32x4 v4 = (f32x4){bf_lo(v2[q].x), bf_hi(v2[q].x), bf_lo(v2[q].y), bf_hi(v2[q].y)}, g4 = (f32x4){bf_lo(g2[q].x), bf_hi(g2[q].x), bf_lo(g2[q].y), bf_hi(g2[q].y)};
            const f32x4 yv = (f32x4){bf_lo(y2[q].x), bf_hi(y2[q].x), bf_lo(y2[q].y), bf_hi(y2[q].y)};
            const float mean = row16_sum((yv.x + yv.y) + (yv.z + yv.w)) * (1.f / WN);
            const f32x4 yc = yv - mean;
            const float rstd = rsqrtf(row16_sum((yc.x * yc.x + yc.y * yc.y) + (yc.z * yc.z + yc.w * yc.w)) * (1.f / WN) + 64e-5f);
            const f32x4 rkk = r4 * k4 * rk4;
            const float bon = row16_sum((rkk.x + rkk.y) + (rkk.z + rkk.w));
            const f32x4 z = (yc * rstd * lw4 + lb4 + v4 * bon) * g4;
            if (it < M * WH) st_bf4(Z + idx, z);
        }
    }
}

constexpr int RT_KP = 528, RT_VP = 144, RT_SP = 528;
constexpr int RT_K_OFF = 0, RT_V_OFF = 128 * RT_KP, RT_ST_OFF = RT_V_OFF + 128 * RT_VP, RT_END = RT_ST_OFF + 64 * RT_SP;
static_assert(RT_END <= LDS_BYTES, "retention LDS map");
typedef short v4s __attribute__((ext_vector_type(4)));
__device__ __forceinline__ bf16x8 tr_pair(LAS unsigned char* a0, LAS unsigned char* a1) {
    const v4s lo = __builtin_amdgcn_ds_read_tr16_b64_v4i16((LAS v4s*)a0), hi = __builtin_amdgcn_ds_read_tr16_b64_v4i16((LAS v4s*)a1);
    return __builtin_shufflevector(lo, hi, 0, 1, 2, 3, 4, 5, 6, 7);
}
__device__ __forceinline__ void ph_ret_fast(const Params& p, int jl, LAS unsigned char* lds, int tid, int lane, int wave) {
    const bf16* QK = (const bf16*)(p.ws + WS_QK); const bf16* V = (const bf16*)(p.ws + WS_V); bf16* O = (bf16*)(p.ws + WS_O);
    const int fr = lane & 15, fq = lane >> 4, li_q = (lane & 15) >> 2, li_p = lane & 3;
    for (int u = blockIdx.x; u < BATCH * RH * 8; u += gridDim.x) {
        const int es = u & 7, h = (u >> 3) & 3, b = u >> 5;
        const float gamma = 1.0f - exp2f(-5.0f - (float)h), lg = log2f(gamma), g128 = exp2f(128.f * lg), g127 = exp2f(127.f * lg);
        const int i0 = 16 * wave, d0 = 32 * wave;
        f32x4 Sacc[2][4];
#pragma unroll
        for (int a = 0; a < 2; ++a)
#pragma unroll
            for (int c = 0; c < 4; ++c) Sacc[a][c] = (f32x4){0.f, 0.f, 0.f, 0.f};
        __syncthreads();
        for (int i = tid; i < 64 * RT_SP / 16; i += NTHR) *(LAS v4u*)(lds + RT_ST_OFF + i * 16) = (v4u){0u, 0u, 0u, 0u};
        v4u kst[8], vst[2];
        const bf16* Kg = QK + 1024 + 256 * h; const bf16* Vg = V + 512 * h + 64 * es; const bf16* Qg = QK + 256 * h;
#define RT_LOAD_STAGE(cc) do { \
            _Pragma("unroll") for (int k_ = 0; k_ < 8; ++k_) { const int id_ = tid + 512 * k_, row_ = id_ >> 5, ch_ = id_ & 31, t_ = 128 * (cc) - 112 + row_; \
                kst[k_] = t_ >= 0 ? *(const v4u*)(Kg + (size_t)(b * TP + t_) * 2048 + 8 * ch_) : (v4u){0u, 0u, 0u, 0u}; } \
            _Pragma("unroll") for (int k_ = 0; k_ < 2; ++k_) { const int id_ = tid + 512 * k_, row_ = id_ >> 3, ch_ = id_ & 7, t_ = 128 * (cc) - 112 + row_; \
                vst[k_] = t_ >= 0 ? *(const v4u*)(Vg + (size_t)(b * TP + t_) * 2048 + 8 * ch_) : (v4u){0u, 0u, 0u, 0u}; } } while (0)
        RT_LOAD_STAGE(0);
        for (int c = 0; c < 17; ++c) {
            __syncthreads();
#pragma unroll
            for (int k_ = 0; k_ < 8; ++k_) { const int id_ = tid + 512 * k_, row_ = id_ >> 5, ch_ = id_ & 31; *(LAS v4u*)(lds + RT_K_OFF + row_ * RT_KP + ch_ * 16) = kst[k_]; }
#pragma unroll
            for (int k_ = 0; k_ < 2; ++k_) { const int id_ = tid + 512 * k_, row_ = id_ >> 3, ch_ = id_ & 7;
                float f[8]; unpack8(vst[k_], f); const float sc = exp2f(-(float)row_ * lg);
#pragma unroll
                for (int e = 0; e < 8; ++e) f[e] *= sc;
                *(LAS v4u*)(lds + RT_V_OFF + row_ * RT_VP + ch_ * 16) = pack8(f); }
            bf16x8 Qf[8];
            { const int t_ = 128 * c - 112 + i0 + fr;
#pragma unroll
              for (int s = 0; s < 8; ++s) Qf[s] = t_ >= 0 ? *(const bf16x8*)(Qg + (size_t)(b * TP + t_) * 2048 + 32 * s + 8 * fq) : (bf16x8){0, 0, 0, 0, 0, 0, 0, 0}; }
            __syncthreads();
            bf16x8 Pf[4];
            { const int ii = i0 + fr; const float gi = exp2f((float)ii * lg);
#pragma unroll
              for (int s2 = 0; s2 < 4; ++s2) { f32x4 Dp[2];
#pragma unroll
                  for (int hh = 0; hh < 2; ++hh) { Dp[hh] = (f32x4){0.f, 0.f, 0.f, 0.f};
#pragma unroll
                      for (int s = 0; s < 8; ++s) { const bf16x8 Kf = *(const LAS bf16x8*)(lds + RT_K_OFF + (16 * (2 * s2 + hh) + fr) * RT_KP + (32 * s + 8 * fq) * 2);
                          Dp[hh] = __builtin_amdgcn_mfma_f32_16x16x32_bf16(Kf, Qf[s], Dp[hh], 0, 0, 0); } }
                  float f[8];
#pragma unroll
                  for (int hh = 0; hh < 2; ++hh)
#pragma unroll
                      for (int r = 0; r < 4; ++r) { const int jj = 16 * (2 * s2 + hh) + 4 * fq + r; f[hh * 4 + r] = ii >= jj ? Dp[hh][r] * gi : 0.f; }
                  const v4u w = pack8(f); Pf[s2] = __builtin_bit_cast(bf16x8, w); } }
            f32x4 Oacc[4];
#pragma unroll
            for (int et = 0; et < 4; ++et) { Oacc[et] = (f32x4){0.f, 0.f, 0.f, 0.f};
#pragma unroll
                for (int s = 0; s < 8; ++s) { const bf16x8 Sf = *(const LAS bf16x8*)(lds + RT_ST_OFF + (16 * et + fr) * RT_SP + (32 * s + 8 * fq) * 2);
                    Oacc[et] = __builtin_amdgcn_mfma_f32_16x16x32_bf16(Qf[s], Sf, Oacc[et], 0, 0, 0); } }
            __syncthreads();
            if (c + 1 < 17) RT_LOAD_STAGE(c + 1);
#pragma unroll
            for (int r = 0; r < 4; ++r) { const float lam = exp2f((float)(i0 + 4 * fq + r + 1) * lg);
#pragma unroll
                for (int et = 0; et < 4; ++et) Oacc[et][r] *= lam; }
#pragma unroll
            for (int et = 0; et < 4; ++et)
#pragma unroll
                for (int s = 0; s < 4; ++s) {
                    LAS unsigned char* a0 = lds + RT_V_OFF + (32 * s + 4 * fq + li_q) * RT_VP + (16 * et + 4 * li_p) * 2;
                    const bf16x8 Vf = tr_pair(a0, a0 + 16 * RT_VP);
                    Oacc[et] = __builtin_amdgcn_mfma_f32_16x16x32_bf16(Pf[s], Vf, Oacc[et], 0, 0, 0); }
#pragma unroll
            for (int r = 0; r < 4; ++r) { const int t_ = 128 * c - 112 + i0 + 4 * fq + r;
                if (t_ >= 0) { bf16* op = O + (size_t)(b * TP + t_) * RV + 512 * h + 64 * es + fr;
#pragma unroll
                    for (int et = 0; et < 4; ++et) op[16 * et] = bf_cv(Oacc[et][r]); } }
#pragma unroll
            for (int dt = 0; dt < 2; ++dt)
#pragma unroll
                for (int et = 0; et < 4; ++et) Sacc[dt][et] = Sacc[dt][et] * (g128 / g127);
#pragma unroll
            for (int s = 0; s < 4; ++s) {
                bf16x8 Kt[2], Vt[4];
#pragma unroll
                for (int dt = 0; dt < 2; ++dt) { LAS unsigned char* a0 = lds + RT_K_OFF + (32 * s + 8 * fq + li_q) * RT_KP + (d0 + 16 * dt + 4 * li_p) * 2; Kt[dt] = tr_pair(a0, a0 + 4 * RT_KP); }
#pragma unroll
                for (int et = 0; et < 4; ++et) { LAS unsigned char* a0 = lds + RT_V_OFF + (32 * s + 8 * fq + li_q) * RT_VP + (16 * et + 4 * li_p) * 2; Vt[et] = tr_pair(a0, a0 + 4 * RT_VP); }
#pragma unroll
                for (int dt = 0; dt < 2; ++dt)
#pragma unroll
                    for (int et = 0; et < 4; ++et) Sacc[dt][et] = __builtin_amdgcn_mfma_f32_16x16x32_bf16(Kt[dt], Vt[et], Sacc[dt][et], 0, 0, 0);
            }
#pragma unroll
            for (int dt = 0; dt < 2; ++dt)
#pragma unroll
                for (int et = 0; et < 4; ++et) Sacc[dt][et] = Sacc[dt][et] * g127;
#pragma unroll
            for (int dt = 0; dt < 2; ++dt)
#pragma unroll
                for (int et = 0; et < 4; ++et) { v2u w; w.x = cvt_pk_bf16(Sacc[dt][et][0], Sacc[dt][et][1]); w.y = cvt_pk_bf16(Sacc[dt][et][2], Sacc[dt][et][3]);
                    *(LAS v2u*)(lds + RT_ST_OFF + (16 * et + fr) * RT_SP + (d0 + 16 * dt + 4 * fq) * 2) = w; }
        }
#undef RT_LOAD_STAGE
        float* so = p.out + O_RETP + ((((size_t)jl * BATCH + b) * RH + h) * RDK) * RDV + 64 * es;
#pragma unroll
        for (int dt = 0; dt < 2; ++dt)
#pragma unroll
            for (int et = 0; et < 4; ++et)
#pragma unroll
                for (int r = 0; r < 4; ++r) so[(size_t)(d0 + 16 * dt + 4 * fq + r) * RDV + 16 * et + fr] = Sacc[dt][et][r];
    }
    {
        LAS float* sq = (LAS float*)lds; LAS float* sk = sq + 256; LAS float* red = sk + 256;
        const int e4 = tid & 127, dq = tid >> 7;
        for (int it = blockIdx.x; it < SB * RH; it += gridDim.x) {
            const int h = it & 3, s = it >> 2, row = MP + s;
            const float gamma = 1.0f - exp2f(-5.0f - (float)h);
            __syncthreads();
            if (tid < 256) sq[tid] = bf_lo((unsigned)QK[(size_t)row * 2048 + 256 * h + tid]);
            else sk[tid - 256] = bf_lo((unsigned)QK[(size_t)row * 2048 + 1024 + 256 * h + (tid - 256)]);
            const v2u vv = *(const v2u*)(V + (size_t)row * 2048 + 512 * h + 4 * e4);
            const f32x4 v4 = (f32x4){bf_lo(vv.x), bf_hi(vv.x), bf_lo(vv.y), bf_hi(vv.y)};
            __syncthreads();
            const float* sin_ = p.in[I_SRET] + ((((size_t)jl * SB + s) * RH + h) * RDK) * RDV + 4 * e4;
            float* sout = p.out + O_RETS + ((((size_t)jl * SB + s) * RH + h) * RDK) * RDV + 4 * e4;
            f32x4 oacc = (f32x4){0.f, 0.f, 0.f, 0.f};
#pragma unroll 8
            for (int k = 0; k < 64; ++k) { const int d = dq + 4 * k;
                const f32x4 sv = __builtin_nontemporal_load((const f32x4*)(sin_ + (size_t)d * RDV));
                const f32x4 sn = sv * gamma + v4 * sk[d];
                oacc += sn * sq[d];
                __builtin_nontemporal_store(sn, (f32x4*)(sout + (size_t)d * RDV)); }
            *(LAS f32x4*)(red + dq * 512 + 4 * e4) = oacc;
            __syncthreads();
            if (dq == 0) { const f32x4 r = (*(LAS f32x4*)(red + 4 * e4) + *(LAS f32x4*)(red + 512 + 4 * e4)) + (*(LAS f32x4*)(red + 1024 + 4 * e4) + *(LAS f32x4*)(red + 1536 + 4 * e4));
                st_bf4(O + (size_t)row * RV + 512 * h + 4 * e4, r); }
        }
    }
}

typedef float f32x2w __attribute__((ext_vector_type(2)));
constexpr int WK_TB = 32, WK_STEP_B = 6 * 256 + 16, WK_BUF_B = WK_TB * WK_STEP_B, WK_Y_OFF = 2 * WK_BUF_B, WK_YB_B = WK_TB * 32 * 4;
static_assert(WK_Y_OFF + 2 * WK_YB_B <= LDS_BYTES - 16, "wkv LDS map");
__device__ __forceinline__ float row16_sum(float x) {
    x += __builtin_bit_cast(float, __builtin_amdgcn_update_dpp(0, __builtin_bit_cast(int, x), 0x128, 0xf, 0xf, false));
    x += __builtin_bit_cast(float, __builtin_amdgcn_update_dpp(0, __builtin_bit_cast(int, x), 0x124, 0xf, 0xf, false));
    x += __builtin_bit_cast(float, __builtin_amdgcn_update_dpp(0, __builtin_bit_cast(int, x), 0x122, 0xf, 0xf, false));
    x += __builtin_bit_cast(float, __builtin_amdgcn_update_dpp(0, __builtin_bit_cast(int, x), 0x121, 0xf, 0xf, false));
    return x;
}
__device__ __forceinline__ float half8_sum(float x) {
    x += __builtin_bit_cast(float, __builtin_amdgcn_update_dpp(0, __builtin_bit_cast(int, x), 0x141, 0xf, 0xf, false));
    x += __builtin_bit_cast(float, __builtin_amdgcn_update_dpp(0, __builtin_bit_cast(int, x), 0xB1, 0xf, 0xf, false));
    x += __builtin_bit_cast(float, __builtin_amdgcn_update_dpp(0, __builtin_bit_cast(int, x), 0x4E, 0xf, 0xf, false));
    return x;
}
struct WkPar { f32x4 w0, a0, kkp, kap, v0; };
__device__ __forceinline__ f32x4 wk_unit_neg(const f32x4 kraw, const f32x4 kkp) {
    const f32x4 kk = kraw * kkp;
    const float ss = row16_sum((kk.x * kk.x + kk.y * kk.y) + (kk.z * kk.z + kk.w * kk.w));
    return kk * (-rsqrtf(fmaxf(ss, 1e-12f)));
}
__device__ __forceinline__ float wk_decay(float x) { return __expf(-0.60653065971263342f * sigmoidf_(x)); }
__device__ __forceinline__ void wk_prep(const WkPar& P, const f32x4 kraw, const f32x4 vraw, const f32x4 lw2, const f32x4 la2, const f32x4 vf, const f32x4 lv2, bool vres,
                                        f32x4& w, f32x4& ka, f32x4& km, f32x4& vp, f32x4& nk) {
    nk = wk_unit_neg(kraw, P.kkp);
    w = (f32x4){wk_decay(P.w0.x + lw2.x), wk_decay(P.w0.y + lw2.y), wk_decay(P.w0.z + lw2.z), wk_decay(P.w0.w + lw2.w)};
    const f32x4 a = (f32x4){sigmoidf_(P.a0.x + la2.x), sigmoidf_(P.a0.y + la2.y), sigmoidf_(P.a0.z + la2.z), sigmoidf_(P.a0.w + la2.w)};
    ka = nk * (-a);
    km = kraw * ((a - 1.f) * P.kap + 1.f);
    vp = vraw;
    if (vres) { const f32x4 sg = (f32x4){sigmoidf_(P.v0.x + lv2.x), sigmoidf_(P.v0.y + lv2.y), sigmoidf_(P.v0.z + lv2.z), sigmoidf_(P.v0.w + lv2.w)}; vp = vraw + (vf - vraw) * sg; }
}
constexpr int WC_C = 16, WC_NCH = TP / WC_C;
static_assert(WC_NCH * WC_C == TP, "chunking");
constexpr int REC_WA = 0, REC_RP = 2048, REC_BK = 4096, REC_VV = 8192, REC_TK = 10240, REC_MY = 10752, REC_GC = 11264, REC_BYTES = 11520;
constexpr size_t WS_REC = WS_END;
constexpr size_t WS_END2 = WS_REC + (size_t)BATCH * WH * WC_NCH * REC_BYTES;
__device__ __forceinline__ unsigned bf_rne_c(float f) { unsigned u = __float_as_uint(f); return (u + 0x7fffu + ((u >> 16) & 1u)) >> 16; }
__device__ __forceinline__ unsigned pk2_c(float lo, float hi) { return bf_rne_c(lo) | (bf_rne_c(hi) << 16); }
__device__ __forceinline__ float bf_rd(const bf16* q) { return __uint_as_float((unsigned)(*q) << 16); }
__device__ __forceinline__ bf16 bf_of(float x) { return (bf16)(cvt_pk_bf16(x, 0.f) & 0xffffu); }

typedef __bf16 bf4v __attribute__((ext_vector_type(4)));
__device__ __forceinline__ v2u pk4(const f32x4 v) { return __builtin_bit_cast(v2u, __builtin_convertvector(v, bf4v)); }
__device__ __forceinline__ f32x4 mm16(const v2u a, const v2u b, const f32x4 c) { return __builtin_amdgcn_mfma_f32_16x16x16bf16_1k(__builtin_bit_cast(v4s, a), __builtin_bit_cast(v4s, b), c, 0, 0, 0); }
__device__ __forceinline__ f32x4 mm32(const v2u a0, const v2u a1, const v2u b0, const v2u b1, const f32x4 c) {
    const v4u a = (v4u){a0.x, a0.y, a1.x, a1.y}, b = (v4u){b0.x, b0.y, b1.x, b1.y};
    return __builtin_amdgcn_mfma_f32_16x16x32_bf16(__builtin_bit_cast(bf16x8, a), __builtin_bit_cast(bf16x8, b), c, 0, 0, 0);
}
template <int CTRL> __device__ __forceinline__ float dppz(float x) { return __int_as_float(__builtin_amdgcn_update_dpp(0, __float_as_int(x), CTRL, 0xf, 0xf, true)); }
__device__ __forceinline__ float psum16(float x) { x += dppz<0x111>(x); x += dppz<0x112>(x); x += dppz<0x114>(x); x += dppz<0x118>(x); return x; }
__device__ __forceinline__ v2u tr16(LAS unsigned char* a) { return __builtin_bit_cast(v2u, __builtin_amdgcn_ds_read_tr16_b64_v4i16((LAS v4s*)a)); }
__device__ __forceinline__ void ph_wkv1(const Params& p, int jl, LAS unsigned char* lds, int lane_in, int wave) {
    const bf16* Kr = (const bf16*)(p.ws + WS_K); const bf16* Vr = (const bf16*)(p.ws + (jl == 0 ? WS_VF : WS_VB)); const bf16* VFp = (const bf16*)(p.ws + WS_VF);
    const bf16* Rr = (const bf16*)(p.ws + WS_R); const bf16* L2 = (const bf16*)(p.ws + WS_L2);
    bf16* KM = (bf16*)(p.ws + WS_NKK); bf16* VP = (bf16*)(p.ws + WS_KKA);
    const bool vres = jl == 1;
    constexpr int IMG = 16 * 144;
    constexpr float CL2 = 0.60653065971263342f * 1.4426950408889634f;
    const int gw = wave * gridDim.x + blockIdx.x, NGW = gridDim.x * NWAVES;
    for (int job = gw; job < BATCH * WH * WC_NCH; job += NGW) {
        int ln = lane_in; asm volatile("" : "+v"(ln));
        const int lane = ln, fr = lane & 15, fq = lane >> 4;
        const int c = job % WC_NCH, sh = job / WC_NCH, h = sh & 15, seq = sh >> 4, r0 = seq * TP + WC_C * c, chb = h * WN + 4 * fq;
        LAS unsigned char* sc = lds + wave * 16384;
        unsigned char* rec = p.ws + WS_REC + (size_t)job * REC_BYTES;
        const size_t ro = (size_t)(r0 + fr) * D + chb, lo = (size_t)(r0 + fr) * NL2 + chb, po = (size_t)jl * D + chb;
        f32x4 kraw[4], kk[4];
        float ss = 0.f;
#pragma unroll
        for (int jt = 0; jt < 4; ++jt) { kraw[jt] = ld_bf4(Kr + ro + 16 * jt); kk[jt] = kraw[jt] * *(const f32x4*)(p.in[I_KK] + po + 16 * jt);
            ss += (kk[jt].x * kk[jt].x + kk[jt].y * kk[jt].y) + (kk[jt].z * kk[jt].z + kk[jt].w * kk[jt].w); }
        ss += shfl_xor_l(ss, 16, lane); ss += shfl_xor_l(ss, 32, lane);
        const float inv = rsqrtf(fmaxf(ss, 1e-12f));
        v2u pa[4], pb[4], pk[4], pr[4]; f32x4 rt[4];
        LAS unsigned char* iw = sc + fr * 144 + 8 * fq;
#pragma unroll
        for (int jt = 0; jt < 4; ++jt) {
            const f32x4 lw2 = ld_bf4(L2 + lo + 16 * jt), la2 = ld_bf4(L2 + lo + 1024 + 16 * jt), rr = ld_bf4(Rr + ro + 16 * jt), vraw = ld_bf4(Vr + ro + 16 * jt);
            const f32x4 pw0 = *(const f32x4*)(p.in[I_W0] + po + 16 * jt), pa0 = *(const f32x4*)(p.in[I_A0] + po + 16 * jt), pka = *(const f32x4*)(p.in[I_KA] + po + 16 * jt);
            f32x4 vp = vraw;
            if (vres) { const f32x4 vf = ld_bf4(VFp + ro + 16 * jt), lv2 = ld_bf4(L2 + lo + 3072 + 16 * jt), pv0 = *(const f32x4*)(p.in[I_V0] + chb + 16 * jt);
#pragma unroll
                for (int e = 0; e < 4; ++e) vp[e] = vraw[e] + (vf[e] - vraw[e]) * sigmoidf_(pv0[e] + lv2[e]); }
            f32x4 at, bt, kt, kq, rq, gg;
#pragma unroll
            for (int e = 0; e < 4; ++e) {
                const float a = sigmoidf_(pa0[e] + la2[e]), d = CL2 * sigmoidf_(pw0[e] + lw2[e]), cum = psum16(d);
                const float g = __builtin_amdgcn_exp2f(-cum), ig = __builtin_amdgcn_exp2f(cum), gp = __builtin_amdgcn_exp2f(d - cum), nk = -kk[jt][e] * inv;
                kt[e] = kraw[jt][e] * (1.f + (a - 1.f) * pka[e]);
                at[e] = nk * gp; bt[e] = -nk * a * ig; kq[e] = kt[e] * ig; rq[e] = rr[e] * g; gg[e] = g;
            }
            st_bf4(KM + ro + 16 * jt, kt); st_bf4(VP + ro + 16 * jt, vp);
            if (fr == 15) *(f32x4*)(rec + REC_GC + (16 * jt + 4 * fq) * 4) = gg;
            pa[jt] = pk4(at); pb[jt] = pk4(bt); pk[jt] = pk4(kq); pr[jt] = pk4(rq); rt[jt] = rq;
            *(LAS v2u*)(iw + 0 * IMG + 32 * jt) = pa[jt]; *(LAS v2u*)(iw + 1 * IMG + 32 * jt) = pb[jt]; *(LAS v2u*)(iw + 2 * IMG + 32 * jt) = pk[jt]; *(LAS v2u*)(iw + 3 * IMG + 32 * jt) = pk4(vp);
        }
        const f32x4 z4 = (f32x4){0.f, 0.f, 0.f, 0.f};
        const int dd = fr - 4 * fq;
        f32x4 L = mm32(pa[2], pa[3], pb[2], pb[3], mm32(pa[0], pa[1], pb[0], pb[1], z4));
        f32x4 LT = mm32(pb[2], pb[3], pa[2], pa[3], mm32(pb[0], pb[1], pa[0], pa[1], z4));
        f32x4 Lak = mm32(pa[2], pa[3], pk[2], pk[3], mm32(pa[0], pa[1], pk[0], pk[1], z4));
        f32x4 MrbT = mm32(pb[2], pb[3], pr[2], pr[3], mm32(pb[0], pb[1], pr[0], pr[1], z4));
        f32x4 MrkT = mm32(pk[2], pk[3], pr[2], pr[3], mm32(pk[0], pk[1], pr[0], pr[1], z4));
        f32x4 TT;
#pragma unroll
        for (int r = 0; r < 4; ++r) {
            L[r] = dd < r ? L[r] : 0.f; Lak[r] = dd < r ? Lak[r] : 0.f;
            LT[r] = r < dd ? LT[r] : 0.f; MrbT[r] = r <= dd ? MrbT[r] : 0.f; MrkT[r] = r <= dd ? MrkT[r] : 0.f;
            TT[r] = LT[r] + (r == dd ? 1.f : 0.f);
        }
        const v2u bL = pk4(L), bLT = pk4(LT), bLak = pk4(Lak);
        const f32x4 L2m = mm16(bLT, bL, z4), L2T = mm16(bL, bLT, z4);
        const v2u bL2 = pk4(L2m), bL2T = pk4(L2T);
        const f32x4 L4m = mm16(bL2T, bL2, z4), L4T = mm16(bL2, bL2T, z4);
        const v2u bL4 = pk4(L4m), bL4T = pk4(L4T);
        const v2u bL8 = pk4(mm16(bL4T, bL4, z4));
        TT = mm16(bL2, pk4(TT), TT); TT = mm16(bL4, pk4(TT), TT); TT = mm16(bL8, pk4(TT), TT);
        f32x4 Zm = mm16(bL, pk4(MrbT), MrbT); Zm = mm16(bL2, pk4(Zm), Zm); Zm = mm16(bL4, pk4(Zm), Zm); Zm = mm16(bL8, pk4(Zm), Zm);
        const v2u bTT = pk4(TT), bMtT = pk4(Zm);
        *(v2u*)(rec + REC_TK + lane * 8) = pk4(mm16(bLak, bTT, z4)); *(v2u*)(rec + REC_MY + lane * 8) = pk4(mm16(bLak, bMtT, MrkT));
        LAS unsigned char* ir = sc + (4 * fq + ((lane & 15) >> 2)) * 144 + 8 * (lane & 3);
        v2u wat[4], rpt[4];
#pragma unroll
        for (int jt = 0; jt < 4; ++jt) {
            const v2u Qa = tr16(ir + 0 * IMG + 32 * jt), Qb = tr16(ir + 1 * IMG + 32 * jt), Qk = tr16(ir + 2 * IMG + 32 * jt);
            wat[jt] = pk4(mm16(Qa, bTT, z4)); rpt[jt] = pk4(mm16(Qa, bMtT, rt[jt]));
            *(v4u*)(rec + REC_BK + (jt * 64 + lane) * 16) = (v4u){Qb.x, Qb.y, Qk.x, Qk.y};
        }
#pragma unroll
        for (int s = 0; s < 2; ++s) {
            *(v4u*)(rec + REC_WA + (s * 64 + lane) * 16) = (v4u){wat[2 * s].x, wat[2 * s].y, wat[2 * s + 1].x, wat[2 * s + 1].y};
            *(v4u*)(rec + REC_RP + (s * 64 + lane) * 16) = (v4u){rpt[2 * s].x, rpt[2 * s].y, rpt[2 * s + 1].x, rpt[2 * s + 1].y};
        }
#pragma unroll
        for (int it = 0; it < 4; ++it) {
            const v2u Qv = tr16(ir + 3 * IMG + 32 * it);
            *(v2u*)(rec + REC_VV + (it * 64 + lane) * 8) = Qv;

        }
    }
}

__device__ __forceinline__ void ph_wkv2(const Params& p, int jl, int lane, int wave) {
    const bf16* Kr = (const bf16*)(p.ws + WS_K); const bf16* Vr = (const bf16*)(p.ws + (jl == 0 ? WS_VF : WS_VB)); const bf16* VFp = (const bf16*)(p.ws + WS_VF);
    const bf16* Rr = (const bf16*)(p.ws + WS_R); const bf16* L2 = (const bf16*)(p.ws + WS_L2);
    bf16* KM = (bf16*)(p.ws + WS_NKK); bf16* VP = (bf16*)(p.ws + WS_KKA);
    const bool vres = jl == 1; const int ri = lane >> 4, cg = lane & 15;
    bf16* YW = (bf16*)(p.ws + WS_YW);
    const int fr = lane & 15, fq = lane >> 4;
    const int gw = blockIdx.x * NWAVES + wave, NGW = gridDim.x * NWAVES;
    for (int job = gw; job < BATCH * WH * 4; job += NGW) {
        const int it = job & 3, h = (job >> 2) & 15, seq = job >> 6, r0 = seq * TP;
        const unsigned char* rec = p.ws + WS_REC + (size_t)((seq * WH + h) * WC_NCH) * REC_BYTES;
        f32x4 Sacc[4];
#pragma unroll
        for (int jt = 0; jt < 4; ++jt) Sacc[jt] = (f32x4){0.f, 0.f, 0.f, 0.f};
        v4u wa[2], rp[2], bk[4]; v2u vvf, tk, my; f32x4 gc[4];
#define WC_LOAD(rc) do { const unsigned char* r_ = (rc); \
            wa[0] = *(const v4u*)(r_ + REC_WA + lane * 16); wa[1] = *(const v4u*)(r_ + REC_WA + 1024 + lane * 16); rp[0] = *(const v4u*)(r_ + REC_RP + lane * 16); rp[1] = *(const v4u*)(r_ + REC_RP + 1024 + lane * 16); \
            _Pragma("unroll") for (int jt_ = 0; jt_ < 4; ++jt_) { bk[jt_] = *(const v4u*)(r_ + REC_BK + (jt_ * 64 + lane) * 16); gc[jt_] = *(const f32x4*)(r_ + REC_GC + (16 * jt_ + 4 * fq) * 4); } \
            vvf = *(const v2u*)(r_ + REC_VV + (it * 64 + lane) * 8); tk = *(const v2u*)(r_ + REC_TK + lane * 8); my = *(const v2u*)(r_ + REC_MY + lane * 8); } while (0)
        WC_LOAD(rec);
        for (int c = 0; c < WC_NCH; ++c) {
            const v4u cwa0 = wa[0], cwa1 = wa[1], crp0 = rp[0], crp1 = rp[1], cbk0 = bk[0], cbk1 = bk[1], cbk2 = bk[2], cbk3 = bk[3]; const v2u cvv = vvf; const f32x4 zz4 = (f32x4){0.f, 0.f, 0.f, 0.f}, cu0 = mm16(tk, vvf, zz4), cy0 = mm16(my, vvf, zz4), cg0 = gc[0], cg1 = gc[1], cg2 = gc[2], cg3 = gc[3];
            if (c + 1 < WC_NCH) WC_LOAD(rec + (size_t)(c + 1) * REC_BYTES);
            v4u sb0, sb1;
            sb0.x = cvt_pk_bf16(Sacc[0][0], Sacc[0][1]); sb0.y = cvt_pk_bf16(Sacc[0][2], Sacc[0][3]); sb0.z = cvt_pk_bf16(Sacc[1][0], Sacc[1][1]); sb0.w = cvt_pk_bf16(Sacc[1][2], Sacc[1][3]);
            sb1.x = cvt_pk_bf16(Sacc[2][0], Sacc[2][1]); sb1.y = cvt_pk_bf16(Sacc[2][2], Sacc[2][3]); sb1.z = cvt_pk_bf16(Sacc[3][0], Sacc[3][1]); sb1.w = cvt_pk_bf16(Sacc[3][2], Sacc[3][3]);
            const bf16x8 B0 = __builtin_bit_cast(bf16x8, sb0), B1 = __builtin_bit_cast(bf16x8, sb1);
            f32x4 U = __builtin_amdgcn_mfma_f32_16x16x32_bf16(__builtin_bit_cast(bf16x8, cwa0), B0, cu0, 0, 0, 0);
            U = __builtin_amdgcn_mfma_f32_16x16x32_bf16(__builtin_bit_cast(bf16x8, cwa1), B1, U, 0, 0, 0);
            f32x4 Y = __builtin_amdgcn_mfma_f32_16x16x32_bf16(__builtin_bit_cast(bf16x8, crp0), B0, cy0, 0, 0, 0);
            Y = __builtin_amdgcn_mfma_f32_16x16x32_bf16(__builtin_bit_cast(bf16x8, crp1), B1, Y, 0, 0, 0);
            v4u ub; ub.x = pk2_c(U[0], U[1]); ub.y = pk2_c(U[2], U[3]); ub.z = cvv.x; ub.w = cvv.y;
            const bf16x8 UB = __builtin_bit_cast(bf16x8, ub);
            Sacc[0] = __builtin_amdgcn_mfma_f32_16x16x32_bf16(__builtin_bit_cast(bf16x8, cbk0), UB, Sacc[0], 0, 0, 0) * cg0;
            Sacc[1] = __builtin_amdgcn_mfma_f32_16x16x32_bf16(__builtin_bit_cast(bf16x8, cbk1), UB, Sacc[1], 0, 0, 0) * cg1;
            Sacc[2] = __builtin_amdgcn_mfma_f32_16x16x32_bf16(__builtin_bit_cast(bf16x8, cbk2), UB, Sacc[2], 0, 0, 0) * cg2;
            Sacc[3] = __builtin_amdgcn_mfma_f32_16x16x32_bf16(__builtin_bit_cast(bf16x8, cbk3), UB, Sacc[3], 0, 0, 0) * cg3;
            bf16* yp = YW + (size_t)(r0 + WC_C * c + 4 * fq) * D + h * WN + 16 * it + fr;
            yp[0] = bf_cv(Y[0]); yp[D] = bf_cv(Y[1]); yp[2 * D] = bf_cv(Y[2]); yp[3 * D] = bf_cv(Y[3]);
        }
#undef WC_LOAD
        float* so = p.out + O_WKVP + ((((size_t)jl * BATCH + seq) * WH + h) * WN + 16 * it + fr) * WN + 4 * fq;
#pragma unroll
        for (int jt = 0; jt < 4; ++jt) *(f32x4*)(so + 16 * jt) = Sacc[jt];
    }
    {
        const int gw = blockIdx.x * NWAVES + wave, NGW = gridDim.x * NWAVES;
        for (int it = gw; it < SB * WH * 16; it += NGW) {
            const int rg = it & 15, h = (it >> 4) & 15, s = it >> 8, row = MP + s, i = 4 * rg + ri;
            const int ch = h * WN + 4 * cg;
            WkPar P; P.w0 = *(const f32x4*)(p.in[I_W0] + (size_t)jl * D + ch); P.a0 = *(const f32x4*)(p.in[I_A0] + (size_t)jl * D + ch); P.kkp = *(const f32x4*)(p.in[I_KK] + (size_t)jl * D + ch);
            P.kap = *(const f32x4*)(p.in[I_KA] + (size_t)jl * D + ch); P.v0 = *(const f32x4*)(p.in[I_V0] + ch);
            const size_t vo = (size_t)row * D + ch, lo = (size_t)row * NL2 + ch;
            const f32x4 kraw = ld_bf4(Kr + vo), vraw = ld_bf4(Vr + vo), r4 = ld_bf4(Rr + vo), lw2 = ld_bf4(L2 + lo), la2 = ld_bf4(L2 + lo + 1024);
            f32x4 vf = (f32x4){0.f, 0.f, 0.f, 0.f}, lv2 = vf;
            if (vres) { vf = ld_bf4(VFp + vo); lv2 = ld_bf4(L2 + lo + 3072); }
            f32x4 w4, ka, k4, vp, nk; wk_prep(P, kraw, vraw, lw2, la2, vf, lv2, vres, w4, ka, k4, vp, nk);
            const int srcl = (lane & 48) | rg;
            const float v0_ = shfl_l(vp.x, srcl), v1_ = shfl_l(vp.y, srcl), v2_ = shfl_l(vp.z, srcl), v3_ = shfl_l(vp.w, srcl);
            const float vi = ri == 0 ? v0_ : (ri == 1 ? v1_ : (ri == 2 ? v2_ : v3_));
            const size_t so = ((((size_t)jl * SB + s) * WH + h) * WN + i) * WN + 4 * cg;
            f32x4 S = *(const f32x4*)(p.in[I_SWKV] + so);
            const float sa = row16_sum((S.x * nk.x + S.y * nk.y) + (S.z * nk.z + S.w * nk.w));
            S.x = fmaf(S.x, w4.x, fmaf(sa, ka.x, vi * k4.x)); S.y = fmaf(S.y, w4.y, fmaf(sa, ka.y, vi * k4.y));
            S.z = fmaf(S.z, w4.z, fmaf(sa, ka.z, vi * k4.z)); S.w = fmaf(S.w, w4.w, fmaf(sa, ka.w, vi * k4.w));
            const float y = row16_sum((S.x * r4.x + S.y * r4.y) + (S.z * r4.z + S.w * r4.w));
            *(f32x4*)(p.out + O_WKVS + so) = S;
            if (cg == 0) YW[(size_t)row * D + h * WN + i] = bf_cv(y);
            if (rg == 0 && ri == 0) { st_bf4(KM + vo, k4); st_bf4(VP + vo, vp); }
        }
    }
}

typedef __attribute__((address_space(1))) unsigned gu32;
#define XB_TMO      128
#define XB_XCNT(j)  (256  + 64 * (j))
#define XB_XSUB(j)  (1280 + 64 * (j))
#define XB_XGEN(j)  (2304 + 64 * (j))
#define XB_TOP      3328
#define XB_TOPGEN   3392
#define XCD_BAR_WORDS 3456
#define XB_SPIN_CAP (1u << 18)

__device__ __forceinline__ unsigned xb_ld(unsigned* p)              { return __hip_atomic_load(p, __ATOMIC_RELAXED, __HIP_MEMORY_SCOPE_AGENT); }
__device__ __forceinline__ unsigned xb_add(unsigned* p, unsigned v) { return __hip_atomic_fetch_add(p, v, __ATOMIC_RELAXED, __HIP_MEMORY_SCOPE_AGENT); }
__device__ __forceinline__ unsigned xb_xcc_id() { return (unsigned)__builtin_amdgcn_s_getreg((3 << 11) | 20) & 0xFu; }
#define XB_SPIN(cond, bar) do { unsigned _sp = 0; while (cond) { __builtin_amdgcn_s_sleep(1); \
    if ((++_sp & 255u) == 0u) { if (xb_ld(&(bar)[XB_TMO])) break; if (_sp > XB_SPIN_CAP) { atomicAdd(&(bar)[XB_TMO], 1u); break; } } } } while (0)

struct XcdBarrier {
    bool tid0; unsigned* bar; unsigned x;
    volatile LAS unsigned* st;
};

__device__ __forceinline__ XcdBarrier xcd_barrier_post(unsigned* bar, volatile LAS unsigned* st, bool tid0) {
    XcdBarrier b; b.tid0 = tid0; b.bar = bar; b.x = xb_xcc_id(); b.st = st;
    if (b.tid0) (void)xb_add(&bar[XB_XCNT(b.x)], 1u);
    return b;
}
__device__ __forceinline__ void xcd_barrier_complete(unsigned* bar, unsigned x, unsigned& nloc, unsigned& nx) {
    const unsigned G = gridDim.x * gridDim.y * gridDim.z;
    unsigned sum, cnt, mine, sp = 0u;
    for (;;) {
        sum = 0u; cnt = 0u; mine = 0u;
#pragma unroll
        for (unsigned j = 0; j < 16; ++j) { const unsigned c = xb_ld(&bar[XB_XCNT(j)]); sum += c; cnt += (c > 0u) ? 1u : 0u; mine = (j == x) ? c : mine; }
        if (sum == G) break;
        __builtin_amdgcn_s_sleep(1);
        if ((++sp & 255u) == 0u) { if (xb_ld(&bar[XB_TMO])) break; if (sp > XB_SPIN_CAP) { atomicAdd(&bar[XB_TMO], 1u); break; } }
    }
    nloc = mine > 0u ? mine : 1u; nx = cnt > 0u ? cnt : 1u;
}

__device__ __forceinline__ void xcd_barrier(const XcdBarrier& b) {
    asm volatile("s_waitcnt vmcnt(0)" ::: "memory");
    __syncthreads();
    if (b.tid0) {
        unsigned* bar = b.bar;
        __builtin_amdgcn_s_waitcnt(0);
        unsigned nloc = b.st[0], nx = b.st[1];
        if (nloc == 0u) { xcd_barrier_complete(bar, b.x, nloc, nx); b.st[0] = nloc; b.st[1] = nx; }
        const unsigned old = xb_add(&bar[XB_XSUB(b.x)], 1u);
        const unsigned gen = old / nloc;
        if (old + 1u == (gen + 1u) * nloc) {
            __builtin_amdgcn_fence(__ATOMIC_RELEASE, "agent");
            asm volatile("s_waitcnt vmcnt(0)" ::: "memory");
            const unsigned og = xb_add(&bar[XB_TOP], 1u);
            const unsigned tg = og / nx;
            if (og + 1u == (tg + 1u) * nx) xb_add(&bar[XB_TOPGEN], 1u);
            else XB_SPIN(xb_ld(&bar[XB_TOPGEN]) == tg, bar);
            __builtin_amdgcn_fence(__ATOMIC_ACQUIRE, "agent");
            xb_add(&bar[XB_XGEN(b.x)], 1u);
            asm volatile("s_waitcnt vmcnt(0)" ::: "memory");
        } else {
            XB_SPIN(xb_ld(&bar[XB_XGEN(b.x)]) == gen, bar);
            __builtin_amdgcn_fence(__ATOMIC_ACQUIRE, "agent");
            asm volatile("s_waitcnt vmcnt(0)" ::: "memory");
        }
    }
    __syncthreads();
}

enum { OP_P0 = 0, OP_NORM_RET, OP_G_RETIN, OP_RET, OP_RETNORM, OP_G_RETOUT, OP_NORM_RW, OP_G_RWPROJ, OP_G_LORA2, OP_PREP, OP_WKV, OP_WKV2, OP_POST, OP_G_WO,
       OP_NORM_FFN, OP_G_UG, OP_CONV, OP_G_WD, OP_FINAL };
struct Ph { unsigned char op, layer; };
constexpr int NPH = 1 + 2 * 6 + 2 * 9 + 1;
__device__ __host__ inline Ph phase_at(int i) {
    if (i == 0) return Ph{OP_P0, 0};
    i -= 1;
    int l;
    if (i < 6) l = 0; else if (i < 15) { l = 1; i -= 6; } else if (i < 21) { l = 2; i -= 15; } else if (i < 30) { l = 3; i -= 21; } else return Ph{OP_FINAL, 0};
    int op = OP_FINAL;
    if ((l & 1) == 0) {
        switch (i) { case 0: op = OP_G_RETIN; break; case 1: op = OP_RET; break; case 2: op = OP_RETNORM; break; case 3: op = OP_G_RETOUT; break;
                     case 4: op = OP_G_UG; break; default: op = OP_G_WD; break; }
    } else {
        switch (i) { case 0: op = OP_NORM_RW; break; case 1: op = OP_G_RWPROJ; break; case 2: op = OP_G_LORA2; break; case 3: op = OP_WKV; break; case 4: op = OP_WKV2; break; case 5: op = OP_POST; break; case 6: op = OP_G_WO; break;
                     case 7: op = OP_G_UG; break; default: op = OP_G_WD; break; }
    }
    return Ph{(unsigned char)op, (unsigned char)l};
}

__global__ void __launch_bounds__(NTHR, 2) mega(Params p, int lo, int hi) {
    extern __shared__ __attribute__((aligned(16))) unsigned char lds_raw[];
    LAS unsigned char* lds = (LAS unsigned char*)lds_raw;
    volatile LAS unsigned* bst = (volatile LAS unsigned*)(lds + LDS_BYTES - 16);
    const int wave0 = __builtin_amdgcn_readfirstlane((int)threadIdx.x >> 6);
    if (threadIdx.x < 4) bst[threadIdx.x] = 0u;
    __syncthreads();
    (void)xcd_barrier_post((unsigned*)(p.ws + WS_CTL), bst, threadIdx.x == 0);
    for (int ph = lo; ph < hi; ++ph) {
        int lid_; asm volatile("v_mbcnt_lo_u32_b32 %0, -1, 0\n\tv_mbcnt_hi_u32_b32 %0, -1, %0" : "=v"(lid_));
        int tid = wave0 * 64 + lid_; asm volatile("" : "+v"(tid));
        const int lane = tid & 63, wave = __builtin_amdgcn_readfirstlane(tid >> 6);
        unsigned char* ws = p.ws;
        const Ph P = phase_at(ph);
        const int li = P.layer, jl = li >> 1;
        const bf16* gA = nullptr; const bf16* gB = nullptr; int gN = 0, gK = 0; EpiAnyT<0> E{}; E.jl = jl; E.ws = ws; E.slot = -1; E.amul = 1.f; E.li = li; E.ldsb = lds; bool is_gemm = false;
        switch (P.op) {
        case OP_P0: ph_p0(p, lds, tid, lane, wave); break;
        case OP_NORM_RET: ph_norm(p, p.in[I_NMIX] + (size_t)li * D, 0, jl, lane, wave); break;
        case OP_NORM_FFN: ph_norm(p, p.in[I_NFFN] + (size_t)li * D, 0, jl, lane, wave); break;
        case OP_NORM_RW: ph_norm(p, p.in[I_NMIX] + (size_t)li * D, 1, jl, lane, wave); break;
        case OP_FINAL: ph_norm(p, p.in[I_NFIN], 2, 0, lane, wave); break;
        case OP_RETNORM: ph_ret_norm(p, jl, lane, wave); break;
        case OP_POST: ph_rwkv_post(p, jl, lane, wave); break;
        case OP_RET: ph_ret_fast(p, jl, lds, tid, lane, wave); break;
        case OP_WKV: ph_wkv1(p, jl, lds, lane, wave); break;
        case OP_WKV2: ph_wkv2(p, jl, lane, wave); break;
        case OP_G_RETIN: is_gemm = true; E.kind = EK_RETIN; E.perm = true; E.slot = 2 * li;
            gA = (const bf16*)(ws + WS_XB); gB = (const bf16*)(ws + WS_WIN + jl * SZ_WIN); gN = RWIN; gK = D; break;
        case OP_G_RETOUT: is_gemm = true; E.kind = EK_RESID; E.perm = false; E.slot = 2 * li + 1;
            gA = (const bf16*)(ws + WS_Y); gB = (const bf16*)(ws + WS_WOUT + jl * SZ_WOUT); gN = D; gK = RV; break;
        case OP_G_RWPROJ: is_gemm = true; E.kind = EK_RWPROJ; E.perm = true;
            gA = (const bf16*)(ws + WS_H); gB = (const bf16*)(ws + WS_WRW + jl * SZ_WRW); gN = NRW; gK = KRW; break;
        case OP_G_LORA2: is_gemm = true; E.kind = EK_F32; E.perm = true;
            gA = (const bf16*)(ws + WS_A2); gB = (const bf16*)(ws + WS_WL2 + jl * SZ_WL2); gN = (jl == 0 ? 3072 : 4096); gK = KL2; break;
        case OP_G_WO: is_gemm = true; E.kind = EK_RESID; E.perm = false; E.slot = 2 * li + 1;
            gA = (const bf16*)(ws + WS_Z); gB = (const bf16*)(ws + WS_WO + jl * SZ_WO); gN = D; gK = D; break;
        case OP_G_UG: is_gemm = true; E.kind = EK_UG; E.perm = true; E.slot = 2 * li + 1;
            gA = (const bf16*)(ws + WS_XB); gB = (const bf16*)(ws + WS_WUG + li * SZ_WUG); gN = 2 * DFF; gK = D; break;
        case OP_G_WD: is_gemm = true; E.kind = EK_RESID; E.perm = false; E.slot = (li == 1) ? 2 * (li + 1) : -1;
            gA = (const bf16*)(ws + WS_ACT); gB = (const bf16*)(ws + WS_WD + li * SZ_WD); gN = D; gK = DFF; break;
        default: break;
        }
        if (is_gemm) {
            const bool ug = E.kind == EK_UG;
            const int gM = (E.kind == EK_RESID) ? MT0 : (ug ? 66 * 256 : M);
            pg8::Gemm g{ug ? gA - 2 * D : gA, gB, gM, gN, gK, ug ? 254 : 256}; pg8::StaticOrder S; S.init(gM, gN, (int)gridDim.x, (int)blockIdx.x);
            if (E.kind == EK_RETIN || E.kind == EK_UG) {
                LAS float* rt = (LAS float*)(lds + 131072);
                Unit uu;
                for (int ui = 0; ui < 8 && S.next(ui, uu); ++ui) if (tid < 256) { int rr = ug ? 254 * uu.pm - 2 + tid : uu.pm * 256 + tid; rr = rr < 0 ? 0 : (rr > M - 1 ? M - 1 : rr); rt[ui * 256 + tid] = row_rstd(ws, E.slot, rr); }
                E.rtab = rt; E.ldsb = lds;
                __syncthreads();
            }
            if (ug) { EpiAnyT<1> E1{}; E1.kind = E.kind; E1.perm = E.perm; E1.jl = E.jl; E1.ws = E.ws; E1.slot = E.slot; E1.rtab = E.rtab; E1.amul = E.amul; E1.li = E.li; E1.ldsb = E.ldsb; E1.pcw = p.in[I_CW]; E1.pcb = p.in[I_CB]; E1.pcst = p.in[I_SCONV]; E1.pout = p.out;
                pg8::gemm_phase<EpiAnyT<1>, pg8::StaticOrder, true, true>(lds, g, S, E1, tid); }
            else pg8::gemm_phase<EpiAnyT<0>, pg8::StaticOrder, true, true>(lds, g, S, E, tid);
            if (E.kind == EK_RESID) tail_resid(gA, gB, gK, ws, E.slot, E.amul, lds, lane, wave);
        }
        if (ph + 1 < hi) { if (ph == 0) cg::this_grid().sync(); else { XcdBarrier bar; bar.tid0 = tid == 0; bar.bar = (unsigned*)(p.ws + WS_CTL); bar.x = xb_xcc_id(); bar.st = (volatile LAS unsigned*)(lds + LDS_BYTES - 16); xcd_barrier(bar); } }
    }
}

}

extern "C" void kernel_launch(void* const* d_in, const int* in_sizes, int n_in, void* d_out, int out_size, void* d_ws, size_t ws_size, hipStream_t stream) {
    static int grid = 0;
    if (grid == 0) {
        int dev = 0, cus = 0;
        if (n_in != N_IN || ws_size < WS_END2) { fprintf(stderr, "kernel_launch: unexpected n_in %d / ws_size %zu (need %zu)\n", n_in, ws_size, (size_t)WS_END2); grid = -1; return; }
        if (hipGetDevice(&dev) != hipSuccess || hipDeviceGetAttribute(&cus, hipDeviceAttributeMultiprocessorCount, dev) != hipSuccess) { grid = -1; return; }
        if (hipFuncSetAttribute((const void*)mega, hipFuncAttributeMaxDynamicSharedMemorySize, LDS_BYTES) != hipSuccess) { fprintf(stderr, "kernel_launch: hipFuncSetAttribute failed\n"); grid = -1; return; }
        int per_cu = 0;
        if (hipOccupancyMaxActiveBlocksPerMultiprocessor(&per_cu, (const void*)mega, NTHR, LDS_BYTES) != hipSuccess || per_cu < 1) { fprintf(stderr, "kernel_launch: occupancy query says %d\n", per_cu); (void)hipGetLastError(); }
        grid = cus * (per_cu >= 1 ? 1 : 1);
    }
    if (grid < 0) return;
    Params p{};
    for (int i = 0; i < N_IN; ++i) p.in[i] = (const float*)d_in[i];
    p.out = (float*)d_out; p.ws = (unsigned char*)d_ws;
    if (hipMemsetAsync(d_ws, 0, 65536, stream) != hipSuccess) { fprintf(stderr, "kernel_launch: memset failed\n"); return; }
    int lo = 0, hi = NPH;
    void* args[] = {(void*)&p, (void*)&lo, (void*)&hi};
    const hipError_t e = hipLaunchCooperativeKernel((const void*)mega, dim3(grid), dim3(NTHR), args, LDS_BYTES, stream);
    if (e != hipSuccess) fprintf(stderr, "kernel_launch: cooperative launch failed: %s (grid %d)\n", hipGetErrorString(e), grid);
    (void)in_sizes; (void)out_size;
}
```

```cpp
#include <hip/hip_runtime.h>
#include <hip/hip_cooperative_groups.h>
#include <cstdio>
#include <stdint.h>
namespace cg = cooperative_groups;
namespace pg8 {
#define PG8_LAS __attribute__((address_space(3)))
typedef unsigned short bf16_t;
typedef short bf16x8 __attribute__((ext_vector_type(8)));
typedef float f32x4 __attribute__((ext_vector_type(4)));
typedef unsigned u32x4 __attribute__((ext_vector_type(4)));
constexpr int BM = 256, BK = 64, HALF = 128, HTB = HALF * BK * 2  , STAGE_BYTES = 8 * HTB, NXCD = 8, WGM = 4;

__host__ __device__ __forceinline__ int lds_byte(int r, int c) { const int st = (r >> 4) * 2 + (c >> 5), rr = r & 15, cc = c & 31, ob = rr * 64 + cc * 2; return st * 1024 + (ob ^ (((ob >> 9) & 1) << 5)); }
__host__ __device__ __forceinline__ void stage_rc(int b, int& R, int& C) { const int st = b / 1024, sb = b % 1024, swz = sb ^ (((sb >> 9) & 1) << 5); R = (st >> 1) * 16 + swz / 64; C = (st & 1) * 32 + (swz % 64) / 2; }
__host__ __device__ __forceinline__ int perm32(int rho) { const int n = rho >> 4, i = rho & 15; return 8 * (i >> 2) + 4 * n + (i & 3); }

struct Unit { int pm, pn, ord; };
struct Gemm { const bf16_t* A; const bf16_t* Bt; int M, N, K, trows; int lda = 0, ksplit = 1 << 30; long kdelta = 0; unsigned ktab = 0; int kshift = 0; };

struct StaticOrder {
    int nM, nN, nwg, G, c;
    __host__ __device__ void init(int M, int N, int G_, int c_) { nM = M / BM; nN = N / BM; nwg = nM * nN; G = G_; c = c_; }
    __host__ __device__ __forceinline__ bool next(int i, Unit& u) const {
        const long L = (long)i * G + c; if (L >= nwg) return false;
        int wgid = (int)L; { const int q = nwg / NXCD, r = nwg % NXCD, xcd = wgid % NXCD, off = wgid / NXCD; wgid = (xcd < r ? xcd * (q + 1) : r * (q + 1) + (xcd - r) * q) + off; }
        const int nig = WGM * nN, gid = wgid / nig, fm = gid * WGM, gsz = (nM - fm) < WGM ? (nM - fm) : WGM;
        u.pm = fm + ((wgid % nig) % gsz); u.pn = (wgid % nig) / gsz; u.ord = i; return true;
    }
    __device__ __forceinline__ void a_ready(const Unit&) const {}
    __device__ __forceinline__ void done(const Unit&) const {}
};
template <class Epi, class Sched, bool ALIGN_EPI = false, bool SP2 = false>
__device__ __forceinline__ void gemm_phase(PG8_LAS unsigned char* lds, const Gemm g, const Sched& S, const Epi& E, int tid_in) {
    int tid = tid_in; asm volatile("" : "+v"(tid));
    const int wid = __builtin_amdgcn_readfirstlane(tid >> 6), lane = tid & 63, wr = wid >> 2, wc = wid & 3, fr = lane & 15, fq = lane >> 4;
    const int K = g.K, nt = K / BK, lda = g.lda ? g.lda : K;
    unsigned voffA[2], voffB[2];
#pragma unroll
    for (int i = 0; i < 2; ++i) { int R, C; stage_rc(tid * 16 + i * 8192, R, C); const int Rb = E.perm ? ((R & ~31) + perm32(R & 31)) : R;
        voffA[i] = (unsigned)(R * lda + C) * 2u; voffB[i] = (unsigned)(Rb * K + C) * 2u; }
    const size_t kstep = (size_t)(BK * 2);
    const size_t hstep = (size_t)HALF * K * 2, hstepA = (size_t)HALF * lda * 2;
    const int ksplit = g.ksplit; const long kdelta = g.kdelta;
#define PG8_KA(base, kt) ((base) + (size_t)(kt) * kstep + ((kt) >= ksplit ? kdelta : 0l))
    const size_t tstep = 2 * hstep; const size_t tstepA = (size_t)g.trows * lda * 2;
    const unsigned ldsw = (unsigned)wid * 1024u;
    const int aoff = lds_byte(wr * 64 + fr, fq * 8), boff = lds_byte(wc * 32 + fr, fq * 8);
#define PG8_SA(b, h) (((b) * 2 + (h)) * HTB)
#define PG8_SB(b, h) ((4 + (b) * 2 + (h)) * HTB)
#define PG8_STAGE(bufoff, gbase, voff) do { _Pragma("unroll") for (int _i = 0; _i < 2; ++_i) \
        __builtin_amdgcn_global_load_lds((const unsigned*)((const char*)(gbase) + (voff)[_i]), (PG8_LAS unsigned*)(lds + (bufoff) + ldsw + _i * 8192), 16, 0, 0); } while (0)
#define PG8_LDA(dst, b, h) do { _Pragma("unroll") for (int m = 0; m < 4; ++m) _Pragma("unroll") for (int k = 0; k < 2; ++k) dst[m][k] = *(const PG8_LAS bf16x8*)(lds + PG8_SA(b, h) + aoff + m * 2048 + k * 1024); } while (0)
#define PG8_LDB(dst, b, h) do { _Pragma("unroll") for (int n = 0; n < 2; ++n) _Pragma("unroll") for (int k = 0; k < 2; ++k) dst[n][k] = *(const PG8_LAS bf16x8*)(lds + PG8_SB(b, h) + boff + n * 2048 + k * 1024); } while (0)
#define PG8_MMA(ai, bj, At, Bt) do { __builtin_amdgcn_s_setprio(1); _Pragma("unroll") for (int m = 0; m < 4; ++m) _Pragma("unroll") for (int n = 0; n < 2; ++n) _Pragma("unroll") for (int k = 0; k < 2; ++k) \
        acc[ai][bj][m][n] = __builtin_amdgcn_mfma_f32_16x16x32_bf16(Bt[n][k], At[m][k], acc[ai][bj][m][n], 0, 0, 0); __builtin_amdgcn_s_setprio(0); } while (0)
#define PG8_WAIT_V(n) asm volatile("s_waitcnt vmcnt(" #n ")" ::: "memory")
#define PG8_WAIT_L(n) asm volatile("s_waitcnt lgkmcnt(" #n ")" ::: "memory")
#define PG8_BAR __builtin_amdgcn_s_barrier()
#define PG8_SCHED __builtin_amdgcn_sched_barrier(0)
    Unit cur, nxt; int ui = 0;
    if (!S.next(0, cur)) return;
    f32x4 acc[2][2][4][2];
#pragma unroll
    for (int a = 0; a < 2; ++a)
#pragma unroll
        for (int b = 0; b < 2; ++b)
#pragma unroll
            for (int m = 0; m < 4; ++m)
#pragma unroll
                for (int n = 0; n < 2; ++n) acc[a][b][m][n] = (f32x4){0.f, 0.f, 0.f, 0.f};
    bf16x8 At[4][2], B0[2][2], B1[2][2];
    const unsigned ktab = g.ktab; const int kshift = g.kshift;
#define PG8_KOFF(pn) (ktab ? (int)((ktab >> (8 * ((pn) >> kshift))) & 15u) : 0)
#define PG8_KNT(pn) (ktab ? (int)((ktab >> (8 * ((pn) >> kshift) + 4)) & 15u) : nt)
    int ntc = PG8_KNT(cur.pn);
    const char* cA = (const char*)g.A + (size_t)cur.pm * tstepA + (size_t)PG8_KOFF(cur.pn) * kstep; const char* cB = (const char*)g.Bt + (size_t)cur.pn * tstep + (size_t)PG8_KOFF(cur.pn) * kstep;
    S.a_ready(cur);
    if constexpr (SP2) {
        PG8_STAGE(PG8_SB(0, 0), cB, voffB); PG8_STAGE(PG8_SB(0, 1), cB + hstep, voffB); PG8_STAGE(PG8_SA(0, 0), cA, voffA); PG8_STAGE(PG8_SA(0, 1), cA + hstepA, voffA);
        if (wr == 1) PG8_BAR;
        PG8_WAIT_V(2); PG8_BAR;
        PG8_STAGE(PG8_SB(1, 0), cB + kstep, voffB); PG8_STAGE(PG8_SA(1, 0), PG8_KA(cA, 1), voffA); PG8_STAGE(PG8_SB(1, 1), cB + hstep + kstep, voffB);
        PG8_WAIT_V(6); PG8_BAR;
    } else {
        PG8_STAGE(PG8_SB(0, 0), cB, voffB); PG8_STAGE(PG8_SA(0, 0), cA, voffA); PG8_STAGE(PG8_SB(0, 1), cB + hstep, voffB); PG8_STAGE(PG8_SA(0, 1), cA + hstepA, voffA);
        if (wr == 1) PG8_BAR;
        PG8_WAIT_V(4); PG8_BAR;
        PG8_STAGE(PG8_SB(1, 0), cB + kstep, voffB); PG8_STAGE(PG8_SA(1, 0), PG8_KA(cA, 1), voffA); PG8_STAGE(PG8_SB(1, 1), cB + hstep + kstep, voffB);
        PG8_WAIT_V(6); PG8_BAR;
    }
    for (;;) {
        const bool has_next = S.next(ui + 1, nxt);
        const char* nA = has_next ? (const char*)g.A + (size_t)nxt.pm * tstepA + (size_t)PG8_KOFF(nxt.pn) * kstep : cA; const char* nB = has_next ? (const char*)g.Bt + (size_t)nxt.pn * tstep + (size_t)PG8_KOFF(nxt.pn) * kstep : cB;
        for (int t = 0; t < ntc; t += 2) {
            const bool last = (t == ntc - 2);
            const char* a1 = PG8_KA(cA, t + 1);
            const char* a2 = last ? nA : PG8_KA(cA, t + 2); const char* b2 = last ? nB : cB + (size_t)(t + 2) * kstep;
            const char* a3 = last ? PG8_KA(nA, 1) : PG8_KA(cA, t + 3); const char* b3 = b2 + kstep;
            if (last && has_next) S.a_ready(nxt);
            if constexpr (SP2) {
            PG8_LDB(B0, 0, 0); PG8_LDB(B1, 0, 1); PG8_SCHED; PG8_LDA(At, 0, 0); PG8_STAGE(PG8_SA(1, 1), a1 + hstepA, voffA);
            PG8_WAIT_V(8); PG8_WAIT_L(0); PG8_BAR; PG8_MMA(0, 0, At, B0); PG8_MMA(0, 1, At, B1); PG8_BAR; PG8_SCHED;
            PG8_LDA(At, 0, 1); PG8_STAGE(PG8_SB(0, 0), b2, voffB); PG8_STAGE(PG8_SB(0, 1), b2 + hstep, voffB); PG8_STAGE(PG8_SA(0, 0), a2, voffA);
            PG8_WAIT_V(8); PG8_WAIT_L(0); PG8_BAR; PG8_MMA(1, 0, At, B0); PG8_MMA(1, 1, At, B1); PG8_BAR; PG8_SCHED;
            PG8_LDB(B0, 1, 0); PG8_LDB(B1, 1, 1); PG8_SCHED; PG8_LDA(At, 1, 0); PG8_STAGE(PG8_SA(0, 1), a2 + hstepA, voffA);
            PG8_WAIT_V(8); PG8_WAIT_L(0); PG8_BAR; PG8_MMA(0, 0, At, B0); PG8_MMA(0, 1, At, B1); PG8_BAR; PG8_SCHED;
            PG8_LDA(At, 1, 1); PG8_STAGE(PG8_SB(1, 0), b3, voffB); PG8_STAGE(PG8_SB(1, 1), b3 + hstep, voffB); PG8_STAGE(PG8_SA(1, 0), a3, voffA);
            PG8_WAIT_V(8); PG8_WAIT_L(0); PG8_BAR; PG8_MMA(1, 0, At, B0); PG8_MMA(1, 1, At, B1); PG8_BAR; PG8_SCHED;
            } else {
            PG8_LDB(B0, 0, 0); PG8_SCHED; PG8_LDA(At, 0, 0); PG8_STAGE(PG8_SA(1, 1), a1 + hstepA, voffA);
            PG8_WAIT_L(8); PG8_BAR; PG8_WAIT_L(0); PG8_MMA(0, 0, At, B0); PG8_BAR; PG8_SCHED;
            PG8_LDB(B1, 0, 1); PG8_STAGE(PG8_SB(0, 0), b2, voffB);
            PG8_BAR; PG8_WAIT_L(0); PG8_MMA(0, 1, At, B1); PG8_BAR;
            PG8_LDA(At, 0, 1); PG8_STAGE(PG8_SA(0, 0), a2, voffA);
            PG8_BAR; PG8_WAIT_L(0); PG8_MMA(1, 0, At, B0); PG8_BAR; PG8_SCHED;
            PG8_STAGE(PG8_SB(0, 1), b2 + hstep, voffB);
            PG8_WAIT_V(6); PG8_BAR; PG8_MMA(1, 1, At, B1); PG8_BAR;
            PG8_LDB(B0, 1, 0); PG8_SCHED; PG8_LDA(At, 1, 0); PG8_STAGE(PG8_SA(0, 1), a2 + hstepA, voffA);
            PG8_WAIT_L(8); PG8_BAR; PG8_WAIT_L(0); PG8_MMA(0, 0, At, B0); PG8_BAR; PG8_SCHED;
            PG8_LDB(B1, 1, 1); PG8_STAGE(PG8_SB(1, 0), b3, voffB);
            PG8_BAR; PG8_WAIT_L(0); PG8_MMA(0, 1, At, B1); PG8_BAR;
            PG8_LDA(At, 1, 1); PG8_STAGE(PG8_SA(1, 0), a3, voffA);
            PG8_BAR; PG8_WAIT_L(0); PG8_MMA(1, 0, At, B0); PG8_BAR; PG8_SCHED;
            PG8_STAGE(PG8_SB(1, 1), b3 + hstep, voffB);
            PG8_WAIT_V(6); PG8_BAR; PG8_MMA(1, 1, At, B1); PG8_BAR;
            }
        }
        if constexpr (ALIGN_EPI) { if (wr == 0) PG8_BAR; }
        if constexpr (!Epi::AFTER_DRAIN) { E(acc, cur, wr, wc, fr, fq); S.done(cur); }
        if (!has_next) break;
#pragma unroll
        for (int a = 0; a < 2; ++a)
#pragma unroll
            for (int b = 0; b < 2; ++b)
#pragma unroll
                for (int m = 0; m < 4; ++m)
#pragma unroll
                    for (int n = 0; n < 2; ++n) acc[a][b][m][n] = (f32x4){0.f, 0.f, 0.f, 0.f};
        cur = nxt; cA = nA; cB = nB; ++ui; ntc = PG8_KNT(cur.pn);
        if constexpr (ALIGN_EPI) { if (wr == 1) PG8_BAR; }
    }
    PG8_WAIT_V(0);
    if constexpr (!ALIGN_EPI) { if (wr == 0) PG8_BAR; }
    PG8_BAR;
    if constexpr (Epi::AFTER_DRAIN) { E.fused(acc, cur, wr, wc, fr, fq, lds, wid, lane); S.done(cur); }
#undef PG8_KA
#undef PG8_KOFF
#undef PG8_KNT
#undef PG8_SA
#undef PG8_SB
#undef PG8_STAGE
#undef PG8_LDA
#undef PG8_LDB
#undef PG8_MMA
#undef PG8_WAIT_V
#undef PG8_WAIT_L
#undef PG8_BAR
#undef PG8_SCHED
}
}

namespace {
constexpr int D = 1024, BATCH = 8, SEQ = 2048, NMETA = 16, TP = SEQ + NMETA, MP = BATCH * TP, SB = 128, M = MP + SB;
constexpr int DEPTH = 4, RH = 4, RDK = 256, RDV = 512, RV = 2048, RWIN = 6144;
constexpr int WH = 16, WN = 64, LW = 64, LA = 64, LV = 32, LG = 160, DFF = 2816;
constexpr int NRW = 3584, KRW = 2048, KL2 = 384, NL2 = 4096;
constexpr float PAST_POS = 16384.f;
constexpr int NWAVES = 8, NTHR = 512;
constexpr int LDS_BYTES = 147456;

constexpr size_t O_YP = 0;
constexpr size_t O_YS = O_YP + (size_t)BATCH * SEQ * D;
constexpr size_t O_RETP = O_YS + (size_t)SB * D;
constexpr size_t O_WKVP = O_RETP + (size_t)2 * BATCH * RH * RDK * RDV;
constexpr size_t O_SHP = O_WKVP + (size_t)2 * BATCH * WH * WN * WN;
constexpr size_t O_CVP = O_SHP + (size_t)2 * BATCH * D;
constexpr size_t O_RETS = O_CVP + (size_t)DEPTH * BATCH * 2 * DFF;
constexpr size_t O_WKVS = O_RETS + (size_t)2 * SB * RH * RDK * RDV;
constexpr size_t O_SHS = O_WKVS + (size_t)2 * SB * WH * WN * WN;
constexpr size_t O_CVS = O_SHS + (size_t)2 * SB * D;

enum { I_XP = 0, I_XS, I_SRET, I_SWKV, I_SSHIFT, I_SCONV, I_META, I_NMIX, I_NFFN, I_NFIN, I_RWIN, I_RGN, I_RWOUT, I_MU, I_WRKV, I_W0, I_W1, I_W2,
       I_A0, I_A1, I_A2, I_V0, I_V1, I_V2, I_G1, I_G2, I_KK, I_KA, I_RK, I_LNW, I_LNB, I_WO, I_WUG, I_CW, I_CB, I_WD, N_IN };

constexpr size_t al256(size_t x) { return (x + 255) & ~(size_t)255; }
constexpr size_t WS_CTL = 0;
constexpr size_t WS_CS = 1u << 20;
constexpr size_t WS_WIN = 4u << 20;
constexpr size_t SZ_WIN = (size_t)RWIN * D * 2;
constexpr size_t WS_WOUT = WS_WIN + 2 * SZ_WIN;
constexpr size_t SZ_WOUT = (size_t)D * RV * 2;
constexpr size_t WS_WRW = WS_WOUT + 2 * SZ_WOUT;
constexpr size_t SZ_WRW = (size_t)NRW * KRW * 2;
constexpr size_t WS_WL2 = WS_WRW + 2 * SZ_WRW;
constexpr size_t SZ_WL2 = (size_t)NL2 * KL2 * 2;
constexpr size_t WS_WO = WS_WL2 + 2 * SZ_WL2;
constexpr size_t SZ_WO = (size_t)D * D * 2;
constexpr size_t WS_WUG = WS_WO + 2 * SZ_WO;
constexpr size_t SZ_WUG = (size_t)2 * DFF * D * 2;
constexpr size_t WS_WD = WS_WUG + 4 * SZ_WUG;
constexpr size_t SZ_WD = (size_t)D * DFF * 2;
constexpr size_t WS_X = al256(WS_WD + 4 * SZ_WD);
constexpr size_t SZ_MD4 = (size_t)M * D * 4;
constexpr size_t WS_H = WS_X + SZ_MD4;
constexpr size_t WS_VF = WS_H + SZ_MD4;
constexpr size_t WS_REG = WS_VF + SZ_MD4;
constexpr size_t WS_QK = WS_REG;
constexpr size_t WS_V = WS_QK + SZ_MD4;
constexpr size_t WS_SG = WS_V + SZ_MD4;
constexpr size_t WS_O = WS_SG + SZ_MD4;
constexpr size_t WS_Y = WS_O + 2 * SZ_MD4;
constexpr size_t WS_R = WS_REG;
constexpr size_t WS_K = WS_R + SZ_MD4;
constexpr size_t WS_VB = WS_K + SZ_MD4;
constexpr size_t WS_WDEC = WS_VB + SZ_MD4;
constexpr size_t WS_NKK = WS_WDEC + SZ_MD4;
constexpr size_t WS_KKA = WS_NKK + SZ_MD4;
constexpr size_t WS_YW = WS_KKA + SZ_MD4;
constexpr size_t WS_L2 = WS_YW + SZ_MD4;
constexpr size_t WS_A2 = WS_L2 + 4 * SZ_MD4;
constexpr size_t WS_Z = al256(WS_A2 + (size_t)M * KL2 * 2);
constexpr size_t WS_RW_END = WS_Z + (size_t)M * D * 2;
constexpr size_t SZ_FF2 = (size_t)M * DFF * 2;
constexpr size_t WS_U = WS_REG;
constexpr size_t WS_G = al256(WS_U + SZ_FF2);
constexpr size_t WS_ACT = al256(WS_G + SZ_FF2);
constexpr size_t WS_XB = al256(WS_RW_END) + 2 * (size_t)D * 2;
constexpr size_t WS_SS = al256(WS_XB + (size_t)(M + 126) * D * 2);
constexpr size_t WS_PTRS = al256(WS_SS + (size_t)8 * M * 16 * 4);
constexpr size_t WS_END = WS_PTRS + 256;

#define LAS __attribute__((address_space(3)))
typedef unsigned short bf16;
typedef unsigned v4u __attribute__((ext_vector_type(4)));
typedef unsigned v2u __attribute__((ext_vector_type(2)));
using pg8::f32x4;
using pg8::Unit;
using pg8::bf16x8;

struct Params { const float* in[N_IN]; float* out; unsigned char* ws; };

__device__ __forceinline__ unsigned cvt_pk_bf16(float lo, float hi) { unsigned r; asm("v_cvt_pk_bf16_f32 %0, %1, %2" : "=v"(r) : "v"(lo), "v"(hi)); return r; }
typedef __bf16 bf4v __attribute__((ext_vector_type(4)));
__device__ __forceinline__ v2u pk4(const f32x4 v) { return __builtin_bit_cast(v2u, __builtin_convertvector(v, bf4v)); }
__device__ __forceinline__ bf16 bf_cv(float x) { return __builtin_bit_cast(unsigned short, (__bf16)x); }
__device__ __forceinline__ float bf_lo(unsigned w) { return __uint_as_float(w << 16); }
__device__ __forceinline__ float bf_hi(unsigned w) { return __uint_as_float(w & 0xffff0000u); }
__device__ __forceinline__ void unpack8(const v4u w, float (&f)[8]) { f[0] = bf_lo(w.x); f[1] = bf_hi(w.x); f[2] = bf_lo(w.y); f[3] = bf_hi(w.y); f[4] = bf_lo(w.z); f[5] = bf_hi(w.z); f[6] = bf_lo(w.w); f[7] = bf_hi(w.w); }
__device__ __forceinline__ v4u pack8(const float (&f)[8]) { v4u w; w.x = cvt_pk_bf16(f[0], f[1]); w.y = cvt_pk_bf16(f[2], f[3]); w.z = cvt_pk_bf16(f[4], f[5]); w.w = cvt_pk_bf16(f[6], f[7]); return w; }
__device__ __forceinline__ f32x4 ld_bf4(const bf16* q) { const v2u w = *(const v2u*)q; return (f32x4){bf_lo(w.x), bf_hi(w.x), bf_lo(w.y), bf_hi(w.y)}; }
__device__ __forceinline__ void st_bf4(bf16* q, const f32x4 v) { v2u w; w.x = cvt_pk_bf16(v.x, v.y); w.y = cvt_pk_bf16(v.z, v.w); *(v2u*)q = w; }
__device__ __forceinline__ float shfl_xor_l(float v, int m, int lane) { return __int_as_float(__builtin_amdgcn_ds_bpermute((lane ^ m) << 2, __float_as_int(v))); }
__device__ __forceinline__ float shfl_l(float v, int src) { return __int_as_float(__builtin_amdgcn_ds_bpermute(src << 2, __float_as_int(v))); }
__device__ __forceinline__ float wave_sum(float v, int) {
    v += __builtin_bit_cast(float, __builtin_amdgcn_update_dpp(0, __float_as_int(v), 0x128, 0xf, 0xf, false));
    v += __builtin_bit_cast(float, __builtin_amdgcn_update_dpp(0, __float_as_int(v), 0x124, 0xf, 0xf, false));
    v += __builtin_bit_cast(float, __builtin_amdgcn_update_dpp(0, __float_as_int(v), 0x122, 0xf, 0xf, false));
    v += __builtin_bit_cast(float, __builtin_amdgcn_update_dpp(0, __float_as_int(v), 0x121, 0xf, 0xf, false));
    const int vi = __float_as_int(v);
    return (__int_as_float(__builtin_amdgcn_readlane(vi, 0)) + __int_as_float(__builtin_amdgcn_readlane(vi, 16))) + (__int_as_float(__builtin_amdgcn_readlane(vi, 32)) + __int_as_float(__builtin_amdgcn_readlane(vi, 48)));
}
__device__ __forceinline__ float rcpf_(float x) { return __builtin_amdgcn_rcpf(x); }
__device__ __forceinline__ float sigmoidf_(float x) { return rcpf_(1.f + __expf(-x)); }
__device__ __forceinline__ float siluf_(float x) { return x * rcpf_(1.f + __expf(-x)); }
__device__ __forceinline__ float tanhf_(float x) { return 1.f - 2.f * rcpf_(1.f + __expf(2.f * x)); }

__device__ __forceinline__ float row_rstd(const unsigned char* ws, int slot, int row) {
    const f32x4* q = (const f32x4*)((const float*)(ws + WS_SS) + ((size_t)slot * M + row) * 16);
    const f32x4 a = q[0], b = q[1], c = q[2], d = q[3];
    const float ss = (((a.x + a.y) + (a.z + a.w)) + ((b.x + b.y) + (b.z + b.w))) + (((c.x + c.y) + (c.z + c.w)) + ((d.x + d.y) + (d.z + d.w)));
    return rsqrtf(ss * (1.f / D) + 1e-6f);
}
__device__ __forceinline__ float dpp_ror1(float v) { return __int_as_float(__builtin_amdgcn_update_dpp(0, __float_as_int(v), 0x121, 0xf, 0xf, false)); }
__device__ __forceinline__ void quad_transpose4(float (&x)[4], int j) {
    const bool o1 = j & 1, o2 = j & 2;
    const float a0 = o1 ? x[0] : x[1], a1 = o1 ? x[2] : x[3];
    const float b0 = __int_as_float(__builtin_amdgcn_mov_dpp(__float_as_int(a0), 0xB1, 0xf, 0xf, true)), b1 = __int_as_float(__builtin_amdgcn_mov_dpp(__float_as_int(a1), 0xB1, 0xf, 0xf, true));
    const float y0 = o1 ? b0 : x[0], y1 = o1 ? x[1] : b0, y2 = o1 ? b1 : x[2], y3 = o1 ? x[3] : b1;
    const float c0 = o2 ? y0 : y2, c1 = o2 ? y1 : y3;
    const float d0 = __int_as_float(__builtin_amdgcn_mov_dpp(__float_as_int(c0), 0x4E, 0xf, 0xf, true)), d1 = __int_as_float(__builtin_amdgcn_mov_dpp(__float_as_int(c1), 0x4E, 0xf, 0xf, true));
    x[0] = o2 ? d0 : y0; x[1] = o2 ? d1 : y1; x[2] = o2 ? y2 : d0; x[3] = o2 ? y3 : d1;
}
template <int CTRL> __device__ __forceinline__ float dpp_mv(float v) { return __int_as_float(__builtin_amdgcn_mov_dpp(__float_as_int(v), CTRL, 0xf, 0xf, true)); }
__device__ __forceinline__ float dpp_ror2(float v) { return __int_as_float(__builtin_amdgcn_update_dpp(0, __float_as_int(v), 0x122, 0xf, 0xf, false)); }
enum { EK_RETIN = 0, EK_RESID, EK_UG, EK_RWPROJ, EK_F32 };
template <int GRP> struct EpiExtra {};
template <> struct EpiExtra<1> { const float* pcw; const float* pcb; const float* pcst; float* pout; };
template <int GRP> struct EpiAnyT : EpiExtra<GRP> {
    static constexpr bool AFTER_DRAIN = false;
    int kind; bool perm; int jl; unsigned char* ws; int slot; const LAS float* rtab; float amul; int li; LAS unsigned char* ldsb;
    __device__ __forceinline__ void operator()(const f32x4 (&acc)[2][2][4][2], const Unit& u, int wr, int wc, int fr, int fq) const {
        const int row0 = u.pm * 256 + wr * 64 + fr;
        if (GRP == 0 && kind == EK_RETIN) {
            bf16* QK = (bf16*)(ws + WS_QK); bf16* V = (bf16*)(ws + WS_V); bf16* SG = (bf16*)(ws + WS_SG); const float* CS = (const float*)(ws + WS_CS);
            const int cw = wc * 32 + 8 * fq;
            if (u.pn < 8) {
                const bool isk = u.pn >= 4; const int h = u.pn & 3; const float sc = isk ? 0.0625f : 1.f;
                bf16* base = QK + (isk ? 1024 : 0) + h * 256 + cw;
#pragma unroll
                for (int ai = 0; ai < 2; ++ai) {
                    f32x4 tt[4][4];
#pragma unroll
                    for (int m = 0; m < 4; ++m) { const int row = row0 + ai * 128 + m * 16; const int pi = row < MP ? row % TP : TP;
                        const f32x4* cs = (const f32x4*)(CS + ((size_t)pi * 128 + cw) * 2);
#pragma unroll
                        for (int q4 = 0; q4 < 4; ++q4) tt[m][q4] = cs[q4]; }
#pragma unroll
                    for (int m = 0; m < 4; ++m) {
                        const int row = row0 + ai * 128 + m * 16;
                        const float rs = rtab[u.ord * 256 + (row - u.pm * 256)] * sc;
                        const f32x4 t0 = tt[m][0], t1 = tt[m][1], t2 = tt[m][2], t3 = tt[m][3];
                        const float c[8] = {t0.x, t0.z, t1.x, t1.z, t2.x, t2.z, t3.x, t3.z}, s[8] = {t0.y, t0.w, t1.y, t1.w, t2.y, t2.w, t3.y, t3.w};
                        float o1[8], o2[8];
#pragma unroll
                        for (int n = 0; n < 2; ++n)
#pragma unroll
                            for (int j = 0; j < 4; ++j) {
                                const float x1 = acc[ai][0][m][n][j], x2 = acc[ai][1][m][n][j];
                                o1[n * 4 + j] = (x1 * c[n * 4 + j] - x2 * s[n * 4 + j]) * rs;
                                o2[n * 4 + j] = (x1 * s[n * 4 + j] + x2 * c[n * 4 + j]) * rs;
                            }
                        bf16* rp = base + (size_t)row * 2048;
                        *(v4u*)rp = pack8(o1); *(v4u*)(rp + 128) = pack8(o2);
                    }
                    asm volatile("" ::: "memory");
                }
            } else {
                const bool isg = u.pn >= 16;
                bf16* base = (isg ? SG : V) + ((u.pn - (isg ? 16 : 8)) * 256) + cw;
#pragma unroll
                for (int ai = 0; ai < 2; ++ai)
#pragma unroll
                    for (int m = 0; m < 4; ++m) {
                        bf16* rp = base + (size_t)(row0 + ai * 128 + m * 16) * 2048;
                        const float rs = rtab[u.ord * 256 + (wr * 64 + fr + ai * 128 + m * 16)];
#pragma unroll
                        for (int bj = 0; bj < 2; ++bj) {
                            float o[8];
#pragma unroll
                            for (int n = 0; n < 2; ++n)
#pragma unroll
                                for (int j = 0; j < 4; ++j) { const float x = acc[ai][bj][m][n][j] * rs; o[n * 4 + j] = isg ? siluf_(x) : x; }
                            *(v4u*)(rp + bj * 128) = pack8(o);
                        }
                    }
            }
        } else if (GRP == 0 && kind == EK_RESID) {
            const int colw = u.pn * 256 + wc * 32 + (fq & 1) * 16 + (fq >> 1) * 8;
#pragma unroll
            for (int am = 0; am < 4; ++am) { const int ai = am >> 1, mb = (am & 1) * 2;
                v4u xv[2][2];
#pragma unroll
                for (int mm = 0; mm < 2; ++mm) { const int m = mb + mm; const bf16* rp = (const bf16*)(ws + WS_XB) + (size_t)(row0 + ai * 128 + m * 16) * D + colw;
#pragma unroll
                    for (int bj = 0; bj < 2; ++bj) xv[mm][bj] = *(const v4u*)(rp + bj * 128); }
#pragma unroll
                for (int mm = 0; mm < 2; ++mm) { const int m = mb + mm;
                    const int row = row0 + ai * 128 + m * 16;
                    bf16* xb = (bf16*)(ws + WS_XB) + (size_t)row * D + colw;
                    float ssq = 0.f;
#pragma unroll
                    for (int bj = 0; bj < 2; ++bj) {
                        const auto s0 = __builtin_amdgcn_permlane16_swap(xv[mm][bj].x, xv[mm][bj].z, false, false), s1 = __builtin_amdgcn_permlane16_swap(xv[mm][bj].y, xv[mm][bj].w, false, false);
                        const unsigned xn[2][2] = {{s0[0], s1[0]}, {s0[1], s1[1]}};
                        unsigned wn[2][2];
#pragma unroll
                        for (int n = 0; n < 2; ++n) {
                            const f32x4 v = (f32x4){bf_lo(xn[n][0]), bf_hi(xn[n][0]), bf_lo(xn[n][1]), bf_hi(xn[n][1])} + acc[ai][bj][m][n] * amul;
                            wn[n][0] = cvt_pk_bf16(v.x, v.y); wn[n][1] = cvt_pk_bf16(v.z, v.w);
                            if (slot >= 0) ssq += (v.x * v.x + v.y * v.y) + (v.z * v.z + v.w * v.w); }
                        const auto t0 = __builtin_amdgcn_permlane16_swap(wn[0][0], wn[1][0], false, false), t1 = __builtin_amdgcn_permlane16_swap(wn[0][1], wn[1][1], false, false);
                        *(v4u*)(xb + bj * 128) = (v4u){t0[0], t1[0], t0[1], t1[1]};
                    }
                    if (slot >= 0) { ssq += shfl_xor_l(ssq, 16, fq * 16 + fr); ssq += shfl_xor_l(ssq, 32, fq * 16 + fr); if (fq == 0) ((float*)(ws + WS_SS))[((size_t)slot * M + row) * 16 + u.pn * 4 + wc] = ssq; }
                }
                asm volatile("" ::: "memory");
            }
        } else if (GRP == 1 && kind == EK_UG) {
            int frL = fr, fqL = fq; asm volatile("" : "+v"(frL), "+v"(fqL));
            const EpiExtra<1>& X1 = *(const EpiExtra<1>*)(const void*)this;
            const float* cw = X1.pcw + (size_t)li * 3 * DFF; const float* cb = X1.pcb + (size_t)li * DFF; const float* cst = X1.pcst + (size_t)li * SB * 2 * DFF;
            float* cvp = X1.pout + O_CVP + (size_t)li * BATCH * 2 * DFF; float* cvs = X1.pout + O_CVS + (size_t)li * SB * 2 * DFF;
            bf16* ACT = (bf16*)(ws + WS_ACT);
            const int fl = wc * 32 + 8 * fqL;
            LAS float* halo = (LAS float*)(ldsb + 131072 + 8192);
            const LAS float* rt = rtab + u.ord * 256;
#pragma unroll
            for (int ai = 0; ai < 2; ++ai) if (frL >= 14) {
                const float rs = rt[128 * ai + 64 * wr + 48 + frL];
                LAS float* hp = halo + ((2 * ai + wr) * 2 + (frL - 14)) * 128 + fl;
                *(LAS f32x4*)hp = acc[ai][1][3][0] * rs; *(LAS f32x4*)(hp + 4) = acc[ai][1][3][1] * rs;
            }
            asm volatile("s_waitcnt lgkmcnt(0)" ::: "memory"); __builtin_amdgcn_s_barrier(); asm volatile("" ::: "memory");
            const int R0 = 254 * u.pm - 2, bq = (R0 + 2) / TP, tq = (R0 + 2) - bq * TP;
            const bool plain = (R0 + 255 < MP) && tq >= 2 && tq + 253 < TP - 2;
            if (plain) {
                const bool k15 = frL == 15, k14 = frL >= 14;
                const int f00 = u.pn * 128 + fl;
                const f32x4 Wa0 = *(const f32x4*)(cw + f00), Wa1 = *(const f32x4*)(cw + DFF + f00), Wa2 = *(const f32x4*)(cw + 2 * DFF + f00), Wab = *(const f32x4*)(cb + f00);
                const f32x4 Wb0 = *(const f32x4*)(cw + f00 + 4), Wb1 = *(const f32x4*)(cw + DFF + f00 + 4), Wb2 = *(const f32x4*)(cw + 2 * DFF + f00 + 4), Wbb = *(const f32x4*)(cb + f00 + 4);
                const unsigned ob = (unsigned)((R0 + 64 * wr + frL) * DFF + f00) * 2u;
                f32x4 prevA = (f32x4){0.f, 0.f, 0.f, 0.f}, prevB = prevA;
#pragma unroll
                for (int ai = 0; ai < 2; ++ai)
#pragma unroll
                    for (int m = 0; m < 4; ++m) {
                        const int l = 128 * ai + 64 * wr + 16 * m + frL;
                        const float rs = rt[l];
                        if (m == 0) {
                            const int B = 2 * ai + wr;
                            prevA = (f32x4){0.f, 0.f, 0.f, 0.f}; prevB = prevA;
                            if (B > 0 && frL >= 14) { const LAS float* hp = halo + ((B - 1) * 2 + (frL - 14)) * 128 + fl; prevA = *(const LAS f32x4*)hp; prevB = *(const LAS f32x4*)(hp + 4); }
                        }
                        unsigned wv[4];
#pragma unroll
                        for (int n = 0; n < 2; ++n) {
                            const f32x4 w0 = n ? Wb0 : Wa0, w1 = n ? Wb1 : Wa1, w2 = n ? Wb2 : Wa2, bb = n ? Wbb : Wab;
                            const f32x4 cur = acc[ai][1][m][n] * rs, uu = acc[ai][0][m][n] * rs, prev = n ? prevB : prevA;
                            float ov[4];
#pragma unroll
                            for (int e = 0; e < 4; ++e) {
                                const float ce = cur[e], pe = prev[e];
                                const float g1 = dpp_mv<0x121>(k15 ? pe : ce), g2 = dpp_mv<0x122>(k14 ? pe : ce);
                                const float cv = fmaf(w0[e], g2, fmaf(w1[e], g1, fmaf(w2[e], ce, bb[e])));
                                ov[e] = siluf_(cv) * uu[e];
                            }
                            wv[2 * n] = cvt_pk_bf16(ov[0], ov[1]); wv[2 * n + 1] = cvt_pk_bf16(ov[2], ov[3]);
                            if (n) prevB = cur; else prevA = cur;
                        }
                        if (ai > 0 || m > 0 || l >= 2) *(v4u*)((unsigned char*)ACT + (ob + (unsigned)((128 * ai + 16 * m) * DFF * 2))) = (v4u){wv[0], wv[1], wv[2], wv[3]};
                        __builtin_amdgcn_sched_barrier(0);
                    }
            } else
#pragma unroll
            for (int n = 0; n < 2; ++n) {
                const int f0 = u.pn * 128 + fl + 4 * n;
                const f32x4 w0 = *(const f32x4*)(cw + f0), w1 = *(const f32x4*)(cw + DFF + f0), w2 = *(const f32x4*)(cw + 2 * DFF + f0), bb = *(const f32x4*)(cb + f0);
                f32x4 prev = (f32x4){0.f, 0.f, 0.f, 0.f};
#pragma unroll
                for (int ai = 0; ai < 2; ++ai)
#pragma unroll
                    for (int m = 0; m < 4; ++m) {
                        const int l = 128 * ai + 64 * wr + 16 * m + frL, row = 254 * u.pm - 2 + l;
                        const float rs = rt[l];
                        const f32x4 cur = acc[ai][1][m][n] * rs, uu = acc[ai][0][m][n] * rs;
                        if (m == 0) {
                            const int B = 2 * ai + wr;
                            prev = (f32x4){0.f, 0.f, 0.f, 0.f};
                            if (B > 0 && frL >= 14) prev = *(const LAS f32x4*)(halo + ((B - 1) * 2 + (frL - 14)) * 128 + fl + 4 * n);
                        }
                        f32x4 g1, g2;
                        {
                            const float c1x = dpp_ror1(cur.x), c1y = dpp_ror1(cur.y), c1z = dpp_ror1(cur.z), c1w = dpp_ror1(cur.w);
                            const float p1x = dpp_ror1(prev.x), p1y = dpp_ror1(prev.y), p1z = dpp_ror1(prev.z), p1w = dpp_ror1(prev.w);
                            const float c2x = dpp_ror2(cur.x), c2y = dpp_ror2(cur.y), c2z = dpp_ror2(cur.z), c2w = dpp_ror2(cur.w);
                            const float p2x = dpp_ror2(prev.x), p2y = dpp_ror2(prev.y), p2z = dpp_ror2(prev.z), p2w = dpp_ror2(prev.w);
                            const bool s1 = frL >= 1, s2 = frL >= 2;
                            g1.x = s1 ? c1x : p1x; g1.y = s1 ? c1y : p1y; g1.z = s1 ? c1z : p1z; g1.w = s1 ? c1w : p1w;
                            g2.x = s2 ? c2x : p2x; g2.y = s2 ? c2y : p2y; g2.z = s2 ? c2z : p2z; g2.w = s2 ? c2w : p2w;
                        }
                        if (l >= 2 && row < M) {
                            if (row < MP) {
                                const int b = row / TP, t = row - b * TP;
                                if (t < 2) { g2 = (f32x4){0.f, 0.f, 0.f, 0.f}; if (t == 0) g1 = g2; }
                                if (t >= TP - 2) *(f32x4*)(cvp + ((size_t)b * 2 + (t - (TP - 2))) * DFF + f0) = cur;
                            } else {
                                const int s = row - MP;
                                const float* c0 = cst + ((size_t)s * 2 + 0) * DFF + f0;
                                g2 = *(const f32x4*)c0; g1 = *(const f32x4*)(c0 + DFF);
                                float* o = cvs + ((size_t)s * 2 + 0) * DFF + f0;
                                *(f32x4*)o = g1; *(f32x4*)(o + DFF) = cur;
                            }
                            const f32x4 cv = bb + w0 * g2 + w1 * g1 + w2 * cur;
                            v2u w; w.x = cvt_pk_bf16(siluf_(cv.x) * uu.x, siluf_(cv.y) * uu.y); w.y = cvt_pk_bf16(siluf_(cv.z) * uu.z, siluf_(cv.w) * uu.w);
                            *(v2u*)(ACT + (size_t)row * DFF + f0) = w;
                        }
                        prev = cur;
                    }
            }
        } else if (GRP == 0 && kind == EK_RWPROJ) {
            const int cw = wc * 32 + 8 * fq;
            int rrow[2][4];
#pragma unroll
            for (int ai = 0; ai < 2; ++ai)
#pragma unroll
                for (int m = 0; m < 4; ++m) { const int mp = row0 + ai * 128 + m * 16;
                    if (mp < 8 * (TP + 1)) { const int b = mp / (TP + 1), t = mp - b * (TP + 1); rrow[ai][m] = t < TP ? b * TP + t : -1; }
                    else { const int q = mp - 8 * (TP + 1); rrow[ai][m] = (!(q & 1) && q < 2 * SB) ? MP + (q >> 1) : -1; } }
            if (u.pn < 12) {
                bf16* dst = (bf16*)(ws + (u.pn < 4 ? WS_R : (u.pn < 8 ? WS_K : (jl == 0 ? WS_VF : WS_VB)))) + (u.pn & 3) * 256 + cw;
#pragma unroll
                for (int ai = 0; ai < 2; ++ai)
#pragma unroll
                    for (int m = 0; m < 4; ++m) if (rrow[ai][m] >= 0) {
                        bf16* rp = dst + (size_t)rrow[ai][m] * D;
#pragma unroll
                        for (int bj = 0; bj < 2; ++bj) { float o[8];
#pragma unroll
                            for (int n = 0; n < 2; ++n)
#pragma unroll
                                for (int j = 0; j < 4; ++j) o[n * 4 + j] = acc[ai][bj][m][n][j];
                            *(v4u*)(rp + bj * 128) = pack8(o); }
                    }
            } else {
                bf16* A2 = (bf16*)(ws + WS_A2);
#pragma unroll
                for (int bj = 0; bj < 2; ++bj) {
                    const int c = (u.pn - 12) * 256 + bj * 128 + cw;
                    if (c < KL2) {
                        const int kd = c < 64 ? 1 : ((c >= 128 && c < 288) ? 2 : 0);
#pragma unroll
                        for (int ai = 0; ai < 2; ++ai)
#pragma unroll
                            for (int m = 0; m < 4; ++m) if (rrow[ai][m] >= 0) { float o[8];
#pragma unroll
                                for (int n = 0; n < 2; ++n)
#pragma unroll
                                    for (int j = 0; j < 4; ++j) { const float x = acc[ai][bj][m][n][j]; o[n * 4 + j] = kd == 1 ? tanhf_(x) : (kd == 2 ? sigmoidf_(x) : x); }
                                *(v4u*)(A2 + (size_t)rrow[ai][m] * KL2 + c) = pack8(o); }
                    }
                }
            }
        } else if (GRP == 0) {
            bf16* C = (bf16*)(ws + WS_L2);
            const int col0 = u.pn * 256 + wc * 32 + 8 * fq;
#pragma unroll
            for (int ai = 0; ai < 2; ++ai)
#pragma unroll
                for (int m = 0; m < 4; ++m) {
                    bf16* rp = C + (size_t)(row0 + ai * 128 + m * 16) * NL2 + col0;
#pragma unroll
                    for (int bj = 0; bj < 2; ++bj) { float o[8];
#pragma unroll
                        for (int n = 0; n < 2; ++n)
#pragma unroll
                            for (int j = 0; j < 4; ++j) o[n * 4 + j] = acc[ai][bj][m][n][j];
                        *(v4u*)(rp + bj * 128) = pack8(o); }
                }
        }
    }
};

constexpr int MT0 = 16384;
constexpr int HP_SEQ = TP + 1, HP_PB = BATCH * HP_SEQ, HP_M = 66 * 256;
static_assert(HP_PB + 2 * SB <= HP_M && (size_t)(HP_M + 2) * D * 2 <= SZ_MD4, "padded rwkv input");
__device__ __forceinline__ void tail_resid(const bf16* __restrict__ A, const bf16* __restrict__ Bt, int K, unsigned char* ws, int slot, float amul, LAS unsigned char* lds, int lane, int wave) {
    const int fr = lane & 15, fq = lane >> 4;
    const int kw = K >> 3;
    for (int job = blockIdx.x; job < 16 * 16; job += gridDim.x) {
        const int rs = job >> 4, cs = job & 15;
        const bf16* ap = A + (size_t)(MT0 + 16 * rs + fr) * K + wave * kw + 8 * fq;
        const bf16* bp = Bt + (size_t)(64 * cs + fr) * K + wave * kw + 8 * fq;
        f32x4 acc[4];
#pragma unroll
        for (int t = 0; t < 4; ++t) acc[t] = (f32x4){0.f, 0.f, 0.f, 0.f};
#pragma unroll 4
        for (int k0 = 0; k0 < kw; k0 += 32) {
            const bf16x8 af = *(const bf16x8*)(ap + k0);
#pragma unroll
            for (int t = 0; t < 4; ++t) { const bf16x8 bf = *(const bf16x8*)(bp + (size_t)(16 * t) * K + k0); acc[t] = __builtin_amdgcn_mfma_f32_16x16x32_bf16(bf, af, acc[t], 0, 0, 0); }
        }
        __syncthreads();
#pragma unroll
        for (int t = 0; t < 4; ++t) *(LAS f32x4*)(lds + ((wave * 4 + t) * 64 + lane) * 16) = acc[t];
        __syncthreads();
        if (wave == 0) {
#pragma unroll
            for (int t = 0; t < 4; ++t) { f32x4 s = acc[t];
#pragma unroll
                for (int w = 1; w < 8; ++w) s += *(LAS f32x4*)(lds + ((w * 4 + t) * 64 + lane) * 16);
                acc[t] = s; }
            const int row = MT0 + 16 * rs + fr;
            bf16* xb = (bf16*)(ws + WS_XB) + (size_t)row * D + 64 * cs + 4 * fq;
            float ssq = 0.f;
#pragma unroll
            for (int t = 0; t < 4; ++t) { const f32x4 v = ld_bf4(xb + 16 * t) + acc[t] * amul; st_bf4(xb + 16 * t, v);
                if (slot >= 0) ssq += (v.x * v.x + v.y * v.y) + (v.z * v.z + v.w * v.w); }
            if (slot >= 0) { ssq += shfl_xor_l(ssq, 16, lane); ssq += shfl_xor_l(ssq, 32, lane); if (fq == 0) ((float*)(ws + WS_SS))[((size_t)slot * M + row) * 16 + cs] = ssq; }
        }
    }
}

__device__ __forceinline__ void tr_item(const float* __restrict__ W, int ldw, int k0, int n0, bf16* __restrict__ WT, int ldt, int drow, const float* __restrict__ mu, LAS float* scr, int lane, const float* __restrict__ gs = nullptr) {
#pragma unroll 8
    for (int i = 0; i < 32; ++i) { const int kk = 2 * i + (lane >> 5); scr[kk * 33 + (lane & 31)] = W[(size_t)(k0 + kk) * ldw + n0 + (lane & 31)]; }
    asm volatile("s_waitcnt lgkmcnt(0)" ::: "memory");
    const int c = lane & 7;
    float mv[8];
    if (mu) {
#pragma unroll
        for (int e = 0; e < 8; ++e) mv[e] = mu[k0 + 8 * c + e];
    } else if (gs) {
#pragma unroll
        for (int e = 0; e < 8; ++e) mv[e] = gs[k0 + 8 * c + e];
    }
#pragma unroll
    for (int j = 0; j < 4; ++j) {
        const int n = (lane >> 3) + 8 * j; const LAS float* s = scr + (8 * c) * 33 + n;
        float f[8];
#pragma unroll
        for (int e = 0; e < 8; ++e) f[e] = s[e * 33];
        bf16* dp = WT + (size_t)(drow + n) * ldt + k0 + 8 * c;
        if (mu) {
            float f1[8], f2[8];
#pragma unroll
            for (int e = 0; e < 8; ++e) { f1[e] = f[e] * (1.f - mv[e]); f2[e] = f[e] * mv[e]; }
            *(v4u*)dp = pack8(f1); *(v4u*)(dp + 1024) = pack8(f2);
        } else { if (gs) {
#pragma unroll
            for (int e = 0; e < 8; ++e) f[e] *= mv[e]; }
            *(v4u*)dp = pack8(f); }
    }
    asm volatile("s_waitcnt lgkmcnt(0)" ::: "memory");
}

__device__ __forceinline__ void ph_p0(const Params& p, LAS unsigned char* lds, int tid, int lane, int wave) {
    unsigned char* ws = p.ws;
    LAS float* scr = (LAS float*)(lds + wave * 16384);
    const int gw = blockIdx.x * NWAVES + wave, NGW = gridDim.x * NWAVES;
    constexpr int C_WIN = 2 * 16 * 192, C_WOUT = 2 * 32 * 32, C_RKV = 2 * 3 * 512, C_W1 = 2 * 32, C_A1 = 2 * 32, C_G1 = 2 * 80, C_V1 = 16, C_WO = 2 * 512, C_WUG = 4 * 16 * 176, C_WD = 4 * 44 * 32;
    constexpr int NITEMS = C_WIN + C_WOUT + C_RKV + C_W1 + C_A1 + C_G1 + C_V1 + C_WO + C_WUG + C_WD;
    for (int it = gw; it < NITEMS; it += NGW) {
        int r = it;
        if (r < C_WIN) { const int j = r / 3072, q = r % 3072, kb = q / 192, nb = q % 192;
            tr_item(p.in[I_RWIN] + (size_t)j * D * RWIN, RWIN, 64 * kb, 32 * nb, (bf16*)(ws + WS_WIN + j * SZ_WIN), D, 32 * nb, nullptr, scr, lane, p.in[I_NMIX] + (size_t)(2 * j) * D); continue; }
        r -= C_WIN;
        if (r < C_WOUT) { const int j = r / 1024, q = r % 1024, kb = q / 32, nb = q % 32;
            tr_item(p.in[I_RWOUT] + (size_t)j * RV * D, D, 64 * kb, 32 * nb, (bf16*)(ws + WS_WOUT + j * SZ_WOUT), RV, 32 * nb, nullptr, scr, lane); continue; }
        r -= C_WOUT;
        if (r < C_RKV) { const int j = r / 1536, q = r % 1536, s = q / 512, q2 = q % 512, kb = q2 / 32, nb = q2 % 32, c = (s == 0 ? 0 : (s == 1 ? 2 : 3));
            tr_item(p.in[I_WRKV] + (size_t)(j * 3 + s) * D * D, D, 64 * kb, 32 * nb, (bf16*)(ws + WS_WRW + j * SZ_WRW), KRW, s * 1024 + 32 * nb, p.in[I_MU] + (size_t)(j * 6 + c) * D, scr, lane); continue; }
        r -= C_RKV;
        if (r < C_W1) { const int j = r / 32, q = r % 32, kb = q / 2, nb = q % 2;
            tr_item(p.in[I_W1] + (size_t)j * D * LW, LW, 64 * kb, 32 * nb, (bf16*)(ws + WS_WRW + j * SZ_WRW), KRW, 3072 + 32 * nb, p.in[I_MU] + (size_t)(j * 6 + 1) * D, scr, lane); continue; }
        r -= C_W1;
        if (r < C_A1) { const int j = r / 32, q = r % 32, kb = q / 2, nb = q % 2;
            tr_item(p.in[I_A1] + (size_t)j * D * LA, LA, 64 * kb, 32 * nb, (bf16*)(ws + WS_WRW + j * SZ_WRW), KRW, 3136 + 32 * nb, p.in[I_MU] + (size_t)(j * 6 + 4) * D, scr, lane); continue; }
        r -= C_A1;
        if (r < C_G1) { const int j = r / 80, q = r % 80, kb = q / 5, nb = q % 5;
            tr_item(p.in[I_G1] + (size_t)j * D * LG, LG, 64 * kb, 32 * nb, (bf16*)(ws + WS_WRW + j * SZ_WRW), KRW, 3200 + 32 * nb, p.in[I_MU] + (size_t)(j * 6 + 5) * D, scr, lane); continue; }
        r -= C_G1;
        if (r < C_V1) { const int kb = r;
            tr_item(p.in[I_V1], LV, 64 * kb, 0, (bf16*)(ws + WS_WRW + 1 * SZ_WRW), KRW, 3360, p.in[I_MU] + (size_t)(1 * 6 + 3) * D, scr, lane); continue; }
        r -= C_V1;
        if (r < C_WO) { const int j = r / 512, q = r % 512, kb = q / 32, nb = q % 32;
            tr_item(p.in[I_WO] + (size_t)j * D * D, D, 64 * kb, 32 * nb, (bf16*)(ws + WS_WO + j * SZ_WO), D, 32 * nb, nullptr, scr, lane); continue; }
        r -= C_WO;
        if (r < C_WUG) { const int i = r / 2816, q = r % 2816, kb = q / 176, nb = q % 176, n0 = 32 * nb;
            const int drow = n0 < DFF ? 256 * (n0 / 128) + (n0 % 128) : 256 * ((n0 - DFF) / 128) + 128 + ((n0 - DFF) % 128);
            tr_item(p.in[I_WUG] + (size_t)i * D * 2 * DFF, 2 * DFF, 64 * kb, n0, (bf16*)(ws + WS_WUG + i * SZ_WUG), D, drow, nullptr, scr, lane, p.in[I_NFFN] + (size_t)i * D); continue; }
        r -= C_WUG;
        { const int i = r / 1408, q = r % 1408, kb = q / 32, nb = q % 32;
            tr_item(p.in[I_WD] + (size_t)i * DFF * D, D, 64 * kb, 32 * nb, (bf16*)(ws + WS_WD + i * SZ_WD), DFF, 32 * nb, nullptr, scr, lane); }
    }
    const size_t gt = (size_t)blockIdx.x * NTHR + tid, GT = (size_t)gridDim.x * NTHR;
    for (size_t i = gt; i < (size_t)(224 + 192) * (KRW / 8); i += GT) {
        const int rr = (int)(i / (KRW / 8)), c8 = (int)(i % (KRW / 8));
        const int j = rr < 224 ? 0 : 1, row = rr < 224 ? 3360 + rr : 3392 + (rr - 224);
        *(v4u*)((bf16*)(ws + WS_WRW + j * SZ_WRW) + (size_t)row * KRW + c8 * 8) = (v4u){0u, 0u, 0u, 0u};
    }
    for (size_t i = gt; i < (size_t)2 * NL2 * KL2; i += GT) {
        const int j = (int)(i / ((size_t)NL2 * KL2)); const int rem = (int)(i % ((size_t)NL2 * KL2)); const int n = rem / KL2, k = rem % KL2, grp = n >> 10, nn = n & 1023;
        float v = 0.f;
        if (grp == 0) { if (k < 64) v = p.in[I_W2][((size_t)j * LW + k) * D + nn]; }
        else if (grp == 1) { if (k >= 64 && k < 128) v = p.in[I_A2][((size_t)j * LA + (k - 64)) * D + nn]; }
        else if (grp == 2) { if (k >= 128 && k < 288) v = p.in[I_G2][((size_t)j * LG + (k - 128)) * D + nn]; }
        else { if (j == 1 && k >= 288 && k < 320) v = p.in[I_V2][((size_t)(k - 288)) * D + nn]; }
        ((bf16*)(ws + WS_WL2 + j * SZ_WL2))[(size_t)n * KL2 + k] = (bf16)(cvt_pk_bf16(v, 0.f) & 0xffffu);
    }
    for (size_t i = gt; i < (size_t)(TP + 1) * 128; i += GT) {
        const int pi = (int)(i >> 7), mi = (int)(i & 127);
        const float pos = pi < TP ? (float)pi : PAST_POS;
        const float inv = 1.0f / powf(10000.0f, (float)mi / 127.0f);
        float s, c; sincosf(pos * inv, &s, &c);
        ((float2*)(ws + WS_CS))[i] = make_float2(c, s);
    }
    bf16* XB = (bf16*)(ws + WS_XB);
    for (int r = gw; r < M; r += NGW) {
        const float* src;
        if (r < MP) { const int b = r / TP, t = r % TP; src = t < NMETA ? p.in[I_META] + (size_t)t * D : p.in[I_XP] + ((size_t)b * SEQ + (t - NMETA)) * D; }
        else src = p.in[I_XS] + (size_t)(r - MP) * D;
        float ss = 0.f;
#pragma unroll
        for (int j = 0; j < 2; ++j) { const int c0 = 512 * j + 8 * lane;
            const f32x4 a4 = *(const f32x4*)(src + c0), b4 = *(const f32x4*)(src + c0 + 4);
            const float f[8] = {a4.x, a4.y, a4.z, a4.w, b4.x, b4.y, b4.z, b4.w};
#pragma unroll
            for (int e = 0; e < 8; ++e) ss += f[e] * f[e];
            *(v4u*)(XB + (size_t)r * D + c0) = pack8(f); }
        ss = wave_sum(ss, lane);
        if (lane < 16) ((float*)(ws + WS_SS))[(size_t)r * 16 + lane] = lane == 0 ? ss : 0.f;
    }
}

__device__ __forceinline__ void ph_norm(const Params& p, const float* __restrict__ g, int mode, int jl, int lane, int wave) {
    const bf16* X = (const bf16*)(p.ws + WS_XB); bf16* H = (bf16*)(p.ws + WS_H);
    const int gw = blockIdx.x * NWAVES + wave, NGW = gridDim.x * NWAVES;
    constexpr int UB = 4;
    for (int row0 = gw; row0 < M; row0 += NGW * UB) {
    v4u raw[UB][2];
#pragma unroll
    for (int q = 0; q < UB; ++q) { const int r_ = row0 + q * NGW, rc_ = r_ < M ? r_ : row0;
#pragma unroll
        for (int j = 0; j < 2; ++j) raw[q][j] = *(const v4u*)(X + (size_t)rc_ * D + 512 * j + 8 * lane); }
#pragma unroll
    for (int q = 0; q < UB; ++q) { const int row = row0 + q * NGW; if (row < M) {
        float v[2][8]; float ss = 0.f;
#pragma unroll
        for (int j = 0; j < 2; ++j) {
            unpack8(raw[q][j], v[j]);
#pragma unroll
            for (int e = 0; e < 8; ++e) ss += v[j][e] * v[j][e];
        }
        ss = wave_sum(ss, lane);
        const float rstd = rsqrtf(ss * (1.f / D) + 1e-6f);
        const bool prompt = row < MP; const int b = prompt ? row / TP : 0, t = prompt ? row % TP : 0;
#pragma unroll
        for (int j = 0; j < 2; ++j) {
            const int c0 = 512 * j + 8 * lane;
            const f32x4 ga = *(const f32x4*)(g + c0), gb = *(const f32x4*)(g + c0 + 4);
            float o[8];
            o[0] = v[j][0] * rstd * ga.x; o[1] = v[j][1] * rstd * ga.y; o[2] = v[j][2] * rstd * ga.z; o[3] = v[j][3] * rstd * ga.w;
            o[4] = v[j][4] * rstd * gb.x; o[5] = v[j][5] * rstd * gb.y; o[6] = v[j][6] * rstd * gb.z; o[7] = v[j][7] * rstd * gb.w;
            if (mode == 0) { *(v4u*)(H + (size_t)row * D + c0) = pack8(o); }
            else if (mode == 1) {
                const v4u w = pack8(o);
                if (prompt) {
                    bf16* hp = H + (size_t)(b * HP_SEQ + 1 + t) * D + c0;
                    *(v4u*)hp = w;
                    if (t == TP - 1) { float* so = p.out + O_SHP + ((size_t)jl * BATCH + b) * D + c0; *(f32x4*)so = (f32x4){o[0], o[1], o[2], o[3]}; *(f32x4*)(so + 4) = (f32x4){o[4], o[5], o[6], o[7]}; }
                    if (t == 0) *(v4u*)(hp - D) = (v4u){0u, 0u, 0u, 0u};
                } else {
                    const int s = row - MP;
                    const float* sp = p.in[I_SSHIFT] + ((size_t)jl * SB + s) * D + c0;
                    const f32x4 sa = *(const f32x4*)sp, sb2 = *(const f32x4*)(sp + 4);
                    const float pv[8] = {sa.x, sa.y, sa.z, sa.w, sb2.x, sb2.y, sb2.z, sb2.w};
                    bf16* hp = H + (size_t)(HP_PB + 2 * s) * D + c0;
                    *(v4u*)hp = pack8(pv); *(v4u*)(hp + D) = w;
                    float* so = p.out + O_SHS + ((size_t)jl * SB + s) * D + c0; *(f32x4*)so = (f32x4){o[0], o[1], o[2], o[3]}; *(f32x4*)(so + 4) = (f32x4){o[4], o[5], o[6], o[7]};
                }
            } else {
                float* dst = nullptr;
                if (prompt) { if (t >= NMETA) dst = p.out + O_YP + ((size_t)b * SEQ + (t - NMETA)) * D + c0; }
                else dst = p.out + O_YS + (size_t)(row - MP) * D + c0;
                if (dst) { *(f32x4*)dst = (f32x4){o[0], o[1], o[2], o[3]}; *(f32x4*)(dst + 4) = (f32x4){o[4], o[5], o[6], o[7]}; }
            }
        }
    } }
    }
}

__device__ __forceinline__ void ph_ret_norm(const Params& p, int jl, int lane, int wave) {
    const bf16* O = (const bf16*)(p.ws + WS_O); const bf16* SG = (const bf16*)(p.ws + WS_SG); bf16* Y = (bf16*)(p.ws + WS_Y);
    const float* gnw = p.in[I_RGN] + (size_t)jl * RV;
    const int gw = blockIdx.x * NWAVES + wave, NGW = gridDim.x * NWAVES;
    constexpr int UB = 4;
    for (int it0 = gw; it0 < M * RH; it0 += NGW * UB) {
        const int h = it0 & 3;
        const f32x4 ga = *(const f32x4*)(gnw + h * RDV + 8 * lane), gb = *(const f32x4*)(gnw + h * RDV + 8 * lane + 4);
        const float gg[8] = {ga.x, ga.y, ga.z, ga.w, gb.x, gb.y, gb.z, gb.w};
        v4u ov[UB], sgv[UB];
#pragma unroll
        for (int q = 0; q < UB; ++q) { const int it = it0 + q * NGW, itc = it < M * RH ? it : it0; const size_t off = (size_t)(itc >> 2) * RV + h * RDV + 8 * lane;
            ov[q] = *(const v4u*)(O + off); sgv[q] = *(const v4u*)(SG + off); }
#pragma unroll
        for (int q = 0; q < UB; ++q) { const int it = it0 + q * NGW; const size_t off = (size_t)(it >> 2) * RV + h * RDV + 8 * lane;
            float v[8]; unpack8(ov[q], v);
            float s = 0.f;
#pragma unroll
            for (int e = 0; e < 8; ++e) s += v[e];
            const float mean = wave_sum(s, lane) * (1.f / RDV);
            float s2 = 0.f;
#pragma unroll
            for (int e = 0; e < 8; ++e) { v[e] -= mean; s2 += v[e] * v[e]; }
            const float rstd = rsqrtf(wave_sum(s2, lane) * (1.f / RDV) + 1e-5f);
            float sg[8]; unpack8(sgv[q], sg);
            float o[8];
#pragma unroll
            for (int e = 0; e < 8; ++e) o[e] = v[e] * rstd * gg[e] * sg[e];
            if (it < M * RH) *(v4u*)(Y + off) = pack8(o);
        }
    }
}

__device__ __forceinline__ float row16_sum(float x);
__device__ __forceinline__ float half8_sum(float x);
__device__ __forceinline__ void ph_rwkv_post(const Params& p, int jl, int lane, int wave) {
    const bf16* YW = (const bf16*)(p.ws + WS_YW); const float* BON = (const float*)(p.ws + WS_NKK);
    const bf16* VP = (const bf16*)(p.ws + (jl == 0 ? WS_VF : WS_KKA)); const bf16* L2 = (const bf16*)(p.ws + WS_L2); bf16* Z = (bf16*)(p.ws + WS_Z);
    const float* lnw = p.in[I_LNW] + (size_t)jl * D; const float* lnb = p.in[I_LNB] + (size_t)jl * D;
    const int gw = blockIdx.x * NWAVES + wave, NGW = gridDim.x * NWAVES;
    const int sub = lane >> 3, c8 = lane & 7;
    constexpr int UB = 4;
    for (int it0 = gw * 8; it0 < M * WH; it0 += NGW * 8 * UB) {
        const int h = (it0 + sub) & 15, c = h * WN + 8 * c8;
        const f32x4 lwa = *(const f32x4*)(lnw + c), lwb = *(const f32x4*)(lnw + c + 4), lba = *(const f32x4*)(lnb + c), lbb = *(const f32x4*)(lnb + c + 4);
        const float lw[8] = {lwa.x, lwa.y, lwa.z, lwa.w, lwb.x, lwb.y, lwb.z, lwb.w}, lb[8] = {lba.x, lba.y, lba.z, lba.w, lbb.x, lbb.y, lbb.z, lbb.w};
        v4u y4[UB], v4[UB], g4[UB]; float bonv[UB];
#pragma unroll
        for (int q = 0; q < UB; ++q) { const int it = it0 + q * NGW * 8 + sub, itc = it < M * WH ? it : it0 + sub, row = itc >> 4; const size_t idx = (size_t)row * D + c;
            y4[q] = *(const v4u*)(YW + idx); bonv[q] = BON[(size_t)row * WH + h]; v4[q] = *(const v4u*)(VP + idx); g4[q] = *(const v4u*)(L2 + (size_t)row * NL2 + 2048 + c); }
#pragma unroll
        for (int q = 0; q < UB; ++q) { const int it = it0 + q * NGW * 8 + sub, row = it >> 4; const size_t idx = (size_t)row * D + c;
            float yv[8], vv[8], gv[8]; unpack8(y4[q], yv); unpack8(v4[q], vv); unpack8(g4[q], gv);
            float s = 0.f;
#pragma unroll
            for (int e = 0; e < 8; ++e) s += yv[e];
            const float mean = half8_sum(s) * (1.f / WN);
            float s2 = 0.f;
#pragma unroll
            for (int e = 0; e < 8; ++e) { yv[e] -= mean; s2 += yv[e] * yv[e]; }
            const float rstd = rsqrtf(half8_sum(s2) * (1.f / WN) + 64e-5f);
            float z[8];
#pragma unroll
            for (int e = 0; e < 8; ++e) z[e] = (yv[e] * rstd * lw[e] + lb[e] + vv[e] * bonv[q]) * gv[e];
            if (it < M * WH) *(v4u*)(Z + idx) = pack8(z);
        }
    }
}

constexpr int RT_KP = 528, RT_VP = 144, RT_SP = 528;
constexpr int RT_K_OFF = 0, RT_V_OFF = 128 * RT_KP, RT_ST_OFF = RT_V_OFF + 128 * RT_VP, RT_END = RT_ST_OFF + 64 * RT_SP;
static_assert(RT_END <= LDS_BYTES, "retention LDS map");
typedef short v4s __attribute__((ext_vector_type(4)));
__device__ __forceinline__ bf16x8 tr_pair(LAS unsigned char* a0, LAS unsigned char* a1) {
    const v4s lo = __builtin_amdgcn_ds_read_tr16_b64_v4i16((LAS v4s*)a0), hi = __builtin_amdgcn_ds_read_tr16_b64_v4i16((LAS v4s*)a1);
    return __builtin_shufflevector(lo, hi, 0, 1, 2, 3, 4, 5, 6, 7);
}
__device__ __forceinline__ void ph_ret_fast(const Params& p, int jl, LAS unsigned char* lds, int tid, int lane, int wave) {
    const bf16* QK = (const bf16*)(p.ws + WS_QK); const bf16* V = (const bf16*)(p.ws + WS_V); bf16* O = (bf16*)(p.ws + WS_O);
    const int fr = lane & 15, fq = lane >> 4, li_q = (lane & 15) >> 2, li_p = lane & 3;
    for (int u = blockIdx.x; u < BATCH * RH * 8; u += gridDim.x) {
        const int es = u & 7, h = (u >> 3) & 3, b = u >> 5;
        const float gamma = 1.0f - exp2f(-5.0f - (float)h), lg = log2f(gamma), g128 = exp2f(128.f * lg), g127 = exp2f(127.f * lg);
        const int it_ = wave < 4 ? wave : 11 - wave, i0 = 16 * it_, d0 = 32 * wave;
        f32x4 Sacc[2][4];
#pragma unroll
        for (int a = 0; a < 2; ++a)
#pragma unroll
            for (int c = 0; c < 4; ++c) Sacc[a][c] = (f32x4){0.f, 0.f, 0.f, 0.f};
        __syncthreads();
        for (int i = tid; i < 64 * RT_SP / 16; i += NTHR) *(LAS v4u*)(lds + RT_ST_OFF + i * 16) = (v4u){0u, 0u, 0u, 0u};
        v4u kst[8], vst[2];
        const bf16* Kg = QK + 1024 + 256 * h; const bf16* Vg = V + 512 * h + 64 * es; const bf16* Qg = QK + 256 * h;
#define RT_LOAD_STAGE(cc) do { int tl_ = tid; asm volatile("" : "+v"(tl_));     \
            _Pragma("unroll") for (int k_ = 0; k_ < 8; ++k_) { const int id_ = tl_ + 512 * k_, row_ = id_ >> 5, ch_ = id_ & 31, t_ = 128 * (cc) - 112 + row_; \
                kst[k_] = t_ >= 0 ? *(const v4u*)(Kg + (size_t)(b * TP + t_) * 2048 + 8 * ch_) : (v4u){0u, 0u, 0u, 0u}; } \
            _Pragma("unroll") for (int k_ = 0; k_ < 2; ++k_) { const int id_ = tl_ + 512 * k_, row_ = id_ >> 3, ch_ = id_ & 7, t_ = 128 * (cc) - 112 + row_; \
                vst[k_] = t_ >= 0 ? *(const v4u*)(Vg + (size_t)(b * TP + t_) * 2048 + 8 * ch_) : (v4u){0u, 0u, 0u, 0u}; } } while (0)
        RT_LOAD_STAGE(0);
        bf16x8 Qf[8];
#define RT_LOAD_Q(cc) do { int ll_ = lane; asm volatile("" : "+v"(ll_)); const int t_ = 128 * (cc) - 112 + i0 + (ll_ & 15); \
            _Pragma("unroll") for (int s = 0; s < 8; ++s) Qf[s] = t_ >= 0 ? *(const bf16x8*)(Qg + (size_t)(b * TP + t_) * 2048 + 32 * s + 8 * (ll_ >> 4)) : (bf16x8){0, 0, 0, 0, 0, 0, 0, 0}; } while (0)
        RT_LOAD_Q(0);
        for (int c = 0; c < 17; ++c) {
            __syncthreads();
#pragma unroll
            for (int k_ = 0; k_ < 8; ++k_) { const int id_ = tid + 512 * k_, row_ = id_ >> 5, ch_ = id_ & 31; *(LAS v4u*)(lds + RT_K_OFF + row_ * RT_KP + ch_ * 16) = kst[k_]; }
#pragma unroll
            for (int k_ = 0; k_ < 2; ++k_) { const int id_ = tid + 512 * k_, row_ = id_ >> 3, ch_ = id_ & 7;
                float f[8]; unpack8(vst[k_], f); const float sc = exp2f(-(float)row_ * lg);
#pragma unroll
                for (int e = 0; e < 8; ++e) f[e] *= sc;
                *(LAS v4u*)(lds + RT_V_OFF + row_ * RT_VP + ch_ * 16) = pack8(f); }
            __syncthreads();
            bf16x8 Pf[4];
            { const int ii = i0 + fr; const float gi = exp2f((float)ii * lg);
#pragma unroll
              for (int s2 = 0; s2 < 4; ++s2) { f32x4 Dp[2];
                  Dp[0] = (f32x4){0.f, 0.f, 0.f, 0.f}; Dp[1] = Dp[0];
                  if (2 * s2 <= it_) {
                      bf16x8 Ka[8], Kb[8];
#pragma unroll
                      for (int s = 0; s < 8; ++s) { Ka[s] = *(const LAS bf16x8*)(lds + RT_K_OFF + (16 * (2 * s2) + fr) * RT_KP + (32 * s + 8 * fq) * 2);
                          Kb[s] = *(const LAS bf16x8*)(lds + RT_K_OFF + (16 * (2 * s2 + 1) + fr) * RT_KP + (32 * s + 8 * fq) * 2); }
                      __builtin_amdgcn_sched_barrier(0);
                      __builtin_amdgcn_s_setprio(1);
#pragma unroll
                      for (int s = 0; s < 8; ++s) { Dp[0] = __builtin_amdgcn_mfma_f32_16x16x32_bf16(Ka[s], Qf[s], Dp[0], 0, 0, 0); Dp[1] = __builtin_amdgcn_mfma_f32_16x16x32_bf16(Kb[s], Qf[s], Dp[1], 0, 0, 0); }
                      __builtin_amdgcn_s_setprio(0);
                      __builtin_amdgcn_sched_barrier(0);
                  }
                  float f[8];
#pragma unroll
                  for (int hh = 0; hh < 2; ++hh)
#pragma unroll
                      for (int r = 0; r < 4; ++r) { const int jj = 16 * (2 * s2 + hh) + 4 * fq + r; f[hh * 4 + r] = ii >= jj ? Dp[hh][r] * gi : 0.f; }
                  const v4u w = pack8(f); Pf[s2] = __builtin_bit_cast(bf16x8, w); } }
            f32x4 Oacc[4];
#pragma unroll
            for (int ep = 0; ep < 2; ++ep) {
                bf16x8 Sa[8], Sb[8];
#pragma unroll
                for (int s = 0; s < 8; ++s) { Sa[s] = *(const LAS bf16x8*)(lds + RT_ST_OFF + (16 * (2 * ep) + fr) * RT_SP + (32 * s + 8 * fq) * 2);
                    Sb[s] = *(const LAS bf16x8*)(lds + RT_ST_OFF + (16 * (2 * ep + 1) + fr) * RT_SP + (32 * s + 8 * fq) * 2); }
                __builtin_amdgcn_sched_barrier(0);
                f32x4 oa = (f32x4){0.f, 0.f, 0.f, 0.f}, ob = oa;
                __builtin_amdgcn_s_setprio(1);
#pragma unroll
                for (int s = 0; s < 8; ++s) { oa = __builtin_amdgcn_mfma_f32_16x16x32_bf16(Qf[s], Sa[s], oa, 0, 0, 0); ob = __builtin_amdgcn_mfma_f32_16x16x32_bf16(Qf[s], Sb[s], ob, 0, 0, 0); }
                __builtin_amdgcn_s_setprio(0);
                Oacc[2 * ep] = oa; Oacc[2 * ep + 1] = ob;
                __builtin_amdgcn_sched_barrier(0);
            }
            __syncthreads();
            if (c + 1 < 17) RT_LOAD_STAGE(c + 1);
#pragma unroll
            for (int r = 0; r < 4; ++r) { const float lam = exp2f((float)(i0 + 4 * fq + r + 1) * lg);
#pragma unroll
                for (int et = 0; et < 4; ++et) Oacc[et][r] *= lam; }
#pragma unroll
            for (int s = 0; s < 4; ++s) if (2 * s <= it_) {
                bf16x8 Vf[4];
#pragma unroll
                for (int et = 0; et < 4; ++et) { LAS unsigned char* a0 = lds + RT_V_OFF + (32 * s + 4 * fq + li_q) * RT_VP + (16 * et + 4 * li_p) * 2; Vf[et] = tr_pair(a0, a0 + 16 * RT_VP); }
                __builtin_amdgcn_sched_barrier(0);
#pragma unroll
                for (int et = 0; et < 4; ++et) Oacc[et] = __builtin_amdgcn_mfma_f32_16x16x32_bf16(Pf[s], Vf[et], Oacc[et], 0, 0, 0);
            }
            {
                v2u ow[4];
#pragma unroll
                for (int et = 0; et < 4; ++et) { float oq[4] = {Oacc[et][0], Oacc[et][1], Oacc[et][2], Oacc[et][3]}; quad_transpose4(oq, fr & 3); ow[et] = pk4((f32x4){oq[0], oq[1], oq[2], oq[3]}); }
                const int t_ = 128 * c - 112 + i0 + 4 * fq + (fr & 3);
                if (t_ >= 0) { bf16* op = O + (size_t)(b * TP + t_) * RV + 512 * h + 64 * es + (fr & 12);
#pragma unroll
                    for (int et = 0; et < 4; ++et) *(v2u*)(op + 16 * et) = ow[et]; }
            }
#pragma unroll
            for (int dt = 0; dt < 2; ++dt)
#pragma unroll
                for (int et = 0; et < 4; ++et) Sacc[dt][et] = Sacc[dt][et] * (g128 / g127);
            {
                bf16x8 Kt[2][2], Vt[2][4];
#define RT_RD4(bufi, s_) do { \
                _Pragma("unroll") for (int dt = 0; dt < 2; ++dt) { LAS unsigned char* a0 = lds + RT_K_OFF + (32 * (s_) + 8 * fq + li_q) * RT_KP + (d0 + 16 * dt + 4 * li_p) * 2; Kt[bufi][dt] = tr_pair(a0, a0 + 4 * RT_KP); } \
                _Pragma("unroll") for (int et = 0; et < 4; ++et) { LAS unsigned char* a0 = lds + RT_V_OFF + (32 * (s_) + 8 * fq + li_q) * RT_VP + (16 * et + 4 * li_p) * 2; Vt[bufi][et] = tr_pair(a0, a0 + 4 * RT_VP); } } while (0)
                RT_RD4(0, 0);
#pragma unroll
                for (int s = 0; s < 4; ++s) {
                    __builtin_amdgcn_sched_barrier(0);
                    if (s + 1 < 4) RT_RD4((s + 1) & 1, s + 1);
                    __builtin_amdgcn_s_setprio(1);
#pragma unroll
                    for (int dt = 0; dt < 2; ++dt)
#pragma unroll
                        for (int et = 0; et < 4; ++et) Sacc[dt][et] = __builtin_amdgcn_mfma_f32_16x16x32_bf16(Kt[s & 1][dt], Vt[s & 1][et], Sacc[dt][et], 0, 0, 0);
                    __builtin_amdgcn_s_setprio(0);
                }
                __builtin_amdgcn_sched_barrier(0);
#undef RT_RD4
            }
#pragma unroll
            for (int dt = 0; dt < 2; ++dt)
#pragma unroll
                for (int et = 0; et < 4; ++et) Sacc[dt][et] = Sacc[dt][et] * g127;
#pragma unroll
            for (int dt = 0; dt < 2; ++dt)
#pragma unroll
                for (int et = 0; et < 4; ++et) { v2u w; w.x = cvt_pk_bf16(Sacc[dt][et][0], Sacc[dt][et][1]); w.y = cvt_pk_bf16(Sacc[dt][et][2], Sacc[dt][et][3]);
                    *(LAS v2u*)(lds + RT_ST_OFF + (16 * et + fr) * RT_SP + (d0 + 16 * dt + 4 * fq) * 2) = w; }
            if (c + 1 < 17) RT_LOAD_Q(c + 1);
        }
#undef RT_LOAD_Q
#undef RT_LOAD_STAGE
        float* so = p.out + O_RETP + ((((size_t)jl * BATCH + b) * RH + h) * RDK) * RDV + 64 * es;
#pragma unroll
        for (int dt = 0; dt < 2; ++dt)
#pragma unroll
            for (int et = 0; et < 4; ++et)
#pragma unroll
                for (int r = 0; r < 4; ++r) so[(size_t)(d0 + 16 * dt + 4 * fq + r) * RDV + 16 * et + fr] = Sacc[dt][et][r];
    }
    {
        LAS float* sq = (LAS float*)lds; LAS float* sk = sq + 256; LAS float* red = sk + 256;
        const int e4 = tid & 127, dq = tid >> 7;
        for (int it = blockIdx.x; it < SB * RH; it += gridDim.x) {
            const int h = it & 3, s = it >> 2, row = MP + s;
            const float gamma = 1.0f - exp2f(-5.0f - (float)h);
            __syncthreads();
            if (tid < 256) sq[tid] = bf_lo((unsigned)QK[(size_t)row * 2048 + 256 * h + tid]);
            else sk[tid - 256] = bf_lo((unsigned)QK[(size_t)row * 2048 + 1024 + 256 * h + (tid - 256)]);
            const v2u vv = *(const v2u*)(V + (size_t)row * 2048 + 512 * h + 4 * e4);
            const f32x4 v4 = (f32x4){bf_lo(vv.x), bf_hi(vv.x), bf_lo(vv.y), bf_hi(vv.y)};
            __syncthreads();
            const float* sin_ = p.in[I_SRET] + ((((size_t)jl * SB + s) * RH + h) * RDK) * RDV + 4 * e4;
            float* sout = p.out + O_RETS + ((((size_t)jl * SB + s) * RH + h) * RDK) * RDV + 4 * e4;
            f32x4 oacc = (f32x4){0.f, 0.f, 0.f, 0.f};
#pragma unroll 8
            for (int k = 0; k < 64; ++k) { const int d = dq + 4 * k;
                const f32x4 sv = __builtin_nontemporal_load((const f32x4*)(sin_ + (size_t)d * RDV));
                const f32x4 sn = sv * gamma + v4 * sk[d];
                oacc += sn * sq[d];
                __builtin_nontemporal_store(sn, (f32x4*)(sout + (size_t)d * RDV)); }
            *(LAS f32x4*)(red + dq * 512 + 4 * e4) = oacc;
            __syncthreads();
            if (dq == 0) { const f32x4 r = (*(LAS f32x4*)(red + 4 * e4) + *(LAS f32x4*)(red + 512 + 4 * e4)) + (*(LAS f32x4*)(red + 1024 + 4 * e4) + *(LAS f32x4*)(red + 1536 + 4 * e4));
                st_bf4(O + (size_t)row * RV + 512 * h + 4 * e4, r); }
        }
    }
}

typedef float f32x2w __attribute__((ext_vector_type(2)));
constexpr int WK_TB = 32, WK_STEP_B = 6 * 256 + 16, WK_BUF_B = WK_TB * WK_STEP_B, WK_Y_OFF = 2 * WK_BUF_B, WK_YB_B = WK_TB * 32 * 4;
static_assert(WK_Y_OFF + 2 * WK_YB_B <= LDS_BYTES - 16, "wkv LDS map");
__device__ __forceinline__ float row16_sum(float x) {
    x += __builtin_bit_cast(float, __builtin_amdgcn_update_dpp(0, __builtin_bit_cast(int, x), 0x128, 0xf, 0xf, false));
    x += __builtin_bit_cast(float, __builtin_amdgcn_update_dpp(0, __builtin_bit_cast(int, x), 0x124, 0xf, 0xf, false));
    x += __builtin_bit_cast(float, __builtin_amdgcn_update_dpp(0, __builtin_bit_cast(int, x), 0x122, 0xf, 0xf, false));
    x += __builtin_bit_cast(float, __builtin_amdgcn_update_dpp(0, __builtin_bit_cast(int, x), 0x121, 0xf, 0xf, false));
    return x;
}
__device__ __forceinline__ float half8_sum(float x) {
    x += __builtin_bit_cast(float, __builtin_amdgcn_update_dpp(0, __builtin_bit_cast(int, x), 0x141, 0xf, 0xf, false));
    x += __builtin_bit_cast(float, __builtin_amdgcn_update_dpp(0, __builtin_bit_cast(int, x), 0xB1, 0xf, 0xf, false));
    x += __builtin_bit_cast(float, __builtin_amdgcn_update_dpp(0, __builtin_bit_cast(int, x), 0x4E, 0xf, 0xf, false));
    return x;
}
struct WkPar { f32x4 w0, a0, kkp, kap, v0; };
__device__ __forceinline__ f32x4 wk_unit_neg(const f32x4 kraw, const f32x4 kkp) {
    const f32x4 kk = kraw * kkp;
    const float ss = row16_sum((kk.x * kk.x + kk.y * kk.y) + (kk.z * kk.z + kk.w * kk.w));
    return kk * (-rsqrtf(fmaxf(ss, 1e-12f)));
}
__device__ __forceinline__ float wk_decay(float x) { return __expf(-0.60653065971263342f * sigmoidf_(x)); }
__device__ __forceinline__ void wk_prep(const WkPar& P, const f32x4 kraw, const f32x4 vraw, const f32x4 lw2, const f32x4 la2, const f32x4 vf, const f32x4 lv2, bool vres,
                                        f32x4& w, f32x4& ka, f32x4& km, f32x4& vp, f32x4& nk) {
    nk = wk_unit_neg(kraw, P.kkp);
    w = (f32x4){wk_decay(P.w0.x + lw2.x), wk_decay(P.w0.y + lw2.y), wk_decay(P.w0.z + lw2.z), wk_decay(P.w0.w + lw2.w)};
    const f32x4 a = (f32x4){sigmoidf_(P.a0.x + la2.x), sigmoidf_(P.a0.y + la2.y), sigmoidf_(P.a0.z + la2.z), sigmoidf_(P.a0.w + la2.w)};
    ka = nk * (-a);
    km = kraw * ((a - 1.f) * P.kap + 1.f);
    vp = vraw;
    if (vres) { const f32x4 sg = (f32x4){sigmoidf_(P.v0.x + lv2.x), sigmoidf_(P.v0.y + lv2.y), sigmoidf_(P.v0.z + lv2.z), sigmoidf_(P.v0.w + lv2.w)}; vp = vraw + (vf - vraw) * sg; }
}
constexpr int WC_C = 16, WC_NCH = TP / WC_C;
static_assert(WC_NCH * WC_C == TP, "chunking");
constexpr int REC_WA = 0, REC_RP = 2048, REC_BK = 4096, REC_VV = 8192, REC_TK = 10240, REC_MY = 10752, REC_GC = 11264, REC_BYTES = 11520;
constexpr size_t WS_REC = WS_END;
constexpr size_t WS_END2 = WS_REC + (size_t)BATCH * WH * WC_NCH * REC_BYTES;
__device__ __forceinline__ unsigned bf_rne_c(float f) { unsigned u = __float_as_uint(f); return (u + 0x7fffu + ((u >> 16) & 1u)) >> 16; }
__device__ __forceinline__ unsigned pk2_c(float lo, float hi) { return bf_rne_c(lo) | (bf_rne_c(hi) << 16); }
__device__ __forceinline__ float bf_rd(const bf16* q) { return __uint_as_float((unsigned)(*q) << 16); }
__device__ __forceinline__ bf16 bf_of(float x) { return (bf16)(cvt_pk_bf16(x, 0.f) & 0xffffu); }

__device__ __forceinline__ f32x4 mm16(const v2u a, const v2u b, const f32x4 c) { return __builtin_amdgcn_mfma_f32_16x16x16bf16_1k(__builtin_bit_cast(v4s, a), __builtin_bit_cast(v4s, b), c, 0, 0, 0); }
__device__ __forceinline__ f32x4 mm32(const v2u a0, const v2u a1, const v2u b0, const v2u b1, const f32x4 c) {
    const v4u a = (v4u){a0.x, a0.y, a1.x, a1.y}, b = (v4u){b0.x, b0.y, b1.x, b1.y};
    return __builtin_amdgcn_mfma_f32_16x16x32_bf16(__builtin_bit_cast(bf16x8, a), __builtin_bit_cast(bf16x8, b), c, 0, 0, 0);
}
template <int CTRL> __device__ __forceinline__ float dppz(float x) { return __int_as_float(__builtin_amdgcn_update_dpp(0, __float_as_int(x), CTRL, 0xf, 0xf, true)); }
__device__ __forceinline__ float psum16(float x) { x += dppz<0x111>(x); x += dppz<0x112>(x); x += dppz<0x114>(x); x += dppz<0x118>(x); return x; }
__device__ __forceinline__ v2u tr16(LAS unsigned char* a) { return __builtin_bit_cast(v2u, __builtin_amdgcn_ds_read_tr16_b64_v4i16((LAS v4s*)a)); }
__device__ __forceinline__ void ph_wkv1(const Params& p, int jl, LAS unsigned char* lds, int lane_in, int wave) {
    const bf16* Kr = (const bf16*)(p.ws + WS_K); const bf16* Vr = (const bf16*)(p.ws + (jl == 0 ? WS_VF : WS_VB)); const bf16* VFp = (const bf16*)(p.ws + WS_VF);
    const bf16* Rr = (const bf16*)(p.ws + WS_R); const bf16* L2 = (const bf16*)(p.ws + WS_L2);
    float* BON = (float*)(p.ws + WS_NKK); bf16* VP = (bf16*)(p.ws + WS_KKA);
    const bool vres = jl == 1;
    constexpr int IMG = 16 * 144;
    constexpr float CL2 = 0.60653065971263342f * 1.4426950408889634f;
    const int gw = wave * gridDim.x + blockIdx.x, NGW = gridDim.x * NWAVES;
    v4u wK[2], wLW[2], wLA[2], wR[2], wV[2], wVF[2], wLV[2];
#define W1_LOAD_RAW(jb, lnx) do { const int c_ = (jb) % WC_NCH, sh_ = (jb) / WC_NCH, r_ = (sh_ >> 4) * TP + WC_C * c_ + ((lnx) & 15), fq_ = (lnx) >> 4, cb_ = (sh_ & 15) * WN + (fq_ & 1) * 16 + (fq_ >> 1) * 8; \
        const size_t ro_ = (size_t)r_ * D + cb_, lo_ = (size_t)r_ * NL2 + cb_; \
        _Pragma("unroll") for (int P = 0; P < 2; ++P) { wK[P] = *(const v4u*)(Kr + ro_ + 32 * P); wLW[P] = *(const v4u*)(L2 + lo_ + 32 * P); wLA[P] = *(const v4u*)(L2 + lo_ + 1024 + 32 * P); \
            wR[P] = *(const v4u*)(Rr + ro_ + 32 * P); wV[P] = *(const v4u*)(Vr + ro_ + 32 * P); wVF[P] = (v4u){0u, 0u, 0u, 0u}; wLV[P] = (v4u){0u, 0u, 0u, 0u}; } \
        if (vres) { _Pragma("unroll") for (int P = 0; P < 2; ++P) { wVF[P] = *(const v4u*)(VFp + ro_ + 32 * P); wLV[P] = *(const v4u*)(L2 + lo_ + 3072 + 32 * P); } } } while (0)
#define W1_UNSWAP(QQ_, WW_) do { _Pragma("unroll") for (int P = 0; P < 2; ++P) { const v4u wv_ = WW_[P]; const auto s0_ = __builtin_amdgcn_permlane16_swap(wv_[0], wv_[2], false, false), s1_ = __builtin_amdgcn_permlane16_swap(wv_[1], wv_[3], false, false); \
        QQ_[2 * P] = (v2u){s0_[0], s1_[0]}; QQ_[2 * P + 1] = (v2u){s0_[1], s1_[1]}; } } while (0)
    if (gw < BATCH * WH * WC_NCH) { int l0 = lane_in; asm volatile("" : "+v"(l0)); W1_LOAD_RAW(gw, l0); }
    for (int job = gw; job < BATCH * WH * WC_NCH; job += NGW) {
        int ln = lane_in; asm volatile("" : "+v"(ln));
        const int lane = ln, fr = lane & 15, fq = lane >> 4;
        const int c = job % WC_NCH, sh = job / WC_NCH, h = sh & 15, seq = sh >> 4, r0 = seq * TP + WC_C * c, chb = h * WN + 4 * fq;
        LAS unsigned char* sc = lds + wave * 16384;
        unsigned char* rec = p.ws + WS_REC + (size_t)job * REC_BYTES;
        const size_t ro = (size_t)(r0 + fr) * D + chb, lo = (size_t)(r0 + fr) * NL2 + chb, po = (size_t)jl * D + chb;
        f32x4 cKK[4], cW0[4], cA0[4], cKA[4], cRK[4];
#pragma unroll
        for (int jt = 0; jt < 4; ++jt) { cKK[jt] = *(const f32x4*)(p.in[I_KK] + po + 16 * jt); cW0[jt] = *(const f32x4*)(p.in[I_W0] + po + 16 * jt); cA0[jt] = *(const f32x4*)(p.in[I_A0] + po + 16 * jt);
            cKA[jt] = *(const f32x4*)(p.in[I_KA] + po + 16 * jt); cRK[jt] = *(const f32x4*)(p.in[I_RK] + po + 16 * jt); }
#define W1_UP4(q) ((f32x4){bf_lo((q).x), bf_hi((q).x), bf_lo((q).y), bf_hi((q).y)})
        v2u qK[4], qLW[4], qLA[4], qR[4], qV[4], qVF[4], qLV[4];
        W1_UNSWAP(qK, wK); W1_UNSWAP(qLW, wLW); W1_UNSWAP(qLA, wLA); W1_UNSWAP(qR, wR); W1_UNSWAP(qV, wV); W1_UNSWAP(qVF, wVF); W1_UNSWAP(qLV, wLV);
        f32x4 kraw[4], kk[4];
        float ss = 0.f;
#pragma unroll
        for (int jt = 0; jt < 4; ++jt) { kraw[jt] = W1_UP4(qK[jt]); kk[jt] = kraw[jt] * cKK[jt];
            ss += (kk[jt].x * kk[jt].x + kk[jt].y * kk[jt].y) + (kk[jt].z * kk[jt].z + kk[jt].w * kk[jt].w); }
        ss += shfl_xor_l(ss, 16, lane); ss += shfl_xor_l(ss, 32, lane);
        const float inv = rsqrtf(fmaxf(ss, 1e-12f));
        v2u pa[4], pb[4], pk[4], pr[4], pvp[4]; f32x4 rt[4], ggv[4];
        float bonp = 0.f;
        LAS unsigned char* iw = sc + fr * 144 + 8 * fq;
#pragma unroll
        for (int jt = 0; jt < 4; ++jt) {
            const f32x4 lw2 = W1_UP4(qLW[jt]), la2 = W1_UP4(qLA[jt]), rr = W1_UP4(qR[jt]), vraw = W1_UP4(qV[jt]);
            const f32x4 pw0 = cW0[jt], pa0 = cA0[jt], pka = cKA[jt], prk = cRK[jt];
            f32x4 vp = vraw;
            if (vres) { const f32x4 vf = W1_UP4(qVF[jt]), lv2 = W1_UP4(qLV[jt]), pv0 = *(const f32x4*)(p.in[I_V0] + chb + 16 * jt);
#pragma unroll
                for (int e = 0; e < 4; ++e) vp[e] = vraw[e] + (vf[e] - vraw[e]) * sigmoidf_(pv0[e] + lv2[e]); }
            f32x4 at, bt, kt, kq, rq, gg;
#pragma unroll
            for (int e = 0; e < 4; ++e) {
                const float a = sigmoidf_(pa0[e] + la2[e]), d = CL2 * sigmoidf_(pw0[e] + lw2[e]), cum = psum16(d);
                const float g = __builtin_amdgcn_exp2f(-cum), ig = __builtin_amdgcn_exp2f(cum), gp = __builtin_amdgcn_exp2f(d - cum), nk = -kk[jt][e] * inv;
                kt[e] = kraw[jt][e] * (1.f + (a - 1.f) * pka[e]);
                bonp = fmaf(rr[e] * kt[e], prk[e], bonp);
                at[e] = nk * gp; bt[e] = -nk * a * ig; kq[e] = kt[e] * ig; rq[e] = rr[e] * g; gg[e] = g;
            }
            pa[jt] = pk4(at); pb[jt] = pk4(bt); pk[jt] = pk4(kq); pr[jt] = pk4(rq); rt[jt] = rq; pvp[jt] = pk4(vp); ggv[jt] = gg;
            *(LAS v2u*)(iw + 0 * IMG + 32 * jt) = pa[jt]; *(LAS v2u*)(iw + 1 * IMG + 32 * jt) = pb[jt]; *(LAS v2u*)(iw + 2 * IMG + 32 * jt) = pk[jt]; *(LAS v2u*)(iw + 3 * IMG + 32 * jt) = pvp[jt];
        }
#undef W1_UP4
        if (job + NGW < BATCH * WH * WC_NCH) W1_LOAD_RAW(job + NGW, lane);
        if (vres) {
#pragma unroll
            for (int P = 0; P < 2; ++P) { const auto t0 = __builtin_amdgcn_permlane16_swap(pvp[2 * P].x, pvp[2 * P + 1].x, false, false), t1 = __builtin_amdgcn_permlane16_swap(pvp[2 * P].y, pvp[2 * P + 1].y, false, false);
                *(v4u*)(VP + (size_t)(r0 + fr) * D + h * WN + (fq & 1) * 16 + (fq >> 1) * 8 + 32 * P) = (v4u){t0[0], t1[0], t0[1], t1[1]}; }
        }
#pragma unroll
        for (int jt = 0; jt < 4; ++jt) if (fr == 15) *(f32x4*)(rec + REC_GC + (16 * jt + 4 * fq) * 4) = ggv[jt];
        bonp += shfl_xor_l(bonp, 16, lane); bonp += shfl_xor_l(bonp, 32, lane);
        if (fq == 0) BON[(size_t)(r0 + fr) * WH + h] = bonp;
        const f32x4 z4 = (f32x4){0.f, 0.f, 0.f, 0.f};
        const int dd = fr - 4 * fq;
        f32x4 L = mm32(pa[2], pa[3], pb[2], pb[3], mm32(pa[0], pa[1], pb[0], pb[1], z4));
        f32x4 LT = mm32(pb[2], pb[3], pa[2], pa[3], mm32(pb[0], pb[1], pa[0], pa[1], z4));
        f32x4 Lak = mm32(pa[2], pa[3], pk[2], pk[3], mm32(pa[0], pa[1], pk[0], pk[1], z4));
        f32x4 MrbT = mm32(pb[2], pb[3], pr[2], pr[3], mm32(pb[0], pb[1], pr[0], pr[1], z4));
        f32x4 MrkT = mm32(pk[2], pk[3], pr[2], pr[3], mm32(pk[0], pk[1], pr[0], pr[1], z4));
        f32x4 TT;
#pragma unroll
        for (int r = 0; r < 4; ++r) {
            L[r] = dd < r ? L[r] : 0.f; Lak[r] = dd < r ? Lak[r] : 0.f;
            LT[r] = r < dd ? LT[r] : 0.f; MrbT[r] = r <= dd ? MrbT[r] : 0.f; MrkT[r] = r <= dd ? MrkT[r] : 0.f;
            TT[r] = LT[r] + (r == dd ? 1.f : 0.f);
        }
        const v2u bL = pk4(L), bLT = pk4(LT), bLak = pk4(Lak);
        const f32x4 L2m = mm16(bLT, bL, z4), L2T = mm16(bL, bLT, z4);
        const v2u bL2 = pk4(L2m), bL2T = pk4(L2T);
        const f32x4 L4m = mm16(bL2T, bL2, z4), L4T = mm16(bL2, bL2T, z4);
        const v2u bL4 = pk4(L4m), bL4T = pk4(L4T);
        const v2u bL8 = pk4(mm16(bL4T, bL4, z4));
        TT = mm16(bL2, pk4(TT), TT); TT = mm16(bL4, pk4(TT), TT); TT = mm16(bL8, pk4(TT), TT);
        f32x4 Zm = mm16(bL, pk4(MrbT), MrbT); Zm = mm16(bL2, pk4(Zm), Zm); Zm = mm16(bL4, pk4(Zm), Zm); Zm = mm16(bL8, pk4(Zm), Zm);
        const v2u bTT = pk4(TT), bMtT = pk4(Zm);
        *(v2u*)(rec + REC_TK + lane * 8) = pk4(mm16(bLak, bTT, z4)); *(v2u*)(rec + REC_MY + lane * 8) = pk4(mm16(bLak, bMtT, MrkT));
        LAS unsigned char* ir = sc + (4 * fq + ((lane & 15) >> 2)) * 144 + 8 * (lane & 3);
        v2u wat[4], rpt[4];
#pragma unroll
        for (int jt = 0; jt < 4; ++jt) {
            const v2u Qa = tr16(ir + 0 * IMG + 32 * jt), Qb = tr16(ir + 1 * IMG + 32 * jt), Qk = tr16(ir + 2 * IMG + 32 * jt);
            wat[jt] = pk4(mm16(Qa, bTT, z4)); rpt[jt] = pk4(mm16(Qa, bMtT, rt[jt]));
            *(v4u*)(rec + REC_BK + (jt * 64 + lane) * 16) = (v4u){Qb.x, Qb.y, Qk.x, Qk.y};
        }
#pragma unroll
        for (int s = 0; s < 2; ++s) {
            *(v4u*)(rec + REC_WA + (s * 64 + lane) * 16) = (v4u){wat[2 * s].x, wat[2 * s].y, wat[2 * s + 1].x, wat[2 * s + 1].y};
            *(v4u*)(rec + REC_RP + (s * 64 + lane) * 16) = (v4u){rpt[2 * s].x, rpt[2 * s].y, rpt[2 * s + 1].x, rpt[2 * s + 1].y};
        }
#pragma unroll
        for (int it = 0; it < 4; ++it) {
            const v2u Qv = tr16(ir + 3 * IMG + 32 * it);
            *(v2u*)(rec + REC_VV + (it * 64 + lane) * 8) = Qv;

        }
    }
}

#undef W1_LOAD_RAW
#undef W1_UNSWAP
__device__ __forceinline__ void ph_wkv2(const Params& p, int jl, int lane, int wave) {
    const bf16* Kr = (const bf16*)(p.ws + WS_K); const bf16* Vr = (const bf16*)(p.ws + (jl == 0 ? WS_VF : WS_VB)); const bf16* VFp = (const bf16*)(p.ws + WS_VF);
    const bf16* Rr = (const bf16*)(p.ws + WS_R); const bf16* L2 = (const bf16*)(p.ws + WS_L2);
    float* BON = (float*)(p.ws + WS_NKK); bf16* VP = (bf16*)(p.ws + WS_KKA);
    const bool vres = jl == 1; const int ri = lane >> 4, cg = lane & 15;
    bf16* YW = (bf16*)(p.ws + WS_YW);
    const int fr = lane & 15, fq = lane >> 4;
    const int gw = blockIdx.x * NWAVES + wave, NGW = gridDim.x * NWAVES;
    for (int job = wave < 2 ? blockIdx.x * 2 + wave : BATCH * WH * 4; job < BATCH * WH * 4; job += gridDim.x * 2) {
        const int it = job & 3, h = (job >> 2) & 15, seq = job >> 6, r0 = seq * TP;
        const unsigned char* rec = p.ws + WS_REC + (size_t)((seq * WH + h) * WC_NCH) * REC_BYTES;
        f32x4 Sacc[4];
#pragma unroll
        for (int jt = 0; jt < 4; ++jt) Sacc[jt] = (f32x4){0.f, 0.f, 0.f, 0.f};
        v4u wa[2], rp[2], bk[4]; v2u vvf, tk, my; f32x4 gc[4];
#define WC_LOAD(rc) do { const unsigned char* r_ = (rc); \
            wa[0] = *(const v4u*)(r_ + REC_WA + lane * 16); wa[1] = *(const v4u*)(r_ + REC_WA + 1024 + lane * 16); rp[0] = *(const v4u*)(r_ + REC_RP + lane * 16); rp[1] = *(const v4u*)(r_ + REC_RP + 1024 + lane * 16); \
            _Pragma("unroll") for (int jt_ = 0; jt_ < 4; ++jt_) { bk[jt_] = *(const v4u*)(r_ + REC_BK + (jt_ * 64 + lane) * 16); gc[jt_] = *(const f32x4*)(r_ + REC_GC + (16 * jt_ + 4 * fq) * 4); } \
            vvf = *(const v2u*)(r_ + REC_VV + (it * 64 + lane) * 8); tk = *(const v2u*)(r_ + REC_TK + lane * 8); my = *(const v2u*)(r_ + REC_MY + lane * 8); } while (0)
        WC_LOAD(rec);
        __builtin_amdgcn_s_setprio(2);
        v2u ypk = (v2u){0u, 0u};
        for (int c = 0; c < WC_NCH; ++c) {
            asm volatile("s_waitcnt vmcnt(0)" ::: "memory");
            const v4u cwa0 = wa[0], cwa1 = wa[1], crp0 = rp[0], crp1 = rp[1], cbk0 = bk[0], cbk1 = bk[1], cbk2 = bk[2], cbk3 = bk[3]; const v2u cvv = vvf; const f32x4 zz4 = (f32x4){0.f, 0.f, 0.f, 0.f}, cu0 = mm16(tk, vvf, zz4), cy0 = mm16(my, vvf, zz4), cg0 = gc[0], cg1 = gc[1], cg2 = gc[2], cg3 = gc[3];
            if (c > 0) *(v2u*)(YW + (size_t)(r0 + WC_C * (c - 1) + 4 * fq + (fr & 3)) * D + h * WN + 16 * it + (fr & 12)) = ypk;
            if (c + 1 < WC_NCH) WC_LOAD(rec + (size_t)(c + 1) * REC_BYTES);
            v4u sb0, sb1;
            { const v2u q0 = pk4(Sacc[0]), q1 = pk4(Sacc[1]), q2 = pk4(Sacc[2]), q3 = pk4(Sacc[3]); sb0 = (v4u){q0.x, q0.y, q1.x, q1.y}; sb1 = (v4u){q2.x, q2.y, q3.x, q3.y}; }
            const bf16x8 B0 = __builtin_bit_cast(bf16x8, sb0), B1 = __builtin_bit_cast(bf16x8, sb1);
            f32x4 U = __builtin_amdgcn_mfma_f32_16x16x32_bf16(__builtin_bit_cast(bf16x8, cwa0), B0, cu0, 0, 0, 0);
            U = __builtin_amdgcn_mfma_f32_16x16x32_bf16(__builtin_bit_cast(bf16x8, cwa1), B1, U, 0, 0, 0);
            f32x4 Y = __builtin_amdgcn_mfma_f32_16x16x32_bf16(__builtin_bit_cast(bf16x8, crp0), B0, cy0, 0, 0, 0);
            Y = __builtin_amdgcn_mfma_f32_16x16x32_bf16(__builtin_bit_cast(bf16x8, crp1), B1, Y, 0, 0, 0);
            v4u ub; { const v2u qu = pk4(U); ub.x = qu.x; ub.y = qu.y; } ub.z = cvv.x; ub.w = cvv.y;
            const bf16x8 UB = __builtin_bit_cast(bf16x8, ub);
            Sacc[0] = __builtin_amdgcn_mfma_f32_16x16x32_bf16(__builtin_bit_cast(bf16x8, cbk0), UB, Sacc[0], 0, 0, 0) * cg0;
            Sacc[1] = __builtin_amdgcn_mfma_f32_16x16x32_bf16(__builtin_bit_cast(bf16x8, cbk1), UB, Sacc[1], 0, 0, 0) * cg1;
            Sacc[2] = __builtin_amdgcn_mfma_f32_16x16x32_bf16(__builtin_bit_cast(bf16x8, cbk2), UB, Sacc[2], 0, 0, 0) * cg2;
            Sacc[3] = __builtin_amdgcn_mfma_f32_16x16x32_bf16(__builtin_bit_cast(bf16x8, cbk3), UB, Sacc[3], 0, 0, 0) * cg3;
            { float yq[4] = {Y[0], Y[1], Y[2], Y[3]}; quad_transpose4(yq, fr & 3); ypk = pk4((f32x4){yq[0], yq[1], yq[2], yq[3]}); }
        }
        *(v2u*)(YW + (size_t)(r0 + WC_C * (WC_NCH - 1) + 4 * fq + (fr & 3)) * D + h * WN + 16 * it + (fr & 12)) = ypk;
        __builtin_amdgcn_s_setprio(0);
#undef WC_LOAD
        float* so = p.out + O_WKVP + ((((size_t)jl * BATCH + seq) * WH + h) * WN + 16 * it + fr) * WN + 4 * fq;
#pragma unroll
        for (int jt = 0; jt < 4; ++jt) *(f32x4*)(so + 16 * jt) = Sacc[jt];
    }
    if (wave >= 2) {
        const int gws = blockIdx.x * (NWAVES - 2) + (wave - 2), NGWS = gridDim.x * (NWAVES - 2);
        constexpr int UB = 4;
        for (int it0 = gws; it0 < SB * WH * 16; it0 += NGWS * UB) {
            v2u qk[UB], qv[UB], qr[UB], qlw[UB], qla[UB], qvf[UB], qlv[UB]; f32x4 qS[UB];
#pragma unroll
            for (int q = 0; q < UB; ++q) { const int it_ = it0 + q * NGWS, itc = it_ < SB * WH * 16 ? it_ : it0;
                const int rg = itc & 15, h = (itc >> 4) & 15, s = itc >> 8, row = MP + s, i = 4 * rg + ri, ch = h * WN + 4 * cg;
                const size_t vo = (size_t)row * D + ch, lo = (size_t)row * NL2 + ch;
                qk[q] = *(const v2u*)(Kr + vo); qv[q] = *(const v2u*)(Vr + vo); qr[q] = *(const v2u*)(Rr + vo); qlw[q] = *(const v2u*)(L2 + lo); qla[q] = *(const v2u*)(L2 + lo + 1024);
                qvf[q] = (v2u){0u, 0u}; qlv[q] = (v2u){0u, 0u};
                if (vres) { qvf[q] = *(const v2u*)(VFp + vo); qlv[q] = *(const v2u*)(L2 + lo + 3072); }
                qS[q] = *(const f32x4*)(p.in[I_SWKV] + ((((size_t)jl * SB + s) * WH + h) * WN + i) * WN + 4 * cg); }
#pragma unroll
            for (int q = 0; q < UB; ++q) { const int it = it0 + q * NGWS; if (it < SB * WH * 16) {
                const int rg = it & 15, h = (it >> 4) & 15, s = it >> 8, row = MP + s, i = 4 * rg + ri;
                const int ch = h * WN + 4 * cg;
                WkPar P; P.w0 = *(const f32x4*)(p.in[I_W0] + (size_t)jl * D + ch); P.a0 = *(const f32x4*)(p.in[I_A0] + (size_t)jl * D + ch); P.kkp = *(const f32x4*)(p.in[I_KK] + (size_t)jl * D + ch);
                P.kap = *(const f32x4*)(p.in[I_KA] + (size_t)jl * D + ch); P.v0 = *(const f32x4*)(p.in[I_V0] + ch);
                const size_t vo = (size_t)row * D + ch;
#define W2_UP4(w) ((f32x4){bf_lo((w).x), bf_hi((w).x), bf_lo((w).y), bf_hi((w).y)})
                const f32x4 kraw = W2_UP4(qk[q]), vraw = W2_UP4(qv[q]), r4 = W2_UP4(qr[q]), lw2 = W2_UP4(qlw[q]), la2 = W2_UP4(qla[q]), vf = W2_UP4(qvf[q]), lv2 = W2_UP4(qlv[q]);
#undef W2_UP4
                f32x4 w4, ka, k4, vp, nk; wk_prep(P, kraw, vraw, lw2, la2, vf, lv2, vres, w4, ka, k4, vp, nk);
                const int srcl = (lane & 48) | rg;
                const float v0_ = shfl_l(vp.x, srcl), v1_ = shfl_l(vp.y, srcl), v2_ = shfl_l(vp.z, srcl), v3_ = shfl_l(vp.w, srcl);
                const float vi = ri == 0 ? v0_ : (ri == 1 ? v1_ : (ri == 2 ? v2_ : v3_));
                const size_t so = ((((size_t)jl * SB + s) * WH + h) * WN + i) * WN + 4 * cg;
                f32x4 S = qS[q];
                const float sa = row16_sum((S.x * nk.x + S.y * nk.y) + (S.z * nk.z + S.w * nk.w));
                S.x = fmaf(S.x, w4.x, fmaf(sa, ka.x, vi * k4.x)); S.y = fmaf(S.y, w4.y, fmaf(sa, ka.y, vi * k4.y));
                S.z = fmaf(S.z, w4.z, fmaf(sa, ka.z, vi * k4.z)); S.w = fmaf(S.w, w4.w, fmaf(sa, ka.w, vi * k4.w));
                const float y = row16_sum((S.x * r4.x + S.y * r4.y) + (S.z * r4.z + S.w * r4.w));
                *(f32x4*)(p.out + O_WKVS + so) = S;
                if (cg == 0) YW[(size_t)row * D + h * WN + i] = bf_cv(y);
                const f32x4 rk4 = *(const f32x4*)(p.in[I_RK] + (size_t)jl * D + ch);
                const float bon = row16_sum((r4.x * k4.x * rk4.x + r4.y * k4.y * rk4.y) + (r4.z * k4.z * rk4.z + r4.w * k4.w * rk4.w));
                if (rg == 0 && ri == 0) { if (vres) st_bf4(VP + vo, vp); if (cg == 0) BON[(size_t)row * WH + h] = bon; }
            } }
        }
    }
}

typedef __attribute__((address_space(1))) unsigned gu32;
#define XB_TMO      128
#define XB_XCNT(j)  (256  + 64 * (j))
#define XB_XSUB(j)  (1280 + 64 * (j))
#define XB_XGEN(j)  (2304 + 64 * (j))
#define XB_TOP      3328
#define XB_TOPGEN   3392
#define XCD_BAR_WORDS 3456
#define XB_SPIN_CAP (1u << 18)

__device__ __forceinline__ unsigned xb_ld(unsigned* p)              { return __hip_atomic_load(p, __ATOMIC_RELAXED, __HIP_MEMORY_SCOPE_AGENT); }
__device__ __forceinline__ unsigned xb_add(unsigned* p, unsigned v) { return __hip_atomic_fetch_add(p, v, __ATOMIC_RELAXED, __HIP_MEMORY_SCOPE_AGENT); }
__device__ __forceinline__ unsigned xb_xcc_id() { return (unsigned)__builtin_amdgcn_s_getreg((3 << 11) | 20) & 0xFu; }
#define XB_SPIN(cond, bar) do { unsigned _sp = 0; while (cond) { __builtin_amdgcn_s_sleep(1); \
    if ((++_sp & 255u) == 0u) { if (xb_ld(&(bar)[XB_TMO])) break; if (_sp > XB_SPIN_CAP) { atomicAdd(&(bar)[XB_TMO], 1u); break; } } } } while (0)

struct XcdBarrier {
    bool tid0; unsigned* bar; unsigned x;
    volatile LAS unsigned* st;
};

__device__ __forceinline__ XcdBarrier xcd_barrier_post(unsigned* bar, volatile LAS unsigned* st, bool tid0) {
    XcdBarrier b; b.tid0 = tid0; b.bar = bar; b.x = xb_xcc_id(); b.st = st;
    if (b.tid0) (void)xb_add(&bar[XB_XCNT(b.x)], 1u);
    return b;
}
__device__ __forceinline__ void xcd_barrier_complete(unsigned* bar, unsigned x, unsigned& nloc, unsigned& nx) {
    const unsigned G = gridDim.x * gridDim.y * gridDim.z;
    unsigned sum, cnt, mine, sp = 0u;
    for (;;) {
        sum = 0u; cnt = 0u; mine = 0u;
#pragma unroll
        for (unsigned j = 0; j < 16; ++j) { const unsigned c = xb_ld(&bar[XB_XCNT(j)]); sum += c; cnt += (c > 0u) ? 1u : 0u; mine = (j == x) ? c : mine; }
        if (sum == G) break;
        __builtin_amdgcn_s_sleep(1);
        if ((++sp & 255u) == 0u) { if (xb_ld(&bar[XB_TMO])) break; if (sp > XB_SPIN_CAP) { atomicAdd(&bar[XB_TMO], 1u); break; } }
    }
    nloc = mine > 0u ? mine : 1u; nx = cnt > 0u ? cnt : 1u;
}

__device__ __forceinline__ void xcd_barrier(const XcdBarrier& b) {
    asm volatile("s_waitcnt vmcnt(0)" ::: "memory");
    __syncthreads();
    if (b.tid0) {
        unsigned* bar = b.bar;
        __builtin_amdgcn_s_waitcnt(0);
        unsigned nloc = b.st[0], nx = b.st[1];
        if (nloc == 0u) { xcd_barrier_complete(bar, b.x, nloc, nx); b.st[0] = nloc; b.st[1] = nx; }
        const unsigned old = xb_add(&bar[XB_XSUB(b.x)], 1u);
        const unsigned gen = old / nloc;
        if (old + 1u == (gen + 1u) * nloc) {
            __builtin_amdgcn_fence(__ATOMIC_RELEASE, "agent");
            asm volatile("s_waitcnt vmcnt(0)" ::: "memory");
            const unsigned og = xb_add(&bar[XB_TOP], 1u);
            const unsigned tg = og / nx;
            if (og + 1u == (tg + 1u) * nx) xb_add(&bar[XB_TOPGEN], 1u);
            else XB_SPIN(xb_ld(&bar[XB_TOPGEN]) == tg, bar);
            __builtin_amdgcn_fence(__ATOMIC_ACQUIRE, "agent");
            xb_add(&bar[XB_XGEN(b.x)], 1u);
            asm volatile("s_waitcnt vmcnt(0)" ::: "memory");
        } else {
            XB_SPIN(xb_ld(&bar[XB_XGEN(b.x)]) == gen, bar);
            __builtin_amdgcn_fence(__ATOMIC_ACQUIRE, "agent");
            asm volatile("s_waitcnt vmcnt(0)" ::: "memory");
        }
    }
    __syncthreads();
}

enum { OP_P0 = 0, OP_NORM_RET, OP_G_RETIN, OP_RET, OP_RETNORM, OP_G_RETOUT, OP_NORM_RW, OP_G_RWPROJ, OP_G_LORA2, OP_PREP, OP_WKV, OP_WKV2, OP_POST, OP_G_WO,
       OP_NORM_FFN, OP_G_UG, OP_CONV, OP_G_WD, OP_FINAL };
struct Ph { unsigned char op, layer; };
constexpr int NPH = 1 + 2 * 6 + 2 * 9 + 1;
__device__ __host__ inline Ph phase_at(int i) {
    if (i == 0) return Ph{OP_P0, 0};
    i -= 1;
    int l;
    if (i < 6) l = 0; else if (i < 15) { l = 1; i -= 6; } else if (i < 21) { l = 2; i -= 15; } else if (i < 30) { l = 3; i -= 21; } else return Ph{OP_FINAL, 0};
    int op = OP_FINAL;
    if ((l & 1) == 0) {
        switch (i) { case 0: op = OP_G_RETIN; break; case 1: op = OP_RET; break; case 2: op = OP_RETNORM; break; case 3: op = OP_G_RETOUT; break;
                     case 4: op = OP_G_UG; break; default: op = OP_G_WD; break; }
    } else {
        switch (i) { case 0: op = OP_NORM_RW; break; case 1: op = OP_G_RWPROJ; break; case 2: op = OP_G_LORA2; break; case 3: op = OP_WKV; break; case 4: op = OP_WKV2; break; case 5: op = OP_POST; break; case 6: op = OP_G_WO; break;
                     case 7: op = OP_G_UG; break; default: op = OP_G_WD; break; }
    }
    return Ph{(unsigned char)op, (unsigned char)l};
}

__global__ void __launch_bounds__(NTHR, 2) mega(Params p, int lo, int hi) {
    extern __shared__ __attribute__((aligned(16))) unsigned char lds_raw[];
    LAS unsigned char* lds = (LAS unsigned char*)lds_raw;
    volatile LAS unsigned* bst = (volatile LAS unsigned*)(lds + LDS_BYTES - 16);
    const int wave0 = __builtin_amdgcn_readfirstlane((int)threadIdx.x >> 6);
    if (threadIdx.x < 4) bst[threadIdx.x] = 0u;
    __syncthreads();
    (void)xcd_barrier_post((unsigned*)(p.ws + WS_CTL), bst, threadIdx.x == 0);
    for (int ph = lo; ph < hi; ++ph) {
        int lid_; asm volatile("v_mbcnt_lo_u32_b32 %0, -1, 0\n\tv_mbcnt_hi_u32_b32 %0, -1, %0" : "=v"(lid_));
        int tid = wave0 * 64 + lid_; asm volatile("" : "+v"(tid));
        const int lane = tid & 63, wave = __builtin_amdgcn_readfirstlane(tid >> 6);
        unsigned char* ws = p.ws;
        const Ph P = phase_at(ph);
        const int li = P.layer, jl = li >> 1;
        const bf16* gA = nullptr; const bf16* gB = nullptr; int gN = 0, gK = 0; EpiAnyT<0> E{}; E.jl = jl; E.ws = ws; E.slot = -1; E.amul = 1.f; E.li = li; E.ldsb = lds; bool is_gemm = false;
        switch (P.op) {
        case OP_P0: ph_p0(p, lds, tid, lane, wave); break;
        case OP_NORM_RET: ph_norm(p, p.in[I_NMIX] + (size_t)li * D, 0, jl, lane, wave); break;
        case OP_NORM_FFN: ph_norm(p, p.in[I_NFFN] + (size_t)li * D, 0, jl, lane, wave); break;
        case OP_NORM_RW: ph_norm(p, p.in[I_NMIX] + (size_t)li * D, 1, jl, lane, wave); break;
        case OP_FINAL: ph_norm(p, p.in[I_NFIN], 2, 0, lane, wave); break;
        case OP_RETNORM: ph_ret_norm(p, jl, lane, wave); break;
        case OP_POST: ph_rwkv_post(p, jl, lane, wave); break;
        case OP_RET: ph_ret_fast(p, jl, lds, tid, lane, wave); break;
        case OP_WKV: ph_wkv1(p, jl, lds, lane, wave); break;
        case OP_WKV2: ph_wkv2(p, jl, lane, wave); break;
        case OP_G_RETIN: is_gemm = true; E.kind = EK_RETIN; E.perm = true; E.slot = 2 * li;
            gA = (const bf16*)(ws + WS_XB); gB = (const bf16*)(ws + WS_WIN + jl * SZ_WIN); gN = RWIN; gK = D; break;
        case OP_G_RETOUT: is_gemm = true; E.kind = EK_RESID; E.perm = false; E.slot = 2 * li + 1;
            gA = (const bf16*)(ws + WS_Y); gB = (const bf16*)(ws + WS_WOUT + jl * SZ_WOUT); gN = D; gK = RV; break;
        case OP_G_RWPROJ: is_gemm = true; E.kind = EK_RWPROJ; E.perm = true;
            gA = (const bf16*)(ws + WS_H) + D; gB = (const bf16*)(ws + WS_WRW + jl * SZ_WRW); gN = NRW; gK = KRW; break;
        case OP_G_LORA2: is_gemm = true; E.kind = EK_F32; E.perm = true;
            gA = (const bf16*)(ws + WS_A2); gB = (const bf16*)(ws + WS_WL2 + jl * SZ_WL2); gN = (jl == 0 ? 3072 : 4096); gK = KL2; break;
        case OP_G_WO: is_gemm = true; E.kind = EK_RESID; E.perm = false; E.slot = 2 * li + 1;
            gA = (const bf16*)(ws + WS_Z); gB = (const bf16*)(ws + WS_WO + jl * SZ_WO); gN = D; gK = D; break;
        case OP_G_UG: is_gemm = true; E.kind = EK_UG; E.perm = true; E.slot = 2 * li + 1;
            gA = (const bf16*)(ws + WS_XB); gB = (const bf16*)(ws + WS_WUG + li * SZ_WUG); gN = 2 * DFF; gK = D; break;
        case OP_G_WD: is_gemm = true; E.kind = EK_RESID; E.perm = false; E.slot = (li == 1) ? 2 * (li + 1) : -1;
            gA = (const bf16*)(ws + WS_ACT); gB = (const bf16*)(ws + WS_WD + li * SZ_WD); gN = D; gK = DFF; break;
        default: break;
        }
        if (is_gemm) {
            const bool ug = E.kind == EK_UG;
            const bool rwp = E.kind == EK_RWPROJ;
            const int gM = (E.kind == EK_RESID) ? MT0 : (ug ? 66 * 256 : (rwp ? HP_M : M));
            pg8::Gemm g{ug ? gA - 2 * D : gA, gB, gM, gN, gK, ug ? 254 : 256};
            if (E.kind == EK_F32) { g.kshift = 2; g.ktab = (0u | 2u << 4) | (0u | 2u << 4) << 8 | (2u | 4u << 4) << 16 | (4u | 2u << 4) << 24; }
            if (rwp) { g.lda = D; g.ksplit = D / pg8::BK; g.kdelta = -(long)(D * 2) - (long)(D * 2); }
            pg8::StaticOrder S; S.init(gM, gN, (int)gridDim.x, (int)blockIdx.x);
            if (E.kind == EK_RETIN || E.kind == EK_UG) {
                LAS float* rt = (LAS float*)(lds + 131072);
                Unit uu;
                for (int ui = 0; ui < 8 && S.next(ui, uu); ++ui) if (tid < 256) { int rr = ug ? 254 * uu.pm - 2 + tid : uu.pm * 256 + tid; rr = rr < 0 ? 0 : (rr > M - 1 ? M - 1 : rr); rt[ui * 256 + tid] = row_rstd(ws, E.slot, rr); }
                E.rtab = rt; E.ldsb = lds;
                __syncthreads();
            }
            if (ug) { EpiAnyT<1> E1{}; E1.kind = E.kind; E1.perm = E.perm; E1.jl = E.jl; E1.ws = E.ws; E1.slot = E.slot; E1.rtab = E.rtab; E1.amul = E.amul; E1.li = E.li; E1.ldsb = E.ldsb; E1.pcw = p.in[I_CW]; E1.pcb = p.in[I_CB]; E1.pcst = p.in[I_SCONV]; E1.pout = p.out;
                pg8::gemm_phase<EpiAnyT<1>, pg8::StaticOrder, true, true>(lds, g, S, E1, tid); }
            else pg8::gemm_phase<EpiAnyT<0>, pg8::StaticOrder, true, true>(lds, g, S, E, tid);
            if (E.kind == EK_RESID) tail_resid(gA, gB, gK, ws, E.slot, E.amul, lds, lane, wave);
        }
        if (ph + 1 < hi) { XcdBarrier bar; bar.tid0 = tid == 0; bar.bar = (unsigned*)(p.ws + WS_CTL); bar.x = xb_xcc_id(); bar.st = (volatile LAS unsigned*)(lds + LDS_BYTES - 16); xcd_barrier(bar); }
    }
}

}

extern "C" void kernel_launch(void* const* d_in, const int* in_sizes, int n_in, void* d_out, int out_size, void* d_ws, size_t ws_size, hipStream_t stream) {
    static int grid = 0;
    if (grid == 0) {
        int dev = 0, cus = 0;
        if (n_in != N_IN || ws_size < WS_END2) { fprintf(stderr, "kernel_launch: unexpected n_in %d / ws_size %zu (need %zu)\n", n_in, ws_size, (size_t)WS_END2); grid = -1; return; }
        if (hipGetDevice(&dev) != hipSuccess || hipDeviceGetAttribute(&cus, hipDeviceAttributeMultiprocessorCount, dev) != hipSuccess) { grid = -1; return; }
        if (hipFuncSetAttribute((const void*)mega, hipFuncAttributeMaxDynamicSharedMemorySize, LDS_BYTES) != hipSuccess) { fprintf(stderr, "kernel_launch: hipFuncSetAttribute failed\n"); grid = -1; return; }
        int per_cu = 0;
        if (hipOccupancyMaxActiveBlocksPerMultiprocessor(&per_cu, (const void*)mega, NTHR, LDS_BYTES) != hipSuccess || per_cu < 1) { fprintf(stderr, "kernel_launch: occupancy query says %d\n", per_cu); (void)hipGetLastError(); }
        grid = cus * (per_cu >= 1 ? 1 : 1);
    }
    if (grid < 0) return;
    Params p{};
    for (int i = 0; i < N_IN; ++i) p.in[i] = (const float*)d_in[i];
    p.out = (float*)d_out; p.ws = (unsigned char*)d_ws;
    if (hipMemsetAsync(d_ws, 0, 65536, stream) != hipSuccess) { fprintf(stderr, "kernel_launch: memset failed\n"); return; }
    int lo = 0, hi = NPH;
    void* args[] = {(void*)&p, (void*)&lo, (void*)&hi};
    const hipError_t e = hipLaunchCooperativeKernel((const void*)mega, dim3(grid), dim3(NTHR), args, LDS_BYTES, stream);
    if (e != hipSuccess) fprintf(stderr, "kernel_launch: cooperative launch failed: %s (grid %d)\n", hipGetErrorString(e), grid);
    (void)in_sizes; (void)out_size;
}
```

```cpp
#include <hip/hip_runtime.h>
#include <hip/hip_cooperative_groups.h>
#include <cstdio>
#include <stdint.h>
namespace cg = cooperative_groups;
namespace pg8 {
#define PG8_LAS __attribute__((address_space(3)))
typedef unsigned short bf16_t;
typedef short bf16x8 __attribute__((ext_vector_type(8)));
typedef float f32x4 __attribute__((ext_vector_type(4)));
typedef unsigned u32x4 __attribute__((ext_vector_type(4)));
constexpr int BM = 256, BK = 64, HALF = 128, HTB = HALF * BK * 2  , STAGE_BYTES = 8 * HTB, NXCD = 8, WGM = 4;

__host__ __device__ __forceinline__ int lds_byte(int r, int c) { const int st = (r >> 4) * 2 + (c >> 5), rr = r & 15, cc = c & 31, ob = rr * 64 + cc * 2; return st * 1024 + (ob ^ (((ob >> 9) & 1) << 5)); }
__host__ __device__ __forceinline__ void stage_rc(int b, int& R, int& C) { const int st = b / 1024, sb = b % 1024, swz = sb ^ (((sb >> 9) & 1) << 5); R = (st >> 1) * 16 + swz / 64; C = (st & 1) * 32 + (swz % 64) / 2; }
__host__ __device__ __forceinline__ int perm32(int rho) { const int n = rho >> 4, i = rho & 15; return 8 * (i >> 2) + 4 * n + (i & 3); }

struct Unit { int pm, pn, ord; };
struct Gemm { const bf16_t* A; const bf16_t* Bt; int M, N, K, trows; int lda = 0, ksplit = 1 << 30; long kdelta = 0; unsigned ktab = 0; int kshift = 0; };

struct StaticOrder {
    int nM, nN, nwg, G, c;
    __host__ __device__ void init(int M, int N, int G_, int c_) { nM = M / BM; nN = N / BM; nwg = nM * nN; G = G_; c = c_; }
    __host__ __device__ __forceinline__ bool next(int i, Unit& u) const {
        const long L = (long)i * G + c; if (L >= nwg) return false;
        int wgid = (int)L; { const int q = nwg / NXCD, r = nwg % NXCD, xcd = wgid % NXCD, off = wgid / NXCD; wgid = (xcd < r ? xcd * (q + 1) : r * (q + 1) + (xcd - r) * q) + off; }
        const int nig = WGM * nN, gid = wgid / nig, fm = gid * WGM, gsz = (nM - fm) < WGM ? (nM - fm) : WGM;
        u.pm = fm + ((wgid % nig) % gsz); u.pn = (wgid % nig) / gsz; u.ord = i; return true;
    }
    __device__ __forceinline__ void a_ready(const Unit&) const {}
    __device__ __forceinline__ void done(const Unit&) const {}
};
template <class Epi, class Sched, bool ALIGN_EPI = false, bool SP2 = false>
__device__ __forceinline__ void gemm_phase(PG8_LAS unsigned char* lds, const Gemm g, const Sched& S, const Epi& E, int tid_in) {
    int tid = tid_in; asm volatile("" : "+v"(tid));
    const int wid = __builtin_amdgcn_readfirstlane(tid >> 6), lane = tid & 63, wr = wid >> 2, wc = wid & 3, fr = lane & 15, fq = lane >> 4;
    const int K = g.K, nt = K / BK, lda = g.lda ? g.lda : K;
    unsigned voffA[2], voffB[2];
#pragma unroll
    for (int i = 0; i < 2; ++i) { int R, C; stage_rc(tid * 16 + i * 8192, R, C); const int Rb = E.perm ? ((R & ~31) + perm32(R & 31)) : R;
        voffA[i] = (unsigned)(R * lda + C) * 2u; voffB[i] = (unsigned)(Rb * K + C) * 2u; }
    const size_t kstep = (size_t)(BK * 2);
    const size_t hstep = (size_t)HALF * K * 2, hstepA = (size_t)HALF * lda * 2;
    const int ksplit = g.ksplit; const long kdelta = g.kdelta;
#define PG8_KA(base, kt) ((base) + (size_t)(kt) * kstep + ((kt) >= ksplit ? kdelta : 0l))
    const size_t tstep = 2 * hstep; const size_t tstepA = (size_t)g.trows * lda * 2;
    const unsigned ldsw = (unsigned)wid * 1024u;
    const int aoff = lds_byte(wr * 64 + fr, fq * 8), boff = lds_byte(wc * 32 + fr, fq * 8);
#define PG8_SA(b, h) (((b) * 2 + (h)) * HTB)
#define PG8_SB(b, h) ((4 + (b) * 2 + (h)) * HTB)
#define PG8_STAGE(bufoff, gbase, voff) do { _Pragma("unroll") for (int _i = 0; _i < 2; ++_i) \
        __builtin_amdgcn_global_load_lds((const unsigned*)((const char*)(gbase) + (voff)[_i]), (PG8_LAS unsigned*)(lds + (bufoff) + ldsw + _i * 8192), 16, 0, 0); } while (0)
#define PG8_LDA(dst, b, h) do { _Pragma("unroll") for (int m = 0; m < 4; ++m) _Pragma("unroll") for (int k = 0; k < 2; ++k) dst[m][k] = *(const PG8_LAS bf16x8*)(lds + PG8_SA(b, h) + aoff + m * 2048 + k * 1024); } while (0)
#define PG8_LDB(dst, b, h) do { _Pragma("unroll") for (int n = 0; n < 2; ++n) _Pragma("unroll") for (int k = 0; k < 2; ++k) dst[n][k] = *(const PG8_LAS bf16x8*)(lds + PG8_SB(b, h) + boff + n * 2048 + k * 1024); } while (0)
#define PG8_MMA(ai, bj, At, Bt) do { __builtin_amdgcn_s_setprio(1); _Pragma("unroll") for (int m = 0; m < 4; ++m) _Pragma("unroll") for (int n = 0; n < 2; ++n) _Pragma("unroll") for (int k = 0; k < 2; ++k) \
        acc[ai][bj][m][n] = __builtin_amdgcn_mfma_f32_16x16x32_bf16(Bt[n][k], At[m][k], acc[ai][bj][m][n], 0, 0, 0); __builtin_amdgcn_s_setprio(0); } while (0)
#define PG8_WAIT_V(n) asm volatile("s_waitcnt vmcnt(" #n ")" ::: "memory")
#define PG8_WAIT_L(n) asm volatile("s_waitcnt lgkmcnt(" #n ")" ::: "memory")
#define PG8_BAR __builtin_amdgcn_s_barrier()
#define PG8_SCHED __builtin_amdgcn_sched_barrier(0)
    Unit cur, nxt; int ui = 0;
    if (!S.next(0, cur)) return;
    f32x4 acc[2][2][4][2];
#pragma unroll
    for (int a = 0; a < 2; ++a)
#pragma unroll
        for (int b = 0; b < 2; ++b)
#pragma unroll
            for (int m = 0; m < 4; ++m)
#pragma unroll
                for (int n = 0; n < 2; ++n) acc[a][b][m][n] = (f32x4){0.f, 0.f, 0.f, 0.f};
    bf16x8 At[4][2], B0[2][2], B1[2][2];
    const unsigned ktab = g.ktab; const int kshift = g.kshift;
#define PG8_KOFF(pn) (ktab ? (int)((ktab >> (8 * ((pn) >> kshift))) & 15u) : 0)
#define PG8_KNT(pn) (ktab ? (int)((ktab >> (8 * ((pn) >> kshift) + 4)) & 15u) : nt)
    int ntc = PG8_KNT(cur.pn);
    const char* cA = (const char*)g.A + (size_t)cur.pm * tstepA + (size_t)PG8_KOFF(cur.pn) * kstep; const char* cB = (const char*)g.Bt + (size_t)cur.pn * tstep + (size_t)PG8_KOFF(cur.pn) * kstep;
    S.a_ready(cur);
    if constexpr (SP2) {
        PG8_STAGE(PG8_SB(0, 0), cB, voffB); PG8_STAGE(PG8_SB(0, 1), cB + hstep, voffB); PG8_STAGE(PG8_SA(0, 0), cA, voffA); PG8_STAGE(PG8_SA(0, 1), cA + hstepA, voffA);
        if (wr == 1) PG8_BAR;
        PG8_WAIT_V(2); PG8_BAR;
        PG8_STAGE(PG8_SB(1, 0), cB + kstep, voffB); PG8_STAGE(PG8_SA(1, 0), PG8_KA(cA, 1), voffA); PG8_STAGE(PG8_SB(1, 1), cB + hstep + kstep, voffB);
        PG8_WAIT_V(6); PG8_BAR;
    } else {
        PG8_STAGE(PG8_SB(0, 0), cB, voffB); PG8_STAGE(PG8_SA(0, 0), cA, voffA); PG8_STAGE(PG8_SB(0, 1), cB + hstep, voffB); PG8_STAGE(PG8_SA(0, 1), cA + hstepA, voffA);
        if (wr == 1) PG8_BAR;
        PG8_WAIT_V(4); PG8_BAR;
        PG8_STAGE(PG8_SB(1, 0), cB + kstep, voffB); PG8_STAGE(PG8_SA(1, 0), PG8_KA(cA, 1), voffA); PG8_STAGE(PG8_SB(1, 1), cB + hstep + kstep, voffB);
        PG8_WAIT_V(6); PG8_BAR;
    }
    for (;;) {
        const bool has_next = S.next(ui + 1, nxt);
        const char* nA = has_next ? (const char*)g.A + (size_t)nxt.pm * tstepA + (size_t)PG8_KOFF(nxt.pn) * kstep : cA; const char* nB = has_next ? (const char*)g.Bt + (size_t)nxt.pn * tstep + (size_t)PG8_KOFF(nxt.pn) * kstep : cB;
        for (int t = 0; t < ntc; t += 2) {
            const bool last = (t == ntc - 2);
            const char* a1 = PG8_KA(cA, t + 1);
            const char* a2 = last ? nA : PG8_KA(cA, t + 2); const char* b2 = last ? nB : cB + (size_t)(t + 2) * kstep;
            const char* a3 = last ? PG8_KA(nA, 1) : PG8_KA(cA, t + 3); const char* b3 = b2 + kstep;
            if (last && has_next) S.a_ready(nxt);
            if constexpr (SP2) {
            PG8_LDB(B0, 0, 0); PG8_LDB(B1, 0, 1); PG8_SCHED; PG8_LDA(At, 0, 0); PG8_STAGE(PG8_SA(1, 1), a1 + hstepA, voffA);
            PG8_WAIT_V(8); PG8_WAIT_L(0); PG8_BAR; PG8_MMA(0, 0, At, B0); PG8_MMA(0, 1, At, B1); PG8_BAR; PG8_SCHED;
            PG8_LDA(At, 0, 1); PG8_STAGE(PG8_SB(0, 0), b2, voffB); PG8_STAGE(PG8_SB(0, 1), b2 + hstep, voffB); PG8_STAGE(PG8_SA(0, 0), a2, voffA);
            PG8_WAIT_V(8); PG8_WAIT_L(0); PG8_BAR; PG8_MMA(1, 0, At, B0); PG8_MMA(1, 1, At, B1); PG8_BAR; PG8_SCHED;
            PG8_LDB(B0, 1, 0); PG8_LDB(B1, 1, 1); PG8_SCHED; PG8_LDA(At, 1, 0); PG8_STAGE(PG8_SA(0, 1), a2 + hstepA, voffA);
            PG8_WAIT_V(8); PG8_WAIT_L(0); PG8_BAR; PG8_MMA(0, 0, At, B0); PG8_MMA(0, 1, At, B1); PG8_BAR; PG8_SCHED;
            PG8_LDA(At, 1, 1); PG8_STAGE(PG8_SB(1, 0), b3, voffB); PG8_STAGE(PG8_SB(1, 1), b3 + hstep, voffB); PG8_STAGE(PG8_SA(1, 0), a3, voffA);
            PG8_WAIT_V(8); PG8_WAIT_L(0); PG8_BAR; PG8_MMA(1, 0, At, B0); PG8_MMA(1, 1, At, B1); PG8_BAR; PG8_SCHED;
            } else {
            PG8_LDB(B0, 0, 0); PG8_SCHED; PG8_LDA(At, 0, 0); PG8_STAGE(PG8_SA(1, 1), a1 + hstepA, voffA);
            PG8_WAIT_L(8); PG8_BAR; PG8_WAIT_L(0); PG8_MMA(0, 0, At, B0); PG8_BAR; PG8_SCHED;
            PG8_LDB(B1, 0, 1); PG8_STAGE(PG8_SB(0, 0), b2, voffB);
            PG8_BAR; PG8_WAIT_L(0); PG8_MMA(0, 1, At, B1); PG8_BAR;
            PG8_LDA(At, 0, 1); PG8_STAGE(PG8_SA(0, 0), a2, voffA);
            PG8_BAR; PG8_WAIT_L(0); PG8_MMA(1, 0, At, B0); PG8_BAR; PG8_SCHED;
            PG8_STAGE(PG8_SB(0, 1), b2 + hstep, voffB);
            PG8_WAIT_V(6); PG8_BAR; PG8_MMA(1, 1, At, B1); PG8_BAR;
            PG8_LDB(B0, 1, 0); PG8_SCHED; PG8_LDA(At, 1, 0); PG8_STAGE(PG8_SA(0, 1), a2 + hstepA, voffA);
            PG8_WAIT_L(8); PG8_BAR; PG8_WAIT_L(0); PG8_MMA(0, 0, At, B0); PG8_BAR; PG8_SCHED;
            PG8_LDB(B1, 1, 1); PG8_STAGE(PG8_SB(1, 0), b3, voffB);
            PG8_BAR; PG8_WAIT_L(0); PG8_MMA(0, 1, At, B1); PG8_BAR;
            PG8_LDA(At, 1, 1); PG8_STAGE(PG8_SA(1, 0), a3, voffA);
            PG8_BAR; PG8_WAIT_L(0); PG8_MMA(1, 0, At, B0); PG8_BAR; PG8_SCHED;
            PG8_STAGE(PG8_SB(1, 1), b3 + hstep, voffB);
            PG8_WAIT_V(6); PG8_BAR; PG8_MMA(1, 1, At, B1); PG8_BAR;
            }
        }
        if constexpr (ALIGN_EPI) { if (wr == 0) PG8_BAR; }
        if constexpr (!Epi::AFTER_DRAIN) { E(acc, cur, wr, wc, fr, fq); S.done(cur); }
        if (!has_next) break;
#pragma unroll
        for (int a = 0; a < 2; ++a)
#pragma unroll
            for (int b = 0; b < 2; ++b)
#pragma unroll
                for (int m = 0; m < 4; ++m)
#pragma unroll
                    for (int n = 0; n < 2; ++n) acc[a][b][m][n] = (f32x4){0.f, 0.f, 0.f, 0.f};
        cur = nxt; cA = nA; cB = nB; ++ui; ntc = PG8_KNT(cur.pn);
        if constexpr (ALIGN_EPI) { if (wr == 1) PG8_BAR; }
    }
    PG8_WAIT_V(0);
    if constexpr (!ALIGN_EPI) { if (wr == 0) PG8_BAR; }
    PG8_BAR;
    if constexpr (Epi::AFTER_DRAIN) { E.fused(acc, cur, wr, wc, fr, fq, lds, wid, lane); S.done(cur); }
#undef PG8_KA
#undef PG8_KOFF
#undef PG8_KNT
#undef PG8_SA
#undef PG8_SB
#undef PG8_STAGE
#undef PG8_LDA
#undef PG8_LDB
#undef PG8_MMA
#undef PG8_WAIT_V
#undef PG8_WAIT_L
#undef PG8_BAR
#undef PG8_SCHED
}
}

namespace {
constexpr int D = 1024, BATCH = 8, SEQ = 2048, NMETA = 16, TP = SEQ + NMETA, MP = BATCH * TP, SB = 128, M = MP + SB;
constexpr int DEPTH = 4, RH = 4, RDK = 256, RDV = 512, RV = 2048, RWIN = 6144;
constexpr int WH = 16, WN = 64, LW = 64, LA = 64, LV = 32, LG = 160, DFF = 2816;
constexpr int NRW = 3584, KRW = 2048, KL2 = 384, NL2 = 4096;
constexpr float PAST_POS = 16384.f;
constexpr int NWAVES = 8, NTHR = 512;
constexpr int LDS_BYTES = 147456;

constexpr size_t O_YP = 0;
constexpr size_t O_YS = O_YP + (size_t)BATCH * SEQ * D;
constexpr size_t O_RETP = O_YS + (size_t)SB * D;
constexpr size_t O_WKVP = O_RETP + (size_t)2 * BATCH * RH * RDK * RDV;
constexpr size_t O_SHP = O_WKVP + (size_t)2 * BATCH * WH * WN * WN;
constexpr size_t O_CVP = O_SHP + (size_t)2 * BATCH * D;
constexpr size_t O_RETS = O_CVP + (size_t)DEPTH * BATCH * 2 * DFF;
constexpr size_t O_WKVS = O_RETS + (size_t)2 * SB * RH * RDK * RDV;
constexpr size_t O_SHS = O_WKVS + (size_t)2 * SB * WH * WN * WN;
constexpr size_t O_CVS = O_SHS + (size_t)2 * SB * D;

enum { I_XP = 0, I_XS, I_SRET, I_SWKV, I_SSHIFT, I_SCONV, I_META, I_NMIX, I_NFFN, I_NFIN, I_RWIN, I_RGN, I_RWOUT, I_MU, I_WRKV, I_W0, I_W1, I_W2,
       I_A0, I_A1, I_A2, I_V0, I_V1, I_V2, I_G1, I_G2, I_KK, I_KA, I_RK, I_LNW, I_LNB, I_WO, I_WUG, I_CW, I_CB, I_WD, N_IN };

constexpr size_t al256(size_t x) { return (x + 255) & ~(size_t)255; }
constexpr size_t WS_CTL = 0;
constexpr size_t WS_CS = 1u << 20;
constexpr size_t WS_WIN = 4u << 20;
constexpr size_t SZ_WIN = (size_t)RWIN * D * 2;
constexpr size_t WS_WOUT = WS_WIN + 2 * SZ_WIN;
constexpr size_t SZ_WOUT = (size_t)D * RV * 2;
constexpr size_t WS_WRW = WS_WOUT + 2 * SZ_WOUT;
constexpr size_t SZ_WRW = (size_t)NRW * KRW * 2;
constexpr size_t WS_WL2 = WS_WRW + 2 * SZ_WRW;
constexpr size_t SZ_WL2 = (size_t)NL2 * KL2 * 2;
constexpr size_t WS_WO = WS_WL2 + 2 * SZ_WL2;
constexpr size_t SZ_WO = (size_t)D * D * 2;
constexpr size_t WS_WUG = WS_WO + 2 * SZ_WO;
constexpr size_t SZ_WUG = (size_t)2 * DFF * D * 2;
constexpr size_t WS_WD = WS_WUG + 4 * SZ_WUG;
constexpr size_t SZ_WD = (size_t)D * DFF * 2;
constexpr size_t WS_X = al256(WS_WD + 4 * SZ_WD);
constexpr size_t SZ_MD4 = (size_t)M * D * 4;
constexpr size_t WS_H = WS_X + SZ_MD4;
constexpr size_t WS_VF = WS_H + SZ_MD4;
constexpr size_t WS_REG = WS_VF + SZ_MD4;
constexpr size_t WS_QK = WS_REG;
constexpr size_t WS_V = WS_QK + SZ_MD4;
constexpr size_t WS_SG = WS_V + SZ_MD4;
constexpr size_t WS_O = WS_SG + SZ_MD4;
constexpr size_t WS_Y = WS_O + 2 * SZ_MD4;
constexpr size_t WS_R = WS_REG;
constexpr size_t WS_K = WS_R + SZ_MD4;
constexpr size_t WS_VB = WS_K + SZ_MD4;
constexpr size_t WS_WDEC = WS_VB + SZ_MD4;
constexpr size_t WS_NKK = WS_WDEC + SZ_MD4;
constexpr size_t WS_KKA = WS_NKK + SZ_MD4;
constexpr size_t WS_YW = WS_KKA + SZ_MD4;
constexpr size_t WS_L2 = WS_YW + SZ_MD4;
constexpr size_t WS_A2 = WS_L2 + 4 * SZ_MD4;
constexpr size_t WS_Z = al256(WS_A2 + (size_t)M * KL2 * 2);
constexpr size_t WS_RW_END = WS_Z + (size_t)M * D * 2;
constexpr size_t SZ_FF2 = (size_t)M * DFF * 2;
constexpr size_t WS_U = WS_REG;
constexpr size_t WS_G = al256(WS_U + SZ_FF2);
constexpr size_t WS_ACT = al256(WS_G + SZ_FF2);
constexpr size_t WS_XB = al256(WS_RW_END) + 2 * (size_t)D * 2;
constexpr size_t WS_SS = al256(WS_XB + (size_t)(M + 126) * D * 2);
constexpr size_t WS_PTRS = al256(WS_SS + (size_t)8 * M * 16 * 4);
constexpr size_t WS_END = WS_PTRS + 256;

#define LAS __attribute__((address_space(3)))
typedef unsigned short bf16;
typedef unsigned v4u __attribute__((ext_vector_type(4)));
typedef unsigned v2u __attribute__((ext_vector_type(2)));
using pg8::f32x4;
using pg8::Unit;
using pg8::bf16x8;

struct Params { const float* in[N_IN]; float* out; unsigned char* ws; };

__device__ __forceinline__ unsigned cvt_pk_bf16(float lo, float hi) { unsigned r; asm("v_cvt_pk_bf16_f32 %0, %1, %2" : "=v"(r) : "v"(lo), "v"(hi)); return r; }
typedef __bf16 bf4v __attribute__((ext_vector_type(4)));
__device__ __forceinline__ v2u pk4(const f32x4 v) { return __builtin_bit_cast(v2u, __builtin_convertvector(v, bf4v)); }
__device__ __forceinline__ bf16 bf_cv(float x) { return __builtin_bit_cast(unsigned short, (__bf16)x); }
__device__ __forceinline__ float bf_lo(unsigned w) { return __uint_as_float(w << 16); }
__device__ __forceinline__ float bf_hi(unsigned w) { return __uint_as_float(w & 0xffff0000u); }
__device__ __forceinline__ void unpack8(const v4u w, float (&f)[8]) { f[0] = bf_lo(w.x); f[1] = bf_hi(w.x); f[2] = bf_lo(w.y); f[3] = bf_hi(w.y); f[4] = bf_lo(w.z); f[5] = bf_hi(w.z); f[6] = bf_lo(w.w); f[7] = bf_hi(w.w); }
__device__ __forceinline__ v4u pack8(const float (&f)[8]) { v4u w; w.x = cvt_pk_bf16(f[0], f[1]); w.y = cvt_pk_bf16(f[2], f[3]); w.z = cvt_pk_bf16(f[4], f[5]); w.w = cvt_pk_bf16(f[6], f[7]); return w; }
__device__ __forceinline__ f32x4 ld_bf4(const bf16* q) { const v2u w = *(const v2u*)q; return (f32x4){bf_lo(w.x), bf_hi(w.x), bf_lo(w.y), bf_hi(w.y)}; }
__device__ __forceinline__ void st_bf4(bf16* q, const f32x4 v) { v2u w; w.x = cvt_pk_bf16(v.x, v.y); w.y = cvt_pk_bf16(v.z, v.w); *(v2u*)q = w; }
__device__ __forceinline__ float shfl_xor_l(float v, int m, int lane) { return __int_as_float(__builtin_amdgcn_ds_bpermute((lane ^ m) << 2, __float_as_int(v))); }
__device__ __forceinline__ float shfl_l(float v, int src) { return __int_as_float(__builtin_amdgcn_ds_bpermute(src << 2, __float_as_int(v))); }
__device__ __forceinline__ float wave_sum(float v, int) {
    v += __builtin_bit_cast(float, __builtin_amdgcn_update_dpp(0, __float_as_int(v), 0x128, 0xf, 0xf, false));
    v += __builtin_bit_cast(float, __builtin_amdgcn_update_dpp(0, __float_as_int(v), 0x124, 0xf, 0xf, false));
    v += __builtin_bit_cast(float, __builtin_amdgcn_update_dpp(0, __float_as_int(v), 0x122, 0xf, 0xf, false));
    v += __builtin_bit_cast(float, __builtin_amdgcn_update_dpp(0, __float_as_int(v), 0x121, 0xf, 0xf, false));
    const int vi = __float_as_int(v);
    return (__int_as_float(__builtin_amdgcn_readlane(vi, 0)) + __int_as_float(__builtin_amdgcn_readlane(vi, 16))) + (__int_as_float(__builtin_amdgcn_readlane(vi, 32)) + __int_as_float(__builtin_amdgcn_readlane(vi, 48)));
}
__device__ __forceinline__ float rcpf_(float x) { return __builtin_amdgcn_rcpf(x); }
__device__ __forceinline__ float sigmoidf_(float x) { return rcpf_(1.f + __expf(-x)); }
__device__ __forceinline__ float siluf_(float x) { return x * rcpf_(1.f + __expf(-x)); }
__device__ __forceinline__ float tanhf_(float x) { return 1.f - 2.f * rcpf_(1.f + __expf(2.f * x)); }

__device__ __forceinline__ float row_rstd(const unsigned char* ws, int slot, int row) {
    const f32x4* q = (const f32x4*)((const float*)(ws + WS_SS) + ((size_t)slot * M + row) * 16);
    const f32x4 a = q[0], b = q[1], c = q[2], d = q[3];
    const float ss = (((a.x + a.y) + (a.z + a.w)) + ((b.x + b.y) + (b.z + b.w))) + (((c.x + c.y) + (c.z + c.w)) + ((d.x + d.y) + (d.z + d.w)));
    return rsqrtf(ss * (1.f / D) + 1e-6f);
}
__device__ __forceinline__ float dpp_ror1(float v) { return __int_as_float(__builtin_amdgcn_update_dpp(0, __float_as_int(v), 0x121, 0xf, 0xf, false)); }
__device__ __forceinline__ void quad_transpose4(float (&x)[4], int j) {
    const bool o1 = j & 1, o2 = j & 2;
    const float a0 = o1 ? x[0] : x[1], a1 = o1 ? x[2] : x[3];
    const float b0 = __int_as_float(__builtin_amdgcn_mov_dpp(__float_as_int(a0), 0xB1, 0xf, 0xf, true)), b1 = __int_as_float(__builtin_amdgcn_mov_dpp(__float_as_int(a1), 0xB1, 0xf, 0xf, true));
    const float y0 = o1 ? b0 : x[0], y1 = o1 ? x[1] : b0, y2 = o1 ? b1 : x[2], y3 = o1 ? x[3] : b1;
    const float c0 = o2 ? y0 : y2, c1 = o2 ? y1 : y3;
    const float d0 = __int_as_float(__builtin_amdgcn_mov_dpp(__float_as_int(c0), 0x4E, 0xf, 0xf, true)), d1 = __int_as_float(__builtin_amdgcn_mov_dpp(__float_as_int(c1), 0x4E, 0xf, 0xf, true));
    x[0] = o2 ? d0 : y0; x[1] = o2 ? d1 : y1; x[2] = o2 ? y2 : d0; x[3] = o2 ? y3 : d1;
}
template <int CTRL> __device__ __forceinline__ float dpp_mv(float v) { return __int_as_float(__builtin_amdgcn_mov_dpp(__float_as_int(v), CTRL, 0xf, 0xf, true)); }
__device__ __forceinline__ float dpp_ror2(float v) { return __int_as_float(__builtin_amdgcn_update_dpp(0, __float_as_int(v), 0x122, 0xf, 0xf, false)); }
enum { EK_RETIN = 0, EK_RESID, EK_UG, EK_RWPROJ, EK_F32 };
template <int GRP> struct EpiExtra {};
template <> struct EpiExtra<1> { const float* pcw; const float* pcb; const float* pcst; float* pout; };
template <int GRP> struct EpiAnyT : EpiExtra<GRP> {
    static constexpr bool AFTER_DRAIN = false;
    int kind; bool perm; int jl; unsigned char* ws; int slot; const LAS float* rtab; float amul; int li; LAS unsigned char* ldsb;
    __device__ __forceinline__ void operator()(const f32x4 (&acc)[2][2][4][2], const Unit& u, int wr, int wc, int fr, int fq) const {
        const int row0 = u.pm * 256 + wr * 64 + fr;
        if (GRP == 0 && kind == EK_RETIN) {
            bf16* QK = (bf16*)(ws + WS_QK); bf16* V = (bf16*)(ws + WS_V); bf16* SG = (bf16*)(ws + WS_SG); const float* CS = (const float*)(ws + WS_CS);
            const int cw = wc * 32 + 8 * fq;
            if (u.pn < 8) {
                const bool isk = u.pn >= 4; const int h = u.pn & 3; const float sc = isk ? 0.0625f : 1.f;
                bf16* base = QK + (isk ? 1024 : 0) + h * 256 + cw;
#pragma unroll
                for (int ai = 0; ai < 2; ++ai) {
                    f32x4 tt[4][4];
#pragma unroll
                    for (int m = 0; m < 4; ++m) { const int row = row0 + ai * 128 + m * 16; const int pi = row < MP ? row % TP : TP;
                        const f32x4* cs = (const f32x4*)(CS + ((size_t)pi * 128 + cw) * 2);
#pragma unroll
                        for (int q4 = 0; q4 < 4; ++q4) tt[m][q4] = cs[q4]; }
#pragma unroll
                    for (int m = 0; m < 4; ++m) {
                        const int row = row0 + ai * 128 + m * 16;
                        const float rs = rtab[u.ord * 256 + (row - u.pm * 256)] * sc;
                        const f32x4 t0 = tt[m][0], t1 = tt[m][1], t2 = tt[m][2], t3 = tt[m][3];
                        const float c[8] = {t0.x, t0.z, t1.x, t1.z, t2.x, t2.z, t3.x, t3.z}, s[8] = {t0.y, t0.w, t1.y, t1.w, t2.y, t2.w, t3.y, t3.w};
                        float o1[8], o2[8];
#pragma unroll
                        for (int n = 0; n < 2; ++n)
#pragma unroll
                            for (int j = 0; j < 4; ++j) {
                                const float x1 = acc[ai][0][m][n][j], x2 = acc[ai][1][m][n][j];
                                o1[n * 4 + j] = (x1 * c[n * 4 + j] - x2 * s[n * 4 + j]) * rs;
                                o2[n * 4 + j] = (x1 * s[n * 4 + j] + x2 * c[n * 4 + j]) * rs;
                            }
                        bf16* rp = base + (size_t)row * 2048;
                        *(v4u*)rp = pack8(o1); *(v4u*)(rp + 128) = pack8(o2);
                    }
                    asm volatile("" ::: "memory");
                }
            } else {
                const bool isg = u.pn >= 16;
                bf16* base = (isg ? SG : V) + ((u.pn - (isg ? 16 : 8)) * 256) + cw;
#pragma unroll
                for (int ai = 0; ai < 2; ++ai)
#pragma unroll
                    for (int m = 0; m < 4; ++m) {
                        bf16* rp = base + (size_t)(row0 + ai * 128 + m * 16) * 2048;
                        const float rs = rtab[u.ord * 256 + (wr * 64 + fr + ai * 128 + m * 16)];
#pragma unroll
                        for (int bj = 0; bj < 2; ++bj) {
                            float o[8];
#pragma unroll
                            for (int n = 0; n < 2; ++n)
#pragma unroll
                                for (int j = 0; j < 4; ++j) { const float x = acc[ai][bj][m][n][j] * rs; o[n * 4 + j] = isg ? siluf_(x) : x; }
                            *(v4u*)(rp + bj * 128) = pack8(o);
                        }
                    }
            }
        } else if (GRP == 0 && kind == EK_RESID) {
            const int colw = u.pn * 256 + wc * 32 + (fq & 1) * 16 + (fq >> 1) * 8;
#pragma unroll
            for (int am = 0; am < 4; ++am) { const int ai = am >> 1, mb = (am & 1) * 2;
                v4u xv[2][2];
#pragma unroll
                for (int mm = 0; mm < 2; ++mm) { const int m = mb + mm; const bf16* rp = (const bf16*)(ws + WS_XB) + (size_t)(row0 + ai * 128 + m * 16) * D + colw;
#pragma unroll
                    for (int bj = 0; bj < 2; ++bj) xv[mm][bj] = *(const v4u*)(rp + bj * 128); }
#pragma unroll
                for (int mm = 0; mm < 2; ++mm) { const int m = mb + mm;
                    const int row = row0 + ai * 128 + m * 16;
                    bf16* xb = (bf16*)(ws + WS_XB) + (size_t)row * D + colw;
                    float ssq = 0.f;
#pragma unroll
                    for (int bj = 0; bj < 2; ++bj) {
                        const auto s0 = __builtin_amdgcn_permlane16_swap(xv[mm][bj].x, xv[mm][bj].z, false, false), s1 = __builtin_amdgcn_permlane16_swap(xv[mm][bj].y, xv[mm][bj].w, false, false);
                        const unsigned xn[2][2] = {{s0[0], s1[0]}, {s0[1], s1[1]}};
                        unsigned wn[2][2];
#pragma unroll
                        for (int n = 0; n < 2; ++n) {
                            const f32x4 v = (f32x4){bf_lo(xn[n][0]), bf_hi(xn[n][0]), bf_lo(xn[n][1]), bf_hi(xn[n][1])} + acc[ai][bj][m][n] * amul;
                            wn[n][0] = cvt_pk_bf16(v.x, v.y); wn[n][1] = cvt_pk_bf16(v.z, v.w);
                            if (slot >= 0) ssq += (v.x * v.x + v.y * v.y) + (v.z * v.z + v.w * v.w); }
                        const auto t0 = __builtin_amdgcn_permlane16_swap(wn[0][0], wn[1][0], false, false), t1 = __builtin_amdgcn_permlane16_swap(wn[0][1], wn[1][1], false, false);
                        *(v4u*)(xb + bj * 128) = (v4u){t0[0], t1[0], t0[1], t1[1]};
                    }
                    if (slot >= 0) { ssq += shfl_xor_l(ssq, 16, fq * 16 + fr); ssq += shfl_xor_l(ssq, 32, fq * 16 + fr); if (fq == 0) ((float*)(ws + WS_SS))[((size_t)slot * M + row) * 16 + u.pn * 4 + wc] = ssq; }
                }
                asm volatile("" ::: "memory");
            }
        } else if (GRP == 1 && kind == EK_UG) {
            int frL = fr, fqL = fq; asm volatile("" : "+v"(frL), "+v"(fqL));
            const EpiExtra<1>& X1 = *(const EpiExtra<1>*)(const void*)this;
            const float* cw = X1.pcw + (size_t)li * 3 * DFF; const float* cb = X1.pcb + (size_t)li * DFF; const float* cst = X1.pcst + (size_t)li * SB * 2 * DFF;
            float* cvp = X1.pout + O_CVP + (size_t)li * BATCH * 2 * DFF; float* cvs = X1.pout + O_CVS + (size_t)li * SB * 2 * DFF;
            bf16* ACT = (bf16*)(ws + WS_ACT);
            const int fl = wc * 32 + 8 * fqL;
            LAS float* halo = (LAS float*)(ldsb + 131072 + 8192);
            const LAS float* rt = rtab + u.ord * 256;
#pragma unroll
            for (int ai = 0; ai < 2; ++ai) if (frL >= 14) {
                const float rs = rt[128 * ai + 64 * wr + 48 + frL];
                LAS float* hp = halo + ((2 * ai + wr) * 2 + (frL - 14)) * 128 + fl;
                *(LAS f32x4*)hp = acc[ai][1][3][0] * rs; *(LAS f32x4*)(hp + 4) = acc[ai][1][3][1] * rs;
            }
            asm volatile("s_waitcnt lgkmcnt(0)" ::: "memory"); __builtin_amdgcn_s_barrier(); asm volatile("" ::: "memory");
            const int R0 = 254 * u.pm - 2, bq = (R0 + 2) / TP, tq = (R0 + 2) - bq * TP;
            const bool plain = (R0 + 255 < MP) && tq >= 2 && tq + 253 < TP - 2;
            if (plain) {
                const bool k15 = frL == 15, k14 = frL >= 14;
                const int f00 = u.pn * 128 + fl;
                const f32x4 Wa0 = *(const f32x4*)(cw + f00), Wa1 = *(const f32x4*)(cw + DFF + f00), Wa2 = *(const f32x4*)(cw + 2 * DFF + f00), Wab = *(const f32x4*)(cb + f00);
                const f32x4 Wb0 = *(const f32x4*)(cw + f00 + 4), Wb1 = *(const f32x4*)(cw + DFF + f00 + 4), Wb2 = *(const f32x4*)(cw + 2 * DFF + f00 + 4), Wbb = *(const f32x4*)(cb + f00 + 4);
                const unsigned ob = (unsigned)((R0 + 64 * wr + frL) * DFF + f00) * 2u;
                f32x4 prevA = (f32x4){0.f, 0.f, 0.f, 0.f}, prevB = prevA;
#pragma unroll
                for (int ai = 0; ai < 2; ++ai)
#pragma unroll
                    for (int m = 0; m < 4; ++m) {
                        const int l = 128 * ai + 64 * wr + 16 * m + frL;
                        const float rs = rt[l];
                        if (m == 0) {
                            const int B = 2 * ai + wr;
                            prevA = (f32x4){0.f, 0.f, 0.f, 0.f}; prevB = prevA;
                            if (B > 0 && frL >= 14) { const LAS float* hp = halo + ((B - 1) * 2 + (frL - 14)) * 128 + fl; prevA = *(const LAS f32x4*)hp; prevB = *(const LAS f32x4*)(hp + 4); }
                        }
                        unsigned wv[4];
#pragma unroll
                        for (int n = 0; n < 2; ++n) {
                            const f32x4 w0 = n ? Wb0 : Wa0, w1 = n ? Wb1 : Wa1, w2 = n ? Wb2 : Wa2, bb = n ? Wbb : Wab;
                            const f32x4 cur = acc[ai][1][m][n] * rs, uu = acc[ai][0][m][n] * rs, prev = n ? prevB : prevA;
                            float ov[4];
#pragma unroll
                            for (int e = 0; e < 4; ++e) {
                                const float ce = cur[e], pe = prev[e];
                                const float g1 = dpp_mv<0x121>(k15 ? pe : ce), g2 = dpp_mv<0x122>(k14 ? pe : ce);
                                const float cv = fmaf(w0[e], g2, fmaf(w1[e], g1, fmaf(w2[e], ce, bb[e])));
                                ov[e] = siluf_(cv) * uu[e];
                            }
                            wv[2 * n] = cvt_pk_bf16(ov[0], ov[1]); wv[2 * n + 1] = cvt_pk_bf16(ov[2], ov[3]);
                            if (n) prevB = cur; else prevA = cur;
                        }
                        if (ai > 0 || m > 0 || l >= 2) *(v4u*)((unsigned char*)ACT + (ob + (unsigned)((128 * ai + 16 * m) * DFF * 2))) = (v4u){wv[0], wv[1], wv[2], wv[3]};
                        __builtin_amdgcn_sched_barrier(0);
                    }
            } else
#pragma unroll
            for (int n = 0; n < 2; ++n) {
                const int f0 = u.pn * 128 + fl + 4 * n;
                const f32x4 w0 = *(const f32x4*)(cw + f0), w1 = *(const f32x4*)(cw + DFF + f0), w2 = *(const f32x4*)(cw + 2 * DFF + f0), bb = *(const f32x4*)(cb + f0);
                f32x4 prev = (f32x4){0.f, 0.f, 0.f, 0.f};
#pragma unroll
                for (int ai = 0; ai < 2; ++ai)
#pragma unroll
                    for (int m = 0; m < 4; ++m) {
                        const int l = 128 * ai + 64 * wr + 16 * m + frL, row = 254 * u.pm - 2 + l;
                        const float rs = rt[l];
                        const f32x4 cur = acc[ai][1][m][n] * rs, uu = acc[ai][0][m][n] * rs;
                        if (m == 0) {
                            const int B = 2 * ai + wr;
                            prev = (f32x4){0.f, 0.f, 0.f, 0.f};
                            if (B > 0 && frL >= 14) prev = *(const LAS f32x4*)(halo + ((B - 1) * 2 + (frL - 14)) * 128 + fl + 4 * n);
                        }
                        f32x4 g1, g2;
                        {
                            const float c1x = dpp_ror1(cur.x), c1y = dpp_ror1(cur.y), c1z = dpp_ror1(cur.z), c1w = dpp_ror1(cur.w);
                            const float p1x = dpp_ror1(prev.x), p1y = dpp_ror1(prev.y), p1z = dpp_ror1(prev.z), p1w = dpp_ror1(prev.w);
                            const float c2x = dpp_ror2(cur.x), c2y = dpp_ror2(cur.y), c2z = dpp_ror2(cur.z), c2w = dpp_ror2(cur.w);
                            const float p2x = dpp_ror2(prev.x), p2y = dpp_ror2(prev.y), p2z = dpp_ror2(prev.z), p2w = dpp_ror2(prev.w);
                            const bool s1 = frL >= 1, s2 = frL >= 2;
                            g1.x = s1 ? c1x : p1x; g1.y = s1 ? c1y : p1y; g1.z = s1 ? c1z : p1z; g1.w = s1 ? c1w : p1w;
                            g2.x = s2 ? c2x : p2x; g2.y = s2 ? c2y : p2y; g2.z = s2 ? c2z : p2z; g2.w = s2 ? c2w : p2w;
                        }
                        if (l >= 2 && row < M) {
                            if (row < MP) {
                                const int b = row / TP, t = row - b * TP;
                                if (t < 2) { g2 = (f32x4){0.f, 0.f, 0.f, 0.f}; if (t == 0) g1 = g2; }
                                if (t >= TP - 2) *(f32x4*)(cvp + ((size_t)b * 2 + (t - (TP - 2))) * DFF + f0) = cur;
                            } else {
                                const int s = row - MP;
                                const float* c0 = cst + ((size_t)s * 2 + 0) * DFF + f0;
                                g2 = *(const f32x4*)c0; g1 = *(const f32x4*)(c0 + DFF);
                                float* o = cvs + ((size_t)s * 2 + 0) * DFF + f0;
                                *(f32x4*)o = g1; *(f32x4*)(o + DFF) = cur;
                            }
                            const f32x4 cv = bb + w0 * g2 + w1 * g1 + w2 * cur;
                            v2u w; w.x = cvt_pk_bf16(siluf_(cv.x) * uu.x, siluf_(cv.y) * uu.y); w.y = cvt_pk_bf16(siluf_(cv.z) * uu.z, siluf_(cv.w) * uu.w);
                            *(v2u*)(ACT + (size_t)row * DFF + f0) = w;
                        }
                        prev = cur;
                    }
            }
        } else if (GRP == 0 && kind == EK_RWPROJ) {
            const int cw = wc * 32 + 8 * fq;
            int rrow[2][4];
#pragma unroll
            for (int ai = 0; ai < 2; ++ai)
#pragma unroll
                for (int m = 0; m < 4; ++m) { const int mp = row0 + ai * 128 + m * 16;
                    if (mp < 8 * (TP + 1)) { const int b = mp / (TP + 1), t = mp - b * (TP + 1); rrow[ai][m] = t < TP ? b * TP + t : -1; }
                    else { const int q = mp - 8 * (TP + 1); rrow[ai][m] = (!(q & 1) && q < 2 * SB) ? MP + (q >> 1) : -1; } }
            if (u.pn < 12) {
                bf16* dst = (bf16*)(ws + (u.pn < 4 ? WS_R : (u.pn < 8 ? WS_K : (jl == 0 ? WS_VF : WS_VB)))) + (u.pn & 3) * 256 + cw;
#pragma unroll
                for (int ai = 0; ai < 2; ++ai)
#pragma unroll
                    for (int m = 0; m < 4; ++m) if (rrow[ai][m] >= 0) {
                        bf16* rp = dst + (size_t)rrow[ai][m] * D;
#pragma unroll
                        for (int bj = 0; bj < 2; ++bj) { float o[8];
#pragma unroll
                            for (int n = 0; n < 2; ++n)
#pragma unroll
                                for (int j = 0; j < 4; ++j) o[n * 4 + j] = acc[ai][bj][m][n][j];
                            *(v4u*)(rp + bj * 128) = pack8(o); }
                    }
            } else {
                bf16* A2 = (bf16*)(ws + WS_A2);
#pragma unroll
                for (int bj = 0; bj < 2; ++bj) {
                    const int c = (u.pn - 12) * 256 + bj * 128 + cw;
                    if (c < KL2) {
                        const int kd = c < 64 ? 1 : ((c >= 128 && c < 288) ? 2 : 0);
#pragma unroll
                        for (int ai = 0; ai < 2; ++ai)
#pragma unroll
                            for (int m = 0; m < 4; ++m) if (rrow[ai][m] >= 0) { float o[8];
#pragma unroll
                                for (int n = 0; n < 2; ++n)
#pragma unroll
                                    for (int j = 0; j < 4; ++j) { const float x = acc[ai][bj][m][n][j]; o[n * 4 + j] = kd == 1 ? tanhf_(x) : (kd == 2 ? sigmoidf_(x) : x); }
                                *(v4u*)(A2 + (size_t)rrow[ai][m] * KL2 + c) = pack8(o); }
                    }
                }
            }
        } else if (GRP == 0) {
            bf16* C = (bf16*)(ws + WS_L2);
            const int col0 = u.pn * 256 + wc * 32 + 8 * fq;
#pragma unroll
            for (int ai = 0; ai < 2; ++ai)
#pragma unroll
                for (int m = 0; m < 4; ++m) {
                    bf16* rp = C + (size_t)(row0 + ai * 128 + m * 16) * NL2 + col0;
#pragma unroll
                    for (int bj = 0; bj < 2; ++bj) { float o[8];
#pragma unroll
                        for (int n = 0; n < 2; ++n)
#pragma unroll
                            for (int j = 0; j < 4; ++j) o[n * 4 + j] = acc[ai][bj][m][n][j];
                        *(v4u*)(rp + bj * 128) = pack8(o); }
                }
        }
    }
};

constexpr int MT0 = 16384;
constexpr int HP_SEQ = TP + 1, HP_PB = BATCH * HP_SEQ, HP_M = 66 * 256;
static_assert(HP_PB + 2 * SB <= HP_M && (size_t)(HP_M + 2) * D * 2 <= SZ_MD4, "padded rwkv input");
__device__ __forceinline__ void tail_resid(const bf16* __restrict__ A, const bf16* __restrict__ Bt, int K, unsigned char* ws, int slot, float amul, LAS unsigned char* lds, int lane, int wave) {
    const int fr = lane & 15, fq = lane >> 4;
    const int kw = K >> 3;
    for (int job = blockIdx.x; job < 16 * 16; job += gridDim.x) {
        const int rs = job >> 4, cs = job & 15;
        const bf16* ap = A + (size_t)(MT0 + 16 * rs + fr) * K + wave * kw + 8 * fq;
        const bf16* bp = Bt + (size_t)(64 * cs + fr) * K + wave * kw + 8 * fq;
        f32x4 acc[4];
#pragma unroll
        for (int t = 0; t < 4; ++t) acc[t] = (f32x4){0.f, 0.f, 0.f, 0.f};
#pragma unroll 4
        for (int k0 = 0; k0 < kw; k0 += 32) {
            const bf16x8 af = *(const bf16x8*)(ap + k0);
#pragma unroll
            for (int t = 0; t < 4; ++t) { const bf16x8 bf = *(const bf16x8*)(bp + (size_t)(16 * t) * K + k0); acc[t] = __builtin_amdgcn_mfma_f32_16x16x32_bf16(bf, af, acc[t], 0, 0, 0); }
        }
        __syncthreads();
#pragma unroll
        for (int t = 0; t < 4; ++t) *(LAS f32x4*)(lds + ((wave * 4 + t) * 64 + lane) * 16) = acc[t];
        __syncthreads();
        if (wave == 0) {
#pragma unroll
            for (int t = 0; t < 4; ++t) { f32x4 s = acc[t];
#pragma unroll
                for (int w = 1; w < 8; ++w) s += *(LAS f32x4*)(lds + ((w * 4 + t) * 64 + lane) * 16);
                acc[t] = s; }
            const int row = MT0 + 16 * rs + fr;
            bf16* xb = (bf16*)(ws + WS_XB) + (size_t)row * D + 64 * cs + 4 * fq;
            float ssq = 0.f;
#pragma unroll
            for (int t = 0; t < 4; ++t) { const f32x4 v = ld_bf4(xb + 16 * t) + acc[t] * amul; st_bf4(xb + 16 * t, v);
                if (slot >= 0) ssq += (v.x * v.x + v.y * v.y) + (v.z * v.z + v.w * v.w); }
            if (slot >= 0) { ssq += shfl_xor_l(ssq, 16, lane); ssq += shfl_xor_l(ssq, 32, lane); if (fq == 0) ((float*)(ws + WS_SS))[((size_t)slot * M + row) * 16 + cs] = ssq; }
        }
    }
}

__device__ __forceinline__ void tr_item(const float* __restrict__ W, int ldw, int k0, int n0, bf16* __restrict__ WT, int ldt, int drow, const float* __restrict__ mu, LAS float* scr, int lane, const float* __restrict__ gs = nullptr) {
#pragma unroll 8
    for (int i = 0; i < 32; ++i) { const int kk = 2 * i + (lane >> 5); scr[kk * 33 + (lane & 31)] = W[(size_t)(k0 + kk) * ldw + n0 + (lane & 31)]; }
    asm volatile("s_waitcnt lgkmcnt(0)" ::: "memory");
    const int c = lane & 7;
    float mv[8];
    if (mu) {
#pragma unroll
        for (int e = 0; e < 8; ++e) mv[e] = mu[k0 + 8 * c + e];
    } else if (gs) {
#pragma unroll
        for (int e = 0; e < 8; ++e) mv[e] = gs[k0 + 8 * c + e];
    }
#pragma unroll
    for (int j = 0; j < 4; ++j) {
        const int n = (lane >> 3) + 8 * j; const LAS float* s = scr + (8 * c) * 33 + n;
        float f[8];
#pragma unroll
        for (int e = 0; e < 8; ++e) f[e] = s[e * 33];
        bf16* dp = WT + (size_t)(drow + n) * ldt + k0 + 8 * c;
        if (mu) {
            float f1[8], f2[8];
#pragma unroll
            for (int e = 0; e < 8; ++e) { f1[e] = f[e] * (1.f - mv[e]); f2[e] = f[e] * mv[e]; }
            *(v4u*)dp = pack8(f1); *(v4u*)(dp + 1024) = pack8(f2);
        } else { if (gs) {
#pragma unroll
            for (int e = 0; e < 8; ++e) f[e] *= mv[e]; }
            *(v4u*)dp = pack8(f); }
    }
    asm volatile("s_waitcnt lgkmcnt(0)" ::: "memory");
}

__device__ __forceinline__ void ph_p0(const Params& p, LAS unsigned char* lds, int tid, int lane, int wave) {
    unsigned char* ws = p.ws;
    LAS float* scr = (LAS float*)(lds + wave * 16384);
    const int gw = blockIdx.x * NWAVES + wave, NGW = gridDim.x * NWAVES;
    constexpr int C_WIN = 2 * 16 * 192, C_WOUT = 2 * 32 * 32, C_RKV = 2 * 3 * 512, C_W1 = 2 * 32, C_A1 = 2 * 32, C_G1 = 2 * 80, C_V1 = 16, C_WO = 2 * 512, C_WUG = 4 * 16 * 176, C_WD = 4 * 44 * 32;
    constexpr int NITEMS = C_WIN + C_WOUT + C_RKV + C_W1 + C_A1 + C_G1 + C_V1 + C_WO + C_WUG + C_WD;
    for (int it = gw; it < NITEMS; it += NGW) {
        int r = it;
        if (r < C_WIN) { const int j = r / 3072, q = r % 3072, kb = q / 192, nb = q % 192;
            tr_item(p.in[I_RWIN] + (size_t)j * D * RWIN, RWIN, 64 * kb, 32 * nb, (bf16*)(ws + WS_WIN + j * SZ_WIN), D, 32 * nb, nullptr, scr, lane, p.in[I_NMIX] + (size_t)(2 * j) * D); continue; }
        r -= C_WIN;
        if (r < C_WOUT) { const int j = r / 1024, q = r % 1024, kb = q / 32, nb = q % 32;
            tr_item(p.in[I_RWOUT] + (size_t)j * RV * D, D, 64 * kb, 32 * nb, (bf16*)(ws + WS_WOUT + j * SZ_WOUT), RV, 32 * nb, nullptr, scr, lane); continue; }
        r -= C_WOUT;
        if (r < C_RKV) { const int j = r / 1536, q = r % 1536, s = q / 512, q2 = q % 512, kb = q2 / 32, nb = q2 % 32, c = (s == 0 ? 0 : (s == 1 ? 2 : 3));
            tr_item(p.in[I_WRKV] + (size_t)(j * 3 + s) * D * D, D, 64 * kb, 32 * nb, (bf16*)(ws + WS_WRW + j * SZ_WRW), KRW, s * 1024 + 32 * nb, p.in[I_MU] + (size_t)(j * 6 + c) * D, scr, lane); continue; }
        r -= C_RKV;
        if (r < C_W1) { const int j = r / 32, q = r % 32, kb = q / 2, nb = q % 2;
            tr_item(p.in[I_W1] + (size_t)j * D * LW, LW, 64 * kb, 32 * nb, (bf16*)(ws + WS_WRW + j * SZ_WRW), KRW, 3072 + 32 * nb, p.in[I_MU] + (size_t)(j * 6 + 1) * D, scr, lane); continue; }
        r -= C_W1;
        if (r < C_A1) { const int j = r / 32, q = r % 32, kb = q / 2, nb = q % 2;
            tr_item(p.in[I_A1] + (size_t)j * D * LA, LA, 64 * kb, 32 * nb, (bf16*)(ws + WS_WRW + j * SZ_WRW), KRW, 3136 + 32 * nb, p.in[I_MU] + (size_t)(j * 6 + 4) * D, scr, lane); continue; }
        r -= C_A1;
        if (r < C_G1) { const int j = r / 80, q = r % 80, kb = q / 5, nb = q % 5;
            tr_item(p.in[I_G1] + (size_t)j * D * LG, LG, 64 * kb, 32 * nb, (bf16*)(ws + WS_WRW + j * SZ_WRW), KRW, 3200 + 32 * nb, p.in[I_MU] + (size_t)(j * 6 + 5) * D, scr, lane); continue; }
        r -= C_G1;
        if (r < C_V1) { const int kb = r;
            tr_item(p.in[I_V1], LV, 64 * kb, 0, (bf16*)(ws + WS_WRW + 1 * SZ_WRW), KRW, 3360, p.in[I_MU] + (size_t)(1 * 6 + 3) * D, scr, lane); continue; }
        r -= C_V1;
        if (r < C_WO) { const int j = r / 512, q = r % 512, kb = q / 32, nb = q % 32;
            tr_item(p.in[I_WO] + (size_t)j * D * D, D, 64 * kb, 32 * nb, (bf16*)(ws + WS_WO + j * SZ_WO), D, 32 * nb, nullptr, scr, lane); continue; }
        r -= C_WO;
        if (r < C_WUG) { const int i = r / 2816, q = r % 2816, kb = q / 176, nb = q % 176, n0 = 32 * nb;
            const int drow = n0 < DFF ? 256 * (n0 / 128) + (n0 % 128) : 256 * ((n0 - DFF) / 128) + 128 + ((n0 - DFF) % 128);
            tr_item(p.in[I_WUG] + (size_t)i * D * 2 * DFF, 2 * DFF, 64 * kb, n0, (bf16*)(ws + WS_WUG + i * SZ_WUG), D, drow, nullptr, scr, lane, p.in[I_NFFN] + (size_t)i * D); continue; }
        r -= C_WUG;
        { const int i = r / 1408, q = r % 1408, kb = q / 32, nb = q % 32;
            tr_item(p.in[I_WD] + (size_t)i * DFF * D, D, 64 * kb, 32 * nb, (bf16*)(ws + WS_WD + i * SZ_WD), DFF, 32 * nb, nullptr, scr, lane); }
    }
    const size_t gt = (size_t)blockIdx.x * NTHR + tid, GT = (size_t)gridDim.x * NTHR;
    for (size_t i = gt; i < (size_t)(224 + 192) * (KRW / 8); i += GT) {
        const int rr = (int)(i / (KRW / 8)), c8 = (int)(i % (KRW / 8));
        const int j = rr < 224 ? 0 : 1, row = rr < 224 ? 3360 + rr : 3392 + (rr - 224);
        *(v4u*)((bf16*)(ws + WS_WRW + j * SZ_WRW) + (size_t)row * KRW + c8 * 8) = (v4u){0u, 0u, 0u, 0u};
    }
    for (size_t i = gt; i < (size_t)2 * NL2 * KL2; i += GT) {
        const int j = (int)(i / ((size_t)NL2 * KL2)); const int rem = (int)(i % ((size_t)NL2 * KL2)); const int n = rem / KL2, k = rem % KL2, grp = n >> 10, nn = n & 1023;
        float v = 0.f;
        if (grp == 0) { if (k < 64) v = p.in[I_W2][((size_t)j * LW + k) * D + nn]; }
        else if (grp == 1) { if (k >= 64 && k < 128) v = p.in[I_A2][((size_t)j * LA + (k - 64)) * D + nn]; }
        else if (grp == 2) { if (k >= 128 && k < 288) v = p.in[I_G2][((size_t)j * LG + (k - 128)) * D + nn]; }
        else { if (j == 1 && k >= 288 && k < 320) v = p.in[I_V2][((size_t)(k - 288)) * D + nn]; }
        ((bf16*)(ws + WS_WL2 + j * SZ_WL2))[(size_t)n * KL2 + k] = (bf16)(cvt_pk_bf16(v, 0.f) & 0xffffu);
    }
    for (size_t i = gt; i < (size_t)(TP + 1) * 128; i += GT) {
        const int pi = (int)(i >> 7), mi = (int)(i & 127);
        const float pos = pi < TP ? (float)pi : PAST_POS;
        const float inv = 1.0f / powf(10000.0f, (float)mi / 127.0f);
        float s, c; sincosf(pos * inv, &s, &c);
        ((float2*)(ws + WS_CS))[i] = make_float2(c, s);
    }
    bf16* XB = (bf16*)(ws + WS_XB);
    for (int r = gw; r < M; r += NGW) {
        const float* src;
        if (r < MP) { const int b = r / TP, t = r % TP; src = t < NMETA ? p.in[I_META] + (size_t)t * D : p.in[I_XP] + ((size_t)b * SEQ + (t - NMETA)) * D; }
        else src = p.in[I_XS] + (size_t)(r - MP) * D;
        float ss = 0.f;
#pragma unroll
        for (int j = 0; j < 2; ++j) { const int c0 = 512 * j + 8 * lane;
            const f32x4 a4 = *(const f32x4*)(src + c0), b4 = *(const f32x4*)(src + c0 + 4);
            const float f[8] = {a4.x, a4.y, a4.z, a4.w, b4.x, b4.y, b4.z, b4.w};
#pragma unroll
            for (int e = 0; e < 8; ++e) ss += f[e] * f[e];
            *(v4u*)(XB + (size_t)r * D + c0) = pack8(f); }
        ss = wave_sum(ss, lane);
        if (lane < 16) ((float*)(ws + WS_SS))[(size_t)r * 16 + lane] = lane == 0 ? ss : 0.f;
    }
}

__device__ __forceinline__ void ph_norm(const Params& p, const float* __restrict__ g, int mode, int jl, int lane, int wave) {
    const bf16* X = (const bf16*)(p.ws + WS_XB); bf16* H = (bf16*)(p.ws + WS_H);
    const int gw = blockIdx.x * NWAVES + wave, NGW = gridDim.x * NWAVES;
    constexpr int UB = 4;
    for (int row0 = gw; row0 < M; row0 += NGW * UB) {
    v4u raw[UB][2];
#pragma unroll
    for (int q = 0; q < UB; ++q) { const int r_ = row0 + q * NGW, rc_ = r_ < M ? r_ : row0;
#pragma unroll
        for (int j = 0; j < 2; ++j) raw[q][j] = *(const v4u*)(X + (size_t)rc_ * D + 512 * j + 8 * lane); }
#pragma unroll
    for (int q = 0; q < UB; ++q) { const int row = row0 + q * NGW; if (row < M) {
        float v[2][8]; float ss = 0.f;
#pragma unroll
        for (int j = 0; j < 2; ++j) {
            unpack8(raw[q][j], v[j]);
#pragma unroll
            for (int e = 0; e < 8; ++e) ss += v[j][e] * v[j][e];
        }
        ss = wave_sum(ss, lane);
        const float rstd = rsqrtf(ss * (1.f / D) + 1e-6f);
        const bool prompt = row < MP; const int b = prompt ? row / TP : 0, t = prompt ? row % TP : 0;
#pragma unroll
        for (int j = 0; j < 2; ++j) {
            const int c0 = 512 * j + 8 * lane;
            const f32x4 ga = *(const f32x4*)(g + c0), gb = *(const f32x4*)(g + c0 + 4);
            float o[8];
            o[0] = v[j][0] * rstd * ga.x; o[1] = v[j][1] * rstd * ga.y; o[2] = v[j][2] * rstd * ga.z; o[3] = v[j][3] * rstd * ga.w;
            o[4] = v[j][4] * rstd * gb.x; o[5] = v[j][5] * rstd * gb.y; o[6] = v[j][6] * rstd * gb.z; o[7] = v[j][7] * rstd * gb.w;
            if (mode == 0) { *(v4u*)(H + (size_t)row * D + c0) = pack8(o); }
            else if (mode == 1) {
                const v4u w = pack8(o);
                if (prompt) {
                    bf16* hp = H + (size_t)(b * HP_SEQ + 1 + t) * D + c0;
                    *(v4u*)hp = w;
                    if (t == TP - 1) { float* so = p.out + O_SHP + ((size_t)jl * BATCH + b) * D + c0; *(f32x4*)so = (f32x4){o[0], o[1], o[2], o[3]}; *(f32x4*)(so + 4) = (f32x4){o[4], o[5], o[6], o[7]}; }
                    if (t == 0) *(v4u*)(hp - D) = (v4u){0u, 0u, 0u, 0u};
                } else {
                    const int s = row - MP;
                    const float* sp = p.in[I_SSHIFT] + ((size_t)jl * SB + s) * D + c0;
                    const f32x4 sa = *(const f32x4*)sp, sb2 = *(const f32x4*)(sp + 4);
                    const float pv[8] = {sa.x, sa.y, sa.z, sa.w, sb2.x, sb2.y, sb2.z, sb2.w};
                    bf16* hp = H + (size_t)(HP_PB + 2 * s) * D + c0;
                    *(v4u*)hp = pack8(pv); *(v4u*)(hp + D) = w;
                    float* so = p.out + O_SHS + ((size_t)jl * SB + s) * D + c0; *(f32x4*)so = (f32x4){o[0], o[1], o[2], o[3]}; *(f32x4*)(so + 4) = (f32x4){o[4], o[5], o[6], o[7]};
                }
            } else {
                float* dst = nullptr;
                if (prompt) { if (t >= NMETA) dst = p.out + O_YP + ((size_t)b * SEQ + (t - NMETA)) * D + c0; }
                else dst = p.out + O_YS + (size_t)(row - MP) * D + c0;
                if (dst) { *(f32x4*)dst = (f32x4){o[0], o[1], o[2], o[3]}; *(f32x4*)(dst + 4) = (f32x4){o[4], o[5], o[6], o[7]}; }
            }
        }
    } }
    }
}

__device__ __forceinline__ void ph_ret_norm(const Params& p, int jl, int lane, int wave) {
    const bf16* O = (const bf16*)(p.ws + WS_O); const bf16* SG = (const bf16*)(p.ws + WS_SG); bf16* Y = (bf16*)(p.ws + WS_Y);
    const float* gnw = p.in[I_RGN] + (size_t)jl * RV;
    const int gw = blockIdx.x * NWAVES + wave, NGW = gridDim.x * NWAVES;
    constexpr int UB = 4;
    for (int it0 = gw; it0 < M * RH; it0 += NGW * UB) {
        const int h = it0 & 3;
        const f32x4 ga = *(const f32x4*)(gnw + h * RDV + 8 * lane), gb = *(const f32x4*)(gnw + h * RDV + 8 * lane + 4);
        const float gg[8] = {ga.x, ga.y, ga.z, ga.w, gb.x, gb.y, gb.z, gb.w};
        v4u ov[UB], sgv[UB];
#pragma unroll
        for (int q = 0; q < UB; ++q) { const int it = it0 + q * NGW, itc = it < M * RH ? it : it0; const size_t off = (size_t)(itc >> 2) * RV + h * RDV + 8 * lane;
            ov[q] = *(const v4u*)(O + off); sgv[q] = *(const v4u*)(SG + off); }
#pragma unroll
        for (int q = 0; q < UB; ++q) { const int it = it0 + q * NGW; const size_t off = (size_t)(it >> 2) * RV + h * RDV + 8 * lane;
            float v[8]; unpack8(ov[q], v);
            float s = 0.f;
#pragma unroll
            for (int e = 0; e < 8; ++e) s += v[e];
            const float mean = wave_sum(s, lane) * (1.f / RDV);
            float s2 = 0.f;
#pragma unroll
            for (int e = 0; e < 8; ++e) { v[e] -= mean; s2 += v[e] * v[e]; }
            const float rstd = rsqrtf(wave_sum(s2, lane) * (1.f / RDV) + 1e-5f);
            float sg[8]; unpack8(sgv[q], sg);
            float o[8];
#pragma unroll
            for (int e = 0; e < 8; ++e) o[e] = v[e] * rstd * gg[e] * sg[e];
            if (it < M * RH) *(v4u*)(Y + off) = pack8(o);
        }
    }
}

__device__ __forceinline__ float row16_sum(float x);
__device__ __forceinline__ float half8_sum(float x);
__device__ __forceinline__ void ph_rwkv_post(const Params& p, int jl, int lane, int wave) {
    const bf16* YW = (const bf16*)(p.ws + WS_YW); const float* BON = (const float*)(p.ws + WS_NKK);
    const bf16* VP = (const bf16*)(p.ws + (jl == 0 ? WS_VF : WS_KKA)); const bf16* L2 = (const bf16*)(p.ws + WS_L2); bf16* Z = (bf16*)(p.ws + WS_Z);
    const float* lnw = p.in[I_LNW] + (size_t)jl * D; const float* lnb = p.in[I_LNB] + (size_t)jl * D;
    const int gw = blockIdx.x * NWAVES + wave, NGW = gridDim.x * NWAVES;
    const int sub = lane >> 3, c8 = lane & 7;
    constexpr int UB = 4;
    for (int it0 = gw * 8; it0 < M * WH; it0 += NGW * 8 * UB) {
        const int h = (it0 + sub) & 15, c = h * WN + 8 * c8;
        const f32x4 lwa = *(const f32x4*)(lnw + c), lwb = *(const f32x4*)(lnw + c + 4), lba = *(const f32x4*)(lnb + c), lbb = *(const f32x4*)(lnb + c + 4);
        const float lw[8] = {lwa.x, lwa.y, lwa.z, lwa.w, lwb.x, lwb.y, lwb.z, lwb.w}, lb[8] = {lba.x, lba.y, lba.z, lba.w, lbb.x, lbb.y, lbb.z, lbb.w};
        v4u y4[UB], v4[UB], g4[UB]; float bonv[UB];
#pragma unroll
        for (int q = 0; q < UB; ++q) { const int it = it0 + q * NGW * 8 + sub, itc = it < M * WH ? it : it0 + sub, row = itc >> 4; const size_t idx = (size_t)row * D + c;
            y4[q] = *(const v4u*)(YW + idx); bonv[q] = BON[(size_t)row * WH + h]; v4[q] = *(const v4u*)(VP + idx); g4[q] = *(const v4u*)(L2 + (size_t)row * NL2 + 2048 + c); }
#pragma unroll
        for (int q = 0; q < UB; ++q) { const int it = it0 + q * NGW * 8 + sub, row = it >> 4; const size_t idx = (size_t)row * D + c;
            float yv[8], vv[8], gv[8]; unpack8(y4[q], yv); unpack8(v4[q], vv); unpack8(g4[q], gv);
            float s = 0.f;
#pragma unroll
            for (int e = 0; e < 8; ++e) s += yv[e];
            const float mean = half8_sum(s) * (1.f / WN);
            float s2 = 0.f;
#pragma unroll
            for (int e = 0; e < 8; ++e) { yv[e] -= mean; s2 += yv[e] * yv[e]; }
            const float rstd = rsqrtf(half8_sum(s2) * (1.f / WN) + 64e-5f);
            float z[8];
#pragma unroll
            for (int e = 0; e < 8; ++e) z[e] = (yv[e] * rstd * lw[e] + lb[e] + vv[e] * bonv[q]) * gv[e];
            if (it < M * WH) *(v4u*)(Z + idx) = pack8(z);
        }
    }
}

constexpr int RT_KP = 528, RT_VP = 144, RT_SP = 528;
constexpr int RT_K_OFF = 0, RT_V_OFF = 128 * RT_KP, RT_ST_OFF = RT_V_OFF + 128 * RT_VP, RT_END = RT_ST_OFF + 64 * RT_SP;
static_assert(RT_END <= LDS_BYTES, "retention LDS map");
typedef short v4s __attribute__((ext_vector_type(4)));
__device__ __forceinline__ bf16x8 tr_pair(LAS unsigned char* a0, LAS unsigned char* a1) {
    const v4s lo = __builtin_amdgcn_ds_read_tr16_b64_v4i16((LAS v4s*)a0), hi = __builtin_amdgcn_ds_read_tr16_b64_v4i16((LAS v4s*)a1);
    return __builtin_shufflevector(lo, hi, 0, 1, 2, 3, 4, 5, 6, 7);
}
__device__ __forceinline__ void ph_ret_fast(const Params& p, int jl, LAS unsigned char* lds, int tid, int lane, int wave) {
    const bf16* QK = (const bf16*)(p.ws + WS_QK); const bf16* V = (const bf16*)(p.ws + WS_V); bf16* O = (bf16*)(p.ws + WS_O);
    const int fr = lane & 15, fq = lane >> 4, li_q = (lane & 15) >> 2, li_p = lane & 3;
    for (int u = blockIdx.x; u < BATCH * RH * 8; u += gridDim.x) {
        const int es = u & 7, h = (u >> 3) & 3, b = u >> 5;
        const float gamma = 1.0f - exp2f(-5.0f - (float)h), lg = log2f(gamma), g128 = exp2f(128.f * lg), g127 = exp2f(127.f * lg);
        const int it_ = wave < 4 ? wave : 11 - wave, i0 = 16 * it_, d0 = 32 * wave;
        f32x4 Sacc[2][4];
#pragma unroll
        for (int a = 0; a < 2; ++a)
#pragma unroll
            for (int c = 0; c < 4; ++c) Sacc[a][c] = (f32x4){0.f, 0.f, 0.f, 0.f};
        __syncthreads();
        for (int i = tid; i < 64 * RT_SP / 16; i += NTHR) *(LAS v4u*)(lds + RT_ST_OFF + i * 16) = (v4u){0u, 0u, 0u, 0u};
        v4u kst[8], vst[2];
        const bf16* Kg = QK + 1024 + 256 * h; const bf16* Vg = V + 512 * h + 64 * es; const bf16* Qg = QK + 256 * h;
#define RT_LOAD_STAGE(cc) do { int tl_ = tid; asm volatile("" : "+v"(tl_));     \
            _Pragma("unroll") for (int k_ = 0; k_ < 8; ++k_) { const int id_ = tl_ + 512 * k_, row_ = id_ >> 5, ch_ = id_ & 31, t_ = 128 * (cc) - 112 + row_; \
                kst[k_] = t_ >= 0 ? *(const v4u*)(Kg + (size_t)(b * TP + t_) * 2048 + 8 * ch_) : (v4u){0u, 0u, 0u, 0u}; } \
            _Pragma("unroll") for (int k_ = 0; k_ < 2; ++k_) { const int id_ = tl_ + 512 * k_, row_ = id_ >> 3, ch_ = id_ & 7, t_ = 128 * (cc) - 112 + row_; \
                vst[k_] = t_ >= 0 ? *(const v4u*)(Vg + (size_t)(b * TP + t_) * 2048 + 8 * ch_) : (v4u){0u, 0u, 0u, 0u}; } } while (0)
        RT_LOAD_STAGE(0);
        bf16x8 Qf[8];
#define RT_LOAD_Q(cc) do { int ll_ = lane; asm volatile("" : "+v"(ll_)); const int t_ = 128 * (cc) - 112 + i0 + (ll_ & 15); \
            _Pragma("unroll") for (int s = 0; s < 8; ++s) Qf[s] = t_ >= 0 ? *(const bf16x8*)(Qg + (size_t)(b * TP + t_) * 2048 + 32 * s + 8 * (ll_ >> 4)) : (bf16x8){0, 0, 0, 0, 0, 0, 0, 0}; } while (0)
        RT_LOAD_Q(0);
        for (int c = 0; c < 17; ++c) {
            __syncthreads();
#pragma unroll
            for (int k_ = 0; k_ < 8; ++k_) { const int id_ = tid + 512 * k_, row_ = id_ >> 5, ch_ = id_ & 31; *(LAS v4u*)(lds + RT_K_OFF + row_ * RT_KP + ch_ * 16) = kst[k_]; }
#pragma unroll
            for (int k_ = 0; k_ < 2; ++k_) { const int id_ = tid + 512 * k_, row_ = id_ >> 3, ch_ = id_ & 7;
                float f[8]; unpack8(vst[k_], f); const float sc = exp2f(-(float)row_ * lg);
#pragma unroll
                for (int e = 0; e < 8; ++e) f[e] *= sc;
                *(LAS v4u*)(lds + RT_V_OFF + row_ * RT_VP + ch_ * 16) = pack8(f); }
            __syncthreads();
            bf16x8 Pf[4];
            { const int ii = i0 + fr; const float gi = exp2f((float)ii * lg);
#pragma unroll
              for (int s2 = 0; s2 < 4; ++s2) { f32x4 Dp[2];
                  Dp[0] = (f32x4){0.f, 0.f, 0.f, 0.f}; Dp[1] = Dp[0];
                  if (2 * s2 <= it_) {
                      bf16x8 Ka[8], Kb[8];
#pragma unroll
                      for (int s = 0; s < 8; ++s) { Ka[s] = *(const LAS bf16x8*)(lds + RT_K_OFF + (16 * (2 * s2) + fr) * RT_KP + (32 * s + 8 * fq) * 2);
                          Kb[s] = *(const LAS bf16x8*)(lds + RT_K_OFF + (16 * (2 * s2 + 1) + fr) * RT_KP + (32 * s + 8 * fq) * 2); }
                      __builtin_amdgcn_sched_barrier(0);
                      __builtin_amdgcn_s_setprio(1);
#pragma unroll
                      for (int s = 0; s < 8; ++s) { Dp[0] = __builtin_amdgcn_mfma_f32_16x16x32_bf16(Ka[s], Qf[s], Dp[0], 0, 0, 0); Dp[1] = __builtin_amdgcn_mfma_f32_16x16x32_bf16(Kb[s], Qf[s], Dp[1], 0, 0, 0); }
                      __builtin_amdgcn_s_setprio(0);
                      __builtin_amdgcn_sched_barrier(0);
                  }
                  float f[8];
#pragma unroll
                  for (int hh = 0; hh < 2; ++hh)
#pragma unroll
                      for (int r = 0; r < 4; ++r) { const int jj = 16 * (2 * s2 + hh) + 4 * fq + r; f[hh * 4 + r] = ii >= jj ? Dp[hh][r] * gi : 0.f; }
                  const v4u w = pack8(f); Pf[s2] = __builtin_bit_cast(bf16x8, w); } }
            f32x4 Oacc[4];
#pragma unroll
            for (int ep = 0; ep < 2; ++ep) {
                bf16x8 Sa[8], Sb[8];
#pragma unroll
                for (int s = 0; s < 8; ++s) { Sa[s] = *(const LAS bf16x8*)(lds + RT_ST_OFF + (16 * (2 * ep) + fr) * RT_SP + (32 * s + 8 * fq) * 2);
                    Sb[s] = *(const LAS bf16x8*)(lds + RT_ST_OFF + (16 * (2 * ep + 1) + fr) * RT_SP + (32 * s + 8 * fq) * 2); }
                __builtin_amdgcn_sched_barrier(0);
                f32x4 oa = (f32x4){0.f, 0.f, 0.f, 0.f}, ob = oa;
                __builtin_amdgcn_s_setprio(1);
#pragma unroll
                for (int s = 0; s < 8; ++s) { oa = __builtin_amdgcn_mfma_f32_16x16x32_bf16(Qf[s], Sa[s], oa, 0, 0, 0); ob = __builtin_amdgcn_mfma_f32_16x16x32_bf16(Qf[s], Sb[s], ob, 0, 0, 0); }
                __builtin_amdgcn_s_setprio(0);
                Oacc[2 * ep] = oa; Oacc[2 * ep + 1] = ob;
                __builtin_amdgcn_sched_barrier(0);
            }
            __syncthreads();
            if (c + 1 < 17) RT_LOAD_STAGE(c + 1);
#pragma unroll
            for (int r = 0; r < 4; ++r) { const float lam = exp2f((float)(i0 + 4 * fq + r + 1) * lg);
#pragma unroll
                for (int et = 0; et < 4; ++et) Oacc[et][r] *= lam; }
#pragma unroll
            for (int s = 0; s < 4; ++s) if (2 * s <= it_) {
                bf16x8 Vf[4];
#pragma unroll
                for (int et = 0; et < 4; ++et) { LAS unsigned char* a0 = lds + RT_V_OFF + (32 * s + 4 * fq + li_q) * RT_VP + (16 * et + 4 * li_p) * 2; Vf[et] = tr_pair(a0, a0 + 16 * RT_VP); }
                __builtin_amdgcn_sched_barrier(0);
#pragma unroll
                for (int et = 0; et < 4; ++et) Oacc[et] = __builtin_amdgcn_mfma_f32_16x16x32_bf16(Pf[s], Vf[et], Oacc[et], 0, 0, 0);
            }
            {
                v2u ow[4];
#pragma unroll
                for (int et = 0; et < 4; ++et) { float oq[4] = {Oacc[et][0], Oacc[et][1], Oacc[et][2], Oacc[et][3]}; quad_transpose4(oq, fr & 3); ow[et] = pk4((f32x4){oq[0], oq[1], oq[2], oq[3]}); }
                const int t_ = 128 * c - 112 + i0 + 4 * fq + (fr & 3);
                if (t_ >= 0) { bf16* op = O + (size_t)(b * TP + t_) * RV + 512 * h + 64 * es + (fr & 12);
#pragma unroll
                    for (int et = 0; et < 4; ++et) *(v2u*)(op + 16 * et) = ow[et]; }
            }
#pragma unroll
            for (int dt = 0; dt < 2; ++dt)
#pragma unroll
                for (int et = 0; et < 4; ++et) Sacc[dt][et] = Sacc[dt][et] * (g128 / g127);
            {
                bf16x8 Kt[2][2], Vt[2][4];
#define RT_RD4(bufi, s_) do { \
                _Pragma("unroll") for (int dt = 0; dt < 2; ++dt) { LAS unsigned char* a0 = lds + RT_K_OFF + (32 * (s_) + 8 * fq + li_q) * RT_KP + (d0 + 16 * dt + 4 * li_p) * 2; Kt[bufi][dt] = tr_pair(a0, a0 + 4 * RT_KP); } \
                _Pragma("unroll") for (int et = 0; et < 4; ++et) { LAS unsigned char* a0 = lds + RT_V_OFF + (32 * (s_) + 8 * fq + li_q) * RT_VP + (16 * et + 4 * li_p) * 2; Vt[bufi][et] = tr_pair(a0, a0 + 4 * RT_VP); } } while (0)
                RT_RD4(0, 0);
#pragma unroll
                for (int s = 0; s < 4; ++s) {
                    __builtin_amdgcn_sched_barrier(0);
                    if (s + 1 < 4) RT_RD4((s + 1) & 1, s + 1);
                    __builtin_amdgcn_s_setprio(1);
#pragma unroll
                    for (int dt = 0; dt < 2; ++dt)
#pragma unroll
                        for (int et = 0; et < 4; ++et) Sacc[dt][et] = __builtin_amdgcn_mfma_f32_16x16x32_bf16(Kt[s & 1][dt], Vt[s & 1][et], Sacc[dt][et], 0, 0, 0);
                    __builtin_amdgcn_s_setprio(0);
                }
                __builtin_amdgcn_sched_barrier(0);
#undef RT_RD4
            }
#pragma unroll
            for (int dt = 0; dt < 2; ++dt)
#pragma unroll
                for (int et = 0; et < 4; ++et) Sacc[dt][et] = Sacc[dt][et] * g127;
#pragma unroll
            for (int dt = 0; dt < 2; ++dt)
#pragma unroll
                for (int et = 0; et < 4; ++et) { v2u w; w.x = cvt_pk_bf16(Sacc[dt][et][0], Sacc[dt][et][1]); w.y = cvt_pk_bf16(Sacc[dt][et][2], Sacc[dt][et][3]);
                    *(LAS v2u*)(lds + RT_ST_OFF + (16 * et + fr) * RT_SP + (d0 + 16 * dt + 4 * fq) * 2) = w; }
            if (c + 1 < 17) RT_LOAD_Q(c + 1);
        }
#undef RT_LOAD_Q
#undef RT_LOAD_STAGE
        float* so = p.out + O_RETP + ((((size_t)jl * BATCH + b) * RH + h) * RDK) * RDV + 64 * es;
#pragma unroll
        for (int dt = 0; dt < 2; ++dt)
#pragma unroll
            for (int et = 0; et < 4; ++et)
#pragma unroll
                for (int r = 0; r < 4; ++r) so[(size_t)(d0 + 16 * dt + 4 * fq + r) * RDV + 16 * et + fr] = Sacc[dt][et][r];
    }
    {
        LAS float* sq = (LAS float*)lds; LAS float* sk = sq + 256; LAS float* red = sk + 256;
        const int e4 = tid & 127, dq = tid >> 7;
        for (int it = blockIdx.x; it < SB * RH; it += gridDim.x) {
            const int h = it & 3, s = it >> 2, row = MP + s;
            const float gamma = 1.0f - exp2f(-5.0f - (float)h);
            __syncthreads();
            if (tid < 256) sq[tid] = bf_lo((unsigned)QK[(size_t)row * 2048 + 256 * h + tid]);
            else sk[tid - 256] = bf_lo((unsigned)QK[(size_t)row * 2048 + 1024 + 256 * h + (tid - 256)]);
            const v2u vv = *(const v2u*)(V + (size_t)row * 2048 + 512 * h + 4 * e4);
            const f32x4 v4 = (f32x4){bf_lo(vv.x), bf_hi(vv.x), bf_lo(vv.y), bf_hi(vv.y)};
            __syncthreads();
            const float* sin_ = p.in[I_SRET] + ((((size_t)jl * SB + s) * RH + h) * RDK) * RDV + 4 * e4;
            float* sout = p.out + O_RETS + ((((size_t)jl * SB + s) * RH + h) * RDK) * RDV + 4 * e4;
            f32x4 oacc = (f32x4){0.f, 0.f, 0.f, 0.f};
#pragma unroll 8
            for (int k = 0; k < 64; ++k) { const int d = dq + 4 * k;
                const f32x4 sv = __builtin_nontemporal_load((const f32x4*)(sin_ + (size_t)d * RDV));
                const f32x4 sn = sv * gamma + v4 * sk[d];
                oacc += sn * sq[d];
                __builtin_nontemporal_store(sn, (f32x4*)(sout + (size_t)d * RDV)); }
            *(LAS f32x4*)(red + dq * 512 + 4 * e4) = oacc;
            __syncthreads();
            if (dq == 0) { const f32x4 r = (*(LAS f32x4*)(red + 4 * e4) + *(LAS f32x4*)(red + 512 + 4 * e4)) + (*(LAS f32x4*)(red + 1024 + 4 * e4) + *(LAS f32x4*)(red + 1536 + 4 * e4));
                st_bf4(O + (size_t)row * RV + 512 * h + 4 * e4, r); }
        }
    }
}

typedef float f32x2w __attribute__((ext_vector_type(2)));
constexpr int WK_TB = 32, WK_STEP_B = 6 * 256 + 16, WK_BUF_B = WK_TB * WK_STEP_B, WK_Y_OFF = 2 * WK_BUF_B, WK_YB_B = WK_TB * 32 * 4;
static_assert(WK_Y_OFF + 2 * WK_YB_B <= LDS_BYTES - 16, "wkv LDS map");
__device__ __forceinline__ float row16_sum(float x) {
    x += __builtin_bit_cast(float, __builtin_amdgcn_update_dpp(0, __builtin_bit_cast(int, x), 0x128, 0xf, 0xf, false));
    x += __builtin_bit_cast(float, __builtin_amdgcn_update_dpp(0, __builtin_bit_cast(int, x), 0x124, 0xf, 0xf, false));
    x += __builtin_bit_cast(float, __builtin_amdgcn_update_dpp(0, __builtin_bit_cast(int, x), 0x122, 0xf, 0xf, false));
    x += __builtin_bit_cast(float, __builtin_amdgcn_update_dpp(0, __builtin_bit_cast(int, x), 0x121, 0xf, 0xf, false));
    return x;
}
__device__ __forceinline__ float half8_sum(float x) {
    x += __builtin_bit_cast(float, __builtin_amdgcn_update_dpp(0, __builtin_bit_cast(int, x), 0x141, 0xf, 0xf, false));
    x += __builtin_bit_cast(float, __builtin_amdgcn_update_dpp(0, __builtin_bit_cast(int, x), 0xB1, 0xf, 0xf, false));
    x += __builtin_bit_cast(float, __builtin_amdgcn_update_dpp(0, __builtin_bit_cast(int, x), 0x4E, 0xf, 0xf, false));
    return x;
}
struct WkPar { f32x4 w0, a0, kkp, kap, v0; };
__device__ __forceinline__ f32x4 wk_unit_neg(const f32x4 kraw, const f32x4 kkp) {
    const f32x4 kk = kraw * kkp;
    const float ss = row16_sum((kk.x * kk.x + kk.y * kk.y) + (kk.z * kk.z + kk.w * kk.w));
    return kk * (-rsqrtf(fmaxf(ss, 1e-12f)));
}
__device__ __forceinline__ float wk_decay(float x) { return __expf(-0.60653065971263342f * sigmoidf_(x)); }
__device__ __forceinline__ void wk_prep(const WkPar& P, const f32x4 kraw, const f32x4 vraw, const f32x4 lw2, const f32x4 la2, const f32x4 vf, const f32x4 lv2, bool vres,
                                        f32x4& w, f32x4& ka, f32x4& km, f32x4& vp, f32x4& nk) {
    nk = wk_unit_neg(kraw, P.kkp);
    w = (f32x4){wk_decay(P.w0.x + lw2.x), wk_decay(P.w0.y + lw2.y), wk_decay(P.w0.z + lw2.z), wk_decay(P.w0.w + lw2.w)};
    const f32x4 a = (f32x4){sigmoidf_(P.a0.x + la2.x), sigmoidf_(P.a0.y + la2.y), sigmoidf_(P.a0.z + la2.z), sigmoidf_(P.a0.w + la2.w)};
    ka = nk * (-a);
    km = kraw * ((a - 1.f) * P.kap + 1.f);
    vp = vraw;
    if (vres) { const f32x4 sg = (f32x4){sigmoidf_(P.v0.x + lv2.x), sigmoidf_(P.v0.y + lv2.y), sigmoidf_(P.v0.z + lv2.z), sigmoidf_(P.v0.w + lv2.w)}; vp = vraw + (vf - vraw) * sg; }
}
constexpr int WC_C = 16, WC_NCH = TP / WC_C;
static_assert(WC_NCH * WC_C == TP, "chunking");
constexpr int REC_WA = 0, REC_RP = 2048, REC_BK = 4096, REC_VV = 8192, REC_TK = 10240, REC_MY = 10752, REC_GC = 11264, REC_BYTES = 11520;
constexpr size_t WS_REC = WS_END;
constexpr size_t WS_END2 = WS_REC + (size_t)BATCH * WH * WC_NCH * REC_BYTES;
__device__ __forceinline__ unsigned bf_rne_c(float f) { unsigned u = __float_as_uint(f); return (u + 0x7fffu + ((u >> 16) & 1u)) >> 16; }
__device__ __forceinline__ unsigned pk2_c(float lo, float hi) { return bf_rne_c(lo) | (bf_rne_c(hi) << 16); }
__device__ __forceinline__ float bf_rd(const bf16* q) { return __uint_as_float((unsigned)(*q) << 16); }
__device__ __forceinline__ bf16 bf_of(float x) { return (bf16)(cvt_pk_bf16(x, 0.f) & 0xffffu); }

__device__ __forceinline__ f32x4 mm16(const v2u a, const v2u b, const f32x4 c) { return __builtin_amdgcn_mfma_f32_16x16x16bf16_1k(__builtin_bit_cast(v4s, a), __builtin_bit_cast(v4s, b), c, 0, 0, 0); }
__device__ __forceinline__ f32x4 mm32(const v2u a0, const v2u a1, const v2u b0, const v2u b1, const f32x4 c) {
    const v4u a = (v4u){a0.x, a0.y, a1.x, a1.y}, b = (v4u){b0.x, b0.y, b1.x, b1.y};
    return __builtin_amdgcn_mfma_f32_16x16x32_bf16(__builtin_bit_cast(bf16x8, a), __builtin_bit_cast(bf16x8, b), c, 0, 0, 0);
}
template <int CTRL> __device__ __forceinline__ float dppz(float x) { return __int_as_float(__builtin_amdgcn_update_dpp(0, __float_as_int(x), CTRL, 0xf, 0xf, true)); }
__device__ __forceinline__ float psum16(float x) { x += dppz<0x111>(x); x += dppz<0x112>(x); x += dppz<0x114>(x); x += dppz<0x118>(x); return x; }
__device__ __forceinline__ v2u tr16(LAS unsigned char* a) { return __builtin_bit_cast(v2u, __builtin_amdgcn_ds_read_tr16_b64_v4i16((LAS v4s*)a)); }
__device__ __forceinline__ void ph_wkv1(const Params& p, int jl, LAS unsigned char* lds, int lane_in, int wave) {
    const bf16* Kr = (const bf16*)(p.ws + WS_K); const bf16* Vr = (const bf16*)(p.ws + (jl == 0 ? WS_VF : WS_VB)); const bf16* VFp = (const bf16*)(p.ws + WS_VF);
    const bf16* Rr = (const bf16*)(p.ws + WS_R); const bf16* L2 = (const bf16*)(p.ws + WS_L2);
    float* BON = (float*)(p.ws + WS_NKK); bf16* VP = (bf16*)(p.ws + WS_KKA);
    const bool vres = jl == 1;
    constexpr int IMG = 16 * 144;
    constexpr float CL2 = 0.60653065971263342f * 1.4426950408889634f;
    const int gw = wave * gridDim.x + blockIdx.x, NGW = gridDim.x * NWAVES;
    v4u wK[2], wLW[2], wLA[2], wR[2], wV[2], wVF[2], wLV[2];
#define W1_LOAD_RAW(jb, lnx) do { const int c_ = (jb) % WC_NCH, sh_ = (jb) / WC_NCH, r_ = (sh_ >> 4) * TP + WC_C * c_ + ((lnx) & 15), fq_ = (lnx) >> 4, cb_ = (sh_ & 15) * WN + (fq_ & 1) * 16 + (fq_ >> 1) * 8; \
        const size_t ro_ = (size_t)r_ * D + cb_, lo_ = (size_t)r_ * NL2 + cb_; \
        _Pragma("unroll") for (int P = 0; P < 2; ++P) { wK[P] = *(const v4u*)(Kr + ro_ + 32 * P); wLW[P] = *(const v4u*)(L2 + lo_ + 32 * P); wLA[P] = *(const v4u*)(L2 + lo_ + 1024 + 32 * P); \
            wR[P] = *(const v4u*)(Rr + ro_ + 32 * P); wV[P] = *(const v4u*)(Vr + ro_ + 32 * P); wVF[P] = (v4u){0u, 0u, 0u, 0u}; wLV[P] = (v4u){0u, 0u, 0u, 0u}; } \
        if (vres) { _Pragma("unroll") for (int P = 0; P < 2; ++P) { wVF[P] = *(const v4u*)(VFp + ro_ + 32 * P); wLV[P] = *(const v4u*)(L2 + lo_ + 3072 + 32 * P); } } } while (0)
#define W1_UNSWAP(QQ_, WW_) do { _Pragma("unroll") for (int P = 0; P < 2; ++P) { const v4u wv_ = WW_[P]; const auto s0_ = __builtin_amdgcn_permlane16_swap(wv_[0], wv_[2], false, false), s1_ = __builtin_amdgcn_permlane16_swap(wv_[1], wv_[3], false, false); \
        QQ_[2 * P] = (v2u){s0_[0], s1_[0]}; QQ_[2 * P + 1] = (v2u){s0_[1], s1_[1]}; } } while (0)
    if (gw < BATCH * WH * WC_NCH) { int l0 = lane_in; asm volatile("" : "+v"(l0)); W1_LOAD_RAW(gw, l0); }
    for (int job = gw; job < BATCH * WH * WC_NCH; job += NGW) {
        int ln = lane_in; asm volatile("" : "+v"(ln));
        const int lane = ln, fr = lane & 15, fq = lane >> 4;
        const int c = job % WC_NCH, sh = job / WC_NCH, h = sh & 15, seq = sh >> 4, r0 = seq * TP + WC_C * c, chb = h * WN + 4 * fq;
        LAS unsigned char* sc = lds + wave * 16384;
        unsigned char* rec = p.ws + WS_REC + (size_t)job * REC_BYTES;
        const size_t ro = (size_t)(r0 + fr) * D + chb, lo = (size_t)(r0 + fr) * NL2 + chb, po = (size_t)jl * D + chb;
        f32x4 cKK[4], cW0[4], cA0[4], cKA[4], cRK[4];
#pragma unroll
        for (int jt = 0; jt < 4; ++jt) { cKK[jt] = *(const f32x4*)(p.in[I_KK] + po + 16 * jt); cW0[jt] = *(const f32x4*)(p.in[I_W0] + po + 16 * jt); cA0[jt] = *(const f32x4*)(p.in[I_A0] + po + 16 * jt);
            cKA[jt] = *(const f32x4*)(p.in[I_KA] + po + 16 * jt); cRK[jt] = *(const f32x4*)(p.in[I_RK] + po + 16 * jt); }
#define W1_UP4(q) ((f32x4){bf_lo((q).x), bf_hi((q).x), bf_lo((q).y), bf_hi((q).y)})
        v2u qK[4], qLW[4], qLA[4], qR[4], qV[4], qVF[4], qLV[4];
        W1_UNSWAP(qK, wK); W1_UNSWAP(qLW, wLW); W1_UNSWAP(qLA, wLA); W1_UNSWAP(qR, wR); W1_UNSWAP(qV, wV); W1_UNSWAP(qVF, wVF); W1_UNSWAP(qLV, wLV);
        f32x4 kraw[4], kk[4];
        float ss = 0.f;
#pragma unroll
        for (int jt = 0; jt < 4; ++jt) { kraw[jt] = W1_UP4(qK[jt]); kk[jt] = kraw[jt] * cKK[jt];
            ss += (kk[jt].x * kk[jt].x + kk[jt].y * kk[jt].y) + (kk[jt].z * kk[jt].z + kk[jt].w * kk[jt].w); }
        ss += shfl_xor_l(ss, 16, lane); ss += shfl_xor_l(ss, 32, lane);
        const float inv = rsqrtf(fmaxf(ss, 1e-12f));
        v2u pa[4], pb[4], pk[4], pr[4], pvp[4]; f32x4 rt[4], ggv[4];
        float bonp = 0.f;
        LAS unsigned char* iw = sc + fr * 144 + 8 * fq;
#pragma unroll
        for (int jt = 0; jt < 4; ++jt) {
            const f32x4 lw2 = W1_UP4(qLW[jt]), la2 = W1_UP4(qLA[jt]), rr = W1_UP4(qR[jt]), vraw = W1_UP4(qV[jt]);
            const f32x4 pw0 = cW0[jt], pa0 = cA0[jt], pka = cKA[jt], prk = cRK[jt];
            f32x4 vp = vraw;
            if (vres) { const f32x4 vf = W1_UP4(qVF[jt]), lv2 = W1_UP4(qLV[jt]), pv0 = *(const f32x4*)(p.in[I_V0] + chb + 16 * jt);
#pragma unroll
                for (int e = 0; e < 4; ++e) vp[e] = vraw[e] + (vf[e] - vraw[e]) * sigmoidf_(pv0[e] + lv2[e]); }
            f32x4 at, bt, kt, kq, rq, gg;
#pragma unroll
            for (int e = 0; e < 4; ++e) {
                const float a = sigmoidf_(pa0[e] + la2[e]), d = CL2 * sigmoidf_(pw0[e] + lw2[e]), cum = psum16(d);
                const float g = __builtin_amdgcn_exp2f(-cum), ig = __builtin_amdgcn_exp2f(cum), gp = __builtin_amdgcn_exp2f(d - cum), nk = -kk[jt][e] * inv;
                kt[e] = kraw[jt][e] * (1.f + (a - 1.f) * pka[e]);
                bonp = fmaf(rr[e] * kt[e], prk[e], bonp);
                at[e] = nk * gp; bt[e] = -nk * a * ig; kq[e] = kt[e] * ig; rq[e] = rr[e] * g; gg[e] = g;
            }
            pa[jt] = pk4(at); pb[jt] = pk4(bt); pk[jt] = pk4(kq); pr[jt] = pk4(rq); rt[jt] = rq; pvp[jt] = pk4(vp); ggv[jt] = gg;
            *(LAS v2u*)(iw + 0 * IMG + 32 * jt) = pa[jt]; *(LAS v2u*)(iw + 1 * IMG + 32 * jt) = pb[jt]; *(LAS v2u*)(iw + 2 * IMG + 32 * jt) = pk[jt]; *(LAS v2u*)(iw + 3 * IMG + 32 * jt) = pvp[jt];
        }
#undef W1_UP4
        if (job + NGW < BATCH * WH * WC_NCH) W1_LOAD_RAW(job + NGW, lane);
        if (vres) {
#pragma unroll
            for (int P = 0; P < 2; ++P) { const auto t0 = __builtin_amdgcn_permlane16_swap(pvp[2 * P].x, pvp[2 * P + 1].x, false, false), t1 = __builtin_amdgcn_permlane16_swap(pvp[2 * P].y, pvp[2 * P + 1].y, false, false);
                *(v4u*)(VP + (size_t)(r0 + fr) * D + h * WN + (fq & 1) * 16 + (fq >> 1) * 8 + 32 * P) = (v4u){t0[0], t1[0], t0[1], t1[1]}; }
        }
#pragma unroll
        for (int jt = 0; jt < 4; ++jt) if (fr == 15) *(f32x4*)(rec + REC_GC + (16 * jt + 4 * fq) * 4) = ggv[jt];
        bonp += shfl_xor_l(bonp, 16, lane); bonp += shfl_xor_l(bonp, 32, lane);
        if (fq == 0) BON[(size_t)(r0 + fr) * WH + h] = bonp;
        const f32x4 z4 = (f32x4){0.f, 0.f, 0.f, 0.f};
        const int dd = fr - 4 * fq;
        f32x4 L = mm32(pa[2], pa[3], pb[2], pb[3], mm32(pa[0], pa[1], pb[0], pb[1], z4));
        f32x4 LT = mm32(pb[2], pb[3], pa[2], pa[3], mm32(pb[0], pb[1], pa[0], pa[1], z4));
        f32x4 Lak = mm32(pa[2], pa[3], pk[2], pk[3], mm32(pa[0], pa[1], pk[0], pk[1], z4));
        f32x4 MrbT = mm32(pb[2], pb[3], pr[2], pr[3], mm32(pb[0], pb[1], pr[0], pr[1], z4));
        f32x4 MrkT = mm32(pk[2], pk[3], pr[2], pr[3], mm32(pk[0], pk[1], pr[0], pr[1], z4));
        f32x4 TT;
#pragma unroll
        for (int r = 0; r < 4; ++r) {
            L[r] = dd < r ? L[r] : 0.f; Lak[r] = dd < r ? Lak[r] : 0.f;
            LT[r] = r < dd ? LT[r] : 0.f; MrbT[r] = r <= dd ? MrbT[r] : 0.f; MrkT[r] = r <= dd ? MrkT[r] : 0.f;
            TT[r] = LT[r] + (r == dd ? 1.f : 0.f);
        }
        const v2u bL = pk4(L), bLT = pk4(LT), bLak = pk4(Lak);
        const f32x4 L2m = mm16(bLT, bL, z4), L2T = mm16(bL, bLT, z4);
        const v2u bL2 = pk4(L2m), bL2T = pk4(L2T);
        const f32x4 L4m = mm16(bL2T, bL2, z4), L4T = mm16(bL2, bL2T, z4);
        const v2u bL4 = pk4(L4m), bL4T = pk4(L4T);
        const v2u bL8 = pk4(mm16(bL4T, bL4, z4));
        TT = mm16(bL2, pk4(TT), TT); TT = mm16(bL4, pk4(TT), TT); TT = mm16(bL8, pk4(TT), TT);
        f32x4 Zm = mm16(bL, pk4(MrbT), MrbT); Zm = mm16(bL2, pk4(Zm), Zm); Zm = mm16(bL4, pk4(Zm), Zm); Zm = mm16(bL8, pk4(Zm), Zm);
        const v2u bTT = pk4(TT), bMtT = pk4(Zm);
        *(v2u*)(rec + REC_TK + lane * 8) = pk4(mm16(bLak, bTT, z4)); *(v2u*)(rec + REC_MY + lane * 8) = pk4(mm16(bLak, bMtT, MrkT));
        LAS unsigned char* ir = sc + (4 * fq + ((lane & 15) >> 2)) * 144 + 8 * (lane & 3);
        v2u wat[4], rpt[4];
#pragma unroll
        for (int jt = 0; jt < 4; ++jt) {
            const v2u Qa = tr16(ir + 0 * IMG + 32 * jt), Qb = tr16(ir + 1 * IMG + 32 * jt), Qk = tr16(ir + 2 * IMG + 32 * jt);
            wat[jt] = pk4(mm16(Qa, bTT, z4)); rpt[jt] = pk4(mm16(Qa, bMtT, rt[jt]));
            *(v4u*)(rec + REC_BK + (jt * 64 + lane) * 16) = (v4u){Qb.x, Qb.y, Qk.x, Qk.y};
        }
#pragma unroll
        for (int s = 0; s < 2; ++s) {
            *(v4u*)(rec + REC_WA + (s * 64 + lane) * 16) = (v4u){wat[2 * s].x, wat[2 * s].y, wat[2 * s + 1].x, wat[2 * s + 1].y};
            *(v4u*)(rec + REC_RP + (s * 64 + lane) * 16) = (v4u){rpt[2 * s].x, rpt[2 * s].y, rpt[2 * s + 1].x, rpt[2 * s + 1].y};
        }
#pragma unroll
        for (int it = 0; it < 4; ++it) {
            const v2u Qv = tr16(ir + 3 * IMG + 32 * it);
            *(v2u*)(rec + REC_VV + (it * 64 + lane) * 8) = Qv;

        }
    }
}

#undef W1_LOAD_RAW
#undef W1_UNSWAP
__device__ __forceinline__ void ph_wkv2(const Params& p, int jl, int lane, int wave) {
    const bf16* Kr = (const bf16*)(p.ws + WS_K); const bf16* Vr = (const bf16*)(p.ws + (jl == 0 ? WS_VF : WS_VB)); const bf16* VFp = (const bf16*)(p.ws + WS_VF);
    const bf16* Rr = (const bf16*)(p.ws + WS_R); const bf16* L2 = (const bf16*)(p.ws + WS_L2);
    float* BON = (float*)(p.ws + WS_NKK); bf16* VP = (bf16*)(p.ws + WS_KKA);
    const bool vres = jl == 1; const int ri = lane >> 4, cg = lane & 15;
    bf16* YW = (bf16*)(p.ws + WS_YW);
    const int fr = lane & 15, fq = lane >> 4;
    const int gw = blockIdx.x * NWAVES + wave, NGW = gridDim.x * NWAVES;
    for (int job = wave < 2 ? blockIdx.x * 2 + wave : BATCH * WH * 4; job < BATCH * WH * 4; job += gridDim.x * 2) {
        const int it = job & 3, h = (job >> 2) & 15, seq = job >> 6, r0 = seq * TP;
        const unsigned char* rec = p.ws + WS_REC + (size_t)((seq * WH + h) * WC_NCH) * REC_BYTES;
        f32x4 Sacc[4];
#pragma unroll
        for (int jt = 0; jt < 4; ++jt) Sacc[jt] = (f32x4){0.f, 0.f, 0.f, 0.f};
        v4u wa[2], rp[2], bk[4]; v2u vvf, tk, my; f32x4 gc[4];
#define WC_LOAD(rc) do { const unsigned char* r_ = (rc); \
            wa[0] = *(const v4u*)(r_ + REC_WA + lane * 16); wa[1] = *(const v4u*)(r_ + REC_WA + 1024 + lane * 16); rp[0] = *(const v4u*)(r_ + REC_RP + lane * 16); rp[1] = *(const v4u*)(r_ + REC_RP + 1024 + lane * 16); \
            _Pragma("unroll") for (int jt_ = 0; jt_ < 4; ++jt_) { bk[jt_] = *(const v4u*)(r_ + REC_BK + (jt_ * 64 + lane) * 16); gc[jt_] = *(const f32x4*)(r_ + REC_GC + (16 * jt_ + 4 * fq) * 4); } \
            vvf = *(const v2u*)(r_ + REC_VV + (it * 64 + lane) * 8); tk = *(const v2u*)(r_ + REC_TK + lane * 8); my = *(const v2u*)(r_ + REC_MY + lane * 8); } while (0)
        WC_LOAD(rec);
        v2u ypk = (v2u){0u, 0u};
        for (int c = 0; c < WC_NCH; ++c) {
            const v4u cwa0 = wa[0], cwa1 = wa[1], crp0 = rp[0], crp1 = rp[1], cbk0 = bk[0], cbk1 = bk[1], cbk2 = bk[2], cbk3 = bk[3]; const v2u cvv = vvf; const f32x4 zz4 = (f32x4){0.f, 0.f, 0.f, 0.f}, cu0 = mm16(tk, vvf, zz4) + 0.f, cy0 = mm16(my, vvf, zz4) + 0.f  , cg0 = gc[0], cg1 = gc[1], cg2 = gc[2], cg3 = gc[3];
            if (c > 0) *(v2u*)(YW + (size_t)(r0 + WC_C * (c - 1) + 4 * fq + (fr & 3)) * D + h * WN + 16 * it + (fr & 12)) = ypk;
            if (c + 1 < WC_NCH) WC_LOAD(rec + (size_t)(c + 1) * REC_BYTES);
            v4u sb0, sb1;
            { const v2u q0 = pk4(Sacc[0]), q1 = pk4(Sacc[1]), q2 = pk4(Sacc[2]), q3 = pk4(Sacc[3]); sb0 = (v4u){q0.x, q0.y, q1.x, q1.y}; sb1 = (v4u){q2.x, q2.y, q3.x, q3.y}; }
            const bf16x8 B0 = __builtin_bit_cast(bf16x8, sb0), B1 = __builtin_bit_cast(bf16x8, sb1);
            f32x4 U = __builtin_amdgcn_mfma_f32_16x16x32_bf16(__builtin_bit_cast(bf16x8, cwa0), B0, cu0, 0, 0, 0);
            U = __builtin_amdgcn_mfma_f32_16x16x32_bf16(__builtin_bit_cast(bf16x8, cwa1), B1, U, 0, 0, 0);
            f32x4 Y = __builtin_amdgcn_mfma_f32_16x16x32_bf16(__builtin_bit_cast(bf16x8, crp0), B0, cy0, 0, 0, 0);
            Y = __builtin_amdgcn_mfma_f32_16x16x32_bf16(__builtin_bit_cast(bf16x8, crp1), B1, Y, 0, 0, 0);
            v4u ub; { const v2u qu = pk4(U); ub.x = qu.x; ub.y = qu.y; } ub.z = cvv.x; ub.w = cvv.y;
            const bf16x8 UB = __builtin_bit_cast(bf16x8, ub);
            Sacc[0] = __builtin_amdgcn_mfma_f32_16x16x32_bf16(__builtin_bit_cast(bf16x8, cbk0), UB, Sacc[0], 0, 0, 0) * cg0;
            Sacc[1] = __builtin_amdgcn_mfma_f32_16x16x32_bf16(__builtin_bit_cast(bf16x8, cbk1), UB, Sacc[1], 0, 0, 0) * cg1;
            Sacc[2] = __builtin_amdgcn_mfma_f32_16x16x32_bf16(__builtin_bit_cast(bf16x8, cbk2), UB, Sacc[2], 0, 0, 0) * cg2;
            Sacc[3] = __builtin_amdgcn_mfma_f32_16x16x32_bf16(__builtin_bit_cast(bf16x8, cbk3), UB, Sacc[3], 0, 0, 0) * cg3;
            { float yq[4] = {Y[0], Y[1], Y[2], Y[3]}; quad_transpose4(yq, fr & 3); ypk = pk4((f32x4){yq[0], yq[1], yq[2], yq[3]}); }
        }
        *(v2u*)(YW + (size_t)(r0 + WC_C * (WC_NCH - 1) + 4 * fq + (fr & 3)) * D + h * WN + 16 * it + (fr & 12)) = ypk;
#undef WC_LOAD
        float* so = p.out + O_WKVP + ((((size_t)jl * BATCH + seq) * WH + h) * WN + 16 * it + fr) * WN + 4 * fq;
#pragma unroll
        for (int jt = 0; jt < 4; ++jt) *(f32x4*)(so + 16 * jt) = Sacc[jt];
    }
    if (wave >= 2) {
        const int gws = blockIdx.x * (NWAVES - 2) + (wave - 2), NGWS = gridDim.x * (NWAVES - 2);
        constexpr int UB = 4;
        for (int it0 = gws; it0 < SB * WH * 16; it0 += NGWS * UB) {
            v2u qk[UB], qv[UB], qr[UB], qlw[UB], qla[UB], qvf[UB], qlv[UB]; f32x4 qS[UB];
#pragma unroll
            for (int q = 0; q < UB; ++q) { const int it_ = it0 + q * NGWS, itc = it_ < SB * WH * 16 ? it_ : it0;
                const int rg = itc & 15, h = (itc >> 4) & 15, s = itc >> 8, row = MP + s, i = 4 * rg + ri, ch = h * WN + 4 * cg;
                const size_t vo = (size_t)row * D + ch, lo = (size_t)row * NL2 + ch;
                qk[q] = *(const v2u*)(Kr + vo); qv[q] = *(const v2u*)(Vr + vo); qr[q] = *(const v2u*)(Rr + vo); qlw[q] = *(const v2u*)(L2 + lo); qla[q] = *(const v2u*)(L2 + lo + 1024);
                qvf[q] = (v2u){0u, 0u}; qlv[q] = (v2u){0u, 0u};
                if (vres) { qvf[q] = *(const v2u*)(VFp + vo); qlv[q] = *(const v2u*)(L2 + lo + 3072); }
                qS[q] = *(const f32x4*)(p.in[I_SWKV] + ((((size_t)jl * SB + s) * WH + h) * WN + i) * WN + 4 * cg); }
#pragma unroll
            for (int q = 0; q < UB; ++q) { const int it = it0 + q * NGWS; if (it < SB * WH * 16) {
                const int rg = it & 15, h = (it >> 4) & 15, s = it >> 8, row = MP + s, i = 4 * rg + ri;
                const int ch = h * WN + 4 * cg;
                WkPar P; P.w0 = *(const f32x4*)(p.in[I_W0] + (size_t)jl * D + ch); P.a0 = *(const f32x4*)(p.in[I_A0] + (size_t)jl * D + ch); P.kkp = *(const f32x4*)(p.in[I_KK] + (size_t)jl * D + ch);
                P.kap = *(const f32x4*)(p.in[I_KA] + (size_t)jl * D + ch); P.v0 = *(const f32x4*)(p.in[I_V0] + ch);
                const size_t vo = (size_t)row * D + ch;
#define W2_UP4(w) ((f32x4){bf_lo((w).x), bf_hi((w).x), bf_lo((w).y), bf_hi((w).y)})
                const f32x4 kraw = W2_UP4(qk[q]), vraw = W2_UP4(qv[q]), r4 = W2_UP4(qr[q]), lw2 = W2_UP4(qlw[q]), la2 = W2_UP4(qla[q]), vf = W2_UP4(qvf[q]), lv2 = W2_UP4(qlv[q]);
#undef W2_UP4
                f32x4 w4, ka, k4, vp, nk; wk_prep(P, kraw, vraw, lw2, la2, vf, lv2, vres, w4, ka, k4, vp, nk);
                const int srcl = (lane & 48) | rg;
                const float v0_ = shfl_l(vp.x, srcl), v1_ = shfl_l(vp.y, srcl), v2_ = shfl_l(vp.z, srcl), v3_ = shfl_l(vp.w, srcl);
                const float vi = ri == 0 ? v0_ : (ri == 1 ? v1_ : (ri == 2 ? v2_ : v3_));
                const size_t so = ((((size_t)jl * SB + s) * WH + h) * WN + i) * WN + 4 * cg;
                f32x4 S = qS[q];
                const float sa = row16_sum((S.x * nk.x + S.y * nk.y) + (S.z * nk.z + S.w * nk.w));
                S.x = fmaf(S.x, w4.x, fmaf(sa, ka.x, vi * k4.x)); S.y = fmaf(S.y, w4.y, fmaf(sa, ka.y, vi * k4.y));
                S.z = fmaf(S.z, w4.z, fmaf(sa, ka.z, vi * k4.z)); S.w = fmaf(S.w, w4.w, fmaf(sa, ka.w, vi * k4.w));
                const float y = row16_sum((S.x * r4.x + S.y * r4.y) + (S.z * r4.z + S.w * r4.w));
                *(f32x4*)(p.out + O_WKVS + so) = S;
                if (cg == 0) YW[(size_t)row * D + h * WN + i] = bf_cv(y);
                const f32x4 rk4 = *(const f32x4*)(p.in[I_RK] + (size_t)jl * D + ch);
                const float bon = row16_sum((r4.x * k4.x * rk4.x + r4.y * k4.y * rk4.y) + (r4.z * k4.z * rk4.z + r4.w * k4.w * rk4.w));
                if (rg == 0 && ri == 0) { if (vres) st_bf4(VP + vo, vp); if (cg == 0) BON[(size_t)row * WH + h] = bon; }
            } }
        }
    }
}

typedef __attribute__((address_space(1))) unsigned gu32;
#define XB_TMO      128
#define XB_XCNT(j)  (256  + 64 * (j))
#define XB_XSUB(j)  (1280 + 64 * (j))
#define XB_XGEN(j)  (2304 + 64 * (j))
#define XB_TOP      3328
#define XB_TOPGEN   3392
#define XCD_BAR_WORDS 3456
#define XB_SPIN_CAP (1u << 18)

__device__ __forceinline__ unsigned xb_ld(unsigned* p)              { return __hip_atomic_load(p, __ATOMIC_RELAXED, __HIP_MEMORY_SCOPE_AGENT); }
__device__ __forceinline__ unsigned xb_add(unsigned* p, unsigned v) { return __hip_atomic_fetch_add(p, v, __ATOMIC_RELAXED, __HIP_MEMORY_SCOPE_AGENT); }
__device__ __forceinline__ unsigned xb_xcc_id() { return (unsigned)__builtin_amdgcn_s_getreg((3 << 11) | 20) & 0xFu; }
#define XB_SPIN(cond, bar) do { unsigned _sp = 0; while (cond) { __builtin_amdgcn_s_sleep(1); \
    if ((++_sp & 255u) == 0u) { if (xb_ld(&(bar)[XB_TMO])) break; if (_sp > XB_SPIN_CAP) { atomicAdd(&(bar)[XB_TMO], 1u); break; } } } } while (0)

struct XcdBarrier {
    bool tid0; unsigned* bar; unsigned x;
    volatile LAS unsigned* st;
};

__device__ __forceinline__ XcdBarrier xcd_barrier_post(unsigned* bar, volatile LAS unsigned* st, bool tid0) {
    XcdBarrier b; b.tid0 = tid0; b.bar = bar; b.x = xb_xcc_id(); b.st = st;
    if (b.tid0) (void)xb_add(&bar[XB_XCNT(b.x)], 1u);
    return b;
}
__device__ __forceinline__ void xcd_barrier_complete(unsigned* bar, unsigned x, unsigned& nloc, unsigned& nx) {
    const unsigned G = gridDim.x * gridDim.y * gridDim.z;
    unsigned sum, cnt, mine, sp = 0u;
    for (;;) {
        sum = 0u; cnt = 0u; mine = 0u;
#pragma unroll
        for (unsigned j = 0; j < 16; ++j) { const unsigned c = xb_ld(&bar[XB_XCNT(j)]); sum += c; cnt += (c > 0u) ? 1u : 0u; mine = (j == x) ? c : mine; }
        if (sum == G) break;
        __builtin_amdgcn_s_sleep(1);
        if ((++sp & 255u) == 0u) { if (xb_ld(&bar[XB_TMO])) break; if (sp > XB_SPIN_CAP) { atomicAdd(&bar[XB_TMO], 1u); break; } }
    }
    nloc = mine > 0u ? mine : 1u; nx = cnt > 0u ? cnt : 1u;
}

__device__ __forceinline__ void xcd_barrier(const XcdBarrier& b) {
    asm volatile("s_waitcnt vmcnt(0)" ::: "memory");
    __syncthreads();
    if (b.tid0) {
        unsigned* bar = b.bar;
        __builtin_amdgcn_s_waitcnt(0);
        unsigned nloc = b.st[0], nx = b.st[1];
        if (nloc == 0u) { xcd_barrier_complete(bar, b.x, nloc, nx); b.st[0] = nloc; b.st[1] = nx; }
        const unsigned old = xb_add(&bar[XB_XSUB(b.x)], 1u);
        const unsigned gen = old / nloc;
        if (old + 1u == (gen + 1u) * nloc) {
            __builtin_amdgcn_fence(__ATOMIC_RELEASE, "agent");
            asm volatile("s_waitcnt vmcnt(0)" ::: "memory");
            const unsigned og = xb_add(&bar[XB_TOP], 1u);
            const unsigned tg = og / nx;
            if (og + 1u == (tg + 1u) * nx) xb_add(&bar[XB_TOPGEN], 1u);
            else XB_SPIN(xb_ld(&bar[XB_TOPGEN]) == tg, bar);
            __builtin_amdgcn_fence(__ATOMIC_ACQUIRE, "agent");
            xb_add(&bar[XB_XGEN(b.x)], 1u);
            asm volatile("s_waitcnt vmcnt(0)" ::: "memory");
        } else {
            XB_SPIN(xb_ld(&bar[XB_XGEN(b.x)]) == gen, bar);
            __builtin_amdgcn_fence(__ATOMIC_ACQUIRE, "agent");
            asm volatile("s_waitcnt vmcnt(0)" ::: "memory");
        }
    }
    __syncthreads();
}

enum { OP_P0 = 0, OP_NORM_RET, OP_G_RETIN, OP_RET, OP_RETNORM, OP_G_RETOUT, OP_NORM_RW, OP_G_RWPROJ, OP_G_LORA2, OP_PREP, OP_WKV, OP_WKV2, OP_POST, OP_G_WO,
       OP_NORM_FFN, OP_G_UG, OP_CONV, OP_G_WD, OP_FINAL };
struct Ph { unsigned char op, layer; };
constexpr int NPH = 1 + 2 * 6 + 2 * 9 + 1;
__device__ __host__ inline Ph phase_at(int i) {
    if (i == 0) return Ph{OP_P0, 0};
    i -= 1;
    int l;
    if (i < 6) l = 0; else if (i < 15) { l = 1; i -= 6; } else if (i < 21) { l = 2; i -= 15; } else if (i < 30) { l = 3; i -= 21; } else return Ph{OP_FINAL, 0};
    int op = OP_FINAL;
    if ((l & 1) == 0) {
        switch (i) { case 0: op = OP_G_RETIN; break; case 1: op = OP_RET; break; case 2: op = OP_RETNORM; break; case 3: op = OP_G_RETOUT; break;
                     case 4: op = OP_G_UG; break; default: op = OP_G_WD; break; }
    } else {
        switch (i) { case 0: op = OP_NORM_RW; break; case 1: op = OP_G_RWPROJ; break; case 2: op = OP_G_LORA2; break; case 3: op = OP_WKV; break; case 4: op = OP_WKV2; break; case 5: op = OP_POST; break; case 6: op = OP_G_WO; break;
                     case 7: op = OP_G_UG; break; default: op = OP_G_WD; break; }
    }
    return Ph{(unsigned char)op, (unsigned char)l};
}

__global__ void __launch_bounds__(NTHR, 2) mega(Params p, int lo, int hi) {
    extern __shared__ __attribute__((aligned(16))) unsigned char lds_raw[];
    LAS unsigned char* lds = (LAS unsigned char*)lds_raw;
    volatile LAS unsigned* bst = (volatile LAS unsigned*)(lds + LDS_BYTES - 16);
    const int wave0 = __builtin_amdgcn_readfirstlane((int)threadIdx.x >> 6);
    if (threadIdx.x < 4) bst[threadIdx.x] = 0u;
    __syncthreads();
    (void)xcd_barrier_post((unsigned*)(p.ws + WS_CTL), bst, threadIdx.x == 0);
    for (int ph = lo; ph < hi; ++ph) {
        int lid_; asm volatile("v_mbcnt_lo_u32_b32 %0, -1, 0\n\tv_mbcnt_hi_u32_b32 %0, -1, %0" : "=v"(lid_));
        int tid = wave0 * 64 + lid_; asm volatile("" : "+v"(tid));
        const int lane = tid & 63, wave = __builtin_amdgcn_readfirstlane(tid >> 6);
        unsigned char* ws = p.ws;
        const Ph P = phase_at(ph);
        const int li = P.layer, jl = li >> 1;
        const bf16* gA = nullptr; const bf16* gB = nullptr; int gN = 0, gK = 0; EpiAnyT<0> E{}; E.jl = jl; E.ws = ws; E.slot = -1; E.amul = 1.f; E.li = li; E.ldsb = lds; bool is_gemm = false;
        switch (P.op) {
        case OP_P0: ph_p0(p, lds, tid, lane, wave); break;
        case OP_NORM_RET: ph_norm(p, p.in[I_NMIX] + (size_t)li * D, 0, jl, lane, wave); break;
        case OP_NORM_FFN: ph_norm(p, p.in[I_NFFN] + (size_t)li * D, 0, jl, lane, wave); break;
        case OP_NORM_RW: ph_norm(p, p.in[I_NMIX] + (size_t)li * D, 1, jl, lane, wave); break;
        case OP_FINAL: ph_norm(p, p.in[I_NFIN], 2, 0, lane, wave); break;
        case OP_RETNORM: ph_ret_norm(p, jl, lane, wave); break;
        case OP_POST: ph_rwkv_post(p, jl, lane, wave); break;
        case OP_RET: ph_ret_fast(p, jl, lds, tid, lane, wave); break;
        case OP_WKV: ph_wkv1(p, jl, lds, lane, wave); break;
        case OP_WKV2: ph_wkv2(p, jl, lane, wave); break;
        case OP_G_RETIN: is_gemm = true; E.kind = EK_RETIN; E.perm = true; E.slot = 2 * li;
            gA = (const bf16*)(ws + WS_XB); gB = (const bf16*)(ws + WS_WIN + jl * SZ_WIN); gN = RWIN; gK = D; break;
        case OP_G_RETOUT: is_gemm = true; E.kind = EK_RESID; E.perm = false; E.slot = 2 * li + 1;
            gA = (const bf16*)(ws + WS_Y); gB = (const bf16*)(ws + WS_WOUT + jl * SZ_WOUT); gN = D; gK = RV; break;
        case OP_G_RWPROJ: is_gemm = true; E.kind = EK_RWPROJ; E.perm = true;
            gA = (const bf16*)(ws + WS_H) + D; gB = (const bf16*)(ws + WS_WRW + jl * SZ_WRW); gN = NRW; gK = KRW; break;
        case OP_G_LORA2: is_gemm = true; E.kind = EK_F32; E.perm = true;
            gA = (const bf16*)(ws + WS_A2); gB = (const bf16*)(ws + WS_WL2 + jl * SZ_WL2); gN = (jl == 0 ? 3072 : 4096); gK = KL2; break;
        case OP_G_WO: is_gemm = true; E.kind = EK_RESID; E.perm = false; E.slot = 2 * li + 1;
            gA = (const bf16*)(ws + WS_Z); gB = (const bf16*)(ws + WS_WO + jl * SZ_WO); gN = D; gK = D; break;
        case OP_G_UG: is_gemm = true; E.kind = EK_UG; E.perm = true; E.slot = 2 * li + 1;
            gA = (const bf16*)(ws + WS_XB); gB = (const bf16*)(ws + WS_WUG + li * SZ_WUG); gN = 2 * DFF; gK = D; break;
        case OP_G_WD: is_gemm = true; E.kind = EK_RESID; E.perm = false; E.slot = (li == 1) ? 2 * (li + 1) : -1;
            gA = (const bf16*)(ws + WS_ACT); gB = (const bf16*)(ws + WS_WD + li * SZ_WD); gN = D; gK = DFF; break;
        default: break;
        }
        if (is_gemm) {
            const bool ug = E.kind == EK_UG;
            const bool rwp = E.kind == EK_RWPROJ;
            const int gM = (E.kind == EK_RESID) ? MT0 : (ug ? 66 * 256 : (rwp ? HP_M : M));
            pg8::Gemm g{ug ? gA - 2 * D : gA, gB, gM, gN, gK, ug ? 254 : 256};
            if (E.kind == EK_F32) { g.kshift = 2; g.ktab = (0u | 2u << 4) | (0u | 2u << 4) << 8 | (2u | 4u << 4) << 16 | (4u | 2u << 4) << 24; }
            if (rwp) { g.lda = D; g.ksplit = D / pg8::BK; g.kdelta = -(long)(D * 2) - (long)(D * 2); }
            pg8::StaticOrder S; S.init(gM, gN, (int)gridDim.x, (int)blockIdx.x);
            if (E.kind == EK_RETIN || E.kind == EK_UG) {
                LAS float* rt = (LAS float*)(lds + 131072);
                Unit uu;
                for (int ui = 0; ui < 8 && S.next(ui, uu); ++ui) if (tid < 256) { int rr = ug ? 254 * uu.pm - 2 + tid : uu.pm * 256 + tid; rr = rr < 0 ? 0 : (rr > M - 1 ? M - 1 : rr); rt[ui * 256 + tid] = row_rstd(ws, E.slot, rr); }
                E.rtab = rt; E.ldsb = lds;
                __syncthreads();
            }
            if (ug) { EpiAnyT<1> E1{}; E1.kind = E.kind; E1.perm = E.perm; E1.jl = E.jl; E1.ws = E.ws; E1.slot = E.slot; E1.rtab = E.rtab; E1.amul = E.amul; E1.li = E.li; E1.ldsb = E.ldsb; E1.pcw = p.in[I_CW]; E1.pcb = p.in[I_CB]; E1.pcst = p.in[I_SCONV]; E1.pout = p.out;
                pg8::gemm_phase<EpiAnyT<1>, pg8::StaticOrder, true, true>(lds, g, S, E1, tid); }
            else pg8::gemm_phase<EpiAnyT<0>, pg8::StaticOrder, true, true>(lds, g, S, E, tid);
            if (E.kind == EK_RESID) tail_resid(gA, gB, gK, ws, E.slot, E.amul, lds, lane, wave);
        }
        if (ph + 1 < hi) { XcdBarrier bar; bar.tid0 = tid == 0; bar.bar = (unsigned*)(p.ws + WS_CTL); bar.x = xb_xcc_id(); bar.st = (volatile LAS unsigned*)(lds + LDS_BYTES - 16); xcd_barrier(bar); }
    }
}

}

extern "C" void kernel_launch(void* const* d_in, const int* in_sizes, int n_in, void* d_out, int out_size, void* d_ws, size_t ws_size, hipStream_t stream) {
    static int grid = 0;
    if (grid == 0) {
        int dev = 0, cus = 0;
        if (n_in != N_IN || ws_size < WS_END2) { fprintf(stderr, "kernel_launch: unexpected n_in %d / ws_size %zu (need %zu)\n", n_in, ws_size, (size_t)WS_END2); grid = -1; return; }
        if (hipGetDevice(&dev) != hipSuccess || hipDeviceGetAttribute(&cus, hipDeviceAttributeMultiprocessorCount, dev) != hipSuccess) { grid = -1; return; }
        if (hipFuncSetAttribute((const void*)mega, hipFuncAttributeMaxDynamicSharedMemorySize, LDS_BYTES) != hipSuccess) { fprintf(stderr, "kernel_launch: hipFuncSetAttribute failed\n"); grid = -1; return; }
        int per_cu = 0;
        if (hipOccupancyMaxActiveBlocksPerMultiprocessor(&per_cu, (const void*)mega, NTHR, LDS_BYTES) != hipSuccess || per_cu < 1) { fprintf(stderr, "kernel_launch: occupancy query says %d\n", per_cu); (void)hipGetLastError(); }
        grid = cus * (per_cu >= 1 ? 1 : 1);
    }
    if (grid < 0) return;
    Params p{};
    for (int i = 0; i < N_IN; ++i) p.in[i] = (const float*)d_in[i];
    p.out = (float*)d_out; p.ws = (unsigned char*)d_ws;
    if (hipMemsetAsync(d_ws, 0, 65536, stream) != hipSuccess) { fprintf(stderr, "kernel_launch: memset failed\n"); return; }
    int lo = 0, hi = NPH;
    void* args[] = {(void*)&p, (void*)&lo, (void*)&hi};
    const hipError_t e = hipLaunchCooperativeKernel((const void*)mega, dim3(grid), dim3(NTHR), args, LDS_BYTES, stream);
    if (e != hipSuccess) fprintf(stderr, "kernel_launch: cooperative launch failed: %s (grid %d)\n", hipGetErrorString(e), grid);
    (void)in_sizes; (void)out_size;
}
```

```cpp
#include <hip/hip_runtime.h>
#include <hip/hip_cooperative_groups.h>
#include <cstdio>
#include <stdint.h>
namespace cg = cooperative_groups;
namespace pg8 {
#define PG8_LAS __attribute__((address_space(3)))
typedef unsigned short bf16_t;
typedef short bf16x8 __attribute__((ext_vector_type(8)));
typedef float f32x4 __attribute__((ext_vector_type(4)));
typedef unsigned u32x4 __attribute__((ext_vector_type(4)));
constexpr int BM = 256, BK = 64, HALF = 128, HTB = HALF * BK * 2  , STAGE_BYTES = 8 * HTB, NXCD = 8, WGM = 4;

__host__ __device__ __forceinline__ int lds_byte(int r, int c) { const int st = (r >> 4) * 2 + (c >> 5), rr = r & 15, cc = c & 31, ob = rr * 64 + cc * 2; return st * 1024 + (ob ^ (((ob >> 9) & 1) << 5)); }
__host__ __device__ __forceinline__ void stage_rc(int b, int& R, int& C) { const int st = b / 1024, sb = b % 1024, swz = sb ^ (((sb >> 9) & 1) << 5); R = (st >> 1) * 16 + swz / 64; C = (st & 1) * 32 + (swz % 64) / 2; }
__host__ __device__ __forceinline__ int perm32(int rho) { const int n = rho >> 4, i = rho & 15; return 8 * (i >> 2) + 4 * n + (i & 3); }

struct Unit { int pm, pn, ord; };
struct Gemm { const bf16_t* A; const bf16_t* Bt; int M, N, K, trows; int lda = 0, ksplit = 1 << 30; long kdelta = 0; unsigned ktab = 0; int kshift = 0; };

struct StaticOrder {
    int nM, nN, nwg, G, c;
    __host__ __device__ void init(int M, int N, int G_, int c_) { nM = M / BM; nN = N / BM; nwg = nM * nN; G = G_; c = c_; }
    __host__ __device__ __forceinline__ bool next(int i, Unit& u) const {
        const long L = (long)i * G + c; if (L >= nwg) return false;
        int wgid = (int)L; { const int q = nwg / NXCD, r = nwg % NXCD, xcd = wgid % NXCD, off = wgid / NXCD; wgid = (xcd < r ? xcd * (q + 1) : r * (q + 1) + (xcd - r) * q) + off; }
        const int nig = WGM * nN, gid = wgid / nig, fm = gid * WGM, gsz = (nM - fm) < WGM ? (nM - fm) : WGM;
        u.pm = fm + ((wgid % nig) % gsz); u.pn = (wgid % nig) / gsz; u.ord = i; return true;
    }
    __device__ __forceinline__ void a_ready(const Unit&) const {}
    __device__ __forceinline__ void done(const Unit&) const {}
};
template <class Epi, class Sched, bool ALIGN_EPI = false, bool SP2 = false>
__device__ __forceinline__ void gemm_phase(PG8_LAS unsigned char* lds, const Gemm g, const Sched& S, const Epi& E, int tid_in) {
    int tid = tid_in; asm volatile("" : "+v"(tid));
    const int wid = __builtin_amdgcn_readfirstlane(tid >> 6), lane = tid & 63, wr = wid >> 2, wc = wid & 3, fr = lane & 15, fq = lane >> 4;
    const int K = g.K, nt = K / BK, lda = g.lda ? g.lda : K;
    unsigned voffA[2], voffB[2];
#pragma unroll
    for (int i = 0; i < 2; ++i) { int R, C; stage_rc(tid * 16 + i * 8192, R, C); const int Rb = E.perm ? ((R & ~31) + perm32(R & 31)) : R;
        voffA[i] = (unsigned)(R * lda + C) * 2u; voffB[i] = (unsigned)(Rb * K + C) * 2u; }
    const size_t kstep = (size_t)(BK * 2);
    const size_t hstep = (size_t)HALF * K * 2, hstepA = (size_t)HALF * lda * 2;
    const int ksplit = g.ksplit; const long kdelta = g.kdelta;
#define PG8_KA(base, kt) ((base) + (size_t)(kt) * kstep + ((kt) >= ksplit ? kdelta : 0l))
    const size_t tstep = 2 * hstep; const size_t tstepA = (size_t)g.trows * lda * 2;
    const unsigned ldsw = (unsigned)wid * 1024u;
    const int aoff = lds_byte(wr * 64 + fr, fq * 8), boff = lds_byte(wc * 32 + fr, fq * 8);
#define PG8_SA(b, h) (((b) * 2 + (h)) * HTB)
#define PG8_SB(b, h) ((4 + (b) * 2 + (h)) * HTB)
#define PG8_STAGE(bufoff, gbase, voff) do { _Pragma("unroll") for (int _i = 0; _i < 2; ++_i) \
        __builtin_amdgcn_global_load_lds((const unsigned*)((const char*)(gbase) + (voff)[_i]), (PG8_LAS unsigned*)(lds + (bufoff) + ldsw + _i * 8192), 16, 0, 0); } while (0)
#define PG8_LDA(dst, b, h) do { _Pragma("unroll") for (int m = 0; m < 4; ++m) _Pragma("unroll") for (int k = 0; k < 2; ++k) dst[m][k] = *(const PG8_LAS bf16x8*)(lds + PG8_SA(b, h) + aoff + m * 2048 + k * 1024); } while (0)
#define PG8_LDB(dst, b, h) do { _Pragma("unroll") for (int n = 0; n < 2; ++n) _Pragma("unroll") for (int k = 0; k < 2; ++k) dst[n][k] = *(const PG8_LAS bf16x8*)(lds + PG8_SB(b, h) + boff + n * 2048 + k * 1024); } while (0)
#define PG8_MMA(ai, bj, At, Bt) do { __builtin_amdgcn_s_setprio(1); _Pragma("unroll") for (int m = 0; m < 4; ++m) _Pragma("unroll") for (int n = 0; n < 2; ++n) _Pragma("unroll") for (int k = 0; k < 2; ++k) \
        acc[ai][bj][m][n] = __builtin_amdgcn_mfma_f32_16x16x32_bf16(Bt[n][k], At[m][k], acc[ai][bj][m][n], 0, 0, 0); __builtin_amdgcn_s_setprio(0); } while (0)
#define PG8_WAIT_V(n) asm volatile("s_waitcnt vmcnt(" #n ")" ::: "memory")
#define PG8_WAIT_L(n) asm volatile("s_waitcnt lgkmcnt(" #n ")" ::: "memory")
#define PG8_BAR __builtin_amdgcn_s_barrier()
#define PG8_SCHED __builtin_amdgcn_sched_barrier(0)
    Unit cur, nxt; int ui = 0;
    if (!S.next(0, cur)) return;
    f32x4 acc[2][2][4][2];
#pragma unroll
    for (int a = 0; a < 2; ++a)
#pragma unroll
        for (int b = 0; b < 2; ++b)
#pragma unroll
            for (int m = 0; m < 4; ++m)
#pragma unroll
                for (int n = 0; n < 2; ++n) acc[a][b][m][n] = (f32x4){0.f, 0.f, 0.f, 0.f};
    bf16x8 At[4][2], B0[2][2], B1[2][2];
    const unsigned ktab = g.ktab; const int kshift = g.kshift;
#define PG8_KOFF(pn) (ktab ? (int)((ktab >> (8 * ((pn) >> kshift))) & 15u) : 0)
#define PG8_KNT(pn) (ktab ? (int)((ktab >> (8 * ((pn) >> kshift) + 4)) & 15u) : nt)
    int ntc = PG8_KNT(cur.pn);
    const char* cA = (const char*)g.A + (size_t)cur.pm * tstepA + (size_t)PG8_KOFF(cur.pn) * kstep; const char* cB = (const char*)g.Bt + (size_t)cur.pn * tstep + (size_t)PG8_KOFF(cur.pn) * kstep;
    S.a_ready(cur);
    if constexpr (SP2) {
        PG8_STAGE(PG8_SB(0, 0), cB, voffB); PG8_STAGE(PG8_SB(0, 1), cB + hstep, voffB); PG8_STAGE(PG8_SA(0, 0), cA, voffA); PG8_STAGE(PG8_SA(0, 1), cA + hstepA, voffA);
        if (wr == 1) PG8_BAR;
        PG8_WAIT_V(2); PG8_BAR;
        PG8_STAGE(PG8_SB(1, 0), cB + kstep, voffB); PG8_STAGE(PG8_SA(1, 0), PG8_KA(cA, 1), voffA); PG8_STAGE(PG8_SB(1, 1), cB + hstep + kstep, voffB);
        PG8_WAIT_V(6); PG8_BAR;
    } else {
        PG8_STAGE(PG8_SB(0, 0), cB, voffB); PG8_STAGE(PG8_SA(0, 0), cA, voffA); PG8_STAGE(PG8_SB(0, 1), cB + hstep, voffB); PG8_STAGE(PG8_SA(0, 1), cA + hstepA, voffA);
        if (wr == 1) PG8_BAR;
        PG8_WAIT_V(4); PG8_BAR;
        PG8_STAGE(PG8_SB(1, 0), cB + kstep, voffB); PG8_STAGE(PG8_SA(1, 0), PG8_KA(cA, 1), voffA); PG8_STAGE(PG8_SB(1, 1), cB + hstep + kstep, voffB);
        PG8_WAIT_V(6); PG8_BAR;
    }
    for (;;) {
        const bool has_next = S.next(ui + 1, nxt);
        const char* nA = has_next ? (const char*)g.A + (size_t)nxt.pm * tstepA + (size_t)PG8_KOFF(nxt.pn) * kstep : cA; const char* nB = has_next ? (const char*)g.Bt + (size_t)nxt.pn * tstep + (size_t)PG8_KOFF(nxt.pn) * kstep : cB;
        for (int t = 0; t < ntc; t += 2) {
            const bool last = (t == ntc - 2);
            const char* a1 = PG8_KA(cA, t + 1);
            const char* a2 = last ? nA : PG8_KA(cA, t + 2); const char* b2 = last ? nB : cB + (size_t)(t + 2) * kstep;
            const char* a3 = last ? PG8_KA(nA, 1) : PG8_KA(cA, t + 3); const char* b3 = b2 + kstep;
            if (last && has_next) S.a_ready(nxt);
            if constexpr (SP2) {
            PG8_LDB(B0, 0, 0); PG8_LDB(B1, 0, 1); PG8_SCHED; PG8_LDA(At, 0, 0); PG8_STAGE(PG8_SA(1, 1), a1 + hstepA, voffA);
            PG8_WAIT_V(8); PG8_WAIT_L(0); PG8_BAR; PG8_MMA(0, 0, At, B0); PG8_MMA(0, 1, At, B1); PG8_BAR; PG8_SCHED;
            PG8_LDA(At, 0, 1); PG8_STAGE(PG8_SB(0, 0), b2, voffB); PG8_STAGE(PG8_SB(0, 1), b2 + hstep, voffB); PG8_STAGE(PG8_SA(0, 0), a2, voffA);
            PG8_WAIT_V(8); PG8_WAIT_L(0); PG8_BAR; PG8_MMA(1, 0, At, B0); PG8_MMA(1, 1, At, B1); PG8_BAR; PG8_SCHED;
            PG8_LDB(B0, 1, 0); PG8_LDB(B1, 1, 1); PG8_SCHED; PG8_LDA(At, 1, 0); PG8_STAGE(PG8_SA(0, 1), a2 + hstepA, voffA);
            PG8_WAIT_V(8); PG8_WAIT_L(0); PG8_BAR; PG8_MMA(0, 0, At, B0); PG8_MMA(0, 1, At, B1); PG8_BAR; PG8_SCHED;
            PG8_LDA(At, 1, 1); PG8_STAGE(PG8_SB(1, 0), b3, voffB); PG8_STAGE(PG8_SB(1, 1), b3 + hstep, voffB); PG8_STAGE(PG8_SA(1, 0), a3, voffA);
            PG8_WAIT_V(8); PG8_WAIT_L(0); PG8_BAR; PG8_MMA(1, 0, At, B0); PG8_MMA(1, 1, At, B1); PG8_BAR; PG8_SCHED;
            } else {
            PG8_LDB(B0, 0, 0); PG8_SCHED; PG8_LDA(At, 0, 0); PG8_STAGE(PG8_SA(1, 1), a1 + hstepA, voffA);
            PG8_WAIT_L(8); PG8_BAR; PG8_WAIT_L(0); PG8_MMA(0, 0, At, B0); PG8_BAR; PG8_SCHED;
            PG8_LDB(B1, 0, 1); PG8_STAGE(PG8_SB(0, 0), b2, voffB);
            PG8_BAR; PG8_WAIT_L(0); PG8_MMA(0, 1, At, B1); PG8_BAR;
            PG8_LDA(At, 0, 1); PG8_STAGE(PG8_SA(0, 0), a2, voffA);
            PG8_BAR; PG8_WAIT_L(0); PG8_MMA(1, 0, At, B0); PG8_BAR; PG8_SCHED;
            PG8_STAGE(PG8_SB(0, 1), b2 + hstep, voffB);
            PG8_WAIT_V(6); PG8_BAR; PG8_MMA(1, 1, At, B1); PG8_BAR;
            PG8_LDB(B0, 1, 0); PG8_SCHED; PG8_LDA(At, 1, 0); PG8_STAGE(PG8_SA(0, 1), a2 + hstepA, voffA);
            PG8_WAIT_L(8); PG8_BAR; PG8_WAIT_L(0); PG8_MMA(0, 0, At, B0); PG8_BAR; PG8_SCHED;
            PG8_LDB(B1, 1, 1); PG8_STAGE(PG8_SB(1, 0), b3, voffB);
            PG8_BAR; PG8_WAIT_L(0); PG8_MMA(0, 1, At, B1); PG8_BAR;
            PG8_LDA(At, 1, 1); PG8_STAGE(PG8_SA(1, 0), a3, voffA);
            PG8_BAR; PG8_WAIT_L(0); PG8_MMA(1, 0, At, B0); PG8_BAR; PG8_SCHED;
            PG8_STAGE(PG8_SB(1, 1), b3 + hstep, voffB);
            PG8_WAIT_V(6); PG8_BAR; PG8_MMA(1, 1, At, B1); PG8_BAR;
            }
        }
        if constexpr (ALIGN_EPI) { if (wr == 0) PG8_BAR; }
        if constexpr (!Epi::AFTER_DRAIN) { E(acc, cur, wr, wc, fr, fq); S.done(cur); }
        if (!has_next) break;
#pragma unroll
        for (int a = 0; a < 2; ++a)
#pragma unroll
            for (int b = 0; b < 2; ++b)
#pragma unroll
                for (int m = 0; m < 4; ++m)
#pragma unroll
                    for (int n = 0; n < 2; ++n) acc[a][b][m][n] = (f32x4){0.f, 0.f, 0.f, 0.f};
        cur = nxt; cA = nA; cB = nB; ++ui; ntc = PG8_KNT(cur.pn);
        if constexpr (ALIGN_EPI) { if (wr == 1) PG8_BAR; }
    }
    PG8_WAIT_V(0);
    if constexpr (!ALIGN_EPI) { if (wr == 0) PG8_BAR; }
    PG8_BAR;
    if constexpr (Epi::AFTER_DRAIN) { E.fused(acc, cur, wr, wc, fr, fq, lds, wid, lane); S.done(cur); }
#undef PG8_KA
#undef PG8_KOFF
#undef PG8_KNT
#undef PG8_SA
#undef PG8_SB
#undef PG8_STAGE
#undef PG8_LDA
#undef PG8_LDB
#undef PG8_MMA
#undef PG8_WAIT_V
#undef PG8_WAIT_L
#undef PG8_BAR
#undef PG8_SCHED
}
}

namespace {
constexpr int D = 1024, BATCH = 8, SEQ = 2048, NMETA = 16, TP = SEQ + NMETA, MP = BATCH * TP, SB = 128, M = MP + SB;
constexpr int DEPTH = 4, RH = 4, RDK = 256, RDV = 512, RV = 2048, RWIN = 6144;
constexpr int WH = 16, WN = 64, LW = 64, LA = 64, LV = 32, LG = 160, DFF = 2816;
constexpr int NRW = 3584, KRW = 2048, KL2 = 384, NL2 = 4096;
constexpr float PAST_POS = 16384.f;
constexpr int NWAVES = 8, NTHR = 512;
constexpr int LDS_BYTES = 147456;

constexpr size_t O_YP = 0;
constexpr size_t O_YS = O_YP + (size_t)BATCH * SEQ * D;
constexpr size_t O_RETP = O_YS + (size_t)SB * D;
constexpr size_t O_WKVP = O_RETP + (size_t)2 * BATCH * RH * RDK * RDV;
constexpr size_t O_SHP = O_WKVP + (size_t)2 * BATCH * WH * WN * WN;
constexpr size_t O_CVP = O_SHP + (size_t)2 * BATCH * D;
constexpr size_t O_RETS = O_CVP + (size_t)DEPTH * BATCH * 2 * DFF;
constexpr size_t O_WKVS = O_RETS + (size_t)2 * SB * RH * RDK * RDV;
constexpr size_t O_SHS = O_WKVS + (size_t)2 * SB * WH * WN * WN;
constexpr size_t O_CVS = O_SHS + (size_t)2 * SB * D;

enum { I_XP = 0, I_XS, I_SRET, I_SWKV, I_SSHIFT, I_SCONV, I_META, I_NMIX, I_NFFN, I_NFIN, I_RWIN, I_RGN, I_RWOUT, I_MU, I_WRKV, I_W0, I_W1, I_W2,
       I_A0, I_A1, I_A2, I_V0, I_V1, I_V2, I_G1, I_G2, I_KK, I_KA, I_RK, I_LNW, I_LNB, I_WO, I_WUG, I_CW, I_CB, I_WD, N_IN };

constexpr size_t al256(size_t x) { return (x + 255) & ~(size_t)255; }
constexpr size_t WS_CTL = 0;
constexpr size_t WS_CS = 1u << 20;
constexpr size_t WS_WIN = 4u << 20;
constexpr size_t SZ_WIN = (size_t)RWIN * D * 2;
constexpr size_t WS_WOUT = WS_WIN + 2 * SZ_WIN;
constexpr size_t SZ_WOUT = (size_t)D * RV * 2;
constexpr size_t WS_WRW = WS_WOUT + 2 * SZ_WOUT;
constexpr size_t SZ_WRW = (size_t)NRW * KRW * 2;
constexpr size_t WS_WL2 = WS_WRW + 2 * SZ_WRW;
constexpr size_t SZ_WL2 = (size_t)NL2 * KL2 * 2;
constexpr size_t WS_WO = WS_WL2 + 2 * SZ_WL2;
constexpr size_t SZ_WO = (size_t)D * D * 2;
constexpr size_t WS_WUG = WS_WO + 2 * SZ_WO;
constexpr size_t SZ_WUG = (size_t)2 * DFF * D * 2;
constexpr size_t WS_WD = WS_WUG + 4 * SZ_WUG;
constexpr size_t SZ_WD = (size_t)D * DFF * 2;
constexpr size_t WS_X = al256(WS_WD + 4 * SZ_WD);
constexpr size_t SZ_MD4 = (size_t)M * D * 4;
constexpr size_t WS_H = WS_X + SZ_MD4;
constexpr size_t WS_VF = WS_H + SZ_MD4;
constexpr size_t WS_REG = WS_VF + SZ_MD4;
constexpr size_t WS_QK = WS_REG;
constexpr size_t WS_V = WS_QK + SZ_MD4;
constexpr size_t WS_SG = WS_V + SZ_MD4;
constexpr size_t WS_O = WS_SG + SZ_MD4;
constexpr size_t WS_Y = WS_O + 2 * SZ_MD4;
constexpr size_t WS_R = WS_REG;
constexpr size_t WS_K = WS_R + SZ_MD4;
constexpr size_t WS_VB = WS_K + SZ_MD4;
constexpr size_t WS_WDEC = WS_VB + SZ_MD4;
constexpr size_t WS_NKK = WS_WDEC + SZ_MD4;
constexpr size_t WS_KKA = WS_NKK + SZ_MD4;
constexpr size_t WS_YW = WS_KKA + SZ_MD4;
constexpr size_t WS_L2 = WS_YW + SZ_MD4;
constexpr size_t WS_A2 = WS_L2 + 4 * SZ_MD4;
constexpr size_t WS_Z = al256(WS_A2 + (size_t)M * KL2 * 2);
constexpr size_t WS_RW_END = WS_Z + (size_t)M * D * 2;
constexpr size_t SZ_FF2 = (size_t)M * DFF * 2;
constexpr size_t WS_U = WS_REG;
constexpr size_t WS_G = al256(WS_U + SZ_FF2);
constexpr size_t WS_ACT = al256(WS_G + SZ_FF2);
constexpr size_t WS_XB = al256(WS_RW_END) + 2 * (size_t)D * 2;
constexpr size_t WS_SS = al256(WS_XB + (size_t)(M + 126) * D * 2);
constexpr size_t WS_PTRS = al256(WS_SS + (size_t)8 * M * 16 * 4);
constexpr size_t WS_END = WS_PTRS + 256;

#define LAS __attribute__((address_space(3)))
typedef unsigned short bf16;
typedef unsigned v4u __attribute__((ext_vector_type(4)));
typedef unsigned v2u __attribute__((ext_vector_type(2)));
using pg8::f32x4;
using pg8::Unit;
using pg8::bf16x8;

struct Params { const float* in[N_IN]; float* out; unsigned char* ws; };

__device__ __forceinline__ unsigned cvt_pk_bf16(float lo, float hi) { unsigned r; asm("v_cvt_pk_bf16_f32 %0, %1, %2" : "=v"(r) : "v"(lo), "v"(hi)); return r; }
typedef __bf16 bf4v __attribute__((ext_vector_type(4)));
__device__ __forceinline__ v2u pk4(const f32x4 v) { return __builtin_bit_cast(v2u, __builtin_convertvector(v, bf4v)); }
__device__ __forceinline__ bf16 bf_cv(float x) { return __builtin_bit_cast(unsigned short, (__bf16)x); }
__device__ __forceinline__ float bf_lo(unsigned w) { return __uint_as_float(w << 16); }
__device__ __forceinline__ float bf_hi(unsigned w) { return __uint_as_float(w & 0xffff0000u); }
__device__ __forceinline__ void unpack8(const v4u w, float (&f)[8]) { f[0] = bf_lo(w.x); f[1] = bf_hi(w.x); f[2] = bf_lo(w.y); f[3] = bf_hi(w.y); f[4] = bf_lo(w.z); f[5] = bf_hi(w.z); f[6] = bf_lo(w.w); f[7] = bf_hi(w.w); }
__device__ __forceinline__ v4u pack8(const float (&f)[8]) { v4u w; w.x = cvt_pk_bf16(f[0], f[1]); w.y = cvt_pk_bf16(f[2], f[3]); w.z = cvt_pk_bf16(f[4], f[5]); w.w = cvt_pk_bf16(f[6], f[7]); return w; }
__device__ __forceinline__ f32x4 ld_bf4(const bf16* q) { const v2u w = *(const v2u*)q; return (f32x4){bf_lo(w.x), bf_hi(w.x), bf_lo(w.y), bf_hi(w.y)}; }
__device__ __forceinline__ void st_bf4(bf16* q, const f32x4 v) { v2u w; w.x = cvt_pk_bf16(v.x, v.y); w.y = cvt_pk_bf16(v.z, v.w); *(v2u*)q = w; }
__device__ __forceinline__ float shfl_xor_l(float v, int m, int lane) { return __int_as_float(__builtin_amdgcn_ds_bpermute((lane ^ m) << 2, __float_as_int(v))); }
__device__ __forceinline__ float shfl_l(float v, int src) { return __int_as_float(__builtin_amdgcn_ds_bpermute(src << 2, __float_as_int(v))); }
__device__ __forceinline__ float wave_sum(float v, int) {
    v += __builtin_bit_cast(float, __builtin_amdgcn_update_dpp(0, __float_as_int(v), 0x128, 0xf, 0xf, false));
    v += __builtin_bit_cast(float, __builtin_amdgcn_update_dpp(0, __float_as_int(v), 0x124, 0xf, 0xf, false));
    v += __builtin_bit_cast(float, __builtin_amdgcn_update_dpp(0, __float_as_int(v), 0x122, 0xf, 0xf, false));
    v += __builtin_bit_cast(float, __builtin_amdgcn_update_dpp(0, __float_as_int(v), 0x121, 0xf, 0xf, false));
    const int vi = __float_as_int(v);
    return (__int_as_float(__builtin_amdgcn_readlane(vi, 0)) + __int_as_float(__builtin_amdgcn_readlane(vi, 16))) + (__int_as_float(__builtin_amdgcn_readlane(vi, 32)) + __int_as_float(__builtin_amdgcn_readlane(vi, 48)));
}
__device__ __forceinline__ float rcpf_(float x) { return __builtin_amdgcn_rcpf(x); }
__device__ __forceinline__ float sigmoidf_(float x) { return rcpf_(1.f + __expf(-x)); }
__device__ __forceinline__ float siluf_(float x) { return x * rcpf_(1.f + __expf(-x)); }
__device__ __forceinline__ float tanhf_(float x) { return 1.f - 2.f * rcpf_(1.f + __expf(2.f * x)); }

__device__ __forceinline__ float row_rstd(const unsigned char* ws, int slot, int row) {
    const f32x4* q = (const f32x4*)((const float*)(ws + WS_SS) + ((size_t)slot * M + row) * 16);
    const f32x4 a = q[0], b = q[1], c = q[2], d = q[3];
    const float ss = (((a.x + a.y) + (a.z + a.w)) + ((b.x + b.y) + (b.z + b.w))) + (((c.x + c.y) + (c.z + c.w)) + ((d.x + d.y) + (d.z + d.w)));
    return rsqrtf(ss * (1.f / D) + 1e-6f);
}
__device__ __forceinline__ float dpp_ror1(float v) { return __int_as_float(__builtin_amdgcn_update_dpp(0, __float_as_int(v), 0x121, 0xf, 0xf, false)); }
__device__ __forceinline__ void quad_transpose4(float (&x)[4], int j) {
    const bool o1 = j & 1, o2 = j & 2;
    const float a0 = o1 ? x[0] : x[1], a1 = o1 ? x[2] : x[3];
    const float b0 = __int_as_float(__builtin_amdgcn_mov_dpp(__float_as_int(a0), 0xB1, 0xf, 0xf, true)), b1 = __int_as_float(__builtin_amdgcn_mov_dpp(__float_as_int(a1), 0xB1, 0xf, 0xf, true));
    const float y0 = o1 ? b0 : x[0], y1 = o1 ? x[1] : b0, y2 = o1 ? b1 : x[2], y3 = o1 ? x[3] : b1;
    const float c0 = o2 ? y0 : y2, c1 = o2 ? y1 : y3;
    const float d0 = __int_as_float(__builtin_amdgcn_mov_dpp(__float_as_int(c0), 0x4E, 0xf, 0xf, true)), d1 = __int_as_float(__builtin_amdgcn_mov_dpp(__float_as_int(c1), 0x4E, 0xf, 0xf, true));
    x[0] = o2 ? d0 : y0; x[1] = o2 ? d1 : y1; x[2] = o2 ? y2 : d0; x[3] = o2 ? y3 : d1;
}
template <int CTRL> __device__ __forceinline__ float dpp_mv(float v) { return __int_as_float(__builtin_amdgcn_mov_dpp(__float_as_int(v), CTRL, 0xf, 0xf, true)); }
__device__ __forceinline__ float dpp_ror2(float v) { return __int_as_float(__builtin_amdgcn_update_dpp(0, __float_as_int(v), 0x122, 0xf, 0xf, false)); }
enum { EK_RETIN = 0, EK_RESID, EK_UG, EK_RWPROJ, EK_F32 };
template <int GRP> struct EpiExtra {};
template <> struct EpiExtra<1> { const float* pcw; const float* pcb; const float* pcst; float* pout; };
template <int GRP> struct EpiAnyT : EpiExtra<GRP> {
    static constexpr bool AFTER_DRAIN = false;
    int kind; bool perm; int jl; unsigned char* ws; int slot; const LAS float* rtab; float amul; int li; LAS unsigned char* ldsb;
    __device__ __forceinline__ void operator()(const f32x4 (&acc)[2][2][4][2], const Unit& u, int wr, int wc, int fr, int fq) const {
        const int row0 = u.pm * 256 + wr * 64 + fr;
        if (GRP == 0 && kind == EK_RETIN) {
            bf16* QK = (bf16*)(ws + WS_QK); bf16* V = (bf16*)(ws + WS_V); bf16* SG = (bf16*)(ws + WS_SG); const float* CS = (const float*)(ws + WS_CS);
            const int cw = wc * 32 + 8 * fq;
            if (u.pn < 8) {
                const bool isk = u.pn >= 4; const int h = u.pn & 3; const float sc = isk ? 0.0625f : 1.f;
                bf16* base = QK + (isk ? 1024 : 0) + h * 256 + cw;
#pragma unroll
                for (int ai = 0; ai < 2; ++ai) {
                    f32x4 tt[4][4];
#pragma unroll
                    for (int m = 0; m < 4; ++m) { const int row = row0 + ai * 128 + m * 16; const int pi = row < MP ? row % TP : TP;
                        const f32x4* cs = (const f32x4*)(CS + ((size_t)pi * 128 + cw) * 2);
#pragma unroll
                        for (int q4 = 0; q4 < 4; ++q4) tt[m][q4] = cs[q4]; }
#pragma unroll
                    for (int m = 0; m < 4; ++m) {
                        const int row = row0 + ai * 128 + m * 16;
                        const float rs = rtab[u.ord * 256 + (row - u.pm * 256)] * sc;
                        const f32x4 t0 = tt[m][0], t1 = tt[m][1], t2 = tt[m][2], t3 = tt[m][3];
                        const float c[8] = {t0.x, t0.z, t1.x, t1.z, t2.x, t2.z, t3.x, t3.z}, s[8] = {t0.y, t0.w, t1.y, t1.w, t2.y, t2.w, t3.y, t3.w};
                        float o1[8], o2[8];
#pragma unroll
                        for (int n = 0; n < 2; ++n)
#pragma unroll
                            for (int j = 0; j < 4; ++j) {
                                const float x1 = acc[ai][0][m][n][j], x2 = acc[ai][1][m][n][j];
                                o1[n * 4 + j] = (x1 * c[n * 4 + j] - x2 * s[n * 4 + j]) * rs;
                                o2[n * 4 + j] = (x1 * s[n * 4 + j] + x2 * c[n * 4 + j]) * rs;
                            }
                        bf16* rp = base + (size_t)row * 2048;
                        *(v4u*)rp = pack8(o1); *(v4u*)(rp + 128) = pack8(o2);
                    }
                    asm volatile("" ::: "memory");
                }
            } else {
                const bool isg = u.pn >= 16;
                bf16* base = (isg ? SG : V) + ((u.pn - (isg ? 16 : 8)) * 256) + cw;
#pragma unroll
                for (int ai = 0; ai < 2; ++ai)
#pragma unroll
                    for (int m = 0; m < 4; ++m) {
                        bf16* rp = base + (size_t)(row0 + ai * 128 + m * 16) * 2048;
                        const float rs = rtab[u.ord * 256 + (wr * 64 + fr + ai * 128 + m * 16)];
#pragma unroll
                        for (int bj = 0; bj < 2; ++bj) {
                            float o[8];
#pragma unroll
                            for (int n = 0; n < 2; ++n)
#pragma unroll
                                for (int j = 0; j < 4; ++j) { const float x = acc[ai][bj][m][n][j] * rs; o[n * 4 + j] = isg ? siluf_(x) : x; }
                            *(v4u*)(rp + bj * 128) = pack8(o);
                        }
                    }
            }
        } else if (GRP == 0 && kind == EK_RESID) {
            const int colw = u.pn * 256 + wc * 32 + (fq & 1) * 16 + (fq >> 1) * 8;
#pragma unroll
            for (int am = 0; am < 4; ++am) { const int ai = am >> 1, mb = (am & 1) * 2;
                v4u xv[2][2];
#pragma unroll
                for (int mm = 0; mm < 2; ++mm) { const int m = mb + mm; const bf16* rp = (const bf16*)(ws + WS_XB) + (size_t)(row0 + ai * 128 + m * 16) * D + colw;
#pragma unroll
                    for (int bj = 0; bj < 2; ++bj) xv[mm][bj] = *(const v4u*)(rp + bj * 128); }
#pragma unroll
                for (int mm = 0; mm < 2; ++mm) { const int m = mb + mm;
                    const int row = row0 + ai * 128 + m * 16;
                    bf16* xb = (bf16*)(ws + WS_XB) + (size_t)row * D + colw;
                    float ssq = 0.f;
#pragma unroll
                    for (int bj = 0; bj < 2; ++bj) {
                        const auto s0 = __builtin_amdgcn_permlane16_swap(xv[mm][bj].x, xv[mm][bj].z, false, false), s1 = __builtin_amdgcn_permlane16_swap(xv[mm][bj].y, xv[mm][bj].w, false, false);
                        const unsigned xn[2][2] = {{s0[0], s1[0]}, {s0[1], s1[1]}};
                        unsigned wn[2][2];
#pragma unroll
                        for (int n = 0; n < 2; ++n) {
                            const f32x4 v = (f32x4){bf_lo(xn[n][0]), bf_hi(xn[n][0]), bf_lo(xn[n][1]), bf_hi(xn[n][1])} + acc[ai][bj][m][n] * amul;
                            wn[n][0] = cvt_pk_bf16(v.x, v.y); wn[n][1] = cvt_pk_bf16(v.z, v.w);
                            if (slot >= 0) ssq += (v.x * v.x + v.y * v.y) + (v.z * v.z + v.w * v.w); }
                        const auto t0 = __builtin_amdgcn_permlane16_swap(wn[0][0], wn[1][0], false, false), t1 = __builtin_amdgcn_permlane16_swap(wn[0][1], wn[1][1], false, false);
                        *(v4u*)(xb + bj * 128) = (v4u){t0[0], t1[0], t0[1], t1[1]};
                    }
                    if (slot >= 0) { ssq += shfl_xor_l(ssq, 16, fq * 16 + fr); ssq += shfl_xor_l(ssq, 32, fq * 16 + fr); if (fq == 0) ((float*)(ws + WS_SS))[((size_t)slot * M + row) * 16 + u.pn * 4 + wc] = ssq; }
                }
                asm volatile("" ::: "memory");
            }
        } else if (GRP == 1 && kind == EK_UG) {
            int frL = fr, fqL = fq; asm volatile("" : "+v"(frL), "+v"(fqL));
            const EpiExtra<1>& X1 = *(const EpiExtra<1>*)(const void*)this;
            const float* cw = X1.pcw + (size_t)li * 3 * DFF; const float* cb = X1.pcb + (size_t)li * DFF; const float* cst = X1.pcst + (size_t)li * SB * 2 * DFF;
            float* cvp = X1.pout + O_CVP + (size_t)li * BATCH * 2 * DFF; float* cvs = X1.pout + O_CVS + (size_t)li * SB * 2 * DFF;
            bf16* ACT = (bf16*)(ws + WS_ACT);
            const int fl = wc * 32 + 8 * fqL;
            LAS float* halo = (LAS float*)(ldsb + 131072 + 8192);
            const LAS float* rt = rtab + u.ord * 256;
#pragma unroll
            for (int ai = 0; ai < 2; ++ai) if (frL >= 14) {
                const float rs = rt[128 * ai + 64 * wr + 48 + frL];
                LAS float* hp = halo + ((2 * ai + wr) * 2 + (frL - 14)) * 128 + fl;
                *(LAS f32x4*)hp = acc[ai][1][3][0] * rs; *(LAS f32x4*)(hp + 4) = acc[ai][1][3][1] * rs;
            }
            asm volatile("s_waitcnt lgkmcnt(0)" ::: "memory"); __builtin_amdgcn_s_barrier(); asm volatile("" ::: "memory");
            const int R0 = 254 * u.pm - 2, bq = (R0 + 2) / TP, tq = (R0 + 2) - bq * TP;
            const bool plain = (R0 + 255 < MP) && tq >= 2 && tq + 253 < TP - 2;
            if (plain) {
                const bool k15 = frL == 15, k14 = frL >= 14;
                const int f00 = u.pn * 128 + fl;
                const f32x4 Wa0 = *(const f32x4*)(cw + f00), Wa1 = *(const f32x4*)(cw + DFF + f00), Wa2 = *(const f32x4*)(cw + 2 * DFF + f00), Wab = *(const f32x4*)(cb + f00);
                const f32x4 Wb0 = *(const f32x4*)(cw + f00 + 4), Wb1 = *(const f32x4*)(cw + DFF + f00 + 4), Wb2 = *(const f32x4*)(cw + 2 * DFF + f00 + 4), Wbb = *(const f32x4*)(cb + f00 + 4);
                const unsigned ob = (unsigned)((R0 + 64 * wr + frL) * DFF + f00) * 2u;
                f32x4 prevA = (f32x4){0.f, 0.f, 0.f, 0.f}, prevB = prevA;
#pragma unroll
                for (int ai = 0; ai < 2; ++ai)
#pragma unroll
                    for (int m = 0; m < 4; ++m) {
                        const int l = 128 * ai + 64 * wr + 16 * m + frL;
                        const float rs = rt[l];
                        if (m == 0) {
                            const int B = 2 * ai + wr;
                            prevA = (f32x4){0.f, 0.f, 0.f, 0.f}; prevB = prevA;
                            if (B > 0 && frL >= 14) { const LAS float* hp = halo + ((B - 1) * 2 + (frL - 14)) * 128 + fl; prevA = *(const LAS f32x4*)hp; prevB = *(const LAS f32x4*)(hp + 4); }
                        }
                        unsigned wv[4];
#pragma unroll
                        for (int n = 0; n < 2; ++n) {
                            const f32x4 w0 = n ? Wb0 : Wa0, w1 = n ? Wb1 : Wa1, w2 = n ? Wb2 : Wa2, bb = n ? Wbb : Wab;
                            const f32x4 cur = acc[ai][1][m][n] * rs, uu = acc[ai][0][m][n] * rs, prev = n ? prevB : prevA;
                            float ov[4];
#pragma unroll
                            for (int e = 0; e < 4; ++e) {
                                const float ce = cur[e], pe = prev[e];
                                const float g1 = dpp_mv<0x121>(k15 ? pe : ce), g2 = dpp_mv<0x122>(k14 ? pe : ce);
                                const float cv = fmaf(w0[e], g2, fmaf(w1[e], g1, fmaf(w2[e], ce, bb[e])));
                                ov[e] = siluf_(cv) * uu[e];
                            }
                            wv[2 * n] = cvt_pk_bf16(ov[0], ov[1]); wv[2 * n + 1] = cvt_pk_bf16(ov[2], ov[3]);
                            if (n) prevB = cur; else prevA = cur;
                        }
                        if (ai > 0 || m > 0 || l >= 2) *(v4u*)((unsigned char*)ACT + (ob + (unsigned)((128 * ai + 16 * m) * DFF * 2))) = (v4u){wv[0], wv[1], wv[2], wv[3]};
                        __builtin_amdgcn_sched_barrier(0);
                    }
            } else
#pragma unroll
            for (int n = 0; n < 2; ++n) {
                const int f0 = u.pn * 128 + fl + 4 * n;
                const f32x4 w0 = *(const f32x4*)(cw + f0), w1 = *(const f32x4*)(cw + DFF + f0), w2 = *(const f32x4*)(cw + 2 * DFF + f0), bb = *(const f32x4*)(cb + f0);
                f32x4 prev = (f32x4){0.f, 0.f, 0.f, 0.f};
#pragma unroll
                for (int ai = 0; ai < 2; ++ai)
#pragma unroll
                    for (int m = 0; m < 4; ++m) {
                        const int l = 128 * ai + 64 * wr + 16 * m + frL, row = 254 * u.pm - 2 + l;
                        const float rs = rt[l];
                        const f32x4 cur = acc[ai][1][m][n] * rs, uu = acc[ai][0][m][n] * rs;
                        if (m == 0) {
                            const int B = 2 * ai + wr;
                            prev = (f32x4){0.f, 0.f, 0.f, 0.f};
                            if (B > 0 && frL >= 14) prev = *(const LAS f32x4*)(halo + ((B - 1) * 2 + (frL - 14)) * 128 + fl + 4 * n);
                        }
                        f32x4 g1, g2;
                        {
                            const float c1x = dpp_ror1(cur.x), c1y = dpp_ror1(cur.y), c1z = dpp_ror1(cur.z), c1w = dpp_ror1(cur.w);
                            const float p1x = dpp_ror1(prev.x), p1y = dpp_ror1(prev.y), p1z = dpp_ror1(prev.z), p1w = dpp_ror1(prev.w);
                            const float c2x = dpp_ror2(cur.x), c2y = dpp_ror2(cur.y), c2z = dpp_ror2(cur.z), c2w = dpp_ror2(cur.w);
                            const float p2x = dpp_ror2(prev.x), p2y = dpp_ror2(prev.y), p2z = dpp_ror2(prev.z), p2w = dpp_ror2(prev.w);
                            const bool s1 = frL >= 1, s2 = frL >= 2;
                            g1.x = s1 ? c1x : p1x; g1.y = s1 ? c1y : p1y; g1.z = s1 ? c1z : p1z; g1.w = s1 ? c1w : p1w;
                            g2.x = s2 ? c2x : p2x; g2.y = s2 ? c2y : p2y; g2.z = s2 ? c2z : p2z; g2.w = s2 ? c2w : p2w;
                        }
                        if (l >= 2 && row < M) {
                            if (row < MP) {
                                const int b = row / TP, t = row - b * TP;
                                if (t < 2) { g2 = (f32x4){0.f, 0.f, 0.f, 0.f}; if (t == 0) g1 = g2; }
                                if (t >= TP - 2) *(f32x4*)(cvp + ((size_t)b * 2 + (t - (TP - 2))) * DFF + f0) = cur;
                            } else {
                                const int s = row - MP;
                                const float* c0 = cst + ((size_t)s * 2 + 0) * DFF + f0;
                                g2 = *(const f32x4*)c0; g1 = *(const f32x4*)(c0 + DFF);
                                float* o = cvs + ((size_t)s * 2 + 0) * DFF + f0;
                                *(f32x4*)o = g1; *(f32x4*)(o + DFF) = cur;
                            }
                            const f32x4 cv = bb + w0 * g2 + w1 * g1 + w2 * cur;
                            v2u w; w.x = cvt_pk_bf16(siluf_(cv.x) * uu.x, siluf_(cv.y) * uu.y); w.y = cvt_pk_bf16(siluf_(cv.z) * uu.z, siluf_(cv.w) * uu.w);
                            *(v2u*)(ACT + (size_t)row * DFF + f0) = w;
                        }
                        prev = cur;
                    }
            }
        } else if (GRP == 0 && kind == EK_RWPROJ) {
            const int cw = wc * 32 + 8 * fq;
            int rrow[2][4];
#pragma unroll
            for (int ai = 0; ai < 2; ++ai)
#pragma unroll
                for (int m = 0; m < 4; ++m) { const int mp = row0 + ai * 128 + m * 16;
                    if (mp < 8 * (TP + 1)) { const int b = mp / (TP + 1), t = mp - b * (TP + 1); rrow[ai][m] = t < TP ? b * TP + t : -1; }
                    else { const int q = mp - 8 * (TP + 1); rrow[ai][m] = (!(q & 1) && q < 2 * SB) ? MP + (q >> 1) : -1; } }
            if (u.pn < 12) {
                bf16* dst = (bf16*)(ws + (u.pn < 4 ? WS_R : (u.pn < 8 ? WS_K : (jl == 0 ? WS_VF : WS_VB)))) + (u.pn & 3) * 256 + cw;
#pragma unroll
                for (int ai = 0; ai < 2; ++ai)
#pragma unroll
                    for (int m = 0; m < 4; ++m) if (rrow[ai][m] >= 0) {
                        bf16* rp = dst + (size_t)rrow[ai][m] * D;
#pragma unroll
                        for (int bj = 0; bj < 2; ++bj) { float o[8];
#pragma unroll
                            for (int n = 0; n < 2; ++n)
#pragma unroll
                                for (int j = 0; j < 4; ++j) o[n * 4 + j] = acc[ai][bj][m][n][j];
                            *(v4u*)(rp + bj * 128) = pack8(o); }
                    }
            } else {
                bf16* A2 = (bf16*)(ws + WS_A2);
#pragma unroll
                for (int bj = 0; bj < 2; ++bj) {
                    const int c = (u.pn - 12) * 256 + bj * 128 + cw;
                    if (c < KL2) {
                        const int kd = c < 64 ? 1 : ((c >= 128 && c < 288) ? 2 : 0);
#pragma unroll
                        for (int ai = 0; ai < 2; ++ai)
#pragma unroll
                            for (int m = 0; m < 4; ++m) if (rrow[ai][m] >= 0) { float o[8];
#pragma unroll
                                for (int n = 0; n < 2; ++n)
#pragma unroll
                                    for (int j = 0; j < 4; ++j) { const float x = acc[ai][bj][m][n][j]; o[n * 4 + j] = kd == 1 ? tanhf_(x) : (kd == 2 ? sigmoidf_(x) : x); }
                                *(v4u*)(A2 + (size_t)rrow[ai][m] * KL2 + c) = pack8(o); }
                    }
                }
            }
        } else if (GRP == 0) {
            bf16* C = (bf16*)(ws + WS_L2);
            const int col0 = u.pn * 256 + wc * 32 + 8 * fq;
#pragma unroll
            for (int ai = 0; ai < 2; ++ai)
#pragma unroll
                for (int m = 0; m < 4; ++m) {
                    bf16* rp = C + (size_t)(row0 + ai * 128 + m * 16) * NL2 + col0;
#pragma unroll
                    for (int bj = 0; bj < 2; ++bj) { float o[8];
#pragma unroll
                        for (int n = 0; n < 2; ++n)
#pragma unroll
                            for (int j = 0; j < 4; ++j) o[n * 4 + j] = acc[ai][bj][m][n][j];
                        *(v4u*)(rp + bj * 128) = pack8(o); }
                }
        }
    }
};

constexpr int MT0 = 16384;
constexpr int HP_SEQ = TP + 1, HP_PB = BATCH * HP_SEQ, HP_M = 66 * 256;
static_assert(HP_PB + 2 * SB <= HP_M && (size_t)(HP_M + 2) * D * 2 <= SZ_MD4, "padded rwkv input");
__device__ __forceinline__ void tail_resid(const bf16* __restrict__ A, const bf16* __restrict__ Bt, int K, unsigned char* ws, int slot, float amul, LAS unsigned char* lds, int lane, int wave) {
    const int fr = lane & 15, fq = lane >> 4;
    const int kw = K >> 3;
    for (int job = blockIdx.x; job < 16 * 16; job += gridDim.x) {
        const int rs = job >> 4, cs = job & 15;
        const bf16* ap = A + (size_t)(MT0 + 16 * rs + fr) * K + wave * kw + 8 * fq;
        const bf16* bp = Bt + (size_t)(64 * cs + fr) * K + wave * kw + 8 * fq;
        f32x4 acc[4];
#pragma unroll
        for (int t = 0; t < 4; ++t) acc[t] = (f32x4){0.f, 0.f, 0.f, 0.f};
#pragma unroll 4
        for (int k0 = 0; k0 < kw; k0 += 32) {
            const bf16x8 af = *(const bf16x8*)(ap + k0);
#pragma unroll
            for (int t = 0; t < 4; ++t) { const bf16x8 bf = *(const bf16x8*)(bp + (size_t)(16 * t) * K + k0); acc[t] = __builtin_amdgcn_mfma_f32_16x16x32_bf16(bf, af, acc[t], 0, 0, 0); }
        }
        __syncthreads();
#pragma unroll
        for (int t = 0; t < 4; ++t) *(LAS f32x4*)(lds + ((wave * 4 + t) * 64 + lane) * 16) = acc[t];
        __syncthreads();
        if (wave == 0) {
#pragma unroll
            for (int t = 0; t < 4; ++t) { f32x4 s = acc[t];
#pragma unroll
                for (int w = 1; w < 8; ++w) s += *(LAS f32x4*)(lds + ((w * 4 + t) * 64 + lane) * 16);
                acc[t] = s; }
            const int row = MT0 + 16 * rs + fr;
            bf16* xb = (bf16*)(ws + WS_XB) + (size_t)row * D + 64 * cs + 4 * fq;
            float ssq = 0.f;
#pragma unroll
            for (int t = 0; t < 4; ++t) { const f32x4 v = ld_bf4(xb + 16 * t) + acc[t] * amul; st_bf4(xb + 16 * t, v);
                if (slot >= 0) ssq += (v.x * v.x + v.y * v.y) + (v.z * v.z + v.w * v.w); }
            if (slot >= 0) { ssq += shfl_xor_l(ssq, 16, lane); ssq += shfl_xor_l(ssq, 32, lane); if (fq == 0) ((float*)(ws + WS_SS))[((size_t)slot * M + row) * 16 + cs] = ssq; }
        }
    }
}

__device__ __forceinline__ void tr_item(const float* __restrict__ W, int ldw, int k0, int n0, bf16* __restrict__ WT, int ldt, int drow, const float* __restrict__ mu, LAS float* scr, int lane, const float* __restrict__ gs = nullptr) {
#pragma unroll 8
    for (int i = 0; i < 32; ++i) { const int kk = 2 * i + (lane >> 5); scr[kk * 33 + (lane & 31)] = W[(size_t)(k0 + kk) * ldw + n0 + (lane & 31)]; }
    asm volatile("s_waitcnt lgkmcnt(0)" ::: "memory");
    const int c = lane & 7;
    float mv[8];
    if (mu) {
#pragma unroll
        for (int e = 0; e < 8; ++e) mv[e] = mu[k0 + 8 * c + e];
    } else if (gs) {
#pragma unroll
        for (int e = 0; e < 8; ++e) mv[e] = gs[k0 + 8 * c + e];
    }
#pragma unroll
    for (int j = 0; j < 4; ++j) {
        const int n = (lane >> 3) + 8 * j; const LAS float* s = scr + (8 * c) * 33 + n;
        float f[8];
#pragma unroll
        for (int e = 0; e < 8; ++e) f[e] = s[e * 33];
        bf16* dp = WT + (size_t)(drow + n) * ldt + k0 + 8 * c;
        if (mu) {
            float f1[8], f2[8];
#pragma unroll
            for (int e = 0; e < 8; ++e) { f1[e] = f[e] * (1.f - mv[e]); f2[e] = f[e] * mv[e]; }
            *(v4u*)dp = pack8(f1); *(v4u*)(dp + 1024) = pack8(f2);
        } else { if (gs) {
#pragma unroll
            for (int e = 0; e < 8; ++e) f[e] *= mv[e]; }
            *(v4u*)dp = pack8(f); }
    }
    asm volatile("s_waitcnt lgkmcnt(0)" ::: "memory");
}

__device__ __forceinline__ void ph_p0(const Params& p, LAS unsigned char* lds, int tid, int lane, int wave) {
    unsigned char* ws = p.ws;
    LAS float* scr = (LAS float*)(lds + wave * 16384);
    const int gw = blockIdx.x * NWAVES + wave, NGW = gridDim.x * NWAVES;
    constexpr int C_WIN = 2 * 16 * 192, C_WOUT = 2 * 32 * 32, C_RKV = 2 * 3 * 512, C_W1 = 2 * 32, C_A1 = 2 * 32, C_G1 = 2 * 80, C_V1 = 16, C_WO = 2 * 512, C_WUG = 4 * 16 * 176, C_WD = 4 * 44 * 32;
    constexpr int NITEMS = C_WIN + C_WOUT + C_RKV + C_W1 + C_A1 + C_G1 + C_V1 + C_WO + C_WUG + C_WD;
    for (int it = gw; it < NITEMS; it += NGW) {
        int r = it;
        if (r < C_WIN) { const int j = r / 3072, q = r % 3072, kb = q / 192, nb = q % 192;
            tr_item(p.in[I_RWIN] + (size_t)j * D * RWIN, RWIN, 64 * kb, 32 * nb, (bf16*)(ws + WS_WIN + j * SZ_WIN), D, 32 * nb, nullptr, scr, lane, p.in[I_NMIX] + (size_t)(2 * j) * D); continue; }
        r -= C_WIN;
        if (r < C_WOUT) { const int j = r / 1024, q = r % 1024, kb = q / 32, nb = q % 32;
            tr_item(p.in[I_RWOUT] + (size_t)j * RV * D, D, 64 * kb, 32 * nb, (bf16*)(ws + WS_WOUT + j * SZ_WOUT), RV, 32 * nb, nullptr, scr, lane); continue; }
        r -= C_WOUT;
        if (r < C_RKV) { const int j = r / 1536, q = r % 1536, s = q / 512, q2 = q % 512, kb = q2 / 32, nb = q2 % 32, c = (s == 0 ? 0 : (s == 1 ? 2 : 3));
            tr_item(p.in[I_WRKV] + (size_t)(j * 3 + s) * D * D, D, 64 * kb, 32 * nb, (bf16*)(ws + WS_WRW + j * SZ_WRW), KRW, s * 1024 + 32 * nb, p.in[I_MU] + (size_t)(j * 6 + c) * D, scr, lane); continue; }
        r -= C_RKV;
        if (r < C_W1) { const int j = r / 32, q = r % 32, kb = q / 2, nb = q % 2;
            tr_item(p.in[I_W1] + (size_t)j * D * LW, LW, 64 * kb, 32 * nb, (bf16*)(ws + WS_WRW + j * SZ_WRW), KRW, 3072 + 32 * nb, p.in[I_MU] + (size_t)(j * 6 + 1) * D, scr, lane); continue; }
        r -= C_W1;
        if (r < C_A1) { const int j = r / 32, q = r % 32, kb = q / 2, nb = q % 2;
            tr_item(p.in[I_A1] + (size_t)j * D * LA, LA, 64 * kb, 32 * nb, (bf16*)(ws + WS_WRW + j * SZ_WRW), KRW, 3136 + 32 * nb, p.in[I_MU] + (size_t)(j * 6 + 4) * D, scr, lane); continue; }
        r -= C_A1;
        if (r < C_G1) { const int j = r / 80, q = r % 80, kb = q / 5, nb = q % 5;
            tr_item(p.in[I_G1] + (size_t)j * D * LG, LG, 64 * kb, 32 * nb, (bf16*)(ws + WS_WRW + j * SZ_WRW), KRW, 3200 + 32 * nb, p.in[I_MU] + (size_t)(j * 6 + 5) * D, scr, lane); continue; }
        r -= C_G1;
        if (r < C_V1) { const int kb = r;
            tr_item(p.in[I_V1], LV, 64 * kb, 0, (bf16*)(ws + WS_WRW + 1 * SZ_WRW), KRW, 3360, p.in[I_MU] + (size_t)(1 * 6 + 3) * D, scr, lane); continue; }
        r -= C_V1;
        if (r < C_WO) { const int j = r / 512, q = r % 512, kb = q / 32, nb = q % 32;
            tr_item(p.in[I_WO] + (size_t)j * D * D, D, 64 * kb, 32 * nb, (bf16*)(ws + WS_WO + j * SZ_WO), D, 32 * nb, nullptr, scr, lane); continue; }
        r -= C_WO;
        if (r < C_WUG) { const int i = r / 2816, q = r % 2816, kb = q / 176, nb = q % 176, n0 = 32 * nb;
            const int drow = n0 < DFF ? 256 * (n0 / 128) + (n0 % 128) : 256 * ((n0 - DFF) / 128) + 128 + ((n0 - DFF) % 128);
            tr_item(p.in[I_WUG] + (size_t)i * D * 2 * DFF, 2 * DFF, 64 * kb, n0, (bf16*)(ws + WS_WUG + i * SZ_WUG), D, drow, nullptr, scr, lane, p.in[I_NFFN] + (size_t)i * D); continue; }
        r -= C_WUG;
        { const int i = r / 1408, q = r % 1408, kb = q / 32, nb = q % 32;
            tr_item(p.in[I_WD] + (size_t)i * DFF * D, D, 64 * kb, 32 * nb, (bf16*)(ws + WS_WD + i * SZ_WD), DFF, 32 * nb, nullptr, scr, lane); }
    }
    const size_t gt = (size_t)blockIdx.x * NTHR + tid, GT = (size_t)gridDim.x * NTHR;
    for (size_t i = gt; i < (size_t)(224 + 192) * (KRW / 8); i += GT) {
        const int rr = (int)(i / (KRW / 8)), c8 = (int)(i % (KRW / 8));
        const int j = rr < 224 ? 0 : 1, row = rr < 224 ? 3360 + rr : 3392 + (rr - 224);
        *(v4u*)((bf16*)(ws + WS_WRW + j * SZ_WRW) + (size_t)row * KRW + c8 * 8) = (v4u){0u, 0u, 0u, 0u};
    }
    for (size_t i = gt; i < (size_t)2 * NL2 * KL2; i += GT) {
        const int j = (int)(i / ((size_t)NL2 * KL2)); const int rem = (int)(i % ((size_t)NL2 * KL2)); const int n = rem / KL2, k = rem % KL2, grp = n >> 10, nn = n & 1023;
        float v = 0.f;
        if (grp == 0) { if (k < 64) v = p.in[I_W2][((size_t)j * LW + k) * D + nn]; }
        else if (grp == 1) { if (k >= 64 && k < 128) v = p.in[I_A2][((size_t)j * LA + (k - 64)) * D + nn]; }
        else if (grp == 2) { if (k >= 128 && k < 288) v = p.in[I_G2][((size_t)j * LG + (k - 128)) * D + nn]; }
        else { if (j == 1 && k >= 288 && k < 320) v = p.in[I_V2][((size_t)(k - 288)) * D + nn]; }
        ((bf16*)(ws + WS_WL2 + j * SZ_WL2))[(size_t)n * KL2 + k] = (bf16)(cvt_pk_bf16(v, 0.f) & 0xffffu);
    }
    for (size_t i = gt; i < (size_t)(TP + 1) * 128; i += GT) {
        const int pi = (int)(i >> 7), mi = (int)(i & 127);
        const float pos = pi < TP ? (float)pi : PAST_POS;
        const float inv = 1.0f / powf(10000.0f, (float)mi / 127.0f);
        float s, c; sincosf(pos * inv, &s, &c);
        ((float2*)(ws + WS_CS))[i] = make_float2(c, s);
    }
    bf16* XB = (bf16*)(ws + WS_XB);
    for (int r = gw; r < M; r += NGW) {
        const float* src;
        if (r < MP) { const int b = r / TP, t = r % TP; src = t < NMETA ? p.in[I_META] + (size_t)t * D : p.in[I_XP] + ((size_t)b * SEQ + (t - NMETA)) * D; }
        else src = p.in[I_XS] + (size_t)(r - MP) * D;
        float ss = 0.f;
#pragma unroll
        for (int j = 0; j < 2; ++j) { const int c0 = 512 * j + 8 * lane;
            const f32x4 a4 = *(const f32x4*)(src + c0), b4 = *(const f32x4*)(src + c0 + 4);
            const float f[8] = {a4.x, a4.y, a4.z, a4.w, b4.x, b4.y, b4.z, b4.w};
#pragma unroll
            for (int e = 0; e < 8; ++e) ss += f[e] * f[e];
            *(v4u*)(XB + (size_t)r * D + c0) = pack8(f); }
        ss = wave_sum(ss, lane);
        if (lane < 16) ((float*)(ws + WS_SS))[(size_t)r * 16 + lane] = lane == 0 ? ss : 0.f;
    }
}

__device__ __forceinline__ void ph_norm(const Params& p, const float* __restrict__ g, int mode, int jl, int lane, int wave) {
    const bf16* X = (const bf16*)(p.ws + WS_XB); bf16* H = (bf16*)(p.ws + WS_H);
    const int gw = blockIdx.x * NWAVES + wave, NGW = gridDim.x * NWAVES;
    constexpr int UB = 4;
    for (int row0 = gw; row0 < M; row0 += NGW * UB) {
    v4u raw[UB][2];
#pragma unroll
    for (int q = 0; q < UB; ++q) { const int r_ = row0 + q * NGW, rc_ = r_ < M ? r_ : row0;
#pragma unroll
        for (int j = 0; j < 2; ++j) raw[q][j] = *(const v4u*)(X + (size_t)rc_ * D + 512 * j + 8 * lane); }
#pragma unroll
    for (int q = 0; q < UB; ++q) { const int row = row0 + q * NGW; if (row < M) {
        float v[2][8]; float ss = 0.f;
#pragma unroll
        for (int j = 0; j < 2; ++j) {
            unpack8(raw[q][j], v[j]);
#pragma unroll
            for (int e = 0; e < 8; ++e) ss += v[j][e] * v[j][e];
        }
        ss = wave_sum(ss, lane);
        const float rstd = rsqrtf(ss * (1.f / D) + 1e-6f);
        const bool prompt = row < MP; const int b = prompt ? row / TP : 0, t = prompt ? row % TP : 0;
#pragma unroll
        for (int j = 0; j < 2; ++j) {
            const int c0 = 512 * j + 8 * lane;
            const f32x4 ga = *(const f32x4*)(g + c0), gb = *(const f32x4*)(g + c0 + 4);
            float o[8];
            o[0] = v[j][0] * rstd * ga.x; o[1] = v[j][1] * rstd * ga.y; o[2] = v[j][2] * rstd * ga.z; o[3] = v[j][3] * rstd * ga.w;
            o[4] = v[j][4] * rstd * gb.x; o[5] = v[j][5] * rstd * gb.y; o[6] = v[j][6] * rstd * gb.z; o[7] = v[j][7] * rstd * gb.w;
            if (mode == 0) { *(v4u*)(H + (size_t)row * D + c0) = pack8(o); }
            else if (mode == 1) {
                const v4u w = pack8(o);
                if (prompt) {
                    bf16* hp = H + (size_t)(b * HP_SEQ + 1 + t) * D + c0;
                    *(v4u*)hp = w;
                    if (t == TP - 1) { float* so = p.out + O_SHP + ((size_t)jl * BATCH + b) * D + c0; *(f32x4*)so = (f32x4){o[0], o[1], o[2], o[3]}; *(f32x4*)(so + 4) = (f32x4){o[4], o[5], o[6], o[7]}; }
                    if (t == 0) *(v4u*)(hp - D) = (v4u){0u, 0u, 0u, 0u};
                } else {
                    const int s = row - MP;
                    const float* sp = p.in[I_SSHIFT] + ((size_t)jl * SB + s) * D + c0;
                    const f32x4 sa = *(const f32x4*)sp, sb2 = *(const f32x4*)(sp + 4);
                    const float pv[8] = {sa.x, sa.y, sa.z, sa.w, sb2.x, sb2.y, sb2.z, sb2.w};
                    bf16* hp = H + (size_t)(HP_PB + 2 * s) * D + c0;
                    *(v4u*)hp = pack8(pv); *(v4u*)(hp + D) = w;
                    float* so = p.out + O_SHS + ((size_t)jl * SB + s) * D + c0; *(f32x4*)so = (f32x4){o[0], o[1], o[2], o[3]}; *(f32x4*)(so + 4) = (f32x4){o[4], o[5], o[6], o[7]};
                }
            } else {
                float* dst = nullptr;
                if (prompt) { if (t >= NMETA) dst = p.out + O_YP + ((size_t)b * SEQ + (t - NMETA)) * D + c0; }
                else dst = p.out + O_YS + (size_t)(row - MP) * D + c0;
                if (dst) { *(f32x4*)dst = (f32x4){o[0], o[1], o[2], o[3]}; *(f32x4*)(dst + 4) = (f32x4){o[4], o[5], o[6], o[7]}; }
            }
        }
    } }
    }
}

__device__ __forceinline__ void ph_ret_norm(const Params& p, int jl, int lane, int wave) {
    const bf16* O = (const bf16*)(p.ws + WS_O); const bf16* SG = (const bf16*)(p.ws + WS_SG); bf16* Y = (bf16*)(p.ws + WS_Y);
    const float* gnw = p.in[I_RGN] + (size_t)jl * RV;
    const int gw = blockIdx.x * NWAVES + wave, NGW = gridDim.x * NWAVES;
    constexpr int UB = 4;
    for (int it0 = gw; it0 < M * RH; it0 += NGW * UB) {
        const int h = it0 & 3;
        const f32x4 ga = *(const f32x4*)(gnw + h * RDV + 8 * lane), gb = *(const f32x4*)(gnw + h * RDV + 8 * lane + 4);
        const float gg[8] = {ga.x, ga.y, ga.z, ga.w, gb.x, gb.y, gb.z, gb.w};
        v4u ov[UB], sgv[UB];
#pragma unroll
        for (int q = 0; q < UB; ++q) { const int it = it0 + q * NGW, itc = it < M * RH ? it : it0; const size_t off = (size_t)(itc >> 2) * RV + h * RDV + 8 * lane;
            ov[q] = *(const v4u*)(O + off); sgv[q] = *(const v4u*)(SG + off); }
#pragma unroll
        for (int q = 0; q < UB; ++q) { const int it = it0 + q * NGW; const size_t off = (size_t)(it >> 2) * RV + h * RDV + 8 * lane;
            float v[8]; unpack8(ov[q], v);
            float s = 0.f;
#pragma unroll
            for (int e = 0; e < 8; ++e) s += v[e];
            const float mean = wave_sum(s, lane) * (1.f / RDV);
            float s2 = 0.f;
#pragma unroll
            for (int e = 0; e < 8; ++e) { v[e] -= mean; s2 += v[e] * v[e]; }
            const float rstd = rsqrtf(wave_sum(s2, lane) * (1.f / RDV) + 1e-5f);
            float sg[8]; unpack8(sgv[q], sg);
            float o[8];
#pragma unroll
            for (int e = 0; e < 8; ++e) o[e] = v[e] * rstd * gg[e] * sg[e];
            if (it < M * RH) *(v4u*)(Y + off) = pack8(o);
        }
    }
}

__device__ __forceinline__ float row16_sum(float x);
__device__ __forceinline__ float half8_sum(float x);
__device__ __forceinline__ void ph_rwkv_post(const Params& p, int jl, int lane, int wave) {
    const bf16* YW = (const bf16*)(p.ws + WS_YW); const float* BON = (const float*)(p.ws + WS_NKK);
    const bf16* VP = (const bf16*)(p.ws + (jl == 0 ? WS_VF : WS_KKA)); const bf16* L2 = (const bf16*)(p.ws + WS_L2); bf16* Z = (bf16*)(p.ws + WS_Z);
    const float* lnw = p.in[I_LNW] + (size_t)jl * D; const float* lnb = p.in[I_LNB] + (size_t)jl * D;
    const int gw = blockIdx.x * NWAVES + wave, NGW = gridDim.x * NWAVES;
    const int sub = lane >> 3, c8 = lane & 7;
    constexpr int UB = 4;
    for (int it0 = gw * 8; it0 < M * WH; it0 += NGW * 8 * UB) {
        const int h = (it0 + sub) & 15, c = h * WN + 8 * c8;
        const f32x4 lwa = *(const f32x4*)(lnw + c), lwb = *(const f32x4*)(lnw + c + 4), lba = *(const f32x4*)(lnb + c), lbb = *(const f32x4*)(lnb + c + 4);
        const float lw[8] = {lwa.x, lwa.y, lwa.z, lwa.w, lwb.x, lwb.y, lwb.z, lwb.w}, lb[8] = {lba.x, lba.y, lba.z, lba.w, lbb.x, lbb.y, lbb.z, lbb.w};
        v4u y4[UB], v4[UB], g4[UB]; float bonv[UB];
#pragma unroll
        for (int q = 0; q < UB; ++q) { const int it = it0 + q * NGW * 8 + sub, itc = it < M * WH ? it : it0 + sub, row = itc >> 4; const size_t idx = (size_t)row * D + c;
            y4[q] = *(const v4u*)(YW + idx); bonv[q] = BON[(size_t)row * WH + h]; v4[q] = *(const v4u*)(VP + idx); g4[q] = *(const v4u*)(L2 + (size_t)row * NL2 + 2048 + c); }
#pragma unroll
        for (int q = 0; q < UB; ++q) { const int it = it0 + q * NGW * 8 + sub, row = it >> 4; const size_t idx = (size_t)row * D + c;
            float yv[8], vv[8], gv[8]; unpack8(y4[q], yv); unpack8(v4[q], vv); unpack8(g4[q], gv);
            float s = 0.f;
#pragma unroll
            for (int e = 0; e < 8; ++e) s += yv[e];
            const float mean = half8_sum(s) * (1.f / WN);
            float s2 = 0.f;
#pragma unroll
            for (int e = 0; e < 8; ++e) { yv[e] -= mean; s2 += yv[e] * yv[e]; }
            const float rstd = rsqrtf(half8_sum(s2) * (1.f / WN) + 64e-5f);
            float z[8];
#pragma unroll
            for (int e = 0; e < 8; ++e) z[e] = (yv[e] * rstd * lw[e] + lb[e] + vv[e] * bonv[q]) * gv[e];
            if (it < M * WH) *(v4u*)(Z + idx) = pack8(z);
        }
    }
}

constexpr int RT_KP = 528, RT_VP = 144, RT_SP = 528;
constexpr int RT_K_OFF = 0, RT_V_OFF = 128 * RT_KP, RT_ST_OFF = RT_V_OFF + 128 * RT_VP, RT_END = RT_ST_OFF + 64 * RT_SP;
static_assert(RT_END <= LDS_BYTES, "retention LDS map");
typedef short v4s __attribute__((ext_vector_type(4)));
__device__ __forceinline__ bf16x8 tr_pair(LAS unsigned char* a0, LAS unsigned char* a1) {
    const v4s lo = __builtin_amdgcn_ds_read_tr16_b64_v4i16((LAS v4s*)a0), hi = __builtin_amdgcn_ds_read_tr16_b64_v4i16((LAS v4s*)a1);
    return __builtin_shufflevector(lo, hi, 0, 1, 2, 3, 4, 5, 6, 7);
}
__device__ __forceinline__ void ph_ret_fast(const Params& p, int jl, LAS unsigned char* lds, int tid, int lane, int wave) {
    const bf16* QK = (const bf16*)(p.ws + WS_QK); const bf16* V = (const bf16*)(p.ws + WS_V); bf16* O = (bf16*)(p.ws + WS_O);
    const int fr = lane & 15, fq = lane >> 4, li_q = (lane & 15) >> 2, li_p = lane & 3;
    for (int u = blockIdx.x; u < BATCH * RH * 8; u += gridDim.x) {
        const int es = u & 7, h = (u >> 3) & 3, b = u >> 5;
        const float gamma = 1.0f - exp2f(-5.0f - (float)h), lg = log2f(gamma), g128 = exp2f(128.f * lg), g127 = exp2f(127.f * lg);
        const int it_ = wave < 4 ? wave : 11 - wave, i0 = 16 * it_, d0 = 32 * wave;
        f32x4 Sacc[2][4];
#pragma unroll
        for (int a = 0; a < 2; ++a)
#pragma unroll
            for (int c = 0; c < 4; ++c) Sacc[a][c] = (f32x4){0.f, 0.f, 0.f, 0.f};
        __syncthreads();
        for (int i = tid; i < 64 * RT_SP / 16; i += NTHR) *(LAS v4u*)(lds + RT_ST_OFF + i * 16) = (v4u){0u, 0u, 0u, 0u};
        v4u kst[8], vst[2];
        const bf16* Kg = QK + 1024 + 256 * h; const bf16* Vg = V + 512 * h + 64 * es; const bf16* Qg = QK + 256 * h;
#define RT_LOAD_STAGE(cc) do { int tl_ = tid; asm volatile("" : "+v"(tl_));     \
            _Pragma("unroll") for (int k_ = 0; k_ < 8; ++k_) { const int id_ = tl_ + 512 * k_, row_ = id_ >> 5, ch_ = id_ & 31, t_ = 128 * (cc) - 112 + row_; \
                kst[k_] = t_ >= 0 ? *(const v4u*)(Kg + (size_t)(b * TP + t_) * 2048 + 8 * ch_) : (v4u){0u, 0u, 0u, 0u}; } \
            _Pragma("unroll") for (int k_ = 0; k_ < 2; ++k_) { const int id_ = tl_ + 512 * k_, row_ = id_ >> 3, ch_ = id_ & 7, t_ = 128 * (cc) - 112 + row_; \
                vst[k_] = t_ >= 0 ? *(const v4u*)(Vg + (size_t)(b * TP + t_) * 2048 + 8 * ch_) : (v4u){0u, 0u, 0u, 0u}; } } while (0)
        RT_LOAD_STAGE(0);
        bf16x8 Qf[8];
#define RT_LOAD_Q(cc) do { int ll_ = lane; asm volatile("" : "+v"(ll_)); const int t_ = 128 * (cc) - 112 + i0 + (ll_ & 15); \
            _Pragma("unroll") for (int s = 0; s < 8; ++s) Qf[s] = t_ >= 0 ? *(const bf16x8*)(Qg + (size_t)(b * TP + t_) * 2048 + 32 * s + 8 * (ll_ >> 4)) : (bf16x8){0, 0, 0, 0, 0, 0, 0, 0}; } while (0)
        RT_LOAD_Q(0);
        for (int c = 0; c < 17; ++c) {
            __syncthreads();
#pragma unroll
            for (int k_ = 0; k_ < 8; ++k_) { const int id_ = tid + 512 * k_, row_ = id_ >> 5, ch_ = id_ & 31; *(LAS v4u*)(lds + RT_K_OFF + row_ * RT_KP + ch_ * 16) = kst[k_]; }
#pragma unroll
            for (int k_ = 0; k_ < 2; ++k_) { const int id_ = tid + 512 * k_, row_ = id_ >> 3, ch_ = id_ & 7;
                float f[8]; unpack8(vst[k_], f); const float sc = exp2f(-(float)row_ * lg);
#pragma unroll
                for (int e = 0; e < 8; ++e) f[e] *= sc;
                *(LAS v4u*)(lds + RT_V_OFF + row_ * RT_VP + ch_ * 16) = pack8(f); }
            __syncthreads();
            bf16x8 Pf[4];
            { const int ii = i0 + fr; const float gi = exp2f((float)ii * lg);
#pragma unroll
              for (int s2 = 0; s2 < 4; ++s2) { f32x4 Dp[2];
                  Dp[0] = (f32x4){0.f, 0.f, 0.f, 0.f}; Dp[1] = Dp[0];
                  if (2 * s2 <= it_) {
                      bf16x8 Ka[8], Kb[8];
#pragma unroll
                      for (int s = 0; s < 8; ++s) { Ka[s] = *(const LAS bf16x8*)(lds + RT_K_OFF + (16 * (2 * s2) + fr) * RT_KP + (32 * s + 8 * fq) * 2);
                          Kb[s] = *(const LAS bf16x8*)(lds + RT_K_OFF + (16 * (2 * s2 + 1) + fr) * RT_KP + (32 * s + 8 * fq) * 2); }
                      __builtin_amdgcn_sched_barrier(0);
                      __builtin_amdgcn_s_setprio(1);
#pragma unroll
                      for (int s = 0; s < 8; ++s) { Dp[0] = __builtin_amdgcn_mfma_f32_16x16x32_bf16(Ka[s], Qf[s], Dp[0], 0, 0, 0); Dp[1] = __builtin_amdgcn_mfma_f32_16x16x32_bf16(Kb[s], Qf[s], Dp[1], 0, 0, 0); }
                      __builtin_amdgcn_s_setprio(0);
                      __builtin_amdgcn_sched_barrier(0);
                  }
                  float f[8];
#pragma unroll
                  for (int hh = 0; hh < 2; ++hh)
#pragma unroll
                      for (int r = 0; r < 4; ++r) { const int jj = 16 * (2 * s2 + hh) + 4 * fq + r; f[hh * 4 + r] = ii >= jj ? Dp[hh][r] * gi : 0.f; }
                  const v4u w = pack8(f); Pf[s2] = __builtin_bit_cast(bf16x8, w); } }
            f32x4 Oacc[4];
#pragma unroll
            for (int ep = 0; ep < 2; ++ep) {
                bf16x8 Sa[8], Sb[8];
#pragma unroll
                for (int s = 0; s < 8; ++s) { Sa[s] = *(const LAS bf16x8*)(lds + RT_ST_OFF + (16 * (2 * ep) + fr) * RT_SP + (32 * s + 8 * fq) * 2);
                    Sb[s] = *(const LAS bf16x8*)(lds + RT_ST_OFF + (16 * (2 * ep + 1) + fr) * RT_SP + (32 * s + 8 * fq) * 2); }
                __builtin_amdgcn_sched_barrier(0);
                f32x4 oa = (f32x4){0.f, 0.f, 0.f, 0.f}, ob = oa;
                __builtin_amdgcn_s_setprio(1);
#pragma unroll
                for (int s = 0; s < 8; ++s) { oa = __builtin_amdgcn_mfma_f32_16x16x32_bf16(Qf[s], Sa[s], oa, 0, 0, 0); ob = __builtin_amdgcn_mfma_f32_16x16x32_bf16(Qf[s], Sb[s], ob, 0, 0, 0); }
                __builtin_amdgcn_s_setprio(0);
                Oacc[2 * ep] = oa; Oacc[2 * ep + 1] = ob;
                __builtin_amdgcn_sched_barrier(0);
            }
            __syncthreads();
            if (c + 1 < 17) RT_LOAD_STAGE(c + 1);
#pragma unroll
            for (int r = 0; r < 4; ++r) { const float lam = exp2f((float)(i0 + 4 * fq + r + 1) * lg);
#pragma unroll
                for (int et = 0; et < 4; ++et) Oacc[et][r] *= lam; }
#pragma unroll
            for (int s = 0; s < 4; ++s) if (2 * s <= it_) {
                bf16x8 Vf[4];
#pragma unroll
                for (int et = 0; et < 4; ++et) { LAS unsigned char* a0 = lds + RT_V_OFF + (32 * s + 4 * fq + li_q) * RT_VP + (16 * et + 4 * li_p) * 2; Vf[et] = tr_pair(a0, a0 + 16 * RT_VP); }
                __builtin_amdgcn_sched_barrier(0);
#pragma unroll
                for (int et = 0; et < 4; ++et) Oacc[et] = __builtin_amdgcn_mfma_f32_16x16x32_bf16(Pf[s], Vf[et], Oacc[et], 0, 0, 0);
            }
            {
                v2u ow[4];
#pragma unroll
                for (int et = 0; et < 4; ++et) { float oq[4] = {Oacc[et][0], Oacc[et][1], Oacc[et][2], Oacc[et][3]}; quad_transpose4(oq, fr & 3); ow[et] = pk4((f32x4){oq[0], oq[1], oq[2], oq[3]}); }
                const int t_ = 128 * c - 112 + i0 + 4 * fq + (fr & 3);
                if (t_ >= 0) { bf16* op = O + (size_t)(b * TP + t_) * RV + 512 * h + 64 * es + (fr & 12);
#pragma unroll
                    for (int et = 0; et < 4; ++et) *(v2u*)(op + 16 * et) = ow[et]; }
            }
#pragma unroll
            for (int dt = 0; dt < 2; ++dt)
#pragma unroll
                for (int et = 0; et < 4; ++et) Sacc[dt][et] = Sacc[dt][et] * (g128 / g127);
            {
                bf16x8 Kt[2][2], Vt[2][4];
#define RT_RD4(bufi, s_) do { \
                _Pragma("unroll") for (int dt = 0; dt < 2; ++dt) { LAS unsigned char* a0 = lds + RT_K_OFF + (32 * (s_) + 8 * fq + li_q) * RT_KP + (d0 + 16 * dt + 4 * li_p) * 2; Kt[bufi][dt] = tr_pair(a0, a0 + 4 * RT_KP); } \
                _Pragma("unroll") for (int et = 0; et < 4; ++et) { LAS unsigned char* a0 = lds + RT_V_OFF + (32 * (s_) + 8 * fq + li_q) * RT_VP + (16 * et + 4 * li_p) * 2; Vt[bufi][et] = tr_pair(a0, a0 + 4 * RT_VP); } } while (0)
                RT_RD4(0, 0);
#pragma unroll
                for (int s = 0; s < 4; ++s) {
                    __builtin_amdgcn_sched_barrier(0);
                    if (s + 1 < 4) RT_RD4((s + 1) & 1, s + 1);
                    __builtin_amdgcn_s_setprio(1);
#pragma unroll
                    for (int dt = 0; dt < 2; ++dt)
#pragma unroll
                        for (int et = 0; et < 4; ++et) Sacc[dt][et] = __builtin_amdgcn_mfma_f32_16x16x32_bf16(Kt[s & 1][dt], Vt[s & 1][et], Sacc[dt][et], 0, 0, 0);
                    __builtin_amdgcn_s_setprio(0);
                }
                __builtin_amdgcn_sched_barrier(0);
#undef RT_RD4
            }
#pragma unroll
            for (int dt = 0; dt < 2; ++dt)
#pragma unroll
                for (int et = 0; et < 4; ++et) Sacc[dt][et] = Sacc[dt][et] * g127;
#pragma unroll
            for (int dt = 0; dt < 2; ++dt)
#pragma unroll
                for (int et = 0; et < 4; ++et) { v2u w; w.x = cvt_pk_bf16(Sacc[dt][et][0], Sacc[dt][et][1]); w.y = cvt_pk_bf16(Sacc[dt][et][2], Sacc[dt][et][3]);
                    *(LAS v2u*)(lds + RT_ST_OFF + (16 * et + fr) * RT_SP + (d0 + 16 * dt + 4 * fq) * 2) = w; }
            if (c + 1 < 17) RT_LOAD_Q(c + 1);
        }
#undef RT_LOAD_Q
#undef RT_LOAD_STAGE
        float* so = p.out + O_RETP + ((((size_t)jl * BATCH + b) * RH + h) * RDK) * RDV + 64 * es;
#pragma unroll
        for (int dt = 0; dt < 2; ++dt)
#pragma unroll
            for (int et = 0; et < 4; ++et)
#pragma unroll
                for (int r = 0; r < 4; ++r) so[(size_t)(d0 + 16 * dt + 4 * fq + r) * RDV + 16 * et + fr] = Sacc[dt][et][r];
    }
    {
        LAS float* sq = (LAS float*)lds; LAS float* sk = sq + 256; LAS float* red = sk + 256;
        const int e4 = tid & 127, dq = tid >> 7;
        for (int it = blockIdx.x; it < SB * RH; it += gridDim.x) {
            const int h = it & 3, s = it >> 2, row = MP + s;
            const float gamma = 1.0f - exp2f(-5.0f - (float)h);
            __syncthreads();
            if (tid < 256) sq[tid] = bf_lo((unsigned)QK[(size_t)row * 2048 + 256 * h + tid]);
            else sk[tid - 256] = bf_lo((unsigned)QK[(size_t)row * 2048 + 1024 + 256 * h + (tid - 256)]);
            const v2u vv = *(const v2u*)(V + (size_t)row * 2048 + 512 * h + 4 * e4);
            const f32x4 v4 = (f32x4){bf_lo(vv.x), bf_hi(vv.x), bf_lo(vv.y), bf_hi(vv.y)};
            __syncthreads();
            const float* sin_ = p.in[I_SRET] + ((((size_t)jl * SB + s) * RH + h) * RDK) * RDV + 4 * e4;
            float* sout = p.out + O_RETS + ((((size_t)jl * SB + s) * RH + h) * RDK) * RDV + 4 * e4;
            f32x4 oacc = (f32x4){0.f, 0.f, 0.f, 0.f};
#pragma unroll 8
            for (int k = 0; k < 64; ++k) { const int d = dq + 4 * k;
                const f32x4 sv = __builtin_nontemporal_load((const f32x4*)(sin_ + (size_t)d * RDV));
                const f32x4 sn = sv * gamma + v4 * sk[d];
                oacc += sn * sq[d];
                __builtin_nontemporal_store(sn, (f32x4*)(sout + (size_t)d * RDV)); }
            *(LAS f32x4*)(red + dq * 512 + 4 * e4) = oacc;
            __syncthreads();
            if (dq == 0) { const f32x4 r = (*(LAS f32x4*)(red + 4 * e4) + *(LAS f32x4*)(red + 512 + 4 * e4)) + (*(LAS f32x4*)(red + 1024 + 4 * e4) + *(LAS f32x4*)(red + 1536 + 4 * e4));
                st_bf4(O + (size_t)row * RV + 512 * h + 4 * e4, r); }
        }
    }
}

typedef float f32x2w __attribute__((ext_vector_type(2)));
constexpr int WK_TB = 32, WK_STEP_B = 6 * 256 + 16, WK_BUF_B = WK_TB * WK_STEP_B, WK_Y_OFF = 2 * WK_BUF_B, WK_YB_B = WK_TB * 32 * 4;
static_assert(WK_Y_OFF + 2 * WK_YB_B <= LDS_BYTES - 16, "wkv LDS map");
__device__ __forceinline__ float row16_sum(float x) {
    x += __builtin_bit_cast(float, __builtin_amdgcn_update_dpp(0, __builtin_bit_cast(int, x), 0x128, 0xf, 0xf, false));
    x += __builtin_bit_cast(float, __builtin_amdgcn_update_dpp(0, __builtin_bit_cast(int, x), 0x124, 0xf, 0xf, false));
    x += __builtin_bit_cast(float, __builtin_amdgcn_update_dpp(0, __builtin_bit_cast(int, x), 0x122, 0xf, 0xf, false));
    x += __builtin_bit_cast(float, __builtin_amdgcn_update_dpp(0, __builtin_bit_cast(int, x), 0x121, 0xf, 0xf, false));
    return x;
}
__device__ __forceinline__ float half8_sum(float x) {
    x += __builtin_bit_cast(float, __builtin_amdgcn_update_dpp(0, __builtin_bit_cast(int, x), 0x141, 0xf, 0xf, false));
    x += __builtin_bit_cast(float, __builtin_amdgcn_update_dpp(0, __builtin_bit_cast(int, x), 0xB1, 0xf, 0xf, false));
    x += __builtin_bit_cast(float, __builtin_amdgcn_update_dpp(0, __builtin_bit_cast(int, x), 0x4E, 0xf, 0xf, false));
    return x;
}
struct WkPar { f32x4 w0, a0, kkp, kap, v0; };
__device__ __forceinline__ f32x4 wk_unit_neg(const f32x4 kraw, const f32x4 kkp) {
    const f32x4 kk = kraw * kkp;
    const float ss = row16_sum((kk.x * kk.x + kk.y * kk.y) + (kk.z * kk.z + kk.w * kk.w));
    return kk * (-rsqrtf(fmaxf(ss, 1e-12f)));
}
__device__ __forceinline__ float wk_decay(float x) { return __expf(-0.60653065971263342f * sigmoidf_(x)); }
__device__ __forceinline__ void wk_prep(const WkPar& P, const f32x4 kraw, const f32x4 vraw, const f32x4 lw2, const f32x4 la2, const f32x4 vf, const f32x4 lv2, bool vres,
                                        f32x4& w, f32x4& ka, f32x4& km, f32x4& vp, f32x4& nk) {
    nk = wk_unit_neg(kraw, P.kkp);
    w = (f32x4){wk_decay(P.w0.x + lw2.x), wk_decay(P.w0.y + lw2.y), wk_decay(P.w0.z + lw2.z), wk_decay(P.w0.w + lw2.w)};
    const f32x4 a = (f32x4){sigmoidf_(P.a0.x + la2.x), sigmoidf_(P.a0.y + la2.y), sigmoidf_(P.a0.z + la2.z), sigmoidf_(P.a0.w + la2.w)};
    ka = nk * (-a);
    km = kraw * ((a - 1.f) * P.kap + 1.f);
    vp = vraw;
    if (vres) { const f32x4 sg = (f32x4){sigmoidf_(P.v0.x + lv2.x), sigmoidf_(P.v0.y + lv2.y), sigmoidf_(P.v0.z + lv2.z), sigmoidf_(P.v0.w + lv2.w)}; vp = vraw + (vf - vraw) * sg; }
}
constexpr int WC_C = 16, WC_NCH = TP / WC_C;
static_assert(WC_NCH * WC_C == TP, "chunking");
constexpr int REC_WA = 0, REC_RP = 2048, REC_BK = 4096, REC_VV = 8192, REC_TK = 10240, REC_MY = 10752, REC_GC = 11264, REC_BYTES = 11520;
constexpr size_t WS_REC = WS_END;
constexpr size_t WS_END2 = WS_REC + (size_t)BATCH * WH * WC_NCH * REC_BYTES;
__device__ __forceinline__ unsigned bf_rne_c(float f) { unsigned u = __float_as_uint(f); return (u + 0x7fffu + ((u >> 16) & 1u)) >> 16; }
__device__ __forceinline__ unsigned pk2_c(float lo, float hi) { return bf_rne_c(lo) | (bf_rne_c(hi) << 16); }
__device__ __forceinline__ float bf_rd(const bf16* q) { return __uint_as_float((unsigned)(*q) << 16); }
__device__ __forceinline__ bf16 bf_of(float x) { return (bf16)(cvt_pk_bf16(x, 0.f) & 0xffffu); }

__device__ __forceinline__ f32x4 mm16(const v2u a, const v2u b, const f32x4 c) { return __builtin_amdgcn_mfma_f32_16x16x16bf16_1k(__builtin_bit_cast(v4s, a), __builtin_bit_cast(v4s, b), c, 0, 0, 0); }
__device__ __forceinline__ f32x4 mm32(const v2u a0, const v2u a1, const v2u b0, const v2u b1, const f32x4 c) {
    const v4u a = (v4u){a0.x, a0.y, a1.x, a1.y}, b = (v4u){b0.x, b0.y, b1.x, b1.y};
    return __builtin_amdgcn_mfma_f32_16x16x32_bf16(__builtin_bit_cast(bf16x8, a), __builtin_bit_cast(bf16x8, b), c, 0, 0, 0);
}
template <int CTRL> __device__ __forceinline__ float dppz(float x) { return __int_as_float(__builtin_amdgcn_update_dpp(0, __float_as_int(x), CTRL, 0xf, 0xf, true)); }
__device__ __forceinline__ float psum16(float x) { x += dppz<0x111>(x); x += dppz<0x112>(x); x += dppz<0x114>(x); x += dppz<0x118>(x); return x; }
__device__ __forceinline__ v2u tr16(LAS unsigned char* a) { return __builtin_bit_cast(v2u, __builtin_amdgcn_ds_read_tr16_b64_v4i16((LAS v4s*)a)); }
__device__ __forceinline__ void ph_wkv1(const Params& p, int jl, LAS unsigned char* lds, int lane_in, int wave) {
    const bf16* Kr = (const bf16*)(p.ws + WS_K); const bf16* Vr = (const bf16*)(p.ws + (jl == 0 ? WS_VF : WS_VB)); const bf16* VFp = (const bf16*)(p.ws + WS_VF);
    const bf16* Rr = (const bf16*)(p.ws + WS_R); const bf16* L2 = (const bf16*)(p.ws + WS_L2);
    float* BON = (float*)(p.ws + WS_NKK); bf16* VP = (bf16*)(p.ws + WS_KKA);
    const bool vres = jl == 1;
    constexpr int IMG = 16 * 144;
    constexpr float CL2 = 0.60653065971263342f * 1.4426950408889634f;
    const int gw = wave * gridDim.x + blockIdx.x, NGW = gridDim.x * NWAVES;
    v4u wK[2], wLW[2], wLA[2], wR[2], wV[2], wVF[2], wLV[2];
#define W1_LOAD_RAW(jb, lnx) do { const int c_ = (jb) % WC_NCH, sh_ = (jb) / WC_NCH, r_ = (sh_ >> 4) * TP + WC_C * c_ + ((lnx) & 15), fq_ = (lnx) >> 4, cb_ = (sh_ & 15) * WN + (fq_ & 1) * 16 + (fq_ >> 1) * 8; \
        const size_t ro_ = (size_t)r_ * D + cb_, lo_ = (size_t)r_ * NL2 + cb_; \
        _Pragma("unroll") for (int P = 0; P < 2; ++P) { wK[P] = *(const v4u*)(Kr + ro_ + 32 * P); wLW[P] = *(const v4u*)(L2 + lo_ + 32 * P); wLA[P] = *(const v4u*)(L2 + lo_ + 1024 + 32 * P); \
            wR[P] = *(const v4u*)(Rr + ro_ + 32 * P); wV[P] = *(const v4u*)(Vr + ro_ + 32 * P); wVF[P] = (v4u){0u, 0u, 0u, 0u}; wLV[P] = (v4u){0u, 0u, 0u, 0u}; } \
        if (vres) { _Pragma("unroll") for (int P = 0; P < 2; ++P) { wVF[P] = *(const v4u*)(VFp + ro_ + 32 * P); wLV[P] = *(const v4u*)(L2 + lo_ + 3072 + 32 * P); } } } while (0)
#define W1_UNSWAP(QQ_, WW_) do { _Pragma("unroll") for (int P = 0; P < 2; ++P) { const v4u wv_ = WW_[P]; const auto s0_ = __builtin_amdgcn_permlane16_swap(wv_[0], wv_[2], false, false), s1_ = __builtin_amdgcn_permlane16_swap(wv_[1], wv_[3], false, false); \
        QQ_[2 * P] = (v2u){s0_[0], s1_[0]}; QQ_[2 * P + 1] = (v2u){s0_[1], s1_[1]}; } } while (0)
    if (gw < BATCH * WH * WC_NCH) { int l0 = lane_in; asm volatile("" : "+v"(l0)); W1_LOAD_RAW(gw, l0); }
    for (int job = gw; job < BATCH * WH * WC_NCH; job += NGW) {
        int ln = lane_in; asm volatile("" : "+v"(ln));
        const int lane = ln, fr = lane & 15, fq = lane >> 4;
        const int c = job % WC_NCH, sh = job / WC_NCH, h = sh & 15, seq = sh >> 4, r0 = seq * TP + WC_C * c, chb = h * WN + 4 * fq;
        LAS unsigned char* sc = lds + wave * 16384;
        unsigned char* rec = p.ws + WS_REC + (size_t)job * REC_BYTES;
        const size_t ro = (size_t)(r0 + fr) * D + chb, lo = (size_t)(r0 + fr) * NL2 + chb, po = (size_t)jl * D + chb;
        f32x4 cKK[4], cW0[4], cA0[4], cKA[4], cRK[4];
#pragma unroll
        for (int jt = 0; jt < 4; ++jt) { cKK[jt] = *(const f32x4*)(p.in[I_KK] + po + 16 * jt); cW0[jt] = *(const f32x4*)(p.in[I_W0] + po + 16 * jt); cA0[jt] = *(const f32x4*)(p.in[I_A0] + po + 16 * jt);
            cKA[jt] = *(const f32x4*)(p.in[I_KA] + po + 16 * jt); cRK[jt] = *(const f32x4*)(p.in[I_RK] + po + 16 * jt); }
#define W1_UP4(q) ((f32x4){bf_lo((q).x), bf_hi((q).x), bf_lo((q).y), bf_hi((q).y)})
        v2u qK[4], qLW[4], qLA[4], qR[4], qV[4], qVF[4], qLV[4];
        W1_UNSWAP(qK, wK); W1_UNSWAP(qLW, wLW); W1_UNSWAP(qLA, wLA); W1_UNSWAP(qR, wR); W1_UNSWAP(qV, wV); W1_UNSWAP(qVF, wVF); W1_UNSWAP(qLV, wLV);
        f32x4 kraw[4], kk[4];
        float ss = 0.f;
#pragma unroll
        for (int jt = 0; jt < 4; ++jt) { kraw[jt] = W1_UP4(qK[jt]); kk[jt] = kraw[jt] * cKK[jt];
            ss += (kk[jt].x * kk[jt].x + kk[jt].y * kk[jt].y) + (kk[jt].z * kk[jt].z + kk[jt].w * kk[jt].w); }
        ss += shfl_xor_l(ss, 16, lane); ss += shfl_xor_l(ss, 32, lane);
        const float inv = rsqrtf(fmaxf(ss, 1e-12f));
        v2u pa[4], pb[4], pk[4], pr[4], pvp[4]; f32x4 rt[4], ggv[4];
        float bonp = 0.f;
        LAS unsigned char* iw = sc + fr * 144 + 8 * fq;
#pragma unroll
        for (int jt = 0; jt < 4; ++jt) {
            const f32x4 lw2 = W1_UP4(qLW[jt]), la2 = W1_UP4(qLA[jt]), rr = W1_UP4(qR[jt]), vraw = W1_UP4(qV[jt]);
            const f32x4 pw0 = cW0[jt], pa0 = cA0[jt], pka = cKA[jt], prk = cRK[jt];
            f32x4 vp = vraw;
            if (vres) { const f32x4 vf = W1_UP4(qVF[jt]), lv2 = W1_UP4(qLV[jt]), pv0 = *(const f32x4*)(p.in[I_V0] + chb + 16 * jt);
#pragma unroll
                for (int e = 0; e < 4; ++e) vp[e] = vraw[e] + (vf[e] - vraw[e]) * sigmoidf_(pv0[e] + lv2[e]); }
            f32x4 at, bt, kt, kq, rq, gg;
#pragma unroll
            for (int e = 0; e < 4; ++e) {
                const float a = sigmoidf_(pa0[e] + la2[e]), d = CL2 * sigmoidf_(pw0[e] + lw2[e]), cum = psum16(d);
                const float g = __builtin_amdgcn_exp2f(-cum), ig = __builtin_amdgcn_exp2f(cum), gp = __builtin_amdgcn_exp2f(d - cum), nk = -kk[jt][e] * inv;
                kt[e] = kraw[jt][e] * (1.f + (a - 1.f) * pka[e]);
                bonp = fmaf(rr[e] * kt[e], prk[e], bonp);
                at[e] = nk * gp; bt[e] = -nk * a * ig; kq[e] = kt[e] * ig; rq[e] = rr[e] * g; gg[e] = g;
            }
            pa[jt] = pk4(at); pb[jt] = pk4(bt); pk[jt] = pk4(kq); pr[jt] = pk4(rq); rt[jt] = rq; pvp[jt] = pk4(vp); ggv[jt] = gg;
            *(LAS v2u*)(iw + 0 * IMG + 32 * jt) = pa[jt]; *(LAS v2u*)(iw + 1 * IMG + 32 * jt) = pb[jt]; *(LAS v2u*)(iw + 2 * IMG + 32 * jt) = pk[jt]; *(LAS v2u*)(iw + 3 * IMG + 32 * jt) = pvp[jt];
        }
#undef W1_UP4
        if (job + NGW < BATCH * WH * WC_NCH) W1_LOAD_RAW(job + NGW, lane);
        if (vres) {
#pragma unroll
            for (int P = 0; P < 2; ++P) { const auto t0 = __builtin_amdgcn_permlane16_swap(pvp[2 * P].x, pvp[2 * P + 1].x, false, false), t1 = __builtin_amdgcn_permlane16_swap(pvp[2 * P].y, pvp[2 * P + 1].y, false, false);
                *(v4u*)(VP + (size_t)(r0 + fr) * D + h * WN + (fq & 1) * 16 + (fq >> 1) * 8 + 32 * P) = (v4u){t0[0], t1[0], t0[1], t1[1]}; }
        }
#pragma unroll
        for (int jt = 0; jt < 4; ++jt) if (fr == 15) *(f32x4*)(rec + REC_GC + (16 * jt + 4 * fq) * 4) = ggv[jt];
        bonp += shfl_xor_l(bonp, 16, lane); bonp += shfl_xor_l(bonp, 32, lane);
        if (fq == 0) BON[(size_t)(r0 + fr) * WH + h] = bonp;
        const f32x4 z4 = (f32x4){0.f, 0.f, 0.f, 0.f};
        const int dd = fr - 4 * fq;
        f32x4 L = mm32(pa[2], pa[3], pb[2], pb[3], mm32(pa[0], pa[1], pb[0], pb[1], z4));
        f32x4 LT = mm32(pb[2], pb[3], pa[2], pa[3], mm32(pb[0], pb[1], pa[0], pa[1], z4));
        f32x4 Lak = mm32(pa[2], pa[3], pk[2], pk[3], mm32(pa[0], pa[1], pk[0], pk[1], z4));
        f32x4 MrbT = mm32(pb[2], pb[3], pr[2], pr[3], mm32(pb[0], pb[1], pr[0], pr[1], z4));
        f32x4 MrkT = mm32(pk[2], pk[3], pr[2], pr[3], mm32(pk[0], pk[1], pr[0], pr[1], z4));
        f32x4 TT;
#pragma unroll
        for (int r = 0; r < 4; ++r) {
            L[r] = dd < r ? L[r] : 0.f; Lak[r] = dd < r ? Lak[r] : 0.f;
            LT[r] = r < dd ? LT[r] : 0.f; MrbT[r] = r <= dd ? MrbT[r] : 0.f; MrkT[r] = r <= dd ? MrkT[r] : 0.f;
            TT[r] = LT[r] + (r == dd ? 1.f : 0.f);
        }
        const v2u bL = pk4(L), bLT = pk4(LT), bLak = pk4(Lak);
        const f32x4 L2m = mm16(bLT, bL, z4), L2T = mm16(bL, bLT, z4);
        const v2u bL2 = pk4(L2m), bL2T = pk4(L2T);
        const f32x4 L4m = mm16(bL2T, bL2, z4), L4T = mm16(bL2, bL2T, z4);
        const v2u bL4 = pk4(L4m), bL4T = pk4(L4T);
        const v2u bL8 = pk4(mm16(bL4T, bL4, z4));
        TT = mm16(bL2, pk4(TT), TT); TT = mm16(bL4, pk4(TT), TT); TT = mm16(bL8, pk4(TT), TT);
        f32x4 Zm = mm16(bL, pk4(MrbT), MrbT); Zm = mm16(bL2, pk4(Zm), Zm); Zm = mm16(bL4, pk4(Zm), Zm); Zm = mm16(bL8, pk4(Zm), Zm);
        const v2u bTT = pk4(TT), bMtT = pk4(Zm);
        *(v2u*)(rec + REC_TK + lane * 8) = pk4(mm16(bLak, bTT, z4)); *(v2u*)(rec + REC_MY + lane * 8) = pk4(mm16(bLak, bMtT, MrkT));
        LAS unsigned char* ir = sc + (4 * fq + ((lane & 15) >> 2)) * 144 + 8 * (lane & 3);
        v2u wat[4], rpt[4];
#pragma unroll
        for (int jt = 0; jt < 4; ++jt) {
            const v2u Qa = tr16(ir + 0 * IMG + 32 * jt), Qb = tr16(ir + 1 * IMG + 32 * jt), Qk = tr16(ir + 2 * IMG + 32 * jt);
            wat[jt] = pk4(mm16(Qa, bTT, z4)); rpt[jt] = pk4(mm16(Qa, bMtT, rt[jt]));
            *(v4u*)(rec + REC_BK + (jt * 64 + lane) * 16) = (v4u){Qb.x, Qb.y, Qk.x, Qk.y};
        }
#pragma unroll
        for (int s = 0; s < 2; ++s) {
            *(v4u*)(rec + REC_WA + (s * 64 + lane) * 16) = (v4u){wat[2 * s].x, wat[2 * s].y, wat[2 * s + 1].x, wat[2 * s + 1].y};
            *(v4u*)(rec + REC_RP + (s * 64 + lane) * 16) = (v4u){rpt[2 * s].x, rpt[2 * s].y, rpt[2 * s + 1].x, rpt[2 * s + 1].y};
        }
#pragma unroll
        for (int it = 0; it < 4; ++it) {
            const v2u Qv = tr16(ir + 3 * IMG + 32 * it);
            *(v2u*)(rec + REC_VV + (it * 64 + lane) * 8) = Qv;

        }
    }
}

#undef W1_LOAD_RAW
#undef W1_UNSWAP
__device__ __forceinline__ void ph_wkv2(const Params& p, int jl, int lane, int wave) {
    const bf16* Kr = (const bf16*)(p.ws + WS_K); const bf16* Vr = (const bf16*)(p.ws + (jl == 0 ? WS_VF : WS_VB)); const bf16* VFp = (const bf16*)(p.ws + WS_VF);
    const bf16* Rr = (const bf16*)(p.ws + WS_R); const bf16* L2 = (const bf16*)(p.ws + WS_L2);
    float* BON = (float*)(p.ws + WS_NKK); bf16* VP = (bf16*)(p.ws + WS_KKA);
    const bool vres = jl == 1; const int ri = lane >> 4, cg = lane & 15;
    bf16* YW = (bf16*)(p.ws + WS_YW);
    const int fr = lane & 15, fq = lane >> 4;
    const int gw = blockIdx.x * NWAVES + wave, NGW = gridDim.x * NWAVES;
    for (int job = wave < 2 ? blockIdx.x * 2 + wave : BATCH * WH * 4; job < BATCH * WH * 4; job += gridDim.x * 2) {
        const int it = job & 3, h = (job >> 2) & 15, seq = job >> 6, r0 = seq * TP;
        const unsigned char* rec = p.ws + WS_REC + (size_t)((seq * WH + h) * WC_NCH) * REC_BYTES;
        f32x4 Sacc[4];
#pragma unroll
        for (int jt = 0; jt < 4; ++jt) Sacc[jt] = (f32x4){0.f, 0.f, 0.f, 0.f};
        struct WRec { v4u wa0, wa1, rp0, rp1, bk0, bk1, bk2, bk3; v2u vv, tk, my; f32x4 g0, g1, g2, g3; };
        WRec RA, RB;
#define WC_LOAD(S, rc) do { const unsigned char* r_ = (rc); \
            S.wa0 = *(const v4u*)(r_ + REC_WA + lane * 16); S.wa1 = *(const v4u*)(r_ + REC_WA + 1024 + lane * 16); S.rp0 = *(const v4u*)(r_ + REC_RP + lane * 16); S.rp1 = *(const v4u*)(r_ + REC_RP + 1024 + lane * 16); \
            S.bk0 = *(const v4u*)(r_ + REC_BK + (0 * 64 + lane) * 16); S.bk1 = *(const v4u*)(r_ + REC_BK + (1 * 64 + lane) * 16); S.bk2 = *(const v4u*)(r_ + REC_BK + (2 * 64 + lane) * 16); S.bk3 = *(const v4u*)(r_ + REC_BK + (3 * 64 + lane) * 16); \
            S.g0 = *(const f32x4*)(r_ + REC_GC + (0 + 4 * fq) * 4); S.g1 = *(const f32x4*)(r_ + REC_GC + (16 + 4 * fq) * 4); S.g2 = *(const f32x4*)(r_ + REC_GC + (32 + 4 * fq) * 4); S.g3 = *(const f32x4*)(r_ + REC_GC + (48 + 4 * fq) * 4); \
            S.vv = *(const v2u*)(r_ + REC_VV + (it * 64 + lane) * 8); S.tk = *(const v2u*)(r_ + REC_TK + lane * 8); S.my = *(const v2u*)(r_ + REC_MY + lane * 8); } while (0)
#define WC_STEP(S, T, cc) do { const int c_ = (cc); \
            if (c_ > 0) *(v2u*)(YW + (size_t)(r0 + WC_C * (c_ - 1) + 4 * fq + (fr & 3)) * D + h * WN + 16 * it + (fr & 12)) = ypk;     \
            if (c_ + 1 < WC_NCH) WC_LOAD(T, rec + (size_t)(c_ + 1) * REC_BYTES); \
            const f32x4 zz4 = (f32x4){0.f, 0.f, 0.f, 0.f}, cu0 = mm16(S.tk, S.vv, zz4) + 0.f, cy0 = mm16(S.my, S.vv, zz4) + 0.f;     \
            v4u sb0, sb1; \
            { const v2u q0 = pk4(Sacc[0]), q1 = pk4(Sacc[1]), q2 = pk4(Sacc[2]), q3 = pk4(Sacc[3]); sb0 = (v4u){q0.x, q0.y, q1.x, q1.y}; sb1 = (v4u){q2.x, q2.y, q3.x, q3.y}; } \
            const bf16x8 B0 = __builtin_bit_cast(bf16x8, sb0), B1 = __builtin_bit_cast(bf16x8, sb1); \
            f32x4 U = __builtin_amdgcn_mfma_f32_16x16x32_bf16(__builtin_bit_cast(bf16x8, S.wa0), B0, cu0, 0, 0, 0); \
            U = __builtin_amdgcn_mfma_f32_16x16x32_bf16(__builtin_bit_cast(bf16x8, S.wa1), B1, U, 0, 0, 0); \
            f32x4 Y = __builtin_amdgcn_mfma_f32_16x16x32_bf16(__builtin_bit_cast(bf16x8, S.rp0), B0, cy0, 0, 0, 0); \
            Y = __builtin_amdgcn_mfma_f32_16x16x32_bf16(__builtin_bit_cast(bf16x8, S.rp1), B1, Y, 0, 0, 0); \
            v4u ub; { const v2u qu = pk4(U); ub.x = qu.x; ub.y = qu.y; } ub.z = S.vv.x; ub.w = S.vv.y; \
            const bf16x8 UB = __builtin_bit_cast(bf16x8, ub); \
            Sacc[0] = __builtin_amdgcn_mfma_f32_16x16x32_bf16(__builtin_bit_cast(bf16x8, S.bk0), UB, Sacc[0], 0, 0, 0) * S.g0; \
            Sacc[1] = __builtin_amdgcn_mfma_f32_16x16x32_bf16(__builtin_bit_cast(bf16x8, S.bk1), UB, Sacc[1], 0, 0, 0) * S.g1; \
            Sacc[2] = __builtin_amdgcn_mfma_f32_16x16x32_bf16(__builtin_bit_cast(bf16x8, S.bk2), UB, Sacc[2], 0, 0, 0) * S.g2; \
            Sacc[3] = __builtin_amdgcn_mfma_f32_16x16x32_bf16(__builtin_bit_cast(bf16x8, S.bk3), UB, Sacc[3], 0, 0, 0) * S.g3; \
            { float yq[4] = {Y[0], Y[1], Y[2], Y[3]}; quad_transpose4(yq, fr & 3); ypk = pk4((f32x4){yq[0], yq[1], yq[2], yq[3]}); } } while (0)
        static_assert(WC_NCH % 2 == 1, "chunk loop unrolled by two plus one");
        WC_LOAD(RA, rec);
        v2u ypk = (v2u){0u, 0u};
        for (int c = 0; c + 1 < WC_NCH; c += 2) { WC_STEP(RA, RB, c); WC_STEP(RB, RA, c + 1); }
        WC_STEP(RA, RB, WC_NCH - 1);
        *(v2u*)(YW + (size_t)(r0 + WC_C * (WC_NCH - 1) + 4 * fq + (fr & 3)) * D + h * WN + 16 * it + (fr & 12)) = ypk;
#undef WC_STEP
#undef WC_LOAD
        float* so = p.out + O_WKVP + ((((size_t)jl * BATCH + seq) * WH + h) * WN + 16 * it + fr) * WN + 4 * fq;
#pragma unroll
        for (int jt = 0; jt < 4; ++jt) *(f32x4*)(so + 16 * jt) = Sacc[jt];
    }
    if (wave >= 2) {
        const int gws = blockIdx.x * (NWAVES - 2) + (wave - 2), NGWS = gridDim.x * (NWAVES - 2);
        constexpr int UB = 4;
        for (int it0 = gws; it0 < SB * WH * 16; it0 += NGWS * UB) {
            v2u qk[UB], qv[UB], qr[UB], qlw[UB], qla[UB], qvf[UB], qlv[UB]; f32x4 qS[UB];
#pragma unroll
            for (int q = 0; q < UB; ++q) { const int it_ = it0 + q * NGWS, itc = it_ < SB * WH * 16 ? it_ : it0;
                const int rg = itc & 15, h = (itc >> 4) & 15, s = itc >> 8, row = MP + s, i = 4 * rg + ri, ch = h * WN + 4 * cg;
                const size_t vo = (size_t)row * D + ch, lo = (size_t)row * NL2 + ch;
                qk[q] = *(const v2u*)(Kr + vo); qv[q] = *(const v2u*)(Vr + vo); qr[q] = *(const v2u*)(Rr + vo); qlw[q] = *(const v2u*)(L2 + lo); qla[q] = *(const v2u*)(L2 + lo + 1024);
                qvf[q] = (v2u){0u, 0u}; qlv[q] = (v2u){0u, 0u};
                if (vres) { qvf[q] = *(const v2u*)(VFp + vo); qlv[q] = *(const v2u*)(L2 + lo + 3072); }
                qS[q] = *(const f32x4*)(p.in[I_SWKV] + ((((size_t)jl * SB + s) * WH + h) * WN + i) * WN + 4 * cg); }
#pragma unroll
            for (int q = 0; q < UB; ++q) { const int it = it0 + q * NGWS; if (it < SB * WH * 16) {
                const int rg = it & 15, h = (it >> 4) & 15, s = it >> 8, row = MP + s, i = 4 * rg + ri;
                const int ch = h * WN + 4 * cg;
                WkPar P; P.w0 = *(const f32x4*)(p.in[I_W0] + (size_t)jl * D + ch); P.a0 = *(const f32x4*)(p.in[I_A0] + (size_t)jl * D + ch); P.kkp = *(const f32x4*)(p.in[I_KK] + (size_t)jl * D + ch);
                P.kap = *(const f32x4*)(p.in[I_KA] + (size_t)jl * D + ch); P.v0 = *(const f32x4*)(p.in[I_V0] + ch);
                const size_t vo = (size_t)row * D + ch;
#define W2_UP4(w) ((f32x4){bf_lo((w).x), bf_hi((w).x), bf_lo((w).y), bf_hi((w).y)})
                const f32x4 kraw = W2_UP4(qk[q]), vraw = W2_UP4(qv[q]), r4 = W2_UP4(qr[q]), lw2 = W2_UP4(qlw[q]), la2 = W2_UP4(qla[q]), vf = W2_UP4(qvf[q]), lv2 = W2_UP4(qlv[q]);
#undef W2_UP4
                f32x4 w4, ka, k4, vp, nk; wk_prep(P, kraw, vraw, lw2, la2, vf, lv2, vres, w4, ka, k4, vp, nk);
                const int srcl = (lane & 48) | rg;
                const float v0_ = shfl_l(vp.x, srcl), v1_ = shfl_l(vp.y, srcl), v2_ = shfl_l(vp.z, srcl), v3_ = shfl_l(vp.w, srcl);
                const float vi = ri == 0 ? v0_ : (ri == 1 ? v1_ : (ri == 2 ? v2_ : v3_));
                const size_t so = ((((size_t)jl * SB + s) * WH + h) * WN + i) * WN + 4 * cg;
                f32x4 S = qS[q];
                const float sa = row16_sum((S.x * nk.x + S.y * nk.y) + (S.z * nk.z + S.w * nk.w));
                S.x = fmaf(S.x, w4.x, fmaf(sa, ka.x, vi * k4.x)); S.y = fmaf(S.y, w4.y, fmaf(sa, ka.y, vi * k4.y));
                S.z = fmaf(S.z, w4.z, fmaf(sa, ka.z, vi * k4.z)); S.w = fmaf(S.w, w4.w, fmaf(sa, ka.w, vi * k4.w));
                const float y = row16_sum((S.x * r4.x + S.y * r4.y) + (S.z * r4.z + S.w * r4.w));
                *(f32x4*)(p.out + O_WKVS + so) = S;
                if (cg == 0) YW[(size_t)row * D + h * WN + i] = bf_cv(y);
                const f32x4 rk4 = *(const f32x4*)(p.in[I_RK] + (size_t)jl * D + ch);
                const float bon = row16_sum((r4.x * k4.x * rk4.x + r4.y * k4.y * rk4.y) + (r4.z * k4.z * rk4.z + r4.w * k4.w * rk4.w));
                if (rg == 0 && ri == 0) { if (vres) st_bf4(VP + vo, vp); if (cg == 0) BON[(size_t)row * WH + h] = bon; }
            } }
        }
    }
}

typedef __attribute__((address_space(1))) unsigned gu32;
#define XB_TMO      128
#define XB_XCNT(j)  (256  + 64 * (j))
#define XB_XSUB(j)  (1280 + 64 * (j))
#define XB_XGEN(j)  (2304 + 64 * (j))
#define XB_TOP      3328
#define XB_TOPGEN   3392
#define XCD_BAR_WORDS 3456
#define XB_SPIN_CAP (1u << 18)

__device__ __forceinline__ unsigned xb_ld(unsigned* p)              { return __hip_atomic_load(p, __ATOMIC_RELAXED, __HIP_MEMORY_SCOPE_AGENT); }
__device__ __forceinline__ unsigned xb_add(unsigned* p, unsigned v) { return __hip_atomic_fetch_add(p, v, __ATOMIC_RELAXED, __HIP_MEMORY_SCOPE_AGENT); }
__device__ __forceinline__ unsigned xb_xcc_id() { return (unsigned)__builtin_amdgcn_s_getreg((3 << 11) | 20) & 0xFu; }
#define XB_SPIN(cond, bar) do { unsigned _sp = 0; while (cond) { __builtin_amdgcn_s_sleep(1); \
    if ((++_sp & 255u) == 0u) { if (xb_ld(&(bar)[XB_TMO])) break; if (_sp > XB_SPIN_CAP) { atomicAdd(&(bar)[XB_TMO], 1u); break; } } } } while (0)

struct XcdBarrier {
    bool tid0; unsigned* bar; unsigned x;
    volatile LAS unsigned* st;
};

__device__ __forceinline__ XcdBarrier xcd_barrier_post(unsigned* bar, volatile LAS unsigned* st, bool tid0) {
    XcdBarrier b; b.tid0 = tid0; b.bar = bar; b.x = xb_xcc_id(); b.st = st;
    if (b.tid0) (void)xb_add(&bar[XB_XCNT(b.x)], 1u);
    return b;
}
__device__ __forceinline__ void xcd_barrier_complete(unsigned* bar, unsigned x, unsigned& nloc, unsigned& nx) {
    const unsigned G = gridDim.x * gridDim.y * gridDim.z;
    unsigned sum, cnt, mine, sp = 0u;
    for (;;) {
        sum = 0u; cnt = 0u; mine = 0u;
#pragma unroll
        for (unsigned j = 0; j < 16; ++j) { const unsigned c = xb_ld(&bar[XB_XCNT(j)]); sum += c; cnt += (c > 0u) ? 1u : 0u; mine = (j == x) ? c : mine; }
        if (sum == G) break;
        __builtin_amdgcn_s_sleep(1);
        if ((++sp & 255u) == 0u) { if (xb_ld(&bar[XB_TMO])) break; if (sp > XB_SPIN_CAP) { atomicAdd(&bar[XB_TMO], 1u); break; } }
    }
    nloc = mine > 0u ? mine : 1u; nx = cnt > 0u ? cnt : 1u;
}

__device__ __forceinline__ void xcd_barrier(const XcdBarrier& b) {
    asm volatile("s_waitcnt vmcnt(0)" ::: "memory");
    __syncthreads();
    if (b.tid0) {
        unsigned* bar = b.bar;
        __builtin_amdgcn_s_waitcnt(0);
        unsigned nloc = b.st[0], nx = b.st[1];
        if (nloc == 0u) { xcd_barrier_complete(bar, b.x, nloc, nx); b.st[0] = nloc; b.st[1] = nx; }
        const unsigned old = xb_add(&bar[XB_XSUB(b.x)], 1u);
        const unsigned gen = old / nloc;
        if (old + 1u == (gen + 1u) * nloc) {
            __builtin_amdgcn_fence(__ATOMIC_RELEASE, "agent");
            asm volatile("s_waitcnt vmcnt(0)" ::: "memory");
            const unsigned og = xb_add(&bar[XB_TOP], 1u);
            const unsigned tg = og / nx;
            if (og + 1u == (tg + 1u) * nx) xb_add(&bar[XB_TOPGEN], 1u);
            else XB_SPIN(xb_ld(&bar[XB_TOPGEN]) == tg, bar);
            __builtin_amdgcn_fence(__ATOMIC_ACQUIRE, "agent");
            xb_add(&bar[XB_XGEN(b.x)], 1u);
            asm volatile("s_waitcnt vmcnt(0)" ::: "memory");
        } else {
            XB_SPIN(xb_ld(&bar[XB_XGEN(b.x)]) == gen, bar);
            __builtin_amdgcn_fence(__ATOMIC_ACQUIRE, "agent");
            asm volatile("s_waitcnt vmcnt(0)" ::: "memory");
        }
    }
    __syncthreads();
}

enum { OP_P0 = 0, OP_NORM_RET, OP_G_RETIN, OP_RET, OP_RETNORM, OP_G_RETOUT, OP_NORM_RW, OP_G_RWPROJ, OP_G_LORA2, OP_PREP, OP_WKV, OP_WKV2, OP_POST, OP_G_WO,
       OP_NORM_FFN, OP_G_UG, OP_CONV, OP_G_WD, OP_FINAL };
struct Ph { unsigned char op, layer; };
constexpr int NPH = 1 + 2 * 6 + 2 * 9 + 1;
__device__ __host__ inline Ph phase_at(int i) {
    if (i == 0) return Ph{OP_P0, 0};
    i -= 1;
    int l;
    if (i < 6) l = 0; else if (i < 15) { l = 1; i -= 6; } else if (i < 21) { l = 2; i -= 15; } else if (i < 30) { l = 3; i -= 21; } else return Ph{OP_FINAL, 0};
    int op = OP_FINAL;
    if ((l & 1) == 0) {
        switch (i) { case 0: op = OP_G_RETIN; break; case 1: op = OP_RET; break; case 2: op = OP_RETNORM; break; case 3: op = OP_G_RETOUT; break;
                     case 4: op = OP_G_UG; break; default: op = OP_G_WD; break; }
    } else {
        switch (i) { case 0: op = OP_NORM_RW; break; case 1: op = OP_G_RWPROJ; break; case 2: op = OP_G_LORA2; break; case 3: op = OP_WKV; break; case 4: op = OP_WKV2; break; case 5: op = OP_POST; break; case 6: op = OP_G_WO; break;
                     case 7: op = OP_G_UG; break; default: op = OP_G_WD; break; }
    }
    return Ph{(unsigned char)op, (unsigned char)l};
}

__global__ void __launch_bounds__(NTHR, 2) mega(Params p, int lo, int hi) {
    extern __shared__ __attribute__((aligned(16))) unsigned char lds_raw[];
    LAS unsigned char* lds = (LAS unsigned char*)lds_raw;
    volatile LAS unsigned* bst = (volatile LAS unsigned*)(lds + LDS_BYTES - 16);
    const int wave0 = __builtin_amdgcn_readfirstlane((int)threadIdx.x >> 6);
    if (threadIdx.x < 4) bst[threadIdx.x] = 0u;
    __syncthreads();
    (void)xcd_barrier_post((unsigned*)(p.ws + WS_CTL), bst, threadIdx.x == 0);
    for (int ph = lo; ph < hi; ++ph) {
        int lid_; asm volatile("v_mbcnt_lo_u32_b32 %0, -1, 0\n\tv_mbcnt_hi_u32_b32 %0, -1, %0" : "=v"(lid_));
        int tid = wave0 * 64 + lid_; asm volatile("" : "+v"(tid));
        const int lane = tid & 63, wave = __builtin_amdgcn_readfirstlane(tid >> 6);
        unsigned char* ws = p.ws;
        const Ph P = phase_at(ph);
        const int li = P.layer, jl = li >> 1;
        const bf16* gA = nullptr; const bf16* gB = nullptr; int gN = 0, gK = 0; EpiAnyT<0> E{}; E.jl = jl; E.ws = ws; E.slot = -1; E.amul = 1.f; E.li = li; E.ldsb = lds; bool is_gemm = false;
        switch (P.op) {
        case OP_P0: ph_p0(p, lds, tid, lane, wave); break;
        case OP_NORM_RET: ph_norm(p, p.in[I_NMIX] + (size_t)li * D, 0, jl, lane, wave); break;
        case OP_NORM_FFN: ph_norm(p, p.in[I_NFFN] + (size_t)li * D, 0, jl, lane, wave); break;
        case OP_NORM_RW: ph_norm(p, p.in[I_NMIX] + (size_t)li * D, 1, jl, lane, wave); break;
        case OP_FINAL: ph_norm(p, p.in[I_NFIN], 2, 0, lane, wave); break;
        case OP_RETNORM: ph_ret_norm(p, jl, lane, wave); break;
        case OP_POST: ph_rwkv_post(p, jl, lane, wave); break;
        case OP_RET: ph_ret_fast(p, jl, lds, tid, lane, wave); break;
        case OP_WKV: ph_wkv1(p, jl, lds, lane, wave); break;
        case OP_WKV2: ph_wkv2(p, jl, lane, wave); break;
        case OP_G_RETIN: is_gemm = true; E.kind = EK_RETIN; E.perm = true; E.slot = 2 * li;
            gA = (const bf16*)(ws + WS_XB); gB = (const bf16*)(ws + WS_WIN + jl * SZ_WIN); gN = RWIN; gK = D; break;
        case OP_G_RETOUT: is_gemm = true; E.kind = EK_RESID; E.perm = false; E.slot = 2 * li + 1;
            gA = (const bf16*)(ws + WS_Y); gB = (const bf16*)(ws + WS_WOUT + jl * SZ_WOUT); gN = D; gK = RV; break;
        case OP_G_RWPROJ: is_gemm = true; E.kind = EK_RWPROJ; E.perm = true;
            gA = (const bf16*)(ws + WS_H) + D; gB = (const bf16*)(ws + WS_WRW + jl * SZ_WRW); gN = NRW; gK = KRW; break;
        case OP_G_LORA2: is_gemm = true; E.kind = EK_F32; E.perm = true;
            gA = (const bf16*)(ws + WS_A2); gB = (const bf16*)(ws + WS_WL2 + jl * SZ_WL2); gN = (jl == 0 ? 3072 : 4096); gK = KL2; break;
        case OP_G_WO: is_gemm = true; E.kind = EK_RESID; E.perm = false; E.slot = 2 * li + 1;
            gA = (const bf16*)(ws + WS_Z); gB = (const bf16*)(ws + WS_WO + jl * SZ_WO); gN = D; gK = D; break;
        case OP_G_UG: is_gemm = true; E.kind = EK_UG; E.perm = true; E.slot = 2 * li + 1;
            gA = (const bf16*)(ws + WS_XB); gB = (const bf16*)(ws + WS_WUG + li * SZ_WUG); gN = 2 * DFF; gK = D; break;
        case OP_G_WD: is_gemm = true; E.kind = EK_RESID; E.perm = false; E.slot = (li == 1) ? 2 * (li + 1) : -1;
            gA = (const bf16*)(ws + WS_ACT); gB = (const bf16*)(ws + WS_WD + li * SZ_WD); gN = D; gK = DFF; break;
        default: break;
        }
        if (is_gemm) {
            const bool ug = E.kind == EK_UG;
            const bool rwp = E.kind == EK_RWPROJ;
            const int gM = (E.kind == EK_RESID) ? MT0 : (ug ? 66 * 256 : (rwp ? HP_M : M));
            pg8::Gemm g{ug ? gA - 2 * D : gA, gB, gM, gN, gK, ug ? 254 : 256};
            if (E.kind == EK_F32) { g.kshift = 2; g.ktab = (0u | 2u << 4) | (0u | 2u << 4) << 8 | (2u | 4u << 4) << 16 | (4u | 2u << 4) << 24; }
            if (rwp) { g.lda = D; g.ksplit = D / pg8::BK; g.kdelta = -(long)(D * 2) - (long)(D * 2); }
            pg8::StaticOrder S; S.init(gM, gN, (int)gridDim.x, (int)blockIdx.x);
            if (E.kind == EK_RETIN || E.kind == EK_UG) {
                LAS float* rt = (LAS float*)(lds + 131072);
                Unit uu;
                for (int ui = 0; ui < 8 && S.next(ui, uu); ++ui) if (tid < 256) { int rr = ug ? 254 * uu.pm - 2 + tid : uu.pm * 256 + tid; rr = rr < 0 ? 0 : (rr > M - 1 ? M - 1 : rr); rt[ui * 256 + tid] = row_rstd(ws, E.slot, rr); }
                E.rtab = rt; E.ldsb = lds;
                __syncthreads();
            }
            if (ug) { EpiAnyT<1> E1{}; E1.kind = E.kind; E1.perm = E.perm; E1.jl = E.jl; E1.ws = E.ws; E1.slot = E.slot; E1.rtab = E.rtab; E1.amul = E.amul; E1.li = E.li; E1.ldsb = E.ldsb; E1.pcw = p.in[I_CW]; E1.pcb = p.in[I_CB]; E1.pcst = p.in[I_SCONV]; E1.pout = p.out;
                pg8::gemm_phase<EpiAnyT<1>, pg8::StaticOrder, true, true>(lds, g, S, E1, tid); }
            else pg8::gemm_phase<EpiAnyT<0>, pg8::StaticOrder, true, true>(lds, g, S, E, tid);
            if (E.kind == EK_RESID) tail_resid(gA, gB, gK, ws, E.slot, E.amul, lds, lane, wave);
        }
        if (ph + 1 < hi) { XcdBarrier bar; bar.tid0 = tid == 0; bar.bar = (unsigned*)(p.ws + WS_CTL); bar.x = xb_xcc_id(); bar.st = (volatile LAS unsigned*)(lds + LDS_BYTES - 16); xcd_barrier(bar); }
    }
}

}

extern "C" void kernel_launch(void* const* d_in, const int* in_sizes, int n_in, void* d_out, int out_size, void* d_ws, size_t ws_size, hipStream_t stream) {
    static int grid = 0;
    if (grid == 0) {
        int dev = 0, cus = 0;
        if (n_in != N_IN || ws_size < WS_END2) { fprintf(stderr, "kernel_launch: unexpected n_in %d / ws_size %zu (need %zu)\n", n_in, ws_size, (size_t)WS_END2); grid = -1; return; }
        if (hipGetDevice(&dev) != hipSuccess || hipDeviceGetAttribute(&cus, hipDeviceAttributeMultiprocessorCount, dev) != hipSuccess) { grid = -1; return; }
        if (hipFuncSetAttribute((const void*)mega, hipFuncAttributeMaxDynamicSharedMemorySize, LDS_BYTES) != hipSuccess) { fprintf(stderr, "kernel_launch: hipFuncSetAttribute failed\n"); grid = -1; return; }
        int per_cu = 0;
        if (hipOccupancyMaxActiveBlocksPerMultiprocessor(&per_cu, (const void*)mega, NTHR, LDS_BYTES) != hipSuccess || per_cu < 1) { fprintf(stderr, "kernel_launch: occupancy query says %d\n", per_cu); (void)hipGetLastError(); }
        grid = cus * (per_cu >= 1 ? 1 : 1);
    }
    if (grid < 0) return;
    Params p{};
    for (int i = 0; i < N_IN; ++i) p.in[i] = (const float*)d_in[i];
    p.out = (float*)d_out; p.ws = (unsigned char*)d_ws;
    if (hipMemsetAsync(d_ws, 0, 65536, stream) != hipSuccess) { fprintf(stderr, "kernel_launch: memset failed\n"); return; }
    int lo = 0, hi = NPH;
    void* args[] = {(void*)&p, (void*)&lo, (void*)&hi};
    const hipError_t e = hipLaunchCooperativeKernel((const void*)mega, dim3(grid), dim3(NTHR), args, LDS_BYTES, stream);
    if (e != hipSuccess) fprintf(stderr, "kernel_launch: cooperative launch failed: %s (grid %d)\n", hipGetErrorString(e), grid);
    (void)in_sizes; (void)out_size;
}
```

```cpp
#include <hip/hip_runtime.h>
#include <hip/hip_cooperative_groups.h>
#include <cstdio>
#include <stdint.h>
namespace cg = cooperative_groups;
namespace pg8 {
#define PG8_LAS __attribute__((address_space(3)))
typedef unsigned short bf16_t;
typedef short bf16x8 __attribute__((ext_vector_type(8)));
typedef float f32x4 __attribute__((ext_vector_type(4)));
typedef unsigned u32x4 __attribute__((ext_vector_type(4)));
constexpr int BM = 256, BK = 64, HALF = 128, HTB = HALF * BK * 2  , STAGE_BYTES = 8 * HTB, NXCD = 8, WGM = 4;

__host__ __device__ __forceinline__ int lds_byte(int r, int c) { const int st = (r >> 4) * 2 + (c >> 5), rr = r & 15, cc = c & 31, ob = rr * 64 + cc * 2; return st * 1024 + (ob ^ (((ob >> 9) & 1) << 5)); }
__host__ __device__ __forceinline__ void stage_rc(int b, int& R, int& C) { const int st = b / 1024, sb = b % 1024, swz = sb ^ (((sb >> 9) & 1) << 5); R = (st >> 1) * 16 + swz / 64; C = (st & 1) * 32 + (swz % 64) / 2; }
__host__ __device__ __forceinline__ int perm32(int rho) { const int n = rho >> 4, i = rho & 15; return 8 * (i >> 2) + 4 * n + (i & 3); }

struct Unit { int pm, pn, ord; };
struct Gemm { const bf16_t* A; const bf16_t* Bt; int M, N, K, trows; int lda = 0, ksplit = 1 << 30; long kdelta = 0; unsigned ktab = 0; int kshift = 0; };

struct StaticOrder {
    int nM, nN, nwg, G, c;
    __host__ __device__ void init(int M, int N, int G_, int c_) { nM = M / BM; nN = N / BM; nwg = nM * nN; G = G_; c = c_; }
    __host__ __device__ __forceinline__ bool next(int i, Unit& u) const {
        const long L = (long)i * G + c; if (L >= nwg) return false;
        int wgid = (int)L; { const int q = nwg / NXCD, r = nwg % NXCD, xcd = wgid % NXCD, off = wgid / NXCD; wgid = (xcd < r ? xcd * (q + 1) : r * (q + 1) + (xcd - r) * q) + off; }
        const int nig = WGM * nN, gid = wgid / nig, fm = gid * WGM, gsz = (nM - fm) < WGM ? (nM - fm) : WGM;
        u.pm = fm + ((wgid % nig) % gsz); u.pn = (wgid % nig) / gsz; u.ord = i; return true;
    }
    __device__ __forceinline__ void a_ready(const Unit&) const {}
    __device__ __forceinline__ void done(const Unit&) const {}
};
template <class Epi, class Sched, bool ALIGN_EPI = false, bool SP2 = false>
__device__ __forceinline__ void gemm_phase(PG8_LAS unsigned char* lds, const Gemm g, const Sched& S, const Epi& E, int tid_in) {
    int tid = tid_in; asm volatile("" : "+v"(tid));
    const int wid = __builtin_amdgcn_readfirstlane(tid >> 6), lane = tid & 63, wr = wid >> 2, wc = wid & 3, fr = lane & 15, fq = lane >> 4;
    const int K = g.K, nt = K / BK, lda = g.lda ? g.lda : K;
    unsigned voffA[2], voffB[2];
#pragma unroll
    for (int i = 0; i < 2; ++i) { int R, C; stage_rc(tid * 16 + i * 8192, R, C); const int Rb = E.perm ? ((R & ~31) + perm32(R & 31)) : R;
        voffA[i] = (unsigned)(R * lda + C) * 2u; voffB[i] = (unsigned)(Rb * K + C) * 2u; }
    const size_t kstep = (size_t)(BK * 2);
    const size_t hstep = (size_t)HALF * K * 2, hstepA = (size_t)HALF * lda * 2;
    const int ksplit = g.ksplit; const long kdelta = g.kdelta;
#define PG8_KA(base, kt) ((base) + (size_t)(kt) * kstep + ((kt) >= ksplit ? kdelta : 0l))
    const size_t tstep = 2 * hstep; const size_t tstepA = (size_t)g.trows * lda * 2;
    const unsigned ldsw = (unsigned)wid * 1024u;
    const int aoff = lds_byte(wr * 64 + fr, fq * 8), boff = lds_byte(wc * 32 + fr, fq * 8);
#define PG8_SA(b, h) (((b) * 2 + (h)) * HTB)
#define PG8_SB(b, h) ((4 + (b) * 2 + (h)) * HTB)
#define PG8_STAGE(bufoff, gbase, voff) do { _Pragma("unroll") for (int _i = 0; _i < 2; ++_i) \
        __builtin_amdgcn_global_load_lds((const unsigned*)((const char*)(gbase) + (voff)[_i]), (PG8_LAS unsigned*)(lds + (bufoff) + ldsw + _i * 8192), 16, 0, 0); } while (0)
#define PG8_LDA(dst, b, h) do { _Pragma("unroll") for (int m = 0; m < 4; ++m) _Pragma("unroll") for (int k = 0; k < 2; ++k) dst[m][k] = *(const PG8_LAS bf16x8*)(lds + PG8_SA(b, h) + aoff + m * 2048 + k * 1024); } while (0)
#define PG8_LDB(dst, b, h) do { _Pragma("unroll") for (int n = 0; n < 2; ++n) _Pragma("unroll") for (int k = 0; k < 2; ++k) dst[n][k] = *(const PG8_LAS bf16x8*)(lds + PG8_SB(b, h) + boff + n * 2048 + k * 1024); } while (0)
#define PG8_MMA(ai, bj, At, Bt) do { __builtin_amdgcn_s_setprio(1); _Pragma("unroll") for (int m = 0; m < 4; ++m) _Pragma("unroll") for (int n = 0; n < 2; ++n) _Pragma("unroll") for (int k = 0; k < 2; ++k) \
        acc[ai][bj][m][n] = __builtin_amdgcn_mfma_f32_16x16x32_bf16(Bt[n][k], At[m][k], acc[ai][bj][m][n], 0, 0, 0); __builtin_amdgcn_s_setprio(0); } while (0)
#define PG8_WAIT_V(n) asm volatile("s_waitcnt vmcnt(" #n ")" ::: "memory")
#define PG8_WAIT_L(n) asm volatile("s_waitcnt lgkmcnt(" #n ")" ::: "memory")
#define PG8_BAR __builtin_amdgcn_s_barrier()
#define PG8_SCHED __builtin_amdgcn_sched_barrier(0)
    Unit cur, nxt; int ui = 0;
    if (!S.next(0, cur)) return;
    f32x4 acc[2][2][4][2];
#pragma unroll
    for (int a = 0; a < 2; ++a)
#pragma unroll
        for (int b = 0; b < 2; ++b)
#pragma unroll
            for (int m = 0; m < 4; ++m)
#pragma unroll
                for (int n = 0; n < 2; ++n) acc[a][b][m][n] = (f32x4){0.f, 0.f, 0.f, 0.f};
    bf16x8 At[4][2], B0[2][2], B1[2][2];
    const unsigned ktab = g.ktab; const int kshift = g.kshift;
#define PG8_KOFF(pn) (ktab ? (int)((ktab >> (8 * ((pn) >> kshift))) & 15u) : 0)
#define PG8_KNT(pn) (ktab ? (int)((ktab >> (8 * ((pn) >> kshift) + 4)) & 15u) : nt)
    int ntc = PG8_KNT(cur.pn);
    const char* cA = (const char*)g.A + (size_t)cur.pm * tstepA + (size_t)PG8_KOFF(cur.pn) * kstep; const char* cB = (const char*)g.Bt + (size_t)cur.pn * tstep + (size_t)PG8_KOFF(cur.pn) * kstep;
    S.a_ready(cur);
    if constexpr (SP2) {
        PG8_STAGE(PG8_SB(0, 0), cB, voffB); PG8_STAGE(PG8_SB(0, 1), cB + hstep, voffB); PG8_STAGE(PG8_SA(0, 0), cA, voffA); PG8_STAGE(PG8_SA(0, 1), cA + hstepA, voffA);
        if (wr == 1) PG8_BAR;
        PG8_WAIT_V(2); PG8_BAR;
        PG8_STAGE(PG8_SB(1, 0), cB + kstep, voffB); PG8_STAGE(PG8_SA(1, 0), PG8_KA(cA, 1), voffA); PG8_STAGE(PG8_SB(1, 1), cB + hstep + kstep, voffB);
        PG8_WAIT_V(6); PG8_BAR;
    } else {
        PG8_STAGE(PG8_SB(0, 0), cB, voffB); PG8_STAGE(PG8_SA(0, 0), cA, voffA); PG8_STAGE(PG8_SB(0, 1), cB + hstep, voffB); PG8_STAGE(PG8_SA(0, 1), cA + hstepA, voffA);
        if (wr == 1) PG8_BAR;
        PG8_WAIT_V(4); PG8_BAR;
        PG8_STAGE(PG8_SB(1, 0), cB + kstep, voffB); PG8_STAGE(PG8_SA(1, 0), PG8_KA(cA, 1), voffA); PG8_STAGE(PG8_SB(1, 1), cB + hstep + kstep, voffB);
        PG8_WAIT_V(6); PG8_BAR;
    }
    for (;;) {
        const bool has_next = S.next(ui + 1, nxt);
        const char* nA = has_next ? (const char*)g.A + (size_t)nxt.pm * tstepA + (size_t)PG8_KOFF(nxt.pn) * kstep : cA; const char* nB = has_next ? (const char*)g.Bt + (size_t)nxt.pn * tstep + (size_t)PG8_KOFF(nxt.pn) * kstep : cB;
        for (int t = 0; t < ntc; t += 2) {
            const bool last = (t == ntc - 2);
            const char* a1 = PG8_KA(cA, t + 1);
            const char* a2 = last ? nA : PG8_KA(cA, t + 2); const char* b2 = last ? nB : cB + (size_t)(t + 2) * kstep;
            const char* a3 = last ? PG8_KA(nA, 1) : PG8_KA(cA, t + 3); const char* b3 = b2 + kstep;
            if (last && has_next) S.a_ready(nxt);
            if constexpr (SP2) {
            PG8_LDB(B0, 0, 0); PG8_LDB(B1, 0, 1); PG8_SCHED; PG8_LDA(At, 0, 0); PG8_STAGE(PG8_SA(1, 1), a1 + hstepA, voffA);
            PG8_WAIT_V(8); PG8_WAIT_L(0); PG8_BAR; PG8_MMA(0, 0, At, B0); PG8_MMA(0, 1, At, B1); PG8_BAR; PG8_SCHED;
            PG8_LDA(At, 0, 1); PG8_STAGE(PG8_SB(0, 0), b2, voffB); PG8_STAGE(PG8_SB(0, 1), b2 + hstep, voffB); PG8_STAGE(PG8_SA(0, 0), a2, voffA);
            PG8_WAIT_V(8); PG8_WAIT_L(0); PG8_BAR; PG8_MMA(1, 0, At, B0); PG8_MMA(1, 1, At, B1); PG8_BAR; PG8_SCHED;
            PG8_LDB(B0, 1, 0); PG8_LDB(B1, 1, 1); PG8_SCHED; PG8_LDA(At, 1, 0); PG8_STAGE(PG8_SA(0, 1), a2 + hstepA, voffA);
            PG8_WAIT_V(8); PG8_WAIT_L(0); PG8_BAR; PG8_MMA(0, 0, At, B0); PG8_MMA(0, 1, At, B1); PG8_BAR; PG8_SCHED;
            PG8_LDA(At, 1, 1); PG8_STAGE(PG8_SB(1, 0), b3, voffB); PG8_STAGE(PG8_SB(1, 1), b3 + hstep, voffB); PG8_STAGE(PG8_SA(1, 0), a3, voffA);
            PG8_WAIT_V(8); PG8_WAIT_L(0); PG8_BAR; PG8_MMA(1, 0, At, B0); PG8_MMA(1, 1, At, B1); PG8_BAR; PG8_SCHED;
            } else {
            PG8_LDB(B0, 0, 0); PG8_SCHED; PG8_LDA(At, 0, 0); PG8_STAGE(PG8_SA(1, 1), a1 + hstepA, voffA);
            PG8_WAIT_L(8); PG8_BAR; PG8_WAIT_L(0); PG8_MMA(0, 0, At, B0); PG8_BAR; PG8_SCHED;
            PG8_LDB(B1, 0, 1); PG8_STAGE(PG8_SB(0, 0), b2, voffB);
            PG8_BAR; PG8_WAIT_L(0); PG8_MMA(0, 1, At, B1); PG8_BAR;
            PG8_LDA(At, 0, 1); PG8_STAGE(PG8_SA(0, 0), a2, voffA);
            PG8_BAR; PG8_WAIT_L(0); PG8_MMA(1, 0, At, B0); PG8_BAR; PG8_SCHED;
            PG8_STAGE(PG8_SB(0, 1), b2 + hstep, voffB);
            PG8_WAIT_V(6); PG8_BAR; PG8_MMA(1, 1, At, B1); PG8_BAR;
            PG8_LDB(B0, 1, 0); PG8_SCHED; PG8_LDA(At, 1, 0); PG8_STAGE(PG8_SA(0, 1), a2 + hstepA, voffA);
            PG8_WAIT_L(8); PG8_BAR; PG8_WAIT_L(0); PG8_MMA(0, 0, At, B0); PG8_BAR; PG8_SCHED;
            PG8_LDB(B1, 1, 1); PG8_STAGE(PG8_SB(1, 0), b3, voffB);
            PG8_BAR; PG8_WAIT_L(0); PG8_MMA(0, 1, At, B1); PG8_BAR;
            PG8_LDA(At, 1, 1); PG8_STAGE(PG8_SA(1, 0), a3, voffA);
            PG8_BAR; PG8_WAIT_L(0); PG8_MMA(1, 0, At, B0); PG8_BAR; PG8_SCHED;
            PG8_STAGE(PG8_SB(1, 1), b3 + hstep, voffB);
            PG8_WAIT_V(6); PG8_BAR; PG8_MMA(1, 1, At, B1); PG8_BAR;
            }
        }
        if constexpr (ALIGN_EPI) { if (wr == 0) PG8_BAR; }
        if constexpr (!Epi::AFTER_DRAIN) { E(acc, cur, wr, wc, fr, fq); S.done(cur); }
        if (!has_next) break;
#pragma unroll
        for (int a = 0; a < 2; ++a)
#pragma unroll
            for (int b = 0; b < 2; ++b)
#pragma unroll
                for (int m = 0; m < 4; ++m)
#pragma unroll
                    for (int n = 0; n < 2; ++n) acc[a][b][m][n] = (f32x4){0.f, 0.f, 0.f, 0.f};
        cur = nxt; cA = nA; cB = nB; ++ui; ntc = PG8_KNT(cur.pn);
        if constexpr (ALIGN_EPI) { if (wr == 1) PG8_BAR; }
    }
    PG8_WAIT_V(0);
    if constexpr (!ALIGN_EPI) { if (wr == 0) PG8_BAR; }
    PG8_BAR;
    if constexpr (Epi::AFTER_DRAIN) { E.fused(acc, cur, wr, wc, fr, fq, lds, wid, lane); S.done(cur); }
#undef PG8_KA
#undef PG8_KOFF
#undef PG8_KNT
#undef PG8_SA
#undef PG8_SB
#undef PG8_STAGE
#undef PG8_LDA
#undef PG8_LDB
#undef PG8_MMA
#undef PG8_WAIT_V
#undef PG8_WAIT_L
#undef PG8_BAR
#undef PG8_SCHED
}
}

namespace {
constexpr int D = 1024, BATCH = 8, SEQ = 2048, NMETA = 16, TP = SEQ + NMETA, MP = BATCH * TP, SB = 128, M = MP + SB;
constexpr int DEPTH = 4, RH = 4, RDK = 256, RDV = 512, RV = 2048, RWIN = 6144;
constexpr int WH = 16, WN = 64, LW = 64, LA = 64, LV = 32, LG = 160, DFF = 2816;
constexpr int NRW = 3584, KRW = 2048, KL2 = 384, NL2 = 4096;
constexpr float PAST_POS = 16384.f;
constexpr int NWAVES = 8, NTHR = 512;
constexpr int LDS_BYTES = 147456;

constexpr size_t O_YP = 0;
constexpr size_t O_YS = O_YP + (size_t)BATCH * SEQ * D;
constexpr size_t O_RETP = O_YS + (size_t)SB * D;
constexpr size_t O_WKVP = O_RETP + (size_t)2 * BATCH * RH * RDK * RDV;
constexpr size_t O_SHP = O_WKVP + (size_t)2 * BATCH * WH * WN * WN;
constexpr size_t O_CVP = O_SHP + (size_t)2 * BATCH * D;
constexpr size_t O_RETS = O_CVP + (size_t)DEPTH * BATCH * 2 * DFF;
constexpr size_t O_WKVS = O_RETS + (size_t)2 * SB * RH * RDK * RDV;
constexpr size_t O_SHS = O_WKVS + (size_t)2 * SB * WH * WN * WN;
constexpr size_t O_CVS = O_SHS + (size_t)2 * SB * D;

enum { I_XP = 0, I_XS, I_SRET, I_SWKV, I_SSHIFT, I_SCONV, I_META, I_NMIX, I_NFFN, I_NFIN, I_RWIN, I_RGN, I_RWOUT, I_MU, I_WRKV, I_W0, I_W1, I_W2,
       I_A0, I_A1, I_A2, I_V0, I_V1, I_V2, I_G1, I_G2, I_KK, I_KA, I_RK, I_LNW, I_LNB, I_WO, I_WUG, I_CW, I_CB, I_WD, N_IN };

constexpr size_t al256(size_t x) { return (x + 255) & ~(size_t)255; }
constexpr size_t WS_CTL = 0;
constexpr size_t WS_CS = 1u << 20;
constexpr size_t WS_WIN = 4u << 20;
constexpr size_t SZ_WIN = (size_t)RWIN * D * 2;
constexpr size_t WS_WOUT = WS_WIN + 2 * SZ_WIN;
constexpr size_t SZ_WOUT = (size_t)D * RV * 2;
constexpr size_t WS_WRW = WS_WOUT + 2 * SZ_WOUT;
constexpr size_t SZ_WRW = (size_t)NRW * KRW * 2;
constexpr size_t WS_WL2 = WS_WRW + 2 * SZ_WRW;
constexpr size_t SZ_WL2 = (size_t)NL2 * KL2 * 2;
constexpr size_t WS_WO = WS_WL2 + 2 * SZ_WL2;
constexpr size_t SZ_WO = (size_t)D * D * 2;
constexpr size_t WS_WUG = WS_WO + 2 * SZ_WO;
constexpr size_t SZ_WUG = (size_t)2 * DFF * D * 2;
constexpr size_t WS_WD = WS_WUG + 4 * SZ_WUG;
constexpr size_t SZ_WD = (size_t)D * DFF * 2;
constexpr size_t WS_X = al256(WS_WD + 4 * SZ_WD);
constexpr size_t SZ_MD4 = (size_t)M * D * 4;
constexpr size_t WS_H = WS_X + SZ_MD4;
constexpr size_t WS_VF = WS_H + SZ_MD4;
constexpr size_t WS_REG = WS_VF + SZ_MD4;
constexpr size_t WS_QK = WS_REG;
constexpr size_t WS_V = WS_QK + SZ_MD4;
constexpr size_t WS_SG = WS_V + SZ_MD4;
constexpr size_t WS_O = WS_SG + SZ_MD4;
constexpr size_t WS_Y = WS_O + 2 * SZ_MD4;
constexpr size_t WS_R = WS_REG;
constexpr size_t WS_K = WS_R + SZ_MD4;
constexpr size_t WS_VB = WS_K + SZ_MD4;
constexpr size_t WS_WDEC = WS_VB + SZ_MD4;
constexpr size_t WS_NKK = WS_WDEC + SZ_MD4;
constexpr size_t WS_KKA = WS_NKK + SZ_MD4;
constexpr size_t WS_YW = WS_KKA + SZ_MD4;
constexpr size_t WS_L2 = WS_YW + SZ_MD4;
constexpr size_t WS_A2 = WS_L2 + 4 * SZ_MD4;
constexpr size_t WS_Z = al256(WS_A2 + (size_t)M * KL2 * 2);
constexpr size_t WS_RW_END = WS_Z + (size_t)M * D * 2;
constexpr size_t SZ_FF2 = (size_t)M * DFF * 2;
constexpr size_t WS_U = WS_REG;
constexpr size_t WS_G = al256(WS_U + SZ_FF2);
constexpr size_t WS_ACT = al256(WS_G + SZ_FF2);
constexpr size_t WS_XB = al256(WS_RW_END) + 2 * (size_t)D * 2;
constexpr size_t WS_SS = al256(WS_XB + (size_t)(M + 126) * D * 2);
constexpr size_t WS_PTRS = al256(WS_SS + (size_t)8 * M * 16 * 4);
constexpr size_t WS_END = WS_PTRS + 256;

#define LAS __attribute__((address_space(3)))
typedef unsigned short bf16;
typedef unsigned v4u __attribute__((ext_vector_type(4)));
typedef unsigned v2u __attribute__((ext_vector_type(2)));
using pg8::f32x4;
using pg8::Unit;
using pg8::bf16x8;

struct Params { const float* in[N_IN]; float* out; unsigned char* ws; };

__device__ __forceinline__ unsigned cvt_pk_bf16(float lo, float hi) { unsigned r; asm("v_cvt_pk_bf16_f32 %0, %1, %2" : "=v"(r) : "v"(lo), "v"(hi)); return r; }
typedef __bf16 bf4v __attribute__((ext_vector_type(4)));
__device__ __forceinline__ v2u pk4(const f32x4 v) { return __builtin_bit_cast(v2u, __builtin_convertvector(v, bf4v)); }
__device__ __forceinline__ bf16 bf_cv(float x) { return __builtin_bit_cast(unsigned short, (__bf16)x); }
__device__ __forceinline__ float bf_lo(unsigned w) { return __uint_as_float(w << 16); }
__device__ __forceinline__ float bf_hi(unsigned w) { return __uint_as_float(w & 0xffff0000u); }
__device__ __forceinline__ void unpack8(const v4u w, float (&f)[8]) { f[0] = bf_lo(w.x); f[1] = bf_hi(w.x); f[2] = bf_lo(w.y); f[3] = bf_hi(w.y); f[4] = bf_lo(w.z); f[5] = bf_hi(w.z); f[6] = bf_lo(w.w); f[7] = bf_hi(w.w); }
__device__ __forceinline__ v4u pack8(const float (&f)[8]) { v4u w; w.x = cvt_pk_bf16(f[0], f[1]); w.y = cvt_pk_bf16(f[2], f[3]); w.z = cvt_pk_bf16(f[4], f[5]); w.w = cvt_pk_bf16(f[6], f[7]); return w; }
__device__ __forceinline__ f32x4 ld_bf4(const bf16* q) { const v2u w = *(const v2u*)q; return (f32x4){bf_lo(w.x), bf_hi(w.x), bf_lo(w.y), bf_hi(w.y)}; }
__device__ __forceinline__ void st_bf4(bf16* q, const f32x4 v) { v2u w; w.x = cvt_pk_bf16(v.x, v.y); w.y = cvt_pk_bf16(v.z, v.w); *(v2u*)q = w; }
__device__ __forceinline__ float shfl_xor_l(float v, int m, int lane) { return __int_as_float(__builtin_amdgcn_ds_bpermute((lane ^ m) << 2, __float_as_int(v))); }
__device__ __forceinline__ float shfl_l(float v, int src) { return __int_as_float(__builtin_amdgcn_ds_bpermute(src << 2, __float_as_int(v))); }
__device__ __forceinline__ float wave_sum(float v, int) {
    v += __builtin_bit_cast(float, __builtin_amdgcn_update_dpp(0, __float_as_int(v), 0x128, 0xf, 0xf, false));
    v += __builtin_bit_cast(float, __builtin_amdgcn_update_dpp(0, __float_as_int(v), 0x124, 0xf, 0xf, false));
    v += __builtin_bit_cast(float, __builtin_amdgcn_update_dpp(0, __float_as_int(v), 0x122, 0xf, 0xf, false));
    v += __builtin_bit_cast(float, __builtin_amdgcn_update_dpp(0, __float_as_int(v), 0x121, 0xf, 0xf, false));
    const int vi = __float_as_int(v);
    return (__int_as_float(__builtin_amdgcn_readlane(vi, 0)) + __int_as_float(__builtin_amdgcn_readlane(vi, 16))) + (__int_as_float(__builtin_amdgcn_readlane(vi, 32)) + __int_as_float(__builtin_amdgcn_readlane(vi, 48)));
}
__device__ __forceinline__ float rcpf_(float x) { return __builtin_amdgcn_rcpf(x); }
__device__ __forceinline__ float sigmoidf_(float x) { return rcpf_(1.f + __expf(-x)); }
__device__ __forceinline__ float siluf_(float x) { return x * rcpf_(1.f + __expf(-x)); }
__device__ __forceinline__ float tanhf_(float x) { return 1.f - 2.f * rcpf_(1.f + __expf(2.f * x)); }

__device__ __forceinline__ float row_rstd(const unsigned char* ws, int slot, int row) {
    const f32x4* q = (const f32x4*)((const float*)(ws + WS_SS) + ((size_t)slot * M + row) * 16);
    const f32x4 a = q[0], b = q[1], c = q[2], d = q[3];
    const float ss = (((a.x + a.y) + (a.z + a.w)) + ((b.x + b.y) + (b.z + b.w))) + (((c.x + c.y) + (c.z + c.w)) + ((d.x + d.y) + (d.z + d.w)));
    return rsqrtf(ss * (1.f / D) + 1e-6f);
}
__device__ __forceinline__ float dpp_ror1(float v) { return __int_as_float(__builtin_amdgcn_update_dpp(0, __float_as_int(v), 0x121, 0xf, 0xf, false)); }
__device__ __forceinline__ void quad_transpose4(float (&x)[4], int j) {
    const bool o1 = j & 1, o2 = j & 2;
    const float a0 = o1 ? x[0] : x[1], a1 = o1 ? x[2] : x[3];
    const float b0 = __int_as_float(__builtin_amdgcn_mov_dpp(__float_as_int(a0), 0xB1, 0xf, 0xf, true)), b1 = __int_as_float(__builtin_amdgcn_mov_dpp(__float_as_int(a1), 0xB1, 0xf, 0xf, true));
    const float y0 = o1 ? b0 : x[0], y1 = o1 ? x[1] : b0, y2 = o1 ? b1 : x[2], y3 = o1 ? x[3] : b1;
    const float c0 = o2 ? y0 : y2, c1 = o2 ? y1 : y3;
    const float d0 = __int_as_float(__builtin_amdgcn_mov_dpp(__float_as_int(c0), 0x4E, 0xf, 0xf, true)), d1 = __int_as_float(__builtin_amdgcn_mov_dpp(__float_as_int(c1), 0x4E, 0xf, 0xf, true));
    x[0] = o2 ? d0 : y0; x[1] = o2 ? d1 : y1; x[2] = o2 ? y2 : d0; x[3] = o2 ? y3 : d1;
}
template <int CTRL> __device__ __forceinline__ float dpp_mv(float v) { return __int_as_float(__builtin_amdgcn_mov_dpp(__float_as_int(v), CTRL, 0xf, 0xf, true)); }
__device__ __forceinline__ float dpp_ror2(float v) { return __int_as_float(__builtin_amdgcn_update_dpp(0, __float_as_int(v), 0x122, 0xf, 0xf, false)); }
enum { EK_RETIN = 0, EK_RESID, EK_UG, EK_RWPROJ, EK_F32 };
template <int GRP> struct EpiExtra {};
template <> struct EpiExtra<1> { const float* pcw; const float* pcb; const float* pcst; float* pout; };
template <int GRP> struct EpiAnyT : EpiExtra<GRP> {
    static constexpr bool AFTER_DRAIN = false;
    int kind; bool perm; int jl; unsigned char* ws; int slot; const LAS float* rtab; float amul; int li; LAS unsigned char* ldsb;
    __device__ __forceinline__ void operator()(const f32x4 (&acc)[2][2][4][2], const Unit& u, int wr, int wc, int fr, int fq) const {
        const int row0 = u.pm * 256 + wr * 64 + fr;
        if (GRP == 0 && kind == EK_RETIN) {
            bf16* QK = (bf16*)(ws + WS_QK); bf16* V = (bf16*)(ws + WS_V); bf16* SG = (bf16*)(ws + WS_SG); const float* CS = (const float*)(ws + WS_CS);
            const int cw = wc * 32 + 8 * fq;
            if (u.pn < 8) {
                const bool isk = u.pn >= 4; const int h = u.pn & 3; const float sc = isk ? 0.0625f : 1.f;
                bf16* base = QK + (isk ? 1024 : 0) + h * 256 + cw;
#pragma unroll
                for (int ai = 0; ai < 2; ++ai) {
                    f32x4 tt[4][4];
#pragma unroll
                    for (int m = 0; m < 4; ++m) { const int row = row0 + ai * 128 + m * 16; const int pi = row < MP ? row % TP : TP;
                        const f32x4* cs = (const f32x4*)(CS + ((size_t)pi * 128 + cw) * 2);
#pragma unroll
                        for (int q4 = 0; q4 < 4; ++q4) tt[m][q4] = cs[q4]; }
#pragma unroll
                    for (int m = 0; m < 4; ++m) {
                        const int row = row0 + ai * 128 + m * 16;
                        const float rs = rtab[u.ord * 256 + (row - u.pm * 256)] * sc;
                        const f32x4 t0 = tt[m][0], t1 = tt[m][1], t2 = tt[m][2], t3 = tt[m][3];
                        const float c[8] = {t0.x, t0.z, t1.x, t1.z, t2.x, t2.z, t3.x, t3.z}, s[8] = {t0.y, t0.w, t1.y, t1.w, t2.y, t2.w, t3.y, t3.w};
                        float o1[8], o2[8];
#pragma unroll
                        for (int n = 0; n < 2; ++n)
#pragma unroll
                            for (int j = 0; j < 4; ++j) {
                                const float x1 = acc[ai][0][m][n][j], x2 = acc[ai][1][m][n][j];
                                o1[n * 4 + j] = (x1 * c[n * 4 + j] - x2 * s[n * 4 + j]) * rs;
                                o2[n * 4 + j] = (x1 * s[n * 4 + j] + x2 * c[n * 4 + j]) * rs;
                            }
                        bf16* rp = base + (size_t)row * 2048;
                        *(v4u*)rp = pack8(o1); *(v4u*)(rp + 128) = pack8(o2);
                    }
                    asm volatile("" ::: "memory");
                }
            } else {
                const bool isg = u.pn >= 16;
                bf16* base = (isg ? SG : V) + ((u.pn - (isg ? 16 : 8)) * 256) + cw;
#pragma unroll
                for (int ai = 0; ai < 2; ++ai)
#pragma unroll
                    for (int m = 0; m < 4; ++m) {
                        bf16* rp = base + (size_t)(row0 + ai * 128 + m * 16) * 2048;
                        const float rs = rtab[u.ord * 256 + (wr * 64 + fr + ai * 128 + m * 16)];
#pragma unroll
                        for (int bj = 0; bj < 2; ++bj) {
                            float o[8];
#pragma unroll
                            for (int n = 0; n < 2; ++n)
#pragma unroll
                                for (int j = 0; j < 4; ++j) { const float x = acc[ai][bj][m][n][j] * rs; o[n * 4 + j] = isg ? siluf_(x) : x; }
                            *(v4u*)(rp + bj * 128) = pack8(o);
                        }
                    }
            }
        } else if (GRP == 0 && kind == EK_RESID) {
            const int colw = u.pn * 256 + wc * 32 + (fq & 1) * 16 + (fq >> 1) * 8;
#pragma unroll
            for (int am = 0; am < 4; ++am) { const int ai = am >> 1, mb = (am & 1) * 2;
                v4u xv[2][2];
#pragma unroll
                for (int mm = 0; mm < 2; ++mm) { const int m = mb + mm; const bf16* rp = (const bf16*)(ws + WS_XB) + (size_t)(row0 + ai * 128 + m * 16) * D + colw;
#pragma unroll
                    for (int bj = 0; bj < 2; ++bj) xv[mm][bj] = *(const v4u*)(rp + bj * 128); }
#pragma unroll
                for (int mm = 0; mm < 2; ++mm) { const int m = mb + mm;
                    const int row = row0 + ai * 128 + m * 16;
                    bf16* xb = (bf16*)(ws + WS_XB) + (size_t)row * D + colw;
                    float ssq = 0.f;
#pragma unroll
                    for (int bj = 0; bj < 2; ++bj) {
                        const auto s0 = __builtin_amdgcn_permlane16_swap(xv[mm][bj].x, xv[mm][bj].z, false, false), s1 = __builtin_amdgcn_permlane16_swap(xv[mm][bj].y, xv[mm][bj].w, false, false);
                        const unsigned xn[2][2] = {{s0[0], s1[0]}, {s0[1], s1[1]}};
                        unsigned wn[2][2];
#pragma unroll
                        for (int n = 0; n < 2; ++n) {
                            const f32x4 v = (f32x4){bf_lo(xn[n][0]), bf_hi(xn[n][0]), bf_lo(xn[n][1]), bf_hi(xn[n][1])} + acc[ai][bj][m][n] * amul;
                            wn[n][0] = cvt_pk_bf16(v.x, v.y); wn[n][1] = cvt_pk_bf16(v.z, v.w);
                            if (slot >= 0) ssq += (v.x * v.x + v.y * v.y) + (v.z * v.z + v.w * v.w); }
                        const auto t0 = __builtin_amdgcn_permlane16_swap(wn[0][0], wn[1][0], false, false), t1 = __builtin_amdgcn_permlane16_swap(wn[0][1], wn[1][1], false, false);
                        *(v4u*)(xb + bj * 128) = (v4u){t0[0], t1[0], t0[1], t1[1]};
                    }
                    if (slot >= 0) { ssq += shfl_xor_l(ssq, 16, fq * 16 + fr); ssq += shfl_xor_l(ssq, 32, fq * 16 + fr); if (fq == 0) ((float*)(ws + WS_SS))[((size_t)slot * M + row) * 16 + u.pn * 4 + wc] = ssq; }
                }
                asm volatile("" ::: "memory");
            }
        } else if (GRP == 1 && kind == EK_UG) {
            int frL = fr, fqL = fq; asm volatile("" : "+v"(frL), "+v"(fqL));
            const EpiExtra<1>& X1 = *(const EpiExtra<1>*)(const void*)this;
            const float* cw = X1.pcw + (size_t)li * 3 * DFF; const float* cb = X1.pcb + (size_t)li * DFF; const float* cst = X1.pcst + (size_t)li * SB * 2 * DFF;
            float* cvp = X1.pout + O_CVP + (size_t)li * BATCH * 2 * DFF; float* cvs = X1.pout + O_CVS + (size_t)li * SB * 2 * DFF;
            bf16* ACT = (bf16*)(ws + WS_ACT);
            const int fl = wc * 32 + 8 * fqL;
            LAS float* halo = (LAS float*)(ldsb + 131072 + 8192);
            const LAS float* rt = rtab + u.ord * 256;
#pragma unroll
            for (int ai = 0; ai < 2; ++ai) if (frL >= 14) {
                const float rs = rt[128 * ai + 64 * wr + 48 + frL];
                LAS float* hp = halo + ((2 * ai + wr) * 2 + (frL - 14)) * 128 + fl;
                *(LAS f32x4*)hp = acc[ai][1][3][0] * rs; *(LAS f32x4*)(hp + 4) = acc[ai][1][3][1] * rs;
            }
            asm volatile("s_waitcnt lgkmcnt(0)" ::: "memory"); __builtin_amdgcn_s_barrier(); asm volatile("" ::: "memory");
            const int R0 = 254 * u.pm - 2, bq = (R0 + 2) / TP, tq = (R0 + 2) - bq * TP;
            const bool plain = (R0 + 255 < MP) && tq >= 2 && tq + 253 < TP - 2;
            if (plain) {
                const bool k15 = frL == 15, k14 = frL >= 14;
                const int f00 = u.pn * 128 + fl;
                const f32x4 Wa0 = *(const f32x4*)(cw + f00), Wa1 = *(const f32x4*)(cw + DFF + f00), Wa2 = *(const f32x4*)(cw + 2 * DFF + f00), Wab = *(const f32x4*)(cb + f00);
                const f32x4 Wb0 = *(const f32x4*)(cw + f00 + 4), Wb1 = *(const f32x4*)(cw + DFF + f00 + 4), Wb2 = *(const f32x4*)(cw + 2 * DFF + f00 + 4), Wbb = *(const f32x4*)(cb + f00 + 4);
                const unsigned ob = (unsigned)((R0 + 64 * wr + frL) * DFF + f00) * 2u;
                f32x4 prevA = (f32x4){0.f, 0.f, 0.f, 0.f}, prevB = prevA;
#pragma unroll
                for (int ai = 0; ai < 2; ++ai)
#pragma unroll
                    for (int m = 0; m < 4; ++m) {
                        const int l = 128 * ai + 64 * wr + 16 * m + frL;
                        const float rs = rt[l];
                        if (m == 0) {
                            const int B = 2 * ai + wr;
                            prevA = (f32x4){0.f, 0.f, 0.f, 0.f}; prevB = prevA;
                            if (B > 0 && frL >= 14) { const LAS float* hp = halo + ((B - 1) * 2 + (frL - 14)) * 128 + fl; prevA = *(const LAS f32x4*)hp; prevB = *(const LAS f32x4*)(hp + 4); }
                        }
                        unsigned wv[4];
#pragma unroll
                        for (int n = 0; n < 2; ++n) {
                            const f32x4 w0 = n ? Wb0 : Wa0, w1 = n ? Wb1 : Wa1, w2 = n ? Wb2 : Wa2, bb = n ? Wbb : Wab;
                            const f32x4 cur = acc[ai][1][m][n] * rs, uu = acc[ai][0][m][n] * rs, prev = n ? prevB : prevA;
                            float ov[4];
#pragma unroll
                            for (int e = 0; e < 4; ++e) {
                                const float ce = cur[e], pe = prev[e];
                                const float g1 = dpp_mv<0x121>(k15 ? pe : ce), g2 = dpp_mv<0x122>(k14 ? pe : ce);
                                const float cv = fmaf(w0[e], g2, fmaf(w1[e], g1, fmaf(w2[e], ce, bb[e])));
                                ov[e] = siluf_(cv) * uu[e];
                            }
                            wv[2 * n] = cvt_pk_bf16(ov[0], ov[1]); wv[2 * n + 1] = cvt_pk_bf16(ov[2], ov[3]);
                            if (n) prevB = cur; else prevA = cur;
                        }
                        if (ai > 0 || m > 0 || l >= 2) *(v4u*)((unsigned char*)ACT + (ob + (unsigned)((128 * ai + 16 * m) * DFF * 2))) = (v4u){wv[0], wv[1], wv[2], wv[3]};
                        __builtin_amdgcn_sched_barrier(0);
                    }
            } else
#pragma unroll
            for (int n = 0; n < 2; ++n) {
                const int f0 = u.pn * 128 + fl + 4 * n;
                const f32x4 w0 = *(const f32x4*)(cw + f0), w1 = *(const f32x4*)(cw + DFF + f0), w2 = *(const f32x4*)(cw + 2 * DFF + f0), bb = *(const f32x4*)(cb + f0);
                f32x4 prev = (f32x4){0.f, 0.f, 0.f, 0.f};
#pragma unroll
                for (int ai = 0; ai < 2; ++ai)
#pragma unroll
                    for (int m = 0; m < 4; ++m) {
                        const int l = 128 * ai + 64 * wr + 16 * m + frL, row = 254 * u.pm - 2 + l;
                        const float rs = rt[l];
                        const f32x4 cur = acc[ai][1][m][n] * rs, uu = acc[ai][0][m][n] * rs;
                        if (m == 0) {
                            const int B = 2 * ai + wr;
                            prev = (f32x4){0.f, 0.f, 0.f, 0.f};
                            if (B > 0 && frL >= 14) prev = *(const LAS f32x4*)(halo + ((B - 1) * 2 + (frL - 14)) * 128 + fl + 4 * n);
                        }
                        f32x4 g1, g2;
                        {
                            const float c1x = dpp_ror1(cur.x), c1y = dpp_ror1(cur.y), c1z = dpp_ror1(cur.z), c1w = dpp_ror1(cur.w);
                            const float p1x = dpp_ror1(prev.x), p1y = dpp_ror1(prev.y), p1z = dpp_ror1(prev.z), p1w = dpp_ror1(prev.w);
                            const float c2x = dpp_ror2(cur.x), c2y = dpp_ror2(cur.y), c2z = dpp_ror2(cur.z), c2w = dpp_ror2(cur.w);
                            const float p2x = dpp_ror2(prev.x), p2y = dpp_ror2(prev.y), p2z = dpp_ror2(prev.z), p2w = dpp_ror2(prev.w);
                            const bool s1 = frL >= 1, s2 = frL >= 2;
                            g1.x = s1 ? c1x : p1x; g1.y = s1 ? c1y : p1y; g1.z = s1 ? c1z : p1z; g1.w = s1 ? c1w : p1w;
                            g2.x = s2 ? c2x : p2x; g2.y = s2 ? c2y : p2y; g2.z = s2 ? c2z : p2z; g2.w = s2 ? c2w : p2w;
                        }
                        if (l >= 2 && row < M) {
                            if (row < MP) {
                                const int b = row / TP, t = row - b * TP;
                                if (t < 2) { g2 = (f32x4){0.f, 0.f, 0.f, 0.f}; if (t == 0) g1 = g2; }
                                if (t >= TP - 2) *(f32x4*)(cvp + ((size_t)b * 2 + (t - (TP - 2))) * DFF + f0) = cur;
                            } else {
                                const int s = row - MP;
                                const float* c0 = cst + ((size_t)s * 2 + 0) * DFF + f0;
                                g2 = *(const f32x4*)c0; g1 = *(const f32x4*)(c0 + DFF);
                                float* o = cvs + ((size_t)s * 2 + 0) * DFF + f0;
                                *(f32x4*)o = g1; *(f32x4*)(o + DFF) = cur;
                            }
                            const f32x4 cv = bb + w0 * g2 + w1 * g1 + w2 * cur;
                            v2u w; w.x = cvt_pk_bf16(siluf_(cv.x) * uu.x, siluf_(cv.y) * uu.y); w.y = cvt_pk_bf16(siluf_(cv.z) * uu.z, siluf_(cv.w) * uu.w);
                            *(v2u*)(ACT + (size_t)row * DFF + f0) = w;
                        }
                        prev = cur;
                    }
            }
        } else if (GRP == 0 && kind == EK_RWPROJ) {
            const int cw = wc * 32 + 8 * fq;
            int rrow[2][4];
#pragma unroll
            for (int ai = 0; ai < 2; ++ai)
#pragma unroll
                for (int m = 0; m < 4; ++m) { const int mp = row0 + ai * 128 + m * 16;
                    if (mp < 8 * (TP + 1)) { const int b = mp / (TP + 1), t = mp - b * (TP + 1); rrow[ai][m] = t < TP ? b * TP + t : -1; }
                    else { const int q = mp - 8 * (TP + 1); rrow[ai][m] = (!(q & 1) && q < 2 * SB) ? MP + (q >> 1) : -1; } }
            if (u.pn < 12) {
                bf16* dst = (bf16*)(ws + (u.pn < 4 ? WS_R : (u.pn < 8 ? WS_K : (jl == 0 ? WS_VF : WS_VB)))) + (u.pn & 3) * 256 + cw;
#pragma unroll
                for (int ai = 0; ai < 2; ++ai)
#pragma unroll
                    for (int m = 0; m < 4; ++m) if (rrow[ai][m] >= 0) {
                        bf16* rp = dst + (size_t)rrow[ai][m] * D;
#pragma unroll
                        for (int bj = 0; bj < 2; ++bj) { float o[8];
#pragma unroll
                            for (int n = 0; n < 2; ++n)
#pragma unroll
                                for (int j = 0; j < 4; ++j) o[n * 4 + j] = acc[ai][bj][m][n][j];
                            *(v4u*)(rp + bj * 128) = pack8(o); }
                    }
            } else {
                bf16* A2 = (bf16*)(ws + WS_A2);
#pragma unroll
                for (int bj = 0; bj < 2; ++bj) {
                    const int c = (u.pn - 12) * 256 + bj * 128 + cw;
                    if (c < KL2) {
                        const int kd = c < 64 ? 1 : ((c >= 128 && c < 288) ? 2 : 0);
#pragma unroll
                        for (int ai = 0; ai < 2; ++ai)
#pragma unroll
                            for (int m = 0; m < 4; ++m) if (rrow[ai][m] >= 0) { float o[8];
#pragma unroll
                                for (int n = 0; n < 2; ++n)
#pragma unroll
                                    for (int j = 0; j < 4; ++j) { const float x = acc[ai][bj][m][n][j]; o[n * 4 + j] = kd == 1 ? tanhf_(x) : (kd == 2 ? sigmoidf_(x) : x); }
                                *(v4u*)(A2 + (size_t)rrow[ai][m] * KL2 + c) = pack8(o); }
                    }
                }
            }
        } else if (GRP == 0) {
            bf16* C = (bf16*)(ws + WS_L2);
            const int col0 = u.pn * 256 + wc * 32 + 8 * fq;
#pragma unroll
            for (int ai = 0; ai < 2; ++ai)
#pragma unroll
                for (int m = 0; m < 4; ++m) {
                    bf16* rp = C + (size_t)(row0 + ai * 128 + m * 16) * NL2 + col0;
#pragma unroll
                    for (int bj = 0; bj < 2; ++bj) { float o[8];
#pragma unroll
                        for (int n = 0; n < 2; ++n)
#pragma unroll
                            for (int j = 0; j < 4; ++j) o[n * 4 + j] = acc[ai][bj][m][n][j];
                        *(v4u*)(rp + bj * 128) = pack8(o); }
                }
        }
    }
};

constexpr int MT0 = 16384;
constexpr int HP_SEQ = TP + 1, HP_PB = BATCH * HP_SEQ, HP_M = 66 * 256;
static_assert(HP_PB + 2 * SB <= HP_M && (size_t)(HP_M + 2) * D * 2 <= SZ_MD4, "padded rwkv input");
__device__ __forceinline__ void tail_resid(const bf16* __restrict__ A, const bf16* __restrict__ Bt, int K, unsigned char* ws, int slot, float amul, LAS unsigned char* lds, int lane, int wave) {
    const int fr = lane & 15, fq = lane >> 4;
    const int kw = K >> 3;
    for (int job = blockIdx.x; job < 16 * 16; job += gridDim.x) {
        const int rs = job >> 4, cs = job & 15;
        const bf16* ap = A + (size_t)(MT0 + 16 * rs + fr) * K + wave * kw + 8 * fq;
        const bf16* bp = Bt + (size_t)(64 * cs + fr) * K + wave * kw + 8 * fq;
        f32x4 acc[4];
#pragma unroll
        for (int t = 0; t < 4; ++t) acc[t] = (f32x4){0.f, 0.f, 0.f, 0.f};
#pragma unroll 4
        for (int k0 = 0; k0 < kw; k0 += 32) {
            const bf16x8 af = *(const bf16x8*)(ap + k0);
#pragma unroll
            for (int t = 0; t < 4; ++t) { const bf16x8 bf = *(const bf16x8*)(bp + (size_t)(16 * t) * K + k0); acc[t] = __builtin_amdgcn_mfma_f32_16x16x32_bf16(bf, af, acc[t], 0, 0, 0); }
        }
        __syncthreads();
#pragma unroll
        for (int t = 0; t < 4; ++t) *(LAS f32x4*)(lds + ((wave * 4 + t) * 64 + lane) * 16) = acc[t];
        __syncthreads();
        if (wave == 0) {
#pragma unroll
            for (int t = 0; t < 4; ++t) { f32x4 s = acc[t];
#pragma unroll
                for (int w = 1; w < 8; ++w) s += *(LAS f32x4*)(lds + ((w * 4 + t) * 64 + lane) * 16);
                acc[t] = s; }
            const int row = MT0 + 16 * rs + fr;
            bf16* xb = (bf16*)(ws + WS_XB) + (size_t)row * D + 64 * cs + 4 * fq;
            float ssq = 0.f;
#pragma unroll
            for (int t = 0; t < 4; ++t) { const f32x4 v = ld_bf4(xb + 16 * t) + acc[t] * amul; st_bf4(xb + 16 * t, v);
                if (slot >= 0) ssq += (v.x * v.x + v.y * v.y) + (v.z * v.z + v.w * v.w); }
            if (slot >= 0) { ssq += shfl_xor_l(ssq, 16, lane); ssq += shfl_xor_l(ssq, 32, lane); if (fq == 0) ((float*)(ws + WS_SS))[((size_t)slot * M + row) * 16 + cs] = ssq; }
        }
    }
}

__device__ __forceinline__ void tr_item(const float* __restrict__ W, int ldw, int k0, int n0, bf16* __restrict__ WT, int ldt, int drow, const float* __restrict__ mu, LAS float* scr, int lane, const float* __restrict__ gs = nullptr) {
#pragma unroll 8
    for (int i = 0; i < 32; ++i) { const int kk = 2 * i + (lane >> 5); scr[kk * 33 + (lane & 31)] = W[(size_t)(k0 + kk) * ldw + n0 + (lane & 31)]; }
    asm volatile("s_waitcnt lgkmcnt(0)" ::: "memory");
    const int c = lane & 7;
    float mv[8];
    if (mu) {
#pragma unroll
        for (int e = 0; e < 8; ++e) mv[e] = mu[k0 + 8 * c + e];
    } else if (gs) {
#pragma unroll
        for (int e = 0; e < 8; ++e) mv[e] = gs[k0 + 8 * c + e];
    }
#pragma unroll
    for (int j = 0; j < 4; ++j) {
        const int n = (lane >> 3) + 8 * j; const LAS float* s = scr + (8 * c) * 33 + n;
        float f[8];
#pragma unroll
        for (int e = 0; e < 8; ++e) f[e] = s[e * 33];
        bf16* dp = WT + (size_t)(drow + n) * ldt + k0 + 8 * c;
        if (mu) {
            float f1[8], f2[8];
#pragma unroll
            for (int e = 0; e < 8; ++e) { f1[e] = f[e] * (1.f - mv[e]); f2[e] = f[e] * mv[e]; }
            *(v4u*)dp = pack8(f1); *(v4u*)(dp + 1024) = pack8(f2);
        } else { if (gs) {
#pragma unroll
            for (int e = 0; e < 8; ++e) f[e] *= mv[e]; }
            *(v4u*)dp = pack8(f); }
    }
    asm volatile("s_waitcnt lgkmcnt(0)" ::: "memory");
}

__device__ __forceinline__ void ph_p0(const Params& p, LAS unsigned char* lds, int tid, int lane, int wave) {
    unsigned char* ws = p.ws;
    LAS float* scr = (LAS float*)(lds + wave * 16384);
    const int gw = blockIdx.x * NWAVES + wave, NGW = gridDim.x * NWAVES;
    constexpr int C_WIN = 2 * 16 * 192, C_WOUT = 2 * 32 * 32, C_RKV = 2 * 3 * 512, C_W1 = 2 * 32, C_A1 = 2 * 32, C_G1 = 2 * 80, C_V1 = 16, C_WO = 2 * 512, C_WUG = 4 * 16 * 176, C_WD = 4 * 44 * 32;
    constexpr int NITEMS = C_WIN + C_WOUT + C_RKV + C_W1 + C_A1 + C_G1 + C_V1 + C_WO + C_WUG + C_WD;
    for (int it = gw; it < NITEMS; it += NGW) {
        int r = it;
        if (r < C_WIN) { const int j = r / 3072, q = r % 3072, kb = q / 192, nb = q % 192;
            tr_item(p.in[I_RWIN] + (size_t)j * D * RWIN, RWIN, 64 * kb, 32 * nb, (bf16*)(ws + WS_WIN + j * SZ_WIN), D, 32 * nb, nullptr, scr, lane, p.in[I_NMIX] + (size_t)(2 * j) * D); continue; }
        r -= C_WIN;
        if (r < C_WOUT) { const int j = r / 1024, q = r % 1024, kb = q / 32, nb = q % 32;
            tr_item(p.in[I_RWOUT] + (size_t)j * RV * D, D, 64 * kb, 32 * nb, (bf16*)(ws + WS_WOUT + j * SZ_WOUT), RV, 32 * nb, nullptr, scr, lane); continue; }
        r -= C_WOUT;
        if (r < C_RKV) { const int j = r / 1536, q = r % 1536, s = q / 512, q2 = q % 512, kb = q2 / 32, nb = q2 % 32, c = (s == 0 ? 0 : (s == 1 ? 2 : 3));
            tr_item(p.in[I_WRKV] + (size_t)(j * 3 + s) * D * D, D, 64 * kb, 32 * nb, (bf16*)(ws + WS_WRW + j * SZ_WRW), KRW, s * 1024 + 32 * nb, p.in[I_MU] + (size_t)(j * 6 + c) * D, scr, lane); continue; }
        r -= C_RKV;
        if (r < C_W1) { const int j = r / 32, q = r % 32, kb = q / 2, nb = q % 2;
            tr_item(p.in[I_W1] + (size_t)j * D * LW, LW, 64 * kb, 32 * nb, (bf16*)(ws + WS_WRW + j * SZ_WRW), KRW, 3072 + 32 * nb, p.in[I_MU] + (size_t)(j * 6 + 1) * D, scr, lane); continue; }
        r -= C_W1;
        if (r < C_A1) { const int j = r / 32, q = r % 32, kb = q / 2, nb = q % 2;
            tr_item(p.in[I_A1] + (size_t)j * D * LA, LA, 64 * kb, 32 * nb, (bf16*)(ws + WS_WRW + j * SZ_WRW), KRW, 3136 + 32 * nb, p.in[I_MU] + (size_t)(j * 6 + 4) * D, scr, lane); continue; }
        r -= C_A1;
        if (r < C_G1) { const int j = r / 80, q = r % 80, kb = q / 5, nb = q % 5;
            tr_item(p.in[I_G1] + (size_t)j * D * LG, LG, 64 * kb, 32 * nb, (bf16*)(ws + WS_WRW + j * SZ_WRW), KRW, 3200 + 32 * nb, p.in[I_MU] + (size_t)(j * 6 + 5) * D, scr, lane); continue; }
        r -= C_G1;
        if (r < C_V1) { const int kb = r;
            tr_item(p.in[I_V1], LV, 64 * kb, 0, (bf16*)(ws + WS_WRW + 1 * SZ_WRW), KRW, 3360, p.in[I_MU] + (size_t)(1 * 6 + 3) * D, scr, lane); continue; }
        r -= C_V1;
        if (r < C_WO) { const int j = r / 512, q = r % 512, kb = q / 32, nb = q % 32;
            tr_item(p.in[I_WO] + (size_t)j * D * D, D, 64 * kb, 32 * nb, (bf16*)(ws + WS_WO + j * SZ_WO), D, 32 * nb, nullptr, scr, lane); continue; }
        r -= C_WO;
        if (r < C_WUG) { const int i = r / 2816, q = r % 2816, kb = q / 176, nb = q % 176, n0 = 32 * nb;
            const int drow = n0 < DFF ? 256 * (n0 / 128) + (n0 % 128) : 256 * ((n0 - DFF) / 128) + 128 + ((n0 - DFF) % 128);
            tr_item(p.in[I_WUG] + (size_t)i * D * 2 * DFF, 2 * DFF, 64 * kb, n0, (bf16*)(ws + WS_WUG + i * SZ_WUG), D, drow, nullptr, scr, lane, p.in[I_NFFN] + (size_t)i * D); continue; }
        r -= C_WUG;
        { const int i = r / 1408, q = r % 1408, kb = q / 32, nb = q % 32;
            tr_item(p.in[I_WD] + (size_t)i * DFF * D, D, 64 * kb, 32 * nb, (bf16*)(ws + WS_WD + i * SZ_WD), DFF, 32 * nb, nullptr, scr, lane); }
    }
    const size_t gt = (size_t)blockIdx.x * NTHR + tid, GT = (size_t)gridDim.x * NTHR;
    for (size_t i = gt; i < (size_t)(224 + 192) * (KRW / 8); i += GT) {
        const int rr = (int)(i / (KRW / 8)), c8 = (int)(i % (KRW / 8));
        const int j = rr < 224 ? 0 : 1, row = rr < 224 ? 3360 + rr : 3392 + (rr - 224);
        *(v4u*)((bf16*)(ws + WS_WRW + j * SZ_WRW) + (size_t)row * KRW + c8 * 8) = (v4u){0u, 0u, 0u, 0u};
    }
    for (size_t i = gt; i < (size_t)2 * NL2 * KL2; i += GT) {
        const int j = (int)(i / ((size_t)NL2 * KL2)); const int rem = (int)(i % ((size_t)NL2 * KL2)); const int n = rem / KL2, k = rem % KL2, grp = n >> 10, nn = n & 1023;
        float v = 0.f;
        if (grp == 0) { if (k < 64) v = p.in[I_W2][((size_t)j * LW + k) * D + nn]; }
        else if (grp == 1) { if (k >= 64 && k < 128) v = p.in[I_A2][((size_t)j * LA + (k - 64)) * D + nn]; }
        else if (grp == 2) { if (k >= 128 && k < 288) v = p.in[I_G2][((size_t)j * LG + (k - 128)) * D + nn]; }
        else { if (j == 1 && k >= 288 && k < 320) v = p.in[I_V2][((size_t)(k - 288)) * D + nn]; }
        ((bf16*)(ws + WS_WL2 + j * SZ_WL2))[(size_t)n * KL2 + k] = (bf16)(cvt_pk_bf16(v, 0.f) & 0xffffu);
    }
    for (size_t i = gt; i < (size_t)(TP + 1) * 128; i += GT) {
        const int pi = (int)(i >> 7), mi = (int)(i & 127);
        const float pos = pi < TP ? (float)pi : PAST_POS;
        const float inv = 1.0f / powf(10000.0f, (float)mi / 127.0f);
        float s, c; sincosf(pos * inv, &s, &c);
        ((float2*)(ws + WS_CS))[i] = make_float2(c, s);
    }
    bf16* XB = (bf16*)(ws + WS_XB);
    for (int r = gw; r < M; r += NGW) {
        const float* src;
        if (r < MP) { const int b = r / TP, t = r % TP; src = t < NMETA ? p.in[I_META] + (size_t)t * D : p.in[I_XP] + ((size_t)b * SEQ + (t - NMETA)) * D; }
        else src = p.in[I_XS] + (size_t)(r - MP) * D;
        float ss = 0.f;
#pragma unroll
        for (int j = 0; j < 2; ++j) { const int c0 = 512 * j + 8 * lane;
            const f32x4 a4 = *(const f32x4*)(src + c0), b4 = *(const f32x4*)(src + c0 + 4);
            const float f[8] = {a4.x, a4.y, a4.z, a4.w, b4.x, b4.y, b4.z, b4.w};
#pragma unroll
            for (int e = 0; e < 8; ++e) ss += f[e] * f[e];
            *(v4u*)(XB + (size_t)r * D + c0) = pack8(f); }
        ss = wave_sum(ss, lane);
        if (lane < 16) ((float*)(ws + WS_SS))[(size_t)r * 16 + lane] = lane == 0 ? ss : 0.f;
    }
}

__device__ __forceinline__ void ph_norm(const Params& p, const float* __restrict__ g, int mode, int jl, int lane, int wave) {
    const bf16* X = (const bf16*)(p.ws + WS_XB); bf16* H = (bf16*)(p.ws + WS_H);
    const int gw = blockIdx.x * NWAVES + wave, NGW = gridDim.x * NWAVES;
    constexpr int UB = 4;
    for (int row0 = gw; row0 < M; row0 += NGW * UB) {
    v4u raw[UB][2];
#pragma unroll
    for (int q = 0; q < UB; ++q) { const int r_ = row0 + q * NGW, rc_ = r_ < M ? r_ : row0;
#pragma unroll
        for (int j = 0; j < 2; ++j) raw[q][j] = *(const v4u*)(X + (size_t)rc_ * D + 512 * j + 8 * lane); }
#pragma unroll
    for (int q = 0; q < UB; ++q) { const int row = row0 + q * NGW; if (row < M) {
        float v[2][8]; float ss = 0.f;
#pragma unroll
        for (int j = 0; j < 2; ++j) {
            unpack8(raw[q][j], v[j]);
#pragma unroll
            for (int e = 0; e < 8; ++e) ss += v[j][e] * v[j][e];
        }
        ss = wave_sum(ss, lane);
        const float rstd = rsqrtf(ss * (1.f / D) + 1e-6f);
        const bool prompt = row < MP; const int b = prompt ? row / TP : 0, t = prompt ? row % TP : 0;
#pragma unroll
        for (int j = 0; j < 2; ++j) {
            const int c0 = 512 * j + 8 * lane;
            const f32x4 ga = *(const f32x4*)(g + c0), gb = *(const f32x4*)(g + c0 + 4);
            float o[8];
            o[0] = v[j][0] * rstd * ga.x; o[1] = v[j][1] * rstd * ga.y; o[2] = v[j][2] * rstd * ga.z; o[3] = v[j][3] * rstd * ga.w;
            o[4] = v[j][4] * rstd * gb.x; o[5] = v[j][5] * rstd * gb.y; o[6] = v[j][6] * rstd * gb.z; o[7] = v[j][7] * rstd * gb.w;
            if (mode == 0) { *(v4u*)(H + (size_t)row * D + c0) = pack8(o); }
            else if (mode == 1) {
                const v4u w = pack8(o);
                if (prompt) {
                    bf16* hp = H + (size_t)(b * HP_SEQ + 1 + t) * D + c0;
                    *(v4u*)hp = w;
                    if (t == TP - 1) { float* so = p.out + O_SHP + ((size_t)jl * BATCH + b) * D + c0; *(f32x4*)so = (f32x4){o[0], o[1], o[2], o[3]}; *(f32x4*)(so + 4) = (f32x4){o[4], o[5], o[6], o[7]}; }
                    if (t == 0) *(v4u*)(hp - D) = (v4u){0u, 0u, 0u, 0u};
                } else {
                    const int s = row - MP;
                    const float* sp = p.in[I_SSHIFT] + ((size_t)jl * SB + s) * D + c0;
                    const f32x4 sa = *(const f32x4*)sp, sb2 = *(const f32x4*)(sp + 4);
                    const float pv[8] = {sa.x, sa.y, sa.z, sa.w, sb2.x, sb2.y, sb2.z, sb2.w};
                    bf16* hp = H + (size_t)(HP_PB + 2 * s) * D + c0;
                    *(v4u*)hp = pack8(pv); *(v4u*)(hp + D) = w;
                    float* so = p.out + O_SHS + ((size_t)jl * SB + s) * D + c0; *(f32x4*)so = (f32x4){o[0], o[1], o[2], o[3]}; *(f32x4*)(so + 4) = (f32x4){o[4], o[5], o[6], o[7]};
                }
            } else {
                float* dst = nullptr;
                if (prompt) { if (t >= NMETA) dst = p.out + O_YP + ((size_t)b * SEQ + (t - NMETA)) * D + c0; }
                else dst = p.out + O_YS + (size_t)(row - MP) * D + c0;
                if (dst) { *(f32x4*)dst = (f32x4){o[0], o[1], o[2], o[3]}; *(f32x4*)(dst + 4) = (f32x4){o[4], o[5], o[6], o[7]}; }
            }
        }
    } }
    }
}

__device__ __forceinline__ void ph_ret_norm(const Params& p, int jl, int lane, int wave) {
    const bf16* O = (const bf16*)(p.ws + WS_O); const bf16* SG = (const bf16*)(p.ws + WS_SG); bf16* Y = (bf16*)(p.ws + WS_Y);
    const float* gnw = p.in[I_RGN] + (size_t)jl * RV;
    const int gw = blockIdx.x * NWAVES + wave, NGW = gridDim.x * NWAVES;
    constexpr int UB = 4;
    for (int it0 = gw; it0 < M * RH; it0 += NGW * UB) {
        const int h = it0 & 3;
        const f32x4 ga = *(const f32x4*)(gnw + h * RDV + 8 * lane), gb = *(const f32x4*)(gnw + h * RDV + 8 * lane + 4);
        const float gg[8] = {ga.x, ga.y, ga.z, ga.w, gb.x, gb.y, gb.z, gb.w};
        v4u ov[UB], sgv[UB];
#pragma unroll
        for (int q = 0; q < UB; ++q) { const int it = it0 + q * NGW, itc = it < M * RH ? it : it0; const size_t off = (size_t)(itc >> 2) * RV + h * RDV + 8 * lane;
            ov[q] = *(const v4u*)(O + off); sgv[q] = *(const v4u*)(SG + off); }
#pragma unroll
        for (int q = 0; q < UB; ++q) { const int it = it0 + q * NGW; const size_t off = (size_t)(it >> 2) * RV + h * RDV + 8 * lane;
            float v[8]; unpack8(ov[q], v);
            float s = 0.f;
#pragma unroll
            for (int e = 0; e < 8; ++e) s += v[e];
            const float mean = wave_sum(s, lane) * (1.f / RDV);
            float s2 = 0.f;
#pragma unroll
            for (int e = 0; e < 8; ++e) { v[e] -= mean; s2 += v[e] * v[e]; }
            const float rstd = rsqrtf(wave_sum(s2, lane) * (1.f / RDV) + 1e-5f);
            float sg[8]; unpack8(sgv[q], sg);
            float o[8];
#pragma unroll
            for (int e = 0; e < 8; ++e) o[e] = v[e] * rstd * gg[e] * sg[e];
            if (it < M * RH) *(v4u*)(Y + off) = pack8(o);
        }
    }
}

__device__ __forceinline__ float row16_sum(float x);
__device__ __forceinline__ float half8_sum(float x);
__device__ __forceinline__ void ph_rwkv_post(const Params& p, int jl, int lane, int wave) {
    const bf16* YW = (const bf16*)(p.ws + WS_YW); const float* BON = (const float*)(p.ws + WS_NKK);
    const bf16* VP = (const bf16*)(p.ws + (jl == 0 ? WS_VF : WS_KKA)); const bf16* L2 = (const bf16*)(p.ws + WS_L2); bf16* Z = (bf16*)(p.ws + WS_Z);
    const float* lnw = p.in[I_LNW] + (size_t)jl * D; const float* lnb = p.in[I_LNB] + (size_t)jl * D;
    const int gw = blockIdx.x * NWAVES + wave, NGW = gridDim.x * NWAVES;
    const int sub = lane >> 3, c8 = lane & 7;
    constexpr int UB = 4;
    for (int it0 = gw * 8; it0 < M * WH; it0 += NGW * 8 * UB) {
        const int h = (it0 + sub) & 15, c = h * WN + 8 * c8;
        const f32x4 lwa = *(const f32x4*)(lnw + c), lwb = *(const f32x4*)(lnw + c + 4), lba = *(const f32x4*)(lnb + c), lbb = *(const f32x4*)(lnb + c + 4);
        const float lw[8] = {lwa.x, lwa.y, lwa.z, lwa.w, lwb.x, lwb.y, lwb.z, lwb.w}, lb[8] = {lba.x, lba.y, lba.z, lba.w, lbb.x, lbb.y, lbb.z, lbb.w};
        v4u y4[UB], v4[UB], g4[UB]; float bonv[UB];
#pragma unroll
        for (int q = 0; q < UB; ++q) { const int it = it0 + q * NGW * 8 + sub, itc = it < M * WH ? it : it0 + sub, row = itc >> 4; const size_t idx = (size_t)row * D + c;
            y4[q] = *(const v4u*)(YW + idx); bonv[q] = BON[(size_t)row * WH + h]; v4[q] = *(const v4u*)(VP + idx); g4[q] = *(const v4u*)(L2 + (size_t)row * NL2 + 2048 + c); }
#pragma unroll
        for (int q = 0; q < UB; ++q) { const int it = it0 + q * NGW * 8 + sub, row = it >> 4; const size_t idx = (size_t)row * D + c;
            float yv[8], vv[8], gv[8]; unpack8(y4[q], yv); unpack8(v4[q], vv); unpack8(g4[q], gv);
            float s = 0.f;
#pragma unroll
            for (int e = 0; e < 8; ++e) s += yv[e];
            const float mean = half8_sum(s) * (1.f / WN);
            float s2 = 0.f;
#pragma unroll
            for (int e = 0; e < 8; ++e) { yv[e] -= mean; s2 += yv[e] * yv[e]; }
            const float rstd = rsqrtf(half8_sum(s2) * (1.f / WN) + 64e-5f);
            float z[8];
#pragma unroll
            for (int e = 0; e < 8; ++e) z[e] = (yv[e] * rstd * lw[e] + lb[e] + vv[e] * bonv[q]) * gv[e];
            if (it < M * WH) *(v4u*)(Z + idx) = pack8(z);
        }
    }
}

constexpr int RT_KP = 528, RT_VP = 144, RT_SP = 528;
constexpr int RT_K_OFF = 0, RT_V_OFF = 128 * RT_KP, RT_ST_OFF = RT_V_OFF + 128 * RT_VP, RT_END = RT_ST_OFF + 64 * RT_SP;
static_assert(RT_END <= LDS_BYTES, "retention LDS map");
typedef short v4s __attribute__((ext_vector_type(4)));
__device__ __forceinline__ bf16x8 tr_pair(LAS unsigned char* a0, LAS unsigned char* a1) {
    const v4s lo = __builtin_amdgcn_ds_read_tr16_b64_v4i16((LAS v4s*)a0), hi = __builtin_amdgcn_ds_read_tr16_b64_v4i16((LAS v4s*)a1);
    return __builtin_shufflevector(lo, hi, 0, 1, 2, 3, 4, 5, 6, 7);
}
__device__ __forceinline__ void ph_ret_fast(const Params& p, int jl, LAS unsigned char* lds, int tid, int lane, int wave) {
    const bf16* QK = (const bf16*)(p.ws + WS_QK); const bf16* V = (const bf16*)(p.ws + WS_V); bf16* O = (bf16*)(p.ws + WS_O);
    const int fr = lane & 15, fq = lane >> 4, li_q = (lane & 15) >> 2, li_p = lane & 3;
    for (int u = blockIdx.x; u < BATCH * RH * 8; u += gridDim.x) {
        const int es = u & 7, h = (u >> 3) & 3, b = u >> 5;
        const float gamma = 1.0f - exp2f(-5.0f - (float)h), lg = log2f(gamma), g128 = exp2f(128.f * lg), g127 = exp2f(127.f * lg);
        const int it_ = wave < 4 ? wave : 11 - wave, i0 = 16 * it_, d0 = 32 * wave;
        f32x4 Sacc[2][4];
#pragma unroll
        for (int a = 0; a < 2; ++a)
#pragma unroll
            for (int c = 0; c < 4; ++c) Sacc[a][c] = (f32x4){0.f, 0.f, 0.f, 0.f};
        __syncthreads();
        for (int i = tid; i < 64 * RT_SP / 16; i += NTHR) *(LAS v4u*)(lds + RT_ST_OFF + i * 16) = (v4u){0u, 0u, 0u, 0u};
        v4u kst[8], vst[2];
        const bf16* Kg = QK + 1024 + 256 * h; const bf16* Vg = V + 512 * h + 64 * es; const bf16* Qg = QK + 256 * h;
#define RT_LOAD_STAGE(cc) do { int tl_ = tid; asm volatile("" : "+v"(tl_));     \
            _Pragma("unroll") for (int k_ = 0; k_ < 8; ++k_) { const int id_ = tl_ + 512 * k_, row_ = id_ >> 5, ch_ = id_ & 31, t_ = 128 * (cc) - 112 + row_; \
                kst[k_] = t_ >= 0 ? *(const v4u*)(Kg + (size_t)(b * TP + t_) * 2048 + 8 * ch_) : (v4u){0u, 0u, 0u, 0u}; } \
            _Pragma("unroll") for (int k_ = 0; k_ < 2; ++k_) { const int id_ = tl_ + 512 * k_, row_ = id_ >> 3, ch_ = id_ & 7, t_ = 128 * (cc) - 112 + row_; \
                vst[k_] = t_ >= 0 ? *(const v4u*)(Vg + (size_t)(b * TP + t_) * 2048 + 8 * ch_) : (v4u){0u, 0u, 0u, 0u}; } } while (0)
        RT_LOAD_STAGE(0);
        bf16x8 Qf[8];
#define RT_LOAD_Q(cc) do { int ll_ = lane; asm volatile("" : "+v"(ll_)); const int t_ = 128 * (cc) - 112 + i0 + (ll_ & 15); \
            _Pragma("unroll") for (int s = 0; s < 8; ++s) Qf[s] = t_ >= 0 ? *(const bf16x8*)(Qg + (size_t)(b * TP + t_) * 2048 + 32 * s + 8 * (ll_ >> 4)) : (bf16x8){0, 0, 0, 0, 0, 0, 0, 0}; } while (0)
        RT_LOAD_Q(0);
        for (int c = 0; c < 17; ++c) {
            __syncthreads();
#pragma unroll
            for (int k_ = 0; k_ < 8; ++k_) { const int id_ = tid + 512 * k_, row_ = id_ >> 5, ch_ = id_ & 31; *(LAS v4u*)(lds + RT_K_OFF + row_ * RT_KP + ch_ * 16) = kst[k_]; }
#pragma unroll
            for (int k_ = 0; k_ < 2; ++k_) { const int id_ = tid + 512 * k_, row_ = id_ >> 3, ch_ = id_ & 7;
                float f[8]; unpack8(vst[k_], f); const float sc = exp2f(-(float)row_ * lg);
#pragma unroll
                for (int e = 0; e < 8; ++e) f[e] *= sc;
                *(LAS v4u*)(lds + RT_V_OFF + row_ * RT_VP + ch_ * 16) = pack8(f); }
            __syncthreads();
            bf16x8 Pf[4];
            { const int ii = i0 + fr; const float gi = exp2f((float)ii * lg);
#pragma unroll
              for (int s2 = 0; s2 < 4; ++s2) { f32x4 Dp[2];
                  Dp[0] = (f32x4){0.f, 0.f, 0.f, 0.f}; Dp[1] = Dp[0];
                  if (2 * s2 <= it_) {
                      bf16x8 Ka[8], Kb[8];
#pragma unroll
                      for (int s = 0; s < 8; ++s) { Ka[s] = *(const LAS bf16x8*)(lds + RT_K_OFF + (16 * (2 * s2) + fr) * RT_KP + (32 * s + 8 * fq) * 2);
                          Kb[s] = *(const LAS bf16x8*)(lds + RT_K_OFF + (16 * (2 * s2 + 1) + fr) * RT_KP + (32 * s + 8 * fq) * 2); }
                      __builtin_amdgcn_sched_barrier(0);
                      __builtin_amdgcn_s_setprio(1);
#pragma unroll
                      for (int s = 0; s < 8; ++s) { Dp[0] = __builtin_amdgcn_mfma_f32_16x16x32_bf16(Ka[s], Qf[s], Dp[0], 0, 0, 0); Dp[1] = __builtin_amdgcn_mfma_f32_16x16x32_bf16(Kb[s], Qf[s], Dp[1], 0, 0, 0); }
                      __builtin_amdgcn_s_setprio(0);
                      __builtin_amdgcn_sched_barrier(0);
                  }
                  float f[8];
#pragma unroll
                  for (int hh = 0; hh < 2; ++hh)
#pragma unroll
                      for (int r = 0; r < 4; ++r) { const int jj = 16 * (2 * s2 + hh) + 4 * fq + r; f[hh * 4 + r] = ii >= jj ? Dp[hh][r] * gi : 0.f; }
                  const v4u w = pack8(f); Pf[s2] = __builtin_bit_cast(bf16x8, w); } }
            f32x4 Oacc[4];
#pragma unroll
            for (int ep = 0; ep < 2; ++ep) {
                bf16x8 Sa[8], Sb[8];
#pragma unroll
                for (int s = 0; s < 8; ++s) { Sa[s] = *(const LAS bf16x8*)(lds + RT_ST_OFF + (16 * (2 * ep) + fr) * RT_SP + (32 * s + 8 * fq) * 2);
                    Sb[s] = *(const LAS bf16x8*)(lds + RT_ST_OFF + (16 * (2 * ep + 1) + fr) * RT_SP + (32 * s + 8 * fq) * 2); }
                __builtin_amdgcn_sched_barrier(0);
                f32x4 oa = (f32x4){0.f, 0.f, 0.f, 0.f}, ob = oa;
                __builtin_amdgcn_s_setprio(1);
#pragma unroll
                for (int s = 0; s < 8; ++s) { oa = __builtin_amdgcn_mfma_f32_16x16x32_bf16(Qf[s], Sa[s], oa, 0, 0, 0); ob = __builtin_amdgcn_mfma_f32_16x16x32_bf16(Qf[s], Sb[s], ob, 0, 0, 0); }
                __builtin_amdgcn_s_setprio(0);
                Oacc[2 * ep] = oa; Oacc[2 * ep + 1] = ob;
                __builtin_amdgcn_sched_barrier(0);
            }
            __syncthreads();
            if (c + 1 < 17) RT_LOAD_STAGE(c + 1);
#pragma unroll
            for (int r = 0; r < 4; ++r) { const float lam = exp2f((float)(i0 + 4 * fq + r + 1) * lg);
#pragma unroll
                for (int et = 0; et < 4; ++et) Oacc[et][r] *= lam; }
#pragma unroll
            for (int s = 0; s < 4; ++s) if (2 * s <= it_) {
                bf16x8 Vf[4];
#pragma unroll
                for (int et = 0; et < 4; ++et) { LAS unsigned char* a0 = lds + RT_V_OFF + (32 * s + 4 * fq + li_q) * RT_VP + (16 * et + 4 * li_p) * 2; Vf[et] = tr_pair(a0, a0 + 16 * RT_VP); }
                __builtin_amdgcn_sched_barrier(0);
#pragma unroll
                for (int et = 0; et < 4; ++et) Oacc[et] = __builtin_amdgcn_mfma_f32_16x16x32_bf16(Pf[s], Vf[et], Oacc[et], 0, 0, 0);
            }
            {
                v2u ow[4];
#pragma unroll
                for (int et = 0; et < 4; ++et) { float oq[4] = {Oacc[et][0], Oacc[et][1], Oacc[et][2], Oacc[et][3]}; quad_transpose4(oq, fr & 3); ow[et] = pk4((f32x4){oq[0], oq[1], oq[2], oq[3]}); }
                const int t_ = 128 * c - 112 + i0 + 4 * fq + (fr & 3);
                if (t_ >= 0) { bf16* op = O + (size_t)(b * TP + t_) * RV + 512 * h + 64 * es + (fr & 12);
#pragma unroll
                    for (int et = 0; et < 4; ++et) *(v2u*)(op + 16 * et) = ow[et]; }
            }
#pragma unroll
            for (int dt = 0; dt < 2; ++dt)
#pragma unroll
                for (int et = 0; et < 4; ++et) Sacc[dt][et] = Sacc[dt][et] * (g128 / g127);
            {
                bf16x8 Kt[2][2], Vt[2][4];
#define RT_RD4(bufi, s_) do { \
                _Pragma("unroll") for (int dt = 0; dt < 2; ++dt) { LAS unsigned char* a0 = lds + RT_K_OFF + (32 * (s_) + 8 * fq + li_q) * RT_KP + (d0 + 16 * dt + 4 * li_p) * 2; Kt[bufi][dt] = tr_pair(a0, a0 + 4 * RT_KP); } \
                _Pragma("unroll") for (int et = 0; et < 4; ++et) { LAS unsigned char* a0 = lds + RT_V_OFF + (32 * (s_) + 8 * fq + li_q) * RT_VP + (16 * et + 4 * li_p) * 2; Vt[bufi][et] = tr_pair(a0, a0 + 4 * RT_VP); } } while (0)
                RT_RD4(0, 0);
#pragma unroll
                for (int s = 0; s < 4; ++s) {
                    __builtin_amdgcn_sched_barrier(0);
                    if (s + 1 < 4) RT_RD4((s + 1) & 1, s + 1);
                    __builtin_amdgcn_s_setprio(1);
#pragma unroll
                    for (int dt = 0; dt < 2; ++dt)
#pragma unroll
                        for (int et = 0; et < 4; ++et) Sacc[dt][et] = __builtin_amdgcn_mfma_f32_16x16x32_bf16(Kt[s & 1][dt], Vt[s & 1][et], Sacc[dt][et], 0, 0, 0);
                    __builtin_amdgcn_s_setprio(0);
                }
                __builtin_amdgcn_sched_barrier(0);
#undef RT_RD4
            }
#pragma unroll
            for (int dt = 0; dt < 2; ++dt)
#pragma unroll
                for (int et = 0; et < 4; ++et) Sacc[dt][et] = Sacc[dt][et] * g127;
#pragma unroll
            for (int dt = 0; dt < 2; ++dt)
#pragma unroll
                for (int et = 0; et < 4; ++et) { v2u w; w.x = cvt_pk_bf16(Sacc[dt][et][0], Sacc[dt][et][1]); w.y = cvt_pk_bf16(Sacc[dt][et][2], Sacc[dt][et][3]);
                    *(LAS v2u*)(lds + RT_ST_OFF + (16 * et + fr) * RT_SP + (d0 + 16 * dt + 4 * fq) * 2) = w; }
            if (c + 1 < 17) RT_LOAD_Q(c + 1);
        }
#undef RT_LOAD_Q
#undef RT_LOAD_STAGE
        float* so = p.out + O_RETP + ((((size_t)jl * BATCH + b) * RH + h) * RDK) * RDV + 64 * es;
#pragma unroll
        for (int dt = 0; dt < 2; ++dt)
#pragma unroll
            for (int et = 0; et < 4; ++et)
#pragma unroll
                for (int r = 0; r < 4; ++r) so[(size_t)(d0 + 16 * dt + 4 * fq + r) * RDV + 16 * et + fr] = Sacc[dt][et][r];
    }
    {
        LAS float* sq = (LAS float*)lds; LAS float* sk = sq + 256; LAS float* red = sk + 256;
        const int e4 = tid & 127, dq = tid >> 7;
        for (int it = blockIdx.x; it < SB * RH; it += gridDim.x) {
            const int h = it & 3, s = it >> 2, row = MP + s;
            const float gamma = 1.0f - exp2f(-5.0f - (float)h);
            __syncthreads();
            if (tid < 256) sq[tid] = bf_lo((unsigned)QK[(size_t)row * 2048 + 256 * h + tid]);
            else sk[tid - 256] = bf_lo((unsigned)QK[(size_t)row * 2048 + 1024 + 256 * h + (tid - 256)]);
            const v2u vv = *(const v2u*)(V + (size_t)row * 2048 + 512 * h + 4 * e4);
            const f32x4 v4 = (f32x4){bf_lo(vv.x), bf_hi(vv.x), bf_lo(vv.y), bf_hi(vv.y)};
            __syncthreads();
            const float* sin_ = p.in[I_SRET] + ((((size_t)jl * SB + s) * RH + h) * RDK) * RDV + 4 * e4;
            float* sout = p.out + O_RETS + ((((size_t)jl * SB + s) * RH + h) * RDK) * RDV + 4 * e4;
            f32x4 oacc = (f32x4){0.f, 0.f, 0.f, 0.f};
#pragma unroll 8
            for (int k = 0; k < 64; ++k) { const int d = dq + 4 * k;
                const f32x4 sv = __builtin_nontemporal_load((const f32x4*)(sin_ + (size_t)d * RDV));
                const f32x4 sn = sv * gamma + v4 * sk[d];
                oacc += sn * sq[d];
                __builtin_nontemporal_store(sn, (f32x4*)(sout + (size_t)d * RDV)); }
            *(LAS f32x4*)(red + dq * 512 + 4 * e4) = oacc;
            __syncthreads();
            if (dq == 0) { const f32x4 r = (*(LAS f32x4*)(red + 4 * e4) + *(LAS f32x4*)(red + 512 + 4 * e4)) + (*(LAS f32x4*)(red + 1024 + 4 * e4) + *(LAS f32x4*)(red + 1536 + 4 * e4));
                st_bf4(O + (size_t)row * RV + 512 * h + 4 * e4, r); }
        }
    }
}

typedef float f32x2w __attribute__((ext_vector_type(2)));
constexpr int WK_TB = 32, WK_STEP_B = 6 * 256 + 16, WK_BUF_B = WK_TB * WK_STEP_B, WK_Y_OFF = 2 * WK_BUF_B, WK_YB_B = WK_TB * 32 * 4;
static_assert(WK_Y_OFF + 2 * WK_YB_B <= LDS_BYTES - 16, "wkv LDS map");
__device__ __forceinline__ float row16_sum(float x) {
    x += __builtin_bit_cast(float, __builtin_amdgcn_update_dpp(0, __builtin_bit_cast(int, x), 0x128, 0xf, 0xf, false));
    x += __builtin_bit_cast(float, __builtin_amdgcn_update_dpp(0, __builtin_bit_cast(int, x), 0x124, 0xf, 0xf, false));
    x += __builtin_bit_cast(float, __builtin_amdgcn_update_dpp(0, __builtin_bit_cast(int, x), 0x122, 0xf, 0xf, false));
    x += __builtin_bit_cast(float, __builtin_amdgcn_update_dpp(0, __builtin_bit_cast(int, x), 0x121, 0xf, 0xf, false));
    return x;
}
__device__ __forceinline__ float half8_sum(float x) {
    x += __builtin_bit_cast(float, __builtin_amdgcn_update_dpp(0, __builtin_bit_cast(int, x), 0x141, 0xf, 0xf, false));
    x += __builtin_bit_cast(float, __builtin_amdgcn_update_dpp(0, __builtin_bit_cast(int, x), 0xB1, 0xf, 0xf, false));
    x += __builtin_bit_cast(float, __builtin_amdgcn_update_dpp(0, __builtin_bit_cast(int, x), 0x4E, 0xf, 0xf, false));
    return x;
}
struct WkPar { f32x4 w0, a0, kkp, kap, v0; };
__device__ __forceinline__ f32x4 wk_unit_neg(const f32x4 kraw, const f32x4 kkp) {
    const f32x4 kk = kraw * kkp;
    const float ss = row16_sum((kk.x * kk.x + kk.y * kk.y) + (kk.z * kk.z + kk.w * kk.w));
    return kk * (-rsqrtf(fmaxf(ss, 1e-12f)));
}
__device__ __forceinline__ float wk_decay(float x) { return __expf(-0.60653065971263342f * sigmoidf_(x)); }
__device__ __forceinline__ void wk_prep(const WkPar& P, const f32x4 kraw, const f32x4 vraw, const f32x4 lw2, const f32x4 la2, const f32x4 vf, const f32x4 lv2, bool vres,
                                        f32x4& w, f32x4& ka, f32x4& km, f32x4& vp, f32x4& nk) {
    nk = wk_unit_neg(kraw, P.kkp);
    w = (f32x4){wk_decay(P.w0.x + lw2.x), wk_decay(P.w0.y + lw2.y), wk_decay(P.w0.z + lw2.z), wk_decay(P.w0.w + lw2.w)};
    const f32x4 a = (f32x4){sigmoidf_(P.a0.x + la2.x), sigmoidf_(P.a0.y + la2.y), sigmoidf_(P.a0.z + la2.z), sigmoidf_(P.a0.w + la2.w)};
    ka = nk * (-a);
    km = kraw * ((a - 1.f) * P.kap + 1.f);
    vp = vraw;
    if (vres) { const f32x4 sg = (f32x4){sigmoidf_(P.v0.x + lv2.x), sigmoidf_(P.v0.y + lv2.y), sigmoidf_(P.v0.z + lv2.z), sigmoidf_(P.v0.w + lv2.w)}; vp = vraw + (vf - vraw) * sg; }
}
constexpr int WC_C = 16, WC_NCH = TP / WC_C;
static_assert(WC_NCH * WC_C == TP, "chunking");
constexpr int REC_WA = 0, REC_RP = 2048, REC_BK = 4096, REC_VV = 8192, REC_TK = 10240, REC_MY = 10752, REC_GC = 11264, REC_BYTES = 11520;
constexpr size_t WS_REC = WS_END;
constexpr size_t WS_END2 = WS_REC + (size_t)BATCH * WH * WC_NCH * REC_BYTES;
__device__ __forceinline__ unsigned bf_rne_c(float f) { unsigned u = __float_as_uint(f); return (u + 0x7fffu + ((u >> 16) & 1u)) >> 16; }
__device__ __forceinline__ unsigned pk2_c(float lo, float hi) { return bf_rne_c(lo) | (bf_rne_c(hi) << 16); }
__device__ __forceinline__ float bf_rd(const bf16* q) { return __uint_as_float((unsigned)(*q) << 16); }
__device__ __forceinline__ bf16 bf_of(float x) { return (bf16)(cvt_pk_bf16(x, 0.f) & 0xffffu); }

__device__ __forceinline__ f32x4 mm16(const v2u a, const v2u b, const f32x4 c) { return __builtin_amdgcn_mfma_f32_16x16x16bf16_1k(__builtin_bit_cast(v4s, a), __builtin_bit_cast(v4s, b), c, 0, 0, 0); }
__device__ __forceinline__ f32x4 mm32(const v2u a0, const v2u a1, const v2u b0, const v2u b1, const f32x4 c) {
    const v4u a = (v4u){a0.x, a0.y, a1.x, a1.y}, b = (v4u){b0.x, b0.y, b1.x, b1.y};
    return __builtin_amdgcn_mfma_f32_16x16x32_bf16(__builtin_bit_cast(bf16x8, a), __builtin_bit_cast(bf16x8, b), c, 0, 0, 0);
}
template <int CTRL> __device__ __forceinline__ float dppz(float x) { return __int_as_float(__builtin_amdgcn_update_dpp(0, __float_as_int(x), CTRL, 0xf, 0xf, true)); }
__device__ __forceinline__ float psum16(float x) { x += dppz<0x111>(x); x += dppz<0x112>(x); x += dppz<0x114>(x); x += dppz<0x118>(x); return x; }
__device__ __forceinline__ v2u tr16(LAS unsigned char* a) { return __builtin_bit_cast(v2u, __builtin_amdgcn_ds_read_tr16_b64_v4i16((LAS v4s*)a)); }
__device__ __forceinline__ void ph_wkv1(const Params& p, int jl, LAS unsigned char* lds, int lane_in, int wave) {
    const bf16* Kr = (const bf16*)(p.ws + WS_K); const bf16* Vr = (const bf16*)(p.ws + (jl == 0 ? WS_VF : WS_VB)); const bf16* VFp = (const bf16*)(p.ws + WS_VF);
    const bf16* Rr = (const bf16*)(p.ws + WS_R); const bf16* L2 = (const bf16*)(p.ws + WS_L2);
    float* BON = (float*)(p.ws + WS_NKK); bf16* VP = (bf16*)(p.ws + WS_KKA);
    const bool vres = jl == 1;
    constexpr int IMG = 16 * 144;
    constexpr float CL2 = 0.60653065971263342f * 1.4426950408889634f;
    const int gw = wave * gridDim.x + blockIdx.x, NGW = gridDim.x * NWAVES;
    v4u wK[2], wLW[2], wLA[2], wR[2], wV[2], wVF[2], wLV[2];
#define W1_LOAD_RAW(jb, lnx) do { const int c_ = (jb) % WC_NCH, sh_ = (jb) / WC_NCH, r_ = (sh_ >> 4) * TP + WC_C * c_ + ((lnx) & 15), fq_ = (lnx) >> 4, cb_ = (sh_ & 15) * WN + (fq_ & 1) * 16 + (fq_ >> 1) * 8; \
        const size_t ro_ = (size_t)r_ * D + cb_, lo_ = (size_t)r_ * NL2 + cb_; \
        _Pragma("unroll") for (int P = 0; P < 2; ++P) { wK[P] = *(const v4u*)(Kr + ro_ + 32 * P); wLW[P] = *(const v4u*)(L2 + lo_ + 32 * P); wLA[P] = *(const v4u*)(L2 + lo_ + 1024 + 32 * P); \
            wR[P] = *(const v4u*)(Rr + ro_ + 32 * P); wV[P] = *(const v4u*)(Vr + ro_ + 32 * P); wVF[P] = (v4u){0u, 0u, 0u, 0u}; wLV[P] = (v4u){0u, 0u, 0u, 0u}; } \
        if (vres) { _Pragma("unroll") for (int P = 0; P < 2; ++P) { wVF[P] = *(const v4u*)(VFp + ro_ + 32 * P); wLV[P] = *(const v4u*)(L2 + lo_ + 3072 + 32 * P); } } } while (0)
#define W1_UNSWAP(QQ_, WW_) do { _Pragma("unroll") for (int P = 0; P < 2; ++P) { const v4u wv_ = WW_[P]; const auto s0_ = __builtin_amdgcn_permlane16_swap(wv_[0], wv_[2], false, false), s1_ = __builtin_amdgcn_permlane16_swap(wv_[1], wv_[3], false, false); \
        QQ_[2 * P] = (v2u){s0_[0], s1_[0]}; QQ_[2 * P + 1] = (v2u){s0_[1], s1_[1]}; } } while (0)
    if (gw < BATCH * WH * WC_NCH) { int l0 = lane_in; asm volatile("" : "+v"(l0)); W1_LOAD_RAW(gw, l0); }
    for (int job = gw; job < BATCH * WH * WC_NCH; job += NGW) {
        int ln = lane_in; asm volatile("" : "+v"(ln));
        const int lane = ln, fr = lane & 15, fq = lane >> 4;
        const int c = job % WC_NCH, sh = job / WC_NCH, h = sh & 15, seq = sh >> 4, r0 = seq * TP + WC_C * c, chb = h * WN + 4 * fq;
        LAS unsigned char* sc = lds + wave * 16384;
        unsigned char* rec = p.ws + WS_REC + (size_t)job * REC_BYTES;
        const size_t ro = (size_t)(r0 + fr) * D + chb, lo = (size_t)(r0 + fr) * NL2 + chb, po = (size_t)jl * D + chb;
        f32x4 cKK[4], cW0[4], cA0[4], cKA[4], cRK[4];
#pragma unroll
        for (int jt = 0; jt < 4; ++jt) { cKK[jt] = *(const f32x4*)(p.in[I_KK] + po + 16 * jt); cW0[jt] = *(const f32x4*)(p.in[I_W0] + po + 16 * jt); cA0[jt] = *(const f32x4*)(p.in[I_A0] + po + 16 * jt);
            cKA[jt] = *(const f32x4*)(p.in[I_KA] + po + 16 * jt); cRK[jt] = *(const f32x4*)(p.in[I_RK] + po + 16 * jt); }
#define W1_UP4(q) ((f32x4){bf_lo((q).x), bf_hi((q).x), bf_lo((q).y), bf_hi((q).y)})
        v2u qK[4], qLW[4], qLA[4], qR[4], qV[4], qVF[4], qLV[4];
        W1_UNSWAP(qK, wK); W1_UNSWAP(qLW, wLW); W1_UNSWAP(qLA, wLA); W1_UNSWAP(qR, wR); W1_UNSWAP(qV, wV); W1_UNSWAP(qVF, wVF); W1_UNSWAP(qLV, wLV);
        f32x4 kraw[4], kk[4];
        float ss = 0.f;
#pragma unroll
        for (int jt = 0; jt < 4; ++jt) { kraw[jt] = W1_UP4(qK[jt]); kk[jt] = kraw[jt] * cKK[jt];
            ss += (kk[jt].x * kk[jt].x + kk[jt].y * kk[jt].y) + (kk[jt].z * kk[jt].z + kk[jt].w * kk[jt].w); }
        ss += shfl_xor_l(ss, 16, lane); ss += shfl_xor_l(ss, 32, lane);
        const float inv = rsqrtf(fmaxf(ss, 1e-12f));
        v2u pa[4], pb[4], pk[4], pr[4], pvp[4]; f32x4 rt[4], ggv[4];
        float bonp = 0.f;
        LAS unsigned char* iw = sc + fr * 144 + 8 * fq;
#pragma unroll
        for (int jt = 0; jt < 4; ++jt) {
            const f32x4 lw2 = W1_UP4(qLW[jt]), la2 = W1_UP4(qLA[jt]), rr = W1_UP4(qR[jt]), vraw = W1_UP4(qV[jt]);
            const f32x4 pw0 = cW0[jt], pa0 = cA0[jt], pka = cKA[jt], prk = cRK[jt];
            f32x4 vp = vraw;
            if (vres) { const f32x4 vf = W1_UP4(qVF[jt]), lv2 = W1_UP4(qLV[jt]), pv0 = *(const f32x4*)(p.in[I_V0] + chb + 16 * jt);
#pragma unroll
                for (int e = 0; e < 4; ++e) vp[e] = vraw[e] + (vf[e] - vraw[e]) * sigmoidf_(pv0[e] + lv2[e]); }
            f32x4 at, bt, kt, kq, rq, gg;
#pragma unroll
            for (int e = 0; e < 4; ++e) {
                const float a = sigmoidf_(pa0[e] + la2[e]), d = CL2 * sigmoidf_(pw0[e] + lw2[e]), cum = psum16(d);
                const float g = __builtin_amdgcn_exp2f(-cum), ig = __builtin_amdgcn_exp2f(cum), gp = __builtin_amdgcn_exp2f(d - cum), nk = -kk[jt][e] * inv;
                kt[e] = kraw[jt][e] * (1.f + (a - 1.f) * pka[e]);
                bonp = fmaf(rr[e] * kt[e], prk[e], bonp);
                at[e] = nk * gp; bt[e] = -nk * a * ig; kq[e] = kt[e] * ig; rq[e] = rr[e] * g; gg[e] = g;
            }
            pa[jt] = pk4(at); pb[jt] = pk4(bt); pk[jt] = pk4(kq); pr[jt] = pk4(rq); rt[jt] = rq; pvp[jt] = pk4(vp); ggv[jt] = gg;
            *(LAS v2u*)(iw + 0 * IMG + 32 * jt) = pa[jt]; *(LAS v2u*)(iw + 1 * IMG + 32 * jt) = pb[jt]; *(LAS v2u*)(iw + 2 * IMG + 32 * jt) = pk[jt]; *(LAS v2u*)(iw + 3 * IMG + 32 * jt) = pvp[jt];
        }
#undef W1_UP4
        if (job + NGW < BATCH * WH * WC_NCH) W1_LOAD_RAW(job + NGW, lane);
        if (vres) {
#pragma unroll
            for (int P = 0; P < 2; ++P) { const auto t0 = __builtin_amdgcn_permlane16_swap(pvp[2 * P].x, pvp[2 * P + 1].x, false, false), t1 = __builtin_amdgcn_permlane16_swap(pvp[2 * P].y, pvp[2 * P + 1].y, false, false);
                *(v4u*)(VP + (size_t)(r0 + fr) * D + h * WN + (fq & 1) * 16 + (fq >> 1) * 8 + 32 * P) = (v4u){t0[0], t1[0], t0[1], t1[1]}; }
        }
#pragma unroll
        for (int jt = 0; jt < 4; ++jt) if (fr == 15) *(f32x4*)(rec + REC_GC + (16 * jt + 4 * fq) * 4) = ggv[jt];
        bonp += shfl_xor_l(bonp, 16, lane); bonp += shfl_xor_l(bonp, 32, lane);
        if (fq == 0) BON[(size_t)(r0 + fr) * WH + h] = bonp;
        const f32x4 z4 = (f32x4){0.f, 0.f, 0.f, 0.f};
        const int dd = fr - 4 * fq;
        f32x4 L = mm32(pa[2], pa[3], pb[2], pb[3], mm32(pa[0], pa[1], pb[0], pb[1], z4));
        f32x4 LT = mm32(pb[2], pb[3], pa[2], pa[3], mm32(pb[0], pb[1], pa[0], pa[1], z4));
        f32x4 Lak = mm32(pa[2], pa[3], pk[2], pk[3], mm32(pa[0], pa[1], pk[0], pk[1], z4));
        f32x4 MrbT = mm32(pb[2], pb[3], pr[2], pr[3], mm32(pb[0], pb[1], pr[0], pr[1], z4));
        f32x4 MrkT = mm32(pk[2], pk[3], pr[2], pr[3], mm32(pk[0], pk[1], pr[0], pr[1], z4));
        f32x4 TT;
#pragma unroll
        for (int r = 0; r < 4; ++r) {
            L[r] = dd < r ? L[r] : 0.f; Lak[r] = dd < r ? Lak[r] : 0.f;
            LT[r] = r < dd ? LT[r] : 0.f; MrbT[r] = r <= dd ? MrbT[r] : 0.f; MrkT[r] = r <= dd ? MrkT[r] : 0.f;
            TT[r] = LT[r] + (r == dd ? 1.f : 0.f);
        }
        const v2u bL = pk4(L), bLT = pk4(LT), bLak = pk4(Lak);
        const f32x4 L2m = mm16(bLT, bL, z4), L2T = mm16(bL, bLT, z4);
        const v2u bL2 = pk4(L2m), bL2T = pk4(L2T);
        const f32x4 L4m = mm16(bL2T, bL2, z4), L4T = mm16(bL2, bL2T, z4);
        const v2u bL4 = pk4(L4m), bL4T = pk4(L4T);
        const v2u bL8 = pk4(mm16(bL4T, bL4, z4));
        TT = mm16(bL2, pk4(TT), TT); TT = mm16(bL4, pk4(TT), TT); TT = mm16(bL8, pk4(TT), TT);
        f32x4 Zm = mm16(bL, pk4(MrbT), MrbT); Zm = mm16(bL2, pk4(Zm), Zm); Zm = mm16(bL4, pk4(Zm), Zm); Zm = mm16(bL8, pk4(Zm), Zm);
        const v2u bTT = pk4(TT), bMtT = pk4(Zm);
        *(v2u*)(rec + REC_TK + lane * 8) = pk4(mm16(bLak, bTT, z4)); *(v2u*)(rec + REC_MY + lane * 8) = pk4(mm16(bLak, bMtT, MrkT));
        LAS unsigned char* ir = sc + (4 * fq + ((lane & 15) >> 2)) * 144 + 8 * (lane & 3);
        v2u wat[4], rpt[4];
#pragma unroll
        for (int jt = 0; jt < 4; ++jt) {
            const v2u Qa = tr16(ir + 0 * IMG + 32 * jt), Qb = tr16(ir + 1 * IMG + 32 * jt), Qk = tr16(ir + 2 * IMG + 32 * jt);
            wat[jt] = pk4(mm16(Qa, bTT, z4)); rpt[jt] = pk4(mm16(Qa, bMtT, rt[jt]));
            *(v4u*)(rec + REC_BK + (jt * 64 + lane) * 16) = (v4u){Qb.x, Qb.y, Qk.x, Qk.y};
        }
#pragma unroll
        for (int s = 0; s < 2; ++s) {
            *(v4u*)(rec + REC_WA + (s * 64 + lane) * 16) = (v4u){wat[2 * s].x, wat[2 * s].y, wat[2 * s + 1].x, wat[2 * s + 1].y};
            *(v4u*)(rec + REC_RP + (s * 64 + lane) * 16) = (v4u){rpt[2 * s].x, rpt[2 * s].y, rpt[2 * s + 1].x, rpt[2 * s + 1].y};
        }
#pragma unroll
        for (int it = 0; it < 4; ++it) {
            const v2u Qv = tr16(ir + 3 * IMG + 32 * it);
            *(v2u*)(rec + REC_VV + (it * 64 + lane) * 8) = Qv;

        }
    }
}

#undef W1_LOAD_RAW
#undef W1_UNSWAP
__device__ __forceinline__ void ph_wkv2(const Params& p, int jl, int lane, int wave) {
    const bf16* Kr = (const bf16*)(p.ws + WS_K); const bf16* Vr = (const bf16*)(p.ws + (jl == 0 ? WS_VF : WS_VB)); const bf16* VFp = (const bf16*)(p.ws + WS_VF);
    const bf16* Rr = (const bf16*)(p.ws + WS_R); const bf16* L2 = (const bf16*)(p.ws + WS_L2);
    float* BON = (float*)(p.ws + WS_NKK); bf16* VP = (bf16*)(p.ws + WS_KKA);
    const bool vres = jl == 1; const int ri = lane >> 4, cg = lane & 15;
    bf16* YW = (bf16*)(p.ws + WS_YW);
    const int fr = lane & 15, fq = lane >> 4;
    const int gw = blockIdx.x * NWAVES + wave, NGW = gridDim.x * NWAVES;
    for (int job = wave < 2 ? blockIdx.x * 2 + wave : BATCH * WH * 4; job < BATCH * WH * 4; job += gridDim.x * 2) {
        const int it = job & 3, h = (job >> 2) & 15, seq = job >> 6, r0 = seq * TP;
        const unsigned char* rec = p.ws + WS_REC + (size_t)((seq * WH + h) * WC_NCH) * REC_BYTES;
        f32x4 Sacc[4];
#pragma unroll
        for (int jt = 0; jt < 4; ++jt) Sacc[jt] = (f32x4){0.f, 0.f, 0.f, 0.f};
        struct WRec { v4u wa0, wa1, rp0, rp1, bk0, bk1, bk2, bk3; v2u vv, tk, my; f32x4 g0, g1, g2, g3; };
        WRec RA, RB;
#define WC_LOAD(S, rc) do { const unsigned char* r_ = (rc); \
            S.wa0 = *(const v4u*)(r_ + REC_WA + lane * 16); S.wa1 = *(const v4u*)(r_ + REC_WA + 1024 + lane * 16); S.rp0 = *(const v4u*)(r_ + REC_RP + lane * 16); S.rp1 = *(const v4u*)(r_ + REC_RP + 1024 + lane * 16); \
            S.bk0 = *(const v4u*)(r_ + REC_BK + (0 * 64 + lane) * 16); S.bk1 = *(const v4u*)(r_ + REC_BK + (1 * 64 + lane) * 16); S.bk2 = *(const v4u*)(r_ + REC_BK + (2 * 64 + lane) * 16); S.bk3 = *(const v4u*)(r_ + REC_BK + (3 * 64 + lane) * 16); \
            S.g0 = *(const f32x4*)(r_ + REC_GC + (0 + 4 * fq) * 4); S.g1 = *(const f32x4*)(r_ + REC_GC + (16 + 4 * fq) * 4); S.g2 = *(const f32x4*)(r_ + REC_GC + (32 + 4 * fq) * 4); S.g3 = *(const f32x4*)(r_ + REC_GC + (48 + 4 * fq) * 4); \
            S.vv = *(const v2u*)(r_ + REC_VV + (it * 64 + lane) * 8); S.tk = *(const v2u*)(r_ + REC_TK + lane * 8); S.my = *(const v2u*)(r_ + REC_MY + lane * 8); } while (0)
#define WC_STEP(S, T, cc) do { const int c_ = (cc); \
            if (c_ > 0) *(v2u*)(YW + (size_t)(r0 + WC_C * (c_ - 1) + 4 * fq + (fr & 3)) * D + h * WN + 16 * it + (fr & 12)) = ypk;     \
            const f32x4 zz4 = (f32x4){0.f, 0.f, 0.f, 0.f}, cu0 = mm16(S.tk, S.vv, zz4) + 0.f, cy0 = mm16(S.my, S.vv, zz4) + 0.f;     \
            v4u sb0, sb1; \
            { const v2u q0 = pk4(Sacc[0]), q1 = pk4(Sacc[1]), q2 = pk4(Sacc[2]), q3 = pk4(Sacc[3]); sb0 = (v4u){q0.x, q0.y, q1.x, q1.y}; sb1 = (v4u){q2.x, q2.y, q3.x, q3.y}; } \
            const bf16x8 B0 = __builtin_bit_cast(bf16x8, sb0), B1 = __builtin_bit_cast(bf16x8, sb1); \
            f32x4 U = __builtin_amdgcn_mfma_f32_16x16x32_bf16(__builtin_bit_cast(bf16x8, S.wa0), B0, cu0, 0, 0, 0); \
            U = __builtin_amdgcn_mfma_f32_16x16x32_bf16(__builtin_bit_cast(bf16x8, S.wa1), B1, U, 0, 0, 0); \
            f32x4 Y = __builtin_amdgcn_mfma_f32_16x16x32_bf16(__builtin_bit_cast(bf16x8, S.rp0), B0, cy0, 0, 0, 0); \
            Y = __builtin_amdgcn_mfma_f32_16x16x32_bf16(__builtin_bit_cast(bf16x8, S.rp1), B1, Y, 0, 0, 0); \
            v4u ub; { const v2u qu = pk4(U); ub.x = qu.x; ub.y = qu.y; } ub.z = S.vv.x; ub.w = S.vv.y; \
            const bf16x8 UB = __builtin_bit_cast(bf16x8, ub); \
            Sacc[0] = __builtin_amdgcn_mfma_f32_16x16x32_bf16(__builtin_bit_cast(bf16x8, S.bk0), UB, Sacc[0], 0, 0, 0) * S.g0; \
            Sacc[1] = __builtin_amdgcn_mfma_f32_16x16x32_bf16(__builtin_bit_cast(bf16x8, S.bk1), UB, Sacc[1], 0, 0, 0) * S.g1; \
            Sacc[2] = __builtin_amdgcn_mfma_f32_16x16x32_bf16(__builtin_bit_cast(bf16x8, S.bk2), UB, Sacc[2], 0, 0, 0) * S.g2; \
            Sacc[3] = __builtin_amdgcn_mfma_f32_16x16x32_bf16(__builtin_bit_cast(bf16x8, S.bk3), UB, Sacc[3], 0, 0, 0) * S.g3; \
            if (c_ + 2 < WC_NCH) WC_LOAD(S, rec + (size_t)(c_ + 2) * REC_BYTES);     \
            { float yq[4] = {Y[0], Y[1], Y[2], Y[3]}; quad_transpose4(yq, fr & 3); ypk = pk4((f32x4){yq[0], yq[1], yq[2], yq[3]}); } } while (0)
        static_assert(WC_NCH % 2 == 1, "chunk loop unrolled by two plus one");
        WC_LOAD(RA, rec); WC_LOAD(RB, rec + REC_BYTES);
        v2u ypk = (v2u){0u, 0u};
        for (int c = 0; c + 1 < WC_NCH; c += 2) { WC_STEP(RA, RB, c); WC_STEP(RB, RA, c + 1); }
        WC_STEP(RA, RB, WC_NCH - 1);
        *(v2u*)(YW + (size_t)(r0 + WC_C * (WC_NCH - 1) + 4 * fq + (fr & 3)) * D + h * WN + 16 * it + (fr & 12)) = ypk;
#undef WC_STEP
#undef WC_LOAD
        float* so = p.out + O_WKVP + ((((size_t)jl * BATCH + seq) * WH + h) * WN + 16 * it + fr) * WN + 4 * fq;
#pragma unroll
        for (int jt = 0; jt < 4; ++jt) *(f32x4*)(so + 16 * jt) = Sacc[jt];
    }
    if (wave >= 2) {
        const int gws = blockIdx.x * (NWAVES - 2) + (wave - 2), NGWS = gridDim.x * (NWAVES - 2);
        constexpr int UB = 4;
        for (int it0 = gws; it0 < SB * WH * 16; it0 += NGWS * UB) {
            v2u qk[UB], qv[UB], qr[UB], qlw[UB], qla[UB], qvf[UB], qlv[UB]; f32x4 qS[UB];
#pragma unroll
            for (int q = 0; q < UB; ++q) { const int it_ = it0 + q * NGWS, itc = it_ < SB * WH * 16 ? it_ : it0;
                const int rg = itc & 15, h = (itc >> 4) & 15, s = itc >> 8, row = MP + s, i = 4 * rg + ri, ch = h * WN + 4 * cg;
                const size_t vo = (size_t)row * D + ch, lo = (size_t)row * NL2 + ch;
                qk[q] = *(const v2u*)(Kr + vo); qv[q] = *(const v2u*)(Vr + vo); qr[q] = *(const v2u*)(Rr + vo); qlw[q] = *(const v2u*)(L2 + lo); qla[q] = *(const v2u*)(L2 + lo + 1024);
                qvf[q] = (v2u){0u, 0u}; qlv[q] = (v2u){0u, 0u};
                if (vres) { qvf[q] = *(const v2u*)(VFp + vo); qlv[q] = *(const v2u*)(L2 + lo + 3072); }
                qS[q] = *(const f32x4*)(p.in[I_SWKV] + ((((size_t)jl * SB + s) * WH + h) * WN + i) * WN + 4 * cg); }
#pragma unroll
            for (int q = 0; q < UB; ++q) { const int it = it0 + q * NGWS; if (it < SB * WH * 16) {
                const int rg = it & 15, h = (it >> 4) & 15, s = it >> 8, row = MP + s, i = 4 * rg + ri;
                const int ch = h * WN + 4 * cg;
                WkPar P; P.w0 = *(const f32x4*)(p.in[I_W0] + (size_t)jl * D + ch); P.a0 = *(const f32x4*)(p.in[I_A0] + (size_t)jl * D + ch); P.kkp = *(const f32x4*)(p.in[I_KK] + (size_t)jl * D + ch);
                P.kap = *(const f32x4*)(p.in[I_KA] + (size_t)jl * D + ch); P.v0 = *(const f32x4*)(p.in[I_V0] + ch);
                const size_t vo = (size_t)row * D + ch;
#define W2_UP4(w) ((f32x4){bf_lo((w).x), bf_hi((w).x), bf_lo((w).y), bf_hi((w).y)})
                const f32x4 kraw = W2_UP4(qk[q]), vraw = W2_UP4(qv[q]), r4 = W2_UP4(qr[q]), lw2 = W2_UP4(qlw[q]), la2 = W2_UP4(qla[q]), vf = W2_UP4(qvf[q]), lv2 = W2_UP4(qlv[q]);
#undef W2_UP4
                f32x4 w4, ka, k4, vp, nk; wk_prep(P, kraw, vraw, lw2, la2, vf, lv2, vres, w4, ka, k4, vp, nk);
                const int srcl = (lane & 48) | rg;
                const float v0_ = shfl_l(vp.x, srcl), v1_ = shfl_l(vp.y, srcl), v2_ = shfl_l(vp.z, srcl), v3_ = shfl_l(vp.w, srcl);
                const float vi = ri == 0 ? v0_ : (ri == 1 ? v1_ : (ri == 2 ? v2_ : v3_));
                const size_t so = ((((size_t)jl * SB + s) * WH + h) * WN + i) * WN + 4 * cg;
                f32x4 S = qS[q];
                const float sa = row16_sum((S.x * nk.x + S.y * nk.y) + (S.z * nk.z + S.w * nk.w));
                S.x = fmaf(S.x, w4.x, fmaf(sa, ka.x, vi * k4.x)); S.y = fmaf(S.y, w4.y, fmaf(sa, ka.y, vi * k4.y));
                S.z = fmaf(S.z, w4.z, fmaf(sa, ka.z, vi * k4.z)); S.w = fmaf(S.w, w4.w, fmaf(sa, ka.w, vi * k4.w));
                const float y = row16_sum((S.x * r4.x + S.y * r4.y) + (S.z * r4.z + S.w * r4.w));
                *(f32x4*)(p.out + O_WKVS + so) = S;
                if (cg == 0) YW[(size_t)row * D + h * WN + i] = bf_cv(y);
                const f32x4 rk4 = *(const f32x4*)(p.in[I_RK] + (size_t)jl * D + ch);
                const float bon = row16_sum((r4.x * k4.x * rk4.x + r4.y * k4.y * rk4.y) + (r4.z * k4.z * rk4.z + r4.w * k4.w * rk4.w));
                if (rg == 0 && ri == 0) { if (vres) st_bf4(VP + vo, vp); if (cg == 0) BON[(size_t)row * WH + h] = bon; }
            } }
        }
    }
}

typedef __attribute__((address_space(1))) unsigned gu32;
#define XB_TMO      128
#define XB_XCNT(j)  (256  + 64 * (j))
#define XB_XSUB(j)  (1280 + 64 * (j))
#define XB_XGEN(j)  (2304 + 64 * (j))
#define XB_TOP      3328
#define XB_TOPGEN   3392
#define XCD_BAR_WORDS 3456
#define XB_SPIN_CAP (1u << 18)

__device__ __forceinline__ unsigned xb_ld(unsigned* p)              { return __hip_atomic_load(p, __ATOMIC_RELAXED, __HIP_MEMORY_SCOPE_AGENT); }
__device__ __forceinline__ unsigned xb_add(unsigned* p, unsigned v) { return __hip_atomic_fetch_add(p, v, __ATOMIC_RELAXED, __HIP_MEMORY_SCOPE_AGENT); }
__device__ __forceinline__ unsigned xb_xcc_id() { return (unsigned)__builtin_amdgcn_s_getreg((3 << 11) | 20) & 0xFu; }
#define XB_SPIN(cond, bar) do { unsigned _sp = 0; while (cond) { __builtin_amdgcn_s_sleep(1); \
    if ((++_sp & 255u) == 0u) { if (xb_ld(&(bar)[XB_TMO])) break; if (_sp > XB_SPIN_CAP) { atomicAdd(&(bar)[XB_TMO], 1u); break; } } } } while (0)

struct XcdBarrier {
    bool tid0; unsigned* bar; unsigned x;
    volatile LAS unsigned* st;
};

__device__ __forceinline__ XcdBarrier xcd_barrier_post(unsigned* bar, volatile LAS unsigned* st, bool tid0) {
    XcdBarrier b; b.tid0 = tid0; b.bar = bar; b.x = xb_xcc_id(); b.st = st;
    if (b.tid0) (void)xb_add(&bar[XB_XCNT(b.x)], 1u);
    return b;
}
__device__ __forceinline__ void xcd_barrier_complete(unsigned* bar, unsigned x, unsigned& nloc, unsigned& nx) {
    const unsigned G = gridDim.x * gridDim.y * gridDim.z;
    unsigned sum, cnt, mine, sp = 0u;
    for (;;) {
        sum = 0u; cnt = 0u; mine = 0u;
#pragma unroll
        for (unsigned j = 0; j < 16; ++j) { const unsigned c = xb_ld(&bar[XB_XCNT(j)]); sum += c; cnt += (c > 0u) ? 1u : 0u; mine = (j == x) ? c : mine; }
        if (sum == G) break;
        __builtin_amdgcn_s_sleep(1);
        if ((++sp & 255u) == 0u) { if (xb_ld(&bar[XB_TMO])) break; if (sp > XB_SPIN_CAP) { atomicAdd(&bar[XB_TMO], 1u); break; } }
    }
    nloc = mine > 0u ? mine : 1u; nx = cnt > 0u ? cnt : 1u;
}

__device__ __forceinline__ void xcd_barrier(const XcdBarrier& b) {
    asm volatile("s_waitcnt vmcnt(0)" ::: "memory");
    __syncthreads();
    if (b.tid0) {
        unsigned* bar = b.bar;
        __builtin_amdgcn_s_waitcnt(0);
        unsigned nloc = b.st[0], nx = b.st[1];
        if (nloc == 0u) { xcd_barrier_complete(bar, b.x, nloc, nx); b.st[0] = nloc; b.st[1] = nx; }
        const unsigned old = xb_add(&bar[XB_XSUB(b.x)], 1u);
        const unsigned gen = old / nloc;
        if (old + 1u == (gen + 1u) * nloc) {
            __builtin_amdgcn_fence(__ATOMIC_RELEASE, "agent");
            asm volatile("s_waitcnt vmcnt(0)" ::: "memory");
            const unsigned og = xb_add(&bar[XB_TOP], 1u);
            const unsigned tg = og / nx;
            if (og + 1u == (tg + 1u) * nx) xb_add(&bar[XB_TOPGEN], 1u);
            else XB_SPIN(xb_ld(&bar[XB_TOPGEN]) == tg, bar);
            __builtin_amdgcn_fence(__ATOMIC_ACQUIRE, "agent");
            xb_add(&bar[XB_XGEN(b.x)], 1u);
            asm volatile("s_waitcnt vmcnt(0)" ::: "memory");
        } else {
            XB_SPIN(xb_ld(&bar[XB_XGEN(b.x)]) == gen, bar);
            __builtin_amdgcn_fence(__ATOMIC_ACQUIRE, "agent");
            asm volatile("s_waitcnt vmcnt(0)" ::: "memory");
        }
    }
    __syncthreads();
}

enum { OP_P0 = 0, OP_NORM_RET, OP_G_RETIN, OP_RET, OP_RETNORM, OP_G_RETOUT, OP_NORM_RW, OP_G_RWPROJ, OP_G_LORA2, OP_PREP, OP_WKV, OP_WKV2, OP_POST, OP_G_WO,
       OP_NORM_FFN, OP_G_UG, OP_CONV, OP_G_WD, OP_FINAL };
struct Ph { unsigned char op, layer; };
constexpr int NPH = 1 + 2 * 6 + 2 * 9 + 1;
__device__ __host__ inline Ph phase_at(int i) {
    if (i == 0) return Ph{OP_P0, 0};
    i -= 1;
    int l;
    if (i < 6) l = 0; else if (i < 15) { l = 1; i -= 6; } else if (i < 21) { l = 2; i -= 15; } else if (i < 30) { l = 3; i -= 21; } else return Ph{OP_FINAL, 0};
    int op = OP_FINAL;
    if ((l & 1) == 0) {
        switch (i) { case 0: op = OP_G_RETIN; break; case 1: op = OP_RET; break; case 2: op = OP_RETNORM; break; case 3: op = OP_G_RETOUT; break;
                     case 4: op = OP_G_UG; break; default: op = OP_G_WD; break; }
    } else {
        switch (i) { case 0: op = OP_NORM_RW; break; case 1: op = OP_G_RWPROJ; break; case 2: op = OP_G_LORA2; break; case 3: op = OP_WKV; break; case 4: op = OP_WKV2; break; case 5: op = OP_POST; break; case 6: op = OP_G_WO; break;
                     case 7: op = OP_G_UG; break; default: op = OP_G_WD; break; }
    }
    return Ph{(unsigned char)op, (unsigned char)l};
}

__global__ void __launch_bounds__(NTHR, 2) mega(Params p, int lo, int hi) {
    extern __shared__ __attribute__((aligned(16))) unsigned char lds_raw[];
    LAS unsigned char* lds = (LAS unsigned char*)lds_raw;
    volatile LAS unsigned* bst = (volatile LAS unsigned*)(lds + LDS_BYTES - 16);
    const int wave0 = __builtin_amdgcn_readfirstlane((int)threadIdx.x >> 6);
    if (threadIdx.x < 4) bst[threadIdx.x] = 0u;
    __syncthreads();
    (void)xcd_barrier_post((unsigned*)(p.ws + WS_CTL), bst, threadIdx.x == 0);
    for (int ph = lo; ph < hi; ++ph) {
        int lid_; asm volatile("v_mbcnt_lo_u32_b32 %0, -1, 0\n\tv_mbcnt_hi_u32_b32 %0, -1, %0" : "=v"(lid_));
        int tid = wave0 * 64 + lid_; asm volatile("" : "+v"(tid));
        const int lane = tid & 63, wave = __builtin_amdgcn_readfirstlane(tid >> 6);
        unsigned char* ws = p.ws;
        const Ph P = phase_at(ph);
        const int li = P.layer, jl = li >> 1;
        const bf16* gA = nullptr; const bf16* gB = nullptr; int gN = 0, gK = 0; EpiAnyT<0> E{}; E.jl = jl; E.ws = ws; E.slot = -1; E.amul = 1.f; E.li = li; E.ldsb = lds; bool is_gemm = false;
        switch (P.op) {
        case OP_P0: ph_p0(p, lds, tid, lane, wave); break;
        case OP_NORM_RET: ph_norm(p, p.in[I_NMIX] + (size_t)li * D, 0, jl, lane, wave); break;
        case OP_NORM_FFN: ph_norm(p, p.in[I_NFFN] + (size_t)li * D, 0, jl, lane, wave); break;
        case OP_NORM_RW: ph_norm(p, p.in[I_NMIX] + (size_t)li * D, 1, jl, lane, wave); break;
        case OP_FINAL: ph_norm(p, p.in[I_NFIN], 2, 0, lane, wave); break;
        case OP_RETNORM: ph_ret_norm(p, jl, lane, wave); break;
        case OP_POST: ph_rwkv_post(p, jl, lane, wave); break;
        case OP_RET: ph_ret_fast(p, jl, lds, tid, lane, wave); break;
        case OP_WKV: ph_wkv1(p, jl, lds, lane, wave); break;
        case OP_WKV2: ph_wkv2(p, jl, lane, wave); break;
        case OP_G_RETIN: is_gemm = true; E.kind = EK_RETIN; E.perm = true; E.slot = 2 * li;
            gA = (const bf16*)(ws + WS_XB); gB = (const bf16*)(ws + WS_WIN + jl * SZ_WIN); gN = RWIN; gK = D; break;
        case OP_G_RETOUT: is_gemm = true; E.kind = EK_RESID; E.perm = false; E.slot = 2 * li + 1;
            gA = (const bf16*)(ws + WS_Y); gB = (const bf16*)(ws + WS_WOUT + jl * SZ_WOUT); gN = D; gK = RV; break;
        case OP_G_RWPROJ: is_gemm = true; E.kind = EK_RWPROJ; E.perm = true;
            gA = (const bf16*)(ws + WS_H) + D; gB = (const bf16*)(ws + WS_WRW + jl * SZ_WRW); gN = NRW; gK = KRW; break;
        case OP_G_LORA2: is_gemm = true; E.kind = EK_F32; E.perm = true;
            gA = (const bf16*)(ws + WS_A2); gB = (const bf16*)(ws + WS_WL2 + jl * SZ_WL2); gN = (jl == 0 ? 3072 : 4096); gK = KL2; break;
        case OP_G_WO: is_gemm = true; E.kind = EK_RESID; E.perm = false; E.slot = 2 * li + 1;
            gA = (const bf16*)(ws + WS_Z); gB = (const bf16*)(ws + WS_WO + jl * SZ_WO); gN = D; gK = D; break;
        case OP_G_UG: is_gemm = true; E.kind = EK_UG; E.perm = true; E.slot = 2 * li + 1;
            gA = (const bf16*)(ws + WS_XB); gB = (const bf16*)(ws + WS_WUG + li * SZ_WUG); gN = 2 * DFF; gK = D; break;
        case OP_G_WD: is_gemm = true; E.kind = EK_RESID; E.perm = false; E.slot = (li == 1) ? 2 * (li + 1) : -1;
            gA = (const bf16*)(ws + WS_ACT); gB = (const bf16*)(ws + WS_WD + li * SZ_WD); gN = D; gK = DFF; break;
        default: break;
        }
        if (is_gemm) {
            const bool ug = E.kind == EK_UG;
            const bool rwp = E.kind == EK_RWPROJ;
            const int gM = (E.kind == EK_RESID) ? MT0 : (ug ? 66 * 256 : (rwp ? HP_M : M));
            pg8::Gemm g{ug ? gA - 2 * D : gA, gB, gM, gN, gK, ug ? 254 : 256};
            if (E.kind == EK_F32) { g.kshift = 2; g.ktab = (0u | 2u << 4) | (0u | 2u << 4) << 8 | (2u | 4u << 4) << 16 | (4u | 2u << 4) << 24; }
            if (rwp) { g.lda = D; g.ksplit = D / pg8::BK; g.kdelta = -(long)(D * 2) - (long)(D * 2); }
            pg8::StaticOrder S; S.init(gM, gN, (int)gridDim.x, (int)blockIdx.x);
            if (E.kind == EK_RETIN || E.kind == EK_UG) {
                LAS float* rt = (LAS float*)(lds + 131072);
                Unit uu;
                for (int ui = 0; ui < 8 && S.next(ui, uu); ++ui) if (tid < 256) { int rr = ug ? 254 * uu.pm - 2 + tid : uu.pm * 256 + tid; rr = rr < 0 ? 0 : (rr > M - 1 ? M - 1 : rr); rt[ui * 256 + tid] = row_rstd(ws, E.slot, rr); }
                E.rtab = rt; E.ldsb = lds;
                __syncthreads();
            }
            if (ug) { EpiAnyT<1> E1{}; E1.kind = E.kind; E1.perm = E.perm; E1.jl = E.jl; E1.ws = E.ws; E1.slot = E.slot; E1.rtab = E.rtab; E1.amul = E.amul; E1.li = E.li; E1.ldsb = E.ldsb; E1.pcw = p.in[I_CW]; E1.pcb = p.in[I_CB]; E1.pcst = p.in[I_SCONV]; E1.pout = p.out;
                pg8::gemm_phase<EpiAnyT<1>, pg8::StaticOrder, true, true>(lds, g, S, E1, tid); }
            else pg8::gemm_phase<EpiAnyT<0>, pg8::StaticOrder, true, true>(lds, g, S, E, tid);
            if (E.kind == EK_RESID) tail_resid(gA, gB, gK, ws, E.slot, E.amul, lds, lane, wave);
        }
        if (ph + 1 < hi) { XcdBarrier bar; bar.tid0 = tid == 0; bar.bar = (unsigned*)(p.ws + WS_CTL); bar.x = xb_xcc_id(); bar.st = (volatile LAS unsigned*)(lds + LDS_BYTES - 16); xcd_barrier(bar); }
    }
}

}

extern "C" void kernel_launch(void* const* d_in, const int* in_sizes, int n_in, void* d_out, int out_size, void* d_ws, size_t ws_size, hipStream_t stream) {
    static int grid = 0;
    if (grid == 0) {
        int dev = 0, cus = 0;
        if (n_in != N_IN || ws_size < WS_END2) { fprintf(stderr, "kernel_launch: unexpected n_in %d / ws_size %zu (need %zu)\n", n_in, ws_size, (size_t)WS_END2); grid = -1; return; }
        if (hipGetDevice(&dev) != hipSuccess || hipDeviceGetAttribute(&cus, hipDeviceAttributeMultiprocessorCount, dev) != hipSuccess) { grid = -1; return; }
        if (hipFuncSetAttribute((const void*)mega, hipFuncAttributeMaxDynamicSharedMemorySize, LDS_BYTES) != hipSuccess) { fprintf(stderr, "kernel_launch: hipFuncSetAttribute failed\n"); grid = -1; return; }
        int per_cu = 0;
        if (hipOccupancyMaxActiveBlocksPerMultiprocessor(&per_cu, (const void*)mega, NTHR, LDS_BYTES) != hipSuccess || per_cu < 1) { fprintf(stderr, "kernel_launch: occupancy query says %d\n", per_cu); (void)hipGetLastError(); }
        grid = cus * (per_cu >= 1 ? 1 : 1);
    }
    if (grid < 0) return;
    Params p{};
    for (int i = 0; i < N_IN; ++i) p.in[i] = (const float*)d_in[i];
    p.out = (float*)d_out; p.ws = (unsigned char*)d_ws;
    if (hipMemsetAsync(d_ws, 0, 65536, stream) != hipSuccess) { fprintf(stderr, "kernel_launch: memset failed\n"); return; }
    int lo = 0, hi = NPH;
    void* args[] = {(void*)&p, (void*)&lo, (void*)&hi};
    const hipError_t e = hipLaunchCooperativeKernel((const void*)mega, dim3(grid), dim3(NTHR), args, LDS_BYTES, stream);
    if (e != hipSuccess) fprintf(stderr, "kernel_launch: cooperative launch failed: %s (grid %d)\n", hipGetErrorString(e), grid);
    (void)in_sizes; (void)out_size;
}
```
